# Optimizing an MI355X kernel written in HIP

```python
import math
import jax
import jax.numpy as jnp
from jax import lax
import numpy as np

D_MODEL = 2048
BATCH = 4
SEQ = 2048
DEPTH = 2

GRID_W = 64
EPS = 1e-6
BRANCH_W = D_MODEL // 2
MOD_SCALE = 0.5
ATT_HEAD_DIM = 128
ATT_HEADS = BRANCH_W // ATT_HEAD_DIM
ATT_KV_HEADS = ATT_HEADS // 4
Q_BLOCK = 128
ROPE_THETA = 10000.0
SSD_HEAD_DIM = 64
SSD_HEADS = BRANCH_W // SSD_HEAD_DIM
SSD_GROUPS = 2
SSD_STATE = 128
SSD_CONV = 4
SSD_CHUNK = 128
GDN_HEAD_DIM = 128
GDN_V_HEADS = BRANCH_W // GDN_HEAD_DIM
GDN_QK_HEADS = GDN_V_HEADS // 2
GDN_CONV = 4
GDN_CHUNK = 64
LRU_WIDTH = BRANCH_W
LRU_BLOCKS = 8
LRU_CONV = 4
LRU_C = 8.0

AB_SPLITS = (ATT_HEADS * ATT_HEAD_DIM, ATT_KV_HEADS * ATT_HEAD_DIM, ATT_KV_HEADS * ATT_HEAD_DIM, BRANCH_W,
             BRANCH_W, SSD_GROUPS * SSD_STATE, SSD_GROUPS * SSD_STATE, SSD_HEADS, SSD_HEADS, BRANCH_W)
CD_SPLITS = (GDN_QK_HEADS * GDN_HEAD_DIM, GDN_QK_HEADS * GDN_HEAD_DIM, BRANCH_W, GDN_V_HEADS, GDN_V_HEADS,
             GDN_V_HEADS, GDN_V_HEADS, BRANCH_W, LRU_WIDTH, LRU_WIDTH)
AB_IN = sum(AB_SPLITS)
CD_IN = sum(CD_SPLITS)

kernel_name = "hybrid_bidir_attn_ssd_deltanet_rglru"


def _rmsnorm(x, w):
    xf = x.astype(jnp.float32)
    y = xf * lax.rsqrt(jnp.mean(xf * xf, axis=-1, keepdims=True) + EPS)
    return (y * w.astype(jnp.float32)).astype(x.dtype)


def _l2norm(x):
    return x * lax.rsqrt(jnp.sum(x * x, axis=-1, keepdims=True) + EPS)


def _split(h, sizes):
    outs, start = [], 0
    for s in sizes:
        outs.append(h[..., start:start + s])
        start += s
    return outs


def _flip(t):
    return jnp.flip(t, axis=1)


def _centred_dwconv(x, w, b):
    K, C = w.shape
    y = lax.conv_general_dilated(x, w[:, None, :].astype(x.dtype), window_strides=(1,),
                                 padding=[(K // 2, K - 1 - K // 2)],
                                 dimension_numbers=('NWC', 'WIO', 'NWC'), feature_group_count=C)
    return y + b


def _axial_rope(seq_len):
    rows = seq_len // GRID_W
    t = jnp.arange(rows * GRID_W, dtype=jnp.int32)
    row = (t // GRID_W).astype(jnp.float32)
    col = (t % GRID_W).astype(jnp.float32)
    n_pairs = ATT_HEAD_DIM // 4
    freqs = ROPE_THETA ** (-jnp.arange(n_pairs, dtype=jnp.float32) / n_pairs)
    ang = jnp.concatenate([row[:, None] * freqs, col[:, None] * freqs], axis=-1)
    return jnp.cos(ang), jnp.sin(ang)


def _apply_rope(x, cos, sin):
    xf = x.astype(jnp.float32).reshape(*x.shape[:-1], x.shape[-1] // 2, 2)
    x0, x1 = xf[..., 0], xf[..., 1]
    c, s = cos[None, :, None, :], sin[None, :, None, :]
    out = jnp.stack([x0 * c - x1 * s, x0 * s + x1 * c], axis=-1)
    return out.reshape(x.shape).astype(x.dtype)


def _blocked_gqa(q, k, v):
    Bsz, S, H, Dh = q.shape
    Hkv = k.shape[2]
    G = H // Hkv
    nblk = S // Q_BLOCK
    qb = q.reshape(Bsz, nblk, Q_BLOCK, Hkv, G, Dh).transpose(1, 0, 2, 3, 4, 5)
    scale = Dh ** -0.5

    def block(qi):
        s = jnp.einsum('bqkgd,bskd->bkgqs', qi, k, preferred_element_type=jnp.float32) * scale
        p = jax.nn.softmax(s, axis=-1).astype(v.dtype)
        return jnp.einsum('bkgqs,bskd->bqkgd', p, v)

    o = lax.map(block, qb)
    return o.transpose(1, 0, 2, 3, 4, 5).reshape(Bsz, S, H * Dh)


def _ssd_scan(x, dt, A, Bm, Cm):
    Bsz, S, H, P = x.shape
    N = Bm.shape[-1]
    L = SSD_CHUNK
    nc = S // L
    xd = (x * dt[..., None]).reshape(Bsz, nc, L, H, P)
    a = (dt * A).reshape(Bsz, nc, L, H).transpose(0, 3, 1, 2)
    Bc = Bm.reshape(Bsz, nc, L, H, N)
    Cc = Cm.reshape(Bsz, nc, L, H, N)
    a_cs = jnp.cumsum(a, axis=-1)
    incl = jnp.tril(jnp.ones((L, L), dtype=bool))
    Lmat = jnp.exp(jnp.where(incl, a_cs[..., :, None] - a_cs[..., None, :], -jnp.inf))
    y_diag = jnp.einsum('bclhn,bcshn,bhcls,bcshp->bclhp', Cc, Bc, Lmat, xd)
    decay_states = jnp.exp(a_cs[..., -1:] - a_cs)
    states = jnp.einsum('bclhn,bhcl,bclhp->bchpn', Bc, decay_states, xd)
    chunk_decay = jnp.exp(a_cs[..., -1])

    def step(prev, inp):
        st, dec = inp
        return prev * dec[..., None, None] + st, prev

    init = jnp.zeros((Bsz, H, P, N), x.dtype)
    _, prev_states = lax.scan(step, init, (jnp.moveaxis(states, 1, 0), jnp.moveaxis(chunk_decay, 2, 0)))
    prev_states = jnp.moveaxis(prev_states, 0, 1)
    y_off = jnp.einsum('bclhn,bchpn,bhcl->bclhp', Cc, prev_states, jnp.exp(a_cs))
    return (y_diag + y_off).reshape(Bsz, S, H, P)


def _bidir_ssd(xs, bs, cs, dtf, dtb, z, dt_bias_f, dt_bias_b, a_log_f, a_log_b, d_skip, norm_w):
    f32 = jnp.float32
    Bsz, S, _ = xs.shape
    rep = SSD_HEADS // SSD_GROUPS
    xh = xs.astype(f32).reshape(Bsz, S, SSD_HEADS, SSD_HEAD_DIM)
    bh = jnp.repeat(bs.astype(f32).reshape(Bsz, S, SSD_GROUPS, SSD_STATE), rep, axis=2)
    ch = jnp.repeat(cs.astype(f32).reshape(Bsz, S, SSD_GROUPS, SSD_STATE), rep, axis=2)
    dt_f = jax.nn.softplus(dtf.astype(f32) + dt_bias_f.astype(f32))
    dt_b = jax.nn.softplus(dtb.astype(f32) + dt_bias_b.astype(f32))
    y_f = _ssd_scan(xh, dt_f, -jnp.exp(a_log_f.astype(f32)), bh, ch)
    y_b = _flip(_ssd_scan(_flip(xh), _flip(dt_b), -jnp.exp(a_log_b.astype(f32)), _flip(bh), _flip(ch)))
    y = (y_f + y_b + d_skip.astype(f32)[:, None] * xh).reshape(Bsz, S, BRANCH_W)
    return _rmsnorm(y * jax.nn.silu(z.astype(f32)), norm_w)


def _gated_delta_chunked(q, k, v, g, beta):
    Bsz, S, H, Dk = q.shape
    Dv = v.shape[-1]
    L = GDN_CHUNK
    nc = S // L

    def chunks(t):
        return t.reshape(Bsz, nc, L, H, t.shape[-1]).transpose(0, 3, 1, 2, 4)

    qc, kc, vc = chunks(q), chunks(k), chunks(v)
    gc = g.reshape(Bsz, nc, L, H).transpose(0, 3, 1, 2)
    bc = beta.reshape(Bsz, nc, L, H).transpose(0, 3, 1, 2)
    G = jnp.cumsum(gc, axis=-1)
    incl = jnp.tril(jnp.ones((L, L), dtype=bool))
    decay = jnp.exp(jnp.where(incl, G[..., :, None] - G[..., None, :], -jnp.inf))
    k_beta = kc * bc[..., None]
    strict = jnp.tril(jnp.ones((L, L), dtype=q.dtype), -1)
    lower = jnp.einsum('bhcid,bhcjd->bhcij', k_beta, kc) * decay * strict
    eye = jnp.eye(L, dtype=q.dtype)
    T = lax.linalg.triangular_solve(lower + eye, jnp.broadcast_to(eye, lower.shape),
                                    left_side=True, lower=True, unit_diagonal=True)
    u = jnp.einsum('bhcij,bhcjv->bhciv', T, vc * bc[..., None])
    w = jnp.einsum('bhcij,bhcjd->bhcid', T, k_beta * jnp.exp(G)[..., None])
    attn = jnp.einsum('bhcid,bhcjd->bhcij', qc, kc) * decay
    q_dec = qc * jnp.exp(G)[..., None]
    k_dec = kc * jnp.exp(G[..., -1:] - G)[..., None]
    chunk_dec = jnp.exp(G[..., -1])

    def step(state, inp):
        u_c, w_c, a_c, qd_c, kd_c, d_c = inp
        v_new = u_c - jnp.einsum('bhld,bhdv->bhlv', w_c, state)
        o_c = jnp.einsum('bhld,bhdv->bhlv', qd_c, state) + jnp.einsum('bhls,bhsv->bhlv', a_c, v_new)
        state = state * d_c[..., None, None] + jnp.einsum('bhld,bhlv->bhdv', kd_c, v_new)
        return state, o_c

    init = jnp.zeros((Bsz, H, Dk, Dv), q.dtype)
    xs = (jnp.moveaxis(u, 2, 0), jnp.moveaxis(w, 2, 0), jnp.moveaxis(attn, 2, 0),
          jnp.moveaxis(q_dec, 2, 0), jnp.moveaxis(k_dec, 2, 0), jnp.moveaxis(chunk_dec, 2, 0))
    _, o = lax.scan(step, init, xs)
    return o.transpose(1, 0, 3, 2, 4).reshape(Bsz, S, H, Dv)


def _bidir_gated_delta(q, k, v, bf, bb, af, ab, z, a_log_f, a_log_b, dt_bias_f, dt_bias_b, norm_w):
    f32 = jnp.float32
    Bsz, S, _ = q.shape
    rep = GDN_V_HEADS // GDN_QK_HEADS
    q = _l2norm(q.astype(f32).reshape(Bsz, S, GDN_QK_HEADS, GDN_HEAD_DIM)) * GDN_HEAD_DIM ** -0.5
    k = _l2norm(k.astype(f32).reshape(Bsz, S, GDN_QK_HEADS, GDN_HEAD_DIM))
    q = jnp.repeat(q, rep, axis=2)
    k = jnp.repeat(k, rep, axis=2)
    v = v.astype(f32).reshape(Bsz, S, GDN_V_HEADS, GDN_HEAD_DIM)
    g_f = -jnp.exp(a_log_f.astype(f32)) * jax.nn.softplus(af.astype(f32) + dt_bias_f.astype(f32))
    g_b = -jnp.exp(a_log_b.astype(f32)) * jax.nn.softplus(ab.astype(f32) + dt_bias_b.astype(f32))
    beta_f = jax.nn.sigmoid(bf.astype(f32))
    beta_b = jax.nn.sigmoid(bb.astype(f32))
    o = _gated_delta_chunked(q, k, v, g_f, beta_f) + _flip(
        _gated_delta_chunked(_flip(q), _flip(k), _flip(v), _flip(g_b), _flip(beta_b)))
    zz = z.astype(f32).reshape(Bsz, S, GDN_V_HEADS, GDN_HEAD_DIM)
    o = _rmsnorm(o, norm_w) * jax.nn.silu(zz)
    return o.reshape(Bsz, S, BRANCH_W)


def _linear_combine(e1, e2):
    a1, b1 = e1
    a2, b2 = e2
    return a1 * a2, a2 * b1 + b2


def _rglru(xc, w_a, b_a, w_x, b_x, lam, reverse):
    f32 = jnp.float32
    Bsz, S, W = xc.shape
    xb = xc.reshape(Bsz, S, LRU_BLOCKS, W // LRU_BLOCKS)
    r = jax.nn.sigmoid(jnp.einsum('bsni,nij->bsnj', xb, w_a.astype(f32)).reshape(Bsz, S, W) + b_a.astype(f32))
    i = jax.nn.sigmoid(jnp.einsum('bsni,nij->bsnj', xb, w_x.astype(f32)).reshape(Bsz, S, W) + b_x.astype(f32))
    log_a = -LRU_C * r * jax.nn.softplus(-lam.astype(f32))
    a = jnp.exp(log_a)
    u = jnp.sqrt(-jnp.expm1(2.0 * log_a)) * (i * xc)
    _, h = lax.associative_scan(_linear_combine, (a, u), reverse=reverse, axis=1)
    return h


def _ab_mixer(h, w_in, q_norm, k_norm, conv_w, conv_b, dt_bias_f, dt_bias_b, a_log_f, a_log_b,
              d_skip, ssd_norm, w_out):
    Bsz, S, _ = h.shape
    proj = jnp.einsum('bsd,de->bse', h, w_in)
    q, k, v, ga, xs, bs, cs, dtf, dtb, z = _split(proj, AB_SPLITS)
    q = _rmsnorm(q.reshape(Bsz, S, ATT_HEADS, ATT_HEAD_DIM), q_norm)
    k = _rmsnorm(k.reshape(Bsz, S, ATT_KV_HEADS, ATT_HEAD_DIM), k_norm)
    v = v.reshape(Bsz, S, ATT_KV_HEADS, ATT_HEAD_DIM)
    cos, sin = _axial_rope(S)
    att = _blocked_gqa(_apply_rope(q, cos, sin), _apply_rope(k, cos, sin), v) * jax.nn.silu(ga)
    xbc = jax.nn.silu(_centred_dwconv(jnp.concatenate([xs, bs, cs], axis=-1), conv_w, conv_b))
    xs, bs, cs = _split(xbc, (BRANCH_W, SSD_GROUPS * SSD_STATE, SSD_GROUPS * SSD_STATE))
    ssd = _bidir_ssd(xs, bs, cs, dtf, dtb, z, dt_bias_f, dt_bias_b, a_log_f, a_log_b, d_skip, ssd_norm)
    y = jnp.concatenate([att.astype(h.dtype), ssd.astype(h.dtype)], axis=-1)
    return jnp.einsum('bse,ed->bsd', y, w_out)


def _cd_mixer(h, w_in, conv_w, conv_b, a_log_f, a_log_b, dt_bias_f, dt_bias_b, gdn_norm,
              lru_conv_w, lru_conv_b, wa_f, ba_f, wx_f, bx_f, lam_f, wa_b, ba_b, wx_b, bx_b, lam_b, w_out):
    proj = jnp.einsum('bsd,de->bse', h, w_in)
    q, k, v, bf, bb, af, ab, z, xl, gl = _split(proj, CD_SPLITS)
    qkv = jax.nn.silu(_centred_dwconv(jnp.concatenate([q, k, v], axis=-1), conv_w, conv_b))
    q, k, v = _split(qkv, (GDN_QK_HEADS * GDN_HEAD_DIM, GDN_QK_HEADS * GDN_HEAD_DIM, BRANCH_W))
    gdn = _bidir_gated_delta(q, k, v, bf, bb, af, ab, z, a_log_f, a_log_b, dt_bias_f, dt_bias_b, gdn_norm)
    xc = _centred_dwconv(xl, lru_conv_w, lru_conv_b).astype(jnp.float32)
    hs = _rglru(xc, wa_f, ba_f, wx_f, bx_f, lam_f, False) + _rglru(xc, wa_b, ba_b, wx_b, bx_b, lam_b, True)
    lru = hs * jax.nn.silu(gl.astype(jnp.float32))
    y = jnp.concatenate([gdn.astype(h.dtype), lru.astype(h.dtype)], axis=-1)
    return jnp.einsum('bse,ed->bsd', y, w_out)


def setup_inputs(seed: int = 0) -> dict:
    key = jax.random.key(seed)
    ks = iter(jax.random.split(key, 48))
    ne, no = (DEPTH + 1) // 2, DEPTH // 2
    f32 = jnp.float32
    d = D_MODEL

    def nrm(shape, scale):
        return jax.random.normal(next(ks), shape, f32) * scale

    def gain(shape):
        return 1.0 + nrm(shape, 0.02)

    def dt_bias(shape):
        dt = jnp.exp(jax.random.uniform(next(ks), shape, f32, math.log(1e-3), math.log(1e-1)))
        return dt + jnp.log(-jnp.expm1(-dt))

    def a_log(shape):
        return jnp.log(jax.random.uniform(next(ks), shape, f32, 1.0, 16.0))

    def lru_lambda(shape):
        a_c = jax.random.uniform(next(ks), shape, f32, 0.9, 0.999)
        s = a_c ** (1.0 / LRU_C)
        return jnp.log(s) - jnp.log1p(-s)

    ssd_ch = BRANCH_W + 2 * SSD_GROUPS * SSD_STATE
    gdn_ch = 2 * GDN_QK_HEADS * GDN_HEAD_DIM + BRANCH_W
    bw = LRU_WIDTH // LRU_BLOCKS
    return {
        "x": nrm((BATCH, SEQ, d), 1.0),
        "c": nrm((BATCH, d), 1.0),
        "w_mod": nrm((DEPTH, d, 3 * d), MOD_SCALE * d ** -0.5),
        "b_mod": nrm((DEPTH, 3 * d), 0.01),
        "norm_w": gain((DEPTH, d)),
        "ab_w_in": nrm((ne, d, AB_IN), d ** -0.5),
        "ab_q_norm": gain((ne, ATT_HEAD_DIM)),
        "ab_k_norm": gain((ne, ATT_HEAD_DIM)),
        "ab_conv_w": nrm((ne, SSD_CONV, ssd_ch), SSD_CONV ** -0.5),
        "ab_conv_b": nrm((ne, ssd_ch), 0.01),
        "ab_dt_bias_f": dt_bias((ne, SSD_HEADS)),
        "ab_dt_bias_b": dt_bias((ne, SSD_HEADS)),
        "ab_a_log_f": a_log((ne, SSD_HEADS)),
        "ab_a_log_b": a_log((ne, SSD_HEADS)),
        "ab_d_skip": gain((ne, SSD_HEADS)),
        "ab_ssd_norm": gain((ne, BRANCH_W)),
        "ab_w_out": nrm((ne, 2 * BRANCH_W, d), (2 * BRANCH_W) ** -0.5),
        "cd_w_in": nrm((no, d, CD_IN), d ** -0.5),
        "cd_conv_w": nrm((no, GDN_CONV, gdn_ch), GDN_CONV ** -0.5),
        "cd_conv_b": nrm((no, gdn_ch), 0.01),
        "cd_a_log_f": a_log((no, GDN_V_HEADS)),
        "cd_a_log_b": a_log((no, GDN_V_HEADS)),
        "cd_dt_bias_f": dt_bias((no, GDN_V_HEADS)),
        "cd_dt_bias_b": dt_bias((no, GDN_V_HEADS)),
        "cd_gdn_norm": gain((no, GDN_HEAD_DIM)),
        "cd_lru_conv_w": nrm((no, LRU_CONV, LRU_WIDTH), LRU_CONV ** -0.5),
        "cd_lru_conv_b": nrm((no, LRU_WIDTH), 0.01),
        "cd_lru_wa_f": nrm((no, LRU_BLOCKS, bw, bw), bw ** -0.5),
        "cd_lru_ba_f": nrm((no, LRU_WIDTH), 0.01),
        "cd_lru_wx_f": nrm((no, LRU_BLOCKS, bw, bw), bw ** -0.5),
        "cd_lru_bx_f": nrm((no, LRU_WIDTH), 0.01),
        "cd_lru_lam_f": lru_lambda((no, LRU_WIDTH)),
        "cd_lru_wa_b": nrm((no, LRU_BLOCKS, bw, bw), bw ** -0.5),
        "cd_lru_ba_b": nrm((no, LRU_WIDTH), 0.01),
        "cd_lru_wx_b": nrm((no, LRU_BLOCKS, bw, bw), bw ** -0.5),
        "cd_lru_bx_b": nrm((no, LRU_WIDTH), 0.01),
        "cd_lru_lam_b": lru_lambda((no, LRU_WIDTH)),
        "cd_w_out": nrm((no, 2 * BRANCH_W, d), (2 * BRANCH_W) ** -0.5),
        "final_norm_w": gain((d,)),
    }


def reference(x, c, w_mod, b_mod, norm_w,
              ab_w_in, ab_q_norm, ab_k_norm, ab_conv_w, ab_conv_b, ab_dt_bias_f, ab_dt_bias_b,
              ab_a_log_f, ab_a_log_b, ab_d_skip, ab_ssd_norm, ab_w_out,
              cd_w_in, cd_conv_w, cd_conv_b, cd_a_log_f, cd_a_log_b, cd_dt_bias_f, cd_dt_bias_b,
              cd_gdn_norm, cd_lru_conv_w, cd_lru_conv_b, cd_lru_wa_f, cd_lru_ba_f, cd_lru_wx_f,
              cd_lru_bx_f, cd_lru_lam_f, cd_lru_wa_b, cd_lru_ba_b, cd_lru_wx_b, cd_lru_bx_b,
              cd_lru_lam_b, cd_w_out, final_norm_w):
    d = x.shape[-1]
    cond = jax.nn.silu(c)
    for layer in range(DEPTH):
        mod = jnp.einsum('bd,de->be', cond, w_mod[layer]) + b_mod[layer]
        shift, scale, gate = mod[:, :d], mod[:, d:2 * d], mod[:, 2 * d:]
        h = _rmsnorm(x, norm_w[layer]) * (1.0 + scale[:, None, :]) + shift[:, None, :]
        j = layer // 2
        if layer % 2 == 0:
            y = _ab_mixer(h, ab_w_in[j], ab_q_norm[j], ab_k_norm[j], ab_conv_w[j], ab_conv_b[j],
                          ab_dt_bias_f[j], ab_dt_bias_b[j], ab_a_log_f[j], ab_a_log_b[j],
                          ab_d_skip[j], ab_ssd_norm[j], ab_w_out[j])
        else:
            y = _cd_mixer(h, cd_w_in[j], cd_conv_w[j], cd_conv_b[j], cd_a_log_f[j], cd_a_log_b[j],
                          cd_dt_bias_f[j], cd_dt_bias_b[j], cd_gdn_norm[j], cd_lru_conv_w[j],
                          cd_lru_conv_b[j], cd_lru_wa_f[j], cd_lru_ba_f[j], cd_lru_wx_f[j],
                          cd_lru_bx_f[j], cd_lru_lam_f[j], cd_lru_wa_b[j], cd_lru_ba_b[j],
                          cd_lru_wx_b[j], cd_lru_bx_b[j], cd_lru_lam_b[j], cd_w_out[j])
        x = x + gate[:, None, :] * y.astype(x.dtype)
    return _rmsnorm(x, final_norm_w)
```

```cpp
#include <hip/hip_runtime.h>
#include <hip/hip_cooperative_groups.h>
#include <hip/hip_bf16.h>
#include <cstdio>
#include <cstdint>
namespace cg = cooperative_groups;

constexpr int BATCH = 4, SEQ = 2048, DM = 2048, MTOK = BATCH * SEQ;
constexpr int NIN = 5152, NINP = 5376;
constexpr float EPS = 1e-6f;
constexpr int A_Q = 0, A_K = 1024, A_V = 1280, A_GA = 1536, A_XS = 2560, A_BS = 3584, A_CS = 3840, A_DT = 4096, A_Z = 4128;
constexpr int C_Q = 0, C_K = 512, C_V = 1024, C_SM = 2048, C_Z = 2080, C_XL = 3104, C_GL = 4128;
namespace pg8 {
#define PG8_LAS __attribute__((address_space(3)))
typedef unsigned short bf16_t;
typedef short bf16x8 __attribute__((ext_vector_type(8)));
typedef float f32x4 __attribute__((ext_vector_type(4)));
typedef unsigned u32x4 __attribute__((ext_vector_type(4)));
constexpr int BM = 256, BK = 64, HALF = 128, HTB = HALF * BK * 2  , STAGE_BYTES = 8 * HTB, NXCD = 8, WGM = 8;

__host__ __device__ __forceinline__ int lds_byte(int r, int c) { const int st = (r >> 4) * 2 + (c >> 5), rr = r & 15, cc = c & 31, ob = rr * 64 + cc * 2; return st * 1024 + (ob ^ (((ob >> 9) & 1) << 5)); }
__host__ __device__ __forceinline__ void stage_rc(int b, int& R, int& C) { const int st = b / 1024, sb = b % 1024, swz = sb ^ (((sb >> 9) & 1) << 5); R = (st >> 1) * 16 + swz / 64; C = (st & 1) * 32 + (swz % 64) / 2; }
__host__ __device__ __forceinline__ int perm32(int rho) { const int n = rho >> 4, i = rho & 15; return 8 * (i >> 2) + 4 * n + (i & 3); }

struct Unit { int pm, pn; };
struct Gemm { const bf16_t* A; const bf16_t* Bt; int M, N, K; };

struct StaticOrder {
    int nM, nN, nwg, G, c;
    __host__ __device__ void init(int M, int N, int G_, int c_) { nM = M / BM; nN = N / BM; nwg = nM * nN; G = G_; c = c_; }
    __host__ __device__ bool next(int i, Unit& u) const {
        const long L = (long)i * G + c; if (L >= nwg) return false;
        int wgid = (int)L; { const int q = nwg / NXCD, r = nwg % NXCD, xcd = wgid % NXCD, off = wgid / NXCD; wgid = (xcd < r ? xcd * (q + 1) : r * (q + 1) + (xcd - r) * q) + off; }
        const int nig = WGM * nN, gid = wgid / nig, fm = gid * WGM, gsz = (nM - fm) < WGM ? (nM - fm) : WGM;
        u.pm = fm + ((wgid % nig) % gsz); u.pn = (wgid % nig) / gsz; return true;
    }
    __device__ __forceinline__ void a_ready(const Unit&) const {}
    __device__ __forceinline__ void done(const Unit&) const {}
};

__device__ __forceinline__ unsigned cvt_pk_bf16(float lo, float hi) { unsigned r; asm volatile("v_cvt_pk_bf16_f32 %0, %1, %2" : "=v"(r) : "v"(lo), "v"(hi)); return r; }
typedef float f32x2 __attribute__((ext_vector_type(2)));
struct EpiProj {
    static constexpr bool PERM = true, AFTER_DRAIN = false;
    bf16_t* O; float* small; int ldc; int small_tile;
    __device__ __forceinline__ void operator()(const f32x4 (&acc)[2][2][4][2], const Unit& u, int wr, int wc, int fr, int fq) const {
        const int row0 = u.pm * BM + wr * 64 + fr; const int col0 = u.pn * BM + wc * 32 + 8 * fq;
        const bool sm = (u.pn == small_tile) && (wc == 0);
#pragma unroll
        for (int ai = 0; ai < 2; ++ai)
#pragma unroll
            for (int m = 0; m < 4; ++m) { const int row = row0 + ai * HALF + m * 16; bf16_t* rowp = O + (size_t)row * ldc + col0;
#pragma unroll
                for (int bj = 0; bj < 2; ++bj) { const f32x4 v0 = acc[ai][bj][m][0], v1 = acc[ai][bj][m][1];
                    u32x4 w; w.x = cvt_pk_bf16(v0[0], v0[1]); w.y = cvt_pk_bf16(v0[2], v0[3]); w.z = cvt_pk_bf16(v1[0], v1[1]); w.w = cvt_pk_bf16(v1[2], v1[3]);
                    *(u32x4*)(rowp + bj * HALF) = w; }
                if (sm) { float* sp = small + (size_t)row * 32 + 8 * fq; *(f32x4*)sp = acc[ai][0][m][0]; *(f32x4*)(sp + 4) = acc[ai][0][m][1]; } }
    }
};
struct EpiResid {
    static constexpr bool PERM = false, AFTER_DRAIN = false;
    const float* xin; float* xout; const float* gacc; const float* gbias;
    __device__ __forceinline__ void operator()(const f32x4 (&acc)[2][2][4][2], const Unit& u, int wr, int wc, int fr, int fq) const {
        const int b = u.pm >> 3;
        const int col0 = u.pn * BM + wc * 32 + 4 * fq;
#pragma unroll
        for (int bj = 0; bj < 2; ++bj)
#pragma unroll
            for (int n = 0; n < 2; ++n) { const int col = col0 + bj * HALF + n * 16;
                const f32x4 g = *(const f32x4*)(gacc + (size_t)b * 6144 + 4096 + col) + *(const f32x4*)(gbias + 4096 + col);
#pragma unroll
                for (int ai = 0; ai < 2; ++ai)
#pragma unroll
                    for (int m = 0; m < 4; ++m) { const size_t off = (size_t)(u.pm * BM + ai * HALF + wr * 64 + m * 16 + fr) * 2048 + col;
                        const f32x4 xv = *(const f32x4*)(xin + off); *(f32x4*)(xout + off) = xv + g * acc[ai][bj][m][n]; } }
    }
};
template <class Epi, class Sched, bool ALIGN_EPI = false, bool SP2 = false>
__device__ __forceinline__ void gemm_phase(PG8_LAS unsigned char* lds, const Gemm g, const Sched& S, const Epi& E) {
    const int tid = threadIdx.x, wid = __builtin_amdgcn_readfirstlane(tid >> 6), lane = tid & 63, wr = wid >> 2, wc = wid & 3, fr = lane & 15, fq = lane >> 4;
    const int K = g.K, nt = K / BK;
    unsigned voffA[2], voffB[2];
#pragma unroll
    for (int i = 0; i < 2; ++i) { int R, C; stage_rc(tid * 16 + i * 8192, R, C); const int Rb = Epi::PERM ? ((R & ~31) + perm32(R & 31)) : R;
        voffA[i] = (unsigned)(R * K + C) * 2u; voffB[i] = (unsigned)(Rb * K + C) * 2u; }
    const size_t kstep = (size_t)(BK * 2);
    const size_t hstep = (size_t)HALF * K * 2;
    const size_t tstep = 2 * hstep;
    const unsigned ldsw = (unsigned)wid * 1024u;
    const int aoff = lds_byte(wr * 64 + fr, fq * 8), boff = lds_byte(wc * 32 + fr, fq * 8);
#define PG8_SA(b, h) (((b) * 2 + (h)) * HTB)
#define PG8_SB(b, h) ((4 + (b) * 2 + (h)) * HTB)
#define PG8_STAGE(bufoff, gbase, voff) do { _Pragma("unroll") for (int _i = 0; _i < 2; ++_i) \
        __builtin_amdgcn_global_load_lds((const unsigned*)((const char*)(gbase) + (voff)[_i]), (PG8_LAS unsigned*)(lds + (bufoff) + ldsw + _i * 8192), 16, 0, 0); } while (0)
#define PG8_LDA(dst, b, h) do { _Pragma("unroll") for (int m = 0; m < 4; ++m) _Pragma("unroll") for (int k = 0; k < 2; ++k) dst[m][k] = *(const PG8_LAS bf16x8*)(lds + PG8_SA(b, h) + aoff + m * 2048 + k * 1024); } while (0)
#define PG8_LDB(dst, b, h) do { _Pragma("unroll") for (int n = 0; n < 2; ++n) _Pragma("unroll") for (int k = 0; k < 2; ++k) dst[n][k] = *(const PG8_LAS bf16x8*)(lds + PG8_SB(b, h) + boff + n * 2048 + k * 1024); } while (0)
#define PG8_MMA(ai, bj, At, Bt) do { __builtin_amdgcn_s_setprio(1); _Pragma("unroll") for (int m = 0; m < 4; ++m) _Pragma("unroll") for (int n = 0; n < 2; ++n) _Pragma("unroll") for (int k = 0; k < 2; ++k) \
        acc[ai][bj][m][n] = __builtin_amdgcn_mfma_f32_16x16x32_bf16(Bt[n][k], At[m][k], acc[ai][bj][m][n], 0, 0, 0); __builtin_amdgcn_s_setprio(0); } while (0)
#define PG8_WAIT_V(n) asm volatile("s_waitcnt vmcnt(" #n ")" ::: "memory")
#define PG8_WAIT_L(n) asm volatile("s_waitcnt lgkmcnt(" #n ")" ::: "memory")
#define PG8_BAR __builtin_amdgcn_s_barrier()
#define PG8_SCHED __builtin_amdgcn_sched_barrier(0)
    Unit cur, nxt; int ui = 0;
    if (!S.next(0, cur)) return;
    f32x4 acc[2][2][4][2];
#pragma unroll
    for (int a = 0; a < 2; ++a)
#pragma unroll
        for (int b = 0; b < 2; ++b)
#pragma unroll
            for (int m = 0; m < 4; ++m)
#pragma unroll
                for (int n = 0; n < 2; ++n) acc[a][b][m][n] = (f32x4){0.f, 0.f, 0.f, 0.f};
    bf16x8 At[4][2], B0[2][2], B1[2][2];
    const char* cA = (const char*)g.A + (size_t)cur.pm * tstep; const char* cB = (const char*)g.Bt + (size_t)cur.pn * tstep;
    S.a_ready(cur);
    if constexpr (SP2) {
        PG8_STAGE(PG8_SB(0, 0), cB, voffB); PG8_STAGE(PG8_SB(0, 1), cB + hstep, voffB); PG8_STAGE(PG8_SA(0, 0), cA, voffA); PG8_STAGE(PG8_SA(0, 1), cA + hstep, voffA);
        if (wr == 1) PG8_BAR;
        PG8_WAIT_V(2); PG8_BAR;
        PG8_STAGE(PG8_SB(1, 0), cB + kstep, voffB); PG8_STAGE(PG8_SA(1, 0), cA + kstep, voffA); PG8_STAGE(PG8_SB(1, 1), cB + hstep + kstep, voffB);
        PG8_WAIT_V(6); PG8_BAR;
    } else {
        PG8_STAGE(PG8_SB(0, 0), cB, voffB); PG8_STAGE(PG8_SA(0, 0), cA, voffA); PG8_STAGE(PG8_SB(0, 1), cB + hstep, voffB); PG8_STAGE(PG8_SA(0, 1), cA + hstep, voffA);
        if (wr == 1) PG8_BAR;
        PG8_WAIT_V(4); PG8_BAR;
        PG8_STAGE(PG8_SB(1, 0), cB + kstep, voffB); PG8_STAGE(PG8_SA(1, 0), cA + kstep, voffA); PG8_STAGE(PG8_SB(1, 1), cB + hstep + kstep, voffB);
        PG8_WAIT_V(6); PG8_BAR;
    }
    for (;;) {
        const bool has_next = S.next(ui + 1, nxt);
        const char* nA = has_next ? (const char*)g.A + (size_t)nxt.pm * tstep : cA; const char* nB = has_next ? (const char*)g.Bt + (size_t)nxt.pn * tstep : cB;
        for (int t = 0; t < nt; t += 2) {
            const bool last = (t == nt - 2);
            const char* a1 = cA + (size_t)(t + 1) * kstep;
            const char* a2 = last ? nA : cA + (size_t)(t + 2) * kstep; const char* b2 = last ? nB : cB + (size_t)(t + 2) * kstep;
            const char* a3 = a2 + kstep; const char* b3 = b2 + kstep;
            if (last && has_next) S.a_ready(nxt);
            if constexpr (SP2) {
            PG8_LDB(B0, 0, 0); PG8_LDB(B1, 0, 1); PG8_SCHED; PG8_LDA(At, 0, 0); PG8_STAGE(PG8_SA(1, 1), a1 + hstep, voffA);
            PG8_WAIT_V(8); PG8_WAIT_L(0); PG8_BAR; PG8_MMA(0, 0, At, B0); PG8_MMA(0, 1, At, B1); PG8_BAR; PG8_SCHED;
            PG8_LDA(At, 0, 1); PG8_STAGE(PG8_SB(0, 0), b2, voffB); PG8_STAGE(PG8_SB(0, 1), b2 + hstep, voffB); PG8_STAGE(PG8_SA(0, 0), a2, voffA);
            PG8_WAIT_V(8); PG8_WAIT_L(0); PG8_BAR; PG8_MMA(1, 0, At, B0); PG8_MMA(1, 1, At, B1); PG8_BAR; PG8_SCHED;
            PG8_LDB(B0, 1, 0); PG8_LDB(B1, 1, 1); PG8_SCHED; PG8_LDA(At, 1, 0); PG8_STAGE(PG8_SA(0, 1), a2 + hstep, voffA);
            PG8_WAIT_V(8); PG8_WAIT_L(0); PG8_BAR; PG8_MMA(0, 0, At, B0); PG8_MMA(0, 1, At, B1); PG8_BAR; PG8_SCHED;
            PG8_LDA(At, 1, 1); PG8_STAGE(PG8_SB(1, 0), b3, voffB); PG8_STAGE(PG8_SB(1, 1), b3 + hstep, voffB); PG8_STAGE(PG8_SA(1, 0), a3, voffA);
            PG8_WAIT_V(8); PG8_WAIT_L(0); PG8_BAR; PG8_MMA(1, 0, At, B0); PG8_MMA(1, 1, At, B1); PG8_BAR; PG8_SCHED;
            } else {
            PG8_LDB(B0, 0, 0); PG8_SCHED; PG8_LDA(At, 0, 0); PG8_STAGE(PG8_SA(1, 1), a1 + hstep, voffA);
            PG8_WAIT_L(8); PG8_BAR; PG8_WAIT_L(0); PG8_MMA(0, 0, At, B0); PG8_BAR; PG8_SCHED;
            PG8_LDB(B1, 0, 1); PG8_STAGE(PG8_SB(0, 0), b2, voffB);
            PG8_BAR; PG8_WAIT_L(0); PG8_MMA(0, 1, At, B1); PG8_BAR;
            PG8_LDA(At, 0, 1); PG8_STAGE(PG8_SA(0, 0), a2, voffA);
            PG8_BAR; PG8_WAIT_L(0); PG8_MMA(1, 0, At, B0); PG8_BAR; PG8_SCHED;
            PG8_STAGE(PG8_SB(0, 1), b2 + hstep, voffB);
            PG8_WAIT_V(6); PG8_BAR; PG8_MMA(1, 1, At, B1); PG8_BAR;
            PG8_LDB(B0, 1, 0); PG8_SCHED; PG8_LDA(At, 1, 0); PG8_STAGE(PG8_SA(0, 1), a2 + hstep, voffA);
            PG8_WAIT_L(8); PG8_BAR; PG8_WAIT_L(0); PG8_MMA(0, 0, At, B0); PG8_BAR; PG8_SCHED;
            PG8_LDB(B1, 1, 1); PG8_STAGE(PG8_SB(1, 0), b3, voffB);
            PG8_BAR; PG8_WAIT_L(0); PG8_MMA(0, 1, At, B1); PG8_BAR;
            PG8_LDA(At, 1, 1); PG8_STAGE(PG8_SA(1, 0), a3, voffA);
            PG8_BAR; PG8_WAIT_L(0); PG8_MMA(1, 0, At, B0); PG8_BAR; PG8_SCHED;
            PG8_STAGE(PG8_SB(1, 1), b3 + hstep, voffB);
            PG8_WAIT_V(6); PG8_BAR; PG8_MMA(1, 1, At, B1); PG8_BAR;
            }
        }
        if constexpr (ALIGN_EPI) { if (wr == 0) PG8_BAR; }
        if constexpr (!Epi::AFTER_DRAIN) { E(acc, cur, wr, wc, fr, fq); S.done(cur); }
        if (!has_next) break;
#pragma unroll
        for (int a = 0; a < 2; ++a)
#pragma unroll
            for (int b = 0; b < 2; ++b)
#pragma unroll
                for (int m = 0; m < 4; ++m)
#pragma unroll
                    for (int n = 0; n < 2; ++n) acc[a][b][m][n] = (f32x4){0.f, 0.f, 0.f, 0.f};
        cur = nxt; cA = nA; cB = nB; ++ui;
        if constexpr (ALIGN_EPI) { if (wr == 1) PG8_BAR; }
    }
    PG8_WAIT_V(0);
    if constexpr (!ALIGN_EPI) { if (wr == 0) PG8_BAR; }
    PG8_BAR;
    if constexpr (Epi::AFTER_DRAIN) { E.fused(acc, cur, wr, wc, fr, fq, lds, wid, lane); S.done(cur); }
#undef PG8_SA
#undef PG8_SB
#undef PG8_STAGE
#undef PG8_LDA
#undef PG8_LDB
#undef PG8_MMA
#undef PG8_WAIT_V
#undef PG8_WAIT_L
#undef PG8_BAR
#undef PG8_SCHED
}
}
namespace att {
using bf16 = __hip_bfloat16;
constexpr int   D = 128, NW = 8, QBLK = 32, KVBLK = 64;
constexpr float SCALE = 0.088388347648318440f;
constexpr float THR = 8.f;
constexpr int SDEPTH = 2;
constexpr int LDQ = 1024, LDK = 256, LDY = 2048, LDG = NINP;
constexpr size_t SHM_V = KVBLK * D * 2, SHM_K = KVBLK * D * 2, SHM_ATTN = 2 * SHM_V + 2 * SHM_K + NW * 64 * 4;
using bf16x8 = __attribute__((ext_vector_type(8))) short;
using s16x4  = __attribute__((ext_vector_type(4))) short;
using f32x16 = __attribute__((ext_vector_type(16))) float;
using f32x8  = __attribute__((ext_vector_type(8))) float;
using u32x4  = __attribute__((ext_vector_type(4))) unsigned;
#define KSWZ(row, colB) ((row) * 256 + ((colB) ^ (((row) & 7) << 4)))
#define SBAR() __builtin_amdgcn_sched_barrier(0)
__device__ __forceinline__ int crow(int r, int hi) { return (r & 3) + 8 * (r >> 2) + 4 * hi; }
__device__ __forceinline__ unsigned cvtpk(float lo, float hi) {
  unsigned r; asm volatile("v_cvt_pk_bf16_f32 %0, %1, %2" : "=v"(r) : "v"(lo), "v"(hi)); return r;
}
template <typename TIn> struct Stage;
template <> struct Stage<bf16>  { using T = bf16x8;
  __device__ static __forceinline__ T ld8(const bf16* p) { return *reinterpret_cast<const bf16x8*>(p); }
  __device__ static __forceinline__ bf16x8 tobf(T x) { return x; } };
template <> struct Stage<float> { using T = f32x8;
  __device__ static __forceinline__ T ld8(const float* p) { return *reinterpret_cast<const f32x8*>(p); }
  __device__ static __forceinline__ bf16x8 tobf(T x) {
    u32x4 w = {cvtpk(x[0], x[1]), cvtpk(x[2], x[3]), cvtpk(x[4], x[5]), cvtpk(x[6], x[7])}; return *reinterpret_cast<bf16x8*>(&w); } };

__device__ __forceinline__ void partialSM(f32x16& p0, f32x16& p1, float& m_reg, float& mn, float& alpha) {
  constexpr float C = SCALE * 1.4426950408889634f;
  float pmax = p0[0]; for (int r = 1; r < 16; ++r) pmax = fmaxf(pmax, p0[r]); for (int r = 0; r < 16; ++r) pmax = fmaxf(pmax, p1[r]);
  { auto rr = __builtin_amdgcn_permlane32_swap(__float_as_uint(pmax), __float_as_uint(pmax), false, false);
    pmax = fmaxf(__uint_as_float(rr[0]), __uint_as_float(rr[1])); }
  if (__builtin_expect(__all(pmax - m_reg <= THR / SCALE), 1)) { mn = m_reg; alpha = 1.f; }
  else { mn = fmaxf(m_reg, pmax); alpha = __builtin_amdgcn_exp2f((m_reg - mn) * C); m_reg = mn; }
  float mnC = -mn * C;
  for (int r = 0; r < 16; ++r) p0[r] = fmaf(p0[r], C, mnC); for (int r = 0; r < 16; ++r) p1[r] = fmaf(p1[r], C, mnC);
  for (int r = 0; r < 16; ++r) p0[r] = __builtin_amdgcn_exp2f(p0[r]);
}
__device__ __forceinline__ void finishSM(f32x16& p0, f32x16& p1, float alpha, float& l_reg, bf16x8& pa0, bf16x8& pa1, bf16x8& pa2, bf16x8& pa3) {
  for (int r = 0; r < 16; ++r) p1[r] = __builtin_amdgcn_exp2f(p1[r]);
  float ps = 0; for (int r = 0; r < 16; ++r) ps += p0[r]; for (int r = 0; r < 16; ++r) ps += p1[r];
  { auto rr = __builtin_amdgcn_permlane32_swap(__float_as_uint(ps), __float_as_uint(ps), false, false);
    ps = __uint_as_float(rr[0]) + __uint_as_float(rr[1]); }
  l_reg = l_reg * alpha + ps;
#define PK4(P, BASE, OUT) do { unsigned a0 = cvtpk(P[BASE + 0], P[BASE + 1]), a1 = cvtpk(P[BASE + 2], P[BASE + 3]);   \
    unsigned b0 = cvtpk(P[BASE + 4], P[BASE + 5]), b1 = cvtpk(P[BASE + 6], P[BASE + 7]);                              \
    auto r0 = __builtin_amdgcn_permlane32_swap(a0, b0, false, false); auto r1 = __builtin_amdgcn_permlane32_swap(a1, b1, false, false); \
    u32x4 w = {r0[0], r1[0], r0[1], r1[1]}; OUT = *reinterpret_cast<bf16x8*>(&w); } while (0)
  PK4(p0, 0, pa0); PK4(p0, 8, pa1); PK4(p1, 0, pa2); PK4(p1, 8, pa3);
#undef PK4
}
__device__ __forceinline__ void qkt(f32x16& p0, f32x16& p1, const bf16* Ks, const bf16x8* qr, int r32, int hi) {
  p0 = f32x16{}; p1 = f32x16{};
  for (int d0 = 0; d0 < 8; ++d0) { int cb = (d0 * 16 + hi * 8) * 2;
    bf16x8 b0 = *reinterpret_cast<const bf16x8*>((const char*)Ks + KSWZ(r32, cb));
    bf16x8 b1 = *reinterpret_cast<const bf16x8*>((const char*)Ks + KSWZ(32 + r32, cb));
    p0 = __builtin_amdgcn_mfma_f32_32x32x16_bf16(b0, qr[d0], p0, 0, 0, 0);
    p1 = __builtin_amdgcn_mfma_f32_32x32x16_bf16(b1, qr[d0], p1, 0, 0, 0); }
}
__device__ __forceinline__ int v_st(int k, int c) { const int kk = (k & ~0xC) | ((k & 4) << 1) | ((k & 8) >> 1); return ((kk >> 3) * 4 + (c >> 5)) * 512 + ((kk & 7) * 32 + (c & 31)) * 2; }
__device__ __forceinline__ int v_rd_base(int lane) { return ((lane & 3) << 3) | (((lane >> 2) & 3) << 6) | (((lane >> 4) & 1) << 5) | (((lane >> 5) & 1) << 8); }
constexpr int v_rd_off(int d0, int ks, int half) { return d0 * 512 + ks * 4096 + half * 2048; }
template <int OFF> __device__ __forceinline__ s16x4 tr_read(int vb) {
  s16x4 r; asm volatile("ds_read_b64_tr_b16 %0, %1 offset:%2" : "=&v"(r) : "v"(vb), "i"(OFF) : "memory"); return r;
}
template <int D0> __device__ __forceinline__ void pv_one(f32x16& od, int vb, bf16x8 pa0, bf16x8 pa1, bf16x8 pa2, bf16x8 pa3) {
  const s16x4 l0 = tr_read<v_rd_off(D0, 0, 0)>(vb), h0 = tr_read<v_rd_off(D0, 0, 1)>(vb), l1 = tr_read<v_rd_off(D0, 1, 0)>(vb), h1 = tr_read<v_rd_off(D0, 1, 1)>(vb);
  const s16x4 l2 = tr_read<v_rd_off(D0, 2, 0)>(vb), h2 = tr_read<v_rd_off(D0, 2, 1)>(vb), l3 = tr_read<v_rd_off(D0, 3, 0)>(vb), h3 = tr_read<v_rd_off(D0, 3, 1)>(vb);
  asm volatile("s_waitcnt lgkmcnt(0)" ::: "memory"); SBAR();
#define PK(L, H) (bf16x8){L[0], L[1], L[2], L[3], H[0], H[1], H[2], H[3]}
  od = __builtin_amdgcn_mfma_f32_32x32x16_bf16(pa0, PK(l0, h0), od, 0, 0, 0);
  od = __builtin_amdgcn_mfma_f32_32x32x16_bf16(pa1, PK(l1, h1), od, 0, 0, 0);
  od = __builtin_amdgcn_mfma_f32_32x32x16_bf16(pa2, PK(l2, h2), od, 0, 0, 0);
  od = __builtin_amdgcn_mfma_f32_32x32x16_bf16(pa3, PK(l3, h3), od, 0, 0, 0);
#undef PK
}
__device__ __forceinline__ void pv_d0(f32x16* o, int vb, bf16x8 pa0, bf16x8 pa1, bf16x8 pa2, bf16x8 pa3) {
  pv_one<0>(o[0], vb, pa0, pa1, pa2, pa3); pv_one<1>(o[1], vb, pa0, pa1, pa2, pa3); pv_one<2>(o[2], vb, pa0, pa1, pa2, pa3); pv_one<3>(o[3], vb, pa0, pa1, pa2, pa3);
}
__device__ __forceinline__ void attn_dense_body(const bf16* __restrict__ Qb, const bf16* __restrict__ Kh, const bf16* __restrict__ Vh,
                                                unsigned short* __restrict__ Yb, const unsigned short* __restrict__ Gb, int seq, char* lds) {
  using St = Stage<bf16>; using SQ = Stage<bf16>; using TQ = bf16;
  const int tid = threadIdx.x, wid = tid >> 6, lane = tid & 63, r32 = lane & 31, hi = lane >> 5;
  bf16* V_lds = (bf16*)lds; bf16* K_lds = (bf16*)(lds + 2 * SHM_V);
  float* ws = (float*)(lds + 2 * SHM_V + 2 * SHM_K) + wid * 64; float* li_l = ws; float* al_l = ws + 32;
  float m_reg = -1e30f, l_reg = 0; f32x16 o[4] = {}; bf16x8 qr[8];
  const TQ* Qw = Qb + (long)(wid * QBLK + r32) * LDQ + hi * 8;
#pragma unroll
  for (int d0 = 0; d0 < 8; ++d0) qr[d0] = SQ::tobf(SQ::ld8(Qw + d0 * 16));
  const int sr = tid >> 4, sc = (tid & 15) * 8, vst0 = v_st(sr, sc), vst1 = v_st(32 + sr, sc);
  const int vb0 = (int)(uintptr_t)V_lds + v_rd_base(lane);
  struct { typename St::T vs0, vs1, ks0, ks1; } sr_[SDEPTH];
#define SLOAD(i, k0) do { sr_[i].vs0 = St::ld8(&Vh[(long)((k0) + sr) * LDK + sc]); sr_[i].vs1 = St::ld8(&Vh[(long)((k0) + 32 + sr) * LDK + sc]); \
    sr_[i].ks0 = St::ld8(&Kh[(long)((k0) + sr) * LDK + sc]); sr_[i].ks1 = St::ld8(&Kh[(long)((k0) + 32 + sr) * LDK + sc]); } while (0)
#define SWRITE(b, i) do { *(bf16x8*)((char*)V_lds + (b) * SHM_V + vst0) = St::tobf(sr_[i].vs0);          \
    *(bf16x8*)((char*)V_lds + (b) * SHM_V + vst1) = St::tobf(sr_[i].vs1); int kc = sc * 2;               \
    *(bf16x8*)((char*)K_lds + (b) * SHM_K + KSWZ(sr, kc)) = St::tobf(sr_[i].ks0);                       \
    *(bf16x8*)((char*)K_lds + (b) * SHM_K + KSWZ(32 + sr, kc)) = St::tobf(sr_[i].ks1); } while (0)
#define SWAIT() do { if constexpr (SDEPTH == 2) asm volatile("s_waitcnt vmcnt(4)" ::: "memory"); else asm volatile("s_waitcnt vmcnt(0)" ::: "memory"); } while (0)
#define RESC(a) do { if (__any((a) < 1.f)) { if (hi == 0) al_l[r32] = (a); asm volatile("s_waitcnt lgkmcnt(0)" ::: "memory"); \
    for (int d = 0; d < 4; ++d) for (int r = 0; r < 16; ++r) o[d][r] *= al_l[crow(r, hi)]; } } while (0)
  f32x16 pA0, pA1, pB0, pB1; float mnA, mnB, alA, alB; bf16x8 pa0, pa1, pa2, pa3; const int NT = seq / KVBLK;
  constexpr int SE = 0, SO = SDEPTH - 1;
  SLOAD(SE, 0); asm volatile("s_waitcnt vmcnt(0)" ::: "memory"); SWRITE(0, SE); __syncthreads();
  qkt(pA0, pA1, K_lds, qr, r32, hi); partialSM(pA0, pA1, m_reg, mnA, alA);
  SLOAD(SO, KVBLK); if constexpr (SDEPTH == 2) { if (2 < NT) SLOAD(SE, 2 * KVBLK); }
  SWAIT(); SWRITE(1, SO); __syncthreads();
  for (int j = 1; j + 1 < NT; j += 2) {
    SBAR(); qkt(pB0, pB1, (bf16*)((char*)K_lds + SHM_K), qr, r32, hi);
    finishSM(pA0, pA1, alA, l_reg, pa0, pa1, pa2, pa3); SBAR();
    SLOAD(SO, (j + SDEPTH) * KVBLK); SBAR();
    pv_d0(o, vb0, pa0, pa1, pa2, pa3); partialSM(pB0, pB1, m_reg, mnB, alB);
    __syncthreads(); SWAIT(); SWRITE(0, SE);
    RESC(alB); __syncthreads();
    SBAR(); qkt(pA0, pA1, K_lds, qr, r32, hi);
    finishSM(pB0, pB1, alB, l_reg, pa0, pa1, pa2, pa3); SBAR();
    if (SDEPTH == 1 || j + 3 < NT) SLOAD(SE, (j + 1 + SDEPTH) * KVBLK); SBAR();
    pv_d0(o, vb0 + (int)SHM_V, pa0, pa1, pa2, pa3); partialSM(pA0, pA1, m_reg, mnA, alA);
    __syncthreads(); SWAIT(); SWRITE(1, SO);
    RESC(alA); __syncthreads();
  }
  SBAR(); qkt(pB0, pB1, (bf16*)((char*)K_lds + SHM_K), qr, r32, hi);
  finishSM(pA0, pA1, alA, l_reg, pa0, pa1, pa2, pa3); SBAR();
  pv_d0(o, vb0, pa0, pa1, pa2, pa3); partialSM(pB0, pB1, m_reg, mnB, alB);
  __syncthreads(); RESC(alB);
  finishSM(pB0, pB1, alB, l_reg, pa0, pa1, pa2, pa3); SBAR();
  pv_d0(o, vb0 + (int)SHM_V, pa0, pa1, pa2, pa3);
  if (hi == 0) li_l[r32] = l_reg; asm volatile("s_waitcnt lgkmcnt(0)" ::: "memory");
  float rli[16];
#pragma unroll
  for (int r = 0; r < 16; ++r) rli[r] = __builtin_amdgcn_rcpf(li_l[crow(r, hi)]);
  int eoff = (wid * QBLK + 4 * hi) ; asm volatile("" : "+v"(eoff));
  const unsigned short* Gw = Gb + (long)eoff * LDG + r32; unsigned short* Yw = Yb + (long)eoff * LDY + r32;
#pragma unroll
  for (int r = 0; r < 16; ++r) { const int orow = (r & 3) + 8 * (r >> 2);
#pragma unroll
    for (int d0 = 0; d0 < 4; ++d0) { const float g = __uint_as_float(((unsigned)Gw[orow * LDG + d0 * 32]) << 16);
      const float val = o[d0][r] * rli[r] * (g / (1.f + __expf(-g)));
      unsigned ub = __float_as_uint(val); ub = (ub + 0x7fffu + ((ub >> 16) & 1u)) >> 16;
      Yw[orow * LDY + d0 * 32] = (unsigned short)ub; } }
#undef SLOAD
#undef SWRITE
#undef SWAIT
#undef RESC
}
}
#define GAS __attribute__((address_space(1)))
#define LAS __attribute__((address_space(3)))
typedef unsigned short bf16_t;
typedef unsigned v4u __attribute__((ext_vector_type(4)));
typedef unsigned v2u __attribute__((ext_vector_type(2)));
typedef float f32x4 __attribute__((ext_vector_type(4)));
#define LDS_WAIT() asm volatile("s_waitcnt lgkmcnt(0)" ::: "memory")

constexpr size_t MiB = 1u << 20;
constexpr size_t WS_CTL = 0, CTL_ZERO_BYTES = 1 * MiB;
constexpr size_t WS_MOD = 64 * 1024;
constexpr size_t WS_ROPE = 1 * MiB;
constexpr size_t WS_SMALL = 2 * MiB;
constexpr size_t WS_WIN0 = 3 * MiB, WS_WOUT0 = 24 * MiB;
constexpr size_t WS_QB = 32 * MiB, WS_KB = 48 * MiB, WS_VB = 52 * MiB;
constexpr size_t WS_HB = 3 * MiB;
constexpr size_t WS_WIN1 = 56 * MiB, WS_WOUT1 = 77 * MiB;
constexpr size_t WS_H = 85 * MiB;
constexpr size_t WS_HF = 85 * MiB;
constexpr size_t WS_PROJ = 117 * MiB;
constexpr size_t WS_YCAT = 201 * MiB;
constexpr size_t WS_ACT = 233 * MiB;
constexpr size_t WS_YF = 297 * MiB, WS_YB = 329 * MiB;
constexpr size_t WS_END = 361 * MiB;

constexpr int NWAVES = 8, NTHREADS = 512;
constexpr int LDS_BYTES = 147456;
constexpr int NPHASE = 14;

struct Args { const float* in[39]; float* out; unsigned char* ws; int ph_lo, ph_hi; };

__device__ __forceinline__ float bf2f(unsigned v) { return __uint_as_float(v << 16); }
__device__ __forceinline__ unsigned f2bf(float f) { unsigned u = __float_as_uint(f); return (u + 0x7fffu + ((u >> 16) & 1u)) >> 16; }
__device__ __forceinline__ unsigned pk2(float lo, float hi) { return f2bf(lo) | (f2bf(hi) << 16); }
__device__ __forceinline__ void unpack8(const v4u w, float* x) {
    x[0] = __uint_as_float(w.x << 16); x[1] = __uint_as_float(w.x & 0xffff0000u); x[2] = __uint_as_float(w.y << 16); x[3] = __uint_as_float(w.y & 0xffff0000u);
    x[4] = __uint_as_float(w.z << 16); x[5] = __uint_as_float(w.z & 0xffff0000u); x[6] = __uint_as_float(w.w << 16); x[7] = __uint_as_float(w.w & 0xffff0000u);
}
__device__ __forceinline__ v4u pack8(const float* x) { v4u w; w.x = pk2(x[0], x[1]); w.y = pk2(x[2], x[3]); w.z = pk2(x[4], x[5]); w.w = pk2(x[6], x[7]); return w; }
__device__ __forceinline__ float silu_f(float x) { return x / (1.f + expf(-x)); }
__device__ __forceinline__ float sigmoid_f(float x) { return 1.f / (1.f + expf(-x)); }
__device__ __forceinline__ float softplus_f(float x) { return fmaxf(x, 0.f) + log1pf(expf(-fabsf(x))); }
template <int N> __device__ __forceinline__ float group_sum(float v) {
#pragma unroll
    for (int o = 1; o < N; o <<= 1) v += __shfl_xor(v, o);
    return v;
}

__device__ __forceinline__ void p0_transpose_item(const float* W, int K, int N, bf16_t* WT, int row_off, LAS float* scr, int item, int lane) {
    const int nblk = N / 32, kb = item / nblk, nb = item % nblk, k0 = 64 * kb, n0 = 32 * nb;
#pragma unroll 8
    for (int i = 0; i < 32; ++i) { const int kk = 2 * i + (lane >> 5); scr[kk * 33 + (lane & 31)] = W[(size_t)(k0 + kk) * N + n0 + (lane & 31)]; }
    LDS_WAIT(); asm volatile("" ::: "memory");
    const int c = lane & 7;
#pragma unroll
    for (int j = 0; j < 4; ++j) { const int n = (lane >> 3) + 8 * j; const LAS float* s = scr + (8 * c) * 33 + n;
        v4u o; o.x = pk2(s[0 * 33], s[1 * 33]); o.y = pk2(s[2 * 33], s[3 * 33]); o.z = pk2(s[4 * 33], s[5 * 33]); o.w = pk2(s[6 * 33], s[7 * 33]);
        *(v4u*)(WT + (size_t)(row_off + n0 + n) * K + k0 + 8 * c) = o; }
    LDS_WAIT(); asm volatile("" ::: "memory");
}

__device__ __forceinline__ void p0_prologue(const Args& a, LAS unsigned char* lds, int vcu, int G) {
    const int tid = threadIdx.x, lane = tid & 63, wave = tid >> 6;
    unsigned char* ws = a.ws;
    { const int gid = blockIdx.x * NTHREADS + tid;
      if (gid < 2048) { const int pos = gid >> 5, i = gid & 31; const float freq = expf(-(float)i * (1.f / 32.f) * 9.210340371976184f); const float ang = (float)pos * freq;
          float* rt = (float*)(ws + WS_ROPE); rt[2 * gid] = cosf(ang); rt[2 * gid + 1] = sinf(ang); } }
    { const int gid = blockIdx.x * NTHREADS + tid, gn = G * NTHREADS; constexpr int NV = (NINP - NIN) * 2048 * 2 / 16;
      v4u* p0 = (v4u*)(ws + WS_WIN0 + (size_t)NIN * 2048 * 2); v4u* p1 = (v4u*)(ws + WS_WIN1 + (size_t)NIN * 2048 * 2);
      for (int i = gid; i < NV; i += gn) { p0[i] = (v4u){0, 0, 0, 0}; p1[i] = (v4u){0, 0, 0, 0}; } }
    if (blockIdx.x < 192) {
        const int it = blockIdx.x, l = it / 96, r = it % 96, kc = r / 3, nc = r % 3;
        LAS float* cond = (LAS float*)lds;
        if (tid < 256) { const int b = tid >> 6, k = tid & 63; const float c = a.in[1][b * 2048 + kc * 64 + k]; cond[tid] = silu_f(c); }
        __syncthreads();
        const float* W = a.in[2] + (size_t)l * 2048 * 6144 + (size_t)(kc * 64) * 6144 + nc * 2048 + tid * 4;
        f32x4 acc0 = {0, 0, 0, 0}, acc1 = acc0, acc2 = acc0, acc3 = acc0;
#pragma unroll 8
        for (int k = 0; k < 64; ++k) { const f32x4 w = *(const f32x4*)(W + (size_t)k * 6144);
            acc0 += cond[k] * w; acc1 += cond[64 + k] * w; acc2 += cond[128 + k] * w; acc3 += cond[192 + k] * w; }
        float* macc = (float*)(ws + WS_MOD) + (size_t)l * 4 * 6144 + nc * 2048 + tid * 4;
#pragma unroll
        for (int i = 0; i < 4; ++i) { atomicAdd(macc + i, acc0[i]); atomicAdd(macc + 6144 + i, acc1[i]); atomicAdd(macc + 2 * 6144 + i, acc2[i]); atomicAdd(macc + 3 * 6144 + i, acc3[i]); }
        __syncthreads();
    }
    { LAS float* scr = (LAS float*)(lds + wave * 16384);
      const int gw = vcu * NWAVES + wave, NGW = G * NWAVES;
      constexpr int I_IN = 32 * (NIN / 32), I_OUT = 32 * 64, NITEMS = 2 * (I_IN + I_OUT);
      for (int it = gw; it < NITEMS; it += NGW) {
          int r = it;
          if (r < I_IN) { p0_transpose_item(a.in[5], 2048, NIN, (bf16_t*)(ws + WS_WIN0), 0, scr, r, lane); continue; } r -= I_IN;
          if (r < I_IN) { p0_transpose_item(a.in[17], 2048, NIN, (bf16_t*)(ws + WS_WIN1), 0, scr, r, lane); continue; } r -= I_IN;
          if (r < I_OUT) { p0_transpose_item(a.in[16], 2048, 2048, (bf16_t*)(ws + WS_WOUT0), 0, scr, r, lane); continue; } r -= I_OUT;
          p0_transpose_item(a.in[37], 2048, 2048, (bf16_t*)(ws + WS_WOUT1), 0, scr, r, lane);
      } }
}

__device__ __forceinline__ void normmod_phase(const Args& a, const float* xin, int layer, int gw, int NGW, int lane) {
    const float* nw = a.in[4] + layer * 2048; const float* bm = a.in[3] + layer * 6144;
    const float* macc = (const float*)(a.ws + WS_MOD) + (size_t)layer * 4 * 6144;
    bf16_t* H = (bf16_t*)(a.ws + WS_H);
    for (int m = gw; m < MTOK; m += NGW) {
        const int b = m >> 11;
        const f32x4* xr = (const f32x4*)(xin + (size_t)m * 2048) + lane;
        f32x4 v[8]; float s = 0.f;
#pragma unroll
        for (int j = 0; j < 8; ++j) { v[j] = xr[64 * j]; s += (v[j].x * v[j].x + v[j].y * v[j].y) + (v[j].z * v[j].z + v[j].w * v[j].w); }
        const float rstd = rsqrtf(group_sum<64>(s) * (1.f / 2048.f) + EPS);
#pragma unroll
        for (int j = 0; j < 8; ++j) { const int col = (64 * j + lane) * 4;
            const f32x4 w = *(const f32x4*)(nw + col);
            const f32x4 sh = *(const f32x4*)(macc + b * 6144 + col) + *(const f32x4*)(bm + col);
            const f32x4 sc = *(const f32x4*)(macc + b * 6144 + 2048 + col) + *(const f32x4*)(bm + 2048 + col);
            const f32x4 o = v[j] * rstd * w * (1.f + sc) + sh;
            v2u pk; pk.x = pk2(o.x, o.y); pk.y = pk2(o.z, o.w);
            *(v2u*)(H + (size_t)m * 2048 + col) = pk; }
    }
}

__device__ __forceinline__ void post0_phase(const Args& a, int gw, int NGW, int lane) {
    const bf16_t* P = (const bf16_t*)(a.ws + WS_PROJ);
    const float2* rope = (const float2*)(a.ws + WS_ROPE);
    const float* qn = a.in[6]; const float* kn = a.in[7]; const float* cw = a.in[8]; const float* cb = a.in[9];
    bf16_t* Q = (bf16_t*)(a.ws + WS_QB); bf16_t* K = (bf16_t*)(a.ws + WS_KB); bf16_t* V = (bf16_t*)(a.ws + WS_VB);
    float* ACT = (float*)(a.ws + WS_ACT);
    for (int m = gw; m < MTOK; m += NGW) {
        const int t = m & 2047, prow = t >> 6, pcol = t & 63;
        const bf16_t* pr = P + (size_t)m * NINP;
        {
            float x[16]; unpack8(*(const v4u*)(pr + A_Q + lane * 16), x); unpack8(*(const v4u*)(pr + A_Q + lane * 16 + 8), x + 8);
            float ss = 0.f;
#pragma unroll
            for (int i = 0; i < 16; ++i) ss += x[i] * x[i];
            ss = group_sum<8>(ss);
            const float r = rsqrtf(ss * (1.f / 128.f) + EPS);
            const int d0 = (lane & 7) * 16;
#pragma unroll
            for (int i = 0; i < 16; ++i) x[i] = x[i] * r * qn[d0 + i];
#pragma unroll
            for (int pi = 0; pi < 8; ++pi) { const int p = (d0 >> 1) + pi; const float2 cs = (p < 32) ? rope[prow * 32 + p] : rope[pcol * 32 + p - 32];
                const float x0 = x[2 * pi], x1 = x[2 * pi + 1]; x[2 * pi] = x0 * cs.x - x1 * cs.y; x[2 * pi + 1] = x0 * cs.y + x1 * cs.x; }
            *(v4u*)(Q + (size_t)m * 1024 + lane * 16) = pack8(x); *(v4u*)(Q + (size_t)m * 1024 + lane * 16 + 8) = pack8(x + 8);
        }
        {
            const v2u w = *(const v2u*)(pr + A_K + lane * 4);
            float x[4] = {__uint_as_float(w.x << 16), __uint_as_float(w.x & 0xffff0000u), __uint_as_float(w.y << 16), __uint_as_float(w.y & 0xffff0000u)};
            float ss = (x[0] * x[0] + x[1] * x[1]) + (x[2] * x[2] + x[3] * x[3]);
            ss = group_sum<32>(ss);
            const float r = rsqrtf(ss * (1.f / 128.f) + EPS);
            const int d0 = (lane & 31) * 4;
#pragma unroll
            for (int i = 0; i < 4; ++i) x[i] = x[i] * r * kn[d0 + i];
#pragma unroll
            for (int pi = 0; pi < 2; ++pi) { const int p = (d0 >> 1) + pi; const float2 cs = (p < 32) ? rope[prow * 32 + p] : rope[pcol * 32 + p - 32];
                const float x0 = x[2 * pi], x1 = x[2 * pi + 1]; x[2 * pi] = x0 * cs.x - x1 * cs.y; x[2 * pi + 1] = x0 * cs.y + x1 * cs.x; }
            v2u o; o.x = pk2(x[0], x[1]); o.y = pk2(x[2], x[3]);
            *(v2u*)(K + (size_t)m * 256 + lane * 4) = o;
            *(v2u*)(V + (size_t)m * 256 + lane * 4) = *(const v2u*)(pr + A_V + lane * 4);
        }
#pragma unroll
        for (int j = 0; j < 3; ++j) { const int ch = (j * 64 + lane) * 8;
            float acc[8];
            { const f32x4 b0 = *(const f32x4*)(cb + ch), b1 = *(const f32x4*)(cb + ch + 4); acc[0] = b0.x; acc[1] = b0.y; acc[2] = b0.z; acc[3] = b0.w; acc[4] = b1.x; acc[5] = b1.y; acc[6] = b1.z; acc[7] = b1.w; }
#pragma unroll
            for (int d = 0; d < 4; ++d) { const int ts = t + d - 2;
                if (ts >= 0 && ts < SEQ) { float x[8]; unpack8(*(const v4u*)(P + (size_t)(m + d - 2) * NINP + A_XS + ch), x);
                    const f32x4 w0 = *(const f32x4*)(cw + d * 1536 + ch), w1 = *(const f32x4*)(cw + d * 1536 + ch + 4);
                    acc[0] += w0.x * x[0]; acc[1] += w0.y * x[1]; acc[2] += w0.z * x[2]; acc[3] += w0.w * x[3];
                    acc[4] += w1.x * x[4]; acc[5] += w1.y * x[5]; acc[6] += w1.z * x[6]; acc[7] += w1.w * x[7]; } }
            f32x4 o0, o1; o0.x = silu_f(acc[0]); o0.y = silu_f(acc[1]); o0.z = silu_f(acc[2]); o0.w = silu_f(acc[3]); o1.x = silu_f(acc[4]); o1.y = silu_f(acc[5]); o1.z = silu_f(acc[6]); o1.w = silu_f(acc[7]);
            *(f32x4*)(ACT + (size_t)m * 1536 + ch) = o0; *(f32x4*)(ACT + (size_t)m * 1536 + ch + 4) = o1; }
    }
}

__device__ __forceinline__ void ssd_item(const Args& a, int item, float* lds) {
    const int ph = item & 1, h = (item >> 1) & 15, dir = (item >> 5) & 1, b = item >> 6, g = h >> 3;
    float* xs = lds; float* Bs = xs + 64 * 32; float* Cs = Bs + 64 * 128; float* dts = Cs + 64 * 128; float* das = dts + 64; float* ys = das + 64;
    const float A = -expf(a.in[dir ? 13 : 12][h]); const float dtb = a.in[dir ? 11 : 10][h];
    const float* ACT = (const float*)(a.ws + WS_ACT); const float* SM = (const float*)(a.ws + WS_SMALL);
    float* Y = (float*)(a.ws + (dir ? WS_YB : WS_YF));
    const int tid = threadIdx.x, p = tid >> 4, ng = tid & 15;
    float hst[8];
#pragma unroll
    for (int i = 0; i < 8; ++i) hst[i] = 0.f;
    for (int tile = 0; tile < 32; ++tile) {
        const int t0 = (dir ? 31 - tile : tile) * 64;
        const size_t row0 = (size_t)b * SEQ + t0;
        __syncthreads();
        { const int r = tid >> 3, c4 = tid & 7; *(f32x4*)(xs + r * 32 + c4 * 4) = *(const f32x4*)(ACT + (row0 + r) * 1536 + h * 64 + ph * 32 + c4 * 4); }
#pragma unroll
        for (int i = 0; i < 4; ++i) { const int idx = tid + i * 512, r = idx >> 5, c4 = idx & 31;
            *(f32x4*)(Bs + r * 128 + c4 * 4) = *(const f32x4*)(ACT + (row0 + r) * 1536 + 1024 + g * 128 + c4 * 4);
            *(f32x4*)(Cs + r * 128 + c4 * 4) = *(const f32x4*)(ACT + (row0 + r) * 1536 + 1280 + g * 128 + c4 * 4); }
        if (tid < 64) { const float raw = SM[(row0 + tid) * 32 + dir * 16 + h]; const float dt = softplus_f(raw + dtb); dts[tid] = dt; das[tid] = expf(dt * A); }
        __syncthreads();
        for (int s = 0; s < 64; ++s) {
            const int r = dir ? 63 - s : s;
            const float dA = das[r], xdt = xs[r * 32 + p] * dts[r];
            const f32x4 b0 = *(const f32x4*)(Bs + r * 128 + ng * 8), b1 = *(const f32x4*)(Bs + r * 128 + ng * 8 + 4);
            const f32x4 c0 = *(const f32x4*)(Cs + r * 128 + ng * 8), c1 = *(const f32x4*)(Cs + r * 128 + ng * 8 + 4);
            float part = 0.f;
            hst[0] = fmaf(xdt, b0.x, hst[0] * dA); part = fmaf(hst[0], c0.x, part);
            hst[1] = fmaf(xdt, b0.y, hst[1] * dA); part = fmaf(hst[1], c0.y, part);
            hst[2] = fmaf(xdt, b0.z, hst[2] * dA); part = fmaf(hst[2], c0.z, part);
            hst[3] = fmaf(xdt, b0.w, hst[3] * dA); part = fmaf(hst[3], c0.w, part);
            hst[4] = fmaf(xdt, b1.x, hst[4] * dA); part = fmaf(hst[4], c1.x, part);
            hst[5] = fmaf(xdt, b1.y, hst[5] * dA); part = fmaf(hst[5], c1.y, part);
            hst[6] = fmaf(xdt, b1.z, hst[6] * dA); part = fmaf(hst[6], c1.z, part);
            hst[7] = fmaf(xdt, b1.w, hst[7] * dA); part = fmaf(hst[7], c1.w, part);
            part = group_sum<16>(part);
            if (ng == 0) ys[r * 32 + p] = part;
        }
        __syncthreads();
        { const int r = tid >> 3, c4 = tid & 7; *(f32x4*)(Y + (row0 + r) * 1024 + h * 64 + ph * 32 + c4 * 4) = *(const f32x4*)(ys + r * 32 + c4 * 4); }
    }
}

__device__ __forceinline__ void ssd_combine_phase(const Args& a, int gw, int NGW, int lane) {
    const float* YF = (const float*)(a.ws + WS_YF); const float* YB = (const float*)(a.ws + WS_YB); const float* ACT = (const float*)(a.ws + WS_ACT);
    const bf16_t* P = (const bf16_t*)(a.ws + WS_PROJ); bf16_t* YC = (bf16_t*)(a.ws + WS_YCAT);
    const float* dsk = a.in[14]; const float* nw = a.in[15];
    for (int m = gw; m < MTOK; m += NGW) {
        const int ch = lane * 16; const float dk = dsk[ch >> 6];
        float z[16], gv[16]; unpack8(*(const v4u*)(P + (size_t)m * NINP + A_Z + ch), z); unpack8(*(const v4u*)(P + (size_t)m * NINP + A_Z + ch + 8), z + 8);
        float ss = 0.f;
#pragma unroll
        for (int q = 0; q < 4; ++q) { const f32x4 f = *(const f32x4*)(YF + (size_t)m * 1024 + ch + 4 * q), bk = *(const f32x4*)(YB + (size_t)m * 1024 + ch + 4 * q), xv = *(const f32x4*)(ACT + (size_t)m * 1536 + ch + 4 * q);
            const f32x4 y = f + bk + dk * xv;
            gv[4 * q] = y.x * silu_f(z[4 * q]); gv[4 * q + 1] = y.y * silu_f(z[4 * q + 1]); gv[4 * q + 2] = y.z * silu_f(z[4 * q + 2]); gv[4 * q + 3] = y.w * silu_f(z[4 * q + 3]); }
#pragma unroll
        for (int i = 0; i < 16; ++i) ss += gv[i] * gv[i];
        const float r = rsqrtf(group_sum<64>(ss) * (1.f / 1024.f) + EPS);
#pragma unroll
        for (int i = 0; i < 16; ++i) gv[i] = gv[i] * r * nw[ch + i];
        *(v4u*)(YC + (size_t)m * 2048 + 1024 + ch) = pack8(gv); *(v4u*)(YC + (size_t)m * 2048 + 1024 + ch + 8) = pack8(gv + 8);
    }
}

__device__ __forceinline__ void post1_phase(const Args& a, int gw, int NGW, int lane) {
    const bf16_t* P = (const bf16_t*)(a.ws + WS_PROJ); const float* cw = a.in[18]; const float* cb = a.in[19];
    float* ACT = (float*)(a.ws + WS_ACT);
    for (int m = gw; m < MTOK; m += NGW) {
        const int t = m & 2047;
#pragma unroll
        for (int j = 0; j < 4; ++j) { const int ch = (j * 64 + lane) * 8;
            float acc[8];
            { const f32x4 b0 = *(const f32x4*)(cb + ch), b1 = *(const f32x4*)(cb + ch + 4); acc[0] = b0.x; acc[1] = b0.y; acc[2] = b0.z; acc[3] = b0.w; acc[4] = b1.x; acc[5] = b1.y; acc[6] = b1.z; acc[7] = b1.w; }
#pragma unroll
            for (int d = 0; d < 4; ++d) { const int ts = t + d - 2;
                if (ts >= 0 && ts < SEQ) { float x[8]; unpack8(*(const v4u*)(P + (size_t)(m + d - 2) * NINP + C_Q + ch), x);
                    const f32x4 w0 = *(const f32x4*)(cw + d * 2048 + ch), w1 = *(const f32x4*)(cw + d * 2048 + ch + 4);
                    acc[0] += w0.x * x[0]; acc[1] += w0.y * x[1]; acc[2] += w0.z * x[2]; acc[3] += w0.w * x[3];
                    acc[4] += w1.x * x[4]; acc[5] += w1.y * x[5]; acc[6] += w1.z * x[6]; acc[7] += w1.w * x[7]; } }
#pragma unroll
            for (int i = 0; i < 8; ++i) acc[i] = silu_f(acc[i]);
            if (j < 2) {
                float ss = 0.f;
#pragma unroll
                for (int i = 0; i < 8; ++i) ss += acc[i] * acc[i];
                ss = group_sum<16>(ss);
                float r = rsqrtf(ss + EPS); if (j == 0) r *= 0.088388347648318440f;
#pragma unroll
                for (int i = 0; i < 8; ++i) acc[i] *= r;
            }
            *(f32x4*)(ACT + (size_t)m * 2048 + ch) = (f32x4){acc[0], acc[1], acc[2], acc[3]}; *(f32x4*)(ACT + (size_t)m * 2048 + ch + 4) = (f32x4){acc[4], acc[5], acc[6], acc[7]}; }
    }
}

__device__ __forceinline__ void gdn_item(const Args& a, int item, float* lds) {
    const int dvs = item & 3, hv = (item >> 2) & 7, dir = (item >> 5) & 1, b = item >> 6, hq = hv >> 1;
    float* ks = lds; float* qs = ks + 32 * 128; float* vs = qs + 32 * 128; float* al = vs + 32 * 32; float* be = al + 32; float* os = be + 32;
    const float Aneg = -expf(a.in[dir ? 21 : 20][hv]); const float dtb = a.in[dir ? 23 : 22][hv];
    const float* ACT = (const float*)(a.ws + WS_ACT); const float* SM = (const float*)(a.ws + WS_SMALL);
    float* O = (float*)(a.ws + (dir ? WS_YB : WS_YF));
    const int tid = threadIdx.x, lane = tid & 63, wave = tid >> 6, dkg = lane & 15, dvi = wave * 4 + (lane >> 4);
    float S[8];
#pragma unroll
    for (int i = 0; i < 8; ++i) S[i] = 0.f;
    for (int tile = 0; tile < 64; ++tile) {
        const int t0 = (dir ? 63 - tile : tile) * 32;
        const size_t row0 = (size_t)b * SEQ + t0;
        __syncthreads();
#pragma unroll
        for (int i = 0; i < 2; ++i) { const int idx = tid + i * 512, r = idx >> 5, c4 = idx & 31;
            *(f32x4*)(ks + r * 128 + c4 * 4) = *(const f32x4*)(ACT + (row0 + r) * 2048 + 512 + hq * 128 + c4 * 4);
            *(f32x4*)(qs + r * 128 + c4 * 4) = *(const f32x4*)(ACT + (row0 + r) * 2048 + hq * 128 + c4 * 4); }
        if (tid < 256) { const int r = tid >> 3, c4 = tid & 7; *(f32x4*)(vs + r * 32 + c4 * 4) = *(const f32x4*)(ACT + (row0 + r) * 2048 + 1024 + hv * 128 + dvs * 32 + c4 * 4); }
        else if (tid < 288) { const int r = tid - 256; const float* sm = SM + (row0 + r) * 32;
            be[r] = sigmoid_f(sm[dir * 8 + hv]); al[r] = expf(Aneg * softplus_f(sm[16 + dir * 8 + hv] + dtb)); }
        __syncthreads();
        for (int s = 0; s < 32; ++s) {
            const int r = dir ? 31 - s : s;
            const f32x4 k0 = *(const f32x4*)(ks + r * 128 + dkg * 8), k1 = *(const f32x4*)(ks + r * 128 + dkg * 8 + 4);
            const f32x4 q0 = *(const f32x4*)(qs + r * 128 + dkg * 8), q1 = *(const f32x4*)(qs + r * 128 + dkg * 8 + 4);
            const float alpha = al[r], beta = be[r], vv = vs[r * 32 + dvi];
            float part = (k0.x * S[0] + k0.y * S[1]) + (k0.z * S[2] + k0.w * S[3]) + (k1.x * S[4] + k1.y * S[5]) + (k1.z * S[6] + k1.w * S[7]);
            part = group_sum<16>(part);
            const float vn = beta * (vv - alpha * part);
            S[0] = fmaf(k0.x, vn, alpha * S[0]); S[1] = fmaf(k0.y, vn, alpha * S[1]); S[2] = fmaf(k0.z, vn, alpha * S[2]); S[3] = fmaf(k0.w, vn, alpha * S[3]);
            S[4] = fmaf(k1.x, vn, alpha * S[4]); S[5] = fmaf(k1.y, vn, alpha * S[5]); S[6] = fmaf(k1.z, vn, alpha * S[6]); S[7] = fmaf(k1.w, vn, alpha * S[7]);
            float po = (q0.x * S[0] + q0.y * S[1]) + (q0.z * S[2] + q0.w * S[3]) + (q1.x * S[4] + q1.y * S[5]) + (q1.z * S[6] + q1.w * S[7]);
            po = group_sum<16>(po);
            if (dkg == 0) os[r * 32 + dvi] = po;
        }
        __syncthreads();
        if (tid < 256) { const int r = tid >> 3, c4 = tid & 7; *(f32x4*)(O + (row0 + r) * 1024 + hv * 128 + dvs * 32 + c4 * 4) = *(const f32x4*)(os + r * 32 + c4 * 4); }
    }
}

__device__ __forceinline__ void lru_item(const Args& a, int item, float* lds) {
    const int n = item & 7, dir = (item >> 3) & 1, b = item >> 4;
    const float* wa = a.in[dir ? 32 : 27] + (size_t)n * 128 * 128; const float* wx = a.in[dir ? 34 : 29] + (size_t)n * 128 * 128;
    const float* ba = a.in[dir ? 33 : 28] + n * 128; const float* bx = a.in[dir ? 35 : 30] + n * 128; const float* lam = a.in[dir ? 36 : 31] + n * 128;
    const float* cw = a.in[25]; const float* cb = a.in[26];
    const bf16_t* P = (const bf16_t*)(a.ws + WS_PROJ);
    float* Hout = (float*)(a.ws + (dir ? WS_HB : WS_HF));
    float* xc = lds; float* As = xc + 64 * 128; float* Us = As + 64 * 128;
    const int tid = threadIdx.x, j = tid & 127, tg = tid >> 7, chn = n * 128 + j;
    const float w0 = cw[chn], w1 = cw[1024 + chn], w2 = cw[2048 + chn], w3 = cw[3072 + chn], cbias = cb[chn];
    const float sp = softplus_f(-lam[j]), baj = ba[j], bxj = bx[j];
    float hstate = 0.f;
    for (int tile = 0; tile < 32; ++tile) {
        const int t0 = (dir ? 31 - tile : tile) * 64;
        __syncthreads();
#pragma unroll 4
        for (int i = 0; i < 16; ++i) { const int tl = tg * 16 + i, t = t0 + tl; const bf16_t* pp = P + ((size_t)b * SEQ + t) * NINP + C_XL + chn;
            float acc = cbias;
            if (t >= 2) acc = fmaf(w0, bf2f(pp[-2 * NINP]), acc);
            if (t >= 1) acc = fmaf(w1, bf2f(pp[-1 * NINP]), acc);
            acc = fmaf(w2, bf2f(pp[0]), acc);
            if (t + 1 < SEQ) acc = fmaf(w3, bf2f(pp[NINP]), acc);
            xc[tl * 128 + j] = acc; }
        __syncthreads();
        float aa[16], ax[16];
#pragma unroll
        for (int i = 0; i < 16; ++i) { aa[i] = baj; ax[i] = bxj; }
        for (int i0 = 0; i0 < 128; i0 += 4) {
            const float a0 = wa[(i0 + 0) * 128 + j], a1 = wa[(i0 + 1) * 128 + j], a2 = wa[(i0 + 2) * 128 + j], a3 = wa[(i0 + 3) * 128 + j];
            const float x0 = wx[(i0 + 0) * 128 + j], x1 = wx[(i0 + 1) * 128 + j], x2 = wx[(i0 + 2) * 128 + j], x3 = wx[(i0 + 3) * 128 + j];
#pragma unroll
            for (int i = 0; i < 16; ++i) { const f32x4 xv = *(const f32x4*)(xc + (tg * 16 + i) * 128 + i0);
                aa[i] += (xv.x * a0 + xv.y * a1) + (xv.z * a2 + xv.w * a3); ax[i] += (xv.x * x0 + xv.y * x1) + (xv.z * x2 + xv.w * x3); }
        }
#pragma unroll
        for (int i = 0; i < 16; ++i) { const int tl = tg * 16 + i;
            const float r = sigmoid_f(aa[i]), ig = sigmoid_f(ax[i]);
            const float la = -8.f * r * sp;
            As[tl * 128 + j] = expf(la); Us[tl * 128 + j] = sqrtf(-expm1f(2.f * la)) * (ig * xc[tl * 128 + j]); }
        __syncthreads();
        if (tid < 128) {
            for (int s = 0; s < 64; ++s) { const int r = dir ? 63 - s : s;
                hstate = fmaf(As[r * 128 + j], hstate, Us[r * 128 + j]);
                Hout[((size_t)b * SEQ + t0 + r) * 1024 + chn] = hstate; }
        }
    }
}

__device__ __forceinline__ void combine1_phase(const Args& a, int gw, int NGW, int lane) {
    const float* OF = (const float*)(a.ws + WS_YF); const float* OB = (const float*)(a.ws + WS_YB);
    const float* HF = (const float*)(a.ws + WS_HF); const float* HB = (const float*)(a.ws + WS_HB);
    const bf16_t* P = (const bf16_t*)(a.ws + WS_PROJ); bf16_t* YC = (bf16_t*)(a.ws + WS_YCAT);
    const float* gn = a.in[24];
    for (int m = gw; m < MTOK; m += NGW) {
        const int ch = lane * 16, d0 = ch & 127;
        float z[16], ov[16];
        unpack8(*(const v4u*)(P + (size_t)m * NINP + C_Z + ch), z); unpack8(*(const v4u*)(P + (size_t)m * NINP + C_Z + ch + 8), z + 8);
#pragma unroll
        for (int q = 0; q < 4; ++q) { const f32x4 f = *(const f32x4*)(OF + (size_t)m * 1024 + ch + 4 * q), bk = *(const f32x4*)(OB + (size_t)m * 1024 + ch + 4 * q); const f32x4 o = f + bk;
            ov[4 * q] = o.x; ov[4 * q + 1] = o.y; ov[4 * q + 2] = o.z; ov[4 * q + 3] = o.w; }
        float ss = 0.f;
#pragma unroll
        for (int i = 0; i < 16; ++i) ss += ov[i] * ov[i];
        ss = group_sum<8>(ss);
        const float r = rsqrtf(ss * (1.f / 128.f) + EPS);
#pragma unroll
        for (int i = 0; i < 16; ++i) ov[i] = ov[i] * r * gn[d0 + i] * silu_f(z[i]);
        *(v4u*)(YC + (size_t)m * 2048 + ch) = pack8(ov); *(v4u*)(YC + (size_t)m * 2048 + ch + 8) = pack8(ov + 8);
        unpack8(*(const v4u*)(P + (size_t)m * NINP + C_GL + ch), z); unpack8(*(const v4u*)(P + (size_t)m * NINP + C_GL + ch + 8), z + 8);
#pragma unroll
        for (int q = 0; q < 4; ++q) { const f32x4 f = *(const f32x4*)(HF + (size_t)m * 1024 + ch + 4 * q), bk = *(const f32x4*)(HB + (size_t)m * 1024 + ch + 4 * q); const f32x4 o = f + bk;
            ov[4 * q] = o.x * silu_f(z[4 * q]); ov[4 * q + 1] = o.y * silu_f(z[4 * q + 1]); ov[4 * q + 2] = o.z * silu_f(z[4 * q + 2]); ov[4 * q + 3] = o.w * silu_f(z[4 * q + 3]); }
        *(v4u*)(YC + (size_t)m * 2048 + 1024 + ch) = pack8(ov); *(v4u*)(YC + (size_t)m * 2048 + 1024 + ch + 8) = pack8(ov + 8);
    }
}

__device__ __forceinline__ void final_norm_phase(const Args& a, int gw, int NGW, int lane) {
    const float* nw = a.in[38];
    for (int m = gw; m < MTOK; m += NGW) {
        f32x4* xr = (f32x4*)(a.out + (size_t)m * 2048) + lane;
        f32x4 v[8]; float s = 0.f;
#pragma unroll
        for (int j = 0; j < 8; ++j) { v[j] = xr[64 * j]; s += (v[j].x * v[j].x + v[j].y * v[j].y) + (v[j].z * v[j].z + v[j].w * v[j].w); }
        const float rstd = rsqrtf(group_sum<64>(s) * (1.f / 2048.f) + EPS);
#pragma unroll
        for (int j = 0; j < 8; ++j) { const f32x4 w = *(const f32x4*)(nw + (64 * j + lane) * 4); xr[64 * j] = v[j] * rstd * w; }
    }
}

typedef GAS unsigned gu32;
#define RLX_AGENT __ATOMIC_RELAXED, __HIP_MEMORY_SCOPE_AGENT
constexpr int CW_BAR = 4096;
constexpr int MISC_OFF = 131072 + 320;
#define XB_TMO      128
#define XB_XCNT(j)  (256  + 64 * (j))
#define XB_XSUB(j)  (1280 + 64 * (j))
#define XB_XGEN(j)  (2304 + 64 * (j))
#define XB_TOP      3328
#define XB_TOPGEN   3392
#define XCD_BAR_WORDS 3456
#define XB_SPIN_CAP (1u << 18)

__device__ __forceinline__ unsigned xb_ld(unsigned* p)              { return __hip_atomic_load(p, __ATOMIC_RELAXED, __HIP_MEMORY_SCOPE_AGENT); }
__device__ __forceinline__ unsigned xb_add(unsigned* p, unsigned v) { return __hip_atomic_fetch_add(p, v, __ATOMIC_RELAXED, __HIP_MEMORY_SCOPE_AGENT); }
__device__ __forceinline__ unsigned xb_xcc_id() { return (unsigned)__builtin_amdgcn_s_getreg((3 << 11) | 20) & 0xFu; }
#define XB_SPIN(cond, bar) do { unsigned _sp = 0; while (cond) { __builtin_amdgcn_s_sleep(1); \
    if ((++_sp & 255u) == 0u) { if (xb_ld(&(bar)[XB_TMO])) break; if (_sp > XB_SPIN_CAP) { atomicAdd(&(bar)[XB_TMO], 1u); break; } } } } while (0)

struct XcdBarrier {
    unsigned* bar; unsigned x;
    volatile LAS unsigned* st;
};

__device__ __forceinline__ XcdBarrier xcd_barrier_post(unsigned* bar, volatile LAS unsigned* st) {
    XcdBarrier b; b.bar = bar; b.x = xb_xcc_id(); b.st = st;
    if (threadIdx.x == 0) (void)xb_add(&bar[XB_XCNT(b.x)], 1u);
    return b;
}
__device__ __forceinline__ void xcd_barrier_complete(unsigned* bar, unsigned x, unsigned& nloc, unsigned& nx) {
    const unsigned G = gridDim.x * gridDim.y * gridDim.z;
    unsigned sum, cnt, mine, sp = 0u;
    for (;;) {
        sum = 0u; cnt = 0u; mine = 0u;
#pragma unroll
        for (unsigned j = 0; j < 16; ++j) { const unsigned c = xb_ld(&bar[XB_XCNT(j)]); sum += c; cnt += (c > 0u) ? 1u : 0u; mine = (j == x) ? c : mine; }
        if (sum == G) break;
        __builtin_amdgcn_s_sleep(1);
        if ((++sp & 255u) == 0u) { if (xb_ld(&bar[XB_TMO])) break; if (sp > XB_SPIN_CAP) { atomicAdd(&bar[XB_TMO], 1u); break; } }
    }
    nloc = mine > 0u ? mine : 1u; nx = cnt > 0u ? cnt : 1u;
}

__device__ __forceinline__ void xcd_barrier(const XcdBarrier& b) {
    asm volatile("s_waitcnt vmcnt(0)" ::: "memory");
    __syncthreads();
    if (threadIdx.x == 0) {
        unsigned* bar = b.bar;
        __builtin_amdgcn_s_waitcnt(0);
        unsigned nloc = b.st[0], nx = b.st[1];
        if (nloc == 0u) { xcd_barrier_complete(bar, b.x, nloc, nx); b.st[0] = nloc; b.st[1] = nx; }
        const unsigned old = xb_add(&bar[XB_XSUB(b.x)], 1u);
        const unsigned gen = old / nloc;
        if (old + 1u == (gen + 1u) * nloc) {
            __builtin_amdgcn_fence(__ATOMIC_RELEASE, "agent");
            asm volatile("s_waitcnt vmcnt(0)" ::: "memory");
            const unsigned og = xb_add(&bar[XB_TOP], 1u);
            const unsigned tg = og / nx;
            if (og + 1u == (tg + 1u) * nx) xb_add(&bar[XB_TOPGEN], 1u);
            else XB_SPIN(xb_ld(&bar[XB_TOPGEN]) == tg, bar);
            __builtin_amdgcn_fence(__ATOMIC_ACQUIRE, "agent");
            xb_add(&bar[XB_XGEN(b.x)], 1u);
            asm volatile("s_waitcnt vmcnt(0)" ::: "memory");
        } else {
            XB_SPIN(xb_ld(&bar[XB_XGEN(b.x)]) == gen, bar);
            __builtin_amdgcn_fence(__ATOMIC_ACQUIRE, "agent");
            asm volatile("s_waitcnt vmcnt(0)" ::: "memory");
        }
    }
    __syncthreads();
}

#ifndef MK_SINGLE
#define MK_SINGLE 1
#endif
__global__ void __launch_bounds__(NTHREADS, 2) mk_fwd(Args a) {
    extern __shared__ __attribute__((aligned(16))) unsigned char lds[];
    LAS unsigned char* ldsl = (LAS unsigned char*)lds;
    const int tid = threadIdx.x, lane = tid & 63, wave = __builtin_amdgcn_readfirstlane(tid >> 6);
    const int G = gridDim.x, bx = blockIdx.x;
    const int vcu = (G % 8 == 0) ? (bx % 8) * (G / 8) + bx / 8 : bx;
    const int gw = vcu * NWAVES + wave, NGW = G * NWAVES;
    unsigned char* ws = a.ws;
    volatile LAS unsigned* MISC = (volatile LAS unsigned*)(ldsl + MISC_OFF);
    if (tid < 32) MISC[tid] = 0u;
    __syncthreads();
    XcdBarrier bar; bar.bar = (unsigned*)(ws + WS_CTL) + CW_BAR; bar.x = 0; bar.st = nullptr;
    if (a.ph_hi - a.ph_lo > 1) bar = xcd_barrier_post((unsigned*)(ws + WS_CTL) + CW_BAR, MISC + 8);
#define IN(k) (a.ph_lo <= (k) && (k) < a.ph_hi)
#define SEAM(k) do { if (IN(k) && IN((k) + 1)) { xcd_barrier(bar); } } while (0)

    if (IN(0)) { p0_prologue(a, ldsl, vcu, G); } SEAM(0);
    if (IN(1)) { normmod_phase(a, a.in[0], 0, gw, NGW, lane); } SEAM(1);
    if (IN(2)) {
        pg8::Gemm g{(const bf16_t*)(ws + WS_H), (const bf16_t*)(ws + WS_WIN0), MTOK, NINP, 2048}; pg8::StaticOrder S; S.init(MTOK, NINP, G, bx);
        pg8::EpiProj E{(bf16_t*)(ws + WS_PROJ), (float*)(ws + WS_SMALL), NINP, A_DT / 256};
        pg8::gemm_phase<pg8::EpiProj, pg8::StaticOrder, true, true>(ldsl, g, S, E);
    } SEAM(2);
    if (IN(3)) { post0_phase(a, gw, NGW, lane); } SEAM(3);
    if (IN(4)) {
        for (int u = vcu; u < 256; u += G) { const int b = u >> 6, h = (u >> 3) & 7, qb = u & 7, kvh = h >> 2; const size_t row0 = (size_t)b * SEQ + qb * 256;
            att::attn_dense_body((const att::bf16*)(ws + WS_QB) + row0 * 1024 + h * 128, (const att::bf16*)(ws + WS_KB) + (size_t)b * SEQ * 256 + kvh * 128,
                                 (const att::bf16*)(ws + WS_VB) + (size_t)b * SEQ * 256 + kvh * 128, (bf16_t*)(ws + WS_YCAT) + row0 * 2048 + h * 128,
                                 (const bf16_t*)(ws + WS_PROJ) + row0 * NINP + A_GA + h * 128, SEQ, (char*)lds);
            __syncthreads(); }
        for (int it = bx; it < 256; it += G) ssd_item(a, it, (float*)lds);
    } SEAM(4);
    if (IN(5)) { ssd_combine_phase(a, gw, NGW, lane); } SEAM(5);
    if (IN(6)) {
        pg8::Gemm g{(const bf16_t*)(ws + WS_YCAT), (const bf16_t*)(ws + WS_WOUT0), MTOK, 2048, 2048}; pg8::StaticOrder S; S.init(MTOK, 2048, G, bx);
        pg8::EpiResid E{a.in[0], a.out, (const float*)(ws + WS_MOD), a.in[3]};
        pg8::gemm_phase<pg8::EpiResid, pg8::StaticOrder, true, true>(ldsl, g, S, E);
    } SEAM(6);
    if (IN(7)) { normmod_phase(a, a.out, 1, gw, NGW, lane); } SEAM(7);
    if (IN(8)) {
        pg8::Gemm g{(const bf16_t*)(ws + WS_H), (const bf16_t*)(ws + WS_WIN1), MTOK, NINP, 2048}; pg8::StaticOrder S; S.init(MTOK, NINP, G, bx);
        pg8::EpiProj E{(bf16_t*)(ws + WS_PROJ), (float*)(ws + WS_SMALL), NINP, C_SM / 256};
        pg8::gemm_phase<pg8::EpiProj, pg8::StaticOrder, true, true>(ldsl, g, S, E);
    } SEAM(8);
    if (IN(9)) { post1_phase(a, gw, NGW, lane); } SEAM(9);
    if (IN(10)) {
        for (int it = bx; it < 256; it += G) gdn_item(a, it, (float*)lds);
        for (int it = bx; it < 64; it += G) lru_item(a, it, (float*)lds);
    } SEAM(10);
    if (IN(11)) { combine1_phase(a, gw, NGW, lane); } SEAM(11);
    if (IN(12)) {
        pg8::Gemm g{(const bf16_t*)(ws + WS_YCAT), (const bf16_t*)(ws + WS_WOUT1), MTOK, 2048, 2048}; pg8::StaticOrder S; S.init(MTOK, 2048, G, bx);
        pg8::EpiResid E{a.out, a.out, (const float*)(ws + WS_MOD) + 4 * 6144, a.in[3] + 6144};
        pg8::gemm_phase<pg8::EpiResid, pg8::StaticOrder, true, true>(ldsl, g, S, E);
    } SEAM(12);
    if (IN(13)) { final_norm_phase(a, gw, NGW, lane); }
#undef IN
#undef SEAM
}

extern "C" void kernel_launch(void* const* d_in, const int* in_sizes, int n_in, void* d_out, int out_size, void* d_ws, size_t ws_size, hipStream_t stream) {
    static int grid = 0;
    if (grid == 0) {
        if (n_in != 39 || out_size != MTOK * DM || ws_size < WS_END) { fprintf(stderr, "kernel_launch: unexpected problem (n_in %d, out %d, ws %zu < %zu)\n", n_in, out_size, ws_size, (size_t)WS_END); grid = -1; return; }
        int dev = 0, cus = 0, per_cu = 0;
        if (hipGetDevice(&dev) != hipSuccess || hipDeviceGetAttribute(&cus, hipDeviceAttributeMultiprocessorCount, dev) != hipSuccess) { grid = -1; return; }
        if (hipFuncSetAttribute((const void*)mk_fwd, hipFuncAttributeMaxDynamicSharedMemorySize, LDS_BYTES) != hipSuccess) { fprintf(stderr, "kernel_launch: hipFuncSetAttribute failed\n"); grid = -1; return; }
        if (hipOccupancyMaxActiveBlocksPerMultiprocessor(&per_cu, (const void*)mk_fwd, NTHREADS, LDS_BYTES) != hipSuccess || per_cu < 1) { fprintf(stderr, "kernel_launch: occupancy query says %d\n", per_cu); (void)hipGetLastError(); per_cu = 1; }
        grid = cus;
    }
    if (grid < 0) return;
    (void)hipMemsetAsync((char*)d_ws + WS_CTL, 0, CTL_ZERO_BYTES, stream);
    Args a{};
    for (int i = 0; i < 39; ++i) a.in[i] = (const float*)d_in[i];
    a.out = (float*)d_out; a.ws = (unsigned char*)d_ws;
#if MK_SINGLE
    a.ph_lo = 0; a.ph_hi = NPHASE;
    void* kargs[] = {&a};
    hipError_t e = hipLaunchCooperativeKernel((const void*)mk_fwd, dim3(grid), dim3(NTHREADS), kargs, LDS_BYTES, stream);
    if (e != hipSuccess) fprintf(stderr, "kernel_launch: cooperative launch failed: %s (grid %d)\n", hipGetErrorString(e), grid);
#else
    for (int p = 0; p < NPHASE; ++p) { a.ph_lo = p; a.ph_hi = p + 1; hipLaunchKernelGGL(mk_fwd, dim3(grid), dim3(NTHREADS), LDS_BYTES, stream, a); }
#endif
}
```

```cpp
#include <hip/hip_runtime.h>
#include <hip/hip_cooperative_groups.h>
#include <hip/hip_bf16.h>
#include <cstdio>
#include <cstdint>
namespace cg = cooperative_groups;

constexpr int BATCH = 4, SEQ = 2048, DM = 2048, MTOK = BATCH * SEQ;
constexpr int NIN = 5152, NINP = 5376;
constexpr float EPS = 1e-6f;
constexpr int A_Q = 0, A_K = 1024, A_V = 1280, A_GA = 1536, A_XS = 2560, A_BS = 3584, A_CS = 3840, A_DT = 4096, A_Z = 4128;
constexpr int C_Q = 0, C_K = 512, C_V = 1024, C_SM = 2048, C_Z = 2080, C_XL = 3104, C_GL = 4128;
namespace pg8 {
#define PG8_LAS __attribute__((address_space(3)))
typedef unsigned short bf16_t;
typedef short bf16x8 __attribute__((ext_vector_type(8)));
typedef float f32x4 __attribute__((ext_vector_type(4)));
typedef unsigned u32x4 __attribute__((ext_vector_type(4)));
constexpr int BM = 256, BK = 64, HALF = 128, HTB = HALF * BK * 2  , STAGE_BYTES = 8 * HTB, NXCD = 8, WGM = 8;

__host__ __device__ __forceinline__ int lds_byte(int r, int c) { const int st = (r >> 4) * 2 + (c >> 5), rr = r & 15, cc = c & 31, ob = rr * 64 + cc * 2; return st * 1024 + (ob ^ (((ob >> 9) & 1) << 5)); }
__host__ __device__ __forceinline__ void stage_rc(int b, int& R, int& C) { const int st = b / 1024, sb = b % 1024, swz = sb ^ (((sb >> 9) & 1) << 5); R = (st >> 1) * 16 + swz / 64; C = (st & 1) * 32 + (swz % 64) / 2; }
__host__ __device__ __forceinline__ int perm32(int rho) { const int n = rho >> 4, i = rho & 15; return 8 * (i >> 2) + 4 * n + (i & 3); }

struct Unit { int pm, pn; };
struct Gemm { const bf16_t* A; const bf16_t* Bt; int M, N, K; };

struct StaticOrder {
    int nM, nN, nwg, G, c;
    __host__ __device__ void init(int M, int N, int G_, int c_) { nM = M / BM; nN = N / BM; nwg = nM * nN; G = G_; c = c_; }
    __host__ __device__ bool next(int i, Unit& u) const {
        const long L = (long)i * G + c; if (L >= nwg) return false;
        int wgid = (int)L; { const int q = nwg / NXCD, r = nwg % NXCD, xcd = wgid % NXCD, off = wgid / NXCD; wgid = (xcd < r ? xcd * (q + 1) : r * (q + 1) + (xcd - r) * q) + off; }
        const int nig = WGM * nN, gid = wgid / nig, fm = gid * WGM, gsz = (nM - fm) < WGM ? (nM - fm) : WGM;
        u.pm = fm + ((wgid % nig) % gsz); u.pn = (wgid % nig) / gsz; return true;
    }
    __device__ __forceinline__ void a_ready(const Unit&) const {}
    __device__ __forceinline__ void done(const Unit&) const {}
};

__device__ __forceinline__ unsigned cvt_pk_bf16(float lo, float hi) { unsigned r; asm volatile("v_cvt_pk_bf16_f32 %0, %1, %2" : "=v"(r) : "v"(lo), "v"(hi)); return r; }
typedef float f32x2 __attribute__((ext_vector_type(2)));
struct EpiProj {
    static constexpr bool PERM = true, AFTER_DRAIN = false;
    bf16_t* O; float* small; int ldc; int small_tile;
    __device__ __forceinline__ void operator()(const f32x4 (&acc)[2][2][4][2], const Unit& u, int wr, int wc, int fr, int fq) const {
        const int row0 = u.pm * BM + wr * 64 + fr; const int col0 = u.pn * BM + wc * 32 + 8 * fq;
        const bool sm = (u.pn == small_tile) && (wc == 0);
#pragma unroll
        for (int ai = 0; ai < 2; ++ai)
#pragma unroll
            for (int m = 0; m < 4; ++m) { const int row = row0 + ai * HALF + m * 16; bf16_t* rowp = O + (size_t)row * ldc + col0;
#pragma unroll
                for (int bj = 0; bj < 2; ++bj) { const f32x4 v0 = acc[ai][bj][m][0], v1 = acc[ai][bj][m][1];
                    u32x4 w; w.x = cvt_pk_bf16(v0[0], v0[1]); w.y = cvt_pk_bf16(v0[2], v0[3]); w.z = cvt_pk_bf16(v1[0], v1[1]); w.w = cvt_pk_bf16(v1[2], v1[3]);
                    *(u32x4*)(rowp + bj * HALF) = w; }
                if (sm) { float* sp = small + (size_t)row * 32 + 8 * fq; *(f32x4*)sp = acc[ai][0][m][0]; *(f32x4*)(sp + 4) = acc[ai][0][m][1]; } }
    }
};
struct EpiResid {
    static constexpr bool PERM = false, AFTER_DRAIN = false;
    const float* xin; float* xout; const float* gacc; const float* gbias;
    __device__ __forceinline__ void operator()(const f32x4 (&acc)[2][2][4][2], const Unit& u, int wr, int wc, int fr, int fq) const {
        const int b = u.pm >> 3;
        const int col0 = u.pn * BM + wc * 32 + 4 * fq;
#pragma unroll
        for (int bj = 0; bj < 2; ++bj)
#pragma unroll
            for (int n = 0; n < 2; ++n) { const int col = col0 + bj * HALF + n * 16;
                const f32x4 g = *(const f32x4*)(gacc + (size_t)b * 6144 + 4096 + col) + *(const f32x4*)(gbias + 4096 + col);
#pragma unroll
                for (int ai = 0; ai < 2; ++ai)
#pragma unroll
                    for (int m = 0; m < 4; ++m) { const size_t off = (size_t)(u.pm * BM + ai * HALF + wr * 64 + m * 16 + fr) * 2048 + col;
                        const f32x4 xv = *(const f32x4*)(xin + off); *(f32x4*)(xout + off) = xv + g * acc[ai][bj][m][n]; } }
    }
};
template <class Epi, class Sched, bool ALIGN_EPI = false, bool SP2 = false>
__device__ __forceinline__ void gemm_phase(PG8_LAS unsigned char* lds, const Gemm g, const Sched& S, const Epi& E) {
    const int tid = threadIdx.x, wid = __builtin_amdgcn_readfirstlane(tid >> 6), lane = tid & 63, wr = wid >> 2, wc = wid & 3, fr = lane & 15, fq = lane >> 4;
    const int K = g.K, nt = K / BK;
    unsigned voffA[2], voffB[2];
#pragma unroll
    for (int i = 0; i < 2; ++i) { int R, C; stage_rc(tid * 16 + i * 8192, R, C); const int Rb = Epi::PERM ? ((R & ~31) + perm32(R & 31)) : R;
        voffA[i] = (unsigned)(R * K + C) * 2u; voffB[i] = (unsigned)(Rb * K + C) * 2u; }
    const size_t kstep = (size_t)(BK * 2);
    const size_t hstep = (size_t)HALF * K * 2;
    const size_t tstep = 2 * hstep;
    const unsigned ldsw = (unsigned)wid * 1024u;
    const int aoff = lds_byte(wr * 64 + fr, fq * 8), boff = lds_byte(wc * 32 + fr, fq * 8);
#define PG8_SA(b, h) (((b) * 2 + (h)) * HTB)
#define PG8_SB(b, h) ((4 + (b) * 2 + (h)) * HTB)
#define PG8_STAGE(bufoff, gbase, voff) do { _Pragma("unroll") for (int _i = 0; _i < 2; ++_i) \
        __builtin_amdgcn_global_load_lds((const unsigned*)((const char*)(gbase) + (voff)[_i]), (PG8_LAS unsigned*)(lds + (bufoff) + ldsw + _i * 8192), 16, 0, 0); } while (0)
#define PG8_LDA(dst, b, h) do { _Pragma("unroll") for (int m = 0; m < 4; ++m) _Pragma("unroll") for (int k = 0; k < 2; ++k) dst[m][k] = *(const PG8_LAS bf16x8*)(lds + PG8_SA(b, h) + aoff + m * 2048 + k * 1024); } while (0)
#define PG8_LDB(dst, b, h) do { _Pragma("unroll") for (int n = 0; n < 2; ++n) _Pragma("unroll") for (int k = 0; k < 2; ++k) dst[n][k] = *(const PG8_LAS bf16x8*)(lds + PG8_SB(b, h) + boff + n * 2048 + k * 1024); } while (0)
#define PG8_MMA(ai, bj, At, Bt) do { __builtin_amdgcn_s_setprio(1); _Pragma("unroll") for (int m = 0; m < 4; ++m) _Pragma("unroll") for (int n = 0; n < 2; ++n) _Pragma("unroll") for (int k = 0; k < 2; ++k) \
        acc[ai][bj][m][n] = __builtin_amdgcn_mfma_f32_16x16x32_bf16(Bt[n][k], At[m][k], acc[ai][bj][m][n], 0, 0, 0); __builtin_amdgcn_s_setprio(0); } while (0)
#define PG8_WAIT_V(n) asm volatile("s_waitcnt vmcnt(" #n ")" ::: "memory")
#define PG8_WAIT_L(n) asm volatile("s_waitcnt lgkmcnt(" #n ")" ::: "memory")
#define PG8_BAR __builtin_amdgcn_s_barrier()
#define PG8_SCHED __builtin_amdgcn_sched_barrier(0)
    Unit cur, nxt; int ui = 0;
    if (!S.next(0, cur)) return;
    f32x4 acc[2][2][4][2];
#pragma unroll
    for (int a = 0; a < 2; ++a)
#pragma unroll
        for (int b = 0; b < 2; ++b)
#pragma unroll
            for (int m = 0; m < 4; ++m)
#pragma unroll
                for (int n = 0; n < 2; ++n) acc[a][b][m][n] = (f32x4){0.f, 0.f, 0.f, 0.f};
    bf16x8 At[4][2], B0[2][2], B1[2][2];
    const char* cA = (const char*)g.A + (size_t)cur.pm * tstep; const char* cB = (const char*)g.Bt + (size_t)cur.pn * tstep;
    S.a_ready(cur);
    if constexpr (SP2) {
        PG8_STAGE(PG8_SB(0, 0), cB, voffB); PG8_STAGE(PG8_SB(0, 1), cB + hstep, voffB); PG8_STAGE(PG8_SA(0, 0), cA, voffA); PG8_STAGE(PG8_SA(0, 1), cA + hstep, voffA);
        if (wr == 1) PG8_BAR;
        PG8_WAIT_V(2); PG8_BAR;
        PG8_STAGE(PG8_SB(1, 0), cB + kstep, voffB); PG8_STAGE(PG8_SA(1, 0), cA + kstep, voffA); PG8_STAGE(PG8_SB(1, 1), cB + hstep + kstep, voffB);
        PG8_WAIT_V(6); PG8_BAR;
    } else {
        PG8_STAGE(PG8_SB(0, 0), cB, voffB); PG8_STAGE(PG8_SA(0, 0), cA, voffA); PG8_STAGE(PG8_SB(0, 1), cB + hstep, voffB); PG8_STAGE(PG8_SA(0, 1), cA + hstep, voffA);
        if (wr == 1) PG8_BAR;
        PG8_WAIT_V(4); PG8_BAR;
        PG8_STAGE(PG8_SB(1, 0), cB + kstep, voffB); PG8_STAGE(PG8_SA(1, 0), cA + kstep, voffA); PG8_STAGE(PG8_SB(1, 1), cB + hstep + kstep, voffB);
        PG8_WAIT_V(6); PG8_BAR;
    }
    for (;;) {
        const bool has_next = S.next(ui + 1, nxt);
        const char* nA = has_next ? (const char*)g.A + (size_t)nxt.pm * tstep : cA; const char* nB = has_next ? (const char*)g.Bt + (size_t)nxt.pn * tstep : cB;
        for (int t = 0; t < nt; t += 2) {
            const bool last = (t == nt - 2);
            const char* a1 = cA + (size_t)(t + 1) * kstep;
            const char* a2 = last ? nA : cA + (size_t)(t + 2) * kstep; const char* b2 = last ? nB : cB + (size_t)(t + 2) * kstep;
            const char* a3 = a2 + kstep; const char* b3 = b2 + kstep;
            if (last && has_next) S.a_ready(nxt);
            if constexpr (SP2) {
            PG8_LDB(B0, 0, 0); PG8_LDB(B1, 0, 1); PG8_SCHED; PG8_LDA(At, 0, 0); PG8_STAGE(PG8_SA(1, 1), a1 + hstep, voffA);
            PG8_WAIT_V(8); PG8_WAIT_L(0); PG8_BAR; PG8_MMA(0, 0, At, B0); PG8_MMA(0, 1, At, B1); PG8_BAR; PG8_SCHED;
            PG8_LDA(At, 0, 1); PG8_STAGE(PG8_SB(0, 0), b2, voffB); PG8_STAGE(PG8_SB(0, 1), b2 + hstep, voffB); PG8_STAGE(PG8_SA(0, 0), a2, voffA);
            PG8_WAIT_V(8); PG8_WAIT_L(0); PG8_BAR; PG8_MMA(1, 0, At, B0); PG8_MMA(1, 1, At, B1); PG8_BAR; PG8_SCHED;
            PG8_LDB(B0, 1, 0); PG8_LDB(B1, 1, 1); PG8_SCHED; PG8_LDA(At, 1, 0); PG8_STAGE(PG8_SA(0, 1), a2 + hstep, voffA);
            PG8_WAIT_V(8); PG8_WAIT_L(0); PG8_BAR; PG8_MMA(0, 0, At, B0); PG8_MMA(0, 1, At, B1); PG8_BAR; PG8_SCHED;
            PG8_LDA(At, 1, 1); PG8_STAGE(PG8_SB(1, 0), b3, voffB); PG8_STAGE(PG8_SB(1, 1), b3 + hstep, voffB); PG8_STAGE(PG8_SA(1, 0), a3, voffA);
            PG8_WAIT_V(8); PG8_WAIT_L(0); PG8_BAR; PG8_MMA(1, 0, At, B0); PG8_MMA(1, 1, At, B1); PG8_BAR; PG8_SCHED;
            } else {
            PG8_LDB(B0, 0, 0); PG8_SCHED; PG8_LDA(At, 0, 0); PG8_STAGE(PG8_SA(1, 1), a1 + hstep, voffA);
            PG8_WAIT_L(8); PG8_BAR; PG8_WAIT_L(0); PG8_MMA(0, 0, At, B0); PG8_BAR; PG8_SCHED;
            PG8_LDB(B1, 0, 1); PG8_STAGE(PG8_SB(0, 0), b2, voffB);
            PG8_BAR; PG8_WAIT_L(0); PG8_MMA(0, 1, At, B1); PG8_BAR;
            PG8_LDA(At, 0, 1); PG8_STAGE(PG8_SA(0, 0), a2, voffA);
            PG8_BAR; PG8_WAIT_L(0); PG8_MMA(1, 0, At, B0); PG8_BAR; PG8_SCHED;
            PG8_STAGE(PG8_SB(0, 1), b2 + hstep, voffB);
            PG8_WAIT_V(6); PG8_BAR; PG8_MMA(1, 1, At, B1); PG8_BAR;
            PG8_LDB(B0, 1, 0); PG8_SCHED; PG8_LDA(At, 1, 0); PG8_STAGE(PG8_SA(0, 1), a2 + hstep, voffA);
            PG8_WAIT_L(8); PG8_BAR; PG8_WAIT_L(0); PG8_MMA(0, 0, At, B0); PG8_BAR; PG8_SCHED;
            PG8_LDB(B1, 1, 1); PG8_STAGE(PG8_SB(1, 0), b3, voffB);
            PG8_BAR; PG8_WAIT_L(0); PG8_MMA(0, 1, At, B1); PG8_BAR;
            PG8_LDA(At, 1, 1); PG8_STAGE(PG8_SA(1, 0), a3, voffA);
            PG8_BAR; PG8_WAIT_L(0); PG8_MMA(1, 0, At, B0); PG8_BAR; PG8_SCHED;
            PG8_STAGE(PG8_SB(1, 1), b3 + hstep, voffB);
            PG8_WAIT_V(6); PG8_BAR; PG8_MMA(1, 1, At, B1); PG8_BAR;
            }
        }
        if constexpr (ALIGN_EPI) { if (wr == 0) PG8_BAR; }
        if constexpr (!Epi::AFTER_DRAIN) { E(acc, cur, wr, wc, fr, fq); S.done(cur); }
        if (!has_next) break;
#pragma unroll
        for (int a = 0; a < 2; ++a)
#pragma unroll
            for (int b = 0; b < 2; ++b)
#pragma unroll
                for (int m = 0; m < 4; ++m)
#pragma unroll
                    for (int n = 0; n < 2; ++n) acc[a][b][m][n] = (f32x4){0.f, 0.f, 0.f, 0.f};
        cur = nxt; cA = nA; cB = nB; ++ui;
        if constexpr (ALIGN_EPI) { if (wr == 1) PG8_BAR; }
    }
    PG8_WAIT_V(0);
    if constexpr (!ALIGN_EPI) { if (wr == 0) PG8_BAR; }
    PG8_BAR;
    if constexpr (Epi::AFTER_DRAIN) { E.fused(acc, cur, wr, wc, fr, fq, lds, wid, lane); S.done(cur); }
#undef PG8_SA
#undef PG8_SB
#undef PG8_STAGE
#undef PG8_LDA
#undef PG8_LDB
#undef PG8_MMA
#undef PG8_WAIT_V
#undef PG8_WAIT_L
#undef PG8_BAR
#undef PG8_SCHED
}
}
namespace att {
using bf16 = __hip_bfloat16;
constexpr int   D = 128, NW = 8, QBLK = 32, KVBLK = 64;
constexpr float SCALE = 0.088388347648318440f;
constexpr float THR = 8.f;
constexpr int SDEPTH = 2;
constexpr int LDQ = 1024, LDK = 256, LDY = 2048, LDG = NINP;
constexpr size_t SHM_V = KVBLK * D * 2, SHM_K = KVBLK * D * 2, SHM_ATTN = 2 * SHM_V + 2 * SHM_K + NW * 64 * 4;
using bf16x8 = __attribute__((ext_vector_type(8))) short;
using s16x4  = __attribute__((ext_vector_type(4))) short;
using f32x16 = __attribute__((ext_vector_type(16))) float;
using f32x8  = __attribute__((ext_vector_type(8))) float;
using u32x4  = __attribute__((ext_vector_type(4))) unsigned;
#define KSWZ(row, colB) ((row) * 256 + ((colB) ^ (((row) & 7) << 4)))
#define SBAR() __builtin_amdgcn_sched_barrier(0)
__device__ __forceinline__ int crow(int r, int hi) { return (r & 3) + 8 * (r >> 2) + 4 * hi; }
__device__ __forceinline__ unsigned cvtpk(float lo, float hi) {
  unsigned r; asm volatile("v_cvt_pk_bf16_f32 %0, %1, %2" : "=v"(r) : "v"(lo), "v"(hi)); return r;
}
template <typename TIn> struct Stage;
template <> struct Stage<bf16>  { using T = bf16x8;
  __device__ static __forceinline__ T ld8(const bf16* p) { return *reinterpret_cast<const bf16x8*>(p); }
  __device__ static __forceinline__ bf16x8 tobf(T x) { return x; } };
template <> struct Stage<float> { using T = f32x8;
  __device__ static __forceinline__ T ld8(const float* p) { return *reinterpret_cast<const f32x8*>(p); }
  __device__ static __forceinline__ bf16x8 tobf(T x) {
    u32x4 w = {cvtpk(x[0], x[1]), cvtpk(x[2], x[3]), cvtpk(x[4], x[5]), cvtpk(x[6], x[7])}; return *reinterpret_cast<bf16x8*>(&w); } };

__device__ __forceinline__ void partialSM(f32x16& p0, f32x16& p1, float& m_reg, float& mn, float& alpha) {
  constexpr float C = SCALE * 1.4426950408889634f;
  float pmax = p0[0]; for (int r = 1; r < 16; ++r) pmax = fmaxf(pmax, p0[r]); for (int r = 0; r < 16; ++r) pmax = fmaxf(pmax, p1[r]);
  { auto rr = __builtin_amdgcn_permlane32_swap(__float_as_uint(pmax), __float_as_uint(pmax), false, false);
    pmax = fmaxf(__uint_as_float(rr[0]), __uint_as_float(rr[1])); }
  if (__builtin_expect(__all(pmax - m_reg <= THR / SCALE), 1)) { mn = m_reg; alpha = 1.f; }
  else { mn = fmaxf(m_reg, pmax); alpha = __builtin_amdgcn_exp2f((m_reg - mn) * C); m_reg = mn; }
  float mnC = -mn * C;
  for (int r = 0; r < 16; ++r) p0[r] = fmaf(p0[r], C, mnC); for (int r = 0; r < 16; ++r) p1[r] = fmaf(p1[r], C, mnC);
  for (int r = 0; r < 16; ++r) p0[r] = __builtin_amdgcn_exp2f(p0[r]);
}
__device__ __forceinline__ void finishSM(f32x16& p0, f32x16& p1, float alpha, float& l_reg, bf16x8& pa0, bf16x8& pa1, bf16x8& pa2, bf16x8& pa3) {
  for (int r = 0; r < 16; ++r) p1[r] = __builtin_amdgcn_exp2f(p1[r]);
  float ps = 0; for (int r = 0; r < 16; ++r) ps += p0[r]; for (int r = 0; r < 16; ++r) ps += p1[r];
  { auto rr = __builtin_amdgcn_permlane32_swap(__float_as_uint(ps), __float_as_uint(ps), false, false);
    ps = __uint_as_float(rr[0]) + __uint_as_float(rr[1]); }
  l_reg = l_reg * alpha + ps;
#define PK4(P, BASE, OUT) do { unsigned a0 = cvtpk(P[BASE + 0], P[BASE + 1]), a1 = cvtpk(P[BASE + 2], P[BASE + 3]);   \
    unsigned b0 = cvtpk(P[BASE + 4], P[BASE + 5]), b1 = cvtpk(P[BASE + 6], P[BASE + 7]);                              \
    auto r0 = __builtin_amdgcn_permlane32_swap(a0, b0, false, false); auto r1 = __builtin_amdgcn_permlane32_swap(a1, b1, false, false); \
    u32x4 w = {r0[0], r1[0], r0[1], r1[1]}; OUT = *reinterpret_cast<bf16x8*>(&w); } while (0)
  PK4(p0, 0, pa0); PK4(p0, 8, pa1); PK4(p1, 0, pa2); PK4(p1, 8, pa3);
#undef PK4
}
__device__ __forceinline__ void qkt(f32x16& p0, f32x16& p1, const bf16* Ks, const bf16x8* qr, int r32, int hi) {
  p0 = f32x16{}; p1 = f32x16{};
  for (int d0 = 0; d0 < 8; ++d0) { int cb = (d0 * 16 + hi * 8) * 2;
    bf16x8 b0 = *reinterpret_cast<const bf16x8*>((const char*)Ks + KSWZ(r32, cb));
    bf16x8 b1 = *reinterpret_cast<const bf16x8*>((const char*)Ks + KSWZ(32 + r32, cb));
    p0 = __builtin_amdgcn_mfma_f32_32x32x16_bf16(b0, qr[d0], p0, 0, 0, 0);
    p1 = __builtin_amdgcn_mfma_f32_32x32x16_bf16(b1, qr[d0], p1, 0, 0, 0); }
}
__device__ __forceinline__ int v_st(int k, int c) { const int kk = (k & ~0xC) | ((k & 4) << 1) | ((k & 8) >> 1); return ((kk >> 3) * 4 + (c >> 5)) * 512 + ((kk & 7) * 32 + (c & 31)) * 2; }
__device__ __forceinline__ int v_rd_base(int lane) { return ((lane & 3) << 3) | (((lane >> 2) & 3) << 6) | (((lane >> 4) & 1) << 5) | (((lane >> 5) & 1) << 8); }
constexpr int v_rd_off(int d0, int ks, int half) { return d0 * 512 + ks * 4096 + half * 2048; }
template <int OFF> __device__ __forceinline__ s16x4 tr_read(int vb) {
  s16x4 r; asm volatile("ds_read_b64_tr_b16 %0, %1 offset:%2" : "=&v"(r) : "v"(vb), "i"(OFF) : "memory"); return r;
}
template <int D0> __device__ __forceinline__ void pv_one(f32x16& od, int vb, bf16x8 pa0, bf16x8 pa1, bf16x8 pa2, bf16x8 pa3) {
  const s16x4 l0 = tr_read<v_rd_off(D0, 0, 0)>(vb), h0 = tr_read<v_rd_off(D0, 0, 1)>(vb), l1 = tr_read<v_rd_off(D0, 1, 0)>(vb), h1 = tr_read<v_rd_off(D0, 1, 1)>(vb);
  const s16x4 l2 = tr_read<v_rd_off(D0, 2, 0)>(vb), h2 = tr_read<v_rd_off(D0, 2, 1)>(vb), l3 = tr_read<v_rd_off(D0, 3, 0)>(vb), h3 = tr_read<v_rd_off(D0, 3, 1)>(vb);
  asm volatile("s_waitcnt lgkmcnt(0)" ::: "memory"); SBAR();
#define PK(L, H) (bf16x8){L[0], L[1], L[2], L[3], H[0], H[1], H[2], H[3]}
  od = __builtin_amdgcn_mfma_f32_32x32x16_bf16(pa0, PK(l0, h0), od, 0, 0, 0);
  od = __builtin_amdgcn_mfma_f32_32x32x16_bf16(pa1, PK(l1, h1), od, 0, 0, 0);
  od = __builtin_amdgcn_mfma_f32_32x32x16_bf16(pa2, PK(l2, h2), od, 0, 0, 0);
  od = __builtin_amdgcn_mfma_f32_32x32x16_bf16(pa3, PK(l3, h3), od, 0, 0, 0);
#undef PK
}
__device__ __forceinline__ void pv_d0(f32x16* o, int vb, bf16x8 pa0, bf16x8 pa1, bf16x8 pa2, bf16x8 pa3) {
  pv_one<0>(o[0], vb, pa0, pa1, pa2, pa3); pv_one<1>(o[1], vb, pa0, pa1, pa2, pa3); pv_one<2>(o[2], vb, pa0, pa1, pa2, pa3); pv_one<3>(o[3], vb, pa0, pa1, pa2, pa3);
}
__device__ __forceinline__ void attn_dense_body(const bf16* __restrict__ Qb, const bf16* __restrict__ Kh, const bf16* __restrict__ Vh,
                                                unsigned short* __restrict__ Yb, const unsigned short* __restrict__ Gb, int seq, char* lds) {
  using St = Stage<bf16>; using SQ = Stage<bf16>; using TQ = bf16;
  const int tid = threadIdx.x, wid = tid >> 6, lane = tid & 63, r32 = lane & 31, hi = lane >> 5;
  bf16* V_lds = (bf16*)lds; bf16* K_lds = (bf16*)(lds + 2 * SHM_V);
  float* ws = (float*)(lds + 2 * SHM_V + 2 * SHM_K) + wid * 64; float* li_l = ws; float* al_l = ws + 32;
  float m_reg = -1e30f, l_reg = 0; f32x16 o[4] = {}; bf16x8 qr[8];
  const TQ* Qw = Qb + (long)(wid * QBLK + r32) * LDQ + hi * 8;
#pragma unroll
  for (int d0 = 0; d0 < 8; ++d0) qr[d0] = SQ::tobf(SQ::ld8(Qw + d0 * 16));
  const int sr = tid >> 4, sc = (tid & 15) * 8, vst0 = v_st(sr, sc), vst1 = v_st(32 + sr, sc);
  const int vb0 = (int)(uintptr_t)V_lds + v_rd_base(lane);
  struct { typename St::T vs0, vs1, ks0, ks1; } sr_[SDEPTH];
#define SLOAD(i, k0) do { sr_[i].vs0 = St::ld8(&Vh[(long)((k0) + sr) * LDK + sc]); sr_[i].vs1 = St::ld8(&Vh[(long)((k0) + 32 + sr) * LDK + sc]); \
    sr_[i].ks0 = St::ld8(&Kh[(long)((k0) + sr) * LDK + sc]); sr_[i].ks1 = St::ld8(&Kh[(long)((k0) + 32 + sr) * LDK + sc]); } while (0)
#define SWRITE(b, i) do { *(bf16x8*)((char*)V_lds + (b) * SHM_V + vst0) = St::tobf(sr_[i].vs0);          \
    *(bf16x8*)((char*)V_lds + (b) * SHM_V + vst1) = St::tobf(sr_[i].vs1); int kc = sc * 2;               \
    *(bf16x8*)((char*)K_lds + (b) * SHM_K + KSWZ(sr, kc)) = St::tobf(sr_[i].ks0);                       \
    *(bf16x8*)((char*)K_lds + (b) * SHM_K + KSWZ(32 + sr, kc)) = St::tobf(sr_[i].ks1); } while (0)
#define SWAIT() do { if constexpr (SDEPTH == 2) asm volatile("s_waitcnt vmcnt(4)" ::: "memory"); else asm volatile("s_waitcnt vmcnt(0)" ::: "memory"); } while (0)
#define RESC(a) do { if (__any((a) < 1.f)) { if (hi == 0) al_l[r32] = (a); asm volatile("s_waitcnt lgkmcnt(0)" ::: "memory"); \
    for (int d = 0; d < 4; ++d) for (int r = 0; r < 16; ++r) o[d][r] *= al_l[crow(r, hi)]; } } while (0)
  f32x16 pA0, pA1, pB0, pB1; float mnA, mnB, alA, alB; bf16x8 pa0, pa1, pa2, pa3; const int NT = seq / KVBLK;
  constexpr int SE = 0, SO = SDEPTH - 1;
  SLOAD(SE, 0); asm volatile("s_waitcnt vmcnt(0)" ::: "memory"); SWRITE(0, SE); __syncthreads();
  qkt(pA0, pA1, K_lds, qr, r32, hi); partialSM(pA0, pA1, m_reg, mnA, alA);
  SLOAD(SO, KVBLK); if constexpr (SDEPTH == 2) { if (2 < NT) SLOAD(SE, 2 * KVBLK); }
  SWAIT(); SWRITE(1, SO); __syncthreads();
  for (int j = 1; j + 1 < NT; j += 2) {
    SBAR(); qkt(pB0, pB1, (bf16*)((char*)K_lds + SHM_K), qr, r32, hi);
    finishSM(pA0, pA1, alA, l_reg, pa0, pa1, pa2, pa3); SBAR();
    SLOAD(SO, (j + SDEPTH) * KVBLK); SBAR();
    pv_d0(o, vb0, pa0, pa1, pa2, pa3); partialSM(pB0, pB1, m_reg, mnB, alB);
    __syncthreads(); SWAIT(); SWRITE(0, SE);
    RESC(alB); __syncthreads();
    SBAR(); qkt(pA0, pA1, K_lds, qr, r32, hi);
    finishSM(pB0, pB1, alB, l_reg, pa0, pa1, pa2, pa3); SBAR();
    if (SDEPTH == 1 || j + 3 < NT) SLOAD(SE, (j + 1 + SDEPTH) * KVBLK); SBAR();
    pv_d0(o, vb0 + (int)SHM_V, pa0, pa1, pa2, pa3); partialSM(pA0, pA1, m_reg, mnA, alA);
    __syncthreads(); SWAIT(); SWRITE(1, SO);
    RESC(alA); __syncthreads();
  }
  SBAR(); qkt(pB0, pB1, (bf16*)((char*)K_lds + SHM_K), qr, r32, hi);
  finishSM(pA0, pA1, alA, l_reg, pa0, pa1, pa2, pa3); SBAR();
  pv_d0(o, vb0, pa0, pa1, pa2, pa3); partialSM(pB0, pB1, m_reg, mnB, alB);
  __syncthreads(); RESC(alB);
  finishSM(pB0, pB1, alB, l_reg, pa0, pa1, pa2, pa3); SBAR();
  pv_d0(o, vb0 + (int)SHM_V, pa0, pa1, pa2, pa3);
  if (hi == 0) li_l[r32] = l_reg; asm volatile("s_waitcnt lgkmcnt(0)" ::: "memory");
  float rli[16];
#pragma unroll
  for (int r = 0; r < 16; ++r) rli[r] = __builtin_amdgcn_rcpf(li_l[crow(r, hi)]);
  int eoff = (wid * QBLK + 4 * hi) ; asm volatile("" : "+v"(eoff));
  const unsigned short* Gw = Gb + (long)eoff * LDG + r32; unsigned short* Yw = Yb + (long)eoff * LDY + r32;
#pragma unroll
  for (int r = 0; r < 16; ++r) { const int orow = (r & 3) + 8 * (r >> 2);
#pragma unroll
    for (int d0 = 0; d0 < 4; ++d0) { const float g = __uint_as_float(((unsigned)Gw[orow * LDG + d0 * 32]) << 16);
      const float val = o[d0][r] * rli[r] * (g / (1.f + __expf(-g)));
      unsigned ub = __float_as_uint(val); ub = (ub + 0x7fffu + ((ub >> 16) & 1u)) >> 16;
      Yw[orow * LDY + d0 * 32] = (unsigned short)ub; } }
#undef SLOAD
#undef SWRITE
#undef SWAIT
#undef RESC
}
}
#define GAS __attribute__((address_space(1)))
#define LAS __attribute__((address_space(3)))
typedef unsigned short bf16_t;
typedef unsigned v4u __attribute__((ext_vector_type(4)));
typedef unsigned v2u __attribute__((ext_vector_type(2)));
typedef float f32x4 __attribute__((ext_vector_type(4)));
#define LDS_WAIT() asm volatile("s_waitcnt lgkmcnt(0)" ::: "memory")

constexpr size_t MiB = 1u << 20;
constexpr size_t WS_CTL = 0, CTL_ZERO_BYTES = 1 * MiB;
constexpr size_t WS_MOD = 64 * 1024;
constexpr size_t WS_ROPE = 1 * MiB;
constexpr size_t WS_SMALL = 2 * MiB;
constexpr size_t WS_WIN0 = 3 * MiB, WS_WOUT0 = 24 * MiB;
constexpr size_t WS_QB = 32 * MiB, WS_KB = 48 * MiB, WS_VB = 52 * MiB;
constexpr size_t WS_HB = 3 * MiB;
constexpr size_t WS_WIN1 = 56 * MiB, WS_WOUT1 = 77 * MiB;
constexpr size_t WS_H = 85 * MiB;
constexpr size_t WS_HF = 85 * MiB;
constexpr size_t WS_PROJ = 117 * MiB;
constexpr size_t WS_YCAT = 201 * MiB;
constexpr size_t WS_ACT = 233 * MiB;
constexpr size_t WS_YF = 297 * MiB, WS_YB = 329 * MiB;
constexpr size_t WS_END = 361 * MiB;

constexpr int NWAVES = 8, NTHREADS = 512;
constexpr int LDS_BYTES = 147456;
constexpr int NPHASE = 14;

struct Args { const float* in[39]; float* out; unsigned char* ws; int ph_lo, ph_hi; };

__device__ __forceinline__ float bf2f(unsigned v) { return __uint_as_float(v << 16); }
__device__ __forceinline__ unsigned f2bf(float f) { unsigned u = __float_as_uint(f); return (u + 0x7fffu + ((u >> 16) & 1u)) >> 16; }
__device__ __forceinline__ unsigned pk2(float lo, float hi) { return f2bf(lo) | (f2bf(hi) << 16); }
__device__ __forceinline__ void unpack8(const v4u w, float* x) {
    x[0] = __uint_as_float(w.x << 16); x[1] = __uint_as_float(w.x & 0xffff0000u); x[2] = __uint_as_float(w.y << 16); x[3] = __uint_as_float(w.y & 0xffff0000u);
    x[4] = __uint_as_float(w.z << 16); x[5] = __uint_as_float(w.z & 0xffff0000u); x[6] = __uint_as_float(w.w << 16); x[7] = __uint_as_float(w.w & 0xffff0000u);
}
__device__ __forceinline__ v4u pack8(const float* x) { v4u w; w.x = pk2(x[0], x[1]); w.y = pk2(x[2], x[3]); w.z = pk2(x[4], x[5]); w.w = pk2(x[6], x[7]); return w; }
__device__ __forceinline__ float silu_f(float x) { return x / (1.f + expf(-x)); }
__device__ __forceinline__ float sigmoid_f(float x) { return 1.f / (1.f + expf(-x)); }
__device__ __forceinline__ float softplus_f(float x) { return fmaxf(x, 0.f) + log1pf(expf(-fabsf(x))); }
template <int CTRL> __device__ __forceinline__ float dpp_mov(float v) { return __builtin_bit_cast(float, __builtin_amdgcn_update_dpp(0, __builtin_bit_cast(int, v), CTRL, 0xF, 0xF, true)); }
template <int N> __device__ __forceinline__ float group_sum(float v) {
    if (N >= 2) v += dpp_mov<0xB1>(v);
    if (N >= 4) v += dpp_mov<0x4E>(v);
    if (N >= 8) v += dpp_mov<0x141>(v);
    if (N >= 16) v += dpp_mov<0x140>(v);
    if (N >= 32) v += __shfl_xor(v, 16);
    if (N >= 64) v += __shfl_xor(v, 32);
    return v;
}

__device__ __forceinline__ void p0_transpose_item(const float* W, int K, int N, bf16_t* WT, int row_off, LAS float* scr, int item, int lane) {
    const int nblk = N / 32, kb = item / nblk, nb = item % nblk, k0 = 64 * kb, n0 = 32 * nb;
#pragma unroll 8
    for (int i = 0; i < 32; ++i) { const int kk = 2 * i + (lane >> 5); scr[kk * 33 + (lane & 31)] = W[(size_t)(k0 + kk) * N + n0 + (lane & 31)]; }
    LDS_WAIT(); asm volatile("" ::: "memory");
    const int c = lane & 7;
#pragma unroll
    for (int j = 0; j < 4; ++j) { const int n = (lane >> 3) + 8 * j; const LAS float* s = scr + (8 * c) * 33 + n;
        v4u o; o.x = pk2(s[0 * 33], s[1 * 33]); o.y = pk2(s[2 * 33], s[3 * 33]); o.z = pk2(s[4 * 33], s[5 * 33]); o.w = pk2(s[6 * 33], s[7 * 33]);
        *(v4u*)(WT + (size_t)(row_off + n0 + n) * K + k0 + 8 * c) = o; }
    LDS_WAIT(); asm volatile("" ::: "memory");
}

__device__ __forceinline__ void p0_prologue(const Args& a, LAS unsigned char* lds, int vcu, int G) {
    const int tid = threadIdx.x, lane = tid & 63, wave = tid >> 6;
    unsigned char* ws = a.ws;
    { const int gid = blockIdx.x * NTHREADS + tid;
      if (gid < 2048) { const int pos = gid >> 5, i = gid & 31; const float freq = expf(-(float)i * (1.f / 32.f) * 9.210340371976184f); const float ang = (float)pos * freq;
          float* rt = (float*)(ws + WS_ROPE); rt[2 * gid] = cosf(ang); rt[2 * gid + 1] = sinf(ang); } }
    { const int gid = blockIdx.x * NTHREADS + tid, gn = G * NTHREADS; constexpr int NV = (NINP - NIN) * 2048 * 2 / 16;
      v4u* p0 = (v4u*)(ws + WS_WIN0 + (size_t)NIN * 2048 * 2); v4u* p1 = (v4u*)(ws + WS_WIN1 + (size_t)NIN * 2048 * 2);
      for (int i = gid; i < NV; i += gn) { p0[i] = (v4u){0, 0, 0, 0}; p1[i] = (v4u){0, 0, 0, 0}; } }
    if (blockIdx.x < 192) {
        const int it = blockIdx.x, l = it / 96, r = it % 96, kc = r / 3, nc = r % 3;
        LAS float* cond = (LAS float*)lds;
        if (tid < 256) { const int b = tid >> 6, k = tid & 63; const float c = a.in[1][b * 2048 + kc * 64 + k]; cond[tid] = silu_f(c); }
        __syncthreads();
        const float* W = a.in[2] + (size_t)l * 2048 * 6144 + (size_t)(kc * 64) * 6144 + nc * 2048 + tid * 4;
        f32x4 acc0 = {0, 0, 0, 0}, acc1 = acc0, acc2 = acc0, acc3 = acc0;
#pragma unroll 8
        for (int k = 0; k < 64; ++k) { const f32x4 w = *(const f32x4*)(W + (size_t)k * 6144);
            acc0 += cond[k] * w; acc1 += cond[64 + k] * w; acc2 += cond[128 + k] * w; acc3 += cond[192 + k] * w; }
        float* macc = (float*)(ws + WS_MOD) + (size_t)l * 4 * 6144 + nc * 2048 + tid * 4;
#pragma unroll
        for (int i = 0; i < 4; ++i) { atomicAdd(macc + i, acc0[i]); atomicAdd(macc + 6144 + i, acc1[i]); atomicAdd(macc + 2 * 6144 + i, acc2[i]); atomicAdd(macc + 3 * 6144 + i, acc3[i]); }
        __syncthreads();
    }
    { LAS float* scr = (LAS float*)(lds + wave * 16384);
      const int gw = vcu * NWAVES + wave, NGW = G * NWAVES;
      constexpr int I_IN = 32 * (NIN / 32), I_OUT = 32 * 64, NITEMS = 2 * (I_IN + I_OUT);
      for (int it = gw; it < NITEMS; it += NGW) {
          int r = it;
          if (r < I_IN) { p0_transpose_item(a.in[5], 2048, NIN, (bf16_t*)(ws + WS_WIN0), 0, scr, r, lane); continue; } r -= I_IN;
          if (r < I_IN) { p0_transpose_item(a.in[17], 2048, NIN, (bf16_t*)(ws + WS_WIN1), 0, scr, r, lane); continue; } r -= I_IN;
          if (r < I_OUT) { p0_transpose_item(a.in[16], 2048, 2048, (bf16_t*)(ws + WS_WOUT0), 0, scr, r, lane); continue; } r -= I_OUT;
          p0_transpose_item(a.in[37], 2048, 2048, (bf16_t*)(ws + WS_WOUT1), 0, scr, r, lane);
      } }
}

__device__ __forceinline__ void normmod_phase(const Args& a, const float* xin, int layer, int gw, int NGW, int lane) {
    const float* nw = a.in[4] + layer * 2048; const float* bm = a.in[3] + layer * 6144;
    const float* macc = (const float*)(a.ws + WS_MOD) + (size_t)layer * 4 * 6144;
    bf16_t* H = (bf16_t*)(a.ws + WS_H);
    for (int m = gw; m < MTOK; m += NGW) {
        const int b = m >> 11;
        const f32x4* xr = (const f32x4*)(xin + (size_t)m * 2048) + lane;
        f32x4 v[8]; float s = 0.f;
#pragma unroll
        for (int j = 0; j < 8; ++j) { v[j] = xr[64 * j]; s += (v[j].x * v[j].x + v[j].y * v[j].y) + (v[j].z * v[j].z + v[j].w * v[j].w); }
        const float rstd = rsqrtf(group_sum<64>(s) * (1.f / 2048.f) + EPS);
#pragma unroll
        for (int j = 0; j < 8; ++j) { const int col = (64 * j + lane) * 4;
            const f32x4 w = *(const f32x4*)(nw + col);
            const f32x4 sh = *(const f32x4*)(macc + b * 6144 + col) + *(const f32x4*)(bm + col);
            const f32x4 sc = *(const f32x4*)(macc + b * 6144 + 2048 + col) + *(const f32x4*)(bm + 2048 + col);
            const f32x4 o = v[j] * rstd * w * (1.f + sc) + sh;
            v2u pk; pk.x = pk2(o.x, o.y); pk.y = pk2(o.z, o.w);
            *(v2u*)(H + (size_t)m * 2048 + col) = pk; }
    }
}

__device__ __forceinline__ void post0_phase(const Args& a, int gw, int NGW, int lane) {
    const bf16_t* P = (const bf16_t*)(a.ws + WS_PROJ);
    const float2* rope = (const float2*)(a.ws + WS_ROPE);
    const float* qn = a.in[6]; const float* kn = a.in[7]; const float* cw = a.in[8]; const float* cb = a.in[9];
    bf16_t* Q = (bf16_t*)(a.ws + WS_QB); bf16_t* K = (bf16_t*)(a.ws + WS_KB); bf16_t* V = (bf16_t*)(a.ws + WS_VB);
    float* ACT = (float*)(a.ws + WS_ACT);
    for (int m = gw; m < MTOK; m += NGW) {
        const int t = m & 2047, prow = t >> 6, pcol = t & 63;
        const bf16_t* pr = P + (size_t)m * NINP;
        {
            float x[16]; unpack8(*(const v4u*)(pr + A_Q + lane * 16), x); unpack8(*(const v4u*)(pr + A_Q + lane * 16 + 8), x + 8);
            float ss = 0.f;
#pragma unroll
            for (int i = 0; i < 16; ++i) ss += x[i] * x[i];
            ss = group_sum<8>(ss);
            const float r = rsqrtf(ss * (1.f / 128.f) + EPS);
            const int d0 = (lane & 7) * 16;
#pragma unroll
            for (int i = 0; i < 16; ++i) x[i] = x[i] * r * qn[d0 + i];
#pragma unroll
            for (int pi = 0; pi < 8; ++pi) { const int p = (d0 >> 1) + pi; const float2 cs = (p < 32) ? rope[prow * 32 + p] : rope[pcol * 32 + p - 32];
                const float x0 = x[2 * pi], x1 = x[2 * pi + 1]; x[2 * pi] = x0 * cs.x - x1 * cs.y; x[2 * pi + 1] = x0 * cs.y + x1 * cs.x; }
            *(v4u*)(Q + (size_t)m * 1024 + lane * 16) = pack8(x); *(v4u*)(Q + (size_t)m * 1024 + lane * 16 + 8) = pack8(x + 8);
        }
        {
            const v2u w = *(const v2u*)(pr + A_K + lane * 4);
            float x[4] = {__uint_as_float(w.x << 16), __uint_as_float(w.x & 0xffff0000u), __uint_as_float(w.y << 16), __uint_as_float(w.y & 0xffff0000u)};
            float ss = (x[0] * x[0] + x[1] * x[1]) + (x[2] * x[2] + x[3] * x[3]);
            ss = group_sum<32>(ss);
            const float r = rsqrtf(ss * (1.f / 128.f) + EPS);
            const int d0 = (lane & 31) * 4;
#pragma unroll
            for (int i = 0; i < 4; ++i) x[i] = x[i] * r * kn[d0 + i];
#pragma unroll
            for (int pi = 0; pi < 2; ++pi) { const int p = (d0 >> 1) + pi; const float2 cs = (p < 32) ? rope[prow * 32 + p] : rope[pcol * 32 + p - 32];
                const float x0 = x[2 * pi], x1 = x[2 * pi + 1]; x[2 * pi] = x0 * cs.x - x1 * cs.y; x[2 * pi + 1] = x0 * cs.y + x1 * cs.x; }
            v2u o; o.x = pk2(x[0], x[1]); o.y = pk2(x[2], x[3]);
            *(v2u*)(K + (size_t)m * 256 + lane * 4) = o;
            *(v2u*)(V + (size_t)m * 256 + lane * 4) = *(const v2u*)(pr + A_V + lane * 4);
        }
#pragma unroll
        for (int j = 0; j < 3; ++j) { const int ch = (j * 64 + lane) * 8;
            float acc[8];
            { const f32x4 b0 = *(const f32x4*)(cb + ch), b1 = *(const f32x4*)(cb + ch + 4); acc[0] = b0.x; acc[1] = b0.y; acc[2] = b0.z; acc[3] = b0.w; acc[4] = b1.x; acc[5] = b1.y; acc[6] = b1.z; acc[7] = b1.w; }
#pragma unroll
            for (int d = 0; d < 4; ++d) { const int ts = t + d - 2;
                if (ts >= 0 && ts < SEQ) { float x[8]; unpack8(*(const v4u*)(P + (size_t)(m + d - 2) * NINP + A_XS + ch), x);
                    const f32x4 w0 = *(const f32x4*)(cw + d * 1536 + ch), w1 = *(const f32x4*)(cw + d * 1536 + ch + 4);
                    acc[0] += w0.x * x[0]; acc[1] += w0.y * x[1]; acc[2] += w0.z * x[2]; acc[3] += w0.w * x[3];
                    acc[4] += w1.x * x[4]; acc[5] += w1.y * x[5]; acc[6] += w1.z * x[6]; acc[7] += w1.w * x[7]; } }
            f32x4 o0, o1; o0.x = silu_f(acc[0]); o0.y = silu_f(acc[1]); o0.z = silu_f(acc[2]); o0.w = silu_f(acc[3]); o1.x = silu_f(acc[4]); o1.y = silu_f(acc[5]); o1.z = silu_f(acc[6]); o1.w = silu_f(acc[7]);
            *(f32x4*)(ACT + (size_t)m * 1536 + ch) = o0; *(f32x4*)(ACT + (size_t)m * 1536 + ch + 4) = o1; }
    }
}

__device__ __forceinline__ void ssd_item(const Args& a, int item, float* lds) {
    const int ph = item & 1, h = (item >> 1) & 15, dir = (item >> 5) & 1, b = item >> 6, g = h >> 3;
    float* xs = lds; float* Bs = xs + 64 * 32; float* Cs = Bs + 64 * 128; float* dts = Cs + 64 * 128; float* das = dts + 64; float* ys = das + 64;
    const float A = -expf(a.in[dir ? 13 : 12][h]); const float dtb = a.in[dir ? 11 : 10][h];
    const float* ACT = (const float*)(a.ws + WS_ACT); const float* SM = (const float*)(a.ws + WS_SMALL);
    float* Y = (float*)(a.ws + (dir ? WS_YB : WS_YF));
    const int tid = threadIdx.x, p = tid >> 4, ng = tid & 15;
    float hst[8];
#pragma unroll
    for (int i = 0; i < 8; ++i) hst[i] = 0.f;
    for (int tile = 0; tile < 32; ++tile) {
        const int t0 = (dir ? 31 - tile : tile) * 64;
        const size_t row0 = (size_t)b * SEQ + t0;
        __syncthreads();
        { const int r = tid >> 3, c4 = tid & 7; *(f32x4*)(xs + r * 32 + c4 * 4) = *(const f32x4*)(ACT + (row0 + r) * 1536 + h * 64 + ph * 32 + c4 * 4); }
#pragma unroll
        for (int i = 0; i < 4; ++i) { const int idx = tid + i * 512, r = idx >> 5, c4 = idx & 31;
            *(f32x4*)(Bs + r * 128 + c4 * 4) = *(const f32x4*)(ACT + (row0 + r) * 1536 + 1024 + g * 128 + c4 * 4);
            *(f32x4*)(Cs + r * 128 + c4 * 4) = *(const f32x4*)(ACT + (row0 + r) * 1536 + 1280 + g * 128 + c4 * 4); }
        if (tid < 64) { const float raw = SM[(row0 + tid) * 32 + dir * 16 + h]; const float dt = softplus_f(raw + dtb); dts[tid] = dt; das[tid] = expf(dt * A); }
        __syncthreads();
        for (int s = 0; s < 64; ++s) {
            const int r = dir ? 63 - s : s;
            const float dA = das[r], xdt = xs[r * 32 + p] * dts[r];
            const f32x4 b0 = *(const f32x4*)(Bs + r * 128 + ng * 8), b1 = *(const f32x4*)(Bs + r * 128 + ng * 8 + 4);
            const f32x4 c0 = *(const f32x4*)(Cs + r * 128 + ng * 8), c1 = *(const f32x4*)(Cs + r * 128 + ng * 8 + 4);
            float part = 0.f;
            hst[0] = fmaf(xdt, b0.x, hst[0] * dA); part = fmaf(hst[0], c0.x, part);
            hst[1] = fmaf(xdt, b0.y, hst[1] * dA); part = fmaf(hst[1], c0.y, part);
            hst[2] = fmaf(xdt, b0.z, hst[2] * dA); part = fmaf(hst[2], c0.z, part);
            hst[3] = fmaf(xdt, b0.w, hst[3] * dA); part = fmaf(hst[3], c0.w, part);
            hst[4] = fmaf(xdt, b1.x, hst[4] * dA); part = fmaf(hst[4], c1.x, part);
            hst[5] = fmaf(xdt, b1.y, hst[5] * dA); part = fmaf(hst[5], c1.y, part);
            hst[6] = fmaf(xdt, b1.z, hst[6] * dA); part = fmaf(hst[6], c1.z, part);
            hst[7] = fmaf(xdt, b1.w, hst[7] * dA); part = fmaf(hst[7], c1.w, part);
            part = group_sum<16>(part);
            if (ng == 0) ys[r * 32 + p] = part;
        }
        __syncthreads();
        { const int r = tid >> 3, c4 = tid & 7; *(f32x4*)(Y + (row0 + r) * 1024 + h * 64 + ph * 32 + c4 * 4) = *(const f32x4*)(ys + r * 32 + c4 * 4); }
    }
}

__device__ __forceinline__ void ssd_combine_phase(const Args& a, int gw, int NGW, int lane) {
    const float* YF = (const float*)(a.ws + WS_YF); const float* YB = (const float*)(a.ws + WS_YB); const float* ACT = (const float*)(a.ws + WS_ACT);
    const bf16_t* P = (const bf16_t*)(a.ws + WS_PROJ); bf16_t* YC = (bf16_t*)(a.ws + WS_YCAT);
    const float* dsk = a.in[14]; const float* nw = a.in[15];
    for (int m = gw; m < MTOK; m += NGW) {
        const int ch = lane * 16; const float dk = dsk[ch >> 6];
        float z[16], gv[16]; unpack8(*(const v4u*)(P + (size_t)m * NINP + A_Z + ch), z); unpack8(*(const v4u*)(P + (size_t)m * NINP + A_Z + ch + 8), z + 8);
        float ss = 0.f;
#pragma unroll
        for (int q = 0; q < 4; ++q) { const f32x4 f = *(const f32x4*)(YF + (size_t)m * 1024 + ch + 4 * q), bk = *(const f32x4*)(YB + (size_t)m * 1024 + ch + 4 * q), xv = *(const f32x4*)(ACT + (size_t)m * 1536 + ch + 4 * q);
            const f32x4 y = f + bk + dk * xv;
            gv[4 * q] = y.x * silu_f(z[4 * q]); gv[4 * q + 1] = y.y * silu_f(z[4 * q + 1]); gv[4 * q + 2] = y.z * silu_f(z[4 * q + 2]); gv[4 * q + 3] = y.w * silu_f(z[4 * q + 3]); }
#pragma unroll
        for (int i = 0; i < 16; ++i) ss += gv[i] * gv[i];
        const float r = rsqrtf(group_sum<64>(ss) * (1.f / 1024.f) + EPS);
#pragma unroll
        for (int i = 0; i < 16; ++i) gv[i] = gv[i] * r * nw[ch + i];
        *(v4u*)(YC + (size_t)m * 2048 + 1024 + ch) = pack8(gv); *(v4u*)(YC + (size_t)m * 2048 + 1024 + ch + 8) = pack8(gv + 8);
    }
}

__device__ __forceinline__ void post1_phase(const Args& a, int gw, int NGW, int lane) {
    const bf16_t* P = (const bf16_t*)(a.ws + WS_PROJ); const float* cw = a.in[18]; const float* cb = a.in[19];
    float* ACT = (float*)(a.ws + WS_ACT);
    for (int m = gw; m < MTOK; m += NGW) {
        const int t = m & 2047;
#pragma unroll
        for (int j = 0; j < 4; ++j) { const int ch = (j * 64 + lane) * 8;
            float acc[8];
            { const f32x4 b0 = *(const f32x4*)(cb + ch), b1 = *(const f32x4*)(cb + ch + 4); acc[0] = b0.x; acc[1] = b0.y; acc[2] = b0.z; acc[3] = b0.w; acc[4] = b1.x; acc[5] = b1.y; acc[6] = b1.z; acc[7] = b1.w; }
#pragma unroll
            for (int d = 0; d < 4; ++d) { const int ts = t + d - 2;
                if (ts >= 0 && ts < SEQ) { float x[8]; unpack8(*(const v4u*)(P + (size_t)(m + d - 2) * NINP + C_Q + ch), x);
                    const f32x4 w0 = *(const f32x4*)(cw + d * 2048 + ch), w1 = *(const f32x4*)(cw + d * 2048 + ch + 4);
                    acc[0] += w0.x * x[0]; acc[1] += w0.y * x[1]; acc[2] += w0.z * x[2]; acc[3] += w0.w * x[3];
                    acc[4] += w1.x * x[4]; acc[5] += w1.y * x[5]; acc[6] += w1.z * x[6]; acc[7] += w1.w * x[7]; } }
#pragma unroll
            for (int i = 0; i < 8; ++i) acc[i] = silu_f(acc[i]);
            if (j < 2) {
                float ss = 0.f;
#pragma unroll
                for (int i = 0; i < 8; ++i) ss += acc[i] * acc[i];
                ss = group_sum<16>(ss);
                float r = rsqrtf(ss + EPS); if (j == 0) r *= 0.088388347648318440f;
#pragma unroll
                for (int i = 0; i < 8; ++i) acc[i] *= r;
            }
            *(f32x4*)(ACT + (size_t)m * 2048 + ch) = (f32x4){acc[0], acc[1], acc[2], acc[3]}; *(f32x4*)(ACT + (size_t)m * 2048 + ch + 4) = (f32x4){acc[4], acc[5], acc[6], acc[7]}; }
    }
}

__device__ __forceinline__ void gdn_item(const Args& a, int item, float* lds) {
    const int dvs = item & 3, hv = (item >> 2) & 7, dir = (item >> 5) & 1, b = item >> 6, hq = hv >> 1;
    float* ks = lds; float* qs = ks + 32 * 128; float* vs = qs + 32 * 128; float* al = vs + 32 * 32; float* be = al + 32; float* os = be + 32;
    const float Aneg = -expf(a.in[dir ? 21 : 20][hv]); const float dtb = a.in[dir ? 23 : 22][hv];
    const float* ACT = (const float*)(a.ws + WS_ACT); const float* SM = (const float*)(a.ws + WS_SMALL);
    float* O = (float*)(a.ws + (dir ? WS_YB : WS_YF));
    const int tid = threadIdx.x, lane = tid & 63, wave = tid >> 6, dkg = lane & 15, dvi = wave * 4 + (lane >> 4);
    float S[8];
#pragma unroll
    for (int i = 0; i < 8; ++i) S[i] = 0.f;
    for (int tile = 0; tile < 64; ++tile) {
        const int t0 = (dir ? 63 - tile : tile) * 32;
        const size_t row0 = (size_t)b * SEQ + t0;
        __syncthreads();
#pragma unroll
        for (int i = 0; i < 2; ++i) { const int idx = tid + i * 512, r = idx >> 5, c4 = idx & 31;
            *(f32x4*)(ks + r * 128 + c4 * 4) = *(const f32x4*)(ACT + (row0 + r) * 2048 + 512 + hq * 128 + c4 * 4);
            *(f32x4*)(qs + r * 128 + c4 * 4) = *(const f32x4*)(ACT + (row0 + r) * 2048 + hq * 128 + c4 * 4); }
        if (tid < 256) { const int r = tid >> 3, c4 = tid & 7; *(f32x4*)(vs + r * 32 + c4 * 4) = *(const f32x4*)(ACT + (row0 + r) * 2048 + 1024 + hv * 128 + dvs * 32 + c4 * 4); }
        else if (tid < 288) { const int r = tid - 256; const float* sm = SM + (row0 + r) * 32;
            be[r] = sigmoid_f(sm[dir * 8 + hv]); al[r] = expf(Aneg * softplus_f(sm[16 + dir * 8 + hv] + dtb)); }
        __syncthreads();
        for (int s = 0; s < 32; ++s) {
            const int r = dir ? 31 - s : s;
            const f32x4 k0 = *(const f32x4*)(ks + r * 128 + dkg * 8), k1 = *(const f32x4*)(ks + r * 128 + dkg * 8 + 4);
            const f32x4 q0 = *(const f32x4*)(qs + r * 128 + dkg * 8), q1 = *(const f32x4*)(qs + r * 128 + dkg * 8 + 4);
            const float alpha = al[r], beta = be[r], vv = vs[r * 32 + dvi];
            float part = (k0.x * S[0] + k0.y * S[1]) + (k0.z * S[2] + k0.w * S[3]) + (k1.x * S[4] + k1.y * S[5]) + (k1.z * S[6] + k1.w * S[7]);
            part = group_sum<16>(part);
            const float vn = beta * (vv - alpha * part);
            S[0] = fmaf(k0.x, vn, alpha * S[0]); S[1] = fmaf(k0.y, vn, alpha * S[1]); S[2] = fmaf(k0.z, vn, alpha * S[2]); S[3] = fmaf(k0.w, vn, alpha * S[3]);
            S[4] = fmaf(k1.x, vn, alpha * S[4]); S[5] = fmaf(k1.y, vn, alpha * S[5]); S[6] = fmaf(k1.z, vn, alpha * S[6]); S[7] = fmaf(k1.w, vn, alpha * S[7]);
            float po = (q0.x * S[0] + q0.y * S[1]) + (q0.z * S[2] + q0.w * S[3]) + (q1.x * S[4] + q1.y * S[5]) + (q1.z * S[6] + q1.w * S[7]);
            po = group_sum<16>(po);
            if (dkg == 0) os[r * 32 + dvi] = po;
        }
        __syncthreads();
        if (tid < 256) { const int r = tid >> 3, c4 = tid & 7; *(f32x4*)(O + (row0 + r) * 1024 + hv * 128 + dvs * 32 + c4 * 4) = *(const f32x4*)(os + r * 32 + c4 * 4); }
    }
}

__device__ __forceinline__ void lru_item(const Args& a, int item, float* lds) {
    const int n = item & 7, dir = (item >> 3) & 1, b = item >> 4;
    const float* wa = a.in[dir ? 32 : 27] + (size_t)n * 128 * 128; const float* wx = a.in[dir ? 34 : 29] + (size_t)n * 128 * 128;
    const float* ba = a.in[dir ? 33 : 28] + n * 128; const float* bx = a.in[dir ? 35 : 30] + n * 128; const float* lam = a.in[dir ? 36 : 31] + n * 128;
    const float* cw = a.in[25]; const float* cb = a.in[26];
    const bf16_t* P = (const bf16_t*)(a.ws + WS_PROJ);
    float* Hout = (float*)(a.ws + (dir ? WS_HB : WS_HF));
    float* xc = lds; float* As = xc + 64 * 128; float* Us = As + 64 * 128;
    const int tid = threadIdx.x, j = tid & 127, tg = tid >> 7, chn = n * 128 + j;
    const float w0 = cw[chn], w1 = cw[1024 + chn], w2 = cw[2048 + chn], w3 = cw[3072 + chn], cbias = cb[chn];
    const float sp = softplus_f(-lam[j]), baj = ba[j], bxj = bx[j];
    float hstate = 0.f;
    for (int tile = 0; tile < 32; ++tile) {
        const int t0 = (dir ? 31 - tile : tile) * 64;
        __syncthreads();
#pragma unroll 4
        for (int i = 0; i < 16; ++i) { const int tl = tg * 16 + i, t = t0 + tl; const bf16_t* pp = P + ((size_t)b * SEQ + t) * NINP + C_XL + chn;
            float acc = cbias;
            if (t >= 2) acc = fmaf(w0, bf2f(pp[-2 * NINP]), acc);
            if (t >= 1) acc = fmaf(w1, bf2f(pp[-1 * NINP]), acc);
            acc = fmaf(w2, bf2f(pp[0]), acc);
            if (t + 1 < SEQ) acc = fmaf(w3, bf2f(pp[NINP]), acc);
            xc[tl * 128 + j] = acc; }
        __syncthreads();
        float aa[16], ax[16];
#pragma unroll
        for (int i = 0; i < 16; ++i) { aa[i] = baj; ax[i] = bxj; }
        for (int i0 = 0; i0 < 128; i0 += 4) {
            const float a0 = wa[(i0 + 0) * 128 + j], a1 = wa[(i0 + 1) * 128 + j], a2 = wa[(i0 + 2) * 128 + j], a3 = wa[(i0 + 3) * 128 + j];
            const float x0 = wx[(i0 + 0) * 128 + j], x1 = wx[(i0 + 1) * 128 + j], x2 = wx[(i0 + 2) * 128 + j], x3 = wx[(i0 + 3) * 128 + j];
#pragma unroll
            for (int i = 0; i < 16; ++i) { const f32x4 xv = *(const f32x4*)(xc + (tg * 16 + i) * 128 + i0);
                aa[i] += (xv.x * a0 + xv.y * a1) + (xv.z * a2 + xv.w * a3); ax[i] += (xv.x * x0 + xv.y * x1) + (xv.z * x2 + xv.w * x3); }
        }
#pragma unroll
        for (int i = 0; i < 16; ++i) { const int tl = tg * 16 + i;
            const float r = sigmoid_f(aa[i]), ig = sigmoid_f(ax[i]);
            const float la = -8.f * r * sp;
            As[tl * 128 + j] = expf(la); Us[tl * 128 + j] = sqrtf(-expm1f(2.f * la)) * (ig * xc[tl * 128 + j]); }
        __syncthreads();
        if (tid < 128) {
            for (int s = 0; s < 64; ++s) { const int r = dir ? 63 - s : s;
                hstate = fmaf(As[r * 128 + j], hstate, Us[r * 128 + j]);
                Hout[((size_t)b * SEQ + t0 + r) * 1024 + chn] = hstate; }
        }
    }
}

__device__ __forceinline__ void combine1_phase(const Args& a, int gw, int NGW, int lane) {
    const float* OF = (const float*)(a.ws + WS_YF); const float* OB = (const float*)(a.ws + WS_YB);
    const float* HF = (const float*)(a.ws + WS_HF); const float* HB = (const float*)(a.ws + WS_HB);
    const bf16_t* P = (const bf16_t*)(a.ws + WS_PROJ); bf16_t* YC = (bf16_t*)(a.ws + WS_YCAT);
    const float* gn = a.in[24];
    for (int m = gw; m < MTOK; m += NGW) {
        const int ch = lane * 16, d0 = ch & 127;
        float z[16], ov[16];
        unpack8(*(const v4u*)(P + (size_t)m * NINP + C_Z + ch), z); unpack8(*(const v4u*)(P + (size_t)m * NINP + C_Z + ch + 8), z + 8);
#pragma unroll
        for (int q = 0; q < 4; ++q) { const f32x4 f = *(const f32x4*)(OF + (size_t)m * 1024 + ch + 4 * q), bk = *(const f32x4*)(OB + (size_t)m * 1024 + ch + 4 * q); const f32x4 o = f + bk;
            ov[4 * q] = o.x; ov[4 * q + 1] = o.y; ov[4 * q + 2] = o.z; ov[4 * q + 3] = o.w; }
        float ss = 0.f;
#pragma unroll
        for (int i = 0; i < 16; ++i) ss += ov[i] * ov[i];
        ss = group_sum<8>(ss);
        const float r = rsqrtf(ss * (1.f / 128.f) + EPS);
#pragma unroll
        for (int i = 0; i < 16; ++i) ov[i] = ov[i] * r * gn[d0 + i] * silu_f(z[i]);
        *(v4u*)(YC + (size_t)m * 2048 + ch) = pack8(ov); *(v4u*)(YC + (size_t)m * 2048 + ch + 8) = pack8(ov + 8);
        unpack8(*(const v4u*)(P + (size_t)m * NINP + C_GL + ch), z); unpack8(*(const v4u*)(P + (size_t)m * NINP + C_GL + ch + 8), z + 8);
#pragma unroll
        for (int q = 0; q < 4; ++q) { const f32x4 f = *(const f32x4*)(HF + (size_t)m * 1024 + ch + 4 * q), bk = *(const f32x4*)(HB + (size_t)m * 1024 + ch + 4 * q); const f32x4 o = f + bk;
            ov[4 * q] = o.x * silu_f(z[4 * q]); ov[4 * q + 1] = o.y * silu_f(z[4 * q + 1]); ov[4 * q + 2] = o.z * silu_f(z[4 * q + 2]); ov[4 * q + 3] = o.w * silu_f(z[4 * q + 3]); }
        *(v4u*)(YC + (size_t)m * 2048 + 1024 + ch) = pack8(ov); *(v4u*)(YC + (size_t)m * 2048 + 1024 + ch + 8) = pack8(ov + 8);
    }
}

__device__ __forceinline__ void final_norm_phase(const Args& a, int gw, int NGW, int lane) {
    const float* nw = a.in[38];
    for (int m = gw; m < MTOK; m += NGW) {
        f32x4* xr = (f32x4*)(a.out + (size_t)m * 2048) + lane;
        f32x4 v[8]; float s = 0.f;
#pragma unroll
        for (int j = 0; j < 8; ++j) { v[j] = xr[64 * j]; s += (v[j].x * v[j].x + v[j].y * v[j].y) + (v[j].z * v[j].z + v[j].w * v[j].w); }
        const float rstd = rsqrtf(group_sum<64>(s) * (1.f / 2048.f) + EPS);
#pragma unroll
        for (int j = 0; j < 8; ++j) { const f32x4 w = *(const f32x4*)(nw + (64 * j + lane) * 4); xr[64 * j] = v[j] * rstd * w; }
    }
}

typedef GAS unsigned gu32;
#define RLX_AGENT __ATOMIC_RELAXED, __HIP_MEMORY_SCOPE_AGENT
constexpr int CW_BAR = 4096;
constexpr int MISC_OFF = 131072 + 320;
#define XB_TMO      128
#define XB_XCNT(j)  (256  + 64 * (j))
#define XB_XSUB(j)  (1280 + 64 * (j))
#define XB_XGEN(j)  (2304 + 64 * (j))
#define XB_TOP      3328
#define XB_TOPGEN   3392
#define XCD_BAR_WORDS 3456
#define XB_SPIN_CAP (1u << 18)

__device__ __forceinline__ unsigned xb_ld(unsigned* p)              { return __hip_atomic_load(p, __ATOMIC_RELAXED, __HIP_MEMORY_SCOPE_AGENT); }
__device__ __forceinline__ unsigned xb_add(unsigned* p, unsigned v) { return __hip_atomic_fetch_add(p, v, __ATOMIC_RELAXED, __HIP_MEMORY_SCOPE_AGENT); }
__device__ __forceinline__ unsigned xb_xcc_id() { return (unsigned)__builtin_amdgcn_s_getreg((3 << 11) | 20) & 0xFu; }
#define XB_SPIN(cond, bar) do { unsigned _sp = 0; while (cond) { __builtin_amdgcn_s_sleep(1); \
    if ((++_sp & 255u) == 0u) { if (xb_ld(&(bar)[XB_TMO])) break; if (_sp > XB_SPIN_CAP) { atomicAdd(&(bar)[XB_TMO], 1u); break; } } } } while (0)

struct XcdBarrier {
    unsigned* bar; unsigned x;
    volatile LAS unsigned* st;
};

__device__ __forceinline__ XcdBarrier xcd_barrier_post(unsigned* bar, volatile LAS unsigned* st) {
    XcdBarrier b; b.bar = bar; b.x = xb_xcc_id(); b.st = st;
    if (threadIdx.x == 0) (void)xb_add(&bar[XB_XCNT(b.x)], 1u);
    return b;
}
__device__ __forceinline__ void xcd_barrier_complete(unsigned* bar, unsigned x, unsigned& nloc, unsigned& nx) {
    const unsigned G = gridDim.x * gridDim.y * gridDim.z;
    unsigned sum, cnt, mine, sp = 0u;
    for (;;) {
        sum = 0u; cnt = 0u; mine = 0u;
#pragma unroll
        for (unsigned j = 0; j < 16; ++j) { const unsigned c = xb_ld(&bar[XB_XCNT(j)]); sum += c; cnt += (c > 0u) ? 1u : 0u; mine = (j == x) ? c : mine; }
        if (sum == G) break;
        __builtin_amdgcn_s_sleep(1);
        if ((++sp & 255u) == 0u) { if (xb_ld(&bar[XB_TMO])) break; if (sp > XB_SPIN_CAP) { atomicAdd(&bar[XB_TMO], 1u); break; } }
    }
    nloc = mine > 0u ? mine : 1u; nx = cnt > 0u ? cnt : 1u;
}

__device__ __forceinline__ void xcd_barrier(const XcdBarrier& b) {
    asm volatile("s_waitcnt vmcnt(0)" ::: "memory");
    __syncthreads();
    if (threadIdx.x == 0) {
        unsigned* bar = b.bar;
        __builtin_amdgcn_s_waitcnt(0);
        unsigned nloc = b.st[0], nx = b.st[1];
        if (nloc == 0u) { xcd_barrier_complete(bar, b.x, nloc, nx); b.st[0] = nloc; b.st[1] = nx; }
        const unsigned old = xb_add(&bar[XB_XSUB(b.x)], 1u);
        const unsigned gen = old / nloc;
        if (old + 1u == (gen + 1u) * nloc) {
            __builtin_amdgcn_fence(__ATOMIC_RELEASE, "agent");
            asm volatile("s_waitcnt vmcnt(0)" ::: "memory");
            const unsigned og = xb_add(&bar[XB_TOP], 1u);
            const unsigned tg = og / nx;
            if (og + 1u == (tg + 1u) * nx) xb_add(&bar[XB_TOPGEN], 1u);
            else XB_SPIN(xb_ld(&bar[XB_TOPGEN]) == tg, bar);
            __builtin_amdgcn_fence(__ATOMIC_ACQUIRE, "agent");
            xb_add(&bar[XB_XGEN(b.x)], 1u);
            asm volatile("s_waitcnt vmcnt(0)" ::: "memory");
        } else {
            XB_SPIN(xb_ld(&bar[XB_XGEN(b.x)]) == gen, bar);
            __builtin_amdgcn_fence(__ATOMIC_ACQUIRE, "agent");
            asm volatile("s_waitcnt vmcnt(0)" ::: "memory");
        }
    }
    __syncthreads();
}

#ifndef PROBE_SSD
#define PROBE_SSD 0
#endif
#ifndef PROBE_GDN
#define PROBE_GDN 0
#endif
#ifndef PROBE_LRU
#define PROBE_LRU 0
#endif
#ifndef MK_SINGLE
#define MK_SINGLE 1
#endif
__global__ void __launch_bounds__(NTHREADS, 2) mk_fwd(Args a) {
    extern __shared__ __attribute__((aligned(16))) unsigned char lds[];
    LAS unsigned char* ldsl = (LAS unsigned char*)lds;
    const int tid = threadIdx.x, lane = tid & 63, wave = __builtin_amdgcn_readfirstlane(tid >> 6);
    const int G = gridDim.x, bx = blockIdx.x;
    const int vcu = (G % 8 == 0) ? (bx % 8) * (G / 8) + bx / 8 : bx;
    const int gw = vcu * NWAVES + wave, NGW = G * NWAVES;
    unsigned char* ws = a.ws;
    volatile LAS unsigned* MISC = (volatile LAS unsigned*)(ldsl + MISC_OFF);
    if (tid < 32) MISC[tid] = 0u;
    __syncthreads();
    XcdBarrier bar; bar.bar = (unsigned*)(ws + WS_CTL) + CW_BAR; bar.x = 0; bar.st = nullptr;
    if (a.ph_hi - a.ph_lo > 1) bar = xcd_barrier_post((unsigned*)(ws + WS_CTL) + CW_BAR, MISC + 8);
#define IN(k) (a.ph_lo <= (k) && (k) < a.ph_hi)
#define SEAM(k) do { if (IN(k) && IN((k) + 1)) { xcd_barrier(bar); } } while (0)

    if (IN(0)) { p0_prologue(a, ldsl, vcu, G); } SEAM(0);
    if (IN(1)) { normmod_phase(a, a.in[0], 0, gw, NGW, lane); } SEAM(1);
    if (IN(2)) {
        pg8::Gemm g{(const bf16_t*)(ws + WS_H), (const bf16_t*)(ws + WS_WIN0), MTOK, NINP, 2048}; pg8::StaticOrder S; S.init(MTOK, NINP, G, bx);
        pg8::EpiProj E{(bf16_t*)(ws + WS_PROJ), (float*)(ws + WS_SMALL), NINP, A_DT / 256};
        pg8::gemm_phase<pg8::EpiProj, pg8::StaticOrder, true, true>(ldsl, g, S, E);
    } SEAM(2);
    if (IN(3)) { post0_phase(a, gw, NGW, lane); } SEAM(3);
    if (IN(4)) {
        for (int u = vcu; u < 256; u += G) { const int b = u >> 6, h = (u >> 3) & 7, qb = u & 7, kvh = h >> 2; const size_t row0 = (size_t)b * SEQ + qb * 256;
            att::attn_dense_body((const att::bf16*)(ws + WS_QB) + row0 * 1024 + h * 128, (const att::bf16*)(ws + WS_KB) + (size_t)b * SEQ * 256 + kvh * 128,
                                 (const att::bf16*)(ws + WS_VB) + (size_t)b * SEQ * 256 + kvh * 128, (bf16_t*)(ws + WS_YCAT) + row0 * 2048 + h * 128,
                                 (const bf16_t*)(ws + WS_PROJ) + row0 * NINP + A_GA + h * 128, SEQ, (char*)lds);
            __syncthreads(); }
        for (int rep = 0; rep < 1 + PROBE_SSD; ++rep) { for (int it = bx; it < 256; it += G) ssd_item(a, it, (float*)lds); __syncthreads(); }
    } SEAM(4);
    if (IN(5)) { ssd_combine_phase(a, gw, NGW, lane); } SEAM(5);
    if (IN(6)) {
        pg8::Gemm g{(const bf16_t*)(ws + WS_YCAT), (const bf16_t*)(ws + WS_WOUT0), MTOK, 2048, 2048}; pg8::StaticOrder S; S.init(MTOK, 2048, G, bx);
        pg8::EpiResid E{a.in[0], a.out, (const float*)(ws + WS_MOD), a.in[3]};
        pg8::gemm_phase<pg8::EpiResid, pg8::StaticOrder, true, true>(ldsl, g, S, E);
    } SEAM(6);
    if (IN(7)) { normmod_phase(a, a.out, 1, gw, NGW, lane); } SEAM(7);
    if (IN(8)) {
        pg8::Gemm g{(const bf16_t*)(ws + WS_H), (const bf16_t*)(ws + WS_WIN1), MTOK, NINP, 2048}; pg8::StaticOrder S; S.init(MTOK, NINP, G, bx);
        pg8::EpiProj E{(bf16_t*)(ws + WS_PROJ), (float*)(ws + WS_SMALL), NINP, C_SM / 256};
        pg8::gemm_phase<pg8::EpiProj, pg8::StaticOrder, true, true>(ldsl, g, S, E);
    } SEAM(8);
    if (IN(9)) { post1_phase(a, gw, NGW, lane); } SEAM(9);
    if (IN(10)) {
        for (int rep = 0; rep < 1 + PROBE_GDN; ++rep) { for (int it = bx; it < 256; it += G) gdn_item(a, it, (float*)lds); __syncthreads(); }
        for (int rep = 0; rep < 1 + PROBE_LRU; ++rep) { for (int it = bx; it < 64; it += G) lru_item(a, it, (float*)lds); __syncthreads(); }
    } SEAM(10);
    if (IN(11)) { combine1_phase(a, gw, NGW, lane); } SEAM(11);
    if (IN(12)) {
        pg8::Gemm g{(const bf16_t*)(ws + WS_YCAT), (const bf16_t*)(ws + WS_WOUT1), MTOK, 2048, 2048}; pg8::StaticOrder S; S.init(MTOK, 2048, G, bx);
        pg8::EpiResid E{a.out, a.out, (const float*)(ws + WS_MOD) + 4 * 6144, a.in[3] + 6144};
        pg8::gemm_phase<pg8::EpiResid, pg8::StaticOrder, true, true>(ldsl, g, S, E);
    } SEAM(12);
    if (IN(13)) { final_norm_phase(a, gw, NGW, lane); }
#undef IN
#undef SEAM
}

extern "C" void kernel_launch(void* const* d_in, const int* in_sizes, int n_in, void* d_out, int out_size, void* d_ws, size_t ws_size, hipStream_t stream) {
    static int grid = 0;
    if (grid == 0) {
        if (n_in != 39 || out_size != MTOK * DM || ws_size < WS_END) { fprintf(stderr, "kernel_launch: unexpected problem (n_in %d, out %d, ws %zu < %zu)\n", n_in, out_size, ws_size, (size_t)WS_END); grid = -1; return; }
        int dev = 0, cus = 0, per_cu = 0;
        if (hipGetDevice(&dev) != hipSuccess || hipDeviceGetAttribute(&cus, hipDeviceAttributeMultiprocessorCount, dev) != hipSuccess) { grid = -1; return; }
        if (hipFuncSetAttribute((const void*)mk_fwd, hipFuncAttributeMaxDynamicSharedMemorySize, LDS_BYTES) != hipSuccess) { fprintf(stderr, "kernel_launch: hipFuncSetAttribute failed\n"); grid = -1; return; }
        if (hipOccupancyMaxActiveBlocksPerMultiprocessor(&per_cu, (const void*)mk_fwd, NTHREADS, LDS_BYTES) != hipSuccess || per_cu < 1) { fprintf(stderr, "kernel_launch: occupancy query says %d\n", per_cu); (void)hipGetLastError(); per_cu = 1; }
        grid = cus;
    }
    if (grid < 0) return;
    (void)hipMemsetAsync((char*)d_ws + WS_CTL, 0, CTL_ZERO_BYTES, stream);
    Args a{};
    for (int i = 0; i < 39; ++i) a.in[i] = (const float*)d_in[i];
    a.out = (float*)d_out; a.ws = (unsigned char*)d_ws;
#if MK_SINGLE
    a.ph_lo = 0; a.ph_hi = NPHASE;
    void* kargs[] = {&a};
    hipError_t e = hipLaunchCooperativeKernel((const void*)mk_fwd, dim3(grid), dim3(NTHREADS), kargs, LDS_BYTES, stream);
    if (e != hipSuccess) fprintf(stderr, "kernel_launch: cooperative launch failed: %s (grid %d)\n", hipGetErrorString(e), grid);
#else
    for (int p = 0; p < NPHASE; ++p) { a.ph_lo = p; a.ph_hi = p + 1; hipLaunchKernelGGL(mk_fwd, dim3(grid), dim3(NTHREADS), LDS_BYTES, stream, a); }
#endif
}
```

```cpp
#include <hip/hip_runtime.h>
#include <hip/hip_cooperative_groups.h>
#include <hip/hip_bf16.h>
#include <cstdio>
#include <cstdint>
namespace cg = cooperative_groups;

constexpr int BATCH = 4, SEQ = 2048, DM = 2048, MTOK = BATCH * SEQ;
constexpr int NIN = 5152, NINP = 5376;
constexpr float EPS = 1e-6f;
constexpr int A_Q = 0, A_K = 1024, A_V = 1280, A_GA = 1536, A_XS = 2560, A_BS = 3584, A_CS = 3840, A_DT = 4096, A_Z = 4128;
constexpr int C_Q = 0, C_K = 512, C_V = 1024, C_SM = 2048, C_Z = 2080, C_XL = 3104, C_GL = 4128;
namespace pg8 {
#define PG8_LAS __attribute__((address_space(3)))
typedef unsigned short bf16_t;
typedef short bf16x8 __attribute__((ext_vector_type(8)));
typedef float f32x4 __attribute__((ext_vector_type(4)));
typedef unsigned u32x4 __attribute__((ext_vector_type(4)));
constexpr int BM = 256, BK = 64, HALF = 128, HTB = HALF * BK * 2  , STAGE_BYTES = 8 * HTB, NXCD = 8, WGM = 8;

__host__ __device__ __forceinline__ int lds_byte(int r, int c) { const int st = (r >> 4) * 2 + (c >> 5), rr = r & 15, cc = c & 31, ob = rr * 64 + cc * 2; return st * 1024 + (ob ^ (((ob >> 9) & 1) << 5)); }
__host__ __device__ __forceinline__ void stage_rc(int b, int& R, int& C) { const int st = b / 1024, sb = b % 1024, swz = sb ^ (((sb >> 9) & 1) << 5); R = (st >> 1) * 16 + swz / 64; C = (st & 1) * 32 + (swz % 64) / 2; }
__host__ __device__ __forceinline__ int perm32(int rho) { const int n = rho >> 4, i = rho & 15; return 8 * (i >> 2) + 4 * n + (i & 3); }

struct Unit { int pm, pn; };
struct Gemm { const bf16_t* A; const bf16_t* Bt; int M, N, K; };

struct StaticOrder {
    int nM, nN, nwg, G, c;
    __host__ __device__ void init(int M, int N, int G_, int c_) { nM = M / BM; nN = N / BM; nwg = nM * nN; G = G_; c = c_; }
    __host__ __device__ bool next(int i, Unit& u) const {
        const long L = (long)i * G + c; if (L >= nwg) return false;
        int wgid = (int)L; { const int q = nwg / NXCD, r = nwg % NXCD, xcd = wgid % NXCD, off = wgid / NXCD; wgid = (xcd < r ? xcd * (q + 1) : r * (q + 1) + (xcd - r) * q) + off; }
        const int nig = WGM * nN, gid = wgid / nig, fm = gid * WGM, gsz = (nM - fm) < WGM ? (nM - fm) : WGM;
        u.pm = fm + ((wgid % nig) % gsz); u.pn = (wgid % nig) / gsz; return true;
    }
    __device__ __forceinline__ void a_ready(const Unit&) const {}
    __device__ __forceinline__ void done(const Unit&) const {}
};

__device__ __forceinline__ unsigned cvt_pk_bf16(float lo, float hi) { unsigned r; asm volatile("v_cvt_pk_bf16_f32 %0, %1, %2" : "=v"(r) : "v"(lo), "v"(hi)); return r; }
typedef float f32x2 __attribute__((ext_vector_type(2)));
struct EpiProj {
    static constexpr bool PERM = true, AFTER_DRAIN = false;
    bf16_t* O; float* small; int ldc; int small_tile;
    __device__ __forceinline__ void operator()(const f32x4 (&acc)[2][2][4][2], const Unit& u, int wr, int wc, int fr, int fq) const {
        const int row0 = u.pm * BM + wr * 64 + fr; const int col0 = u.pn * BM + wc * 32 + 8 * fq;
        const bool sm = (u.pn == small_tile) && (wc == 0);
#pragma unroll
        for (int ai = 0; ai < 2; ++ai)
#pragma unroll
            for (int m = 0; m < 4; ++m) { const int row = row0 + ai * HALF + m * 16; bf16_t* rowp = O + (size_t)row * ldc + col0;
#pragma unroll
                for (int bj = 0; bj < 2; ++bj) { const f32x4 v0 = acc[ai][bj][m][0], v1 = acc[ai][bj][m][1];
                    u32x4 w; w.x = cvt_pk_bf16(v0[0], v0[1]); w.y = cvt_pk_bf16(v0[2], v0[3]); w.z = cvt_pk_bf16(v1[0], v1[1]); w.w = cvt_pk_bf16(v1[2], v1[3]);
                    *(u32x4*)(rowp + bj * HALF) = w; }
                if (sm) { float* sp = small + (size_t)row * 32 + 8 * fq; *(f32x4*)sp = acc[ai][0][m][0]; *(f32x4*)(sp + 4) = acc[ai][0][m][1]; } }
    }
};
struct EpiResid {
    static constexpr bool PERM = false, AFTER_DRAIN = false;
    const float* xin; float* xout; const float* gacc; const float* gbias;
    __device__ __forceinline__ void operator()(const f32x4 (&acc)[2][2][4][2], const Unit& u, int wr, int wc, int fr, int fq) const {
        const int b = u.pm >> 3;
        const int col0 = u.pn * BM + wc * 32 + 4 * fq;
#pragma unroll
        for (int bj = 0; bj < 2; ++bj)
#pragma unroll
            for (int n = 0; n < 2; ++n) { const int col = col0 + bj * HALF + n * 16;
                const f32x4 g = *(const f32x4*)(gacc + (size_t)b * 6144 + 4096 + col) + *(const f32x4*)(gbias + 4096 + col);
#pragma unroll
                for (int ai = 0; ai < 2; ++ai)
#pragma unroll
                    for (int m = 0; m < 4; ++m) { const size_t off = (size_t)(u.pm * BM + ai * HALF + wr * 64 + m * 16 + fr) * 2048 + col;
                        const f32x4 xv = *(const f32x4*)(xin + off); *(f32x4*)(xout + off) = xv + g * acc[ai][bj][m][n]; } }
    }
};
template <class Epi, class Sched, bool ALIGN_EPI = false, bool SP2 = false>
__device__ __forceinline__ void gemm_phase(PG8_LAS unsigned char* lds, const Gemm g, const Sched& S, const Epi& E) {
    const int tid = threadIdx.x, wid = __builtin_amdgcn_readfirstlane(tid >> 6), lane = tid & 63, wr = wid >> 2, wc = wid & 3, fr = lane & 15, fq = lane >> 4;
    const int K = g.K, nt = K / BK;
    unsigned voffA[2], voffB[2];
#pragma unroll
    for (int i = 0; i < 2; ++i) { int R, C; stage_rc(tid * 16 + i * 8192, R, C); const int Rb = Epi::PERM ? ((R & ~31) + perm32(R & 31)) : R;
        voffA[i] = (unsigned)(R * K + C) * 2u; voffB[i] = (unsigned)(Rb * K + C) * 2u; }
    const size_t kstep = (size_t)(BK * 2);
    const size_t hstep = (size_t)HALF * K * 2;
    const size_t tstep = 2 * hstep;
    const unsigned ldsw = (unsigned)wid * 1024u;
    const int aoff = lds_byte(wr * 64 + fr, fq * 8), boff = lds_byte(wc * 32 + fr, fq * 8);
#define PG8_SA(b, h) (((b) * 2 + (h)) * HTB)
#define PG8_SB(b, h) ((4 + (b) * 2 + (h)) * HTB)
#define PG8_STAGE(bufoff, gbase, voff) do { _Pragma("unroll") for (int _i = 0; _i < 2; ++_i) \
        __builtin_amdgcn_global_load_lds((const unsigned*)((const char*)(gbase) + (voff)[_i]), (PG8_LAS unsigned*)(lds + (bufoff) + ldsw + _i * 8192), 16, 0, 0); } while (0)
#define PG8_LDA(dst, b, h) do { _Pragma("unroll") for (int m = 0; m < 4; ++m) _Pragma("unroll") for (int k = 0; k < 2; ++k) dst[m][k] = *(const PG8_LAS bf16x8*)(lds + PG8_SA(b, h) + aoff + m * 2048 + k * 1024); } while (0)
#define PG8_LDB(dst, b, h) do { _Pragma("unroll") for (int n = 0; n < 2; ++n) _Pragma("unroll") for (int k = 0; k < 2; ++k) dst[n][k] = *(const PG8_LAS bf16x8*)(lds + PG8_SB(b, h) + boff + n * 2048 + k * 1024); } while (0)
#define PG8_MMA(ai, bj, At, Bt) do { __builtin_amdgcn_s_setprio(1); _Pragma("unroll") for (int m = 0; m < 4; ++m) _Pragma("unroll") for (int n = 0; n < 2; ++n) _Pragma("unroll") for (int k = 0; k < 2; ++k) \
        acc[ai][bj][m][n] = __builtin_amdgcn_mfma_f32_16x16x32_bf16(Bt[n][k], At[m][k], acc[ai][bj][m][n], 0, 0, 0); __builtin_amdgcn_s_setprio(0); } while (0)
#define PG8_WAIT_V(n) asm volatile("s_waitcnt vmcnt(" #n ")" ::: "memory")
#define PG8_WAIT_L(n) asm volatile("s_waitcnt lgkmcnt(" #n ")" ::: "memory")
#define PG8_BAR __builtin_amdgcn_s_barrier()
#define PG8_SCHED __builtin_amdgcn_sched_barrier(0)
    Unit cur, nxt; int ui = 0;
    if (!S.next(0, cur)) return;
    f32x4 acc[2][2][4][2];
#pragma unroll
    for (int a = 0; a < 2; ++a)
#pragma unroll
        for (int b = 0; b < 2; ++b)
#pragma unroll
            for (int m = 0; m < 4; ++m)
#pragma unroll
                for (int n = 0; n < 2; ++n) acc[a][b][m][n] = (f32x4){0.f, 0.f, 0.f, 0.f};
    bf16x8 At[4][2], B0[2][2], B1[2][2];
    const char* cA = (const char*)g.A + (size_t)cur.pm * tstep; const char* cB = (const char*)g.Bt + (size_t)cur.pn * tstep;
    S.a_ready(cur);
    if constexpr (SP2) {
        PG8_STAGE(PG8_SB(0, 0), cB, voffB); PG8_STAGE(PG8_SB(0, 1), cB + hstep, voffB); PG8_STAGE(PG8_SA(0, 0), cA, voffA); PG8_STAGE(PG8_SA(0, 1), cA + hstep, voffA);
        if (wr == 1) PG8_BAR;
        PG8_WAIT_V(2); PG8_BAR;
        PG8_STAGE(PG8_SB(1, 0), cB + kstep, voffB); PG8_STAGE(PG8_SA(1, 0), cA + kstep, voffA); PG8_STAGE(PG8_SB(1, 1), cB + hstep + kstep, voffB);
        PG8_WAIT_V(6); PG8_BAR;
    } else {
        PG8_STAGE(PG8_SB(0, 0), cB, voffB); PG8_STAGE(PG8_SA(0, 0), cA, voffA); PG8_STAGE(PG8_SB(0, 1), cB + hstep, voffB); PG8_STAGE(PG8_SA(0, 1), cA + hstep, voffA);
        if (wr == 1) PG8_BAR;
        PG8_WAIT_V(4); PG8_BAR;
        PG8_STAGE(PG8_SB(1, 0), cB + kstep, voffB); PG8_STAGE(PG8_SA(1, 0), cA + kstep, voffA); PG8_STAGE(PG8_SB(1, 1), cB + hstep + kstep, voffB);
        PG8_WAIT_V(6); PG8_BAR;
    }
    for (;;) {
        const bool has_next = S.next(ui + 1, nxt);
        const char* nA = has_next ? (const char*)g.A + (size_t)nxt.pm * tstep : cA; const char* nB = has_next ? (const char*)g.Bt + (size_t)nxt.pn * tstep : cB;
        for (int t = 0; t < nt; t += 2) {
            const bool last = (t == nt - 2);
            const char* a1 = cA + (size_t)(t + 1) * kstep;
            const char* a2 = last ? nA : cA + (size_t)(t + 2) * kstep; const char* b2 = last ? nB : cB + (size_t)(t + 2) * kstep;
            const char* a3 = a2 + kstep; const char* b3 = b2 + kstep;
            if (last && has_next) S.a_ready(nxt);
            if constexpr (SP2) {
            PG8_LDB(B0, 0, 0); PG8_LDB(B1, 0, 1); PG8_SCHED; PG8_LDA(At, 0, 0); PG8_STAGE(PG8_SA(1, 1), a1 + hstep, voffA);
            PG8_WAIT_V(8); PG8_WAIT_L(0); PG8_BAR; PG8_MMA(0, 0, At, B0); PG8_MMA(0, 1, At, B1); PG8_BAR; PG8_SCHED;
            PG8_LDA(At, 0, 1); PG8_STAGE(PG8_SB(0, 0), b2, voffB); PG8_STAGE(PG8_SB(0, 1), b2 + hstep, voffB); PG8_STAGE(PG8_SA(0, 0), a2, voffA);
            PG8_WAIT_V(8); PG8_WAIT_L(0); PG8_BAR; PG8_MMA(1, 0, At, B0); PG8_MMA(1, 1, At, B1); PG8_BAR; PG8_SCHED;
            PG8_LDB(B0, 1, 0); PG8_LDB(B1, 1, 1); PG8_SCHED; PG8_LDA(At, 1, 0); PG8_STAGE(PG8_SA(0, 1), a2 + hstep, voffA);
            PG8_WAIT_V(8); PG8_WAIT_L(0); PG8_BAR; PG8_MMA(0, 0, At, B0); PG8_MMA(0, 1, At, B1); PG8_BAR; PG8_SCHED;
            PG8_LDA(At, 1, 1); PG8_STAGE(PG8_SB(1, 0), b3, voffB); PG8_STAGE(PG8_SB(1, 1), b3 + hstep, voffB); PG8_STAGE(PG8_SA(1, 0), a3, voffA);
            PG8_WAIT_V(8); PG8_WAIT_L(0); PG8_BAR; PG8_MMA(1, 0, At, B0); PG8_MMA(1, 1, At, B1); PG8_BAR; PG8_SCHED;
            } else {
            PG8_LDB(B0, 0, 0); PG8_SCHED; PG8_LDA(At, 0, 0); PG8_STAGE(PG8_SA(1, 1), a1 + hstep, voffA);
            PG8_WAIT_L(8); PG8_BAR; PG8_WAIT_L(0); PG8_MMA(0, 0, At, B0); PG8_BAR; PG8_SCHED;
            PG8_LDB(B1, 0, 1); PG8_STAGE(PG8_SB(0, 0), b2, voffB);
            PG8_BAR; PG8_WAIT_L(0); PG8_MMA(0, 1, At, B1); PG8_BAR;
            PG8_LDA(At, 0, 1); PG8_STAGE(PG8_SA(0, 0), a2, voffA);
            PG8_BAR; PG8_WAIT_L(0); PG8_MMA(1, 0, At, B0); PG8_BAR; PG8_SCHED;
            PG8_STAGE(PG8_SB(0, 1), b2 + hstep, voffB);
            PG8_WAIT_V(6); PG8_BAR; PG8_MMA(1, 1, At, B1); PG8_BAR;
            PG8_LDB(B0, 1, 0); PG8_SCHED; PG8_LDA(At, 1, 0); PG8_STAGE(PG8_SA(0, 1), a2 + hstep, voffA);
            PG8_WAIT_L(8); PG8_BAR; PG8_WAIT_L(0); PG8_MMA(0, 0, At, B0); PG8_BAR; PG8_SCHED;
            PG8_LDB(B1, 1, 1); PG8_STAGE(PG8_SB(1, 0), b3, voffB);
            PG8_BAR; PG8_WAIT_L(0); PG8_MMA(0, 1, At, B1); PG8_BAR;
            PG8_LDA(At, 1, 1); PG8_STAGE(PG8_SA(1, 0), a3, voffA);
            PG8_BAR; PG8_WAIT_L(0); PG8_MMA(1, 0, At, B0); PG8_BAR; PG8_SCHED;
            PG8_STAGE(PG8_SB(1, 1), b3 + hstep, voffB);
            PG8_WAIT_V(6); PG8_BAR; PG8_MMA(1, 1, At, B1); PG8_BAR;
            }
        }
        if constexpr (ALIGN_EPI) { if (wr == 0) PG8_BAR; }
        if constexpr (!Epi::AFTER_DRAIN) { E(acc, cur, wr, wc, fr, fq); S.done(cur); }
        if (!has_next) break;
#pragma unroll
        for (int a = 0; a < 2; ++a)
#pragma unroll
            for (int b = 0; b < 2; ++b)
#pragma unroll
                for (int m = 0; m < 4; ++m)
#pragma unroll
                    for (int n = 0; n < 2; ++n) acc[a][b][m][n] = (f32x4){0.f, 0.f, 0.f, 0.f};
        cur = nxt; cA = nA; cB = nB; ++ui;
        if constexpr (ALIGN_EPI) { if (wr == 1) PG8_BAR; }
    }
    PG8_WAIT_V(0);
    if constexpr (!ALIGN_EPI) { if (wr == 0) PG8_BAR; }
    PG8_BAR;
    if constexpr (Epi::AFTER_DRAIN) { E.fused(acc, cur, wr, wc, fr, fq, lds, wid, lane); S.done(cur); }
#undef PG8_SA
#undef PG8_SB
#undef PG8_STAGE
#undef PG8_LDA
#undef PG8_LDB
#undef PG8_MMA
#undef PG8_WAIT_V
#undef PG8_WAIT_L
#undef PG8_BAR
#undef PG8_SCHED
}
}
namespace att {
using bf16 = __hip_bfloat16;
constexpr int   D = 128, NW = 8, QBLK = 32, KVBLK = 64;
constexpr float SCALE = 0.088388347648318440f;
constexpr float THR = 8.f;
constexpr int SDEPTH = 2;
constexpr int LDQ = 1024, LDK = 256, LDY = 2048, LDG = NINP;
constexpr size_t SHM_V = KVBLK * D * 2, SHM_K = KVBLK * D * 2, SHM_ATTN = 2 * SHM_V + 2 * SHM_K + NW * 64 * 4;
using bf16x8 = __attribute__((ext_vector_type(8))) short;
using s16x4  = __attribute__((ext_vector_type(4))) short;
using f32x16 = __attribute__((ext_vector_type(16))) float;
using f32x8  = __attribute__((ext_vector_type(8))) float;
using u32x4  = __attribute__((ext_vector_type(4))) unsigned;
#define KSWZ(row, colB) ((row) * 256 + ((colB) ^ (((row) & 7) << 4)))
#define SBAR() __builtin_amdgcn_sched_barrier(0)
__device__ __forceinline__ int crow(int r, int hi) { return (r & 3) + 8 * (r >> 2) + 4 * hi; }
__device__ __forceinline__ unsigned cvtpk(float lo, float hi) {
  unsigned r; asm volatile("v_cvt_pk_bf16_f32 %0, %1, %2" : "=v"(r) : "v"(lo), "v"(hi)); return r;
}
template <typename TIn> struct Stage;
template <> struct Stage<bf16>  { using T = bf16x8;
  __device__ static __forceinline__ T ld8(const bf16* p) { return *reinterpret_cast<const bf16x8*>(p); }
  __device__ static __forceinline__ bf16x8 tobf(T x) { return x; } };
template <> struct Stage<float> { using T = f32x8;
  __device__ static __forceinline__ T ld8(const float* p) { return *reinterpret_cast<const f32x8*>(p); }
  __device__ static __forceinline__ bf16x8 tobf(T x) {
    u32x4 w = {cvtpk(x[0], x[1]), cvtpk(x[2], x[3]), cvtpk(x[4], x[5]), cvtpk(x[6], x[7])}; return *reinterpret_cast<bf16x8*>(&w); } };

__device__ __forceinline__ void partialSM(f32x16& p0, f32x16& p1, float& m_reg, float& mn, float& alpha) {
  constexpr float C = SCALE * 1.4426950408889634f;
  float pmax = p0[0]; for (int r = 1; r < 16; ++r) pmax = fmaxf(pmax, p0[r]); for (int r = 0; r < 16; ++r) pmax = fmaxf(pmax, p1[r]);
  { auto rr = __builtin_amdgcn_permlane32_swap(__float_as_uint(pmax), __float_as_uint(pmax), false, false);
    pmax = fmaxf(__uint_as_float(rr[0]), __uint_as_float(rr[1])); }
  if (__builtin_expect(__all(pmax - m_reg <= THR / SCALE), 1)) { mn = m_reg; alpha = 1.f; }
  else { mn = fmaxf(m_reg, pmax); alpha = __builtin_amdgcn_exp2f((m_reg - mn) * C); m_reg = mn; }
  float mnC = -mn * C;
  for (int r = 0; r < 16; ++r) p0[r] = fmaf(p0[r], C, mnC); for (int r = 0; r < 16; ++r) p1[r] = fmaf(p1[r], C, mnC);
  for (int r = 0; r < 16; ++r) p0[r] = __builtin_amdgcn_exp2f(p0[r]);
}
__device__ __forceinline__ void finishSM(f32x16& p0, f32x16& p1, float alpha, float& l_reg, bf16x8& pa0, bf16x8& pa1, bf16x8& pa2, bf16x8& pa3) {
  for (int r = 0; r < 16; ++r) p1[r] = __builtin_amdgcn_exp2f(p1[r]);
  float ps = 0; for (int r = 0; r < 16; ++r) ps += p0[r]; for (int r = 0; r < 16; ++r) ps += p1[r];
  { auto rr = __builtin_amdgcn_permlane32_swap(__float_as_uint(ps), __float_as_uint(ps), false, false);
    ps = __uint_as_float(rr[0]) + __uint_as_float(rr[1]); }
  l_reg = l_reg * alpha + ps;
#define PK4(P, BASE, OUT) do { unsigned a0 = cvtpk(P[BASE + 0], P[BASE + 1]), a1 = cvtpk(P[BASE + 2], P[BASE + 3]);   \
    unsigned b0 = cvtpk(P[BASE + 4], P[BASE + 5]), b1 = cvtpk(P[BASE + 6], P[BASE + 7]);                              \
    auto r0 = __builtin_amdgcn_permlane32_swap(a0, b0, false, false); auto r1 = __builtin_amdgcn_permlane32_swap(a1, b1, false, false); \
    u32x4 w = {r0[0], r1[0], r0[1], r1[1]}; OUT = *reinterpret_cast<bf16x8*>(&w); } while (0)
  PK4(p0, 0, pa0); PK4(p0, 8, pa1); PK4(p1, 0, pa2); PK4(p1, 8, pa3);
#undef PK4
}
__device__ __forceinline__ void qkt(f32x16& p0, f32x16& p1, const bf16* Ks, const bf16x8* qr, int r32, int hi) {
  p0 = f32x16{}; p1 = f32x16{};
  for (int d0 = 0; d0 < 8; ++d0) { int cb = (d0 * 16 + hi * 8) * 2;
    bf16x8 b0 = *reinterpret_cast<const bf16x8*>((const char*)Ks + KSWZ(r32, cb));
    bf16x8 b1 = *reinterpret_cast<const bf16x8*>((const char*)Ks + KSWZ(32 + r32, cb));
    p0 = __builtin_amdgcn_mfma_f32_32x32x16_bf16(b0, qr[d0], p0, 0, 0, 0);
    p1 = __builtin_amdgcn_mfma_f32_32x32x16_bf16(b1, qr[d0], p1, 0, 0, 0); }
}
__device__ __forceinline__ int v_st(int k, int c) { const int kk = (k & ~0xC) | ((k & 4) << 1) | ((k & 8) >> 1); return ((kk >> 3) * 4 + (c >> 5)) * 512 + ((kk & 7) * 32 + (c & 31)) * 2; }
__device__ __forceinline__ int v_rd_base(int lane) { return ((lane & 3) << 3) | (((lane >> 2) & 3) << 6) | (((lane >> 4) & 1) << 5) | (((lane >> 5) & 1) << 8); }
constexpr int v_rd_off(int d0, int ks, int half) { return d0 * 512 + ks * 4096 + half * 2048; }
template <int OFF> __device__ __forceinline__ s16x4 tr_read(int vb) {
  s16x4 r; asm volatile("ds_read_b64_tr_b16 %0, %1 offset:%2" : "=&v"(r) : "v"(vb), "i"(OFF) : "memory"); return r;
}
template <int D0> __device__ __forceinline__ void pv_one(f32x16& od, int vb, bf16x8 pa0, bf16x8 pa1, bf16x8 pa2, bf16x8 pa3) {
  const s16x4 l0 = tr_read<v_rd_off(D0, 0, 0)>(vb), h0 = tr_read<v_rd_off(D0, 0, 1)>(vb), l1 = tr_read<v_rd_off(D0, 1, 0)>(vb), h1 = tr_read<v_rd_off(D0, 1, 1)>(vb);
  const s16x4 l2 = tr_read<v_rd_off(D0, 2, 0)>(vb), h2 = tr_read<v_rd_off(D0, 2, 1)>(vb), l3 = tr_read<v_rd_off(D0, 3, 0)>(vb), h3 = tr_read<v_rd_off(D0, 3, 1)>(vb);
  asm volatile("s_waitcnt lgkmcnt(0)" ::: "memory"); SBAR();
#define PK(L, H) (bf16x8){L[0], L[1], L[2], L[3], H[0], H[1], H[2], H[3]}
  od = __builtin_amdgcn_mfma_f32_32x32x16_bf16(pa0, PK(l0, h0), od, 0, 0, 0);
  od = __builtin_amdgcn_mfma_f32_32x32x16_bf16(pa1, PK(l1, h1), od, 0, 0, 0);
  od = __builtin_amdgcn_mfma_f32_32x32x16_bf16(pa2, PK(l2, h2), od, 0, 0, 0);
  od = __builtin_amdgcn_mfma_f32_32x32x16_bf16(pa3, PK(l3, h3), od, 0, 0, 0);
#undef PK
}
__device__ __forceinline__ void pv_d0(f32x16* o, int vb, bf16x8 pa0, bf16x8 pa1, bf16x8 pa2, bf16x8 pa3) {
  pv_one<0>(o[0], vb, pa0, pa1, pa2, pa3); pv_one<1>(o[1], vb, pa0, pa1, pa2, pa3); pv_one<2>(o[2], vb, pa0, pa1, pa2, pa3); pv_one<3>(o[3], vb, pa0, pa1, pa2, pa3);
}
__device__ __forceinline__ void attn_dense_body(const bf16* __restrict__ Qb, const bf16* __restrict__ Kh, const bf16* __restrict__ Vh,
                                                unsigned short* __restrict__ Yb, const unsigned short* __restrict__ Gb, int seq, char* lds) {
  using St = Stage<bf16>; using SQ = Stage<bf16>; using TQ = bf16;
  const int tid = threadIdx.x, wid = tid >> 6, lane = tid & 63, r32 = lane & 31, hi = lane >> 5;
  bf16* V_lds = (bf16*)lds; bf16* K_lds = (bf16*)(lds + 2 * SHM_V);
  float* ws = (float*)(lds + 2 * SHM_V + 2 * SHM_K) + wid * 64; float* li_l = ws; float* al_l = ws + 32;
  float m_reg = -1e30f, l_reg = 0; f32x16 o[4] = {}; bf16x8 qr[8];
  const TQ* Qw = Qb + (long)(wid * QBLK + r32) * LDQ + hi * 8;
#pragma unroll
  for (int d0 = 0; d0 < 8; ++d0) qr[d0] = SQ::tobf(SQ::ld8(Qw + d0 * 16));
  const int sr = tid >> 4, sc = (tid & 15) * 8, vst0 = v_st(sr, sc), vst1 = v_st(32 + sr, sc);
  const int vb0 = (int)(uintptr_t)V_lds + v_rd_base(lane);
  struct { typename St::T vs0, vs1, ks0, ks1; } sr_[SDEPTH];
#define SLOAD(i, k0) do { sr_[i].vs0 = St::ld8(&Vh[(long)((k0) + sr) * LDK + sc]); sr_[i].vs1 = St::ld8(&Vh[(long)((k0) + 32 + sr) * LDK + sc]); \
    sr_[i].ks0 = St::ld8(&Kh[(long)((k0) + sr) * LDK + sc]); sr_[i].ks1 = St::ld8(&Kh[(long)((k0) + 32 + sr) * LDK + sc]); } while (0)
#define SWRITE(b, i) do { *(bf16x8*)((char*)V_lds + (b) * SHM_V + vst0) = St::tobf(sr_[i].vs0);          \
    *(bf16x8*)((char*)V_lds + (b) * SHM_V + vst1) = St::tobf(sr_[i].vs1); int kc = sc * 2;               \
    *(bf16x8*)((char*)K_lds + (b) * SHM_K + KSWZ(sr, kc)) = St::tobf(sr_[i].ks0);                       \
    *(bf16x8*)((char*)K_lds + (b) * SHM_K + KSWZ(32 + sr, kc)) = St::tobf(sr_[i].ks1); } while (0)
#define SWAIT() do { if constexpr (SDEPTH == 2) asm volatile("s_waitcnt vmcnt(4)" ::: "memory"); else asm volatile("s_waitcnt vmcnt(0)" ::: "memory"); } while (0)
#define RESC(a) do { if (__any((a) < 1.f)) { if (hi == 0) al_l[r32] = (a); asm volatile("s_waitcnt lgkmcnt(0)" ::: "memory"); \
    for (int d = 0; d < 4; ++d) for (int r = 0; r < 16; ++r) o[d][r] *= al_l[crow(r, hi)]; } } while (0)
  f32x16 pA0, pA1, pB0, pB1; float mnA, mnB, alA, alB; bf16x8 pa0, pa1, pa2, pa3; const int NT = seq / KVBLK;
  constexpr int SE = 0, SO = SDEPTH - 1;
  SLOAD(SE, 0); asm volatile("s_waitcnt vmcnt(0)" ::: "memory"); SWRITE(0, SE); __syncthreads();
  qkt(pA0, pA1, K_lds, qr, r32, hi); partialSM(pA0, pA1, m_reg, mnA, alA);
  SLOAD(SO, KVBLK); if constexpr (SDEPTH == 2) { if (2 < NT) SLOAD(SE, 2 * KVBLK); }
  SWAIT(); SWRITE(1, SO); __syncthreads();
  for (int j = 1; j + 1 < NT; j += 2) {
    SBAR(); qkt(pB0, pB1, (bf16*)((char*)K_lds + SHM_K), qr, r32, hi);
    finishSM(pA0, pA1, alA, l_reg, pa0, pa1, pa2, pa3); SBAR();
    SLOAD(SO, (j + SDEPTH) * KVBLK); SBAR();
    pv_d0(o, vb0, pa0, pa1, pa2, pa3); partialSM(pB0, pB1, m_reg, mnB, alB);
    __syncthreads(); SWAIT(); SWRITE(0, SE);
    RESC(alB); __syncthreads();
    SBAR(); qkt(pA0, pA1, K_lds, qr, r32, hi);
    finishSM(pB0, pB1, alB, l_reg, pa0, pa1, pa2, pa3); SBAR();
    if (SDEPTH == 1 || j + 3 < NT) SLOAD(SE, (j + 1 + SDEPTH) * KVBLK); SBAR();
    pv_d0(o, vb0 + (int)SHM_V, pa0, pa1, pa2, pa3); partialSM(pA0, pA1, m_reg, mnA, alA);
    __syncthreads(); SWAIT(); SWRITE(1, SO);
    RESC(alA); __syncthreads();
  }
  SBAR(); qkt(pB0, pB1, (bf16*)((char*)K_lds + SHM_K), qr, r32, hi);
  finishSM(pA0, pA1, alA, l_reg, pa0, pa1, pa2, pa3); SBAR();
  pv_d0(o, vb0, pa0, pa1, pa2, pa3); partialSM(pB0, pB1, m_reg, mnB, alB);
  __syncthreads(); RESC(alB);
  finishSM(pB0, pB1, alB, l_reg, pa0, pa1, pa2, pa3); SBAR();
  pv_d0(o, vb0 + (int)SHM_V, pa0, pa1, pa2, pa3);
  if (hi == 0) li_l[r32] = l_reg; asm volatile("s_waitcnt lgkmcnt(0)" ::: "memory");
  float rli[16];
#pragma unroll
  for (int r = 0; r < 16; ++r) rli[r] = __builtin_amdgcn_rcpf(li_l[crow(r, hi)]);
  int eoff = (wid * QBLK + 4 * hi) ; asm volatile("" : "+v"(eoff));
  const unsigned short* Gw = Gb + (long)eoff * LDG + r32; unsigned short* Yw = Yb + (long)eoff * LDY + r32;
#pragma unroll
  for (int r = 0; r < 16; ++r) { const int orow = (r & 3) + 8 * (r >> 2);
#pragma unroll
    for (int d0 = 0; d0 < 4; ++d0) { const float g = __uint_as_float(((unsigned)Gw[orow * LDG + d0 * 32]) << 16);
      const float val = o[d0][r] * rli[r] * (g / (1.f + __expf(-g)));
      unsigned ub = __float_as_uint(val); ub = (ub + 0x7fffu + ((ub >> 16) & 1u)) >> 16;
      Yw[orow * LDY + d0 * 32] = (unsigned short)ub; } }
#undef SLOAD
#undef SWRITE
#undef SWAIT
#undef RESC
}
}
#define GAS __attribute__((address_space(1)))
#define LAS __attribute__((address_space(3)))
typedef unsigned short bf16_t;
typedef unsigned v4u __attribute__((ext_vector_type(4)));
typedef unsigned v2u __attribute__((ext_vector_type(2)));
typedef float f32x4 __attribute__((ext_vector_type(4)));
#define LDS_WAIT() asm volatile("s_waitcnt lgkmcnt(0)" ::: "memory")

constexpr size_t MiB = 1u << 20;
constexpr size_t WS_CTL = 0, CTL_ZERO_BYTES = 1 * MiB;
constexpr size_t WS_MOD = 64 * 1024;
constexpr size_t WS_ROPE = 1 * MiB;
constexpr size_t WS_SMALL = 2 * MiB;
constexpr size_t WS_WIN0 = 3 * MiB, WS_WOUT0 = 24 * MiB;
constexpr size_t WS_QB = 32 * MiB, WS_KB = 48 * MiB, WS_VB = 52 * MiB;
constexpr size_t WS_HB = 3 * MiB;
constexpr size_t WS_WIN1 = 56 * MiB, WS_WOUT1 = 77 * MiB;
constexpr size_t WS_H = 85 * MiB;
constexpr size_t WS_HF = 85 * MiB;
constexpr size_t WS_PROJ = 117 * MiB;
constexpr size_t WS_YCAT = 201 * MiB;
constexpr size_t WS_ACT = 233 * MiB;
constexpr size_t WS_YF = 297 * MiB, WS_YB = 329 * MiB;
constexpr size_t WS_WGT = 361 * MiB;
constexpr size_t WS_LSUM = 362 * MiB;
constexpr size_t WS_END = 366 * MiB;

constexpr int NWAVES = 8, NTHREADS = 512;
constexpr int LDS_BYTES = 147456;
constexpr int NPHASE = 14;

struct Args { const float* in[39]; float* out; unsigned char* ws; int ph_lo, ph_hi; };

__device__ __forceinline__ float bf2f(unsigned v) { return __uint_as_float(v << 16); }
__device__ __forceinline__ unsigned f2bf(float f) { unsigned u = __float_as_uint(f); return (u + 0x7fffu + ((u >> 16) & 1u)) >> 16; }
__device__ __forceinline__ unsigned pk2(float lo, float hi) { return f2bf(lo) | (f2bf(hi) << 16); }
__device__ __forceinline__ void unpack8(const v4u w, float* x) {
    x[0] = __uint_as_float(w.x << 16); x[1] = __uint_as_float(w.x & 0xffff0000u); x[2] = __uint_as_float(w.y << 16); x[3] = __uint_as_float(w.y & 0xffff0000u);
    x[4] = __uint_as_float(w.z << 16); x[5] = __uint_as_float(w.z & 0xffff0000u); x[6] = __uint_as_float(w.w << 16); x[7] = __uint_as_float(w.w & 0xffff0000u);
}
__device__ __forceinline__ v4u pack8(const float* x) { v4u w; w.x = pk2(x[0], x[1]); w.y = pk2(x[2], x[3]); w.z = pk2(x[4], x[5]); w.w = pk2(x[6], x[7]); return w; }
__device__ __forceinline__ float silu_f(float x) { return x / (1.f + expf(-x)); }
__device__ __forceinline__ float sigmoid_f(float x) { return 1.f / (1.f + expf(-x)); }
__device__ __forceinline__ float softplus_f(float x) { return fmaxf(x, 0.f) + log1pf(expf(-fabsf(x))); }
template <int CTRL> __device__ __forceinline__ float dpp_mov(float v) { return __builtin_bit_cast(float, __builtin_amdgcn_update_dpp(0, __builtin_bit_cast(int, v), CTRL, 0xF, 0xF, true)); }
template <int N> __device__ __forceinline__ float group_sum(float v) {
    if (N >= 2) v += dpp_mov<0xB1>(v);
    if (N >= 4) v += dpp_mov<0x4E>(v);
    if (N >= 8) v += dpp_mov<0x141>(v);
    if (N >= 16) v += dpp_mov<0x140>(v);
    if (N >= 32) v += __shfl_xor(v, 16);
    if (N >= 64) v += __shfl_xor(v, 32);
    return v;
}

__device__ __forceinline__ void p0_transpose_item(const float* W, int K, int N, bf16_t* WT, int row_off, LAS float* scr, int item, int lane) {
    const int nblk = N / 32, kb = item / nblk, nb = item % nblk, k0 = 64 * kb, n0 = 32 * nb;
#pragma unroll 8
    for (int i = 0; i < 32; ++i) { const int kk = 2 * i + (lane >> 5); scr[kk * 33 + (lane & 31)] = W[(size_t)(k0 + kk) * N + n0 + (lane & 31)]; }
    LDS_WAIT(); asm volatile("" ::: "memory");
    const int c = lane & 7;
#pragma unroll
    for (int j = 0; j < 4; ++j) { const int n = (lane >> 3) + 8 * j; const LAS float* s = scr + (8 * c) * 33 + n;
        v4u o; o.x = pk2(s[0 * 33], s[1 * 33]); o.y = pk2(s[2 * 33], s[3 * 33]); o.z = pk2(s[4 * 33], s[5 * 33]); o.w = pk2(s[6 * 33], s[7 * 33]);
        *(v4u*)(WT + (size_t)(row_off + n0 + n) * K + k0 + 8 * c) = o; }
    LDS_WAIT(); asm volatile("" ::: "memory");
}

__device__ __forceinline__ void p0_prologue(const Args& a, LAS unsigned char* lds, int vcu, int G) {
    const int tid = threadIdx.x, lane = tid & 63, wave = tid >> 6;
    unsigned char* ws = a.ws;
    { const int gid = blockIdx.x * NTHREADS + tid;
      if (gid < 2048) { const int pos = gid >> 5, i = gid & 31; const float freq = expf(-(float)i * (1.f / 32.f) * 9.210340371976184f); const float ang = (float)pos * freq;
          float* rt = (float*)(ws + WS_ROPE); rt[2 * gid] = cosf(ang); rt[2 * gid + 1] = sinf(ang); } }
    { const int gid = blockIdx.x * NTHREADS + tid, gn = G * NTHREADS; constexpr int NV = (NINP - NIN) * 2048 * 2 / 16;
      v4u* p0 = (v4u*)(ws + WS_WIN0 + (size_t)NIN * 2048 * 2); v4u* p1 = (v4u*)(ws + WS_WIN1 + (size_t)NIN * 2048 * 2);
      for (int i = gid; i < NV; i += gn) { p0[i] = (v4u){0, 0, 0, 0}; p1[i] = (v4u){0, 0, 0, 0}; } }
    if (blockIdx.x < 192) {
        const int it = blockIdx.x, l = it / 96, r = it % 96, kc = r / 3, nc = r % 3;
        LAS float* cond = (LAS float*)lds;
        if (tid < 256) { const int b = tid >> 6, k = tid & 63; const float c = a.in[1][b * 2048 + kc * 64 + k]; cond[tid] = silu_f(c); }
        __syncthreads();
        const float* W = a.in[2] + (size_t)l * 2048 * 6144 + (size_t)(kc * 64) * 6144 + nc * 2048 + tid * 4;
        f32x4 acc0 = {0, 0, 0, 0}, acc1 = acc0, acc2 = acc0, acc3 = acc0;
#pragma unroll 8
        for (int k = 0; k < 64; ++k) { const f32x4 w = *(const f32x4*)(W + (size_t)k * 6144);
            acc0 += cond[k] * w; acc1 += cond[64 + k] * w; acc2 += cond[128 + k] * w; acc3 += cond[192 + k] * w; }
        float* macc = (float*)(ws + WS_MOD) + (size_t)l * 4 * 6144 + nc * 2048 + tid * 4;
#pragma unroll
        for (int i = 0; i < 4; ++i) { atomicAdd(macc + i, acc0[i]); atomicAdd(macc + 6144 + i, acc1[i]); atomicAdd(macc + 2 * 6144 + i, acc2[i]); atomicAdd(macc + 3 * 6144 + i, acc3[i]); }
        __syncthreads();
    }
    { LAS float* scr = (LAS float*)(lds + wave * 16384);
      const int gw = vcu * NWAVES + wave, NGW = G * NWAVES;
      constexpr int I_IN = 32 * (NIN / 32), I_OUT = 32 * 64, I_G = 32 * 8, NITEMS = 2 * (I_IN + I_OUT) + I_G;
      for (int it = gw; it < NITEMS; it += NGW) {
          int r = it;
          if (r < I_G) { const int mn = r >> 3, m = mn >> 3; const float* Wg = a.in[m == 0 ? 27 : m == 1 ? 29 : m == 2 ? 32 : 34] + (size_t)(mn & 7) * 128 * 128;
              p0_transpose_item(Wg, 128, 128, (bf16_t*)(ws + WS_WGT) + (size_t)mn * 128 * 128, 0, scr, r & 7, lane); continue; } r -= I_G;
          if (r < I_IN) { p0_transpose_item(a.in[5], 2048, NIN, (bf16_t*)(ws + WS_WIN0), 0, scr, r, lane); continue; } r -= I_IN;
          if (r < I_IN) { p0_transpose_item(a.in[17], 2048, NIN, (bf16_t*)(ws + WS_WIN1), 0, scr, r, lane); continue; } r -= I_IN;
          if (r < I_OUT) { p0_transpose_item(a.in[16], 2048, 2048, (bf16_t*)(ws + WS_WOUT0), 0, scr, r, lane); continue; } r -= I_OUT;
          p0_transpose_item(a.in[37], 2048, 2048, (bf16_t*)(ws + WS_WOUT1), 0, scr, r, lane);
      } }
}

__device__ __forceinline__ void normmod_phase(const Args& a, const float* xin, int layer, int gw, int NGW, int lane) {
    const float* nw = a.in[4] + layer * 2048; const float* bm = a.in[3] + layer * 6144;
    const float* macc = (const float*)(a.ws + WS_MOD) + (size_t)layer * 4 * 6144;
    bf16_t* H = (bf16_t*)(a.ws + WS_H);
    for (int m = gw; m < MTOK; m += NGW) {
        const int b = m >> 11;
        const f32x4* xr = (const f32x4*)(xin + (size_t)m * 2048) + lane;
        f32x4 v[8]; float s = 0.f;
#pragma unroll
        for (int j = 0; j < 8; ++j) { v[j] = xr[64 * j]; s += (v[j].x * v[j].x + v[j].y * v[j].y) + (v[j].z * v[j].z + v[j].w * v[j].w); }
        const float rstd = rsqrtf(group_sum<64>(s) * (1.f / 2048.f) + EPS);
#pragma unroll
        for (int j = 0; j < 8; ++j) { const int col = (64 * j + lane) * 4;
            const f32x4 w = *(const f32x4*)(nw + col);
            const f32x4 sh = *(const f32x4*)(macc + b * 6144 + col) + *(const f32x4*)(bm + col);
            const f32x4 sc = *(const f32x4*)(macc + b * 6144 + 2048 + col) + *(const f32x4*)(bm + 2048 + col);
            const f32x4 o = v[j] * rstd * w * (1.f + sc) + sh;
            v2u pk; pk.x = pk2(o.x, o.y); pk.y = pk2(o.z, o.w);
            *(v2u*)(H + (size_t)m * 2048 + col) = pk; }
    }
}

__device__ __forceinline__ void post0_phase(const Args& a, int gw, int NGW, int lane) {
    const bf16_t* P = (const bf16_t*)(a.ws + WS_PROJ);
    const float2* rope = (const float2*)(a.ws + WS_ROPE);
    const float* qn = a.in[6]; const float* kn = a.in[7]; const float* cw = a.in[8]; const float* cb = a.in[9];
    bf16_t* Q = (bf16_t*)(a.ws + WS_QB); bf16_t* K = (bf16_t*)(a.ws + WS_KB); bf16_t* V = (bf16_t*)(a.ws + WS_VB);
    float* ACT = (float*)(a.ws + WS_ACT);
    for (int m = gw; m < MTOK; m += NGW) {
        const int t = m & 2047, prow = t >> 6, pcol = t & 63;
        const bf16_t* pr = P + (size_t)m * NINP;
        {
            float x[16]; unpack8(*(const v4u*)(pr + A_Q + lane * 16), x); unpack8(*(const v4u*)(pr + A_Q + lane * 16 + 8), x + 8);
            float ss = 0.f;
#pragma unroll
            for (int i = 0; i < 16; ++i) ss += x[i] * x[i];
            ss = group_sum<8>(ss);
            const float r = rsqrtf(ss * (1.f / 128.f) + EPS);
            const int d0 = (lane & 7) * 16;
#pragma unroll
            for (int i = 0; i < 16; ++i) x[i] = x[i] * r * qn[d0 + i];
#pragma unroll
            for (int pi = 0; pi < 8; ++pi) { const int p = (d0 >> 1) + pi; const float2 cs = (p < 32) ? rope[prow * 32 + p] : rope[pcol * 32 + p - 32];
                const float x0 = x[2 * pi], x1 = x[2 * pi + 1]; x[2 * pi] = x0 * cs.x - x1 * cs.y; x[2 * pi + 1] = x0 * cs.y + x1 * cs.x; }
            *(v4u*)(Q + (size_t)m * 1024 + lane * 16) = pack8(x); *(v4u*)(Q + (size_t)m * 1024 + lane * 16 + 8) = pack8(x + 8);
        }
        {
            const v2u w = *(const v2u*)(pr + A_K + lane * 4);
            float x[4] = {__uint_as_float(w.x << 16), __uint_as_float(w.x & 0xffff0000u), __uint_as_float(w.y << 16), __uint_as_float(w.y & 0xffff0000u)};
            float ss = (x[0] * x[0] + x[1] * x[1]) + (x[2] * x[2] + x[3] * x[3]);
            ss = group_sum<32>(ss);
            const float r = rsqrtf(ss * (1.f / 128.f) + EPS);
            const int d0 = (lane & 31) * 4;
#pragma unroll
            for (int i = 0; i < 4; ++i) x[i] = x[i] * r * kn[d0 + i];
#pragma unroll
            for (int pi = 0; pi < 2; ++pi) { const int p = (d0 >> 1) + pi; const float2 cs = (p < 32) ? rope[prow * 32 + p] : rope[pcol * 32 + p - 32];
                const float x0 = x[2 * pi], x1 = x[2 * pi + 1]; x[2 * pi] = x0 * cs.x - x1 * cs.y; x[2 * pi + 1] = x0 * cs.y + x1 * cs.x; }
            v2u o; o.x = pk2(x[0], x[1]); o.y = pk2(x[2], x[3]);
            *(v2u*)(K + (size_t)m * 256 + lane * 4) = o;
            *(v2u*)(V + (size_t)m * 256 + lane * 4) = *(const v2u*)(pr + A_V + lane * 4);
        }
#pragma unroll
        for (int j = 0; j < 3; ++j) { const int ch = (j * 64 + lane) * 8;
            float acc[8];
            { const f32x4 b0 = *(const f32x4*)(cb + ch), b1 = *(const f32x4*)(cb + ch + 4); acc[0] = b0.x; acc[1] = b0.y; acc[2] = b0.z; acc[3] = b0.w; acc[4] = b1.x; acc[5] = b1.y; acc[6] = b1.z; acc[7] = b1.w; }
#pragma unroll
            for (int d = 0; d < 4; ++d) { const int ts = t + d - 2;
                if (ts >= 0 && ts < SEQ) { float x[8]; unpack8(*(const v4u*)(P + (size_t)(m + d - 2) * NINP + A_XS + ch), x);
                    const f32x4 w0 = *(const f32x4*)(cw + d * 1536 + ch), w1 = *(const f32x4*)(cw + d * 1536 + ch + 4);
                    acc[0] += w0.x * x[0]; acc[1] += w0.y * x[1]; acc[2] += w0.z * x[2]; acc[3] += w0.w * x[3];
                    acc[4] += w1.x * x[4]; acc[5] += w1.y * x[5]; acc[6] += w1.z * x[6]; acc[7] += w1.w * x[7]; } }
            f32x4 o0, o1; o0.x = silu_f(acc[0]); o0.y = silu_f(acc[1]); o0.z = silu_f(acc[2]); o0.w = silu_f(acc[3]); o1.x = silu_f(acc[4]); o1.y = silu_f(acc[5]); o1.z = silu_f(acc[6]); o1.w = silu_f(acc[7]);
            *(f32x4*)(ACT + (size_t)m * 1536 + ch) = o0; *(f32x4*)(ACT + (size_t)m * 1536 + ch + 4) = o1; }
    }
}

__device__ __forceinline__ void ssd_item(const Args& a, int item, float* lds) {
    const int ph = item & 1, h = (item >> 1) & 15, dir = (item >> 5) & 1, b = item >> 6, g = h >> 3;
    float* xs = lds; float* Bs = xs + 64 * 32; float* Cs = Bs + 64 * 128; float* dts = Cs + 64 * 128; float* das = dts + 64; float* ys = das + 64;
    const float A = -expf(a.in[dir ? 13 : 12][h]); const float dtb = a.in[dir ? 11 : 10][h];
    const float* ACT = (const float*)(a.ws + WS_ACT); const float* SM = (const float*)(a.ws + WS_SMALL);
    float* Y = (float*)(a.ws + (dir ? WS_YB : WS_YF));
    const int tid = threadIdx.x, p = tid >> 4, ng = tid & 15;
    float hst[8];
#pragma unroll
    for (int i = 0; i < 8; ++i) hst[i] = 0.f;
    for (int tile = 0; tile < 32; ++tile) {
        const int t0 = (dir ? 31 - tile : tile) * 64;
        const size_t row0 = (size_t)b * SEQ + t0;
        __syncthreads();
        { const int r = tid >> 3, c4 = tid & 7; *(f32x4*)(xs + r * 32 + c4 * 4) = *(const f32x4*)(ACT + (row0 + r) * 1536 + h * 64 + ph * 32 + c4 * 4); }
#pragma unroll
        for (int i = 0; i < 4; ++i) { const int idx = tid + i * 512, r = idx >> 5, c4 = idx & 31;
            *(f32x4*)(Bs + r * 128 + c4 * 4) = *(const f32x4*)(ACT + (row0 + r) * 1536 + 1024 + g * 128 + c4 * 4);
            *(f32x4*)(Cs + r * 128 + c4 * 4) = *(const f32x4*)(ACT + (row0 + r) * 1536 + 1280 + g * 128 + c4 * 4); }
        if (tid < 64) { const float raw = SM[(row0 + tid) * 32 + dir * 16 + h]; const float dt = softplus_f(raw + dtb); dts[tid] = dt; das[tid] = expf(dt * A); }
        __syncthreads();
        for (int s = 0; s < 64; ++s) {
            const int r = dir ? 63 - s : s;
            const float dA = das[r], xdt = xs[r * 32 + p] * dts[r];
            const f32x4 b0 = *(const f32x4*)(Bs + r * 128 + ng * 8), b1 = *(const f32x4*)(Bs + r * 128 + ng * 8 + 4);
            const f32x4 c0 = *(const f32x4*)(Cs + r * 128 + ng * 8), c1 = *(const f32x4*)(Cs + r * 128 + ng * 8 + 4);
            float part = 0.f;
            hst[0] = fmaf(xdt, b0.x, hst[0] * dA); part = fmaf(hst[0], c0.x, part);
            hst[1] = fmaf(xdt, b0.y, hst[1] * dA); part = fmaf(hst[1], c0.y, part);
            hst[2] = fmaf(xdt, b0.z, hst[2] * dA); part = fmaf(hst[2], c0.z, part);
            hst[3] = fmaf(xdt, b0.w, hst[3] * dA); part = fmaf(hst[3], c0.w, part);
            hst[4] = fmaf(xdt, b1.x, hst[4] * dA); part = fmaf(hst[4], c1.x, part);
            hst[5] = fmaf(xdt, b1.y, hst[5] * dA); part = fmaf(hst[5], c1.y, part);
            hst[6] = fmaf(xdt, b1.z, hst[6] * dA); part = fmaf(hst[6], c1.z, part);
            hst[7] = fmaf(xdt, b1.w, hst[7] * dA); part = fmaf(hst[7], c1.w, part);
            part = group_sum<16>(part);
            if (ng == 0) ys[r * 32 + p] = part;
        }
        __syncthreads();
        { const int r = tid >> 3, c4 = tid & 7; *(f32x4*)(Y + (row0 + r) * 1024 + h * 64 + ph * 32 + c4 * 4) = *(const f32x4*)(ys + r * 32 + c4 * 4); }
    }
}

__device__ __forceinline__ void ssd_combine_phase(const Args& a, int gw, int NGW, int lane) {
    const float* YF = (const float*)(a.ws + WS_YF); const float* YB = (const float*)(a.ws + WS_YB); const float* ACT = (const float*)(a.ws + WS_ACT);
    const bf16_t* P = (const bf16_t*)(a.ws + WS_PROJ); bf16_t* YC = (bf16_t*)(a.ws + WS_YCAT);
    const float* dsk = a.in[14]; const float* nw = a.in[15];
    for (int m = gw; m < MTOK; m += NGW) {
        const int ch = lane * 16; const float dk = dsk[ch >> 6];
        float z[16], gv[16]; unpack8(*(const v4u*)(P + (size_t)m * NINP + A_Z + ch), z); unpack8(*(const v4u*)(P + (size_t)m * NINP + A_Z + ch + 8), z + 8);
        float ss = 0.f;
#pragma unroll
        for (int q = 0; q < 4; ++q) { const f32x4 f = *(const f32x4*)(YF + (size_t)m * 1024 + ch + 4 * q), bk = *(const f32x4*)(YB + (size_t)m * 1024 + ch + 4 * q), xv = *(const f32x4*)(ACT + (size_t)m * 1536 + ch + 4 * q);
            const f32x4 y = f + bk + dk * xv;
            gv[4 * q] = y.x * silu_f(z[4 * q]); gv[4 * q + 1] = y.y * silu_f(z[4 * q + 1]); gv[4 * q + 2] = y.z * silu_f(z[4 * q + 2]); gv[4 * q + 3] = y.w * silu_f(z[4 * q + 3]); }
#pragma unroll
        for (int i = 0; i < 16; ++i) ss += gv[i] * gv[i];
        const float r = rsqrtf(group_sum<64>(ss) * (1.f / 1024.f) + EPS);
#pragma unroll
        for (int i = 0; i < 16; ++i) gv[i] = gv[i] * r * nw[ch + i];
        *(v4u*)(YC + (size_t)m * 2048 + 1024 + ch) = pack8(gv); *(v4u*)(YC + (size_t)m * 2048 + 1024 + ch + 8) = pack8(gv + 8);
    }
}

__device__ __forceinline__ void post1_phase(const Args& a, int gw, int NGW, int lane) {
    const bf16_t* P = (const bf16_t*)(a.ws + WS_PROJ); const float* cw = a.in[18]; const float* cb = a.in[19];
    float* ACT = (float*)(a.ws + WS_ACT);
    for (int m = gw; m < MTOK; m += NGW) {
        const int t = m & 2047;
#pragma unroll
        for (int j = 0; j < 4; ++j) { const int ch = (j * 64 + lane) * 8;
            float acc[8];
            { const f32x4 b0 = *(const f32x4*)(cb + ch), b1 = *(const f32x4*)(cb + ch + 4); acc[0] = b0.x; acc[1] = b0.y; acc[2] = b0.z; acc[3] = b0.w; acc[4] = b1.x; acc[5] = b1.y; acc[6] = b1.z; acc[7] = b1.w; }
#pragma unroll
            for (int d = 0; d < 4; ++d) { const int ts = t + d - 2;
                if (ts >= 0 && ts < SEQ) { float x[8]; unpack8(*(const v4u*)(P + (size_t)(m + d - 2) * NINP + C_Q + ch), x);
                    const f32x4 w0 = *(const f32x4*)(cw + d * 2048 + ch), w1 = *(const f32x4*)(cw + d * 2048 + ch + 4);
                    acc[0] += w0.x * x[0]; acc[1] += w0.y * x[1]; acc[2] += w0.z * x[2]; acc[3] += w0.w * x[3];
                    acc[4] += w1.x * x[4]; acc[5] += w1.y * x[5]; acc[6] += w1.z * x[6]; acc[7] += w1.w * x[7]; } }
#pragma unroll
            for (int i = 0; i < 8; ++i) acc[i] = silu_f(acc[i]);
            if (j < 2) {
                float ss = 0.f;
#pragma unroll
                for (int i = 0; i < 8; ++i) ss += acc[i] * acc[i];
                ss = group_sum<16>(ss);
                float r = rsqrtf(ss + EPS); if (j == 0) r *= 0.088388347648318440f;
#pragma unroll
                for (int i = 0; i < 8; ++i) acc[i] *= r;
            }
            *(f32x4*)(ACT + (size_t)m * 2048 + ch) = (f32x4){acc[0], acc[1], acc[2], acc[3]}; *(f32x4*)(ACT + (size_t)m * 2048 + ch + 4) = (f32x4){acc[4], acc[5], acc[6], acc[7]}; }
    }
}

__device__ __forceinline__ void gdn_item(const Args& a, int item, float* lds) {
    const int dvs = item & 3, hv = (item >> 2) & 7, dir = (item >> 5) & 1, b = item >> 6, hq = hv >> 1;
    float* ks = lds; float* qs = ks + 32 * 128; float* vs = qs + 32 * 128; float* al = vs + 32 * 32; float* be = al + 32; float* os = be + 32;
    const float Aneg = -expf(a.in[dir ? 21 : 20][hv]); const float dtb = a.in[dir ? 23 : 22][hv];
    const float* ACT = (const float*)(a.ws + WS_ACT); const float* SM = (const float*)(a.ws + WS_SMALL);
    float* O = (float*)(a.ws + (dir ? WS_YB : WS_YF));
    const int tid = threadIdx.x, lane = tid & 63, wave = tid >> 6, dkg = lane & 15, dvi = wave * 4 + (lane >> 4);
    float S[8];
#pragma unroll
    for (int i = 0; i < 8; ++i) S[i] = 0.f;
    for (int tile = 0; tile < 64; ++tile) {
        const int t0 = (dir ? 63 - tile : tile) * 32;
        const size_t row0 = (size_t)b * SEQ + t0;
        __syncthreads();
#pragma unroll
        for (int i = 0; i < 2; ++i) { const int idx = tid + i * 512, r = idx >> 5, c4 = idx & 31;
            *(f32x4*)(ks + r * 128 + c4 * 4) = *(const f32x4*)(ACT + (row0 + r) * 2048 + 512 + hq * 128 + c4 * 4);
            *(f32x4*)(qs + r * 128 + c4 * 4) = *(const f32x4*)(ACT + (row0 + r) * 2048 + hq * 128 + c4 * 4); }
        if (tid < 256) { const int r = tid >> 3, c4 = tid & 7; *(f32x4*)(vs + r * 32 + c4 * 4) = *(const f32x4*)(ACT + (row0 + r) * 2048 + 1024 + hv * 128 + dvs * 32 + c4 * 4); }
        else if (tid < 288) { const int r = tid - 256; const float* sm = SM + (row0 + r) * 32;
            be[r] = sigmoid_f(sm[dir * 8 + hv]); al[r] = expf(Aneg * softplus_f(sm[16 + dir * 8 + hv] + dtb)); }
        __syncthreads();
        for (int s = 0; s < 32; ++s) {
            const int r = dir ? 31 - s : s;
            const f32x4 k0 = *(const f32x4*)(ks + r * 128 + dkg * 8), k1 = *(const f32x4*)(ks + r * 128 + dkg * 8 + 4);
            const f32x4 q0 = *(const f32x4*)(qs + r * 128 + dkg * 8), q1 = *(const f32x4*)(qs + r * 128 + dkg * 8 + 4);
            const float alpha = al[r], beta = be[r], vv = vs[r * 32 + dvi];
            float part = (k0.x * S[0] + k0.y * S[1]) + (k0.z * S[2] + k0.w * S[3]) + (k1.x * S[4] + k1.y * S[5]) + (k1.z * S[6] + k1.w * S[7]);
            part = group_sum<16>(part);
            const float vn = beta * (vv - alpha * part);
            S[0] = fmaf(k0.x, vn, alpha * S[0]); S[1] = fmaf(k0.y, vn, alpha * S[1]); S[2] = fmaf(k0.z, vn, alpha * S[2]); S[3] = fmaf(k0.w, vn, alpha * S[3]);
            S[4] = fmaf(k1.x, vn, alpha * S[4]); S[5] = fmaf(k1.y, vn, alpha * S[5]); S[6] = fmaf(k1.z, vn, alpha * S[6]); S[7] = fmaf(k1.w, vn, alpha * S[7]);
            float po = (q0.x * S[0] + q0.y * S[1]) + (q0.z * S[2] + q0.w * S[3]) + (q1.x * S[4] + q1.y * S[5]) + (q1.z * S[6] + q1.w * S[7]);
            po = group_sum<16>(po);
            if (dkg == 0) os[r * 32 + dvi] = po;
        }
        __syncthreads();
        if (tid < 256) { const int r = tid >> 3, c4 = tid & 7; *(f32x4*)(O + (row0 + r) * 1024 + hv * 128 + dvs * 32 + c4 * 4) = *(const f32x4*)(os + r * 32 + c4 * 4); }
    }
}

typedef short bf16x8_t __attribute__((ext_vector_type(8)));
typedef float f32x16_t __attribute__((ext_vector_type(16)));
__device__ __forceinline__ void lru_tile(const Args& a, int item, unsigned char* lds, int pass) {
    const int n = item & 7, tc = (item >> 3) & 63, b = item >> 9, t0 = tc * 32;
    float* xc = (float*)lds; bf16_t* xcb = (bf16_t*)(lds + 16384); float* As = (float*)(lds + 25088); float* Us = As + 2 * 32 * 128; float2* sg = (float2*)(Us + 2 * 32 * 128);
    const int tid = threadIdx.x, lane = tid & 63, wave = tid >> 6;
    const bf16_t* P = (const bf16_t*)(a.ws + WS_PROJ);
    __syncthreads();
    {
        const int j = tid & 127, tg = tid >> 7, chn = n * 128 + j; const float* cw = a.in[25];
        const float w0 = cw[chn], w1 = cw[1024 + chn], w2 = cw[2048 + chn], w3 = cw[3072 + chn], cbias = a.in[26][chn];
        const int tb = t0 + tg * 8;
        const bf16_t* pp = P + ((size_t)b * SEQ + tb) * NINP + C_XL + chn;
        float xm2 = (tb >= 2) ? bf2f(pp[-2 * NINP]) : 0.f, xm1 = (tb >= 1) ? bf2f(pp[-NINP]) : 0.f, x0 = bf2f(pp[0]);
#pragma unroll
        for (int i = 0; i < 8; ++i) { const float xp1 = (tb + i + 1 < SEQ) ? bf2f(pp[(i + 1) * NINP]) : 0.f;
            const float acc = cbias + w0 * xm2 + w1 * xm1 + w2 * x0 + w3 * xp1;
            xc[(tg * 8 + i) * 128 + j] = acc; xcb[(tg * 8 + i) * 136 + j] = (bf16_t)f2bf(acc);
            xm2 = xm1; xm1 = x0; x0 = xp1; }
    }
    __syncthreads();
    {
        const int ct = wave & 3, d = wave >> 2, r32 = lane & 31, hi = lane >> 5;
        const bf16_t* WT = (const bf16_t*)(a.ws + WS_WGT);
        const bf16_t* wa_p = WT + ((size_t)((2 * d) * 8 + n) * 128 + ct * 32 + r32) * 128 + hi * 8;
        const bf16_t* wx_p = WT + ((size_t)((2 * d + 1) * 8 + n) * 128 + ct * 32 + r32) * 128 + hi * 8;
        f32x16_t ca, cx;
#pragma unroll
        for (int r = 0; r < 16; ++r) { ca[r] = 0.f; cx[r] = 0.f; }
#pragma unroll
        for (int s = 0; s < 8; ++s) {
            const bf16x8_t af = *(const bf16x8_t*)((const char*)xcb + r32 * 272 + (s * 16 + hi * 8) * 2);
            const bf16x8_t fa = *(const bf16x8_t*)(wa_p + s * 16); const bf16x8_t fx = *(const bf16x8_t*)(wx_p + s * 16);
            ca = __builtin_amdgcn_mfma_f32_32x32x16_bf16(af, fa, ca, 0, 0, 0); cx = __builtin_amdgcn_mfma_f32_32x32x16_bf16(af, fx, cx, 0, 0, 0);
        }
        const int j = ct * 32 + r32, cj = n * 128 + j;
        const float baj = a.in[d ? 33 : 28][cj], bxj = a.in[d ? 35 : 30][cj], sp = softplus_f(-a.in[d ? 36 : 31][cj]);
#pragma unroll
        for (int r = 0; r < 16; ++r) { const int t = (r & 3) + 8 * (r >> 2) + 4 * hi;
            const float rg = sigmoid_f(ca[r] + baj), ig = sigmoid_f(cx[r] + bxj); const float la = -8.f * rg * sp;
            As[(d * 32 + t) * 128 + j] = expf(la); Us[(d * 32 + t) * 128 + j] = sqrtf(-expm1f(2.f * la)) * (ig * xc[t * 128 + j]); }
    }
    __syncthreads();
    {
        const int j = tid & 127, d = (tid >> 7) & 1, seg = tid >> 8;
        float Pp = 1.f, H = 0.f;
#pragma unroll
        for (int k = 0; k < 16; ++k) { const int q = seg * 16 + k, t = d ? 31 - q : q; const float a_ = As[(d * 32 + t) * 128 + j], u_ = Us[(d * 32 + t) * 128 + j]; H = fmaf(a_, H, u_); Pp *= a_; }
        sg[(d * 2 + seg) * 128 + j] = make_float2(Pp, H);
        __syncthreads();
        float2* LS = (float2*)(a.ws + WS_LSUM);
        if (pass == 0) {
            if (seg == 0) { const float2 s1 = sg[(d * 2 + 1) * 128 + j]; LS[((size_t)(d * 4 + b) * 64 + tc) * 1024 + n * 128 + j] = make_float2(Pp * s1.x, fmaf(s1.x, H, s1.y)); }
        } else {
            float c = 0.f;
            const float2* lsp = LS + ((size_t)(d * 4 + b) * 64) * 1024 + n * 128 + j;
            if (d == 0) { for (int cc = 0; cc < tc; ++cc) { const float2 s = lsp[(size_t)cc * 1024]; c = fmaf(s.x, c, s.y); } }
            else { for (int cc = 63; cc > tc; --cc) { const float2 s = lsp[(size_t)cc * 1024]; c = fmaf(s.x, c, s.y); } }
            if (seg == 1) { const float2 s0 = sg[(d * 2) * 128 + j]; c = fmaf(s0.x, c, s0.y); }
            float h = c;
#pragma unroll
            for (int k = 0; k < 16; ++k) { const int q = seg * 16 + k, t = d ? 31 - q : q; const float a_ = As[(d * 32 + t) * 128 + j], u_ = Us[(d * 32 + t) * 128 + j]; h = fmaf(a_, h, u_); Us[(d * 32 + t) * 128 + j] = h; }
            __syncthreads();
            bf16_t* YC = (bf16_t*)(a.ws + WS_YCAT);
            const int jj = tid & 127, tg = tid >> 7;
#pragma unroll
            for (int i = 0; i < 8; ++i) { const int t = tg * 8 + i; const size_t row = (size_t)b * SEQ + t0 + t;
                const float hs = Us[t * 128 + jj] + Us[(32 + t) * 128 + jj]; const float gl = bf2f(P[row * NINP + C_GL + n * 128 + jj]);
                YC[row * 2048 + 1024 + n * 128 + jj] = (bf16_t)f2bf(hs * silu_f(gl)); }
        }
    }
}

__device__ __forceinline__ void combine1_phase(const Args& a, int gw, int NGW, int lane) {
    const float* OF = (const float*)(a.ws + WS_YF); const float* OB = (const float*)(a.ws + WS_YB);
    const bf16_t* P = (const bf16_t*)(a.ws + WS_PROJ); bf16_t* YC = (bf16_t*)(a.ws + WS_YCAT);
    const float* gn = a.in[24];
    for (int m = gw; m < MTOK; m += NGW) {
        const int ch = lane * 16, d0 = ch & 127;
        float z[16], ov[16];
        unpack8(*(const v4u*)(P + (size_t)m * NINP + C_Z + ch), z); unpack8(*(const v4u*)(P + (size_t)m * NINP + C_Z + ch + 8), z + 8);
#pragma unroll
        for (int q = 0; q < 4; ++q) { const f32x4 f = *(const f32x4*)(OF + (size_t)m * 1024 + ch + 4 * q), bk = *(const f32x4*)(OB + (size_t)m * 1024 + ch + 4 * q); const f32x4 o = f + bk;
            ov[4 * q] = o.x; ov[4 * q + 1] = o.y; ov[4 * q + 2] = o.z; ov[4 * q + 3] = o.w; }
        float ss = 0.f;
#pragma unroll
        for (int i = 0; i < 16; ++i) ss += ov[i] * ov[i];
        ss = group_sum<8>(ss);
        const float r = rsqrtf(ss * (1.f / 128.f) + EPS);
#pragma unroll
        for (int i = 0; i < 16; ++i) ov[i] = ov[i] * r * gn[d0 + i] * silu_f(z[i]);
        *(v4u*)(YC + (size_t)m * 2048 + ch) = pack8(ov); *(v4u*)(YC + (size_t)m * 2048 + ch + 8) = pack8(ov + 8);
    }
}

__device__ __forceinline__ void final_norm_phase(const Args& a, int gw, int NGW, int lane) {
    const float* nw = a.in[38];
    for (int m = gw; m < MTOK; m += NGW) {
        f32x4* xr = (f32x4*)(a.out + (size_t)m * 2048) + lane;
        f32x4 v[8]; float s = 0.f;
#pragma unroll
        for (int j = 0; j < 8; ++j) { v[j] = xr[64 * j]; s += (v[j].x * v[j].x + v[j].y * v[j].y) + (v[j].z * v[j].z + v[j].w * v[j].w); }
        const float rstd = rsqrtf(group_sum<64>(s) * (1.f / 2048.f) + EPS);
#pragma unroll
        for (int j = 0; j < 8; ++j) { const f32x4 w = *(const f32x4*)(nw + (64 * j + lane) * 4); xr[64 * j] = v[j] * rstd * w; }
    }
}

typedef GAS unsigned gu32;
#define RLX_AGENT __ATOMIC_RELAXED, __HIP_MEMORY_SCOPE_AGENT
constexpr int CW_BAR = 4096;
constexpr int MISC_OFF = 131072 + 320;
#define XB_TMO      128
#define XB_XCNT(j)  (256  + 64 * (j))
#define XB_XSUB(j)  (1280 + 64 * (j))
#define XB_XGEN(j)  (2304 + 64 * (j))
#define XB_TOP      3328
#define XB_TOPGEN   3392
#define XCD_BAR_WORDS 3456
#define XB_SPIN_CAP (1u << 18)

__device__ __forceinline__ unsigned xb_ld(unsigned* p)              { return __hip_atomic_load(p, __ATOMIC_RELAXED, __HIP_MEMORY_SCOPE_AGENT); }
__device__ __forceinline__ unsigned xb_add(unsigned* p, unsigned v) { return __hip_atomic_fetch_add(p, v, __ATOMIC_RELAXED, __HIP_MEMORY_SCOPE_AGENT); }
__device__ __forceinline__ unsigned xb_xcc_id() { return (unsigned)__builtin_amdgcn_s_getreg((3 << 11) | 20) & 0xFu; }
#define XB_SPIN(cond, bar) do { unsigned _sp = 0; while (cond) { __builtin_amdgcn_s_sleep(1); \
    if ((++_sp & 255u) == 0u) { if (xb_ld(&(bar)[XB_TMO])) break; if (_sp > XB_SPIN_CAP) { atomicAdd(&(bar)[XB_TMO], 1u); break; } } } } while (0)

struct XcdBarrier {
    unsigned* bar; unsigned x;
    volatile LAS unsigned* st;
};

__device__ __forceinline__ XcdBarrier xcd_barrier_post(unsigned* bar, volatile LAS unsigned* st) {
    XcdBarrier b; b.bar = bar; b.x = xb_xcc_id(); b.st = st;
    if (threadIdx.x == 0) (void)xb_add(&bar[XB_XCNT(b.x)], 1u);
    return b;
}
__device__ __forceinline__ void xcd_barrier_complete(unsigned* bar, unsigned x, unsigned& nloc, unsigned& nx) {
    const unsigned G = gridDim.x * gridDim.y * gridDim.z;
    unsigned sum, cnt, mine, sp = 0u;
    for (;;) {
        sum = 0u; cnt = 0u; mine = 0u;
#pragma unroll
        for (unsigned j = 0; j < 16; ++j) { const unsigned c = xb_ld(&bar[XB_XCNT(j)]); sum += c; cnt += (c > 0u) ? 1u : 0u; mine = (j == x) ? c : mine; }
        if (sum == G) break;
        __builtin_amdgcn_s_sleep(1);
        if ((++sp & 255u) == 0u) { if (xb_ld(&bar[XB_TMO])) break; if (sp > XB_SPIN_CAP) { atomicAdd(&bar[XB_TMO], 1u); break; } }
    }
    nloc = mine > 0u ? mine : 1u; nx = cnt > 0u ? cnt : 1u;
}

__device__ __forceinline__ void xcd_barrier(const XcdBarrier& b) {
    asm volatile("s_waitcnt vmcnt(0)" ::: "memory");
    __syncthreads();
    if (threadIdx.x == 0) {
        unsigned* bar = b.bar;
        __builtin_amdgcn_s_waitcnt(0);
        unsigned nloc = b.st[0], nx = b.st[1];
        if (nloc == 0u) { xcd_barrier_complete(bar, b.x, nloc, nx); b.st[0] = nloc; b.st[1] = nx; }
        const unsigned old = xb_add(&bar[XB_XSUB(b.x)], 1u);
        const unsigned gen = old / nloc;
        if (old + 1u == (gen + 1u) * nloc) {
            __builtin_amdgcn_fence(__ATOMIC_RELEASE, "agent");
            asm volatile("s_waitcnt vmcnt(0)" ::: "memory");
            const unsigned og = xb_add(&bar[XB_TOP], 1u);
            const unsigned tg = og / nx;
            if (og + 1u == (tg + 1u) * nx) xb_add(&bar[XB_TOPGEN], 1u);
            else XB_SPIN(xb_ld(&bar[XB_TOPGEN]) == tg, bar);
            __builtin_amdgcn_fence(__ATOMIC_ACQUIRE, "agent");
            xb_add(&bar[XB_XGEN(b.x)], 1u);
            asm volatile("s_waitcnt vmcnt(0)" ::: "memory");
        } else {
            XB_SPIN(xb_ld(&bar[XB_XGEN(b.x)]) == gen, bar);
            __builtin_amdgcn_fence(__ATOMIC_ACQUIRE, "agent");
            asm volatile("s_waitcnt vmcnt(0)" ::: "memory");
        }
    }
    __syncthreads();
}

#ifndef PROBE_SSD
#define PROBE_SSD 0
#endif
#ifndef PROBE_GDN
#define PROBE_GDN 0
#endif
#ifndef PROBE_LRU
#define PROBE_LRU 0
#endif
#ifndef MK_SINGLE
#define MK_SINGLE 1
#endif
__global__ void __launch_bounds__(NTHREADS, 2) mk_fwd(Args a) {
    extern __shared__ __attribute__((aligned(16))) unsigned char lds[];
    LAS unsigned char* ldsl = (LAS unsigned char*)lds;
    const int tid = threadIdx.x, lane = tid & 63, wave = __builtin_amdgcn_readfirstlane(tid >> 6);
    const int G = gridDim.x, bx = blockIdx.x;
    const int vcu = (G % 8 == 0) ? (bx % 8) * (G / 8) + bx / 8 : bx;
    const int gw = vcu * NWAVES + wave, NGW = G * NWAVES;
    unsigned char* ws = a.ws;
    volatile LAS unsigned* MISC = (volatile LAS unsigned*)(ldsl + MISC_OFF);
    if (tid < 32) MISC[tid] = 0u;
    __syncthreads();
    XcdBarrier bar; bar.bar = (unsigned*)(ws + WS_CTL) + CW_BAR; bar.x = 0; bar.st = nullptr;
    if (a.ph_hi - a.ph_lo > 1) bar = xcd_barrier_post((unsigned*)(ws + WS_CTL) + CW_BAR, MISC + 8);
#define IN(k) (a.ph_lo <= (k) && (k) < a.ph_hi)
#define SEAM(k) do { if (IN(k) && IN((k) + 1)) { xcd_barrier(bar); } } while (0)

    if (IN(0)) { p0_prologue(a, ldsl, vcu, G); } SEAM(0);
    if (IN(1)) { normmod_phase(a, a.in[0], 0, gw, NGW, lane); } SEAM(1);
    if (IN(2)) {
        pg8::Gemm g{(const bf16_t*)(ws + WS_H), (const bf16_t*)(ws + WS_WIN0), MTOK, NINP, 2048}; pg8::StaticOrder S; S.init(MTOK, NINP, G, bx);
        pg8::EpiProj E{(bf16_t*)(ws + WS_PROJ), (float*)(ws + WS_SMALL), NINP, A_DT / 256};
        pg8::gemm_phase<pg8::EpiProj, pg8::StaticOrder, true, true>(ldsl, g, S, E);
    } SEAM(2);
    if (IN(3)) { post0_phase(a, gw, NGW, lane); } SEAM(3);
    if (IN(4)) {
        for (int u = vcu; u < 256; u += G) { const int b = u >> 6, h = (u >> 3) & 7, qb = u & 7, kvh = h >> 2; const size_t row0 = (size_t)b * SEQ + qb * 256;
            att::attn_dense_body((const att::bf16*)(ws + WS_QB) + row0 * 1024 + h * 128, (const att::bf16*)(ws + WS_KB) + (size_t)b * SEQ * 256 + kvh * 128,
                                 (const att::bf16*)(ws + WS_VB) + (size_t)b * SEQ * 256 + kvh * 128, (bf16_t*)(ws + WS_YCAT) + row0 * 2048 + h * 128,
                                 (const bf16_t*)(ws + WS_PROJ) + row0 * NINP + A_GA + h * 128, SEQ, (char*)lds);
            __syncthreads(); }
        for (int rep = 0; rep < 1 + PROBE_SSD; ++rep) { for (int it = bx; it < 256; it += G) ssd_item(a, it, (float*)lds); __syncthreads(); }
    } SEAM(4);
    if (IN(5)) { ssd_combine_phase(a, gw, NGW, lane); } SEAM(5);
    if (IN(6)) {
        pg8::Gemm g{(const bf16_t*)(ws + WS_YCAT), (const bf16_t*)(ws + WS_WOUT0), MTOK, 2048, 2048}; pg8::StaticOrder S; S.init(MTOK, 2048, G, bx);
        pg8::EpiResid E{a.in[0], a.out, (const float*)(ws + WS_MOD), a.in[3]};
        pg8::gemm_phase<pg8::EpiResid, pg8::StaticOrder, true, true>(ldsl, g, S, E);
    } SEAM(6);
    if (IN(7)) { normmod_phase(a, a.out, 1, gw, NGW, lane); } SEAM(7);
    if (IN(8)) {
        pg8::Gemm g{(const bf16_t*)(ws + WS_H), (const bf16_t*)(ws + WS_WIN1), MTOK, NINP, 2048}; pg8::StaticOrder S; S.init(MTOK, NINP, G, bx);
        pg8::EpiProj E{(bf16_t*)(ws + WS_PROJ), (float*)(ws + WS_SMALL), NINP, C_SM / 256};
        pg8::gemm_phase<pg8::EpiProj, pg8::StaticOrder, true, true>(ldsl, g, S, E);
    } SEAM(8);
    if (IN(9)) { post1_phase(a, gw, NGW, lane); } SEAM(9);
    if (IN(10)) {
        for (int rep = 0; rep < 1 + PROBE_GDN; ++rep) { for (int it = bx; it < 256; it += G) gdn_item(a, it, (float*)lds); __syncthreads(); }
        for (int rep = 0; rep < 1 + PROBE_LRU; ++rep) { for (int it = bx; it < 2048; it += G) lru_tile(a, it, lds, 0); __syncthreads(); }
    } SEAM(10);
    if (IN(11)) { combine1_phase(a, gw, NGW, lane); __syncthreads(); for (int it = bx; it < 2048; it += G) lru_tile(a, it, lds, 1); } SEAM(11);
    if (IN(12)) {
        pg8::Gemm g{(const bf16_t*)(ws + WS_YCAT), (const bf16_t*)(ws + WS_WOUT1), MTOK, 2048, 2048}; pg8::StaticOrder S; S.init(MTOK, 2048, G, bx);
        pg8::EpiResid E{a.out, a.out, (const float*)(ws + WS_MOD) + 4 * 6144, a.in[3] + 6144};
        pg8::gemm_phase<pg8::EpiResid, pg8::StaticOrder, true, true>(ldsl, g, S, E);
    } SEAM(12);
    if (IN(13)) { final_norm_phase(a, gw, NGW, lane); }
#undef IN
#undef SEAM
}

extern "C" void kernel_launch(void* const* d_in, const int* in_sizes, int n_in, void* d_out, int out_size, void* d_ws, size_t ws_size, hipStream_t stream) {
    static int grid = 0;
    if (grid == 0) {
        if (n_in != 39 || out_size != MTOK * DM || ws_size < WS_END) { fprintf(stderr, "kernel_launch: unexpected problem (n_in %d, out %d, ws %zu < %zu)\n", n_in, out_size, ws_size, (size_t)WS_END); grid = -1; return; }
        int dev = 0, cus = 0, per_cu = 0;
        if (hipGetDevice(&dev) != hipSuccess || hipDeviceGetAttribute(&cus, hipDeviceAttributeMultiprocessorCount, dev) != hipSuccess) { grid = -1; return; }
        if (hipFuncSetAttribute((const void*)mk_fwd, hipFuncAttributeMaxDynamicSharedMemorySize, LDS_BYTES) != hipSuccess) { fprintf(stderr, "kernel_launch: hipFuncSetAttribute failed\n"); grid = -1; return; }
        if (hipOccupancyMaxActiveBlocksPerMultiprocessor(&per_cu, (const void*)mk_fwd, NTHREADS, LDS_BYTES) != hipSuccess || per_cu < 1) { fprintf(stderr, "kernel_launch: occupancy query says %d\n", per_cu); (void)hipGetLastError(); per_cu = 1; }
        grid = cus;
    }
    if (grid < 0) return;
    (void)hipMemsetAsync((char*)d_ws + WS_CTL, 0, CTL_ZERO_BYTES, stream);
    Args a{};
    for (int i = 0; i < 39; ++i) a.in[i] = (const float*)d_in[i];
    a.out = (float*)d_out; a.ws = (unsigned char*)d_ws;
#if MK_SINGLE
    a.ph_lo = 0; a.ph_hi = NPHASE;
    void* kargs[] = {&a};
    hipError_t e = hipLaunchCooperativeKernel((const void*)mk_fwd, dim3(grid), dim3(NTHREADS), kargs, LDS_BYTES, stream);
    if (e != hipSuccess) fprintf(stderr, "kernel_launch: cooperative launch failed: %s (grid %d)\n", hipGetErrorString(e), grid);
#else
    for (int p = 0; p < NPHASE; ++p) { a.ph_lo = p; a.ph_hi = p + 1; hipLaunchKernelGGL(mk_fwd, dim3(grid), dim3(NTHREADS), LDS_BYTES, stream, a); }
#endif
}
```

```cpp
#include <hip/hip_runtime.h>
#include <hip/hip_cooperative_groups.h>
#include <hip/hip_bf16.h>
#include <cstdio>
#include <cstdint>
namespace cg = cooperative_groups;

constexpr int BATCH = 4, SEQ = 2048, DM = 2048, MTOK = BATCH * SEQ;
constexpr int NIN = 5152, NINP = 5376;
constexpr float EPS = 1e-6f;
constexpr int A_Q = 0, A_K = 1024, A_V = 1280, A_GA = 1536, A_XS = 2560, A_BS = 3584, A_CS = 3840, A_DT = 4096, A_Z = 4128;
constexpr int C_Q = 0, C_K = 512, C_V = 1024, C_SM = 2048, C_Z = 2080, C_XL = 3104, C_GL = 4128;
namespace pg8 {
#define PG8_LAS __attribute__((address_space(3)))
typedef unsigned short bf16_t;
typedef short bf16x8 __attribute__((ext_vector_type(8)));
typedef float f32x4 __attribute__((ext_vector_type(4)));
typedef unsigned u32x4 __attribute__((ext_vector_type(4)));
constexpr int BM = 256, BK = 64, HALF = 128, HTB = HALF * BK * 2  , STAGE_BYTES = 8 * HTB, NXCD = 8, WGM = 8;

__host__ __device__ __forceinline__ int lds_byte(int r, int c) { const int st = (r >> 4) * 2 + (c >> 5), rr = r & 15, cc = c & 31, ob = rr * 64 + cc * 2; return st * 1024 + (ob ^ (((ob >> 9) & 1) << 5)); }
__host__ __device__ __forceinline__ void stage_rc(int b, int& R, int& C) { const int st = b / 1024, sb = b % 1024, swz = sb ^ (((sb >> 9) & 1) << 5); R = (st >> 1) * 16 + swz / 64; C = (st & 1) * 32 + (swz % 64) / 2; }
__host__ __device__ __forceinline__ int perm32(int rho) { const int n = rho >> 4, i = rho & 15; return 8 * (i >> 2) + 4 * n + (i & 3); }

struct Unit { int pm, pn; };
struct Gemm { const bf16_t* A; const bf16_t* Bt; int M, N, K; };

struct StaticOrder {
    int nM, nN, nwg, G, c;
    __host__ __device__ void init(int M, int N, int G_, int c_) { nM = M / BM; nN = N / BM; nwg = nM * nN; G = G_; c = c_; }
    __host__ __device__ bool next(int i, Unit& u) const {
        const long L = (long)i * G + c; if (L >= nwg) return false;
        int wgid = (int)L; { const int q = nwg / NXCD, r = nwg % NXCD, xcd = wgid % NXCD, off = wgid / NXCD; wgid = (xcd < r ? xcd * (q + 1) : r * (q + 1) + (xcd - r) * q) + off; }
        const int nig = WGM * nN, gid = wgid / nig, fm = gid * WGM, gsz = (nM - fm) < WGM ? (nM - fm) : WGM;
        u.pm = fm + ((wgid % nig) % gsz); u.pn = (wgid % nig) / gsz; return true;
    }
    __device__ __forceinline__ void a_ready(const Unit&) const {}
    __device__ __forceinline__ void done(const Unit&) const {}
};

__device__ __forceinline__ unsigned cvt_pk_bf16(float lo, float hi) { unsigned r; asm volatile("v_cvt_pk_bf16_f32 %0, %1, %2" : "=v"(r) : "v"(lo), "v"(hi)); return r; }
typedef float f32x2 __attribute__((ext_vector_type(2)));
struct EpiProj {
    static constexpr bool PERM = true, AFTER_DRAIN = false;
    bf16_t* O; float* small; int ldc; int small_tile;
    __device__ __forceinline__ void operator()(const f32x4 (&acc)[2][2][4][2], const Unit& u, int wr, int wc, int fr, int fq) const {
        const int row0 = u.pm * BM + wr * 64 + fr; const int col0 = u.pn * BM + wc * 32 + 8 * fq;
        const bool sm = (u.pn == small_tile) && (wc == 0);
#pragma unroll
        for (int ai = 0; ai < 2; ++ai)
#pragma unroll
            for (int m = 0; m < 4; ++m) { const int row = row0 + ai * HALF + m * 16; bf16_t* rowp = O + (size_t)row * ldc + col0;
#pragma unroll
                for (int bj = 0; bj < 2; ++bj) { const f32x4 v0 = acc[ai][bj][m][0], v1 = acc[ai][bj][m][1];
                    u32x4 w; w.x = cvt_pk_bf16(v0[0], v0[1]); w.y = cvt_pk_bf16(v0[2], v0[3]); w.z = cvt_pk_bf16(v1[0], v1[1]); w.w = cvt_pk_bf16(v1[2], v1[3]);
                    *(u32x4*)(rowp + bj * HALF) = w; }
                if (sm) { float* sp = small + (size_t)row * 32 + 8 * fq; *(f32x4*)sp = acc[ai][0][m][0]; *(f32x4*)(sp + 4) = acc[ai][0][m][1]; } }
    }
};
struct EpiResid {
    static constexpr bool PERM = false, AFTER_DRAIN = false;
    const float* xin; float* xout; const float* gacc; const float* gbias;
    __device__ __forceinline__ void operator()(const f32x4 (&acc)[2][2][4][2], const Unit& u, int wr, int wc, int fr, int fq) const {
        const int b = u.pm >> 3;
        const int col0 = u.pn * BM + wc * 32 + 4 * fq;
#pragma unroll
        for (int bj = 0; bj < 2; ++bj)
#pragma unroll
            for (int n = 0; n < 2; ++n) { const int col = col0 + bj * HALF + n * 16;
                const f32x4 g = *(const f32x4*)(gacc + (size_t)b * 6144 + 4096 + col) + *(const f32x4*)(gbias + 4096 + col);
#pragma unroll
                for (int ai = 0; ai < 2; ++ai)
#pragma unroll
                    for (int m = 0; m < 4; ++m) { const size_t off = (size_t)(u.pm * BM + ai * HALF + wr * 64 + m * 16 + fr) * 2048 + col;
                        const f32x4 xv = *(const f32x4*)(xin + off); *(f32x4*)(xout + off) = xv + g * acc[ai][bj][m][n]; } }
    }
};
template <class Epi, class Sched, bool ALIGN_EPI = false, bool SP2 = false>
__device__ __forceinline__ void gemm_phase(PG8_LAS unsigned char* lds, const Gemm g, const Sched& S, const Epi& E) {
    const int tid = threadIdx.x, wid = __builtin_amdgcn_readfirstlane(tid >> 6), lane = tid & 63, wr = wid >> 2, wc = wid & 3, fr = lane & 15, fq = lane >> 4;
    const int K = g.K, nt = K / BK;
    unsigned voffA[2], voffB[2];
#pragma unroll
    for (int i = 0; i < 2; ++i) { int R, C; stage_rc(tid * 16 + i * 8192, R, C); const int Rb = Epi::PERM ? ((R & ~31) + perm32(R & 31)) : R;
        voffA[i] = (unsigned)(R * K + C) * 2u; voffB[i] = (unsigned)(Rb * K + C) * 2u; }
    const size_t kstep = (size_t)(BK * 2);
    const size_t hstep = (size_t)HALF * K * 2;
    const size_t tstep = 2 * hstep;
    const unsigned ldsw = (unsigned)wid * 1024u;
    const int aoff = lds_byte(wr * 64 + fr, fq * 8), boff = lds_byte(wc * 32 + fr, fq * 8);
#define PG8_SA(b, h) (((b) * 2 + (h)) * HTB)
#define PG8_SB(b, h) ((4 + (b) * 2 + (h)) * HTB)
#define PG8_STAGE(bufoff, gbase, voff) do { _Pragma("unroll") for (int _i = 0; _i < 2; ++_i) \
        __builtin_amdgcn_global_load_lds((const unsigned*)((const char*)(gbase) + (voff)[_i]), (PG8_LAS unsigned*)(lds + (bufoff) + ldsw + _i * 8192), 16, 0, 0); } while (0)
#define PG8_LDA(dst, b, h) do { _Pragma("unroll") for (int m = 0; m < 4; ++m) _Pragma("unroll") for (int k = 0; k < 2; ++k) dst[m][k] = *(const PG8_LAS bf16x8*)(lds + PG8_SA(b, h) + aoff + m * 2048 + k * 1024); } while (0)
#define PG8_LDB(dst, b, h) do { _Pragma("unroll") for (int n = 0; n < 2; ++n) _Pragma("unroll") for (int k = 0; k < 2; ++k) dst[n][k] = *(const PG8_LAS bf16x8*)(lds + PG8_SB(b, h) + boff + n * 2048 + k * 1024); } while (0)
#define PG8_MMA(ai, bj, At, Bt) do { __builtin_amdgcn_s_setprio(1); _Pragma("unroll") for (int m = 0; m < 4; ++m) _Pragma("unroll") for (int n = 0; n < 2; ++n) _Pragma("unroll") for (int k = 0; k < 2; ++k) \
        acc[ai][bj][m][n] = __builtin_amdgcn_mfma_f32_16x16x32_bf16(Bt[n][k], At[m][k], acc[ai][bj][m][n], 0, 0, 0); __builtin_amdgcn_s_setprio(0); } while (0)
#define PG8_WAIT_V(n) asm volatile("s_waitcnt vmcnt(" #n ")" ::: "memory")
#define PG8_WAIT_L(n) asm volatile("s_waitcnt lgkmcnt(" #n ")" ::: "memory")
#define PG8_BAR __builtin_amdgcn_s_barrier()
#define PG8_SCHED __builtin_amdgcn_sched_barrier(0)
    Unit cur, nxt; int ui = 0;
    if (!S.next(0, cur)) return;
    f32x4 acc[2][2][4][2];
#pragma unroll
    for (int a = 0; a < 2; ++a)
#pragma unroll
        for (int b = 0; b < 2; ++b)
#pragma unroll
            for (int m = 0; m < 4; ++m)
#pragma unroll
                for (int n = 0; n < 2; ++n) acc[a][b][m][n] = (f32x4){0.f, 0.f, 0.f, 0.f};
    bf16x8 At[4][2], B0[2][2], B1[2][2];
    const char* cA = (const char*)g.A + (size_t)cur.pm * tstep; const char* cB = (const char*)g.Bt + (size_t)cur.pn * tstep;
    S.a_ready(cur);
    if constexpr (SP2) {
        PG8_STAGE(PG8_SB(0, 0), cB, voffB); PG8_STAGE(PG8_SB(0, 1), cB + hstep, voffB); PG8_STAGE(PG8_SA(0, 0), cA, voffA); PG8_STAGE(PG8_SA(0, 1), cA + hstep, voffA);
        if (wr == 1) PG8_BAR;
        PG8_WAIT_V(2); PG8_BAR;
        PG8_STAGE(PG8_SB(1, 0), cB + kstep, voffB); PG8_STAGE(PG8_SA(1, 0), cA + kstep, voffA); PG8_STAGE(PG8_SB(1, 1), cB + hstep + kstep, voffB);
        PG8_WAIT_V(6); PG8_BAR;
    } else {
        PG8_STAGE(PG8_SB(0, 0), cB, voffB); PG8_STAGE(PG8_SA(0, 0), cA, voffA); PG8_STAGE(PG8_SB(0, 1), cB + hstep, voffB); PG8_STAGE(PG8_SA(0, 1), cA + hstep, voffA);
        if (wr == 1) PG8_BAR;
        PG8_WAIT_V(4); PG8_BAR;
        PG8_STAGE(PG8_SB(1, 0), cB + kstep, voffB); PG8_STAGE(PG8_SA(1, 0), cA + kstep, voffA); PG8_STAGE(PG8_SB(1, 1), cB + hstep + kstep, voffB);
        PG8_WAIT_V(6); PG8_BAR;
    }
    for (;;) {
        const bool has_next = S.next(ui + 1, nxt);
        const char* nA = has_next ? (const char*)g.A + (size_t)nxt.pm * tstep : cA; const char* nB = has_next ? (const char*)g.Bt + (size_t)nxt.pn * tstep : cB;
        for (int t = 0; t < nt; t += 2) {
            const bool last = (t == nt - 2);
            const char* a1 = cA + (size_t)(t + 1) * kstep;
            const char* a2 = last ? nA : cA + (size_t)(t + 2) * kstep; const char* b2 = last ? nB : cB + (size_t)(t + 2) * kstep;
            const char* a3 = a2 + kstep; const char* b3 = b2 + kstep;
            if (last && has_next) S.a_ready(nxt);
            if constexpr (SP2) {
            PG8_LDB(B0, 0, 0); PG8_LDB(B1, 0, 1); PG8_SCHED; PG8_LDA(At, 0, 0); PG8_STAGE(PG8_SA(1, 1), a1 + hstep, voffA);
            PG8_WAIT_V(8); PG8_WAIT_L(0); PG8_BAR; PG8_MMA(0, 0, At, B0); PG8_MMA(0, 1, At, B1); PG8_BAR; PG8_SCHED;
            PG8_LDA(At, 0, 1); PG8_STAGE(PG8_SB(0, 0), b2, voffB); PG8_STAGE(PG8_SB(0, 1), b2 + hstep, voffB); PG8_STAGE(PG8_SA(0, 0), a2, voffA);
            PG8_WAIT_V(8); PG8_WAIT_L(0); PG8_BAR; PG8_MMA(1, 0, At, B0); PG8_MMA(1, 1, At, B1); PG8_BAR; PG8_SCHED;
            PG8_LDB(B0, 1, 0); PG8_LDB(B1, 1, 1); PG8_SCHED; PG8_LDA(At, 1, 0); PG8_STAGE(PG8_SA(0, 1), a2 + hstep, voffA);
            PG8_WAIT_V(8); PG8_WAIT_L(0); PG8_BAR; PG8_MMA(0, 0, At, B0); PG8_MMA(0, 1, At, B1); PG8_BAR; PG8_SCHED;
            PG8_LDA(At, 1, 1); PG8_STAGE(PG8_SB(1, 0), b3, voffB); PG8_STAGE(PG8_SB(1, 1), b3 + hstep, voffB); PG8_STAGE(PG8_SA(1, 0), a3, voffA);
            PG8_WAIT_V(8); PG8_WAIT_L(0); PG8_BAR; PG8_MMA(1, 0, At, B0); PG8_MMA(1, 1, At, B1); PG8_BAR; PG8_SCHED;
            } else {
            PG8_LDB(B0, 0, 0); PG8_SCHED; PG8_LDA(At, 0, 0); PG8_STAGE(PG8_SA(1, 1), a1 + hstep, voffA);
            PG8_WAIT_L(8); PG8_BAR; PG8_WAIT_L(0); PG8_MMA(0, 0, At, B0); PG8_BAR; PG8_SCHED;
            PG8_LDB(B1, 0, 1); PG8_STAGE(PG8_SB(0, 0), b2, voffB);
            PG8_BAR; PG8_WAIT_L(0); PG8_MMA(0, 1, At, B1); PG8_BAR;
            PG8_LDA(At, 0, 1); PG8_STAGE(PG8_SA(0, 0), a2, voffA);
            PG8_BAR; PG8_WAIT_L(0); PG8_MMA(1, 0, At, B0); PG8_BAR; PG8_SCHED;
            PG8_STAGE(PG8_SB(0, 1), b2 + hstep, voffB);
            PG8_WAIT_V(6); PG8_BAR; PG8_MMA(1, 1, At, B1); PG8_BAR;
            PG8_LDB(B0, 1, 0); PG8_SCHED; PG8_LDA(At, 1, 0); PG8_STAGE(PG8_SA(0, 1), a2 + hstep, voffA);
            PG8_WAIT_L(8); PG8_BAR; PG8_WAIT_L(0); PG8_MMA(0, 0, At, B0); PG8_BAR; PG8_SCHED;
            PG8_LDB(B1, 1, 1); PG8_STAGE(PG8_SB(1, 0), b3, voffB);
            PG8_BAR; PG8_WAIT_L(0); PG8_MMA(0, 1, At, B1); PG8_BAR;
            PG8_LDA(At, 1, 1); PG8_STAGE(PG8_SA(1, 0), a3, voffA);
            PG8_BAR; PG8_WAIT_L(0); PG8_MMA(1, 0, At, B0); PG8_BAR; PG8_SCHED;
            PG8_STAGE(PG8_SB(1, 1), b3 + hstep, voffB);
            PG8_WAIT_V(6); PG8_BAR; PG8_MMA(1, 1, At, B1); PG8_BAR;
            }
        }
        if constexpr (ALIGN_EPI) { if (wr == 0) PG8_BAR; }
        if constexpr (!Epi::AFTER_DRAIN) { E(acc, cur, wr, wc, fr, fq); S.done(cur); }
        if (!has_next) break;
#pragma unroll
        for (int a = 0; a < 2; ++a)
#pragma unroll
            for (int b = 0; b < 2; ++b)
#pragma unroll
                for (int m = 0; m < 4; ++m)
#pragma unroll
                    for (int n = 0; n < 2; ++n) acc[a][b][m][n] = (f32x4){0.f, 0.f, 0.f, 0.f};
        cur = nxt; cA = nA; cB = nB; ++ui;
        if constexpr (ALIGN_EPI) { if (wr == 1) PG8_BAR; }
    }
    PG8_WAIT_V(0);
    if constexpr (!ALIGN_EPI) { if (wr == 0) PG8_BAR; }
    PG8_BAR;
    if constexpr (Epi::AFTER_DRAIN) { E.fused(acc, cur, wr, wc, fr, fq, lds, wid, lane); S.done(cur); }
#undef PG8_SA
#undef PG8_SB
#undef PG8_STAGE
#undef PG8_LDA
#undef PG8_LDB
#undef PG8_MMA
#undef PG8_WAIT_V
#undef PG8_WAIT_L
#undef PG8_BAR
#undef PG8_SCHED
}
}
namespace att {
using bf16 = __hip_bfloat16;
constexpr int   D = 128, NW = 8, QBLK = 32, KVBLK = 64;
constexpr float SCALE = 0.088388347648318440f;
constexpr float THR = 8.f;
constexpr int SDEPTH = 2;
constexpr int LDQ = 1024, LDK = 256, LDY = 2048, LDG = NINP;
constexpr size_t SHM_V = KVBLK * D * 2, SHM_K = KVBLK * D * 2, SHM_ATTN = 2 * SHM_V + 2 * SHM_K + NW * 64 * 4;
using bf16x8 = __attribute__((ext_vector_type(8))) short;
using s16x4  = __attribute__((ext_vector_type(4))) short;
using f32x16 = __attribute__((ext_vector_type(16))) float;
using f32x8  = __attribute__((ext_vector_type(8))) float;
using u32x4  = __attribute__((ext_vector_type(4))) unsigned;
#define KSWZ(row, colB) ((row) * 256 + ((colB) ^ (((row) & 7) << 4)))
#define SBAR() __builtin_amdgcn_sched_barrier(0)
__device__ __forceinline__ int crow(int r, int hi) { return (r & 3) + 8 * (r >> 2) + 4 * hi; }
__device__ __forceinline__ unsigned cvtpk(float lo, float hi) {
  unsigned r; asm volatile("v_cvt_pk_bf16_f32 %0, %1, %2" : "=v"(r) : "v"(lo), "v"(hi)); return r;
}
template <typename TIn> struct Stage;
template <> struct Stage<bf16>  { using T = bf16x8;
  __device__ static __forceinline__ T ld8(const bf16* p) { return *reinterpret_cast<const bf16x8*>(p); }
  __device__ static __forceinline__ bf16x8 tobf(T x) { return x; } };
template <> struct Stage<float> { using T = f32x8;
  __device__ static __forceinline__ T ld8(const float* p) { return *reinterpret_cast<const f32x8*>(p); }
  __device__ static __forceinline__ bf16x8 tobf(T x) {
    u32x4 w = {cvtpk(x[0], x[1]), cvtpk(x[2], x[3]), cvtpk(x[4], x[5]), cvtpk(x[6], x[7])}; return *reinterpret_cast<bf16x8*>(&w); } };

__device__ __forceinline__ void partialSM(f32x16& p0, f32x16& p1, float& m_reg, float& mn, float& alpha) {
  constexpr float C = SCALE * 1.4426950408889634f;
  float pmax = p0[0]; for (int r = 1; r < 16; ++r) pmax = fmaxf(pmax, p0[r]); for (int r = 0; r < 16; ++r) pmax = fmaxf(pmax, p1[r]);
  { auto rr = __builtin_amdgcn_permlane32_swap(__float_as_uint(pmax), __float_as_uint(pmax), false, false);
    pmax = fmaxf(__uint_as_float(rr[0]), __uint_as_float(rr[1])); }
  if (__builtin_expect(__all(pmax - m_reg <= THR / SCALE), 1)) { mn = m_reg; alpha = 1.f; }
  else { mn = fmaxf(m_reg, pmax); alpha = __builtin_amdgcn_exp2f((m_reg - mn) * C); m_reg = mn; }
  float mnC = -mn * C;
  for (int r = 0; r < 16; ++r) p0[r] = fmaf(p0[r], C, mnC); for (int r = 0; r < 16; ++r) p1[r] = fmaf(p1[r], C, mnC);
  for (int r = 0; r < 16; ++r) p0[r] = __builtin_amdgcn_exp2f(p0[r]);
}
__device__ __forceinline__ void finishSM(f32x16& p0, f32x16& p1, float alpha, float& l_reg, bf16x8& pa0, bf16x8& pa1, bf16x8& pa2, bf16x8& pa3) {
  for (int r = 0; r < 16; ++r) p1[r] = __builtin_amdgcn_exp2f(p1[r]);
  float ps = 0; for (int r = 0; r < 16; ++r) ps += p0[r]; for (int r = 0; r < 16; ++r) ps += p1[r];
  { auto rr = __builtin_amdgcn_permlane32_swap(__float_as_uint(ps), __float_as_uint(ps), false, false);
    ps = __uint_as_float(rr[0]) + __uint_as_float(rr[1]); }
  l_reg = l_reg * alpha + ps;
#define PK4(P, BASE, OUT) do { unsigned a0 = cvtpk(P[BASE + 0], P[BASE + 1]), a1 = cvtpk(P[BASE + 2], P[BASE + 3]);   \
    unsigned b0 = cvtpk(P[BASE + 4], P[BASE + 5]), b1 = cvtpk(P[BASE + 6], P[BASE + 7]);                              \
    auto r0 = __builtin_amdgcn_permlane32_swap(a0, b0, false, false); auto r1 = __builtin_amdgcn_permlane32_swap(a1, b1, false, false); \
    u32x4 w = {r0[0], r1[0], r0[1], r1[1]}; OUT = *reinterpret_cast<bf16x8*>(&w); } while (0)
  PK4(p0, 0, pa0); PK4(p0, 8, pa1); PK4(p1, 0, pa2); PK4(p1, 8, pa3);
#undef PK4
}
__device__ __forceinline__ void qkt(f32x16& p0, f32x16& p1, const bf16* Ks, const bf16x8* qr, int r32, int hi) {
  p0 = f32x16{}; p1 = f32x16{};
  for (int d0 = 0; d0 < 8; ++d0) { int cb = (d0 * 16 + hi * 8) * 2;
    bf16x8 b0 = *reinterpret_cast<const bf16x8*>((const char*)Ks + KSWZ(r32, cb));
    bf16x8 b1 = *reinterpret_cast<const bf16x8*>((const char*)Ks + KSWZ(32 + r32, cb));
    p0 = __builtin_amdgcn_mfma_f32_32x32x16_bf16(b0, qr[d0], p0, 0, 0, 0);
    p1 = __builtin_amdgcn_mfma_f32_32x32x16_bf16(b1, qr[d0], p1, 0, 0, 0); }
}
__device__ __forceinline__ int v_st(int k, int c) { const int kk = (k & ~0xC) | ((k & 4) << 1) | ((k & 8) >> 1); return ((kk >> 3) * 4 + (c >> 5)) * 512 + ((kk & 7) * 32 + (c & 31)) * 2; }
__device__ __forceinline__ int v_rd_base(int lane) { return ((lane & 3) << 3) | (((lane >> 2) & 3) << 6) | (((lane >> 4) & 1) << 5) | (((lane >> 5) & 1) << 8); }
constexpr int v_rd_off(int d0, int ks, int half) { return d0 * 512 + ks * 4096 + half * 2048; }
template <int OFF> __device__ __forceinline__ s16x4 tr_read(int vb) {
  s16x4 r; asm volatile("ds_read_b64_tr_b16 %0, %1 offset:%2" : "=&v"(r) : "v"(vb), "i"(OFF) : "memory"); return r;
}
template <int D0> __device__ __forceinline__ void pv_one(f32x16& od, int vb, bf16x8 pa0, bf16x8 pa1, bf16x8 pa2, bf16x8 pa3) {
  const s16x4 l0 = tr_read<v_rd_off(D0, 0, 0)>(vb), h0 = tr_read<v_rd_off(D0, 0, 1)>(vb), l1 = tr_read<v_rd_off(D0, 1, 0)>(vb), h1 = tr_read<v_rd_off(D0, 1, 1)>(vb);
  const s16x4 l2 = tr_read<v_rd_off(D0, 2, 0)>(vb), h2 = tr_read<v_rd_off(D0, 2, 1)>(vb), l3 = tr_read<v_rd_off(D0, 3, 0)>(vb), h3 = tr_read<v_rd_off(D0, 3, 1)>(vb);
  asm volatile("s_waitcnt lgkmcnt(0)" ::: "memory"); SBAR();
#define PK(L, H) (bf16x8){L[0], L[1], L[2], L[3], H[0], H[1], H[2], H[3]}
  od = __builtin_amdgcn_mfma_f32_32x32x16_bf16(pa0, PK(l0, h0), od, 0, 0, 0);
  od = __builtin_amdgcn_mfma_f32_32x32x16_bf16(pa1, PK(l1, h1), od, 0, 0, 0);
  od = __builtin_amdgcn_mfma_f32_32x32x16_bf16(pa2, PK(l2, h2), od, 0, 0, 0);
  od = __builtin_amdgcn_mfma_f32_32x32x16_bf16(pa3, PK(l3, h3), od, 0, 0, 0);
#undef PK
}
__device__ __forceinline__ void pv_d0(f32x16* o, int vb, bf16x8 pa0, bf16x8 pa1, bf16x8 pa2, bf16x8 pa3) {
  pv_one<0>(o[0], vb, pa0, pa1, pa2, pa3); pv_one<1>(o[1], vb, pa0, pa1, pa2, pa3); pv_one<2>(o[2], vb, pa0, pa1, pa2, pa3); pv_one<3>(o[3], vb, pa0, pa1, pa2, pa3);
}
__device__ __forceinline__ void attn_dense_body(const bf16* __restrict__ Qb, const bf16* __restrict__ Kh, const bf16* __restrict__ Vh,
                                                unsigned short* __restrict__ Yb, const unsigned short* __restrict__ Gb, int seq, char* lds) {
  using St = Stage<bf16>; using SQ = Stage<bf16>; using TQ = bf16;
  const int tid = threadIdx.x, wid = tid >> 6, lane = tid & 63, r32 = lane & 31, hi = lane >> 5;
  bf16* V_lds = (bf16*)lds; bf16* K_lds = (bf16*)(lds + 2 * SHM_V);
  float* ws = (float*)(lds + 2 * SHM_V + 2 * SHM_K) + wid * 64; float* li_l = ws; float* al_l = ws + 32;
  float m_reg = -1e30f, l_reg = 0; f32x16 o[4] = {}; bf16x8 qr[8];
  const TQ* Qw = Qb + (long)(wid * QBLK + r32) * LDQ + hi * 8;
#pragma unroll
  for (int d0 = 0; d0 < 8; ++d0) qr[d0] = SQ::tobf(SQ::ld8(Qw + d0 * 16));
  const int sr = tid >> 4, sc = (tid & 15) * 8, vst0 = v_st(sr, sc), vst1 = v_st(32 + sr, sc);
  const int vb0 = (int)(uintptr_t)V_lds + v_rd_base(lane);
  struct { typename St::T vs0, vs1, ks0, ks1; } sr_[SDEPTH];
#define SLOAD(i, k0) do { sr_[i].vs0 = St::ld8(&Vh[(long)((k0) + sr) * LDK + sc]); sr_[i].vs1 = St::ld8(&Vh[(long)((k0) + 32 + sr) * LDK + sc]); \
    sr_[i].ks0 = St::ld8(&Kh[(long)((k0) + sr) * LDK + sc]); sr_[i].ks1 = St::ld8(&Kh[(long)((k0) + 32 + sr) * LDK + sc]); } while (0)
#define SWRITE(b, i) do { *(bf16x8*)((char*)V_lds + (b) * SHM_V + vst0) = St::tobf(sr_[i].vs0);          \
    *(bf16x8*)((char*)V_lds + (b) * SHM_V + vst1) = St::tobf(sr_[i].vs1); int kc = sc * 2;               \
    *(bf16x8*)((char*)K_lds + (b) * SHM_K + KSWZ(sr, kc)) = St::tobf(sr_[i].ks0);                       \
    *(bf16x8*)((char*)K_lds + (b) * SHM_K + KSWZ(32 + sr, kc)) = St::tobf(sr_[i].ks1); } while (0)
#define SWAIT() do { if constexpr (SDEPTH == 2) asm volatile("s_waitcnt vmcnt(4)" ::: "memory"); else asm volatile("s_waitcnt vmcnt(0)" ::: "memory"); } while (0)
#define RESC(a) do { if (__any((a) < 1.f)) { if (hi == 0) al_l[r32] = (a); asm volatile("s_waitcnt lgkmcnt(0)" ::: "memory"); \
    for (int d = 0; d < 4; ++d) for (int r = 0; r < 16; ++r) o[d][r] *= al_l[crow(r, hi)]; } } while (0)
  f32x16 pA0, pA1, pB0, pB1; float mnA, mnB, alA, alB; bf16x8 pa0, pa1, pa2, pa3; const int NT = seq / KVBLK;
  constexpr int SE = 0, SO = SDEPTH - 1;
  SLOAD(SE, 0); asm volatile("s_waitcnt vmcnt(0)" ::: "memory"); SWRITE(0, SE); __syncthreads();
  qkt(pA0, pA1, K_lds, qr, r32, hi); partialSM(pA0, pA1, m_reg, mnA, alA);
  SLOAD(SO, KVBLK); if constexpr (SDEPTH == 2) { if (2 < NT) SLOAD(SE, 2 * KVBLK); }
  SWAIT(); SWRITE(1, SO); __syncthreads();
  for (int j = 1; j + 1 < NT; j += 2) {
    SBAR(); qkt(pB0, pB1, (bf16*)((char*)K_lds + SHM_K), qr, r32, hi);
    finishSM(pA0, pA1, alA, l_reg, pa0, pa1, pa2, pa3); SBAR();
    SLOAD(SO, (j + SDEPTH) * KVBLK); SBAR();
    pv_d0(o, vb0, pa0, pa1, pa2, pa3); partialSM(pB0, pB1, m_reg, mnB, alB);
    __syncthreads(); SWAIT(); SWRITE(0, SE);
    RESC(alB); __syncthreads();
    SBAR(); qkt(pA0, pA1, K_lds, qr, r32, hi);
    finishSM(pB0, pB1, alB, l_reg, pa0, pa1, pa2, pa3); SBAR();
    if (SDEPTH == 1 || j + 3 < NT) SLOAD(SE, (j + 1 + SDEPTH) * KVBLK); SBAR();
    pv_d0(o, vb0 + (int)SHM_V, pa0, pa1, pa2, pa3); partialSM(pA0, pA1, m_reg, mnA, alA);
    __syncthreads(); SWAIT(); SWRITE(1, SO);
    RESC(alA); __syncthreads();
  }
  SBAR(); qkt(pB0, pB1, (bf16*)((char*)K_lds + SHM_K), qr, r32, hi);
  finishSM(pA0, pA1, alA, l_reg, pa0, pa1, pa2, pa3); SBAR();
  pv_d0(o, vb0, pa0, pa1, pa2, pa3); partialSM(pB0, pB1, m_reg, mnB, alB);
  __syncthreads(); RESC(alB);
  finishSM(pB0, pB1, alB, l_reg, pa0, pa1, pa2, pa3); SBAR();
  pv_d0(o, vb0 + (int)SHM_V, pa0, pa1, pa2, pa3);
  if (hi == 0) li_l[r32] = l_reg; asm volatile("s_waitcnt lgkmcnt(0)" ::: "memory");
  float rli[16];
#pragma unroll
  for (int r = 0; r < 16; ++r) rli[r] = __builtin_amdgcn_rcpf(li_l[crow(r, hi)]);
  int eoff = (wid * QBLK + 4 * hi) ; asm volatile("" : "+v"(eoff));
  const unsigned short* Gw = Gb + (long)eoff * LDG + r32; unsigned short* Yw = Yb + (long)eoff * LDY + r32;
#pragma unroll
  for (int r = 0; r < 16; ++r) { const int orow = (r & 3) + 8 * (r >> 2);
#pragma unroll
    for (int d0 = 0; d0 < 4; ++d0) { const float g = __uint_as_float(((unsigned)Gw[orow * LDG + d0 * 32]) << 16);
      const float val = o[d0][r] * rli[r] * (g / (1.f + __expf(-g)));
      unsigned ub = __float_as_uint(val); ub = (ub + 0x7fffu + ((ub >> 16) & 1u)) >> 16;
      Yw[orow * LDY + d0 * 32] = (unsigned short)ub; } }
#undef SLOAD
#undef SWRITE
#undef SWAIT
#undef RESC
}
}
#define GAS __attribute__((address_space(1)))
#define LAS __attribute__((address_space(3)))
typedef unsigned short bf16_t;
typedef unsigned v4u __attribute__((ext_vector_type(4)));
typedef unsigned v2u __attribute__((ext_vector_type(2)));
typedef float f32x4 __attribute__((ext_vector_type(4)));
#define LDS_WAIT() asm volatile("s_waitcnt lgkmcnt(0)" ::: "memory")

constexpr size_t MiB = 1u << 20;
constexpr size_t WS_CTL = 0, CTL_ZERO_BYTES = 1 * MiB;
constexpr size_t WS_MOD = 64 * 1024;
constexpr size_t WS_ROPE = 1 * MiB;
constexpr size_t WS_SMALL = 2 * MiB;
constexpr size_t WS_WIN0 = 3 * MiB, WS_WOUT0 = 24 * MiB;
constexpr size_t WS_QB = 32 * MiB, WS_KB = 48 * MiB, WS_VB = 52 * MiB;
constexpr size_t WS_HB = 3 * MiB;
constexpr size_t WS_WIN1 = 56 * MiB, WS_WOUT1 = 77 * MiB;
constexpr size_t WS_H = 85 * MiB;
constexpr size_t WS_HF = 85 * MiB;
constexpr size_t WS_PROJ = 117 * MiB;
constexpr size_t WS_YCAT = 201 * MiB;
constexpr size_t WS_ACT = 233 * MiB;
constexpr size_t WS_YF = 297 * MiB, WS_YB = 329 * MiB;
constexpr size_t WS_WGT = 361 * MiB;
constexpr size_t WS_LSUM = 362 * MiB;
constexpr size_t WS_END = 366 * MiB;

constexpr int NWAVES = 8, NTHREADS = 512;
constexpr int LDS_BYTES = 147456;
constexpr int NPHASE = 14;

struct Args { const float* in[39]; float* out; unsigned char* ws; int ph_lo, ph_hi; };

__device__ __forceinline__ float bf2f(unsigned v) { return __uint_as_float(v << 16); }
__device__ __forceinline__ unsigned f2bf(float f) { unsigned u = __float_as_uint(f); return (u + 0x7fffu + ((u >> 16) & 1u)) >> 16; }
__device__ __forceinline__ unsigned pk2(float lo, float hi) { return f2bf(lo) | (f2bf(hi) << 16); }
__device__ __forceinline__ void unpack8(const v4u w, float* x) {
    x[0] = __uint_as_float(w.x << 16); x[1] = __uint_as_float(w.x & 0xffff0000u); x[2] = __uint_as_float(w.y << 16); x[3] = __uint_as_float(w.y & 0xffff0000u);
    x[4] = __uint_as_float(w.z << 16); x[5] = __uint_as_float(w.z & 0xffff0000u); x[6] = __uint_as_float(w.w << 16); x[7] = __uint_as_float(w.w & 0xffff0000u);
}
__device__ __forceinline__ v4u pack8(const float* x) { v4u w; w.x = pk2(x[0], x[1]); w.y = pk2(x[2], x[3]); w.z = pk2(x[4], x[5]); w.w = pk2(x[6], x[7]); return w; }
__device__ __forceinline__ float silu_f(float x) { return x / (1.f + expf(-x)); }
__device__ __forceinline__ float sigmoid_f(float x) { return 1.f / (1.f + expf(-x)); }
__device__ __forceinline__ float softplus_f(float x) { return fmaxf(x, 0.f) + log1pf(expf(-fabsf(x))); }
template <int CTRL> __device__ __forceinline__ float dpp_mov(float v) { return __builtin_bit_cast(float, __builtin_amdgcn_update_dpp(0, __builtin_bit_cast(int, v), CTRL, 0xF, 0xF, true)); }
template <int N> __device__ __forceinline__ float group_sum(float v) {
    if (N >= 2) v += dpp_mov<0xB1>(v);
    if (N >= 4) v += dpp_mov<0x4E>(v);
    if (N >= 8) v += dpp_mov<0x141>(v);
    if (N >= 16) v += dpp_mov<0x140>(v);
    if (N >= 32) v += __shfl_xor(v, 16);
    if (N >= 64) v += __shfl_xor(v, 32);
    return v;
}

__device__ __forceinline__ void p0_transpose_item(const float* W, int K, int N, bf16_t* WT, int row_off, LAS float* scr, int item, int lane) {
    const int nblk = N / 32, kb = item / nblk, nb = item % nblk, k0 = 64 * kb, n0 = 32 * nb;
#pragma unroll 8
    for (int i = 0; i < 32; ++i) { const int kk = 2 * i + (lane >> 5); scr[kk * 33 + (lane & 31)] = W[(size_t)(k0 + kk) * N + n0 + (lane & 31)]; }
    LDS_WAIT(); asm volatile("" ::: "memory");
    const int c = lane & 7;
#pragma unroll
    for (int j = 0; j < 4; ++j) { const int n = (lane >> 3) + 8 * j; const LAS float* s = scr + (8 * c) * 33 + n;
        v4u o; o.x = pk2(s[0 * 33], s[1 * 33]); o.y = pk2(s[2 * 33], s[3 * 33]); o.z = pk2(s[4 * 33], s[5 * 33]); o.w = pk2(s[6 * 33], s[7 * 33]);
        *(v4u*)(WT + (size_t)(row_off + n0 + n) * K + k0 + 8 * c) = o; }
    LDS_WAIT(); asm volatile("" ::: "memory");
}

__device__ __forceinline__ void p0_prologue(const Args& a, LAS unsigned char* lds, int vcu, int G) {
    const int tid = threadIdx.x, lane = tid & 63, wave = tid >> 6;
    unsigned char* ws = a.ws;
    { const int gid = blockIdx.x * NTHREADS + tid;
      if (gid < 2048) { const int pos = gid >> 5, i = gid & 31; const float freq = expf(-(float)i * (1.f / 32.f) * 9.210340371976184f); const float ang = (float)pos * freq;
          float* rt = (float*)(ws + WS_ROPE); rt[2 * gid] = cosf(ang); rt[2 * gid + 1] = sinf(ang); } }
    { const int gid = blockIdx.x * NTHREADS + tid, gn = G * NTHREADS; constexpr int NV = (NINP - NIN) * 2048 * 2 / 16;
      v4u* p0 = (v4u*)(ws + WS_WIN0 + (size_t)NIN * 2048 * 2); v4u* p1 = (v4u*)(ws + WS_WIN1 + (size_t)NIN * 2048 * 2);
      for (int i = gid; i < NV; i += gn) { p0[i] = (v4u){0, 0, 0, 0}; p1[i] = (v4u){0, 0, 0, 0}; } }
    if (blockIdx.x < 192) {
        const int it = blockIdx.x, l = it / 96, r = it % 96, kc = r / 3, nc = r % 3;
        LAS float* cond = (LAS float*)lds;
        if (tid < 256) { const int b = tid >> 6, k = tid & 63; const float c = a.in[1][b * 2048 + kc * 64 + k]; cond[tid] = silu_f(c); }
        __syncthreads();
        const float* W = a.in[2] + (size_t)l * 2048 * 6144 + (size_t)(kc * 64) * 6144 + nc * 2048 + tid * 4;
        f32x4 acc0 = {0, 0, 0, 0}, acc1 = acc0, acc2 = acc0, acc3 = acc0;
#pragma unroll 8
        for (int k = 0; k < 64; ++k) { const f32x4 w = *(const f32x4*)(W + (size_t)k * 6144);
            acc0 += cond[k] * w; acc1 += cond[64 + k] * w; acc2 += cond[128 + k] * w; acc3 += cond[192 + k] * w; }
        float* macc = (float*)(ws + WS_MOD) + (size_t)l * 4 * 6144 + nc * 2048 + tid * 4;
#pragma unroll
        for (int i = 0; i < 4; ++i) { atomicAdd(macc + i, acc0[i]); atomicAdd(macc + 6144 + i, acc1[i]); atomicAdd(macc + 2 * 6144 + i, acc2[i]); atomicAdd(macc + 3 * 6144 + i, acc3[i]); }
        __syncthreads();
    }
    { LAS float* scr = (LAS float*)(lds + wave * 16384);
      const int gw = vcu * NWAVES + wave, NGW = G * NWAVES;
      constexpr int I_IN = 32 * (NIN / 32), I_OUT = 32 * 64, I_G = 32 * 8, NITEMS = 2 * (I_IN + I_OUT) + I_G;
      for (int it = gw; it < NITEMS; it += NGW) {
          int r = it;
          if (r < I_G) { const int mn = r >> 3, m = mn >> 3; const float* Wg = a.in[m == 0 ? 27 : m == 1 ? 29 : m == 2 ? 32 : 34] + (size_t)(mn & 7) * 128 * 128;
              p0_transpose_item(Wg, 128, 128, (bf16_t*)(ws + WS_WGT) + (size_t)mn * 128 * 128, 0, scr, r & 7, lane); continue; } r -= I_G;
          if (r < I_IN) { p0_transpose_item(a.in[5], 2048, NIN, (bf16_t*)(ws + WS_WIN0), 0, scr, r, lane); continue; } r -= I_IN;
          if (r < I_IN) { p0_transpose_item(a.in[17], 2048, NIN, (bf16_t*)(ws + WS_WIN1), 0, scr, r, lane); continue; } r -= I_IN;
          if (r < I_OUT) { p0_transpose_item(a.in[16], 2048, 2048, (bf16_t*)(ws + WS_WOUT0), 0, scr, r, lane); continue; } r -= I_OUT;
          p0_transpose_item(a.in[37], 2048, 2048, (bf16_t*)(ws + WS_WOUT1), 0, scr, r, lane);
      } }
}

__device__ __forceinline__ void normmod_phase(const Args& a, const float* xin, int layer, int gw, int NGW, int lane) {
    const float* nw = a.in[4] + layer * 2048; const float* bm = a.in[3] + layer * 6144;
    const float* macc = (const float*)(a.ws + WS_MOD) + (size_t)layer * 4 * 6144;
    bf16_t* H = (bf16_t*)(a.ws + WS_H);
    for (int m = gw; m < MTOK; m += NGW) {
        const int b = m >> 11;
        const f32x4* xr = (const f32x4*)(xin + (size_t)m * 2048) + lane;
        f32x4 v[8]; float s = 0.f;
#pragma unroll
        for (int j = 0; j < 8; ++j) { v[j] = xr[64 * j]; s += (v[j].x * v[j].x + v[j].y * v[j].y) + (v[j].z * v[j].z + v[j].w * v[j].w); }
        const float rstd = rsqrtf(group_sum<64>(s) * (1.f / 2048.f) + EPS);
#pragma unroll
        for (int j = 0; j < 8; ++j) { const int col = (64 * j + lane) * 4;
            const f32x4 w = *(const f32x4*)(nw + col);
            const f32x4 sh = *(const f32x4*)(macc + b * 6144 + col) + *(const f32x4*)(bm + col);
            const f32x4 sc = *(const f32x4*)(macc + b * 6144 + 2048 + col) + *(const f32x4*)(bm + 2048 + col);
            const f32x4 o = v[j] * rstd * w * (1.f + sc) + sh;
            v2u pk; pk.x = pk2(o.x, o.y); pk.y = pk2(o.z, o.w);
            *(v2u*)(H + (size_t)m * 2048 + col) = pk; }
    }
}

__device__ __forceinline__ void post0_phase(const Args& a, int gw, int NGW, int lane) {
    const bf16_t* P = (const bf16_t*)(a.ws + WS_PROJ);
    const float2* rope = (const float2*)(a.ws + WS_ROPE);
    const float* qn = a.in[6]; const float* kn = a.in[7]; const float* cw = a.in[8]; const float* cb = a.in[9];
    bf16_t* Q = (bf16_t*)(a.ws + WS_QB); bf16_t* K = (bf16_t*)(a.ws + WS_KB); bf16_t* V = (bf16_t*)(a.ws + WS_VB);
    float* ACT = (float*)(a.ws + WS_ACT);
    for (int m = gw; m < MTOK; m += NGW) {
        const int t = m & 2047, prow = t >> 6, pcol = t & 63;
        const bf16_t* pr = P + (size_t)m * NINP;
        {
            float x[16]; unpack8(*(const v4u*)(pr + A_Q + lane * 16), x); unpack8(*(const v4u*)(pr + A_Q + lane * 16 + 8), x + 8);
            float ss = 0.f;
#pragma unroll
            for (int i = 0; i < 16; ++i) ss += x[i] * x[i];
            ss = group_sum<8>(ss);
            const float r = rsqrtf(ss * (1.f / 128.f) + EPS);
            const int d0 = (lane & 7) * 16;
#pragma unroll
            for (int i = 0; i < 16; ++i) x[i] = x[i] * r * qn[d0 + i];
#pragma unroll
            for (int pi = 0; pi < 8; ++pi) { const int p = (d0 >> 1) + pi; const float2 cs = (p < 32) ? rope[prow * 32 + p] : rope[pcol * 32 + p - 32];
                const float x0 = x[2 * pi], x1 = x[2 * pi + 1]; x[2 * pi] = x0 * cs.x - x1 * cs.y; x[2 * pi + 1] = x0 * cs.y + x1 * cs.x; }
            *(v4u*)(Q + (size_t)m * 1024 + lane * 16) = pack8(x); *(v4u*)(Q + (size_t)m * 1024 + lane * 16 + 8) = pack8(x + 8);
        }
        {
            const v2u w = *(const v2u*)(pr + A_K + lane * 4);
            float x[4] = {__uint_as_float(w.x << 16), __uint_as_float(w.x & 0xffff0000u), __uint_as_float(w.y << 16), __uint_as_float(w.y & 0xffff0000u)};
            float ss = (x[0] * x[0] + x[1] * x[1]) + (x[2] * x[2] + x[3] * x[3]);
            ss = group_sum<32>(ss);
            const float r = rsqrtf(ss * (1.f / 128.f) + EPS);
            const int d0 = (lane & 31) * 4;
#pragma unroll
            for (int i = 0; i < 4; ++i) x[i] = x[i] * r * kn[d0 + i];
#pragma unroll
            for (int pi = 0; pi < 2; ++pi) { const int p = (d0 >> 1) + pi; const float2 cs = (p < 32) ? rope[prow * 32 + p] : rope[pcol * 32 + p - 32];
                const float x0 = x[2 * pi], x1 = x[2 * pi + 1]; x[2 * pi] = x0 * cs.x - x1 * cs.y; x[2 * pi + 1] = x0 * cs.y + x1 * cs.x; }
            v2u o; o.x = pk2(x[0], x[1]); o.y = pk2(x[2], x[3]);
            *(v2u*)(K + (size_t)m * 256 + lane * 4) = o;
            *(v2u*)(V + (size_t)m * 256 + lane * 4) = *(const v2u*)(pr + A_V + lane * 4);
        }
#pragma unroll
        for (int j = 0; j < 3; ++j) { const int ch = (j * 64 + lane) * 8;
            float acc[8];
            { const f32x4 b0 = *(const f32x4*)(cb + ch), b1 = *(const f32x4*)(cb + ch + 4); acc[0] = b0.x; acc[1] = b0.y; acc[2] = b0.z; acc[3] = b0.w; acc[4] = b1.x; acc[5] = b1.y; acc[6] = b1.z; acc[7] = b1.w; }
#pragma unroll
            for (int d = 0; d < 4; ++d) { const int ts = t + d - 2;
                if (ts >= 0 && ts < SEQ) { float x[8]; unpack8(*(const v4u*)(P + (size_t)(m + d - 2) * NINP + A_XS + ch), x);
                    const f32x4 w0 = *(const f32x4*)(cw + d * 1536 + ch), w1 = *(const f32x4*)(cw + d * 1536 + ch + 4);
                    acc[0] += w0.x * x[0]; acc[1] += w0.y * x[1]; acc[2] += w0.z * x[2]; acc[3] += w0.w * x[3];
                    acc[4] += w1.x * x[4]; acc[5] += w1.y * x[5]; acc[6] += w1.z * x[6]; acc[7] += w1.w * x[7]; } }
            f32x4 o0, o1; o0.x = silu_f(acc[0]); o0.y = silu_f(acc[1]); o0.z = silu_f(acc[2]); o0.w = silu_f(acc[3]); o1.x = silu_f(acc[4]); o1.y = silu_f(acc[5]); o1.z = silu_f(acc[6]); o1.w = silu_f(acc[7]);
            *(f32x4*)(ACT + (size_t)m * 1536 + ch) = o0; *(f32x4*)(ACT + (size_t)m * 1536 + ch + 4) = o1; }
    }
}

typedef float f32x2 __attribute__((ext_vector_type(2)));
__device__ __forceinline__ void ssd_item(const Args& a, int item, float* lds) {
    const int ph = item & 1, h = (item >> 1) & 15, dir = (item >> 5) & 1, b = item >> 6, g = h >> 3;
    constexpr int BUF = 32 * 32 + 2 * 32 * 128 + 32;
    float* ysb = lds + 2 * BUF;
    const float A = -expf(a.in[dir ? 13 : 12][h]); const float dtb = a.in[dir ? 11 : 10][h];
    const float* ACT = (const float*)(a.ws + WS_ACT); const float* SM = (const float*)(a.ws + WS_SMALL);
    float* Y = (float*)(a.ws + (dir ? WS_YB : WS_YF));
    const int tid = threadIdx.x, p = tid >> 4, ng = tid & 15;
    f32x2 hst[4];
#pragma unroll
    for (int i = 0; i < 4; ++i) hst[i] = (f32x2){0.f, 0.f};
    f32x4 gB[2], gC[2], gx; float gdt;
#define SSD_LOAD(tile_) do { const size_t r0_ = (size_t)b * SEQ + (dir ? 63 - (tile_) : (tile_)) * 32; \
        _Pragma("unroll") for (int i = 0; i < 2; ++i) { const int idx = tid + i * 512, s_ = idx >> 5, c4_ = idx & 31, tl_ = dir ? 31 - s_ : s_; \
            gB[i] = *(const f32x4*)(ACT + (r0_ + tl_) * 1536 + 1024 + g * 128 + c4_ * 4); gC[i] = *(const f32x4*)(ACT + (r0_ + tl_) * 1536 + 1280 + g * 128 + c4_ * 4); } \
        if (tid < 256) { const int s_ = tid >> 3, c4_ = tid & 7, tl_ = dir ? 31 - s_ : s_; gx = *(const f32x4*)(ACT + (r0_ + tl_) * 1536 + h * 64 + ph * 32 + c4_ * 4); gdt = SM[(r0_ + tl_) * 32 + dir * 16 + h]; } } while (0)
#define SSD_STORE(buf_) do { float* xs_ = lds + (buf_) * BUF; float* Bs_ = xs_ + 32 * 32; float* Cs_ = Bs_ + 32 * 128; float* das_ = Cs_ + 32 * 128; \
        _Pragma("unroll") for (int i = 0; i < 2; ++i) { const int idx = tid + i * 512, s_ = idx >> 5, c4_ = idx & 31; const int so_ = s_ * 128 + (c4_ & 1) * 64 + (c4_ >> 1) * 4; \
            *(f32x4*)(Bs_ + so_) = gB[i]; *(f32x4*)(Cs_ + so_) = gC[i]; } \
        if (tid < 256) { const int s_ = tid >> 3, c4_ = tid & 7; const float dt_ = softplus_f(gdt + dtb); *(f32x4*)(xs_ + s_ * 32 + c4_ * 4) = gx * dt_; if (c4_ == 0) das_[s_] = expf(dt_ * A); } } while (0)
    __syncthreads();
    SSD_LOAD(0); SSD_STORE(0);
    __syncthreads();
    for (int tile = 0; tile < 64; ++tile) {
        const int cur = tile & 1;
        const size_t row0 = (size_t)b * SEQ + (dir ? 63 - tile : tile) * 32;
        if (tile + 1 < 64) SSD_LOAD(tile + 1);
        const float* xs = lds + cur * BUF; const float* Bs = xs + 32 * 32; const float* Cs = Bs + 32 * 128; const float* das = Cs + 32 * 128; float* ys = ysb + cur * 1024;
        {
            float n_dA = das[0], n_xdt = xs[p];
            f32x4 n_b0 = *(const f32x4*)(Bs + ng * 4), n_b1 = *(const f32x4*)(Bs + 64 + ng * 4), n_c0 = *(const f32x4*)(Cs + ng * 4), n_c1 = *(const f32x4*)(Cs + 64 + ng * 4);
#pragma unroll 4
            for (int s = 0; s < 32; ++s) {
                const float dA = n_dA, xdt = n_xdt; const f32x4 b0 = n_b0, b1 = n_b1, c0 = n_c0, c1 = n_c1;
                const int sn = (s + 1) & 31;
                n_dA = das[sn]; n_xdt = xs[sn * 32 + p];
                n_b0 = *(const f32x4*)(Bs + sn * 128 + ng * 4); n_b1 = *(const f32x4*)(Bs + sn * 128 + 64 + ng * 4);
                n_c0 = *(const f32x4*)(Cs + sn * 128 + ng * 4); n_c1 = *(const f32x4*)(Cs + sn * 128 + 64 + ng * 4);
                const f32x2 xd2 = (f32x2){xdt, xdt}, da2 = (f32x2){dA, dA};
                hst[0] = hst[0] * da2 + xd2 * (f32x2){b0.x, b0.y};
                hst[1] = hst[1] * da2 + xd2 * (f32x2){b0.z, b0.w};
                hst[2] = hst[2] * da2 + xd2 * (f32x2){b1.x, b1.y};
                hst[3] = hst[3] * da2 + xd2 * (f32x2){b1.z, b1.w};
                f32x2 acc = hst[0] * (f32x2){c0.x, c0.y};
                acc += hst[1] * (f32x2){c0.z, c0.w};
                acc += hst[2] * (f32x2){c1.x, c1.y};
                acc += hst[3] * (f32x2){c1.z, c1.w};
                const float part = group_sum<16>(acc.x + acc.y);
                if (ng == 0) ys[s * 32 + p] = part;
            }
        }
        if (tile + 1 < 64) SSD_STORE(cur ^ 1);
        __syncthreads();
        if (tid < 256) { const int s = tid >> 3, c4 = tid & 7, tl = dir ? 31 - s : s; *(f32x4*)(Y + (row0 + tl) * 1024 + h * 64 + ph * 32 + c4 * 4) = *(const f32x4*)(ys + s * 32 + c4 * 4); }
    }
#undef SSD_LOAD
#undef SSD_STORE
}

__device__ __forceinline__ void ssd_combine_phase(const Args& a, int gw, int NGW, int lane) {
    const float* YF = (const float*)(a.ws + WS_YF); const float* YB = (const float*)(a.ws + WS_YB); const float* ACT = (const float*)(a.ws + WS_ACT);
    const bf16_t* P = (const bf16_t*)(a.ws + WS_PROJ); bf16_t* YC = (bf16_t*)(a.ws + WS_YCAT);
    const float* dsk = a.in[14]; const float* nw = a.in[15];
    for (int m = gw; m < MTOK; m += NGW) {
        const int ch = lane * 16; const float dk = dsk[ch >> 6];
        float z[16], gv[16]; unpack8(*(const v4u*)(P + (size_t)m * NINP + A_Z + ch), z); unpack8(*(const v4u*)(P + (size_t)m * NINP + A_Z + ch + 8), z + 8);
        float ss = 0.f;
#pragma unroll
        for (int q = 0; q < 4; ++q) { const f32x4 f = *(const f32x4*)(YF + (size_t)m * 1024 + ch + 4 * q), bk = *(const f32x4*)(YB + (size_t)m * 1024 + ch + 4 * q), xv = *(const f32x4*)(ACT + (size_t)m * 1536 + ch + 4 * q);
            const f32x4 y = f + bk + dk * xv;
            gv[4 * q] = y.x * silu_f(z[4 * q]); gv[4 * q + 1] = y.y * silu_f(z[4 * q + 1]); gv[4 * q + 2] = y.z * silu_f(z[4 * q + 2]); gv[4 * q + 3] = y.w * silu_f(z[4 * q + 3]); }
#pragma unroll
        for (int i = 0; i < 16; ++i) ss += gv[i] * gv[i];
        const float r = rsqrtf(group_sum<64>(ss) * (1.f / 1024.f) + EPS);
#pragma unroll
        for (int i = 0; i < 16; ++i) gv[i] = gv[i] * r * nw[ch + i];
        *(v4u*)(YC + (size_t)m * 2048 + 1024 + ch) = pack8(gv); *(v4u*)(YC + (size_t)m * 2048 + 1024 + ch + 8) = pack8(gv + 8);
    }
}

__device__ __forceinline__ void post1_phase(const Args& a, int gw, int NGW, int lane) {
    const bf16_t* P = (const bf16_t*)(a.ws + WS_PROJ); const float* cw = a.in[18]; const float* cb = a.in[19];
    float* ACT = (float*)(a.ws + WS_ACT);
    for (int m = gw; m < MTOK; m += NGW) {
        const int t = m & 2047;
#pragma unroll
        for (int j = 0; j < 4; ++j) { const int ch = (j * 64 + lane) * 8;
            float acc[8];
            { const f32x4 b0 = *(const f32x4*)(cb + ch), b1 = *(const f32x4*)(cb + ch + 4); acc[0] = b0.x; acc[1] = b0.y; acc[2] = b0.z; acc[3] = b0.w; acc[4] = b1.x; acc[5] = b1.y; acc[6] = b1.z; acc[7] = b1.w; }
#pragma unroll
            for (int d = 0; d < 4; ++d) { const int ts = t + d - 2;
                if (ts >= 0 && ts < SEQ) { float x[8]; unpack8(*(const v4u*)(P + (size_t)(m + d - 2) * NINP + C_Q + ch), x);
                    const f32x4 w0 = *(const f32x4*)(cw + d * 2048 + ch), w1 = *(const f32x4*)(cw + d * 2048 + ch + 4);
                    acc[0] += w0.x * x[0]; acc[1] += w0.y * x[1]; acc[2] += w0.z * x[2]; acc[3] += w0.w * x[3];
                    acc[4] += w1.x * x[4]; acc[5] += w1.y * x[5]; acc[6] += w1.z * x[6]; acc[7] += w1.w * x[7]; } }
#pragma unroll
            for (int i = 0; i < 8; ++i) acc[i] = silu_f(acc[i]);
            if (j < 2) {
                float ss = 0.f;
#pragma unroll
                for (int i = 0; i < 8; ++i) ss += acc[i] * acc[i];
                ss = group_sum<16>(ss);
                float r = rsqrtf(ss + EPS); if (j == 0) r *= 0.088388347648318440f;
#pragma unroll
                for (int i = 0; i < 8; ++i) acc[i] *= r;
            }
            *(f32x4*)(ACT + (size_t)m * 2048 + ch) = (f32x4){acc[0], acc[1], acc[2], acc[3]}; *(f32x4*)(ACT + (size_t)m * 2048 + ch + 4) = (f32x4){acc[4], acc[5], acc[6], acc[7]}; }
    }
}

__device__ __forceinline__ void gdn_item(const Args& a, int item, float* lds) {
    const int dvs = item & 3, hv = (item >> 2) & 7, dir = (item >> 5) & 1, b = item >> 6, hq = hv >> 1;
    constexpr int BUF = 2 * 32 * 128 + 32 * 32 + 32 * 4;
    float* osb = lds + 2 * BUF;
    const float Aneg = -expf(a.in[dir ? 21 : 20][hv]); const float dtb = a.in[dir ? 23 : 22][hv];
    const float* ACT = (const float*)(a.ws + WS_ACT); const float* SM = (const float*)(a.ws + WS_SMALL);
    float* O = (float*)(a.ws + (dir ? WS_YB : WS_YF));
    const int tid = threadIdx.x, lane = tid & 63, wave = tid >> 6, dkg = lane & 15, dvi = wave * 4 + (lane >> 4);
    f32x2 S[4];
#pragma unroll
    for (int i = 0; i < 4; ++i) S[i] = (f32x2){0.f, 0.f};
    f32x4 gk0, gk1, gq0, gq1, gv; float gbr = 0.f, gar = 0.f;
#define GDN_LOAD(tile_) do { const size_t r0_ = (size_t)b * SEQ + (dir ? 63 - (tile_) : (tile_)) * 32; \
        { const int s_ = tid >> 4, c8_ = tid & 15, tl_ = dir ? 31 - s_ : s_; const float* kp_ = ACT + (r0_ + tl_) * 2048 + 512 + hq * 128 + c8_ * 8; const float* qp_ = ACT + (r0_ + tl_) * 2048 + hq * 128 + c8_ * 8; \
          gk0 = *(const f32x4*)kp_; gk1 = *(const f32x4*)(kp_ + 4); gq0 = *(const f32x4*)qp_; gq1 = *(const f32x4*)(qp_ + 4); \
          if (c8_ == 0) { const float* sm_ = SM + (r0_ + tl_) * 32; gbr = sm_[dir * 8 + hv]; gar = sm_[16 + dir * 8 + hv]; } } \
        if (tid < 256) { const int s2_ = tid >> 3, c4_ = tid & 7, tl2_ = dir ? 31 - s2_ : s2_; gv = *(const f32x4*)(ACT + (r0_ + tl2_) * 2048 + 1024 + hv * 128 + dvs * 32 + c4_ * 4); } } while (0)
#define GDN_STORE(buf_) do { float* ks_ = lds + (buf_) * BUF; float* qs_ = ks_ + 32 * 128; float* vs_ = qs_ + 32 * 128; float* sc_ = vs_ + 32 * 32; \
        { const int s_ = tid >> 4, c8_ = tid & 15; \
          *(f32x4*)(ks_ + s_ * 128 + c8_ * 4) = gk0; *(f32x4*)(ks_ + s_ * 128 + 64 + c8_ * 4) = gk1; *(f32x4*)(qs_ + s_ * 128 + c8_ * 4) = gq0; *(f32x4*)(qs_ + s_ * 128 + 64 + c8_ * 4) = gq1; \
          float kq_ = (gk0.x * gq0.x + gk0.y * gq0.y) + (gk0.z * gq0.z + gk0.w * gq0.w) + (gk1.x * gq1.x + gk1.y * gq1.y) + (gk1.z * gq1.z + gk1.w * gq1.w); \
          kq_ = group_sum<16>(kq_); \
          if (c8_ == 0) { const float beta_ = sigmoid_f(gbr), alpha_ = expf(Aneg * softplus_f(gar + dtb)); *(f32x4*)(sc_ + s_ * 4) = (f32x4){alpha_, beta_, kq_, alpha_ * beta_}; } } \
        if (tid < 256) { const int s2_ = tid >> 3, c4_ = tid & 7; *(f32x4*)(vs_ + s2_ * 32 + c4_ * 4) = gv; } } while (0)
    __syncthreads();
    GDN_LOAD(0); GDN_STORE(0);
    __syncthreads();
    for (int tile = 0; tile < 64; ++tile) {
        const int cur = tile & 1;
        const size_t row0 = (size_t)b * SEQ + (dir ? 63 - tile : tile) * 32;
        if (tile + 1 < 64) GDN_LOAD(tile + 1);
        const float* ks = lds + cur * BUF; const float* qs = ks + 32 * 128; const float* vs = qs + 32 * 128; const float* sc = vs + 32 * 32; float* os = osb + cur * 1024;
        {
            f32x4 n_k0 = *(const f32x4*)(ks + dkg * 4), n_k1 = *(const f32x4*)(ks + 64 + dkg * 4), n_q0 = *(const f32x4*)(qs + dkg * 4), n_q1 = *(const f32x4*)(qs + 64 + dkg * 4);
            f32x4 n_sc = *(const f32x4*)(sc); float n_vv = vs[dvi];
#pragma unroll 4
            for (int s = 0; s < 32; ++s) {
                const f32x4 k0 = n_k0, k1 = n_k1, q0 = n_q0, q1 = n_q1, scv = n_sc; const float vv = n_vv;
                const int sn = (s + 1) & 31;
                n_k0 = *(const f32x4*)(ks + sn * 128 + dkg * 4); n_k1 = *(const f32x4*)(ks + sn * 128 + 64 + dkg * 4);
                n_q0 = *(const f32x4*)(qs + sn * 128 + dkg * 4); n_q1 = *(const f32x4*)(qs + sn * 128 + 64 + dkg * 4);
                n_sc = *(const f32x4*)(sc + sn * 4); n_vv = vs[sn * 32 + dvi];
                const f32x2 ka = (f32x2){k0.x, k0.y}, kb = (f32x2){k0.z, k0.w}, kc = (f32x2){k1.x, k1.y}, kd = (f32x2){k1.z, k1.w};
                f32x2 pk = ka * S[0]; pk += kb * S[1]; pk += kc * S[2]; pk += kd * S[3];
                f32x2 pq = (f32x2){q0.x, q0.y} * S[0]; pq += (f32x2){q0.z, q0.w} * S[1]; pq += (f32x2){q1.x, q1.y} * S[2]; pq += (f32x2){q1.z, q1.w} * S[3];
                float sk = pk.x + pk.y, sq = pq.x + pq.y;
                sk += dpp_mov<0xB1>(sk); sq += dpp_mov<0xB1>(sq);
                sk += dpp_mov<0x4E>(sk); sq += dpp_mov<0x4E>(sq);
                sk += dpp_mov<0x141>(sk); sq += dpp_mov<0x141>(sq);
                sk += dpp_mov<0x140>(sk); sq += dpp_mov<0x140>(sq);
                const float alpha = scv.x, vn = fmaf(-scv.w, sk, scv.y * vv);
                const float po = fmaf(alpha, sq, scv.z * vn);
                const f32x2 al2 = (f32x2){alpha, alpha}, vn2 = (f32x2){vn, vn};
                S[0] = S[0] * al2 + ka * vn2; S[1] = S[1] * al2 + kb * vn2; S[2] = S[2] * al2 + kc * vn2; S[3] = S[3] * al2 + kd * vn2;
                if (dkg == 0) os[s * 32 + dvi] = po;
            }
        }
        if (tile + 1 < 64) GDN_STORE(cur ^ 1);
        __syncthreads();
        if (tid < 256) { const int s2 = tid >> 3, c4 = tid & 7, tl2 = dir ? 31 - s2 : s2; *(f32x4*)(O + (row0 + tl2) * 1024 + hv * 128 + dvs * 32 + c4 * 4) = *(const f32x4*)(os + s2 * 32 + c4 * 4); }
    }
#undef GDN_LOAD
#undef GDN_STORE
}

typedef short bf16x8_t __attribute__((ext_vector_type(8)));
typedef float f32x16_t __attribute__((ext_vector_type(16)));
__device__ __forceinline__ void lru_tile(const Args& a, int item, unsigned char* lds, int pass) {
    const int n = item & 7, tc = (item >> 3) & 63, b = item >> 9, t0 = tc * 32;
    float* xc = (float*)lds; bf16_t* xcb = (bf16_t*)(lds + 16384); float* As = (float*)(lds + 25088); float* Us = As + 2 * 32 * 128; float2* sg = (float2*)(Us + 2 * 32 * 128);
    const int tid = threadIdx.x, lane = tid & 63, wave = tid >> 6;
    const bf16_t* P = (const bf16_t*)(a.ws + WS_PROJ);
    __syncthreads();
    {
        const int j = tid & 127, tg = tid >> 7, chn = n * 128 + j; const float* cw = a.in[25];
        const float w0 = cw[chn], w1 = cw[1024 + chn], w2 = cw[2048 + chn], w3 = cw[3072 + chn], cbias = a.in[26][chn];
        const int tb = t0 + tg * 8;
        const bf16_t* pp = P + ((size_t)b * SEQ + tb) * NINP + C_XL + chn;
        float xm2 = (tb >= 2) ? bf2f(pp[-2 * NINP]) : 0.f, xm1 = (tb >= 1) ? bf2f(pp[-NINP]) : 0.f, x0 = bf2f(pp[0]);
#pragma unroll
        for (int i = 0; i < 8; ++i) { const float xp1 = (tb + i + 1 < SEQ) ? bf2f(pp[(i + 1) * NINP]) : 0.f;
            const float acc = cbias + w0 * xm2 + w1 * xm1 + w2 * x0 + w3 * xp1;
            xc[(tg * 8 + i) * 128 + j] = acc; xcb[(tg * 8 + i) * 136 + j] = (bf16_t)f2bf(acc);
            xm2 = xm1; xm1 = x0; x0 = xp1; }
    }
    __syncthreads();
    {
        const int ct = wave & 3, d = wave >> 2, r32 = lane & 31, hi = lane >> 5;
        const bf16_t* WT = (const bf16_t*)(a.ws + WS_WGT);
        const bf16_t* wa_p = WT + ((size_t)((2 * d) * 8 + n) * 128 + ct * 32 + r32) * 128 + hi * 8;
        const bf16_t* wx_p = WT + ((size_t)((2 * d + 1) * 8 + n) * 128 + ct * 32 + r32) * 128 + hi * 8;
        f32x16_t ca, cx;
#pragma unroll
        for (int r = 0; r < 16; ++r) { ca[r] = 0.f; cx[r] = 0.f; }
#pragma unroll
        for (int s = 0; s < 8; ++s) {
            const bf16x8_t af = *(const bf16x8_t*)((const char*)xcb + r32 * 272 + (s * 16 + hi * 8) * 2);
            const bf16x8_t fa = *(const bf16x8_t*)(wa_p + s * 16); const bf16x8_t fx = *(const bf16x8_t*)(wx_p + s * 16);
            ca = __builtin_amdgcn_mfma_f32_32x32x16_bf16(af, fa, ca, 0, 0, 0); cx = __builtin_amdgcn_mfma_f32_32x32x16_bf16(af, fx, cx, 0, 0, 0);
        }
        const int j = ct * 32 + r32, cj = n * 128 + j;
        const float baj = a.in[d ? 33 : 28][cj], bxj = a.in[d ? 35 : 30][cj], sp = softplus_f(-a.in[d ? 36 : 31][cj]);
#pragma unroll
        for (int r = 0; r < 16; ++r) { const int t = (r & 3) + 8 * (r >> 2) + 4 * hi;
            const float rg = sigmoid_f(ca[r] + baj), ig = sigmoid_f(cx[r] + bxj); const float la = -8.f * rg * sp;
            As[(d * 32 + t) * 128 + j] = expf(la); Us[(d * 32 + t) * 128 + j] = sqrtf(-expm1f(2.f * la)) * (ig * xc[t * 128 + j]); }
    }
    __syncthreads();
    {
        const int j = tid & 127, d = (tid >> 7) & 1, seg = tid >> 8;
        float Pp = 1.f, H = 0.f;
#pragma unroll
        for (int k = 0; k < 16; ++k) { const int q = seg * 16 + k, t = d ? 31 - q : q; const float a_ = As[(d * 32 + t) * 128 + j], u_ = Us[(d * 32 + t) * 128 + j]; H = fmaf(a_, H, u_); Pp *= a_; }
        sg[(d * 2 + seg) * 128 + j] = make_float2(Pp, H);
        __syncthreads();
        float2* LS = (float2*)(a.ws + WS_LSUM);
        if (pass == 0) {
            if (seg == 0) { const float2 s1 = sg[(d * 2 + 1) * 128 + j]; LS[((size_t)(d * 4 + b) * 64 + tc) * 1024 + n * 128 + j] = make_float2(Pp * s1.x, fmaf(s1.x, H, s1.y)); }
        } else {
            float c = 0.f;
            const float2* lsp = LS + ((size_t)(d * 4 + b) * 64) * 1024 + n * 128 + j;
            if (d == 0) { for (int cc = 0; cc < tc; ++cc) { const float2 s = lsp[(size_t)cc * 1024]; c = fmaf(s.x, c, s.y); } }
            else { for (int cc = 63; cc > tc; --cc) { const float2 s = lsp[(size_t)cc * 1024]; c = fmaf(s.x, c, s.y); } }
            if (seg == 1) { const float2 s0 = sg[(d * 2) * 128 + j]; c = fmaf(s0.x, c, s0.y); }
            float h = c;
#pragma unroll
            for (int k = 0; k < 16; ++k) { const int q = seg * 16 + k, t = d ? 31 - q : q; const float a_ = As[(d * 32 + t) * 128 + j], u_ = Us[(d * 32 + t) * 128 + j]; h = fmaf(a_, h, u_); Us[(d * 32 + t) * 128 + j] = h; }
            __syncthreads();
            bf16_t* YC = (bf16_t*)(a.ws + WS_YCAT);
            const int jj = tid & 127, tg = tid >> 7;
#pragma unroll
            for (int i = 0; i < 8; ++i) { const int t = tg * 8 + i; const size_t row = (size_t)b * SEQ + t0 + t;
                const float hs = Us[t * 128 + jj] + Us[(32 + t) * 128 + jj]; const float gl = bf2f(P[row * NINP + C_GL + n * 128 + jj]);
                YC[row * 2048 + 1024 + n * 128 + jj] = (bf16_t)f2bf(hs * silu_f(gl)); }
        }
    }
}

__device__ __forceinline__ void combine1_phase(const Args& a, int gw, int NGW, int lane) {
    const float* OF = (const float*)(a.ws + WS_YF); const float* OB = (const float*)(a.ws + WS_YB);
    const bf16_t* P = (const bf16_t*)(a.ws + WS_PROJ); bf16_t* YC = (bf16_t*)(a.ws + WS_YCAT);
    const float* gn = a.in[24];
    for (int m = gw; m < MTOK; m += NGW) {
        const int ch = lane * 16, d0 = ch & 127;
        float z[16], ov[16];
        unpack8(*(const v4u*)(P + (size_t)m * NINP + C_Z + ch), z); unpack8(*(const v4u*)(P + (size_t)m * NINP + C_Z + ch + 8), z + 8);
#pragma unroll
        for (int q = 0; q < 4; ++q) { const f32x4 f = *(const f32x4*)(OF + (size_t)m * 1024 + ch + 4 * q), bk = *(const f32x4*)(OB + (size_t)m * 1024 + ch + 4 * q); const f32x4 o = f + bk;
            ov[4 * q] = o.x; ov[4 * q + 1] = o.y; ov[4 * q + 2] = o.z; ov[4 * q + 3] = o.w; }
        float ss = 0.f;
#pragma unroll
        for (int i = 0; i < 16; ++i) ss += ov[i] * ov[i];
        ss = group_sum<8>(ss);
        const float r = rsqrtf(ss * (1.f / 128.f) + EPS);
#pragma unroll
        for (int i = 0; i < 16; ++i) ov[i] = ov[i] * r * gn[d0 + i] * silu_f(z[i]);
        *(v4u*)(YC + (size_t)m * 2048 + ch) = pack8(ov); *(v4u*)(YC + (size_t)m * 2048 + ch + 8) = pack8(ov + 8);
    }
}

__device__ __forceinline__ void final_norm_phase(const Args& a, int gw, int NGW, int lane) {
    const float* nw = a.in[38];
    for (int m = gw; m < MTOK; m += NGW) {
        f32x4* xr = (f32x4*)(a.out + (size_t)m * 2048) + lane;
        f32x4 v[8]; float s = 0.f;
#pragma unroll
        for (int j = 0; j < 8; ++j) { v[j] = xr[64 * j]; s += (v[j].x * v[j].x + v[j].y * v[j].y) + (v[j].z * v[j].z + v[j].w * v[j].w); }
        const float rstd = rsqrtf(group_sum<64>(s) * (1.f / 2048.f) + EPS);
#pragma unroll
        for (int j = 0; j < 8; ++j) { const f32x4 w = *(const f32x4*)(nw + (64 * j + lane) * 4); xr[64 * j] = v[j] * rstd * w; }
    }
}

typedef GAS unsigned gu32;
#define RLX_AGENT __ATOMIC_RELAXED, __HIP_MEMORY_SCOPE_AGENT
constexpr int CW_BAR = 4096;
constexpr int MISC_OFF = 131072 + 320;
#define XB_TMO      128
#define XB_XCNT(j)  (256  + 64 * (j))
#define XB_XSUB(j)  (1280 + 64 * (j))
#define XB_XGEN(j)  (2304 + 64 * (j))
#define XB_TOP      3328
#define XB_TOPGEN   3392
#define XCD_BAR_WORDS 3456
#define XB_SPIN_CAP (1u << 18)

__device__ __forceinline__ unsigned xb_ld(unsigned* p)              { return __hip_atomic_load(p, __ATOMIC_RELAXED, __HIP_MEMORY_SCOPE_AGENT); }
__device__ __forceinline__ unsigned xb_add(unsigned* p, unsigned v) { return __hip_atomic_fetch_add(p, v, __ATOMIC_RELAXED, __HIP_MEMORY_SCOPE_AGENT); }
__device__ __forceinline__ unsigned xb_xcc_id() { return (unsigned)__builtin_amdgcn_s_getreg((3 << 11) | 20) & 0xFu; }
#define XB_SPIN(cond, bar) do { unsigned _sp = 0; while (cond) { __builtin_amdgcn_s_sleep(1); \
    if ((++_sp & 255u) == 0u) { if (xb_ld(&(bar)[XB_TMO])) break; if (_sp > XB_SPIN_CAP) { atomicAdd(&(bar)[XB_TMO], 1u); break; } } } } while (0)

struct XcdBarrier {
    unsigned* bar; unsigned x;
    volatile LAS unsigned* st;
};

__device__ __forceinline__ XcdBarrier xcd_barrier_post(unsigned* bar, volatile LAS unsigned* st) {
    XcdBarrier b; b.bar = bar; b.x = xb_xcc_id(); b.st = st;
    if (threadIdx.x == 0) (void)xb_add(&bar[XB_XCNT(b.x)], 1u);
    return b;
}
__device__ __forceinline__ void xcd_barrier_complete(unsigned* bar, unsigned x, unsigned& nloc, unsigned& nx) {
    const unsigned G = gridDim.x * gridDim.y * gridDim.z;
    unsigned sum, cnt, mine, sp = 0u;
    for (;;) {
        sum = 0u; cnt = 0u; mine = 0u;
#pragma unroll
        for (unsigned j = 0; j < 16; ++j) { const unsigned c = xb_ld(&bar[XB_XCNT(j)]); sum += c; cnt += (c > 0u) ? 1u : 0u; mine = (j == x) ? c : mine; }
        if (sum == G) break;
        __builtin_amdgcn_s_sleep(1);
        if ((++sp & 255u) == 0u) { if (xb_ld(&bar[XB_TMO])) break; if (sp > XB_SPIN_CAP) { atomicAdd(&bar[XB_TMO], 1u); break; } }
    }
    nloc = mine > 0u ? mine : 1u; nx = cnt > 0u ? cnt : 1u;
}

__device__ __forceinline__ void xcd_barrier(const XcdBarrier& b) {
    asm volatile("s_waitcnt vmcnt(0)" ::: "memory");
    __syncthreads();
    if (threadIdx.x == 0) {
        unsigned* bar = b.bar;
        __builtin_amdgcn_s_waitcnt(0);
        unsigned nloc = b.st[0], nx = b.st[1];
        if (nloc == 0u) { xcd_barrier_complete(bar, b.x, nloc, nx); b.st[0] = nloc; b.st[1] = nx; }
        const unsigned old = xb_add(&bar[XB_XSUB(b.x)], 1u);
        const unsigned gen = old / nloc;
        if (old + 1u == (gen + 1u) * nloc) {
            __builtin_amdgcn_fence(__ATOMIC_RELEASE, "agent");
            asm volatile("s_waitcnt vmcnt(0)" ::: "memory");
            const unsigned og = xb_add(&bar[XB_TOP], 1u);
            const unsigned tg = og / nx;
            if (og + 1u == (tg + 1u) * nx) xb_add(&bar[XB_TOPGEN], 1u);
            else XB_SPIN(xb_ld(&bar[XB_TOPGEN]) == tg, bar);
            __builtin_amdgcn_fence(__ATOMIC_ACQUIRE, "agent");
            xb_add(&bar[XB_XGEN(b.x)], 1u);
            asm volatile("s_waitcnt vmcnt(0)" ::: "memory");
        } else {
            XB_SPIN(xb_ld(&bar[XB_XGEN(b.x)]) == gen, bar);
            __builtin_amdgcn_fence(__ATOMIC_ACQUIRE, "agent");
            asm volatile("s_waitcnt vmcnt(0)" ::: "memory");
        }
    }
    __syncthreads();
}

#ifndef PROBE_SSD
#define PROBE_SSD 0
#endif
#ifndef PROBE_GDN
#define PROBE_GDN 0
#endif
#ifndef PROBE_LRU
#define PROBE_LRU 0
#endif
#ifndef MK_SINGLE
#define MK_SINGLE 1
#endif
__global__ void __launch_bounds__(NTHREADS, 2) mk_fwd(Args a) {
    extern __shared__ __attribute__((aligned(16))) unsigned char lds[];
    LAS unsigned char* ldsl = (LAS unsigned char*)lds;
    const int tid = threadIdx.x, lane = tid & 63, wave = __builtin_amdgcn_readfirstlane(tid >> 6);
    const int G = gridDim.x, bx = blockIdx.x;
    const int vcu = (G % 8 == 0) ? (bx % 8) * (G / 8) + bx / 8 : bx;
    const int gw = vcu * NWAVES + wave, NGW = G * NWAVES;
    unsigned char* ws = a.ws;
    volatile LAS unsigned* MISC = (volatile LAS unsigned*)(ldsl + MISC_OFF);
    if (tid < 32) MISC[tid] = 0u;
    __syncthreads();
    XcdBarrier bar; bar.bar = (unsigned*)(ws + WS_CTL) + CW_BAR; bar.x = 0; bar.st = nullptr;
    if (a.ph_hi - a.ph_lo > 1) bar = xcd_barrier_post((unsigned*)(ws + WS_CTL) + CW_BAR, MISC + 8);
#define IN(k) (a.ph_lo <= (k) && (k) < a.ph_hi)
#define SEAM(k) do { if (IN(k) && IN((k) + 1)) { xcd_barrier(bar); } } while (0)

    if (IN(0)) { p0_prologue(a, ldsl, vcu, G); } SEAM(0);
    if (IN(1)) { normmod_phase(a, a.in[0], 0, gw, NGW, lane); } SEAM(1);
    if (IN(2)) {
        pg8::Gemm g{(const bf16_t*)(ws + WS_H), (const bf16_t*)(ws + WS_WIN0), MTOK, NINP, 2048}; pg8::StaticOrder S; S.init(MTOK, NINP, G, bx);
        pg8::EpiProj E{(bf16_t*)(ws + WS_PROJ), (float*)(ws + WS_SMALL), NINP, A_DT / 256};
        pg8::gemm_phase<pg8::EpiProj, pg8::StaticOrder, true, true>(ldsl, g, S, E);
    } SEAM(2);
    if (IN(3)) { post0_phase(a, gw, NGW, lane); } SEAM(3);
    if (IN(4)) {
        for (int u = vcu; u < 256; u += G) { const int b = u >> 6, h = (u >> 3) & 7, qb = u & 7, kvh = h >> 2; const size_t row0 = (size_t)b * SEQ + qb * 256;
            att::attn_dense_body((const att::bf16*)(ws + WS_QB) + row0 * 1024 + h * 128, (const att::bf16*)(ws + WS_KB) + (size_t)b * SEQ * 256 + kvh * 128,
                                 (const att::bf16*)(ws + WS_VB) + (size_t)b * SEQ * 256 + kvh * 128, (bf16_t*)(ws + WS_YCAT) + row0 * 2048 + h * 128,
                                 (const bf16_t*)(ws + WS_PROJ) + row0 * NINP + A_GA + h * 128, SEQ, (char*)lds);
            __syncthreads(); }
        for (int rep = 0; rep < 1 + PROBE_SSD; ++rep) { for (int it = bx; it < 256; it += G) ssd_item(a, it, (float*)lds); __syncthreads(); }
    } SEAM(4);
    if (IN(5)) { ssd_combine_phase(a, gw, NGW, lane); } SEAM(5);
    if (IN(6)) {
        pg8::Gemm g{(const bf16_t*)(ws + WS_YCAT), (const bf16_t*)(ws + WS_WOUT0), MTOK, 2048, 2048}; pg8::StaticOrder S; S.init(MTOK, 2048, G, bx);
        pg8::EpiResid E{a.in[0], a.out, (const float*)(ws + WS_MOD), a.in[3]};
        pg8::gemm_phase<pg8::EpiResid, pg8::StaticOrder, true, true>(ldsl, g, S, E);
    } SEAM(6);
    if (IN(7)) { normmod_phase(a, a.out, 1, gw, NGW, lane); } SEAM(7);
    if (IN(8)) {
        pg8::Gemm g{(const bf16_t*)(ws + WS_H), (const bf16_t*)(ws + WS_WIN1), MTOK, NINP, 2048}; pg8::StaticOrder S; S.init(MTOK, NINP, G, bx);
        pg8::EpiProj E{(bf16_t*)(ws + WS_PROJ), (float*)(ws + WS_SMALL), NINP, C_SM / 256};
        pg8::gemm_phase<pg8::EpiProj, pg8::StaticOrder, true, true>(ldsl, g, S, E);
    } SEAM(8);
    if (IN(9)) { post1_phase(a, gw, NGW, lane); } SEAM(9);
    if (IN(10)) {
        for (int rep = 0; rep < 1 + PROBE_GDN; ++rep) { for (int it = bx; it < 256; it += G) gdn_item(a, it, (float*)lds); __syncthreads(); }
        for (int rep = 0; rep < 1 + PROBE_LRU; ++rep) { for (int it = bx; it < 2048; it += G) lru_tile(a, it, lds, 0); __syncthreads(); }
    } SEAM(10);
    if (IN(11)) { combine1_phase(a, gw, NGW, lane); __syncthreads(); for (int it = bx; it < 2048; it += G) lru_tile(a, it, lds, 1); } SEAM(11);
    if (IN(12)) {
        pg8::Gemm g{(const bf16_t*)(ws + WS_YCAT), (const bf16_t*)(ws + WS_WOUT1), MTOK, 2048, 2048}; pg8::StaticOrder S; S.init(MTOK, 2048, G, bx);
        pg8::EpiResid E{a.out, a.out, (const float*)(ws + WS_MOD) + 4 * 6144, a.in[3] + 6144};
        pg8::gemm_phase<pg8::EpiResid, pg8::StaticOrder, true, true>(ldsl, g, S, E);
    } SEAM(12);
    if (IN(13)) { final_norm_phase(a, gw, NGW, lane); }
#undef IN
#undef SEAM
}

extern "C" void kernel_launch(void* const* d_in, const int* in_sizes, int n_in, void* d_out, int out_size, void* d_ws, size_t ws_size, hipStream_t stream) {
    static int grid = 0;
    if (grid == 0) {
        if (n_in != 39 || out_size != MTOK * DM || ws_size < WS_END) { fprintf(stderr, "kernel_launch: unexpected problem (n_in %d, out %d, ws %zu < %zu)\n", n_in, out_size, ws_size, (size_t)WS_END); grid = -1; return; }
        int dev = 0, cus = 0, per_cu = 0;
        if (hipGetDevice(&dev) != hipSuccess || hipDeviceGetAttribute(&cus, hipDeviceAttributeMultiprocessorCount, dev) != hipSuccess) { grid = -1; return; }
        if (hipFuncSetAttribute((const void*)mk_fwd, hipFuncAttributeMaxDynamicSharedMemorySize, LDS_BYTES) != hipSuccess) { fprintf(stderr, "kernel_launch: hipFuncSetAttribute failed\n"); grid = -1; return; }
        if (hipOccupancyMaxActiveBlocksPerMultiprocessor(&per_cu, (const void*)mk_fwd, NTHREADS, LDS_BYTES) != hipSuccess || per_cu < 1) { fprintf(stderr, "kernel_launch: occupancy query says %d\n", per_cu); (void)hipGetLastError(); per_cu = 1; }
        grid = cus;
    }
    if (grid < 0) return;
    (void)hipMemsetAsync((char*)d_ws + WS_CTL, 0, CTL_ZERO_BYTES, stream);
    Args a{};
    for (int i = 0; i < 39; ++i) a.in[i] = (const float*)d_in[i];
    a.out = (float*)d_out; a.ws = (unsigned char*)d_ws;
#if MK_SINGLE
    a.ph_lo = 0; a.ph_hi = NPHASE;
    void* kargs[] = {&a};
    hipError_t e = hipLaunchCooperativeKernel((const void*)mk_fwd, dim3(grid), dim3(NTHREADS), kargs, LDS_BYTES, stream);
    if (e != hipSuccess) fprintf(stderr, "kernel_launch: cooperative launch failed: %s (grid %d)\n", hipGetErrorString(e), grid);
#else
    for (int p = 0; p < NPHASE; ++p) { a.ph_lo = p; a.ph_hi = p + 1; hipLaunchKernelGGL(mk_fwd, dim3(grid), dim3(NTHREADS), LDS_BYTES, stream, a); }
#endif
}
```

```cpp
#include <hip/hip_runtime.h>
#include <hip/hip_cooperative_groups.h>
#include <hip/hip_bf16.h>
#include <cstdio>
#include <cstdint>
namespace cg = cooperative_groups;

constexpr int BATCH = 4, SEQ = 2048, DM = 2048, MTOK = BATCH * SEQ;
constexpr int NIN = 5152, NINP = 5376;
constexpr float EPS = 1e-6f;
constexpr int A_Q = 0, A_K = 1024, A_V = 1280, A_GA = 1536, A_XS = 2560, A_BS = 3584, A_CS = 3840, A_DT = 4096, A_Z = 4128;
constexpr int C_Q = 0, C_K = 512, C_V = 1024, C_SM = 2048, C_Z = 2080, C_XL = 3104, C_GL = 4128;
namespace pg8 {
#define PG8_LAS __attribute__((address_space(3)))
typedef unsigned short bf16_t;
typedef short bf16x8 __attribute__((ext_vector_type(8)));
typedef float f32x4 __attribute__((ext_vector_type(4)));
typedef unsigned u32x4 __attribute__((ext_vector_type(4)));
constexpr int BM = 256, BK = 64, HALF = 128, HTB = HALF * BK * 2  , STAGE_BYTES = 8 * HTB, NXCD = 8, WGM = 8;

__host__ __device__ __forceinline__ int lds_byte(int r, int c) { const int st = (r >> 4) * 2 + (c >> 5), rr = r & 15, cc = c & 31, ob = rr * 64 + cc * 2; return st * 1024 + (ob ^ (((ob >> 9) & 1) << 5)); }
__host__ __device__ __forceinline__ void stage_rc(int b, int& R, int& C) { const int st = b / 1024, sb = b % 1024, swz = sb ^ (((sb >> 9) & 1) << 5); R = (st >> 1) * 16 + swz / 64; C = (st & 1) * 32 + (swz % 64) / 2; }
__host__ __device__ __forceinline__ int perm32(int rho) { const int n = rho >> 4, i = rho & 15; return 8 * (i >> 2) + 4 * n + (i & 3); }

struct Unit { int pm, pn; };
struct Gemm { const bf16_t* A; const bf16_t* Bt; int M, N, K; };

struct StaticOrder {
    int nM, nN, nwg, G, c;
    __host__ __device__ void init(int M, int N, int G_, int c_) { nM = M / BM; nN = N / BM; nwg = nM * nN; G = G_; c = c_; }
    __host__ __device__ bool next(int i, Unit& u) const {
        const long L = (long)i * G + c; if (L >= nwg) return false;
        int wgid = (int)L; { const int q = nwg / NXCD, r = nwg % NXCD, xcd = wgid % NXCD, off = wgid / NXCD; wgid = (xcd < r ? xcd * (q + 1) : r * (q + 1) + (xcd - r) * q) + off; }
        const int nig = WGM * nN, gid = wgid / nig, fm = gid * WGM, gsz = (nM - fm) < WGM ? (nM - fm) : WGM;
        u.pm = fm + ((wgid % nig) % gsz); u.pn = (wgid % nig) / gsz; return true;
    }
    __device__ __forceinline__ void a_ready(const Unit&) const {}
    __device__ __forceinline__ void done(const Unit&) const {}
};

__device__ __forceinline__ unsigned cvt_pk_bf16(float lo, float hi) { unsigned r; asm volatile("v_cvt_pk_bf16_f32 %0, %1, %2" : "=v"(r) : "v"(lo), "v"(hi)); return r; }
typedef float f32x2 __attribute__((ext_vector_type(2)));
struct EpiProj {
    static constexpr bool PERM = true, AFTER_DRAIN = false;
    bf16_t* O; float* small; int ldc; int small_tile;
    __device__ __forceinline__ void operator()(const f32x4 (&acc)[2][2][4][2], const Unit& u, int wr, int wc, int fr, int fq) const {
        const int row0 = u.pm * BM + wr * 64 + fr; const int col0 = u.pn * BM + wc * 32 + 8 * fq;
        const bool sm = (u.pn == small_tile) && (wc == 0);
#pragma unroll
        for (int ai = 0; ai < 2; ++ai)
#pragma unroll
            for (int m = 0; m < 4; ++m) { const int row = row0 + ai * HALF + m * 16; bf16_t* rowp = O + (size_t)row * ldc + col0;
#pragma unroll
                for (int bj = 0; bj < 2; ++bj) { const f32x4 v0 = acc[ai][bj][m][0], v1 = acc[ai][bj][m][1];
                    u32x4 w; w.x = cvt_pk_bf16(v0[0], v0[1]); w.y = cvt_pk_bf16(v0[2], v0[3]); w.z = cvt_pk_bf16(v1[0], v1[1]); w.w = cvt_pk_bf16(v1[2], v1[3]);
                    *(u32x4*)(rowp + bj * HALF) = w; }
                if (sm) { float* sp = small + (size_t)row * 32 + 8 * fq; *(f32x4*)sp = acc[ai][0][m][0]; *(f32x4*)(sp + 4) = acc[ai][0][m][1]; } }
    }
};
struct EpiResid {
    static constexpr bool PERM = false, AFTER_DRAIN = false;
    const float* xin; float* xout; const float* gacc; const float* gbias;
    __device__ __forceinline__ void operator()(const f32x4 (&acc)[2][2][4][2], const Unit& u, int wr, int wc, int fr, int fq) const {
        const int b = u.pm >> 3;
        const int col0 = u.pn * BM + wc * 32 + 4 * fq;
#pragma unroll
        for (int bj = 0; bj < 2; ++bj)
#pragma unroll
            for (int n = 0; n < 2; ++n) { const int col = col0 + bj * HALF + n * 16;
                const f32x4 g = *(const f32x4*)(gacc + (size_t)b * 6144 + 4096 + col) + *(const f32x4*)(gbias + 4096 + col);
#pragma unroll
                for (int ai = 0; ai < 2; ++ai)
#pragma unroll
                    for (int m = 0; m < 4; ++m) { const size_t off = (size_t)(u.pm * BM + ai * HALF + wr * 64 + m * 16 + fr) * 2048 + col;
                        const f32x4 xv = *(const f32x4*)(xin + off); *(f32x4*)(xout + off) = xv + g * acc[ai][bj][m][n]; } }
    }
};
template <class Epi, class Sched, bool ALIGN_EPI = false, bool SP2 = false>
__device__ __forceinline__ void gemm_phase(PG8_LAS unsigned char* lds, const Gemm g, const Sched& S, const Epi& E) {
    const int tid = threadIdx.x, wid = __builtin_amdgcn_readfirstlane(tid >> 6), lane = tid & 63, wr = wid >> 2, wc = wid & 3, fr = lane & 15, fq = lane >> 4;
    const int K = g.K, nt = K / BK;
    unsigned voffA[2], voffB[2];
#pragma unroll
    for (int i = 0; i < 2; ++i) { int R, C; stage_rc(tid * 16 + i * 8192, R, C); const int Rb = Epi::PERM ? ((R & ~31) + perm32(R & 31)) : R;
        voffA[i] = (unsigned)(R * K + C) * 2u; voffB[i] = (unsigned)(Rb * K + C) * 2u; }
    const size_t kstep = (size_t)(BK * 2);
    const size_t hstep = (size_t)HALF * K * 2;
    const size_t tstep = 2 * hstep;
    const unsigned ldsw = (unsigned)wid * 1024u;
    const int aoff = lds_byte(wr * 64 + fr, fq * 8), boff = lds_byte(wc * 32 + fr, fq * 8);
#define PG8_SA(b, h) (((b) * 2 + (h)) * HTB)
#define PG8_SB(b, h) ((4 + (b) * 2 + (h)) * HTB)
#define PG8_STAGE(bufoff, gbase, voff) do { _Pragma("unroll") for (int _i = 0; _i < 2; ++_i) \
        __builtin_amdgcn_global_load_lds((const unsigned*)((const char*)(gbase) + (voff)[_i]), (PG8_LAS unsigned*)(lds + (bufoff) + ldsw + _i * 8192), 16, 0, 0); } while (0)
#define PG8_LDA(dst, b, h) do { _Pragma("unroll") for (int m = 0; m < 4; ++m) _Pragma("unroll") for (int k = 0; k < 2; ++k) dst[m][k] = *(const PG8_LAS bf16x8*)(lds + PG8_SA(b, h) + aoff + m * 2048 + k * 1024); } while (0)
#define PG8_LDB(dst, b, h) do { _Pragma("unroll") for (int n = 0; n < 2; ++n) _Pragma("unroll") for (int k = 0; k < 2; ++k) dst[n][k] = *(const PG8_LAS bf16x8*)(lds + PG8_SB(b, h) + boff + n * 2048 + k * 1024); } while (0)
#define PG8_MMA(ai, bj, At, Bt) do { __builtin_amdgcn_s_setprio(1); _Pragma("unroll") for (int m = 0; m < 4; ++m) _Pragma("unroll") for (int n = 0; n < 2; ++n) _Pragma("unroll") for (int k = 0; k < 2; ++k) \
        acc[ai][bj][m][n] = __builtin_amdgcn_mfma_f32_16x16x32_bf16(Bt[n][k], At[m][k], acc[ai][bj][m][n], 0, 0, 0); __builtin_amdgcn_s_setprio(0); } while (0)
#define PG8_WAIT_V(n) asm volatile("s_waitcnt vmcnt(" #n ")" ::: "memory")
#define PG8_WAIT_L(n) asm volatile("s_waitcnt lgkmcnt(" #n ")" ::: "memory")
#define PG8_BAR __builtin_amdgcn_s_barrier()
#define PG8_SCHED __builtin_amdgcn_sched_barrier(0)
    Unit cur, nxt; int ui = 0;
    if (!S.next(0, cur)) return;
    f32x4 acc[2][2][4][2];
#pragma unroll
    for (int a = 0; a < 2; ++a)
#pragma unroll
        for (int b = 0; b < 2; ++b)
#pragma unroll
            for (int m = 0; m < 4; ++m)
#pragma unroll
                for (int n = 0; n < 2; ++n) acc[a][b][m][n] = (f32x4){0.f, 0.f, 0.f, 0.f};
    bf16x8 At[4][2], B0[2][2], B1[2][2];
    const char* cA = (const char*)g.A + (size_t)cur.pm * tstep; const char* cB = (const char*)g.Bt + (size_t)cur.pn * tstep;
    S.a_ready(cur);
    if constexpr (SP2) {
        PG8_STAGE(PG8_SB(0, 0), cB, voffB); PG8_STAGE(PG8_SB(0, 1), cB + hstep, voffB); PG8_STAGE(PG8_SA(0, 0), cA, voffA); PG8_STAGE(PG8_SA(0, 1), cA + hstep, voffA);
        if (wr == 1) PG8_BAR;
        PG8_WAIT_V(2); PG8_BAR;
        PG8_STAGE(PG8_SB(1, 0), cB + kstep, voffB); PG8_STAGE(PG8_SA(1, 0), cA + kstep, voffA); PG8_STAGE(PG8_SB(1, 1), cB + hstep + kstep, voffB);
        PG8_WAIT_V(6); PG8_BAR;
    } else {
        PG8_STAGE(PG8_SB(0, 0), cB, voffB); PG8_STAGE(PG8_SA(0, 0), cA, voffA); PG8_STAGE(PG8_SB(0, 1), cB + hstep, voffB); PG8_STAGE(PG8_SA(0, 1), cA + hstep, voffA);
        if (wr == 1) PG8_BAR;
        PG8_WAIT_V(4); PG8_BAR;
        PG8_STAGE(PG8_SB(1, 0), cB + kstep, voffB); PG8_STAGE(PG8_SA(1, 0), cA + kstep, voffA); PG8_STAGE(PG8_SB(1, 1), cB + hstep + kstep, voffB);
        PG8_WAIT_V(6); PG8_BAR;
    }
    for (;;) {
        const bool has_next = S.next(ui + 1, nxt);
        const char* nA = has_next ? (const char*)g.A + (size_t)nxt.pm * tstep : cA; const char* nB = has_next ? (const char*)g.Bt + (size_t)nxt.pn * tstep : cB;
        for (int t = 0; t < nt; t += 2) {
            const bool last = (t == nt - 2);
            const char* a1 = cA + (size_t)(t + 1) * kstep;
            const char* a2 = last ? nA : cA + (size_t)(t + 2) * kstep; const char* b2 = last ? nB : cB + (size_t)(t + 2) * kstep;
            const char* a3 = a2 + kstep; const char* b3 = b2 + kstep;
            if (last && has_next) S.a_ready(nxt);
            if constexpr (SP2) {
            PG8_LDB(B0, 0, 0); PG8_LDB(B1, 0, 1); PG8_SCHED; PG8_LDA(At, 0, 0); PG8_STAGE(PG8_SA(1, 1), a1 + hstep, voffA);
            PG8_WAIT_V(8); PG8_WAIT_L(0); PG8_BAR; PG8_MMA(0, 0, At, B0); PG8_MMA(0, 1, At, B1); PG8_BAR; PG8_SCHED;
            PG8_LDA(At, 0, 1); PG8_STAGE(PG8_SB(0, 0), b2, voffB); PG8_STAGE(PG8_SB(0, 1), b2 + hstep, voffB); PG8_STAGE(PG8_SA(0, 0), a2, voffA);
            PG8_WAIT_V(8); PG8_WAIT_L(0); PG8_BAR; PG8_MMA(1, 0, At, B0); PG8_MMA(1, 1, At, B1); PG8_BAR; PG8_SCHED;
            PG8_LDB(B0, 1, 0); PG8_LDB(B1, 1, 1); PG8_SCHED; PG8_LDA(At, 1, 0); PG8_STAGE(PG8_SA(0, 1), a2 + hstep, voffA);
            PG8_WAIT_V(8); PG8_WAIT_L(0); PG8_BAR; PG8_MMA(0, 0, At, B0); PG8_MMA(0, 1, At, B1); PG8_BAR; PG8_SCHED;
            PG8_LDA(At, 1, 1); PG8_STAGE(PG8_SB(1, 0), b3, voffB); PG8_STAGE(PG8_SB(1, 1), b3 + hstep, voffB); PG8_STAGE(PG8_SA(1, 0), a3, voffA);
            PG8_WAIT_V(8); PG8_WAIT_L(0); PG8_BAR; PG8_MMA(1, 0, At, B0); PG8_MMA(1, 1, At, B1); PG8_BAR; PG8_SCHED;
            } else {
            PG8_LDB(B0, 0, 0); PG8_SCHED; PG8_LDA(At, 0, 0); PG8_STAGE(PG8_SA(1, 1), a1 + hstep, voffA);
            PG8_WAIT_L(8); PG8_BAR; PG8_WAIT_L(0); PG8_MMA(0, 0, At, B0); PG8_BAR; PG8_SCHED;
            PG8_LDB(B1, 0, 1); PG8_STAGE(PG8_SB(0, 0), b2, voffB);
            PG8_BAR; PG8_WAIT_L(0); PG8_MMA(0, 1, At, B1); PG8_BAR;
            PG8_LDA(At, 0, 1); PG8_STAGE(PG8_SA(0, 0), a2, voffA);
            PG8_BAR; PG8_WAIT_L(0); PG8_MMA(1, 0, At, B0); PG8_BAR; PG8_SCHED;
            PG8_STAGE(PG8_SB(0, 1), b2 + hstep, voffB);
            PG8_WAIT_V(6); PG8_BAR; PG8_MMA(1, 1, At, B1); PG8_BAR;
            PG8_LDB(B0, 1, 0); PG8_SCHED; PG8_LDA(At, 1, 0); PG8_STAGE(PG8_SA(0, 1), a2 + hstep, voffA);
            PG8_WAIT_L(8); PG8_BAR; PG8_WAIT_L(0); PG8_MMA(0, 0, At, B0); PG8_BAR; PG8_SCHED;
            PG8_LDB(B1, 1, 1); PG8_STAGE(PG8_SB(1, 0), b3, voffB);
            PG8_BAR; PG8_WAIT_L(0); PG8_MMA(0, 1, At, B1); PG8_BAR;
            PG8_LDA(At, 1, 1); PG8_STAGE(PG8_SA(1, 0), a3, voffA);
            PG8_BAR; PG8_WAIT_L(0); PG8_MMA(1, 0, At, B0); PG8_BAR; PG8_SCHED;
            PG8_STAGE(PG8_SB(1, 1), b3 + hstep, voffB);
            PG8_WAIT_V(6); PG8_BAR; PG8_MMA(1, 1, At, B1); PG8_BAR;
            }
        }
        if constexpr (ALIGN_EPI) { if (wr == 0) PG8_BAR; }
        if constexpr (!Epi::AFTER_DRAIN) { E(acc, cur, wr, wc, fr, fq); S.done(cur); }
        if (!has_next) break;
#pragma unroll
        for (int a = 0; a < 2; ++a)
#pragma unroll
            for (int b = 0; b < 2; ++b)
#pragma unroll
                for (int m = 0; m < 4; ++m)
#pragma unroll
                    for (int n = 0; n < 2; ++n) acc[a][b][m][n] = (f32x4){0.f, 0.f, 0.f, 0.f};
        cur = nxt; cA = nA; cB = nB; ++ui;
        if constexpr (ALIGN_EPI) { if (wr == 1) PG8_BAR; }
    }
    PG8_WAIT_V(0);
    if constexpr (!ALIGN_EPI) { if (wr == 0) PG8_BAR; }
    PG8_BAR;
    if constexpr (Epi::AFTER_DRAIN) { E.fused(acc, cur, wr, wc, fr, fq, lds, wid, lane); S.done(cur); }
#undef PG8_SA
#undef PG8_SB
#undef PG8_STAGE
#undef PG8_LDA
#undef PG8_LDB
#undef PG8_MMA
#undef PG8_WAIT_V
#undef PG8_WAIT_L
#undef PG8_BAR
#undef PG8_SCHED
}
}
namespace att {
using bf16 = __hip_bfloat16;
constexpr int   D = 128, NW = 8, QBLK = 32, KVBLK = 64;
constexpr float SCALE = 0.088388347648318440f;
constexpr float THR = 8.f;
constexpr int SDEPTH = 2;
constexpr int LDQ = 1024, LDK = 256, LDY = 2048, LDG = NINP;
constexpr size_t SHM_V = KVBLK * D * 2, SHM_K = KVBLK * D * 2, SHM_ATTN = 2 * SHM_V + 2 * SHM_K + NW * 64 * 4;
using bf16x8 = __attribute__((ext_vector_type(8))) short;
using s16x4  = __attribute__((ext_vector_type(4))) short;
using f32x16 = __attribute__((ext_vector_type(16))) float;
using f32x8  = __attribute__((ext_vector_type(8))) float;
using u32x4  = __attribute__((ext_vector_type(4))) unsigned;
#define KSWZ(row, colB) ((row) * 256 + ((colB) ^ (((row) & 7) << 4)))
#define SBAR() __builtin_amdgcn_sched_barrier(0)
__device__ __forceinline__ int crow(int r, int hi) { return (r & 3) + 8 * (r >> 2) + 4 * hi; }
__device__ __forceinline__ unsigned cvtpk(float lo, float hi) {
  unsigned r; asm volatile("v_cvt_pk_bf16_f32 %0, %1, %2" : "=v"(r) : "v"(lo), "v"(hi)); return r;
}
template <typename TIn> struct Stage;
template <> struct Stage<bf16>  { using T = bf16x8;
  __device__ static __forceinline__ T ld8(const bf16* p) { return *reinterpret_cast<const bf16x8*>(p); }
  __device__ static __forceinline__ bf16x8 tobf(T x) { return x; } };
template <> struct Stage<float> { using T = f32x8;
  __device__ static __forceinline__ T ld8(const float* p) { return *reinterpret_cast<const f32x8*>(p); }
  __device__ static __forceinline__ bf16x8 tobf(T x) {
    u32x4 w = {cvtpk(x[0], x[1]), cvtpk(x[2], x[3]), cvtpk(x[4], x[5]), cvtpk(x[6], x[7])}; return *reinterpret_cast<bf16x8*>(&w); } };

__device__ __forceinline__ void partialSM(f32x16& p0, f32x16& p1, float& m_reg, float& mn, float& alpha) {
  constexpr float C = SCALE * 1.4426950408889634f;
  float pmax = p0[0]; for (int r = 1; r < 16; ++r) pmax = fmaxf(pmax, p0[r]); for (int r = 0; r < 16; ++r) pmax = fmaxf(pmax, p1[r]);
  { auto rr = __builtin_amdgcn_permlane32_swap(__float_as_uint(pmax), __float_as_uint(pmax), false, false);
    pmax = fmaxf(__uint_as_float(rr[0]), __uint_as_float(rr[1])); }
  if (__builtin_expect(__all(pmax - m_reg <= THR / SCALE), 1)) { mn = m_reg; alpha = 1.f; }
  else { mn = fmaxf(m_reg, pmax); alpha = __builtin_amdgcn_exp2f((m_reg - mn) * C); m_reg = mn; }
  float mnC = -mn * C;
  for (int r = 0; r < 16; ++r) p0[r] = fmaf(p0[r], C, mnC); for (int r = 0; r < 16; ++r) p1[r] = fmaf(p1[r], C, mnC);
  for (int r = 0; r < 16; ++r) p0[r] = __builtin_amdgcn_exp2f(p0[r]);
}
__device__ __forceinline__ void finishSM(f32x16& p0, f32x16& p1, float alpha, float& l_reg, bf16x8& pa0, bf16x8& pa1, bf16x8& pa2, bf16x8& pa3) {
  for (int r = 0; r < 16; ++r) p1[r] = __builtin_amdgcn_exp2f(p1[r]);
  float ps = 0; for (int r = 0; r < 16; ++r) ps += p0[r]; for (int r = 0; r < 16; ++r) ps += p1[r];
  { auto rr = __builtin_amdgcn_permlane32_swap(__float_as_uint(ps), __float_as_uint(ps), false, false);
    ps = __uint_as_float(rr[0]) + __uint_as_float(rr[1]); }
  l_reg = l_reg * alpha + ps;
#define PK4(P, BASE, OUT) do { unsigned a0 = cvtpk(P[BASE + 0], P[BASE + 1]), a1 = cvtpk(P[BASE + 2], P[BASE + 3]);   \
    unsigned b0 = cvtpk(P[BASE + 4], P[BASE + 5]), b1 = cvtpk(P[BASE + 6], P[BASE + 7]);                              \
    auto r0 = __builtin_amdgcn_permlane32_swap(a0, b0, false, false); auto r1 = __builtin_amdgcn_permlane32_swap(a1, b1, false, false); \
    u32x4 w = {r0[0], r1[0], r0[1], r1[1]}; OUT = *reinterpret_cast<bf16x8*>(&w); } while (0)
  PK4(p0, 0, pa0); PK4(p0, 8, pa1); PK4(p1, 0, pa2); PK4(p1, 8, pa3);
#undef PK4
}
__device__ __forceinline__ void qkt(f32x16& p0, f32x16& p1, const bf16* Ks, const bf16x8* qr, int r32, int hi) {
  p0 = f32x16{}; p1 = f32x16{};
  for (int d0 = 0; d0 < 8; ++d0) { int cb = (d0 * 16 + hi * 8) * 2;
    bf16x8 b0 = *reinterpret_cast<const bf16x8*>((const char*)Ks + KSWZ(r32, cb));
    bf16x8 b1 = *reinterpret_cast<const bf16x8*>((const char*)Ks + KSWZ(32 + r32, cb));
    p0 = __builtin_amdgcn_mfma_f32_32x32x16_bf16(b0, qr[d0], p0, 0, 0, 0);
    p1 = __builtin_amdgcn_mfma_f32_32x32x16_bf16(b1, qr[d0], p1, 0, 0, 0); }
}
__device__ __forceinline__ int v_st(int k, int c) { const int kk = (k & ~0xC) | ((k & 4) << 1) | ((k & 8) >> 1); return ((kk >> 3) * 4 + (c >> 5)) * 512 + ((kk & 7) * 32 + (c & 31)) * 2; }
__device__ __forceinline__ int v_rd_base(int lane) { return ((lane & 3) << 3) | (((lane >> 2) & 3) << 6) | (((lane >> 4) & 1) << 5) | (((lane >> 5) & 1) << 8); }
constexpr int v_rd_off(int d0, int ks, int half) { return d0 * 512 + ks * 4096 + half * 2048; }
template <int OFF> __device__ __forceinline__ s16x4 tr_read(int vb) {
  s16x4 r; asm volatile("ds_read_b64_tr_b16 %0, %1 offset:%2" : "=&v"(r) : "v"(vb), "i"(OFF) : "memory"); return r;
}
template <int D0> __device__ __forceinline__ void pv_one(f32x16& od, int vb, bf16x8 pa0, bf16x8 pa1, bf16x8 pa2, bf16x8 pa3) {
  const s16x4 l0 = tr_read<v_rd_off(D0, 0, 0)>(vb), h0 = tr_read<v_rd_off(D0, 0, 1)>(vb), l1 = tr_read<v_rd_off(D0, 1, 0)>(vb), h1 = tr_read<v_rd_off(D0, 1, 1)>(vb);
  const s16x4 l2 = tr_read<v_rd_off(D0, 2, 0)>(vb), h2 = tr_read<v_rd_off(D0, 2, 1)>(vb), l3 = tr_read<v_rd_off(D0, 3, 0)>(vb), h3 = tr_read<v_rd_off(D0, 3, 1)>(vb);
  asm volatile("s_waitcnt lgkmcnt(0)" ::: "memory"); SBAR();
#define PK(L, H) (bf16x8){L[0], L[1], L[2], L[3], H[0], H[1], H[2], H[3]}
  od = __builtin_amdgcn_mfma_f32_32x32x16_bf16(pa0, PK(l0, h0), od, 0, 0, 0);
  od = __builtin_amdgcn_mfma_f32_32x32x16_bf16(pa1, PK(l1, h1), od, 0, 0, 0);
  od = __builtin_amdgcn_mfma_f32_32x32x16_bf16(pa2, PK(l2, h2), od, 0, 0, 0);
  od = __builtin_amdgcn_mfma_f32_32x32x16_bf16(pa3, PK(l3, h3), od, 0, 0, 0);
#undef PK
}
__device__ __forceinline__ void pv_d0(f32x16* o, int vb, bf16x8 pa0, bf16x8 pa1, bf16x8 pa2, bf16x8 pa3) {
  pv_one<0>(o[0], vb, pa0, pa1, pa2, pa3); pv_one<1>(o[1], vb, pa0, pa1, pa2, pa3); pv_one<2>(o[2], vb, pa0, pa1, pa2, pa3); pv_one<3>(o[3], vb, pa0, pa1, pa2, pa3);
}
__device__ __forceinline__ void attn_dense_body(const bf16* __restrict__ Qb, const bf16* __restrict__ Kh, const bf16* __restrict__ Vh,
                                                unsigned short* __restrict__ Yb, const unsigned short* __restrict__ Gb, int seq, char* lds) {
  using St = Stage<bf16>; using SQ = Stage<bf16>; using TQ = bf16;
  const int tid = threadIdx.x, wid = tid >> 6, lane = tid & 63, r32 = lane & 31, hi = lane >> 5;
  bf16* V_lds = (bf16*)lds; bf16* K_lds = (bf16*)(lds + 2 * SHM_V);
  float* ws = (float*)(lds + 2 * SHM_V + 2 * SHM_K) + wid * 64; float* li_l = ws; float* al_l = ws + 32;
  float m_reg = -1e30f, l_reg = 0; f32x16 o[4] = {}; bf16x8 qr[8];
  const TQ* Qw = Qb + (long)(wid * QBLK + r32) * LDQ + hi * 8;
#pragma unroll
  for (int d0 = 0; d0 < 8; ++d0) qr[d0] = SQ::tobf(SQ::ld8(Qw + d0 * 16));
  const int sr = tid >> 4, sc = (tid & 15) * 8, vst0 = v_st(sr, sc), vst1 = v_st(32 + sr, sc);
  const int vb0 = (int)(uintptr_t)V_lds + v_rd_base(lane);
  struct { typename St::T vs0, vs1, ks0, ks1; } sr_[SDEPTH];
#define SLOAD(i, k0) do { sr_[i].vs0 = St::ld8(&Vh[(long)((k0) + sr) * LDK + sc]); sr_[i].vs1 = St::ld8(&Vh[(long)((k0) + 32 + sr) * LDK + sc]); \
    sr_[i].ks0 = St::ld8(&Kh[(long)((k0) + sr) * LDK + sc]); sr_[i].ks1 = St::ld8(&Kh[(long)((k0) + 32 + sr) * LDK + sc]); } while (0)
#define SWRITE(b, i) do { *(bf16x8*)((char*)V_lds + (b) * SHM_V + vst0) = St::tobf(sr_[i].vs0);          \
    *(bf16x8*)((char*)V_lds + (b) * SHM_V + vst1) = St::tobf(sr_[i].vs1); int kc = sc * 2;               \
    *(bf16x8*)((char*)K_lds + (b) * SHM_K + KSWZ(sr, kc)) = St::tobf(sr_[i].ks0);                       \
    *(bf16x8*)((char*)K_lds + (b) * SHM_K + KSWZ(32 + sr, kc)) = St::tobf(sr_[i].ks1); } while (0)
#define SWAIT() do { if constexpr (SDEPTH == 2) asm volatile("s_waitcnt vmcnt(4)" ::: "memory"); else asm volatile("s_waitcnt vmcnt(0)" ::: "memory"); } while (0)
#define RESC(a) do { if (__any((a) < 1.f)) { if (hi == 0) al_l[r32] = (a); asm volatile("s_waitcnt lgkmcnt(0)" ::: "memory"); \
    for (int d = 0; d < 4; ++d) for (int r = 0; r < 16; ++r) o[d][r] *= al_l[crow(r, hi)]; } } while (0)
  f32x16 pA0, pA1, pB0, pB1; float mnA, mnB, alA, alB; bf16x8 pa0, pa1, pa2, pa3; const int NT = seq / KVBLK;
  constexpr int SE = 0, SO = SDEPTH - 1;
  SLOAD(SE, 0); asm volatile("s_waitcnt vmcnt(0)" ::: "memory"); SWRITE(0, SE); __syncthreads();
  qkt(pA0, pA1, K_lds, qr, r32, hi); partialSM(pA0, pA1, m_reg, mnA, alA);
  SLOAD(SO, KVBLK); if constexpr (SDEPTH == 2) { if (2 < NT) SLOAD(SE, 2 * KVBLK); }
  SWAIT(); SWRITE(1, SO); __syncthreads();
  for (int j = 1; j + 1 < NT; j += 2) {
    SBAR(); qkt(pB0, pB1, (bf16*)((char*)K_lds + SHM_K), qr, r32, hi);
    finishSM(pA0, pA1, alA, l_reg, pa0, pa1, pa2, pa3); SBAR();
    SLOAD(SO, (j + SDEPTH) * KVBLK); SBAR();
    pv_d0(o, vb0, pa0, pa1, pa2, pa3); partialSM(pB0, pB1, m_reg, mnB, alB);
    __syncthreads(); SWAIT(); SWRITE(0, SE);
    RESC(alB); __syncthreads();
    SBAR(); qkt(pA0, pA1, K_lds, qr, r32, hi);
    finishSM(pB0, pB1, alB, l_reg, pa0, pa1, pa2, pa3); SBAR();
    if (SDEPTH == 1 || j + 3 < NT) SLOAD(SE, (j + 1 + SDEPTH) * KVBLK); SBAR();
    pv_d0(o, vb0 + (int)SHM_V, pa0, pa1, pa2, pa3); partialSM(pA0, pA1, m_reg, mnA, alA);
    __syncthreads(); SWAIT(); SWRITE(1, SO);
    RESC(alA); __syncthreads();
  }
  SBAR(); qkt(pB0, pB1, (bf16*)((char*)K_lds + SHM_K), qr, r32, hi);
  finishSM(pA0, pA1, alA, l_reg, pa0, pa1, pa2, pa3); SBAR();
  pv_d0(o, vb0, pa0, pa1, pa2, pa3); partialSM(pB0, pB1, m_reg, mnB, alB);
  __syncthreads(); RESC(alB);
  finishSM(pB0, pB1, alB, l_reg, pa0, pa1, pa2, pa3); SBAR();
  pv_d0(o, vb0 + (int)SHM_V, pa0, pa1, pa2, pa3);
  if (hi == 0) li_l[r32] = l_reg; asm volatile("s_waitcnt lgkmcnt(0)" ::: "memory");
  float rli[16];
#pragma unroll
  for (int r = 0; r < 16; ++r) rli[r] = __builtin_amdgcn_rcpf(li_l[crow(r, hi)]);
  int eoff = (wid * QBLK + 4 * hi) ; asm volatile("" : "+v"(eoff));
  const unsigned short* Gw = Gb + (long)eoff * LDG + r32; unsigned short* Yw = Yb + (long)eoff * LDY + r32;
#pragma unroll
  for (int r = 0; r < 16; ++r) { const int orow = (r & 3) + 8 * (r >> 2);
#pragma unroll
    for (int d0 = 0; d0 < 4; ++d0) { const float g = __uint_as_float(((unsigned)Gw[orow * LDG + d0 * 32]) << 16);
      const float val = o[d0][r] * rli[r] * (g / (1.f + __expf(-g)));
      unsigned ub = __float_as_uint(val); ub = (ub + 0x7fffu + ((ub >> 16) & 1u)) >> 16;
      Yw[orow * LDY + d0 * 32] = (unsigned short)ub; } }
#undef SLOAD
#undef SWRITE
#undef SWAIT
#undef RESC
}
}
#define GAS __attribute__((address_space(1)))
#define LAS __attribute__((address_space(3)))
typedef unsigned short bf16_t;
typedef unsigned v4u __attribute__((ext_vector_type(4)));
typedef unsigned v2u __attribute__((ext_vector_type(2)));
typedef float f32x4 __attribute__((ext_vector_type(4)));
typedef short bf16x8_t __attribute__((ext_vector_type(8)));
typedef float f32x16_t __attribute__((ext_vector_type(16)));
#define LDS_WAIT() asm volatile("s_waitcnt lgkmcnt(0)" ::: "memory")

constexpr size_t MiB = 1u << 20;
constexpr size_t WS_CTL = 0, CTL_ZERO_BYTES = 1 * MiB;
constexpr size_t WS_MOD = 64 * 1024;
constexpr size_t WS_ROPE = 1 * MiB;
constexpr size_t WS_SMALL = 2 * MiB;
constexpr size_t WS_WIN0 = 3 * MiB, WS_WOUT0 = 24 * MiB;
constexpr size_t WS_QB = 32 * MiB, WS_KB = 48 * MiB, WS_VB = 52 * MiB;
constexpr size_t WS_HB = 3 * MiB;
constexpr size_t WS_WIN1 = 56 * MiB, WS_WOUT1 = 77 * MiB;
constexpr size_t WS_H = 85 * MiB;
constexpr size_t WS_HF = 85 * MiB;
constexpr size_t WS_PROJ = 117 * MiB;
constexpr size_t WS_YCAT = 201 * MiB;
constexpr size_t WS_ACT = 233 * MiB;
constexpr size_t WS_YF = 297 * MiB, WS_YB = 329 * MiB;
constexpr size_t WS_QKV16 = 3 * MiB;
constexpr size_t WS_GT = 85 * MiB, WS_GA = 101 * MiB;
constexpr size_t WS_WGT = 361 * MiB;
constexpr size_t WS_LSUM = 362 * MiB;
constexpr size_t WS_END = 366 * MiB;

constexpr int NWAVES = 8, NTHREADS = 512;
constexpr int LDS_BYTES = 147456;
constexpr int NPHASE = 15;

struct Args { const float* in[39]; float* out; unsigned char* ws; int ph_lo, ph_hi; };

__device__ __forceinline__ float bf2f(unsigned v) { return __uint_as_float(v << 16); }
__device__ __forceinline__ unsigned f2bf(float f) { unsigned u = __float_as_uint(f); return (u + 0x7fffu + ((u >> 16) & 1u)) >> 16; }
__device__ __forceinline__ unsigned pk2(float lo, float hi) { return f2bf(lo) | (f2bf(hi) << 16); }
__device__ __forceinline__ void unpack8(const v4u w, float* x) {
    x[0] = __uint_as_float(w.x << 16); x[1] = __uint_as_float(w.x & 0xffff0000u); x[2] = __uint_as_float(w.y << 16); x[3] = __uint_as_float(w.y & 0xffff0000u);
    x[4] = __uint_as_float(w.z << 16); x[5] = __uint_as_float(w.z & 0xffff0000u); x[6] = __uint_as_float(w.w << 16); x[7] = __uint_as_float(w.w & 0xffff0000u);
}
__device__ __forceinline__ v4u pack8(const float* x) { v4u w; w.x = pk2(x[0], x[1]); w.y = pk2(x[2], x[3]); w.z = pk2(x[4], x[5]); w.w = pk2(x[6], x[7]); return w; }
__device__ __forceinline__ float silu_f(float x) { return x / (1.f + expf(-x)); }
__device__ __forceinline__ float sigmoid_f(float x) { return 1.f / (1.f + expf(-x)); }
__device__ __forceinline__ float softplus_f(float x) { return fmaxf(x, 0.f) + log1pf(expf(-fabsf(x))); }
template <int CTRL> __device__ __forceinline__ float dpp_mov(float v) { return __builtin_bit_cast(float, __builtin_amdgcn_update_dpp(0, __builtin_bit_cast(int, v), CTRL, 0xF, 0xF, true)); }
template <int N> __device__ __forceinline__ float group_sum(float v) {
    if (N >= 2) v += dpp_mov<0xB1>(v);
    if (N >= 4) v += dpp_mov<0x4E>(v);
    if (N >= 8) v += dpp_mov<0x141>(v);
    if (N >= 16) v += dpp_mov<0x140>(v);
    if (N >= 32) v += __shfl_xor(v, 16);
    if (N >= 64) v += __shfl_xor(v, 32);
    return v;
}

__device__ __forceinline__ void p0_transpose_item(const float* W, int K, int N, bf16_t* WT, int row_off, LAS float* scr, int item, int lane) {
    const int nblk = N / 32, kb = item / nblk, nb = item % nblk, k0 = 64 * kb, n0 = 32 * nb;
#pragma unroll 8
    for (int i = 0; i < 32; ++i) { const int kk = 2 * i + (lane >> 5); scr[kk * 33 + (lane & 31)] = W[(size_t)(k0 + kk) * N + n0 + (lane & 31)]; }
    LDS_WAIT(); asm volatile("" ::: "memory");
    const int c = lane & 7;
#pragma unroll
    for (int j = 0; j < 4; ++j) { const int n = (lane >> 3) + 8 * j; const LAS float* s = scr + (8 * c) * 33 + n;
        v4u o; o.x = pk2(s[0 * 33], s[1 * 33]); o.y = pk2(s[2 * 33], s[3 * 33]); o.z = pk2(s[4 * 33], s[5 * 33]); o.w = pk2(s[6 * 33], s[7 * 33]);
        *(v4u*)(WT + (size_t)(row_off + n0 + n) * K + k0 + 8 * c) = o; }
    LDS_WAIT(); asm volatile("" ::: "memory");
}

__device__ __forceinline__ void p0_prologue(const Args& a, LAS unsigned char* lds, int vcu, int G) {
    const int tid = threadIdx.x, lane = tid & 63, wave = tid >> 6;
    unsigned char* ws = a.ws;
    { const int gid = blockIdx.x * NTHREADS + tid;
      if (gid < 2048) { const int pos = gid >> 5, i = gid & 31; const float freq = expf(-(float)i * (1.f / 32.f) * 9.210340371976184f); const float ang = (float)pos * freq;
          float* rt = (float*)(ws + WS_ROPE); rt[2 * gid] = cosf(ang); rt[2 * gid + 1] = sinf(ang); } }
    { const int gid = blockIdx.x * NTHREADS + tid, gn = G * NTHREADS; constexpr int NV = (NINP - NIN) * 2048 * 2 / 16;
      v4u* p0 = (v4u*)(ws + WS_WIN0 + (size_t)NIN * 2048 * 2); v4u* p1 = (v4u*)(ws + WS_WIN1 + (size_t)NIN * 2048 * 2);
      for (int i = gid; i < NV; i += gn) { p0[i] = (v4u){0, 0, 0, 0}; p1[i] = (v4u){0, 0, 0, 0}; } }
    if (blockIdx.x < 192) {
        const int it = blockIdx.x, l = it / 96, r = it % 96, kc = r / 3, nc = r % 3;
        LAS float* cond = (LAS float*)lds;
        if (tid < 256) { const int b = tid >> 6, k = tid & 63; const float c = a.in[1][b * 2048 + kc * 64 + k]; cond[tid] = silu_f(c); }
        __syncthreads();
        const float* W = a.in[2] + (size_t)l * 2048 * 6144 + (size_t)(kc * 64) * 6144 + nc * 2048 + tid * 4;
        f32x4 acc0 = {0, 0, 0, 0}, acc1 = acc0, acc2 = acc0, acc3 = acc0;
#pragma unroll 8
        for (int k = 0; k < 64; ++k) { const f32x4 w = *(const f32x4*)(W + (size_t)k * 6144);
            acc0 += cond[k] * w; acc1 += cond[64 + k] * w; acc2 += cond[128 + k] * w; acc3 += cond[192 + k] * w; }
        float* macc = (float*)(ws + WS_MOD) + (size_t)l * 4 * 6144 + nc * 2048 + tid * 4;
#pragma unroll
        for (int i = 0; i < 4; ++i) { atomicAdd(macc + i, acc0[i]); atomicAdd(macc + 6144 + i, acc1[i]); atomicAdd(macc + 2 * 6144 + i, acc2[i]); atomicAdd(macc + 3 * 6144 + i, acc3[i]); }
        __syncthreads();
    }
    { LAS float* scr = (LAS float*)(lds + wave * 16384);
      const int gw = vcu * NWAVES + wave, NGW = G * NWAVES;
      constexpr int I_IN = 32 * (NIN / 32), I_OUT = 32 * 64, I_G = 32 * 8, NITEMS = 2 * (I_IN + I_OUT) + I_G;
      for (int it = gw; it < NITEMS; it += NGW) {
          int r = it;
          if (r < I_G) { const int mn = r >> 3, m = mn >> 3; const float* Wg = a.in[m == 0 ? 27 : m == 1 ? 29 : m == 2 ? 32 : 34] + (size_t)(mn & 7) * 128 * 128;
              p0_transpose_item(Wg, 128, 128, (bf16_t*)(ws + WS_WGT) + (size_t)mn * 128 * 128, 0, scr, r & 7, lane); continue; } r -= I_G;
          if (r < I_IN) { p0_transpose_item(a.in[5], 2048, NIN, (bf16_t*)(ws + WS_WIN0), 0, scr, r, lane); continue; } r -= I_IN;
          if (r < I_IN) { p0_transpose_item(a.in[17], 2048, NIN, (bf16_t*)(ws + WS_WIN1), 0, scr, r, lane); continue; } r -= I_IN;
          if (r < I_OUT) { p0_transpose_item(a.in[16], 2048, 2048, (bf16_t*)(ws + WS_WOUT0), 0, scr, r, lane); continue; } r -= I_OUT;
          p0_transpose_item(a.in[37], 2048, 2048, (bf16_t*)(ws + WS_WOUT1), 0, scr, r, lane);
      } }
}

__device__ __forceinline__ void normmod_phase(const Args& a, const float* xin, int layer, int gw, int NGW, int lane) {
    const float* nw = a.in[4] + layer * 2048; const float* bm = a.in[3] + layer * 6144;
    const float* macc = (const float*)(a.ws + WS_MOD) + (size_t)layer * 4 * 6144;
    bf16_t* H = (bf16_t*)(a.ws + WS_H);
    for (int m = gw; m < MTOK; m += NGW) {
        const int b = m >> 11;
        const f32x4* xr = (const f32x4*)(xin + (size_t)m * 2048) + lane;
        f32x4 v[8]; float s = 0.f;
#pragma unroll
        for (int j = 0; j < 8; ++j) { v[j] = xr[64 * j]; s += (v[j].x * v[j].x + v[j].y * v[j].y) + (v[j].z * v[j].z + v[j].w * v[j].w); }
        const float rstd = rsqrtf(group_sum<64>(s) * (1.f / 2048.f) + EPS);
#pragma unroll
        for (int j = 0; j < 8; ++j) { const int col = (64 * j + lane) * 4;
            const f32x4 w = *(const f32x4*)(nw + col);
            const f32x4 sh = *(const f32x4*)(macc + b * 6144 + col) + *(const f32x4*)(bm + col);
            const f32x4 sc = *(const f32x4*)(macc + b * 6144 + 2048 + col) + *(const f32x4*)(bm + 2048 + col);
            const f32x4 o = v[j] * rstd * w * (1.f + sc) + sh;
            v2u pk; pk.x = pk2(o.x, o.y); pk.y = pk2(o.z, o.w);
            *(v2u*)(H + (size_t)m * 2048 + col) = pk; }
    }
}

__device__ __forceinline__ void post0_phase(const Args& a, int gw, int NGW, int lane) {
    const bf16_t* P = (const bf16_t*)(a.ws + WS_PROJ);
    const float2* rope = (const float2*)(a.ws + WS_ROPE);
    const float* qn = a.in[6]; const float* kn = a.in[7]; const float* cw = a.in[8]; const float* cb = a.in[9];
    bf16_t* Q = (bf16_t*)(a.ws + WS_QB); bf16_t* K = (bf16_t*)(a.ws + WS_KB); bf16_t* V = (bf16_t*)(a.ws + WS_VB);
    float* ACT = (float*)(a.ws + WS_ACT);
    for (int m = gw; m < MTOK; m += NGW) {
        const int t = m & 2047, prow = t >> 6, pcol = t & 63;
        const bf16_t* pr = P + (size_t)m * NINP;
        {
            float x[16]; unpack8(*(const v4u*)(pr + A_Q + lane * 16), x); unpack8(*(const v4u*)(pr + A_Q + lane * 16 + 8), x + 8);
            float ss = 0.f;
#pragma unroll
            for (int i = 0; i < 16; ++i) ss += x[i] * x[i];
            ss = group_sum<8>(ss);
            const float r = rsqrtf(ss * (1.f / 128.f) + EPS);
            const int d0 = (lane & 7) * 16;
#pragma unroll
            for (int i = 0; i < 16; ++i) x[i] = x[i] * r * qn[d0 + i];
#pragma unroll
            for (int pi = 0; pi < 8; ++pi) { const int p = (d0 >> 1) + pi; const float2 cs = (p < 32) ? rope[prow * 32 + p] : rope[pcol * 32 + p - 32];
                const float x0 = x[2 * pi], x1 = x[2 * pi + 1]; x[2 * pi] = x0 * cs.x - x1 * cs.y; x[2 * pi + 1] = x0 * cs.y + x1 * cs.x; }
            *(v4u*)(Q + (size_t)m * 1024 + lane * 16) = pack8(x); *(v4u*)(Q + (size_t)m * 1024 + lane * 16 + 8) = pack8(x + 8);
        }
        {
            const v2u w = *(const v2u*)(pr + A_K + lane * 4);
            float x[4] = {__uint_as_float(w.x << 16), __uint_as_float(w.x & 0xffff0000u), __uint_as_float(w.y << 16), __uint_as_float(w.y & 0xffff0000u)};
            float ss = (x[0] * x[0] + x[1] * x[1]) + (x[2] * x[2] + x[3] * x[3]);
            ss = group_sum<32>(ss);
            const float r = rsqrtf(ss * (1.f / 128.f) + EPS);
            const int d0 = (lane & 31) * 4;
#pragma unroll
            for (int i = 0; i < 4; ++i) x[i] = x[i] * r * kn[d0 + i];
#pragma unroll
            for (int pi = 0; pi < 2; ++pi) { const int p = (d0 >> 1) + pi; const float2 cs = (p < 32) ? rope[prow * 32 + p] : rope[pcol * 32 + p - 32];
                const float x0 = x[2 * pi], x1 = x[2 * pi + 1]; x[2 * pi] = x0 * cs.x - x1 * cs.y; x[2 * pi + 1] = x0 * cs.y + x1 * cs.x; }
            v2u o; o.x = pk2(x[0], x[1]); o.y = pk2(x[2], x[3]);
            *(v2u*)(K + (size_t)m * 256 + lane * 4) = o;
            *(v2u*)(V + (size_t)m * 256 + lane * 4) = *(const v2u*)(pr + A_V + lane * 4);
        }
#pragma unroll
        for (int j = 0; j < 3; ++j) { const int ch = (j * 64 + lane) * 8;
            float acc[8];
            { const f32x4 b0 = *(const f32x4*)(cb + ch), b1 = *(const f32x4*)(cb + ch + 4); acc[0] = b0.x; acc[1] = b0.y; acc[2] = b0.z; acc[3] = b0.w; acc[4] = b1.x; acc[5] = b1.y; acc[6] = b1.z; acc[7] = b1.w; }
#pragma unroll
            for (int d = 0; d < 4; ++d) { const int ts = t + d - 2;
                if (ts >= 0 && ts < SEQ) { float x[8]; unpack8(*(const v4u*)(P + (size_t)(m + d - 2) * NINP + A_XS + ch), x);
                    const f32x4 w0 = *(const f32x4*)(cw + d * 1536 + ch), w1 = *(const f32x4*)(cw + d * 1536 + ch + 4);
                    acc[0] += w0.x * x[0]; acc[1] += w0.y * x[1]; acc[2] += w0.z * x[2]; acc[3] += w0.w * x[3];
                    acc[4] += w1.x * x[4]; acc[5] += w1.y * x[5]; acc[6] += w1.z * x[6]; acc[7] += w1.w * x[7]; } }
            f32x4 o0, o1; o0.x = silu_f(acc[0]); o0.y = silu_f(acc[1]); o0.z = silu_f(acc[2]); o0.w = silu_f(acc[3]); o1.x = silu_f(acc[4]); o1.y = silu_f(acc[5]); o1.z = silu_f(acc[6]); o1.w = silu_f(acc[7]);
            *(f32x4*)(ACT + (size_t)m * 1536 + ch) = o0; *(f32x4*)(ACT + (size_t)m * 1536 + ch + 4) = o1; }
    }
}

typedef float f32x2 __attribute__((ext_vector_type(2)));
__device__ __forceinline__ void ssd_item(const Args& a, int item, float* lds) {
    const int ph = item & 1, h = (item >> 1) & 15, dir = (item >> 5) & 1, b = item >> 6, g = h >> 3;
    constexpr int BUF = 32 * 32 + 2 * 32 * 128 + 32;
    float* ysb = lds + 2 * BUF;
    const float A = -expf(a.in[dir ? 13 : 12][h]); const float dtb = a.in[dir ? 11 : 10][h];
    const float* ACT = (const float*)(a.ws + WS_ACT); const float* SM = (const float*)(a.ws + WS_SMALL);
    float* Y = (float*)(a.ws + (dir ? WS_YB : WS_YF));
    const int tid = threadIdx.x, p = tid >> 4, ng = tid & 15;
    f32x2 hst[4];
#pragma unroll
    for (int i = 0; i < 4; ++i) hst[i] = (f32x2){0.f, 0.f};
    f32x4 gB[2], gC[2], gx; float gdt;
#define SSD_LOAD(tile_) do { const size_t r0_ = (size_t)b * SEQ + (dir ? 63 - (tile_) : (tile_)) * 32; \
        _Pragma("unroll") for (int i = 0; i < 2; ++i) { const int idx = tid + i * 512, s_ = idx >> 5, c4_ = idx & 31, tl_ = dir ? 31 - s_ : s_; \
            gB[i] = *(const f32x4*)(ACT + (r0_ + tl_) * 1536 + 1024 + g * 128 + c4_ * 4); gC[i] = *(const f32x4*)(ACT + (r0_ + tl_) * 1536 + 1280 + g * 128 + c4_ * 4); } \
        if (tid < 256) { const int s_ = tid >> 3, c4_ = tid & 7, tl_ = dir ? 31 - s_ : s_; gx = *(const f32x4*)(ACT + (r0_ + tl_) * 1536 + h * 64 + ph * 32 + c4_ * 4); gdt = SM[(r0_ + tl_) * 32 + dir * 16 + h]; } } while (0)
#define SSD_STORE(buf_) do { float* xs_ = lds + (buf_) * BUF; float* Bs_ = xs_ + 32 * 32; float* Cs_ = Bs_ + 32 * 128; float* das_ = Cs_ + 32 * 128; \
        _Pragma("unroll") for (int i = 0; i < 2; ++i) { const int idx = tid + i * 512, s_ = idx >> 5, c4_ = idx & 31; const int so_ = s_ * 128 + (c4_ & 1) * 64 + (c4_ >> 1) * 4; \
            *(f32x4*)(Bs_ + so_) = gB[i]; *(f32x4*)(Cs_ + so_) = gC[i]; } \
        if (tid < 256) { const int s_ = tid >> 3, c4_ = tid & 7; const float dt_ = softplus_f(gdt + dtb); *(f32x4*)(xs_ + s_ * 32 + c4_ * 4) = gx * dt_; if (c4_ == 0) das_[s_] = expf(dt_ * A); } } while (0)
    __syncthreads();
    SSD_LOAD(0); SSD_STORE(0);
    __syncthreads();
    for (int tile = 0; tile < 64; ++tile) {
        const int cur = tile & 1;
        const size_t row0 = (size_t)b * SEQ + (dir ? 63 - tile : tile) * 32;
        if (tile + 1 < 64) SSD_LOAD(tile + 1);
        const float* xs = lds + cur * BUF; const float* Bs = xs + 32 * 32; const float* Cs = Bs + 32 * 128; const float* das = Cs + 32 * 128; float* ys = ysb + cur * 1024;
        {
            float n_dA = das[0], n_xdt = xs[p];
            f32x4 n_b0 = *(const f32x4*)(Bs + ng * 4), n_b1 = *(const f32x4*)(Bs + 64 + ng * 4), n_c0 = *(const f32x4*)(Cs + ng * 4), n_c1 = *(const f32x4*)(Cs + 64 + ng * 4);
#pragma unroll 4
            for (int s = 0; s < 32; ++s) {
                const float dA = n_dA, xdt = n_xdt; const f32x4 b0 = n_b0, b1 = n_b1, c0 = n_c0, c1 = n_c1;
                const int sn = (s + 1) & 31;
                n_dA = das[sn]; n_xdt = xs[sn * 32 + p];
                n_b0 = *(const f32x4*)(Bs + sn * 128 + ng * 4); n_b1 = *(const f32x4*)(Bs + sn * 128 + 64 + ng * 4);
                n_c0 = *(const f32x4*)(Cs + sn * 128 + ng * 4); n_c1 = *(const f32x4*)(Cs + sn * 128 + 64 + ng * 4);
                const f32x2 xd2 = (f32x2){xdt, xdt}, da2 = (f32x2){dA, dA};
                hst[0] = hst[0] * da2 + xd2 * (f32x2){b0.x, b0.y};
                hst[1] = hst[1] * da2 + xd2 * (f32x2){b0.z, b0.w};
                hst[2] = hst[2] * da2 + xd2 * (f32x2){b1.x, b1.y};
                hst[3] = hst[3] * da2 + xd2 * (f32x2){b1.z, b1.w};
                f32x2 acc = hst[0] * (f32x2){c0.x, c0.y};
                acc += hst[1] * (f32x2){c0.z, c0.w};
                acc += hst[2] * (f32x2){c1.x, c1.y};
                acc += hst[3] * (f32x2){c1.z, c1.w};
                const float part = group_sum<16>(acc.x + acc.y);
                if (ng == 0) ys[s * 32 + p] = part;
            }
        }
        if (tile + 1 < 64) SSD_STORE(cur ^ 1);
        __syncthreads();
        if (tid < 256) { const int s = tid >> 3, c4 = tid & 7, tl = dir ? 31 - s : s; *(f32x4*)(Y + (row0 + tl) * 1024 + h * 64 + ph * 32 + c4 * 4) = *(const f32x4*)(ys + s * 32 + c4 * 4); }
    }
#undef SSD_LOAD
#undef SSD_STORE
}

__device__ __forceinline__ void ssd_combine_phase(const Args& a, int gw, int NGW, int lane) {
    const float* YF = (const float*)(a.ws + WS_YF); const float* YB = (const float*)(a.ws + WS_YB); const float* ACT = (const float*)(a.ws + WS_ACT);
    const bf16_t* P = (const bf16_t*)(a.ws + WS_PROJ); bf16_t* YC = (bf16_t*)(a.ws + WS_YCAT);
    const float* dsk = a.in[14]; const float* nw = a.in[15];
    for (int m = gw; m < MTOK; m += NGW) {
        const int ch = lane * 16; const float dk = dsk[ch >> 6];
        float z[16], gv[16]; unpack8(*(const v4u*)(P + (size_t)m * NINP + A_Z + ch), z); unpack8(*(const v4u*)(P + (size_t)m * NINP + A_Z + ch + 8), z + 8);
        float ss = 0.f;
#pragma unroll
        for (int q = 0; q < 4; ++q) { const f32x4 f = *(const f32x4*)(YF + (size_t)m * 1024 + ch + 4 * q), bk = *(const f32x4*)(YB + (size_t)m * 1024 + ch + 4 * q), xv = *(const f32x4*)(ACT + (size_t)m * 1536 + ch + 4 * q);
            const f32x4 y = f + bk + dk * xv;
            gv[4 * q] = y.x * silu_f(z[4 * q]); gv[4 * q + 1] = y.y * silu_f(z[4 * q + 1]); gv[4 * q + 2] = y.z * silu_f(z[4 * q + 2]); gv[4 * q + 3] = y.w * silu_f(z[4 * q + 3]); }
#pragma unroll
        for (int i = 0; i < 16; ++i) ss += gv[i] * gv[i];
        const float r = rsqrtf(group_sum<64>(ss) * (1.f / 1024.f) + EPS);
#pragma unroll
        for (int i = 0; i < 16; ++i) gv[i] = gv[i] * r * nw[ch + i];
        *(v4u*)(YC + (size_t)m * 2048 + 1024 + ch) = pack8(gv); *(v4u*)(YC + (size_t)m * 2048 + 1024 + ch + 8) = pack8(gv + 8);
    }
}

__device__ __forceinline__ void post1_phase(const Args& a, int gw, int NGW, int lane) {
    const bf16_t* P = (const bf16_t*)(a.ws + WS_PROJ); const float* cw = a.in[18]; const float* cb = a.in[19];
    float* ACT = (float*)(a.ws + WS_ACT);
    for (int m = gw; m < MTOK; m += NGW) {
        const int t = m & 2047;
#pragma unroll
        for (int j = 0; j < 4; ++j) { const int ch = (j * 64 + lane) * 8;
            float acc[8];
            { const f32x4 b0 = *(const f32x4*)(cb + ch), b1 = *(const f32x4*)(cb + ch + 4); acc[0] = b0.x; acc[1] = b0.y; acc[2] = b0.z; acc[3] = b0.w; acc[4] = b1.x; acc[5] = b1.y; acc[6] = b1.z; acc[7] = b1.w; }
#pragma unroll
            for (int d = 0; d < 4; ++d) { const int ts = t + d - 2;
                if (ts >= 0 && ts < SEQ) { float x[8]; unpack8(*(const v4u*)(P + (size_t)(m + d - 2) * NINP + C_Q + ch), x);
                    const f32x4 w0 = *(const f32x4*)(cw + d * 2048 + ch), w1 = *(const f32x4*)(cw + d * 2048 + ch + 4);
                    acc[0] += w0.x * x[0]; acc[1] += w0.y * x[1]; acc[2] += w0.z * x[2]; acc[3] += w0.w * x[3];
                    acc[4] += w1.x * x[4]; acc[5] += w1.y * x[5]; acc[6] += w1.z * x[6]; acc[7] += w1.w * x[7]; } }
#pragma unroll
            for (int i = 0; i < 8; ++i) acc[i] = silu_f(acc[i]);
            if (j < 2) {
                float ss = 0.f;
#pragma unroll
                for (int i = 0; i < 8; ++i) ss += acc[i] * acc[i];
                ss = group_sum<16>(ss);
                float r = rsqrtf(ss + EPS); if (j == 0) r *= 0.088388347648318440f;
#pragma unroll
                for (int i = 0; i < 8; ++i) acc[i] *= r;
            }
            *(f32x4*)(ACT + (size_t)m * 2048 + ch) = (f32x4){acc[0], acc[1], acc[2], acc[3]}; *(f32x4*)(ACT + (size_t)m * 2048 + ch + 4) = (f32x4){acc[4], acc[5], acc[6], acc[7]};
            *(v4u*)((bf16_t*)(a.ws + WS_QKV16) + (size_t)m * 2048 + ch) = pack8(acc); }
    }
}

__device__ __forceinline__ void gdn_item(const Args& a, int item, float* lds) {
    const int dvs = item & 3, hv = (item >> 2) & 7, dir = (item >> 5) & 1, b = item >> 6, hq = hv >> 1;
    constexpr int BUF = 2 * 32 * 128 + 32 * 32 + 32 * 4;
    float* osb = lds + 2 * BUF;
    const float Aneg = -expf(a.in[dir ? 21 : 20][hv]); const float dtb = a.in[dir ? 23 : 22][hv];
    const float* ACT = (const float*)(a.ws + WS_ACT); const float* SM = (const float*)(a.ws + WS_SMALL);
    float* O = (float*)(a.ws + (dir ? WS_YB : WS_YF));
    const int tid = threadIdx.x, lane = tid & 63, wave = tid >> 6, dkg = lane & 15, dvi = wave * 4 + (lane >> 4);
    f32x2 S[4];
#pragma unroll
    for (int i = 0; i < 4; ++i) S[i] = (f32x2){0.f, 0.f};
    f32x4 gk0, gk1, gq0, gq1, gv; float gbr = 0.f, gar = 0.f;
#define GDN_LOAD(tile_) do { const size_t r0_ = (size_t)b * SEQ + (dir ? 63 - (tile_) : (tile_)) * 32; \
        { const int s_ = tid >> 4, c8_ = tid & 15, tl_ = dir ? 31 - s_ : s_; const float* kp_ = ACT + (r0_ + tl_) * 2048 + 512 + hq * 128 + c8_ * 8; const float* qp_ = ACT + (r0_ + tl_) * 2048 + hq * 128 + c8_ * 8; \
          gk0 = *(const f32x4*)kp_; gk1 = *(const f32x4*)(kp_ + 4); gq0 = *(const f32x4*)qp_; gq1 = *(const f32x4*)(qp_ + 4); \
          if (c8_ == 0) { const float* sm_ = SM + (r0_ + tl_) * 32; gbr = sm_[dir * 8 + hv]; gar = sm_[16 + dir * 8 + hv]; } } \
        if (tid < 256) { const int s2_ = tid >> 3, c4_ = tid & 7, tl2_ = dir ? 31 - s2_ : s2_; gv = *(const f32x4*)(ACT + (r0_ + tl2_) * 2048 + 1024 + hv * 128 + dvs * 32 + c4_ * 4); } } while (0)
#define GDN_STORE(buf_) do { float* ks_ = lds + (buf_) * BUF; float* qs_ = ks_ + 32 * 128; float* vs_ = qs_ + 32 * 128; float* sc_ = vs_ + 32 * 32; \
        { const int s_ = tid >> 4, c8_ = tid & 15; \
          *(f32x4*)(ks_ + s_ * 128 + c8_ * 4) = gk0; *(f32x4*)(ks_ + s_ * 128 + 64 + c8_ * 4) = gk1; *(f32x4*)(qs_ + s_ * 128 + c8_ * 4) = gq0; *(f32x4*)(qs_ + s_ * 128 + 64 + c8_ * 4) = gq1; \
          float kq_ = (gk0.x * gq0.x + gk0.y * gq0.y) + (gk0.z * gq0.z + gk0.w * gq0.w) + (gk1.x * gq1.x + gk1.y * gq1.y) + (gk1.z * gq1.z + gk1.w * gq1.w); \
          kq_ = group_sum<16>(kq_); \
          if (c8_ == 0) { const float beta_ = sigmoid_f(gbr), alpha_ = expf(Aneg * softplus_f(gar + dtb)); *(f32x4*)(sc_ + s_ * 4) = (f32x4){alpha_, beta_, kq_, alpha_ * beta_}; } } \
        if (tid < 256) { const int s2_ = tid >> 3, c4_ = tid & 7; *(f32x4*)(vs_ + s2_ * 32 + c4_ * 4) = gv; } } while (0)
    __syncthreads();
    GDN_LOAD(0); GDN_STORE(0);
    __syncthreads();
    for (int tile = 0; tile < 64; ++tile) {
        const int cur = tile & 1;
        const size_t row0 = (size_t)b * SEQ + (dir ? 63 - tile : tile) * 32;
        if (tile + 1 < 64) GDN_LOAD(tile + 1);
        const float* ks = lds + cur * BUF; const float* qs = ks + 32 * 128; const float* vs = qs + 32 * 128; const float* sc = vs + 32 * 32; float* os = osb + cur * 1024;
        {
            f32x4 n_k0 = *(const f32x4*)(ks + dkg * 4), n_k1 = *(const f32x4*)(ks + 64 + dkg * 4), n_q0 = *(const f32x4*)(qs + dkg * 4), n_q1 = *(const f32x4*)(qs + 64 + dkg * 4);
            f32x4 n_sc = *(const f32x4*)(sc); float n_vv = vs[dvi];
#pragma unroll 4
            for (int s = 0; s < 32; ++s) {
                const f32x4 k0 = n_k0, k1 = n_k1, q0 = n_q0, q1 = n_q1, scv = n_sc; const float vv = n_vv;
                const int sn = (s + 1) & 31;
                n_k0 = *(const f32x4*)(ks + sn * 128 + dkg * 4); n_k1 = *(const f32x4*)(ks + sn * 128 + 64 + dkg * 4);
                n_q0 = *(const f32x4*)(qs + sn * 128 + dkg * 4); n_q1 = *(const f32x4*)(qs + sn * 128 + 64 + dkg * 4);
                n_sc = *(const f32x4*)(sc + sn * 4); n_vv = vs[sn * 32 + dvi];
                const f32x2 ka = (f32x2){k0.x, k0.y}, kb = (f32x2){k0.z, k0.w}, kc = (f32x2){k1.x, k1.y}, kd = (f32x2){k1.z, k1.w};
                f32x2 pk = ka * S[0]; pk += kb * S[1]; pk += kc * S[2]; pk += kd * S[3];
                f32x2 pq = (f32x2){q0.x, q0.y} * S[0]; pq += (f32x2){q0.z, q0.w} * S[1]; pq += (f32x2){q1.x, q1.y} * S[2]; pq += (f32x2){q1.z, q1.w} * S[3];
                float sk = pk.x + pk.y, sq = pq.x + pq.y;
                sk += dpp_mov<0xB1>(sk); sq += dpp_mov<0xB1>(sq);
                sk += dpp_mov<0x4E>(sk); sq += dpp_mov<0x4E>(sq);
                sk += dpp_mov<0x141>(sk); sq += dpp_mov<0x141>(sq);
                sk += dpp_mov<0x140>(sk); sq += dpp_mov<0x140>(sq);
                const float alpha = scv.x, vn = fmaf(-scv.w, sk, scv.y * vv);
                const float po = fmaf(alpha, sq, scv.z * vn);
                const f32x2 al2 = (f32x2){alpha, alpha}, vn2 = (f32x2){vn, vn};
                S[0] = S[0] * al2 + ka * vn2; S[1] = S[1] * al2 + kb * vn2; S[2] = S[2] * al2 + kc * vn2; S[3] = S[3] * al2 + kd * vn2;
                if (dkg == 0) os[s * 32 + dvi] = po;
            }
        }
        if (tile + 1 < 64) GDN_STORE(cur ^ 1);
        __syncthreads();
        if (tid < 256) { const int s2 = tid >> 3, c4 = tid & 7, tl2 = dir ? 31 - s2 : s2; *(f32x4*)(O + (row0 + tl2) * 1024 + hv * 128 + dvs * 32 + c4 * 4) = *(const f32x4*)(os + s2 * 32 + c4 * 4); }
    }
#undef GDN_LOAD
#undef GDN_STORE
}

typedef short s16x4_t __attribute__((ext_vector_type(4)));
typedef __bf16 bf16x2_v __attribute__((ext_vector_type(2)));
__device__ __forceinline__ unsigned cvtpk_rne(float lo, float hi) { f32x2 v = {lo, hi}; bf16x2_v bb = __builtin_convertvector(v, bf16x2_v); return __builtin_bit_cast(unsigned, bb); }
template <int S_> __device__ __forceinline__ bf16x8_t acc_frag(const f32x16_t& x) {
    v4u w; w.x = cvtpk_rne(x[8 * S_ + 0], x[8 * S_ + 1]); w.y = cvtpk_rne(x[8 * S_ + 2], x[8 * S_ + 3]); w.z = cvtpk_rne(x[8 * S_ + 4], x[8 * S_ + 5]); w.w = cvtpk_rne(x[8 * S_ + 6], x[8 * S_ + 7]);
    return __builtin_bit_cast(bf16x8_t, w);
}
__device__ __forceinline__ bf16x8_t join44(v2u lo, v2u hi) { v4u w; w.x = lo.x; w.y = lo.y; w.z = hi.x; w.w = hi.y; return __builtin_bit_cast(bf16x8_t, w); }
__device__ __forceinline__ float wave_incl_scan(float v, int lane) {
#pragma unroll
    for (int o = 1; o < 64; o <<= 1) { const float t = __shfl_up(v, o); if (lane >= o) v += t; }
    return v;
}
constexpr int GDN_LDS_PER_WAVE = 17920;
__device__ __forceinline__ void gdn1_item(const Args& a, int item, unsigned char* ldsw, int lane) {
    asm volatile("" : "+v"(lane));
    const int c = item & 31, dir = (item >> 5) & 1, hv = (item >> 6) & 7, b = item >> 9, hq = hv >> 1;
    const int r32 = lane & 31, hi = lane >> 5;
    float* AT = (float*)ldsw; float* Gs = AT + 64 * 64; float* Bs = Gs + 64;
    const bf16_t* QK = (const bf16_t*)(a.ws + WS_QKV16); const float* SM = (const float*)(a.ws + WS_SMALL);
    bf16_t* GT = (bf16_t*)(a.ws + WS_GT) + (size_t)item * 4096; bf16_t* GA = (bf16_t*)(a.ws + WS_GA) + (size_t)item * 4096;
    const float Aneg = -expf(a.in[dir ? 21 : 20][hv]); const float dtb = a.in[dir ? 23 : 22][hv];
    {
        const int t = dir ? SEQ - 1 - (64 * c + lane) : 64 * c + lane; const float* sm = SM + ((size_t)b * SEQ + t) * 32;
        const float gi = Aneg * softplus_f(sm[16 + dir * 8 + hv] + dtb), bi = sigmoid_f(sm[dir * 8 + hv]);
        Gs[lane] = wave_incl_scan(gi, lane); Bs[lane] = bi;
    }
    const int t0r = dir ? SEQ - 1 - (64 * c + r32) : 64 * c + r32, t1r = dir ? t0r - 32 : t0r + 32;
    const bf16_t* k0p = QK + ((size_t)b * SEQ + t0r) * 2048 + 512 + hq * 128 + hi * 8; const bf16_t* k1p = QK + ((size_t)b * SEQ + t1r) * 2048 + 512 + hq * 128 + hi * 8;
    const bf16_t* q0p = k0p - 512, * q1p = k1p - 512;
    LDS_WAIT();
    const float Gj0 = Gs[r32], Gj1 = Gs[32 + r32];
    {
        f32x16_t kk00, kk10, kk11;
#pragma unroll
        for (int r = 0; r < 16; ++r) { kk00[r] = 0.f; kk10[r] = 0.f; kk11[r] = 0.f; }
#pragma unroll
        for (int s = 0; s < 8; ++s) {
            const bf16x8_t kA0 = *(const bf16x8_t*)(k0p + 16 * s), kA1 = *(const bf16x8_t*)(k1p + 16 * s);
            kk00 = __builtin_amdgcn_mfma_f32_32x32x16_bf16(kA0, kA0, kk00, 0, 0, 0); kk10 = __builtin_amdgcn_mfma_f32_32x32x16_bf16(kA1, kA0, kk10, 0, 0, 0); kk11 = __builtin_amdgcn_mfma_f32_32x32x16_bf16(kA1, kA1, kk11, 0, 0, 0);
        }
#pragma unroll
        for (int r = 0; r < 16; ++r) { const int il = (r & 3) + 8 * (r >> 2) + 4 * hi;
            const float Gi0 = Gs[il], Gi1 = Gs[32 + il], bi0 = Bs[il], bi1 = Bs[32 + il];
            AT[r32 * 64 + il] = (r32 < il) ? bi0 * kk00[r] * expf(Gi0 - Gj0) : 0.f;
            AT[r32 * 64 + 32 + il] = bi1 * kk10[r] * expf(Gi1 - Gj0);
            AT[(32 + r32) * 64 + 32 + il] = (r32 < il) ? bi1 * kk11[r] * expf(Gi1 - Gj1) : 0.f;
            AT[(32 + r32) * 64 + il] = 0.f;
        }
    }
    asm volatile("" ::: "memory");
    {
        f32x16_t qk00, qk10, qk11;
#pragma unroll
        for (int r = 0; r < 16; ++r) { qk00[r] = 0.f; qk10[r] = 0.f; qk11[r] = 0.f; }
#pragma unroll
        for (int s = 0; s < 8; ++s) {
            const bf16x8_t kA0 = *(const bf16x8_t*)(k0p + 16 * s), kA1 = *(const bf16x8_t*)(k1p + 16 * s), qA0 = *(const bf16x8_t*)(q0p + 16 * s), qA1 = *(const bf16x8_t*)(q1p + 16 * s);
            qk00 = __builtin_amdgcn_mfma_f32_32x32x16_bf16(qA0, kA0, qk00, 0, 0, 0); qk10 = __builtin_amdgcn_mfma_f32_32x32x16_bf16(qA1, kA0, qk10, 0, 0, 0); qk11 = __builtin_amdgcn_mfma_f32_32x32x16_bf16(qA1, kA1, qk11, 0, 0, 0);
        }
#pragma unroll
        for (int r = 0; r < 16; ++r) { const int il = (r & 3) + 8 * (r >> 2) + 4 * hi;
            const float Gi0 = Gs[il], Gi1 = Gs[32 + il];
            GA[il * 64 + r32] = (bf16_t)f2bf((r32 <= il) ? qk00[r] * expf(Gi0 - Gj0) : 0.f);
            GA[(32 + il) * 64 + r32] = (bf16_t)f2bf(qk10[r] * expf(Gi1 - Gj0));
            GA[(32 + il) * 64 + 32 + r32] = (bf16_t)f2bf((r32 <= il) ? qk11[r] * expf(Gi1 - Gj1) : 0.f);
        }
    }
    LDS_WAIT(); asm volatile("" ::: "memory");
    float tr[64];
    int lane2 = lane; asm volatile("" : "+v"(lane2) :: "memory");
#pragma unroll
    for (int j = 0; j < 64; ++j) tr[j] = (j == lane2) ? 1.f : 0.f;
    int atoff = 0;
#pragma unroll
    for (int j = 62; j >= 0; --j) { float c0 = 0.f, c1 = 0.f, c2 = 0.f, c3 = 0.f;
        asm volatile("" : "+v"(atoff) : "v"(tr[j + 1]));
#pragma unroll
        for (int qd = (j + 1) / 4; qd < 16; ++qd) { const f32x4 av = *(const f32x4*)(AT + atoff + j * 64 + 4 * qd);
            if (4 * qd + 0 > j) c0 = fmaf(tr[4 * qd + 0], av.x, c0);
            if (4 * qd + 1 > j) c1 = fmaf(tr[4 * qd + 1], av.y, c1);
            if (4 * qd + 2 > j) c2 = fmaf(tr[4 * qd + 2], av.z, c2);
            if (4 * qd + 3 > j) c3 = fmaf(tr[4 * qd + 3], av.w, c3); }
        tr[j] -= (c0 + c1) + (c2 + c3); asm volatile("" ::: "memory"); }
#pragma unroll
    for (int x = 0; x < 8; ++x) *(v4u*)(GT + lane2 * 64 + x * 8) = pack8(tr + x * 8);
    LDS_WAIT();
}

__device__ __forceinline__ void gdn2_item(const Args& a, int item, unsigned char* lds) {
    const int dvs = item & 3, hv = (item >> 2) & 7, dir = (item >> 5) & 1, b = item >> 6, hq = hv >> 1;
    const int lane0 = threadIdx.x & 63;
    constexpr int BUFB = 57344, O_K = 0, O_Q = 16384, O_T = 32768, O_A = 40960, O_V = 49152;
    float* Gs = (float*)(lds + 2 * BUFB); float* Bs = Gs + 64; float* Es = Bs + 64; float* Ws = Es + 64; float* ot = Ws + 64;
    const LAS unsigned char* ldl = (const LAS unsigned char*)lds;
    const bf16_t* QK = (const bf16_t*)(a.ws + WS_QKV16); const float* ACT = (const float*)(a.ws + WS_ACT); const float* SM = (const float*)(a.ws + WS_SMALL);
    float* O = (float*)(a.ws + (dir ? WS_YB : WS_YF));
    const float Aneg = -expf(a.in[dir ? 21 : 20][hv]); const float dtb = a.in[dir ? 23 : 22][hv];
    const size_t gbase = (size_t)(((b * 8 + hv) * 2 + dir) * 32) * 4096;
    f32x16_t S[4];
#pragma unroll
    for (int nt = 0; nt < 4; ++nt)
#pragma unroll
        for (int r = 0; r < 16; ++r) S[nt][r] = 0.f;
    float gar, gbr;
#define G2_DMA(c_, buf_) do { const int t_ = dir ? SEQ - 1 - (64 * (c_) + lane0) : 64 * (c_) + lane0; const size_t mi_ = (size_t)b * SEQ + t_; \
        const bf16_t* kr_ = QK + mi_ * 2048 + 512 + hq * 128; const bf16_t* qr_ = QK + mi_ * 2048 + hq * 128; \
        const bf16_t* tr_ = (const bf16_t*)(a.ws + WS_GT) + gbase + (size_t)(c_) * 4096 + lane0 * 64; const bf16_t* ar_ = (const bf16_t*)(a.ws + WS_GA) + gbase + (size_t)(c_) * 4096 + lane0 * 64; \
        const float* vr_ = ACT + mi_ * 2048 + 1024 + hv * 128 + dvs * 32; \
        LAS unsigned char* lb_ = (LAS unsigned char*)lds + (buf_) * BUFB; \
        _Pragma("unroll") for (int x = 0; x < 16; ++x) { __builtin_amdgcn_global_load_lds((const unsigned*)(kr_ + 8 * x), (LAS unsigned*)(lb_ + O_K + 1024 * x), 16, 0, 0); \
                                                         __builtin_amdgcn_global_load_lds((const unsigned*)(qr_ + 8 * x), (LAS unsigned*)(lb_ + O_Q + 1024 * x), 16, 0, 0); } \
        _Pragma("unroll") for (int x = 0; x < 8; ++x) { __builtin_amdgcn_global_load_lds((const unsigned*)(tr_ + 8 * x), (LAS unsigned*)(lb_ + O_T + 1024 * x), 16, 0, 0); \
                                                        __builtin_amdgcn_global_load_lds((const unsigned*)(ar_ + 8 * x), (LAS unsigned*)(lb_ + O_A + 1024 * x), 16, 0, 0); \
                                                        __builtin_amdgcn_global_load_lds((const unsigned*)(vr_ + 4 * x), (LAS unsigned*)(lb_ + O_V + 1024 * x), 16, 0, 0); } \
        const float* sm_ = SM + mi_ * 32; gar = sm_[16 + dir * 8 + hv]; gbr = sm_[dir * 8 + hv]; } while (0)
    G2_DMA(0, 0);
    for (int c = 0; c < 32; ++c) {
        int lane = lane0; asm volatile("" : "+v"(lane));
        const int r32 = lane & 31, hi = lane >> 5, trq = (lane & 15) >> 2, trp = lane & 3, trc = (lane >> 4) & 1;
        const int bo = (c & 1) * BUFB;
        float GL;
        {
            const float gi = Aneg * softplus_f(gar + dtb), bi = sigmoid_f(gbr);
            const float G = wave_incl_scan(gi, lane); GL = __shfl(G, 63);
            Gs[lane] = G; Bs[lane] = bi; Es[lane] = expf(G); Ws[lane] = expf(GL - G);
        }
        asm volatile("s_waitcnt vmcnt(0)" ::: "memory");
        if (c + 1 < 32) G2_DMA(c + 1, (c + 1) & 1);
        LDS_WAIT();
        f32x16_t KS[2];
#pragma unroll
        for (int rt = 0; rt < 2; ++rt)
#pragma unroll
            for (int r = 0; r < 16; ++r) KS[rt][r] = 0.f;
#define LFRAG(off_) join44(*(const LAS v2u*)(ldl + (off_)), *(const LAS v2u*)(ldl + (off_) + 1024))
#pragma unroll
        for (int nt = 0; nt < 4; ++nt) {
            const bf16x8_t sb0 = acc_frag<0>(S[nt]), sb1 = acc_frag<1>(S[nt]);
#pragma unroll
            for (int rt = 0; rt < 2; ++rt) {
                const int ro = bo + O_K + ((4 * nt) * 64 + 32 * rt + r32) * 16 + 8 * hi;
                KS[rt] = __builtin_amdgcn_mfma_f32_32x32x16_bf16(LFRAG(ro), sb0, KS[rt], 0, 0, 0); KS[rt] = __builtin_amdgcn_mfma_f32_32x32x16_bf16(LFRAG(ro + 2048), sb1, KS[rt], 0, 0, 0);
            }
        }
        asm volatile("" ::: "memory");
        f32x16_t rhs[2];
#pragma unroll
        for (int rt = 0; rt < 2; ++rt)
#pragma unroll
            for (int r = 0; r < 16; ++r) { const int i = 32 * rt + (r & 3) + 8 * (r >> 2) + 4 * hi;
                const float vv = *(const LAS float*)(ldl + bo + O_V + ((r32 >> 2) * 64 + i) * 16 + (r32 & 3) * 4); const float bi = Bs[i];
                rhs[rt][r] = bi * vv - bi * Es[i] * KS[rt][r]; }
        asm volatile("" ::: "memory");
        f32x16_t vn[2];
#pragma unroll
        for (int r = 0; r < 16; ++r) { vn[0][r] = 0.f; vn[1][r] = 0.f; }
        {
            const bf16x8_t rb00 = acc_frag<0>(rhs[0]), rb01 = acc_frag<1>(rhs[0]), rb10 = acc_frag<0>(rhs[1]), rb11 = acc_frag<1>(rhs[1]);
            const int t0 = bo + O_T + r32 * 16 + 8 * hi, t1 = t0 + 512;
            vn[0] = __builtin_amdgcn_mfma_f32_32x32x16_bf16(LFRAG(t0), rb00, vn[0], 0, 0, 0); vn[0] = __builtin_amdgcn_mfma_f32_32x32x16_bf16(LFRAG(t0 + 2048), rb01, vn[0], 0, 0, 0);
            vn[1] = __builtin_amdgcn_mfma_f32_32x32x16_bf16(LFRAG(t1), rb00, vn[1], 0, 0, 0); vn[1] = __builtin_amdgcn_mfma_f32_32x32x16_bf16(LFRAG(t1 + 2048), rb01, vn[1], 0, 0, 0);
            vn[1] = __builtin_amdgcn_mfma_f32_32x32x16_bf16(LFRAG(t1 + 4096), rb10, vn[1], 0, 0, 0); vn[1] = __builtin_amdgcn_mfma_f32_32x32x16_bf16(LFRAG(t1 + 6144), rb11, vn[1], 0, 0, 0);
        }
        asm volatile("" ::: "memory");
        f32x16_t QS[2];
#pragma unroll
        for (int rt = 0; rt < 2; ++rt)
#pragma unroll
            for (int r = 0; r < 16; ++r) QS[rt][r] = 0.f;
#pragma unroll
        for (int nt = 0; nt < 4; ++nt) {
            const bf16x8_t sb0 = acc_frag<0>(S[nt]), sb1 = acc_frag<1>(S[nt]);
#pragma unroll
            for (int rt = 0; rt < 2; ++rt) {
                const int ro = bo + O_Q + ((4 * nt) * 64 + 32 * rt + r32) * 16 + 8 * hi;
                QS[rt] = __builtin_amdgcn_mfma_f32_32x32x16_bf16(LFRAG(ro), sb0, QS[rt], 0, 0, 0); QS[rt] = __builtin_amdgcn_mfma_f32_32x32x16_bf16(LFRAG(ro + 2048), sb1, QS[rt], 0, 0, 0);
            }
        }
        asm volatile("" ::: "memory");
        {
            const bf16x8_t vb00 = acc_frag<0>(vn[0]), vb01 = acc_frag<1>(vn[0]), vb10 = acc_frag<0>(vn[1]), vb11 = acc_frag<1>(vn[1]);
            const int a0 = bo + O_A + r32 * 16 + 8 * hi, a1 = a0 + 512;
            f32x16_t o0, o1;
#pragma unroll
            for (int r = 0; r < 16; ++r) { const int il = (r & 3) + 8 * (r >> 2) + 4 * hi; o0[r] = Es[il] * QS[0][r]; o1[r] = Es[32 + il] * QS[1][r]; }
            o0 = __builtin_amdgcn_mfma_f32_32x32x16_bf16(LFRAG(a0), vb00, o0, 0, 0, 0); o0 = __builtin_amdgcn_mfma_f32_32x32x16_bf16(LFRAG(a0 + 2048), vb01, o0, 0, 0, 0);
            o1 = __builtin_amdgcn_mfma_f32_32x32x16_bf16(LFRAG(a1), vb00, o1, 0, 0, 0); o1 = __builtin_amdgcn_mfma_f32_32x32x16_bf16(LFRAG(a1 + 2048), vb01, o1, 0, 0, 0);
            o1 = __builtin_amdgcn_mfma_f32_32x32x16_bf16(LFRAG(a1 + 4096), vb10, o1, 0, 0, 0); o1 = __builtin_amdgcn_mfma_f32_32x32x16_bf16(LFRAG(a1 + 6144), vb11, o1, 0, 0, 0);
#pragma unroll
            for (int r = 0; r < 16; ++r) { const int il = (r & 3) + 8 * (r >> 2) + 4 * hi; ot[il * 33 + r32] = o0[r]; ot[(32 + il) * 33 + r32] = o1[r]; }
            LDS_WAIT();
            { const int t = dir ? SEQ - 1 - (64 * c + lane) : 64 * c + lane; float* orow = O + ((size_t)b * SEQ + t) * 1024 + hv * 128 + dvs * 32;
#pragma unroll
              for (int x = 0; x < 8; ++x) *(f32x4*)(orow + 4 * x) = (f32x4){ot[lane * 33 + 4 * x], ot[lane * 33 + 4 * x + 1], ot[lane * 33 + 4 * x + 2], ot[lane * 33 + 4 * x + 3]}; }
        }
        asm volatile("" ::: "memory");
        {
#pragma unroll
            for (int r = 0; r < 16; ++r) { const int il = (r & 3) + 8 * (r >> 2) + 4 * hi; vn[0][r] *= Ws[il]; vn[1][r] *= Ws[32 + il]; }
            const bf16x8_t wb[4] = {acc_frag<0>(vn[0]), acc_frag<1>(vn[0]), acc_frag<0>(vn[1]), acc_frag<1>(vn[1])};
            const float eGL = expf(GL);
#pragma unroll
            for (int nt = 0; nt < 4; ++nt) {
#pragma unroll
                for (int r = 0; r < 16; ++r) S[nt][r] *= eGL;
#pragma unroll
                for (int ks = 0; ks < 4; ++ks) {
                    const int ro = bo + O_K + ((4 * nt + 2 * trc + (trp >> 1)) * 64 + 16 * ks + 4 * hi + trq) * 16 + 8 * (trp & 1);
                    const s16x4_t lo = __builtin_bit_cast(s16x4_t, __builtin_amdgcn_ds_read_tr16_b64_v4i16((LAS s16x4_t*)(ldl + ro)));
                    const s16x4_t hi4 = __builtin_bit_cast(s16x4_t, __builtin_amdgcn_ds_read_tr16_b64_v4i16((LAS s16x4_t*)(ldl + ro + 8 * 16)));
                    const bf16x8_t kf = (bf16x8_t){lo[0], lo[1], lo[2], lo[3], hi4[0], hi4[1], hi4[2], hi4[3]};
                    S[nt] = __builtin_amdgcn_mfma_f32_32x32x16_bf16(kf, wb[ks], S[nt], 0, 0, 0);
                }
            }
        }
        LDS_WAIT();
    }
#undef LFRAG
#undef G2_DMA
}

__device__ __forceinline__ void lru_tile(const Args& a, int item, unsigned char* lds, int pass) {
    const int n = item & 7, tc = (item >> 3) & 63, b = item >> 9, t0 = tc * 32;
    float* xc = (float*)lds; bf16_t* xcb = (bf16_t*)(lds + 16384); float* As = (float*)(lds + 25088); float* Us = As + 2 * 32 * 128; float2* sg = (float2*)(Us + 2 * 32 * 128);
    const int tid = threadIdx.x, lane = tid & 63, wave = tid >> 6;
    const bf16_t* P = (const bf16_t*)(a.ws + WS_PROJ);
    __syncthreads();
    {
        const int j = tid & 127, tg = tid >> 7, chn = n * 128 + j; const float* cw = a.in[25];
        const float w0 = cw[chn], w1 = cw[1024 + chn], w2 = cw[2048 + chn], w3 = cw[3072 + chn], cbias = a.in[26][chn];
        const int tb = t0 + tg * 8;
        const bf16_t* pp = P + ((size_t)b * SEQ + tb) * NINP + C_XL + chn;
        float xm2 = (tb >= 2) ? bf2f(pp[-2 * NINP]) : 0.f, xm1 = (tb >= 1) ? bf2f(pp[-NINP]) : 0.f, x0 = bf2f(pp[0]);
#pragma unroll
        for (int i = 0; i < 8; ++i) { const float xp1 = (tb + i + 1 < SEQ) ? bf2f(pp[(i + 1) * NINP]) : 0.f;
            const float acc = cbias + w0 * xm2 + w1 * xm1 + w2 * x0 + w3 * xp1;
            xc[(tg * 8 + i) * 128 + j] = acc; xcb[(tg * 8 + i) * 136 + j] = (bf16_t)f2bf(acc);
            xm2 = xm1; xm1 = x0; x0 = xp1; }
    }
    __syncthreads();
    {
        const int ct = wave & 3, d = wave >> 2, r32 = lane & 31, hi = lane >> 5;
        const bf16_t* WT = (const bf16_t*)(a.ws + WS_WGT);
        const bf16_t* wa_p = WT + ((size_t)((2 * d) * 8 + n) * 128 + ct * 32 + r32) * 128 + hi * 8;
        const bf16_t* wx_p = WT + ((size_t)((2 * d + 1) * 8 + n) * 128 + ct * 32 + r32) * 128 + hi * 8;
        f32x16_t ca, cx;
#pragma unroll
        for (int r = 0; r < 16; ++r) { ca[r] = 0.f; cx[r] = 0.f; }
#pragma unroll
        for (int s = 0; s < 8; ++s) {
            const bf16x8_t af = *(const bf16x8_t*)((const char*)xcb + r32 * 272 + (s * 16 + hi * 8) * 2);
            const bf16x8_t fa = *(const bf16x8_t*)(wa_p + s * 16); const bf16x8_t fx = *(const bf16x8_t*)(wx_p + s * 16);
            ca = __builtin_amdgcn_mfma_f32_32x32x16_bf16(af, fa, ca, 0, 0, 0); cx = __builtin_amdgcn_mfma_f32_32x32x16_bf16(af, fx, cx, 0, 0, 0);
        }
        const int j = ct * 32 + r32, cj = n * 128 + j;
        const float baj = a.in[d ? 33 : 28][cj], bxj = a.in[d ? 35 : 30][cj], sp = softplus_f(-a.in[d ? 36 : 31][cj]);
#pragma unroll
        for (int r = 0; r < 16; ++r) { const int t = (r & 3) + 8 * (r >> 2) + 4 * hi;
            const float rg = sigmoid_f(ca[r] + baj), ig = sigmoid_f(cx[r] + bxj); const float la = -8.f * rg * sp;
            As[(d * 32 + t) * 128 + j] = expf(la); Us[(d * 32 + t) * 128 + j] = sqrtf(-expm1f(2.f * la)) * (ig * xc[t * 128 + j]); }
    }
    __syncthreads();
    {
        const int j = tid & 127, d = (tid >> 7) & 1, seg = tid >> 8;
        float Pp = 1.f, H = 0.f;
#pragma unroll
        for (int k = 0; k < 16; ++k) { const int q = seg * 16 + k, t = d ? 31 - q : q; const float a_ = As[(d * 32 + t) * 128 + j], u_ = Us[(d * 32 + t) * 128 + j]; H = fmaf(a_, H, u_); Pp *= a_; }
        sg[(d * 2 + seg) * 128 + j] = make_float2(Pp, H);
        __syncthreads();
        float2* LS = (float2*)(a.ws + WS_LSUM);
        if (pass == 0) {
            if (seg == 0) { const float2 s1 = sg[(d * 2 + 1) * 128 + j]; LS[((size_t)(d * 4 + b) * 64 + tc) * 1024 + n * 128 + j] = make_float2(Pp * s1.x, fmaf(s1.x, H, s1.y)); }
        } else {
            float c = 0.f;
            const float2* lsp = LS + ((size_t)(d * 4 + b) * 64) * 1024 + n * 128 + j;
#pragma unroll 1
            for (int c0 = 0; c0 < 64; c0 += 16) { float2 sv[16];
#pragma unroll
                for (int i = 0; i < 16; ++i) { const int cc = d ? 63 - (c0 + i) : c0 + i; sv[i] = lsp[(size_t)cc * 1024]; }
#pragma unroll
                for (int i = 0; i < 16; ++i) { const int cc = d ? 63 - (c0 + i) : c0 + i; const bool before = d ? (cc > tc) : (cc < tc); if (before) c = fmaf(sv[i].x, c, sv[i].y); } }
            if (seg == 1) { const float2 s0 = sg[(d * 2) * 128 + j]; c = fmaf(s0.x, c, s0.y); }
            float h = c;
#pragma unroll
            for (int k = 0; k < 16; ++k) { const int q = seg * 16 + k, t = d ? 31 - q : q; const float a_ = As[(d * 32 + t) * 128 + j], u_ = Us[(d * 32 + t) * 128 + j]; h = fmaf(a_, h, u_); Us[(d * 32 + t) * 128 + j] = h; }
            __syncthreads();
            bf16_t* YC = (bf16_t*)(a.ws + WS_YCAT);
            const int jj = tid & 127, tg = tid >> 7;
#pragma unroll
            for (int i = 0; i < 8; ++i) { const int t = tg * 8 + i; const size_t row = (size_t)b * SEQ + t0 + t;
                const float hs = Us[t * 128 + jj] + Us[(32 + t) * 128 + jj]; const float gl = bf2f(P[row * NINP + C_GL + n * 128 + jj]);
                YC[row * 2048 + 1024 + n * 128 + jj] = (bf16_t)f2bf(hs * silu_f(gl)); }
        }
    }
}

__device__ __forceinline__ void combine1_phase(const Args& a, int gw, int NGW, int lane) {
    const float* OF = (const float*)(a.ws + WS_YF); const float* OB = (const float*)(a.ws + WS_YB);
    const bf16_t* P = (const bf16_t*)(a.ws + WS_PROJ); bf16_t* YC = (bf16_t*)(a.ws + WS_YCAT);
    const float* gn = a.in[24];
    for (int m = gw; m < MTOK; m += NGW) {
        const int ch = lane * 16, d0 = ch & 127;
        float z[16], ov[16];
        unpack8(*(const v4u*)(P + (size_t)m * NINP + C_Z + ch), z); unpack8(*(const v4u*)(P + (size_t)m * NINP + C_Z + ch + 8), z + 8);
#pragma unroll
        for (int q = 0; q < 4; ++q) { const f32x4 f = *(const f32x4*)(OF + (size_t)m * 1024 + ch + 4 * q), bk = *(const f32x4*)(OB + (size_t)m * 1024 + ch + 4 * q); const f32x4 o = f + bk;
            ov[4 * q] = o.x; ov[4 * q + 1] = o.y; ov[4 * q + 2] = o.z; ov[4 * q + 3] = o.w; }
        float ss = 0.f;
#pragma unroll
        for (int i = 0; i < 16; ++i) ss += ov[i] * ov[i];
        ss = group_sum<8>(ss);
        const float r = rsqrtf(ss * (1.f / 128.f) + EPS);
#pragma unroll
        for (int i = 0; i < 16; ++i) ov[i] = ov[i] * r * gn[d0 + i] * silu_f(z[i]);
        *(v4u*)(YC + (size_t)m * 2048 + ch) = pack8(ov); *(v4u*)(YC + (size_t)m * 2048 + ch + 8) = pack8(ov + 8);
    }
}

__device__ __forceinline__ void final_norm_phase(const Args& a, int gw, int NGW, int lane) {
    const float* nw = a.in[38];
    for (int m = gw; m < MTOK; m += NGW) {
        f32x4* xr = (f32x4*)(a.out + (size_t)m * 2048) + lane;
        f32x4 v[8]; float s = 0.f;
#pragma unroll
        for (int j = 0; j < 8; ++j) { v[j] = xr[64 * j]; s += (v[j].x * v[j].x + v[j].y * v[j].y) + (v[j].z * v[j].z + v[j].w * v[j].w); }
        const float rstd = rsqrtf(group_sum<64>(s) * (1.f / 2048.f) + EPS);
#pragma unroll
        for (int j = 0; j < 8; ++j) { const f32x4 w = *(const f32x4*)(nw + (64 * j + lane) * 4); xr[64 * j] = v[j] * rstd * w; }
    }
}

typedef GAS unsigned gu32;
#define RLX_AGENT __ATOMIC_RELAXED, __HIP_MEMORY_SCOPE_AGENT
constexpr int CW_BAR = 4096;
constexpr int MISC_OFF = 147456 - 128;
#define XB_TMO      128
#define XB_XCNT(j)  (256  + 64 * (j))
#define XB_XSUB(j)  (1280 + 64 * (j))
#define XB_XGEN(j)  (2304 + 64 * (j))
#define XB_TOP      3328
#define XB_TOPGEN   3392
#define XCD_BAR_WORDS 3456
#define XB_SPIN_CAP (1u << 18)

__device__ __forceinline__ unsigned xb_ld(unsigned* p)              { return __hip_atomic_load(p, __ATOMIC_RELAXED, __HIP_MEMORY_SCOPE_AGENT); }
__device__ __forceinline__ unsigned xb_add(unsigned* p, unsigned v) { return __hip_atomic_fetch_add(p, v, __ATOMIC_RELAXED, __HIP_MEMORY_SCOPE_AGENT); }
__device__ __forceinline__ unsigned xb_xcc_id() { return (unsigned)__builtin_amdgcn_s_getreg((3 << 11) | 20) & 0xFu; }
#define XB_SPIN(cond, bar) do { unsigned _sp = 0; while (cond) { __builtin_amdgcn_s_sleep(1); \
    if ((++_sp & 255u) == 0u) { if (xb_ld(&(bar)[XB_TMO])) break; if (_sp > XB_SPIN_CAP) { atomicAdd(&(bar)[XB_TMO], 1u); break; } } } } while (0)

struct XcdBarrier {
    unsigned* bar; unsigned x;
    volatile LAS unsigned* st;
};

__device__ __forceinline__ XcdBarrier xcd_barrier_post(unsigned* bar, volatile LAS unsigned* st) {
    XcdBarrier b; b.bar = bar; b.x = xb_xcc_id(); b.st = st;
    if (threadIdx.x == 0) (void)xb_add(&bar[XB_XCNT(b.x)], 1u);
    return b;
}
__device__ __forceinline__ void xcd_barrier_complete(unsigned* bar, unsigned x, unsigned& nloc, unsigned& nx) {
    const unsigned G = gridDim.x * gridDim.y * gridDim.z;
    unsigned sum, cnt, mine, sp = 0u;
    for (;;) {
        sum = 0u; cnt = 0u; mine = 0u;
#pragma unroll
        for (unsigned j = 0; j < 16; ++j) { const unsigned c = xb_ld(&bar[XB_XCNT(j)]); sum += c; cnt += (c > 0u) ? 1u : 0u; mine = (j == x) ? c : mine; }
        if (sum == G) break;
        __builtin_amdgcn_s_sleep(1);
        if ((++sp & 255u) == 0u) { if (xb_ld(&bar[XB_TMO])) break; if (sp > XB_SPIN_CAP) { atomicAdd(&bar[XB_TMO], 1u); break; } }
    }
    nloc = mine > 0u ? mine : 1u; nx = cnt > 0u ? cnt : 1u;
}

__device__ __forceinline__ void xcd_barrier(const XcdBarrier& b) {
    asm volatile("s_waitcnt vmcnt(0)" ::: "memory");
    __syncthreads();
    if (threadIdx.x == 0) {
        unsigned* bar = b.bar;
        __builtin_amdgcn_s_waitcnt(0);
        unsigned nloc = b.st[0], nx = b.st[1];
        if (nloc == 0u) { xcd_barrier_complete(bar, b.x, nloc, nx); b.st[0] = nloc; b.st[1] = nx; }
        const unsigned old = xb_add(&bar[XB_XSUB(b.x)], 1u);
        const unsigned gen = old / nloc;
        if (old + 1u == (gen + 1u) * nloc) {
            __builtin_amdgcn_fence(__ATOMIC_RELEASE, "agent");
            asm volatile("s_waitcnt vmcnt(0)" ::: "memory");
            const unsigned og = xb_add(&bar[XB_TOP], 1u);
            const unsigned tg = og / nx;
            if (og + 1u == (tg + 1u) * nx) xb_add(&bar[XB_TOPGEN], 1u);
            else XB_SPIN(xb_ld(&bar[XB_TOPGEN]) == tg, bar);
            __builtin_amdgcn_fence(__ATOMIC_ACQUIRE, "agent");
            xb_add(&bar[XB_XGEN(b.x)], 1u);
            asm volatile("s_waitcnt vmcnt(0)" ::: "memory");
        } else {
            XB_SPIN(xb_ld(&bar[XB_XGEN(b.x)]) == gen, bar);
            __builtin_amdgcn_fence(__ATOMIC_ACQUIRE, "agent");
            asm volatile("s_waitcnt vmcnt(0)" ::: "memory");
        }
    }
    __syncthreads();
}

#ifndef PROBE_MASK
#define PROBE_MASK 0
#endif
#define REP(bit) for (int rep_ = 0; rep_ < 1 + ((PROBE_MASK >> (bit)) & 1); ++rep_)
#ifndef PROBE_SSD
#define PROBE_SSD 0
#endif
#ifndef PROBE_GDN
#define PROBE_GDN 0
#endif
#ifndef PROBE_LRU
#define PROBE_LRU 0
#endif
#ifndef MK_SINGLE
#define MK_SINGLE 1
#endif
__global__ void __launch_bounds__(NTHREADS, 2) mk_fwd(Args a) {
    extern __shared__ __attribute__((aligned(16))) unsigned char lds[];
    LAS unsigned char* ldsl = (LAS unsigned char*)lds;
    const int tid = threadIdx.x, lane = tid & 63, wave = __builtin_amdgcn_readfirstlane(tid >> 6);
    const int G = gridDim.x, bx = blockIdx.x;
    const int vcu = (G % 8 == 0) ? (bx % 8) * (G / 8) + bx / 8 : bx;
    const int gw = vcu * NWAVES + wave, NGW = G * NWAVES;
    unsigned char* ws = a.ws;
    volatile LAS unsigned* MISC = (volatile LAS unsigned*)(ldsl + MISC_OFF);
    if (tid < 32) MISC[tid] = 0u;
    __syncthreads();
    XcdBarrier bar; bar.bar = (unsigned*)(ws + WS_CTL) + CW_BAR; bar.x = 0; bar.st = nullptr;
    if (a.ph_hi - a.ph_lo > 1) bar = xcd_barrier_post((unsigned*)(ws + WS_CTL) + CW_BAR, MISC + 8);
#define IN(k) (a.ph_lo <= (k) && (k) < a.ph_hi)
#define SEAM(k) do { if (IN(k) && IN((k) + 1)) { xcd_barrier(bar); } } while (0)

    if (IN(0)) { p0_prologue(a, ldsl, vcu, G); } SEAM(0);
    if (IN(1)) { REP(0) normmod_phase(a, a.in[0], 0, gw, NGW, lane); } SEAM(1);
    if (IN(2)) {
        pg8::Gemm g{(const bf16_t*)(ws + WS_H), (const bf16_t*)(ws + WS_WIN0), MTOK, NINP, 2048}; pg8::StaticOrder S; S.init(MTOK, NINP, G, bx);
        pg8::EpiProj E{(bf16_t*)(ws + WS_PROJ), (float*)(ws + WS_SMALL), NINP, A_DT / 256};
        REP(1) { pg8::gemm_phase<pg8::EpiProj, pg8::StaticOrder, true, true>(ldsl, g, S, E); __syncthreads(); }
    } SEAM(2);
    if (IN(3)) { REP(0) post0_phase(a, gw, NGW, lane); } SEAM(3);
    if (IN(4)) {
        REP(3) for (int u = vcu; u < 256; u += G) { const int b = u >> 6, h = (u >> 3) & 7, qb = u & 7, kvh = h >> 2; const size_t row0 = (size_t)b * SEQ + qb * 256;
            att::attn_dense_body((const att::bf16*)(ws + WS_QB) + row0 * 1024 + h * 128, (const att::bf16*)(ws + WS_KB) + (size_t)b * SEQ * 256 + kvh * 128,
                                 (const att::bf16*)(ws + WS_VB) + (size_t)b * SEQ * 256 + kvh * 128, (bf16_t*)(ws + WS_YCAT) + row0 * 2048 + h * 128,
                                 (const bf16_t*)(ws + WS_PROJ) + row0 * NINP + A_GA + h * 128, SEQ, (char*)lds);
            __syncthreads(); }
        for (int rep = 0; rep < 1 + PROBE_SSD; ++rep) { for (int it = bx; it < 256; it += G) ssd_item(a, it, (float*)lds); __syncthreads(); }
    } SEAM(4);
    if (IN(5)) { REP(0) ssd_combine_phase(a, gw, NGW, lane); } SEAM(5);
    if (IN(6)) {
        pg8::Gemm g{(const bf16_t*)(ws + WS_YCAT), (const bf16_t*)(ws + WS_WOUT0), MTOK, 2048, 2048}; pg8::StaticOrder S; S.init(MTOK, 2048, G, bx);
        pg8::EpiResid E{a.in[0], a.out, (const float*)(ws + WS_MOD), a.in[3]};
        REP(2) { pg8::gemm_phase<pg8::EpiResid, pg8::StaticOrder, true, true>(ldsl, g, S, E); __syncthreads(); }
    } SEAM(6);
    if (IN(7)) { REP(0) normmod_phase(a, a.out, 1, gw, NGW, lane); } SEAM(7);
    if (IN(8)) {
        pg8::Gemm g{(const bf16_t*)(ws + WS_H), (const bf16_t*)(ws + WS_WIN1), MTOK, NINP, 2048}; pg8::StaticOrder S; S.init(MTOK, NINP, G, bx);
        pg8::EpiProj E{(bf16_t*)(ws + WS_PROJ), (float*)(ws + WS_SMALL), NINP, C_SM / 256};
        pg8::gemm_phase<pg8::EpiProj, pg8::StaticOrder, true, true>(ldsl, g, S, E);
    } SEAM(8);
    if (IN(9)) { REP(0) post1_phase(a, gw, NGW, lane); } SEAM(9);
    if (IN(10)) {
        REP(5) { for (int it = gw; it < 2048; it += NGW) gdn1_item(a, it, lds + wave * GDN_LDS_PER_WAVE, lane); __syncthreads(); }
        for (int rep = 0; rep < 1 + PROBE_LRU; ++rep) { for (int it = bx; it < 2048; it += G) lru_tile(a, it, lds, 0); __syncthreads(); }
    } SEAM(10);
    if (IN(11)) {
        REP(6) { if (wave == 0) { for (int it = vcu; it < 256; it += G) gdn2_item(a, it, lds); } __syncthreads(); }
    } SEAM(11);
    if (IN(12)) { REP(0) combine1_phase(a, gw, NGW, lane); __syncthreads(); REP(4) { for (int it = bx; it < 2048; it += G) lru_tile(a, it, lds, 1); __syncthreads(); } } SEAM(12);
    if (IN(13)) {
        pg8::Gemm g{(const bf16_t*)(ws + WS_YCAT), (const bf16_t*)(ws + WS_WOUT1), MTOK, 2048, 2048}; pg8::StaticOrder S; S.init(MTOK, 2048, G, bx);
        pg8::EpiResid E{a.out, a.out, (const float*)(ws + WS_MOD) + 4 * 6144, a.in[3] + 6144};
        pg8::gemm_phase<pg8::EpiResid, pg8::StaticOrder, true, true>(ldsl, g, S, E);
    } SEAM(13);
    if (IN(14)) { final_norm_phase(a, gw, NGW, lane); }
#undef IN
#undef SEAM
}

extern "C" void kernel_launch(void* const* d_in, const int* in_sizes, int n_in, void* d_out, int out_size, void* d_ws, size_t ws_size, hipStream_t stream) {
    static int grid = 0;
    if (grid == 0) {
        if (n_in != 39 || out_size != MTOK * DM || ws_size < WS_END) { fprintf(stderr, "kernel_launch: unexpected problem (n_in %d, out %d, ws %zu < %zu)\n", n_in, out_size, ws_size, (size_t)WS_END); grid = -1; return; }
        int dev = 0, cus = 0, per_cu = 0;
        if (hipGetDevice(&dev) != hipSuccess || hipDeviceGetAttribute(&cus, hipDeviceAttributeMultiprocessorCount, dev) != hipSuccess) { grid = -1; return; }
        if (hipFuncSetAttribute((const void*)mk_fwd, hipFuncAttributeMaxDynamicSharedMemorySize, LDS_BYTES) != hipSuccess) { fprintf(stderr, "kernel_launch: hipFuncSetAttribute failed\n"); grid = -1; return; }
        if (hipOccupancyMaxActiveBlocksPerMultiprocessor(&per_cu, (const void*)mk_fwd, NTHREADS, LDS_BYTES) != hipSuccess || per_cu < 1) { fprintf(stderr, "kernel_launch: occupancy query says %d\n", per_cu); (void)hipGetLastError(); per_cu = 1; }
        grid = cus;
    }
    if (grid < 0) return;
    (void)hipMemsetAsync((char*)d_ws + WS_CTL, 0, CTL_ZERO_BYTES, stream);
    Args a{};
    for (int i = 0; i < 39; ++i) a.in[i] = (const float*)d_in[i];
    a.out = (float*)d_out; a.ws = (unsigned char*)d_ws;
#if MK_SINGLE
    a.ph_lo = 0; a.ph_hi = NPHASE;
    void* kargs[] = {&a};
    hipError_t e = hipLaunchCooperativeKernel((const void*)mk_fwd, dim3(grid), dim3(NTHREADS), kargs, LDS_BYTES, stream);
    if (e != hipSuccess) fprintf(stderr, "kernel_launch: cooperative launch failed: %s (grid %d)\n", hipGetErrorString(e), grid);
#else
    for (int p = 0; p < NPHASE; ++p) { a.ph_lo = p; a.ph_hi = p + 1; hipLaunchKernelGGL(mk_fwd, dim3(grid), dim3(NTHREADS), LDS_BYTES, stream, a); }
#endif
}
```

```cpp
#include <hip/hip_runtime.h>
#include <hip/hip_cooperative_groups.h>
#include <hip/hip_bf16.h>
#include <cstdio>
#include <cstdint>
namespace cg = cooperative_groups;

constexpr int BATCH = 4, SEQ = 2048, DM = 2048, MTOK = BATCH * SEQ;
constexpr int NIN = 5152, NINP = 5376;
constexpr float EPS = 1e-6f;
constexpr int A_Q = 0, A_K = 1024, A_V = 1280, A_GA = 1536, A_XS = 2560, A_BS = 3584, A_CS = 3840, A_DT = 4096, A_Z = 4128;
constexpr int C_Q = 0, C_K = 512, C_V = 1024, C_SM = 2048, C_Z = 2080, C_XL = 3104, C_GL = 4128;
namespace pg8 {
#define PG8_LAS __attribute__((address_space(3)))
typedef unsigned short bf16_t;
typedef short bf16x8 __attribute__((ext_vector_type(8)));
typedef float f32x4 __attribute__((ext_vector_type(4)));
typedef unsigned u32x4 __attribute__((ext_vector_type(4)));
constexpr int BM = 256, BK = 64, HALF = 128, HTB = HALF * BK * 2  , STAGE_BYTES = 8 * HTB, NXCD = 8, WGM = 8;

__host__ __device__ __forceinline__ int lds_byte(int r, int c) { const int st = (r >> 4) * 2 + (c >> 5), rr = r & 15, cc = c & 31, ob = rr * 64 + cc * 2; return st * 1024 + (ob ^ (((ob >> 9) & 1) << 5)); }
__host__ __device__ __forceinline__ void stage_rc(int b, int& R, int& C) { const int st = b / 1024, sb = b % 1024, swz = sb ^ (((sb >> 9) & 1) << 5); R = (st >> 1) * 16 + swz / 64; C = (st & 1) * 32 + (swz % 64) / 2; }
__host__ __device__ __forceinline__ int perm32(int rho) { const int n = rho >> 4, i = rho & 15; return 8 * (i >> 2) + 4 * n + (i & 3); }

struct Unit { int pm, pn; };
struct Gemm { const bf16_t* A; const bf16_t* Bt; int M, N, K; };

struct StaticOrder {
    int nM, nN, nwg, G, c;
    __host__ __device__ void init(int M, int N, int G_, int c_) { nM = M / BM; nN = N / BM; nwg = nM * nN; G = G_; c = c_; }
    __host__ __device__ bool next(int i, Unit& u) const {
        const long L = (long)i * G + c; if (L >= nwg) return false;
        int wgid = (int)L; { const int q = nwg / NXCD, r = nwg % NXCD, xcd = wgid % NXCD, off = wgid / NXCD; wgid = (xcd < r ? xcd * (q + 1) : r * (q + 1) + (xcd - r) * q) + off; }
        const int nig = WGM * nN, gid = wgid / nig, fm = gid * WGM, gsz = (nM - fm) < WGM ? (nM - fm) : WGM;
        u.pm = fm + ((wgid % nig) % gsz); u.pn = (wgid % nig) / gsz; return true;
    }
    __device__ __forceinline__ void a_ready(const Unit&) const {}
    __device__ __forceinline__ void done(const Unit&) const {}
};

__device__ __forceinline__ unsigned cvt_pk_bf16(float lo, float hi) { unsigned r; asm volatile("v_cvt_pk_bf16_f32 %0, %1, %2" : "=v"(r) : "v"(lo), "v"(hi)); return r; }
typedef float f32x2 __attribute__((ext_vector_type(2)));
struct EpiProj {
    static constexpr bool PERM = true, AFTER_DRAIN = false;
    bf16_t* O; float* small; int ldc; int small_tile;
    __device__ __forceinline__ void operator()(const f32x4 (&acc)[2][2][4][2], const Unit& u, int wr, int wc, int fr, int fq) const {
        const int row0 = u.pm * BM + wr * 64 + fr; const int col0 = u.pn * BM + wc * 32 + 8 * fq;
        const bool sm = (u.pn == small_tile) && (wc == 0);
#pragma unroll
        for (int ai = 0; ai < 2; ++ai)
#pragma unroll
            for (int m = 0; m < 4; ++m) { const int row = row0 + ai * HALF + m * 16; bf16_t* rowp = O + (size_t)row * ldc + col0;
#pragma unroll
                for (int bj = 0; bj < 2; ++bj) { const f32x4 v0 = acc[ai][bj][m][0], v1 = acc[ai][bj][m][1];
                    u32x4 w; w.x = cvt_pk_bf16(v0[0], v0[1]); w.y = cvt_pk_bf16(v0[2], v0[3]); w.z = cvt_pk_bf16(v1[0], v1[1]); w.w = cvt_pk_bf16(v1[2], v1[3]);
                    *(u32x4*)(rowp + bj * HALF) = w; }
                if (sm) { float* sp = small + (size_t)row * 32 + 8 * fq; *(f32x4*)sp = acc[ai][0][m][0]; *(f32x4*)(sp + 4) = acc[ai][0][m][1]; } }
    }
};
struct EpiResid {
    static constexpr bool PERM = false, AFTER_DRAIN = false;
    const float* xin; float* xout; const float* gacc; const float* gbias;
    __device__ __forceinline__ void operator()(const f32x4 (&acc)[2][2][4][2], const Unit& u, int wr, int wc, int fr, int fq) const {
        const int b = u.pm >> 3;
        const int col0 = u.pn * BM + wc * 32 + 4 * fq;
#pragma unroll
        for (int bj = 0; bj < 2; ++bj)
#pragma unroll
            for (int n = 0; n < 2; ++n) { const int col = col0 + bj * HALF + n * 16;
                const f32x4 g = *(const f32x4*)(gacc + (size_t)b * 6144 + 4096 + col) + *(const f32x4*)(gbias + 4096 + col);
#pragma unroll
                for (int ai = 0; ai < 2; ++ai)
#pragma unroll
                    for (int m = 0; m < 4; ++m) { const size_t off = (size_t)(u.pm * BM + ai * HALF + wr * 64 + m * 16 + fr) * 2048 + col;
                        const f32x4 xv = *(const f32x4*)(xin + off); *(f32x4*)(xout + off) = xv + g * acc[ai][bj][m][n]; } }
    }
};
template <class Epi, class Sched, bool ALIGN_EPI = false, bool SP2 = false>
__device__ __forceinline__ void gemm_phase(PG8_LAS unsigned char* lds, const Gemm g, const Sched& S, const Epi& E) {
    const int tid = threadIdx.x, wid = __builtin_amdgcn_readfirstlane(tid >> 6), lane = tid & 63, wr = wid >> 2, wc = wid & 3, fr = lane & 15, fq = lane >> 4;
    const int K = g.K, nt = K / BK;
    unsigned voffA[2], voffB[2];
#pragma unroll
    for (int i = 0; i < 2; ++i) { int R, C; stage_rc(tid * 16 + i * 8192, R, C); const int Rb = Epi::PERM ? ((R & ~31) + perm32(R & 31)) : R;
        voffA[i] = (unsigned)(R * K + C) * 2u; voffB[i] = (unsigned)(Rb * K + C) * 2u; }
    const size_t kstep = (size_t)(BK * 2);
    const size_t hstep = (size_t)HALF * K * 2;
    const size_t tstep = 2 * hstep;
    const unsigned ldsw = (unsigned)wid * 1024u;
    const int aoff = lds_byte(wr * 64 + fr, fq * 8), boff = lds_byte(wc * 32 + fr, fq * 8);
#define PG8_SA(b, h) (((b) * 2 + (h)) * HTB)
#define PG8_SB(b, h) ((4 + (b) * 2 + (h)) * HTB)
#define PG8_STAGE(bufoff, gbase, voff) do { _Pragma("unroll") for (int _i = 0; _i < 2; ++_i) \
        __builtin_amdgcn_global_load_lds((const unsigned*)((const char*)(gbase) + (voff)[_i]), (PG8_LAS unsigned*)(lds + (bufoff) + ldsw + _i * 8192), 16, 0, 0); } while (0)
#define PG8_LDA(dst, b, h) do { _Pragma("unroll") for (int m = 0; m < 4; ++m) _Pragma("unroll") for (int k = 0; k < 2; ++k) dst[m][k] = *(const PG8_LAS bf16x8*)(lds + PG8_SA(b, h) + aoff + m * 2048 + k * 1024); } while (0)
#define PG8_LDB(dst, b, h) do { _Pragma("unroll") for (int n = 0; n < 2; ++n) _Pragma("unroll") for (int k = 0; k < 2; ++k) dst[n][k] = *(const PG8_LAS bf16x8*)(lds + PG8_SB(b, h) + boff + n * 2048 + k * 1024); } while (0)
#define PG8_MMA(ai, bj, At, Bt) do { __builtin_amdgcn_s_setprio(1); _Pragma("unroll") for (int m = 0; m < 4; ++m) _Pragma("unroll") for (int n = 0; n < 2; ++n) _Pragma("unroll") for (int k = 0; k < 2; ++k) \
        acc[ai][bj][m][n] = __builtin_amdgcn_mfma_f32_16x16x32_bf16(Bt[n][k], At[m][k], acc[ai][bj][m][n], 0, 0, 0); __builtin_amdgcn_s_setprio(0); } while (0)
#define PG8_WAIT_V(n) asm volatile("s_waitcnt vmcnt(" #n ")" ::: "memory")
#define PG8_WAIT_L(n) asm volatile("s_waitcnt lgkmcnt(" #n ")" ::: "memory")
#define PG8_BAR __builtin_amdgcn_s_barrier()
#define PG8_SCHED __builtin_amdgcn_sched_barrier(0)
    Unit cur, nxt; int ui = 0;
    if (!S.next(0, cur)) return;
    f32x4 acc[2][2][4][2];
#pragma unroll
    for (int a = 0; a < 2; ++a)
#pragma unroll
        for (int b = 0; b < 2; ++b)
#pragma unroll
            for (int m = 0; m < 4; ++m)
#pragma unroll
                for (int n = 0; n < 2; ++n) acc[a][b][m][n] = (f32x4){0.f, 0.f, 0.f, 0.f};
    bf16x8 At[4][2], B0[2][2], B1[2][2];
    const char* cA = (const char*)g.A + (size_t)cur.pm * tstep; const char* cB = (const char*)g.Bt + (size_t)cur.pn * tstep;
    S.a_ready(cur);
    if constexpr (SP2) {
        PG8_STAGE(PG8_SB(0, 0), cB, voffB); PG8_STAGE(PG8_SB(0, 1), cB + hstep, voffB); PG8_STAGE(PG8_SA(0, 0), cA, voffA); PG8_STAGE(PG8_SA(0, 1), cA + hstep, voffA);
        if (wr == 1) PG8_BAR;
        PG8_WAIT_V(2); PG8_BAR;
        PG8_STAGE(PG8_SB(1, 0), cB + kstep, voffB); PG8_STAGE(PG8_SA(1, 0), cA + kstep, voffA); PG8_STAGE(PG8_SB(1, 1), cB + hstep + kstep, voffB);
        PG8_WAIT_V(6); PG8_BAR;
    } else {
        PG8_STAGE(PG8_SB(0, 0), cB, voffB); PG8_STAGE(PG8_SA(0, 0), cA, voffA); PG8_STAGE(PG8_SB(0, 1), cB + hstep, voffB); PG8_STAGE(PG8_SA(0, 1), cA + hstep, voffA);
        if (wr == 1) PG8_BAR;
        PG8_WAIT_V(4); PG8_BAR;
        PG8_STAGE(PG8_SB(1, 0), cB + kstep, voffB); PG8_STAGE(PG8_SA(1, 0), cA + kstep, voffA); PG8_STAGE(PG8_SB(1, 1), cB + hstep + kstep, voffB);
        PG8_WAIT_V(6); PG8_BAR;
    }
    for (;;) {
        const bool has_next = S.next(ui + 1, nxt);
        const char* nA = has_next ? (const char*)g.A + (size_t)nxt.pm * tstep : cA; const char* nB = has_next ? (const char*)g.Bt + (size_t)nxt.pn * tstep : cB;
        for (int t = 0; t < nt; t += 2) {
            const bool last = (t == nt - 2);
            const char* a1 = cA + (size_t)(t + 1) * kstep;
            const char* a2 = last ? nA : cA + (size_t)(t + 2) * kstep; const char* b2 = last ? nB : cB + (size_t)(t + 2) * kstep;
            const char* a3 = a2 + kstep; const char* b3 = b2 + kstep;
            if (last && has_next) S.a_ready(nxt);
            if constexpr (SP2) {
            PG8_LDB(B0, 0, 0); PG8_LDB(B1, 0, 1); PG8_SCHED; PG8_LDA(At, 0, 0); PG8_STAGE(PG8_SA(1, 1), a1 + hstep, voffA);
            PG8_WAIT_V(8); PG8_WAIT_L(0); PG8_BAR; PG8_MMA(0, 0, At, B0); PG8_MMA(0, 1, At, B1); PG8_BAR; PG8_SCHED;
            PG8_LDA(At, 0, 1); PG8_STAGE(PG8_SB(0, 0), b2, voffB); PG8_STAGE(PG8_SB(0, 1), b2 + hstep, voffB); PG8_STAGE(PG8_SA(0, 0), a2, voffA);
            PG8_WAIT_V(8); PG8_WAIT_L(0); PG8_BAR; PG8_MMA(1, 0, At, B0); PG8_MMA(1, 1, At, B1); PG8_BAR; PG8_SCHED;
            PG8_LDB(B0, 1, 0); PG8_LDB(B1, 1, 1); PG8_SCHED; PG8_LDA(At, 1, 0); PG8_STAGE(PG8_SA(0, 1), a2 + hstep, voffA);
            PG8_WAIT_V(8); PG8_WAIT_L(0); PG8_BAR; PG8_MMA(0, 0, At, B0); PG8_MMA(0, 1, At, B1); PG8_BAR; PG8_SCHED;
            PG8_LDA(At, 1, 1); PG8_STAGE(PG8_SB(1, 0), b3, voffB); PG8_STAGE(PG8_SB(1, 1), b3 + hstep, voffB); PG8_STAGE(PG8_SA(1, 0), a3, voffA);
            PG8_WAIT_V(8); PG8_WAIT_L(0); PG8_BAR; PG8_MMA(1, 0, At, B0); PG8_MMA(1, 1, At, B1); PG8_BAR; PG8_SCHED;
            } else {
            PG8_LDB(B0, 0, 0); PG8_SCHED; PG8_LDA(At, 0, 0); PG8_STAGE(PG8_SA(1, 1), a1 + hstep, voffA);
            PG8_WAIT_L(8); PG8_BAR; PG8_WAIT_L(0); PG8_MMA(0, 0, At, B0); PG8_BAR; PG8_SCHED;
            PG8_LDB(B1, 0, 1); PG8_STAGE(PG8_SB(0, 0), b2, voffB);
            PG8_BAR; PG8_WAIT_L(0); PG8_MMA(0, 1, At, B1); PG8_BAR;
            PG8_LDA(At, 0, 1); PG8_STAGE(PG8_SA(0, 0), a2, voffA);
            PG8_BAR; PG8_WAIT_L(0); PG8_MMA(1, 0, At, B0); PG8_BAR; PG8_SCHED;
            PG8_STAGE(PG8_SB(0, 1), b2 + hstep, voffB);
            PG8_WAIT_V(6); PG8_BAR; PG8_MMA(1, 1, At, B1); PG8_BAR;
            PG8_LDB(B0, 1, 0); PG8_SCHED; PG8_LDA(At, 1, 0); PG8_STAGE(PG8_SA(0, 1), a2 + hstep, voffA);
            PG8_WAIT_L(8); PG8_BAR; PG8_WAIT_L(0); PG8_MMA(0, 0, At, B0); PG8_BAR; PG8_SCHED;
            PG8_LDB(B1, 1, 1); PG8_STAGE(PG8_SB(1, 0), b3, voffB);
            PG8_BAR; PG8_WAIT_L(0); PG8_MMA(0, 1, At, B1); PG8_BAR;
            PG8_LDA(At, 1, 1); PG8_STAGE(PG8_SA(1, 0), a3, voffA);
            PG8_BAR; PG8_WAIT_L(0); PG8_MMA(1, 0, At, B0); PG8_BAR; PG8_SCHED;
            PG8_STAGE(PG8_SB(1, 1), b3 + hstep, voffB);
            PG8_WAIT_V(6); PG8_BAR; PG8_MMA(1, 1, At, B1); PG8_BAR;
            }
        }
        if constexpr (ALIGN_EPI) { if (wr == 0) PG8_BAR; }
        if constexpr (!Epi::AFTER_DRAIN) { E(acc, cur, wr, wc, fr, fq); S.done(cur); }
        if (!has_next) break;
#pragma unroll
        for (int a = 0; a < 2; ++a)
#pragma unroll
            for (int b = 0; b < 2; ++b)
#pragma unroll
                for (int m = 0; m < 4; ++m)
#pragma unroll
                    for (int n = 0; n < 2; ++n) acc[a][b][m][n] = (f32x4){0.f, 0.f, 0.f, 0.f};
        cur = nxt; cA = nA; cB = nB; ++ui;
        if constexpr (ALIGN_EPI) { if (wr == 1) PG8_BAR; }
    }
    PG8_WAIT_V(0);
    if constexpr (!ALIGN_EPI) { if (wr == 0) PG8_BAR; }
    PG8_BAR;
    if constexpr (Epi::AFTER_DRAIN) { E.fused(acc, cur, wr, wc, fr, fq, lds, wid, lane); S.done(cur); }
#undef PG8_SA
#undef PG8_SB
#undef PG8_STAGE
#undef PG8_LDA
#undef PG8_LDB
#undef PG8_MMA
#undef PG8_WAIT_V
#undef PG8_WAIT_L
#undef PG8_BAR
#undef PG8_SCHED
}
}
namespace att {
using bf16 = __hip_bfloat16;
constexpr int   D = 128, NW = 8, QBLK = 32, KVBLK = 64;
constexpr float SCALE = 0.088388347648318440f;
constexpr float THR = 8.f;
constexpr int SDEPTH = 2;
constexpr int LDQ = 1024, LDK = 256, LDY = 2048, LDG = NINP;
constexpr size_t SHM_V = KVBLK * D * 2, SHM_K = KVBLK * D * 2, SHM_ATTN = 2 * SHM_V + 2 * SHM_K + NW * 64 * 4;
using bf16x8 = __attribute__((ext_vector_type(8))) short;
using s16x4  = __attribute__((ext_vector_type(4))) short;
using f32x16 = __attribute__((ext_vector_type(16))) float;
using f32x8  = __attribute__((ext_vector_type(8))) float;
using u32x4  = __attribute__((ext_vector_type(4))) unsigned;
#define KSWZ(row, colB) ((row) * 256 + ((colB) ^ (((row) & 7) << 4)))
#define SBAR() __builtin_amdgcn_sched_barrier(0)
__device__ __forceinline__ int crow(int r, int hi) { return (r & 3) + 8 * (r >> 2) + 4 * hi; }
__device__ __forceinline__ unsigned cvtpk(float lo, float hi) {
  unsigned r; asm volatile("v_cvt_pk_bf16_f32 %0, %1, %2" : "=v"(r) : "v"(lo), "v"(hi)); return r;
}
template <typename TIn> struct Stage;
template <> struct Stage<bf16>  { using T = bf16x8;
  __device__ static __forceinline__ T ld8(const bf16* p) { return *reinterpret_cast<const bf16x8*>(p); }
  __device__ static __forceinline__ bf16x8 tobf(T x) { return x; } };
template <> struct Stage<float> { using T = f32x8;
  __device__ static __forceinline__ T ld8(const float* p) { return *reinterpret_cast<const f32x8*>(p); }
  __device__ static __forceinline__ bf16x8 tobf(T x) {
    u32x4 w = {cvtpk(x[0], x[1]), cvtpk(x[2], x[3]), cvtpk(x[4], x[5]), cvtpk(x[6], x[7])}; return *reinterpret_cast<bf16x8*>(&w); } };

__device__ __forceinline__ void partialSM(f32x16& p0, f32x16& p1, float& m_reg, float& mn, float& alpha) {
  constexpr float C = SCALE * 1.4426950408889634f;
  float pmax = p0[0]; for (int r = 1; r < 16; ++r) pmax = fmaxf(pmax, p0[r]); for (int r = 0; r < 16; ++r) pmax = fmaxf(pmax, p1[r]);
  { auto rr = __builtin_amdgcn_permlane32_swap(__float_as_uint(pmax), __float_as_uint(pmax), false, false);
    pmax = fmaxf(__uint_as_float(rr[0]), __uint_as_float(rr[1])); }
  if (__builtin_expect(__all(pmax - m_reg <= THR / SCALE), 1)) { mn = m_reg; alpha = 1.f; }
  else { mn = fmaxf(m_reg, pmax); alpha = __builtin_amdgcn_exp2f((m_reg - mn) * C); m_reg = mn; }
  float mnC = -mn * C;
  for (int r = 0; r < 16; ++r) p0[r] = fmaf(p0[r], C, mnC); for (int r = 0; r < 16; ++r) p1[r] = fmaf(p1[r], C, mnC);
  for (int r = 0; r < 16; ++r) p0[r] = __builtin_amdgcn_exp2f(p0[r]);
}
__device__ __forceinline__ void finishSM(f32x16& p0, f32x16& p1, float alpha, float& l_reg, bf16x8& pa0, bf16x8& pa1, bf16x8& pa2, bf16x8& pa3) {
  for (int r = 0; r < 16; ++r) p1[r] = __builtin_amdgcn_exp2f(p1[r]);
  float ps = 0; for (int r = 0; r < 16; ++r) ps += p0[r]; for (int r = 0; r < 16; ++r) ps += p1[r];
  { auto rr = __builtin_amdgcn_permlane32_swap(__float_as_uint(ps), __float_as_uint(ps), false, false);
    ps = __uint_as_float(rr[0]) + __uint_as_float(rr[1]); }
  l_reg = l_reg * alpha + ps;
#define PK4(P, BASE, OUT) do { unsigned a0 = cvtpk(P[BASE + 0], P[BASE + 1]), a1 = cvtpk(P[BASE + 2], P[BASE + 3]);   \
    unsigned b0 = cvtpk(P[BASE + 4], P[BASE + 5]), b1 = cvtpk(P[BASE + 6], P[BASE + 7]);                              \
    auto r0 = __builtin_amdgcn_permlane32_swap(a0, b0, false, false); auto r1 = __builtin_amdgcn_permlane32_swap(a1, b1, false, false); \
    u32x4 w = {r0[0], r1[0], r0[1], r1[1]}; OUT = *reinterpret_cast<bf16x8*>(&w); } while (0)
  PK4(p0, 0, pa0); PK4(p0, 8, pa1); PK4(p1, 0, pa2); PK4(p1, 8, pa3);
#undef PK4
}
__device__ __forceinline__ void qkt(f32x16& p0, f32x16& p1, const bf16* Ks, const bf16x8* qr, int r32, int hi) {
  p0 = f32x16{}; p1 = f32x16{};
  for (int d0 = 0; d0 < 8; ++d0) { int cb = (d0 * 16 + hi * 8) * 2;
    bf16x8 b0 = *reinterpret_cast<const bf16x8*>((const char*)Ks + KSWZ(r32, cb));
    bf16x8 b1 = *reinterpret_cast<const bf16x8*>((const char*)Ks + KSWZ(32 + r32, cb));
    p0 = __builtin_amdgcn_mfma_f32_32x32x16_bf16(b0, qr[d0], p0, 0, 0, 0);
    p1 = __builtin_amdgcn_mfma_f32_32x32x16_bf16(b1, qr[d0], p1, 0, 0, 0); }
}
__device__ __forceinline__ int v_st(int k, int c) { const int kk = (k & ~0xC) | ((k & 4) << 1) | ((k & 8) >> 1); return ((kk >> 3) * 4 + (c >> 5)) * 512 + ((kk & 7) * 32 + (c & 31)) * 2; }
__device__ __forceinline__ int v_rd_base(int lane) { return ((lane & 3) << 3) | (((lane >> 2) & 3) << 6) | (((lane >> 4) & 1) << 5) | (((lane >> 5) & 1) << 8); }
constexpr int v_rd_off(int d0, int ks, int half) { return d0 * 512 + ks * 4096 + half * 2048; }
template <int OFF> __device__ __forceinline__ s16x4 tr_read(int vb) {
  s16x4 r; asm volatile("ds_read_b64_tr_b16 %0, %1 offset:%2" : "=&v"(r) : "v"(vb), "i"(OFF) : "memory"); return r;
}
template <int D0> __device__ __forceinline__ void pv_one(f32x16& od, int vb, bf16x8 pa0, bf16x8 pa1, bf16x8 pa2, bf16x8 pa3) {
  const s16x4 l0 = tr_read<v_rd_off(D0, 0, 0)>(vb), h0 = tr_read<v_rd_off(D0, 0, 1)>(vb), l1 = tr_read<v_rd_off(D0, 1, 0)>(vb), h1 = tr_read<v_rd_off(D0, 1, 1)>(vb);
  const s16x4 l2 = tr_read<v_rd_off(D0, 2, 0)>(vb), h2 = tr_read<v_rd_off(D0, 2, 1)>(vb), l3 = tr_read<v_rd_off(D0, 3, 0)>(vb), h3 = tr_read<v_rd_off(D0, 3, 1)>(vb);
  asm volatile("s_waitcnt lgkmcnt(0)" ::: "memory"); SBAR();
#define PK(L, H) (bf16x8){L[0], L[1], L[2], L[3], H[0], H[1], H[2], H[3]}
  od = __builtin_amdgcn_mfma_f32_32x32x16_bf16(pa0, PK(l0, h0), od, 0, 0, 0);
  od = __builtin_amdgcn_mfma_f32_32x32x16_bf16(pa1, PK(l1, h1), od, 0, 0, 0);
  od = __builtin_amdgcn_mfma_f32_32x32x16_bf16(pa2, PK(l2, h2), od, 0, 0, 0);
  od = __builtin_amdgcn_mfma_f32_32x32x16_bf16(pa3, PK(l3, h3), od, 0, 0, 0);
#undef PK
}
__device__ __forceinline__ void pv_d0(f32x16* o, int vb, bf16x8 pa0, bf16x8 pa1, bf16x8 pa2, bf16x8 pa3) {
  pv_one<0>(o[0], vb, pa0, pa1, pa2, pa3); pv_one<1>(o[1], vb, pa0, pa1, pa2, pa3); pv_one<2>(o[2], vb, pa0, pa1, pa2, pa3); pv_one<3>(o[3], vb, pa0, pa1, pa2, pa3);
}
__device__ __forceinline__ void attn_dense_body(const bf16* __restrict__ Qb, const bf16* __restrict__ Kh, const bf16* __restrict__ Vh,
                                                unsigned short* __restrict__ Yb, const unsigned short* __restrict__ Gb, int seq, char* lds) {
  using St = Stage<bf16>; using SQ = Stage<bf16>; using TQ = bf16;
  const int tid = threadIdx.x, wid = tid >> 6, lane = tid & 63, r32 = lane & 31, hi = lane >> 5;
  bf16* V_lds = (bf16*)lds; bf16* K_lds = (bf16*)(lds + 2 * SHM_V);
  float* ws = (float*)(lds + 2 * SHM_V + 2 * SHM_K) + wid * 64; float* li_l = ws; float* al_l = ws + 32;
  float m_reg = -1e30f, l_reg = 0; f32x16 o[4] = {}; bf16x8 qr[8];
  const TQ* Qw = Qb + (long)(wid * QBLK + r32) * LDQ + hi * 8;
#pragma unroll
  for (int d0 = 0; d0 < 8; ++d0) qr[d0] = SQ::tobf(SQ::ld8(Qw + d0 * 16));
  const int sr = tid >> 4, sc = (tid & 15) * 8, vst0 = v_st(sr, sc), vst1 = v_st(32 + sr, sc);
  const int vb0 = (int)(uintptr_t)V_lds + v_rd_base(lane);
  struct { typename St::T vs0, vs1, ks0, ks1; } sr_[SDEPTH];
#define SLOAD(i, k0) do { sr_[i].vs0 = St::ld8(&Vh[(long)((k0) + sr) * LDK + sc]); sr_[i].vs1 = St::ld8(&Vh[(long)((k0) + 32 + sr) * LDK + sc]); \
    sr_[i].ks0 = St::ld8(&Kh[(long)((k0) + sr) * LDK + sc]); sr_[i].ks1 = St::ld8(&Kh[(long)((k0) + 32 + sr) * LDK + sc]); } while (0)
#define SWRITE(b, i) do { *(bf16x8*)((char*)V_lds + (b) * SHM_V + vst0) = St::tobf(sr_[i].vs0);          \
    *(bf16x8*)((char*)V_lds + (b) * SHM_V + vst1) = St::tobf(sr_[i].vs1); int kc = sc * 2;               \
    *(bf16x8*)((char*)K_lds + (b) * SHM_K + KSWZ(sr, kc)) = St::tobf(sr_[i].ks0);                       \
    *(bf16x8*)((char*)K_lds + (b) * SHM_K + KSWZ(32 + sr, kc)) = St::tobf(sr_[i].ks1); } while (0)
#define SWAIT() do { if constexpr (SDEPTH == 2) asm volatile("s_waitcnt vmcnt(4)" ::: "memory"); else asm volatile("s_waitcnt vmcnt(0)" ::: "memory"); } while (0)
#define RESC(a) do { if (__any((a) < 1.f)) { if (hi == 0) al_l[r32] = (a); asm volatile("s_waitcnt lgkmcnt(0)" ::: "memory"); \
    for (int d = 0; d < 4; ++d) for (int r = 0; r < 16; ++r) o[d][r] *= al_l[crow(r, hi)]; } } while (0)
  f32x16 pA0, pA1, pB0, pB1; float mnA, mnB, alA, alB; bf16x8 pa0, pa1, pa2, pa3; const int NT = seq / KVBLK;
  constexpr int SE = 0, SO = SDEPTH - 1;
  SLOAD(SE, 0); asm volatile("s_waitcnt vmcnt(0)" ::: "memory"); SWRITE(0, SE); __syncthreads();
  qkt(pA0, pA1, K_lds, qr, r32, hi); partialSM(pA0, pA1, m_reg, mnA, alA);
  SLOAD(SO, KVBLK); if constexpr (SDEPTH == 2) { if (2 < NT) SLOAD(SE, 2 * KVBLK); }
  SWAIT(); SWRITE(1, SO); __syncthreads();
  for (int j = 1; j + 1 < NT; j += 2) {
    SBAR(); qkt(pB0, pB1, (bf16*)((char*)K_lds + SHM_K), qr, r32, hi);
    finishSM(pA0, pA1, alA, l_reg, pa0, pa1, pa2, pa3); SBAR();
    SLOAD(SO, (j + SDEPTH) * KVBLK); SBAR();
    pv_d0(o, vb0, pa0, pa1, pa2, pa3); partialSM(pB0, pB1, m_reg, mnB, alB);
    __syncthreads(); SWAIT(); SWRITE(0, SE);
    RESC(alB); __syncthreads();
    SBAR(); qkt(pA0, pA1, K_lds, qr, r32, hi);
    finishSM(pB0, pB1, alB, l_reg, pa0, pa1, pa2, pa3); SBAR();
    if (SDEPTH == 1 || j + 3 < NT) SLOAD(SE, (j + 1 + SDEPTH) * KVBLK); SBAR();
    pv_d0(o, vb0 + (int)SHM_V, pa0, pa1, pa2, pa3); partialSM(pA0, pA1, m_reg, mnA, alA);
    __syncthreads(); SWAIT(); SWRITE(1, SO);
    RESC(alA); __syncthreads();
  }
  SBAR(); qkt(pB0, pB1, (bf16*)((char*)K_lds + SHM_K), qr, r32, hi);
  finishSM(pA0, pA1, alA, l_reg, pa0, pa1, pa2, pa3); SBAR();
  pv_d0(o, vb0, pa0, pa1, pa2, pa3); partialSM(pB0, pB1, m_reg, mnB, alB);
  __syncthreads(); RESC(alB);
  finishSM(pB0, pB1, alB, l_reg, pa0, pa1, pa2, pa3); SBAR();
  pv_d0(o, vb0 + (int)SHM_V, pa0, pa1, pa2, pa3);
  if (hi == 0) li_l[r32] = l_reg; asm volatile("s_waitcnt lgkmcnt(0)" ::: "memory");
  float rli[16];
#pragma unroll
  for (int r = 0; r < 16; ++r) rli[r] = __builtin_amdgcn_rcpf(li_l[crow(r, hi)]);
  int eoff = (wid * QBLK + 4 * hi) ; asm volatile("" : "+v"(eoff));
  const unsigned short* Gw = Gb + (long)eoff * LDG + r32; unsigned short* Yw = Yb + (long)eoff * LDY + r32;
#pragma unroll
  for (int r = 0; r < 16; ++r) { const int orow = (r & 3) + 8 * (r >> 2);
#pragma unroll
    for (int d0 = 0; d0 < 4; ++d0) { const float g = __uint_as_float(((unsigned)Gw[orow * LDG + d0 * 32]) << 16);
      const float val = o[d0][r] * rli[r] * (g / (1.f + __expf(-g)));
      unsigned ub = __float_as_uint(val); ub = (ub + 0x7fffu + ((ub >> 16) & 1u)) >> 16;
      Yw[orow * LDY + d0 * 32] = (unsigned short)ub; } }
#undef SLOAD
#undef SWRITE
#undef SWAIT
#undef RESC
}
}
#define GAS __attribute__((address_space(1)))
#define LAS __attribute__((address_space(3)))
typedef unsigned short bf16_t;
typedef unsigned v4u __attribute__((ext_vector_type(4)));
typedef unsigned v2u __attribute__((ext_vector_type(2)));
typedef float f32x4 __attribute__((ext_vector_type(4)));
typedef short bf16x8_t __attribute__((ext_vector_type(8)));
typedef float f32x16_t __attribute__((ext_vector_type(16)));
#define LDS_WAIT() asm volatile("s_waitcnt lgkmcnt(0)" ::: "memory")

constexpr size_t MiB = 1u << 20;
constexpr size_t WS_CTL = 0, CTL_ZERO_BYTES = 1 * MiB;
constexpr size_t WS_MOD = 64 * 1024;
constexpr size_t WS_ROPE = 1 * MiB;
constexpr size_t WS_SMALL = 2 * MiB;
constexpr size_t WS_WIN0 = 3 * MiB, WS_WOUT0 = 24 * MiB;
constexpr size_t WS_QB = 32 * MiB, WS_KB = 48 * MiB, WS_VB = 52 * MiB;
constexpr size_t WS_HB = 3 * MiB;
constexpr size_t WS_WIN1 = 56 * MiB, WS_WOUT1 = 77 * MiB;
constexpr size_t WS_H = 85 * MiB;
constexpr size_t WS_HF = 85 * MiB;
constexpr size_t WS_PROJ = 117 * MiB;
constexpr size_t WS_YCAT = 201 * MiB;
constexpr size_t WS_ACT = 233 * MiB;
constexpr size_t WS_YF = 297 * MiB, WS_YB = 329 * MiB;
constexpr size_t WS_XBC16 = 85 * MiB;
constexpr size_t WS_QKV16 = 3 * MiB;
constexpr size_t WS_GT = 85 * MiB, WS_GA = 101 * MiB;
constexpr size_t WS_WGT = 361 * MiB;
constexpr size_t WS_LSUM = 362 * MiB;
constexpr size_t WS_END = 366 * MiB;

constexpr int NWAVES = 8, NTHREADS = 512;
constexpr int LDS_BYTES = 147456;
constexpr int NPHASE = 15;

struct Args { const float* in[39]; float* out; unsigned char* ws; int ph_lo, ph_hi; };

__device__ __forceinline__ float bf2f(unsigned v) { return __uint_as_float(v << 16); }
__device__ __forceinline__ unsigned f2bf(float f) { unsigned u = __float_as_uint(f); return (u + 0x7fffu + ((u >> 16) & 1u)) >> 16; }
__device__ __forceinline__ unsigned pk2(float lo, float hi) { return f2bf(lo) | (f2bf(hi) << 16); }
__device__ __forceinline__ void unpack8(const v4u w, float* x) {
    x[0] = __uint_as_float(w.x << 16); x[1] = __uint_as_float(w.x & 0xffff0000u); x[2] = __uint_as_float(w.y << 16); x[3] = __uint_as_float(w.y & 0xffff0000u);
    x[4] = __uint_as_float(w.z << 16); x[5] = __uint_as_float(w.z & 0xffff0000u); x[6] = __uint_as_float(w.w << 16); x[7] = __uint_as_float(w.w & 0xffff0000u);
}
__device__ __forceinline__ v4u pack8(const float* x) { v4u w; w.x = pk2(x[0], x[1]); w.y = pk2(x[2], x[3]); w.z = pk2(x[4], x[5]); w.w = pk2(x[6], x[7]); return w; }
__device__ __forceinline__ float silu_f(float x) { return x / (1.f + expf(-x)); }
__device__ __forceinline__ float sigmoid_f(float x) { return 1.f / (1.f + expf(-x)); }
__device__ __forceinline__ float softplus_f(float x) { return fmaxf(x, 0.f) + log1pf(expf(-fabsf(x))); }
template <int CTRL> __device__ __forceinline__ float dpp_mov(float v) { return __builtin_bit_cast(float, __builtin_amdgcn_update_dpp(0, __builtin_bit_cast(int, v), CTRL, 0xF, 0xF, true)); }
template <int N> __device__ __forceinline__ float group_sum(float v) {
    if (N >= 2) v += dpp_mov<0xB1>(v);
    if (N >= 4) v += dpp_mov<0x4E>(v);
    if (N >= 8) v += dpp_mov<0x141>(v);
    if (N >= 16) v += dpp_mov<0x140>(v);
    if (N >= 32) v += __shfl_xor(v, 16);
    if (N >= 64) v += __shfl_xor(v, 32);
    return v;
}

__device__ __forceinline__ void p0_transpose_item(const float* W, int K, int N, bf16_t* WT, int row_off, LAS float* scr, int item, int lane) {
    const int nblk = N / 32, kb = item / nblk, nb = item % nblk, k0 = 64 * kb, n0 = 32 * nb;
#pragma unroll 8
    for (int i = 0; i < 32; ++i) { const int kk = 2 * i + (lane >> 5); scr[kk * 33 + (lane & 31)] = W[(size_t)(k0 + kk) * N + n0 + (lane & 31)]; }
    LDS_WAIT(); asm volatile("" ::: "memory");
    const int c = lane & 7;
#pragma unroll
    for (int j = 0; j < 4; ++j) { const int n = (lane >> 3) + 8 * j; const LAS float* s = scr + (8 * c) * 33 + n;
        v4u o; o.x = pk2(s[0 * 33], s[1 * 33]); o.y = pk2(s[2 * 33], s[3 * 33]); o.z = pk2(s[4 * 33], s[5 * 33]); o.w = pk2(s[6 * 33], s[7 * 33]);
        *(v4u*)(WT + (size_t)(row_off + n0 + n) * K + k0 + 8 * c) = o; }
    LDS_WAIT(); asm volatile("" ::: "memory");
}

__device__ __forceinline__ void p0_prologue(const Args& a, LAS unsigned char* lds, int vcu, int G) {
    const int tid = threadIdx.x, lane = tid & 63, wave = tid >> 6;
    unsigned char* ws = a.ws;
    { const int gid = blockIdx.x * NTHREADS + tid;
      if (gid < 2048) { const int pos = gid >> 5, i = gid & 31; const float freq = expf(-(float)i * (1.f / 32.f) * 9.210340371976184f); const float ang = (float)pos * freq;
          float* rt = (float*)(ws + WS_ROPE); rt[2 * gid] = cosf(ang); rt[2 * gid + 1] = sinf(ang); } }
    { const int gid = blockIdx.x * NTHREADS + tid, gn = G * NTHREADS; constexpr int NV = (NINP - NIN) * 2048 * 2 / 16;
      v4u* p0 = (v4u*)(ws + WS_WIN0 + (size_t)NIN * 2048 * 2); v4u* p1 = (v4u*)(ws + WS_WIN1 + (size_t)NIN * 2048 * 2);
      for (int i = gid; i < NV; i += gn) { p0[i] = (v4u){0, 0, 0, 0}; p1[i] = (v4u){0, 0, 0, 0}; } }
    if (blockIdx.x < 192) {
        const int it = blockIdx.x, l = it / 96, r = it % 96, kc = r / 3, nc = r % 3;
        LAS float* cond = (LAS float*)lds;
        if (tid < 256) { const int b = tid >> 6, k = tid & 63; const float c = a.in[1][b * 2048 + kc * 64 + k]; cond[tid] = silu_f(c); }
        __syncthreads();
        const float* W = a.in[2] + (size_t)l * 2048 * 6144 + (size_t)(kc * 64) * 6144 + nc * 2048 + tid * 4;
        f32x4 acc0 = {0, 0, 0, 0}, acc1 = acc0, acc2 = acc0, acc3 = acc0;
#pragma unroll 8
        for (int k = 0; k < 64; ++k) { const f32x4 w = *(const f32x4*)(W + (size_t)k * 6144);
            acc0 += cond[k] * w; acc1 += cond[64 + k] * w; acc2 += cond[128 + k] * w; acc3 += cond[192 + k] * w; }
        float* macc = (float*)(ws + WS_MOD) + (size_t)l * 4 * 6144 + nc * 2048 + tid * 4;
#pragma unroll
        for (int i = 0; i < 4; ++i) { atomicAdd(macc + i, acc0[i]); atomicAdd(macc + 6144 + i, acc1[i]); atomicAdd(macc + 2 * 6144 + i, acc2[i]); atomicAdd(macc + 3 * 6144 + i, acc3[i]); }
        __syncthreads();
    }
    { LAS float* scr = (LAS float*)(lds + wave * 16384);
      const int gw = vcu * NWAVES + wave, NGW = G * NWAVES;
      constexpr int I_IN = 32 * (NIN / 32), I_OUT = 32 * 64, I_G = 32 * 8, NITEMS = 2 * (I_IN + I_OUT) + I_G;
      for (int it = gw; it < NITEMS; it += NGW) {
          int r = it;
          if (r < I_G) { const int mn = r >> 3, m = mn >> 3; const float* Wg = a.in[m == 0 ? 27 : m == 1 ? 29 : m == 2 ? 32 : 34] + (size_t)(mn & 7) * 128 * 128;
              p0_transpose_item(Wg, 128, 128, (bf16_t*)(ws + WS_WGT) + (size_t)mn * 128 * 128, 0, scr, r & 7, lane); continue; } r -= I_G;
          if (r < I_IN) { p0_transpose_item(a.in[5], 2048, NIN, (bf16_t*)(ws + WS_WIN0), 0, scr, r, lane); continue; } r -= I_IN;
          if (r < I_IN) { p0_transpose_item(a.in[17], 2048, NIN, (bf16_t*)(ws + WS_WIN1), 0, scr, r, lane); continue; } r -= I_IN;
          if (r < I_OUT) { p0_transpose_item(a.in[16], 2048, 2048, (bf16_t*)(ws + WS_WOUT0), 0, scr, r, lane); continue; } r -= I_OUT;
          p0_transpose_item(a.in[37], 2048, 2048, (bf16_t*)(ws + WS_WOUT1), 0, scr, r, lane);
      } }
}

__device__ __forceinline__ void normmod_phase(const Args& a, const float* xin, int layer, int gw, int NGW, int lane) {
    const float* nw = a.in[4] + layer * 2048; const float* bm = a.in[3] + layer * 6144;
    const float* macc = (const float*)(a.ws + WS_MOD) + (size_t)layer * 4 * 6144;
    bf16_t* H = (bf16_t*)(a.ws + WS_H);
    for (int m = gw; m < MTOK; m += NGW) {
        const int b = m >> 11;
        const f32x4* xr = (const f32x4*)(xin + (size_t)m * 2048) + lane;
        f32x4 v[8]; float s = 0.f;
#pragma unroll
        for (int j = 0; j < 8; ++j) { v[j] = xr[64 * j]; s += (v[j].x * v[j].x + v[j].y * v[j].y) + (v[j].z * v[j].z + v[j].w * v[j].w); }
        const float rstd = rsqrtf(group_sum<64>(s) * (1.f / 2048.f) + EPS);
#pragma unroll
        for (int j = 0; j < 8; ++j) { const int col = (64 * j + lane) * 4;
            const f32x4 w = *(const f32x4*)(nw + col);
            const f32x4 sh = *(const f32x4*)(macc + b * 6144 + col) + *(const f32x4*)(bm + col);
            const f32x4 sc = *(const f32x4*)(macc + b * 6144 + 2048 + col) + *(const f32x4*)(bm + 2048 + col);
            const f32x4 o = v[j] * rstd * w * (1.f + sc) + sh;
            v2u pk; pk.x = pk2(o.x, o.y); pk.y = pk2(o.z, o.w);
            *(v2u*)(H + (size_t)m * 2048 + col) = pk; }
    }
}

__device__ __forceinline__ void post0_phase(const Args& a, int gw, int NGW, int lane) {
    const bf16_t* P = (const bf16_t*)(a.ws + WS_PROJ);
    const float2* rope = (const float2*)(a.ws + WS_ROPE);
    const float* qn = a.in[6]; const float* kn = a.in[7]; const float* cw = a.in[8]; const float* cb = a.in[9];
    bf16_t* Q = (bf16_t*)(a.ws + WS_QB); bf16_t* K = (bf16_t*)(a.ws + WS_KB); bf16_t* V = (bf16_t*)(a.ws + WS_VB);
    float* ACT = (float*)(a.ws + WS_ACT);
    for (int m = gw; m < MTOK; m += NGW) {
        const int t = m & 2047, prow = t >> 6, pcol = t & 63;
        const bf16_t* pr = P + (size_t)m * NINP;
        {
            float x[16]; unpack8(*(const v4u*)(pr + A_Q + lane * 16), x); unpack8(*(const v4u*)(pr + A_Q + lane * 16 + 8), x + 8);
            float ss = 0.f;
#pragma unroll
            for (int i = 0; i < 16; ++i) ss += x[i] * x[i];
            ss = group_sum<8>(ss);
            const float r = rsqrtf(ss * (1.f / 128.f) + EPS);
            const int d0 = (lane & 7) * 16;
#pragma unroll
            for (int i = 0; i < 16; ++i) x[i] = x[i] * r * qn[d0 + i];
#pragma unroll
            for (int pi = 0; pi < 8; ++pi) { const int p = (d0 >> 1) + pi; const float2 cs = (p < 32) ? rope[prow * 32 + p] : rope[pcol * 32 + p - 32];
                const float x0 = x[2 * pi], x1 = x[2 * pi + 1]; x[2 * pi] = x0 * cs.x - x1 * cs.y; x[2 * pi + 1] = x0 * cs.y + x1 * cs.x; }
            *(v4u*)(Q + (size_t)m * 1024 + lane * 16) = pack8(x); *(v4u*)(Q + (size_t)m * 1024 + lane * 16 + 8) = pack8(x + 8);
        }
        {
            const v2u w = *(const v2u*)(pr + A_K + lane * 4);
            float x[4] = {__uint_as_float(w.x << 16), __uint_as_float(w.x & 0xffff0000u), __uint_as_float(w.y << 16), __uint_as_float(w.y & 0xffff0000u)};
            float ss = (x[0] * x[0] + x[1] * x[1]) + (x[2] * x[2] + x[3] * x[3]);
            ss = group_sum<32>(ss);
            const float r = rsqrtf(ss * (1.f / 128.f) + EPS);
            const int d0 = (lane & 31) * 4;
#pragma unroll
            for (int i = 0; i < 4; ++i) x[i] = x[i] * r * kn[d0 + i];
#pragma unroll
            for (int pi = 0; pi < 2; ++pi) { const int p = (d0 >> 1) + pi; const float2 cs = (p < 32) ? rope[prow * 32 + p] : rope[pcol * 32 + p - 32];
                const float x0 = x[2 * pi], x1 = x[2 * pi + 1]; x[2 * pi] = x0 * cs.x - x1 * cs.y; x[2 * pi + 1] = x0 * cs.y + x1 * cs.x; }
            v2u o; o.x = pk2(x[0], x[1]); o.y = pk2(x[2], x[3]);
            *(v2u*)(K + (size_t)m * 256 + lane * 4) = o;
            *(v2u*)(V + (size_t)m * 256 + lane * 4) = *(const v2u*)(pr + A_V + lane * 4);
        }
#pragma unroll
        for (int j = 0; j < 3; ++j) { const int ch = (j * 64 + lane) * 8;
            float acc[8];
            { const f32x4 b0 = *(const f32x4*)(cb + ch), b1 = *(const f32x4*)(cb + ch + 4); acc[0] = b0.x; acc[1] = b0.y; acc[2] = b0.z; acc[3] = b0.w; acc[4] = b1.x; acc[5] = b1.y; acc[6] = b1.z; acc[7] = b1.w; }
#pragma unroll
            for (int d = 0; d < 4; ++d) { const int ts = t + d - 2;
                if (ts >= 0 && ts < SEQ) { float x[8]; unpack8(*(const v4u*)(P + (size_t)(m + d - 2) * NINP + A_XS + ch), x);
                    const f32x4 w0 = *(const f32x4*)(cw + d * 1536 + ch), w1 = *(const f32x4*)(cw + d * 1536 + ch + 4);
                    acc[0] += w0.x * x[0]; acc[1] += w0.y * x[1]; acc[2] += w0.z * x[2]; acc[3] += w0.w * x[3];
                    acc[4] += w1.x * x[4]; acc[5] += w1.y * x[5]; acc[6] += w1.z * x[6]; acc[7] += w1.w * x[7]; } }
            f32x4 o0, o1; o0.x = silu_f(acc[0]); o0.y = silu_f(acc[1]); o0.z = silu_f(acc[2]); o0.w = silu_f(acc[3]); o1.x = silu_f(acc[4]); o1.y = silu_f(acc[5]); o1.z = silu_f(acc[6]); o1.w = silu_f(acc[7]);
            *(f32x4*)(ACT + (size_t)m * 1536 + ch) = o0; *(f32x4*)(ACT + (size_t)m * 1536 + ch + 4) = o1;
            { v4u w; w.x = pk2(o0.x, o0.y); w.y = pk2(o0.z, o0.w); w.z = pk2(o1.x, o1.y); w.w = pk2(o1.z, o1.w); *(v4u*)((bf16_t*)(a.ws + WS_XBC16) + (size_t)m * 1536 + ch) = w; } }
    }
}

typedef float f32x2 __attribute__((ext_vector_type(2)));
__device__ __forceinline__ void ssd_item(const Args& a, int item, float* lds) {
    const int ph = item & 1, h = (item >> 1) & 15, dir = (item >> 5) & 1, b = item >> 6, g = h >> 3;
    constexpr int BUF = 32 * 32 + 2 * 32 * 128 + 32;
    float* ysb = lds + 2 * BUF;
    const float A = -expf(a.in[dir ? 13 : 12][h]); const float dtb = a.in[dir ? 11 : 10][h];
    const float* ACT = (const float*)(a.ws + WS_ACT); const float* SM = (const float*)(a.ws + WS_SMALL);
    float* Y = (float*)(a.ws + (dir ? WS_YB : WS_YF));
    const int tid = threadIdx.x, p = tid >> 4, ng = tid & 15;
    f32x2 hst[4];
#pragma unroll
    for (int i = 0; i < 4; ++i) hst[i] = (f32x2){0.f, 0.f};
    f32x4 gB[2], gC[2], gx; float gdt;
#define SSD_LOAD(tile_) do { const size_t r0_ = (size_t)b * SEQ + (dir ? 63 - (tile_) : (tile_)) * 32; \
        _Pragma("unroll") for (int i = 0; i < 2; ++i) { const int idx = tid + i * 512, s_ = idx >> 5, c4_ = idx & 31, tl_ = dir ? 31 - s_ : s_; \
            gB[i] = *(const f32x4*)(ACT + (r0_ + tl_) * 1536 + 1024 + g * 128 + c4_ * 4); gC[i] = *(const f32x4*)(ACT + (r0_ + tl_) * 1536 + 1280 + g * 128 + c4_ * 4); } \
        if (tid < 256) { const int s_ = tid >> 3, c4_ = tid & 7, tl_ = dir ? 31 - s_ : s_; gx = *(const f32x4*)(ACT + (r0_ + tl_) * 1536 + h * 64 + ph * 32 + c4_ * 4); gdt = SM[(r0_ + tl_) * 32 + dir * 16 + h]; } } while (0)
#define SSD_STORE(buf_) do { float* xs_ = lds + (buf_) * BUF; float* Bs_ = xs_ + 32 * 32; float* Cs_ = Bs_ + 32 * 128; float* das_ = Cs_ + 32 * 128; \
        _Pragma("unroll") for (int i = 0; i < 2; ++i) { const int idx = tid + i * 512, s_ = idx >> 5, c4_ = idx & 31; const int so_ = s_ * 128 + (c4_ & 1) * 64 + (c4_ >> 1) * 4; \
            *(f32x4*)(Bs_ + so_) = gB[i]; *(f32x4*)(Cs_ + so_) = gC[i]; } \
        if (tid < 256) { const int s_ = tid >> 3, c4_ = tid & 7; const float dt_ = softplus_f(gdt + dtb); *(f32x4*)(xs_ + s_ * 32 + c4_ * 4) = gx * dt_; if (c4_ == 0) das_[s_] = expf(dt_ * A); } } while (0)
    __syncthreads();
    SSD_LOAD(0); SSD_STORE(0);
    __syncthreads();
    for (int tile = 0; tile < 64; ++tile) {
        const int cur = tile & 1;
        const size_t row0 = (size_t)b * SEQ + (dir ? 63 - tile : tile) * 32;
        if (tile + 1 < 64) SSD_LOAD(tile + 1);
        const float* xs = lds + cur * BUF; const float* Bs = xs + 32 * 32; const float* Cs = Bs + 32 * 128; const float* das = Cs + 32 * 128; float* ys = ysb + cur * 1024;
        {
            float n_dA = das[0], n_xdt = xs[p];
            f32x4 n_b0 = *(const f32x4*)(Bs + ng * 4), n_b1 = *(const f32x4*)(Bs + 64 + ng * 4), n_c0 = *(const f32x4*)(Cs + ng * 4), n_c1 = *(const f32x4*)(Cs + 64 + ng * 4);
#pragma unroll 4
            for (int s = 0; s < 32; ++s) {
                const float dA = n_dA, xdt = n_xdt; const f32x4 b0 = n_b0, b1 = n_b1, c0 = n_c0, c1 = n_c1;
                const int sn = (s + 1) & 31;
                n_dA = das[sn]; n_xdt = xs[sn * 32 + p];
                n_b0 = *(const f32x4*)(Bs + sn * 128 + ng * 4); n_b1 = *(const f32x4*)(Bs + sn * 128 + 64 + ng * 4);
                n_c0 = *(const f32x4*)(Cs + sn * 128 + ng * 4); n_c1 = *(const f32x4*)(Cs + sn * 128 + 64 + ng * 4);
                const f32x2 xd2 = (f32x2){xdt, xdt}, da2 = (f32x2){dA, dA};
                hst[0] = hst[0] * da2 + xd2 * (f32x2){b0.x, b0.y};
                hst[1] = hst[1] * da2 + xd2 * (f32x2){b0.z, b0.w};
                hst[2] = hst[2] * da2 + xd2 * (f32x2){b1.x, b1.y};
                hst[3] = hst[3] * da2 + xd2 * (f32x2){b1.z, b1.w};
                f32x2 acc = hst[0] * (f32x2){c0.x, c0.y};
                acc += hst[1] * (f32x2){c0.z, c0.w};
                acc += hst[2] * (f32x2){c1.x, c1.y};
                acc += hst[3] * (f32x2){c1.z, c1.w};
                const float part = group_sum<16>(acc.x + acc.y);
                if (ng == 0) ys[s * 32 + p] = part;
            }
        }
        if (tile + 1 < 64) SSD_STORE(cur ^ 1);
        __syncthreads();
        if (tid < 256) { const int s = tid >> 3, c4 = tid & 7, tl = dir ? 31 - s : s; *(f32x4*)(Y + (row0 + tl) * 1024 + h * 64 + ph * 32 + c4 * 4) = *(const f32x4*)(ys + s * 32 + c4 * 4); }
    }
#undef SSD_LOAD
#undef SSD_STORE
}

__device__ __forceinline__ void ssd_combine_phase(const Args& a, int gw, int NGW, int lane) {
    const float* YF = (const float*)(a.ws + WS_YF); const float* YB = (const float*)(a.ws + WS_YB); const float* ACT = (const float*)(a.ws + WS_ACT);
    const bf16_t* P = (const bf16_t*)(a.ws + WS_PROJ); bf16_t* YC = (bf16_t*)(a.ws + WS_YCAT);
    const float* dsk = a.in[14]; const float* nw = a.in[15];
    for (int m = gw; m < MTOK; m += NGW) {
        const int ch = lane * 16; const float dk = dsk[ch >> 6];
        float z[16], gv[16]; unpack8(*(const v4u*)(P + (size_t)m * NINP + A_Z + ch), z); unpack8(*(const v4u*)(P + (size_t)m * NINP + A_Z + ch + 8), z + 8);
        float ss = 0.f;
#pragma unroll
        for (int q = 0; q < 4; ++q) { const f32x4 f = *(const f32x4*)(YF + (size_t)m * 1024 + ch + 4 * q), bk = *(const f32x4*)(YB + (size_t)m * 1024 + ch + 4 * q), xv = *(const f32x4*)(ACT + (size_t)m * 1536 + ch + 4 * q);
            const f32x4 y = f + bk + dk * xv;
            gv[4 * q] = y.x * silu_f(z[4 * q]); gv[4 * q + 1] = y.y * silu_f(z[4 * q + 1]); gv[4 * q + 2] = y.z * silu_f(z[4 * q + 2]); gv[4 * q + 3] = y.w * silu_f(z[4 * q + 3]); }
#pragma unroll
        for (int i = 0; i < 16; ++i) ss += gv[i] * gv[i];
        const float r = rsqrtf(group_sum<64>(ss) * (1.f / 1024.f) + EPS);
#pragma unroll
        for (int i = 0; i < 16; ++i) gv[i] = gv[i] * r * nw[ch + i];
        *(v4u*)(YC + (size_t)m * 2048 + 1024 + ch) = pack8(gv); *(v4u*)(YC + (size_t)m * 2048 + 1024 + ch + 8) = pack8(gv + 8);
    }
}

__device__ __forceinline__ void post1_phase(const Args& a, int gw, int NGW, int lane) {
    const bf16_t* P = (const bf16_t*)(a.ws + WS_PROJ); const float* cw = a.in[18]; const float* cb = a.in[19];
    float* ACT = (float*)(a.ws + WS_ACT);
    for (int m = gw; m < MTOK; m += NGW) {
        const int t = m & 2047;
#pragma unroll
        for (int j = 0; j < 4; ++j) { const int ch = (j * 64 + lane) * 8;
            float acc[8];
            { const f32x4 b0 = *(const f32x4*)(cb + ch), b1 = *(const f32x4*)(cb + ch + 4); acc[0] = b0.x; acc[1] = b0.y; acc[2] = b0.z; acc[3] = b0.w; acc[4] = b1.x; acc[5] = b1.y; acc[6] = b1.z; acc[7] = b1.w; }
#pragma unroll
            for (int d = 0; d < 4; ++d) { const int ts = t + d - 2;
                if (ts >= 0 && ts < SEQ) { float x[8]; unpack8(*(const v4u*)(P + (size_t)(m + d - 2) * NINP + C_Q + ch), x);
                    const f32x4 w0 = *(const f32x4*)(cw + d * 2048 + ch), w1 = *(const f32x4*)(cw + d * 2048 + ch + 4);
                    acc[0] += w0.x * x[0]; acc[1] += w0.y * x[1]; acc[2] += w0.z * x[2]; acc[3] += w0.w * x[3];
                    acc[4] += w1.x * x[4]; acc[5] += w1.y * x[5]; acc[6] += w1.z * x[6]; acc[7] += w1.w * x[7]; } }
#pragma unroll
            for (int i = 0; i < 8; ++i) acc[i] = silu_f(acc[i]);
            if (j < 2) {
                float ss = 0.f;
#pragma unroll
                for (int i = 0; i < 8; ++i) ss += acc[i] * acc[i];
                ss = group_sum<16>(ss);
                float r = rsqrtf(ss + EPS); if (j == 0) r *= 0.088388347648318440f;
#pragma unroll
                for (int i = 0; i < 8; ++i) acc[i] *= r;
            }
            *(f32x4*)(ACT + (size_t)m * 2048 + ch) = (f32x4){acc[0], acc[1], acc[2], acc[3]}; *(f32x4*)(ACT + (size_t)m * 2048 + ch + 4) = (f32x4){acc[4], acc[5], acc[6], acc[7]};
            *(v4u*)((bf16_t*)(a.ws + WS_QKV16) + (size_t)m * 2048 + ch) = pack8(acc); }
    }
}

__device__ __forceinline__ void gdn_item(const Args& a, int item, float* lds) {
    const int dvs = item & 3, hv = (item >> 2) & 7, dir = (item >> 5) & 1, b = item >> 6, hq = hv >> 1;
    constexpr int BUF = 2 * 32 * 128 + 32 * 32 + 32 * 4;
    float* osb = lds + 2 * BUF;
    const float Aneg = -expf(a.in[dir ? 21 : 20][hv]); const float dtb = a.in[dir ? 23 : 22][hv];
    const float* ACT = (const float*)(a.ws + WS_ACT); const float* SM = (const float*)(a.ws + WS_SMALL);
    float* O = (float*)(a.ws + (dir ? WS_YB : WS_YF));
    const int tid = threadIdx.x, lane = tid & 63, wave = tid >> 6, dkg = lane & 15, dvi = wave * 4 + (lane >> 4);
    f32x2 S[4];
#pragma unroll
    for (int i = 0; i < 4; ++i) S[i] = (f32x2){0.f, 0.f};
    f32x4 gk0, gk1, gq0, gq1, gv; float gbr = 0.f, gar = 0.f;
#define GDN_LOAD(tile_) do { const size_t r0_ = (size_t)b * SEQ + (dir ? 63 - (tile_) : (tile_)) * 32; \
        { const int s_ = tid >> 4, c8_ = tid & 15, tl_ = dir ? 31 - s_ : s_; const float* kp_ = ACT + (r0_ + tl_) * 2048 + 512 + hq * 128 + c8_ * 8; const float* qp_ = ACT + (r0_ + tl_) * 2048 + hq * 128 + c8_ * 8; \
          gk0 = *(const f32x4*)kp_; gk1 = *(const f32x4*)(kp_ + 4); gq0 = *(const f32x4*)qp_; gq1 = *(const f32x4*)(qp_ + 4); \
          if (c8_ == 0) { const float* sm_ = SM + (r0_ + tl_) * 32; gbr = sm_[dir * 8 + hv]; gar = sm_[16 + dir * 8 + hv]; } } \
        if (tid < 256) { const int s2_ = tid >> 3, c4_ = tid & 7, tl2_ = dir ? 31 - s2_ : s2_; gv = *(const f32x4*)(ACT + (r0_ + tl2_) * 2048 + 1024 + hv * 128 + dvs * 32 + c4_ * 4); } } while (0)
#define GDN_STORE(buf_) do { float* ks_ = lds + (buf_) * BUF; float* qs_ = ks_ + 32 * 128; float* vs_ = qs_ + 32 * 128; float* sc_ = vs_ + 32 * 32; \
        { const int s_ = tid >> 4, c8_ = tid & 15; \
          *(f32x4*)(ks_ + s_ * 128 + c8_ * 4) = gk0; *(f32x4*)(ks_ + s_ * 128 + 64 + c8_ * 4) = gk1; *(f32x4*)(qs_ + s_ * 128 + c8_ * 4) = gq0; *(f32x4*)(qs_ + s_ * 128 + 64 + c8_ * 4) = gq1; \
          float kq_ = (gk0.x * gq0.x + gk0.y * gq0.y) + (gk0.z * gq0.z + gk0.w * gq0.w) + (gk1.x * gq1.x + gk1.y * gq1.y) + (gk1.z * gq1.z + gk1.w * gq1.w); \
          kq_ = group_sum<16>(kq_); \
          if (c8_ == 0) { const float beta_ = sigmoid_f(gbr), alpha_ = expf(Aneg * softplus_f(gar + dtb)); *(f32x4*)(sc_ + s_ * 4) = (f32x4){alpha_, beta_, kq_, alpha_ * beta_}; } } \
        if (tid < 256) { const int s2_ = tid >> 3, c4_ = tid & 7; *(f32x4*)(vs_ + s2_ * 32 + c4_ * 4) = gv; } } while (0)
    __syncthreads();
    GDN_LOAD(0); GDN_STORE(0);
    __syncthreads();
    for (int tile = 0; tile < 64; ++tile) {
        const int cur = tile & 1;
        const size_t row0 = (size_t)b * SEQ + (dir ? 63 - tile : tile) * 32;
        if (tile + 1 < 64) GDN_LOAD(tile + 1);
        const float* ks = lds + cur * BUF; const float* qs = ks + 32 * 128; const float* vs = qs + 32 * 128; const float* sc = vs + 32 * 32; float* os = osb + cur * 1024;
        {
            f32x4 n_k0 = *(const f32x4*)(ks + dkg * 4), n_k1 = *(const f32x4*)(ks + 64 + dkg * 4), n_q0 = *(const f32x4*)(qs + dkg * 4), n_q1 = *(const f32x4*)(qs + 64 + dkg * 4);
            f32x4 n_sc = *(const f32x4*)(sc); float n_vv = vs[dvi];
#pragma unroll 4
            for (int s = 0; s < 32; ++s) {
                const f32x4 k0 = n_k0, k1 = n_k1, q0 = n_q0, q1 = n_q1, scv = n_sc; const float vv = n_vv;
                const int sn = (s + 1) & 31;
                n_k0 = *(const f32x4*)(ks + sn * 128 + dkg * 4); n_k1 = *(const f32x4*)(ks + sn * 128 + 64 + dkg * 4);
                n_q0 = *(const f32x4*)(qs + sn * 128 + dkg * 4); n_q1 = *(const f32x4*)(qs + sn * 128 + 64 + dkg * 4);
                n_sc = *(const f32x4*)(sc + sn * 4); n_vv = vs[sn * 32 + dvi];
                const f32x2 ka = (f32x2){k0.x, k0.y}, kb = (f32x2){k0.z, k0.w}, kc = (f32x2){k1.x, k1.y}, kd = (f32x2){k1.z, k1.w};
                f32x2 pk = ka * S[0]; pk += kb * S[1]; pk += kc * S[2]; pk += kd * S[3];
                f32x2 pq = (f32x2){q0.x, q0.y} * S[0]; pq += (f32x2){q0.z, q0.w} * S[1]; pq += (f32x2){q1.x, q1.y} * S[2]; pq += (f32x2){q1.z, q1.w} * S[3];
                float sk = pk.x + pk.y, sq = pq.x + pq.y;
                sk += dpp_mov<0xB1>(sk); sq += dpp_mov<0xB1>(sq);
                sk += dpp_mov<0x4E>(sk); sq += dpp_mov<0x4E>(sq);
                sk += dpp_mov<0x141>(sk); sq += dpp_mov<0x141>(sq);
                sk += dpp_mov<0x140>(sk); sq += dpp_mov<0x140>(sq);
                const float alpha = scv.x, vn = fmaf(-scv.w, sk, scv.y * vv);
                const float po = fmaf(alpha, sq, scv.z * vn);
                const f32x2 al2 = (f32x2){alpha, alpha}, vn2 = (f32x2){vn, vn};
                S[0] = S[0] * al2 + ka * vn2; S[1] = S[1] * al2 + kb * vn2; S[2] = S[2] * al2 + kc * vn2; S[3] = S[3] * al2 + kd * vn2;
                if (dkg == 0) os[s * 32 + dvi] = po;
            }
        }
        if (tile + 1 < 64) GDN_STORE(cur ^ 1);
        __syncthreads();
        if (tid < 256) { const int s2 = tid >> 3, c4 = tid & 7, tl2 = dir ? 31 - s2 : s2; *(f32x4*)(O + (row0 + tl2) * 1024 + hv * 128 + dvs * 32 + c4 * 4) = *(const f32x4*)(os + s2 * 32 + c4 * 4); }
    }
#undef GDN_LOAD
#undef GDN_STORE
}

typedef short s16x4_t __attribute__((ext_vector_type(4)));
typedef __bf16 bf16x2_v __attribute__((ext_vector_type(2)));
__device__ __forceinline__ unsigned cvtpk_rne(float lo, float hi) { f32x2 v = {lo, hi}; bf16x2_v bb = __builtin_convertvector(v, bf16x2_v); return __builtin_bit_cast(unsigned, bb); }
template <int S_> __device__ __forceinline__ bf16x8_t acc_frag(const f32x16_t& x) {
    v4u w; w.x = cvtpk_rne(x[8 * S_ + 0], x[8 * S_ + 1]); w.y = cvtpk_rne(x[8 * S_ + 2], x[8 * S_ + 3]); w.z = cvtpk_rne(x[8 * S_ + 4], x[8 * S_ + 5]); w.w = cvtpk_rne(x[8 * S_ + 6], x[8 * S_ + 7]);
    return __builtin_bit_cast(bf16x8_t, w);
}
__device__ __forceinline__ bf16x8_t join44(v2u lo, v2u hi) { v4u w; w.x = lo.x; w.y = lo.y; w.z = hi.x; w.w = hi.y; return __builtin_bit_cast(bf16x8_t, w); }
__device__ __forceinline__ float wave_incl_scan(float v, int lane) {
#pragma unroll
    for (int o = 1; o < 64; o <<= 1) { const float t = __shfl_up(v, o); if (lane >= o) v += t; }
    return v;
}
constexpr int GDN_LDS_PER_WAVE = 17920;
__device__ __forceinline__ void gdn1_item(const Args& a, int item, unsigned char* ldsw, int lane) {
    asm volatile("" : "+v"(lane));
    const int c = item & 31, dir = (item >> 5) & 1, hv = (item >> 6) & 7, b = item >> 9, hq = hv >> 1;
    const int r32 = lane & 31, hi = lane >> 5;
    float* AT = (float*)ldsw; float* Gs = AT + 64 * 64; float* Bs = Gs + 64;
    const bf16_t* QK = (const bf16_t*)(a.ws + WS_QKV16); const float* SM = (const float*)(a.ws + WS_SMALL);
    bf16_t* GT = (bf16_t*)(a.ws + WS_GT) + (size_t)item * 4096; bf16_t* GA = (bf16_t*)(a.ws + WS_GA) + (size_t)item * 4096;
    const float Aneg = -expf(a.in[dir ? 21 : 20][hv]); const float dtb = a.in[dir ? 23 : 22][hv];
    {
        const int t = dir ? SEQ - 1 - (64 * c + lane) : 64 * c + lane; const float* sm = SM + ((size_t)b * SEQ + t) * 32;
        const float gi = Aneg * softplus_f(sm[16 + dir * 8 + hv] + dtb), bi = sigmoid_f(sm[dir * 8 + hv]);
        Gs[lane] = wave_incl_scan(gi, lane); Bs[lane] = bi;
    }
    const int t0r = dir ? SEQ - 1 - (64 * c + r32) : 64 * c + r32, t1r = dir ? t0r - 32 : t0r + 32;
    const bf16_t* k0p = QK + ((size_t)b * SEQ + t0r) * 2048 + 512 + hq * 128 + hi * 8; const bf16_t* k1p = QK + ((size_t)b * SEQ + t1r) * 2048 + 512 + hq * 128 + hi * 8;
    const bf16_t* q0p = k0p - 512, * q1p = k1p - 512;
    LDS_WAIT();
    const float Gj0 = Gs[r32], Gj1 = Gs[32 + r32];
    {
        f32x16_t kk00, kk10, kk11;
#pragma unroll
        for (int r = 0; r < 16; ++r) { kk00[r] = 0.f; kk10[r] = 0.f; kk11[r] = 0.f; }
#pragma unroll
        for (int s = 0; s < 8; ++s) {
            const bf16x8_t kA0 = *(const bf16x8_t*)(k0p + 16 * s), kA1 = *(const bf16x8_t*)(k1p + 16 * s);
            kk00 = __builtin_amdgcn_mfma_f32_32x32x16_bf16(kA0, kA0, kk00, 0, 0, 0); kk10 = __builtin_amdgcn_mfma_f32_32x32x16_bf16(kA1, kA0, kk10, 0, 0, 0); kk11 = __builtin_amdgcn_mfma_f32_32x32x16_bf16(kA1, kA1, kk11, 0, 0, 0);
        }
#pragma unroll
        for (int r = 0; r < 16; ++r) { const int il = (r & 3) + 8 * (r >> 2) + 4 * hi;
            const float Gi0 = Gs[il], Gi1 = Gs[32 + il], bi0 = Bs[il], bi1 = Bs[32 + il];
            AT[r32 * 64 + il] = (r32 < il) ? bi0 * kk00[r] * expf(Gi0 - Gj0) : 0.f;
            AT[r32 * 64 + 32 + il] = bi1 * kk10[r] * expf(Gi1 - Gj0);
            AT[(32 + r32) * 64 + 32 + il] = (r32 < il) ? bi1 * kk11[r] * expf(Gi1 - Gj1) : 0.f;
            AT[(32 + r32) * 64 + il] = 0.f;
        }
    }
    asm volatile("" ::: "memory");
    {
        f32x16_t qk00, qk10, qk11;
#pragma unroll
        for (int r = 0; r < 16; ++r) { qk00[r] = 0.f; qk10[r] = 0.f; qk11[r] = 0.f; }
#pragma unroll
        for (int s = 0; s < 8; ++s) {
            const bf16x8_t kA0 = *(const bf16x8_t*)(k0p + 16 * s), kA1 = *(const bf16x8_t*)(k1p + 16 * s), qA0 = *(const bf16x8_t*)(q0p + 16 * s), qA1 = *(const bf16x8_t*)(q1p + 16 * s);
            qk00 = __builtin_amdgcn_mfma_f32_32x32x16_bf16(qA0, kA0, qk00, 0, 0, 0); qk10 = __builtin_amdgcn_mfma_f32_32x32x16_bf16(qA1, kA0, qk10, 0, 0, 0); qk11 = __builtin_amdgcn_mfma_f32_32x32x16_bf16(qA1, kA1, qk11, 0, 0, 0);
        }
#pragma unroll
        for (int r = 0; r < 16; ++r) { const int il = (r & 3) + 8 * (r >> 2) + 4 * hi;
            const float Gi0 = Gs[il], Gi1 = Gs[32 + il];
            GA[il * 64 + r32] = (bf16_t)f2bf((r32 <= il) ? qk00[r] * expf(Gi0 - Gj0) : 0.f);
            GA[(32 + il) * 64 + r32] = (bf16_t)f2bf(qk10[r] * expf(Gi1 - Gj0));
            GA[(32 + il) * 64 + 32 + r32] = (bf16_t)f2bf((r32 <= il) ? qk11[r] * expf(Gi1 - Gj1) : 0.f);
        }
    }
    LDS_WAIT(); asm volatile("" ::: "memory");
    float tr[64];
    int lane2 = lane; asm volatile("" : "+v"(lane2) :: "memory");
#pragma unroll
    for (int j = 0; j < 64; ++j) tr[j] = (j == lane2) ? 1.f : 0.f;
    int atoff = 0;
#pragma unroll
    for (int j = 62; j >= 0; --j) { float c0 = 0.f, c1 = 0.f, c2 = 0.f, c3 = 0.f;
        asm volatile("" : "+v"(atoff) : "v"(tr[j + 1]));
#pragma unroll
        for (int qd = (j + 1) / 4; qd < 16; ++qd) { const f32x4 av = *(const f32x4*)(AT + atoff + j * 64 + 4 * qd);
            if (4 * qd + 0 > j) c0 = fmaf(tr[4 * qd + 0], av.x, c0);
            if (4 * qd + 1 > j) c1 = fmaf(tr[4 * qd + 1], av.y, c1);
            if (4 * qd + 2 > j) c2 = fmaf(tr[4 * qd + 2], av.z, c2);
            if (4 * qd + 3 > j) c3 = fmaf(tr[4 * qd + 3], av.w, c3); }
        tr[j] -= (c0 + c1) + (c2 + c3); asm volatile("" ::: "memory"); }
#pragma unroll
    for (int x = 0; x < 8; ++x) *(v4u*)(GT + lane2 * 64 + x * 8) = pack8(tr + x * 8);
    LDS_WAIT();
}

__device__ __forceinline__ void gdn2_item(const Args& a, int item, unsigned char* lds) {
    const int dvs = item & 3, hv = (item >> 2) & 7, dir = (item >> 5) & 1, b = item >> 6, hq = hv >> 1;
    const int lane0 = threadIdx.x & 63;
    constexpr int BUFB = 57344, O_K = 0, O_Q = 16384, O_T = 32768, O_A = 40960, O_V = 49152;
    float* Gs = (float*)(lds + 2 * BUFB); float* Bs = Gs + 64; float* Es = Bs + 64; float* Ws = Es + 64; float* ot = Ws + 64;
    const LAS unsigned char* ldl = (const LAS unsigned char*)lds;
    const bf16_t* QK = (const bf16_t*)(a.ws + WS_QKV16); const float* ACT = (const float*)(a.ws + WS_ACT); const float* SM = (const float*)(a.ws + WS_SMALL);
    float* O = (float*)(a.ws + (dir ? WS_YB : WS_YF));
    const float Aneg = -expf(a.in[dir ? 21 : 20][hv]); const float dtb = a.in[dir ? 23 : 22][hv];
    const size_t gbase = (size_t)(((b * 8 + hv) * 2 + dir) * 32) * 4096;
    f32x16_t S[4];
#pragma unroll
    for (int nt = 0; nt < 4; ++nt)
#pragma unroll
        for (int r = 0; r < 16; ++r) S[nt][r] = 0.f;
    float gar, gbr;
#define G2_DMA(c_, buf_) do { const int t_ = dir ? SEQ - 1 - (64 * (c_) + lane0) : 64 * (c_) + lane0; const size_t mi_ = (size_t)b * SEQ + t_; \
        const bf16_t* kr_ = QK + mi_ * 2048 + 512 + hq * 128; const bf16_t* qr_ = QK + mi_ * 2048 + hq * 128; \
        const bf16_t* tr_ = (const bf16_t*)(a.ws + WS_GT) + gbase + (size_t)(c_) * 4096 + lane0 * 64; const bf16_t* ar_ = (const bf16_t*)(a.ws + WS_GA) + gbase + (size_t)(c_) * 4096 + lane0 * 64; \
        const float* vr_ = ACT + mi_ * 2048 + 1024 + hv * 128 + dvs * 32; \
        LAS unsigned char* lb_ = (LAS unsigned char*)lds + (buf_) * BUFB; \
        _Pragma("unroll") for (int x = 0; x < 16; ++x) { __builtin_amdgcn_global_load_lds((const unsigned*)(kr_ + 8 * x), (LAS unsigned*)(lb_ + O_K + 1024 * x), 16, 0, 0); \
                                                         __builtin_amdgcn_global_load_lds((const unsigned*)(qr_ + 8 * x), (LAS unsigned*)(lb_ + O_Q + 1024 * x), 16, 0, 0); } \
        _Pragma("unroll") for (int x = 0; x < 8; ++x) { __builtin_amdgcn_global_load_lds((const unsigned*)(tr_ + 8 * x), (LAS unsigned*)(lb_ + O_T + 1024 * x), 16, 0, 0); \
                                                        __builtin_amdgcn_global_load_lds((const unsigned*)(ar_ + 8 * x), (LAS unsigned*)(lb_ + O_A + 1024 * x), 16, 0, 0); \
                                                        __builtin_amdgcn_global_load_lds((const unsigned*)(vr_ + 4 * x), (LAS unsigned*)(lb_ + O_V + 1024 * x), 16, 0, 0); } \
        const float* sm_ = SM + mi_ * 32; gar = sm_[16 + dir * 8 + hv]; gbr = sm_[dir * 8 + hv]; } while (0)
    G2_DMA(0, 0);
    for (int c = 0; c < 32; ++c) {
        int lane = lane0; asm volatile("" : "+v"(lane));
        const int r32 = lane & 31, hi = lane >> 5, trq = (lane & 15) >> 2, trp = lane & 3, trc = (lane >> 4) & 1;
        const int bo = (c & 1) * BUFB;
        float GL;
        {
            const float gi = Aneg * softplus_f(gar + dtb), bi = sigmoid_f(gbr);
            const float G = wave_incl_scan(gi, lane); GL = __shfl(G, 63);
            Gs[lane] = G; Bs[lane] = bi; Es[lane] = expf(G); Ws[lane] = expf(GL - G);
        }
        asm volatile("s_waitcnt vmcnt(0)" ::: "memory");
        if (c + 1 < 32) G2_DMA(c + 1, (c + 1) & 1);
        LDS_WAIT();
        f32x16_t KS[2];
#pragma unroll
        for (int rt = 0; rt < 2; ++rt)
#pragma unroll
            for (int r = 0; r < 16; ++r) KS[rt][r] = 0.f;
#define LFRAG(off_) join44(*(const LAS v2u*)(ldl + (off_)), *(const LAS v2u*)(ldl + (off_) + 1024))
#pragma unroll
        for (int nt = 0; nt < 4; ++nt) {
            const bf16x8_t sb0 = acc_frag<0>(S[nt]), sb1 = acc_frag<1>(S[nt]);
#pragma unroll
            for (int rt = 0; rt < 2; ++rt) {
                const int ro = bo + O_K + ((4 * nt) * 64 + 32 * rt + r32) * 16 + 8 * hi;
                KS[rt] = __builtin_amdgcn_mfma_f32_32x32x16_bf16(LFRAG(ro), sb0, KS[rt], 0, 0, 0); KS[rt] = __builtin_amdgcn_mfma_f32_32x32x16_bf16(LFRAG(ro + 2048), sb1, KS[rt], 0, 0, 0);
            }
        }
        asm volatile("" ::: "memory");
        f32x16_t rhs[2];
#pragma unroll
        for (int rt = 0; rt < 2; ++rt)
#pragma unroll
            for (int r = 0; r < 16; ++r) { const int i = 32 * rt + (r & 3) + 8 * (r >> 2) + 4 * hi;
                const float vv = *(const LAS float*)(ldl + bo + O_V + ((r32 >> 2) * 64 + i) * 16 + (r32 & 3) * 4); const float bi = Bs[i];
                rhs[rt][r] = bi * vv - bi * Es[i] * KS[rt][r]; }
        asm volatile("" ::: "memory");
        f32x16_t vn[2];
#pragma unroll
        for (int r = 0; r < 16; ++r) { vn[0][r] = 0.f; vn[1][r] = 0.f; }
        {
            const bf16x8_t rb00 = acc_frag<0>(rhs[0]), rb01 = acc_frag<1>(rhs[0]), rb10 = acc_frag<0>(rhs[1]), rb11 = acc_frag<1>(rhs[1]);
            const int t0 = bo + O_T + r32 * 16 + 8 * hi, t1 = t0 + 512;
            vn[0] = __builtin_amdgcn_mfma_f32_32x32x16_bf16(LFRAG(t0), rb00, vn[0], 0, 0, 0); vn[0] = __builtin_amdgcn_mfma_f32_32x32x16_bf16(LFRAG(t0 + 2048), rb01, vn[0], 0, 0, 0);
            vn[1] = __builtin_amdgcn_mfma_f32_32x32x16_bf16(LFRAG(t1), rb00, vn[1], 0, 0, 0); vn[1] = __builtin_amdgcn_mfma_f32_32x32x16_bf16(LFRAG(t1 + 2048), rb01, vn[1], 0, 0, 0);
            vn[1] = __builtin_amdgcn_mfma_f32_32x32x16_bf16(LFRAG(t1 + 4096), rb10, vn[1], 0, 0, 0); vn[1] = __builtin_amdgcn_mfma_f32_32x32x16_bf16(LFRAG(t1 + 6144), rb11, vn[1], 0, 0, 0);
        }
        asm volatile("" ::: "memory");
        f32x16_t QS[2];
#pragma unroll
        for (int rt = 0; rt < 2; ++rt)
#pragma unroll
            for (int r = 0; r < 16; ++r) QS[rt][r] = 0.f;
#pragma unroll
        for (int nt = 0; nt < 4; ++nt) {
            const bf16x8_t sb0 = acc_frag<0>(S[nt]), sb1 = acc_frag<1>(S[nt]);
#pragma unroll
            for (int rt = 0; rt < 2; ++rt) {
                const int ro = bo + O_Q + ((4 * nt) * 64 + 32 * rt + r32) * 16 + 8 * hi;
                QS[rt] = __builtin_amdgcn_mfma_f32_32x32x16_bf16(LFRAG(ro), sb0, QS[rt], 0, 0, 0); QS[rt] = __builtin_amdgcn_mfma_f32_32x32x16_bf16(LFRAG(ro + 2048), sb1, QS[rt], 0, 0, 0);
            }
        }
        asm volatile("" ::: "memory");
        {
            const bf16x8_t vb00 = acc_frag<0>(vn[0]), vb01 = acc_frag<1>(vn[0]), vb10 = acc_frag<0>(vn[1]), vb11 = acc_frag<1>(vn[1]);
            const int a0 = bo + O_A + r32 * 16 + 8 * hi, a1 = a0 + 512;
            f32x16_t o0, o1;
#pragma unroll
            for (int r = 0; r < 16; ++r) { const int il = (r & 3) + 8 * (r >> 2) + 4 * hi; o0[r] = Es[il] * QS[0][r]; o1[r] = Es[32 + il] * QS[1][r]; }
            o0 = __builtin_amdgcn_mfma_f32_32x32x16_bf16(LFRAG(a0), vb00, o0, 0, 0, 0); o0 = __builtin_amdgcn_mfma_f32_32x32x16_bf16(LFRAG(a0 + 2048), vb01, o0, 0, 0, 0);
            o1 = __builtin_amdgcn_mfma_f32_32x32x16_bf16(LFRAG(a1), vb00, o1, 0, 0, 0); o1 = __builtin_amdgcn_mfma_f32_32x32x16_bf16(LFRAG(a1 + 2048), vb01, o1, 0, 0, 0);
            o1 = __builtin_amdgcn_mfma_f32_32x32x16_bf16(LFRAG(a1 + 4096), vb10, o1, 0, 0, 0); o1 = __builtin_amdgcn_mfma_f32_32x32x16_bf16(LFRAG(a1 + 6144), vb11, o1, 0, 0, 0);
#pragma unroll
            for (int r = 0; r < 16; ++r) { const int il = (r & 3) + 8 * (r >> 2) + 4 * hi; ot[il * 33 + r32] = o0[r]; ot[(32 + il) * 33 + r32] = o1[r]; }
            LDS_WAIT();
            { const int t = dir ? SEQ - 1 - (64 * c + lane) : 64 * c + lane; float* orow = O + ((size_t)b * SEQ + t) * 1024 + hv * 128 + dvs * 32;
#pragma unroll
              for (int x = 0; x < 8; ++x) *(f32x4*)(orow + 4 * x) = (f32x4){ot[lane * 33 + 4 * x], ot[lane * 33 + 4 * x + 1], ot[lane * 33 + 4 * x + 2], ot[lane * 33 + 4 * x + 3]}; }
        }
        asm volatile("" ::: "memory");
        {
#pragma unroll
            for (int r = 0; r < 16; ++r) { const int il = (r & 3) + 8 * (r >> 2) + 4 * hi; vn[0][r] *= Ws[il]; vn[1][r] *= Ws[32 + il]; }
            const bf16x8_t wb[4] = {acc_frag<0>(vn[0]), acc_frag<1>(vn[0]), acc_frag<0>(vn[1]), acc_frag<1>(vn[1])};
            const float eGL = expf(GL);
#pragma unroll
            for (int nt = 0; nt < 4; ++nt) {
#pragma unroll
                for (int r = 0; r < 16; ++r) S[nt][r] *= eGL;
#pragma unroll
                for (int ks = 0; ks < 4; ++ks) {
                    const int ro = bo + O_K + ((4 * nt + 2 * trc + (trp >> 1)) * 64 + 16 * ks + 4 * hi + trq) * 16 + 8 * (trp & 1);
                    const s16x4_t lo = __builtin_bit_cast(s16x4_t, __builtin_amdgcn_ds_read_tr16_b64_v4i16((LAS s16x4_t*)(ldl + ro)));
                    const s16x4_t hi4 = __builtin_bit_cast(s16x4_t, __builtin_amdgcn_ds_read_tr16_b64_v4i16((LAS s16x4_t*)(ldl + ro + 8 * 16)));
                    const bf16x8_t kf = (bf16x8_t){lo[0], lo[1], lo[2], lo[3], hi4[0], hi4[1], hi4[2], hi4[3]};
                    S[nt] = __builtin_amdgcn_mfma_f32_32x32x16_bf16(kf, wb[ks], S[nt], 0, 0, 0);
                }
            }
        }
        LDS_WAIT();
    }
#undef LFRAG
#undef G2_DMA
}

__device__ __forceinline__ void ssd2_item(const Args& a, int item, unsigned char* lds) {
    const int ps = item & 1, h = (item >> 1) & 15, dir = (item >> 5) & 1, b = item >> 6, g = h >> 3;
    const int lane0 = threadIdx.x & 63;
    constexpr int BUFB = 40960, O_B = 0, O_C = 16384, O_X = 32768, O_XD = 2 * BUFB + 512, O_XW = O_XD + 64 * 72;
    float* Gs = (float*)(lds + 2 * BUFB); float* Es = Gs + 64; float* ot = (float*)(lds + O_XW + 64 * 72);
    const LAS unsigned char* ldl = (const LAS unsigned char*)lds;
    const bf16_t* XB = (const bf16_t*)(a.ws + WS_XBC16); const float* ACT = (const float*)(a.ws + WS_ACT); const float* SM = (const float*)(a.ws + WS_SMALL);
    float* Y = (float*)(a.ws + (dir ? WS_YB : WS_YF));
    const float A = -expf(a.in[dir ? 13 : 12][h]); const float dtb = a.in[dir ? 11 : 10][h];
    f32x16_t H[4];
#pragma unroll
    for (int nt = 0; nt < 4; ++nt)
#pragma unroll
        for (int r = 0; r < 16; ++r) H[nt][r] = 0.f;
    float gdr;
#define S2_DMA(c_, buf_) do { const int t_ = dir ? SEQ - 1 - (64 * (c_) + lane0) : 64 * (c_) + lane0; const size_t mi_ = (size_t)b * SEQ + t_; \
        const bf16_t* br_ = XB + mi_ * 1536 + 1024 + g * 128; const bf16_t* cr_ = XB + mi_ * 1536 + 1280 + g * 128; const float* xr_ = ACT + mi_ * 1536 + h * 64 + ps * 32; \
        LAS unsigned char* lb_ = (LAS unsigned char*)lds + (buf_) * BUFB; \
        _Pragma("unroll") for (int x = 0; x < 16; ++x) { __builtin_amdgcn_global_load_lds((const unsigned*)(br_ + 8 * x), (LAS unsigned*)(lb_ + O_B + 1024 * x), 16, 0, 0); \
                                                         __builtin_amdgcn_global_load_lds((const unsigned*)(cr_ + 8 * x), (LAS unsigned*)(lb_ + O_C + 1024 * x), 16, 0, 0); } \
        _Pragma("unroll") for (int x = 0; x < 8; ++x) __builtin_amdgcn_global_load_lds((const unsigned*)(xr_ + 4 * x), (LAS unsigned*)(lb_ + O_X + 1024 * x), 16, 0, 0); \
        gdr = SM[mi_ * 32 + dir * 16 + h]; } while (0)
    S2_DMA(0, 0);
    for (int c = 0; c < 32; ++c) {
        int lane = lane0; asm volatile("" : "+v"(lane));
        const int r32 = lane & 31, hi = lane >> 5, trq = (lane & 15) >> 2, trp = lane & 3, trc = (lane >> 4) & 1;
        const int bo = (c & 1) * BUFB;
        const float dt = softplus_f(gdr + dtb);
        const float cs = wave_incl_scan(dt * A, lane); const float csL = __shfl(cs, 63);
        Gs[lane] = cs; Es[lane] = expf(cs);
        asm volatile("s_waitcnt vmcnt(0)" ::: "memory");
        if (c + 1 < 32) S2_DMA(c + 1, (c + 1) & 1);
        {
            const float wsc = dt * expf(csL - cs);
#pragma unroll
            for (int x = 0; x < 8; ++x) { const f32x4 xv = *(const LAS f32x4*)(ldl + bo + O_X + (x * 64 + lane) * 16);
                v2u d; d.x = cvtpk_rne(xv.x * dt, xv.y * dt); d.y = cvtpk_rne(xv.z * dt, xv.w * dt); *(LAS v2u*)((LAS unsigned char*)lds + O_XD + lane * 72 + 8 * x) = d;
                v2u w; w.x = cvtpk_rne(xv.x * wsc, xv.y * wsc); w.y = cvtpk_rne(xv.z * wsc, xv.w * wsc); *(LAS v2u*)((LAS unsigned char*)lds + O_XW + lane * 72 + 8 * x) = w; }
        }
        LDS_WAIT();
        f32x16_t g00, g01, g11;
#pragma unroll
        for (int r = 0; r < 16; ++r) { g00[r] = 0.f; g01[r] = 0.f; g11[r] = 0.f; }
#pragma unroll
        for (int kk = 0; kk < 8; ++kk) { const int fo = ((2 * kk + hi) * 64 + r32) * 16;
            const bf16x8_t A0 = *(const LAS bf16x8_t*)(ldl + bo + O_B + fo), A1 = *(const LAS bf16x8_t*)(ldl + bo + O_B + fo + 512);
            const bf16x8_t B0 = *(const LAS bf16x8_t*)(ldl + bo + O_C + fo), B1 = *(const LAS bf16x8_t*)(ldl + bo + O_C + fo + 512);
            g00 = __builtin_amdgcn_mfma_f32_32x32x16_bf16(A0, B0, g00, 0, 0, 0); g01 = __builtin_amdgcn_mfma_f32_32x32x16_bf16(A0, B1, g01, 0, 0, 0); g11 = __builtin_amdgcn_mfma_f32_32x32x16_bf16(A1, B1, g11, 0, 0, 0); }
        {   const float cst0 = Gs[r32], cst1 = Gs[32 + r32];
#pragma unroll
            for (int r = 0; r < 16; ++r) { const int il = (r & 3) + 8 * (r >> 2) + 4 * hi; const float css0 = Gs[il], css1 = Gs[32 + il];
                g00[r] = (il <= r32) ? g00[r] * expf(cst0 - css0) : 0.f; g01[r] = g01[r] * expf(cst1 - css0); g11[r] = (il <= r32) ? g11[r] * expf(cst1 - css1) : 0.f; } }
        asm volatile("" ::: "memory");
        f32x16_t y0, y1;
#pragma unroll
        for (int r = 0; r < 16; ++r) { y0[r] = 0.f; y1[r] = 0.f; }
#define TRFRAG(base_) ({ const s16x4_t lo_ = __builtin_bit_cast(s16x4_t, __builtin_amdgcn_ds_read_tr16_b64_v4i16((LAS s16x4_t*)(ldl + (base_)))); \
                         const s16x4_t hi_ = __builtin_bit_cast(s16x4_t, __builtin_amdgcn_ds_read_tr16_b64_v4i16((LAS s16x4_t*)(ldl + (base_) + 8 * 72))); \
                         (bf16x8_t){lo_[0], lo_[1], lo_[2], lo_[3], hi_[0], hi_[1], hi_[2], hi_[3]}; })
        {   const int xo = O_XD + (4 * hi + trq) * 72 + (16 * trc + 4 * trp) * 2;
            const bf16x8_t x0 = TRFRAG(xo), x1 = TRFRAG(xo + 16 * 72), x2 = TRFRAG(xo + 32 * 72), x3 = TRFRAG(xo + 48 * 72);
            y0 = __builtin_amdgcn_mfma_f32_32x32x16_bf16(acc_frag<0>(g00), x0, y0, 0, 0, 0); y0 = __builtin_amdgcn_mfma_f32_32x32x16_bf16(acc_frag<1>(g00), x1, y0, 0, 0, 0);
            y1 = __builtin_amdgcn_mfma_f32_32x32x16_bf16(acc_frag<0>(g01), x0, y1, 0, 0, 0); y1 = __builtin_amdgcn_mfma_f32_32x32x16_bf16(acc_frag<1>(g01), x1, y1, 0, 0, 0);
            y1 = __builtin_amdgcn_mfma_f32_32x32x16_bf16(acc_frag<0>(g11), x2, y1, 0, 0, 0); y1 = __builtin_amdgcn_mfma_f32_32x32x16_bf16(acc_frag<1>(g11), x3, y1, 0, 0, 0); }
        asm volatile("" ::: "memory");
        {   f32x16_t Z0, Z1;
#pragma unroll
            for (int r = 0; r < 16; ++r) { Z0[r] = 0.f; Z1[r] = 0.f; }
#define LFRAG(off_) join44(*(const LAS v2u*)(ldl + (off_)), *(const LAS v2u*)(ldl + (off_) + 1024))
#pragma unroll
            for (int nt = 0; nt < 4; ++nt) { const bf16x8_t hb0 = acc_frag<0>(H[nt]), hb1 = acc_frag<1>(H[nt]);
                const int ro = bo + O_C + ((4 * nt) * 64 + r32) * 16 + 8 * hi;
                Z0 = __builtin_amdgcn_mfma_f32_32x32x16_bf16(LFRAG(ro), hb0, Z0, 0, 0, 0); Z0 = __builtin_amdgcn_mfma_f32_32x32x16_bf16(LFRAG(ro + 2048), hb1, Z0, 0, 0, 0);
                Z1 = __builtin_amdgcn_mfma_f32_32x32x16_bf16(LFRAG(ro + 512), hb0, Z1, 0, 0, 0); Z1 = __builtin_amdgcn_mfma_f32_32x32x16_bf16(LFRAG(ro + 512 + 2048), hb1, Z1, 0, 0, 0); }
#undef LFRAG
#pragma unroll
            for (int r = 0; r < 16; ++r) { const int il = (r & 3) + 8 * (r >> 2) + 4 * hi; ot[il * 33 + r32] = fmaf(Es[il], Z0[r], y0[r]); ot[(32 + il) * 33 + r32] = fmaf(Es[32 + il], Z1[r], y1[r]); } }
        LDS_WAIT();
        { const int t = dir ? SEQ - 1 - (64 * c + lane) : 64 * c + lane; float* yrow = Y + ((size_t)b * SEQ + t) * 1024 + h * 64 + ps * 32;
#pragma unroll
          for (int x = 0; x < 8; ++x) *(f32x4*)(yrow + 4 * x) = (f32x4){ot[lane * 33 + 4 * x], ot[lane * 33 + 4 * x + 1], ot[lane * 33 + 4 * x + 2], ot[lane * 33 + 4 * x + 3]}; }
        asm volatile("" ::: "memory");
        {   const float eL = expf(csL);
            const int xo = O_XW + (4 * hi + trq) * 72 + (16 * trc + 4 * trp) * 2;
            const bf16x8_t w0 = TRFRAG(xo), w1 = TRFRAG(xo + 16 * 72), w2 = TRFRAG(xo + 32 * 72), w3 = TRFRAG(xo + 48 * 72);
#undef TRFRAG
#pragma unroll
            for (int nt = 0; nt < 4; ++nt) {
#pragma unroll
                for (int r = 0; r < 16; ++r) H[nt][r] *= eL;
#pragma unroll
                for (int ks = 0; ks < 4; ++ks) {
                    const int ro = bo + O_B + ((4 * nt + 2 * trc + (trp >> 1)) * 64 + 16 * ks + 4 * hi + trq) * 16 + 8 * (trp & 1);
                    const s16x4_t lo = __builtin_bit_cast(s16x4_t, __builtin_amdgcn_ds_read_tr16_b64_v4i16((LAS s16x4_t*)(ldl + ro)));
                    const s16x4_t hi4 = __builtin_bit_cast(s16x4_t, __builtin_amdgcn_ds_read_tr16_b64_v4i16((LAS s16x4_t*)(ldl + ro + 8 * 16)));
                    const bf16x8_t bfr = (bf16x8_t){lo[0], lo[1], lo[2], lo[3], hi4[0], hi4[1], hi4[2], hi4[3]};
                    H[nt] = __builtin_amdgcn_mfma_f32_32x32x16_bf16(bfr, ks == 0 ? w0 : ks == 1 ? w1 : ks == 2 ? w2 : w3, H[nt], 0, 0, 0);
                }
            }
        }
        LDS_WAIT();
    }
#undef S2_DMA
}

__device__ __forceinline__ void lru_tile(const Args& a, int item, unsigned char* lds, int pass) {
    const int n = item & 7, tc = (item >> 3) & 63, b = item >> 9, t0 = tc * 32;
    float* xc = (float*)lds; bf16_t* xcb = (bf16_t*)(lds + 16384); float* As = (float*)(lds + 25088); float* Us = As + 2 * 32 * 128; float2* sg = (float2*)(Us + 2 * 32 * 128);
    const int tid = threadIdx.x, lane = tid & 63, wave = tid >> 6;
    const bf16_t* P = (const bf16_t*)(a.ws + WS_PROJ);
    __syncthreads();
    {
        const int j = tid & 127, tg = tid >> 7, chn = n * 128 + j; const float* cw = a.in[25];
        const float w0 = cw[chn], w1 = cw[1024 + chn], w2 = cw[2048 + chn], w3 = cw[3072 + chn], cbias = a.in[26][chn];
        const int tb = t0 + tg * 8;
        const bf16_t* pp = P + ((size_t)b * SEQ + tb) * NINP + C_XL + chn;
        float xm2 = (tb >= 2) ? bf2f(pp[-2 * NINP]) : 0.f, xm1 = (tb >= 1) ? bf2f(pp[-NINP]) : 0.f, x0 = bf2f(pp[0]);
#pragma unroll
        for (int i = 0; i < 8; ++i) { const float xp1 = (tb + i + 1 < SEQ) ? bf2f(pp[(i + 1) * NINP]) : 0.f;
            const float acc = cbias + w0 * xm2 + w1 * xm1 + w2 * x0 + w3 * xp1;
            xc[(tg * 8 + i) * 128 + j] = acc; xcb[(tg * 8 + i) * 136 + j] = (bf16_t)f2bf(acc);
            xm2 = xm1; xm1 = x0; x0 = xp1; }
    }
    __syncthreads();
    {
        const int ct = wave & 3, d = wave >> 2, r32 = lane & 31, hi = lane >> 5;
        const bf16_t* WT = (const bf16_t*)(a.ws + WS_WGT);
        const bf16_t* wa_p = WT + ((size_t)((2 * d) * 8 + n) * 128 + ct * 32 + r32) * 128 + hi * 8;
        const bf16_t* wx_p = WT + ((size_t)((2 * d + 1) * 8 + n) * 128 + ct * 32 + r32) * 128 + hi * 8;
        f32x16_t ca, cx;
#pragma unroll
        for (int r = 0; r < 16; ++r) { ca[r] = 0.f; cx[r] = 0.f; }
#pragma unroll
        for (int s = 0; s < 8; ++s) {
            const bf16x8_t af = *(const bf16x8_t*)((const char*)xcb + r32 * 272 + (s * 16 + hi * 8) * 2);
            const bf16x8_t fa = *(const bf16x8_t*)(wa_p + s * 16); const bf16x8_t fx = *(const bf16x8_t*)(wx_p + s * 16);
            ca = __builtin_amdgcn_mfma_f32_32x32x16_bf16(af, fa, ca, 0, 0, 0); cx = __builtin_amdgcn_mfma_f32_32x32x16_bf16(af, fx, cx, 0, 0, 0);
        }
        const int j = ct * 32 + r32, cj = n * 128 + j;
        const float baj = a.in[d ? 33 : 28][cj], bxj = a.in[d ? 35 : 30][cj], sp = softplus_f(-a.in[d ? 36 : 31][cj]);
#pragma unroll
        for (int r = 0; r < 16; ++r) { const int t = (r & 3) + 8 * (r >> 2) + 4 * hi;
            const float rg = sigmoid_f(ca[r] + baj), ig = sigmoid_f(cx[r] + bxj); const float la = -8.f * rg * sp;
            As[(d * 32 + t) * 128 + j] = expf(la); Us[(d * 32 + t) * 128 + j] = sqrtf(-expm1f(2.f * la)) * (ig * xc[t * 128 + j]); }
    }
    __syncthreads();
    {
        const int j = tid & 127, d = (tid >> 7) & 1, seg = tid >> 8;
        float Pp = 1.f, H = 0.f;
#pragma unroll
        for (int k = 0; k < 16; ++k) { const int q = seg * 16 + k, t = d ? 31 - q : q; const float a_ = As[(d * 32 + t) * 128 + j], u_ = Us[(d * 32 + t) * 128 + j]; H = fmaf(a_, H, u_); Pp *= a_; }
        sg[(d * 2 + seg) * 128 + j] = make_float2(Pp, H);
        __syncthreads();
        float2* LS = (float2*)(a.ws + WS_LSUM);
        if (pass == 0) {
            if (seg == 0) { const float2 s1 = sg[(d * 2 + 1) * 128 + j]; LS[((size_t)(d * 4 + b) * 64 + tc) * 1024 + n * 128 + j] = make_float2(Pp * s1.x, fmaf(s1.x, H, s1.y)); }
        } else {
            float c = 0.f;
            const float2* lsp = LS + ((size_t)(d * 4 + b) * 64) * 1024 + n * 128 + j;
#pragma unroll 1
            for (int c0 = 0; c0 < 64; c0 += 16) { float2 sv[16];
#pragma unroll
                for (int i = 0; i < 16; ++i) { const int cc = d ? 63 - (c0 + i) : c0 + i; sv[i] = lsp[(size_t)cc * 1024]; }
#pragma unroll
                for (int i = 0; i < 16; ++i) { const int cc = d ? 63 - (c0 + i) : c0 + i; const bool before = d ? (cc > tc) : (cc < tc); if (before) c = fmaf(sv[i].x, c, sv[i].y); } }
            if (seg == 1) { const float2 s0 = sg[(d * 2) * 128 + j]; c = fmaf(s0.x, c, s0.y); }
            float h = c;
#pragma unroll
            for (int k = 0; k < 16; ++k) { const int q = seg * 16 + k, t = d ? 31 - q : q; const float a_ = As[(d * 32 + t) * 128 + j], u_ = Us[(d * 32 + t) * 128 + j]; h = fmaf(a_, h, u_); Us[(d * 32 + t) * 128 + j] = h; }
            __syncthreads();
            bf16_t* YC = (bf16_t*)(a.ws + WS_YCAT);
            const int jj = tid & 127, tg = tid >> 7;
#pragma unroll
            for (int i = 0; i < 8; ++i) { const int t = tg * 8 + i; const size_t row = (size_t)b * SEQ + t0 + t;
                const float hs = Us[t * 128 + jj] + Us[(32 + t) * 128 + jj]; const float gl = bf2f(P[row * NINP + C_GL + n * 128 + jj]);
                YC[row * 2048 + 1024 + n * 128 + jj] = (bf16_t)f2bf(hs * silu_f(gl)); }
        }
    }
}

__device__ __forceinline__ void combine1_phase(const Args& a, int gw, int NGW, int lane) {
    const float* OF = (const float*)(a.ws + WS_YF); const float* OB = (const float*)(a.ws + WS_YB);
    const bf16_t* P = (const bf16_t*)(a.ws + WS_PROJ); bf16_t* YC = (bf16_t*)(a.ws + WS_YCAT);
    const float* gn = a.in[24];
    for (int m = gw; m < MTOK; m += NGW) {
        const int ch = lane * 16, d0 = ch & 127;
        float z[16], ov[16];
        unpack8(*(const v4u*)(P + (size_t)m * NINP + C_Z + ch), z); unpack8(*(const v4u*)(P + (size_t)m * NINP + C_Z + ch + 8), z + 8);
#pragma unroll
        for (int q = 0; q < 4; ++q) { const f32x4 f = *(const f32x4*)(OF + (size_t)m * 1024 + ch + 4 * q), bk = *(const f32x4*)(OB + (size_t)m * 1024 + ch + 4 * q); const f32x4 o = f + bk;
            ov[4 * q] = o.x; ov[4 * q + 1] = o.y; ov[4 * q + 2] = o.z; ov[4 * q + 3] = o.w; }
        float ss = 0.f;
#pragma unroll
        for (int i = 0; i < 16; ++i) ss += ov[i] * ov[i];
        ss = group_sum<8>(ss);
        const float r = rsqrtf(ss * (1.f / 128.f) + EPS);
#pragma unroll
        for (int i = 0; i < 16; ++i) ov[i] = ov[i] * r * gn[d0 + i] * silu_f(z[i]);
        *(v4u*)(YC + (size_t)m * 2048 + ch) = pack8(ov); *(v4u*)(YC + (size_t)m * 2048 + ch + 8) = pack8(ov + 8);
    }
}

__device__ __forceinline__ void final_norm_phase(const Args& a, int gw, int NGW, int lane) {
    const float* nw = a.in[38];
    for (int m = gw; m < MTOK; m += NGW) {
        f32x4* xr = (f32x4*)(a.out + (size_t)m * 2048) + lane;
        f32x4 v[8]; float s = 0.f;
#pragma unroll
        for (int j = 0; j < 8; ++j) { v[j] = xr[64 * j]; s += (v[j].x * v[j].x + v[j].y * v[j].y) + (v[j].z * v[j].z + v[j].w * v[j].w); }
        const float rstd = rsqrtf(group_sum<64>(s) * (1.f / 2048.f) + EPS);
#pragma unroll
        for (int j = 0; j < 8; ++j) { const f32x4 w = *(const f32x4*)(nw + (64 * j + lane) * 4); xr[64 * j] = v[j] * rstd * w; }
    }
}

typedef GAS unsigned gu32;
#define RLX_AGENT __ATOMIC_RELAXED, __HIP_MEMORY_SCOPE_AGENT
constexpr int CW_BAR = 4096;
constexpr int MISC_OFF = 147456 - 128;
#define XB_TMO      128
#define XB_XCNT(j)  (256  + 64 * (j))
#define XB_XSUB(j)  (1280 + 64 * (j))
#define XB_XGEN(j)  (2304 + 64 * (j))
#define XB_TOP      3328
#define XB_TOPGEN   3392
#define XCD_BAR_WORDS 3456
#define XB_SPIN_CAP (1u << 18)

__device__ __forceinline__ unsigned xb_ld(unsigned* p)              { return __hip_atomic_load(p, __ATOMIC_RELAXED, __HIP_MEMORY_SCOPE_AGENT); }
__device__ __forceinline__ unsigned xb_add(unsigned* p, unsigned v) { return __hip_atomic_fetch_add(p, v, __ATOMIC_RELAXED, __HIP_MEMORY_SCOPE_AGENT); }
__device__ __forceinline__ unsigned xb_xcc_id() { return (unsigned)__builtin_amdgcn_s_getreg((3 << 11) | 20) & 0xFu; }
#define XB_SPIN(cond, bar) do { unsigned _sp = 0; while (cond) { __builtin_amdgcn_s_sleep(1); \
    if ((++_sp & 255u) == 0u) { if (xb_ld(&(bar)[XB_TMO])) break; if (_sp > XB_SPIN_CAP) { atomicAdd(&(bar)[XB_TMO], 1u); break; } } } } while (0)

struct XcdBarrier {
    unsigned* bar; unsigned x;
    volatile LAS unsigned* st;
};

__device__ __forceinline__ XcdBarrier xcd_barrier_post(unsigned* bar, volatile LAS unsigned* st) {
    XcdBarrier b; b.bar = bar; b.x = xb_xcc_id(); b.st = st;
    if (threadIdx.x == 0) (void)xb_add(&bar[XB_XCNT(b.x)], 1u);
    return b;
}
__device__ __forceinline__ void xcd_barrier_complete(unsigned* bar, unsigned x, unsigned& nloc, unsigned& nx) {
    const unsigned G = gridDim.x * gridDim.y * gridDim.z;
    unsigned sum, cnt, mine, sp = 0u;
    for (;;) {
        sum = 0u; cnt = 0u; mine = 0u;
#pragma unroll
        for (unsigned j = 0; j < 16; ++j) { const unsigned c = xb_ld(&bar[XB_XCNT(j)]); sum += c; cnt += (c > 0u) ? 1u : 0u; mine = (j == x) ? c : mine; }
        if (sum == G) break;
        __builtin_amdgcn_s_sleep(1);
        if ((++sp & 255u) == 0u) { if (xb_ld(&bar[XB_TMO])) break; if (sp > XB_SPIN_CAP) { atomicAdd(&bar[XB_TMO], 1u); break; } }
    }
    nloc = mine > 0u ? mine : 1u; nx = cnt > 0u ? cnt : 1u;
}

__device__ __forceinline__ void xcd_barrier(const XcdBarrier& b) {
    asm volatile("s_waitcnt vmcnt(0)" ::: "memory");
    __syncthreads();
    if (threadIdx.x == 0) {
        unsigned* bar = b.bar;
        __builtin_amdgcn_s_waitcnt(0);
        unsigned nloc = b.st[0], nx = b.st[1];
        if (nloc == 0u) { xcd_barrier_complete(bar, b.x, nloc, nx); b.st[0] = nloc; b.st[1] = nx; }
        const unsigned old = xb_add(&bar[XB_XSUB(b.x)], 1u);
        const unsigned gen = old / nloc;
        if (old + 1u == (gen + 1u) * nloc) {
            __builtin_amdgcn_fence(__ATOMIC_RELEASE, "agent");
            asm volatile("s_waitcnt vmcnt(0)" ::: "memory");
            const unsigned og = xb_add(&bar[XB_TOP], 1u);
            const unsigned tg = og / nx;
            if (og + 1u == (tg + 1u) * nx) xb_add(&bar[XB_TOPGEN], 1u);
            else XB_SPIN(xb_ld(&bar[XB_TOPGEN]) == tg, bar);
            __builtin_amdgcn_fence(__ATOMIC_ACQUIRE, "agent");
            xb_add(&bar[XB_XGEN(b.x)], 1u);
            asm volatile("s_waitcnt vmcnt(0)" ::: "memory");
        } else {
            XB_SPIN(xb_ld(&bar[XB_XGEN(b.x)]) == gen, bar);
            __builtin_amdgcn_fence(__ATOMIC_ACQUIRE, "agent");
            asm volatile("s_waitcnt vmcnt(0)" ::: "memory");
        }
    }
    __syncthreads();
}

#ifndef PROBE_MASK
#define PROBE_MASK 0
#endif
#define REP(bit) for (int rep_ = 0; rep_ < 1 + ((PROBE_MASK >> (bit)) & 1); ++rep_)
#ifndef PROBE_SSD
#define PROBE_SSD 0
#endif
#ifndef PROBE_GDN
#define PROBE_GDN 0
#endif
#ifndef PROBE_LRU
#define PROBE_LRU 0
#endif
#ifndef MK_SINGLE
#define MK_SINGLE 1
#endif
__global__ void __launch_bounds__(NTHREADS, 2) mk_fwd(Args a) {
    extern __shared__ __attribute__((aligned(16))) unsigned char lds[];
    LAS unsigned char* ldsl = (LAS unsigned char*)lds;
    const int tid = threadIdx.x, lane = tid & 63, wave = __builtin_amdgcn_readfirstlane(tid >> 6);
    const int G = gridDim.x, bx = blockIdx.x;
    const int vcu = (G % 8 == 0) ? (bx % 8) * (G / 8) + bx / 8 : bx;
    const int gw = vcu * NWAVES + wave, NGW = G * NWAVES;
    unsigned char* ws = a.ws;
    volatile LAS unsigned* MISC = (volatile LAS unsigned*)(ldsl + MISC_OFF);
    if (tid < 32) MISC[tid] = 0u;
    __syncthreads();
    XcdBarrier bar; bar.bar = (unsigned*)(ws + WS_CTL) + CW_BAR; bar.x = 0; bar.st = nullptr;
    if (a.ph_hi - a.ph_lo > 1) bar = xcd_barrier_post((unsigned*)(ws + WS_CTL) + CW_BAR, MISC + 8);
#define IN(k) (a.ph_lo <= (k) && (k) < a.ph_hi)
#define SEAM(k) do { if (IN(k) && IN((k) + 1)) { xcd_barrier(bar); } } while (0)

    if (IN(0)) { p0_prologue(a, ldsl, vcu, G); } SEAM(0);
    if (IN(1)) { REP(0) normmod_phase(a, a.in[0], 0, gw, NGW, lane); } SEAM(1);
    if (IN(2)) {
        pg8::Gemm g{(const bf16_t*)(ws + WS_H), (const bf16_t*)(ws + WS_WIN0), MTOK, NINP, 2048}; pg8::StaticOrder S; S.init(MTOK, NINP, G, bx);
        pg8::EpiProj E{(bf16_t*)(ws + WS_PROJ), (float*)(ws + WS_SMALL), NINP, A_DT / 256};
        REP(1) { pg8::gemm_phase<pg8::EpiProj, pg8::StaticOrder, true, true>(ldsl, g, S, E); __syncthreads(); }
    } SEAM(2);
    if (IN(3)) { REP(0) post0_phase(a, gw, NGW, lane); } SEAM(3);
    if (IN(4)) {
        REP(3) for (int u = vcu; u < 256; u += G) { const int b = u >> 6, h = (u >> 3) & 7, qb = u & 7, kvh = h >> 2; const size_t row0 = (size_t)b * SEQ + qb * 256;
            att::attn_dense_body((const att::bf16*)(ws + WS_QB) + row0 * 1024 + h * 128, (const att::bf16*)(ws + WS_KB) + (size_t)b * SEQ * 256 + kvh * 128,
                                 (const att::bf16*)(ws + WS_VB) + (size_t)b * SEQ * 256 + kvh * 128, (bf16_t*)(ws + WS_YCAT) + row0 * 2048 + h * 128,
                                 (const bf16_t*)(ws + WS_PROJ) + row0 * NINP + A_GA + h * 128, SEQ, (char*)lds);
            __syncthreads(); }
        for (int rep = 0; rep < 1 + PROBE_SSD; ++rep) { if (wave == 0) { for (int it = vcu; it < 256; it += G) ssd2_item(a, it, lds); } __syncthreads(); }
    } SEAM(4);
    if (IN(5)) { REP(0) ssd_combine_phase(a, gw, NGW, lane); } SEAM(5);
    if (IN(6)) {
        pg8::Gemm g{(const bf16_t*)(ws + WS_YCAT), (const bf16_t*)(ws + WS_WOUT0), MTOK, 2048, 2048}; pg8::StaticOrder S; S.init(MTOK, 2048, G, bx);
        pg8::EpiResid E{a.in[0], a.out, (const float*)(ws + WS_MOD), a.in[3]};
        REP(2) { pg8::gemm_phase<pg8::EpiResid, pg8::StaticOrder, true, true>(ldsl, g, S, E); __syncthreads(); }
    } SEAM(6);
    if (IN(7)) { REP(0) normmod_phase(a, a.out, 1, gw, NGW, lane); } SEAM(7);
    if (IN(8)) {
        pg8::Gemm g{(const bf16_t*)(ws + WS_H), (const bf16_t*)(ws + WS_WIN1), MTOK, NINP, 2048}; pg8::StaticOrder S; S.init(MTOK, NINP, G, bx);
        pg8::EpiProj E{(bf16_t*)(ws + WS_PROJ), (float*)(ws + WS_SMALL), NINP, C_SM / 256};
        pg8::gemm_phase<pg8::EpiProj, pg8::StaticOrder, true, true>(ldsl, g, S, E);
    } SEAM(8);
    if (IN(9)) { REP(0) post1_phase(a, gw, NGW, lane); } SEAM(9);
    if (IN(10)) {
        REP(5) { for (int it = gw; it < 2048; it += NGW) gdn1_item(a, it, lds + wave * GDN_LDS_PER_WAVE, lane); __syncthreads(); }
        for (int rep = 0; rep < 1 + PROBE_LRU; ++rep) { for (int it = bx; it < 2048; it += G) lru_tile(a, it, lds, 0); __syncthreads(); }
    } SEAM(10);
    if (IN(11)) {
        REP(6) { if (wave == 0) { for (int it = vcu; it < 256; it += G) gdn2_item(a, it, lds); } __syncthreads(); }
    } SEAM(11);
    if (IN(12)) { REP(0) combine1_phase(a, gw, NGW, lane); __syncthreads(); REP(4) { for (int it = bx; it < 2048; it += G) lru_tile(a, it, lds, 1); __syncthreads(); } } SEAM(12);
    if (IN(13)) {
        pg8::Gemm g{(const bf16_t*)(ws + WS_YCAT), (const bf16_t*)(ws + WS_WOUT1), MTOK, 2048, 2048}; pg8::StaticOrder S; S.init(MTOK, 2048, G, bx);
        pg8::EpiResid E{a.out, a.out, (const float*)(ws + WS_MOD) + 4 * 6144, a.in[3] + 6144};
        pg8::gemm_phase<pg8::EpiResid, pg8::StaticOrder, true, true>(ldsl, g, S, E);
    } SEAM(13);
    if (IN(14)) { final_norm_phase(a, gw, NGW, lane); }
#undef IN
#undef SEAM
}

extern "C" void kernel_launch(void* const* d_in, const int* in_sizes, int n_in, void* d_out, int out_size, void* d_ws, size_t ws_size, hipStream_t stream) {
    static int grid = 0;
    if (grid == 0) {
        if (n_in != 39 || out_size != MTOK * DM || ws_size < WS_END) { fprintf(stderr, "kernel_launch: unexpected problem (n_in %d, out %d, ws %zu < %zu)\n", n_in, out_size, ws_size, (size_t)WS_END); grid = -1; return; }
        int dev = 0, cus = 0, per_cu = 0;
        if (hipGetDevice(&dev) != hipSuccess || hipDeviceGetAttribute(&cus, hipDeviceAttributeMultiprocessorCount, dev) != hipSuccess) { grid = -1; return; }
        if (hipFuncSetAttribute((const void*)mk_fwd, hipFuncAttributeMaxDynamicSharedMemorySize, LDS_BYTES) != hipSuccess) { fprintf(stderr, "kernel_launch: hipFuncSetAttribute failed\n"); grid = -1; return; }
        if (hipOccupancyMaxActiveBlocksPerMultiprocessor(&per_cu, (const void*)mk_fwd, NTHREADS, LDS_BYTES) != hipSuccess || per_cu < 1) { fprintf(stderr, "kernel_launch: occupancy query says %d\n", per_cu); (void)hipGetLastError(); per_cu = 1; }
        grid = cus;
    }
    if (grid < 0) return;
    (void)hipMemsetAsync((char*)d_ws + WS_CTL, 0, CTL_ZERO_BYTES, stream);
    Args a{};
    for (int i = 0; i < 39; ++i) a.in[i] = (const float*)d_in[i];
    a.out = (float*)d_out; a.ws = (unsigned char*)d_ws;
#if MK_SINGLE
    a.ph_lo = 0; a.ph_hi = NPHASE;
    void* kargs[] = {&a};
    hipError_t e = hipLaunchCooperativeKernel((const void*)mk_fwd, dim3(grid), dim3(NTHREADS), kargs, LDS_BYTES, stream);
    if (e != hipSuccess) fprintf(stderr, "kernel_launch: cooperative launch failed: %s (grid %d)\n", hipGetErrorString(e), grid);
#else
    for (int p = 0; p < NPHASE; ++p) { a.ph_lo = p; a.ph_hi = p + 1; hipLaunchKernelGGL(mk_fwd, dim3(grid), dim3(NTHREADS), LDS_BYTES, stream, a); }
#endif
}
```

```cpp
#include <hip/hip_runtime.h>
#include <hip/hip_cooperative_groups.h>
#include <hip/hip_bf16.h>
#include <cstdio>
#include <cstdint>
namespace cg = cooperative_groups;

constexpr int BATCH = 4, SEQ = 2048, DM = 2048, MTOK = BATCH * SEQ;
constexpr int NIN = 5152, NINP = 5376;
constexpr float EPS = 1e-6f;
constexpr int A_Q = 0, A_K = 1024, A_V = 1280, A_GA = 1536, A_XS = 2560, A_BS = 3584, A_CS = 3840, A_DT = 4096, A_Z = 4128;
constexpr int C_Q = 0, C_K = 512, C_V = 1024, C_SM = 2048, C_Z = 2080, C_XL = 3104, C_GL = 4128;
namespace pg8 {
#define PG8_LAS __attribute__((address_space(3)))
typedef unsigned short bf16_t;
typedef short bf16x8 __attribute__((ext_vector_type(8)));
typedef float f32x4 __attribute__((ext_vector_type(4)));
typedef unsigned u32x4 __attribute__((ext_vector_type(4)));
constexpr int BM = 256, BK = 64, HALF = 128, HTB = HALF * BK * 2  , STAGE_BYTES = 8 * HTB, NXCD = 8, WGM = 8;

__host__ __device__ __forceinline__ int lds_byte(int r, int c) { const int st = (r >> 4) * 2 + (c >> 5), rr = r & 15, cc = c & 31, ob = rr * 64 + cc * 2; return st * 1024 + (ob ^ (((ob >> 9) & 1) << 5)); }
__host__ __device__ __forceinline__ void stage_rc(int b, int& R, int& C) { const int st = b / 1024, sb = b % 1024, swz = sb ^ (((sb >> 9) & 1) << 5); R = (st >> 1) * 16 + swz / 64; C = (st & 1) * 32 + (swz % 64) / 2; }
__host__ __device__ __forceinline__ int perm32(int rho) { const int n = rho >> 4, i = rho & 15; return 8 * (i >> 2) + 4 * n + (i & 3); }

struct Unit { int pm, pn; };
struct Gemm { const bf16_t* A; const bf16_t* Bt; int M, N, K; };

struct StaticOrder {
    int nM, nN, nwg, G, c;
    __host__ __device__ void init(int M, int N, int G_, int c_) { nM = M / BM; nN = N / BM; nwg = nM * nN; G = G_; c = c_; }
    __host__ __device__ bool next(int i, Unit& u) const {
        const long L = (long)i * G + c; if (L >= nwg) return false;
        int wgid = (int)L; { const int q = nwg / NXCD, r = nwg % NXCD, xcd = wgid % NXCD, off = wgid / NXCD; wgid = (xcd < r ? xcd * (q + 1) : r * (q + 1) + (xcd - r) * q) + off; }
        const int nig = WGM * nN, gid = wgid / nig, fm = gid * WGM, gsz = (nM - fm) < WGM ? (nM - fm) : WGM;
        u.pm = fm + ((wgid % nig) % gsz); u.pn = (wgid % nig) / gsz; return true;
    }
    __device__ __forceinline__ void a_ready(const Unit&) const {}
    __device__ __forceinline__ void done(const Unit&) const {}
};

__device__ __forceinline__ unsigned cvt_pk_bf16(float lo, float hi) { unsigned r; asm volatile("v_cvt_pk_bf16_f32 %0, %1, %2" : "=v"(r) : "v"(lo), "v"(hi)); return r; }
typedef float f32x2 __attribute__((ext_vector_type(2)));
struct EpiProj {
    static constexpr bool PERM = true, AFTER_DRAIN = false;
    bf16_t* O; float* small; int ldc; int small_tile;
    __device__ __forceinline__ void operator()(const f32x4 (&acc)[2][2][4][2], const Unit& u, int wr, int wc, int fr, int fq) const {
        const int row0 = u.pm * BM + wr * 64 + fr; const int col0 = u.pn * BM + wc * 32 + 8 * fq;
        const bool sm = (u.pn == small_tile) && (wc == 0);
#pragma unroll
        for (int ai = 0; ai < 2; ++ai)
#pragma unroll
            for (int m = 0; m < 4; ++m) { const int row = row0 + ai * HALF + m * 16; bf16_t* rowp = O + (size_t)row * ldc + col0;
#pragma unroll
                for (int bj = 0; bj < 2; ++bj) { const f32x4 v0 = acc[ai][bj][m][0], v1 = acc[ai][bj][m][1];
                    u32x4 w; w.x = cvt_pk_bf16(v0[0], v0[1]); w.y = cvt_pk_bf16(v0[2], v0[3]); w.z = cvt_pk_bf16(v1[0], v1[1]); w.w = cvt_pk_bf16(v1[2], v1[3]);
                    *(u32x4*)(rowp + bj * HALF) = w; }
                if (sm) { float* sp = small + (size_t)row * 32 + 8 * fq; *(f32x4*)sp = acc[ai][0][m][0]; *(f32x4*)(sp + 4) = acc[ai][0][m][1]; } }
    }
};
struct EpiResid {
    static constexpr bool PERM = false, AFTER_DRAIN = false;
    const float* xin; float* xout; const float* gacc; const float* gbias;
    __device__ __forceinline__ void operator()(const f32x4 (&acc)[2][2][4][2], const Unit& u, int wr, int wc, int fr, int fq) const {
        const int b = u.pm >> 3;
        const int col0 = u.pn * BM + wc * 32 + 4 * fq;
#pragma unroll
        for (int bj = 0; bj < 2; ++bj)
#pragma unroll
            for (int n = 0; n < 2; ++n) { const int col = col0 + bj * HALF + n * 16;
                const f32x4 g = *(const f32x4*)(gacc + (size_t)b * 6144 + 4096 + col) + *(const f32x4*)(gbias + 4096 + col);
#pragma unroll
                for (int ai = 0; ai < 2; ++ai)
#pragma unroll
                    for (int m = 0; m < 4; ++m) { const size_t off = (size_t)(u.pm * BM + ai * HALF + wr * 64 + m * 16 + fr) * 2048 + col;
                        const f32x4 xv = *(const f32x4*)(xin + off); *(f32x4*)(xout + off) = xv + g * acc[ai][bj][m][n]; } }
    }
};
template <class Epi, class Sched, bool ALIGN_EPI = false, bool SP2 = false>
__device__ __forceinline__ void gemm_phase(PG8_LAS unsigned char* lds, const Gemm g, const Sched& S, const Epi& E) {
    const int tid = threadIdx.x, wid = __builtin_amdgcn_readfirstlane(tid >> 6), lane = tid & 63, wr = wid >> 2, wc = wid & 3, fr = lane & 15, fq = lane >> 4;
    const int K = g.K, nt = K / BK;
    unsigned voffA[2], voffB[2];
#pragma unroll
    for (int i = 0; i < 2; ++i) { int R, C; stage_rc(tid * 16 + i * 8192, R, C); const int Rb = Epi::PERM ? ((R & ~31) + perm32(R & 31)) : R;
        voffA[i] = (unsigned)(R * K + C) * 2u; voffB[i] = (unsigned)(Rb * K + C) * 2u; }
    const size_t kstep = (size_t)(BK * 2);
    const size_t hstep = (size_t)HALF * K * 2;
    const size_t tstep = 2 * hstep;
    const unsigned ldsw = (unsigned)wid * 1024u;
    const int aoff = lds_byte(wr * 64 + fr, fq * 8), boff = lds_byte(wc * 32 + fr, fq * 8);
#define PG8_SA(b, h) (((b) * 2 + (h)) * HTB)
#define PG8_SB(b, h) ((4 + (b) * 2 + (h)) * HTB)
#define PG8_STAGE(bufoff, gbase, voff) do { _Pragma("unroll") for (int _i = 0; _i < 2; ++_i) \
        __builtin_amdgcn_global_load_lds((const unsigned*)((const char*)(gbase) + (voff)[_i]), (PG8_LAS unsigned*)(lds + (bufoff) + ldsw + _i * 8192), 16, 0, 0); } while (0)
#define PG8_LDA(dst, b, h) do { _Pragma("unroll") for (int m = 0; m < 4; ++m) _Pragma("unroll") for (int k = 0; k < 2; ++k) dst[m][k] = *(const PG8_LAS bf16x8*)(lds + PG8_SA(b, h) + aoff + m * 2048 + k * 1024); } while (0)
#define PG8_LDB(dst, b, h) do { _Pragma("unroll") for (int n = 0; n < 2; ++n) _Pragma("unroll") for (int k = 0; k < 2; ++k) dst[n][k] = *(const PG8_LAS bf16x8*)(lds + PG8_SB(b, h) + boff + n * 2048 + k * 1024); } while (0)
#define PG8_MMA(ai, bj, At, Bt) do { __builtin_amdgcn_s_setprio(1); _Pragma("unroll") for (int m = 0; m < 4; ++m) _Pragma("unroll") for (int n = 0; n < 2; ++n) _Pragma("unroll") for (int k = 0; k < 2; ++k) \
        acc[ai][bj][m][n] = __builtin_amdgcn_mfma_f32_16x16x32_bf16(Bt[n][k], At[m][k], acc[ai][bj][m][n], 0, 0, 0); __builtin_amdgcn_s_setprio(0); } while (0)
#define PG8_WAIT_V(n) asm volatile("s_waitcnt vmcnt(" #n ")" ::: "memory")
#define PG8_WAIT_L(n) asm volatile("s_waitcnt lgkmcnt(" #n ")" ::: "memory")
#define PG8_BAR __builtin_amdgcn_s_barrier()
#define PG8_SCHED __builtin_amdgcn_sched_barrier(0)
    Unit cur, nxt; int ui = 0;
    if (!S.next(0, cur)) return;
    f32x4 acc[2][2][4][2];
#pragma unroll
    for (int a = 0; a < 2; ++a)
#pragma unroll
        for (int b = 0; b < 2; ++b)
#pragma unroll
            for (int m = 0; m < 4; ++m)
#pragma unroll
                for (int n = 0; n < 2; ++n) acc[a][b][m][n] = (f32x4){0.f, 0.f, 0.f, 0.f};
    bf16x8 At[4][2], B0[2][2], B1[2][2];
    const char* cA = (const char*)g.A + (size_t)cur.pm * tstep; const char* cB = (const char*)g.Bt + (size_t)cur.pn * tstep;
    S.a_ready(cur);
    if constexpr (SP2) {
        PG8_STAGE(PG8_SB(0, 0), cB, voffB); PG8_STAGE(PG8_SB(0, 1), cB + hstep, voffB); PG8_STAGE(PG8_SA(0, 0), cA, voffA); PG8_STAGE(PG8_SA(0, 1), cA + hstep, voffA);
        if (wr == 1) PG8_BAR;
        PG8_WAIT_V(2); PG8_BAR;
        PG8_STAGE(PG8_SB(1, 0), cB + kstep, voffB); PG8_STAGE(PG8_SA(1, 0), cA + kstep, voffA); PG8_STAGE(PG8_SB(1, 1), cB + hstep + kstep, voffB);
        PG8_WAIT_V(6); PG8_BAR;
    } else {
        PG8_STAGE(PG8_SB(0, 0), cB, voffB); PG8_STAGE(PG8_SA(0, 0), cA, voffA); PG8_STAGE(PG8_SB(0, 1), cB + hstep, voffB); PG8_STAGE(PG8_SA(0, 1), cA + hstep, voffA);
        if (wr == 1) PG8_BAR;
        PG8_WAIT_V(4); PG8_BAR;
        PG8_STAGE(PG8_SB(1, 0), cB + kstep, voffB); PG8_STAGE(PG8_SA(1, 0), cA + kstep, voffA); PG8_STAGE(PG8_SB(1, 1), cB + hstep + kstep, voffB);
        PG8_WAIT_V(6); PG8_BAR;
    }
    for (;;) {
        const bool has_next = S.next(ui + 1, nxt);
        const char* nA = has_next ? (const char*)g.A + (size_t)nxt.pm * tstep : cA; const char* nB = has_next ? (const char*)g.Bt + (size_t)nxt.pn * tstep : cB;
        for (int t = 0; t < nt; t += 2) {
            const bool last = (t == nt - 2);
            const char* a1 = cA + (size_t)(t + 1) * kstep;
            const char* a2 = last ? nA : cA + (size_t)(t + 2) * kstep; const char* b2 = last ? nB : cB + (size_t)(t + 2) * kstep;
            const char* a3 = a2 + kstep; const char* b3 = b2 + kstep;
            if (last && has_next) S.a_ready(nxt);
            if constexpr (SP2) {
            PG8_LDB(B0, 0, 0); PG8_LDB(B1, 0, 1); PG8_SCHED; PG8_LDA(At, 0, 0); PG8_STAGE(PG8_SA(1, 1), a1 + hstep, voffA);
            PG8_WAIT_V(8); PG8_WAIT_L(0); PG8_BAR; PG8_MMA(0, 0, At, B0); PG8_MMA(0, 1, At, B1); PG8_BAR; PG8_SCHED;
            PG8_LDA(At, 0, 1); PG8_STAGE(PG8_SB(0, 0), b2, voffB); PG8_STAGE(PG8_SB(0, 1), b2 + hstep, voffB); PG8_STAGE(PG8_SA(0, 0), a2, voffA);
            PG8_WAIT_V(8); PG8_WAIT_L(0); PG8_BAR; PG8_MMA(1, 0, At, B0); PG8_MMA(1, 1, At, B1); PG8_BAR; PG8_SCHED;
            PG8_LDB(B0, 1, 0); PG8_LDB(B1, 1, 1); PG8_SCHED; PG8_LDA(At, 1, 0); PG8_STAGE(PG8_SA(0, 1), a2 + hstep, voffA);
            PG8_WAIT_V(8); PG8_WAIT_L(0); PG8_BAR; PG8_MMA(0, 0, At, B0); PG8_MMA(0, 1, At, B1); PG8_BAR; PG8_SCHED;
            PG8_LDA(At, 1, 1); PG8_STAGE(PG8_SB(1, 0), b3, voffB); PG8_STAGE(PG8_SB(1, 1), b3 + hstep, voffB); PG8_STAGE(PG8_SA(1, 0), a3, voffA);
            PG8_WAIT_V(8); PG8_WAIT_L(0); PG8_BAR; PG8_MMA(1, 0, At, B0); PG8_MMA(1, 1, At, B1); PG8_BAR; PG8_SCHED;
            } else {
            PG8_LDB(B0, 0, 0); PG8_SCHED; PG8_LDA(At, 0, 0); PG8_STAGE(PG8_SA(1, 1), a1 + hstep, voffA);
            PG8_WAIT_L(8); PG8_BAR; PG8_WAIT_L(0); PG8_MMA(0, 0, At, B0); PG8_BAR; PG8_SCHED;
            PG8_LDB(B1, 0, 1); PG8_STAGE(PG8_SB(0, 0), b2, voffB);
            PG8_BAR; PG8_WAIT_L(0); PG8_MMA(0, 1, At, B1); PG8_BAR;
            PG8_LDA(At, 0, 1); PG8_STAGE(PG8_SA(0, 0), a2, voffA);
            PG8_BAR; PG8_WAIT_L(0); PG8_MMA(1, 0, At, B0); PG8_BAR; PG8_SCHED;
            PG8_STAGE(PG8_SB(0, 1), b2 + hstep, voffB);
            PG8_WAIT_V(6); PG8_BAR; PG8_MMA(1, 1, At, B1); PG8_BAR;
            PG8_LDB(B0, 1, 0); PG8_SCHED; PG8_LDA(At, 1, 0); PG8_STAGE(PG8_SA(0, 1), a2 + hstep, voffA);
            PG8_WAIT_L(8); PG8_BAR; PG8_WAIT_L(0); PG8_MMA(0, 0, At, B0); PG8_BAR; PG8_SCHED;
            PG8_LDB(B1, 1, 1); PG8_STAGE(PG8_SB(1, 0), b3, voffB);
            PG8_BAR; PG8_WAIT_L(0); PG8_MMA(0, 1, At, B1); PG8_BAR;
            PG8_LDA(At, 1, 1); PG8_STAGE(PG8_SA(1, 0), a3, voffA);
            PG8_BAR; PG8_WAIT_L(0); PG8_MMA(1, 0, At, B0); PG8_BAR; PG8_SCHED;
            PG8_STAGE(PG8_SB(1, 1), b3 + hstep, voffB);
            PG8_WAIT_V(6); PG8_BAR; PG8_MMA(1, 1, At, B1); PG8_BAR;
            }
        }
        if constexpr (ALIGN_EPI) { if (wr == 0) PG8_BAR; }
        if constexpr (!Epi::AFTER_DRAIN) { E(acc, cur, wr, wc, fr, fq); S.done(cur); }
        if (!has_next) break;
#pragma unroll
        for (int a = 0; a < 2; ++a)
#pragma unroll
            for (int b = 0; b < 2; ++b)
#pragma unroll
                for (int m = 0; m < 4; ++m)
#pragma unroll
                    for (int n = 0; n < 2; ++n) acc[a][b][m][n] = (f32x4){0.f, 0.f, 0.f, 0.f};
        cur = nxt; cA = nA; cB = nB; ++ui;
        if constexpr (ALIGN_EPI) { if (wr == 1) PG8_BAR; }
    }
    PG8_WAIT_V(0);
    if constexpr (!ALIGN_EPI) { if (wr == 0) PG8_BAR; }
    PG8_BAR;
    if constexpr (Epi::AFTER_DRAIN) { E.fused(acc, cur, wr, wc, fr, fq, lds, wid, lane); S.done(cur); }
#undef PG8_SA
#undef PG8_SB
#undef PG8_STAGE
#undef PG8_LDA
#undef PG8_LDB
#undef PG8_MMA
#undef PG8_WAIT_V
#undef PG8_WAIT_L
#undef PG8_BAR
#undef PG8_SCHED
}
}
namespace att {
using bf16 = __hip_bfloat16;
constexpr int   D = 128, NW = 8, QBLK = 32, KVBLK = 64;
constexpr float SCALE = 0.088388347648318440f;
constexpr float THR = 8.f;
constexpr int SDEPTH = 2;
constexpr int LDQ = 1024, LDK = 256, LDY = 2048, LDG = NINP;
constexpr size_t SHM_V = KVBLK * D * 2, SHM_K = KVBLK * D * 2, SHM_ATTN = 2 * SHM_V + 2 * SHM_K + NW * 64 * 4;
using bf16x8 = __attribute__((ext_vector_type(8))) short;
using s16x4  = __attribute__((ext_vector_type(4))) short;
using f32x16 = __attribute__((ext_vector_type(16))) float;
using f32x8  = __attribute__((ext_vector_type(8))) float;
using u32x4  = __attribute__((ext_vector_type(4))) unsigned;
#define KSWZ(row, colB) ((row) * 256 + ((colB) ^ (((row) & 7) << 4)))
#define SBAR() __builtin_amdgcn_sched_barrier(0)
__device__ __forceinline__ int crow(int r, int hi) { return (r & 3) + 8 * (r >> 2) + 4 * hi; }
__device__ __forceinline__ unsigned cvtpk(float lo, float hi) {
  unsigned r; asm volatile("v_cvt_pk_bf16_f32 %0, %1, %2" : "=v"(r) : "v"(lo), "v"(hi)); return r;
}
template <typename TIn> struct Stage;
template <> struct Stage<bf16>  { using T = bf16x8;
  __device__ static __forceinline__ T ld8(const bf16* p) { return *reinterpret_cast<const bf16x8*>(p); }
  __device__ static __forceinline__ bf16x8 tobf(T x) { return x; } };
template <> struct Stage<float> { using T = f32x8;
  __device__ static __forceinline__ T ld8(const float* p) { return *reinterpret_cast<const f32x8*>(p); }
  __device__ static __forceinline__ bf16x8 tobf(T x) {
    u32x4 w = {cvtpk(x[0], x[1]), cvtpk(x[2], x[3]), cvtpk(x[4], x[5]), cvtpk(x[6], x[7])}; return *reinterpret_cast<bf16x8*>(&w); } };

__device__ __forceinline__ void partialSM(f32x16& p0, f32x16& p1, float& m_reg, float& mn, float& alpha) {
  constexpr float C = SCALE * 1.4426950408889634f;
  float pmax = p0[0]; for (int r = 1; r < 16; ++r) pmax = fmaxf(pmax, p0[r]); for (int r = 0; r < 16; ++r) pmax = fmaxf(pmax, p1[r]);
  { auto rr = __builtin_amdgcn_permlane32_swap(__float_as_uint(pmax), __float_as_uint(pmax), false, false);
    pmax = fmaxf(__uint_as_float(rr[0]), __uint_as_float(rr[1])); }
  if (__builtin_expect(__all(pmax - m_reg <= THR / SCALE), 1)) { mn = m_reg; alpha = 1.f; }
  else { mn = fmaxf(m_reg, pmax); alpha = __builtin_amdgcn_exp2f((m_reg - mn) * C); m_reg = mn; }
  float mnC = -mn * C;
  for (int r = 0; r < 16; ++r) p0[r] = fmaf(p0[r], C, mnC); for (int r = 0; r < 16; ++r) p1[r] = fmaf(p1[r], C, mnC);
  for (int r = 0; r < 16; ++r) p0[r] = __builtin_amdgcn_exp2f(p0[r]);
}
__device__ __forceinline__ void finishSM(f32x16& p0, f32x16& p1, float alpha, float& l_reg, bf16x8& pa0, bf16x8& pa1, bf16x8& pa2, bf16x8& pa3) {
  for (int r = 0; r < 16; ++r) p1[r] = __builtin_amdgcn_exp2f(p1[r]);
  float ps = 0; for (int r = 0; r < 16; ++r) ps += p0[r]; for (int r = 0; r < 16; ++r) ps += p1[r];
  { auto rr = __builtin_amdgcn_permlane32_swap(__float_as_uint(ps), __float_as_uint(ps), false, false);
    ps = __uint_as_float(rr[0]) + __uint_as_float(rr[1]); }
  l_reg = l_reg * alpha + ps;
#define PK4(P, BASE, OUT) do { unsigned a0 = cvtpk(P[BASE + 0], P[BASE + 1]), a1 = cvtpk(P[BASE + 2], P[BASE + 3]);   \
    unsigned b0 = cvtpk(P[BASE + 4], P[BASE + 5]), b1 = cvtpk(P[BASE + 6], P[BASE + 7]);                              \
    auto r0 = __builtin_amdgcn_permlane32_swap(a0, b0, false, false); auto r1 = __builtin_amdgcn_permlane32_swap(a1, b1, false, false); \
    u32x4 w = {r0[0], r1[0], r0[1], r1[1]}; OUT = *reinterpret_cast<bf16x8*>(&w); } while (0)
  PK4(p0, 0, pa0); PK4(p0, 8, pa1); PK4(p1, 0, pa2); PK4(p1, 8, pa3);
#undef PK4
}
__device__ __forceinline__ void qkt(f32x16& p0, f32x16& p1, const bf16* Ks, const bf16x8* qr, int r32, int hi) {
  p0 = f32x16{}; p1 = f32x16{};
  for (int d0 = 0; d0 < 8; ++d0) { int cb = (d0 * 16 + hi * 8) * 2;
    bf16x8 b0 = *reinterpret_cast<const bf16x8*>((const char*)Ks + KSWZ(r32, cb));
    bf16x8 b1 = *reinterpret_cast<const bf16x8*>((const char*)Ks + KSWZ(32 + r32, cb));
    p0 = __builtin_amdgcn_mfma_f32_32x32x16_bf16(b0, qr[d0], p0, 0, 0, 0);
    p1 = __builtin_amdgcn_mfma_f32_32x32x16_bf16(b1, qr[d0], p1, 0, 0, 0); }
}
__device__ __forceinline__ int v_st(int k, int c) { const int kk = (k & ~0xC) | ((k & 4) << 1) | ((k & 8) >> 1); return ((kk >> 3) * 4 + (c >> 5)) * 512 + ((kk & 7) * 32 + (c & 31)) * 2; }
__device__ __forceinline__ int v_rd_base(int lane) { return ((lane & 3) << 3) | (((lane >> 2) & 3) << 6) | (((lane >> 4) & 1) << 5) | (((lane >> 5) & 1) << 8); }
constexpr int v_rd_off(int d0, int ks, int half) { return d0 * 512 + ks * 4096 + half * 2048; }
template <int OFF> __device__ __forceinline__ s16x4 tr_read(int vb) {
  s16x4 r; asm volatile("ds_read_b64_tr_b16 %0, %1 offset:%2" : "=&v"(r) : "v"(vb), "i"(OFF) : "memory"); return r;
}
template <int D0> __device__ __forceinline__ void pv_one(f32x16& od, int vb, bf16x8 pa0, bf16x8 pa1, bf16x8 pa2, bf16x8 pa3) {
  const s16x4 l0 = tr_read<v_rd_off(D0, 0, 0)>(vb), h0 = tr_read<v_rd_off(D0, 0, 1)>(vb), l1 = tr_read<v_rd_off(D0, 1, 0)>(vb), h1 = tr_read<v_rd_off(D0, 1, 1)>(vb);
  const s16x4 l2 = tr_read<v_rd_off(D0, 2, 0)>(vb), h2 = tr_read<v_rd_off(D0, 2, 1)>(vb), l3 = tr_read<v_rd_off(D0, 3, 0)>(vb), h3 = tr_read<v_rd_off(D0, 3, 1)>(vb);
  asm volatile("s_waitcnt lgkmcnt(0)" ::: "memory"); SBAR();
#define PK(L, H) (bf16x8){L[0], L[1], L[2], L[3], H[0], H[1], H[2], H[3]}
  od = __builtin_amdgcn_mfma_f32_32x32x16_bf16(pa0, PK(l0, h0), od, 0, 0, 0);
  od = __builtin_amdgcn_mfma_f32_32x32x16_bf16(pa1, PK(l1, h1), od, 0, 0, 0);
  od = __builtin_amdgcn_mfma_f32_32x32x16_bf16(pa2, PK(l2, h2), od, 0, 0, 0);
  od = __builtin_amdgcn_mfma_f32_32x32x16_bf16(pa3, PK(l3, h3), od, 0, 0, 0);
#undef PK
}
__device__ __forceinline__ void pv_d0(f32x16* o, int vb, bf16x8 pa0, bf16x8 pa1, bf16x8 pa2, bf16x8 pa3) {
  pv_one<0>(o[0], vb, pa0, pa1, pa2, pa3); pv_one<1>(o[1], vb, pa0, pa1, pa2, pa3); pv_one<2>(o[2], vb, pa0, pa1, pa2, pa3); pv_one<3>(o[3], vb, pa0, pa1, pa2, pa3);
}
__device__ __forceinline__ void attn_dense_body(const bf16* __restrict__ Qb, const bf16* __restrict__ Kh, const bf16* __restrict__ Vh,
                                                unsigned short* __restrict__ Yb, const unsigned short* __restrict__ Gb, int seq, char* lds) {
  using St = Stage<bf16>; using SQ = Stage<bf16>; using TQ = bf16;
  const int tid = threadIdx.x, wid = tid >> 6, lane = tid & 63, r32 = lane & 31, hi = lane >> 5;
  bf16* V_lds = (bf16*)lds; bf16* K_lds = (bf16*)(lds + 2 * SHM_V);
  float* ws = (float*)(lds + 2 * SHM_V + 2 * SHM_K) + wid * 64; float* li_l = ws; float* al_l = ws + 32;
  float m_reg = -1e30f, l_reg = 0; f32x16 o[4] = {}; bf16x8 qr[8];
  const TQ* Qw = Qb + (long)(wid * QBLK + r32) * LDQ + hi * 8;
#pragma unroll
  for (int d0 = 0; d0 < 8; ++d0) qr[d0] = SQ::tobf(SQ::ld8(Qw + d0 * 16));
  const int sr = tid >> 4, sc = (tid & 15) * 8, vst0 = v_st(sr, sc), vst1 = v_st(32 + sr, sc);
  const int vb0 = (int)(uintptr_t)V_lds + v_rd_base(lane);
  struct { typename St::T vs0, vs1, ks0, ks1; } sr_[SDEPTH];
#define SLOAD(i, k0) do { sr_[i].vs0 = St::ld8(&Vh[(long)((k0) + sr) * LDK + sc]); sr_[i].vs1 = St::ld8(&Vh[(long)((k0) + 32 + sr) * LDK + sc]); \
    sr_[i].ks0 = St::ld8(&Kh[(long)((k0) + sr) * LDK + sc]); sr_[i].ks1 = St::ld8(&Kh[(long)((k0) + 32 + sr) * LDK + sc]); } while (0)
#define SWRITE(b, i) do { *(bf16x8*)((char*)V_lds + (b) * SHM_V + vst0) = St::tobf(sr_[i].vs0);          \
    *(bf16x8*)((char*)V_lds + (b) * SHM_V + vst1) = St::tobf(sr_[i].vs1); int kc = sc * 2;               \
    *(bf16x8*)((char*)K_lds + (b) * SHM_K + KSWZ(sr, kc)) = St::tobf(sr_[i].ks0);                       \
    *(bf16x8*)((char*)K_lds + (b) * SHM_K + KSWZ(32 + sr, kc)) = St::tobf(sr_[i].ks1); } while (0)
#define SWAIT() do { if constexpr (SDEPTH == 2) asm volatile("s_waitcnt vmcnt(4)" ::: "memory"); else asm volatile("s_waitcnt vmcnt(0)" ::: "memory"); } while (0)
#define RESC(a) do { if (__any((a) < 1.f)) { if (hi == 0) al_l[r32] = (a); asm volatile("s_waitcnt lgkmcnt(0)" ::: "memory"); \
    for (int d = 0; d < 4; ++d) for (int r = 0; r < 16; ++r) o[d][r] *= al_l[crow(r, hi)]; } } while (0)
  f32x16 pA0, pA1, pB0, pB1; float mnA, mnB, alA, alB; bf16x8 pa0, pa1, pa2, pa3; const int NT = seq / KVBLK;
  constexpr int SE = 0, SO = SDEPTH - 1;
  SLOAD(SE, 0); asm volatile("s_waitcnt vmcnt(0)" ::: "memory"); SWRITE(0, SE); __syncthreads();
  qkt(pA0, pA1, K_lds, qr, r32, hi); partialSM(pA0, pA1, m_reg, mnA, alA);
  SLOAD(SO, KVBLK); if constexpr (SDEPTH == 2) { if (2 < NT) SLOAD(SE, 2 * KVBLK); }
  SWAIT(); SWRITE(1, SO); __syncthreads();
  for (int j = 1; j + 1 < NT; j += 2) {
    SBAR(); qkt(pB0, pB1, (bf16*)((char*)K_lds + SHM_K), qr, r32, hi);
    finishSM(pA0, pA1, alA, l_reg, pa0, pa1, pa2, pa3); SBAR();
    SLOAD(SO, (j + SDEPTH) * KVBLK); SBAR();
    pv_d0(o, vb0, pa0, pa1, pa2, pa3); partialSM(pB0, pB1, m_reg, mnB, alB);
    __syncthreads(); SWAIT(); SWRITE(0, SE);
    RESC(alB); __syncthreads();
    SBAR(); qkt(pA0, pA1, K_lds, qr, r32, hi);
    finishSM(pB0, pB1, alB, l_reg, pa0, pa1, pa2, pa3); SBAR();
    if (SDEPTH == 1 || j + 3 < NT) SLOAD(SE, (j + 1 + SDEPTH) * KVBLK); SBAR();
    pv_d0(o, vb0 + (int)SHM_V, pa0, pa1, pa2, pa3); partialSM(pA0, pA1, m_reg, mnA, alA);
    __syncthreads(); SWAIT(); SWRITE(1, SO);
    RESC(alA); __syncthreads();
  }
  SBAR(); qkt(pB0, pB1, (bf16*)((char*)K_lds + SHM_K), qr, r32, hi);
  finishSM(pA0, pA1, alA, l_reg, pa0, pa1, pa2, pa3); SBAR();
  pv_d0(o, vb0, pa0, pa1, pa2, pa3); partialSM(pB0, pB1, m_reg, mnB, alB);
  __syncthreads(); RESC(alB);
  finishSM(pB0, pB1, alB, l_reg, pa0, pa1, pa2, pa3); SBAR();
  pv_d0(o, vb0 + (int)SHM_V, pa0, pa1, pa2, pa3);
  if (hi == 0) li_l[r32] = l_reg; asm volatile("s_waitcnt lgkmcnt(0)" ::: "memory");
  float rli[16];
#pragma unroll
  for (int r = 0; r < 16; ++r) rli[r] = __builtin_amdgcn_rcpf(li_l[crow(r, hi)]);
  int eoff = (wid * QBLK + 4 * hi) ; asm volatile("" : "+v"(eoff));
  const unsigned short* Gw = Gb + (long)eoff * LDG + r32; unsigned short* Yw = Yb + (long)eoff * LDY + r32;
#pragma unroll
  for (int r = 0; r < 16; ++r) { const int orow = (r & 3) + 8 * (r >> 2);
#pragma unroll
    for (int d0 = 0; d0 < 4; ++d0) { const float g = __uint_as_float(((unsigned)Gw[orow * LDG + d0 * 32]) << 16);
      const float val = o[d0][r] * rli[r] * (g / (1.f + __expf(-g)));
      unsigned ub = __float_as_uint(val); ub = (ub + 0x7fffu + ((ub >> 16) & 1u)) >> 16;
      Yw[orow * LDY + d0 * 32] = (unsigned short)ub; } }
#undef SLOAD
#undef SWRITE
#undef SWAIT
#undef RESC
}
}
#define GAS __attribute__((address_space(1)))
#define LAS __attribute__((address_space(3)))
typedef unsigned short bf16_t;
typedef unsigned v4u __attribute__((ext_vector_type(4)));
typedef unsigned v2u __attribute__((ext_vector_type(2)));
typedef float f32x4 __attribute__((ext_vector_type(4)));
typedef short bf16x8_t __attribute__((ext_vector_type(8)));
typedef float f32x16_t __attribute__((ext_vector_type(16)));
#define LDS_WAIT() asm volatile("s_waitcnt lgkmcnt(0)" ::: "memory")

constexpr size_t MiB = 1u << 20;
constexpr size_t WS_CTL = 0, CTL_ZERO_BYTES = 1 * MiB;
constexpr size_t WS_MOD = 64 * 1024;
constexpr size_t WS_ROPE = 1 * MiB;
constexpr size_t WS_SMALL = 2 * MiB;
constexpr size_t WS_WIN0 = 3 * MiB, WS_WOUT0 = 24 * MiB;
constexpr size_t WS_QB = 32 * MiB, WS_KB = 48 * MiB, WS_VB = 52 * MiB;
constexpr size_t WS_HB = 3 * MiB;
constexpr size_t WS_WIN1 = 56 * MiB, WS_WOUT1 = 77 * MiB;
constexpr size_t WS_H = 85 * MiB;
constexpr size_t WS_HF = 85 * MiB;
constexpr size_t WS_PROJ = 117 * MiB;
constexpr size_t WS_YCAT = 201 * MiB;
constexpr size_t WS_ACT = 233 * MiB;
constexpr size_t WS_YF = 297 * MiB, WS_YB = 329 * MiB;
constexpr size_t WS_XBC16 = 85 * MiB;
constexpr size_t WS_QKV16 = 3 * MiB;
constexpr size_t WS_GT = 85 * MiB, WS_GA = 101 * MiB;
constexpr size_t WS_WGT = 361 * MiB;
constexpr size_t WS_LSUM = 362 * MiB;
constexpr size_t WS_END = 366 * MiB;

constexpr int NWAVES = 8, NTHREADS = 512;
constexpr int LDS_BYTES = 147456;
constexpr int NPHASE = 15;

struct Args { const float* in[39]; float* out; unsigned char* ws; int ph_lo, ph_hi; };

__device__ __forceinline__ float bf2f(unsigned v) { return __uint_as_float(v << 16); }
__device__ __forceinline__ unsigned f2bf(float f) { unsigned u = __float_as_uint(f); return (u + 0x7fffu + ((u >> 16) & 1u)) >> 16; }
__device__ __forceinline__ unsigned pk2(float lo, float hi) { return f2bf(lo) | (f2bf(hi) << 16); }
__device__ __forceinline__ void unpack8(const v4u w, float* x) {
    x[0] = __uint_as_float(w.x << 16); x[1] = __uint_as_float(w.x & 0xffff0000u); x[2] = __uint_as_float(w.y << 16); x[3] = __uint_as_float(w.y & 0xffff0000u);
    x[4] = __uint_as_float(w.z << 16); x[5] = __uint_as_float(w.z & 0xffff0000u); x[6] = __uint_as_float(w.w << 16); x[7] = __uint_as_float(w.w & 0xffff0000u);
}
__device__ __forceinline__ v4u pack8(const float* x) { v4u w; w.x = pk2(x[0], x[1]); w.y = pk2(x[2], x[3]); w.z = pk2(x[4], x[5]); w.w = pk2(x[6], x[7]); return w; }
__device__ __forceinline__ float silu_f(float x) { return x / (1.f + expf(-x)); }
__device__ __forceinline__ float sigmoid_f(float x) { return 1.f / (1.f + expf(-x)); }
__device__ __forceinline__ float softplus_f(float x) { return fmaxf(x, 0.f) + log1pf(expf(-fabsf(x))); }
template <int CTRL> __device__ __forceinline__ float dpp_mov(float v) { return __builtin_bit_cast(float, __builtin_amdgcn_update_dpp(0, __builtin_bit_cast(int, v), CTRL, 0xF, 0xF, true)); }
template <int N> __device__ __forceinline__ float group_sum(float v) {
    if (N >= 2) v += dpp_mov<0xB1>(v);
    if (N >= 4) v += dpp_mov<0x4E>(v);
    if (N >= 8) v += dpp_mov<0x141>(v);
    if (N >= 16) v += dpp_mov<0x140>(v);
    if (N >= 32) v += __shfl_xor(v, 16);
    if (N >= 64) v += __shfl_xor(v, 32);
    return v;
}

__device__ __forceinline__ void p0_transpose_item(const float* W, int K, int N, bf16_t* WT, int row_off, LAS float* scr, int item, int lane) {
    const int nblk = N / 32, kb = item / nblk, nb = item % nblk, k0 = 64 * kb, n0 = 32 * nb;
#pragma unroll 8
    for (int i = 0; i < 32; ++i) { const int kk = 2 * i + (lane >> 5); scr[kk * 33 + (lane & 31)] = W[(size_t)(k0 + kk) * N + n0 + (lane & 31)]; }
    LDS_WAIT(); asm volatile("" ::: "memory");
    const int c = lane & 7;
#pragma unroll
    for (int j = 0; j < 4; ++j) { const int n = (lane >> 3) + 8 * j; const LAS float* s = scr + (8 * c) * 33 + n;
        v4u o; o.x = pk2(s[0 * 33], s[1 * 33]); o.y = pk2(s[2 * 33], s[3 * 33]); o.z = pk2(s[4 * 33], s[5 * 33]); o.w = pk2(s[6 * 33], s[7 * 33]);
        *(v4u*)(WT + (size_t)(row_off + n0 + n) * K + k0 + 8 * c) = o; }
    LDS_WAIT(); asm volatile("" ::: "memory");
}

__device__ __forceinline__ void p0_prologue(const Args& a, LAS unsigned char* lds, int vcu, int G) {
    const int tid = threadIdx.x, lane = tid & 63, wave = tid >> 6;
    unsigned char* ws = a.ws;
    { const int gid = blockIdx.x * NTHREADS + tid;
      if (gid < 2048) { const int pos = gid >> 5, i = gid & 31; const float freq = expf(-(float)i * (1.f / 32.f) * 9.210340371976184f); const float ang = (float)pos * freq;
          float* rt = (float*)(ws + WS_ROPE); rt[2 * gid] = cosf(ang); rt[2 * gid + 1] = sinf(ang); } }
    { const int gid = blockIdx.x * NTHREADS + tid, gn = G * NTHREADS; constexpr int NV = (NINP - NIN) * 2048 * 2 / 16;
      v4u* p0 = (v4u*)(ws + WS_WIN0 + (size_t)NIN * 2048 * 2); v4u* p1 = (v4u*)(ws + WS_WIN1 + (size_t)NIN * 2048 * 2);
      for (int i = gid; i < NV; i += gn) { p0[i] = (v4u){0, 0, 0, 0}; p1[i] = (v4u){0, 0, 0, 0}; } }
    if (blockIdx.x < 192) {
        const int it = blockIdx.x, l = it / 96, r = it % 96, kc = r / 3, nc = r % 3;
        LAS float* cond = (LAS float*)lds;
        if (tid < 256) { const int b = tid >> 6, k = tid & 63; const float c = a.in[1][b * 2048 + kc * 64 + k]; cond[tid] = silu_f(c); }
        __syncthreads();
        const float* W = a.in[2] + (size_t)l * 2048 * 6144 + (size_t)(kc * 64) * 6144 + nc * 2048 + tid * 4;
        f32x4 acc0 = {0, 0, 0, 0}, acc1 = acc0, acc2 = acc0, acc3 = acc0;
#pragma unroll 8
        for (int k = 0; k < 64; ++k) { const f32x4 w = *(const f32x4*)(W + (size_t)k * 6144);
            acc0 += cond[k] * w; acc1 += cond[64 + k] * w; acc2 += cond[128 + k] * w; acc3 += cond[192 + k] * w; }
        float* macc = (float*)(ws + WS_MOD) + (size_t)l * 4 * 6144 + nc * 2048 + tid * 4;
#pragma unroll
        for (int i = 0; i < 4; ++i) { atomicAdd(macc + i, acc0[i]); atomicAdd(macc + 6144 + i, acc1[i]); atomicAdd(macc + 2 * 6144 + i, acc2[i]); atomicAdd(macc + 3 * 6144 + i, acc3[i]); }
        __syncthreads();
    }
    { LAS float* scr = (LAS float*)(lds + wave * 16384);
      const int gw = vcu * NWAVES + wave, NGW = G * NWAVES;
      constexpr int I_IN = 32 * (NIN / 32), I_OUT = 32 * 64, I_G = 32 * 8, NITEMS = 2 * (I_IN + I_OUT) + I_G;
      for (int it = gw; it < NITEMS; it += NGW) {
          int r = it;
          if (r < I_G) { const int mn = r >> 3, m = mn >> 3; const float* Wg = a.in[m == 0 ? 27 : m == 1 ? 29 : m == 2 ? 32 : 34] + (size_t)(mn & 7) * 128 * 128;
              p0_transpose_item(Wg, 128, 128, (bf16_t*)(ws + WS_WGT) + (size_t)mn * 128 * 128, 0, scr, r & 7, lane); continue; } r -= I_G;
          if (r < I_IN) { p0_transpose_item(a.in[5], 2048, NIN, (bf16_t*)(ws + WS_WIN0), 0, scr, r, lane); continue; } r -= I_IN;
          if (r < I_IN) { p0_transpose_item(a.in[17], 2048, NIN, (bf16_t*)(ws + WS_WIN1), 0, scr, r, lane); continue; } r -= I_IN;
          if (r < I_OUT) { p0_transpose_item(a.in[16], 2048, 2048, (bf16_t*)(ws + WS_WOUT0), 0, scr, r, lane); continue; } r -= I_OUT;
          p0_transpose_item(a.in[37], 2048, 2048, (bf16_t*)(ws + WS_WOUT1), 0, scr, r, lane);
      } }
}

__device__ __forceinline__ void normmod_phase(const Args& a, const float* xin, int layer, int gw, int NGW, int lane) {
    const float* nw = a.in[4] + layer * 2048; const float* bm = a.in[3] + layer * 6144;
    const float* macc = (const float*)(a.ws + WS_MOD) + (size_t)layer * 4 * 6144;
    bf16_t* H = (bf16_t*)(a.ws + WS_H);
    for (int m = gw; m < MTOK; m += NGW) {
        const int b = m >> 11;
        const f32x4* xr = (const f32x4*)(xin + (size_t)m * 2048) + lane;
        f32x4 v[8]; float s = 0.f;
#pragma unroll
        for (int j = 0; j < 8; ++j) { v[j] = xr[64 * j]; s += (v[j].x * v[j].x + v[j].y * v[j].y) + (v[j].z * v[j].z + v[j].w * v[j].w); }
        const float rstd = rsqrtf(group_sum<64>(s) * (1.f / 2048.f) + EPS);
#pragma unroll
        for (int j = 0; j < 8; ++j) { const int col = (64 * j + lane) * 4;
            const f32x4 w = *(const f32x4*)(nw + col);
            const f32x4 sh = *(const f32x4*)(macc + b * 6144 + col) + *(const f32x4*)(bm + col);
            const f32x4 sc = *(const f32x4*)(macc + b * 6144 + 2048 + col) + *(const f32x4*)(bm + 2048 + col);
            const f32x4 o = v[j] * rstd * w * (1.f + sc) + sh;
            v2u pk; pk.x = pk2(o.x, o.y); pk.y = pk2(o.z, o.w);
            *(v2u*)(H + (size_t)m * 2048 + col) = pk; }
    }
}

__device__ __forceinline__ void post0_phase(const Args& a, int gw, int NGW, int lane) {
    const bf16_t* P = (const bf16_t*)(a.ws + WS_PROJ);
    const float2* rope = (const float2*)(a.ws + WS_ROPE);
    const float* qn = a.in[6]; const float* kn = a.in[7]; const float* cw = a.in[8]; const float* cb = a.in[9];
    bf16_t* Q = (bf16_t*)(a.ws + WS_QB); bf16_t* K = (bf16_t*)(a.ws + WS_KB); bf16_t* V = (bf16_t*)(a.ws + WS_VB);
    float* ACT = (float*)(a.ws + WS_ACT);
    for (int m = gw; m < MTOK; m += NGW) {
        const int t = m & 2047, prow = t >> 6, pcol = t & 63;
        const bf16_t* pr = P + (size_t)m * NINP;
        {
            float x[16]; unpack8(*(const v4u*)(pr + A_Q + lane * 16), x); unpack8(*(const v4u*)(pr + A_Q + lane * 16 + 8), x + 8);
            float ss = 0.f;
#pragma unroll
            for (int i = 0; i < 16; ++i) ss += x[i] * x[i];
            ss = group_sum<8>(ss);
            const float r = rsqrtf(ss * (1.f / 128.f) + EPS);
            const int d0 = (lane & 7) * 16;
#pragma unroll
            for (int i = 0; i < 16; ++i) x[i] = x[i] * r * qn[d0 + i];
#pragma unroll
            for (int pi = 0; pi < 8; ++pi) { const int p = (d0 >> 1) + pi; const float2 cs = (p < 32) ? rope[prow * 32 + p] : rope[pcol * 32 + p - 32];
                const float x0 = x[2 * pi], x1 = x[2 * pi + 1]; x[2 * pi] = x0 * cs.x - x1 * cs.y; x[2 * pi + 1] = x0 * cs.y + x1 * cs.x; }
            *(v4u*)(Q + (size_t)m * 1024 + lane * 16) = pack8(x); *(v4u*)(Q + (size_t)m * 1024 + lane * 16 + 8) = pack8(x + 8);
        }
        {
            const v2u w = *(const v2u*)(pr + A_K + lane * 4);
            float x[4] = {__uint_as_float(w.x << 16), __uint_as_float(w.x & 0xffff0000u), __uint_as_float(w.y << 16), __uint_as_float(w.y & 0xffff0000u)};
            float ss = (x[0] * x[0] + x[1] * x[1]) + (x[2] * x[2] + x[3] * x[3]);
            ss = group_sum<32>(ss);
            const float r = rsqrtf(ss * (1.f / 128.f) + EPS);
            const int d0 = (lane & 31) * 4;
#pragma unroll
            for (int i = 0; i < 4; ++i) x[i] = x[i] * r * kn[d0 + i];
#pragma unroll
            for (int pi = 0; pi < 2; ++pi) { const int p = (d0 >> 1) + pi; const float2 cs = (p < 32) ? rope[prow * 32 + p] : rope[pcol * 32 + p - 32];
                const float x0 = x[2 * pi], x1 = x[2 * pi + 1]; x[2 * pi] = x0 * cs.x - x1 * cs.y; x[2 * pi + 1] = x0 * cs.y + x1 * cs.x; }
            v2u o; o.x = pk2(x[0], x[1]); o.y = pk2(x[2], x[3]);
            *(v2u*)(K + (size_t)m * 256 + lane * 4) = o;
            *(v2u*)(V + (size_t)m * 256 + lane * 4) = *(const v2u*)(pr + A_V + lane * 4);
        }
#pragma unroll
        for (int j = 0; j < 3; ++j) { const int ch = (j * 64 + lane) * 8;
            float acc[8];
            { const f32x4 b0 = *(const f32x4*)(cb + ch), b1 = *(const f32x4*)(cb + ch + 4); acc[0] = b0.x; acc[1] = b0.y; acc[2] = b0.z; acc[3] = b0.w; acc[4] = b1.x; acc[5] = b1.y; acc[6] = b1.z; acc[7] = b1.w; }
#pragma unroll
            for (int d = 0; d < 4; ++d) { const int ts = t + d - 2;
                if (ts >= 0 && ts < SEQ) { float x[8]; unpack8(*(const v4u*)(P + (size_t)(m + d - 2) * NINP + A_XS + ch), x);
                    const f32x4 w0 = *(const f32x4*)(cw + d * 1536 + ch), w1 = *(const f32x4*)(cw + d * 1536 + ch + 4);
                    acc[0] += w0.x * x[0]; acc[1] += w0.y * x[1]; acc[2] += w0.z * x[2]; acc[3] += w0.w * x[3];
                    acc[4] += w1.x * x[4]; acc[5] += w1.y * x[5]; acc[6] += w1.z * x[6]; acc[7] += w1.w * x[7]; } }
            f32x4 o0, o1; o0.x = silu_f(acc[0]); o0.y = silu_f(acc[1]); o0.z = silu_f(acc[2]); o0.w = silu_f(acc[3]); o1.x = silu_f(acc[4]); o1.y = silu_f(acc[5]); o1.z = silu_f(acc[6]); o1.w = silu_f(acc[7]);
            *(f32x4*)(ACT + (size_t)m * 1536 + ch) = o0; *(f32x4*)(ACT + (size_t)m * 1536 + ch + 4) = o1;
            { v4u w; w.x = pk2(o0.x, o0.y); w.y = pk2(o0.z, o0.w); w.z = pk2(o1.x, o1.y); w.w = pk2(o1.z, o1.w); *(v4u*)((bf16_t*)(a.ws + WS_XBC16) + (size_t)m * 1536 + ch) = w; } }
    }
}

typedef float f32x2 __attribute__((ext_vector_type(2)));
__device__ __forceinline__ void ssd_item(const Args& a, int item, float* lds) {
    const int ph = item & 1, h = (item >> 1) & 15, dir = (item >> 5) & 1, b = item >> 6, g = h >> 3;
    constexpr int BUF = 32 * 32 + 2 * 32 * 128 + 32;
    float* ysb = lds + 2 * BUF;
    const float A = -expf(a.in[dir ? 13 : 12][h]); const float dtb = a.in[dir ? 11 : 10][h];
    const float* ACT = (const float*)(a.ws + WS_ACT); const float* SM = (const float*)(a.ws + WS_SMALL);
    float* Y = (float*)(a.ws + (dir ? WS_YB : WS_YF));
    const int tid = threadIdx.x, p = tid >> 4, ng = tid & 15;
    f32x2 hst[4];
#pragma unroll
    for (int i = 0; i < 4; ++i) hst[i] = (f32x2){0.f, 0.f};
    f32x4 gB[2], gC[2], gx; float gdt;
#define SSD_LOAD(tile_) do { const size_t r0_ = (size_t)b * SEQ + (dir ? 63 - (tile_) : (tile_)) * 32; \
        _Pragma("unroll") for (int i = 0; i < 2; ++i) { const int idx = tid + i * 512, s_ = idx >> 5, c4_ = idx & 31, tl_ = dir ? 31 - s_ : s_; \
            gB[i] = *(const f32x4*)(ACT + (r0_ + tl_) * 1536 + 1024 + g * 128 + c4_ * 4); gC[i] = *(const f32x4*)(ACT + (r0_ + tl_) * 1536 + 1280 + g * 128 + c4_ * 4); } \
        if (tid < 256) { const int s_ = tid >> 3, c4_ = tid & 7, tl_ = dir ? 31 - s_ : s_; gx = *(const f32x4*)(ACT + (r0_ + tl_) * 1536 + h * 64 + ph * 32 + c4_ * 4); gdt = SM[(r0_ + tl_) * 32 + dir * 16 + h]; } } while (0)
#define SSD_STORE(buf_) do { float* xs_ = lds + (buf_) * BUF; float* Bs_ = xs_ + 32 * 32; float* Cs_ = Bs_ + 32 * 128; float* das_ = Cs_ + 32 * 128; \
        _Pragma("unroll") for (int i = 0; i < 2; ++i) { const int idx = tid + i * 512, s_ = idx >> 5, c4_ = idx & 31; const int so_ = s_ * 128 + (c4_ & 1) * 64 + (c4_ >> 1) * 4; \
            *(f32x4*)(Bs_ + so_) = gB[i]; *(f32x4*)(Cs_ + so_) = gC[i]; } \
        if (tid < 256) { const int s_ = tid >> 3, c4_ = tid & 7; const float dt_ = softplus_f(gdt + dtb); *(f32x4*)(xs_ + s_ * 32 + c4_ * 4) = gx * dt_; if (c4_ == 0) das_[s_] = expf(dt_ * A); } } while (0)
    __syncthreads();
    SSD_LOAD(0); SSD_STORE(0);
    __syncthreads();
    for (int tile = 0; tile < 64; ++tile) {
        const int cur = tile & 1;
        const size_t row0 = (size_t)b * SEQ + (dir ? 63 - tile : tile) * 32;
        if (tile + 1 < 64) SSD_LOAD(tile + 1);
        const float* xs = lds + cur * BUF; const float* Bs = xs + 32 * 32; const float* Cs = Bs + 32 * 128; const float* das = Cs + 32 * 128; float* ys = ysb + cur * 1024;
        {
            float n_dA = das[0], n_xdt = xs[p];
            f32x4 n_b0 = *(const f32x4*)(Bs + ng * 4), n_b1 = *(const f32x4*)(Bs + 64 + ng * 4), n_c0 = *(const f32x4*)(Cs + ng * 4), n_c1 = *(const f32x4*)(Cs + 64 + ng * 4);
#pragma unroll 4
            for (int s = 0; s < 32; ++s) {
                const float dA = n_dA, xdt = n_xdt; const f32x4 b0 = n_b0, b1 = n_b1, c0 = n_c0, c1 = n_c1;
                const int sn = (s + 1) & 31;
                n_dA = das[sn]; n_xdt = xs[sn * 32 + p];
                n_b0 = *(const f32x4*)(Bs + sn * 128 + ng * 4); n_b1 = *(const f32x4*)(Bs + sn * 128 + 64 + ng * 4);
                n_c0 = *(const f32x4*)(Cs + sn * 128 + ng * 4); n_c1 = *(const f32x4*)(Cs + sn * 128 + 64 + ng * 4);
                const f32x2 xd2 = (f32x2){xdt, xdt}, da2 = (f32x2){dA, dA};
                hst[0] = hst[0] * da2 + xd2 * (f32x2){b0.x, b0.y};
                hst[1] = hst[1] * da2 + xd2 * (f32x2){b0.z, b0.w};
                hst[2] = hst[2] * da2 + xd2 * (f32x2){b1.x, b1.y};
                hst[3] = hst[3] * da2 + xd2 * (f32x2){b1.z, b1.w};
                f32x2 acc = hst[0] * (f32x2){c0.x, c0.y};
                acc += hst[1] * (f32x2){c0.z, c0.w};
                acc += hst[2] * (f32x2){c1.x, c1.y};
                acc += hst[3] * (f32x2){c1.z, c1.w};
                const float part = group_sum<16>(acc.x + acc.y);
                if (ng == 0) ys[s * 32 + p] = part;
            }
        }
        if (tile + 1 < 64) SSD_STORE(cur ^ 1);
        __syncthreads();
        if (tid < 256) { const int s = tid >> 3, c4 = tid & 7, tl = dir ? 31 - s : s; *(f32x4*)(Y + (row0 + tl) * 1024 + h * 64 + ph * 32 + c4 * 4) = *(const f32x4*)(ys + s * 32 + c4 * 4); }
    }
#undef SSD_LOAD
#undef SSD_STORE
}

__device__ __forceinline__ void ssd_combine_phase(const Args& a, int gw, int NGW, int lane) {
    const float* YF = (const float*)(a.ws + WS_YF); const float* YB = (const float*)(a.ws + WS_YB); const float* ACT = (const float*)(a.ws + WS_ACT);
    const bf16_t* P = (const bf16_t*)(a.ws + WS_PROJ); bf16_t* YC = (bf16_t*)(a.ws + WS_YCAT);
    const float* dsk = a.in[14]; const float* nw = a.in[15];
    for (int m = gw; m < MTOK; m += NGW) {
        const int ch = lane * 16; const float dk = dsk[ch >> 6];
        float z[16], gv[16]; unpack8(*(const v4u*)(P + (size_t)m * NINP + A_Z + ch), z); unpack8(*(const v4u*)(P + (size_t)m * NINP + A_Z + ch + 8), z + 8);
        float ss = 0.f;
#pragma unroll
        for (int q = 0; q < 4; ++q) { const f32x4 f = *(const f32x4*)(YF + (size_t)m * 1024 + ch + 4 * q), bk = *(const f32x4*)(YB + (size_t)m * 1024 + ch + 4 * q), xv = *(const f32x4*)(ACT + (size_t)m * 1536 + ch + 4 * q);
            const f32x4 y = f + bk + dk * xv;
            gv[4 * q] = y.x * silu_f(z[4 * q]); gv[4 * q + 1] = y.y * silu_f(z[4 * q + 1]); gv[4 * q + 2] = y.z * silu_f(z[4 * q + 2]); gv[4 * q + 3] = y.w * silu_f(z[4 * q + 3]); }
#pragma unroll
        for (int i = 0; i < 16; ++i) ss += gv[i] * gv[i];
        const float r = rsqrtf(group_sum<64>(ss) * (1.f / 1024.f) + EPS);
#pragma unroll
        for (int i = 0; i < 16; ++i) gv[i] = gv[i] * r * nw[ch + i];
        *(v4u*)(YC + (size_t)m * 2048 + 1024 + ch) = pack8(gv); *(v4u*)(YC + (size_t)m * 2048 + 1024 + ch + 8) = pack8(gv + 8);
    }
}

__device__ __forceinline__ void post1_phase(const Args& a, int gw, int NGW, int lane) {
    const bf16_t* P = (const bf16_t*)(a.ws + WS_PROJ); const float* cw = a.in[18]; const float* cb = a.in[19];
    float* ACT = (float*)(a.ws + WS_ACT);
    for (int m = gw; m < MTOK; m += NGW) {
        const int t = m & 2047;
#pragma unroll
        for (int j = 0; j < 4; ++j) { const int ch = (j * 64 + lane) * 8;
            float acc[8];
            { const f32x4 b0 = *(const f32x4*)(cb + ch), b1 = *(const f32x4*)(cb + ch + 4); acc[0] = b0.x; acc[1] = b0.y; acc[2] = b0.z; acc[3] = b0.w; acc[4] = b1.x; acc[5] = b1.y; acc[6] = b1.z; acc[7] = b1.w; }
#pragma unroll
            for (int d = 0; d < 4; ++d) { const int ts = t + d - 2;
                if (ts >= 0 && ts < SEQ) { float x[8]; unpack8(*(const v4u*)(P + (size_t)(m + d - 2) * NINP + C_Q + ch), x);
                    const f32x4 w0 = *(const f32x4*)(cw + d * 2048 + ch), w1 = *(const f32x4*)(cw + d * 2048 + ch + 4);
                    acc[0] += w0.x * x[0]; acc[1] += w0.y * x[1]; acc[2] += w0.z * x[2]; acc[3] += w0.w * x[3];
                    acc[4] += w1.x * x[4]; acc[5] += w1.y * x[5]; acc[6] += w1.z * x[6]; acc[7] += w1.w * x[7]; } }
#pragma unroll
            for (int i = 0; i < 8; ++i) acc[i] = silu_f(acc[i]);
            if (j < 2) {
                float ss = 0.f;
#pragma unroll
                for (int i = 0; i < 8; ++i) ss += acc[i] * acc[i];
                ss = group_sum<16>(ss);
                float r = rsqrtf(ss + EPS); if (j == 0) r *= 0.088388347648318440f;
#pragma unroll
                for (int i = 0; i < 8; ++i) acc[i] *= r;
            }
            *(f32x4*)(ACT + (size_t)m * 2048 + ch) = (f32x4){acc[0], acc[1], acc[2], acc[3]}; *(f32x4*)(ACT + (size_t)m * 2048 + ch + 4) = (f32x4){acc[4], acc[5], acc[6], acc[7]};
            *(v4u*)((bf16_t*)(a.ws + WS_QKV16) + (size_t)m * 2048 + ch) = pack8(acc); }
    }
}

__device__ __forceinline__ void gdn_item(const Args& a, int item, float* lds) {
    const int dvs = item & 3, hv = (item >> 2) & 7, dir = (item >> 5) & 1, b = item >> 6, hq = hv >> 1;
    constexpr int BUF = 2 * 32 * 128 + 32 * 32 + 32 * 4;
    float* osb = lds + 2 * BUF;
    const float Aneg = -expf(a.in[dir ? 21 : 20][hv]); const float dtb = a.in[dir ? 23 : 22][hv];
    const float* ACT = (const float*)(a.ws + WS_ACT); const float* SM = (const float*)(a.ws + WS_SMALL);
    float* O = (float*)(a.ws + (dir ? WS_YB : WS_YF));
    const int tid = threadIdx.x, lane = tid & 63, wave = tid >> 6, dkg = lane & 15, dvi = wave * 4 + (lane >> 4);
    f32x2 S[4];
#pragma unroll
    for (int i = 0; i < 4; ++i) S[i] = (f32x2){0.f, 0.f};
    f32x4 gk0, gk1, gq0, gq1, gv; float gbr = 0.f, gar = 0.f;
#define GDN_LOAD(tile_) do { const size_t r0_ = (size_t)b * SEQ + (dir ? 63 - (tile_) : (tile_)) * 32; \
        { const int s_ = tid >> 4, c8_ = tid & 15, tl_ = dir ? 31 - s_ : s_; const float* kp_ = ACT + (r0_ + tl_) * 2048 + 512 + hq * 128 + c8_ * 8; const float* qp_ = ACT + (r0_ + tl_) * 2048 + hq * 128 + c8_ * 8; \
          gk0 = *(const f32x4*)kp_; gk1 = *(const f32x4*)(kp_ + 4); gq0 = *(const f32x4*)qp_; gq1 = *(const f32x4*)(qp_ + 4); \
          if (c8_ == 0) { const float* sm_ = SM + (r0_ + tl_) * 32; gbr = sm_[dir * 8 + hv]; gar = sm_[16 + dir * 8 + hv]; } } \
        if (tid < 256) { const int s2_ = tid >> 3, c4_ = tid & 7, tl2_ = dir ? 31 - s2_ : s2_; gv = *(const f32x4*)(ACT + (r0_ + tl2_) * 2048 + 1024 + hv * 128 + dvs * 32 + c4_ * 4); } } while (0)
#define GDN_STORE(buf_) do { float* ks_ = lds + (buf_) * BUF; float* qs_ = ks_ + 32 * 128; float* vs_ = qs_ + 32 * 128; float* sc_ = vs_ + 32 * 32; \
        { const int s_ = tid >> 4, c8_ = tid & 15; \
          *(f32x4*)(ks_ + s_ * 128 + c8_ * 4) = gk0; *(f32x4*)(ks_ + s_ * 128 + 64 + c8_ * 4) = gk1; *(f32x4*)(qs_ + s_ * 128 + c8_ * 4) = gq0; *(f32x4*)(qs_ + s_ * 128 + 64 + c8_ * 4) = gq1; \
          float kq_ = (gk0.x * gq0.x + gk0.y * gq0.y) + (gk0.z * gq0.z + gk0.w * gq0.w) + (gk1.x * gq1.x + gk1.y * gq1.y) + (gk1.z * gq1.z + gk1.w * gq1.w); \
          kq_ = group_sum<16>(kq_); \
          if (c8_ == 0) { const float beta_ = sigmoid_f(gbr), alpha_ = expf(Aneg * softplus_f(gar + dtb)); *(f32x4*)(sc_ + s_ * 4) = (f32x4){alpha_, beta_, kq_, alpha_ * beta_}; } } \
        if (tid < 256) { const int s2_ = tid >> 3, c4_ = tid & 7; *(f32x4*)(vs_ + s2_ * 32 + c4_ * 4) = gv; } } while (0)
    __syncthreads();
    GDN_LOAD(0); GDN_STORE(0);
    __syncthreads();
    for (int tile = 0; tile < 64; ++tile) {
        const int cur = tile & 1;
        const size_t row0 = (size_t)b * SEQ + (dir ? 63 - tile : tile) * 32;
        if (tile + 1 < 64) GDN_LOAD(tile + 1);
        const float* ks = lds + cur * BUF; const float* qs = ks + 32 * 128; const float* vs = qs + 32 * 128; const float* sc = vs + 32 * 32; float* os = osb + cur * 1024;
        {
            f32x4 n_k0 = *(const f32x4*)(ks + dkg * 4), n_k1 = *(const f32x4*)(ks + 64 + dkg * 4), n_q0 = *(const f32x4*)(qs + dkg * 4), n_q1 = *(const f32x4*)(qs + 64 + dkg * 4);
            f32x4 n_sc = *(const f32x4*)(sc); float n_vv = vs[dvi];
#pragma unroll 4
            for (int s = 0; s < 32; ++s) {
                const f32x4 k0 = n_k0, k1 = n_k1, q0 = n_q0, q1 = n_q1, scv = n_sc; const float vv = n_vv;
                const int sn = (s + 1) & 31;
                n_k0 = *(const f32x4*)(ks + sn * 128 + dkg * 4); n_k1 = *(const f32x4*)(ks + sn * 128 + 64 + dkg * 4);
                n_q0 = *(const f32x4*)(qs + sn * 128 + dkg * 4); n_q1 = *(const f32x4*)(qs + sn * 128 + 64 + dkg * 4);
                n_sc = *(const f32x4*)(sc + sn * 4); n_vv = vs[sn * 32 + dvi];
                const f32x2 ka = (f32x2){k0.x, k0.y}, kb = (f32x2){k0.z, k0.w}, kc = (f32x2){k1.x, k1.y}, kd = (f32x2){k1.z, k1.w};
                f32x2 pk = ka * S[0]; pk += kb * S[1]; pk += kc * S[2]; pk += kd * S[3];
                f32x2 pq = (f32x2){q0.x, q0.y} * S[0]; pq += (f32x2){q0.z, q0.w} * S[1]; pq += (f32x2){q1.x, q1.y} * S[2]; pq += (f32x2){q1.z, q1.w} * S[3];
                float sk = pk.x + pk.y, sq = pq.x + pq.y;
                sk += dpp_mov<0xB1>(sk); sq += dpp_mov<0xB1>(sq);
                sk += dpp_mov<0x4E>(sk); sq += dpp_mov<0x4E>(sq);
                sk += dpp_mov<0x141>(sk); sq += dpp_mov<0x141>(sq);
                sk += dpp_mov<0x140>(sk); sq += dpp_mov<0x140>(sq);
                const float alpha = scv.x, vn = fmaf(-scv.w, sk, scv.y * vv);
                const float po = fmaf(alpha, sq, scv.z * vn);
                const f32x2 al2 = (f32x2){alpha, alpha}, vn2 = (f32x2){vn, vn};
                S[0] = S[0] * al2 + ka * vn2; S[1] = S[1] * al2 + kb * vn2; S[2] = S[2] * al2 + kc * vn2; S[3] = S[3] * al2 + kd * vn2;
                if (dkg == 0) os[s * 32 + dvi] = po;
            }
        }
        if (tile + 1 < 64) GDN_STORE(cur ^ 1);
        __syncthreads();
        if (tid < 256) { const int s2 = tid >> 3, c4 = tid & 7, tl2 = dir ? 31 - s2 : s2; *(f32x4*)(O + (row0 + tl2) * 1024 + hv * 128 + dvs * 32 + c4 * 4) = *(const f32x4*)(os + s2 * 32 + c4 * 4); }
    }
#undef GDN_LOAD
#undef GDN_STORE
}

typedef short s16x4_t __attribute__((ext_vector_type(4)));
typedef __bf16 bf16x2_v __attribute__((ext_vector_type(2)));
__device__ __forceinline__ unsigned cvtpk_rne(float lo, float hi) { f32x2 v = {lo, hi}; bf16x2_v bb = __builtin_convertvector(v, bf16x2_v); return __builtin_bit_cast(unsigned, bb); }
template <int S_> __device__ __forceinline__ bf16x8_t acc_frag(const f32x16_t& x) {
    v4u w; w.x = cvtpk_rne(x[8 * S_ + 0], x[8 * S_ + 1]); w.y = cvtpk_rne(x[8 * S_ + 2], x[8 * S_ + 3]); w.z = cvtpk_rne(x[8 * S_ + 4], x[8 * S_ + 5]); w.w = cvtpk_rne(x[8 * S_ + 6], x[8 * S_ + 7]);
    return __builtin_bit_cast(bf16x8_t, w);
}
__device__ __forceinline__ bf16x8_t join44(v2u lo, v2u hi) { v4u w; w.x = lo.x; w.y = lo.y; w.z = hi.x; w.w = hi.y; return __builtin_bit_cast(bf16x8_t, w); }
__device__ __forceinline__ float wave_incl_scan(float v, int lane) {
#pragma unroll
    for (int o = 1; o < 64; o <<= 1) { const float t = __shfl_up(v, o); if (lane >= o) v += t; }
    return v;
}
constexpr int GDN_LDS_PER_WAVE = 17920;
__device__ __forceinline__ void gdn1_item(const Args& a, int item, unsigned char* ldsw, int lane) {
    asm volatile("" : "+v"(lane));
    const int c = item & 31, dir = (item >> 5) & 1, hv = (item >> 6) & 7, b = item >> 9, hq = hv >> 1;
    const int r32 = lane & 31, hi = lane >> 5;
    float* AT = (float*)ldsw; float* Gs = AT + 64 * 64; float* Bs = Gs + 64;
    const bf16_t* QK = (const bf16_t*)(a.ws + WS_QKV16); const float* SM = (const float*)(a.ws + WS_SMALL);
    bf16_t* GT = (bf16_t*)(a.ws + WS_GT) + (size_t)item * 4096; bf16_t* GA = (bf16_t*)(a.ws + WS_GA) + (size_t)item * 4096;
    const float Aneg = -expf(a.in[dir ? 21 : 20][hv]); const float dtb = a.in[dir ? 23 : 22][hv];
    {
        const int t = dir ? SEQ - 1 - (64 * c + lane) : 64 * c + lane; const float* sm = SM + ((size_t)b * SEQ + t) * 32;
        const float gi = Aneg * softplus_f(sm[16 + dir * 8 + hv] + dtb), bi = sigmoid_f(sm[dir * 8 + hv]);
        Gs[lane] = wave_incl_scan(gi, lane); Bs[lane] = bi;
    }
    const int t0r = dir ? SEQ - 1 - (64 * c + r32) : 64 * c + r32, t1r = dir ? t0r - 32 : t0r + 32;
    const bf16_t* k0p = QK + ((size_t)b * SEQ + t0r) * 2048 + 512 + hq * 128 + hi * 8; const bf16_t* k1p = QK + ((size_t)b * SEQ + t1r) * 2048 + 512 + hq * 128 + hi * 8;
    const bf16_t* q0p = k0p - 512, * q1p = k1p - 512;
    LDS_WAIT();
    const float Gj0 = Gs[r32], Gj1 = Gs[32 + r32];
    {
        f32x16_t kk00, kk10, kk11;
#pragma unroll
        for (int r = 0; r < 16; ++r) { kk00[r] = 0.f; kk10[r] = 0.f; kk11[r] = 0.f; }
#pragma unroll
        for (int s = 0; s < 8; ++s) {
            const bf16x8_t kA0 = *(const bf16x8_t*)(k0p + 16 * s), kA1 = *(const bf16x8_t*)(k1p + 16 * s);
            kk00 = __builtin_amdgcn_mfma_f32_32x32x16_bf16(kA0, kA0, kk00, 0, 0, 0); kk10 = __builtin_amdgcn_mfma_f32_32x32x16_bf16(kA1, kA0, kk10, 0, 0, 0); kk11 = __builtin_amdgcn_mfma_f32_32x32x16_bf16(kA1, kA1, kk11, 0, 0, 0);
        }
#pragma unroll
        for (int r = 0; r < 16; ++r) { const int il = (r & 3) + 8 * (r >> 2) + 4 * hi;
            const float Gi0 = Gs[il], Gi1 = Gs[32 + il], bi0 = Bs[il], bi1 = Bs[32 + il];
            AT[r32 * 64 + il] = (r32 < il) ? bi0 * kk00[r] * expf(Gi0 - Gj0) : 0.f;
            AT[r32 * 64 + 32 + il] = bi1 * kk10[r] * expf(Gi1 - Gj0);
            AT[(32 + r32) * 64 + 32 + il] = (r32 < il) ? bi1 * kk11[r] * expf(Gi1 - Gj1) : 0.f;
            AT[(32 + r32) * 64 + il] = 0.f;
        }
    }
    asm volatile("" ::: "memory");
    {
        f32x16_t qk00, qk10, qk11;
#pragma unroll
        for (int r = 0; r < 16; ++r) { qk00[r] = 0.f; qk10[r] = 0.f; qk11[r] = 0.f; }
#pragma unroll
        for (int s = 0; s < 8; ++s) {
            const bf16x8_t kA0 = *(const bf16x8_t*)(k0p + 16 * s), kA1 = *(const bf16x8_t*)(k1p + 16 * s), qA0 = *(const bf16x8_t*)(q0p + 16 * s), qA1 = *(const bf16x8_t*)(q1p + 16 * s);
            qk00 = __builtin_amdgcn_mfma_f32_32x32x16_bf16(qA0, kA0, qk00, 0, 0, 0); qk10 = __builtin_amdgcn_mfma_f32_32x32x16_bf16(qA1, kA0, qk10, 0, 0, 0); qk11 = __builtin_amdgcn_mfma_f32_32x32x16_bf16(qA1, kA1, qk11, 0, 0, 0);
        }
#pragma unroll
        for (int r = 0; r < 16; ++r) { const int il = (r & 3) + 8 * (r >> 2) + 4 * hi;
            const float Gi0 = Gs[il], Gi1 = Gs[32 + il];
            GA[il * 64 + r32] = (bf16_t)f2bf((r32 <= il) ? qk00[r] * expf(Gi0 - Gj0) : 0.f);
            GA[(32 + il) * 64 + r32] = (bf16_t)f2bf(qk10[r] * expf(Gi1 - Gj0));
            GA[(32 + il) * 64 + 32 + r32] = (bf16_t)f2bf((r32 <= il) ? qk11[r] * expf(Gi1 - Gj1) : 0.f);
        }
    }
    LDS_WAIT(); asm volatile("" ::: "memory");
    float tr[64];
    int lane2 = lane; asm volatile("" : "+v"(lane2) :: "memory");
#pragma unroll
    for (int j = 0; j < 64; ++j) tr[j] = (j == lane2) ? 1.f : 0.f;
    int atoff = 0;
#pragma unroll
    for (int j = 62; j >= 0; --j) { float c0 = 0.f, c1 = 0.f, c2 = 0.f, c3 = 0.f;
        asm volatile("" : "+v"(atoff) : "v"(tr[j + 1]));
#pragma unroll
        for (int qd = (j + 1) / 4; qd < 16; ++qd) { const f32x4 av = *(const f32x4*)(AT + atoff + j * 64 + 4 * qd);
            if (4 * qd + 0 > j) c0 = fmaf(tr[4 * qd + 0], av.x, c0);
            if (4 * qd + 1 > j) c1 = fmaf(tr[4 * qd + 1], av.y, c1);
            if (4 * qd + 2 > j) c2 = fmaf(tr[4 * qd + 2], av.z, c2);
            if (4 * qd + 3 > j) c3 = fmaf(tr[4 * qd + 3], av.w, c3); }
        tr[j] -= (c0 + c1) + (c2 + c3); asm volatile("" ::: "memory"); }
#pragma unroll
    for (int x = 0; x < 8; ++x) *(v4u*)(GT + lane2 * 64 + x * 8) = pack8(tr + x * 8);
    LDS_WAIT();
}

__device__ __forceinline__ void gdn2_item(const Args& a, int item, unsigned char* lds) {
    const int dvs = item & 3, hv = (item >> 2) & 7, dir = (item >> 5) & 1, b = item >> 6, hq = hv >> 1;
    const int lane0 = threadIdx.x & 63;
    constexpr int BUFB = 57344, O_K = 0, O_Q = 16384, O_T = 32768, O_A = 40960, O_V = 49152;
    float* Gs = (float*)(lds + 2 * BUFB); float* Bs = Gs + 64; float* Es = Bs + 64; float* Ws = Es + 64; float* ot = Ws + 64;
    const LAS unsigned char* ldl = (const LAS unsigned char*)lds;
    const bf16_t* QK = (const bf16_t*)(a.ws + WS_QKV16); const float* ACT = (const float*)(a.ws + WS_ACT); const float* SM = (const float*)(a.ws + WS_SMALL);
    float* O = (float*)(a.ws + (dir ? WS_YB : WS_YF));
    const float Aneg = -expf(a.in[dir ? 21 : 20][hv]); const float dtb = a.in[dir ? 23 : 22][hv];
    const size_t gbase = (size_t)(((b * 8 + hv) * 2 + dir) * 32) * 4096;
    f32x16_t S[4];
#pragma unroll
    for (int nt = 0; nt < 4; ++nt)
#pragma unroll
        for (int r = 0; r < 16; ++r) S[nt][r] = 0.f;
    float gar, gbr;
#define G2_DMA(c_, buf_) do { const int t_ = dir ? SEQ - 1 - (64 * (c_) + lane0) : 64 * (c_) + lane0; const size_t mi_ = (size_t)b * SEQ + t_; \
        const bf16_t* kr_ = QK + mi_ * 2048 + 512 + hq * 128; const bf16_t* qr_ = QK + mi_ * 2048 + hq * 128; \
        const bf16_t* tr_ = (const bf16_t*)(a.ws + WS_GT) + gbase + (size_t)(c_) * 4096 + lane0 * 64; const bf16_t* ar_ = (const bf16_t*)(a.ws + WS_GA) + gbase + (size_t)(c_) * 4096 + lane0 * 64; \
        const float* vr_ = ACT + mi_ * 2048 + 1024 + hv * 128 + dvs * 32; \
        LAS unsigned char* lb_ = (LAS unsigned char*)lds + (buf_) * BUFB; \
        _Pragma("unroll") for (int x = 0; x < 16; ++x) { __builtin_amdgcn_global_load_lds((const unsigned*)(kr_ + 8 * x), (LAS unsigned*)(lb_ + O_K + 1024 * x), 16, 0, 0); \
                                                         __builtin_amdgcn_global_load_lds((const unsigned*)(qr_ + 8 * x), (LAS unsigned*)(lb_ + O_Q + 1024 * x), 16, 0, 0); } \
        _Pragma("unroll") for (int x = 0; x < 8; ++x) { __builtin_amdgcn_global_load_lds((const unsigned*)(tr_ + 8 * x), (LAS unsigned*)(lb_ + O_T + 1024 * x), 16, 0, 0); \
                                                        __builtin_amdgcn_global_load_lds((const unsigned*)(ar_ + 8 * x), (LAS unsigned*)(lb_ + O_A + 1024 * x), 16, 0, 0); \
                                                        __builtin_amdgcn_global_load_lds((const unsigned*)(vr_ + 4 * x), (LAS unsigned*)(lb_ + O_V + 1024 * x), 16, 0, 0); } \
        const float* sm_ = SM + mi_ * 32; gar = sm_[16 + dir * 8 + hv]; gbr = sm_[dir * 8 + hv]; } while (0)
    G2_DMA(0, 0);
    for (int c = 0; c < 32; ++c) {
        int lane = lane0; asm volatile("" : "+v"(lane));
        const int r32 = lane & 31, hi = lane >> 5, trq = (lane & 15) >> 2, trp = lane & 3, trc = (lane >> 4) & 1;
        const int bo = (c & 1) * BUFB;
        float GL;
        {
            const float gi = Aneg * softplus_f(gar + dtb), bi = sigmoid_f(gbr);
            const float G = wave_incl_scan(gi, lane); GL = __shfl(G, 63);
            Gs[lane] = G; Bs[lane] = bi; Es[lane] = __expf(G); Ws[lane] = __expf(GL - G);
        }
        asm volatile("s_waitcnt vmcnt(0)" ::: "memory");
        if (c + 1 < 32) G2_DMA(c + 1, (c + 1) & 1);
        LDS_WAIT();
        f32x16_t KS[2];
#pragma unroll
        for (int rt = 0; rt < 2; ++rt)
#pragma unroll
            for (int r = 0; r < 16; ++r) KS[rt][r] = 0.f;
#define LFRAG(off_) join44(*(const LAS v2u*)(ldl + (off_)), *(const LAS v2u*)(ldl + (off_) + 1024))
#pragma unroll
        for (int nt = 0; nt < 4; ++nt) {
            const bf16x8_t sb0 = acc_frag<0>(S[nt]), sb1 = acc_frag<1>(S[nt]);
#pragma unroll
            for (int rt = 0; rt < 2; ++rt) {
                const int ro = bo + O_K + ((4 * nt) * 64 + 32 * rt + r32) * 16 + 8 * hi;
                KS[rt] = __builtin_amdgcn_mfma_f32_32x32x16_bf16(LFRAG(ro), sb0, KS[rt], 0, 0, 0); KS[rt] = __builtin_amdgcn_mfma_f32_32x32x16_bf16(LFRAG(ro + 2048), sb1, KS[rt], 0, 0, 0);
            }
        }
        asm volatile("" ::: "memory");
        f32x16_t rhs[2];
#pragma unroll
        for (int rt = 0; rt < 2; ++rt)
#pragma unroll
            for (int r = 0; r < 16; ++r) { const int i = 32 * rt + (r & 3) + 8 * (r >> 2) + 4 * hi;
                const float vv = *(const LAS float*)(ldl + bo + O_V + ((r32 >> 2) * 64 + i) * 16 + (r32 & 3) * 4); const float bi = Bs[i];
                rhs[rt][r] = bi * vv - bi * Es[i] * KS[rt][r]; }
        asm volatile("" ::: "memory");
        f32x16_t vn[2];
#pragma unroll
        for (int r = 0; r < 16; ++r) { vn[0][r] = 0.f; vn[1][r] = 0.f; }
        {
            const bf16x8_t rb00 = acc_frag<0>(rhs[0]), rb01 = acc_frag<1>(rhs[0]), rb10 = acc_frag<0>(rhs[1]), rb11 = acc_frag<1>(rhs[1]);
            const int t0 = bo + O_T + r32 * 16 + 8 * hi, t1 = t0 + 512;
            vn[0] = __builtin_amdgcn_mfma_f32_32x32x16_bf16(LFRAG(t0), rb00, vn[0], 0, 0, 0); vn[0] = __builtin_amdgcn_mfma_f32_32x32x16_bf16(LFRAG(t0 + 2048), rb01, vn[0], 0, 0, 0);
            vn[1] = __builtin_amdgcn_mfma_f32_32x32x16_bf16(LFRAG(t1), rb00, vn[1], 0, 0, 0); vn[1] = __builtin_amdgcn_mfma_f32_32x32x16_bf16(LFRAG(t1 + 2048), rb01, vn[1], 0, 0, 0);
            vn[1] = __builtin_amdgcn_mfma_f32_32x32x16_bf16(LFRAG(t1 + 4096), rb10, vn[1], 0, 0, 0); vn[1] = __builtin_amdgcn_mfma_f32_32x32x16_bf16(LFRAG(t1 + 6144), rb11, vn[1], 0, 0, 0);
        }
        asm volatile("" ::: "memory");
        f32x16_t QS[2];
#pragma unroll
        for (int rt = 0; rt < 2; ++rt)
#pragma unroll
            for (int r = 0; r < 16; ++r) QS[rt][r] = 0.f;
#pragma unroll
        for (int nt = 0; nt < 4; ++nt) {
            const bf16x8_t sb0 = acc_frag<0>(S[nt]), sb1 = acc_frag<1>(S[nt]);
#pragma unroll
            for (int rt = 0; rt < 2; ++rt) {
                const int ro = bo + O_Q + ((4 * nt) * 64 + 32 * rt + r32) * 16 + 8 * hi;
                QS[rt] = __builtin_amdgcn_mfma_f32_32x32x16_bf16(LFRAG(ro), sb0, QS[rt], 0, 0, 0); QS[rt] = __builtin_amdgcn_mfma_f32_32x32x16_bf16(LFRAG(ro + 2048), sb1, QS[rt], 0, 0, 0);
            }
        }
        asm volatile("" ::: "memory");
        {
            const bf16x8_t vb00 = acc_frag<0>(vn[0]), vb01 = acc_frag<1>(vn[0]), vb10 = acc_frag<0>(vn[1]), vb11 = acc_frag<1>(vn[1]);
            const int a0 = bo + O_A + r32 * 16 + 8 * hi, a1 = a0 + 512;
            f32x16_t o0, o1;
#pragma unroll
            for (int r = 0; r < 16; ++r) { const int il = (r & 3) + 8 * (r >> 2) + 4 * hi; o0[r] = Es[il] * QS[0][r]; o1[r] = Es[32 + il] * QS[1][r]; }
            o0 = __builtin_amdgcn_mfma_f32_32x32x16_bf16(LFRAG(a0), vb00, o0, 0, 0, 0); o0 = __builtin_amdgcn_mfma_f32_32x32x16_bf16(LFRAG(a0 + 2048), vb01, o0, 0, 0, 0);
            o1 = __builtin_amdgcn_mfma_f32_32x32x16_bf16(LFRAG(a1), vb00, o1, 0, 0, 0); o1 = __builtin_amdgcn_mfma_f32_32x32x16_bf16(LFRAG(a1 + 2048), vb01, o1, 0, 0, 0);
            o1 = __builtin_amdgcn_mfma_f32_32x32x16_bf16(LFRAG(a1 + 4096), vb10, o1, 0, 0, 0); o1 = __builtin_amdgcn_mfma_f32_32x32x16_bf16(LFRAG(a1 + 6144), vb11, o1, 0, 0, 0);
#pragma unroll
            for (int r = 0; r < 16; ++r) { const int il = (r & 3) + 8 * (r >> 2) + 4 * hi; ot[il * 33 + r32] = o0[r]; ot[(32 + il) * 33 + r32] = o1[r]; }
            LDS_WAIT();
            { const int t = dir ? SEQ - 1 - (64 * c + lane) : 64 * c + lane; float* orow = O + ((size_t)b * SEQ + t) * 1024 + hv * 128 + dvs * 32;
#pragma unroll
              for (int x = 0; x < 8; ++x) *(f32x4*)(orow + 4 * x) = (f32x4){ot[lane * 33 + 4 * x], ot[lane * 33 + 4 * x + 1], ot[lane * 33 + 4 * x + 2], ot[lane * 33 + 4 * x + 3]}; }
        }
        asm volatile("" ::: "memory");
        {
#pragma unroll
            for (int r = 0; r < 16; ++r) { const int il = (r & 3) + 8 * (r >> 2) + 4 * hi; vn[0][r] *= Ws[il]; vn[1][r] *= Ws[32 + il]; }
            const bf16x8_t wb[4] = {acc_frag<0>(vn[0]), acc_frag<1>(vn[0]), acc_frag<0>(vn[1]), acc_frag<1>(vn[1])};
            const float eGL = __expf(GL);
#pragma unroll
            for (int nt = 0; nt < 4; ++nt) {
#pragma unroll
                for (int r = 0; r < 16; ++r) S[nt][r] *= eGL;
#pragma unroll
                for (int ks = 0; ks < 4; ++ks) {
                    const int ro = bo + O_K + ((4 * nt + 2 * trc + (trp >> 1)) * 64 + 16 * ks + 4 * hi + trq) * 16 + 8 * (trp & 1);
                    const s16x4_t lo = __builtin_bit_cast(s16x4_t, __builtin_amdgcn_ds_read_tr16_b64_v4i16((LAS s16x4_t*)(ldl + ro)));
                    const s16x4_t hi4 = __builtin_bit_cast(s16x4_t, __builtin_amdgcn_ds_read_tr16_b64_v4i16((LAS s16x4_t*)(ldl + ro + 8 * 16)));
                    const bf16x8_t kf = (bf16x8_t){lo[0], lo[1], lo[2], lo[3], hi4[0], hi4[1], hi4[2], hi4[3]};
                    S[nt] = __builtin_amdgcn_mfma_f32_32x32x16_bf16(kf, wb[ks], S[nt], 0, 0, 0);
                }
            }
        }
        LDS_WAIT();
    }
#undef LFRAG
#undef G2_DMA
}

__device__ __forceinline__ void ssd2_item(const Args& a, int item, unsigned char* lds) {
    const int ps = item & 1, h = (item >> 1) & 15, dir = (item >> 5) & 1, b = item >> 6, g = h >> 3;
    const int lane0 = threadIdx.x & 63;
    constexpr int BUFB = 40960, O_B = 0, O_C = 16384, O_X = 32768, O_XD = 2 * BUFB + 512, O_XW = O_XD + 64 * 72;
    float* Gs = (float*)(lds + 2 * BUFB); float* Es = Gs + 64; float* ot = (float*)(lds + O_XW + 64 * 72);
    const LAS unsigned char* ldl = (const LAS unsigned char*)lds;
    const bf16_t* XB = (const bf16_t*)(a.ws + WS_XBC16); const float* ACT = (const float*)(a.ws + WS_ACT); const float* SM = (const float*)(a.ws + WS_SMALL);
    float* Y = (float*)(a.ws + (dir ? WS_YB : WS_YF));
    const float A = -expf(a.in[dir ? 13 : 12][h]); const float dtb = a.in[dir ? 11 : 10][h];
    f32x16_t H[4];
#pragma unroll
    for (int nt = 0; nt < 4; ++nt)
#pragma unroll
        for (int r = 0; r < 16; ++r) H[nt][r] = 0.f;
    float gdr;
#define S2_DMA(c_, buf_) do { const int t_ = dir ? SEQ - 1 - (64 * (c_) + lane0) : 64 * (c_) + lane0; const size_t mi_ = (size_t)b * SEQ + t_; \
        const bf16_t* br_ = XB + mi_ * 1536 + 1024 + g * 128; const bf16_t* cr_ = XB + mi_ * 1536 + 1280 + g * 128; const float* xr_ = ACT + mi_ * 1536 + h * 64 + ps * 32; \
        LAS unsigned char* lb_ = (LAS unsigned char*)lds + (buf_) * BUFB; \
        _Pragma("unroll") for (int x = 0; x < 16; ++x) { __builtin_amdgcn_global_load_lds((const unsigned*)(br_ + 8 * x), (LAS unsigned*)(lb_ + O_B + 1024 * x), 16, 0, 0); \
                                                         __builtin_amdgcn_global_load_lds((const unsigned*)(cr_ + 8 * x), (LAS unsigned*)(lb_ + O_C + 1024 * x), 16, 0, 0); } \
        _Pragma("unroll") for (int x = 0; x < 8; ++x) __builtin_amdgcn_global_load_lds((const unsigned*)(xr_ + 4 * x), (LAS unsigned*)(lb_ + O_X + 1024 * x), 16, 0, 0); \
        gdr = SM[mi_ * 32 + dir * 16 + h]; } while (0)
    S2_DMA(0, 0);
    for (int c = 0; c < 32; ++c) {
        int lane = lane0; asm volatile("" : "+v"(lane));
        const int r32 = lane & 31, hi = lane >> 5, trq = (lane & 15) >> 2, trp = lane & 3, trc = (lane >> 4) & 1;
        const int bo = (c & 1) * BUFB;
        const float dt = softplus_f(gdr + dtb);
        const float cs = wave_incl_scan(dt * A, lane); const float csL = __shfl(cs, 63);
        Gs[lane] = cs; Es[lane] = __expf(cs);
        asm volatile("s_waitcnt vmcnt(0)" ::: "memory");
        if (c + 1 < 32) S2_DMA(c + 1, (c + 1) & 1);
        {
            const float wsc = dt * __expf(csL - cs);
#pragma unroll
            for (int x = 0; x < 8; ++x) { const f32x4 xv = *(const LAS f32x4*)(ldl + bo + O_X + (x * 64 + lane) * 16);
                v2u d; d.x = cvtpk_rne(xv.x * dt, xv.y * dt); d.y = cvtpk_rne(xv.z * dt, xv.w * dt); *(LAS v2u*)((LAS unsigned char*)lds + O_XD + lane * 72 + 8 * x) = d;
                v2u w; w.x = cvtpk_rne(xv.x * wsc, xv.y * wsc); w.y = cvtpk_rne(xv.z * wsc, xv.w * wsc); *(LAS v2u*)((LAS unsigned char*)lds + O_XW + lane * 72 + 8 * x) = w; }
        }
        LDS_WAIT();
        f32x16_t g00, g01, g11;
#pragma unroll
        for (int r = 0; r < 16; ++r) { g00[r] = 0.f; g01[r] = 0.f; g11[r] = 0.f; }
#pragma unroll
        for (int kk = 0; kk < 8; ++kk) { const int fo = ((2 * kk + hi) * 64 + r32) * 16;
            const bf16x8_t A0 = *(const LAS bf16x8_t*)(ldl + bo + O_B + fo), A1 = *(const LAS bf16x8_t*)(ldl + bo + O_B + fo + 512);
            const bf16x8_t B0 = *(const LAS bf16x8_t*)(ldl + bo + O_C + fo), B1 = *(const LAS bf16x8_t*)(ldl + bo + O_C + fo + 512);
            g00 = __builtin_amdgcn_mfma_f32_32x32x16_bf16(A0, B0, g00, 0, 0, 0); g01 = __builtin_amdgcn_mfma_f32_32x32x16_bf16(A0, B1, g01, 0, 0, 0); g11 = __builtin_amdgcn_mfma_f32_32x32x16_bf16(A1, B1, g11, 0, 0, 0); }
        {   const float cst0 = Gs[r32], cst1 = Gs[32 + r32];
#pragma unroll
            for (int r = 0; r < 16; ++r) { const int il = (r & 3) + 8 * (r >> 2) + 4 * hi; const float css0 = Gs[il], css1 = Gs[32 + il];
                g00[r] = (il <= r32) ? g00[r] * __expf(cst0 - css0) : 0.f; g01[r] = g01[r] * __expf(cst1 - css0); g11[r] = (il <= r32) ? g11[r] * __expf(cst1 - css1) : 0.f; } }
        asm volatile("" ::: "memory");
        f32x16_t y0, y1;
#pragma unroll
        for (int r = 0; r < 16; ++r) { y0[r] = 0.f; y1[r] = 0.f; }
#define TRFRAG(base_) ({ const s16x4_t lo_ = __builtin_bit_cast(s16x4_t, __builtin_amdgcn_ds_read_tr16_b64_v4i16((LAS s16x4_t*)(ldl + (base_)))); \
                         const s16x4_t hi_ = __builtin_bit_cast(s16x4_t, __builtin_amdgcn_ds_read_tr16_b64_v4i16((LAS s16x4_t*)(ldl + (base_) + 8 * 72))); \
                         (bf16x8_t){lo_[0], lo_[1], lo_[2], lo_[3], hi_[0], hi_[1], hi_[2], hi_[3]}; })
        {   const int xo = O_XD + (4 * hi + trq) * 72 + (16 * trc + 4 * trp) * 2;
            const bf16x8_t x0 = TRFRAG(xo), x1 = TRFRAG(xo + 16 * 72), x2 = TRFRAG(xo + 32 * 72), x3 = TRFRAG(xo + 48 * 72);
            y0 = __builtin_amdgcn_mfma_f32_32x32x16_bf16(acc_frag<0>(g00), x0, y0, 0, 0, 0); y0 = __builtin_amdgcn_mfma_f32_32x32x16_bf16(acc_frag<1>(g00), x1, y0, 0, 0, 0);
            y1 = __builtin_amdgcn_mfma_f32_32x32x16_bf16(acc_frag<0>(g01), x0, y1, 0, 0, 0); y1 = __builtin_amdgcn_mfma_f32_32x32x16_bf16(acc_frag<1>(g01), x1, y1, 0, 0, 0);
            y1 = __builtin_amdgcn_mfma_f32_32x32x16_bf16(acc_frag<0>(g11), x2, y1, 0, 0, 0); y1 = __builtin_amdgcn_mfma_f32_32x32x16_bf16(acc_frag<1>(g11), x3, y1, 0, 0, 0); }
        asm volatile("" ::: "memory");
        {   f32x16_t Z0, Z1;
#pragma unroll
            for (int r = 0; r < 16; ++r) { Z0[r] = 0.f; Z1[r] = 0.f; }
#define LFRAG(off_) join44(*(const LAS v2u*)(ldl + (off_)), *(const LAS v2u*)(ldl + (off_) + 1024))
#pragma unroll
            for (int nt = 0; nt < 4; ++nt) { const bf16x8_t hb0 = acc_frag<0>(H[nt]), hb1 = acc_frag<1>(H[nt]);
                const int ro = bo + O_C + ((4 * nt) * 64 + r32) * 16 + 8 * hi;
                Z0 = __builtin_amdgcn_mfma_f32_32x32x16_bf16(LFRAG(ro), hb0, Z0, 0, 0, 0); Z0 = __builtin_amdgcn_mfma_f32_32x32x16_bf16(LFRAG(ro + 2048), hb1, Z0, 0, 0, 0);
                Z1 = __builtin_amdgcn_mfma_f32_32x32x16_bf16(LFRAG(ro + 512), hb0, Z1, 0, 0, 0); Z1 = __builtin_amdgcn_mfma_f32_32x32x16_bf16(LFRAG(ro + 512 + 2048), hb1, Z1, 0, 0, 0); }
#undef LFRAG
#pragma unroll
            for (int r = 0; r < 16; ++r) { const int il = (r & 3) + 8 * (r >> 2) + 4 * hi; ot[il * 33 + r32] = fmaf(Es[il], Z0[r], y0[r]); ot[(32 + il) * 33 + r32] = fmaf(Es[32 + il], Z1[r], y1[r]); } }
        LDS_WAIT();
        { const int t = dir ? SEQ - 1 - (64 * c + lane) : 64 * c + lane; float* yrow = Y + ((size_t)b * SEQ + t) * 1024 + h * 64 + ps * 32;
#pragma unroll
          for (int x = 0; x < 8; ++x) *(f32x4*)(yrow + 4 * x) = (f32x4){ot[lane * 33 + 4 * x], ot[lane * 33 + 4 * x + 1], ot[lane * 33 + 4 * x + 2], ot[lane * 33 + 4 * x + 3]}; }
        asm volatile("" ::: "memory");
        {   const float eL = __expf(csL);
            const int xo = O_XW + (4 * hi + trq) * 72 + (16 * trc + 4 * trp) * 2;
            const bf16x8_t w0 = TRFRAG(xo), w1 = TRFRAG(xo + 16 * 72), w2 = TRFRAG(xo + 32 * 72), w3 = TRFRAG(xo + 48 * 72);
#undef TRFRAG
#pragma unroll
            for (int nt = 0; nt < 4; ++nt) {
#pragma unroll
                for (int r = 0; r < 16; ++r) H[nt][r] *= eL;
#pragma unroll
                for (int ks = 0; ks < 4; ++ks) {
                    const int ro = bo + O_B + ((4 * nt + 2 * trc + (trp >> 1)) * 64 + 16 * ks + 4 * hi + trq) * 16 + 8 * (trp & 1);
                    const s16x4_t lo = __builtin_bit_cast(s16x4_t, __builtin_amdgcn_ds_read_tr16_b64_v4i16((LAS s16x4_t*)(ldl + ro)));
                    const s16x4_t hi4 = __builtin_bit_cast(s16x4_t, __builtin_amdgcn_ds_read_tr16_b64_v4i16((LAS s16x4_t*)(ldl + ro + 8 * 16)));
                    const bf16x8_t bfr = (bf16x8_t){lo[0], lo[1], lo[2], lo[3], hi4[0], hi4[1], hi4[2], hi4[3]};
                    H[nt] = __builtin_amdgcn_mfma_f32_32x32x16_bf16(bfr, ks == 0 ? w0 : ks == 1 ? w1 : ks == 2 ? w2 : w3, H[nt], 0, 0, 0);
                }
            }
        }
        LDS_WAIT();
    }
#undef S2_DMA
}

__device__ __forceinline__ void lru_tile(const Args& a, int item, unsigned char* lds, int pass) {
    const int n = item & 7, tc = (item >> 3) & 63, b = item >> 9, t0 = tc * 32;
    float* xc = (float*)lds; bf16_t* xcb = (bf16_t*)(lds + 16384); float* As = (float*)(lds + 25088); float* Us = As + 2 * 32 * 128; float2* sg = (float2*)(Us + 2 * 32 * 128);
    const int tid = threadIdx.x, lane = tid & 63, wave = tid >> 6;
    const bf16_t* P = (const bf16_t*)(a.ws + WS_PROJ);
    __syncthreads();
    {
        const int j = tid & 127, tg = tid >> 7, chn = n * 128 + j; const float* cw = a.in[25];
        const float w0 = cw[chn], w1 = cw[1024 + chn], w2 = cw[2048 + chn], w3 = cw[3072 + chn], cbias = a.in[26][chn];
        const int tb = t0 + tg * 8;
        const bf16_t* pp = P + ((size_t)b * SEQ + tb) * NINP + C_XL + chn;
        float xm2 = (tb >= 2) ? bf2f(pp[-2 * NINP]) : 0.f, xm1 = (tb >= 1) ? bf2f(pp[-NINP]) : 0.f, x0 = bf2f(pp[0]);
#pragma unroll
        for (int i = 0; i < 8; ++i) { const float xp1 = (tb + i + 1 < SEQ) ? bf2f(pp[(i + 1) * NINP]) : 0.f;
            const float acc = cbias + w0 * xm2 + w1 * xm1 + w2 * x0 + w3 * xp1;
            xc[(tg * 8 + i) * 128 + j] = acc; xcb[(tg * 8 + i) * 136 + j] = (bf16_t)f2bf(acc);
            xm2 = xm1; xm1 = x0; x0 = xp1; }
    }
    __syncthreads();
    {
        const int ct = wave & 3, d = wave >> 2, r32 = lane & 31, hi = lane >> 5;
        const bf16_t* WT = (const bf16_t*)(a.ws + WS_WGT);
        const bf16_t* wa_p = WT + ((size_t)((2 * d) * 8 + n) * 128 + ct * 32 + r32) * 128 + hi * 8;
        const bf16_t* wx_p = WT + ((size_t)((2 * d + 1) * 8 + n) * 128 + ct * 32 + r32) * 128 + hi * 8;
        f32x16_t ca, cx;
#pragma unroll
        for (int r = 0; r < 16; ++r) { ca[r] = 0.f; cx[r] = 0.f; }
#pragma unroll
        for (int s = 0; s < 8; ++s) {
            const bf16x8_t af = *(const bf16x8_t*)((const char*)xcb + r32 * 272 + (s * 16 + hi * 8) * 2);
            const bf16x8_t fa = *(const bf16x8_t*)(wa_p + s * 16); const bf16x8_t fx = *(const bf16x8_t*)(wx_p + s * 16);
            ca = __builtin_amdgcn_mfma_f32_32x32x16_bf16(af, fa, ca, 0, 0, 0); cx = __builtin_amdgcn_mfma_f32_32x32x16_bf16(af, fx, cx, 0, 0, 0);
        }
        const int j = ct * 32 + r32, cj = n * 128 + j;
        const float baj = a.in[d ? 33 : 28][cj], bxj = a.in[d ? 35 : 30][cj], sp = softplus_f(-a.in[d ? 36 : 31][cj]);
#pragma unroll
        for (int r = 0; r < 16; ++r) { const int t = (r & 3) + 8 * (r >> 2) + 4 * hi;
            const float rg = __builtin_amdgcn_rcpf(1.f + __expf(-(ca[r] + baj))), ig = __builtin_amdgcn_rcpf(1.f + __expf(-(cx[r] + bxj))); const float la = -8.f * rg * sp;
            const float av = __expf(la);
            const float om = (la > -0.0625f) ? -2.f * la * (1.f + la * (1.f + la * (0.6666667f + 0.3333333f * la))) : (1.f - av) * (1.f + av);
            As[(d * 32 + t) * 128 + j] = av; Us[(d * 32 + t) * 128 + j] = __builtin_amdgcn_sqrtf(om) * (ig * xc[t * 128 + j]); }
    }
    __syncthreads();
    {
        const int j = tid & 127, d = (tid >> 7) & 1, seg = tid >> 8;
        float Pp = 1.f, H = 0.f;
#pragma unroll
        for (int k = 0; k < 16; ++k) { const int q = seg * 16 + k, t = d ? 31 - q : q; const float a_ = As[(d * 32 + t) * 128 + j], u_ = Us[(d * 32 + t) * 128 + j]; H = fmaf(a_, H, u_); Pp *= a_; }
        sg[(d * 2 + seg) * 128 + j] = make_float2(Pp, H);
        __syncthreads();
        float2* LS = (float2*)(a.ws + WS_LSUM);
        if (pass == 0) {
            if (seg == 0) { const float2 s1 = sg[(d * 2 + 1) * 128 + j]; LS[((size_t)(d * 4 + b) * 64 + tc) * 1024 + n * 128 + j] = make_float2(Pp * s1.x, fmaf(s1.x, H, s1.y)); }
        } else {
            float c = 0.f;
            const float2* lsp = LS + ((size_t)(d * 4 + b) * 64) * 1024 + n * 128 + j;
#pragma unroll 1
            for (int c0 = 0; c0 < 64; c0 += 16) { float2 sv[16];
#pragma unroll
                for (int i = 0; i < 16; ++i) { const int cc = d ? 63 - (c0 + i) : c0 + i; sv[i] = lsp[(size_t)cc * 1024]; }
#pragma unroll
                for (int i = 0; i < 16; ++i) { const int cc = d ? 63 - (c0 + i) : c0 + i; const bool before = d ? (cc > tc) : (cc < tc); if (before) c = fmaf(sv[i].x, c, sv[i].y); } }
            if (seg == 1) { const float2 s0 = sg[(d * 2) * 128 + j]; c = fmaf(s0.x, c, s0.y); }
            float h = c;
#pragma unroll
            for (int k = 0; k < 16; ++k) { const int q = seg * 16 + k, t = d ? 31 - q : q; const float a_ = As[(d * 32 + t) * 128 + j], u_ = Us[(d * 32 + t) * 128 + j]; h = fmaf(a_, h, u_); Us[(d * 32 + t) * 128 + j] = h; }
            __syncthreads();
            bf16_t* YC = (bf16_t*)(a.ws + WS_YCAT);
            const int jj = tid & 127, tg = tid >> 7;
#pragma unroll
            for (int i = 0; i < 8; ++i) { const int t = tg * 8 + i; const size_t row = (size_t)b * SEQ + t0 + t;
                const float hs = Us[t * 128 + jj] + Us[(32 + t) * 128 + jj]; const float gl = bf2f(P[row * NINP + C_GL + n * 128 + jj]);
                YC[row * 2048 + 1024 + n * 128 + jj] = (bf16_t)f2bf(hs * silu_f(gl)); }
        }
    }
}

__device__ __forceinline__ void combine1_phase(const Args& a, int gw, int NGW, int lane) {
    const float* OF = (const float*)(a.ws + WS_YF); const float* OB = (const float*)(a.ws + WS_YB);
    const bf16_t* P = (const bf16_t*)(a.ws + WS_PROJ); bf16_t* YC = (bf16_t*)(a.ws + WS_YCAT);
    const float* gn = a.in[24];
    for (int m = gw; m < MTOK; m += NGW) {
        const int ch = lane * 16, d0 = ch & 127;
        float z[16], ov[16];
        unpack8(*(const v4u*)(P + (size_t)m * NINP + C_Z + ch), z); unpack8(*(const v4u*)(P + (size_t)m * NINP + C_Z + ch + 8), z + 8);
#pragma unroll
        for (int q = 0; q < 4; ++q) { const f32x4 f = *(const f32x4*)(OF + (size_t)m * 1024 + ch + 4 * q), bk = *(const f32x4*)(OB + (size_t)m * 1024 + ch + 4 * q); const f32x4 o = f + bk;
            ov[4 * q] = o.x; ov[4 * q + 1] = o.y; ov[4 * q + 2] = o.z; ov[4 * q + 3] = o.w; }
        float ss = 0.f;
#pragma unroll
        for (int i = 0; i < 16; ++i) ss += ov[i] * ov[i];
        ss = group_sum<8>(ss);
        const float r = rsqrtf(ss * (1.f / 128.f) + EPS);
#pragma unroll
        for (int i = 0; i < 16; ++i) ov[i] = ov[i] * r * gn[d0 + i] * silu_f(z[i]);
        *(v4u*)(YC + (size_t)m * 2048 + ch) = pack8(ov); *(v4u*)(YC + (size_t)m * 2048 + ch + 8) = pack8(ov + 8);
    }
}

__device__ __forceinline__ void final_norm_phase(const Args& a, int gw, int NGW, int lane) {
    const float* nw = a.in[38];
    for (int m = gw; m < MTOK; m += NGW) {
        f32x4* xr = (f32x4*)(a.out + (size_t)m * 2048) + lane;
        f32x4 v[8]; float s = 0.f;
#pragma unroll
        for (int j = 0; j < 8; ++j) { v[j] = xr[64 * j]; s += (v[j].x * v[j].x + v[j].y * v[j].y) + (v[j].z * v[j].z + v[j].w * v[j].w); }
        const float rstd = rsqrtf(group_sum<64>(s) * (1.f / 2048.f) + EPS);
#pragma unroll
        for (int j = 0; j < 8; ++j) { const f32x4 w = *(const f32x4*)(nw + (64 * j + lane) * 4); xr[64 * j] = v[j] * rstd * w; }
    }
}

typedef GAS unsigned gu32;
#define RLX_AGENT __ATOMIC_RELAXED, __HIP_MEMORY_SCOPE_AGENT
constexpr int CW_BAR = 4096;
constexpr int MISC_OFF = 147456 - 128;
#define XB_TMO      128
#define XB_XCNT(j)  (256  + 64 * (j))
#define XB_XSUB(j)  (1280 + 64 * (j))
#define XB_XGEN(j)  (2304 + 64 * (j))
#define XB_TOP      3328
#define XB_TOPGEN   3392
#define XCD_BAR_WORDS 3456
#define XB_SPIN_CAP (1u << 18)

__device__ __forceinline__ unsigned xb_ld(unsigned* p)              { return __hip_atomic_load(p, __ATOMIC_RELAXED, __HIP_MEMORY_SCOPE_AGENT); }
__device__ __forceinline__ unsigned xb_add(unsigned* p, unsigned v) { return __hip_atomic_fetch_add(p, v, __ATOMIC_RELAXED, __HIP_MEMORY_SCOPE_AGENT); }
__device__ __forceinline__ unsigned xb_xcc_id() { return (unsigned)__builtin_amdgcn_s_getreg((3 << 11) | 20) & 0xFu; }
#define XB_SPIN(cond, bar) do { unsigned _sp = 0; while (cond) { __builtin_amdgcn_s_sleep(1); \
    if ((++_sp & 255u) == 0u) { if (xb_ld(&(bar)[XB_TMO])) break; if (_sp > XB_SPIN_CAP) { atomicAdd(&(bar)[XB_TMO], 1u); break; } } } } while (0)

struct XcdBarrier {
    unsigned* bar; unsigned x;
    volatile LAS unsigned* st;
};

__device__ __forceinline__ XcdBarrier xcd_barrier_post(unsigned* bar, volatile LAS unsigned* st) {
    XcdBarrier b; b.bar = bar; b.x = xb_xcc_id(); b.st = st;
    if (threadIdx.x == 0) (void)xb_add(&bar[XB_XCNT(b.x)], 1u);
    return b;
}
__device__ __forceinline__ void xcd_barrier_complete(unsigned* bar, unsigned x, unsigned& nloc, unsigned& nx) {
    const unsigned G = gridDim.x * gridDim.y * gridDim.z;
    unsigned sum, cnt, mine, sp = 0u;
    for (;;) {
        sum = 0u; cnt = 0u; mine = 0u;
#pragma unroll
        for (unsigned j = 0; j < 16; ++j) { const unsigned c = xb_ld(&bar[XB_XCNT(j)]); sum += c; cnt += (c > 0u) ? 1u : 0u; mine = (j == x) ? c : mine; }
        if (sum == G) break;
        __builtin_amdgcn_s_sleep(1);
        if ((++sp & 255u) == 0u) { if (xb_ld(&bar[XB_TMO])) break; if (sp > XB_SPIN_CAP) { atomicAdd(&bar[XB_TMO], 1u); break; } }
    }
    nloc = mine > 0u ? mine : 1u; nx = cnt > 0u ? cnt : 1u;
}

__device__ __forceinline__ void xcd_barrier(const XcdBarrier& b) {
    asm volatile("s_waitcnt vmcnt(0)" ::: "memory");
    __syncthreads();
    if (threadIdx.x == 0) {
        unsigned* bar = b.bar;
        __builtin_amdgcn_s_waitcnt(0);
        unsigned nloc = b.st[0], nx = b.st[1];
        if (nloc == 0u) { xcd_barrier_complete(bar, b.x, nloc, nx); b.st[0] = nloc; b.st[1] = nx; }
        const unsigned old = xb_add(&bar[XB_XSUB(b.x)], 1u);
        const unsigned gen = old / nloc;
        if (old + 1u == (gen + 1u) * nloc) {
            __builtin_amdgcn_fence(__ATOMIC_RELEASE, "agent");
            asm volatile("s_waitcnt vmcnt(0)" ::: "memory");
            const unsigned og = xb_add(&bar[XB_TOP], 1u);
            const unsigned tg = og / nx;
            if (og + 1u == (tg + 1u) * nx) xb_add(&bar[XB_TOPGEN], 1u);
            else XB_SPIN(xb_ld(&bar[XB_TOPGEN]) == tg, bar);
            __builtin_amdgcn_fence(__ATOMIC_ACQUIRE, "agent");
            xb_add(&bar[XB_XGEN(b.x)], 1u);
            asm volatile("s_waitcnt vmcnt(0)" ::: "memory");
        } else {
            XB_SPIN(xb_ld(&bar[XB_XGEN(b.x)]) == gen, bar);
            __builtin_amdgcn_fence(__ATOMIC_ACQUIRE, "agent");
            asm volatile("s_waitcnt vmcnt(0)" ::: "memory");
        }
    }
    __syncthreads();
}

#ifndef PROBE_MASK
#define PROBE_MASK 0
#endif
#define REP(bit) for (int rep_ = 0; rep_ < 1 + ((PROBE_MASK >> (bit)) & 1); ++rep_)
#ifndef PROBE_SSD
#define PROBE_SSD 0
#endif
#ifndef PROBE_GDN
#define PROBE_GDN 0
#endif
#ifndef PROBE_LRU
#define PROBE_LRU 0
#endif
#ifndef MK_SINGLE
#define MK_SINGLE 1
#endif
__global__ void __launch_bounds__(NTHREADS, 2) mk_fwd(Args a) {
    extern __shared__ __attribute__((aligned(16))) unsigned char lds[];
    LAS unsigned char* ldsl = (LAS unsigned char*)lds;
    const int tid = threadIdx.x, lane = tid & 63, wave = __builtin_amdgcn_readfirstlane(tid >> 6);
    const int G = gridDim.x, bx = blockIdx.x;
    const int vcu = (G % 8 == 0) ? (bx % 8) * (G / 8) + bx / 8 : bx;
    const int gw = vcu * NWAVES + wave, NGW = G * NWAVES;
    unsigned char* ws = a.ws;
    volatile LAS unsigned* MISC = (volatile LAS unsigned*)(ldsl + MISC_OFF);
    if (tid < 32) MISC[tid] = 0u;
    __syncthreads();
    XcdBarrier bar; bar.bar = (unsigned*)(ws + WS_CTL) + CW_BAR; bar.x = 0; bar.st = nullptr;
    if (a.ph_hi - a.ph_lo > 1) bar = xcd_barrier_post((unsigned*)(ws + WS_CTL) + CW_BAR, MISC + 8);
#define IN(k) (a.ph_lo <= (k) && (k) < a.ph_hi)
#define SEAM(k) do { if (IN(k) && IN((k) + 1)) { xcd_barrier(bar); } } while (0)

    if (IN(0)) { p0_prologue(a, ldsl, vcu, G); } SEAM(0);
    if (IN(1)) { REP(0) normmod_phase(a, a.in[0], 0, gw, NGW, lane); } SEAM(1);
    if (IN(2)) {
        pg8::Gemm g{(const bf16_t*)(ws + WS_H), (const bf16_t*)(ws + WS_WIN0), MTOK, NINP, 2048}; pg8::StaticOrder S; S.init(MTOK, NINP, G, bx);
        pg8::EpiProj E{(bf16_t*)(ws + WS_PROJ), (float*)(ws + WS_SMALL), NINP, A_DT / 256};
        REP(1) { pg8::gemm_phase<pg8::EpiProj, pg8::StaticOrder, true, true>(ldsl, g, S, E); __syncthreads(); }
    } SEAM(2);
    if (IN(3)) { REP(0) post0_phase(a, gw, NGW, lane); } SEAM(3);
    if (IN(4)) {
        REP(3) for (int u = vcu; u < 256; u += G) { const int b = u >> 6, h = (u >> 3) & 7, qb = u & 7, kvh = h >> 2; const size_t row0 = (size_t)b * SEQ + qb * 256;
            att::attn_dense_body((const att::bf16*)(ws + WS_QB) + row0 * 1024 + h * 128, (const att::bf16*)(ws + WS_KB) + (size_t)b * SEQ * 256 + kvh * 128,
                                 (const att::bf16*)(ws + WS_VB) + (size_t)b * SEQ * 256 + kvh * 128, (bf16_t*)(ws + WS_YCAT) + row0 * 2048 + h * 128,
                                 (const bf16_t*)(ws + WS_PROJ) + row0 * NINP + A_GA + h * 128, SEQ, (char*)lds);
            __syncthreads(); }
        for (int rep = 0; rep < 1 + PROBE_SSD; ++rep) { if (wave == 0) { for (int it = vcu; it < 256; it += G) ssd2_item(a, it, lds); } __syncthreads(); }
    } SEAM(4);
    if (IN(5)) { REP(0) ssd_combine_phase(a, gw, NGW, lane); } SEAM(5);
    if (IN(6)) {
        pg8::Gemm g{(const bf16_t*)(ws + WS_YCAT), (const bf16_t*)(ws + WS_WOUT0), MTOK, 2048, 2048}; pg8::StaticOrder S; S.init(MTOK, 2048, G, bx);
        pg8::EpiResid E{a.in[0], a.out, (const float*)(ws + WS_MOD), a.in[3]};
        REP(2) { pg8::gemm_phase<pg8::EpiResid, pg8::StaticOrder, true, true>(ldsl, g, S, E); __syncthreads(); }
    } SEAM(6);
    if (IN(7)) { REP(0) normmod_phase(a, a.out, 1, gw, NGW, lane); } SEAM(7);
    if (IN(8)) {
        pg8::Gemm g{(const bf16_t*)(ws + WS_H), (const bf16_t*)(ws + WS_WIN1), MTOK, NINP, 2048}; pg8::StaticOrder S; S.init(MTOK, NINP, G, bx);
        pg8::EpiProj E{(bf16_t*)(ws + WS_PROJ), (float*)(ws + WS_SMALL), NINP, C_SM / 256};
        pg8::gemm_phase<pg8::EpiProj, pg8::StaticOrder, true, true>(ldsl, g, S, E);
    } SEAM(8);
    if (IN(9)) { REP(0) post1_phase(a, gw, NGW, lane); } SEAM(9);
    if (IN(10)) {
        REP(5) { for (int it = gw; it < 2048; it += NGW) gdn1_item(a, it, lds + wave * GDN_LDS_PER_WAVE, lane); __syncthreads(); }
        for (int rep = 0; rep < 1 + PROBE_LRU; ++rep) { for (int it = bx; it < 2048; it += G) lru_tile(a, it, lds, 0); __syncthreads(); }
    } SEAM(10);
    if (IN(11)) {
        REP(6) { if (wave == 0) { for (int it = vcu; it < 256; it += G) gdn2_item(a, it, lds); } __syncthreads(); }
    } SEAM(11);
    if (IN(12)) { REP(0) combine1_phase(a, gw, NGW, lane); __syncthreads(); REP(4) { for (int it = bx; it < 2048; it += G) lru_tile(a, it, lds, 1); __syncthreads(); } } SEAM(12);
    if (IN(13)) {
        pg8::Gemm g{(const bf16_t*)(ws + WS_YCAT), (const bf16_t*)(ws + WS_WOUT1), MTOK, 2048, 2048}; pg8::StaticOrder S; S.init(MTOK, 2048, G, bx);
        pg8::EpiResid E{a.out, a.out, (const float*)(ws + WS_MOD) + 4 * 6144, a.in[3] + 6144};
        pg8::gemm_phase<pg8::EpiResid, pg8::StaticOrder, true, true>(ldsl, g, S, E);
    } SEAM(13);
    if (IN(14)) { final_norm_phase(a, gw, NGW, lane); }
#undef IN
#undef SEAM
}

extern "C" void kernel_launch(void* const* d_in, const int* in_sizes, int n_in, void* d_out, int out_size, void* d_ws, size_t ws_size, hipStream_t stream) {
    static int grid = 0;
    if (grid == 0) {
        if (n_in != 39 || out_size != MTOK * DM || ws_size < WS_END) { fprintf(stderr, "kernel_launch: unexpected problem (n_in %d, out %d, ws %zu < %zu)\n", n_in, out_size, ws_size, (size_t)WS_END); grid = -1; return; }
        int dev = 0, cus = 0, per_cu = 0;
        if (hipGetDevice(&dev) != hipSuccess || hipDeviceGetAttribute(&cus, hipDeviceAttributeMultiprocessorCount, dev) != hipSuccess) { grid = -1; return; }
        if (hipFuncSetAttribute((const void*)mk_fwd, hipFuncAttributeMaxDynamicSharedMemorySize, LDS_BYTES) != hipSuccess) { fprintf(stderr, "kernel_launch: hipFuncSetAttribute failed\n"); grid = -1; return; }
        if (hipOccupancyMaxActiveBlocksPerMultiprocessor(&per_cu, (const void*)mk_fwd, NTHREADS, LDS_BYTES) != hipSuccess || per_cu < 1) { fprintf(stderr, "kernel_launch: occupancy query says %d\n", per_cu); (void)hipGetLastError(); per_cu = 1; }
        grid = cus;
    }
    if (grid < 0) return;
    (void)hipMemsetAsync((char*)d_ws + WS_CTL, 0, CTL_ZERO_BYTES, stream);
    Args a{};
    for (int i = 0; i < 39; ++i) a.in[i] = (const float*)d_in[i];
    a.out = (float*)d_out; a.ws = (unsigned char*)d_ws;
#if MK_SINGLE
    a.ph_lo = 0; a.ph_hi = NPHASE;
    void* kargs[] = {&a};
    hipError_t e = hipLaunchCooperativeKernel((const void*)mk_fwd, dim3(grid), dim3(NTHREADS), kargs, LDS_BYTES, stream);
    if (e != hipSuccess) fprintf(stderr, "kernel_launch: cooperative launch failed: %s (grid %d)\n", hipGetErrorString(e), grid);
#else
    for (int p = 0; p < NPHASE; ++p) { a.ph_lo = p; a.ph_hi = p + 1; hipLaunchKernelGGL(mk_fwd, dim3(grid), dim3(NTHREADS), LDS_BYTES, stream, a); }
#endif
}
```

```cpp
#include <hip/hip_runtime.h>
#include <hip/hip_cooperative_groups.h>
#include <hip/hip_bf16.h>
#include <cstdio>
#include <cstdint>
namespace cg = cooperative_groups;

constexpr int BATCH = 4, SEQ = 2048, DM = 2048, MTOK = BATCH * SEQ;
constexpr int NIN = 5152, NINP = 5376;
constexpr float EPS = 1e-6f;
constexpr int A_Q = 0, A_K = 1024, A_V = 1280, A_GA = 1536, A_XS = 2560, A_BS = 3584, A_CS = 3840, A_DT = 4096, A_Z = 4128;
constexpr int C_Q = 0, C_K = 512, C_V = 1024, C_SM = 2048, C_Z = 2080, C_XL = 3104, C_GL = 4128;
namespace pg8 {
#define PG8_LAS __attribute__((address_space(3)))
typedef unsigned short bf16_t;
typedef short bf16x8 __attribute__((ext_vector_type(8)));
typedef float f32x4 __attribute__((ext_vector_type(4)));
typedef unsigned u32x4 __attribute__((ext_vector_type(4)));
constexpr int BM = 256, BK = 64, HALF = 128, HTB = HALF * BK * 2  , STAGE_BYTES = 8 * HTB, NXCD = 8, WGM = 8;

__host__ __device__ __forceinline__ int lds_byte(int r, int c) { const int st = (r >> 4) * 2 + (c >> 5), rr = r & 15, cc = c & 31, ob = rr * 64 + cc * 2; return st * 1024 + (ob ^ (((ob >> 9) & 1) << 5)); }
__host__ __device__ __forceinline__ void stage_rc(int b, int& R, int& C) { const int st = b / 1024, sb = b % 1024, swz = sb ^ (((sb >> 9) & 1) << 5); R = (st >> 1) * 16 + swz / 64; C = (st & 1) * 32 + (swz % 64) / 2; }
__host__ __device__ __forceinline__ int perm32(int rho) { const int n = rho >> 4, i = rho & 15; return 8 * (i >> 2) + 4 * n + (i & 3); }

struct Unit { int pm, pn; };
struct Gemm { const bf16_t* A; const bf16_t* Bt; int M, N, K; };

struct StaticOrder {
    int nM, nN, nwg, G, c;
    __host__ __device__ void init(int M, int N, int G_, int c_) { nM = M / BM; nN = N / BM; nwg = nM * nN; G = G_; c = c_; }
    __host__ __device__ bool next(int i, Unit& u) const {
        const long L = (long)i * G + c; if (L >= nwg) return false;
        int wgid = (int)L; { const int q = nwg / NXCD, r = nwg % NXCD, xcd = wgid % NXCD, off = wgid / NXCD; wgid = (xcd < r ? xcd * (q + 1) : r * (q + 1) + (xcd - r) * q) + off; }
        const int nig = WGM * nN, gid = wgid / nig, fm = gid * WGM, gsz = (nM - fm) < WGM ? (nM - fm) : WGM;
        u.pm = fm + ((wgid % nig) % gsz); u.pn = (wgid % nig) / gsz; return true;
    }
    __device__ __forceinline__ void a_ready(const Unit&) const {}
    __device__ __forceinline__ void done(const Unit&) const {}
};

__device__ __forceinline__ unsigned cvt_pk_bf16(float lo, float hi) { unsigned r; asm volatile("v_cvt_pk_bf16_f32 %0, %1, %2" : "=v"(r) : "v"(lo), "v"(hi)); return r; }
typedef float f32x2 __attribute__((ext_vector_type(2)));
struct EpiProj {
    static constexpr bool PERM = true, AFTER_DRAIN = false;
    bf16_t* O; float* small; int ldc; int small_tile;
    __device__ __forceinline__ void operator()(const f32x4 (&acc)[2][2][4][2], const Unit& u, int wr, int wc, int fr, int fq) const {
        const int row0 = u.pm * BM + wr * 64 + fr; const int col0 = u.pn * BM + wc * 32 + 8 * fq;
        const bool sm = (u.pn == small_tile) && (wc == 0);
#pragma unroll
        for (int ai = 0; ai < 2; ++ai)
#pragma unroll
            for (int m = 0; m < 4; ++m) { const int row = row0 + ai * HALF + m * 16; bf16_t* rowp = O + (size_t)row * ldc + col0;
#pragma unroll
                for (int bj = 0; bj < 2; ++bj) { const f32x4 v0 = acc[ai][bj][m][0], v1 = acc[ai][bj][m][1];
                    u32x4 w; w.x = cvt_pk_bf16(v0[0], v0[1]); w.y = cvt_pk_bf16(v0[2], v0[3]); w.z = cvt_pk_bf16(v1[0], v1[1]); w.w = cvt_pk_bf16(v1[2], v1[3]);
                    *(u32x4*)(rowp + bj * HALF) = w; }
                if (sm) { float* sp = small + (size_t)row * 32 + 8 * fq; *(f32x4*)sp = acc[ai][0][m][0]; *(f32x4*)(sp + 4) = acc[ai][0][m][1]; } }
    }
};
struct EpiResid {
    static constexpr bool PERM = false, AFTER_DRAIN = false;
    const float* xin; float* xout; const float* gacc; const float* gbias;
    __device__ __forceinline__ void operator()(const f32x4 (&acc)[2][2][4][2], const Unit& u, int wr, int wc, int fr, int fq) const {
        const int b = u.pm >> 3;
        const int col0 = u.pn * BM + wc * 32 + 4 * fq;
#pragma unroll
        for (int bj = 0; bj < 2; ++bj)
#pragma unroll
            for (int n = 0; n < 2; ++n) { const int col = col0 + bj * HALF + n * 16;
                const f32x4 g = *(const f32x4*)(gacc + (size_t)b * 6144 + 4096 + col) + *(const f32x4*)(gbias + 4096 + col);
#pragma unroll
                for (int ai = 0; ai < 2; ++ai)
#pragma unroll
                    for (int m = 0; m < 4; ++m) { const size_t off = (size_t)(u.pm * BM + ai * HALF + wr * 64 + m * 16 + fr) * 2048 + col;
                        const f32x4 xv = *(const f32x4*)(xin + off); *(f32x4*)(xout + off) = xv + g * acc[ai][bj][m][n]; } }
    }
};
template <class Epi, class Sched, bool ALIGN_EPI = false, bool SP2 = false>
__device__ __forceinline__ void gemm_phase(PG8_LAS unsigned char* lds, const Gemm g, const Sched& S, const Epi& E) {
    const int tid = threadIdx.x, wid = __builtin_amdgcn_readfirstlane(tid >> 6), lane = tid & 63, wr = wid >> 2, wc = wid & 3, fr = lane & 15, fq = lane >> 4;
    const int K = g.K, nt = K / BK;
    unsigned voffA[2], voffB[2];
#pragma unroll
    for (int i = 0; i < 2; ++i) { int R, C; stage_rc(tid * 16 + i * 8192, R, C); const int Rb = Epi::PERM ? ((R & ~31) + perm32(R & 31)) : R;
        voffA[i] = (unsigned)(R * K + C) * 2u; voffB[i] = (unsigned)(Rb * K + C) * 2u; }
    const size_t kstep = (size_t)(BK * 2);
    const size_t hstep = (size_t)HALF * K * 2;
    const size_t tstep = 2 * hstep;
    const unsigned ldsw = (unsigned)wid * 1024u;
    const int aoff = lds_byte(wr * 64 + fr, fq * 8), boff = lds_byte(wc * 32 + fr, fq * 8);
#define PG8_SA(b, h) (((b) * 2 + (h)) * HTB)
#define PG8_SB(b, h) ((4 + (b) * 2 + (h)) * HTB)
#define PG8_STAGE(bufoff, gbase, voff) do { _Pragma("unroll") for (int _i = 0; _i < 2; ++_i) \
        __builtin_amdgcn_global_load_lds((const unsigned*)((const char*)(gbase) + (voff)[_i]), (PG8_LAS unsigned*)(lds + (bufoff) + ldsw + _i * 8192), 16, 0, 0); } while (0)
#define PG8_LDA(dst, b, h) do { _Pragma("unroll") for (int m = 0; m < 4; ++m) _Pragma("unroll") for (int k = 0; k < 2; ++k) dst[m][k] = *(const PG8_LAS bf16x8*)(lds + PG8_SA(b, h) + aoff + m * 2048 + k * 1024); } while (0)
#define PG8_LDB(dst, b, h) do { _Pragma("unroll") for (int n = 0; n < 2; ++n) _Pragma("unroll") for (int k = 0; k < 2; ++k) dst[n][k] = *(const PG8_LAS bf16x8*)(lds + PG8_SB(b, h) + boff + n * 2048 + k * 1024); } while (0)
#define PG8_MMA(ai, bj, At, Bt) do { __builtin_amdgcn_s_setprio(1); _Pragma("unroll") for (int m = 0; m < 4; ++m) _Pragma("unroll") for (int n = 0; n < 2; ++n) _Pragma("unroll") for (int k = 0; k < 2; ++k) \
        acc[ai][bj][m][n] = __builtin_amdgcn_mfma_f32_16x16x32_bf16(Bt[n][k], At[m][k], acc[ai][bj][m][n], 0, 0, 0); __builtin_amdgcn_s_setprio(0); } while (0)
#define PG8_WAIT_V(n) asm volatile("s_waitcnt vmcnt(" #n ")" ::: "memory")
#define PG8_WAIT_L(n) asm volatile("s_waitcnt lgkmcnt(" #n ")" ::: "memory")
#define PG8_BAR __builtin_amdgcn_s_barrier()
#define PG8_SCHED __builtin_amdgcn_sched_barrier(0)
    Unit cur, nxt; int ui = 0;
    if (!S.next(0, cur)) return;
    f32x4 acc[2][2][4][2];
#pragma unroll
    for (int a = 0; a < 2; ++a)
#pragma unroll
        for (int b = 0; b < 2; ++b)
#pragma unroll
            for (int m = 0; m < 4; ++m)
#pragma unroll
                for (int n = 0; n < 2; ++n) acc[a][b][m][n] = (f32x4){0.f, 0.f, 0.f, 0.f};
    bf16x8 At[4][2], B0[2][2], B1[2][2];
    const char* cA = (const char*)g.A + (size_t)cur.pm * tstep; const char* cB = (const char*)g.Bt + (size_t)cur.pn * tstep;
    S.a_ready(cur);
    if constexpr (SP2) {
        PG8_STAGE(PG8_SB(0, 0), cB, voffB); PG8_STAGE(PG8_SB(0, 1), cB + hstep, voffB); PG8_STAGE(PG8_SA(0, 0), cA, voffA); PG8_STAGE(PG8_SA(0, 1), cA + hstep, voffA);
        if (wr == 1) PG8_BAR;
        PG8_WAIT_V(2); PG8_BAR;
        PG8_STAGE(PG8_SB(1, 0), cB + kstep, voffB); PG8_STAGE(PG8_SA(1, 0), cA + kstep, voffA); PG8_STAGE(PG8_SB(1, 1), cB + hstep + kstep, voffB);
        PG8_WAIT_V(6); PG8_BAR;
    } else {
        PG8_STAGE(PG8_SB(0, 0), cB, voffB); PG8_STAGE(PG8_SA(0, 0), cA, voffA); PG8_STAGE(PG8_SB(0, 1), cB + hstep, voffB); PG8_STAGE(PG8_SA(0, 1), cA + hstep, voffA);
        if (wr == 1) PG8_BAR;
        PG8_WAIT_V(4); PG8_BAR;
        PG8_STAGE(PG8_SB(1, 0), cB + kstep, voffB); PG8_STAGE(PG8_SA(1, 0), cA + kstep, voffA); PG8_STAGE(PG8_SB(1, 1), cB + hstep + kstep, voffB);
        PG8_WAIT_V(6); PG8_BAR;
    }
    for (;;) {
        const bool has_next = S.next(ui + 1, nxt);
        const char* nA = has_next ? (const char*)g.A + (size_t)nxt.pm * tstep : cA; const char* nB = has_next ? (const char*)g.Bt + (size_t)nxt.pn * tstep : cB;
        for (int t = 0; t < nt; t += 2) {
            const bool last = (t == nt - 2);
            const char* a1 = cA + (size_t)(t + 1) * kstep;
            const char* a2 = last ? nA : cA + (size_t)(t + 2) * kstep; const char* b2 = last ? nB : cB + (size_t)(t + 2) * kstep;
            const char* a3 = a2 + kstep; const char* b3 = b2 + kstep;
            if (last && has_next) S.a_ready(nxt);
            if constexpr (SP2) {
            PG8_LDB(B0, 0, 0); PG8_LDB(B1, 0, 1); PG8_SCHED; PG8_LDA(At, 0, 0); PG8_STAGE(PG8_SA(1, 1), a1 + hstep, voffA);
            PG8_WAIT_V(8); PG8_WAIT_L(0); PG8_BAR; PG8_MMA(0, 0, At, B0); PG8_MMA(0, 1, At, B1); PG8_BAR; PG8_SCHED;
            PG8_LDA(At, 0, 1); PG8_STAGE(PG8_SB(0, 0), b2, voffB); PG8_STAGE(PG8_SB(0, 1), b2 + hstep, voffB); PG8_STAGE(PG8_SA(0, 0), a2, voffA);
            PG8_WAIT_V(8); PG8_WAIT_L(0); PG8_BAR; PG8_MMA(1, 0, At, B0); PG8_MMA(1, 1, At, B1); PG8_BAR; PG8_SCHED;
            PG8_LDB(B0, 1, 0); PG8_LDB(B1, 1, 1); PG8_SCHED; PG8_LDA(At, 1, 0); PG8_STAGE(PG8_SA(0, 1), a2 + hstep, voffA);
            PG8_WAIT_V(8); PG8_WAIT_L(0); PG8_BAR; PG8_MMA(0, 0, At, B0); PG8_MMA(0, 1, At, B1); PG8_BAR; PG8_SCHED;
            PG8_LDA(At, 1, 1); PG8_STAGE(PG8_SB(1, 0), b3, voffB); PG8_STAGE(PG8_SB(1, 1), b3 + hstep, voffB); PG8_STAGE(PG8_SA(1, 0), a3, voffA);
            PG8_WAIT_V(8); PG8_WAIT_L(0); PG8_BAR; PG8_MMA(1, 0, At, B0); PG8_MMA(1, 1, At, B1); PG8_BAR; PG8_SCHED;
            } else {
            PG8_LDB(B0, 0, 0); PG8_SCHED; PG8_LDA(At, 0, 0); PG8_STAGE(PG8_SA(1, 1), a1 + hstep, voffA);
            PG8_WAIT_L(8); PG8_BAR; PG8_WAIT_L(0); PG8_MMA(0, 0, At, B0); PG8_BAR; PG8_SCHED;
            PG8_LDB(B1, 0, 1); PG8_STAGE(PG8_SB(0, 0), b2, voffB);
            PG8_BAR; PG8_WAIT_L(0); PG8_MMA(0, 1, At, B1); PG8_BAR;
            PG8_LDA(At, 0, 1); PG8_STAGE(PG8_SA(0, 0), a2, voffA);
            PG8_BAR; PG8_WAIT_L(0); PG8_MMA(1, 0, At, B0); PG8_BAR; PG8_SCHED;
            PG8_STAGE(PG8_SB(0, 1), b2 + hstep, voffB);
            PG8_WAIT_V(6); PG8_BAR; PG8_MMA(1, 1, At, B1); PG8_BAR;
            PG8_LDB(B0, 1, 0); PG8_SCHED; PG8_LDA(At, 1, 0); PG8_STAGE(PG8_SA(0, 1), a2 + hstep, voffA);
            PG8_WAIT_L(8); PG8_BAR; PG8_WAIT_L(0); PG8_MMA(0, 0, At, B0); PG8_BAR; PG8_SCHED;
            PG8_LDB(B1, 1, 1); PG8_STAGE(PG8_SB(1, 0), b3, voffB);
            PG8_BAR; PG8_WAIT_L(0); PG8_MMA(0, 1, At, B1); PG8_BAR;
            PG8_LDA(At, 1, 1); PG8_STAGE(PG8_SA(1, 0), a3, voffA);
            PG8_BAR; PG8_WAIT_L(0); PG8_MMA(1, 0, At, B0); PG8_BAR; PG8_SCHED;
            PG8_STAGE(PG8_SB(1, 1), b3 + hstep, voffB);
            PG8_WAIT_V(6); PG8_BAR; PG8_MMA(1, 1, At, B1); PG8_BAR;
            }
        }
        if constexpr (ALIGN_EPI) { if (wr == 0) PG8_BAR; }
        if constexpr (!Epi::AFTER_DRAIN) { E(acc, cur, wr, wc, fr, fq); S.done(cur); }
        if (!has_next) break;
#pragma unroll
        for (int a = 0; a < 2; ++a)
#pragma unroll
            for (int b = 0; b < 2; ++b)
#pragma unroll
                for (int m = 0; m < 4; ++m)
#pragma unroll
                    for (int n = 0; n < 2; ++n) acc[a][b][m][n] = (f32x4){0.f, 0.f, 0.f, 0.f};
        cur = nxt; cA = nA; cB = nB; ++ui;
        if constexpr (ALIGN_EPI) { if (wr == 1) PG8_BAR; }
    }
    PG8_WAIT_V(0);
    if constexpr (!ALIGN_EPI) { if (wr == 0) PG8_BAR; }
    PG8_BAR;
    if constexpr (Epi::AFTER_DRAIN) { E.fused(acc, cur, wr, wc, fr, fq, lds, wid, lane); S.done(cur); }
#undef PG8_SA
#undef PG8_SB
#undef PG8_STAGE
#undef PG8_LDA
#undef PG8_LDB
#undef PG8_MMA
#undef PG8_WAIT_V
#undef PG8_WAIT_L
#undef PG8_BAR
#undef PG8_SCHED
}
}
namespace att {
using bf16 = __hip_bfloat16;
constexpr int   D = 128, NW = 8, QBLK = 32, KVBLK = 64;
constexpr float SCALE = 0.088388347648318440f;
constexpr float THR = 8.f;
constexpr int SDEPTH = 2;
constexpr int LDQ = 1024, LDK = 256, LDY = 2048, LDG = NINP;
constexpr size_t SHM_V = KVBLK * D * 2, SHM_K = KVBLK * D * 2, SHM_ATTN = 2 * SHM_V + 2 * SHM_K + NW * 64 * 4;
using bf16x8 = __attribute__((ext_vector_type(8))) short;
using s16x4  = __attribute__((ext_vector_type(4))) short;
using f32x16 = __attribute__((ext_vector_type(16))) float;
using f32x8  = __attribute__((ext_vector_type(8))) float;
using u32x4  = __attribute__((ext_vector_type(4))) unsigned;
#define KSWZ(row, colB) ((row) * 256 + ((colB) ^ (((row) & 7) << 4)))
#define SBAR() __builtin_amdgcn_sched_barrier(0)
__device__ __forceinline__ int crow(int r, int hi) { return (r & 3) + 8 * (r >> 2) + 4 * hi; }
__device__ __forceinline__ unsigned cvtpk(float lo, float hi) {
  unsigned r; asm volatile("v_cvt_pk_bf16_f32 %0, %1, %2" : "=v"(r) : "v"(lo), "v"(hi)); return r;
}
template <typename TIn> struct Stage;
template <> struct Stage<bf16>  { using T = bf16x8;
  __device__ static __forceinline__ T ld8(const bf16* p) { return *reinterpret_cast<const bf16x8*>(p); }
  __device__ static __forceinline__ bf16x8 tobf(T x) { return x; } };
template <> struct Stage<float> { using T = f32x8;
  __device__ static __forceinline__ T ld8(const float* p) { return *reinterpret_cast<const f32x8*>(p); }
  __device__ static __forceinline__ bf16x8 tobf(T x) {
    u32x4 w = {cvtpk(x[0], x[1]), cvtpk(x[2], x[3]), cvtpk(x[4], x[5]), cvtpk(x[6], x[7])}; return *reinterpret_cast<bf16x8*>(&w); } };

__device__ __forceinline__ void partialSM(f32x16& p0, f32x16& p1, float& m_reg, float& mn, float& alpha) {
  constexpr float C = SCALE * 1.4426950408889634f;
  float pmax = p0[0]; for (int r = 1; r < 16; ++r) pmax = fmaxf(pmax, p0[r]); for (int r = 0; r < 16; ++r) pmax = fmaxf(pmax, p1[r]);
  { auto rr = __builtin_amdgcn_permlane32_swap(__float_as_uint(pmax), __float_as_uint(pmax), false, false);
    pmax = fmaxf(__uint_as_float(rr[0]), __uint_as_float(rr[1])); }
  if (__builtin_expect(__all(pmax - m_reg <= THR / SCALE), 1)) { mn = m_reg; alpha = 1.f; }
  else { mn = fmaxf(m_reg, pmax); alpha = __builtin_amdgcn_exp2f((m_reg - mn) * C); m_reg = mn; }
  float mnC = -mn * C;
  for (int r = 0; r < 16; ++r) p0[r] = fmaf(p0[r], C, mnC); for (int r = 0; r < 16; ++r) p1[r] = fmaf(p1[r], C, mnC);
  for (int r = 0; r < 16; ++r) p0[r] = __builtin_amdgcn_exp2f(p0[r]);
}
__device__ __forceinline__ void finishSM(f32x16& p0, f32x16& p1, float alpha, float& l_reg, bf16x8& pa0, bf16x8& pa1, bf16x8& pa2, bf16x8& pa3) {
  for (int r = 0; r < 16; ++r) p1[r] = __builtin_amdgcn_exp2f(p1[r]);
  float ps = 0; for (int r = 0; r < 16; ++r) ps += p0[r]; for (int r = 0; r < 16; ++r) ps += p1[r];
  { auto rr = __builtin_amdgcn_permlane32_swap(__float_as_uint(ps), __float_as_uint(ps), false, false);
    ps = __uint_as_float(rr[0]) + __uint_as_float(rr[1]); }
  l_reg = l_reg * alpha + ps;
#define PK4(P, BASE, OUT) do { unsigned a0 = cvtpk(P[BASE + 0], P[BASE + 1]), a1 = cvtpk(P[BASE + 2], P[BASE + 3]);   \
    unsigned b0 = cvtpk(P[BASE + 4], P[BASE + 5]), b1 = cvtpk(P[BASE + 6], P[BASE + 7]);                              \
    auto r0 = __builtin_amdgcn_permlane32_swap(a0, b0, false, false); auto r1 = __builtin_amdgcn_permlane32_swap(a1, b1, false, false); \
    u32x4 w = {r0[0], r1[0], r0[1], r1[1]}; OUT = *reinterpret_cast<bf16x8*>(&w); } while (0)
  PK4(p0, 0, pa0); PK4(p0, 8, pa1); PK4(p1, 0, pa2); PK4(p1, 8, pa3);
#undef PK4
}
__device__ __forceinline__ void qkt(f32x16& p0, f32x16& p1, const bf16* Ks, const bf16x8* qr, int r32, int hi) {
  p0 = f32x16{}; p1 = f32x16{};
  for (int d0 = 0; d0 < 8; ++d0) { int cb = (d0 * 16 + hi * 8) * 2;
    bf16x8 b0 = *reinterpret_cast<const bf16x8*>((const char*)Ks + KSWZ(r32, cb));
    bf16x8 b1 = *reinterpret_cast<const bf16x8*>((const char*)Ks + KSWZ(32 + r32, cb));
    p0 = __builtin_amdgcn_mfma_f32_32x32x16_bf16(b0, qr[d0], p0, 0, 0, 0);
    p1 = __builtin_amdgcn_mfma_f32_32x32x16_bf16(b1, qr[d0], p1, 0, 0, 0); }
}
__device__ __forceinline__ int v_st(int k, int c) { const int kk = (k & ~0xC) | ((k & 4) << 1) | ((k & 8) >> 1); return ((kk >> 3) * 4 + (c >> 5)) * 512 + ((kk & 7) * 32 + (c & 31)) * 2; }
__device__ __forceinline__ int v_rd_base(int lane) { return ((lane & 3) << 3) | (((lane >> 2) & 3) << 6) | (((lane >> 4) & 1) << 5) | (((lane >> 5) & 1) << 8); }
constexpr int v_rd_off(int d0, int ks, int half) { return d0 * 512 + ks * 4096 + half * 2048; }
template <int OFF> __device__ __forceinline__ s16x4 tr_read(int vb) {
  s16x4 r; asm volatile("ds_read_b64_tr_b16 %0, %1 offset:%2" : "=&v"(r) : "v"(vb), "i"(OFF) : "memory"); return r;
}
template <int D0> __device__ __forceinline__ void pv_one(f32x16& od, int vb, bf16x8 pa0, bf16x8 pa1, bf16x8 pa2, bf16x8 pa3) {
  const s16x4 l0 = tr_read<v_rd_off(D0, 0, 0)>(vb), h0 = tr_read<v_rd_off(D0, 0, 1)>(vb), l1 = tr_read<v_rd_off(D0, 1, 0)>(vb), h1 = tr_read<v_rd_off(D0, 1, 1)>(vb);
  const s16x4 l2 = tr_read<v_rd_off(D0, 2, 0)>(vb), h2 = tr_read<v_rd_off(D0, 2, 1)>(vb), l3 = tr_read<v_rd_off(D0, 3, 0)>(vb), h3 = tr_read<v_rd_off(D0, 3, 1)>(vb);
  asm volatile("s_waitcnt lgkmcnt(0)" ::: "memory"); SBAR();
#define PK(L, H) (bf16x8){L[0], L[1], L[2], L[3], H[0], H[1], H[2], H[3]}
  od = __builtin_amdgcn_mfma_f32_32x32x16_bf16(pa0, PK(l0, h0), od, 0, 0, 0);
  od = __builtin_amdgcn_mfma_f32_32x32x16_bf16(pa1, PK(l1, h1), od, 0, 0, 0);
  od = __builtin_amdgcn_mfma_f32_32x32x16_bf16(pa2, PK(l2, h2), od, 0, 0, 0);
  od = __builtin_amdgcn_mfma_f32_32x32x16_bf16(pa3, PK(l3, h3), od, 0, 0, 0);
#undef PK
}
__device__ __forceinline__ void pv_d0(f32x16* o, int vb, bf16x8 pa0, bf16x8 pa1, bf16x8 pa2, bf16x8 pa3) {
  pv_one<0>(o[0], vb, pa0, pa1, pa2, pa3); pv_one<1>(o[1], vb, pa0, pa1, pa2, pa3); pv_one<2>(o[2], vb, pa0, pa1, pa2, pa3); pv_one<3>(o[3], vb, pa0, pa1, pa2, pa3);
}
__device__ __forceinline__ void attn_dense_body(const bf16* __restrict__ Qb, const bf16* __restrict__ Kh, const bf16* __restrict__ Vh,
                                                unsigned short* __restrict__ Yb, const unsigned short* __restrict__ Gb, int seq, char* lds) {
  using St = Stage<bf16>; using SQ = Stage<bf16>; using TQ = bf16;
  const int tid = threadIdx.x, wid = tid >> 6, lane = tid & 63, r32 = lane & 31, hi = lane >> 5;
  bf16* V_lds = (bf16*)lds; bf16* K_lds = (bf16*)(lds + 2 * SHM_V);
  float* ws = (float*)(lds + 2 * SHM_V + 2 * SHM_K) + wid * 64; float* li_l = ws; float* al_l = ws + 32;
  float m_reg = -1e30f, l_reg = 0; f32x16 o[4] = {}; bf16x8 qr[8];
  const TQ* Qw = Qb + (long)(wid * QBLK + r32) * LDQ + hi * 8;
#pragma unroll
  for (int d0 = 0; d0 < 8; ++d0) qr[d0] = SQ::tobf(SQ::ld8(Qw + d0 * 16));
  const int sr = tid >> 4, sc = (tid & 15) * 8, vst0 = v_st(sr, sc), vst1 = v_st(32 + sr, sc);
  const int vb0 = (int)(uintptr_t)V_lds + v_rd_base(lane);
  struct { typename St::T vs0, vs1, ks0, ks1; } sr_[SDEPTH];
#define SLOAD(i, k0) do { sr_[i].vs0 = St::ld8(&Vh[(long)((k0) + sr) * LDK + sc]); sr_[i].vs1 = St::ld8(&Vh[(long)((k0) + 32 + sr) * LDK + sc]); \
    sr_[i].ks0 = St::ld8(&Kh[(long)((k0) + sr) * LDK + sc]); sr_[i].ks1 = St::ld8(&Kh[(long)((k0) + 32 + sr) * LDK + sc]); } while (0)
#define SWRITE(b, i) do { *(bf16x8*)((char*)V_lds + (b) * SHM_V + vst0) = St::tobf(sr_[i].vs0);          \
    *(bf16x8*)((char*)V_lds + (b) * SHM_V + vst1) = St::tobf(sr_[i].vs1); int kc = sc * 2;               \
    *(bf16x8*)((char*)K_lds + (b) * SHM_K + KSWZ(sr, kc)) = St::tobf(sr_[i].ks0);                       \
    *(bf16x8*)((char*)K_lds + (b) * SHM_K + KSWZ(32 + sr, kc)) = St::tobf(sr_[i].ks1); } while (0)
#define SWAIT() do { if constexpr (SDEPTH == 2) asm volatile("s_waitcnt vmcnt(4)" ::: "memory"); else asm volatile("s_waitcnt vmcnt(0)" ::: "memory"); } while (0)
#define RESC(a) do { if (__any((a) < 1.f)) { if (hi == 0) al_l[r32] = (a); asm volatile("s_waitcnt lgkmcnt(0)" ::: "memory"); \
    for (int d = 0; d < 4; ++d) for (int r = 0; r < 16; ++r) o[d][r] *= al_l[crow(r, hi)]; } } while (0)
  f32x16 pA0, pA1, pB0, pB1; float mnA, mnB, alA, alB; bf16x8 pa0, pa1, pa2, pa3; const int NT = seq / KVBLK;
  constexpr int SE = 0, SO = SDEPTH - 1;
  SLOAD(SE, 0); asm volatile("s_waitcnt vmcnt(0)" ::: "memory"); SWRITE(0, SE); __syncthreads();
  qkt(pA0, pA1, K_lds, qr, r32, hi); partialSM(pA0, pA1, m_reg, mnA, alA);
  SLOAD(SO, KVBLK); if constexpr (SDEPTH == 2) { if (2 < NT) SLOAD(SE, 2 * KVBLK); }
  SWAIT(); SWRITE(1, SO); __syncthreads();
  for (int j = 1; j + 1 < NT; j += 2) {
    SBAR(); qkt(pB0, pB1, (bf16*)((char*)K_lds + SHM_K), qr, r32, hi);
    finishSM(pA0, pA1, alA, l_reg, pa0, pa1, pa2, pa3); SBAR();
    SLOAD(SO, (j + SDEPTH) * KVBLK); SBAR();
    pv_d0(o, vb0, pa0, pa1, pa2, pa3); partialSM(pB0, pB1, m_reg, mnB, alB);
    __syncthreads(); SWAIT(); SWRITE(0, SE);
    RESC(alB); __syncthreads();
    SBAR(); qkt(pA0, pA1, K_lds, qr, r32, hi);
    finishSM(pB0, pB1, alB, l_reg, pa0, pa1, pa2, pa3); SBAR();
    if (SDEPTH == 1 || j + 3 < NT) SLOAD(SE, (j + 1 + SDEPTH) * KVBLK); SBAR();
    pv_d0(o, vb0 + (int)SHM_V, pa0, pa1, pa2, pa3); partialSM(pA0, pA1, m_reg, mnA, alA);
    __syncthreads(); SWAIT(); SWRITE(1, SO);
    RESC(alA); __syncthreads();
  }
  SBAR(); qkt(pB0, pB1, (bf16*)((char*)K_lds + SHM_K), qr, r32, hi);
  finishSM(pA0, pA1, alA, l_reg, pa0, pa1, pa2, pa3); SBAR();
  pv_d0(o, vb0, pa0, pa1, pa2, pa3); partialSM(pB0, pB1, m_reg, mnB, alB);
  __syncthreads(); RESC(alB);
  finishSM(pB0, pB1, alB, l_reg, pa0, pa1, pa2, pa3); SBAR();
  pv_d0(o, vb0 + (int)SHM_V, pa0, pa1, pa2, pa3);
  if (hi == 0) li_l[r32] = l_reg; asm volatile("s_waitcnt lgkmcnt(0)" ::: "memory");
  float rli[16];
#pragma unroll
  for (int r = 0; r < 16; ++r) rli[r] = __builtin_amdgcn_rcpf(li_l[crow(r, hi)]);
  int eoff = (wid * QBLK + 4 * hi) ; asm volatile("" : "+v"(eoff));
  const unsigned short* Gw = Gb + (long)eoff * LDG + r32; unsigned short* Yw = Yb + (long)eoff * LDY + r32;
#pragma unroll
  for (int r = 0; r < 16; ++r) { const int orow = (r & 3) + 8 * (r >> 2);
#pragma unroll
    for (int d0 = 0; d0 < 4; ++d0) { const float g = __uint_as_float(((unsigned)Gw[orow * LDG + d0 * 32]) << 16);
      const float val = o[d0][r] * rli[r] * (g / (1.f + __expf(-g)));
      unsigned ub = __float_as_uint(val); ub = (ub + 0x7fffu + ((ub >> 16) & 1u)) >> 16;
      Yw[orow * LDY + d0 * 32] = (unsigned short)ub; } }
#undef SLOAD
#undef SWRITE
#undef SWAIT
#undef RESC
}
}
#define GAS __attribute__((address_space(1)))
#define LAS __attribute__((address_space(3)))
typedef unsigned short bf16_t;
typedef unsigned v4u __attribute__((ext_vector_type(4)));
typedef unsigned v2u __attribute__((ext_vector_type(2)));
typedef float f32x4 __attribute__((ext_vector_type(4)));
typedef short bf16x8_t __attribute__((ext_vector_type(8)));
typedef float f32x16_t __attribute__((ext_vector_type(16)));
#define LDS_WAIT() asm volatile("s_waitcnt lgkmcnt(0)" ::: "memory")

constexpr size_t MiB = 1u << 20;
constexpr size_t WS_CTL = 0, CTL_ZERO_BYTES = 1 * MiB;
constexpr size_t WS_MOD = 64 * 1024;
constexpr size_t WS_ROPE = 1 * MiB;
constexpr size_t WS_SMALL = 2 * MiB;
constexpr size_t WS_WIN0 = 3 * MiB, WS_WOUT0 = 24 * MiB;
constexpr size_t WS_QB = 32 * MiB, WS_KB = 48 * MiB, WS_VB = 52 * MiB;
constexpr size_t WS_HB = 3 * MiB;
constexpr size_t WS_WIN1 = 56 * MiB, WS_WOUT1 = 77 * MiB;
constexpr size_t WS_H = 85 * MiB;
constexpr size_t WS_HF = 85 * MiB;
constexpr size_t WS_PROJ = 117 * MiB;
constexpr size_t WS_YCAT = 201 * MiB;
constexpr size_t WS_ACT = 233 * MiB;
constexpr size_t WS_YF = 297 * MiB, WS_YB = 329 * MiB;
constexpr size_t WS_XBC16 = 85 * MiB;
constexpr size_t WS_QKV16 = 3 * MiB;
constexpr size_t WS_GT = 85 * MiB, WS_GA = 101 * MiB;
constexpr size_t WS_WGT = 361 * MiB;
constexpr size_t WS_LSUM = 362 * MiB;
constexpr size_t WS_END = 366 * MiB;

constexpr int NWAVES = 8, NTHREADS = 512;
constexpr int LDS_BYTES = 147456;
constexpr int NPHASE = 15;

struct Args { const float* in[39]; float* out; unsigned char* ws; int ph_lo, ph_hi; };

__device__ __forceinline__ float bf2f(unsigned v) { return __uint_as_float(v << 16); }
__device__ __forceinline__ unsigned f2bf(float f) { unsigned u = __float_as_uint(f); return (u + 0x7fffu + ((u >> 16) & 1u)) >> 16; }
__device__ __forceinline__ unsigned pk2(float lo, float hi) { return f2bf(lo) | (f2bf(hi) << 16); }
__device__ __forceinline__ void unpack8(const v4u w, float* x) {
    x[0] = __uint_as_float(w.x << 16); x[1] = __uint_as_float(w.x & 0xffff0000u); x[2] = __uint_as_float(w.y << 16); x[3] = __uint_as_float(w.y & 0xffff0000u);
    x[4] = __uint_as_float(w.z << 16); x[5] = __uint_as_float(w.z & 0xffff0000u); x[6] = __uint_as_float(w.w << 16); x[7] = __uint_as_float(w.w & 0xffff0000u);
}
__device__ __forceinline__ v4u pack8(const float* x) { v4u w; w.x = pk2(x[0], x[1]); w.y = pk2(x[2], x[3]); w.z = pk2(x[4], x[5]); w.w = pk2(x[6], x[7]); return w; }
__device__ __forceinline__ float silu_f(float x) { return x / (1.f + expf(-x)); }
__device__ __forceinline__ float sigmoid_f(float x) { return 1.f / (1.f + expf(-x)); }
__device__ __forceinline__ float softplus_f(float x) { return fmaxf(x, 0.f) + log1pf(expf(-fabsf(x))); }
template <int CTRL> __device__ __forceinline__ float dpp_mov(float v) { return __builtin_bit_cast(float, __builtin_amdgcn_update_dpp(0, __builtin_bit_cast(int, v), CTRL, 0xF, 0xF, true)); }
template <int N> __device__ __forceinline__ float group_sum(float v) {
    if (N >= 2) v += dpp_mov<0xB1>(v);
    if (N >= 4) v += dpp_mov<0x4E>(v);
    if (N >= 8) v += dpp_mov<0x141>(v);
    if (N >= 16) v += dpp_mov<0x140>(v);
    if (N >= 32) v += __shfl_xor(v, 16);
    if (N >= 64) v += __shfl_xor(v, 32);
    return v;
}

__device__ __forceinline__ void p0_transpose_item(const float* W, int K, int N, bf16_t* WT, int row_off, LAS float* scr, int item, int lane) {
    const int nblk = N / 32, kb = item / nblk, nb = item % nblk, k0 = 64 * kb, n0 = 32 * nb;
#pragma unroll 8
    for (int i = 0; i < 32; ++i) { const int kk = 2 * i + (lane >> 5); scr[kk * 33 + (lane & 31)] = W[(size_t)(k0 + kk) * N + n0 + (lane & 31)]; }
    LDS_WAIT(); asm volatile("" ::: "memory");
    const int c = lane & 7;
#pragma unroll
    for (int j = 0; j < 4; ++j) { const int n = (lane >> 3) + 8 * j; const LAS float* s = scr + (8 * c) * 33 + n;
        v4u o; o.x = pk2(s[0 * 33], s[1 * 33]); o.y = pk2(s[2 * 33], s[3 * 33]); o.z = pk2(s[4 * 33], s[5 * 33]); o.w = pk2(s[6 * 33], s[7 * 33]);
        *(v4u*)(WT + (size_t)(row_off + n0 + n) * K + k0 + 8 * c) = o; }
    LDS_WAIT(); asm volatile("" ::: "memory");
}

__device__ __forceinline__ void p0_prologue(const Args& a, LAS unsigned char* lds, int vcu, int G) {
    const int tid = threadIdx.x, lane = tid & 63, wave = tid >> 6;
    unsigned char* ws = a.ws;
    { const int gid = blockIdx.x * NTHREADS + tid;
      if (gid < 2048) { const int pos = gid >> 5, i = gid & 31; const float freq = expf(-(float)i * (1.f / 32.f) * 9.210340371976184f); const float ang = (float)pos * freq;
          float* rt = (float*)(ws + WS_ROPE); rt[2 * gid] = cosf(ang); rt[2 * gid + 1] = sinf(ang); } }
    { const int gid = blockIdx.x * NTHREADS + tid, gn = G * NTHREADS; constexpr int NV = (NINP - NIN) * 2048 * 2 / 16;
      v4u* p0 = (v4u*)(ws + WS_WIN0 + (size_t)NIN * 2048 * 2); v4u* p1 = (v4u*)(ws + WS_WIN1 + (size_t)NIN * 2048 * 2);
      for (int i = gid; i < NV; i += gn) { p0[i] = (v4u){0, 0, 0, 0}; p1[i] = (v4u){0, 0, 0, 0}; } }
    if (blockIdx.x < 192) {
        const int it = blockIdx.x, l = it / 96, r = it % 96, kc = r / 3, nc = r % 3;
        LAS float* cond = (LAS float*)lds;
        if (tid < 256) { const int b = tid >> 6, k = tid & 63; const float c = a.in[1][b * 2048 + kc * 64 + k]; cond[tid] = silu_f(c); }
        __syncthreads();
        const float* W = a.in[2] + (size_t)l * 2048 * 6144 + (size_t)(kc * 64) * 6144 + nc * 2048 + tid * 4;
        f32x4 acc0 = {0, 0, 0, 0}, acc1 = acc0, acc2 = acc0, acc3 = acc0;
#pragma unroll 8
        for (int k = 0; k < 64; ++k) { const f32x4 w = *(const f32x4*)(W + (size_t)k * 6144);
            acc0 += cond[k] * w; acc1 += cond[64 + k] * w; acc2 += cond[128 + k] * w; acc3 += cond[192 + k] * w; }
        float* macc = (float*)(ws + WS_MOD) + (size_t)l * 4 * 6144 + nc * 2048 + tid * 4;
#pragma unroll
        for (int i = 0; i < 4; ++i) { atomicAdd(macc + i, acc0[i]); atomicAdd(macc + 6144 + i, acc1[i]); atomicAdd(macc + 2 * 6144 + i, acc2[i]); atomicAdd(macc + 3 * 6144 + i, acc3[i]); }
        __syncthreads();
    }
    { LAS float* scr = (LAS float*)(lds + wave * 16384);
      const int gw = vcu * NWAVES + wave, NGW = G * NWAVES;
      constexpr int I_IN = 32 * (NIN / 32), I_OUT = 32 * 64, NITEMS = I_IN + I_OUT;
      for (int it = gw; it < NITEMS; it += NGW) {
          int r = it;
          if (r < I_IN) { p0_transpose_item(a.in[5], 2048, NIN, (bf16_t*)(ws + WS_WIN0), 0, scr, r, lane); continue; } r -= I_IN;
          p0_transpose_item(a.in[16], 2048, 2048, (bf16_t*)(ws + WS_WOUT0), 0, scr, r, lane);
      } }
}
__device__ __forceinline__ void late_transposes(const Args& a, LAS float* scr, int hw, int NHW, int lane) {
    unsigned char* ws = a.ws;
    constexpr int I_IN = 32 * (NIN / 32), I_OUT = 32 * 64, I_G = 32 * 8, NITEMS = I_IN + I_OUT + I_G;
    for (int it = hw; it < NITEMS; it += NHW) {
        int r = it;
        if (r < I_G) { const int mn = r >> 3, m = mn >> 3; const float* Wg = a.in[m == 0 ? 27 : m == 1 ? 29 : m == 2 ? 32 : 34] + (size_t)(mn & 7) * 128 * 128;
            p0_transpose_item(Wg, 128, 128, (bf16_t*)(ws + WS_WGT) + (size_t)mn * 128 * 128, 0, scr, r & 7, lane); continue; } r -= I_G;
        if (r < I_IN) { p0_transpose_item(a.in[17], 2048, NIN, (bf16_t*)(ws + WS_WIN1), 0, scr, r, lane); continue; } r -= I_IN;
        p0_transpose_item(a.in[37], 2048, 2048, (bf16_t*)(ws + WS_WOUT1), 0, scr, r, lane);
    }
}

__device__ __forceinline__ void normmod_phase(const Args& a, const float* xin, int layer, int gw, int NGW, int lane) {
    const float* nw = a.in[4] + layer * 2048; const float* bm = a.in[3] + layer * 6144;
    const float* macc = (const float*)(a.ws + WS_MOD) + (size_t)layer * 4 * 6144;
    bf16_t* H = (bf16_t*)(a.ws + WS_H);
    for (int m = gw; m < MTOK; m += NGW) {
        const int b = m >> 11;
        const f32x4* xr = (const f32x4*)(xin + (size_t)m * 2048) + lane;
        f32x4 v[8]; float s = 0.f;
#pragma unroll
        for (int j = 0; j < 8; ++j) { v[j] = xr[64 * j]; s += (v[j].x * v[j].x + v[j].y * v[j].y) + (v[j].z * v[j].z + v[j].w * v[j].w); }
        const float rstd = rsqrtf(group_sum<64>(s) * (1.f / 2048.f) + EPS);
#pragma unroll
        for (int j = 0; j < 8; ++j) { const int col = (64 * j + lane) * 4;
            const f32x4 w = *(const f32x4*)(nw + col);
            const f32x4 sh = *(const f32x4*)(macc + b * 6144 + col) + *(const f32x4*)(bm + col);
            const f32x4 sc = *(const f32x4*)(macc + b * 6144 + 2048 + col) + *(const f32x4*)(bm + 2048 + col);
            const f32x4 o = v[j] * rstd * w * (1.f + sc) + sh;
            v2u pk; pk.x = pk2(o.x, o.y); pk.y = pk2(o.z, o.w);
            *(v2u*)(H + (size_t)m * 2048 + col) = pk; }
    }
}

__device__ __forceinline__ void post0_phase(const Args& a, int gw, int NGW, int lane) {
    const bf16_t* P = (const bf16_t*)(a.ws + WS_PROJ);
    const float2* rope = (const float2*)(a.ws + WS_ROPE);
    const float* qn = a.in[6]; const float* kn = a.in[7]; const float* cw = a.in[8]; const float* cb = a.in[9];
    bf16_t* Q = (bf16_t*)(a.ws + WS_QB); bf16_t* K = (bf16_t*)(a.ws + WS_KB); bf16_t* V = (bf16_t*)(a.ws + WS_VB);
    float* ACT = (float*)(a.ws + WS_ACT);
    for (int m = gw; m < MTOK; m += NGW) {
        const int t = m & 2047, prow = t >> 6, pcol = t & 63;
        const bf16_t* pr = P + (size_t)m * NINP;
        {
            float x[16]; unpack8(*(const v4u*)(pr + A_Q + lane * 16), x); unpack8(*(const v4u*)(pr + A_Q + lane * 16 + 8), x + 8);
            float ss = 0.f;
#pragma unroll
            for (int i = 0; i < 16; ++i) ss += x[i] * x[i];
            ss = group_sum<8>(ss);
            const float r = rsqrtf(ss * (1.f / 128.f) + EPS);
            const int d0 = (lane & 7) * 16;
#pragma unroll
            for (int i = 0; i < 16; ++i) x[i] = x[i] * r * qn[d0 + i];
#pragma unroll
            for (int pi = 0; pi < 8; ++pi) { const int p = (d0 >> 1) + pi; const float2 cs = (p < 32) ? rope[prow * 32 + p] : rope[pcol * 32 + p - 32];
                const float x0 = x[2 * pi], x1 = x[2 * pi + 1]; x[2 * pi] = x0 * cs.x - x1 * cs.y; x[2 * pi + 1] = x0 * cs.y + x1 * cs.x; }
            *(v4u*)(Q + (size_t)m * 1024 + lane * 16) = pack8(x); *(v4u*)(Q + (size_t)m * 1024 + lane * 16 + 8) = pack8(x + 8);
        }
        {
            const v2u w = *(const v2u*)(pr + A_K + lane * 4);
            float x[4] = {__uint_as_float(w.x << 16), __uint_as_float(w.x & 0xffff0000u), __uint_as_float(w.y << 16), __uint_as_float(w.y & 0xffff0000u)};
            float ss = (x[0] * x[0] + x[1] * x[1]) + (x[2] * x[2] + x[3] * x[3]);
            ss = group_sum<32>(ss);
            const float r = rsqrtf(ss * (1.f / 128.f) + EPS);
            const int d0 = (lane & 31) * 4;
#pragma unroll
            for (int i = 0; i < 4; ++i) x[i] = x[i] * r * kn[d0 + i];
#pragma unroll
            for (int pi = 0; pi < 2; ++pi) { const int p = (d0 >> 1) + pi; const float2 cs = (p < 32) ? rope[prow * 32 + p] : rope[pcol * 32 + p - 32];
                const float x0 = x[2 * pi], x1 = x[2 * pi + 1]; x[2 * pi] = x0 * cs.x - x1 * cs.y; x[2 * pi + 1] = x0 * cs.y + x1 * cs.x; }
            v2u o; o.x = pk2(x[0], x[1]); o.y = pk2(x[2], x[3]);
            *(v2u*)(K + (size_t)m * 256 + lane * 4) = o;
            *(v2u*)(V + (size_t)m * 256 + lane * 4) = *(const v2u*)(pr + A_V + lane * 4);
        }
#pragma unroll
        for (int j = 0; j < 3; ++j) { const int ch = (j * 64 + lane) * 8;
            float acc[8];
            { const f32x4 b0 = *(const f32x4*)(cb + ch), b1 = *(const f32x4*)(cb + ch + 4); acc[0] = b0.x; acc[1] = b0.y; acc[2] = b0.z; acc[3] = b0.w; acc[4] = b1.x; acc[5] = b1.y; acc[6] = b1.z; acc[7] = b1.w; }
#pragma unroll
            for (int d = 0; d < 4; ++d) { const int ts = t + d - 2;
                if (ts >= 0 && ts < SEQ) { float x[8]; unpack8(*(const v4u*)(P + (size_t)(m + d - 2) * NINP + A_XS + ch), x);
                    const f32x4 w0 = *(const f32x4*)(cw + d * 1536 + ch), w1 = *(const f32x4*)(cw + d * 1536 + ch + 4);
                    acc[0] += w0.x * x[0]; acc[1] += w0.y * x[1]; acc[2] += w0.z * x[2]; acc[3] += w0.w * x[3];
                    acc[4] += w1.x * x[4]; acc[5] += w1.y * x[5]; acc[6] += w1.z * x[6]; acc[7] += w1.w * x[7]; } }
            f32x4 o0, o1; o0.x = silu_f(acc[0]); o0.y = silu_f(acc[1]); o0.z = silu_f(acc[2]); o0.w = silu_f(acc[3]); o1.x = silu_f(acc[4]); o1.y = silu_f(acc[5]); o1.z = silu_f(acc[6]); o1.w = silu_f(acc[7]);
            *(f32x4*)(ACT + (size_t)m * 1536 + ch) = o0; *(f32x4*)(ACT + (size_t)m * 1536 + ch + 4) = o1;
            { v4u w; w.x = pk2(o0.x, o0.y); w.y = pk2(o0.z, o0.w); w.z = pk2(o1.x, o1.y); w.w = pk2(o1.z, o1.w); *(v4u*)((bf16_t*)(a.ws + WS_XBC16) + (size_t)m * 1536 + ch) = w; } }
    }
}

typedef float f32x2 __attribute__((ext_vector_type(2)));
__device__ __forceinline__ void ssd_item(const Args& a, int item, float* lds) {
    const int ph = item & 1, h = (item >> 1) & 15, dir = (item >> 5) & 1, b = item >> 6, g = h >> 3;
    constexpr int BUF = 32 * 32 + 2 * 32 * 128 + 32;
    float* ysb = lds + 2 * BUF;
    const float A = -expf(a.in[dir ? 13 : 12][h]); const float dtb = a.in[dir ? 11 : 10][h];
    const float* ACT = (const float*)(a.ws + WS_ACT); const float* SM = (const float*)(a.ws + WS_SMALL);
    float* Y = (float*)(a.ws + (dir ? WS_YB : WS_YF));
    const int tid = threadIdx.x, p = tid >> 4, ng = tid & 15;
    f32x2 hst[4];
#pragma unroll
    for (int i = 0; i < 4; ++i) hst[i] = (f32x2){0.f, 0.f};
    f32x4 gB[2], gC[2], gx; float gdt;
#define SSD_LOAD(tile_) do { const size_t r0_ = (size_t)b * SEQ + (dir ? 63 - (tile_) : (tile_)) * 32; \
        _Pragma("unroll") for (int i = 0; i < 2; ++i) { const int idx = tid + i * 512, s_ = idx >> 5, c4_ = idx & 31, tl_ = dir ? 31 - s_ : s_; \
            gB[i] = *(const f32x4*)(ACT + (r0_ + tl_) * 1536 + 1024 + g * 128 + c4_ * 4); gC[i] = *(const f32x4*)(ACT + (r0_ + tl_) * 1536 + 1280 + g * 128 + c4_ * 4); } \
        if (tid < 256) { const int s_ = tid >> 3, c4_ = tid & 7, tl_ = dir ? 31 - s_ : s_; gx = *(const f32x4*)(ACT + (r0_ + tl_) * 1536 + h * 64 + ph * 32 + c4_ * 4); gdt = SM[(r0_ + tl_) * 32 + dir * 16 + h]; } } while (0)
#define SSD_STORE(buf_) do { float* xs_ = lds + (buf_) * BUF; float* Bs_ = xs_ + 32 * 32; float* Cs_ = Bs_ + 32 * 128; float* das_ = Cs_ + 32 * 128; \
        _Pragma("unroll") for (int i = 0; i < 2; ++i) { const int idx = tid + i * 512, s_ = idx >> 5, c4_ = idx & 31; const int so_ = s_ * 128 + (c4_ & 1) * 64 + (c4_ >> 1) * 4; \
            *(f32x4*)(Bs_ + so_) = gB[i]; *(f32x4*)(Cs_ + so_) = gC[i]; } \
        if (tid < 256) { const int s_ = tid >> 3, c4_ = tid & 7; const float dt_ = softplus_f(gdt + dtb); *(f32x4*)(xs_ + s_ * 32 + c4_ * 4) = gx * dt_; if (c4_ == 0) das_[s_] = expf(dt_ * A); } } while (0)
    __syncthreads();
    SSD_LOAD(0); SSD_STORE(0);
    __syncthreads();
    for (int tile = 0; tile < 64; ++tile) {
        const int cur = tile & 1;
        const size_t row0 = (size_t)b * SEQ + (dir ? 63 - tile : tile) * 32;
        if (tile + 1 < 64) SSD_LOAD(tile + 1);
        const float* xs = lds + cur * BUF; const float* Bs = xs + 32 * 32; const float* Cs = Bs + 32 * 128; const float* das = Cs + 32 * 128; float* ys = ysb + cur * 1024;
        {
            float n_dA = das[0], n_xdt = xs[p];
            f32x4 n_b0 = *(const f32x4*)(Bs + ng * 4), n_b1 = *(const f32x4*)(Bs + 64 + ng * 4), n_c0 = *(const f32x4*)(Cs + ng * 4), n_c1 = *(const f32x4*)(Cs + 64 + ng * 4);
#pragma unroll 4
            for (int s = 0; s < 32; ++s) {
                const float dA = n_dA, xdt = n_xdt; const f32x4 b0 = n_b0, b1 = n_b1, c0 = n_c0, c1 = n_c1;
                const int sn = (s + 1) & 31;
                n_dA = das[sn]; n_xdt = xs[sn * 32 + p];
                n_b0 = *(const f32x4*)(Bs + sn * 128 + ng * 4); n_b1 = *(const f32x4*)(Bs + sn * 128 + 64 + ng * 4);
                n_c0 = *(const f32x4*)(Cs + sn * 128 + ng * 4); n_c1 = *(const f32x4*)(Cs + sn * 128 + 64 + ng * 4);
                const f32x2 xd2 = (f32x2){xdt, xdt}, da2 = (f32x2){dA, dA};
                hst[0] = hst[0] * da2 + xd2 * (f32x2){b0.x, b0.y};
                hst[1] = hst[1] * da2 + xd2 * (f32x2){b0.z, b0.w};
                hst[2] = hst[2] * da2 + xd2 * (f32x2){b1.x, b1.y};
                hst[3] = hst[3] * da2 + xd2 * (f32x2){b1.z, b1.w};
                f32x2 acc = hst[0] * (f32x2){c0.x, c0.y};
                acc += hst[1] * (f32x2){c0.z, c0.w};
                acc += hst[2] * (f32x2){c1.x, c1.y};
                acc += hst[3] * (f32x2){c1.z, c1.w};
                const float part = group_sum<16>(acc.x + acc.y);
                if (ng == 0) ys[s * 32 + p] = part;
            }
        }
        if (tile + 1 < 64) SSD_STORE(cur ^ 1);
        __syncthreads();
        if (tid < 256) { const int s = tid >> 3, c4 = tid & 7, tl = dir ? 31 - s : s; *(f32x4*)(Y + (row0 + tl) * 1024 + h * 64 + ph * 32 + c4 * 4) = *(const f32x4*)(ys + s * 32 + c4 * 4); }
    }
#undef SSD_LOAD
#undef SSD_STORE
}

__device__ __forceinline__ void ssd_combine_phase(const Args& a, int gw, int NGW, int lane) {
    const float* YF = (const float*)(a.ws + WS_YF); const float* YB = (const float*)(a.ws + WS_YB); const float* ACT = (const float*)(a.ws + WS_ACT);
    const bf16_t* P = (const bf16_t*)(a.ws + WS_PROJ); bf16_t* YC = (bf16_t*)(a.ws + WS_YCAT);
    const float* dsk = a.in[14]; const float* nw = a.in[15];
    for (int m = gw; m < MTOK; m += NGW) {
        const int ch = lane * 16; const float dk = dsk[ch >> 6];
        float z[16], gv[16]; unpack8(*(const v4u*)(P + (size_t)m * NINP + A_Z + ch), z); unpack8(*(const v4u*)(P + (size_t)m * NINP + A_Z + ch + 8), z + 8);
        float ss = 0.f;
#pragma unroll
        for (int q = 0; q < 4; ++q) { const f32x4 f = *(const f32x4*)(YF + (size_t)m * 1024 + ch + 4 * q), bk = *(const f32x4*)(YB + (size_t)m * 1024 + ch + 4 * q), xv = *(const f32x4*)(ACT + (size_t)m * 1536 + ch + 4 * q);
            const f32x4 y = f + bk + dk * xv;
            gv[4 * q] = y.x * silu_f(z[4 * q]); gv[4 * q + 1] = y.y * silu_f(z[4 * q + 1]); gv[4 * q + 2] = y.z * silu_f(z[4 * q + 2]); gv[4 * q + 3] = y.w * silu_f(z[4 * q + 3]); }
#pragma unroll
        for (int i = 0; i < 16; ++i) ss += gv[i] * gv[i];
        const float r = rsqrtf(group_sum<64>(ss) * (1.f / 1024.f) + EPS);
#pragma unroll
        for (int i = 0; i < 16; ++i) gv[i] = gv[i] * r * nw[ch + i];
        *(v4u*)(YC + (size_t)m * 2048 + 1024 + ch) = pack8(gv); *(v4u*)(YC + (size_t)m * 2048 + 1024 + ch + 8) = pack8(gv + 8);
    }
}

__device__ __forceinline__ void post1_phase(const Args& a, int gw, int NGW, int lane) {
    const bf16_t* P = (const bf16_t*)(a.ws + WS_PROJ); const float* cw = a.in[18]; const float* cb = a.in[19];
    float* ACT = (float*)(a.ws + WS_ACT);
    for (int m = gw; m < MTOK; m += NGW) {
        const int t = m & 2047;
#pragma unroll
        for (int j = 0; j < 4; ++j) { const int ch = (j * 64 + lane) * 8;
            float acc[8];
            { const f32x4 b0 = *(const f32x4*)(cb + ch), b1 = *(const f32x4*)(cb + ch + 4); acc[0] = b0.x; acc[1] = b0.y; acc[2] = b0.z; acc[3] = b0.w; acc[4] = b1.x; acc[5] = b1.y; acc[6] = b1.z; acc[7] = b1.w; }
#pragma unroll
            for (int d = 0; d < 4; ++d) { const int ts = t + d - 2;
                if (ts >= 0 && ts < SEQ) { float x[8]; unpack8(*(const v4u*)(P + (size_t)(m + d - 2) * NINP + C_Q + ch), x);
                    const f32x4 w0 = *(const f32x4*)(cw + d * 2048 + ch), w1 = *(const f32x4*)(cw + d * 2048 + ch + 4);
                    acc[0] += w0.x * x[0]; acc[1] += w0.y * x[1]; acc[2] += w0.z * x[2]; acc[3] += w0.w * x[3];
                    acc[4] += w1.x * x[4]; acc[5] += w1.y * x[5]; acc[6] += w1.z * x[6]; acc[7] += w1.w * x[7]; } }
#pragma unroll
            for (int i = 0; i < 8; ++i) acc[i] = silu_f(acc[i]);
            if (j < 2) {
                float ss = 0.f;
#pragma unroll
                for (int i = 0; i < 8; ++i) ss += acc[i] * acc[i];
                ss = group_sum<16>(ss);
                float r = rsqrtf(ss + EPS); if (j == 0) r *= 0.088388347648318440f;
#pragma unroll
                for (int i = 0; i < 8; ++i) acc[i] *= r;
            }
            *(f32x4*)(ACT + (size_t)m * 2048 + ch) = (f32x4){acc[0], acc[1], acc[2], acc[3]}; *(f32x4*)(ACT + (size_t)m * 2048 + ch + 4) = (f32x4){acc[4], acc[5], acc[6], acc[7]};
            *(v4u*)((bf16_t*)(a.ws + WS_QKV16) + (size_t)m * 2048 + ch) = pack8(acc); }
    }
}

__device__ __forceinline__ void gdn_item(const Args& a, int item, float* lds) {
    const int dvs = item & 3, hv = (item >> 2) & 7, dir = (item >> 5) & 1, b = item >> 6, hq = hv >> 1;
    constexpr int BUF = 2 * 32 * 128 + 32 * 32 + 32 * 4;
    float* osb = lds + 2 * BUF;
    const float Aneg = -expf(a.in[dir ? 21 : 20][hv]); const float dtb = a.in[dir ? 23 : 22][hv];
    const float* ACT = (const float*)(a.ws + WS_ACT); const float* SM = (const float*)(a.ws + WS_SMALL);
    float* O = (float*)(a.ws + (dir ? WS_YB : WS_YF));
    const int tid = threadIdx.x, lane = tid & 63, wave = tid >> 6, dkg = lane & 15, dvi = wave * 4 + (lane >> 4);
    f32x2 S[4];
#pragma unroll
    for (int i = 0; i < 4; ++i) S[i] = (f32x2){0.f, 0.f};
    f32x4 gk0, gk1, gq0, gq1, gv; float gbr = 0.f, gar = 0.f;
#define GDN_LOAD(tile_) do { const size_t r0_ = (size_t)b * SEQ + (dir ? 63 - (tile_) : (tile_)) * 32; \
        { const int s_ = tid >> 4, c8_ = tid & 15, tl_ = dir ? 31 - s_ : s_; const float* kp_ = ACT + (r0_ + tl_) * 2048 + 512 + hq * 128 + c8_ * 8; const float* qp_ = ACT + (r0_ + tl_) * 2048 + hq * 128 + c8_ * 8; \
          gk0 = *(const f32x4*)kp_; gk1 = *(const f32x4*)(kp_ + 4); gq0 = *(const f32x4*)qp_; gq1 = *(const f32x4*)(qp_ + 4); \
          if (c8_ == 0) { const float* sm_ = SM + (r0_ + tl_) * 32; gbr = sm_[dir * 8 + hv]; gar = sm_[16 + dir * 8 + hv]; } } \
        if (tid < 256) { const int s2_ = tid >> 3, c4_ = tid & 7, tl2_ = dir ? 31 - s2_ : s2_; gv = *(const f32x4*)(ACT + (r0_ + tl2_) * 2048 + 1024 + hv * 128 + dvs * 32 + c4_ * 4); } } while (0)
#define GDN_STORE(buf_) do { float* ks_ = lds + (buf_) * BUF; float* qs_ = ks_ + 32 * 128; float* vs_ = qs_ + 32 * 128; float* sc_ = vs_ + 32 * 32; \
        { const int s_ = tid >> 4, c8_ = tid & 15; \
          *(f32x4*)(ks_ + s_ * 128 + c8_ * 4) = gk0; *(f32x4*)(ks_ + s_ * 128 + 64 + c8_ * 4) = gk1; *(f32x4*)(qs_ + s_ * 128 + c8_ * 4) = gq0; *(f32x4*)(qs_ + s_ * 128 + 64 + c8_ * 4) = gq1; \
          float kq_ = (gk0.x * gq0.x + gk0.y * gq0.y) + (gk0.z * gq0.z + gk0.w * gq0.w) + (gk1.x * gq1.x + gk1.y * gq1.y) + (gk1.z * gq1.z + gk1.w * gq1.w); \
          kq_ = group_sum<16>(kq_); \
          if (c8_ == 0) { const float beta_ = sigmoid_f(gbr), alpha_ = expf(Aneg * softplus_f(gar + dtb)); *(f32x4*)(sc_ + s_ * 4) = (f32x4){alpha_, beta_, kq_, alpha_ * beta_}; } } \
        if (tid < 256) { const int s2_ = tid >> 3, c4_ = tid & 7; *(f32x4*)(vs_ + s2_ * 32 + c4_ * 4) = gv; } } while (0)
    __syncthreads();
    GDN_LOAD(0); GDN_STORE(0);
    __syncthreads();
    for (int tile = 0; tile < 64; ++tile) {
        const int cur = tile & 1;
        const size_t row0 = (size_t)b * SEQ + (dir ? 63 - tile : tile) * 32;
        if (tile + 1 < 64) GDN_LOAD(tile + 1);
        const float* ks = lds + cur * BUF; const float* qs = ks + 32 * 128; const float* vs = qs + 32 * 128; const float* sc = vs + 32 * 32; float* os = osb + cur * 1024;
        {
            f32x4 n_k0 = *(const f32x4*)(ks + dkg * 4), n_k1 = *(const f32x4*)(ks + 64 + dkg * 4), n_q0 = *(const f32x4*)(qs + dkg * 4), n_q1 = *(const f32x4*)(qs + 64 + dkg * 4);
            f32x4 n_sc = *(const f32x4*)(sc); float n_vv = vs[dvi];
#pragma unroll 4
            for (int s = 0; s < 32; ++s) {
                const f32x4 k0 = n_k0, k1 = n_k1, q0 = n_q0, q1 = n_q1, scv = n_sc; const float vv = n_vv;
                const int sn = (s + 1) & 31;
                n_k0 = *(const f32x4*)(ks + sn * 128 + dkg * 4); n_k1 = *(const f32x4*)(ks + sn * 128 + 64 + dkg * 4);
                n_q0 = *(const f32x4*)(qs + sn * 128 + dkg * 4); n_q1 = *(const f32x4*)(qs + sn * 128 + 64 + dkg * 4);
                n_sc = *(const f32x4*)(sc + sn * 4); n_vv = vs[sn * 32 + dvi];
                const f32x2 ka = (f32x2){k0.x, k0.y}, kb = (f32x2){k0.z, k0.w}, kc = (f32x2){k1.x, k1.y}, kd = (f32x2){k1.z, k1.w};
                f32x2 pk = ka * S[0]; pk += kb * S[1]; pk += kc * S[2]; pk += kd * S[3];
                f32x2 pq = (f32x2){q0.x, q0.y} * S[0]; pq += (f32x2){q0.z, q0.w} * S[1]; pq += (f32x2){q1.x, q1.y} * S[2]; pq += (f32x2){q1.z, q1.w} * S[3];
                float sk = pk.x + pk.y, sq = pq.x + pq.y;
                sk += dpp_mov<0xB1>(sk); sq += dpp_mov<0xB1>(sq);
                sk += dpp_mov<0x4E>(sk); sq += dpp_mov<0x4E>(sq);
                sk += dpp_mov<0x141>(sk); sq += dpp_mov<0x141>(sq);
                sk += dpp_mov<0x140>(sk); sq += dpp_mov<0x140>(sq);
                const float alpha = scv.x, vn = fmaf(-scv.w, sk, scv.y * vv);
                const float po = fmaf(alpha, sq, scv.z * vn);
                const f32x2 al2 = (f32x2){alpha, alpha}, vn2 = (f32x2){vn, vn};
                S[0] = S[0] * al2 + ka * vn2; S[1] = S[1] * al2 + kb * vn2; S[2] = S[2] * al2 + kc * vn2; S[3] = S[3] * al2 + kd * vn2;
                if (dkg == 0) os[s * 32 + dvi] = po;
            }
        }
        if (tile + 1 < 64) GDN_STORE(cur ^ 1);
        __syncthreads();
        if (tid < 256) { const int s2 = tid >> 3, c4 = tid & 7, tl2 = dir ? 31 - s2 : s2; *(f32x4*)(O + (row0 + tl2) * 1024 + hv * 128 + dvs * 32 + c4 * 4) = *(const f32x4*)(os + s2 * 32 + c4 * 4); }
    }
#undef GDN_LOAD
#undef GDN_STORE
}

typedef short s16x4_t __attribute__((ext_vector_type(4)));
typedef __bf16 bf16x2_v __attribute__((ext_vector_type(2)));
__device__ __forceinline__ unsigned cvtpk_rne(float lo, float hi) { f32x2 v = {lo, hi}; bf16x2_v bb = __builtin_convertvector(v, bf16x2_v); return __builtin_bit_cast(unsigned, bb); }
template <int S_> __device__ __forceinline__ bf16x8_t acc_frag(const f32x16_t& x) {
    v4u w; w.x = cvtpk_rne(x[8 * S_ + 0], x[8 * S_ + 1]); w.y = cvtpk_rne(x[8 * S_ + 2], x[8 * S_ + 3]); w.z = cvtpk_rne(x[8 * S_ + 4], x[8 * S_ + 5]); w.w = cvtpk_rne(x[8 * S_ + 6], x[8 * S_ + 7]);
    return __builtin_bit_cast(bf16x8_t, w);
}
__device__ __forceinline__ bf16x8_t join44(v2u lo, v2u hi) { v4u w; w.x = lo.x; w.y = lo.y; w.z = hi.x; w.w = hi.y; return __builtin_bit_cast(bf16x8_t, w); }
__device__ __forceinline__ float wave_incl_scan(float v, int lane) {
#pragma unroll
    for (int o = 1; o < 64; o <<= 1) { const float t = __shfl_up(v, o); if (lane >= o) v += t; }
    return v;
}
constexpr int GDN_LDS_PER_WAVE = 17920;
__device__ __forceinline__ void gdn1_item(const Args& a, int item, unsigned char* ldsw, int lane) {
    asm volatile("" : "+v"(lane));
    const int c = item & 31, dir = (item >> 5) & 1, hv = (item >> 6) & 7, b = item >> 9, hq = hv >> 1;
    const int r32 = lane & 31, hi = lane >> 5;
    float* AT = (float*)ldsw; float* Gs = AT + 64 * 64; float* Bs = Gs + 64;
    const bf16_t* QK = (const bf16_t*)(a.ws + WS_QKV16); const float* SM = (const float*)(a.ws + WS_SMALL);
    bf16_t* GT = (bf16_t*)(a.ws + WS_GT) + (size_t)item * 4096; bf16_t* GA = (bf16_t*)(a.ws + WS_GA) + (size_t)item * 4096;
    const float Aneg = -expf(a.in[dir ? 21 : 20][hv]); const float dtb = a.in[dir ? 23 : 22][hv];
    {
        const int t = dir ? SEQ - 1 - (64 * c + lane) : 64 * c + lane; const float* sm = SM + ((size_t)b * SEQ + t) * 32;
        const float gi = Aneg * softplus_f(sm[16 + dir * 8 + hv] + dtb), bi = sigmoid_f(sm[dir * 8 + hv]);
        Gs[lane] = wave_incl_scan(gi, lane); Bs[lane] = bi;
    }
    const int t0r = dir ? SEQ - 1 - (64 * c + r32) : 64 * c + r32, t1r = dir ? t0r - 32 : t0r + 32;
    const bf16_t* k0p = QK + ((size_t)b * SEQ + t0r) * 2048 + 512 + hq * 128 + hi * 8; const bf16_t* k1p = QK + ((size_t)b * SEQ + t1r) * 2048 + 512 + hq * 128 + hi * 8;
    const bf16_t* q0p = k0p - 512, * q1p = k1p - 512;
    LDS_WAIT();
    const float Gj0 = Gs[r32], Gj1 = Gs[32 + r32];
    {
        f32x16_t kk00, kk10, kk11;
#pragma unroll
        for (int r = 0; r < 16; ++r) { kk00[r] = 0.f; kk10[r] = 0.f; kk11[r] = 0.f; }
#pragma unroll
        for (int s = 0; s < 8; ++s) {
            const bf16x8_t kA0 = *(const bf16x8_t*)(k0p + 16 * s), kA1 = *(const bf16x8_t*)(k1p + 16 * s);
            kk00 = __builtin_amdgcn_mfma_f32_32x32x16_bf16(kA0, kA0, kk00, 0, 0, 0); kk10 = __builtin_amdgcn_mfma_f32_32x32x16_bf16(kA1, kA0, kk10, 0, 0, 0); kk11 = __builtin_amdgcn_mfma_f32_32x32x16_bf16(kA1, kA1, kk11, 0, 0, 0);
        }
#pragma unroll
        for (int r = 0; r < 16; ++r) { const int il = (r & 3) + 8 * (r >> 2) + 4 * hi;
            const float Gi0 = Gs[il], Gi1 = Gs[32 + il], bi0 = Bs[il], bi1 = Bs[32 + il];
            AT[r32 * 64 + il] = (r32 < il) ? bi0 * kk00[r] * expf(Gi0 - Gj0) : 0.f;
            AT[r32 * 64 + 32 + il] = bi1 * kk10[r] * expf(Gi1 - Gj0);
            AT[(32 + r32) * 64 + 32 + il] = (r32 < il) ? bi1 * kk11[r] * expf(Gi1 - Gj1) : 0.f;
            AT[(32 + r32) * 64 + il] = 0.f;
        }
    }
    asm volatile("" ::: "memory");
    {
        f32x16_t qk00, qk10, qk11;
#pragma unroll
        for (int r = 0; r < 16; ++r) { qk00[r] = 0.f; qk10[r] = 0.f; qk11[r] = 0.f; }
#pragma unroll
        for (int s = 0; s < 8; ++s) {
            const bf16x8_t kA0 = *(const bf16x8_t*)(k0p + 16 * s), kA1 = *(const bf16x8_t*)(k1p + 16 * s), qA0 = *(const bf16x8_t*)(q0p + 16 * s), qA1 = *(const bf16x8_t*)(q1p + 16 * s);
            qk00 = __builtin_amdgcn_mfma_f32_32x32x16_bf16(qA0, kA0, qk00, 0, 0, 0); qk10 = __builtin_amdgcn_mfma_f32_32x32x16_bf16(qA1, kA0, qk10, 0, 0, 0); qk11 = __builtin_amdgcn_mfma_f32_32x32x16_bf16(qA1, kA1, qk11, 0, 0, 0);
        }
#pragma unroll
        for (int r = 0; r < 16; ++r) { const int il = (r & 3) + 8 * (r >> 2) + 4 * hi;
            const float Gi0 = Gs[il], Gi1 = Gs[32 + il];
            GA[il * 64 + r32] = (bf16_t)f2bf((r32 <= il) ? qk00[r] * expf(Gi0 - Gj0) : 0.f);
            GA[(32 + il) * 64 + r32] = (bf16_t)f2bf(qk10[r] * expf(Gi1 - Gj0));
            GA[(32 + il) * 64 + 32 + r32] = (bf16_t)f2bf((r32 <= il) ? qk11[r] * expf(Gi1 - Gj1) : 0.f);
        }
    }
    LDS_WAIT(); asm volatile("" ::: "memory");
    float tr[64];
    int lane2 = lane; asm volatile("" : "+v"(lane2) :: "memory");
#pragma unroll
    for (int j = 0; j < 64; ++j) tr[j] = (j == lane2) ? 1.f : 0.f;
    int atoff = 0;
#pragma unroll
    for (int j = 62; j >= 0; --j) { float c0 = 0.f, c1 = 0.f, c2 = 0.f, c3 = 0.f;
        asm volatile("" : "+v"(atoff) : "v"(tr[j + 1]));
#pragma unroll
        for (int qd = (j + 1) / 4; qd < 16; ++qd) { const f32x4 av = *(const f32x4*)(AT + atoff + j * 64 + 4 * qd);
            if (4 * qd + 0 > j) c0 = fmaf(tr[4 * qd + 0], av.x, c0);
            if (4 * qd + 1 > j) c1 = fmaf(tr[4 * qd + 1], av.y, c1);
            if (4 * qd + 2 > j) c2 = fmaf(tr[4 * qd + 2], av.z, c2);
            if (4 * qd + 3 > j) c3 = fmaf(tr[4 * qd + 3], av.w, c3); }
        tr[j] -= (c0 + c1) + (c2 + c3); asm volatile("" ::: "memory"); }
#pragma unroll
    for (int x = 0; x < 8; ++x) *(v4u*)(GT + lane2 * 64 + x * 8) = pack8(tr + x * 8);
    LDS_WAIT();
}

__device__ __forceinline__ void gdn2_item(const Args& a, int item, unsigned char* lds) {
    const int dvs = item & 3, hv = (item >> 2) & 7, dir = (item >> 5) & 1, b = item >> 6, hq = hv >> 1;
    const int lane0 = threadIdx.x & 63;
    constexpr int BUFB = 57344, O_K = 0, O_Q = 16384, O_T = 32768, O_A = 40960, O_V = 49152;
    float* Gs = (float*)(lds + 2 * BUFB); float* Bs = Gs + 64; float* Es = Bs + 64; float* Ws = Es + 64; float* ot = Ws + 64;
    const LAS unsigned char* ldl = (const LAS unsigned char*)lds;
    const bf16_t* QK = (const bf16_t*)(a.ws + WS_QKV16); const float* ACT = (const float*)(a.ws + WS_ACT); const float* SM = (const float*)(a.ws + WS_SMALL);
    float* O = (float*)(a.ws + (dir ? WS_YB : WS_YF));
    const float Aneg = -expf(a.in[dir ? 21 : 20][hv]); const float dtb = a.in[dir ? 23 : 22][hv];
    const size_t gbase = (size_t)(((b * 8 + hv) * 2 + dir) * 32) * 4096;
    f32x16_t S[4];
#pragma unroll
    for (int nt = 0; nt < 4; ++nt)
#pragma unroll
        for (int r = 0; r < 16; ++r) S[nt][r] = 0.f;
    float gar, gbr;
#define G2_DMA(c_, buf_) do { const int t_ = dir ? SEQ - 1 - (64 * (c_) + lane0) : 64 * (c_) + lane0; const size_t mi_ = (size_t)b * SEQ + t_; \
        const bf16_t* kr_ = QK + mi_ * 2048 + 512 + hq * 128; const bf16_t* qr_ = QK + mi_ * 2048 + hq * 128; \
        const bf16_t* tr_ = (const bf16_t*)(a.ws + WS_GT) + gbase + (size_t)(c_) * 4096 + lane0 * 64; const bf16_t* ar_ = (const bf16_t*)(a.ws + WS_GA) + gbase + (size_t)(c_) * 4096 + lane0 * 64; \
        const float* vr_ = ACT + mi_ * 2048 + 1024 + hv * 128 + dvs * 32; \
        LAS unsigned char* lb_ = (LAS unsigned char*)lds + (buf_) * BUFB; \
        _Pragma("unroll") for (int x = 0; x < 16; ++x) { __builtin_amdgcn_global_load_lds((const unsigned*)(kr_ + 8 * x), (LAS unsigned*)(lb_ + O_K + 1024 * x), 16, 0, 0); \
                                                         __builtin_amdgcn_global_load_lds((const unsigned*)(qr_ + 8 * x), (LAS unsigned*)(lb_ + O_Q + 1024 * x), 16, 0, 0); } \
        _Pragma("unroll") for (int x = 0; x < 8; ++x) { __builtin_amdgcn_global_load_lds((const unsigned*)(tr_ + 8 * x), (LAS unsigned*)(lb_ + O_T + 1024 * x), 16, 0, 0); \
                                                        __builtin_amdgcn_global_load_lds((const unsigned*)(ar_ + 8 * x), (LAS unsigned*)(lb_ + O_A + 1024 * x), 16, 0, 0); \
                                                        __builtin_amdgcn_global_load_lds((const unsigned*)(vr_ + 4 * x), (LAS unsigned*)(lb_ + O_V + 1024 * x), 16, 0, 0); } \
        const float* sm_ = SM + mi_ * 32; gar = sm_[16 + dir * 8 + hv]; gbr = sm_[dir * 8 + hv]; } while (0)
    G2_DMA(0, 0);
    for (int c = 0; c < 32; ++c) {
        int lane = lane0; asm volatile("" : "+v"(lane));
        const int r32 = lane & 31, hi = lane >> 5, trq = (lane & 15) >> 2, trp = lane & 3, trc = (lane >> 4) & 1;
        const int bo = (c & 1) * BUFB;
        float GL;
        {
            const float gi = Aneg * softplus_f(gar + dtb), bi = sigmoid_f(gbr);
            const float G = wave_incl_scan(gi, lane); GL = __shfl(G, 63);
            Gs[lane] = G; Bs[lane] = bi; Es[lane] = __expf(G); Ws[lane] = __expf(GL - G);
        }
        asm volatile("s_waitcnt vmcnt(0)" ::: "memory");
        if (c + 1 < 32) G2_DMA(c + 1, (c + 1) & 1);
        LDS_WAIT();
        f32x16_t KS[2];
#pragma unroll
        for (int rt = 0; rt < 2; ++rt)
#pragma unroll
            for (int r = 0; r < 16; ++r) KS[rt][r] = 0.f;
#define LFRAG(off_) join44(*(const LAS v2u*)(ldl + (off_)), *(const LAS v2u*)(ldl + (off_) + 1024))
#pragma unroll
        for (int nt = 0; nt < 4; ++nt) {
            const bf16x8_t sb0 = acc_frag<0>(S[nt]), sb1 = acc_frag<1>(S[nt]);
#pragma unroll
            for (int rt = 0; rt < 2; ++rt) {
                const int ro = bo + O_K + ((4 * nt) * 64 + 32 * rt + r32) * 16 + 8 * hi;
                KS[rt] = __builtin_amdgcn_mfma_f32_32x32x16_bf16(LFRAG(ro), sb0, KS[rt], 0, 0, 0); KS[rt] = __builtin_amdgcn_mfma_f32_32x32x16_bf16(LFRAG(ro + 2048), sb1, KS[rt], 0, 0, 0);
            }
        }
        asm volatile("" ::: "memory");
        f32x16_t rhs[2];
#pragma unroll
        for (int rt = 0; rt < 2; ++rt)
#pragma unroll
            for (int r = 0; r < 16; ++r) { const int i = 32 * rt + (r & 3) + 8 * (r >> 2) + 4 * hi;
                const float vv = *(const LAS float*)(ldl + bo + O_V + ((r32 >> 2) * 64 + i) * 16 + (r32 & 3) * 4); const float bi = Bs[i];
                rhs[rt][r] = bi * vv - bi * Es[i] * KS[rt][r]; }
        asm volatile("" ::: "memory");
        f32x16_t vn[2];
#pragma unroll
        for (int r = 0; r < 16; ++r) { vn[0][r] = 0.f; vn[1][r] = 0.f; }
        {
            const bf16x8_t rb00 = acc_frag<0>(rhs[0]), rb01 = acc_frag<1>(rhs[0]), rb10 = acc_frag<0>(rhs[1]), rb11 = acc_frag<1>(rhs[1]);
            const int t0 = bo + O_T + r32 * 16 + 8 * hi, t1 = t0 + 512;
            vn[0] = __builtin_amdgcn_mfma_f32_32x32x16_bf16(LFRAG(t0), rb00, vn[0], 0, 0, 0); vn[0] = __builtin_amdgcn_mfma_f32_32x32x16_bf16(LFRAG(t0 + 2048), rb01, vn[0], 0, 0, 0);
            vn[1] = __builtin_amdgcn_mfma_f32_32x32x16_bf16(LFRAG(t1), rb00, vn[1], 0, 0, 0); vn[1] = __builtin_amdgcn_mfma_f32_32x32x16_bf16(LFRAG(t1 + 2048), rb01, vn[1], 0, 0, 0);
            vn[1] = __builtin_amdgcn_mfma_f32_32x32x16_bf16(LFRAG(t1 + 4096), rb10, vn[1], 0, 0, 0); vn[1] = __builtin_amdgcn_mfma_f32_32x32x16_bf16(LFRAG(t1 + 6144), rb11, vn[1], 0, 0, 0);
        }
        asm volatile("" ::: "memory");
        f32x16_t QS[2];
#pragma unroll
        for (int rt = 0; rt < 2; ++rt)
#pragma unroll
            for (int r = 0; r < 16; ++r) QS[rt][r] = 0.f;
#pragma unroll
        for (int nt = 0; nt < 4; ++nt) {
            const bf16x8_t sb0 = acc_frag<0>(S[nt]), sb1 = acc_frag<1>(S[nt]);
#pragma unroll
            for (int rt = 0; rt < 2; ++rt) {
                const int ro = bo + O_Q + ((4 * nt) * 64 + 32 * rt + r32) * 16 + 8 * hi;
                QS[rt] = __builtin_amdgcn_mfma_f32_32x32x16_bf16(LFRAG(ro), sb0, QS[rt], 0, 0, 0); QS[rt] = __builtin_amdgcn_mfma_f32_32x32x16_bf16(LFRAG(ro + 2048), sb1, QS[rt], 0, 0, 0);
            }
        }
        asm volatile("" ::: "memory");
        {
            const bf16x8_t vb00 = acc_frag<0>(vn[0]), vb01 = acc_frag<1>(vn[0]), vb10 = acc_frag<0>(vn[1]), vb11 = acc_frag<1>(vn[1]);
            const int a0 = bo + O_A + r32 * 16 + 8 * hi, a1 = a0 + 512;
            f32x16_t o0, o1;
#pragma unroll
            for (int r = 0; r < 16; ++r) { const int il = (r & 3) + 8 * (r >> 2) + 4 * hi; o0[r] = Es[il] * QS[0][r]; o1[r] = Es[32 + il] * QS[1][r]; }
            o0 = __builtin_amdgcn_mfma_f32_32x32x16_bf16(LFRAG(a0), vb00, o0, 0, 0, 0); o0 = __builtin_amdgcn_mfma_f32_32x32x16_bf16(LFRAG(a0 + 2048), vb01, o0, 0, 0, 0);
            o1 = __builtin_amdgcn_mfma_f32_32x32x16_bf16(LFRAG(a1), vb00, o1, 0, 0, 0); o1 = __builtin_amdgcn_mfma_f32_32x32x16_bf16(LFRAG(a1 + 2048), vb01, o1, 0, 0, 0);
            o1 = __builtin_amdgcn_mfma_f32_32x32x16_bf16(LFRAG(a1 + 4096), vb10, o1, 0, 0, 0); o1 = __builtin_amdgcn_mfma_f32_32x32x16_bf16(LFRAG(a1 + 6144), vb11, o1, 0, 0, 0);
#pragma unroll
            for (int r = 0; r < 16; ++r) { const int il = (r & 3) + 8 * (r >> 2) + 4 * hi; ot[il * 33 + r32] = o0[r]; ot[(32 + il) * 33 + r32] = o1[r]; }
            LDS_WAIT();
            { const int t = dir ? SEQ - 1 - (64 * c + lane) : 64 * c + lane; float* orow = O + ((size_t)b * SEQ + t) * 1024 + hv * 128 + dvs * 32;
#pragma unroll
              for (int x = 0; x < 8; ++x) *(f32x4*)(orow + 4 * x) = (f32x4){ot[lane * 33 + 4 * x], ot[lane * 33 + 4 * x + 1], ot[lane * 33 + 4 * x + 2], ot[lane * 33 + 4 * x + 3]}; }
        }
        asm volatile("" ::: "memory");
        {
#pragma unroll
            for (int r = 0; r < 16; ++r) { const int il = (r & 3) + 8 * (r >> 2) + 4 * hi; vn[0][r] *= Ws[il]; vn[1][r] *= Ws[32 + il]; }
            const bf16x8_t wb[4] = {acc_frag<0>(vn[0]), acc_frag<1>(vn[0]), acc_frag<0>(vn[1]), acc_frag<1>(vn[1])};
            const float eGL = __expf(GL);
#pragma unroll
            for (int nt = 0; nt < 4; ++nt) {
#pragma unroll
                for (int r = 0; r < 16; ++r) S[nt][r] *= eGL;
#pragma unroll
                for (int ks = 0; ks < 4; ++ks) {
                    const int ro = bo + O_K + ((4 * nt + 2 * trc + (trp >> 1)) * 64 + 16 * ks + 4 * hi + trq) * 16 + 8 * (trp & 1);
                    const s16x4_t lo = __builtin_bit_cast(s16x4_t, __builtin_amdgcn_ds_read_tr16_b64_v4i16((LAS s16x4_t*)(ldl + ro)));
                    const s16x4_t hi4 = __builtin_bit_cast(s16x4_t, __builtin_amdgcn_ds_read_tr16_b64_v4i16((LAS s16x4_t*)(ldl + ro + 8 * 16)));
                    const bf16x8_t kf = (bf16x8_t){lo[0], lo[1], lo[2], lo[3], hi4[0], hi4[1], hi4[2], hi4[3]};
                    S[nt] = __builtin_amdgcn_mfma_f32_32x32x16_bf16(kf, wb[ks], S[nt], 0, 0, 0);
                }
            }
        }
        LDS_WAIT();
    }
#undef LFRAG
#undef G2_DMA
}

__device__ __forceinline__ void ssd2_item(const Args& a, int item, unsigned char* lds) {
    const int ps = item & 1, h = (item >> 1) & 15, dir = (item >> 5) & 1, b = item >> 6, g = h >> 3;
    const int lane0 = threadIdx.x & 63;
    constexpr int BUFB = 40960, O_B = 0, O_C = 16384, O_X = 32768, O_XD = 2 * BUFB + 512, O_XW = O_XD + 64 * 72;
    float* Gs = (float*)(lds + 2 * BUFB); float* Es = Gs + 64; float* ot = (float*)(lds + O_XW + 64 * 72);
    const LAS unsigned char* ldl = (const LAS unsigned char*)lds;
    const bf16_t* XB = (const bf16_t*)(a.ws + WS_XBC16); const float* ACT = (const float*)(a.ws + WS_ACT); const float* SM = (const float*)(a.ws + WS_SMALL);
    float* Y = (float*)(a.ws + (dir ? WS_YB : WS_YF));
    const float A = -expf(a.in[dir ? 13 : 12][h]); const float dtb = a.in[dir ? 11 : 10][h];
    f32x16_t H[4];
#pragma unroll
    for (int nt = 0; nt < 4; ++nt)
#pragma unroll
        for (int r = 0; r < 16; ++r) H[nt][r] = 0.f;
    float gdr;
#define S2_DMA(c_, buf_) do { const int t_ = dir ? SEQ - 1 - (64 * (c_) + lane0) : 64 * (c_) + lane0; const size_t mi_ = (size_t)b * SEQ + t_; \
        const bf16_t* br_ = XB + mi_ * 1536 + 1024 + g * 128; const bf16_t* cr_ = XB + mi_ * 1536 + 1280 + g * 128; const float* xr_ = ACT + mi_ * 1536 + h * 64 + ps * 32; \
        LAS unsigned char* lb_ = (LAS unsigned char*)lds + (buf_) * BUFB; \
        _Pragma("unroll") for (int x = 0; x < 16; ++x) { __builtin_amdgcn_global_load_lds((const unsigned*)(br_ + 8 * x), (LAS unsigned*)(lb_ + O_B + 1024 * x), 16, 0, 0); \
                                                         __builtin_amdgcn_global_load_lds((const unsigned*)(cr_ + 8 * x), (LAS unsigned*)(lb_ + O_C + 1024 * x), 16, 0, 0); } \
        _Pragma("unroll") for (int x = 0; x < 8; ++x) __builtin_amdgcn_global_load_lds((const unsigned*)(xr_ + 4 * x), (LAS unsigned*)(lb_ + O_X + 1024 * x), 16, 0, 0); \
        gdr = SM[mi_ * 32 + dir * 16 + h]; } while (0)
    S2_DMA(0, 0);
    for (int c = 0; c < 32; ++c) {
        int lane = lane0; asm volatile("" : "+v"(lane));
        const int r32 = lane & 31, hi = lane >> 5, trq = (lane & 15) >> 2, trp = lane & 3, trc = (lane >> 4) & 1;
        const int bo = (c & 1) * BUFB;
        const float dt = softplus_f(gdr + dtb);
        const float cs = wave_incl_scan(dt * A, lane); const float csL = __shfl(cs, 63);
        Gs[lane] = cs; Es[lane] = __expf(cs);
        asm volatile("s_waitcnt vmcnt(0)" ::: "memory");
        if (c + 1 < 32) S2_DMA(c + 1, (c + 1) & 1);
        {
            const float wsc = dt * __expf(csL - cs);
#pragma unroll
            for (int x = 0; x < 8; ++x) { const f32x4 xv = *(const LAS f32x4*)(ldl + bo + O_X + (x * 64 + lane) * 16);
                v2u d; d.x = cvtpk_rne(xv.x * dt, xv.y * dt); d.y = cvtpk_rne(xv.z * dt, xv.w * dt); *(LAS v2u*)((LAS unsigned char*)lds + O_XD + lane * 72 + 8 * x) = d;
                v2u w; w.x = cvtpk_rne(xv.x * wsc, xv.y * wsc); w.y = cvtpk_rne(xv.z * wsc, xv.w * wsc); *(LAS v2u*)((LAS unsigned char*)lds + O_XW + lane * 72 + 8 * x) = w; }
        }
        LDS_WAIT();
        f32x16_t g00, g01, g11;
#pragma unroll
        for (int r = 0; r < 16; ++r) { g00[r] = 0.f; g01[r] = 0.f; g11[r] = 0.f; }
#pragma unroll
        for (int kk = 0; kk < 8; ++kk) { const int fo = ((2 * kk + hi) * 64 + r32) * 16;
            const bf16x8_t A0 = *(const LAS bf16x8_t*)(ldl + bo + O_B + fo), A1 = *(const LAS bf16x8_t*)(ldl + bo + O_B + fo + 512);
            const bf16x8_t B0 = *(const LAS bf16x8_t*)(ldl + bo + O_C + fo), B1 = *(const LAS bf16x8_t*)(ldl + bo + O_C + fo + 512);
            g00 = __builtin_amdgcn_mfma_f32_32x32x16_bf16(A0, B0, g00, 0, 0, 0); g01 = __builtin_amdgcn_mfma_f32_32x32x16_bf16(A0, B1, g01, 0, 0, 0); g11 = __builtin_amdgcn_mfma_f32_32x32x16_bf16(A1, B1, g11, 0, 0, 0); }
        {   const float cst0 = Gs[r32], cst1 = Gs[32 + r32];
#pragma unroll
            for (int r = 0; r < 16; ++r) { const int il = (r & 3) + 8 * (r >> 2) + 4 * hi; const float css0 = Gs[il], css1 = Gs[32 + il];
                g00[r] = (il <= r32) ? g00[r] * __expf(cst0 - css0) : 0.f; g01[r] = g01[r] * __expf(cst1 - css0); g11[r] = (il <= r32) ? g11[r] * __expf(cst1 - css1) : 0.f; } }
        asm volatile("" ::: "memory");
        f32x16_t y0, y1;
#pragma unroll
        for (int r = 0; r < 16; ++r) { y0[r] = 0.f; y1[r] = 0.f; }
#define TRFRAG(base_) ({ const s16x4_t lo_ = __builtin_bit_cast(s16x4_t, __builtin_amdgcn_ds_read_tr16_b64_v4i16((LAS s16x4_t*)(ldl + (base_)))); \
                         const s16x4_t hi_ = __builtin_bit_cast(s16x4_t, __builtin_amdgcn_ds_read_tr16_b64_v4i16((LAS s16x4_t*)(ldl + (base_) + 8 * 72))); \
                         (bf16x8_t){lo_[0], lo_[1], lo_[2], lo_[3], hi_[0], hi_[1], hi_[2], hi_[3]}; })
        {   const int xo = O_XD + (4 * hi + trq) * 72 + (16 * trc + 4 * trp) * 2;
            const bf16x8_t x0 = TRFRAG(xo), x1 = TRFRAG(xo + 16 * 72), x2 = TRFRAG(xo + 32 * 72), x3 = TRFRAG(xo + 48 * 72);
            y0 = __builtin_amdgcn_mfma_f32_32x32x16_bf16(acc_frag<0>(g00), x0, y0, 0, 0, 0); y0 = __builtin_amdgcn_mfma_f32_32x32x16_bf16(acc_frag<1>(g00), x1, y0, 0, 0, 0);
            y1 = __builtin_amdgcn_mfma_f32_32x32x16_bf16(acc_frag<0>(g01), x0, y1, 0, 0, 0); y1 = __builtin_amdgcn_mfma_f32_32x32x16_bf16(acc_frag<1>(g01), x1, y1, 0, 0, 0);
            y1 = __builtin_amdgcn_mfma_f32_32x32x16_bf16(acc_frag<0>(g11), x2, y1, 0, 0, 0); y1 = __builtin_amdgcn_mfma_f32_32x32x16_bf16(acc_frag<1>(g11), x3, y1, 0, 0, 0); }
        asm volatile("" ::: "memory");
        {   f32x16_t Z0, Z1;
#pragma unroll
            for (int r = 0; r < 16; ++r) { Z0[r] = 0.f; Z1[r] = 0.f; }
#define LFRAG(off_) join44(*(const LAS v2u*)(ldl + (off_)), *(const LAS v2u*)(ldl + (off_) + 1024))
#pragma unroll
            for (int nt = 0; nt < 4; ++nt) { const bf16x8_t hb0 = acc_frag<0>(H[nt]), hb1 = acc_frag<1>(H[nt]);
                const int ro = bo + O_C + ((4 * nt) * 64 + r32) * 16 + 8 * hi;
                Z0 = __builtin_amdgcn_mfma_f32_32x32x16_bf16(LFRAG(ro), hb0, Z0, 0, 0, 0); Z0 = __builtin_amdgcn_mfma_f32_32x32x16_bf16(LFRAG(ro + 2048), hb1, Z0, 0, 0, 0);
                Z1 = __builtin_amdgcn_mfma_f32_32x32x16_bf16(LFRAG(ro + 512), hb0, Z1, 0, 0, 0); Z1 = __builtin_amdgcn_mfma_f32_32x32x16_bf16(LFRAG(ro + 512 + 2048), hb1, Z1, 0, 0, 0); }
#undef LFRAG
#pragma unroll
            for (int r = 0; r < 16; ++r) { const int il = (r & 3) + 8 * (r >> 2) + 4 * hi; ot[il * 33 + r32] = fmaf(Es[il], Z0[r], y0[r]); ot[(32 + il) * 33 + r32] = fmaf(Es[32 + il], Z1[r], y1[r]); } }
        LDS_WAIT();
        { const int t = dir ? SEQ - 1 - (64 * c + lane) : 64 * c + lane; float* yrow = Y + ((size_t)b * SEQ + t) * 1024 + h * 64 + ps * 32;
#pragma unroll
          for (int x = 0; x < 8; ++x) *(f32x4*)(yrow + 4 * x) = (f32x4){ot[lane * 33 + 4 * x], ot[lane * 33 + 4 * x + 1], ot[lane * 33 + 4 * x + 2], ot[lane * 33 + 4 * x + 3]}; }
        asm volatile("" ::: "memory");
        {   const float eL = __expf(csL);
            const int xo = O_XW + (4 * hi + trq) * 72 + (16 * trc + 4 * trp) * 2;
            const bf16x8_t w0 = TRFRAG(xo), w1 = TRFRAG(xo + 16 * 72), w2 = TRFRAG(xo + 32 * 72), w3 = TRFRAG(xo + 48 * 72);
#undef TRFRAG
#pragma unroll
            for (int nt = 0; nt < 4; ++nt) {
#pragma unroll
                for (int r = 0; r < 16; ++r) H[nt][r] *= eL;
#pragma unroll
                for (int ks = 0; ks < 4; ++ks) {
                    const int ro = bo + O_B + ((4 * nt + 2 * trc + (trp >> 1)) * 64 + 16 * ks + 4 * hi + trq) * 16 + 8 * (trp & 1);
                    const s16x4_t lo = __builtin_bit_cast(s16x4_t, __builtin_amdgcn_ds_read_tr16_b64_v4i16((LAS s16x4_t*)(ldl + ro)));
                    const s16x4_t hi4 = __builtin_bit_cast(s16x4_t, __builtin_amdgcn_ds_read_tr16_b64_v4i16((LAS s16x4_t*)(ldl + ro + 8 * 16)));
                    const bf16x8_t bfr = (bf16x8_t){lo[0], lo[1], lo[2], lo[3], hi4[0], hi4[1], hi4[2], hi4[3]};
                    H[nt] = __builtin_amdgcn_mfma_f32_32x32x16_bf16(bfr, ks == 0 ? w0 : ks == 1 ? w1 : ks == 2 ? w2 : w3, H[nt], 0, 0, 0);
                }
            }
        }
        LDS_WAIT();
    }
#undef S2_DMA
}

__device__ __forceinline__ void lru_tile(const Args& a, int item, unsigned char* lds, int pass) {
    const int n = item & 7, tc = (item >> 3) & 63, b = item >> 9, t0 = tc * 32;
    float* xc = (float*)lds; bf16_t* xcb = (bf16_t*)(lds + 16384); float* As = (float*)(lds + 25088); float* Us = As + 2 * 32 * 128; float2* sg = (float2*)(Us + 2 * 32 * 128);
    const int tid = threadIdx.x, lane = tid & 63, wave = tid >> 6;
    const bf16_t* P = (const bf16_t*)(a.ws + WS_PROJ);
    __syncthreads();
    {
        const int j = tid & 127, tg = tid >> 7, chn = n * 128 + j; const float* cw = a.in[25];
        const float w0 = cw[chn], w1 = cw[1024 + chn], w2 = cw[2048 + chn], w3 = cw[3072 + chn], cbias = a.in[26][chn];
        const int tb = t0 + tg * 8;
        const bf16_t* pp = P + ((size_t)b * SEQ + tb) * NINP + C_XL + chn;
        float xm2 = (tb >= 2) ? bf2f(pp[-2 * NINP]) : 0.f, xm1 = (tb >= 1) ? bf2f(pp[-NINP]) : 0.f, x0 = bf2f(pp[0]);
#pragma unroll
        for (int i = 0; i < 8; ++i) { const float xp1 = (tb + i + 1 < SEQ) ? bf2f(pp[(i + 1) * NINP]) : 0.f;
            const float acc = cbias + w0 * xm2 + w1 * xm1 + w2 * x0 + w3 * xp1;
            xc[(tg * 8 + i) * 128 + j] = acc; xcb[(tg * 8 + i) * 136 + j] = (bf16_t)f2bf(acc);
            xm2 = xm1; xm1 = x0; x0 = xp1; }
    }
    __syncthreads();
    {
        const int ct = wave & 3, d = wave >> 2, r32 = lane & 31, hi = lane >> 5;
        const bf16_t* WT = (const bf16_t*)(a.ws + WS_WGT);
        const bf16_t* wa_p = WT + ((size_t)((2 * d) * 8 + n) * 128 + ct * 32 + r32) * 128 + hi * 8;
        const bf16_t* wx_p = WT + ((size_t)((2 * d + 1) * 8 + n) * 128 + ct * 32 + r32) * 128 + hi * 8;
        f32x16_t ca, cx;
#pragma unroll
        for (int r = 0; r < 16; ++r) { ca[r] = 0.f; cx[r] = 0.f; }
#pragma unroll
        for (int s = 0; s < 8; ++s) {
            const bf16x8_t af = *(const bf16x8_t*)((const char*)xcb + r32 * 272 + (s * 16 + hi * 8) * 2);
            const bf16x8_t fa = *(const bf16x8_t*)(wa_p + s * 16); const bf16x8_t fx = *(const bf16x8_t*)(wx_p + s * 16);
            ca = __builtin_amdgcn_mfma_f32_32x32x16_bf16(af, fa, ca, 0, 0, 0); cx = __builtin_amdgcn_mfma_f32_32x32x16_bf16(af, fx, cx, 0, 0, 0);
        }
        const int j = ct * 32 + r32, cj = n * 128 + j;
        const float baj = a.in[d ? 33 : 28][cj], bxj = a.in[d ? 35 : 30][cj], sp = softplus_f(-a.in[d ? 36 : 31][cj]);
#pragma unroll
        for (int r = 0; r < 16; ++r) { const int t = (r & 3) + 8 * (r >> 2) + 4 * hi;
            const float rg = __builtin_amdgcn_rcpf(1.f + __expf(-(ca[r] + baj))), ig = __builtin_amdgcn_rcpf(1.f + __expf(-(cx[r] + bxj))); const float la = -8.f * rg * sp;
            const float av = __expf(la);
            const float om = (la > -0.0625f) ? -2.f * la * (1.f + la * (1.f + la * (0.6666667f + 0.3333333f * la))) : (1.f - av) * (1.f + av);
            As[(d * 32 + t) * 128 + j] = av; Us[(d * 32 + t) * 128 + j] = __builtin_amdgcn_sqrtf(om) * (ig * xc[t * 128 + j]); }
    }
    __syncthreads();
    {
        const int j = tid & 127, d = (tid >> 7) & 1, seg = tid >> 8;
        float Pp = 1.f, H = 0.f;
#pragma unroll
        for (int k = 0; k < 16; ++k) { const int q = seg * 16 + k, t = d ? 31 - q : q; const float a_ = As[(d * 32 + t) * 128 + j], u_ = Us[(d * 32 + t) * 128 + j]; H = fmaf(a_, H, u_); Pp *= a_; }
        sg[(d * 2 + seg) * 128 + j] = make_float2(Pp, H);
        __syncthreads();
        float2* LS = (float2*)(a.ws + WS_LSUM);
        if (pass == 0) {
            if (seg == 0) { const float2 s1 = sg[(d * 2 + 1) * 128 + j]; LS[((size_t)(d * 4 + b) * 64 + tc) * 1024 + n * 128 + j] = make_float2(Pp * s1.x, fmaf(s1.x, H, s1.y)); }
        } else {
            float c = 0.f;
            const float2* lsp = LS + ((size_t)(d * 4 + b) * 64) * 1024 + n * 128 + j;
#pragma unroll 1
            for (int c0 = 0; c0 < 64; c0 += 16) { float2 sv[16];
#pragma unroll
                for (int i = 0; i < 16; ++i) { const int cc = d ? 63 - (c0 + i) : c0 + i; sv[i] = lsp[(size_t)cc * 1024]; }
#pragma unroll
                for (int i = 0; i < 16; ++i) { const int cc = d ? 63 - (c0 + i) : c0 + i; const bool before = d ? (cc > tc) : (cc < tc); if (before) c = fmaf(sv[i].x, c, sv[i].y); } }
            if (seg == 1) { const float2 s0 = sg[(d * 2) * 128 + j]; c = fmaf(s0.x, c, s0.y); }
            float h = c;
#pragma unroll
            for (int k = 0; k < 16; ++k) { const int q = seg * 16 + k, t = d ? 31 - q : q; const float a_ = As[(d * 32 + t) * 128 + j], u_ = Us[(d * 32 + t) * 128 + j]; h = fmaf(a_, h, u_); Us[(d * 32 + t) * 128 + j] = h; }
            __syncthreads();
            bf16_t* YC = (bf16_t*)(a.ws + WS_YCAT);
            const int jj = tid & 127, tg = tid >> 7;
#pragma unroll
            for (int i = 0; i < 8; ++i) { const int t = tg * 8 + i; const size_t row = (size_t)b * SEQ + t0 + t;
                const float hs = Us[t * 128 + jj] + Us[(32 + t) * 128 + jj]; const float gl = bf2f(P[row * NINP + C_GL + n * 128 + jj]);
                YC[row * 2048 + 1024 + n * 128 + jj] = (bf16_t)f2bf(hs * silu_f(gl)); }
        }
    }
}

__device__ __forceinline__ void lru_sum_wave(const Args& a, int witem, unsigned char* ldsw, int lane) {
    asm volatile("" : "+v"(lane));
    const int ct = witem & 3, n = (witem >> 2) & 7, tc = (witem >> 5) & 63, b = witem >> 11, t0 = tc * 32;
    const int r32 = lane & 31, hi = lane >> 5;
    bf16_t* xcb = (bf16_t*)ldsw;
    const bf16_t* P = (const bf16_t*)(a.ws + WS_PROJ);
    {
        const int chn = n * 128 + 2 * lane; const float* cw = a.in[25];
        const f32x2 w0 = *(const f32x2*)(cw + chn), w1 = *(const f32x2*)(cw + 1024 + chn), w2 = *(const f32x2*)(cw + 2048 + chn), w3 = *(const f32x2*)(cw + 3072 + chn), cb2 = *(const f32x2*)(a.in[26] + chn);
        const bf16_t* pp = P + ((size_t)b * SEQ + t0) * NINP + C_XL + chn;
        f32x2 xm2 = {0.f, 0.f}, xm1 = {0.f, 0.f}, x0;
        if (t0 >= 2) { const unsigned v = *(const unsigned*)(pp - 2 * NINP); xm2 = (f32x2){bf2f(v & 0xffffu), __uint_as_float(v & 0xffff0000u)}; }
        if (t0 >= 1) { const unsigned v = *(const unsigned*)(pp - NINP); xm1 = (f32x2){bf2f(v & 0xffffu), __uint_as_float(v & 0xffff0000u)}; }
        { const unsigned v = *(const unsigned*)pp; x0 = (f32x2){bf2f(v & 0xffffu), __uint_as_float(v & 0xffff0000u)}; }
#pragma unroll 8
        for (int i = 0; i < 32; ++i) { f32x2 xp1 = {0.f, 0.f};
            if (t0 + i + 1 < SEQ) { const unsigned v = *(const unsigned*)(pp + (size_t)(i + 1) * NINP); xp1 = (f32x2){bf2f(v & 0xffffu), __uint_as_float(v & 0xffff0000u)}; }
            const f32x2 acc = cb2 + w0 * xm2 + w1 * xm1 + w2 * x0 + w3 * xp1;
            *(unsigned*)(xcb + i * 136 + 2 * lane) = pk2(acc.x, acc.y);
            xm2 = xm1; xm1 = x0; x0 = xp1; }
    }
    LDS_WAIT();
    const bf16_t* WT = (const bf16_t*)(a.ws + WS_WGT);
    float2* LS = (float2*)(a.ws + WS_LSUM);
    const int j = ct * 32 + r32, cj = n * 128 + j;
#pragma unroll
    for (int d = 0; d < 2; ++d) {
        const bf16_t* wa_p = WT + ((size_t)((2 * d) * 8 + n) * 128 + j) * 128 + hi * 8;
        const bf16_t* wx_p = WT + ((size_t)((2 * d + 1) * 8 + n) * 128 + j) * 128 + hi * 8;
        f32x16_t ca, cx;
#pragma unroll
        for (int r = 0; r < 16; ++r) { ca[r] = 0.f; cx[r] = 0.f; }
#pragma unroll
        for (int s = 0; s < 8; ++s) {
            const bf16x8_t af = *(const bf16x8_t*)((const char*)xcb + r32 * 272 + (s * 16 + hi * 8) * 2);
            const bf16x8_t fa = *(const bf16x8_t*)(wa_p + s * 16); const bf16x8_t fx = *(const bf16x8_t*)(wx_p + s * 16);
            ca = __builtin_amdgcn_mfma_f32_32x32x16_bf16(af, fa, ca, 0, 0, 0); cx = __builtin_amdgcn_mfma_f32_32x32x16_bf16(af, fx, cx, 0, 0, 0);
        }
        const float baj = a.in[d ? 33 : 28][cj], bxj = a.in[d ? 35 : 30][cj], sp = softplus_f(-a.in[d ? 36 : 31][cj]);
        float Pg[4], Hg[4];
#pragma unroll
        for (int sg = 0; sg < 4; ++sg) { float Pp = 1.f, Hh = 0.f;
#pragma unroll
            for (int e4 = 0; e4 < 4; ++e4) { const int e = d ? 3 - e4 : e4; const int r = 4 * sg + e; const int t = (r & 3) + 8 * (r >> 2) + 4 * hi;
                const float rg = __builtin_amdgcn_rcpf(1.f + __expf(-(ca[r] + baj))), ig = __builtin_amdgcn_rcpf(1.f + __expf(-(cx[r] + bxj))); const float la = -8.f * rg * sp;
                const float av = __expf(la);
                const float om = (la > -0.0625f) ? -2.f * la * (1.f + la * (1.f + la * (0.6666667f + 0.3333333f * la))) : (1.f - av) * (1.f + av);
                const float uv = __builtin_amdgcn_sqrtf(om) * (ig * bf2f(xcb[t * 136 + j]));
                Hh = fmaf(av, Hh, uv); Pp *= av; }
            Pg[sg] = Pp; Hg[sg] = Hh; }
        float Po[4], Ho[4];
#pragma unroll
        for (int sg = 0; sg < 4; ++sg) { Po[sg] = __shfl_xor(Pg[sg], 32); Ho[sg] = __shfl_xor(Hg[sg], 32); }
        float Ac = 1.f, Hc = 0.f;
#pragma unroll
        for (int qq = 0; qq < 8; ++qq) { const int q = d ? 7 - qq : qq;
            const bool mine = ((q & 1) == hi); const float pq = mine ? Pg[q >> 1] : Po[q >> 1], hq_ = mine ? Hg[q >> 1] : Ho[q >> 1];
            Hc = fmaf(pq, Hc, hq_); Ac *= pq; }
        if (hi == 0) LS[((size_t)(d * 4 + b) * 64 + tc) * 1024 + cj] = make_float2(Ac, Hc);
    }
    LDS_WAIT();
}

__device__ __forceinline__ void combine1_phase(const Args& a, int gw, int NGW, int lane) {
    const float* OF = (const float*)(a.ws + WS_YF); const float* OB = (const float*)(a.ws + WS_YB);
    const bf16_t* P = (const bf16_t*)(a.ws + WS_PROJ); bf16_t* YC = (bf16_t*)(a.ws + WS_YCAT);
    const float* gn = a.in[24];
    for (int m = gw; m < MTOK; m += NGW) {
        const int ch = lane * 16, d0 = ch & 127;
        float z[16], ov[16];
        unpack8(*(const v4u*)(P + (size_t)m * NINP + C_Z + ch), z); unpack8(*(const v4u*)(P + (size_t)m * NINP + C_Z + ch + 8), z + 8);
#pragma unroll
        for (int q = 0; q < 4; ++q) { const f32x4 f = *(const f32x4*)(OF + (size_t)m * 1024 + ch + 4 * q), bk = *(const f32x4*)(OB + (size_t)m * 1024 + ch + 4 * q); const f32x4 o = f + bk;
            ov[4 * q] = o.x; ov[4 * q + 1] = o.y; ov[4 * q + 2] = o.z; ov[4 * q + 3] = o.w; }
        float ss = 0.f;
#pragma unroll
        for (int i = 0; i < 16; ++i) ss += ov[i] * ov[i];
        ss = group_sum<8>(ss);
        const float r = rsqrtf(ss * (1.f / 128.f) + EPS);
#pragma unroll
        for (int i = 0; i < 16; ++i) ov[i] = ov[i] * r * gn[d0 + i] * silu_f(z[i]);
        *(v4u*)(YC + (size_t)m * 2048 + ch) = pack8(ov); *(v4u*)(YC + (size_t)m * 2048 + ch + 8) = pack8(ov + 8);
    }
}

__device__ __forceinline__ void final_norm_phase(const Args& a, int gw, int NGW, int lane) {
    const float* nw = a.in[38];
    for (int m = gw; m < MTOK; m += NGW) {
        f32x4* xr = (f32x4*)(a.out + (size_t)m * 2048) + lane;
        f32x4 v[8]; float s = 0.f;
#pragma unroll
        for (int j = 0; j < 8; ++j) { v[j] = xr[64 * j]; s += (v[j].x * v[j].x + v[j].y * v[j].y) + (v[j].z * v[j].z + v[j].w * v[j].w); }
        const float rstd = rsqrtf(group_sum<64>(s) * (1.f / 2048.f) + EPS);
#pragma unroll
        for (int j = 0; j < 8; ++j) { const f32x4 w = *(const f32x4*)(nw + (64 * j + lane) * 4); xr[64 * j] = v[j] * rstd * w; }
    }
}

typedef GAS unsigned gu32;
#define RLX_AGENT __ATOMIC_RELAXED, __HIP_MEMORY_SCOPE_AGENT
constexpr int CW_BAR = 4096;
constexpr int MISC_OFF = 147456 - 128;
#define XB_TMO      128
#define XB_XCNT(j)  (256  + 64 * (j))
#define XB_XSUB(j)  (1280 + 64 * (j))
#define XB_XGEN(j)  (2304 + 64 * (j))
#define XB_TOP      3328
#define XB_TOPGEN   3392
#define XCD_BAR_WORDS 3456
#define XB_SPIN_CAP (1u << 18)

__device__ __forceinline__ unsigned xb_ld(unsigned* p)              { return __hip_atomic_load(p, __ATOMIC_RELAXED, __HIP_MEMORY_SCOPE_AGENT); }
__device__ __forceinline__ unsigned xb_add(unsigned* p, unsigned v) { return __hip_atomic_fetch_add(p, v, __ATOMIC_RELAXED, __HIP_MEMORY_SCOPE_AGENT); }
__device__ __forceinline__ unsigned xb_xcc_id() { return (unsigned)__builtin_amdgcn_s_getreg((3 << 11) | 20) & 0xFu; }
#define XB_SPIN(cond, bar) do { unsigned _sp = 0; while (cond) { __builtin_amdgcn_s_sleep(1); \
    if ((++_sp & 255u) == 0u) { if (xb_ld(&(bar)[XB_TMO])) break; if (_sp > XB_SPIN_CAP) { atomicAdd(&(bar)[XB_TMO], 1u); break; } } } } while (0)

struct XcdBarrier {
    unsigned* bar; unsigned x;
    volatile LAS unsigned* st;
};

__device__ __forceinline__ XcdBarrier xcd_barrier_post(unsigned* bar, volatile LAS unsigned* st) {
    XcdBarrier b; b.bar = bar; b.x = xb_xcc_id(); b.st = st;
    if (threadIdx.x == 0) (void)xb_add(&bar[XB_XCNT(b.x)], 1u);
    return b;
}
__device__ __forceinline__ void xcd_barrier_complete(unsigned* bar, unsigned x, unsigned& nloc, unsigned& nx) {
    const unsigned G = gridDim.x * gridDim.y * gridDim.z;
    unsigned sum, cnt, mine, sp = 0u;
    for (;;) {
        sum = 0u; cnt = 0u; mine = 0u;
#pragma unroll
        for (unsigned j = 0; j < 16; ++j) { const unsigned c = xb_ld(&bar[XB_XCNT(j)]); sum += c; cnt += (c > 0u) ? 1u : 0u; mine = (j == x) ? c : mine; }
        if (sum == G) break;
        __builtin_amdgcn_s_sleep(1);
        if ((++sp & 255u) == 0u) { if (xb_ld(&bar[XB_TMO])) break; if (sp > XB_SPIN_CAP) { atomicAdd(&bar[XB_TMO], 1u); break; } }
    }
    nloc = mine > 0u ? mine : 1u; nx = cnt > 0u ? cnt : 1u;
}

__device__ __forceinline__ void xcd_barrier(const XcdBarrier& b) {
    asm volatile("s_waitcnt vmcnt(0)" ::: "memory");
    __syncthreads();
    if (threadIdx.x == 0) {
        unsigned* bar = b.bar;
        __builtin_amdgcn_s_waitcnt(0);
        unsigned nloc = b.st[0], nx = b.st[1];
        if (nloc == 0u) { xcd_barrier_complete(bar, b.x, nloc, nx); b.st[0] = nloc; b.st[1] = nx; }
        const unsigned old = xb_add(&bar[XB_XSUB(b.x)], 1u);
        const unsigned gen = old / nloc;
        if (old + 1u == (gen + 1u) * nloc) {
            __builtin_amdgcn_fence(__ATOMIC_RELEASE, "agent");
            asm volatile("s_waitcnt vmcnt(0)" ::: "memory");
            const unsigned og = xb_add(&bar[XB_TOP], 1u);
            const unsigned tg = og / nx;
            if (og + 1u == (tg + 1u) * nx) xb_add(&bar[XB_TOPGEN], 1u);
            else XB_SPIN(xb_ld(&bar[XB_TOPGEN]) == tg, bar);
            __builtin_amdgcn_fence(__ATOMIC_ACQUIRE, "agent");
            xb_add(&bar[XB_XGEN(b.x)], 1u);
            asm volatile("s_waitcnt vmcnt(0)" ::: "memory");
        } else {
            XB_SPIN(xb_ld(&bar[XB_XGEN(b.x)]) == gen, bar);
            __builtin_amdgcn_fence(__ATOMIC_ACQUIRE, "agent");
            asm volatile("s_waitcnt vmcnt(0)" ::: "memory");
        }
    }
    __syncthreads();
}

#ifndef PROBE_MASK
#define PROBE_MASK 0
#endif
#define REP(bit) for (int rep_ = 0; rep_ < 1 + ((PROBE_MASK >> (bit)) & 1); ++rep_)
#ifndef PROBE_SSD
#define PROBE_SSD 0
#endif
#ifndef PROBE_GDN
#define PROBE_GDN 0
#endif
#ifndef PROBE_LRU
#define PROBE_LRU 0
#endif
#ifndef MK_SINGLE
#define MK_SINGLE 1
#endif
__global__ void __launch_bounds__(NTHREADS, 2) mk_fwd(Args a) {
    extern __shared__ __attribute__((aligned(16))) unsigned char lds[];
    LAS unsigned char* ldsl = (LAS unsigned char*)lds;
    const int tid = threadIdx.x, lane = tid & 63, wave = __builtin_amdgcn_readfirstlane(tid >> 6);
    const int G = gridDim.x, bx = blockIdx.x;
    const int vcu = (G % 8 == 0) ? (bx % 8) * (G / 8) + bx / 8 : bx;
    const int gw = vcu * NWAVES + wave, NGW = G * NWAVES;
    unsigned char* ws = a.ws;
    volatile LAS unsigned* MISC = (volatile LAS unsigned*)(ldsl + MISC_OFF);
    if (tid < 32) MISC[tid] = 0u;
    __syncthreads();
    XcdBarrier bar; bar.bar = (unsigned*)(ws + WS_CTL) + CW_BAR; bar.x = 0; bar.st = nullptr;
    if (a.ph_hi - a.ph_lo > 1) bar = xcd_barrier_post((unsigned*)(ws + WS_CTL) + CW_BAR, MISC + 8);
#define IN(k) (a.ph_lo <= (k) && (k) < a.ph_hi)
#define SEAM(k) do { if (IN(k) && IN((k) + 1)) { xcd_barrier(bar); } } while (0)

    if (IN(0)) { p0_prologue(a, ldsl, vcu, G); } SEAM(0);
    if (IN(1)) { REP(0) normmod_phase(a, a.in[0], 0, gw, NGW, lane); } SEAM(1);
    if (IN(2)) {
        pg8::Gemm g{(const bf16_t*)(ws + WS_H), (const bf16_t*)(ws + WS_WIN0), MTOK, NINP, 2048}; pg8::StaticOrder S; S.init(MTOK, NINP, G, bx);
        pg8::EpiProj E{(bf16_t*)(ws + WS_PROJ), (float*)(ws + WS_SMALL), NINP, A_DT / 256};
        REP(1) { pg8::gemm_phase<pg8::EpiProj, pg8::StaticOrder, true, true>(ldsl, g, S, E); __syncthreads(); }
    } SEAM(2);
    if (IN(3)) { REP(0) post0_phase(a, gw, NGW, lane); } SEAM(3);
    if (IN(4)) {
        REP(3) for (int u = vcu; u < 256; u += G) { const int b = u >> 6, h = (u >> 3) & 7, qb = u & 7, kvh = h >> 2; const size_t row0 = (size_t)b * SEQ + qb * 256;
            att::attn_dense_body((const att::bf16*)(ws + WS_QB) + row0 * 1024 + h * 128, (const att::bf16*)(ws + WS_KB) + (size_t)b * SEQ * 256 + kvh * 128,
                                 (const att::bf16*)(ws + WS_VB) + (size_t)b * SEQ * 256 + kvh * 128, (bf16_t*)(ws + WS_YCAT) + row0 * 2048 + h * 128,
                                 (const bf16_t*)(ws + WS_PROJ) + row0 * NINP + A_GA + h * 128, SEQ, (char*)lds);
            __syncthreads(); }
        if (wave == 0) { for (int it = vcu; it < 256; it += G) ssd2_item(a, it, lds); }
        else if (wave <= 4) late_transposes(a, (LAS float*)(ldsl + 100096 + (wave - 1) * 8448), vcu * 4 + (wave - 1), G * 4, lane);
        __syncthreads();
    } SEAM(4);
    if (IN(5)) { REP(0) ssd_combine_phase(a, gw, NGW, lane); } SEAM(5);
    if (IN(6)) {
        pg8::Gemm g{(const bf16_t*)(ws + WS_YCAT), (const bf16_t*)(ws + WS_WOUT0), MTOK, 2048, 2048}; pg8::StaticOrder S; S.init(MTOK, 2048, G, bx);
        pg8::EpiResid E{a.in[0], a.out, (const float*)(ws + WS_MOD), a.in[3]};
        REP(2) { pg8::gemm_phase<pg8::EpiResid, pg8::StaticOrder, true, true>(ldsl, g, S, E); __syncthreads(); }
    } SEAM(6);
    if (IN(7)) { REP(0) normmod_phase(a, a.out, 1, gw, NGW, lane); } SEAM(7);
    if (IN(8)) {
        pg8::Gemm g{(const bf16_t*)(ws + WS_H), (const bf16_t*)(ws + WS_WIN1), MTOK, NINP, 2048}; pg8::StaticOrder S; S.init(MTOK, NINP, G, bx);
        pg8::EpiProj E{(bf16_t*)(ws + WS_PROJ), (float*)(ws + WS_SMALL), NINP, C_SM / 256};
        pg8::gemm_phase<pg8::EpiProj, pg8::StaticOrder, true, true>(ldsl, g, S, E);
    } SEAM(8);
    if (IN(9)) { REP(0) post1_phase(a, gw, NGW, lane); } SEAM(9);
    if (IN(10)) {
        REP(5) { for (int it = gw; it < 2048; it += NGW) gdn1_item(a, it, lds + wave * GDN_LDS_PER_WAVE, lane); __syncthreads(); }
    } SEAM(10);
    if (IN(11)) {
        if (wave == 0) { for (int it = vcu; it < 256; it += G) gdn2_item(a, it, lds); }
        else if (wave <= 2) { for (int wi = vcu * 2 + (wave - 1); wi < 8192; wi += G * 2) lru_sum_wave(a, wi, lds + 124160 + (wave - 1) * 8704, lane); }
        __syncthreads();
    } SEAM(11);
    if (IN(12)) { REP(0) combine1_phase(a, gw, NGW, lane); __syncthreads(); REP(4) { for (int it = bx; it < 2048; it += G) lru_tile(a, it, lds, 1); __syncthreads(); } } SEAM(12);
    if (IN(13)) {
        pg8::Gemm g{(const bf16_t*)(ws + WS_YCAT), (const bf16_t*)(ws + WS_WOUT1), MTOK, 2048, 2048}; pg8::StaticOrder S; S.init(MTOK, 2048, G, bx);
        pg8::EpiResid E{a.out, a.out, (const float*)(ws + WS_MOD) + 4 * 6144, a.in[3] + 6144};
        pg8::gemm_phase<pg8::EpiResid, pg8::StaticOrder, true, true>(ldsl, g, S, E);
    } SEAM(13);
    if (IN(14)) { final_norm_phase(a, gw, NGW, lane); }
#undef IN
#undef SEAM
}

extern "C" void kernel_launch(void* const* d_in, const int* in_sizes, int n_in, void* d_out, int out_size, void* d_ws, size_t ws_size, hipStream_t stream) {
    static int grid = 0;
    if (grid == 0) {
        if (n_in != 39 || out_size != MTOK * DM || ws_size < WS_END) { fprintf(stderr, "kernel_launch: unexpected problem (n_in %d, out %d, ws %zu < %zu)\n", n_in, out_size, ws_size, (size_t)WS_END); grid = -1; return; }
        int dev = 0, cus = 0, per_cu = 0;
        if (hipGetDevice(&dev) != hipSuccess || hipDeviceGetAttribute(&cus, hipDeviceAttributeMultiprocessorCount, dev) != hipSuccess) { grid = -1; return; }
        if (hipFuncSetAttribute((const void*)mk_fwd, hipFuncAttributeMaxDynamicSharedMemorySize, LDS_BYTES) != hipSuccess) { fprintf(stderr, "kernel_launch: hipFuncSetAttribute failed\n"); grid = -1; return; }
        if (hipOccupancyMaxActiveBlocksPerMultiprocessor(&per_cu, (const void*)mk_fwd, NTHREADS, LDS_BYTES) != hipSuccess || per_cu < 1) { fprintf(stderr, "kernel_launch: occupancy query says %d\n", per_cu); (void)hipGetLastError(); per_cu = 1; }
        grid = cus;
    }
    if (grid < 0) return;
    (void)hipMemsetAsync((char*)d_ws + WS_CTL, 0, CTL_ZERO_BYTES, stream);
    Args a{};
    for (int i = 0; i < 39; ++i) a.in[i] = (const float*)d_in[i];
    a.out = (float*)d_out; a.ws = (unsigned char*)d_ws;
#if MK_SINGLE
    a.ph_lo = 0; a.ph_hi = NPHASE;
    void* kargs[] = {&a};
    hipError_t e = hipLaunchCooperativeKernel((const void*)mk_fwd, dim3(grid), dim3(NTHREADS), kargs, LDS_BYTES, stream);
    if (e != hipSuccess) fprintf(stderr, "kernel_launch: cooperative launch failed: %s (grid %d)\n", hipGetErrorString(e), grid);
#else
    for (int p = 0; p < NPHASE; ++p) { a.ph_lo = p; a.ph_hi = p + 1; hipLaunchKernelGGL(mk_fwd, dim3(grid), dim3(NTHREADS), LDS_BYTES, stream, a); }
#endif
}
```

```cpp
#include <hip/hip_runtime.h>
#include <hip/hip_cooperative_groups.h>
#include <hip/hip_bf16.h>
#include <cstdio>
#include <cstdint>
namespace cg = cooperative_groups;

constexpr int BATCH = 4, SEQ = 2048, DM = 2048, MTOK = BATCH * SEQ;
constexpr int NIN = 5152, NINP = 5376;
constexpr float EPS = 1e-6f;
constexpr int A_Q = 0, A_K = 1024, A_V = 1280, A_GA = 1536, A_XS = 2560, A_BS = 3584, A_CS = 3840, A_DT = 4096, A_Z = 4128;
constexpr int C_Q = 0, C_K = 512, C_V = 1024, C_SM = 2048, C_Z = 2080, C_XL = 3104, C_GL = 4128;
namespace pg8 {
#define PG8_LAS __attribute__((address_space(3)))
typedef unsigned short bf16_t;
typedef short bf16x8 __attribute__((ext_vector_type(8)));
typedef float f32x4 __attribute__((ext_vector_type(4)));
typedef unsigned u32x4 __attribute__((ext_vector_type(4)));
constexpr int BM = 256, BK = 64, HALF = 128, HTB = HALF * BK * 2  , STAGE_BYTES = 8 * HTB, NXCD = 8, WGM = 8;

__host__ __device__ __forceinline__ int lds_byte(int r, int c) { const int st = (r >> 4) * 2 + (c >> 5), rr = r & 15, cc = c & 31, ob = rr * 64 + cc * 2; return st * 1024 + (ob ^ (((ob >> 9) & 1) << 5)); }
__host__ __device__ __forceinline__ void stage_rc(int b, int& R, int& C) { const int st = b / 1024, sb = b % 1024, swz = sb ^ (((sb >> 9) & 1) << 5); R = (st >> 1) * 16 + swz / 64; C = (st & 1) * 32 + (swz % 64) / 2; }
__host__ __device__ __forceinline__ int perm32(int rho) { const int n = rho >> 4, i = rho & 15; return 8 * (i >> 2) + 4 * n + (i & 3); }

struct Unit { int pm, pn; };
struct Gemm { const bf16_t* A; const bf16_t* Bt; int M, N, K; };

struct StaticOrder {
    int nM, nN, nwg, G, c;
    __host__ __device__ void init(int M, int N, int G_, int c_) { nM = M / BM; nN = N / BM; nwg = nM * nN; G = G_; c = c_; }
    __host__ __device__ bool next(int i, Unit& u) const {
        const long L = (long)i * G + c; if (L >= nwg) return false;
        int wgid = (int)L; { const int q = nwg / NXCD, r = nwg % NXCD, xcd = wgid % NXCD, off = wgid / NXCD; wgid = (xcd < r ? xcd * (q + 1) : r * (q + 1) + (xcd - r) * q) + off; }
        const int nig = WGM * nN, gid = wgid / nig, fm = gid * WGM, gsz = (nM - fm) < WGM ? (nM - fm) : WGM;
        u.pm = fm + ((wgid % nig) % gsz); u.pn = (wgid % nig) / gsz; return true;
    }
    __device__ __forceinline__ void a_ready(const Unit&) const {}
    __device__ __forceinline__ void done(const Unit&) const {}
};

__device__ __forceinline__ unsigned cvt_pk_bf16(float lo, float hi) { unsigned r; asm volatile("v_cvt_pk_bf16_f32 %0, %1, %2" : "=v"(r) : "v"(lo), "v"(hi)); return r; }
typedef float f32x2 __attribute__((ext_vector_type(2)));
struct EpiProj {
    static constexpr bool PERM = true, AFTER_DRAIN = false;
    bf16_t* O; float* small; int ldc; int small_tile;
    __device__ __forceinline__ void operator()(const f32x4 (&acc)[2][2][4][2], const Unit& u, int wr, int wc, int fr, int fq) const {
        const int row0 = u.pm * BM + wr * 64 + fr; const int col0 = u.pn * BM + wc * 32 + 8 * fq;
        const bool sm = (u.pn == small_tile) && (wc == 0);
#pragma unroll
        for (int ai = 0; ai < 2; ++ai)
#pragma unroll
            for (int m = 0; m < 4; ++m) { const int row = row0 + ai * HALF + m * 16; bf16_t* rowp = O + (size_t)row * ldc + col0;
#pragma unroll
                for (int bj = 0; bj < 2; ++bj) { const f32x4 v0 = acc[ai][bj][m][0], v1 = acc[ai][bj][m][1];
                    u32x4 w; w.x = cvt_pk_bf16(v0[0], v0[1]); w.y = cvt_pk_bf16(v0[2], v0[3]); w.z = cvt_pk_bf16(v1[0], v1[1]); w.w = cvt_pk_bf16(v1[2], v1[3]);
                    *(u32x4*)(rowp + bj * HALF) = w; }
                if (sm) { float* sp = small + (size_t)row * 32 + 8 * fq; *(f32x4*)sp = acc[ai][0][m][0]; *(f32x4*)(sp + 4) = acc[ai][0][m][1]; } }
    }
};
struct EpiResid {
    static constexpr bool PERM = false, AFTER_DRAIN = false;
    const float* xin; float* xout; const float* gacc; const float* gbias;
    __device__ __forceinline__ void operator()(const f32x4 (&acc)[2][2][4][2], const Unit& u, int wr, int wc, int fr, int fq) const {
        const int b = u.pm >> 3;
        const int col0 = u.pn * BM + wc * 32 + 4 * fq;
#pragma unroll
        for (int bj = 0; bj < 2; ++bj)
#pragma unroll
            for (int n = 0; n < 2; ++n) { const int col = col0 + bj * HALF + n * 16;
                const f32x4 g = *(const f32x4*)(gacc + (size_t)b * 6144 + 4096 + col) + *(const f32x4*)(gbias + 4096 + col);
#pragma unroll
                for (int ai = 0; ai < 2; ++ai)
#pragma unroll
                    for (int m = 0; m < 4; ++m) { const size_t off = (size_t)(u.pm * BM + ai * HALF + wr * 64 + m * 16 + fr) * 2048 + col;
                        const f32x4 xv = *(const f32x4*)(xin + off); *(f32x4*)(xout + off) = xv + g * acc[ai][bj][m][n]; } }
    }
};
template <class Epi, class Sched, bool ALIGN_EPI = false, bool SP2 = false>
__device__ __forceinline__ void gemm_phase(PG8_LAS unsigned char* lds, const Gemm g, const Sched& S, const Epi& E) {
    const int tid = threadIdx.x, wid = __builtin_amdgcn_readfirstlane(tid >> 6), lane = tid & 63, wr = wid >> 2, wc = wid & 3, fr = lane & 15, fq = lane >> 4;
    const int K = g.K, nt = K / BK;
    unsigned voffA[2], voffB[2];
#pragma unroll
    for (int i = 0; i < 2; ++i) { int R, C; stage_rc(tid * 16 + i * 8192, R, C); const int Rb = Epi::PERM ? ((R & ~31) + perm32(R & 31)) : R;
        voffA[i] = (unsigned)(R * K + C) * 2u; voffB[i] = (unsigned)(Rb * K + C) * 2u; }
    const size_t kstep = (size_t)(BK * 2);
    const size_t hstep = (size_t)HALF * K * 2;
    const size_t tstep = 2 * hstep;
    const unsigned ldsw = (unsigned)wid * 1024u;
    const int aoff = lds_byte(wr * 64 + fr, fq * 8), boff = lds_byte(wc * 32 + fr, fq * 8);
#define PG8_SA(b, h) (((b) * 2 + (h)) * HTB)
#define PG8_SB(b, h) ((4 + (b) * 2 + (h)) * HTB)
#define PG8_STAGE(bufoff, gbase, voff) do { _Pragma("unroll") for (int _i = 0; _i < 2; ++_i) \
        __builtin_amdgcn_global_load_lds((const unsigned*)((const char*)(gbase) + (voff)[_i]), (PG8_LAS unsigned*)(lds + (bufoff) + ldsw + _i * 8192), 16, 0, 0); } while (0)
#define PG8_LDA(dst, b, h) do { _Pragma("unroll") for (int m = 0; m < 4; ++m) _Pragma("unroll") for (int k = 0; k < 2; ++k) dst[m][k] = *(const PG8_LAS bf16x8*)(lds + PG8_SA(b, h) + aoff + m * 2048 + k * 1024); } while (0)
#define PG8_LDB(dst, b, h) do { _Pragma("unroll") for (int n = 0; n < 2; ++n) _Pragma("unroll") for (int k = 0; k < 2; ++k) dst[n][k] = *(const PG8_LAS bf16x8*)(lds + PG8_SB(b, h) + boff + n * 2048 + k * 1024); } while (0)
#define PG8_MMA(ai, bj, At, Bt) do { __builtin_amdgcn_s_setprio(1); _Pragma("unroll") for (int m = 0; m < 4; ++m) _Pragma("unroll") for (int n = 0; n < 2; ++n) _Pragma("unroll") for (int k = 0; k < 2; ++k) \
        acc[ai][bj][m][n] = __builtin_amdgcn_mfma_f32_16x16x32_bf16(Bt[n][k], At[m][k], acc[ai][bj][m][n], 0, 0, 0); __builtin_amdgcn_s_setprio(0); } while (0)
#define PG8_WAIT_V(n) asm volatile("s_waitcnt vmcnt(" #n ")" ::: "memory")
#define PG8_WAIT_L(n) asm volatile("s_waitcnt lgkmcnt(" #n ")" ::: "memory")
#define PG8_BAR __builtin_amdgcn_s_barrier()
#define PG8_SCHED __builtin_amdgcn_sched_barrier(0)
    Unit cur, nxt; int ui = 0;
    if (!S.next(0, cur)) return;
    f32x4 acc[2][2][4][2];
#pragma unroll
    for (int a = 0; a < 2; ++a)
#pragma unroll
        for (int b = 0; b < 2; ++b)
#pragma unroll
            for (int m = 0; m < 4; ++m)
#pragma unroll
                for (int n = 0; n < 2; ++n) acc[a][b][m][n] = (f32x4){0.f, 0.f, 0.f, 0.f};
    bf16x8 At[4][2], B0[2][2], B1[2][2];
    const char* cA = (const char*)g.A + (size_t)cur.pm * tstep; const char* cB = (const char*)g.Bt + (size_t)cur.pn * tstep;
    S.a_ready(cur);
    if constexpr (SP2) {
        PG8_STAGE(PG8_SB(0, 0), cB, voffB); PG8_STAGE(PG8_SB(0, 1), cB + hstep, voffB); PG8_STAGE(PG8_SA(0, 0), cA, voffA); PG8_STAGE(PG8_SA(0, 1), cA + hstep, voffA);
        if (wr == 1) PG8_BAR;
        PG8_WAIT_V(2); PG8_BAR;
        PG8_STAGE(PG8_SB(1, 0), cB + kstep, voffB); PG8_STAGE(PG8_SA(1, 0), cA + kstep, voffA); PG8_STAGE(PG8_SB(1, 1), cB + hstep + kstep, voffB);
        PG8_WAIT_V(6); PG8_BAR;
    } else {
        PG8_STAGE(PG8_SB(0, 0), cB, voffB); PG8_STAGE(PG8_SA(0, 0), cA, voffA); PG8_STAGE(PG8_SB(0, 1), cB + hstep, voffB); PG8_STAGE(PG8_SA(0, 1), cA + hstep, voffA);
        if (wr == 1) PG8_BAR;
        PG8_WAIT_V(4); PG8_BAR;
        PG8_STAGE(PG8_SB(1, 0), cB + kstep, voffB); PG8_STAGE(PG8_SA(1, 0), cA + kstep, voffA); PG8_STAGE(PG8_SB(1, 1), cB + hstep + kstep, voffB);
        PG8_WAIT_V(6); PG8_BAR;
    }
    for (;;) {
        const bool has_next = S.next(ui + 1, nxt);
        const char* nA = has_next ? (const char*)g.A + (size_t)nxt.pm * tstep : cA; const char* nB = has_next ? (const char*)g.Bt + (size_t)nxt.pn * tstep : cB;
        for (int t = 0; t < nt; t += 2) {
            const bool last = (t == nt - 2);
            const char* a1 = cA + (size_t)(t + 1) * kstep;
            const char* a2 = last ? nA : cA + (size_t)(t + 2) * kstep; const char* b2 = last ? nB : cB + (size_t)(t + 2) * kstep;
            const char* a3 = a2 + kstep; const char* b3 = b2 + kstep;
            if (last && has_next) S.a_ready(nxt);
            if constexpr (SP2) {
            PG8_LDB(B0, 0, 0); PG8_LDB(B1, 0, 1); PG8_SCHED; PG8_LDA(At, 0, 0); PG8_STAGE(PG8_SA(1, 1), a1 + hstep, voffA);
            PG8_WAIT_V(8); PG8_WAIT_L(0); PG8_BAR; PG8_MMA(0, 0, At, B0); PG8_MMA(0, 1, At, B1); PG8_BAR; PG8_SCHED;
            PG8_LDA(At, 0, 1); PG8_STAGE(PG8_SB(0, 0), b2, voffB); PG8_STAGE(PG8_SB(0, 1), b2 + hstep, voffB); PG8_STAGE(PG8_SA(0, 0), a2, voffA);
            PG8_WAIT_V(8); PG8_WAIT_L(0); PG8_BAR; PG8_MMA(1, 0, At, B0); PG8_MMA(1, 1, At, B1); PG8_BAR; PG8_SCHED;
            PG8_LDB(B0, 1, 0); PG8_LDB(B1, 1, 1); PG8_SCHED; PG8_LDA(At, 1, 0); PG8_STAGE(PG8_SA(0, 1), a2 + hstep, voffA);
            PG8_WAIT_V(8); PG8_WAIT_L(0); PG8_BAR; PG8_MMA(0, 0, At, B0); PG8_MMA(0, 1, At, B1); PG8_BAR; PG8_SCHED;
            PG8_LDA(At, 1, 1); PG8_STAGE(PG8_SB(1, 0), b3, voffB); PG8_STAGE(PG8_SB(1, 1), b3 + hstep, voffB); PG8_STAGE(PG8_SA(1, 0), a3, voffA);
            PG8_WAIT_V(8); PG8_WAIT_L(0); PG8_BAR; PG8_MMA(1, 0, At, B0); PG8_MMA(1, 1, At, B1); PG8_BAR; PG8_SCHED;
            } else {
            PG8_LDB(B0, 0, 0); PG8_SCHED; PG8_LDA(At, 0, 0); PG8_STAGE(PG8_SA(1, 1), a1 + hstep, voffA);
            PG8_WAIT_L(8); PG8_BAR; PG8_WAIT_L(0); PG8_MMA(0, 0, At, B0); PG8_BAR; PG8_SCHED;
            PG8_LDB(B1, 0, 1); PG8_STAGE(PG8_SB(0, 0), b2, voffB);
            PG8_BAR; PG8_WAIT_L(0); PG8_MMA(0, 1, At, B1); PG8_BAR;
            PG8_LDA(At, 0, 1); PG8_STAGE(PG8_SA(0, 0), a2, voffA);
            PG8_BAR; PG8_WAIT_L(0); PG8_MMA(1, 0, At, B0); PG8_BAR; PG8_SCHED;
            PG8_STAGE(PG8_SB(0, 1), b2 + hstep, voffB);
            PG8_WAIT_V(6); PG8_BAR; PG8_MMA(1, 1, At, B1); PG8_BAR;
            PG8_LDB(B0, 1, 0); PG8_SCHED; PG8_LDA(At, 1, 0); PG8_STAGE(PG8_SA(0, 1), a2 + hstep, voffA);
            PG8_WAIT_L(8); PG8_BAR; PG8_WAIT_L(0); PG8_MMA(0, 0, At, B0); PG8_BAR; PG8_SCHED;
            PG8_LDB(B1, 1, 1); PG8_STAGE(PG8_SB(1, 0), b3, voffB);
            PG8_BAR; PG8_WAIT_L(0); PG8_MMA(0, 1, At, B1); PG8_BAR;
            PG8_LDA(At, 1, 1); PG8_STAGE(PG8_SA(1, 0), a3, voffA);
            PG8_BAR; PG8_WAIT_L(0); PG8_MMA(1, 0, At, B0); PG8_BAR; PG8_SCHED;
            PG8_STAGE(PG8_SB(1, 1), b3 + hstep, voffB);
            PG8_WAIT_V(6); PG8_BAR; PG8_MMA(1, 1, At, B1); PG8_BAR;
            }
        }
        if constexpr (ALIGN_EPI) { if (wr == 0) PG8_BAR; }
        if constexpr (!Epi::AFTER_DRAIN) { E(acc, cur, wr, wc, fr, fq); S.done(cur); }
        if (!has_next) break;
#pragma unroll
        for (int a = 0; a < 2; ++a)
#pragma unroll
            for (int b = 0; b < 2; ++b)
#pragma unroll
                for (int m = 0; m < 4; ++m)
#pragma unroll
                    for (int n = 0; n < 2; ++n) acc[a][b][m][n] = (f32x4){0.f, 0.f, 0.f, 0.f};
        cur = nxt; cA = nA; cB = nB; ++ui;
        if constexpr (ALIGN_EPI) { if (wr == 1) PG8_BAR; }
    }
    PG8_WAIT_V(0);
    if constexpr (!ALIGN_EPI) { if (wr == 0) PG8_BAR; }
    PG8_BAR;
    if constexpr (Epi::AFTER_DRAIN) { E.fused(acc, cur, wr, wc, fr, fq, lds, wid, lane); S.done(cur); }
#undef PG8_SA
#undef PG8_SB
#undef PG8_STAGE
#undef PG8_LDA
#undef PG8_LDB
#undef PG8_MMA
#undef PG8_WAIT_V
#undef PG8_WAIT_L
#undef PG8_BAR
#undef PG8_SCHED
}
}
namespace att {
using bf16 = __hip_bfloat16;
constexpr int   D = 128, NW = 8, QBLK = 32, KVBLK = 64;
constexpr float SCALE = 0.088388347648318440f;
constexpr float THR = 8.f;
constexpr int SDEPTH = 2;
constexpr int LDQ = 1024, LDK = 256, LDY = 2048, LDG = NINP;
constexpr size_t SHM_V = KVBLK * D * 2, SHM_K = KVBLK * D * 2, SHM_ATTN = 2 * SHM_V + 2 * SHM_K + NW * 64 * 4;
using bf16x8 = __attribute__((ext_vector_type(8))) short;
using s16x4  = __attribute__((ext_vector_type(4))) short;
using f32x16 = __attribute__((ext_vector_type(16))) float;
using f32x8  = __attribute__((ext_vector_type(8))) float;
using u32x4  = __attribute__((ext_vector_type(4))) unsigned;
#define KSWZ(row, colB) ((row) * 256 + ((colB) ^ (((row) & 7) << 4)))
#define SBAR() __builtin_amdgcn_sched_barrier(0)
__device__ __forceinline__ int crow(int r, int hi) { return (r & 3) + 8 * (r >> 2) + 4 * hi; }
__device__ __forceinline__ unsigned cvtpk(float lo, float hi) {
  unsigned r; asm volatile("v_cvt_pk_bf16_f32 %0, %1, %2" : "=v"(r) : "v"(lo), "v"(hi)); return r;
}
template <typename TIn> struct Stage;
template <> struct Stage<bf16>  { using T = bf16x8;
  __device__ static __forceinline__ T ld8(const bf16* p) { return *reinterpret_cast<const bf16x8*>(p); }
  __device__ static __forceinline__ bf16x8 tobf(T x) { return x; } };
template <> struct Stage<float> { using T = f32x8;
  __device__ static __forceinline__ T ld8(const float* p) { return *reinterpret_cast<const f32x8*>(p); }
  __device__ static __forceinline__ bf16x8 tobf(T x) {
    u32x4 w = {cvtpk(x[0], x[1]), cvtpk(x[2], x[3]), cvtpk(x[4], x[5]), cvtpk(x[6], x[7])}; return *reinterpret_cast<bf16x8*>(&w); } };

__device__ __forceinline__ void partialSM(f32x16& p0, f32x16& p1, float& m_reg, float& mn, float& alpha) {
  constexpr float C = SCALE * 1.4426950408889634f;
  float pmax = p0[0]; for (int r = 1; r < 16; ++r) pmax = fmaxf(pmax, p0[r]); for (int r = 0; r < 16; ++r) pmax = fmaxf(pmax, p1[r]);
  { auto rr = __builtin_amdgcn_permlane32_swap(__float_as_uint(pmax), __float_as_uint(pmax), false, false);
    pmax = fmaxf(__uint_as_float(rr[0]), __uint_as_float(rr[1])); }
  if (__builtin_expect(__all(pmax - m_reg <= THR / SCALE), 1)) { mn = m_reg; alpha = 1.f; }
  else { mn = fmaxf(m_reg, pmax); alpha = __builtin_amdgcn_exp2f((m_reg - mn) * C); m_reg = mn; }
  float mnC = -mn * C;
  for (int r = 0; r < 16; ++r) p0[r] = fmaf(p0[r], C, mnC); for (int r = 0; r < 16; ++r) p1[r] = fmaf(p1[r], C, mnC);
  for (int r = 0; r < 16; ++r) p0[r] = __builtin_amdgcn_exp2f(p0[r]);
}
__device__ __forceinline__ void finishSM(f32x16& p0, f32x16& p1, float alpha, float& l_reg, bf16x8& pa0, bf16x8& pa1, bf16x8& pa2, bf16x8& pa3) {
  for (int r = 0; r < 16; ++r) p1[r] = __builtin_amdgcn_exp2f(p1[r]);
  float ps = 0; for (int r = 0; r < 16; ++r) ps += p0[r]; for (int r = 0; r < 16; ++r) ps += p1[r];
  { auto rr = __builtin_amdgcn_permlane32_swap(__float_as_uint(ps), __float_as_uint(ps), false, false);
    ps = __uint_as_float(rr[0]) + __uint_as_float(rr[1]); }
  l_reg = l_reg * alpha + ps;
#define PK4(P, BASE, OUT) do { unsigned a0 = cvtpk(P[BASE + 0], P[BASE + 1]), a1 = cvtpk(P[BASE + 2], P[BASE + 3]);   \
    unsigned b0 = cvtpk(P[BASE + 4], P[BASE + 5]), b1 = cvtpk(P[BASE + 6], P[BASE + 7]);                              \
    auto r0 = __builtin_amdgcn_permlane32_swap(a0, b0, false, false); auto r1 = __builtin_amdgcn_permlane32_swap(a1, b1, false, false); \
    u32x4 w = {r0[0], r1[0], r0[1], r1[1]}; OUT = *reinterpret_cast<bf16x8*>(&w); } while (0)
  PK4(p0, 0, pa0); PK4(p0, 8, pa1); PK4(p1, 0, pa2); PK4(p1, 8, pa3);
#undef PK4
}
__device__ __forceinline__ void qkt(f32x16& p0, f32x16& p1, const bf16* Ks, const bf16x8* qr, int r32, int hi) {
  p0 = f32x16{}; p1 = f32x16{};
  for (int d0 = 0; d0 < 8; ++d0) { int cb = (d0 * 16 + hi * 8) * 2;
    bf16x8 b0 = *reinterpret_cast<const bf16x8*>((const char*)Ks + KSWZ(r32, cb));
    bf16x8 b1 = *reinterpret_cast<const bf16x8*>((const char*)Ks + KSWZ(32 + r32, cb));
    p0 = __builtin_amdgcn_mfma_f32_32x32x16_bf16(b0, qr[d0], p0, 0, 0, 0);
    p1 = __builtin_amdgcn_mfma_f32_32x32x16_bf16(b1, qr[d0], p1, 0, 0, 0); }
}
__device__ __forceinline__ int v_st(int k, int c) { const int kk = (k & ~0xC) | ((k & 4) << 1) | ((k & 8) >> 1); return ((kk >> 3) * 4 + (c >> 5)) * 512 + ((kk & 7) * 32 + (c & 31)) * 2; }
__device__ __forceinline__ int v_rd_base(int lane) { return ((lane & 3) << 3) | (((lane >> 2) & 3) << 6) | (((lane >> 4) & 1) << 5) | (((lane >> 5) & 1) << 8); }
constexpr int v_rd_off(int d0, int ks, int half) { return d0 * 512 + ks * 4096 + half * 2048; }
template <int OFF> __device__ __forceinline__ s16x4 tr_read(int vb) {
  s16x4 r; asm volatile("ds_read_b64_tr_b16 %0, %1 offset:%2" : "=&v"(r) : "v"(vb), "i"(OFF) : "memory"); return r;
}
template <int D0> __device__ __forceinline__ void pv_one(f32x16& od, int vb, bf16x8 pa0, bf16x8 pa1, bf16x8 pa2, bf16x8 pa3) {
  const s16x4 l0 = tr_read<v_rd_off(D0, 0, 0)>(vb), h0 = tr_read<v_rd_off(D0, 0, 1)>(vb), l1 = tr_read<v_rd_off(D0, 1, 0)>(vb), h1 = tr_read<v_rd_off(D0, 1, 1)>(vb);
  const s16x4 l2 = tr_read<v_rd_off(D0, 2, 0)>(vb), h2 = tr_read<v_rd_off(D0, 2, 1)>(vb), l3 = tr_read<v_rd_off(D0, 3, 0)>(vb), h3 = tr_read<v_rd_off(D0, 3, 1)>(vb);
  asm volatile("s_waitcnt lgkmcnt(0)" ::: "memory"); SBAR();
#define PK(L, H) (bf16x8){L[0], L[1], L[2], L[3], H[0], H[1], H[2], H[3]}
  od = __builtin_amdgcn_mfma_f32_32x32x16_bf16(pa0, PK(l0, h0), od, 0, 0, 0);
  od = __builtin_amdgcn_mfma_f32_32x32x16_bf16(pa1, PK(l1, h1), od, 0, 0, 0);
  od = __builtin_amdgcn_mfma_f32_32x32x16_bf16(pa2, PK(l2, h2), od, 0, 0, 0);
  od = __builtin_amdgcn_mfma_f32_32x32x16_bf16(pa3, PK(l3, h3), od, 0, 0, 0);
#undef PK
}
__device__ __forceinline__ void pv_d0(f32x16* o, int vb, bf16x8 pa0, bf16x8 pa1, bf16x8 pa2, bf16x8 pa3) {
  pv_one<0>(o[0], vb, pa0, pa1, pa2, pa3); pv_one<1>(o[1], vb, pa0, pa1, pa2, pa3); pv_one<2>(o[2], vb, pa0, pa1, pa2, pa3); pv_one<3>(o[3], vb, pa0, pa1, pa2, pa3);
}
__device__ __forceinline__ void attn_dense_body(const bf16* __restrict__ Qb, const bf16* __restrict__ Kh, const bf16* __restrict__ Vh,
                                                unsigned short* __restrict__ Yb, const unsigned short* __restrict__ Gb, int seq, char* lds) {
  using St = Stage<bf16>; using SQ = Stage<bf16>; using TQ = bf16;
  const int tid = threadIdx.x, wid = tid >> 6, lane = tid & 63, r32 = lane & 31, hi = lane >> 5;
  bf16* V_lds = (bf16*)lds; bf16* K_lds = (bf16*)(lds + 2 * SHM_V);
  float* ws = (float*)(lds + 2 * SHM_V + 2 * SHM_K) + wid * 64; float* li_l = ws; float* al_l = ws + 32;
  float m_reg = -1e30f, l_reg = 0; f32x16 o[4] = {}; bf16x8 qr[8];
  const TQ* Qw = Qb + (long)(wid * QBLK + r32) * LDQ + hi * 8;
#pragma unroll
  for (int d0 = 0; d0 < 8; ++d0) qr[d0] = SQ::tobf(SQ::ld8(Qw + d0 * 16));
  const int sr = tid >> 4, sc = (tid & 15) * 8, vst0 = v_st(sr, sc), vst1 = v_st(32 + sr, sc);
  const int vb0 = (int)(uintptr_t)V_lds + v_rd_base(lane);
  struct { typename St::T vs0, vs1, ks0, ks1; } sr_[SDEPTH];
#define SLOAD(i, k0) do { sr_[i].vs0 = St::ld8(&Vh[(long)((k0) + sr) * LDK + sc]); sr_[i].vs1 = St::ld8(&Vh[(long)((k0) + 32 + sr) * LDK + sc]); \
    sr_[i].ks0 = St::ld8(&Kh[(long)((k0) + sr) * LDK + sc]); sr_[i].ks1 = St::ld8(&Kh[(long)((k0) + 32 + sr) * LDK + sc]); } while (0)
#define SWRITE(b, i) do { *(bf16x8*)((char*)V_lds + (b) * SHM_V + vst0) = St::tobf(sr_[i].vs0);          \
    *(bf16x8*)((char*)V_lds + (b) * SHM_V + vst1) = St::tobf(sr_[i].vs1); int kc = sc * 2;               \
    *(bf16x8*)((char*)K_lds + (b) * SHM_K + KSWZ(sr, kc)) = St::tobf(sr_[i].ks0);                       \
    *(bf16x8*)((char*)K_lds + (b) * SHM_K + KSWZ(32 + sr, kc)) = St::tobf(sr_[i].ks1); } while (0)
#define SWAIT() do { if constexpr (SDEPTH == 2) asm volatile("s_waitcnt vmcnt(4)" ::: "memory"); else asm volatile("s_waitcnt vmcnt(0)" ::: "memory"); } while (0)
#define RESC(a) do { if (__any((a) < 1.f)) { if (hi == 0) al_l[r32] = (a); asm volatile("s_waitcnt lgkmcnt(0)" ::: "memory"); \
    for (int d = 0; d < 4; ++d) for (int r = 0; r < 16; ++r) o[d][r] *= al_l[crow(r, hi)]; } } while (0)
  f32x16 pA0, pA1, pB0, pB1; float mnA, mnB, alA, alB; bf16x8 pa0, pa1, pa2, pa3; const int NT = seq / KVBLK;
  constexpr int SE = 0, SO = SDEPTH - 1;
  SLOAD(SE, 0); asm volatile("s_waitcnt vmcnt(0)" ::: "memory"); SWRITE(0, SE); __syncthreads();
  qkt(pA0, pA1, K_lds, qr, r32, hi); partialSM(pA0, pA1, m_reg, mnA, alA);
  SLOAD(SO, KVBLK); if constexpr (SDEPTH == 2) { if (2 < NT) SLOAD(SE, 2 * KVBLK); }
  SWAIT(); SWRITE(1, SO); __syncthreads();
  for (int j = 1; j + 1 < NT; j += 2) {
    SBAR(); qkt(pB0, pB1, (bf16*)((char*)K_lds + SHM_K), qr, r32, hi);
    finishSM(pA0, pA1, alA, l_reg, pa0, pa1, pa2, pa3); SBAR();
    SLOAD(SO, (j + SDEPTH) * KVBLK); SBAR();
    pv_d0(o, vb0, pa0, pa1, pa2, pa3); partialSM(pB0, pB1, m_reg, mnB, alB);
    __syncthreads(); SWAIT(); SWRITE(0, SE);
    RESC(alB); __syncthreads();
    SBAR(); qkt(pA0, pA1, K_lds, qr, r32, hi);
    finishSM(pB0, pB1, alB, l_reg, pa0, pa1, pa2, pa3); SBAR();
    if (SDEPTH == 1 || j + 3 < NT) SLOAD(SE, (j + 1 + SDEPTH) * KVBLK); SBAR();
    pv_d0(o, vb0 + (int)SHM_V, pa0, pa1, pa2, pa3); partialSM(pA0, pA1, m_reg, mnA, alA);
    __syncthreads(); SWAIT(); SWRITE(1, SO);
    RESC(alA); __syncthreads();
  }
  SBAR(); qkt(pB0, pB1, (bf16*)((char*)K_lds + SHM_K), qr, r32, hi);
  finishSM(pA0, pA1, alA, l_reg, pa0, pa1, pa2, pa3); SBAR();
  pv_d0(o, vb0, pa0, pa1, pa2, pa3); partialSM(pB0, pB1, m_reg, mnB, alB);
  __syncthreads(); RESC(alB);
  finishSM(pB0, pB1, alB, l_reg, pa0, pa1, pa2, pa3); SBAR();
  pv_d0(o, vb0 + (int)SHM_V, pa0, pa1, pa2, pa3);
  if (hi == 0) li_l[r32] = l_reg; asm volatile("s_waitcnt lgkmcnt(0)" ::: "memory");
  float rli[16];
#pragma unroll
  for (int r = 0; r < 16; ++r) rli[r] = __builtin_amdgcn_rcpf(li_l[crow(r, hi)]);
  __syncthreads();
  { int ew = wid; asm volatile("" : "+v"(ew));
    float* stg = (float*)lds + ew * (32 * 132);
#pragma unroll
    for (int r = 0; r < 16; ++r) { const int orow = crow(r, hi);
#pragma unroll
      for (int d0 = 0; d0 < 4; ++d0) stg[orow * 132 + d0 * 32 + r32] = o[d0][r] * rli[r]; }
    asm volatile("s_waitcnt lgkmcnt(0)" ::: "memory");
    int el = lane; asm volatile("" : "+v"(el));
    const unsigned short* Gw0 = Gb + (long)(ew * QBLK) * LDG; unsigned short* Yw0 = Yb + (long)(ew * QBLK) * LDY;
#pragma unroll 2
    for (int i = 0; i < 8; ++i) { const int id = el + 64 * i, row = id >> 4, c8 = id & 15;
      const float* sp = stg + row * 132 + c8 * 8;
      const u32x4 gw = *reinterpret_cast<const u32x4*>(Gw0 + (long)row * LDG + c8 * 8);
      u32x4 ow;
#pragma unroll
      for (int q = 0; q < 4; ++q) { const unsigned gq = (q == 0) ? gw.x : (q == 1) ? gw.y : (q == 2) ? gw.z : gw.w;
        const float g0 = __uint_as_float(gq << 16), g1 = __uint_as_float(gq & 0xffff0000u);
        const float v0 = sp[2 * q] * (g0 / (1.f + __expf(-g0))), v1 = sp[2 * q + 1] * (g1 / (1.f + __expf(-g1)));
        const unsigned pk = cvtpk(v0, v1);
        if (q == 0) ow.x = pk; else if (q == 1) ow.y = pk; else if (q == 2) ow.z = pk; else ow.w = pk; }
      *reinterpret_cast<u32x4*>(Yw0 + (long)row * LDY + c8 * 8) = ow; } }
#undef SLOAD
#undef SWRITE
#undef SWAIT
#undef RESC
}
}
#define GAS __attribute__((address_space(1)))
#define LAS __attribute__((address_space(3)))
typedef unsigned short bf16_t;
typedef unsigned v4u __attribute__((ext_vector_type(4)));
typedef unsigned v2u __attribute__((ext_vector_type(2)));
typedef float f32x4 __attribute__((ext_vector_type(4)));
typedef short bf16x8_t __attribute__((ext_vector_type(8)));
typedef float f32x16_t __attribute__((ext_vector_type(16)));
#define LDS_WAIT() asm volatile("s_waitcnt lgkmcnt(0)" ::: "memory")

constexpr size_t MiB = 1u << 20;
constexpr size_t WS_CTL = 0, CTL_ZERO_BYTES = 1 * MiB;
constexpr size_t WS_MOD = 64 * 1024;
constexpr size_t WS_ROPE = 1 * MiB;
constexpr size_t WS_SMALL = 2 * MiB;
constexpr size_t WS_WIN0 = 3 * MiB, WS_WOUT0 = 24 * MiB;
constexpr size_t WS_QB = 32 * MiB, WS_KB = 48 * MiB, WS_VB = 52 * MiB;
constexpr size_t WS_HB = 3 * MiB;
constexpr size_t WS_WIN1 = 56 * MiB, WS_WOUT1 = 77 * MiB;
constexpr size_t WS_H = 85 * MiB;
constexpr size_t WS_HF = 85 * MiB;
constexpr size_t WS_PROJ = 117 * MiB;
constexpr size_t WS_YCAT = 201 * MiB;
constexpr size_t WS_ACT = 233 * MiB;
constexpr size_t WS_YF = 297 * MiB, WS_YB = 329 * MiB;
constexpr size_t WS_XBC16 = 85 * MiB;
constexpr size_t WS_QKV16 = 3 * MiB;
constexpr size_t WS_GT = 85 * MiB, WS_GA = 101 * MiB;
constexpr size_t WS_WGT = 361 * MiB;
constexpr size_t WS_LSUM = 362 * MiB;
constexpr size_t WS_END = 366 * MiB;

constexpr int NWAVES = 8, NTHREADS = 512;
constexpr int LDS_BYTES = 147456;
constexpr int NPHASE = 15;

struct Args { const float* in[39]; float* out; unsigned char* ws; int ph_lo, ph_hi; };

__device__ __forceinline__ float bf2f(unsigned v) { return __uint_as_float(v << 16); }
__device__ __forceinline__ unsigned f2bf(float f) { unsigned u = __float_as_uint(f); return (u + 0x7fffu + ((u >> 16) & 1u)) >> 16; }
__device__ __forceinline__ unsigned pk2(float lo, float hi) { return f2bf(lo) | (f2bf(hi) << 16); }
__device__ __forceinline__ void unpack8(const v4u w, float* x) {
    x[0] = __uint_as_float(w.x << 16); x[1] = __uint_as_float(w.x & 0xffff0000u); x[2] = __uint_as_float(w.y << 16); x[3] = __uint_as_float(w.y & 0xffff0000u);
    x[4] = __uint_as_float(w.z << 16); x[5] = __uint_as_float(w.z & 0xffff0000u); x[6] = __uint_as_float(w.w << 16); x[7] = __uint_as_float(w.w & 0xffff0000u);
}
__device__ __forceinline__ v4u pack8(const float* x) { v4u w; w.x = pk2(x[0], x[1]); w.y = pk2(x[2], x[3]); w.z = pk2(x[4], x[5]); w.w = pk2(x[6], x[7]); return w; }
__device__ __forceinline__ float silu_f(float x) { return x / (1.f + expf(-x)); }
__device__ __forceinline__ float sigmoid_f(float x) { return 1.f / (1.f + expf(-x)); }
__device__ __forceinline__ float softplus_f(float x) { return fmaxf(x, 0.f) + log1pf(expf(-fabsf(x))); }
template <int CTRL> __device__ __forceinline__ float dpp_mov(float v) { return __builtin_bit_cast(float, __builtin_amdgcn_update_dpp(0, __builtin_bit_cast(int, v), CTRL, 0xF, 0xF, true)); }
template <int N> __device__ __forceinline__ float group_sum(float v) {
    if (N >= 2) v += dpp_mov<0xB1>(v);
    if (N >= 4) v += dpp_mov<0x4E>(v);
    if (N >= 8) v += dpp_mov<0x141>(v);
    if (N >= 16) v += dpp_mov<0x140>(v);
    if (N >= 32) v += __shfl_xor(v, 16);
    if (N >= 64) v += __shfl_xor(v, 32);
    return v;
}

__device__ __forceinline__ void p0_transpose_item(const float* W, int K, int N, bf16_t* WT, int row_off, LAS float* scr, int item, int lane) {
    const int nblk = N / 32, kb = item / nblk, nb = item % nblk, k0 = 64 * kb, n0 = 32 * nb;
#pragma unroll 8
    for (int i = 0; i < 32; ++i) { const int kk = 2 * i + (lane >> 5); scr[kk * 33 + (lane & 31)] = W[(size_t)(k0 + kk) * N + n0 + (lane & 31)]; }
    LDS_WAIT(); asm volatile("" ::: "memory");
    const int c = lane & 7;
#pragma unroll
    for (int j = 0; j < 4; ++j) { const int n = (lane >> 3) + 8 * j; const LAS float* s = scr + (8 * c) * 33 + n;
        v4u o; o.x = pk2(s[0 * 33], s[1 * 33]); o.y = pk2(s[2 * 33], s[3 * 33]); o.z = pk2(s[4 * 33], s[5 * 33]); o.w = pk2(s[6 * 33], s[7 * 33]);
        *(v4u*)(WT + (size_t)(row_off + n0 + n) * K + k0 + 8 * c) = o; }
    LDS_WAIT(); asm volatile("" ::: "memory");
}

__device__ __forceinline__ void p0_prologue(const Args& a, LAS unsigned char* lds, int vcu, int G) {
    const int tid = threadIdx.x, lane = tid & 63, wave = tid >> 6;
    unsigned char* ws = a.ws;
    { const int gid = blockIdx.x * NTHREADS + tid;
      if (gid < 2048) { const int pos = gid >> 5, i = gid & 31; const float freq = expf(-(float)i * (1.f / 32.f) * 9.210340371976184f); const float ang = (float)pos * freq;
          float* rt = (float*)(ws + WS_ROPE); rt[2 * gid] = cosf(ang); rt[2 * gid + 1] = sinf(ang); } }
    { const int gid = blockIdx.x * NTHREADS + tid, gn = G * NTHREADS; constexpr int NV = (NINP - NIN) * 2048 * 2 / 16;
      v4u* p0 = (v4u*)(ws + WS_WIN0 + (size_t)NIN * 2048 * 2); v4u* p1 = (v4u*)(ws + WS_WIN1 + (size_t)NIN * 2048 * 2);
      for (int i = gid; i < NV; i += gn) { p0[i] = (v4u){0, 0, 0, 0}; p1[i] = (v4u){0, 0, 0, 0}; } }
    if (blockIdx.x < 192) {
        const int it = blockIdx.x, l = it / 96, r = it % 96, kc = r / 3, nc = r % 3;
        LAS float* cond = (LAS float*)lds;
        if (tid < 256) { const int b = tid >> 6, k = tid & 63; const float c = a.in[1][b * 2048 + kc * 64 + k]; cond[tid] = silu_f(c); }
        __syncthreads();
        const float* W = a.in[2] + (size_t)l * 2048 * 6144 + (size_t)(kc * 64) * 6144 + nc * 2048 + tid * 4;
        f32x4 acc0 = {0, 0, 0, 0}, acc1 = acc0, acc2 = acc0, acc3 = acc0;
#pragma unroll 8
        for (int k = 0; k < 64; ++k) { const f32x4 w = *(const f32x4*)(W + (size_t)k * 6144);
            acc0 += cond[k] * w; acc1 += cond[64 + k] * w; acc2 += cond[128 + k] * w; acc3 += cond[192 + k] * w; }
        float* macc = (float*)(ws + WS_MOD) + (size_t)l * 4 * 6144 + nc * 2048 + tid * 4;
#pragma unroll
        for (int i = 0; i < 4; ++i) { atomicAdd(macc + i, acc0[i]); atomicAdd(macc + 6144 + i, acc1[i]); atomicAdd(macc + 2 * 6144 + i, acc2[i]); atomicAdd(macc + 3 * 6144 + i, acc3[i]); }
        __syncthreads();
    }
    { LAS float* scr = (LAS float*)(lds + wave * 16384);
      const int gw = vcu * NWAVES + wave, NGW = G * NWAVES;
      constexpr int I_IN = 32 * (NIN / 32), I_OUT = 32 * 64, NITEMS = I_IN + I_OUT;
      for (int it = gw; it < NITEMS; it += NGW) {
          int r = it;
          if (r < I_IN) { p0_transpose_item(a.in[5], 2048, NIN, (bf16_t*)(ws + WS_WIN0), 0, scr, r, lane); continue; } r -= I_IN;
          p0_transpose_item(a.in[16], 2048, 2048, (bf16_t*)(ws + WS_WOUT0), 0, scr, r, lane);
      } }
}
__device__ __forceinline__ void late_transposes(const Args& a, LAS float* scr, int hw, int NHW, int lane) {
    unsigned char* ws = a.ws;
    constexpr int I_IN = 32 * (NIN / 32), I_OUT = 32 * 64, I_G = 32 * 8, NITEMS = I_IN + I_OUT + I_G;
    for (int it = hw; it < NITEMS; it += NHW) {
        int r = it;
        if (r < I_G) { const int mn = r >> 3, m = mn >> 3; const float* Wg = a.in[m == 0 ? 27 : m == 1 ? 29 : m == 2 ? 32 : 34] + (size_t)(mn & 7) * 128 * 128;
            p0_transpose_item(Wg, 128, 128, (bf16_t*)(ws + WS_WGT) + (size_t)mn * 128 * 128, 0, scr, r & 7, lane); continue; } r -= I_G;
        if (r < I_IN) { p0_transpose_item(a.in[17], 2048, NIN, (bf16_t*)(ws + WS_WIN1), 0, scr, r, lane); continue; } r -= I_IN;
        p0_transpose_item(a.in[37], 2048, 2048, (bf16_t*)(ws + WS_WOUT1), 0, scr, r, lane);
    }
}

__device__ __forceinline__ void normmod_phase(const Args& a, const float* xin, int layer, int gw, int NGW, int lane) {
    const float* nw = a.in[4] + layer * 2048; const float* bm = a.in[3] + layer * 6144;
    const float* macc = (const float*)(a.ws + WS_MOD) + (size_t)layer * 4 * 6144;
    bf16_t* H = (bf16_t*)(a.ws + WS_H);
    for (int m = gw; m < MTOK; m += NGW) {
        const int b = m >> 11;
        const f32x4* xr = (const f32x4*)(xin + (size_t)m * 2048) + lane;
        f32x4 v[8]; float s = 0.f;
#pragma unroll
        for (int j = 0; j < 8; ++j) { v[j] = xr[64 * j]; s += (v[j].x * v[j].x + v[j].y * v[j].y) + (v[j].z * v[j].z + v[j].w * v[j].w); }
        const float rstd = rsqrtf(group_sum<64>(s) * (1.f / 2048.f) + EPS);
#pragma unroll
        for (int j = 0; j < 8; ++j) { const int col = (64 * j + lane) * 4;
            const f32x4 w = *(const f32x4*)(nw + col);
            const f32x4 sh = *(const f32x4*)(macc + b * 6144 + col) + *(const f32x4*)(bm + col);
            const f32x4 sc = *(const f32x4*)(macc + b * 6144 + 2048 + col) + *(const f32x4*)(bm + 2048 + col);
            const f32x4 o = v[j] * rstd * w * (1.f + sc) + sh;
            v2u pk; pk.x = pk2(o.x, o.y); pk.y = pk2(o.z, o.w);
            *(v2u*)(H + (size_t)m * 2048 + col) = pk; }
    }
}

__device__ __forceinline__ void post0_phase(const Args& a, int gw, int NGW, int lane) {
    const bf16_t* P = (const bf16_t*)(a.ws + WS_PROJ);
    const float2* rope = (const float2*)(a.ws + WS_ROPE);
    const float* qn = a.in[6]; const float* kn = a.in[7]; const float* cw = a.in[8]; const float* cb = a.in[9];
    bf16_t* Q = (bf16_t*)(a.ws + WS_QB); bf16_t* K = (bf16_t*)(a.ws + WS_KB); bf16_t* V = (bf16_t*)(a.ws + WS_VB);
    float* ACT = (float*)(a.ws + WS_ACT);
    for (int m = gw; m < MTOK; m += NGW) {
        const int t = m & 2047, prow = t >> 6, pcol = t & 63;
        const bf16_t* pr = P + (size_t)m * NINP;
        {
            float x[16]; unpack8(*(const v4u*)(pr + A_Q + lane * 16), x); unpack8(*(const v4u*)(pr + A_Q + lane * 16 + 8), x + 8);
            float ss = 0.f;
#pragma unroll
            for (int i = 0; i < 16; ++i) ss += x[i] * x[i];
            ss = group_sum<8>(ss);
            const float r = rsqrtf(ss * (1.f / 128.f) + EPS);
            const int d0 = (lane & 7) * 16;
#pragma unroll
            for (int i = 0; i < 16; ++i) x[i] = x[i] * r * qn[d0 + i];
#pragma unroll
            for (int pi = 0; pi < 8; ++pi) { const int p = (d0 >> 1) + pi; const float2 cs = (p < 32) ? rope[prow * 32 + p] : rope[pcol * 32 + p - 32];
                const float x0 = x[2 * pi], x1 = x[2 * pi + 1]; x[2 * pi] = x0 * cs.x - x1 * cs.y; x[2 * pi + 1] = x0 * cs.y + x1 * cs.x; }
            *(v4u*)(Q + (size_t)m * 1024 + lane * 16) = pack8(x); *(v4u*)(Q + (size_t)m * 1024 + lane * 16 + 8) = pack8(x + 8);
        }
        {
            const v2u w = *(const v2u*)(pr + A_K + lane * 4);
            float x[4] = {__uint_as_float(w.x << 16), __uint_as_float(w.x & 0xffff0000u), __uint_as_float(w.y << 16), __uint_as_float(w.y & 0xffff0000u)};
            float ss = (x[0] * x[0] + x[1] * x[1]) + (x[2] * x[2] + x[3] * x[3]);
            ss = group_sum<32>(ss);
            const float r = rsqrtf(ss * (1.f / 128.f) + EPS);
            const int d0 = (lane & 31) * 4;
#pragma unroll
            for (int i = 0; i < 4; ++i) x[i] = x[i] * r * kn[d0 + i];
#pragma unroll
            for (int pi = 0; pi < 2; ++pi) { const int p = (d0 >> 1) + pi; const float2 cs = (p < 32) ? rope[prow * 32 + p] : rope[pcol * 32 + p - 32];
                const float x0 = x[2 * pi], x1 = x[2 * pi + 1]; x[2 * pi] = x0 * cs.x - x1 * cs.y; x[2 * pi + 1] = x0 * cs.y + x1 * cs.x; }
            v2u o; o.x = pk2(x[0], x[1]); o.y = pk2(x[2], x[3]);
            *(v2u*)(K + (size_t)m * 256 + lane * 4) = o;
            *(v2u*)(V + (size_t)m * 256 + lane * 4) = *(const v2u*)(pr + A_V + lane * 4);
        }
#pragma unroll
        for (int j = 0; j < 3; ++j) { const int ch = (j * 64 + lane) * 8;
            float acc[8];
            { const f32x4 b0 = *(const f32x4*)(cb + ch), b1 = *(const f32x4*)(cb + ch + 4); acc[0] = b0.x; acc[1] = b0.y; acc[2] = b0.z; acc[3] = b0.w; acc[4] = b1.x; acc[5] = b1.y; acc[6] = b1.z; acc[7] = b1.w; }
#pragma unroll
            for (int d = 0; d < 4; ++d) { const int ts = t + d - 2;
                if (ts >= 0 && ts < SEQ) { float x[8]; unpack8(*(const v4u*)(P + (size_t)(m + d - 2) * NINP + A_XS + ch), x);
                    const f32x4 w0 = *(const f32x4*)(cw + d * 1536 + ch), w1 = *(const f32x4*)(cw + d * 1536 + ch + 4);
                    acc[0] += w0.x * x[0]; acc[1] += w0.y * x[1]; acc[2] += w0.z * x[2]; acc[3] += w0.w * x[3];
                    acc[4] += w1.x * x[4]; acc[5] += w1.y * x[5]; acc[6] += w1.z * x[6]; acc[7] += w1.w * x[7]; } }
            f32x4 o0, o1; o0.x = silu_f(acc[0]); o0.y = silu_f(acc[1]); o0.z = silu_f(acc[2]); o0.w = silu_f(acc[3]); o1.x = silu_f(acc[4]); o1.y = silu_f(acc[5]); o1.z = silu_f(acc[6]); o1.w = silu_f(acc[7]);
            *(f32x4*)(ACT + (size_t)m * 1536 + ch) = o0; *(f32x4*)(ACT + (size_t)m * 1536 + ch + 4) = o1;
            { v4u w; w.x = pk2(o0.x, o0.y); w.y = pk2(o0.z, o0.w); w.z = pk2(o1.x, o1.y); w.w = pk2(o1.z, o1.w); *(v4u*)((bf16_t*)(a.ws + WS_XBC16) + (size_t)m * 1536 + ch) = w; } }
    }
}

typedef float f32x2 __attribute__((ext_vector_type(2)));
__device__ __forceinline__ void ssd_item(const Args& a, int item, float* lds) {
    const int ph = item & 1, h = (item >> 1) & 15, dir = (item >> 5) & 1, b = item >> 6, g = h >> 3;
    constexpr int BUF = 32 * 32 + 2 * 32 * 128 + 32;
    float* ysb = lds + 2 * BUF;
    const float A = -expf(a.in[dir ? 13 : 12][h]); const float dtb = a.in[dir ? 11 : 10][h];
    const float* ACT = (const float*)(a.ws + WS_ACT); const float* SM = (const float*)(a.ws + WS_SMALL);
    float* Y = (float*)(a.ws + (dir ? WS_YB : WS_YF));
    const int tid = threadIdx.x, p = tid >> 4, ng = tid & 15;
    f32x2 hst[4];
#pragma unroll
    for (int i = 0; i < 4; ++i) hst[i] = (f32x2){0.f, 0.f};
    f32x4 gB[2], gC[2], gx; float gdt;
#define SSD_LOAD(tile_) do { const size_t r0_ = (size_t)b * SEQ + (dir ? 63 - (tile_) : (tile_)) * 32; \
        _Pragma("unroll") for (int i = 0; i < 2; ++i) { const int idx = tid + i * 512, s_ = idx >> 5, c4_ = idx & 31, tl_ = dir ? 31 - s_ : s_; \
            gB[i] = *(const f32x4*)(ACT + (r0_ + tl_) * 1536 + 1024 + g * 128 + c4_ * 4); gC[i] = *(const f32x4*)(ACT + (r0_ + tl_) * 1536 + 1280 + g * 128 + c4_ * 4); } \
        if (tid < 256) { const int s_ = tid >> 3, c4_ = tid & 7, tl_ = dir ? 31 - s_ : s_; gx = *(const f32x4*)(ACT + (r0_ + tl_) * 1536 + h * 64 + ph * 32 + c4_ * 4); gdt = SM[(r0_ + tl_) * 32 + dir * 16 + h]; } } while (0)
#define SSD_STORE(buf_) do { float* xs_ = lds + (buf_) * BUF; float* Bs_ = xs_ + 32 * 32; float* Cs_ = Bs_ + 32 * 128; float* das_ = Cs_ + 32 * 128; \
        _Pragma("unroll") for (int i = 0; i < 2; ++i) { const int idx = tid + i * 512, s_ = idx >> 5, c4_ = idx & 31; const int so_ = s_ * 128 + (c4_ & 1) * 64 + (c4_ >> 1) * 4; \
            *(f32x4*)(Bs_ + so_) = gB[i]; *(f32x4*)(Cs_ + so_) = gC[i]; } \
        if (tid < 256) { const int s_ = tid >> 3, c4_ = tid & 7; const float dt_ = softplus_f(gdt + dtb); *(f32x4*)(xs_ + s_ * 32 + c4_ * 4) = gx * dt_; if (c4_ == 0) das_[s_] = expf(dt_ * A); } } while (0)
    __syncthreads();
    SSD_LOAD(0); SSD_STORE(0);
    __syncthreads();
    for (int tile = 0; tile < 64; ++tile) {
        const int cur = tile & 1;
        const size_t row0 = (size_t)b * SEQ + (dir ? 63 - tile : tile) * 32;
        if (tile + 1 < 64) SSD_LOAD(tile + 1);
        const float* xs = lds + cur * BUF; const float* Bs = xs + 32 * 32; const float* Cs = Bs + 32 * 128; const float* das = Cs + 32 * 128; float* ys = ysb + cur * 1024;
        {
            float n_dA = das[0], n_xdt = xs[p];
            f32x4 n_b0 = *(const f32x4*)(Bs + ng * 4), n_b1 = *(const f32x4*)(Bs + 64 + ng * 4), n_c0 = *(const f32x4*)(Cs + ng * 4), n_c1 = *(const f32x4*)(Cs + 64 + ng * 4);
#pragma unroll 4
            for (int s = 0; s < 32; ++s) {
                const float dA = n_dA, xdt = n_xdt; const f32x4 b0 = n_b0, b1 = n_b1, c0 = n_c0, c1 = n_c1;
                const int sn = (s + 1) & 31;
                n_dA = das[sn]; n_xdt = xs[sn * 32 + p];
                n_b0 = *(const f32x4*)(Bs + sn * 128 + ng * 4); n_b1 = *(const f32x4*)(Bs + sn * 128 + 64 + ng * 4);
                n_c0 = *(const f32x4*)(Cs + sn * 128 + ng * 4); n_c1 = *(const f32x4*)(Cs + sn * 128 + 64 + ng * 4);
                const f32x2 xd2 = (f32x2){xdt, xdt}, da2 = (f32x2){dA, dA};
                hst[0] = hst[0] * da2 + xd2 * (f32x2){b0.x, b0.y};
                hst[1] = hst[1] * da2 + xd2 * (f32x2){b0.z, b0.w};
                hst[2] = hst[2] * da2 + xd2 * (f32x2){b1.x, b1.y};
                hst[3] = hst[3] * da2 + xd2 * (f32x2){b1.z, b1.w};
                f32x2 acc = hst[0] * (f32x2){c0.x, c0.y};
                acc += hst[1] * (f32x2){c0.z, c0.w};
                acc += hst[2] * (f32x2){c1.x, c1.y};
                acc += hst[3] * (f32x2){c1.z, c1.w};
                const float part = group_sum<16>(acc.x + acc.y);
                if (ng == 0) ys[s * 32 + p] = part;
            }
        }
        if (tile + 1 < 64) SSD_STORE(cur ^ 1);
        __syncthreads();
        if (tid < 256) { const int s = tid >> 3, c4 = tid & 7, tl = dir ? 31 - s : s; *(f32x4*)(Y + (row0 + tl) * 1024 + h * 64 + ph * 32 + c4 * 4) = *(const f32x4*)(ys + s * 32 + c4 * 4); }
    }
#undef SSD_LOAD
#undef SSD_STORE
}

__device__ __forceinline__ void ssd_combine_phase(const Args& a, int gw, int NGW, int lane) {
    const float* YF = (const float*)(a.ws + WS_YF); const float* YB = (const float*)(a.ws + WS_YB); const float* ACT = (const float*)(a.ws + WS_ACT);
    const bf16_t* P = (const bf16_t*)(a.ws + WS_PROJ); bf16_t* YC = (bf16_t*)(a.ws + WS_YCAT);
    const float* dsk = a.in[14]; const float* nw = a.in[15];
    for (int m = gw; m < MTOK; m += NGW) {
        const int ch = lane * 16; const float dk = dsk[ch >> 6];
        float z[16], gv[16]; unpack8(*(const v4u*)(P + (size_t)m * NINP + A_Z + ch), z); unpack8(*(const v4u*)(P + (size_t)m * NINP + A_Z + ch + 8), z + 8);
        float ss = 0.f;
#pragma unroll
        for (int q = 0; q < 4; ++q) { const f32x4 f = *(const f32x4*)(YF + (size_t)m * 1024 + ch + 4 * q), bk = *(const f32x4*)(YB + (size_t)m * 1024 + ch + 4 * q), xv = *(const f32x4*)(ACT + (size_t)m * 1536 + ch + 4 * q);
            const f32x4 y = f + bk + dk * xv;
            gv[4 * q] = y.x * silu_f(z[4 * q]); gv[4 * q + 1] = y.y * silu_f(z[4 * q + 1]); gv[4 * q + 2] = y.z * silu_f(z[4 * q + 2]); gv[4 * q + 3] = y.w * silu_f(z[4 * q + 3]); }
#pragma unroll
        for (int i = 0; i < 16; ++i) ss += gv[i] * gv[i];
        const float r = rsqrtf(group_sum<64>(ss) * (1.f / 1024.f) + EPS);
#pragma unroll
        for (int i = 0; i < 16; ++i) gv[i] = gv[i] * r * nw[ch + i];
        *(v4u*)(YC + (size_t)m * 2048 + 1024 + ch) = pack8(gv); *(v4u*)(YC + (size_t)m * 2048 + 1024 + ch + 8) = pack8(gv + 8);
    }
}

__device__ __forceinline__ void post1_phase(const Args& a, int gw, int NGW, int lane) {
    const bf16_t* P = (const bf16_t*)(a.ws + WS_PROJ); const float* cw = a.in[18]; const float* cb = a.in[19];
    float* ACT = (float*)(a.ws + WS_ACT);
    for (int m = gw; m < MTOK; m += NGW) {
        const int t = m & 2047;
#pragma unroll
        for (int j = 0; j < 4; ++j) { const int ch = (j * 64 + lane) * 8;
            float acc[8];
            { const f32x4 b0 = *(const f32x4*)(cb + ch), b1 = *(const f32x4*)(cb + ch + 4); acc[0] = b0.x; acc[1] = b0.y; acc[2] = b0.z; acc[3] = b0.w; acc[4] = b1.x; acc[5] = b1.y; acc[6] = b1.z; acc[7] = b1.w; }
#pragma unroll
            for (int d = 0; d < 4; ++d) { const int ts = t + d - 2;
                if (ts >= 0 && ts < SEQ) { float x[8]; unpack8(*(const v4u*)(P + (size_t)(m + d - 2) * NINP + C_Q + ch), x);
                    const f32x4 w0 = *(const f32x4*)(cw + d * 2048 + ch), w1 = *(const f32x4*)(cw + d * 2048 + ch + 4);
                    acc[0] += w0.x * x[0]; acc[1] += w0.y * x[1]; acc[2] += w0.z * x[2]; acc[3] += w0.w * x[3];
                    acc[4] += w1.x * x[4]; acc[5] += w1.y * x[5]; acc[6] += w1.z * x[6]; acc[7] += w1.w * x[7]; } }
#pragma unroll
            for (int i = 0; i < 8; ++i) acc[i] = silu_f(acc[i]);
            if (j < 2) {
                float ss = 0.f;
#pragma unroll
                for (int i = 0; i < 8; ++i) ss += acc[i] * acc[i];
                ss = group_sum<16>(ss);
                float r = rsqrtf(ss + EPS); if (j == 0) r *= 0.088388347648318440f;
#pragma unroll
                for (int i = 0; i < 8; ++i) acc[i] *= r;
            }
            *(f32x4*)(ACT + (size_t)m * 2048 + ch) = (f32x4){acc[0], acc[1], acc[2], acc[3]}; *(f32x4*)(ACT + (size_t)m * 2048 + ch + 4) = (f32x4){acc[4], acc[5], acc[6], acc[7]};
            *(v4u*)((bf16_t*)(a.ws + WS_QKV16) + (size_t)m * 2048 + ch) = pack8(acc); }
    }
}

__device__ __forceinline__ void gdn_item(const Args& a, int item, float* lds) {
    const int dvs = item & 3, hv = (item >> 2) & 7, dir = (item >> 5) & 1, b = item >> 6, hq = hv >> 1;
    constexpr int BUF = 2 * 32 * 128 + 32 * 32 + 32 * 4;
    float* osb = lds + 2 * BUF;
    const float Aneg = -expf(a.in[dir ? 21 : 20][hv]); const float dtb = a.in[dir ? 23 : 22][hv];
    const float* ACT = (const float*)(a.ws + WS_ACT); const float* SM = (const float*)(a.ws + WS_SMALL);
    float* O = (float*)(a.ws + (dir ? WS_YB : WS_YF));
    const int tid = threadIdx.x, lane = tid & 63, wave = tid >> 6, dkg = lane & 15, dvi = wave * 4 + (lane >> 4);
    f32x2 S[4];
#pragma unroll
    for (int i = 0; i < 4; ++i) S[i] = (f32x2){0.f, 0.f};
    f32x4 gk0, gk1, gq0, gq1, gv; float gbr = 0.f, gar = 0.f;
#define GDN_LOAD(tile_) do { const size_t r0_ = (size_t)b * SEQ + (dir ? 63 - (tile_) : (tile_)) * 32; \
        { const int s_ = tid >> 4, c8_ = tid & 15, tl_ = dir ? 31 - s_ : s_; const float* kp_ = ACT + (r0_ + tl_) * 2048 + 512 + hq * 128 + c8_ * 8; const float* qp_ = ACT + (r0_ + tl_) * 2048 + hq * 128 + c8_ * 8; \
          gk0 = *(const f32x4*)kp_; gk1 = *(const f32x4*)(kp_ + 4); gq0 = *(const f32x4*)qp_; gq1 = *(const f32x4*)(qp_ + 4); \
          if (c8_ == 0) { const float* sm_ = SM + (r0_ + tl_) * 32; gbr = sm_[dir * 8 + hv]; gar = sm_[16 + dir * 8 + hv]; } } \
        if (tid < 256) { const int s2_ = tid >> 3, c4_ = tid & 7, tl2_ = dir ? 31 - s2_ : s2_; gv = *(const f32x4*)(ACT + (r0_ + tl2_) * 2048 + 1024 + hv * 128 + dvs * 32 + c4_ * 4); } } while (0)
#define GDN_STORE(buf_) do { float* ks_ = lds + (buf_) * BUF; float* qs_ = ks_ + 32 * 128; float* vs_ = qs_ + 32 * 128; float* sc_ = vs_ + 32 * 32; \
        { const int s_ = tid >> 4, c8_ = tid & 15; \
          *(f32x4*)(ks_ + s_ * 128 + c8_ * 4) = gk0; *(f32x4*)(ks_ + s_ * 128 + 64 + c8_ * 4) = gk1; *(f32x4*)(qs_ + s_ * 128 + c8_ * 4) = gq0; *(f32x4*)(qs_ + s_ * 128 + 64 + c8_ * 4) = gq1; \
          float kq_ = (gk0.x * gq0.x + gk0.y * gq0.y) + (gk0.z * gq0.z + gk0.w * gq0.w) + (gk1.x * gq1.x + gk1.y * gq1.y) + (gk1.z * gq1.z + gk1.w * gq1.w); \
          kq_ = group_sum<16>(kq_); \
          if (c8_ == 0) { const float beta_ = sigmoid_f(gbr), alpha_ = expf(Aneg * softplus_f(gar + dtb)); *(f32x4*)(sc_ + s_ * 4) = (f32x4){alpha_, beta_, kq_, alpha_ * beta_}; } } \
        if (tid < 256) { const int s2_ = tid >> 3, c4_ = tid & 7; *(f32x4*)(vs_ + s2_ * 32 + c4_ * 4) = gv; } } while (0)
    __syncthreads();
    GDN_LOAD(0); GDN_STORE(0);
    __syncthreads();
    for (int tile = 0; tile < 64; ++tile) {
        const int cur = tile & 1;
        const size_t row0 = (size_t)b * SEQ + (dir ? 63 - tile : tile) * 32;
        if (tile + 1 < 64) GDN_LOAD(tile + 1);
        const float* ks = lds + cur * BUF; const float* qs = ks + 32 * 128; const float* vs = qs + 32 * 128; const float* sc = vs + 32 * 32; float* os = osb + cur * 1024;
        {
            f32x4 n_k0 = *(const f32x4*)(ks + dkg * 4), n_k1 = *(const f32x4*)(ks + 64 + dkg * 4), n_q0 = *(const f32x4*)(qs + dkg * 4), n_q1 = *(const f32x4*)(qs + 64 + dkg * 4);
            f32x4 n_sc = *(const f32x4*)(sc); float n_vv = vs[dvi];
#pragma unroll 4
            for (int s = 0; s < 32; ++s) {
                const f32x4 k0 = n_k0, k1 = n_k1, q0 = n_q0, q1 = n_q1, scv = n_sc; const float vv = n_vv;
                const int sn = (s + 1) & 31;
                n_k0 = *(const f32x4*)(ks + sn * 128 + dkg * 4); n_k1 = *(const f32x4*)(ks + sn * 128 + 64 + dkg * 4);
                n_q0 = *(const f32x4*)(qs + sn * 128 + dkg * 4); n_q1 = *(const f32x4*)(qs + sn * 128 + 64 + dkg * 4);
                n_sc = *(const f32x4*)(sc + sn * 4); n_vv = vs[sn * 32 + dvi];
                const f32x2 ka = (f32x2){k0.x, k0.y}, kb = (f32x2){k0.z, k0.w}, kc = (f32x2){k1.x, k1.y}, kd = (f32x2){k1.z, k1.w};
                f32x2 pk = ka * S[0]; pk += kb * S[1]; pk += kc * S[2]; pk += kd * S[3];
                f32x2 pq = (f32x2){q0.x, q0.y} * S[0]; pq += (f32x2){q0.z, q0.w} * S[1]; pq += (f32x2){q1.x, q1.y} * S[2]; pq += (f32x2){q1.z, q1.w} * S[3];
                float sk = pk.x + pk.y, sq = pq.x + pq.y;
                sk += dpp_mov<0xB1>(sk); sq += dpp_mov<0xB1>(sq);
                sk += dpp_mov<0x4E>(sk); sq += dpp_mov<0x4E>(sq);
                sk += dpp_mov<0x141>(sk); sq += dpp_mov<0x141>(sq);
                sk += dpp_mov<0x140>(sk); sq += dpp_mov<0x140>(sq);
                const float alpha = scv.x, vn = fmaf(-scv.w, sk, scv.y * vv);
                const float po = fmaf(alpha, sq, scv.z * vn);
                const f32x2 al2 = (f32x2){alpha, alpha}, vn2 = (f32x2){vn, vn};
                S[0] = S[0] * al2 + ka * vn2; S[1] = S[1] * al2 + kb * vn2; S[2] = S[2] * al2 + kc * vn2; S[3] = S[3] * al2 + kd * vn2;
                if (dkg == 0) os[s * 32 + dvi] = po;
            }
        }
        if (tile + 1 < 64) GDN_STORE(cur ^ 1);
        __syncthreads();
        if (tid < 256) { const int s2 = tid >> 3, c4 = tid & 7, tl2 = dir ? 31 - s2 : s2; *(f32x4*)(O + (row0 + tl2) * 1024 + hv * 128 + dvs * 32 + c4 * 4) = *(const f32x4*)(os + s2 * 32 + c4 * 4); }
    }
#undef GDN_LOAD
#undef GDN_STORE
}

typedef short s16x4_t __attribute__((ext_vector_type(4)));
typedef __bf16 bf16x2_v __attribute__((ext_vector_type(2)));
__device__ __forceinline__ unsigned cvtpk_rne(float lo, float hi) { f32x2 v = {lo, hi}; bf16x2_v bb = __builtin_convertvector(v, bf16x2_v); return __builtin_bit_cast(unsigned, bb); }
template <int S_> __device__ __forceinline__ bf16x8_t acc_frag(const f32x16_t& x) {
    v4u w; w.x = cvtpk_rne(x[8 * S_ + 0], x[8 * S_ + 1]); w.y = cvtpk_rne(x[8 * S_ + 2], x[8 * S_ + 3]); w.z = cvtpk_rne(x[8 * S_ + 4], x[8 * S_ + 5]); w.w = cvtpk_rne(x[8 * S_ + 6], x[8 * S_ + 7]);
    return __builtin_bit_cast(bf16x8_t, w);
}
__device__ __forceinline__ bf16x8_t join44(v2u lo, v2u hi) { v4u w; w.x = lo.x; w.y = lo.y; w.z = hi.x; w.w = hi.y; return __builtin_bit_cast(bf16x8_t, w); }
__device__ __forceinline__ float wave_incl_scan(float v, int lane) {
#pragma unroll
    for (int o = 1; o < 64; o <<= 1) { const float t = __shfl_up(v, o); if (lane >= o) v += t; }
    return v;
}
constexpr int GDN_LDS_PER_WAVE = 17920;
__device__ __forceinline__ void gdn1_item(const Args& a, int item, unsigned char* ldsw, int lane) {
    asm volatile("" : "+v"(lane));
    const int c = item & 31, dir = (item >> 5) & 1, hv = (item >> 6) & 7, b = item >> 9, hq = hv >> 1;
    const int r32 = lane & 31, hi = lane >> 5;
    float* AT = (float*)ldsw; float* Gs = AT + 64 * 64; float* Bs = Gs + 64;
    const bf16_t* QK = (const bf16_t*)(a.ws + WS_QKV16); const float* SM = (const float*)(a.ws + WS_SMALL);
    bf16_t* GT = (bf16_t*)(a.ws + WS_GT) + (size_t)item * 4096; bf16_t* GA = (bf16_t*)(a.ws + WS_GA) + (size_t)item * 4096;
    const float Aneg = -expf(a.in[dir ? 21 : 20][hv]); const float dtb = a.in[dir ? 23 : 22][hv];
    {
        const int t = dir ? SEQ - 1 - (64 * c + lane) : 64 * c + lane; const float* sm = SM + ((size_t)b * SEQ + t) * 32;
        const float gi = Aneg * softplus_f(sm[16 + dir * 8 + hv] + dtb), bi = sigmoid_f(sm[dir * 8 + hv]);
        Gs[lane] = wave_incl_scan(gi, lane); Bs[lane] = bi;
    }
    const int t0r = dir ? SEQ - 1 - (64 * c + r32) : 64 * c + r32, t1r = dir ? t0r - 32 : t0r + 32;
    const bf16_t* k0p = QK + ((size_t)b * SEQ + t0r) * 2048 + 512 + hq * 128 + hi * 8; const bf16_t* k1p = QK + ((size_t)b * SEQ + t1r) * 2048 + 512 + hq * 128 + hi * 8;
    const bf16_t* q0p = k0p - 512, * q1p = k1p - 512;
    LDS_WAIT();
    const float Gj0 = Gs[r32], Gj1 = Gs[32 + r32];
    {
        f32x16_t kk00, kk10, kk11;
#pragma unroll
        for (int r = 0; r < 16; ++r) { kk00[r] = 0.f; kk10[r] = 0.f; kk11[r] = 0.f; }
#pragma unroll
        for (int s = 0; s < 8; ++s) {
            const bf16x8_t kA0 = *(const bf16x8_t*)(k0p + 16 * s), kA1 = *(const bf16x8_t*)(k1p + 16 * s);
            kk00 = __builtin_amdgcn_mfma_f32_32x32x16_bf16(kA0, kA0, kk00, 0, 0, 0); kk10 = __builtin_amdgcn_mfma_f32_32x32x16_bf16(kA1, kA0, kk10, 0, 0, 0); kk11 = __builtin_amdgcn_mfma_f32_32x32x16_bf16(kA1, kA1, kk11, 0, 0, 0);
        }
#pragma unroll
        for (int r = 0; r < 16; ++r) { const int il = (r & 3) + 8 * (r >> 2) + 4 * hi;
            const float Gi0 = Gs[il], Gi1 = Gs[32 + il], bi0 = Bs[il], bi1 = Bs[32 + il];
            AT[r32 * 64 + il] = (r32 < il) ? bi0 * kk00[r] * expf(Gi0 - Gj0) : 0.f;
            AT[r32 * 64 + 32 + il] = bi1 * kk10[r] * expf(Gi1 - Gj0);
            AT[(32 + r32) * 64 + 32 + il] = (r32 < il) ? bi1 * kk11[r] * expf(Gi1 - Gj1) : 0.f;
            AT[(32 + r32) * 64 + il] = 0.f;
        }
    }
    asm volatile("" ::: "memory");
    {
        f32x16_t qk00, qk10, qk11;
#pragma unroll
        for (int r = 0; r < 16; ++r) { qk00[r] = 0.f; qk10[r] = 0.f; qk11[r] = 0.f; }
#pragma unroll
        for (int s = 0; s < 8; ++s) {
            const bf16x8_t kA0 = *(const bf16x8_t*)(k0p + 16 * s), kA1 = *(const bf16x8_t*)(k1p + 16 * s), qA0 = *(const bf16x8_t*)(q0p + 16 * s), qA1 = *(const bf16x8_t*)(q1p + 16 * s);
            qk00 = __builtin_amdgcn_mfma_f32_32x32x16_bf16(qA0, kA0, qk00, 0, 0, 0); qk10 = __builtin_amdgcn_mfma_f32_32x32x16_bf16(qA1, kA0, qk10, 0, 0, 0); qk11 = __builtin_amdgcn_mfma_f32_32x32x16_bf16(qA1, kA1, qk11, 0, 0, 0);
        }
#pragma unroll
        for (int r = 0; r < 16; ++r) { const int il = (r & 3) + 8 * (r >> 2) + 4 * hi;
            const float Gi0 = Gs[il], Gi1 = Gs[32 + il];
            GA[il * 64 + r32] = (bf16_t)f2bf((r32 <= il) ? qk00[r] * expf(Gi0 - Gj0) : 0.f);
            GA[(32 + il) * 64 + r32] = (bf16_t)f2bf(qk10[r] * expf(Gi1 - Gj0));
            GA[(32 + il) * 64 + 32 + r32] = (bf16_t)f2bf((r32 <= il) ? qk11[r] * expf(Gi1 - Gj1) : 0.f);
        }
    }
    LDS_WAIT(); asm volatile("" ::: "memory");
    float tr[64];
    int lane2 = lane; asm volatile("" : "+v"(lane2) :: "memory");
#pragma unroll
    for (int j = 0; j < 64; ++j) tr[j] = (j == lane2) ? 1.f : 0.f;
    int atoff = 0;
#pragma unroll
    for (int j = 62; j >= 0; --j) { float c0 = 0.f, c1 = 0.f, c2 = 0.f, c3 = 0.f;
        asm volatile("" : "+v"(atoff) : "v"(tr[j + 1]));
#pragma unroll
        for (int qd = (j + 1) / 4; qd < 16; ++qd) { const f32x4 av = *(const f32x4*)(AT + atoff + j * 64 + 4 * qd);
            if (4 * qd + 0 > j) c0 = fmaf(tr[4 * qd + 0], av.x, c0);
            if (4 * qd + 1 > j) c1 = fmaf(tr[4 * qd + 1], av.y, c1);
            if (4 * qd + 2 > j) c2 = fmaf(tr[4 * qd + 2], av.z, c2);
            if (4 * qd + 3 > j) c3 = fmaf(tr[4 * qd + 3], av.w, c3); }
        tr[j] -= (c0 + c1) + (c2 + c3); asm volatile("" ::: "memory"); }
#pragma unroll
    for (int x = 0; x < 8; ++x) *(v4u*)(GT + lane2 * 64 + x * 8) = pack8(tr + x * 8);
    LDS_WAIT();
}

__device__ __forceinline__ void gdn2_item(const Args& a, int item, unsigned char* lds) {
    const int dvs = item & 3, hv = (item >> 2) & 7, dir = (item >> 5) & 1, b = item >> 6, hq = hv >> 1;
    const int lane0 = threadIdx.x & 63;
    constexpr int BUFB = 57344, O_K = 0, O_Q = 16384, O_T = 32768, O_A = 40960, O_V = 49152;
    float* Gs = (float*)(lds + 2 * BUFB); float* Bs = Gs + 64; float* Es = Bs + 64; float* Ws = Es + 64; float* ot = Ws + 64;
    const LAS unsigned char* ldl = (const LAS unsigned char*)lds;
    const bf16_t* QK = (const bf16_t*)(a.ws + WS_QKV16); const float* ACT = (const float*)(a.ws + WS_ACT); const float* SM = (const float*)(a.ws + WS_SMALL);
    float* O = (float*)(a.ws + (dir ? WS_YB : WS_YF));
    const float Aneg = -expf(a.in[dir ? 21 : 20][hv]); const float dtb = a.in[dir ? 23 : 22][hv];
    const size_t gbase = (size_t)(((b * 8 + hv) * 2 + dir) * 32) * 4096;
    f32x16_t S[4];
#pragma unroll
    for (int nt = 0; nt < 4; ++nt)
#pragma unroll
        for (int r = 0; r < 16; ++r) S[nt][r] = 0.f;
    float gar, gbr;
#define G2_DMA(c_, buf_) do { const int t_ = dir ? SEQ - 1 - (64 * (c_) + lane0) : 64 * (c_) + lane0; const size_t mi_ = (size_t)b * SEQ + t_; \
        const bf16_t* kr_ = QK + mi_ * 2048 + 512 + hq * 128; const bf16_t* qr_ = QK + mi_ * 2048 + hq * 128; \
        const bf16_t* tr_ = (const bf16_t*)(a.ws + WS_GT) + gbase + (size_t)(c_) * 4096 + lane0 * 64; const bf16_t* ar_ = (const bf16_t*)(a.ws + WS_GA) + gbase + (size_t)(c_) * 4096 + lane0 * 64; \
        const float* vr_ = ACT + mi_ * 2048 + 1024 + hv * 128 + dvs * 32; \
        LAS unsigned char* lb_ = (LAS unsigned char*)lds + (buf_) * BUFB; \
        _Pragma("unroll") for (int x = 0; x < 16; ++x) { __builtin_amdgcn_global_load_lds((const unsigned*)(kr_ + 8 * x), (LAS unsigned*)(lb_ + O_K + 1024 * x), 16, 0, 0); \
                                                         __builtin_amdgcn_global_load_lds((const unsigned*)(qr_ + 8 * x), (LAS unsigned*)(lb_ + O_Q + 1024 * x), 16, 0, 0); } \
        _Pragma("unroll") for (int x = 0; x < 8; ++x) { __builtin_amdgcn_global_load_lds((const unsigned*)(tr_ + 8 * x), (LAS unsigned*)(lb_ + O_T + 1024 * x), 16, 0, 0); \
                                                        __builtin_amdgcn_global_load_lds((const unsigned*)(ar_ + 8 * x), (LAS unsigned*)(lb_ + O_A + 1024 * x), 16, 0, 0); \
                                                        __builtin_amdgcn_global_load_lds((const unsigned*)(vr_ + 4 * x), (LAS unsigned*)(lb_ + O_V + 1024 * x), 16, 0, 0); } \
        const float* sm_ = SM + mi_ * 32; gar = sm_[16 + dir * 8 + hv]; gbr = sm_[dir * 8 + hv]; } while (0)
    G2_DMA(0, 0);
    for (int c = 0; c < 32; ++c) {
        int lane = lane0; asm volatile("" : "+v"(lane));
        const int r32 = lane & 31, hi = lane >> 5, trq = (lane & 15) >> 2, trp = lane & 3, trc = (lane >> 4) & 1;
        const int bo = (c & 1) * BUFB;
        float GL;
        {
            const float gi = Aneg * softplus_f(gar + dtb), bi = sigmoid_f(gbr);
            const float G = wave_incl_scan(gi, lane); GL = __shfl(G, 63);
            Gs[lane] = G; Bs[lane] = bi; Es[lane] = __expf(G); Ws[lane] = __expf(GL - G);
        }
        asm volatile("s_waitcnt vmcnt(0)" ::: "memory");
        if (c + 1 < 32) G2_DMA(c + 1, (c + 1) & 1);
        LDS_WAIT();
        f32x16_t KS[2];
#pragma unroll
        for (int rt = 0; rt < 2; ++rt)
#pragma unroll
            for (int r = 0; r < 16; ++r) KS[rt][r] = 0.f;
#define LFRAG(off_) join44(*(const LAS v2u*)(ldl + (off_)), *(const LAS v2u*)(ldl + (off_) + 1024))
#pragma unroll
        for (int nt = 0; nt < 4; ++nt) {
            const bf16x8_t sb0 = acc_frag<0>(S[nt]), sb1 = acc_frag<1>(S[nt]);
#pragma unroll
            for (int rt = 0; rt < 2; ++rt) {
                const int ro = bo + O_K + ((4 * nt) * 64 + 32 * rt + r32) * 16 + 8 * hi;
                KS[rt] = __builtin_amdgcn_mfma_f32_32x32x16_bf16(LFRAG(ro), sb0, KS[rt], 0, 0, 0); KS[rt] = __builtin_amdgcn_mfma_f32_32x32x16_bf16(LFRAG(ro + 2048), sb1, KS[rt], 0, 0, 0);
            }
        }
        asm volatile("" ::: "memory");
        f32x16_t rhs[2];
#pragma unroll
        for (int rt = 0; rt < 2; ++rt)
#pragma unroll
            for (int r = 0; r < 16; ++r) { const int i = 32 * rt + (r & 3) + 8 * (r >> 2) + 4 * hi;
                const float vv = *(const LAS float*)(ldl + bo + O_V + ((r32 >> 2) * 64 + i) * 16 + (r32 & 3) * 4); const float bi = Bs[i];
                rhs[rt][r] = bi * vv - bi * Es[i] * KS[rt][r]; }
        asm volatile("" ::: "memory");
        f32x16_t vn[2];
#pragma unroll
        for (int r = 0; r < 16; ++r) { vn[0][r] = 0.f; vn[1][r] = 0.f; }
        {
            const bf16x8_t rb00 = acc_frag<0>(rhs[0]), rb01 = acc_frag<1>(rhs[0]), rb10 = acc_frag<0>(rhs[1]), rb11 = acc_frag<1>(rhs[1]);
            const int t0 = bo + O_T + r32 * 16 + 8 * hi, t1 = t0 + 512;
            vn[0] = __builtin_amdgcn_mfma_f32_32x32x16_bf16(LFRAG(t0), rb00, vn[0], 0, 0, 0); vn[0] = __builtin_amdgcn_mfma_f32_32x32x16_bf16(LFRAG(t0 + 2048), rb01, vn[0], 0, 0, 0);
            vn[1] = __builtin_amdgcn_mfma_f32_32x32x16_bf16(LFRAG(t1), rb00, vn[1], 0, 0, 0); vn[1] = __builtin_amdgcn_mfma_f32_32x32x16_bf16(LFRAG(t1 + 2048), rb01, vn[1], 0, 0, 0);
            vn[1] = __builtin_amdgcn_mfma_f32_32x32x16_bf16(LFRAG(t1 + 4096), rb10, vn[1], 0, 0, 0); vn[1] = __builtin_amdgcn_mfma_f32_32x32x16_bf16(LFRAG(t1 + 6144), rb11, vn[1], 0, 0, 0);
        }
        asm volatile("" ::: "memory");
        f32x16_t QS[2];
#pragma unroll
        for (int rt = 0; rt < 2; ++rt)
#pragma unroll
            for (int r = 0; r < 16; ++r) QS[rt][r] = 0.f;
#pragma unroll
        for (int nt = 0; nt < 4; ++nt) {
            const bf16x8_t sb0 = acc_frag<0>(S[nt]), sb1 = acc_frag<1>(S[nt]);
#pragma unroll
            for (int rt = 0; rt < 2; ++rt) {
                const int ro = bo + O_Q + ((4 * nt) * 64 + 32 * rt + r32) * 16 + 8 * hi;
                QS[rt] = __builtin_amdgcn_mfma_f32_32x32x16_bf16(LFRAG(ro), sb0, QS[rt], 0, 0, 0); QS[rt] = __builtin_amdgcn_mfma_f32_32x32x16_bf16(LFRAG(ro + 2048), sb1, QS[rt], 0, 0, 0);
            }
        }
        asm volatile("" ::: "memory");
        {
            const bf16x8_t vb00 = acc_frag<0>(vn[0]), vb01 = acc_frag<1>(vn[0]), vb10 = acc_frag<0>(vn[1]), vb11 = acc_frag<1>(vn[1]);
            const int a0 = bo + O_A + r32 * 16 + 8 * hi, a1 = a0 + 512;
            f32x16_t o0, o1;
#pragma unroll
            for (int r = 0; r < 16; ++r) { const int il = (r & 3) + 8 * (r >> 2) + 4 * hi; o0[r] = Es[il] * QS[0][r]; o1[r] = Es[32 + il] * QS[1][r]; }
            o0 = __builtin_amdgcn_mfma_f32_32x32x16_bf16(LFRAG(a0), vb00, o0, 0, 0, 0); o0 = __builtin_amdgcn_mfma_f32_32x32x16_bf16(LFRAG(a0 + 2048), vb01, o0, 0, 0, 0);
            o1 = __builtin_amdgcn_mfma_f32_32x32x16_bf16(LFRAG(a1), vb00, o1, 0, 0, 0); o1 = __builtin_amdgcn_mfma_f32_32x32x16_bf16(LFRAG(a1 + 2048), vb01, o1, 0, 0, 0);
            o1 = __builtin_amdgcn_mfma_f32_32x32x16_bf16(LFRAG(a1 + 4096), vb10, o1, 0, 0, 0); o1 = __builtin_amdgcn_mfma_f32_32x32x16_bf16(LFRAG(a1 + 6144), vb11, o1, 0, 0, 0);
#pragma unroll
            for (int r = 0; r < 16; ++r) { const int il = (r & 3) + 8 * (r >> 2) + 4 * hi; ot[il * 33 + r32] = o0[r]; ot[(32 + il) * 33 + r32] = o1[r]; }
            LDS_WAIT();
            { const int t = dir ? SEQ - 1 - (64 * c + lane) : 64 * c + lane; float* orow = O + ((size_t)b * SEQ + t) * 1024 + hv * 128 + dvs * 32;
#pragma unroll
              for (int x = 0; x < 8; ++x) *(f32x4*)(orow + 4 * x) = (f32x4){ot[lane * 33 + 4 * x], ot[lane * 33 + 4 * x + 1], ot[lane * 33 + 4 * x + 2], ot[lane * 33 + 4 * x + 3]}; }
        }
        asm volatile("" ::: "memory");
        {
#pragma unroll
            for (int r = 0; r < 16; ++r) { const int il = (r & 3) + 8 * (r >> 2) + 4 * hi; vn[0][r] *= Ws[il]; vn[1][r] *= Ws[32 + il]; }
            const bf16x8_t wb[4] = {acc_frag<0>(vn[0]), acc_frag<1>(vn[0]), acc_frag<0>(vn[1]), acc_frag<1>(vn[1])};
            const float eGL = __expf(GL);
#pragma unroll
            for (int nt = 0; nt < 4; ++nt) {
#pragma unroll
                for (int r = 0; r < 16; ++r) S[nt][r] *= eGL;
#pragma unroll
                for (int ks = 0; ks < 4; ++ks) {
                    const int ro = bo + O_K + ((4 * nt + 2 * trc + (trp >> 1)) * 64 + 16 * ks + 4 * hi + trq) * 16 + 8 * (trp & 1);
                    const s16x4_t lo = __builtin_bit_cast(s16x4_t, __builtin_amdgcn_ds_read_tr16_b64_v4i16((LAS s16x4_t*)(ldl + ro)));
                    const s16x4_t hi4 = __builtin_bit_cast(s16x4_t, __builtin_amdgcn_ds_read_tr16_b64_v4i16((LAS s16x4_t*)(ldl + ro + 8 * 16)));
                    const bf16x8_t kf = (bf16x8_t){lo[0], lo[1], lo[2], lo[3], hi4[0], hi4[1], hi4[2], hi4[3]};
                    S[nt] = __builtin_amdgcn_mfma_f32_32x32x16_bf16(kf, wb[ks], S[nt], 0, 0, 0);
                }
            }
        }
        LDS_WAIT();
    }
#undef LFRAG
#undef G2_DMA
}

__device__ __forceinline__ void ssd2_item(const Args& a, int item, unsigned char* lds) {
    const int ps = item & 1, h = (item >> 1) & 15, dir = (item >> 5) & 1, b = item >> 6, g = h >> 3;
    const int lane0 = threadIdx.x & 63;
    constexpr int BUFB = 40960, O_B = 0, O_C = 16384, O_X = 32768, O_XD = 2 * BUFB + 512, O_XW = O_XD + 64 * 72;
    float* Gs = (float*)(lds + 2 * BUFB); float* Es = Gs + 64; float* ot = (float*)(lds + O_XW + 64 * 72);
    const LAS unsigned char* ldl = (const LAS unsigned char*)lds;
    const bf16_t* XB = (const bf16_t*)(a.ws + WS_XBC16); const float* ACT = (const float*)(a.ws + WS_ACT); const float* SM = (const float*)(a.ws + WS_SMALL);
    float* Y = (float*)(a.ws + (dir ? WS_YB : WS_YF));
    const float A = -expf(a.in[dir ? 13 : 12][h]); const float dtb = a.in[dir ? 11 : 10][h];
    f32x16_t H[4];
#pragma unroll
    for (int nt = 0; nt < 4; ++nt)
#pragma unroll
        for (int r = 0; r < 16; ++r) H[nt][r] = 0.f;
    float gdr;
#define S2_DMA(c_, buf_) do { const int t_ = dir ? SEQ - 1 - (64 * (c_) + lane0) : 64 * (c_) + lane0; const size_t mi_ = (size_t)b * SEQ + t_; \
        const bf16_t* br_ = XB + mi_ * 1536 + 1024 + g * 128; const bf16_t* cr_ = XB + mi_ * 1536 + 1280 + g * 128; const float* xr_ = ACT + mi_ * 1536 + h * 64 + ps * 32; \
        LAS unsigned char* lb_ = (LAS unsigned char*)lds + (buf_) * BUFB; \
        _Pragma("unroll") for (int x = 0; x < 16; ++x) { __builtin_amdgcn_global_load_lds((const unsigned*)(br_ + 8 * x), (LAS unsigned*)(lb_ + O_B + 1024 * x), 16, 0, 0); \
                                                         __builtin_amdgcn_global_load_lds((const unsigned*)(cr_ + 8 * x), (LAS unsigned*)(lb_ + O_C + 1024 * x), 16, 0, 0); } \
        _Pragma("unroll") for (int x = 0; x < 8; ++x) __builtin_amdgcn_global_load_lds((const unsigned*)(xr_ + 4 * x), (LAS unsigned*)(lb_ + O_X + 1024 * x), 16, 0, 0); \
        gdr = SM[mi_ * 32 + dir * 16 + h]; } while (0)
    S2_DMA(0, 0);
    for (int c = 0; c < 32; ++c) {
        int lane = lane0; asm volatile("" : "+v"(lane));
        const int r32 = lane & 31, hi = lane >> 5, trq = (lane & 15) >> 2, trp = lane & 3, trc = (lane >> 4) & 1;
        const int bo = (c & 1) * BUFB;
        const float dt = softplus_f(gdr + dtb);
        const float cs = wave_incl_scan(dt * A, lane); const float csL = __shfl(cs, 63);
        Gs[lane] = cs; Es[lane] = __expf(cs);
        asm volatile("s_waitcnt vmcnt(0)" ::: "memory");
        if (c + 1 < 32) S2_DMA(c + 1, (c + 1) & 1);
        {
            const float wsc = dt * __expf(csL - cs);
#pragma unroll
            for (int x = 0; x < 8; ++x) { const f32x4 xv = *(const LAS f32x4*)(ldl + bo + O_X + (x * 64 + lane) * 16);
                v2u d; d.x = cvtpk_rne(xv.x * dt, xv.y * dt); d.y = cvtpk_rne(xv.z * dt, xv.w * dt); *(LAS v2u*)((LAS unsigned char*)lds + O_XD + lane * 72 + 8 * x) = d;
                v2u w; w.x = cvtpk_rne(xv.x * wsc, xv.y * wsc); w.y = cvtpk_rne(xv.z * wsc, xv.w * wsc); *(LAS v2u*)((LAS unsigned char*)lds + O_XW + lane * 72 + 8 * x) = w; }
        }
        LDS_WAIT();
        f32x16_t g00, g01, g11;
#pragma unroll
        for (int r = 0; r < 16; ++r) { g00[r] = 0.f; g01[r] = 0.f; g11[r] = 0.f; }
#pragma unroll
        for (int kk = 0; kk < 8; ++kk) { const int fo = ((2 * kk + hi) * 64 + r32) * 16;
            const bf16x8_t A0 = *(const LAS bf16x8_t*)(ldl + bo + O_B + fo), A1 = *(const LAS bf16x8_t*)(ldl + bo + O_B + fo + 512);
            const bf16x8_t B0 = *(const LAS bf16x8_t*)(ldl + bo + O_C + fo), B1 = *(const LAS bf16x8_t*)(ldl + bo + O_C + fo + 512);
            g00 = __builtin_amdgcn_mfma_f32_32x32x16_bf16(A0, B0, g00, 0, 0, 0); g01 = __builtin_amdgcn_mfma_f32_32x32x16_bf16(A0, B1, g01, 0, 0, 0); g11 = __builtin_amdgcn_mfma_f32_32x32x16_bf16(A1, B1, g11, 0, 0, 0); }
        {   const float cst0 = Gs[r32], cst1 = Gs[32 + r32];
#pragma unroll
            for (int r = 0; r < 16; ++r) { const int il = (r & 3) + 8 * (r >> 2) + 4 * hi; const float css0 = Gs[il], css1 = Gs[32 + il];
                g00[r] = (il <= r32) ? g00[r] * __expf(cst0 - css0) : 0.f; g01[r] = g01[r] * __expf(cst1 - css0); g11[r] = (il <= r32) ? g11[r] * __expf(cst1 - css1) : 0.f; } }
        asm volatile("" ::: "memory");
        f32x16_t y0, y1;
#pragma unroll
        for (int r = 0; r < 16; ++r) { y0[r] = 0.f; y1[r] = 0.f; }
#define TRFRAG(base_) ({ const s16x4_t lo_ = __builtin_bit_cast(s16x4_t, __builtin_amdgcn_ds_read_tr16_b64_v4i16((LAS s16x4_t*)(ldl + (base_)))); \
                         const s16x4_t hi_ = __builtin_bit_cast(s16x4_t, __builtin_amdgcn_ds_read_tr16_b64_v4i16((LAS s16x4_t*)(ldl + (base_) + 8 * 72))); \
                         (bf16x8_t){lo_[0], lo_[1], lo_[2], lo_[3], hi_[0], hi_[1], hi_[2], hi_[3]}; })
        {   const int xo = O_XD + (4 * hi + trq) * 72 + (16 * trc + 4 * trp) * 2;
            const bf16x8_t x0 = TRFRAG(xo), x1 = TRFRAG(xo + 16 * 72), x2 = TRFRAG(xo + 32 * 72), x3 = TRFRAG(xo + 48 * 72);
            y0 = __builtin_amdgcn_mfma_f32_32x32x16_bf16(acc_frag<0>(g00), x0, y0, 0, 0, 0); y0 = __builtin_amdgcn_mfma_f32_32x32x16_bf16(acc_frag<1>(g00), x1, y0, 0, 0, 0);
            y1 = __builtin_amdgcn_mfma_f32_32x32x16_bf16(acc_frag<0>(g01), x0, y1, 0, 0, 0); y1 = __builtin_amdgcn_mfma_f32_32x32x16_bf16(acc_frag<1>(g01), x1, y1, 0, 0, 0);
            y1 = __builtin_amdgcn_mfma_f32_32x32x16_bf16(acc_frag<0>(g11), x2, y1, 0, 0, 0); y1 = __builtin_amdgcn_mfma_f32_32x32x16_bf16(acc_frag<1>(g11), x3, y1, 0, 0, 0); }
        asm volatile("" ::: "memory");
        {   f32x16_t Z0, Z1;
#pragma unroll
            for (int r = 0; r < 16; ++r) { Z0[r] = 0.f; Z1[r] = 0.f; }
#define LFRAG(off_) join44(*(const LAS v2u*)(ldl + (off_)), *(const LAS v2u*)(ldl + (off_) + 1024))
#pragma unroll
            for (int nt = 0; nt < 4; ++nt) { const bf16x8_t hb0 = acc_frag<0>(H[nt]), hb1 = acc_frag<1>(H[nt]);
                const int ro = bo + O_C + ((4 * nt) * 64 + r32) * 16 + 8 * hi;
                Z0 = __builtin_amdgcn_mfma_f32_32x32x16_bf16(LFRAG(ro), hb0, Z0, 0, 0, 0); Z0 = __builtin_amdgcn_mfma_f32_32x32x16_bf16(LFRAG(ro + 2048), hb1, Z0, 0, 0, 0);
                Z1 = __builtin_amdgcn_mfma_f32_32x32x16_bf16(LFRAG(ro + 512), hb0, Z1, 0, 0, 0); Z1 = __builtin_amdgcn_mfma_f32_32x32x16_bf16(LFRAG(ro + 512 + 2048), hb1, Z1, 0, 0, 0); }
#undef LFRAG
#pragma unroll
            for (int r = 0; r < 16; ++r) { const int il = (r & 3) + 8 * (r >> 2) + 4 * hi; ot[il * 33 + r32] = fmaf(Es[il], Z0[r], y0[r]); ot[(32 + il) * 33 + r32] = fmaf(Es[32 + il], Z1[r], y1[r]); } }
        LDS_WAIT();
        { const int t = dir ? SEQ - 1 - (64 * c + lane) : 64 * c + lane; float* yrow = Y + ((size_t)b * SEQ + t) * 1024 + h * 64 + ps * 32;
#pragma unroll
          for (int x = 0; x < 8; ++x) *(f32x4*)(yrow + 4 * x) = (f32x4){ot[lane * 33 + 4 * x], ot[lane * 33 + 4 * x + 1], ot[lane * 33 + 4 * x + 2], ot[lane * 33 + 4 * x + 3]}; }
        asm volatile("" ::: "memory");
        {   const float eL = __expf(csL);
            const int xo = O_XW + (4 * hi + trq) * 72 + (16 * trc + 4 * trp) * 2;
            const bf16x8_t w0 = TRFRAG(xo), w1 = TRFRAG(xo + 16 * 72), w2 = TRFRAG(xo + 32 * 72), w3 = TRFRAG(xo + 48 * 72);
#undef TRFRAG
#pragma unroll
            for (int nt = 0; nt < 4; ++nt) {
#pragma unroll
                for (int r = 0; r < 16; ++r) H[nt][r] *= eL;
#pragma unroll
                for (int ks = 0; ks < 4; ++ks) {
                    const int ro = bo + O_B + ((4 * nt + 2 * trc + (trp >> 1)) * 64 + 16 * ks + 4 * hi + trq) * 16 + 8 * (trp & 1);
                    const s16x4_t lo = __builtin_bit_cast(s16x4_t, __builtin_amdgcn_ds_read_tr16_b64_v4i16((LAS s16x4_t*)(ldl + ro)));
                    const s16x4_t hi4 = __builtin_bit_cast(s16x4_t, __builtin_amdgcn_ds_read_tr16_b64_v4i16((LAS s16x4_t*)(ldl + ro + 8 * 16)));
                    const bf16x8_t bfr = (bf16x8_t){lo[0], lo[1], lo[2], lo[3], hi4[0], hi4[1], hi4[2], hi4[3]};
                    H[nt] = __builtin_amdgcn_mfma_f32_32x32x16_bf16(bfr, ks == 0 ? w0 : ks == 1 ? w1 : ks == 2 ? w2 : w3, H[nt], 0, 0, 0);
                }
            }
        }
        LDS_WAIT();
    }
#undef S2_DMA
}

__device__ __forceinline__ void lru_tile(const Args& a, int item, unsigned char* lds, int pass) {
    const int n = item & 7, tc = (item >> 3) & 63, b = item >> 9, t0 = tc * 32;
    float* xc = (float*)lds; bf16_t* xcb = (bf16_t*)(lds + 16384); float* As = (float*)(lds + 25088); float* Us = As + 2 * 32 * 128; float2* sg = (float2*)(Us + 2 * 32 * 128);
    const int tid = threadIdx.x, lane = tid & 63, wave = tid >> 6;
    const bf16_t* P = (const bf16_t*)(a.ws + WS_PROJ);
    __syncthreads();
    {
        const int j = tid & 127, tg = tid >> 7, chn = n * 128 + j; const float* cw = a.in[25];
        const float w0 = cw[chn], w1 = cw[1024 + chn], w2 = cw[2048 + chn], w3 = cw[3072 + chn], cbias = a.in[26][chn];
        const int tb = t0 + tg * 8;
        const bf16_t* pp = P + ((size_t)b * SEQ + tb) * NINP + C_XL + chn;
        float xm2 = (tb >= 2) ? bf2f(pp[-2 * NINP]) : 0.f, xm1 = (tb >= 1) ? bf2f(pp[-NINP]) : 0.f, x0 = bf2f(pp[0]);
#pragma unroll
        for (int i = 0; i < 8; ++i) { const float xp1 = (tb + i + 1 < SEQ) ? bf2f(pp[(i + 1) * NINP]) : 0.f;
            const float acc = cbias + w0 * xm2 + w1 * xm1 + w2 * x0 + w3 * xp1;
            xc[(tg * 8 + i) * 128 + j] = acc; xcb[(tg * 8 + i) * 136 + j] = (bf16_t)f2bf(acc);
            xm2 = xm1; xm1 = x0; x0 = xp1; }
    }
    __syncthreads();
    {
        const int ct = wave & 3, d = wave >> 2, r32 = lane & 31, hi = lane >> 5;
        const bf16_t* WT = (const bf16_t*)(a.ws + WS_WGT);
        const bf16_t* wa_p = WT + ((size_t)((2 * d) * 8 + n) * 128 + ct * 32 + r32) * 128 + hi * 8;
        const bf16_t* wx_p = WT + ((size_t)((2 * d + 1) * 8 + n) * 128 + ct * 32 + r32) * 128 + hi * 8;
        f32x16_t ca, cx;
#pragma unroll
        for (int r = 0; r < 16; ++r) { ca[r] = 0.f; cx[r] = 0.f; }
#pragma unroll
        for (int s = 0; s < 8; ++s) {
            const bf16x8_t af = *(const bf16x8_t*)((const char*)xcb + r32 * 272 + (s * 16 + hi * 8) * 2);
            const bf16x8_t fa = *(const bf16x8_t*)(wa_p + s * 16); const bf16x8_t fx = *(const bf16x8_t*)(wx_p + s * 16);
            ca = __builtin_amdgcn_mfma_f32_32x32x16_bf16(af, fa, ca, 0, 0, 0); cx = __builtin_amdgcn_mfma_f32_32x32x16_bf16(af, fx, cx, 0, 0, 0);
        }
        const int j = ct * 32 + r32, cj = n * 128 + j;
        const float baj = a.in[d ? 33 : 28][cj], bxj = a.in[d ? 35 : 30][cj], sp = softplus_f(-a.in[d ? 36 : 31][cj]);
#pragma unroll
        for (int r = 0; r < 16; ++r) { const int t = (r & 3) + 8 * (r >> 2) + 4 * hi;
            const float rg = __builtin_amdgcn_rcpf(1.f + __expf(-(ca[r] + baj))), ig = __builtin_amdgcn_rcpf(1.f + __expf(-(cx[r] + bxj))); const float la = -8.f * rg * sp;
            const float av = __expf(la);
            const float om = (la > -0.0625f) ? -2.f * la * (1.f + la * (1.f + la * (0.6666667f + 0.3333333f * la))) : (1.f - av) * (1.f + av);
            As[(d * 32 + t) * 128 + j] = av; Us[(d * 32 + t) * 128 + j] = __builtin_amdgcn_sqrtf(om) * (ig * xc[t * 128 + j]); }
    }
    __syncthreads();
    {
        const int j = tid & 127, d = (tid >> 7) & 1, seg = tid >> 8;
        float Pp = 1.f, H = 0.f;
#pragma unroll
        for (int k = 0; k < 16; ++k) { const int q = seg * 16 + k, t = d ? 31 - q : q; const float a_ = As[(d * 32 + t) * 128 + j], u_ = Us[(d * 32 + t) * 128 + j]; H = fmaf(a_, H, u_); Pp *= a_; }
        sg[(d * 2 + seg) * 128 + j] = make_float2(Pp, H);
        __syncthreads();
        float2* LS = (float2*)(a.ws + WS_LSUM);
        if (pass == 0) {
            if (seg == 0) { const float2 s1 = sg[(d * 2 + 1) * 128 + j]; LS[((size_t)(d * 4 + b) * 64 + tc) * 1024 + n * 128 + j] = make_float2(Pp * s1.x, fmaf(s1.x, H, s1.y)); }
        } else {
            float c = 0.f;
            const float2* lsp = LS + ((size_t)(d * 4 + b) * 64) * 1024 + n * 128 + j;
#pragma unroll 1
            for (int c0 = 0; c0 < 64; c0 += 16) { float2 sv[16];
#pragma unroll
                for (int i = 0; i < 16; ++i) { const int cc = d ? 63 - (c0 + i) : c0 + i; sv[i] = lsp[(size_t)cc * 1024]; }
#pragma unroll
                for (int i = 0; i < 16; ++i) { const int cc = d ? 63 - (c0 + i) : c0 + i; const bool before = d ? (cc > tc) : (cc < tc); if (before) c = fmaf(sv[i].x, c, sv[i].y); } }
            if (seg == 1) { const float2 s0 = sg[(d * 2) * 128 + j]; c = fmaf(s0.x, c, s0.y); }
            float h = c;
#pragma unroll
            for (int k = 0; k < 16; ++k) { const int q = seg * 16 + k, t = d ? 31 - q : q; const float a_ = As[(d * 32 + t) * 128 + j], u_ = Us[(d * 32 + t) * 128 + j]; h = fmaf(a_, h, u_); Us[(d * 32 + t) * 128 + j] = h; }
            __syncthreads();
            bf16_t* YC = (bf16_t*)(a.ws + WS_YCAT);
            const int jj = tid & 127, tg = tid >> 7;
#pragma unroll
            for (int i = 0; i < 8; ++i) { const int t = tg * 8 + i; const size_t row = (size_t)b * SEQ + t0 + t;
                const float hs = Us[t * 128 + jj] + Us[(32 + t) * 128 + jj]; const float gl = bf2f(P[row * NINP + C_GL + n * 128 + jj]);
                YC[row * 2048 + 1024 + n * 128 + jj] = (bf16_t)f2bf(hs * silu_f(gl)); }
        }
    }
}

__device__ __forceinline__ void lru_sum_wave(const Args& a, int witem, unsigned char* ldsw, int lane) {
    asm volatile("" : "+v"(lane));
    const int n = witem & 7, tc = (witem >> 3) & 63, b = witem >> 9, t0 = tc * 32;
    const int r32 = lane & 31, hi = lane >> 5;
    bf16_t* xcb = (bf16_t*)ldsw;
    const bf16_t* P = (const bf16_t*)(a.ws + WS_PROJ);
    {
        const int chn = n * 128 + 2 * lane; const float* cw = a.in[25];
        const f32x2 w0 = *(const f32x2*)(cw + chn), w1 = *(const f32x2*)(cw + 1024 + chn), w2 = *(const f32x2*)(cw + 2048 + chn), w3 = *(const f32x2*)(cw + 3072 + chn), cb2 = *(const f32x2*)(a.in[26] + chn);
        const bf16_t* pp = P + ((size_t)b * SEQ + t0) * NINP + C_XL + chn;
        f32x2 xm2 = {0.f, 0.f}, xm1 = {0.f, 0.f}, x0;
        if (t0 >= 2) { const unsigned v = *(const unsigned*)(pp - 2 * NINP); xm2 = (f32x2){bf2f(v & 0xffffu), __uint_as_float(v & 0xffff0000u)}; }
        if (t0 >= 1) { const unsigned v = *(const unsigned*)(pp - NINP); xm1 = (f32x2){bf2f(v & 0xffffu), __uint_as_float(v & 0xffff0000u)}; }
        { const unsigned v = *(const unsigned*)pp; x0 = (f32x2){bf2f(v & 0xffffu), __uint_as_float(v & 0xffff0000u)}; }
#pragma unroll 8
        for (int i = 0; i < 32; ++i) { f32x2 xp1 = {0.f, 0.f};
            if (t0 + i + 1 < SEQ) { const unsigned v = *(const unsigned*)(pp + (size_t)(i + 1) * NINP); xp1 = (f32x2){bf2f(v & 0xffffu), __uint_as_float(v & 0xffff0000u)}; }
            const f32x2 acc = cb2 + w0 * xm2 + w1 * xm1 + w2 * x0 + w3 * xp1;
            *(unsigned*)(xcb + i * 136 + 2 * lane) = pk2(acc.x, acc.y);
            xm2 = xm1; xm1 = x0; x0 = xp1; }
    }
    LDS_WAIT();
    const bf16_t* WT = (const bf16_t*)(a.ws + WS_WGT);
    float2* LS = (float2*)(a.ws + WS_LSUM);
#pragma unroll 1
    for (int ct = 0; ct < 4; ++ct) {
    const int j = ct * 32 + r32, cj = n * 128 + j;
#pragma unroll
    for (int d = 0; d < 2; ++d) {
        const bf16_t* wa_p = WT + ((size_t)((2 * d) * 8 + n) * 128 + j) * 128 + hi * 8;
        const bf16_t* wx_p = WT + ((size_t)((2 * d + 1) * 8 + n) * 128 + j) * 128 + hi * 8;
        f32x16_t ca, cx;
#pragma unroll
        for (int r = 0; r < 16; ++r) { ca[r] = 0.f; cx[r] = 0.f; }
#pragma unroll
        for (int s = 0; s < 8; ++s) {
            const bf16x8_t af = *(const bf16x8_t*)((const char*)xcb + r32 * 272 + (s * 16 + hi * 8) * 2);
            const bf16x8_t fa = *(const bf16x8_t*)(wa_p + s * 16); const bf16x8_t fx = *(const bf16x8_t*)(wx_p + s * 16);
            ca = __builtin_amdgcn_mfma_f32_32x32x16_bf16(af, fa, ca, 0, 0, 0); cx = __builtin_amdgcn_mfma_f32_32x32x16_bf16(af, fx, cx, 0, 0, 0);
        }
        const float baj = a.in[d ? 33 : 28][cj], bxj = a.in[d ? 35 : 30][cj], sp = softplus_f(-a.in[d ? 36 : 31][cj]);
        float Pg[4], Hg[4];
#pragma unroll
        for (int sg = 0; sg < 4; ++sg) { float Pp = 1.f, Hh = 0.f;
#pragma unroll
            for (int e4 = 0; e4 < 4; ++e4) { const int e = d ? 3 - e4 : e4; const int r = 4 * sg + e; const int t = (r & 3) + 8 * (r >> 2) + 4 * hi;
                const float rg = __builtin_amdgcn_rcpf(1.f + __expf(-(ca[r] + baj))), ig = __builtin_amdgcn_rcpf(1.f + __expf(-(cx[r] + bxj))); const float la = -8.f * rg * sp;
                const float av = __expf(la);
                const float om = (la > -0.0625f) ? -2.f * la * (1.f + la * (1.f + la * (0.6666667f + 0.3333333f * la))) : (1.f - av) * (1.f + av);
                const float uv = __builtin_amdgcn_sqrtf(om) * (ig * bf2f(xcb[t * 136 + j]));
                Hh = fmaf(av, Hh, uv); Pp *= av; }
            Pg[sg] = Pp; Hg[sg] = Hh; }
        float Po[4], Ho[4];
#pragma unroll
        for (int sg = 0; sg < 4; ++sg) { Po[sg] = __shfl_xor(Pg[sg], 32); Ho[sg] = __shfl_xor(Hg[sg], 32); }
        float Ac = 1.f, Hc = 0.f;
#pragma unroll
        for (int qq = 0; qq < 8; ++qq) { const int q = d ? 7 - qq : qq;
            const bool mine = ((q & 1) == hi); const float pq = mine ? Pg[q >> 1] : Po[q >> 1], hq_ = mine ? Hg[q >> 1] : Ho[q >> 1];
            Hc = fmaf(pq, Hc, hq_); Ac *= pq; }
        if (hi == 0) LS[((size_t)(d * 4 + b) * 64 + tc) * 1024 + cj] = make_float2(Ac, Hc);
    }
    }
    LDS_WAIT();
}

__device__ __forceinline__ void combine1_phase(const Args& a, int gw, int NGW, int lane) {
    const float* OF = (const float*)(a.ws + WS_YF); const float* OB = (const float*)(a.ws + WS_YB);
    const bf16_t* P = (const bf16_t*)(a.ws + WS_PROJ); bf16_t* YC = (bf16_t*)(a.ws + WS_YCAT);
    const float* gn = a.in[24];
    for (int m = gw; m < MTOK; m += NGW) {
        const int ch = lane * 16, d0 = ch & 127;
        float z[16], ov[16];
        unpack8(*(const v4u*)(P + (size_t)m * NINP + C_Z + ch), z); unpack8(*(const v4u*)(P + (size_t)m * NINP + C_Z + ch + 8), z + 8);
#pragma unroll
        for (int q = 0; q < 4; ++q) { const f32x4 f = *(const f32x4*)(OF + (size_t)m * 1024 + ch + 4 * q), bk = *(const f32x4*)(OB + (size_t)m * 1024 + ch + 4 * q); const f32x4 o = f + bk;
            ov[4 * q] = o.x; ov[4 * q + 1] = o.y; ov[4 * q + 2] = o.z; ov[4 * q + 3] = o.w; }
        float ss = 0.f;
#pragma unroll
        for (int i = 0; i < 16; ++i) ss += ov[i] * ov[i];
        ss = group_sum<8>(ss);
        const float r = rsqrtf(ss * (1.f / 128.f) + EPS);
#pragma unroll
        for (int i = 0; i < 16; ++i) ov[i] = ov[i] * r * gn[d0 + i] * silu_f(z[i]);
        *(v4u*)(YC + (size_t)m * 2048 + ch) = pack8(ov); *(v4u*)(YC + (size_t)m * 2048 + ch + 8) = pack8(ov + 8);
    }
}

__device__ __forceinline__ void final_norm_phase(const Args& a, int gw, int NGW, int lane) {
    const float* nw = a.in[38];
    for (int m = gw; m < MTOK; m += NGW) {
        f32x4* xr = (f32x4*)(a.out + (size_t)m * 2048) + lane;
        f32x4 v[8]; float s = 0.f;
#pragma unroll
        for (int j = 0; j < 8; ++j) { v[j] = xr[64 * j]; s += (v[j].x * v[j].x + v[j].y * v[j].y) + (v[j].z * v[j].z + v[j].w * v[j].w); }
        const float rstd = rsqrtf(group_sum<64>(s) * (1.f / 2048.f) + EPS);
#pragma unroll
        for (int j = 0; j < 8; ++j) { const f32x4 w = *(const f32x4*)(nw + (64 * j + lane) * 4); xr[64 * j] = v[j] * rstd * w; }
    }
}

typedef GAS unsigned gu32;
#define RLX_AGENT __ATOMIC_RELAXED, __HIP_MEMORY_SCOPE_AGENT
constexpr int CW_BAR = 4096;
constexpr int MISC_OFF = 147456 - 128;
#define XB_TMO      128
#define XB_XCNT(j)  (256  + 64 * (j))
#define XB_XSUB(j)  (1280 + 64 * (j))
#define XB_XGEN(j)  (2304 + 64 * (j))
#define XB_TOP      3328
#define XB_TOPGEN   3392
#define XCD_BAR_WORDS 3456
#define XB_SPIN_CAP (1u << 18)

__device__ __forceinline__ unsigned xb_ld(unsigned* p)              { return __hip_atomic_load(p, __ATOMIC_RELAXED, __HIP_MEMORY_SCOPE_AGENT); }
__device__ __forceinline__ unsigned xb_add(unsigned* p, unsigned v) { return __hip_atomic_fetch_add(p, v, __ATOMIC_RELAXED, __HIP_MEMORY_SCOPE_AGENT); }
__device__ __forceinline__ unsigned xb_xcc_id() { return (unsigned)__builtin_amdgcn_s_getreg((3 << 11) | 20) & 0xFu; }
#define XB_SPIN(cond, bar) do { unsigned _sp = 0; while (cond) { __builtin_amdgcn_s_sleep(1); \
    if ((++_sp & 255u) == 0u) { if (xb_ld(&(bar)[XB_TMO])) break; if (_sp > XB_SPIN_CAP) { atomicAdd(&(bar)[XB_TMO], 1u); break; } } } } while (0)

struct XcdBarrier {
    unsigned* bar; unsigned x;
    volatile LAS unsigned* st;
};

__device__ __forceinline__ XcdBarrier xcd_barrier_post(unsigned* bar, volatile LAS unsigned* st) {
    XcdBarrier b; b.bar = bar; b.x = xb_xcc_id(); b.st = st;
    if (threadIdx.x == 0) (void)xb_add(&bar[XB_XCNT(b.x)], 1u);
    return b;
}
__device__ __forceinline__ void xcd_barrier_complete(unsigned* bar, unsigned x, unsigned& nloc, unsigned& nx) {
    const unsigned G = gridDim.x * gridDim.y * gridDim.z;
    unsigned sum, cnt, mine, sp = 0u;
    for (;;) {
        sum = 0u; cnt = 0u; mine = 0u;
#pragma unroll
        for (unsigned j = 0; j < 16; ++j) { const unsigned c = xb_ld(&bar[XB_XCNT(j)]); sum += c; cnt += (c > 0u) ? 1u : 0u; mine = (j == x) ? c : mine; }
        if (sum == G) break;
        __builtin_amdgcn_s_sleep(1);
        if ((++sp & 255u) == 0u) { if (xb_ld(&bar[XB_TMO])) break; if (sp > XB_SPIN_CAP) { atomicAdd(&bar[XB_TMO], 1u); break; } }
    }
    nloc = mine > 0u ? mine : 1u; nx = cnt > 0u ? cnt : 1u;
}

__device__ __forceinline__ void xcd_barrier(const XcdBarrier& b) {
    asm volatile("s_waitcnt vmcnt(0)" ::: "memory");
    __syncthreads();
    if (threadIdx.x == 0) {
        unsigned* bar = b.bar;
        __builtin_amdgcn_s_waitcnt(0);
        unsigned nloc = b.st[0], nx = b.st[1];
        if (nloc == 0u) { xcd_barrier_complete(bar, b.x, nloc, nx); b.st[0] = nloc; b.st[1] = nx; }
        const unsigned old = xb_add(&bar[XB_XSUB(b.x)], 1u);
        const unsigned gen = old / nloc;
        if (old + 1u == (gen + 1u) * nloc) {
            __builtin_amdgcn_fence(__ATOMIC_RELEASE, "agent");
            asm volatile("s_waitcnt vmcnt(0)" ::: "memory");
            const unsigned og = xb_add(&bar[XB_TOP], 1u);
            const unsigned tg = og / nx;
            if (og + 1u == (tg + 1u) * nx) xb_add(&bar[XB_TOPGEN], 1u);
            else XB_SPIN(xb_ld(&bar[XB_TOPGEN]) == tg, bar);
            __builtin_amdgcn_fence(__ATOMIC_ACQUIRE, "agent");
            xb_add(&bar[XB_XGEN(b.x)], 1u);
            asm volatile("s_waitcnt vmcnt(0)" ::: "memory");
        } else {
            XB_SPIN(xb_ld(&bar[XB_XGEN(b.x)]) == gen, bar);
            __builtin_amdgcn_fence(__ATOMIC_ACQUIRE, "agent");
            asm volatile("s_waitcnt vmcnt(0)" ::: "memory");
        }
    }
    __syncthreads();
}

#ifndef PROBE_MASK
#define PROBE_MASK 0
#endif
#define REP(bit) for (int rep_ = 0; rep_ < 1 + ((PROBE_MASK >> (bit)) & 1); ++rep_)
#ifndef PROBE_SSD
#define PROBE_SSD 0
#endif
#ifndef PROBE_GDN
#define PROBE_GDN 0
#endif
#ifndef PROBE_LRU
#define PROBE_LRU 0
#endif
#ifndef MK_SINGLE
#define MK_SINGLE 1
#endif
__global__ void __launch_bounds__(NTHREADS, 2) mk_fwd(Args a) {
    extern __shared__ __attribute__((aligned(16))) unsigned char lds[];
    LAS unsigned char* ldsl = (LAS unsigned char*)lds;
    const int tid = threadIdx.x, lane = tid & 63, wave = __builtin_amdgcn_readfirstlane(tid >> 6);
    const int G = gridDim.x, bx = blockIdx.x;
    const int vcu = (G % 8 == 0) ? (bx % 8) * (G / 8) + bx / 8 : bx;
    const int gw = vcu * NWAVES + wave, NGW = G * NWAVES;
    unsigned char* ws = a.ws;
    volatile LAS unsigned* MISC = (volatile LAS unsigned*)(ldsl + MISC_OFF);
    if (tid < 32) MISC[tid] = 0u;
    __syncthreads();
    XcdBarrier bar; bar.bar = (unsigned*)(ws + WS_CTL) + CW_BAR; bar.x = 0; bar.st = nullptr;
    if (a.ph_hi - a.ph_lo > 1) bar = xcd_barrier_post((unsigned*)(ws + WS_CTL) + CW_BAR, MISC + 8);
#define IN(k) (a.ph_lo <= (k) && (k) < a.ph_hi)
#define SEAM(k) do { if (IN(k) && IN((k) + 1)) { xcd_barrier(bar); } } while (0)

    if (IN(0)) { p0_prologue(a, ldsl, vcu, G); } SEAM(0);
    if (IN(1)) { REP(0) normmod_phase(a, a.in[0], 0, gw, NGW, lane); } SEAM(1);
    if (IN(2)) {
        pg8::Gemm g{(const bf16_t*)(ws + WS_H), (const bf16_t*)(ws + WS_WIN0), MTOK, NINP, 2048}; pg8::StaticOrder S; S.init(MTOK, NINP, G, bx);
        pg8::EpiProj E{(bf16_t*)(ws + WS_PROJ), (float*)(ws + WS_SMALL), NINP, A_DT / 256};
        REP(1) { pg8::gemm_phase<pg8::EpiProj, pg8::StaticOrder, true, true>(ldsl, g, S, E); __syncthreads(); }
    } SEAM(2);
    if (IN(3)) { REP(0) post0_phase(a, gw, NGW, lane); } SEAM(3);
    if (IN(4)) {
        REP(3) for (int u = vcu; u < 256; u += G) { const int b = u >> 6, h = (u >> 3) & 7, qb = u & 7, kvh = h >> 2; const size_t row0 = (size_t)b * SEQ + qb * 256;
            att::attn_dense_body((const att::bf16*)(ws + WS_QB) + row0 * 1024 + h * 128, (const att::bf16*)(ws + WS_KB) + (size_t)b * SEQ * 256 + kvh * 128,
                                 (const att::bf16*)(ws + WS_VB) + (size_t)b * SEQ * 256 + kvh * 128, (bf16_t*)(ws + WS_YCAT) + row0 * 2048 + h * 128,
                                 (const bf16_t*)(ws + WS_PROJ) + row0 * NINP + A_GA + h * 128, SEQ, (char*)lds);
            __syncthreads(); }
        if (wave == 0) { for (int it = vcu; it < 256; it += G) ssd2_item(a, it, lds); }
        else if (wave <= 4) late_transposes(a, (LAS float*)(ldsl + 100096 + (wave - 1) * 8448), vcu * 4 + (wave - 1), G * 4, lane);
        __syncthreads();
    } SEAM(4);
    if (IN(5)) { REP(0) ssd_combine_phase(a, gw, NGW, lane); } SEAM(5);
    if (IN(6)) {
        pg8::Gemm g{(const bf16_t*)(ws + WS_YCAT), (const bf16_t*)(ws + WS_WOUT0), MTOK, 2048, 2048}; pg8::StaticOrder S; S.init(MTOK, 2048, G, bx);
        pg8::EpiResid E{a.in[0], a.out, (const float*)(ws + WS_MOD), a.in[3]};
        REP(2) { pg8::gemm_phase<pg8::EpiResid, pg8::StaticOrder, true, true>(ldsl, g, S, E); __syncthreads(); }
    } SEAM(6);
    if (IN(7)) { REP(0) normmod_phase(a, a.out, 1, gw, NGW, lane); } SEAM(7);
    if (IN(8)) {
        pg8::Gemm g{(const bf16_t*)(ws + WS_H), (const bf16_t*)(ws + WS_WIN1), MTOK, NINP, 2048}; pg8::StaticOrder S; S.init(MTOK, NINP, G, bx);
        pg8::EpiProj E{(bf16_t*)(ws + WS_PROJ), (float*)(ws + WS_SMALL), NINP, C_SM / 256};
        pg8::gemm_phase<pg8::EpiProj, pg8::StaticOrder, true, true>(ldsl, g, S, E);
    } SEAM(8);
    if (IN(9)) { REP(0) post1_phase(a, gw, NGW, lane); } SEAM(9);
    if (IN(10)) {
        REP(5) { for (int it = gw; it < 2048; it += NGW) gdn1_item(a, it, lds + wave * GDN_LDS_PER_WAVE, lane); __syncthreads(); }
    } SEAM(10);
    if (IN(11)) {
        if (wave == 0) { for (int it = vcu; it < 256; it += G) gdn2_item(a, it, lds); }
        else if (wave <= 2) { for (int wi = vcu * 2 + (wave - 1); wi < 2048; wi += G * 2) lru_sum_wave(a, wi, lds + 124160 + (wave - 1) * 8704, lane); }
        __syncthreads();
    } SEAM(11);
    if (IN(12)) { REP(0) combine1_phase(a, gw, NGW, lane); __syncthreads(); REP(4) { for (int it = bx; it < 2048; it += G) lru_tile(a, it, lds, 1); __syncthreads(); } } SEAM(12);
    if (IN(13)) {
        pg8::Gemm g{(const bf16_t*)(ws + WS_YCAT), (const bf16_t*)(ws + WS_WOUT1), MTOK, 2048, 2048}; pg8::StaticOrder S; S.init(MTOK, 2048, G, bx);
        pg8::EpiResid E{a.out, a.out, (const float*)(ws + WS_MOD) + 4 * 6144, a.in[3] + 6144};
        pg8::gemm_phase<pg8::EpiResid, pg8::StaticOrder, true, true>(ldsl, g, S, E);
    } SEAM(13);
    if (IN(14)) { final_norm_phase(a, gw, NGW, lane); }
#undef IN
#undef SEAM
}

extern "C" void kernel_launch(void* const* d_in, const int* in_sizes, int n_in, void* d_out, int out_size, void* d_ws, size_t ws_size, hipStream_t stream) {
    static int grid = 0;
    if (grid == 0) {
        if (n_in != 39 || out_size != MTOK * DM || ws_size < WS_END) { fprintf(stderr, "kernel_launch: unexpected problem (n_in %d, out %d, ws %zu < %zu)\n", n_in, out_size, ws_size, (size_t)WS_END); grid = -1; return; }
        int dev = 0, cus = 0, per_cu = 0;
        if (hipGetDevice(&dev) != hipSuccess || hipDeviceGetAttribute(&cus, hipDeviceAttributeMultiprocessorCount, dev) != hipSuccess) { grid = -1; return; }
        if (hipFuncSetAttribute((const void*)mk_fwd, hipFuncAttributeMaxDynamicSharedMemorySize, LDS_BYTES) != hipSuccess) { fprintf(stderr, "kernel_launch: hipFuncSetAttribute failed\n"); grid = -1; return; }
        if (hipOccupancyMaxActiveBlocksPerMultiprocessor(&per_cu, (const void*)mk_fwd, NTHREADS, LDS_BYTES) != hipSuccess || per_cu < 1) { fprintf(stderr, "kernel_launch: occupancy query says %d\n", per_cu); (void)hipGetLastError(); per_cu = 1; }
        grid = cus;
    }
    if (grid < 0) return;
    (void)hipMemsetAsync((char*)d_ws + WS_CTL, 0, CTL_ZERO_BYTES, stream);
    Args a{};
    for (int i = 0; i < 39; ++i) a.in[i] = (const float*)d_in[i];
    a.out = (float*)d_out; a.ws = (unsigned char*)d_ws;
#if MK_SINGLE
    a.ph_lo = 0; a.ph_hi = NPHASE;
    void* kargs[] = {&a};
    hipError_t e = hipLaunchCooperativeKernel((const void*)mk_fwd, dim3(grid), dim3(NTHREADS), kargs, LDS_BYTES, stream);
    if (e != hipSuccess) fprintf(stderr, "kernel_launch: cooperative launch failed: %s (grid %d)\n", hipGetErrorString(e), grid);
#else
    for (int p = 0; p < NPHASE; ++p) { a.ph_lo = p; a.ph_hi = p + 1; hipLaunchKernelGGL(mk_fwd, dim3(grid), dim3(NTHREADS), LDS_BYTES, stream, a); }
#endif
}
```

```cpp
#include <hip/hip_runtime.h>
#include <hip/hip_cooperative_groups.h>
#include <hip/hip_bf16.h>
#include <cstdio>
#include <cstdint>
namespace cg = cooperative_groups;

constexpr int BATCH = 4, SEQ = 2048, DM = 2048, MTOK = BATCH * SEQ;
constexpr int NIN = 5152, NINP = 5376;
constexpr float EPS = 1e-6f;
constexpr int A_Q = 0, A_K = 1024, A_V = 1280, A_GA = 1536, A_XS = 2560, A_BS = 3584, A_CS = 3840, A_DT = 4096, A_Z = 4128;
constexpr int C_Q = 0, C_K = 512, C_V = 1024, C_SM = 2048, C_Z = 2080, C_XL = 3104, C_GL = 4128;
namespace pg8 {
#define PG8_LAS __attribute__((address_space(3)))
typedef unsigned short bf16_t;
typedef short bf16x8 __attribute__((ext_vector_type(8)));
typedef float f32x4 __attribute__((ext_vector_type(4)));
typedef unsigned u32x4 __attribute__((ext_vector_type(4)));
constexpr int BM = 256, BK = 64, HALF = 128, HTB = HALF * BK * 2  , STAGE_BYTES = 8 * HTB, NXCD = 8, WGM = 8;

__host__ __device__ __forceinline__ int lds_byte(int r, int c) { const int st = (r >> 4) * 2 + (c >> 5), rr = r & 15, cc = c & 31, ob = rr * 64 + cc * 2; return st * 1024 + (ob ^ (((ob >> 9) & 1) << 5)); }
__host__ __device__ __forceinline__ void stage_rc(int b, int& R, int& C) { const int st = b / 1024, sb = b % 1024, swz = sb ^ (((sb >> 9) & 1) << 5); R = (st >> 1) * 16 + swz / 64; C = (st & 1) * 32 + (swz % 64) / 2; }
__host__ __device__ __forceinline__ int perm32(int rho) { const int n = rho >> 4, i = rho & 15; return 8 * (i >> 2) + 4 * n + (i & 3); }

struct Unit { int pm, pn; };
struct Gemm { const bf16_t* A; const bf16_t* Bt; int M, N, K; };

struct StaticOrder {
    int nM, nN, nwg, G, c;
    __host__ __device__ void init(int M, int N, int G_, int c_) { nM = M / BM; nN = N / BM; nwg = nM * nN; G = G_; c = c_; }
    __host__ __device__ bool next(int i, Unit& u) const {
        const long L = (long)i * G + c; if (L >= nwg) return false;
        int wgid = (int)L; { const int q = nwg / NXCD, r = nwg % NXCD, xcd = wgid % NXCD, off = wgid / NXCD; wgid = (xcd < r ? xcd * (q + 1) : r * (q + 1) + (xcd - r) * q) + off; }
        const int nig = WGM * nN, gid = wgid / nig, fm = gid * WGM, gsz = (nM - fm) < WGM ? (nM - fm) : WGM;
        u.pm = fm + ((wgid % nig) % gsz); u.pn = (wgid % nig) / gsz; return true;
    }
    __device__ __forceinline__ void a_ready(const Unit&) const {}
    __device__ __forceinline__ void done(const Unit&) const {}
};

__device__ __forceinline__ unsigned cvt_pk_bf16(float lo, float hi) { unsigned r; asm volatile("v_cvt_pk_bf16_f32 %0, %1, %2" : "=v"(r) : "v"(lo), "v"(hi)); return r; }
typedef float f32x2 __attribute__((ext_vector_type(2)));
struct EpiProj {
    static constexpr bool PERM = true, AFTER_DRAIN = false;
    bf16_t* O; float* small; int ldc; int small_tile;
    __device__ __forceinline__ void operator()(const f32x4 (&acc)[2][2][4][2], const Unit& u, int wr, int wc, int fr, int fq) const {
        const int row0 = u.pm * BM + wr * 64 + fr; const int col0 = u.pn * BM + wc * 32 + 8 * fq;
        const bool sm = (u.pn == small_tile) && (wc == 0);
#pragma unroll
        for (int ai = 0; ai < 2; ++ai)
#pragma unroll
            for (int m = 0; m < 4; ++m) { const int row = row0 + ai * HALF + m * 16; bf16_t* rowp = O + (size_t)row * ldc + col0;
#pragma unroll
                for (int bj = 0; bj < 2; ++bj) { const f32x4 v0 = acc[ai][bj][m][0], v1 = acc[ai][bj][m][1];
                    u32x4 w; w.x = cvt_pk_bf16(v0[0], v0[1]); w.y = cvt_pk_bf16(v0[2], v0[3]); w.z = cvt_pk_bf16(v1[0], v1[1]); w.w = cvt_pk_bf16(v1[2], v1[3]);
                    *(u32x4*)(rowp + bj * HALF) = w; }
                if (sm) { float* sp = small + (size_t)row * 32 + 8 * fq; *(f32x4*)sp = acc[ai][0][m][0]; *(f32x4*)(sp + 4) = acc[ai][0][m][1]; } }
    }
};
struct EpiResid {
    static constexpr bool PERM = false, AFTER_DRAIN = false;
    const float* xin; float* xout; const float* gacc; const float* gbias;
    __device__ __forceinline__ void operator()(const f32x4 (&acc)[2][2][4][2], const Unit& u, int wr, int wc, int fr, int fq) const {
        const int b = u.pm >> 3;
        const int col0 = u.pn * BM + wc * 32 + 4 * fq;
#pragma unroll
        for (int bj = 0; bj < 2; ++bj)
#pragma unroll
            for (int n = 0; n < 2; ++n) { const int col = col0 + bj * HALF + n * 16;
                const f32x4 g = *(const f32x4*)(gacc + (size_t)b * 6144 + 4096 + col) + *(const f32x4*)(gbias + 4096 + col);
#pragma unroll
                for (int ai = 0; ai < 2; ++ai)
#pragma unroll
                    for (int m = 0; m < 4; ++m) { const size_t off = (size_t)(u.pm * BM + ai * HALF + wr * 64 + m * 16 + fr) * 2048 + col;
                        const f32x4 xv = *(const f32x4*)(xin + off); *(f32x4*)(xout + off) = xv + g * acc[ai][bj][m][n]; } }
    }
};
template <class Epi, class Sched, bool ALIGN_EPI = false, bool SP2 = false>
__device__ __forceinline__ void gemm_phase(PG8_LAS unsigned char* lds, const Gemm g, const Sched& S, const Epi& E) {
    const int tid = threadIdx.x, wid = __builtin_amdgcn_readfirstlane(tid >> 6), lane = tid & 63, wr = wid >> 2, wc = wid & 3, fr = lane & 15, fq = lane >> 4;
    const int K = g.K, nt = K / BK;
    unsigned voffA[2], voffB[2];
#pragma unroll
    for (int i = 0; i < 2; ++i) { int R, C; stage_rc(tid * 16 + i * 8192, R, C); const int Rb = Epi::PERM ? ((R & ~31) + perm32(R & 31)) : R;
        voffA[i] = (unsigned)(R * K + C) * 2u; voffB[i] = (unsigned)(Rb * K + C) * 2u; }
    const size_t kstep = (size_t)(BK * 2);
    const size_t hstep = (size_t)HALF * K * 2;
    const size_t tstep = 2 * hstep;
    const unsigned ldsw = (unsigned)wid * 1024u;
    const int aoff = lds_byte(wr * 64 + fr, fq * 8), boff = lds_byte(wc * 32 + fr, fq * 8);
#define PG8_SA(b, h) (((b) * 2 + (h)) * HTB)
#define PG8_SB(b, h) ((4 + (b) * 2 + (h)) * HTB)
#define PG8_STAGE(bufoff, gbase, voff) do { _Pragma("unroll") for (int _i = 0; _i < 2; ++_i) \
        __builtin_amdgcn_global_load_lds((const unsigned*)((const char*)(gbase) + (voff)[_i]), (PG8_LAS unsigned*)(lds + (bufoff) + ldsw + _i * 8192), 16, 0, 0); } while (0)
#define PG8_LDA(dst, b, h) do { _Pragma("unroll") for (int m = 0; m < 4; ++m) _Pragma("unroll") for (int k = 0; k < 2; ++k) dst[m][k] = *(const PG8_LAS bf16x8*)(lds + PG8_SA(b, h) + aoff + m * 2048 + k * 1024); } while (0)
#define PG8_LDB(dst, b, h) do { _Pragma("unroll") for (int n = 0; n < 2; ++n) _Pragma("unroll") for (int k = 0; k < 2; ++k) dst[n][k] = *(const PG8_LAS bf16x8*)(lds + PG8_SB(b, h) + boff + n * 2048 + k * 1024); } while (0)
#define PG8_MMA(ai, bj, At, Bt) do { __builtin_amdgcn_s_setprio(1); _Pragma("unroll") for (int m = 0; m < 4; ++m) _Pragma("unroll") for (int n = 0; n < 2; ++n) _Pragma("unroll") for (int k = 0; k < 2; ++k) \
        acc[ai][bj][m][n] = __builtin_amdgcn_mfma_f32_16x16x32_bf16(Bt[n][k], At[m][k], acc[ai][bj][m][n], 0, 0, 0); __builtin_amdgcn_s_setprio(0); } while (0)
#define PG8_WAIT_V(n) asm volatile("s_waitcnt vmcnt(" #n ")" ::: "memory")
#define PG8_WAIT_L(n) asm volatile("s_waitcnt lgkmcnt(" #n ")" ::: "memory")
#define PG8_BAR __builtin_amdgcn_s_barrier()
#define PG8_SCHED __builtin_amdgcn_sched_barrier(0)
    Unit cur, nxt; int ui = 0;
    if (!S.next(0, cur)) return;
    f32x4 acc[2][2][4][2];
#pragma unroll
    for (int a = 0; a < 2; ++a)
#pragma unroll
        for (int b = 0; b < 2; ++b)
#pragma unroll
            for (int m = 0; m < 4; ++m)
#pragma unroll
                for (int n = 0; n < 2; ++n) acc[a][b][m][n] = (f32x4){0.f, 0.f, 0.f, 0.f};
    bf16x8 At[4][2], B0[2][2], B1[2][2];
    const char* cA = (const char*)g.A + (size_t)cur.pm * tstep; const char* cB = (const char*)g.Bt + (size_t)cur.pn * tstep;
    S.a_ready(cur);
    if constexpr (SP2) {
        PG8_STAGE(PG8_SB(0, 0), cB, voffB); PG8_STAGE(PG8_SB(0, 1), cB + hstep, voffB); PG8_STAGE(PG8_SA(0, 0), cA, voffA); PG8_STAGE(PG8_SA(0, 1), cA + hstep, voffA);
        if (wr == 1) PG8_BAR;
        PG8_WAIT_V(2); PG8_BAR;
        PG8_STAGE(PG8_SB(1, 0), cB + kstep, voffB); PG8_STAGE(PG8_SA(1, 0), cA + kstep, voffA); PG8_STAGE(PG8_SB(1, 1), cB + hstep + kstep, voffB);
        PG8_WAIT_V(6); PG8_BAR;
    } else {
        PG8_STAGE(PG8_SB(0, 0), cB, voffB); PG8_STAGE(PG8_SA(0, 0), cA, voffA); PG8_STAGE(PG8_SB(0, 1), cB + hstep, voffB); PG8_STAGE(PG8_SA(0, 1), cA + hstep, voffA);
        if (wr == 1) PG8_BAR;
        PG8_WAIT_V(4); PG8_BAR;
        PG8_STAGE(PG8_SB(1, 0), cB + kstep, voffB); PG8_STAGE(PG8_SA(1, 0), cA + kstep, voffA); PG8_STAGE(PG8_SB(1, 1), cB + hstep + kstep, voffB);
        PG8_WAIT_V(6); PG8_BAR;
    }
    for (;;) {
        const bool has_next = S.next(ui + 1, nxt);
        const char* nA = has_next ? (const char*)g.A + (size_t)nxt.pm * tstep : cA; const char* nB = has_next ? (const char*)g.Bt + (size_t)nxt.pn * tstep : cB;
        for (int t = 0; t < nt; t += 2) {
            const bool last = (t == nt - 2);
            const char* a1 = cA + (size_t)(t + 1) * kstep;
            const char* a2 = last ? nA : cA + (size_t)(t + 2) * kstep; const char* b2 = last ? nB : cB + (size_t)(t + 2) * kstep;
            const char* a3 = a2 + kstep; const char* b3 = b2 + kstep;
            if (last && has_next) S.a_ready(nxt);
            if constexpr (SP2) {
            PG8_LDB(B0, 0, 0); PG8_LDB(B1, 0, 1); PG8_SCHED; PG8_LDA(At, 0, 0); PG8_STAGE(PG8_SA(1, 1), a1 + hstep, voffA);
            PG8_WAIT_V(8); PG8_WAIT_L(0); PG8_BAR; PG8_MMA(0, 0, At, B0); PG8_MMA(0, 1, At, B1); PG8_BAR; PG8_SCHED;
            PG8_LDA(At, 0, 1); PG8_STAGE(PG8_SB(0, 0), b2, voffB); PG8_STAGE(PG8_SB(0, 1), b2 + hstep, voffB); PG8_STAGE(PG8_SA(0, 0), a2, voffA);
            PG8_WAIT_V(8); PG8_WAIT_L(0); PG8_BAR; PG8_MMA(1, 0, At, B0); PG8_MMA(1, 1, At, B1); PG8_BAR; PG8_SCHED;
            PG8_LDB(B0, 1, 0); PG8_LDB(B1, 1, 1); PG8_SCHED; PG8_LDA(At, 1, 0); PG8_STAGE(PG8_SA(0, 1), a2 + hstep, voffA);
            PG8_WAIT_V(8); PG8_WAIT_L(0); PG8_BAR; PG8_MMA(0, 0, At, B0); PG8_MMA(0, 1, At, B1); PG8_BAR; PG8_SCHED;
            PG8_LDA(At, 1, 1); PG8_STAGE(PG8_SB(1, 0), b3, voffB); PG8_STAGE(PG8_SB(1, 1), b3 + hstep, voffB); PG8_STAGE(PG8_SA(1, 0), a3, voffA);
            PG8_WAIT_V(8); PG8_WAIT_L(0); PG8_BAR; PG8_MMA(1, 0, At, B0); PG8_MMA(1, 1, At, B1); PG8_BAR; PG8_SCHED;
            } else {
            PG8_LDB(B0, 0, 0); PG8_SCHED; PG8_LDA(At, 0, 0); PG8_STAGE(PG8_SA(1, 1), a1 + hstep, voffA);
            PG8_WAIT_L(8); PG8_BAR; PG8_WAIT_L(0); PG8_MMA(0, 0, At, B0); PG8_BAR; PG8_SCHED;
            PG8_LDB(B1, 0, 1); PG8_STAGE(PG8_SB(0, 0), b2, voffB);
            PG8_BAR; PG8_WAIT_L(0); PG8_MMA(0, 1, At, B1); PG8_BAR;
            PG8_LDA(At, 0, 1); PG8_STAGE(PG8_SA(0, 0), a2, voffA);
            PG8_BAR; PG8_WAIT_L(0); PG8_MMA(1, 0, At, B0); PG8_BAR; PG8_SCHED;
            PG8_STAGE(PG8_SB(0, 1), b2 + hstep, voffB);
            PG8_WAIT_V(6); PG8_BAR; PG8_MMA(1, 1, At, B1); PG8_BAR;
            PG8_LDB(B0, 1, 0); PG8_SCHED; PG8_LDA(At, 1, 0); PG8_STAGE(PG8_SA(0, 1), a2 + hstep, voffA);
            PG8_WAIT_L(8); PG8_BAR; PG8_WAIT_L(0); PG8_MMA(0, 0, At, B0); PG8_BAR; PG8_SCHED;
            PG8_LDB(B1, 1, 1); PG8_STAGE(PG8_SB(1, 0), b3, voffB);
            PG8_BAR; PG8_WAIT_L(0); PG8_MMA(0, 1, At, B1); PG8_BAR;
            PG8_LDA(At, 1, 1); PG8_STAGE(PG8_SA(1, 0), a3, voffA);
            PG8_BAR; PG8_WAIT_L(0); PG8_MMA(1, 0, At, B0); PG8_BAR; PG8_SCHED;
            PG8_STAGE(PG8_SB(1, 1), b3 + hstep, voffB);
            PG8_WAIT_V(6); PG8_BAR; PG8_MMA(1, 1, At, B1); PG8_BAR;
            }
        }
        if constexpr (ALIGN_EPI) { if (wr == 0) PG8_BAR; }
        if constexpr (!Epi::AFTER_DRAIN) { E(acc, cur, wr, wc, fr, fq); S.done(cur); }
        if (!has_next) break;
#pragma unroll
        for (int a = 0; a < 2; ++a)
#pragma unroll
            for (int b = 0; b < 2; ++b)
#pragma unroll
                for (int m = 0; m < 4; ++m)
#pragma unroll
                    for (int n = 0; n < 2; ++n) acc[a][b][m][n] = (f32x4){0.f, 0.f, 0.f, 0.f};
        cur = nxt; cA = nA; cB = nB; ++ui;
        if constexpr (ALIGN_EPI) { if (wr == 1) PG8_BAR; }
    }
    PG8_WAIT_V(0);
    if constexpr (!ALIGN_EPI) { if (wr == 0) PG8_BAR; }
    PG8_BAR;
    if constexpr (Epi::AFTER_DRAIN) { E.fused(acc, cur, wr, wc, fr, fq, lds, wid, lane); S.done(cur); }
#undef PG8_SA
#undef PG8_SB
#undef PG8_STAGE
#undef PG8_LDA
#undef PG8_LDB
#undef PG8_MMA
#undef PG8_WAIT_V
#undef PG8_WAIT_L
#undef PG8_BAR
#undef PG8_SCHED
}
}
namespace att {
using bf16 = __hip_bfloat16;
constexpr int   D = 128, NW = 8, QBLK = 32, KVBLK = 64;
constexpr float SCALE = 0.088388347648318440f;
constexpr float THR = 8.f;
constexpr int SDEPTH = 2;
constexpr int LDQ = 1024, LDK = 256, LDY = 2048, LDG = NINP;
constexpr size_t SHM_V = KVBLK * D * 2, SHM_K = KVBLK * D * 2, SHM_ATTN = 2 * SHM_V + 2 * SHM_K + NW * 64 * 4;
using bf16x8 = __attribute__((ext_vector_type(8))) short;
using s16x4  = __attribute__((ext_vector_type(4))) short;
using f32x16 = __attribute__((ext_vector_type(16))) float;
using f32x8  = __attribute__((ext_vector_type(8))) float;
using u32x4  = __attribute__((ext_vector_type(4))) unsigned;
#define KSWZ(row, colB) ((row) * 256 + ((colB) ^ (((row) & 7) << 4)))
#define SBAR() __builtin_amdgcn_sched_barrier(0)
__device__ __forceinline__ int crow(int r, int hi) { return (r & 3) + 8 * (r >> 2) + 4 * hi; }
__device__ __forceinline__ unsigned cvtpk(float lo, float hi) {
  unsigned r; asm volatile("v_cvt_pk_bf16_f32 %0, %1, %2" : "=v"(r) : "v"(lo), "v"(hi)); return r;
}
template <typename TIn> struct Stage;
template <> struct Stage<bf16>  { using T = bf16x8;
  __device__ static __forceinline__ T ld8(const bf16* p) { return *reinterpret_cast<const bf16x8*>(p); }
  __device__ static __forceinline__ bf16x8 tobf(T x) { return x; } };
template <> struct Stage<float> { using T = f32x8;
  __device__ static __forceinline__ T ld8(const float* p) { return *reinterpret_cast<const f32x8*>(p); }
  __device__ static __forceinline__ bf16x8 tobf(T x) {
    u32x4 w = {cvtpk(x[0], x[1]), cvtpk(x[2], x[3]), cvtpk(x[4], x[5]), cvtpk(x[6], x[7])}; return *reinterpret_cast<bf16x8*>(&w); } };

__device__ __forceinline__ void partialSM(f32x16& p0, f32x16& p1, float& m_reg, float& mn, float& alpha) {
  constexpr float C = SCALE * 1.4426950408889634f;
  float pmax = p0[0]; for (int r = 1; r < 16; ++r) pmax = fmaxf(pmax, p0[r]); for (int r = 0; r < 16; ++r) pmax = fmaxf(pmax, p1[r]);
  { auto rr = __builtin_amdgcn_permlane32_swap(__float_as_uint(pmax), __float_as_uint(pmax), false, false);
    pmax = fmaxf(__uint_as_float(rr[0]), __uint_as_float(rr[1])); }
  if (__builtin_expect(__all(pmax - m_reg <= THR / SCALE), 1)) { mn = m_reg; alpha = 1.f; }
  else { mn = fmaxf(m_reg, pmax); alpha = __builtin_amdgcn_exp2f((m_reg - mn) * C); m_reg = mn; }
  float mnC = -mn * C;
  for (int r = 0; r < 16; ++r) p0[r] = fmaf(p0[r], C, mnC); for (int r = 0; r < 16; ++r) p1[r] = fmaf(p1[r], C, mnC);
  for (int r = 0; r < 16; ++r) p0[r] = __builtin_amdgcn_exp2f(p0[r]);
}
__device__ __forceinline__ void finishSM(f32x16& p0, f32x16& p1, float alpha, float& l_reg, bf16x8& pa0, bf16x8& pa1, bf16x8& pa2, bf16x8& pa3) {
  for (int r = 0; r < 16; ++r) p1[r] = __builtin_amdgcn_exp2f(p1[r]);
  float ps = 0; for (int r = 0; r < 16; ++r) ps += p0[r]; for (int r = 0; r < 16; ++r) ps += p1[r];
  { auto rr = __builtin_amdgcn_permlane32_swap(__float_as_uint(ps), __float_as_uint(ps), false, false);
    ps = __uint_as_float(rr[0]) + __uint_as_float(rr[1]); }
  l_reg = l_reg * alpha + ps;
#define PK4(P, BASE, OUT) do { unsigned a0 = cvtpk(P[BASE + 0], P[BASE + 1]), a1 = cvtpk(P[BASE + 2], P[BASE + 3]);   \
    unsigned b0 = cvtpk(P[BASE + 4], P[BASE + 5]), b1 = cvtpk(P[BASE + 6], P[BASE + 7]);                              \
    auto r0 = __builtin_amdgcn_permlane32_swap(a0, b0, false, false); auto r1 = __builtin_amdgcn_permlane32_swap(a1, b1, false, false); \
    u32x4 w = {r0[0], r1[0], r0[1], r1[1]}; OUT = *reinterpret_cast<bf16x8*>(&w); } while (0)
  PK4(p0, 0, pa0); PK4(p0, 8, pa1); PK4(p1, 0, pa2); PK4(p1, 8, pa3);
#undef PK4
}
__device__ __forceinline__ void qkt(f32x16& p0, f32x16& p1, const bf16* Ks, const bf16x8* qr, int r32, int hi) {
  p0 = f32x16{}; p1 = f32x16{};
  for (int d0 = 0; d0 < 8; ++d0) { int cb = (d0 * 16 + hi * 8) * 2;
    bf16x8 b0 = *reinterpret_cast<const bf16x8*>((const char*)Ks + KSWZ(r32, cb));
    bf16x8 b1 = *reinterpret_cast<const bf16x8*>((const char*)Ks + KSWZ(32 + r32, cb));
    p0 = __builtin_amdgcn_mfma_f32_32x32x16_bf16(b0, qr[d0], p0, 0, 0, 0);
    p1 = __builtin_amdgcn_mfma_f32_32x32x16_bf16(b1, qr[d0], p1, 0, 0, 0); }
}
__device__ __forceinline__ int v_st(int k, int c) { const int kk = (k & ~0xC) | ((k & 4) << 1) | ((k & 8) >> 1); return ((kk >> 3) * 4 + (c >> 5)) * 512 + ((kk & 7) * 32 + (c & 31)) * 2; }
__device__ __forceinline__ int v_rd_base(int lane) { return ((lane & 3) << 3) | (((lane >> 2) & 3) << 6) | (((lane >> 4) & 1) << 5) | (((lane >> 5) & 1) << 8); }
constexpr int v_rd_off(int d0, int ks, int half) { return d0 * 512 + ks * 4096 + half * 2048; }
template <int OFF> __device__ __forceinline__ s16x4 tr_read(int vb) {
  s16x4 r; asm volatile("ds_read_b64_tr_b16 %0, %1 offset:%2" : "=&v"(r) : "v"(vb), "i"(OFF) : "memory"); return r;
}
template <int D0> __device__ __forceinline__ void pv_one(f32x16& od, int vb, bf16x8 pa0, bf16x8 pa1, bf16x8 pa2, bf16x8 pa3) {
  const s16x4 l0 = tr_read<v_rd_off(D0, 0, 0)>(vb), h0 = tr_read<v_rd_off(D0, 0, 1)>(vb), l1 = tr_read<v_rd_off(D0, 1, 0)>(vb), h1 = tr_read<v_rd_off(D0, 1, 1)>(vb);
  const s16x4 l2 = tr_read<v_rd_off(D0, 2, 0)>(vb), h2 = tr_read<v_rd_off(D0, 2, 1)>(vb), l3 = tr_read<v_rd_off(D0, 3, 0)>(vb), h3 = tr_read<v_rd_off(D0, 3, 1)>(vb);
  asm volatile("s_waitcnt lgkmcnt(0)" ::: "memory"); SBAR();
#define PK(L, H) (bf16x8){L[0], L[1], L[2], L[3], H[0], H[1], H[2], H[3]}
  od = __builtin_amdgcn_mfma_f32_32x32x16_bf16(pa0, PK(l0, h0), od, 0, 0, 0);
  od = __builtin_amdgcn_mfma_f32_32x32x16_bf16(pa1, PK(l1, h1), od, 0, 0, 0);
  od = __builtin_amdgcn_mfma_f32_32x32x16_bf16(pa2, PK(l2, h2), od, 0, 0, 0);
  od = __builtin_amdgcn_mfma_f32_32x32x16_bf16(pa3, PK(l3, h3), od, 0, 0, 0);
#undef PK
}
__device__ __forceinline__ void pv_d0(f32x16* o, int vb, bf16x8 pa0, bf16x8 pa1, bf16x8 pa2, bf16x8 pa3) {
  pv_one<0>(o[0], vb, pa0, pa1, pa2, pa3); pv_one<1>(o[1], vb, pa0, pa1, pa2, pa3); pv_one<2>(o[2], vb, pa0, pa1, pa2, pa3); pv_one<3>(o[3], vb, pa0, pa1, pa2, pa3);
}
__device__ __forceinline__ void attn_dense_body(const bf16* __restrict__ Qb, const bf16* __restrict__ Kh, const bf16* __restrict__ Vh,
                                                unsigned short* __restrict__ Yb, const unsigned short* __restrict__ Gb, int seq, char* lds) {
  using St = Stage<bf16>; using SQ = Stage<bf16>; using TQ = bf16;
  const int tid = threadIdx.x, wid = tid >> 6, lane = tid & 63, r32 = lane & 31, hi = lane >> 5;
  bf16* V_lds = (bf16*)lds; bf16* K_lds = (bf16*)(lds + 2 * SHM_V);
  float* ws = (float*)(lds + 2 * SHM_V + 2 * SHM_K) + wid * 64; float* li_l = ws; float* al_l = ws + 32;
  float m_reg = -1e30f, l_reg = 0; f32x16 o[4] = {}; bf16x8 qr[8];
  const TQ* Qw = Qb + (long)(wid * QBLK + r32) * LDQ + hi * 8;
#pragma unroll
  for (int d0 = 0; d0 < 8; ++d0) qr[d0] = SQ::tobf(SQ::ld8(Qw + d0 * 16));
  const int sr = tid >> 4, sc = (tid & 15) * 8, vst0 = v_st(sr, sc), vst1 = v_st(32 + sr, sc);
  const int vb0 = (int)(uintptr_t)V_lds + v_rd_base(lane);
  struct { typename St::T vs0, vs1, ks0, ks1; } sr_[SDEPTH];
#define SLOAD(i, k0) do { sr_[i].vs0 = St::ld8(&Vh[(long)((k0) + sr) * LDK + sc]); sr_[i].vs1 = St::ld8(&Vh[(long)((k0) + 32 + sr) * LDK + sc]); \
    sr_[i].ks0 = St::ld8(&Kh[(long)((k0) + sr) * LDK + sc]); sr_[i].ks1 = St::ld8(&Kh[(long)((k0) + 32 + sr) * LDK + sc]); } while (0)
#define SWRITE(b, i) do { *(bf16x8*)((char*)V_lds + (b) * SHM_V + vst0) = St::tobf(sr_[i].vs0);          \
    *(bf16x8*)((char*)V_lds + (b) * SHM_V + vst1) = St::tobf(sr_[i].vs1); int kc = sc * 2;               \
    *(bf16x8*)((char*)K_lds + (b) * SHM_K + KSWZ(sr, kc)) = St::tobf(sr_[i].ks0);                       \
    *(bf16x8*)((char*)K_lds + (b) * SHM_K + KSWZ(32 + sr, kc)) = St::tobf(sr_[i].ks1); } while (0)
#define SWAIT() do { if constexpr (SDEPTH == 2) asm volatile("s_waitcnt vmcnt(4)" ::: "memory"); else asm volatile("s_waitcnt vmcnt(0)" ::: "memory"); } while (0)
#define RESC(a) do { if (__any((a) < 1.f)) { if (hi == 0) al_l[r32] = (a); asm volatile("s_waitcnt lgkmcnt(0)" ::: "memory"); \
    for (int d = 0; d < 4; ++d) for (int r = 0; r < 16; ++r) o[d][r] *= al_l[crow(r, hi)]; } } while (0)
  f32x16 pA0, pA1, pB0, pB1; float mnA, mnB, alA, alB; bf16x8 pa0, pa1, pa2, pa3; const int NT = seq / KVBLK;
  constexpr int SE = 0, SO = SDEPTH - 1;
  SLOAD(SE, 0); asm volatile("s_waitcnt vmcnt(0)" ::: "memory"); SWRITE(0, SE); __syncthreads();
  qkt(pA0, pA1, K_lds, qr, r32, hi); partialSM(pA0, pA1, m_reg, mnA, alA);
  SLOAD(SO, KVBLK); if constexpr (SDEPTH == 2) { if (2 < NT) SLOAD(SE, 2 * KVBLK); }
  SWAIT(); SWRITE(1, SO); __syncthreads();
  for (int j = 1; j + 1 < NT; j += 2) {
    SBAR(); qkt(pB0, pB1, (bf16*)((char*)K_lds + SHM_K), qr, r32, hi);
    finishSM(pA0, pA1, alA, l_reg, pa0, pa1, pa2, pa3); SBAR();
    SLOAD(SO, (j + SDEPTH) * KVBLK); SBAR();
    pv_d0(o, vb0, pa0, pa1, pa2, pa3); partialSM(pB0, pB1, m_reg, mnB, alB);
    __syncthreads(); SWAIT(); SWRITE(0, SE);
    RESC(alB); __syncthreads();
    SBAR(); qkt(pA0, pA1, K_lds, qr, r32, hi);
    finishSM(pB0, pB1, alB, l_reg, pa0, pa1, pa2, pa3); SBAR();
    if (SDEPTH == 1 || j + 3 < NT) SLOAD(SE, (j + 1 + SDEPTH) * KVBLK); SBAR();
    pv_d0(o, vb0 + (int)SHM_V, pa0, pa1, pa2, pa3); partialSM(pA0, pA1, m_reg, mnA, alA);
    __syncthreads(); SWAIT(); SWRITE(1, SO);
    RESC(alA); __syncthreads();
  }
  SBAR(); qkt(pB0, pB1, (bf16*)((char*)K_lds + SHM_K), qr, r32, hi);
  finishSM(pA0, pA1, alA, l_reg, pa0, pa1, pa2, pa3); SBAR();
  pv_d0(o, vb0, pa0, pa1, pa2, pa3); partialSM(pB0, pB1, m_reg, mnB, alB);
  __syncthreads(); RESC(alB);
  finishSM(pB0, pB1, alB, l_reg, pa0, pa1, pa2, pa3); SBAR();
  pv_d0(o, vb0 + (int)SHM_V, pa0, pa1, pa2, pa3);
  if (hi == 0) li_l[r32] = l_reg; asm volatile("s_waitcnt lgkmcnt(0)" ::: "memory");
  float rli[16];
#pragma unroll
  for (int r = 0; r < 16; ++r) rli[r] = __builtin_amdgcn_rcpf(li_l[crow(r, hi)]);
  __syncthreads();
  { int ew = wid; asm volatile("" : "+v"(ew));
    float* stg = (float*)lds + ew * (32 * 132);
#pragma unroll
    for (int r = 0; r < 16; ++r) { const int orow = crow(r, hi);
#pragma unroll
      for (int d0 = 0; d0 < 4; ++d0) stg[orow * 132 + d0 * 32 + r32] = o[d0][r] * rli[r]; }
    asm volatile("s_waitcnt lgkmcnt(0)" ::: "memory");
    int el = lane; asm volatile("" : "+v"(el));
    const unsigned short* Gw0 = Gb + (long)(ew * QBLK) * LDG; unsigned short* Yw0 = Yb + (long)(ew * QBLK) * LDY;
#pragma unroll 2
    for (int i = 0; i < 8; ++i) { const int id = el + 64 * i, row = id >> 4, c8 = id & 15;
      const float* sp = stg + row * 132 + c8 * 8;
      const u32x4 gw = *reinterpret_cast<const u32x4*>(Gw0 + (long)row * LDG + c8 * 8);
      u32x4 ow;
#pragma unroll
      for (int q = 0; q < 4; ++q) { const unsigned gq = (q == 0) ? gw.x : (q == 1) ? gw.y : (q == 2) ? gw.z : gw.w;
        const float g0 = __uint_as_float(gq << 16), g1 = __uint_as_float(gq & 0xffff0000u);
        const float v0 = sp[2 * q] * (g0 / (1.f + __expf(-g0))), v1 = sp[2 * q + 1] * (g1 / (1.f + __expf(-g1)));
        const unsigned pk = cvtpk(v0, v1);
        if (q == 0) ow.x = pk; else if (q == 1) ow.y = pk; else if (q == 2) ow.z = pk; else ow.w = pk; }
      *reinterpret_cast<u32x4*>(Yw0 + (long)row * LDY + c8 * 8) = ow; } }
#undef SLOAD
#undef SWRITE
#undef SWAIT
#undef RESC
}
}
#define GAS __attribute__((address_space(1)))
#define LAS __attribute__((address_space(3)))
typedef unsigned short bf16_t;
typedef unsigned v4u __attribute__((ext_vector_type(4)));
typedef unsigned v2u __attribute__((ext_vector_type(2)));
typedef float f32x4 __attribute__((ext_vector_type(4)));
typedef short bf16x8_t __attribute__((ext_vector_type(8)));
typedef float f32x16_t __attribute__((ext_vector_type(16)));
#define LDS_WAIT() asm volatile("s_waitcnt lgkmcnt(0)" ::: "memory")

constexpr size_t MiB = 1u << 20;
constexpr size_t WS_CTL = 0, CTL_ZERO_BYTES = 1 * MiB;
constexpr size_t WS_MOD = 64 * 1024;
constexpr size_t WS_ROPE = 1 * MiB;
constexpr size_t WS_SMALL = 2 * MiB;
constexpr size_t WS_WIN0 = 3 * MiB, WS_WOUT0 = 24 * MiB;
constexpr size_t WS_QB = 32 * MiB, WS_KB = 48 * MiB, WS_VB = 52 * MiB;
constexpr size_t WS_HB = 3 * MiB;
constexpr size_t WS_WIN1 = 56 * MiB, WS_WOUT1 = 77 * MiB;
constexpr size_t WS_H = 85 * MiB;
constexpr size_t WS_HF = 85 * MiB;
constexpr size_t WS_PROJ = 117 * MiB;
constexpr size_t WS_YCAT = 201 * MiB;
constexpr size_t WS_ACT = 233 * MiB;
constexpr size_t WS_YF = 297 * MiB, WS_YB = 329 * MiB;
constexpr size_t WS_XBC16 = 85 * MiB;
constexpr size_t WS_QKV16 = 3 * MiB;
constexpr size_t WS_GT = 85 * MiB, WS_GA = 101 * MiB;
constexpr size_t WS_WGT = 361 * MiB;
constexpr size_t WS_LSUM = 362 * MiB;
constexpr size_t WS_END = 366 * MiB;

constexpr int NWAVES = 8, NTHREADS = 512;
constexpr int LDS_BYTES = 147456;
constexpr int NPHASE = 15;

struct Args { const float* in[39]; float* out; unsigned char* ws; int ph_lo, ph_hi; };

__device__ __forceinline__ float bf2f(unsigned v) { return __uint_as_float(v << 16); }
__device__ __forceinline__ unsigned f2bf(float f) { unsigned u = __float_as_uint(f); return (u + 0x7fffu + ((u >> 16) & 1u)) >> 16; }
__device__ __forceinline__ unsigned pk2(float lo, float hi) { return f2bf(lo) | (f2bf(hi) << 16); }
__device__ __forceinline__ void unpack8(const v4u w, float* x) {
    x[0] = __uint_as_float(w.x << 16); x[1] = __uint_as_float(w.x & 0xffff0000u); x[2] = __uint_as_float(w.y << 16); x[3] = __uint_as_float(w.y & 0xffff0000u);
    x[4] = __uint_as_float(w.z << 16); x[5] = __uint_as_float(w.z & 0xffff0000u); x[6] = __uint_as_float(w.w << 16); x[7] = __uint_as_float(w.w & 0xffff0000u);
}
__device__ __forceinline__ v4u pack8(const float* x) { v4u w; w.x = pk2(x[0], x[1]); w.y = pk2(x[2], x[3]); w.z = pk2(x[4], x[5]); w.w = pk2(x[6], x[7]); return w; }
__device__ __forceinline__ float silu_f(float x) { return x / (1.f + expf(-x)); }
__device__ __forceinline__ float sigmoid_f(float x) { return 1.f / (1.f + expf(-x)); }
__device__ __forceinline__ float softplus_f(float x) { return fmaxf(x, 0.f) + log1pf(expf(-fabsf(x))); }
template <int CTRL> __device__ __forceinline__ float dpp_mov(float v) { return __builtin_bit_cast(float, __builtin_amdgcn_update_dpp(0, __builtin_bit_cast(int, v), CTRL, 0xF, 0xF, true)); }
template <int N> __device__ __forceinline__ float group_sum(float v) {
    if (N >= 2) v += dpp_mov<0xB1>(v);
    if (N >= 4) v += dpp_mov<0x4E>(v);
    if (N >= 8) v += dpp_mov<0x141>(v);
    if (N >= 16) v += dpp_mov<0x140>(v);
    if (N >= 32) v += __shfl_xor(v, 16);
    if (N >= 64) v += __shfl_xor(v, 32);
    return v;
}

__device__ __forceinline__ void p0_transpose_item(const float* W, int K, int N, bf16_t* WT, int row_off, LAS float* scr, int item, int lane) {
    const int nblk = N / 32, kb = item / nblk, nb = item % nblk, k0 = 64 * kb, n0 = 32 * nb;
#pragma unroll 8
    for (int i = 0; i < 32; ++i) { const int kk = 2 * i + (lane >> 5); scr[kk * 33 + (lane & 31)] = W[(size_t)(k0 + kk) * N + n0 + (lane & 31)]; }
    LDS_WAIT(); asm volatile("" ::: "memory");
    const int c = lane & 7;
#pragma unroll
    for (int j = 0; j < 4; ++j) { const int n = (lane >> 3) + 8 * j; const LAS float* s = scr + (8 * c) * 33 + n;
        v4u o; o.x = pk2(s[0 * 33], s[1 * 33]); o.y = pk2(s[2 * 33], s[3 * 33]); o.z = pk2(s[4 * 33], s[5 * 33]); o.w = pk2(s[6 * 33], s[7 * 33]);
        *(v4u*)(WT + (size_t)(row_off + n0 + n) * K + k0 + 8 * c) = o; }
    LDS_WAIT(); asm volatile("" ::: "memory");
}

__device__ __forceinline__ void p0_prologue(const Args& a, LAS unsigned char* lds, int vcu, int G) {
    const int tid = threadIdx.x, lane = tid & 63, wave = tid >> 6;
    unsigned char* ws = a.ws;
    { const int gid = blockIdx.x * NTHREADS + tid;
      if (gid < 2048) { const int pos = gid >> 5, i = gid & 31; const float freq = expf(-(float)i * (1.f / 32.f) * 9.210340371976184f); const float ang = (float)pos * freq;
          float* rt = (float*)(ws + WS_ROPE); rt[2 * gid] = cosf(ang); rt[2 * gid + 1] = sinf(ang); } }
    { const int gid = blockIdx.x * NTHREADS + tid, gn = G * NTHREADS; constexpr int NV = (NINP - NIN) * 2048 * 2 / 16;
      v4u* p0 = (v4u*)(ws + WS_WIN0 + (size_t)NIN * 2048 * 2); v4u* p1 = (v4u*)(ws + WS_WIN1 + (size_t)NIN * 2048 * 2);
      for (int i = gid; i < NV; i += gn) { p0[i] = (v4u){0, 0, 0, 0}; p1[i] = (v4u){0, 0, 0, 0}; } }
    if (blockIdx.x < 192) {
        const int it = blockIdx.x, l = it / 96, r = it % 96, kc = r / 3, nc = r % 3;
        LAS float* cond = (LAS float*)lds;
        if (tid < 256) { const int b = tid >> 6, k = tid & 63; const float c = a.in[1][b * 2048 + kc * 64 + k]; cond[tid] = silu_f(c); }
        __syncthreads();
        const float* W = a.in[2] + (size_t)l * 2048 * 6144 + (size_t)(kc * 64) * 6144 + nc * 2048 + tid * 4;
        f32x4 acc0 = {0, 0, 0, 0}, acc1 = acc0, acc2 = acc0, acc3 = acc0;
#pragma unroll 8
        for (int k = 0; k < 64; ++k) { const f32x4 w = *(const f32x4*)(W + (size_t)k * 6144);
            acc0 += cond[k] * w; acc1 += cond[64 + k] * w; acc2 += cond[128 + k] * w; acc3 += cond[192 + k] * w; }
        float* macc = (float*)(ws + WS_MOD) + (size_t)l * 4 * 6144 + nc * 2048 + tid * 4;
#pragma unroll
        for (int i = 0; i < 4; ++i) { atomicAdd(macc + i, acc0[i]); atomicAdd(macc + 6144 + i, acc1[i]); atomicAdd(macc + 2 * 6144 + i, acc2[i]); atomicAdd(macc + 3 * 6144 + i, acc3[i]); }
        __syncthreads();
    }
    { LAS float* scr = (LAS float*)(lds + wave * 16384);
      const int gw = vcu * NWAVES + wave, NGW = G * NWAVES;
      constexpr int I_IN = 32 * (NIN / 32), I_OUT = 32 * 64, NITEMS = I_IN + I_OUT;
      for (int it = gw; it < NITEMS; it += NGW) {
          int r = it;
          if (r < I_IN) { p0_transpose_item(a.in[5], 2048, NIN, (bf16_t*)(ws + WS_WIN0), 0, scr, r, lane); continue; } r -= I_IN;
          p0_transpose_item(a.in[16], 2048, 2048, (bf16_t*)(ws + WS_WOUT0), 0, scr, r, lane);
      } }
}
__device__ __forceinline__ void late_transposes(const Args& a, LAS float* scr, int hw, int NHW, int lane) {
    unsigned char* ws = a.ws;
    constexpr int I_IN = 32 * (NIN / 32), I_OUT = 32 * 64, I_G = 32 * 8, NITEMS = I_IN + I_OUT + I_G;
    for (int it = hw; it < NITEMS; it += NHW) {
        int r = it;
        if (r < I_G) { const int mn = r >> 3, m = mn >> 3; const float* Wg = a.in[m == 0 ? 27 : m == 1 ? 29 : m == 2 ? 32 : 34] + (size_t)(mn & 7) * 128 * 128;
            p0_transpose_item(Wg, 128, 128, (bf16_t*)(ws + WS_WGT) + (size_t)mn * 128 * 128, 0, scr, r & 7, lane); continue; } r -= I_G;
        if (r < I_IN) { p0_transpose_item(a.in[17], 2048, NIN, (bf16_t*)(ws + WS_WIN1), 0, scr, r, lane); continue; } r -= I_IN;
        p0_transpose_item(a.in[37], 2048, 2048, (bf16_t*)(ws + WS_WOUT1), 0, scr, r, lane);
    }
}

__device__ __forceinline__ void normmod_phase(const Args& a, const float* xin, int layer, int gw, int NGW, int lane) {
    const float* nw = a.in[4] + layer * 2048; const float* bm = a.in[3] + layer * 6144;
    const float* macc = (const float*)(a.ws + WS_MOD) + (size_t)layer * 4 * 6144;
    bf16_t* H = (bf16_t*)(a.ws + WS_H);
    for (int m = gw; m < MTOK; m += NGW) {
        const int b = m >> 11;
        const f32x4* xr = (const f32x4*)(xin + (size_t)m * 2048) + lane;
        f32x4 v[8]; float s = 0.f;
#pragma unroll
        for (int j = 0; j < 8; ++j) { v[j] = xr[64 * j]; s += (v[j].x * v[j].x + v[j].y * v[j].y) + (v[j].z * v[j].z + v[j].w * v[j].w); }
        const float rstd = rsqrtf(group_sum<64>(s) * (1.f / 2048.f) + EPS);
#pragma unroll
        for (int j = 0; j < 8; ++j) { const int col = (64 * j + lane) * 4;
            const f32x4 w = *(const f32x4*)(nw + col);
            const f32x4 sh = *(const f32x4*)(macc + b * 6144 + col) + *(const f32x4*)(bm + col);
            const f32x4 sc = *(const f32x4*)(macc + b * 6144 + 2048 + col) + *(const f32x4*)(bm + 2048 + col);
            const f32x4 o = v[j] * rstd * w * (1.f + sc) + sh;
            v2u pk; pk.x = pk2(o.x, o.y); pk.y = pk2(o.z, o.w);
            *(v2u*)(H + (size_t)m * 2048 + col) = pk; }
    }
}

__device__ __forceinline__ void post0_phase(const Args& a, int gw, int NGW, int lane) {
    const bf16_t* P = (const bf16_t*)(a.ws + WS_PROJ);
    const float2* rope = (const float2*)(a.ws + WS_ROPE);
    const float* qn = a.in[6]; const float* kn = a.in[7]; const float* cw = a.in[8]; const float* cb = a.in[9];
    bf16_t* Q = (bf16_t*)(a.ws + WS_QB); bf16_t* K = (bf16_t*)(a.ws + WS_KB); bf16_t* V = (bf16_t*)(a.ws + WS_VB);
    float* ACT = (float*)(a.ws + WS_ACT);
    for (int m = gw; m < MTOK; m += NGW) {
        const int t = m & 2047, prow = t >> 6, pcol = t & 63;
        const bf16_t* pr = P + (size_t)m * NINP;
        {
            float x[16]; unpack8(*(const v4u*)(pr + A_Q + lane * 16), x); unpack8(*(const v4u*)(pr + A_Q + lane * 16 + 8), x + 8);
            float ss = 0.f;
#pragma unroll
            for (int i = 0; i < 16; ++i) ss += x[i] * x[i];
            ss = group_sum<8>(ss);
            const float r = rsqrtf(ss * (1.f / 128.f) + EPS);
            const int d0 = (lane & 7) * 16;
#pragma unroll
            for (int i = 0; i < 16; ++i) x[i] = x[i] * r * qn[d0 + i];
#pragma unroll
            for (int pi = 0; pi < 8; ++pi) { const int p = (d0 >> 1) + pi; const float2 cs = (p < 32) ? rope[prow * 32 + p] : rope[pcol * 32 + p - 32];
                const float x0 = x[2 * pi], x1 = x[2 * pi + 1]; x[2 * pi] = x0 * cs.x - x1 * cs.y; x[2 * pi + 1] = x0 * cs.y + x1 * cs.x; }
            *(v4u*)(Q + (size_t)m * 1024 + lane * 16) = pack8(x); *(v4u*)(Q + (size_t)m * 1024 + lane * 16 + 8) = pack8(x + 8);
        }
        {
            const v2u w = *(const v2u*)(pr + A_K + lane * 4);
            float x[4] = {__uint_as_float(w.x << 16), __uint_as_float(w.x & 0xffff0000u), __uint_as_float(w.y << 16), __uint_as_float(w.y & 0xffff0000u)};
            float ss = (x[0] * x[0] + x[1] * x[1]) + (x[2] * x[2] + x[3] * x[3]);
            ss = group_sum<32>(ss);
            const float r = rsqrtf(ss * (1.f / 128.f) + EPS);
            const int d0 = (lane & 31) * 4;
#pragma unroll
            for (int i = 0; i < 4; ++i) x[i] = x[i] * r * kn[d0 + i];
#pragma unroll
            for (int pi = 0; pi < 2; ++pi) { const int p = (d0 >> 1) + pi; const float2 cs = (p < 32) ? rope[prow * 32 + p] : rope[pcol * 32 + p - 32];
                const float x0 = x[2 * pi], x1 = x[2 * pi + 1]; x[2 * pi] = x0 * cs.x - x1 * cs.y; x[2 * pi + 1] = x0 * cs.y + x1 * cs.x; }
            v2u o; o.x = pk2(x[0], x[1]); o.y = pk2(x[2], x[3]);
            *(v2u*)(K + (size_t)m * 256 + lane * 4) = o;
            *(v2u*)(V + (size_t)m * 256 + lane * 4) = *(const v2u*)(pr + A_V + lane * 4);
        }
#pragma unroll
        for (int j = 0; j < 3; ++j) { const int ch = (j * 64 + lane) * 8;
            float acc[8];
            { const f32x4 b0 = *(const f32x4*)(cb + ch), b1 = *(const f32x4*)(cb + ch + 4); acc[0] = b0.x; acc[1] = b0.y; acc[2] = b0.z; acc[3] = b0.w; acc[4] = b1.x; acc[5] = b1.y; acc[6] = b1.z; acc[7] = b1.w; }
#pragma unroll
            for (int d = 0; d < 4; ++d) { const int ts = t + d - 2;
                if (ts >= 0 && ts < SEQ) { float x[8]; unpack8(*(const v4u*)(P + (size_t)(m + d - 2) * NINP + A_XS + ch), x);
                    const f32x4 w0 = *(const f32x4*)(cw + d * 1536 + ch), w1 = *(const f32x4*)(cw + d * 1536 + ch + 4);
                    acc[0] += w0.x * x[0]; acc[1] += w0.y * x[1]; acc[2] += w0.z * x[2]; acc[3] += w0.w * x[3];
                    acc[4] += w1.x * x[4]; acc[5] += w1.y * x[5]; acc[6] += w1.z * x[6]; acc[7] += w1.w * x[7]; } }
            f32x4 o0, o1; o0.x = silu_f(acc[0]); o0.y = silu_f(acc[1]); o0.z = silu_f(acc[2]); o0.w = silu_f(acc[3]); o1.x = silu_f(acc[4]); o1.y = silu_f(acc[5]); o1.z = silu_f(acc[6]); o1.w = silu_f(acc[7]);
            *(f32x4*)(ACT + (size_t)m * 1536 + ch) = o0; *(f32x4*)(ACT + (size_t)m * 1536 + ch + 4) = o1;
            { v4u w; w.x = pk2(o0.x, o0.y); w.y = pk2(o0.z, o0.w); w.z = pk2(o1.x, o1.y); w.w = pk2(o1.z, o1.w); *(v4u*)((bf16_t*)(a.ws + WS_XBC16) + (size_t)m * 1536 + ch) = w; } }
    }
}

typedef float f32x2 __attribute__((ext_vector_type(2)));
__device__ __forceinline__ void ssd_combine_phase(const Args& a, int gw, int NGW, int lane) {
    const float* YF = (const float*)(a.ws + WS_YF); const float* YB = (const float*)(a.ws + WS_YB); const float* ACT = (const float*)(a.ws + WS_ACT);
    const bf16_t* P = (const bf16_t*)(a.ws + WS_PROJ); bf16_t* YC = (bf16_t*)(a.ws + WS_YCAT);
    const float* dsk = a.in[14]; const float* nw = a.in[15];
    for (int m = gw; m < MTOK; m += NGW) {
        const int ch = lane * 16; const float dk = dsk[ch >> 6];
        float z[16], gv[16]; unpack8(*(const v4u*)(P + (size_t)m * NINP + A_Z + ch), z); unpack8(*(const v4u*)(P + (size_t)m * NINP + A_Z + ch + 8), z + 8);
        float ss = 0.f;
#pragma unroll
        for (int q = 0; q < 4; ++q) { const f32x4 f = *(const f32x4*)(YF + (size_t)m * 1024 + ch + 4 * q), bk = *(const f32x4*)(YB + (size_t)m * 1024 + ch + 4 * q), xv = *(const f32x4*)(ACT + (size_t)m * 1536 + ch + 4 * q);
            const f32x4 y = f + bk + dk * xv;
            gv[4 * q] = y.x * silu_f(z[4 * q]); gv[4 * q + 1] = y.y * silu_f(z[4 * q + 1]); gv[4 * q + 2] = y.z * silu_f(z[4 * q + 2]); gv[4 * q + 3] = y.w * silu_f(z[4 * q + 3]); }
#pragma unroll
        for (int i = 0; i < 16; ++i) ss += gv[i] * gv[i];
        const float r = rsqrtf(group_sum<64>(ss) * (1.f / 1024.f) + EPS);
#pragma unroll
        for (int i = 0; i < 16; ++i) gv[i] = gv[i] * r * nw[ch + i];
        *(v4u*)(YC + (size_t)m * 2048 + 1024 + ch) = pack8(gv); *(v4u*)(YC + (size_t)m * 2048 + 1024 + ch + 8) = pack8(gv + 8);
    }
}

__device__ __forceinline__ void post1_phase(const Args& a, int gw, int NGW, int lane) {
    const bf16_t* P = (const bf16_t*)(a.ws + WS_PROJ); const float* cw = a.in[18]; const float* cb = a.in[19];
    float* ACT = (float*)(a.ws + WS_ACT);
    for (int m = gw; m < MTOK; m += NGW) {
        const int t = m & 2047;
#pragma unroll
        for (int j = 0; j < 4; ++j) { const int ch = (j * 64 + lane) * 8;
            float acc[8];
            { const f32x4 b0 = *(const f32x4*)(cb + ch), b1 = *(const f32x4*)(cb + ch + 4); acc[0] = b0.x; acc[1] = b0.y; acc[2] = b0.z; acc[3] = b0.w; acc[4] = b1.x; acc[5] = b1.y; acc[6] = b1.z; acc[7] = b1.w; }
#pragma unroll
            for (int d = 0; d < 4; ++d) { const int ts = t + d - 2;
                if (ts >= 0 && ts < SEQ) { float x[8]; unpack8(*(const v4u*)(P + (size_t)(m + d - 2) * NINP + C_Q + ch), x);
                    const f32x4 w0 = *(const f32x4*)(cw + d * 2048 + ch), w1 = *(const f32x4*)(cw + d * 2048 + ch + 4);
                    acc[0] += w0.x * x[0]; acc[1] += w0.y * x[1]; acc[2] += w0.z * x[2]; acc[3] += w0.w * x[3];
                    acc[4] += w1.x * x[4]; acc[5] += w1.y * x[5]; acc[6] += w1.z * x[6]; acc[7] += w1.w * x[7]; } }
#pragma unroll
            for (int i = 0; i < 8; ++i) acc[i] = silu_f(acc[i]);
            if (j < 2) {
                float ss = 0.f;
#pragma unroll
                for (int i = 0; i < 8; ++i) ss += acc[i] * acc[i];
                ss = group_sum<16>(ss);
                float r = rsqrtf(ss + EPS); if (j == 0) r *= 0.088388347648318440f;
#pragma unroll
                for (int i = 0; i < 8; ++i) acc[i] *= r;
            }
            *(f32x4*)(ACT + (size_t)m * 2048 + ch) = (f32x4){acc[0], acc[1], acc[2], acc[3]}; *(f32x4*)(ACT + (size_t)m * 2048 + ch + 4) = (f32x4){acc[4], acc[5], acc[6], acc[7]};
            *(v4u*)((bf16_t*)(a.ws + WS_QKV16) + (size_t)m * 2048 + ch) = pack8(acc); }
    }
}

typedef short s16x4_t __attribute__((ext_vector_type(4)));
typedef __bf16 bf16x2_v __attribute__((ext_vector_type(2)));
__device__ __forceinline__ unsigned cvtpk_rne(float lo, float hi) { f32x2 v = {lo, hi}; bf16x2_v bb = __builtin_convertvector(v, bf16x2_v); return __builtin_bit_cast(unsigned, bb); }
template <int S_> __device__ __forceinline__ bf16x8_t acc_frag(const f32x16_t& x) {
    v4u w; w.x = cvtpk_rne(x[8 * S_ + 0], x[8 * S_ + 1]); w.y = cvtpk_rne(x[8 * S_ + 2], x[8 * S_ + 3]); w.z = cvtpk_rne(x[8 * S_ + 4], x[8 * S_ + 5]); w.w = cvtpk_rne(x[8 * S_ + 6], x[8 * S_ + 7]);
    return __builtin_bit_cast(bf16x8_t, w);
}
__device__ __forceinline__ bf16x8_t join44(v2u lo, v2u hi) { v4u w; w.x = lo.x; w.y = lo.y; w.z = hi.x; w.w = hi.y; return __builtin_bit_cast(bf16x8_t, w); }
__device__ __forceinline__ float wave_incl_scan(float v, int lane) {
#pragma unroll
    for (int o = 1; o < 64; o <<= 1) { const float t = __shfl_up(v, o); if (lane >= o) v += t; }
    return v;
}
constexpr int GDN_LDS_PER_WAVE = 17920;
__device__ __forceinline__ void gdn1_item(const Args& a, int item, unsigned char* ldsw, int lane) {
    asm volatile("" : "+v"(lane));
    const int c = item & 31, dir = (item >> 5) & 1, hv = (item >> 6) & 7, b = item >> 9, hq = hv >> 1;
    const int r32 = lane & 31, hi = lane >> 5;
    float* AT = (float*)ldsw; float* Gs = AT + 64 * 64; float* Bs = Gs + 64;
    const bf16_t* QK = (const bf16_t*)(a.ws + WS_QKV16); const float* SM = (const float*)(a.ws + WS_SMALL);
    bf16_t* GT = (bf16_t*)(a.ws + WS_GT) + (size_t)item * 4096; bf16_t* GA = (bf16_t*)(a.ws + WS_GA) + (size_t)item * 4096;
    const float Aneg = -expf(a.in[dir ? 21 : 20][hv]); const float dtb = a.in[dir ? 23 : 22][hv];
    {
        const int t = dir ? SEQ - 1 - (64 * c + lane) : 64 * c + lane; const float* sm = SM + ((size_t)b * SEQ + t) * 32;
        const float gi = Aneg * softplus_f(sm[16 + dir * 8 + hv] + dtb), bi = sigmoid_f(sm[dir * 8 + hv]);
        Gs[lane] = wave_incl_scan(gi, lane); Bs[lane] = bi;
    }
    const int t0r = dir ? SEQ - 1 - (64 * c + r32) : 64 * c + r32, t1r = dir ? t0r - 32 : t0r + 32;
    const bf16_t* k0p = QK + ((size_t)b * SEQ + t0r) * 2048 + 512 + hq * 128 + hi * 8; const bf16_t* k1p = QK + ((size_t)b * SEQ + t1r) * 2048 + 512 + hq * 128 + hi * 8;
    const bf16_t* q0p = k0p - 512, * q1p = k1p - 512;
    LDS_WAIT();
    const float Gj0 = Gs[r32], Gj1 = Gs[32 + r32];
    {
        f32x16_t kk00, kk10, kk11;
#pragma unroll
        for (int r = 0; r < 16; ++r) { kk00[r] = 0.f; kk10[r] = 0.f; kk11[r] = 0.f; }
#pragma unroll
        for (int s = 0; s < 8; ++s) {
            const bf16x8_t kA0 = *(const bf16x8_t*)(k0p + 16 * s), kA1 = *(const bf16x8_t*)(k1p + 16 * s);
            kk00 = __builtin_amdgcn_mfma_f32_32x32x16_bf16(kA0, kA0, kk00, 0, 0, 0); kk10 = __builtin_amdgcn_mfma_f32_32x32x16_bf16(kA1, kA0, kk10, 0, 0, 0); kk11 = __builtin_amdgcn_mfma_f32_32x32x16_bf16(kA1, kA1, kk11, 0, 0, 0);
        }
#pragma unroll
        for (int r = 0; r < 16; ++r) { const int il = (r & 3) + 8 * (r >> 2) + 4 * hi;
            const float Gi0 = Gs[il], Gi1 = Gs[32 + il], bi0 = Bs[il], bi1 = Bs[32 + il];
            AT[r32 * 64 + il] = (r32 < il) ? bi0 * kk00[r] * expf(Gi0 - Gj0) : 0.f;
            AT[r32 * 64 + 32 + il] = bi1 * kk10[r] * expf(Gi1 - Gj0);
            AT[(32 + r32) * 64 + 32 + il] = (r32 < il) ? bi1 * kk11[r] * expf(Gi1 - Gj1) : 0.f;
            AT[(32 + r32) * 64 + il] = 0.f;
        }
    }
    asm volatile("" ::: "memory");
    {
        f32x16_t qk00, qk10, qk11;
#pragma unroll
        for (int r = 0; r < 16; ++r) { qk00[r] = 0.f; qk10[r] = 0.f; qk11[r] = 0.f; }
#pragma unroll
        for (int s = 0; s < 8; ++s) {
            const bf16x8_t kA0 = *(const bf16x8_t*)(k0p + 16 * s), kA1 = *(const bf16x8_t*)(k1p + 16 * s), qA0 = *(const bf16x8_t*)(q0p + 16 * s), qA1 = *(const bf16x8_t*)(q1p + 16 * s);
            qk00 = __builtin_amdgcn_mfma_f32_32x32x16_bf16(qA0, kA0, qk00, 0, 0, 0); qk10 = __builtin_amdgcn_mfma_f32_32x32x16_bf16(qA1, kA0, qk10, 0, 0, 0); qk11 = __builtin_amdgcn_mfma_f32_32x32x16_bf16(qA1, kA1, qk11, 0, 0, 0);
        }
#pragma unroll
        for (int r = 0; r < 16; ++r) { const int il = (r & 3) + 8 * (r >> 2) + 4 * hi;
            const float Gi0 = Gs[il], Gi1 = Gs[32 + il];
            GA[il * 64 + r32] = (bf16_t)f2bf((r32 <= il) ? qk00[r] * expf(Gi0 - Gj0) : 0.f);
            GA[(32 + il) * 64 + r32] = (bf16_t)f2bf(qk10[r] * expf(Gi1 - Gj0));
            GA[(32 + il) * 64 + 32 + r32] = (bf16_t)f2bf((r32 <= il) ? qk11[r] * expf(Gi1 - Gj1) : 0.f);
        }
    }
    LDS_WAIT(); asm volatile("" ::: "memory");
    float tr[64];
    int lane2 = lane; asm volatile("" : "+v"(lane2) :: "memory");
#pragma unroll
    for (int j = 0; j < 64; ++j) tr[j] = (j == lane2) ? 1.f : 0.f;
    int atoff = 0;
#pragma unroll
    for (int j = 62; j >= 0; --j) { float c0 = 0.f, c1 = 0.f, c2 = 0.f, c3 = 0.f;
        asm volatile("" : "+v"(atoff) : "v"(tr[j + 1]));
#pragma unroll
        for (int qd = (j + 1) / 4; qd < 16; ++qd) { const f32x4 av = *(const f32x4*)(AT + atoff + j * 64 + 4 * qd);
            if (4 * qd + 0 > j) c0 = fmaf(tr[4 * qd + 0], av.x, c0);
            if (4 * qd + 1 > j) c1 = fmaf(tr[4 * qd + 1], av.y, c1);
            if (4 * qd + 2 > j) c2 = fmaf(tr[4 * qd + 2], av.z, c2);
            if (4 * qd + 3 > j) c3 = fmaf(tr[4 * qd + 3], av.w, c3); }
        tr[j] -= (c0 + c1) + (c2 + c3); asm volatile("" ::: "memory"); }
#pragma unroll
    for (int x = 0; x < 8; ++x) *(v4u*)(GT + lane2 * 64 + x * 8) = pack8(tr + x * 8);
    LDS_WAIT();
}

__device__ __forceinline__ void gdn2_item(const Args& a, int item, unsigned char* lds) {
    const int dvs = item & 3, hv = (item >> 2) & 7, dir = (item >> 5) & 1, b = item >> 6, hq = hv >> 1;
    const int lane0 = threadIdx.x & 63;
    constexpr int BUFB = 57344, O_K = 0, O_Q = 16384, O_T = 32768, O_A = 40960, O_V = 49152;
    float* Gs = (float*)(lds + 2 * BUFB); float* Bs = Gs + 64; float* Es = Bs + 64; float* Ws = Es + 64; float* ot = Ws + 64;
    const LAS unsigned char* ldl = (const LAS unsigned char*)lds;
    const bf16_t* QK = (const bf16_t*)(a.ws + WS_QKV16); const float* ACT = (const float*)(a.ws + WS_ACT); const float* SM = (const float*)(a.ws + WS_SMALL);
    float* O = (float*)(a.ws + (dir ? WS_YB : WS_YF));
    const float Aneg = -expf(a.in[dir ? 21 : 20][hv]); const float dtb = a.in[dir ? 23 : 22][hv];
    const size_t gbase = (size_t)(((b * 8 + hv) * 2 + dir) * 32) * 4096;
    f32x16_t S[4];
#pragma unroll
    for (int nt = 0; nt < 4; ++nt)
#pragma unroll
        for (int r = 0; r < 16; ++r) S[nt][r] = 0.f;
    float gar, gbr;
#define G2_DMA(c_, buf_) do { const int t_ = dir ? SEQ - 1 - (64 * (c_) + lane0) : 64 * (c_) + lane0; const size_t mi_ = (size_t)b * SEQ + t_; \
        const bf16_t* kr_ = QK + mi_ * 2048 + 512 + hq * 128; const bf16_t* qr_ = QK + mi_ * 2048 + hq * 128; \
        const bf16_t* tr_ = (const bf16_t*)(a.ws + WS_GT) + gbase + (size_t)(c_) * 4096 + lane0 * 64; const bf16_t* ar_ = (const bf16_t*)(a.ws + WS_GA) + gbase + (size_t)(c_) * 4096 + lane0 * 64; \
        const float* vr_ = ACT + mi_ * 2048 + 1024 + hv * 128 + dvs * 32; \
        LAS unsigned char* lb_ = (LAS unsigned char*)lds + (buf_) * BUFB; \
        _Pragma("unroll") for (int x = 0; x < 16; ++x) { __builtin_amdgcn_global_load_lds((const unsigned*)(kr_ + 8 * x), (LAS unsigned*)(lb_ + O_K + 1024 * x), 16, 0, 0); \
                                                         __builtin_amdgcn_global_load_lds((const unsigned*)(qr_ + 8 * x), (LAS unsigned*)(lb_ + O_Q + 1024 * x), 16, 0, 0); } \
        _Pragma("unroll") for (int x = 0; x < 8; ++x) { __builtin_amdgcn_global_load_lds((const unsigned*)(tr_ + 8 * x), (LAS unsigned*)(lb_ + O_T + 1024 * x), 16, 0, 0); \
                                                        __builtin_amdgcn_global_load_lds((const unsigned*)(ar_ + 8 * x), (LAS unsigned*)(lb_ + O_A + 1024 * x), 16, 0, 0); \
                                                        __builtin_amdgcn_global_load_lds((const unsigned*)(vr_ + 4 * x), (LAS unsigned*)(lb_ + O_V + 1024 * x), 16, 0, 0); } \
        const float* sm_ = SM + mi_ * 32; gar = sm_[16 + dir * 8 + hv]; gbr = sm_[dir * 8 + hv]; } while (0)
    G2_DMA(0, 0);
    for (int c = 0; c < 32; ++c) {
        int lane = lane0; asm volatile("" : "+v"(lane));
        const int r32 = lane & 31, hi = lane >> 5, trq = (lane & 15) >> 2, trp = lane & 3, trc = (lane >> 4) & 1;
        const int bo = (c & 1) * BUFB;
        float GL;
        {
            const float gi = Aneg * softplus_f(gar + dtb), bi = sigmoid_f(gbr);
            const float G = wave_incl_scan(gi, lane); GL = __shfl(G, 63);
            Gs[lane] = G; Bs[lane] = bi; Es[lane] = __expf(G); Ws[lane] = __expf(GL - G);
        }
        asm volatile("s_waitcnt vmcnt(0)" ::: "memory");
        if (c + 1 < 32) G2_DMA(c + 1, (c + 1) & 1);
        LDS_WAIT();
        f32x16_t KS[2];
#pragma unroll
        for (int rt = 0; rt < 2; ++rt)
#pragma unroll
            for (int r = 0; r < 16; ++r) KS[rt][r] = 0.f;
#define LFRAG(off_) join44(*(const LAS v2u*)(ldl + (off_)), *(const LAS v2u*)(ldl + (off_) + 1024))
#pragma unroll
        for (int nt = 0; nt < 4; ++nt) {
            const bf16x8_t sb0 = acc_frag<0>(S[nt]), sb1 = acc_frag<1>(S[nt]);
#pragma unroll
            for (int rt = 0; rt < 2; ++rt) {
                const int ro = bo + O_K + ((4 * nt) * 64 + 32 * rt + r32) * 16 + 8 * hi;
                KS[rt] = __builtin_amdgcn_mfma_f32_32x32x16_bf16(LFRAG(ro), sb0, KS[rt], 0, 0, 0); KS[rt] = __builtin_amdgcn_mfma_f32_32x32x16_bf16(LFRAG(ro + 2048), sb1, KS[rt], 0, 0, 0);
            }
        }
        asm volatile("" ::: "memory");
        f32x16_t rhs[2];
#pragma unroll
        for (int rt = 0; rt < 2; ++rt)
#pragma unroll
            for (int r = 0; r < 16; ++r) { const int i = 32 * rt + (r & 3) + 8 * (r >> 2) + 4 * hi;
                const float vv = *(const LAS float*)(ldl + bo + O_V + ((r32 >> 2) * 64 + i) * 16 + (r32 & 3) * 4); const float bi = Bs[i];
                rhs[rt][r] = bi * vv - bi * Es[i] * KS[rt][r]; }
        asm volatile("" ::: "memory");
        f32x16_t vn[2];
#pragma unroll
        for (int r = 0; r < 16; ++r) { vn[0][r] = 0.f; vn[1][r] = 0.f; }
        {
            const bf16x8_t rb00 = acc_frag<0>(rhs[0]), rb01 = acc_frag<1>(rhs[0]), rb10 = acc_frag<0>(rhs[1]), rb11 = acc_frag<1>(rhs[1]);
            const int t0 = bo + O_T + r32 * 16 + 8 * hi, t1 = t0 + 512;
            vn[0] = __builtin_amdgcn_mfma_f32_32x32x16_bf16(LFRAG(t0), rb00, vn[0], 0, 0, 0); vn[0] = __builtin_amdgcn_mfma_f32_32x32x16_bf16(LFRAG(t0 + 2048), rb01, vn[0], 0, 0, 0);
            vn[1] = __builtin_amdgcn_mfma_f32_32x32x16_bf16(LFRAG(t1), rb00, vn[1], 0, 0, 0); vn[1] = __builtin_amdgcn_mfma_f32_32x32x16_bf16(LFRAG(t1 + 2048), rb01, vn[1], 0, 0, 0);
            vn[1] = __builtin_amdgcn_mfma_f32_32x32x16_bf16(LFRAG(t1 + 4096), rb10, vn[1], 0, 0, 0); vn[1] = __builtin_amdgcn_mfma_f32_32x32x16_bf16(LFRAG(t1 + 6144), rb11, vn[1], 0, 0, 0);
        }
        asm volatile("" ::: "memory");
        f32x16_t QS[2];
#pragma unroll
        for (int rt = 0; rt < 2; ++rt)
#pragma unroll
            for (int r = 0; r < 16; ++r) QS[rt][r] = 0.f;
#pragma unroll
        for (int nt = 0; nt < 4; ++nt) {
            const bf16x8_t sb0 = acc_frag<0>(S[nt]), sb1 = acc_frag<1>(S[nt]);
#pragma unroll
            for (int rt = 0; rt < 2; ++rt) {
                const int ro = bo + O_Q + ((4 * nt) * 64 + 32 * rt + r32) * 16 + 8 * hi;
                QS[rt] = __builtin_amdgcn_mfma_f32_32x32x16_bf16(LFRAG(ro), sb0, QS[rt], 0, 0, 0); QS[rt] = __builtin_amdgcn_mfma_f32_32x32x16_bf16(LFRAG(ro + 2048), sb1, QS[rt], 0, 0, 0);
            }
        }
        asm volatile("" ::: "memory");
        {
            const bf16x8_t vb00 = acc_frag<0>(vn[0]), vb01 = acc_frag<1>(vn[0]), vb10 = acc_frag<0>(vn[1]), vb11 = acc_frag<1>(vn[1]);
            const int a0 = bo + O_A + r32 * 16 + 8 * hi, a1 = a0 + 512;
            f32x16_t o0, o1;
#pragma unroll
            for (int r = 0; r < 16; ++r) { const int il = (r & 3) + 8 * (r >> 2) + 4 * hi; o0[r] = Es[il] * QS[0][r]; o1[r] = Es[32 + il] * QS[1][r]; }
            o0 = __builtin_amdgcn_mfma_f32_32x32x16_bf16(LFRAG(a0), vb00, o0, 0, 0, 0); o0 = __builtin_amdgcn_mfma_f32_32x32x16_bf16(LFRAG(a0 + 2048), vb01, o0, 0, 0, 0);
            o1 = __builtin_amdgcn_mfma_f32_32x32x16_bf16(LFRAG(a1), vb00, o1, 0, 0, 0); o1 = __builtin_amdgcn_mfma_f32_32x32x16_bf16(LFRAG(a1 + 2048), vb01, o1, 0, 0, 0);
            o1 = __builtin_amdgcn_mfma_f32_32x32x16_bf16(LFRAG(a1 + 4096), vb10, o1, 0, 0, 0); o1 = __builtin_amdgcn_mfma_f32_32x32x16_bf16(LFRAG(a1 + 6144), vb11, o1, 0, 0, 0);
#pragma unroll
            for (int r = 0; r < 16; ++r) { const int il = (r & 3) + 8 * (r >> 2) + 4 * hi; ot[il * 33 + r32] = o0[r]; ot[(32 + il) * 33 + r32] = o1[r]; }
            LDS_WAIT();
            { const int t = dir ? SEQ - 1 - (64 * c + lane) : 64 * c + lane; float* orow = O + ((size_t)b * SEQ + t) * 1024 + hv * 128 + dvs * 32;
#pragma unroll
              for (int x = 0; x < 8; ++x) *(f32x4*)(orow + 4 * x) = (f32x4){ot[lane * 33 + 4 * x], ot[lane * 33 + 4 * x + 1], ot[lane * 33 + 4 * x + 2], ot[lane * 33 + 4 * x + 3]}; }
        }
        asm volatile("" ::: "memory");
        {
#pragma unroll
            for (int r = 0; r < 16; ++r) { const int il = (r & 3) + 8 * (r >> 2) + 4 * hi; vn[0][r] *= Ws[il]; vn[1][r] *= Ws[32 + il]; }
            const bf16x8_t wb[4] = {acc_frag<0>(vn[0]), acc_frag<1>(vn[0]), acc_frag<0>(vn[1]), acc_frag<1>(vn[1])};
            const float eGL = __expf(GL);
#pragma unroll
            for (int nt = 0; nt < 4; ++nt) {
#pragma unroll
                for (int r = 0; r < 16; ++r) S[nt][r] *= eGL;
#pragma unroll
                for (int ks = 0; ks < 4; ++ks) {
                    const int ro = bo + O_K + ((4 * nt + 2 * trc + (trp >> 1)) * 64 + 16 * ks + 4 * hi + trq) * 16 + 8 * (trp & 1);
                    const s16x4_t lo = __builtin_bit_cast(s16x4_t, __builtin_amdgcn_ds_read_tr16_b64_v4i16((LAS s16x4_t*)(ldl + ro)));
                    const s16x4_t hi4 = __builtin_bit_cast(s16x4_t, __builtin_amdgcn_ds_read_tr16_b64_v4i16((LAS s16x4_t*)(ldl + ro + 8 * 16)));
                    const bf16x8_t kf = (bf16x8_t){lo[0], lo[1], lo[2], lo[3], hi4[0], hi4[1], hi4[2], hi4[3]};
                    S[nt] = __builtin_amdgcn_mfma_f32_32x32x16_bf16(kf, wb[ks], S[nt], 0, 0, 0);
                }
            }
        }
        LDS_WAIT();
    }
#undef LFRAG
#undef G2_DMA
}

__device__ __forceinline__ void ssd2_item(const Args& a, int item, unsigned char* lds) {
    const int ps = item & 1, h = (item >> 1) & 15, dir = (item >> 5) & 1, b = item >> 6, g = h >> 3;
    const int lane0 = threadIdx.x & 63;
    constexpr int BUFB = 40960, O_B = 0, O_C = 16384, O_X = 32768, O_XD = 2 * BUFB + 512, O_XW = O_XD + 64 * 72;
    float* Gs = (float*)(lds + 2 * BUFB); float* Es = Gs + 64; float* ot = (float*)(lds + O_XW + 64 * 72);
    const LAS unsigned char* ldl = (const LAS unsigned char*)lds;
    const bf16_t* XB = (const bf16_t*)(a.ws + WS_XBC16); const float* ACT = (const float*)(a.ws + WS_ACT); const float* SM = (const float*)(a.ws + WS_SMALL);
    float* Y = (float*)(a.ws + (dir ? WS_YB : WS_YF));
    const float A = -expf(a.in[dir ? 13 : 12][h]); const float dtb = a.in[dir ? 11 : 10][h];
    f32x16_t H[4];
#pragma unroll
    for (int nt = 0; nt < 4; ++nt)
#pragma unroll
        for (int r = 0; r < 16; ++r) H[nt][r] = 0.f;
    float gdr;
#define S2_DMA(c_, buf_) do { const int t_ = dir ? SEQ - 1 - (64 * (c_) + lane0) : 64 * (c_) + lane0; const size_t mi_ = (size_t)b * SEQ + t_; \
        const bf16_t* br_ = XB + mi_ * 1536 + 1024 + g * 128; const bf16_t* cr_ = XB + mi_ * 1536 + 1280 + g * 128; const float* xr_ = ACT + mi_ * 1536 + h * 64 + ps * 32; \
        LAS unsigned char* lb_ = (LAS unsigned char*)lds + (buf_) * BUFB; \
        _Pragma("unroll") for (int x = 0; x < 16; ++x) { __builtin_amdgcn_global_load_lds((const unsigned*)(br_ + 8 * x), (LAS unsigned*)(lb_ + O_B + 1024 * x), 16, 0, 0); \
                                                         __builtin_amdgcn_global_load_lds((const unsigned*)(cr_ + 8 * x), (LAS unsigned*)(lb_ + O_C + 1024 * x), 16, 0, 0); } \
        _Pragma("unroll") for (int x = 0; x < 8; ++x) __builtin_amdgcn_global_load_lds((const unsigned*)(xr_ + 4 * x), (LAS unsigned*)(lb_ + O_X + 1024 * x), 16, 0, 0); \
        gdr = SM[mi_ * 32 + dir * 16 + h]; } while (0)
    S2_DMA(0, 0);
    for (int c = 0; c < 32; ++c) {
        int lane = lane0; asm volatile("" : "+v"(lane));
        const int r32 = lane & 31, hi = lane >> 5, trq = (lane & 15) >> 2, trp = lane & 3, trc = (lane >> 4) & 1;
        const int bo = (c & 1) * BUFB;
        const float dt = softplus_f(gdr + dtb);
        const float cs = wave_incl_scan(dt * A, lane); const float csL = __shfl(cs, 63);
        Gs[lane] = cs; Es[lane] = __expf(cs);
        asm volatile("s_waitcnt vmcnt(0)" ::: "memory");
        if (c + 1 < 32) S2_DMA(c + 1, (c + 1) & 1);
        {
            const float wsc = dt * __expf(csL - cs);
#pragma unroll
            for (int x = 0; x < 8; ++x) { const f32x4 xv = *(const LAS f32x4*)(ldl + bo + O_X + (x * 64 + lane) * 16);
                v2u d; d.x = cvtpk_rne(xv.x * dt, xv.y * dt); d.y = cvtpk_rne(xv.z * dt, xv.w * dt); *(LAS v2u*)((LAS unsigned char*)lds + O_XD + lane * 72 + 8 * x) = d;
                v2u w; w.x = cvtpk_rne(xv.x * wsc, xv.y * wsc); w.y = cvtpk_rne(xv.z * wsc, xv.w * wsc); *(LAS v2u*)((LAS unsigned char*)lds + O_XW + lane * 72 + 8 * x) = w; }
        }
        LDS_WAIT();
        f32x16_t g00, g01, g11;
#pragma unroll
        for (int r = 0; r < 16; ++r) { g00[r] = 0.f; g01[r] = 0.f; g11[r] = 0.f; }
#pragma unroll
        for (int kk = 0; kk < 8; ++kk) { const int fo = ((2 * kk + hi) * 64 + r32) * 16;
            const bf16x8_t A0 = *(const LAS bf16x8_t*)(ldl + bo + O_B + fo), A1 = *(const LAS bf16x8_t*)(ldl + bo + O_B + fo + 512);
            const bf16x8_t B0 = *(const LAS bf16x8_t*)(ldl + bo + O_C + fo), B1 = *(const LAS bf16x8_t*)(ldl + bo + O_C + fo + 512);
            g00 = __builtin_amdgcn_mfma_f32_32x32x16_bf16(A0, B0, g00, 0, 0, 0); g01 = __builtin_amdgcn_mfma_f32_32x32x16_bf16(A0, B1, g01, 0, 0, 0); g11 = __builtin_amdgcn_mfma_f32_32x32x16_bf16(A1, B1, g11, 0, 0, 0); }
        {   const float cst0 = Gs[r32], cst1 = Gs[32 + r32];
#pragma unroll
            for (int r = 0; r < 16; ++r) { const int il = (r & 3) + 8 * (r >> 2) + 4 * hi; const float css0 = Gs[il], css1 = Gs[32 + il];
                g00[r] = (il <= r32) ? g00[r] * __expf(cst0 - css0) : 0.f; g01[r] = g01[r] * __expf(cst1 - css0); g11[r] = (il <= r32) ? g11[r] * __expf(cst1 - css1) : 0.f; } }
        asm volatile("" ::: "memory");
        f32x16_t y0, y1;
#pragma unroll
        for (int r = 0; r < 16; ++r) { y0[r] = 0.f; y1[r] = 0.f; }
#define TRFRAG(base_) ({ const s16x4_t lo_ = __builtin_bit_cast(s16x4_t, __builtin_amdgcn_ds_read_tr16_b64_v4i16((LAS s16x4_t*)(ldl + (base_)))); \
                         const s16x4_t hi_ = __builtin_bit_cast(s16x4_t, __builtin_amdgcn_ds_read_tr16_b64_v4i16((LAS s16x4_t*)(ldl + (base_) + 8 * 72))); \
                         (bf16x8_t){lo_[0], lo_[1], lo_[2], lo_[3], hi_[0], hi_[1], hi_[2], hi_[3]}; })
        {   const int xo = O_XD + (4 * hi + trq) * 72 + (16 * trc + 4 * trp) * 2;
            const bf16x8_t x0 = TRFRAG(xo), x1 = TRFRAG(xo + 16 * 72), x2 = TRFRAG(xo + 32 * 72), x3 = TRFRAG(xo + 48 * 72);
            y0 = __builtin_amdgcn_mfma_f32_32x32x16_bf16(acc_frag<0>(g00), x0, y0, 0, 0, 0); y0 = __builtin_amdgcn_mfma_f32_32x32x16_bf16(acc_frag<1>(g00), x1, y0, 0, 0, 0);
            y1 = __builtin_amdgcn_mfma_f32_32x32x16_bf16(acc_frag<0>(g01), x0, y1, 0, 0, 0); y1 = __builtin_amdgcn_mfma_f32_32x32x16_bf16(acc_frag<1>(g01), x1, y1, 0, 0, 0);
            y1 = __builtin_amdgcn_mfma_f32_32x32x16_bf16(acc_frag<0>(g11), x2, y1, 0, 0, 0); y1 = __builtin_amdgcn_mfma_f32_32x32x16_bf16(acc_frag<1>(g11), x3, y1, 0, 0, 0); }
        asm volatile("" ::: "memory");
        {   f32x16_t Z0, Z1;
#pragma unroll
            for (int r = 0; r < 16; ++r) { Z0[r] = 0.f; Z1[r] = 0.f; }
#define LFRAG(off_) join44(*(const LAS v2u*)(ldl + (off_)), *(const LAS v2u*)(ldl + (off_) + 1024))
#pragma unroll
            for (int nt = 0; nt < 4; ++nt) { const bf16x8_t hb0 = acc_frag<0>(H[nt]), hb1 = acc_frag<1>(H[nt]);
                const int ro = bo + O_C + ((4 * nt) * 64 + r32) * 16 + 8 * hi;
                Z0 = __builtin_amdgcn_mfma_f32_32x32x16_bf16(LFRAG(ro), hb0, Z0, 0, 0, 0); Z0 = __builtin_amdgcn_mfma_f32_32x32x16_bf16(LFRAG(ro + 2048), hb1, Z0, 0, 0, 0);
                Z1 = __builtin_amdgcn_mfma_f32_32x32x16_bf16(LFRAG(ro + 512), hb0, Z1, 0, 0, 0); Z1 = __builtin_amdgcn_mfma_f32_32x32x16_bf16(LFRAG(ro + 512 + 2048), hb1, Z1, 0, 0, 0); }
#undef LFRAG
#pragma unroll
            for (int r = 0; r < 16; ++r) { const int il = (r & 3) + 8 * (r >> 2) + 4 * hi; ot[il * 33 + r32] = fmaf(Es[il], Z0[r], y0[r]); ot[(32 + il) * 33 + r32] = fmaf(Es[32 + il], Z1[r], y1[r]); } }
        LDS_WAIT();
        { const int t = dir ? SEQ - 1 - (64 * c + lane) : 64 * c + lane; float* yrow = Y + ((size_t)b * SEQ + t) * 1024 + h * 64 + ps * 32;
#pragma unroll
          for (int x = 0; x < 8; ++x) *(f32x4*)(yrow + 4 * x) = (f32x4){ot[lane * 33 + 4 * x], ot[lane * 33 + 4 * x + 1], ot[lane * 33 + 4 * x + 2], ot[lane * 33 + 4 * x + 3]}; }
        asm volatile("" ::: "memory");
        {   const float eL = __expf(csL);
            const int xo = O_XW + (4 * hi + trq) * 72 + (16 * trc + 4 * trp) * 2;
            const bf16x8_t w0 = TRFRAG(xo), w1 = TRFRAG(xo + 16 * 72), w2 = TRFRAG(xo + 32 * 72), w3 = TRFRAG(xo + 48 * 72);
#undef TRFRAG
#pragma unroll
            for (int nt = 0; nt < 4; ++nt) {
#pragma unroll
                for (int r = 0; r < 16; ++r) H[nt][r] *= eL;
#pragma unroll
                for (int ks = 0; ks < 4; ++ks) {
                    const int ro = bo + O_B + ((4 * nt + 2 * trc + (trp >> 1)) * 64 + 16 * ks + 4 * hi + trq) * 16 + 8 * (trp & 1);
                    const s16x4_t lo = __builtin_bit_cast(s16x4_t, __builtin_amdgcn_ds_read_tr16_b64_v4i16((LAS s16x4_t*)(ldl + ro)));
                    const s16x4_t hi4 = __builtin_bit_cast(s16x4_t, __builtin_amdgcn_ds_read_tr16_b64_v4i16((LAS s16x4_t*)(ldl + ro + 8 * 16)));
                    const bf16x8_t bfr = (bf16x8_t){lo[0], lo[1], lo[2], lo[3], hi4[0], hi4[1], hi4[2], hi4[3]};
                    H[nt] = __builtin_amdgcn_mfma_f32_32x32x16_bf16(bfr, ks == 0 ? w0 : ks == 1 ? w1 : ks == 2 ? w2 : w3, H[nt], 0, 0, 0);
                }
            }
        }
        LDS_WAIT();
    }
#undef S2_DMA
}

__device__ __forceinline__ void lru_tile(const Args& a, int item, unsigned char* lds, int pass) {
    const int n = item & 7, tc = (item >> 3) & 63, b = item >> 9, t0 = tc * 32;
    float* xc = (float*)lds; bf16_t* xcb = (bf16_t*)(lds + 16384); float* As = (float*)(lds + 25088); float* Us = As + 2 * 32 * 128; float2* sg = (float2*)(Us + 2 * 32 * 128);
    const int tid = threadIdx.x, lane = tid & 63, wave = tid >> 6;
    const bf16_t* P = (const bf16_t*)(a.ws + WS_PROJ);
    __syncthreads();
    {
        const int j = tid & 127, tg = tid >> 7, chn = n * 128 + j; const float* cw = a.in[25];
        const float w0 = cw[chn], w1 = cw[1024 + chn], w2 = cw[2048 + chn], w3 = cw[3072 + chn], cbias = a.in[26][chn];
        const int tb = t0 + tg * 8;
        const bf16_t* pp = P + ((size_t)b * SEQ + tb) * NINP + C_XL + chn;
        float xm2 = (tb >= 2) ? bf2f(pp[-2 * NINP]) : 0.f, xm1 = (tb >= 1) ? bf2f(pp[-NINP]) : 0.f, x0 = bf2f(pp[0]);
#pragma unroll
        for (int i = 0; i < 8; ++i) { const float xp1 = (tb + i + 1 < SEQ) ? bf2f(pp[(i + 1) * NINP]) : 0.f;
            const float acc = cbias + w0 * xm2 + w1 * xm1 + w2 * x0 + w3 * xp1;
            xc[(tg * 8 + i) * 128 + j] = acc; xcb[(tg * 8 + i) * 136 + j] = (bf16_t)f2bf(acc);
            xm2 = xm1; xm1 = x0; x0 = xp1; }
    }
    __syncthreads();
    {
        const int ct = wave & 3, d = wave >> 2, r32 = lane & 31, hi = lane >> 5;
        const bf16_t* WT = (const bf16_t*)(a.ws + WS_WGT);
        const bf16_t* wa_p = WT + ((size_t)((2 * d) * 8 + n) * 128 + ct * 32 + r32) * 128 + hi * 8;
        const bf16_t* wx_p = WT + ((size_t)((2 * d + 1) * 8 + n) * 128 + ct * 32 + r32) * 128 + hi * 8;
        f32x16_t ca, cx;
#pragma unroll
        for (int r = 0; r < 16; ++r) { ca[r] = 0.f; cx[r] = 0.f; }
#pragma unroll
        for (int s = 0; s < 8; ++s) {
            const bf16x8_t af = *(const bf16x8_t*)((const char*)xcb + r32 * 272 + (s * 16 + hi * 8) * 2);
            const bf16x8_t fa = *(const bf16x8_t*)(wa_p + s * 16); const bf16x8_t fx = *(const bf16x8_t*)(wx_p + s * 16);
            ca = __builtin_amdgcn_mfma_f32_32x32x16_bf16(af, fa, ca, 0, 0, 0); cx = __builtin_amdgcn_mfma_f32_32x32x16_bf16(af, fx, cx, 0, 0, 0);
        }
        const int j = ct * 32 + r32, cj = n * 128 + j;
        const float baj = a.in[d ? 33 : 28][cj], bxj = a.in[d ? 35 : 30][cj], sp = softplus_f(-a.in[d ? 36 : 31][cj]);
#pragma unroll
        for (int r = 0; r < 16; ++r) { const int t = (r & 3) + 8 * (r >> 2) + 4 * hi;
            const float rg = __builtin_amdgcn_rcpf(1.f + __expf(-(ca[r] + baj))), ig = __builtin_amdgcn_rcpf(1.f + __expf(-(cx[r] + bxj))); const float la = -8.f * rg * sp;
            const float av = __expf(la);
            const float om = (la > -0.0625f) ? -2.f * la * (1.f + la * (1.f + la * (0.6666667f + 0.3333333f * la))) : (1.f - av) * (1.f + av);
            As[(d * 32 + t) * 128 + j] = av; Us[(d * 32 + t) * 128 + j] = __builtin_amdgcn_sqrtf(om) * (ig * xc[t * 128 + j]); }
    }
    __syncthreads();
    {
        const int j = tid & 127, d = (tid >> 7) & 1, seg = tid >> 8;
        float Pp = 1.f, H = 0.f;
#pragma unroll
        for (int k = 0; k < 16; ++k) { const int q = seg * 16 + k, t = d ? 31 - q : q; const float a_ = As[(d * 32 + t) * 128 + j], u_ = Us[(d * 32 + t) * 128 + j]; H = fmaf(a_, H, u_); Pp *= a_; }
        sg[(d * 2 + seg) * 128 + j] = make_float2(Pp, H);
        __syncthreads();
        float2* LS = (float2*)(a.ws + WS_LSUM);
        if (pass == 0) {
            if (seg == 0) { const float2 s1 = sg[(d * 2 + 1) * 128 + j]; LS[((size_t)(d * 4 + b) * 64 + tc) * 1024 + n * 128 + j] = make_float2(Pp * s1.x, fmaf(s1.x, H, s1.y)); }
        } else {
            float c = 0.f;
            const float2* lsp = LS + ((size_t)(d * 4 + b) * 64) * 1024 + n * 128 + j;
#pragma unroll 1
            for (int c0 = 0; c0 < 64; c0 += 16) { float2 sv[16];
#pragma unroll
                for (int i = 0; i < 16; ++i) { const int cc = d ? 63 - (c0 + i) : c0 + i; sv[i] = lsp[(size_t)cc * 1024]; }
#pragma unroll
                for (int i = 0; i < 16; ++i) { const int cc = d ? 63 - (c0 + i) : c0 + i; const bool before = d ? (cc > tc) : (cc < tc); if (before) c = fmaf(sv[i].x, c, sv[i].y); } }
            if (seg == 1) { const float2 s0 = sg[(d * 2) * 128 + j]; c = fmaf(s0.x, c, s0.y); }
            float h = c;
#pragma unroll
            for (int k = 0; k < 16; ++k) { const int q = seg * 16 + k, t = d ? 31 - q : q; const float a_ = As[(d * 32 + t) * 128 + j], u_ = Us[(d * 32 + t) * 128 + j]; h = fmaf(a_, h, u_); Us[(d * 32 + t) * 128 + j] = h; }
            __syncthreads();
            bf16_t* YC = (bf16_t*)(a.ws + WS_YCAT);
            const int jj = tid & 127, tg = tid >> 7;
#pragma unroll
            for (int i = 0; i < 8; ++i) { const int t = tg * 8 + i; const size_t row = (size_t)b * SEQ + t0 + t;
                const float hs = Us[t * 128 + jj] + Us[(32 + t) * 128 + jj]; const float gl = bf2f(P[row * NINP + C_GL + n * 128 + jj]);
                YC[row * 2048 + 1024 + n * 128 + jj] = (bf16_t)f2bf(hs * silu_f(gl)); }
        }
    }
}

__device__ __forceinline__ void lru_sum_wave(const Args& a, int witem, unsigned char* ldsw, int lane) {
    asm volatile("" : "+v"(lane));
    const int n = witem & 7, tc = (witem >> 3) & 63, b = witem >> 9, t0 = tc * 32;
    const int r32 = lane & 31, hi = lane >> 5;
    bf16_t* xcb = (bf16_t*)ldsw;
    const bf16_t* P = (const bf16_t*)(a.ws + WS_PROJ);
    {
        const int chn = n * 128 + 2 * lane; const float* cw = a.in[25];
        const f32x2 w0 = *(const f32x2*)(cw + chn), w1 = *(const f32x2*)(cw + 1024 + chn), w2 = *(const f32x2*)(cw + 2048 + chn), w3 = *(const f32x2*)(cw + 3072 + chn), cb2 = *(const f32x2*)(a.in[26] + chn);
        const bf16_t* pp = P + ((size_t)b * SEQ + t0) * NINP + C_XL + chn;
        f32x2 xm2 = {0.f, 0.f}, xm1 = {0.f, 0.f}, x0;
        if (t0 >= 2) { const unsigned v = *(const unsigned*)(pp - 2 * NINP); xm2 = (f32x2){bf2f(v & 0xffffu), __uint_as_float(v & 0xffff0000u)}; }
        if (t0 >= 1) { const unsigned v = *(const unsigned*)(pp - NINP); xm1 = (f32x2){bf2f(v & 0xffffu), __uint_as_float(v & 0xffff0000u)}; }
        { const unsigned v = *(const unsigned*)pp; x0 = (f32x2){bf2f(v & 0xffffu), __uint_as_float(v & 0xffff0000u)}; }
#pragma unroll 8
        for (int i = 0; i < 32; ++i) { f32x2 xp1 = {0.f, 0.f};
            if (t0 + i + 1 < SEQ) { const unsigned v = *(const unsigned*)(pp + (size_t)(i + 1) * NINP); xp1 = (f32x2){bf2f(v & 0xffffu), __uint_as_float(v & 0xffff0000u)}; }
            const f32x2 acc = cb2 + w0 * xm2 + w1 * xm1 + w2 * x0 + w3 * xp1;
            *(unsigned*)(xcb + i * 136 + 2 * lane) = pk2(acc.x, acc.y);
            xm2 = xm1; xm1 = x0; x0 = xp1; }
    }
    LDS_WAIT();
    const bf16_t* WT = (const bf16_t*)(a.ws + WS_WGT);
    float2* LS = (float2*)(a.ws + WS_LSUM);
#pragma unroll 1
    for (int ct = 0; ct < 4; ++ct) {
    const int j = ct * 32 + r32, cj = n * 128 + j;
#pragma unroll
    for (int d = 0; d < 2; ++d) {
        const bf16_t* wa_p = WT + ((size_t)((2 * d) * 8 + n) * 128 + j) * 128 + hi * 8;
        const bf16_t* wx_p = WT + ((size_t)((2 * d + 1) * 8 + n) * 128 + j) * 128 + hi * 8;
        f32x16_t ca, cx;
#pragma unroll
        for (int r = 0; r < 16; ++r) { ca[r] = 0.f; cx[r] = 0.f; }
#pragma unroll
        for (int s = 0; s < 8; ++s) {
            const bf16x8_t af = *(const bf16x8_t*)((const char*)xcb + r32 * 272 + (s * 16 + hi * 8) * 2);
            const bf16x8_t fa = *(const bf16x8_t*)(wa_p + s * 16); const bf16x8_t fx = *(const bf16x8_t*)(wx_p + s * 16);
            ca = __builtin_amdgcn_mfma_f32_32x32x16_bf16(af, fa, ca, 0, 0, 0); cx = __builtin_amdgcn_mfma_f32_32x32x16_bf16(af, fx, cx, 0, 0, 0);
        }
        const float baj = a.in[d ? 33 : 28][cj], bxj = a.in[d ? 35 : 30][cj], sp = softplus_f(-a.in[d ? 36 : 31][cj]);
        float Pg[4], Hg[4];
#pragma unroll
        for (int sg = 0; sg < 4; ++sg) { float Pp = 1.f, Hh = 0.f;
#pragma unroll
            for (int e4 = 0; e4 < 4; ++e4) { const int e = d ? 3 - e4 : e4; const int r = 4 * sg + e; const int t = (r & 3) + 8 * (r >> 2) + 4 * hi;
                const float rg = __builtin_amdgcn_rcpf(1.f + __expf(-(ca[r] + baj))), ig = __builtin_amdgcn_rcpf(1.f + __expf(-(cx[r] + bxj))); const float la = -8.f * rg * sp;
                const float av = __expf(la);
                const float om = (la > -0.0625f) ? -2.f * la * (1.f + la * (1.f + la * (0.6666667f + 0.3333333f * la))) : (1.f - av) * (1.f + av);
                const float uv = __builtin_amdgcn_sqrtf(om) * (ig * bf2f(xcb[t * 136 + j]));
                Hh = fmaf(av, Hh, uv); Pp *= av; }
            Pg[sg] = Pp; Hg[sg] = Hh; }
        float Po[4], Ho[4];
#pragma unroll
        for (int sg = 0; sg < 4; ++sg) { Po[sg] = __shfl_xor(Pg[sg], 32); Ho[sg] = __shfl_xor(Hg[sg], 32); }
        float Ac = 1.f, Hc = 0.f;
#pragma unroll
        for (int qq = 0; qq < 8; ++qq) { const int q = d ? 7 - qq : qq;
            const bool mine = ((q & 1) == hi); const float pq = mine ? Pg[q >> 1] : Po[q >> 1], hq_ = mine ? Hg[q >> 1] : Ho[q >> 1];
            Hc = fmaf(pq, Hc, hq_); Ac *= pq; }
        if (hi == 0) LS[((size_t)(d * 4 + b) * 64 + tc) * 1024 + cj] = make_float2(Ac, Hc);
    }
    }
    LDS_WAIT();
}

__device__ __forceinline__ void combine1_phase(const Args& a, int gw, int NGW, int lane) {
    const float* OF = (const float*)(a.ws + WS_YF); const float* OB = (const float*)(a.ws + WS_YB);
    const bf16_t* P = (const bf16_t*)(a.ws + WS_PROJ); bf16_t* YC = (bf16_t*)(a.ws + WS_YCAT);
    const float* gn = a.in[24];
    for (int m = gw; m < MTOK; m += NGW) {
        const int ch = lane * 16, d0 = ch & 127;
        float z[16], ov[16];
        unpack8(*(const v4u*)(P + (size_t)m * NINP + C_Z + ch), z); unpack8(*(const v4u*)(P + (size_t)m * NINP + C_Z + ch + 8), z + 8);
#pragma unroll
        for (int q = 0; q < 4; ++q) { const f32x4 f = *(const f32x4*)(OF + (size_t)m * 1024 + ch + 4 * q), bk = *(const f32x4*)(OB + (size_t)m * 1024 + ch + 4 * q); const f32x4 o = f + bk;
            ov[4 * q] = o.x; ov[4 * q + 1] = o.y; ov[4 * q + 2] = o.z; ov[4 * q + 3] = o.w; }
        float ss = 0.f;
#pragma unroll
        for (int i = 0; i < 16; ++i) ss += ov[i] * ov[i];
        ss = group_sum<8>(ss);
        const float r = rsqrtf(ss * (1.f / 128.f) + EPS);
#pragma unroll
        for (int i = 0; i < 16; ++i) ov[i] = ov[i] * r * gn[d0 + i] * silu_f(z[i]);
        *(v4u*)(YC + (size_t)m * 2048 + ch) = pack8(ov); *(v4u*)(YC + (size_t)m * 2048 + ch + 8) = pack8(ov + 8);
    }
}

__device__ __forceinline__ void final_norm_phase(const Args& a, int gw, int NGW, int lane) {
    const float* nw = a.in[38];
    for (int m = gw; m < MTOK; m += NGW) {
        f32x4* xr = (f32x4*)(a.out + (size_t)m * 2048) + lane;
        f32x4 v[8]; float s = 0.f;
#pragma unroll
        for (int j = 0; j < 8; ++j) { v[j] = xr[64 * j]; s += (v[j].x * v[j].x + v[j].y * v[j].y) + (v[j].z * v[j].z + v[j].w * v[j].w); }
        const float rstd = rsqrtf(group_sum<64>(s) * (1.f / 2048.f) + EPS);
#pragma unroll
        for (int j = 0; j < 8; ++j) { const f32x4 w = *(const f32x4*)(nw + (64 * j + lane) * 4); xr[64 * j] = v[j] * rstd * w; }
    }
}

typedef GAS unsigned gu32;
#define RLX_AGENT __ATOMIC_RELAXED, __HIP_MEMORY_SCOPE_AGENT
constexpr int CW_BAR = 4096;
constexpr int MISC_OFF = 147456 - 128;
#define XB_TMO      128
#define XB_XCNT(j)  (256  + 64 * (j))
#define XB_XSUB(j)  (1280 + 64 * (j))
#define XB_XGEN(j)  (2304 + 64 * (j))
#define XB_TOP      3328
#define XB_TOPGEN   3392
#define XCD_BAR_WORDS 3456
#define XB_SPIN_CAP (1u << 18)

__device__ __forceinline__ unsigned xb_ld(unsigned* p)              { return __hip_atomic_load(p, __ATOMIC_RELAXED, __HIP_MEMORY_SCOPE_AGENT); }
__device__ __forceinline__ unsigned xb_add(unsigned* p, unsigned v) { return __hip_atomic_fetch_add(p, v, __ATOMIC_RELAXED, __HIP_MEMORY_SCOPE_AGENT); }
__device__ __forceinline__ unsigned xb_xcc_id() { return (unsigned)__builtin_amdgcn_s_getreg((3 << 11) | 20) & 0xFu; }
#define XB_SPIN(cond, bar) do { unsigned _sp = 0; while (cond) { __builtin_amdgcn_s_sleep(1); \
    if ((++_sp & 255u) == 0u) { if (xb_ld(&(bar)[XB_TMO])) break; if (_sp > XB_SPIN_CAP) { atomicAdd(&(bar)[XB_TMO], 1u); break; } } } } while (0)

struct XcdBarrier {
    unsigned* bar; unsigned x;
    volatile LAS unsigned* st;
};

__device__ __forceinline__ XcdBarrier xcd_barrier_post(unsigned* bar, volatile LAS unsigned* st) {
    XcdBarrier b; b.bar = bar; b.x = xb_xcc_id(); b.st = st;
    if (threadIdx.x == 0) (void)xb_add(&bar[XB_XCNT(b.x)], 1u);
    return b;
}
__device__ __forceinline__ void xcd_barrier_complete(unsigned* bar, unsigned x, unsigned& nloc, unsigned& nx) {
    const unsigned G = gridDim.x * gridDim.y * gridDim.z;
    unsigned sum, cnt, mine, sp = 0u;
    for (;;) {
        sum = 0u; cnt = 0u; mine = 0u;
#pragma unroll
        for (unsigned j = 0; j < 16; ++j) { const unsigned c = xb_ld(&bar[XB_XCNT(j)]); sum += c; cnt += (c > 0u) ? 1u : 0u; mine = (j == x) ? c : mine; }
        if (sum == G) break;
        __builtin_amdgcn_s_sleep(1);
        if ((++sp & 255u) == 0u) { if (xb_ld(&bar[XB_TMO])) break; if (sp > XB_SPIN_CAP) { atomicAdd(&bar[XB_TMO], 1u); break; } }
    }
    nloc = mine > 0u ? mine : 1u; nx = cnt > 0u ? cnt : 1u;
}

__device__ __forceinline__ void xcd_barrier(const XcdBarrier& b) {
    asm volatile("s_waitcnt vmcnt(0)" ::: "memory");
    __syncthreads();
    if (threadIdx.x == 0) {
        unsigned* bar = b.bar;
        __builtin_amdgcn_s_waitcnt(0);
        unsigned nloc = b.st[0], nx = b.st[1];
        if (nloc == 0u) { xcd_barrier_complete(bar, b.x, nloc, nx); b.st[0] = nloc; b.st[1] = nx; }
        const unsigned old = xb_add(&bar[XB_XSUB(b.x)], 1u);
        const unsigned gen = old / nloc;
        if (old + 1u == (gen + 1u) * nloc) {
            __builtin_amdgcn_fence(__ATOMIC_RELEASE, "agent");
            asm volatile("s_waitcnt vmcnt(0)" ::: "memory");
            const unsigned og = xb_add(&bar[XB_TOP], 1u);
            const unsigned tg = og / nx;
            if (og + 1u == (tg + 1u) * nx) xb_add(&bar[XB_TOPGEN], 1u);
            else XB_SPIN(xb_ld(&bar[XB_TOPGEN]) == tg, bar);
            __builtin_amdgcn_fence(__ATOMIC_ACQUIRE, "agent");
            xb_add(&bar[XB_XGEN(b.x)], 1u);
            asm volatile("s_waitcnt vmcnt(0)" ::: "memory");
        } else {
            XB_SPIN(xb_ld(&bar[XB_XGEN(b.x)]) == gen, bar);
            __builtin_amdgcn_fence(__ATOMIC_ACQUIRE, "agent");
            asm volatile("s_waitcnt vmcnt(0)" ::: "memory");
        }
    }
    __syncthreads();
}

#ifndef PROBE_MASK
#define PROBE_MASK 0
#endif
#define REP(bit) for (int rep_ = 0; rep_ < 1 + ((PROBE_MASK >> (bit)) & 1); ++rep_)
#ifndef PROBE_SSD
#define PROBE_SSD 0
#endif
#ifndef PROBE_GDN
#define PROBE_GDN 0
#endif
#ifndef PROBE_LRU
#define PROBE_LRU 0
#endif
#ifndef MK_SINGLE
#define MK_SINGLE 1
#endif
__global__ void __launch_bounds__(NTHREADS, 2) mk_fwd(Args a) {
    extern __shared__ __attribute__((aligned(16))) unsigned char lds[];
    LAS unsigned char* ldsl = (LAS unsigned char*)lds;
    const int tid = threadIdx.x, lane = tid & 63, wave = __builtin_amdgcn_readfirstlane(tid >> 6);
    const int G = gridDim.x, bx = blockIdx.x;
    const int vcu = (G % 8 == 0) ? (bx % 8) * (G / 8) + bx / 8 : bx;
    const int gw = vcu * NWAVES + wave, NGW = G * NWAVES;
    unsigned char* ws = a.ws;
    volatile LAS unsigned* MISC = (volatile LAS unsigned*)(ldsl + MISC_OFF);
    if (tid < 32) MISC[tid] = 0u;
    __syncthreads();
    XcdBarrier bar; bar.bar = (unsigned*)(ws + WS_CTL) + CW_BAR; bar.x = 0; bar.st = nullptr;
    if (a.ph_hi - a.ph_lo > 1) bar = xcd_barrier_post((unsigned*)(ws + WS_CTL) + CW_BAR, MISC + 8);
#define IN(k) (a.ph_lo <= (k) && (k) < a.ph_hi)
#define SEAM(k) do { if (IN(k) && IN((k) + 1)) { xcd_barrier(bar); } } while (0)

    if (IN(0)) { p0_prologue(a, ldsl, vcu, G); } SEAM(0);
    if (IN(1)) { REP(0) normmod_phase(a, a.in[0], 0, gw, NGW, lane); } SEAM(1);
    if (IN(2)) {
        pg8::Gemm g{(const bf16_t*)(ws + WS_H), (const bf16_t*)(ws + WS_WIN0), MTOK, NINP, 2048}; pg8::StaticOrder S; S.init(MTOK, NINP, G, bx);
        pg8::EpiProj E{(bf16_t*)(ws + WS_PROJ), (float*)(ws + WS_SMALL), NINP, A_DT / 256};
        REP(1) { pg8::gemm_phase<pg8::EpiProj, pg8::StaticOrder, true, true>(ldsl, g, S, E); __syncthreads(); }
    } SEAM(2);
    if (IN(3)) { REP(0) post0_phase(a, gw, NGW, lane); } SEAM(3);
    if (IN(4)) {
        REP(3) for (int u = vcu; u < 256; u += G) { const int b = u >> 6, h = (u >> 3) & 7, qb = u & 7, kvh = h >> 2; const size_t row0 = (size_t)b * SEQ + qb * 256;
            att::attn_dense_body((const att::bf16*)(ws + WS_QB) + row0 * 1024 + h * 128, (const att::bf16*)(ws + WS_KB) + (size_t)b * SEQ * 256 + kvh * 128,
                                 (const att::bf16*)(ws + WS_VB) + (size_t)b * SEQ * 256 + kvh * 128, (bf16_t*)(ws + WS_YCAT) + row0 * 2048 + h * 128,
                                 (const bf16_t*)(ws + WS_PROJ) + row0 * NINP + A_GA + h * 128, SEQ, (char*)lds);
            __syncthreads(); }
        if (wave == 0) { for (int it = vcu; it < 256; it += G) ssd2_item(a, it, lds); }
        else if (wave <= 4) late_transposes(a, (LAS float*)(ldsl + 100096 + (wave - 1) * 8448), vcu * 4 + (wave - 1), G * 4, lane);
        __syncthreads();
    } SEAM(4);
    if (IN(5)) { REP(0) ssd_combine_phase(a, gw, NGW, lane); } SEAM(5);
    if (IN(6)) {
        pg8::Gemm g{(const bf16_t*)(ws + WS_YCAT), (const bf16_t*)(ws + WS_WOUT0), MTOK, 2048, 2048}; pg8::StaticOrder S; S.init(MTOK, 2048, G, bx);
        pg8::EpiResid E{a.in[0], a.out, (const float*)(ws + WS_MOD), a.in[3]};
        REP(2) { pg8::gemm_phase<pg8::EpiResid, pg8::StaticOrder, true, true>(ldsl, g, S, E); __syncthreads(); }
    } SEAM(6);
    if (IN(7)) { REP(0) normmod_phase(a, a.out, 1, gw, NGW, lane); } SEAM(7);
    if (IN(8)) {
        pg8::Gemm g{(const bf16_t*)(ws + WS_H), (const bf16_t*)(ws + WS_WIN1), MTOK, NINP, 2048}; pg8::StaticOrder S; S.init(MTOK, NINP, G, bx);
        pg8::EpiProj E{(bf16_t*)(ws + WS_PROJ), (float*)(ws + WS_SMALL), NINP, C_SM / 256};
        pg8::gemm_phase<pg8::EpiProj, pg8::StaticOrder, true, true>(ldsl, g, S, E);
    } SEAM(8);
    if (IN(9)) { REP(0) post1_phase(a, gw, NGW, lane); } SEAM(9);
    if (IN(10)) {
        REP(5) { for (int it = gw; it < 2048; it += NGW) gdn1_item(a, it, lds + wave * GDN_LDS_PER_WAVE, lane); __syncthreads(); }
    } SEAM(10);
    if (IN(11)) {
        if (wave == 0) { for (int it = vcu; it < 256; it += G) gdn2_item(a, it, lds); }
        else if (wave <= 2) { for (int wi = vcu * 2 + (wave - 1); wi < 2048; wi += G * 2) lru_sum_wave(a, wi, lds + 124160 + (wave - 1) * 8704, lane); }
        __syncthreads();
    } SEAM(11);
    if (IN(12)) { REP(0) combine1_phase(a, gw, NGW, lane); __syncthreads(); REP(4) { for (int it = bx; it < 2048; it += G) lru_tile(a, it, lds, 1); __syncthreads(); } } SEAM(12);
    if (IN(13)) {
        pg8::Gemm g{(const bf16_t*)(ws + WS_YCAT), (const bf16_t*)(ws + WS_WOUT1), MTOK, 2048, 2048}; pg8::StaticOrder S; S.init(MTOK, 2048, G, bx);
        pg8::EpiResid E{a.out, a.out, (const float*)(ws + WS_MOD) + 4 * 6144, a.in[3] + 6144};
        pg8::gemm_phase<pg8::EpiResid, pg8::StaticOrder, true, true>(ldsl, g, S, E);
    } SEAM(13);
    if (IN(14)) { final_norm_phase(a, gw, NGW, lane); }
#undef IN
#undef SEAM
}

extern "C" void kernel_launch(void* const* d_in, const int* in_sizes, int n_in, void* d_out, int out_size, void* d_ws, size_t ws_size, hipStream_t stream) {
    static int grid = 0;
    if (grid == 0) {
        if (n_in != 39 || out_size != MTOK * DM || ws_size < WS_END) { fprintf(stderr, "kernel_launch: unexpected problem (n_in %d, out %d, ws %zu < %zu)\n", n_in, out_size, ws_size, (size_t)WS_END); grid = -1; return; }
        int dev = 0, cus = 0, per_cu = 0;
        if (hipGetDevice(&dev) != hipSuccess || hipDeviceGetAttribute(&cus, hipDeviceAttributeMultiprocessorCount, dev) != hipSuccess) { grid = -1; return; }
        if (hipFuncSetAttribute((const void*)mk_fwd, hipFuncAttributeMaxDynamicSharedMemorySize, LDS_BYTES) != hipSuccess) { fprintf(stderr, "kernel_launch: hipFuncSetAttribute failed\n"); grid = -1; return; }
        if (hipOccupancyMaxActiveBlocksPerMultiprocessor(&per_cu, (const void*)mk_fwd, NTHREADS, LDS_BYTES) != hipSuccess || per_cu < 1) { fprintf(stderr, "kernel_launch: occupancy query says %d\n", per_cu); (void)hipGetLastError(); per_cu = 1; }
        grid = cus;
    }
    if (grid < 0) return;
    (void)hipMemsetAsync((char*)d_ws + WS_CTL, 0, CTL_ZERO_BYTES, stream);
    Args a{};
    for (int i = 0; i < 39; ++i) a.in[i] = (const float*)d_in[i];
    a.out = (float*)d_out; a.ws = (unsigned char*)d_ws;
#if MK_SINGLE
    a.ph_lo = 0; a.ph_hi = NPHASE;
    void* kargs[] = {&a};
    hipError_t e = hipLaunchCooperativeKernel((const void*)mk_fwd, dim3(grid), dim3(NTHREADS), kargs, LDS_BYTES, stream);
    if (e != hipSuccess) fprintf(stderr, "kernel_launch: cooperative launch failed: %s (grid %d)\n", hipGetErrorString(e), grid);
#else
    for (int p = 0; p < NPHASE; ++p) { a.ph_lo = p; a.ph_hi = p + 1; hipLaunchKernelGGL(mk_fwd, dim3(grid), dim3(NTHREADS), LDS_BYTES, stream, a); }
#endif
}
```

```cpp
#include <hip/hip_runtime.h>
#include <hip/hip_cooperative_groups.h>
#include <hip/hip_bf16.h>
#include <cstdio>
#include <cstdint>
namespace cg = cooperative_groups;

constexpr int BATCH = 4, SEQ = 2048, DM = 2048, MTOK = BATCH * SEQ;
constexpr int NIN = 5152, NINP = 5376;
constexpr float EPS = 1e-6f;
constexpr int A_Q = 0, A_K = 1024, A_V = 1280, A_GA = 1536, A_XS = 2560, A_BS = 3584, A_CS = 3840, A_DT = 4096, A_Z = 4128;
constexpr int C_Q = 0, C_K = 512, C_V = 1024, C_SM = 2048, C_Z = 2080, C_XL = 3104, C_GL = 4128;
namespace pg8 {
#define PG8_LAS __attribute__((address_space(3)))
typedef unsigned short bf16_t;
typedef short bf16x8 __attribute__((ext_vector_type(8)));
typedef float f32x4 __attribute__((ext_vector_type(4)));
typedef unsigned u32x4 __attribute__((ext_vector_type(4)));
constexpr int BM = 256, BK = 64, HALF = 128, HTB = HALF * BK * 2  , STAGE_BYTES = 8 * HTB, NXCD = 8, WGM = 8;

__host__ __device__ __forceinline__ int lds_byte(int r, int c) { const int st = (r >> 4) * 2 + (c >> 5), rr = r & 15, cc = c & 31, ob = rr * 64 + cc * 2; return st * 1024 + (ob ^ (((ob >> 9) & 1) << 5)); }
__host__ __device__ __forceinline__ void stage_rc(int b, int& R, int& C) { const int st = b / 1024, sb = b % 1024, swz = sb ^ (((sb >> 9) & 1) << 5); R = (st >> 1) * 16 + swz / 64; C = (st & 1) * 32 + (swz % 64) / 2; }
__host__ __device__ __forceinline__ int perm32(int rho) { const int n = rho >> 4, i = rho & 15; return 8 * (i >> 2) + 4 * n + (i & 3); }

struct Unit { int pm, pn; };
struct Gemm { const bf16_t* A; const bf16_t* Bt; int M, N, K; };

struct StaticOrder {
    int nM, nN, nwg, G, c;
    __host__ __device__ void init(int M, int N, int G_, int c_) { nM = M / BM; nN = N / BM; nwg = nM * nN; G = G_; c = c_; }
    __host__ __device__ bool next(int i, Unit& u) const {
        const long L = (long)i * G + c; if (L >= nwg) return false;
        int wgid = (int)L; { const int q = nwg / NXCD, r = nwg % NXCD, xcd = wgid % NXCD, off = wgid / NXCD; wgid = (xcd < r ? xcd * (q + 1) : r * (q + 1) + (xcd - r) * q) + off; }
        const int nig = WGM * nN, gid = wgid / nig, fm = gid * WGM, gsz = (nM - fm) < WGM ? (nM - fm) : WGM;
        u.pm = fm + ((wgid % nig) % gsz); u.pn = (wgid % nig) / gsz; return true;
    }
    __device__ __forceinline__ void a_ready(const Unit&) const {}
    __device__ __forceinline__ void done(const Unit&) const {}
};

__device__ __forceinline__ unsigned cvt_pk_bf16(float lo, float hi) { unsigned r; asm volatile("v_cvt_pk_bf16_f32 %0, %1, %2" : "=v"(r) : "v"(lo), "v"(hi)); return r; }
typedef float f32x2 __attribute__((ext_vector_type(2)));
struct EpiProj {
    static constexpr bool PERM = true, AFTER_DRAIN = false;
    bf16_t* O; float* small; int ldc; int small_tile;
    __device__ __forceinline__ void operator()(const f32x4 (&acc)[2][2][4][2], const Unit& u, int wr, int wc, int fr, int fq) const {
        const int row0 = u.pm * BM + wr * 64 + fr; const int col0 = u.pn * BM + wc * 32 + 8 * fq;
        const bool sm = (u.pn == small_tile) && (wc == 0);
#pragma unroll
        for (int ai = 0; ai < 2; ++ai)
#pragma unroll
            for (int m = 0; m < 4; ++m) { const int row = row0 + ai * HALF + m * 16; bf16_t* rowp = O + (size_t)row * ldc + col0;
#pragma unroll
                for (int bj = 0; bj < 2; ++bj) { const f32x4 v0 = acc[ai][bj][m][0], v1 = acc[ai][bj][m][1];
                    u32x4 w; w.x = cvt_pk_bf16(v0[0], v0[1]); w.y = cvt_pk_bf16(v0[2], v0[3]); w.z = cvt_pk_bf16(v1[0], v1[1]); w.w = cvt_pk_bf16(v1[2], v1[3]);
                    *(u32x4*)(rowp + bj * HALF) = w; }
                if (sm) { float* sp = small + (size_t)row * 32 + 8 * fq; *(f32x4*)sp = acc[ai][0][m][0]; *(f32x4*)(sp + 4) = acc[ai][0][m][1]; } }
    }
};
struct EpiResid {
    static constexpr bool PERM = false, AFTER_DRAIN = false;
    const float* xin; float* xout; const float* gacc; const float* gbias;
    __device__ __forceinline__ void operator()(const f32x4 (&acc)[2][2][4][2], const Unit& u, int wr, int wc, int fr, int fq) const {
        const int b = u.pm >> 3;
        const int col0 = u.pn * BM + wc * 32 + 4 * fq;
#pragma unroll
        for (int bj = 0; bj < 2; ++bj)
#pragma unroll
            for (int n = 0; n < 2; ++n) { const int col = col0 + bj * HALF + n * 16;
                const f32x4 g = *(const f32x4*)(gacc + (size_t)b * 6144 + 4096 + col) + *(const f32x4*)(gbias + 4096 + col);
#pragma unroll
                for (int ai = 0; ai < 2; ++ai)
#pragma unroll
                    for (int m = 0; m < 4; ++m) { const size_t off = (size_t)(u.pm * BM + ai * HALF + wr * 64 + m * 16 + fr) * 2048 + col;
                        const f32x4 xv = *(const f32x4*)(xin + off); *(f32x4*)(xout + off) = xv + g * acc[ai][bj][m][n]; } }
    }
};
template <class Epi, class Sched, bool ALIGN_EPI = false, bool SP2 = false>
__device__ __forceinline__ void gemm_phase(PG8_LAS unsigned char* lds, const Gemm g, const Sched& S, const Epi& E) {
    const int tid = threadIdx.x, wid = __builtin_amdgcn_readfirstlane(tid >> 6), lane = tid & 63, wr = wid >> 2, wc = wid & 3, fr = lane & 15, fq = lane >> 4;
    const int K = g.K, nt = K / BK;
    unsigned voffA[2], voffB[2];
#pragma unroll
    for (int i = 0; i < 2; ++i) { int R, C; stage_rc(tid * 16 + i * 8192, R, C); const int Rb = Epi::PERM ? ((R & ~31) + perm32(R & 31)) : R;
        voffA[i] = (unsigned)(R * K + C) * 2u; voffB[i] = (unsigned)(Rb * K + C) * 2u; }
    const size_t kstep = (size_t)(BK * 2);
    const size_t hstep = (size_t)HALF * K * 2;
    const size_t tstep = 2 * hstep;
    const unsigned ldsw = (unsigned)wid * 1024u;
    const int aoff = lds_byte(wr * 64 + fr, fq * 8), boff = lds_byte(wc * 32 + fr, fq * 8);
#define PG8_SA(b, h) (((b) * 2 + (h)) * HTB)
#define PG8_SB(b, h) ((4 + (b) * 2 + (h)) * HTB)
#define PG8_STAGE(bufoff, gbase, voff) do { _Pragma("unroll") for (int _i = 0; _i < 2; ++_i) \
        __builtin_amdgcn_global_load_lds((const unsigned*)((const char*)(gbase) + (voff)[_i]), (PG8_LAS unsigned*)(lds + (bufoff) + ldsw + _i * 8192), 16, 0, 0); } while (0)
#define PG8_LDA(dst, b, h) do { _Pragma("unroll") for (int m = 0; m < 4; ++m) _Pragma("unroll") for (int k = 0; k < 2; ++k) dst[m][k] = *(const PG8_LAS bf16x8*)(lds + PG8_SA(b, h) + aoff + m * 2048 + k * 1024); } while (0)
#define PG8_LDB(dst, b, h) do { _Pragma("unroll") for (int n = 0; n < 2; ++n) _Pragma("unroll") for (int k = 0; k < 2; ++k) dst[n][k] = *(const PG8_LAS bf16x8*)(lds + PG8_SB(b, h) + boff + n * 2048 + k * 1024); } while (0)
#define PG8_MMA(ai, bj, At, Bt) do { __builtin_amdgcn_s_setprio(1); _Pragma("unroll") for (int m = 0; m < 4; ++m) _Pragma("unroll") for (int n = 0; n < 2; ++n) _Pragma("unroll") for (int k = 0; k < 2; ++k) \
        acc[ai][bj][m][n] = __builtin_amdgcn_mfma_f32_16x16x32_bf16(Bt[n][k], At[m][k], acc[ai][bj][m][n], 0, 0, 0); __builtin_amdgcn_s_setprio(0); } while (0)
#define PG8_WAIT_V(n) asm volatile("s_waitcnt vmcnt(" #n ")" ::: "memory")
#define PG8_WAIT_L(n) asm volatile("s_waitcnt lgkmcnt(" #n ")" ::: "memory")
#define PG8_BAR __builtin_amdgcn_s_barrier()
#define PG8_SCHED __builtin_amdgcn_sched_barrier(0)
    Unit cur, nxt; int ui = 0;
    if (!S.next(0, cur)) return;
    f32x4 acc[2][2][4][2];
#pragma unroll
    for (int a = 0; a < 2; ++a)
#pragma unroll
        for (int b = 0; b < 2; ++b)
#pragma unroll
            for (int m = 0; m < 4; ++m)
#pragma unroll
                for (int n = 0; n < 2; ++n) acc[a][b][m][n] = (f32x4){0.f, 0.f, 0.f, 0.f};
    bf16x8 At[4][2], B0[2][2], B1[2][2];
    const char* cA = (const char*)g.A + (size_t)cur.pm * tstep; const char* cB = (const char*)g.Bt + (size_t)cur.pn * tstep;
    S.a_ready(cur);
    if constexpr (SP2) {
        PG8_STAGE(PG8_SB(0, 0), cB, voffB); PG8_STAGE(PG8_SB(0, 1), cB + hstep, voffB); PG8_STAGE(PG8_SA(0, 0), cA, voffA); PG8_STAGE(PG8_SA(0, 1), cA + hstep, voffA);
        if (wr == 1) PG8_BAR;
        PG8_WAIT_V(2); PG8_BAR;
        PG8_STAGE(PG8_SB(1, 0), cB + kstep, voffB); PG8_STAGE(PG8_SA(1, 0), cA + kstep, voffA); PG8_STAGE(PG8_SB(1, 1), cB + hstep + kstep, voffB);
        PG8_WAIT_V(6); PG8_BAR;
    } else {
        PG8_STAGE(PG8_SB(0, 0), cB, voffB); PG8_STAGE(PG8_SA(0, 0), cA, voffA); PG8_STAGE(PG8_SB(0, 1), cB + hstep, voffB); PG8_STAGE(PG8_SA(0, 1), cA + hstep, voffA);
        if (wr == 1) PG8_BAR;
        PG8_WAIT_V(4); PG8_BAR;
        PG8_STAGE(PG8_SB(1, 0), cB + kstep, voffB); PG8_STAGE(PG8_SA(1, 0), cA + kstep, voffA); PG8_STAGE(PG8_SB(1, 1), cB + hstep + kstep, voffB);
        PG8_WAIT_V(6); PG8_BAR;
    }
    for (;;) {
        const bool has_next = S.next(ui + 1, nxt);
        const char* nA = has_next ? (const char*)g.A + (size_t)nxt.pm * tstep : cA; const char* nB = has_next ? (const char*)g.Bt + (size_t)nxt.pn * tstep : cB;
        for (int t = 0; t < nt; t += 2) {
            const bool last = (t == nt - 2);
            const char* a1 = cA + (size_t)(t + 1) * kstep;
            const char* a2 = last ? nA : cA + (size_t)(t + 2) * kstep; const char* b2 = last ? nB : cB + (size_t)(t + 2) * kstep;
            const char* a3 = a2 + kstep; const char* b3 = b2 + kstep;
            if (last && has_next) S.a_ready(nxt);
            if constexpr (SP2) {
            PG8_LDB(B0, 0, 0); PG8_LDB(B1, 0, 1); PG8_SCHED; PG8_LDA(At, 0, 0); PG8_STAGE(PG8_SA(1, 1), a1 + hstep, voffA);
            PG8_WAIT_V(8); PG8_WAIT_L(0); PG8_BAR; PG8_MMA(0, 0, At, B0); PG8_MMA(0, 1, At, B1); PG8_BAR; PG8_SCHED;
            PG8_LDA(At, 0, 1); PG8_STAGE(PG8_SB(0, 0), b2, voffB); PG8_STAGE(PG8_SB(0, 1), b2 + hstep, voffB); PG8_STAGE(PG8_SA(0, 0), a2, voffA);
            PG8_WAIT_V(8); PG8_WAIT_L(0); PG8_BAR; PG8_MMA(1, 0, At, B0); PG8_MMA(1, 1, At, B1); PG8_BAR; PG8_SCHED;
            PG8_LDB(B0, 1, 0); PG8_LDB(B1, 1, 1); PG8_SCHED; PG8_LDA(At, 1, 0); PG8_STAGE(PG8_SA(0, 1), a2 + hstep, voffA);
            PG8_WAIT_V(8); PG8_WAIT_L(0); PG8_BAR; PG8_MMA(0, 0, At, B0); PG8_MMA(0, 1, At, B1); PG8_BAR; PG8_SCHED;
            PG8_LDA(At, 1, 1); PG8_STAGE(PG8_SB(1, 0), b3, voffB); PG8_STAGE(PG8_SB(1, 1), b3 + hstep, voffB); PG8_STAGE(PG8_SA(1, 0), a3, voffA);
            PG8_WAIT_V(8); PG8_WAIT_L(0); PG8_BAR; PG8_MMA(1, 0, At, B0); PG8_MMA(1, 1, At, B1); PG8_BAR; PG8_SCHED;
            } else {
            PG8_LDB(B0, 0, 0); PG8_SCHED; PG8_LDA(At, 0, 0); PG8_STAGE(PG8_SA(1, 1), a1 + hstep, voffA);
            PG8_WAIT_L(8); PG8_BAR; PG8_WAIT_L(0); PG8_MMA(0, 0, At, B0); PG8_BAR; PG8_SCHED;
            PG8_LDB(B1, 0, 1); PG8_STAGE(PG8_SB(0, 0), b2, voffB);
            PG8_BAR; PG8_WAIT_L(0); PG8_MMA(0, 1, At, B1); PG8_BAR;
            PG8_LDA(At, 0, 1); PG8_STAGE(PG8_SA(0, 0), a2, voffA);
            PG8_BAR; PG8_WAIT_L(0); PG8_MMA(1, 0, At, B0); PG8_BAR; PG8_SCHED;
            PG8_STAGE(PG8_SB(0, 1), b2 + hstep, voffB);
            PG8_WAIT_V(6); PG8_BAR; PG8_MMA(1, 1, At, B1); PG8_BAR;
            PG8_LDB(B0, 1, 0); PG8_SCHED; PG8_LDA(At, 1, 0); PG8_STAGE(PG8_SA(0, 1), a2 + hstep, voffA);
            PG8_WAIT_L(8); PG8_BAR; PG8_WAIT_L(0); PG8_MMA(0, 0, At, B0); PG8_BAR; PG8_SCHED;
            PG8_LDB(B1, 1, 1); PG8_STAGE(PG8_SB(1, 0), b3, voffB);
            PG8_BAR; PG8_WAIT_L(0); PG8_MMA(0, 1, At, B1); PG8_BAR;
            PG8_LDA(At, 1, 1); PG8_STAGE(PG8_SA(1, 0), a3, voffA);
            PG8_BAR; PG8_WAIT_L(0); PG8_MMA(1, 0, At, B0); PG8_BAR; PG8_SCHED;
            PG8_STAGE(PG8_SB(1, 1), b3 + hstep, voffB);
            PG8_WAIT_V(6); PG8_BAR; PG8_MMA(1, 1, At, B1); PG8_BAR;
            }
        }
        if constexpr (ALIGN_EPI) { if (wr == 0) PG8_BAR; }
        if constexpr (!Epi::AFTER_DRAIN) { E(acc, cur, wr, wc, fr, fq); S.done(cur); }
        if (!has_next) break;
#pragma unroll
        for (int a = 0; a < 2; ++a)
#pragma unroll
            for (int b = 0; b < 2; ++b)
#pragma unroll
                for (int m = 0; m < 4; ++m)
#pragma unroll
                    for (int n = 0; n < 2; ++n) acc[a][b][m][n] = (f32x4){0.f, 0.f, 0.f, 0.f};
        cur = nxt; cA = nA; cB = nB; ++ui;
        if constexpr (ALIGN_EPI) { if (wr == 1) PG8_BAR; }
    }
    PG8_WAIT_V(0);
    if constexpr (!ALIGN_EPI) { if (wr == 0) PG8_BAR; }
    PG8_BAR;
    if constexpr (Epi::AFTER_DRAIN) { E.fused(acc, cur, wr, wc, fr, fq, lds, wid, lane); S.done(cur); }
#undef PG8_SA
#undef PG8_SB
#undef PG8_STAGE
#undef PG8_LDA
#undef PG8_LDB
#undef PG8_MMA
#undef PG8_WAIT_V
#undef PG8_WAIT_L
#undef PG8_BAR
#undef PG8_SCHED
}
}
namespace att {
using bf16 = __hip_bfloat16;
constexpr int   D = 128, NW = 8, QBLK = 32, KVBLK = 64;
constexpr float SCALE = 0.088388347648318440f;
constexpr float THR = 8.f;
constexpr int SDEPTH = 2;
constexpr int LDQ = 1024, LDK = 256, LDY = 2048, LDG = NINP;
constexpr size_t SHM_V = KVBLK * D * 2, SHM_K = KVBLK * D * 2, SHM_ATTN = 2 * SHM_V + 2 * SHM_K + NW * 64 * 4;
using bf16x8 = __attribute__((ext_vector_type(8))) short;
using s16x4  = __attribute__((ext_vector_type(4))) short;
using f32x16 = __attribute__((ext_vector_type(16))) float;
using f32x8  = __attribute__((ext_vector_type(8))) float;
using u32x4  = __attribute__((ext_vector_type(4))) unsigned;
#define KSWZ(row, colB) ((row) * 256 + ((colB) ^ (((row) & 7) << 4)))
#define SBAR() __builtin_amdgcn_sched_barrier(0)
__device__ __forceinline__ int crow(int r, int hi) { return (r & 3) + 8 * (r >> 2) + 4 * hi; }
__device__ __forceinline__ unsigned cvtpk(float lo, float hi) {
  unsigned r; asm volatile("v_cvt_pk_bf16_f32 %0, %1, %2" : "=v"(r) : "v"(lo), "v"(hi)); return r;
}
template <typename TIn> struct Stage;
template <> struct Stage<bf16>  { using T = bf16x8;
  __device__ static __forceinline__ T ld8(const bf16* p) { return *reinterpret_cast<const bf16x8*>(p); }
  __device__ static __forceinline__ bf16x8 tobf(T x) { return x; } };
template <> struct Stage<float> { using T = f32x8;
  __device__ static __forceinline__ T ld8(const float* p) { return *reinterpret_cast<const f32x8*>(p); }
  __device__ static __forceinline__ bf16x8 tobf(T x) {
    u32x4 w = {cvtpk(x[0], x[1]), cvtpk(x[2], x[3]), cvtpk(x[4], x[5]), cvtpk(x[6], x[7])}; return *reinterpret_cast<bf16x8*>(&w); } };

__device__ __forceinline__ void partialSM(f32x16& p0, f32x16& p1, float& m_reg, float& mn, float& alpha) {
  constexpr float C = SCALE * 1.4426950408889634f;
  float pmax = p0[0]; for (int r = 1; r < 16; ++r) pmax = fmaxf(pmax, p0[r]); for (int r = 0; r < 16; ++r) pmax = fmaxf(pmax, p1[r]);
  { auto rr = __builtin_amdgcn_permlane32_swap(__float_as_uint(pmax), __float_as_uint(pmax), false, false);
    pmax = fmaxf(__uint_as_float(rr[0]), __uint_as_float(rr[1])); }
  if (__builtin_expect(__all(pmax - m_reg <= THR / SCALE), 1)) { mn = m_reg; alpha = 1.f; }
  else { mn = fmaxf(m_reg, pmax); alpha = __builtin_amdgcn_exp2f((m_reg - mn) * C); m_reg = mn; }
  float mnC = -mn * C;
  for (int r = 0; r < 16; ++r) p0[r] = fmaf(p0[r], C, mnC); for (int r = 0; r < 16; ++r) p1[r] = fmaf(p1[r], C, mnC);
  for (int r = 0; r < 16; ++r) p0[r] = __builtin_amdgcn_exp2f(p0[r]);
}
__device__ __forceinline__ void finishSM(f32x16& p0, f32x16& p1, float alpha, float& l_reg, bf16x8& pa0, bf16x8& pa1, bf16x8& pa2, bf16x8& pa3) {
  for (int r = 0; r < 16; ++r) p1[r] = __builtin_amdgcn_exp2f(p1[r]);
  float ps = 0; for (int r = 0; r < 16; ++r) ps += p0[r]; for (int r = 0; r < 16; ++r) ps += p1[r];
  { auto rr = __builtin_amdgcn_permlane32_swap(__float_as_uint(ps), __float_as_uint(ps), false, false);
    ps = __uint_as_float(rr[0]) + __uint_as_float(rr[1]); }
  l_reg = l_reg * alpha + ps;
#define PK4(P, BASE, OUT) do { unsigned a0 = cvtpk(P[BASE + 0], P[BASE + 1]), a1 = cvtpk(P[BASE + 2], P[BASE + 3]);   \
    unsigned b0 = cvtpk(P[BASE + 4], P[BASE + 5]), b1 = cvtpk(P[BASE + 6], P[BASE + 7]);                              \
    auto r0 = __builtin_amdgcn_permlane32_swap(a0, b0, false, false); auto r1 = __builtin_amdgcn_permlane32_swap(a1, b1, false, false); \
    u32x4 w = {r0[0], r1[0], r0[1], r1[1]}; OUT = *reinterpret_cast<bf16x8*>(&w); } while (0)
  PK4(p0, 0, pa0); PK4(p0, 8, pa1); PK4(p1, 0, pa2); PK4(p1, 8, pa3);
#undef PK4
}
__device__ __forceinline__ void qkt(f32x16& p0, f32x16& p1, const bf16* Ks, const bf16x8* qr, int r32, int hi) {
  p0 = f32x16{}; p1 = f32x16{};
  for (int d0 = 0; d0 < 8; ++d0) { int cb = (d0 * 16 + hi * 8) * 2;
    bf16x8 b0 = *reinterpret_cast<const bf16x8*>((const char*)Ks + KSWZ(r32, cb));
    bf16x8 b1 = *reinterpret_cast<const bf16x8*>((const char*)Ks + KSWZ(32 + r32, cb));
    p0 = __builtin_amdgcn_mfma_f32_32x32x16_bf16(b0, qr[d0], p0, 0, 0, 0);
    p1 = __builtin_amdgcn_mfma_f32_32x32x16_bf16(b1, qr[d0], p1, 0, 0, 0); }
}
__device__ __forceinline__ int v_st(int k, int c) { const int kk = (k & ~0xC) | ((k & 4) << 1) | ((k & 8) >> 1); return ((kk >> 3) * 4 + (c >> 5)) * 512 + ((kk & 7) * 32 + (c & 31)) * 2; }
__device__ __forceinline__ int v_rd_base(int lane) { return ((lane & 3) << 3) | (((lane >> 2) & 3) << 6) | (((lane >> 4) & 1) << 5) | (((lane >> 5) & 1) << 8); }
constexpr int v_rd_off(int d0, int ks, int half) { return d0 * 512 + ks * 4096 + half * 2048; }
template <int OFF> __device__ __forceinline__ s16x4 tr_read(int vb) {
  s16x4 r; asm volatile("ds_read_b64_tr_b16 %0, %1 offset:%2" : "=&v"(r) : "v"(vb), "i"(OFF) : "memory"); return r;
}
template <int D0> __device__ __forceinline__ void pv_one(f32x16& od, int vb, bf16x8 pa0, bf16x8 pa1, bf16x8 pa2, bf16x8 pa3) {
  const s16x4 l0 = tr_read<v_rd_off(D0, 0, 0)>(vb), h0 = tr_read<v_rd_off(D0, 0, 1)>(vb), l1 = tr_read<v_rd_off(D0, 1, 0)>(vb), h1 = tr_read<v_rd_off(D0, 1, 1)>(vb);
  const s16x4 l2 = tr_read<v_rd_off(D0, 2, 0)>(vb), h2 = tr_read<v_rd_off(D0, 2, 1)>(vb), l3 = tr_read<v_rd_off(D0, 3, 0)>(vb), h3 = tr_read<v_rd_off(D0, 3, 1)>(vb);
  asm volatile("s_waitcnt lgkmcnt(0)" ::: "memory"); SBAR();
#define PK(L, H) (bf16x8){L[0], L[1], L[2], L[3], H[0], H[1], H[2], H[3]}
  od = __builtin_amdgcn_mfma_f32_32x32x16_bf16(pa0, PK(l0, h0), od, 0, 0, 0);
  od = __builtin_amdgcn_mfma_f32_32x32x16_bf16(pa1, PK(l1, h1), od, 0, 0, 0);
  od = __builtin_amdgcn_mfma_f32_32x32x16_bf16(pa2, PK(l2, h2), od, 0, 0, 0);
  od = __builtin_amdgcn_mfma_f32_32x32x16_bf16(pa3, PK(l3, h3), od, 0, 0, 0);
#undef PK
}
__device__ __forceinline__ void pv_d0(f32x16* o, int vb, bf16x8 pa0, bf16x8 pa1, bf16x8 pa2, bf16x8 pa3) {
  pv_one<0>(o[0], vb, pa0, pa1, pa2, pa3); pv_one<1>(o[1], vb, pa0, pa1, pa2, pa3); pv_one<2>(o[2], vb, pa0, pa1, pa2, pa3); pv_one<3>(o[3], vb, pa0, pa1, pa2, pa3);
}
__device__ __forceinline__ void attn_dense_body(const bf16* __restrict__ Qb, const bf16* __restrict__ Kh, const bf16* __restrict__ Vh,
                                                unsigned short* __restrict__ Yb, const unsigned short* __restrict__ Gb, int seq, char* lds) {
  using St = Stage<bf16>; using SQ = Stage<bf16>; using TQ = bf16;
  const int tid = threadIdx.x, wid = tid >> 6, lane = tid & 63, r32 = lane & 31, hi = lane >> 5;
  bf16* V_lds = (bf16*)lds; bf16* K_lds = (bf16*)(lds + 2 * SHM_V);
  float* ws = (float*)(lds + 2 * SHM_V + 2 * SHM_K) + wid * 64; float* li_l = ws; float* al_l = ws + 32;
  float m_reg = -1e30f, l_reg = 0; f32x16 o[4] = {}; bf16x8 qr[8];
  const TQ* Qw = Qb + (long)(wid * QBLK + r32) * LDQ + hi * 8;
#pragma unroll
  for (int d0 = 0; d0 < 8; ++d0) qr[d0] = SQ::tobf(SQ::ld8(Qw + d0 * 16));
  const int sr = tid >> 4, sc = (tid & 15) * 8, vst0 = v_st(sr, sc), vst1 = v_st(32 + sr, sc);
  const int vb0 = (int)(uintptr_t)V_lds + v_rd_base(lane);
  struct { typename St::T vs0, vs1, ks0, ks1; } sr_[SDEPTH];
#define SLOAD(i, k0) do { sr_[i].vs0 = St::ld8(&Vh[(long)((k0) + sr) * LDK + sc]); sr_[i].vs1 = St::ld8(&Vh[(long)((k0) + 32 + sr) * LDK + sc]); \
    sr_[i].ks0 = St::ld8(&Kh[(long)((k0) + sr) * LDK + sc]); sr_[i].ks1 = St::ld8(&Kh[(long)((k0) + 32 + sr) * LDK + sc]); } while (0)
#define SWRITE(b, i) do { *(bf16x8*)((char*)V_lds + (b) * SHM_V + vst0) = St::tobf(sr_[i].vs0);          \
    *(bf16x8*)((char*)V_lds + (b) * SHM_V + vst1) = St::tobf(sr_[i].vs1); int kc = sc * 2;               \
    *(bf16x8*)((char*)K_lds + (b) * SHM_K + KSWZ(sr, kc)) = St::tobf(sr_[i].ks0);                       \
    *(bf16x8*)((char*)K_lds + (b) * SHM_K + KSWZ(32 + sr, kc)) = St::tobf(sr_[i].ks1); } while (0)
#define SWAIT() do { if constexpr (SDEPTH == 2) asm volatile("s_waitcnt vmcnt(4)" ::: "memory"); else asm volatile("s_waitcnt vmcnt(0)" ::: "memory"); } while (0)
#define RESC(a) do { if (__any((a) < 1.f)) { if (hi == 0) al_l[r32] = (a); asm volatile("s_waitcnt lgkmcnt(0)" ::: "memory"); \
    for (int d = 0; d < 4; ++d) for (int r = 0; r < 16; ++r) o[d][r] *= al_l[crow(r, hi)]; } } while (0)
  f32x16 pA0, pA1, pB0, pB1; float mnA, mnB, alA, alB; bf16x8 pa0, pa1, pa2, pa3; const int NT = seq / KVBLK;
  constexpr int SE = 0, SO = SDEPTH - 1;
  SLOAD(SE, 0); asm volatile("s_waitcnt vmcnt(0)" ::: "memory"); SWRITE(0, SE); __syncthreads();
  qkt(pA0, pA1, K_lds, qr, r32, hi); partialSM(pA0, pA1, m_reg, mnA, alA);
  SLOAD(SO, KVBLK); if constexpr (SDEPTH == 2) { if (2 < NT) SLOAD(SE, 2 * KVBLK); }
  SWAIT(); SWRITE(1, SO); __syncthreads();
  for (int j = 1; j + 1 < NT; j += 2) {
    SBAR(); qkt(pB0, pB1, (bf16*)((char*)K_lds + SHM_K), qr, r32, hi);
    finishSM(pA0, pA1, alA, l_reg, pa0, pa1, pa2, pa3); SBAR();
    SLOAD(SO, (j + SDEPTH) * KVBLK); SBAR();
    pv_d0(o, vb0, pa0, pa1, pa2, pa3); partialSM(pB0, pB1, m_reg, mnB, alB);
    __syncthreads(); SWAIT(); SWRITE(0, SE);
    RESC(alB); __syncthreads();
    SBAR(); qkt(pA0, pA1, K_lds, qr, r32, hi);
    finishSM(pB0, pB1, alB, l_reg, pa0, pa1, pa2, pa3); SBAR();
    if (SDEPTH == 1 || j + 3 < NT) SLOAD(SE, (j + 1 + SDEPTH) * KVBLK); SBAR();
    pv_d0(o, vb0 + (int)SHM_V, pa0, pa1, pa2, pa3); partialSM(pA0, pA1, m_reg, mnA, alA);
    __syncthreads(); SWAIT(); SWRITE(1, SO);
    RESC(alA); __syncthreads();
  }
  SBAR(); qkt(pB0, pB1, (bf16*)((char*)K_lds + SHM_K), qr, r32, hi);
  finishSM(pA0, pA1, alA, l_reg, pa0, pa1, pa2, pa3); SBAR();
  pv_d0(o, vb0, pa0, pa1, pa2, pa3); partialSM(pB0, pB1, m_reg, mnB, alB);
  __syncthreads(); RESC(alB);
  finishSM(pB0, pB1, alB, l_reg, pa0, pa1, pa2, pa3); SBAR();
  pv_d0(o, vb0 + (int)SHM_V, pa0, pa1, pa2, pa3);
  if (hi == 0) li_l[r32] = l_reg; asm volatile("s_waitcnt lgkmcnt(0)" ::: "memory");
  float rli[16];
#pragma unroll
  for (int r = 0; r < 16; ++r) rli[r] = __builtin_amdgcn_rcpf(li_l[crow(r, hi)]);
  __syncthreads();
  { int ew = wid; asm volatile("" : "+v"(ew));
    float* stg = (float*)lds + ew * (32 * 132);
#pragma unroll
    for (int r = 0; r < 16; ++r) { const int orow = crow(r, hi);
#pragma unroll
      for (int d0 = 0; d0 < 4; ++d0) stg[orow * 132 + d0 * 32 + r32] = o[d0][r] * rli[r]; }
    asm volatile("s_waitcnt lgkmcnt(0)" ::: "memory");
    int el = lane; asm volatile("" : "+v"(el));
    const unsigned short* Gw0 = Gb + (long)(ew * QBLK) * LDG; unsigned short* Yw0 = Yb + (long)(ew * QBLK) * LDY;
#pragma unroll 2
    for (int i = 0; i < 8; ++i) { const int id = el + 64 * i, row = id >> 4, c8 = id & 15;
      const float* sp = stg + row * 132 + c8 * 8;
      const u32x4 gw = *reinterpret_cast<const u32x4*>(Gw0 + (long)row * LDG + c8 * 8);
      u32x4 ow;
#pragma unroll
      for (int q = 0; q < 4; ++q) { const unsigned gq = (q == 0) ? gw.x : (q == 1) ? gw.y : (q == 2) ? gw.z : gw.w;
        const float g0 = __uint_as_float(gq << 16), g1 = __uint_as_float(gq & 0xffff0000u);
        const float v0 = sp[2 * q] * (g0 / (1.f + __expf(-g0))), v1 = sp[2 * q + 1] * (g1 / (1.f + __expf(-g1)));
        const unsigned pk = cvtpk(v0, v1);
        if (q == 0) ow.x = pk; else if (q == 1) ow.y = pk; else if (q == 2) ow.z = pk; else ow.w = pk; }
      *reinterpret_cast<u32x4*>(Yw0 + (long)row * LDY + c8 * 8) = ow; } }
#undef SLOAD
#undef SWRITE
#undef SWAIT
#undef RESC
}
}
#define GAS __attribute__((address_space(1)))
#define LAS __attribute__((address_space(3)))
typedef unsigned short bf16_t;
typedef unsigned v4u __attribute__((ext_vector_type(4)));
typedef unsigned v2u __attribute__((ext_vector_type(2)));
typedef float f32x4 __attribute__((ext_vector_type(4)));
typedef short bf16x8_t __attribute__((ext_vector_type(8)));
typedef float f32x16_t __attribute__((ext_vector_type(16)));
#define LDS_WAIT() asm volatile("s_waitcnt lgkmcnt(0)" ::: "memory")

constexpr size_t MiB = 1u << 20;
constexpr size_t WS_CTL = 0, CTL_ZERO_BYTES = 1 * MiB;
constexpr size_t WS_MOD = 64 * 1024;
constexpr size_t WS_ROPE = 1 * MiB;
constexpr size_t WS_SMALL = 2 * MiB;
constexpr size_t WS_WIN0 = 3 * MiB, WS_WOUT0 = 24 * MiB;
constexpr size_t WS_QB = 32 * MiB, WS_KB = 48 * MiB, WS_VB = 52 * MiB;
constexpr size_t WS_HB = 3 * MiB;
constexpr size_t WS_WIN1 = 56 * MiB, WS_WOUT1 = 77 * MiB;
constexpr size_t WS_H = 85 * MiB;
constexpr size_t WS_HF = 85 * MiB;
constexpr size_t WS_PROJ = 117 * MiB;
constexpr size_t WS_YCAT = 201 * MiB;
constexpr size_t WS_ACT = 233 * MiB;
constexpr size_t WS_YF = 297 * MiB, WS_YB = 329 * MiB;
constexpr size_t WS_XBC16 = 85 * MiB;
constexpr size_t WS_QKV16 = 3 * MiB;
constexpr size_t WS_XC16 = 35 * MiB;
constexpr size_t WS_GT = 85 * MiB, WS_GA = 101 * MiB;
constexpr size_t WS_WGT = 361 * MiB;
constexpr size_t WS_LSUM = 362 * MiB;
constexpr size_t WS_HF16 = 56 * MiB;
constexpr size_t WS_HB16 = 366 * MiB;
constexpr size_t WS_END = 382 * MiB;

constexpr int NWAVES = 8, NTHREADS = 512;
constexpr int LDS_BYTES = 147456;
constexpr int NPHASE = 15;

struct Args { const float* in[39]; float* out; unsigned char* ws; int ph_lo, ph_hi; };

__device__ __forceinline__ float bf2f(unsigned v) { return __uint_as_float(v << 16); }
__device__ __forceinline__ unsigned f2bf(float f) { unsigned u = __float_as_uint(f); return (u + 0x7fffu + ((u >> 16) & 1u)) >> 16; }
__device__ __forceinline__ unsigned pk2(float lo, float hi) { return f2bf(lo) | (f2bf(hi) << 16); }
__device__ __forceinline__ void unpack8(const v4u w, float* x) {
    x[0] = __uint_as_float(w.x << 16); x[1] = __uint_as_float(w.x & 0xffff0000u); x[2] = __uint_as_float(w.y << 16); x[3] = __uint_as_float(w.y & 0xffff0000u);
    x[4] = __uint_as_float(w.z << 16); x[5] = __uint_as_float(w.z & 0xffff0000u); x[6] = __uint_as_float(w.w << 16); x[7] = __uint_as_float(w.w & 0xffff0000u);
}
__device__ __forceinline__ v4u pack8(const float* x) { v4u w; w.x = pk2(x[0], x[1]); w.y = pk2(x[2], x[3]); w.z = pk2(x[4], x[5]); w.w = pk2(x[6], x[7]); return w; }
__device__ __forceinline__ float silu_f(float x) { return x / (1.f + expf(-x)); }
__device__ __forceinline__ float sigmoid_f(float x) { return 1.f / (1.f + expf(-x)); }
__device__ __forceinline__ float softplus_f(float x) { return fmaxf(x, 0.f) + log1pf(expf(-fabsf(x))); }
template <int CTRL> __device__ __forceinline__ float dpp_mov(float v) { return __builtin_bit_cast(float, __builtin_amdgcn_update_dpp(0, __builtin_bit_cast(int, v), CTRL, 0xF, 0xF, true)); }
template <int N> __device__ __forceinline__ float group_sum(float v) {
    if (N >= 2) v += dpp_mov<0xB1>(v);
    if (N >= 4) v += dpp_mov<0x4E>(v);
    if (N >= 8) v += dpp_mov<0x141>(v);
    if (N >= 16) v += dpp_mov<0x140>(v);
    if (N >= 32) v += __shfl_xor(v, 16);
    if (N >= 64) v += __shfl_xor(v, 32);
    return v;
}

__device__ __forceinline__ void p0_transpose_item(const float* W, int K, int N, bf16_t* WT, int row_off, LAS float* scr, int item, int lane) {
    const int nblk = N / 32, kb = item / nblk, nb = item % nblk, k0 = 64 * kb, n0 = 32 * nb;
#pragma unroll 8
    for (int i = 0; i < 32; ++i) { const int kk = 2 * i + (lane >> 5); scr[kk * 33 + (lane & 31)] = W[(size_t)(k0 + kk) * N + n0 + (lane & 31)]; }
    LDS_WAIT(); asm volatile("" ::: "memory");
    const int c = lane & 7;
#pragma unroll
    for (int j = 0; j < 4; ++j) { const int n = (lane >> 3) + 8 * j; const LAS float* s = scr + (8 * c) * 33 + n;
        v4u o; o.x = pk2(s[0 * 33], s[1 * 33]); o.y = pk2(s[2 * 33], s[3 * 33]); o.z = pk2(s[4 * 33], s[5 * 33]); o.w = pk2(s[6 * 33], s[7 * 33]);
        *(v4u*)(WT + (size_t)(row_off + n0 + n) * K + k0 + 8 * c) = o; }
    LDS_WAIT(); asm volatile("" ::: "memory");
}

__device__ __forceinline__ void p0_prologue(const Args& a, LAS unsigned char* lds, int vcu, int G) {
    const int tid = threadIdx.x, lane = tid & 63, wave = tid >> 6;
    unsigned char* ws = a.ws;
    { const int gid = blockIdx.x * NTHREADS + tid;
      if (gid < 2048) { const int pos = gid >> 5, i = gid & 31; const float freq = expf(-(float)i * (1.f / 32.f) * 9.210340371976184f); const float ang = (float)pos * freq;
          float* rt = (float*)(ws + WS_ROPE); rt[2 * gid] = cosf(ang); rt[2 * gid + 1] = sinf(ang); } }
    { const int gid = blockIdx.x * NTHREADS + tid, gn = G * NTHREADS; constexpr int NV = (NINP - NIN) * 2048 * 2 / 16;
      v4u* p0 = (v4u*)(ws + WS_WIN0 + (size_t)NIN * 2048 * 2); v4u* p1 = (v4u*)(ws + WS_WIN1 + (size_t)NIN * 2048 * 2);
      for (int i = gid; i < NV; i += gn) { p0[i] = (v4u){0, 0, 0, 0}; p1[i] = (v4u){0, 0, 0, 0}; } }
    if (blockIdx.x < 192) {
        const int it = blockIdx.x, l = it / 96, r = it % 96, kc = r / 3, nc = r % 3;
        LAS float* cond = (LAS float*)lds;
        if (tid < 256) { const int b = tid >> 6, k = tid & 63; const float c = a.in[1][b * 2048 + kc * 64 + k]; cond[tid] = silu_f(c); }
        __syncthreads();
        const float* W = a.in[2] + (size_t)l * 2048 * 6144 + (size_t)(kc * 64) * 6144 + nc * 2048 + tid * 4;
        f32x4 acc0 = {0, 0, 0, 0}, acc1 = acc0, acc2 = acc0, acc3 = acc0;
#pragma unroll 8
        for (int k = 0; k < 64; ++k) { const f32x4 w = *(const f32x4*)(W + (size_t)k * 6144);
            acc0 += cond[k] * w; acc1 += cond[64 + k] * w; acc2 += cond[128 + k] * w; acc3 += cond[192 + k] * w; }
        float* macc = (float*)(ws + WS_MOD) + (size_t)l * 4 * 6144 + nc * 2048 + tid * 4;
#pragma unroll
        for (int i = 0; i < 4; ++i) { atomicAdd(macc + i, acc0[i]); atomicAdd(macc + 6144 + i, acc1[i]); atomicAdd(macc + 2 * 6144 + i, acc2[i]); atomicAdd(macc + 3 * 6144 + i, acc3[i]); }
        __syncthreads();
    }
    { LAS float* scr = (LAS float*)(lds + wave * 16384);
      const int gw = vcu * NWAVES + wave, NGW = G * NWAVES;
      constexpr int I_IN = 32 * (NIN / 32), I_OUT = 32 * 64, NITEMS = I_IN + I_OUT;
      for (int it = gw; it < NITEMS; it += NGW) {
          int r = it;
          if (r < I_IN) { p0_transpose_item(a.in[5], 2048, NIN, (bf16_t*)(ws + WS_WIN0), 0, scr, r, lane); continue; } r -= I_IN;
          p0_transpose_item(a.in[16], 2048, 2048, (bf16_t*)(ws + WS_WOUT0), 0, scr, r, lane);
      } }
}
__device__ __forceinline__ void late_transposes(const Args& a, LAS float* scr, int hw, int NHW, int lane) {
    unsigned char* ws = a.ws;
    constexpr int I_IN = 32 * (NIN / 32), I_OUT = 32 * 64, I_G = 32 * 8, NITEMS = I_IN + I_OUT + I_G;
    for (int it = hw; it < NITEMS; it += NHW) {
        int r = it;
        if (r < I_G) { const int mn = r >> 3, m = mn >> 3; const float* Wg = a.in[m == 0 ? 27 : m == 1 ? 29 : m == 2 ? 32 : 34] + (size_t)(mn & 7) * 128 * 128;
            p0_transpose_item(Wg, 128, 128, (bf16_t*)(ws + WS_WGT) + (size_t)mn * 128 * 128, 0, scr, r & 7, lane); continue; } r -= I_G;
        if (r < I_IN) { p0_transpose_item(a.in[17], 2048, NIN, (bf16_t*)(ws + WS_WIN1), 0, scr, r, lane); continue; } r -= I_IN;
        p0_transpose_item(a.in[37], 2048, 2048, (bf16_t*)(ws + WS_WOUT1), 0, scr, r, lane);
    }
}

__device__ __forceinline__ void normmod_phase(const Args& a, const float* xin, int layer, int gw, int NGW, int lane) {
    const float* nw = a.in[4] + layer * 2048; const float* bm = a.in[3] + layer * 6144;
    const float* macc = (const float*)(a.ws + WS_MOD) + (size_t)layer * 4 * 6144;
    bf16_t* H = (bf16_t*)(a.ws + WS_H);
    for (int m = gw; m < MTOK; m += NGW) {
        const int b = m >> 11;
        const f32x4* xr = (const f32x4*)(xin + (size_t)m * 2048) + lane;
        f32x4 v[8]; float s = 0.f;
#pragma unroll
        for (int j = 0; j < 8; ++j) { v[j] = xr[64 * j]; s += (v[j].x * v[j].x + v[j].y * v[j].y) + (v[j].z * v[j].z + v[j].w * v[j].w); }
        const float rstd = rsqrtf(group_sum<64>(s) * (1.f / 2048.f) + EPS);
#pragma unroll
        for (int j = 0; j < 8; ++j) { const int col = (64 * j + lane) * 4;
            const f32x4 w = *(const f32x4*)(nw + col);
            const f32x4 sh = *(const f32x4*)(macc + b * 6144 + col) + *(const f32x4*)(bm + col);
            const f32x4 sc = *(const f32x4*)(macc + b * 6144 + 2048 + col) + *(const f32x4*)(bm + 2048 + col);
            const f32x4 o = v[j] * rstd * w * (1.f + sc) + sh;
            v2u pk; pk.x = pk2(o.x, o.y); pk.y = pk2(o.z, o.w);
            *(v2u*)(H + (size_t)m * 2048 + col) = pk; }
    }
}

__device__ __forceinline__ void post0_phase(const Args& a, int gw, int NGW, int lane) {
    const bf16_t* P = (const bf16_t*)(a.ws + WS_PROJ);
    const float2* rope = (const float2*)(a.ws + WS_ROPE);
    const float* qn = a.in[6]; const float* kn = a.in[7]; const float* cw = a.in[8]; const float* cb = a.in[9];
    bf16_t* Q = (bf16_t*)(a.ws + WS_QB); bf16_t* K = (bf16_t*)(a.ws + WS_KB); bf16_t* V = (bf16_t*)(a.ws + WS_VB);
    float* ACT = (float*)(a.ws + WS_ACT);
    for (int m = gw; m < MTOK; m += NGW) {
        const int t = m & 2047, prow = t >> 6, pcol = t & 63;
        const bf16_t* pr = P + (size_t)m * NINP;
        {
            float x[16]; unpack8(*(const v4u*)(pr + A_Q + lane * 16), x); unpack8(*(const v4u*)(pr + A_Q + lane * 16 + 8), x + 8);
            float ss = 0.f;
#pragma unroll
            for (int i = 0; i < 16; ++i) ss += x[i] * x[i];
            ss = group_sum<8>(ss);
            const float r = rsqrtf(ss * (1.f / 128.f) + EPS);
            const int d0 = (lane & 7) * 16;
#pragma unroll
            for (int i = 0; i < 16; ++i) x[i] = x[i] * r * qn[d0 + i];
#pragma unroll
            for (int pi = 0; pi < 8; ++pi) { const int p = (d0 >> 1) + pi; const float2 cs = (p < 32) ? rope[prow * 32 + p] : rope[pcol * 32 + p - 32];
                const float x0 = x[2 * pi], x1 = x[2 * pi + 1]; x[2 * pi] = x0 * cs.x - x1 * cs.y; x[2 * pi + 1] = x0 * cs.y + x1 * cs.x; }
            *(v4u*)(Q + (size_t)m * 1024 + lane * 16) = pack8(x); *(v4u*)(Q + (size_t)m * 1024 + lane * 16 + 8) = pack8(x + 8);
        }
        {
            const v2u w = *(const v2u*)(pr + A_K + lane * 4);
            float x[4] = {__uint_as_float(w.x << 16), __uint_as_float(w.x & 0xffff0000u), __uint_as_float(w.y << 16), __uint_as_float(w.y & 0xffff0000u)};
            float ss = (x[0] * x[0] + x[1] * x[1]) + (x[2] * x[2] + x[3] * x[3]);
            ss = group_sum<32>(ss);
            const float r = rsqrtf(ss * (1.f / 128.f) + EPS);
            const int d0 = (lane & 31) * 4;
#pragma unroll
            for (int i = 0; i < 4; ++i) x[i] = x[i] * r * kn[d0 + i];
#pragma unroll
            for (int pi = 0; pi < 2; ++pi) { const int p = (d0 >> 1) + pi; const float2 cs = (p < 32) ? rope[prow * 32 + p] : rope[pcol * 32 + p - 32];
                const float x0 = x[2 * pi], x1 = x[2 * pi + 1]; x[2 * pi] = x0 * cs.x - x1 * cs.y; x[2 * pi + 1] = x0 * cs.y + x1 * cs.x; }
            v2u o; o.x = pk2(x[0], x[1]); o.y = pk2(x[2], x[3]);
            *(v2u*)(K + (size_t)m * 256 + lane * 4) = o;
            *(v2u*)(V + (size_t)m * 256 + lane * 4) = *(const v2u*)(pr + A_V + lane * 4);
        }
#pragma unroll
        for (int j = 0; j < 3; ++j) { const int ch = (j * 64 + lane) * 8;
            float acc[8];
            { const f32x4 b0 = *(const f32x4*)(cb + ch), b1 = *(const f32x4*)(cb + ch + 4); acc[0] = b0.x; acc[1] = b0.y; acc[2] = b0.z; acc[3] = b0.w; acc[4] = b1.x; acc[5] = b1.y; acc[6] = b1.z; acc[7] = b1.w; }
#pragma unroll
            for (int d = 0; d < 4; ++d) { const int ts = t + d - 2;
                if (ts >= 0 && ts < SEQ) { float x[8]; unpack8(*(const v4u*)(P + (size_t)(m + d - 2) * NINP + A_XS + ch), x);
                    const f32x4 w0 = *(const f32x4*)(cw + d * 1536 + ch), w1 = *(const f32x4*)(cw + d * 1536 + ch + 4);
                    acc[0] += w0.x * x[0]; acc[1] += w0.y * x[1]; acc[2] += w0.z * x[2]; acc[3] += w0.w * x[3];
                    acc[4] += w1.x * x[4]; acc[5] += w1.y * x[5]; acc[6] += w1.z * x[6]; acc[7] += w1.w * x[7]; } }
            f32x4 o0, o1; o0.x = silu_f(acc[0]); o0.y = silu_f(acc[1]); o0.z = silu_f(acc[2]); o0.w = silu_f(acc[3]); o1.x = silu_f(acc[4]); o1.y = silu_f(acc[5]); o1.z = silu_f(acc[6]); o1.w = silu_f(acc[7]);
            *(f32x4*)(ACT + (size_t)m * 1536 + ch) = o0; *(f32x4*)(ACT + (size_t)m * 1536 + ch + 4) = o1;
            { v4u w; w.x = pk2(o0.x, o0.y); w.y = pk2(o0.z, o0.w); w.z = pk2(o1.x, o1.y); w.w = pk2(o1.z, o1.w); *(v4u*)((bf16_t*)(a.ws + WS_XBC16) + (size_t)m * 1536 + ch) = w; } }
    }
}

typedef float f32x2 __attribute__((ext_vector_type(2)));
__device__ __forceinline__ void ssd_combine_phase(const Args& a, int gw, int NGW, int lane) {
    const float* YF = (const float*)(a.ws + WS_YF); const float* YB = (const float*)(a.ws + WS_YB); const float* ACT = (const float*)(a.ws + WS_ACT);
    const bf16_t* P = (const bf16_t*)(a.ws + WS_PROJ); bf16_t* YC = (bf16_t*)(a.ws + WS_YCAT);
    const float* dsk = a.in[14]; const float* nw = a.in[15];
    for (int m = gw; m < MTOK; m += NGW) {
        const int ch = lane * 16; const float dk = dsk[ch >> 6];
        float z[16], gv[16]; unpack8(*(const v4u*)(P + (size_t)m * NINP + A_Z + ch), z); unpack8(*(const v4u*)(P + (size_t)m * NINP + A_Z + ch + 8), z + 8);
        float ss = 0.f;
#pragma unroll
        for (int q = 0; q < 4; ++q) { const f32x4 f = *(const f32x4*)(YF + (size_t)m * 1024 + ch + 4 * q), bk = *(const f32x4*)(YB + (size_t)m * 1024 + ch + 4 * q), xv = *(const f32x4*)(ACT + (size_t)m * 1536 + ch + 4 * q);
            const f32x4 y = f + bk + dk * xv;
            gv[4 * q] = y.x * silu_f(z[4 * q]); gv[4 * q + 1] = y.y * silu_f(z[4 * q + 1]); gv[4 * q + 2] = y.z * silu_f(z[4 * q + 2]); gv[4 * q + 3] = y.w * silu_f(z[4 * q + 3]); }
#pragma unroll
        for (int i = 0; i < 16; ++i) ss += gv[i] * gv[i];
        const float r = rsqrtf(group_sum<64>(ss) * (1.f / 1024.f) + EPS);
#pragma unroll
        for (int i = 0; i < 16; ++i) gv[i] = gv[i] * r * nw[ch + i];
        *(v4u*)(YC + (size_t)m * 2048 + 1024 + ch) = pack8(gv); *(v4u*)(YC + (size_t)m * 2048 + 1024 + ch + 8) = pack8(gv + 8);
    }
}

__device__ __forceinline__ void post1_phase(const Args& a, int gw, int NGW, int lane) {
    const bf16_t* P = (const bf16_t*)(a.ws + WS_PROJ); const float* cw = a.in[18]; const float* cb = a.in[19];
    float* ACT = (float*)(a.ws + WS_ACT);
    for (int m = gw; m < MTOK; m += NGW) {
        const int t = m & 2047;
#pragma unroll
        for (int j = 0; j < 4; ++j) { const int ch = (j * 64 + lane) * 8;
            float acc[8];
            { const f32x4 b0 = *(const f32x4*)(cb + ch), b1 = *(const f32x4*)(cb + ch + 4); acc[0] = b0.x; acc[1] = b0.y; acc[2] = b0.z; acc[3] = b0.w; acc[4] = b1.x; acc[5] = b1.y; acc[6] = b1.z; acc[7] = b1.w; }
#pragma unroll
            for (int d = 0; d < 4; ++d) { const int ts = t + d - 2;
                if (ts >= 0 && ts < SEQ) { float x[8]; unpack8(*(const v4u*)(P + (size_t)(m + d - 2) * NINP + C_Q + ch), x);
                    const f32x4 w0 = *(const f32x4*)(cw + d * 2048 + ch), w1 = *(const f32x4*)(cw + d * 2048 + ch + 4);
                    acc[0] += w0.x * x[0]; acc[1] += w0.y * x[1]; acc[2] += w0.z * x[2]; acc[3] += w0.w * x[3];
                    acc[4] += w1.x * x[4]; acc[5] += w1.y * x[5]; acc[6] += w1.z * x[6]; acc[7] += w1.w * x[7]; } }
#pragma unroll
            for (int i = 0; i < 8; ++i) acc[i] = silu_f(acc[i]);
            if (j < 2) {
                float ss = 0.f;
#pragma unroll
                for (int i = 0; i < 8; ++i) ss += acc[i] * acc[i];
                ss = group_sum<16>(ss);
                float r = rsqrtf(ss + EPS); if (j == 0) r *= 0.088388347648318440f;
#pragma unroll
                for (int i = 0; i < 8; ++i) acc[i] *= r;
            }
            *(f32x4*)(ACT + (size_t)m * 2048 + ch) = (f32x4){acc[0], acc[1], acc[2], acc[3]}; *(f32x4*)(ACT + (size_t)m * 2048 + ch + 4) = (f32x4){acc[4], acc[5], acc[6], acc[7]};
            *(v4u*)((bf16_t*)(a.ws + WS_QKV16) + (size_t)m * 2048 + ch) = pack8(acc); }
    }
}

typedef short s16x4_t __attribute__((ext_vector_type(4)));
typedef __bf16 bf16x2_v __attribute__((ext_vector_type(2)));
__device__ __forceinline__ unsigned cvtpk_rne(float lo, float hi) { f32x2 v = {lo, hi}; bf16x2_v bb = __builtin_convertvector(v, bf16x2_v); return __builtin_bit_cast(unsigned, bb); }
template <int S_> __device__ __forceinline__ bf16x8_t acc_frag(const f32x16_t& x) {
    v4u w; w.x = cvtpk_rne(x[8 * S_ + 0], x[8 * S_ + 1]); w.y = cvtpk_rne(x[8 * S_ + 2], x[8 * S_ + 3]); w.z = cvtpk_rne(x[8 * S_ + 4], x[8 * S_ + 5]); w.w = cvtpk_rne(x[8 * S_ + 6], x[8 * S_ + 7]);
    return __builtin_bit_cast(bf16x8_t, w);
}
__device__ __forceinline__ bf16x8_t join44(v2u lo, v2u hi) { v4u w; w.x = lo.x; w.y = lo.y; w.z = hi.x; w.w = hi.y; return __builtin_bit_cast(bf16x8_t, w); }
__device__ __forceinline__ float wave_incl_scan(float v, int lane) {
#pragma unroll
    for (int o = 1; o < 64; o <<= 1) { const float t = __shfl_up(v, o); if (lane >= o) v += t; }
    return v;
}
constexpr int GDN_LDS_PER_WAVE = 17920;
__device__ __forceinline__ void gdn1_item(const Args& a, int item, unsigned char* ldsw, int lane) {
    asm volatile("" : "+v"(lane));
    const int c = item & 31, dir = (item >> 5) & 1, hv = (item >> 6) & 7, b = item >> 9, hq = hv >> 1;
    const int r32 = lane & 31, hi = lane >> 5;
    float* AT = (float*)ldsw; float* Gs = AT + 64 * 64; float* Bs = Gs + 64;
    const bf16_t* QK = (const bf16_t*)(a.ws + WS_QKV16); const float* SM = (const float*)(a.ws + WS_SMALL);
    bf16_t* GT = (bf16_t*)(a.ws + WS_GT) + (size_t)item * 4096; bf16_t* GA = (bf16_t*)(a.ws + WS_GA) + (size_t)item * 4096;
    const float Aneg = -expf(a.in[dir ? 21 : 20][hv]); const float dtb = a.in[dir ? 23 : 22][hv];
    {
        const int t = dir ? SEQ - 1 - (64 * c + lane) : 64 * c + lane; const float* sm = SM + ((size_t)b * SEQ + t) * 32;
        const float gi = Aneg * softplus_f(sm[16 + dir * 8 + hv] + dtb), bi = sigmoid_f(sm[dir * 8 + hv]);
        Gs[lane] = wave_incl_scan(gi, lane); Bs[lane] = bi;
    }
    const int t0r = dir ? SEQ - 1 - (64 * c + r32) : 64 * c + r32, t1r = dir ? t0r - 32 : t0r + 32;
    const bf16_t* k0p = QK + ((size_t)b * SEQ + t0r) * 2048 + 512 + hq * 128 + hi * 8; const bf16_t* k1p = QK + ((size_t)b * SEQ + t1r) * 2048 + 512 + hq * 128 + hi * 8;
    const bf16_t* q0p = k0p - 512, * q1p = k1p - 512;
    LDS_WAIT();
    const float Gj0 = Gs[r32], Gj1 = Gs[32 + r32];
    {
        f32x16_t kk00, kk10, kk11;
#pragma unroll
        for (int r = 0; r < 16; ++r) { kk00[r] = 0.f; kk10[r] = 0.f; kk11[r] = 0.f; }
#pragma unroll
        for (int s = 0; s < 8; ++s) {
            const bf16x8_t kA0 = *(const bf16x8_t*)(k0p + 16 * s), kA1 = *(const bf16x8_t*)(k1p + 16 * s);
            kk00 = __builtin_amdgcn_mfma_f32_32x32x16_bf16(kA0, kA0, kk00, 0, 0, 0); kk10 = __builtin_amdgcn_mfma_f32_32x32x16_bf16(kA1, kA0, kk10, 0, 0, 0); kk11 = __builtin_amdgcn_mfma_f32_32x32x16_bf16(kA1, kA1, kk11, 0, 0, 0);
        }
#pragma unroll
        for (int r = 0; r < 16; ++r) { const int il = (r & 3) + 8 * (r >> 2) + 4 * hi;
            const float Gi0 = Gs[il], Gi1 = Gs[32 + il], bi0 = Bs[il], bi1 = Bs[32 + il];
            AT[r32 * 64 + il] = (r32 < il) ? bi0 * kk00[r] * expf(Gi0 - Gj0) : 0.f;
            AT[r32 * 64 + 32 + il] = bi1 * kk10[r] * expf(Gi1 - Gj0);
            AT[(32 + r32) * 64 + 32 + il] = (r32 < il) ? bi1 * kk11[r] * expf(Gi1 - Gj1) : 0.f;
            AT[(32 + r32) * 64 + il] = 0.f;
        }
    }
    asm volatile("" ::: "memory");
    {
        f32x16_t qk00, qk10, qk11;
#pragma unroll
        for (int r = 0; r < 16; ++r) { qk00[r] = 0.f; qk10[r] = 0.f; qk11[r] = 0.f; }
#pragma unroll
        for (int s = 0; s < 8; ++s) {
            const bf16x8_t kA0 = *(const bf16x8_t*)(k0p + 16 * s), kA1 = *(const bf16x8_t*)(k1p + 16 * s), qA0 = *(const bf16x8_t*)(q0p + 16 * s), qA1 = *(const bf16x8_t*)(q1p + 16 * s);
            qk00 = __builtin_amdgcn_mfma_f32_32x32x16_bf16(qA0, kA0, qk00, 0, 0, 0); qk10 = __builtin_amdgcn_mfma_f32_32x32x16_bf16(qA1, kA0, qk10, 0, 0, 0); qk11 = __builtin_amdgcn_mfma_f32_32x32x16_bf16(qA1, kA1, qk11, 0, 0, 0);
        }
#pragma unroll
        for (int r = 0; r < 16; ++r) { const int il = (r & 3) + 8 * (r >> 2) + 4 * hi;
            const float Gi0 = Gs[il], Gi1 = Gs[32 + il];
            GA[il * 64 + r32] = (bf16_t)f2bf((r32 <= il) ? qk00[r] * expf(Gi0 - Gj0) : 0.f);
            GA[(32 + il) * 64 + r32] = (bf16_t)f2bf(qk10[r] * expf(Gi1 - Gj0));
            GA[(32 + il) * 64 + 32 + r32] = (bf16_t)f2bf((r32 <= il) ? qk11[r] * expf(Gi1 - Gj1) : 0.f);
        }
    }
    LDS_WAIT(); asm volatile("" ::: "memory");
    float tr[64];
    int lane2 = lane; asm volatile("" : "+v"(lane2) :: "memory");
#pragma unroll
    for (int j = 0; j < 64; ++j) tr[j] = (j == lane2) ? 1.f : 0.f;
    int atoff = 0;
#pragma unroll
    for (int j = 62; j >= 0; --j) { float c0 = 0.f, c1 = 0.f, c2 = 0.f, c3 = 0.f;
        asm volatile("" : "+v"(atoff) : "v"(tr[j + 1]));
#pragma unroll
        for (int qd = (j + 1) / 4; qd < 16; ++qd) { const f32x4 av = *(const f32x4*)(AT + atoff + j * 64 + 4 * qd);
            if (4 * qd + 0 > j) c0 = fmaf(tr[4 * qd + 0], av.x, c0);
            if (4 * qd + 1 > j) c1 = fmaf(tr[4 * qd + 1], av.y, c1);
            if (4 * qd + 2 > j) c2 = fmaf(tr[4 * qd + 2], av.z, c2);
            if (4 * qd + 3 > j) c3 = fmaf(tr[4 * qd + 3], av.w, c3); }
        tr[j] -= (c0 + c1) + (c2 + c3); asm volatile("" ::: "memory"); }
#pragma unroll
    for (int x = 0; x < 8; ++x) *(v4u*)(GT + lane2 * 64 + x * 8) = pack8(tr + x * 8);
    LDS_WAIT();
}

__device__ __forceinline__ void gdn2_item(const Args& a, int item, unsigned char* lds) {
    const int dvs = item & 3, hv = (item >> 2) & 7, dir = (item >> 5) & 1, b = item >> 6, hq = hv >> 1;
    const int lane0 = threadIdx.x & 63;
    constexpr int BUFB = 57344, O_K = 0, O_Q = 16384, O_T = 32768, O_A = 40960, O_V = 49152;
    float* Gs = (float*)(lds + 2 * BUFB); float* Bs = Gs + 64; float* Es = Bs + 64; float* Ws = Es + 64; float* ot = Ws + 64;
    const LAS unsigned char* ldl = (const LAS unsigned char*)lds;
    const bf16_t* QK = (const bf16_t*)(a.ws + WS_QKV16); const float* ACT = (const float*)(a.ws + WS_ACT); const float* SM = (const float*)(a.ws + WS_SMALL);
    float* O = (float*)(a.ws + (dir ? WS_YB : WS_YF));
    const float Aneg = -expf(a.in[dir ? 21 : 20][hv]); const float dtb = a.in[dir ? 23 : 22][hv];
    const size_t gbase = (size_t)(((b * 8 + hv) * 2 + dir) * 32) * 4096;
    f32x16_t S[4];
#pragma unroll
    for (int nt = 0; nt < 4; ++nt)
#pragma unroll
        for (int r = 0; r < 16; ++r) S[nt][r] = 0.f;
    float gar, gbr;
#define G2_DMA(c_, buf_) do { const int t_ = dir ? SEQ - 1 - (64 * (c_) + lane0) : 64 * (c_) + lane0; const size_t mi_ = (size_t)b * SEQ + t_; \
        const bf16_t* kr_ = QK + mi_ * 2048 + 512 + hq * 128; const bf16_t* qr_ = QK + mi_ * 2048 + hq * 128; \
        const bf16_t* tr_ = (const bf16_t*)(a.ws + WS_GT) + gbase + (size_t)(c_) * 4096 + lane0 * 64; const bf16_t* ar_ = (const bf16_t*)(a.ws + WS_GA) + gbase + (size_t)(c_) * 4096 + lane0 * 64; \
        const float* vr_ = ACT + mi_ * 2048 + 1024 + hv * 128 + dvs * 32; \
        LAS unsigned char* lb_ = (LAS unsigned char*)lds + (buf_) * BUFB; \
        _Pragma("unroll") for (int x = 0; x < 16; ++x) { __builtin_amdgcn_global_load_lds((const unsigned*)(kr_ + 8 * x), (LAS unsigned*)(lb_ + O_K + 1024 * x), 16, 0, 0); \
                                                         __builtin_amdgcn_global_load_lds((const unsigned*)(qr_ + 8 * x), (LAS unsigned*)(lb_ + O_Q + 1024 * x), 16, 0, 0); } \
        _Pragma("unroll") for (int x = 0; x < 8; ++x) { __builtin_amdgcn_global_load_lds((const unsigned*)(tr_ + 8 * x), (LAS unsigned*)(lb_ + O_T + 1024 * x), 16, 0, 0); \
                                                        __builtin_amdgcn_global_load_lds((const unsigned*)(ar_ + 8 * x), (LAS unsigned*)(lb_ + O_A + 1024 * x), 16, 0, 0); \
                                                        __builtin_amdgcn_global_load_lds((const unsigned*)(vr_ + 4 * x), (LAS unsigned*)(lb_ + O_V + 1024 * x), 16, 0, 0); } \
        const float* sm_ = SM + mi_ * 32; gar = sm_[16 + dir * 8 + hv]; gbr = sm_[dir * 8 + hv]; } while (0)
    G2_DMA(0, 0);
    for (int c = 0; c < 32; ++c) {
        int lane = lane0; asm volatile("" : "+v"(lane));
        const int r32 = lane & 31, hi = lane >> 5, trq = (lane & 15) >> 2, trp = lane & 3, trc = (lane >> 4) & 1;
        const int bo = (c & 1) * BUFB;
        float GL;
        {
            const float gi = Aneg * softplus_f(gar + dtb), bi = sigmoid_f(gbr);
            const float G = wave_incl_scan(gi, lane); GL = __shfl(G, 63);
            Gs[lane] = G; Bs[lane] = bi; Es[lane] = __expf(G); Ws[lane] = __expf(GL - G);
        }
        asm volatile("s_waitcnt vmcnt(0)" ::: "memory");
        if (c + 1 < 32) G2_DMA(c + 1, (c + 1) & 1);
        LDS_WAIT();
        f32x16_t KS[2];
#pragma unroll
        for (int rt = 0; rt < 2; ++rt)
#pragma unroll
            for (int r = 0; r < 16; ++r) KS[rt][r] = 0.f;
#define LFRAG(off_) join44(*(const LAS v2u*)(ldl + (off_)), *(const LAS v2u*)(ldl + (off_) + 1024))
#pragma unroll
        for (int nt = 0; nt < 4; ++nt) {
            const bf16x8_t sb0 = acc_frag<0>(S[nt]), sb1 = acc_frag<1>(S[nt]);
#pragma unroll
            for (int rt = 0; rt < 2; ++rt) {
                const int ro = bo + O_K + ((4 * nt) * 64 + 32 * rt + r32) * 16 + 8 * hi;
                KS[rt] = __builtin_amdgcn_mfma_f32_32x32x16_bf16(LFRAG(ro), sb0, KS[rt], 0, 0, 0); KS[rt] = __builtin_amdgcn_mfma_f32_32x32x16_bf16(LFRAG(ro + 2048), sb1, KS[rt], 0, 0, 0);
            }
        }
        asm volatile("" ::: "memory");
        f32x16_t rhs[2];
#pragma unroll
        for (int rt = 0; rt < 2; ++rt)
#pragma unroll
            for (int r = 0; r < 16; ++r) { const int i = 32 * rt + (r & 3) + 8 * (r >> 2) + 4 * hi;
                const float vv = *(const LAS float*)(ldl + bo + O_V + ((r32 >> 2) * 64 + i) * 16 + (r32 & 3) * 4); const float bi = Bs[i];
                rhs[rt][r] = bi * vv - bi * Es[i] * KS[rt][r]; }
        asm volatile("" ::: "memory");
        f32x16_t vn[2];
#pragma unroll
        for (int r = 0; r < 16; ++r) { vn[0][r] = 0.f; vn[1][r] = 0.f; }
        {
            const bf16x8_t rb00 = acc_frag<0>(rhs[0]), rb01 = acc_frag<1>(rhs[0]), rb10 = acc_frag<0>(rhs[1]), rb11 = acc_frag<1>(rhs[1]);
            const int t0 = bo + O_T + r32 * 16 + 8 * hi, t1 = t0 + 512;
            vn[0] = __builtin_amdgcn_mfma_f32_32x32x16_bf16(LFRAG(t0), rb00, vn[0], 0, 0, 0); vn[0] = __builtin_amdgcn_mfma_f32_32x32x16_bf16(LFRAG(t0 + 2048), rb01, vn[0], 0, 0, 0);
            vn[1] = __builtin_amdgcn_mfma_f32_32x32x16_bf16(LFRAG(t1), rb00, vn[1], 0, 0, 0); vn[1] = __builtin_amdgcn_mfma_f32_32x32x16_bf16(LFRAG(t1 + 2048), rb01, vn[1], 0, 0, 0);
            vn[1] = __builtin_amdgcn_mfma_f32_32x32x16_bf16(LFRAG(t1 + 4096), rb10, vn[1], 0, 0, 0); vn[1] = __builtin_amdgcn_mfma_f32_32x32x16_bf16(LFRAG(t1 + 6144), rb11, vn[1], 0, 0, 0);
        }
        asm volatile("" ::: "memory");
        f32x16_t QS[2];
#pragma unroll
        for (int rt = 0; rt < 2; ++rt)
#pragma unroll
            for (int r = 0; r < 16; ++r) QS[rt][r] = 0.f;
#pragma unroll
        for (int nt = 0; nt < 4; ++nt) {
            const bf16x8_t sb0 = acc_frag<0>(S[nt]), sb1 = acc_frag<1>(S[nt]);
#pragma unroll
            for (int rt = 0; rt < 2; ++rt) {
                const int ro = bo + O_Q + ((4 * nt) * 64 + 32 * rt + r32) * 16 + 8 * hi;
                QS[rt] = __builtin_amdgcn_mfma_f32_32x32x16_bf16(LFRAG(ro), sb0, QS[rt], 0, 0, 0); QS[rt] = __builtin_amdgcn_mfma_f32_32x32x16_bf16(LFRAG(ro + 2048), sb1, QS[rt], 0, 0, 0);
            }
        }
        asm volatile("" ::: "memory");
        {
            const bf16x8_t vb00 = acc_frag<0>(vn[0]), vb01 = acc_frag<1>(vn[0]), vb10 = acc_frag<0>(vn[1]), vb11 = acc_frag<1>(vn[1]);
            const int a0 = bo + O_A + r32 * 16 + 8 * hi, a1 = a0 + 512;
            f32x16_t o0, o1;
#pragma unroll
            for (int r = 0; r < 16; ++r) { const int il = (r & 3) + 8 * (r >> 2) + 4 * hi; o0[r] = Es[il] * QS[0][r]; o1[r] = Es[32 + il] * QS[1][r]; }
            o0 = __builtin_amdgcn_mfma_f32_32x32x16_bf16(LFRAG(a0), vb00, o0, 0, 0, 0); o0 = __builtin_amdgcn_mfma_f32_32x32x16_bf16(LFRAG(a0 + 2048), vb01, o0, 0, 0, 0);
            o1 = __builtin_amdgcn_mfma_f32_32x32x16_bf16(LFRAG(a1), vb00, o1, 0, 0, 0); o1 = __builtin_amdgcn_mfma_f32_32x32x16_bf16(LFRAG(a1 + 2048), vb01, o1, 0, 0, 0);
            o1 = __builtin_amdgcn_mfma_f32_32x32x16_bf16(LFRAG(a1 + 4096), vb10, o1, 0, 0, 0); o1 = __builtin_amdgcn_mfma_f32_32x32x16_bf16(LFRAG(a1 + 6144), vb11, o1, 0, 0, 0);
#pragma unroll
            for (int r = 0; r < 16; ++r) { const int il = (r & 3) + 8 * (r >> 2) + 4 * hi; ot[il * 33 + r32] = o0[r]; ot[(32 + il) * 33 + r32] = o1[r]; }
            LDS_WAIT();
            { const int t = dir ? SEQ - 1 - (64 * c + lane) : 64 * c + lane; float* orow = O + ((size_t)b * SEQ + t) * 1024 + hv * 128 + dvs * 32;
#pragma unroll
              for (int x = 0; x < 8; ++x) *(f32x4*)(orow + 4 * x) = (f32x4){ot[lane * 33 + 4 * x], ot[lane * 33 + 4 * x + 1], ot[lane * 33 + 4 * x + 2], ot[lane * 33 + 4 * x + 3]}; }
        }
        asm volatile("" ::: "memory");
        {
#pragma unroll
            for (int r = 0; r < 16; ++r) { const int il = (r & 3) + 8 * (r >> 2) + 4 * hi; vn[0][r] *= Ws[il]; vn[1][r] *= Ws[32 + il]; }
            const bf16x8_t wb[4] = {acc_frag<0>(vn[0]), acc_frag<1>(vn[0]), acc_frag<0>(vn[1]), acc_frag<1>(vn[1])};
            const float eGL = __expf(GL);
#pragma unroll
            for (int nt = 0; nt < 4; ++nt) {
#pragma unroll
                for (int r = 0; r < 16; ++r) S[nt][r] *= eGL;
#pragma unroll
                for (int ks = 0; ks < 4; ++ks) {
                    const int ro = bo + O_K + ((4 * nt + 2 * trc + (trp >> 1)) * 64 + 16 * ks + 4 * hi + trq) * 16 + 8 * (trp & 1);
                    const s16x4_t lo = __builtin_bit_cast(s16x4_t, __builtin_amdgcn_ds_read_tr16_b64_v4i16((LAS s16x4_t*)(ldl + ro)));
                    const s16x4_t hi4 = __builtin_bit_cast(s16x4_t, __builtin_amdgcn_ds_read_tr16_b64_v4i16((LAS s16x4_t*)(ldl + ro + 8 * 16)));
                    const bf16x8_t kf = (bf16x8_t){lo[0], lo[1], lo[2], lo[3], hi4[0], hi4[1], hi4[2], hi4[3]};
                    S[nt] = __builtin_amdgcn_mfma_f32_32x32x16_bf16(kf, wb[ks], S[nt], 0, 0, 0);
                }
            }
        }
        LDS_WAIT();
    }
#undef LFRAG
#undef G2_DMA
}

__device__ __forceinline__ void ssd2_item(const Args& a, int item, unsigned char* lds) {
    const int ps = item & 1, h = (item >> 1) & 15, dir = (item >> 5) & 1, b = item >> 6, g = h >> 3;
    const int lane0 = threadIdx.x & 63;
    constexpr int BUFB = 40960, O_B = 0, O_C = 16384, O_X = 32768, O_XD = 2 * BUFB + 512, O_XW = O_XD + 64 * 72;
    float* Gs = (float*)(lds + 2 * BUFB); float* Es = Gs + 64; float* ot = (float*)(lds + O_XW + 64 * 72);
    const LAS unsigned char* ldl = (const LAS unsigned char*)lds;
    const bf16_t* XB = (const bf16_t*)(a.ws + WS_XBC16); const float* ACT = (const float*)(a.ws + WS_ACT); const float* SM = (const float*)(a.ws + WS_SMALL);
    float* Y = (float*)(a.ws + (dir ? WS_YB : WS_YF));
    const float A = -expf(a.in[dir ? 13 : 12][h]); const float dtb = a.in[dir ? 11 : 10][h];
    f32x16_t H[4];
#pragma unroll
    for (int nt = 0; nt < 4; ++nt)
#pragma unroll
        for (int r = 0; r < 16; ++r) H[nt][r] = 0.f;
    float gdr;
#define S2_DMA(c_, buf_) do { const int t_ = dir ? SEQ - 1 - (64 * (c_) + lane0) : 64 * (c_) + lane0; const size_t mi_ = (size_t)b * SEQ + t_; \
        const bf16_t* br_ = XB + mi_ * 1536 + 1024 + g * 128; const bf16_t* cr_ = XB + mi_ * 1536 + 1280 + g * 128; const float* xr_ = ACT + mi_ * 1536 + h * 64 + ps * 32; \
        LAS unsigned char* lb_ = (LAS unsigned char*)lds + (buf_) * BUFB; \
        _Pragma("unroll") for (int x = 0; x < 16; ++x) { __builtin_amdgcn_global_load_lds((const unsigned*)(br_ + 8 * x), (LAS unsigned*)(lb_ + O_B + 1024 * x), 16, 0, 0); \
                                                         __builtin_amdgcn_global_load_lds((const unsigned*)(cr_ + 8 * x), (LAS unsigned*)(lb_ + O_C + 1024 * x), 16, 0, 0); } \
        _Pragma("unroll") for (int x = 0; x < 8; ++x) __builtin_amdgcn_global_load_lds((const unsigned*)(xr_ + 4 * x), (LAS unsigned*)(lb_ + O_X + 1024 * x), 16, 0, 0); \
        gdr = SM[mi_ * 32 + dir * 16 + h]; } while (0)
    S2_DMA(0, 0);
    for (int c = 0; c < 32; ++c) {
        int lane = lane0; asm volatile("" : "+v"(lane));
        const int r32 = lane & 31, hi = lane >> 5, trq = (lane & 15) >> 2, trp = lane & 3, trc = (lane >> 4) & 1;
        const int bo = (c & 1) * BUFB;
        const float dt = softplus_f(gdr + dtb);
        const float cs = wave_incl_scan(dt * A, lane); const float csL = __shfl(cs, 63);
        Gs[lane] = cs; Es[lane] = __expf(cs);
        asm volatile("s_waitcnt vmcnt(0)" ::: "memory");
        if (c + 1 < 32) S2_DMA(c + 1, (c + 1) & 1);
        {
            const float wsc = dt * __expf(csL - cs);
#pragma unroll
            for (int x = 0; x < 8; ++x) { const f32x4 xv = *(const LAS f32x4*)(ldl + bo + O_X + (x * 64 + lane) * 16);
                v2u d; d.x = cvtpk_rne(xv.x * dt, xv.y * dt); d.y = cvtpk_rne(xv.z * dt, xv.w * dt); *(LAS v2u*)((LAS unsigned char*)lds + O_XD + lane * 72 + 8 * x) = d;
                v2u w; w.x = cvtpk_rne(xv.x * wsc, xv.y * wsc); w.y = cvtpk_rne(xv.z * wsc, xv.w * wsc); *(LAS v2u*)((LAS unsigned char*)lds + O_XW + lane * 72 + 8 * x) = w; }
        }
        LDS_WAIT();
        f32x16_t g00, g01, g11;
#pragma unroll
        for (int r = 0; r < 16; ++r) { g00[r] = 0.f; g01[r] = 0.f; g11[r] = 0.f; }
#pragma unroll
        for (int kk = 0; kk < 8; ++kk) { const int fo = ((2 * kk + hi) * 64 + r32) * 16;
            const bf16x8_t A0 = *(const LAS bf16x8_t*)(ldl + bo + O_B + fo), A1 = *(const LAS bf16x8_t*)(ldl + bo + O_B + fo + 512);
            const bf16x8_t B0 = *(const LAS bf16x8_t*)(ldl + bo + O_C + fo), B1 = *(const LAS bf16x8_t*)(ldl + bo + O_C + fo + 512);
            g00 = __builtin_amdgcn_mfma_f32_32x32x16_bf16(A0, B0, g00, 0, 0, 0); g01 = __builtin_amdgcn_mfma_f32_32x32x16_bf16(A0, B1, g01, 0, 0, 0); g11 = __builtin_amdgcn_mfma_f32_32x32x16_bf16(A1, B1, g11, 0, 0, 0); }
        {   const float cst0 = Gs[r32], cst1 = Gs[32 + r32];
#pragma unroll
            for (int r = 0; r < 16; ++r) { const int il = (r & 3) + 8 * (r >> 2) + 4 * hi; const float css0 = Gs[il], css1 = Gs[32 + il];
                g00[r] = (il <= r32) ? g00[r] * __expf(cst0 - css0) : 0.f; g01[r] = g01[r] * __expf(cst1 - css0); g11[r] = (il <= r32) ? g11[r] * __expf(cst1 - css1) : 0.f; } }
        asm volatile("" ::: "memory");
        f32x16_t y0, y1;
#pragma unroll
        for (int r = 0; r < 16; ++r) { y0[r] = 0.f; y1[r] = 0.f; }
#define TRFRAG(base_) ({ const s16x4_t lo_ = __builtin_bit_cast(s16x4_t, __builtin_amdgcn_ds_read_tr16_b64_v4i16((LAS s16x4_t*)(ldl + (base_)))); \
                         const s16x4_t hi_ = __builtin_bit_cast(s16x4_t, __builtin_amdgcn_ds_read_tr16_b64_v4i16((LAS s16x4_t*)(ldl + (base_) + 8 * 72))); \
                         (bf16x8_t){lo_[0], lo_[1], lo_[2], lo_[3], hi_[0], hi_[1], hi_[2], hi_[3]}; })
        {   const int xo = O_XD + (4 * hi + trq) * 72 + (16 * trc + 4 * trp) * 2;
            const bf16x8_t x0 = TRFRAG(xo), x1 = TRFRAG(xo + 16 * 72), x2 = TRFRAG(xo + 32 * 72), x3 = TRFRAG(xo + 48 * 72);
            y0 = __builtin_amdgcn_mfma_f32_32x32x16_bf16(acc_frag<0>(g00), x0, y0, 0, 0, 0); y0 = __builtin_amdgcn_mfma_f32_32x32x16_bf16(acc_frag<1>(g00), x1, y0, 0, 0, 0);
            y1 = __builtin_amdgcn_mfma_f32_32x32x16_bf16(acc_frag<0>(g01), x0, y1, 0, 0, 0); y1 = __builtin_amdgcn_mfma_f32_32x32x16_bf16(acc_frag<1>(g01), x1, y1, 0, 0, 0);
            y1 = __builtin_amdgcn_mfma_f32_32x32x16_bf16(acc_frag<0>(g11), x2, y1, 0, 0, 0); y1 = __builtin_amdgcn_mfma_f32_32x32x16_bf16(acc_frag<1>(g11), x3, y1, 0, 0, 0); }
        asm volatile("" ::: "memory");
        {   f32x16_t Z0, Z1;
#pragma unroll
            for (int r = 0; r < 16; ++r) { Z0[r] = 0.f; Z1[r] = 0.f; }
#define LFRAG(off_) join44(*(const LAS v2u*)(ldl + (off_)), *(const LAS v2u*)(ldl + (off_) + 1024))
#pragma unroll
            for (int nt = 0; nt < 4; ++nt) { const bf16x8_t hb0 = acc_frag<0>(H[nt]), hb1 = acc_frag<1>(H[nt]);
                const int ro = bo + O_C + ((4 * nt) * 64 + r32) * 16 + 8 * hi;
                Z0 = __builtin_amdgcn_mfma_f32_32x32x16_bf16(LFRAG(ro), hb0, Z0, 0, 0, 0); Z0 = __builtin_amdgcn_mfma_f32_32x32x16_bf16(LFRAG(ro + 2048), hb1, Z0, 0, 0, 0);
                Z1 = __builtin_amdgcn_mfma_f32_32x32x16_bf16(LFRAG(ro + 512), hb0, Z1, 0, 0, 0); Z1 = __builtin_amdgcn_mfma_f32_32x32x16_bf16(LFRAG(ro + 512 + 2048), hb1, Z1, 0, 0, 0); }
#undef LFRAG
#pragma unroll
            for (int r = 0; r < 16; ++r) { const int il = (r & 3) + 8 * (r >> 2) + 4 * hi; ot[il * 33 + r32] = fmaf(Es[il], Z0[r], y0[r]); ot[(32 + il) * 33 + r32] = fmaf(Es[32 + il], Z1[r], y1[r]); } }
        LDS_WAIT();
        { const int t = dir ? SEQ - 1 - (64 * c + lane) : 64 * c + lane; float* yrow = Y + ((size_t)b * SEQ + t) * 1024 + h * 64 + ps * 32;
#pragma unroll
          for (int x = 0; x < 8; ++x) *(f32x4*)(yrow + 4 * x) = (f32x4){ot[lane * 33 + 4 * x], ot[lane * 33 + 4 * x + 1], ot[lane * 33 + 4 * x + 2], ot[lane * 33 + 4 * x + 3]}; }
        asm volatile("" ::: "memory");
        {   const float eL = __expf(csL);
            const int xo = O_XW + (4 * hi + trq) * 72 + (16 * trc + 4 * trp) * 2;
            const bf16x8_t w0 = TRFRAG(xo), w1 = TRFRAG(xo + 16 * 72), w2 = TRFRAG(xo + 32 * 72), w3 = TRFRAG(xo + 48 * 72);
#undef TRFRAG
#pragma unroll
            for (int nt = 0; nt < 4; ++nt) {
#pragma unroll
                for (int r = 0; r < 16; ++r) H[nt][r] *= eL;
#pragma unroll
                for (int ks = 0; ks < 4; ++ks) {
                    const int ro = bo + O_B + ((4 * nt + 2 * trc + (trp >> 1)) * 64 + 16 * ks + 4 * hi + trq) * 16 + 8 * (trp & 1);
                    const s16x4_t lo = __builtin_bit_cast(s16x4_t, __builtin_amdgcn_ds_read_tr16_b64_v4i16((LAS s16x4_t*)(ldl + ro)));
                    const s16x4_t hi4 = __builtin_bit_cast(s16x4_t, __builtin_amdgcn_ds_read_tr16_b64_v4i16((LAS s16x4_t*)(ldl + ro + 8 * 16)));
                    const bf16x8_t bfr = (bf16x8_t){lo[0], lo[1], lo[2], lo[3], hi4[0], hi4[1], hi4[2], hi4[3]};
                    H[nt] = __builtin_amdgcn_mfma_f32_32x32x16_bf16(bfr, ks == 0 ? w0 : ks == 1 ? w1 : ks == 2 ? w2 : w3, H[nt], 0, 0, 0);
                }
            }
        }
        LDS_WAIT();
    }
#undef S2_DMA
}

__device__ __forceinline__ void lru_tile(const Args& a, int item, unsigned char* lds, int pass) {
    const int n = item & 7, tc = (item >> 3) & 63, b = item >> 9, t0 = tc * 32;
    float* xc = (float*)lds; bf16_t* xcb = (bf16_t*)(lds + 16384); float* As = (float*)(lds + 25088); float* Us = As + 2 * 32 * 128; float2* sg = (float2*)(Us + 2 * 32 * 128);
    const int tid = threadIdx.x, lane = tid & 63, wave = tid >> 6;
    const bf16_t* P = (const bf16_t*)(a.ws + WS_PROJ);
    __syncthreads();
    {
        const int j = tid & 127, tg = tid >> 7, chn = n * 128 + j; const float* cw = a.in[25];
        const float w0 = cw[chn], w1 = cw[1024 + chn], w2 = cw[2048 + chn], w3 = cw[3072 + chn], cbias = a.in[26][chn];
        const int tb = t0 + tg * 8;
        const bf16_t* pp = P + ((size_t)b * SEQ + tb) * NINP + C_XL + chn;
        float xm2 = (tb >= 2) ? bf2f(pp[-2 * NINP]) : 0.f, xm1 = (tb >= 1) ? bf2f(pp[-NINP]) : 0.f, x0 = bf2f(pp[0]);
#pragma unroll
        for (int i = 0; i < 8; ++i) { const float xp1 = (tb + i + 1 < SEQ) ? bf2f(pp[(i + 1) * NINP]) : 0.f;
            const float acc = cbias + w0 * xm2 + w1 * xm1 + w2 * x0 + w3 * xp1;
            xc[(tg * 8 + i) * 128 + j] = acc; xcb[(tg * 8 + i) * 136 + j] = (bf16_t)f2bf(acc);
            xm2 = xm1; xm1 = x0; x0 = xp1; }
    }
    __syncthreads();
    {
        const int ct = wave & 3, d = wave >> 2, r32 = lane & 31, hi = lane >> 5;
        const bf16_t* WT = (const bf16_t*)(a.ws + WS_WGT);
        const bf16_t* wa_p = WT + ((size_t)((2 * d) * 8 + n) * 128 + ct * 32 + r32) * 128 + hi * 8;
        const bf16_t* wx_p = WT + ((size_t)((2 * d + 1) * 8 + n) * 128 + ct * 32 + r32) * 128 + hi * 8;
        f32x16_t ca, cx;
#pragma unroll
        for (int r = 0; r < 16; ++r) { ca[r] = 0.f; cx[r] = 0.f; }
#pragma unroll
        for (int s = 0; s < 8; ++s) {
            const bf16x8_t af = *(const bf16x8_t*)((const char*)xcb + r32 * 272 + (s * 16 + hi * 8) * 2);
            const bf16x8_t fa = *(const bf16x8_t*)(wa_p + s * 16); const bf16x8_t fx = *(const bf16x8_t*)(wx_p + s * 16);
            ca = __builtin_amdgcn_mfma_f32_32x32x16_bf16(af, fa, ca, 0, 0, 0); cx = __builtin_amdgcn_mfma_f32_32x32x16_bf16(af, fx, cx, 0, 0, 0);
        }
        const int j = ct * 32 + r32, cj = n * 128 + j;
        const float baj = a.in[d ? 33 : 28][cj], bxj = a.in[d ? 35 : 30][cj], sp = softplus_f(-a.in[d ? 36 : 31][cj]);
#pragma unroll
        for (int r = 0; r < 16; ++r) { const int t = (r & 3) + 8 * (r >> 2) + 4 * hi;
            const float rg = __builtin_amdgcn_rcpf(1.f + __expf(-(ca[r] + baj))), ig = __builtin_amdgcn_rcpf(1.f + __expf(-(cx[r] + bxj))); const float la = -8.f * rg * sp;
            const float av = __expf(la);
            const float om = (la > -0.0625f) ? -2.f * la * (1.f + la * (1.f + la * (0.6666667f + 0.3333333f * la))) : (1.f - av) * (1.f + av);
            As[(d * 32 + t) * 128 + j] = av; Us[(d * 32 + t) * 128 + j] = __builtin_amdgcn_sqrtf(om) * (ig * xc[t * 128 + j]); }
    }
    __syncthreads();
    {
        const int j = tid & 127, d = (tid >> 7) & 1, seg = tid >> 8;
        float Pp = 1.f, H = 0.f;
#pragma unroll
        for (int k = 0; k < 16; ++k) { const int q = seg * 16 + k, t = d ? 31 - q : q; const float a_ = As[(d * 32 + t) * 128 + j], u_ = Us[(d * 32 + t) * 128 + j]; H = fmaf(a_, H, u_); Pp *= a_; }
        sg[(d * 2 + seg) * 128 + j] = make_float2(Pp, H);
        __syncthreads();
        float2* LS = (float2*)(a.ws + WS_LSUM);
        if (pass == 0) {
            if (seg == 0) { const float2 s1 = sg[(d * 2 + 1) * 128 + j]; LS[((size_t)(d * 4 + b) * 64 + tc) * 1024 + n * 128 + j] = make_float2(Pp * s1.x, fmaf(s1.x, H, s1.y)); }
        } else {
            float c = 0.f;
            const float2* lsp = LS + ((size_t)(d * 4 + b) * 64) * 1024 + n * 128 + j;
#pragma unroll 1
            for (int c0 = 0; c0 < 64; c0 += 16) { float2 sv[16];
#pragma unroll
                for (int i = 0; i < 16; ++i) { const int cc = d ? 63 - (c0 + i) : c0 + i; sv[i] = lsp[(size_t)cc * 1024]; }
#pragma unroll
                for (int i = 0; i < 16; ++i) { const int cc = d ? 63 - (c0 + i) : c0 + i; const bool before = d ? (cc > tc) : (cc < tc); if (before) c = fmaf(sv[i].x, c, sv[i].y); } }
            if (seg == 1) { const float2 s0 = sg[(d * 2) * 128 + j]; c = fmaf(s0.x, c, s0.y); }
            float h = c;
#pragma unroll
            for (int k = 0; k < 16; ++k) { const int q = seg * 16 + k, t = d ? 31 - q : q; const float a_ = As[(d * 32 + t) * 128 + j], u_ = Us[(d * 32 + t) * 128 + j]; h = fmaf(a_, h, u_); Us[(d * 32 + t) * 128 + j] = h; }
            __syncthreads();
            bf16_t* YC = (bf16_t*)(a.ws + WS_YCAT);
            const int jj = tid & 127, tg = tid >> 7;
#pragma unroll
            for (int i = 0; i < 8; ++i) { const int t = tg * 8 + i; const size_t row = (size_t)b * SEQ + t0 + t;
                const float hs = Us[t * 128 + jj] + Us[(32 + t) * 128 + jj]; const float gl = bf2f(P[row * NINP + C_GL + n * 128 + jj]);
                YC[row * 2048 + 1024 + n * 128 + jj] = (bf16_t)f2bf(hs * silu_f(gl)); }
        }
    }
}

template <bool FINAL>
__device__ __forceinline__ void lru_wave(const Args& a, int witem, unsigned char* ldsw, int lane) {
    asm volatile("" : "+v"(lane));
    const int n = witem & 7, tc = (witem >> 3) & 63, b = witem >> 9, t0 = tc * 32;
    const int r32 = lane & 31, hi = lane >> 5;
    bf16_t* xcb = (bf16_t*)ldsw;
    const bf16_t* P = (const bf16_t*)(a.ws + WS_PROJ);
    bf16_t* XC = (bf16_t*)(a.ws + WS_XC16) + ((size_t)b * SEQ + t0) * 1024 + n * 128;
    if constexpr (!FINAL) {
        const int chn = n * 128 + 2 * lane; const float* cw = a.in[25];
        const f32x2 w0 = *(const f32x2*)(cw + chn), w1 = *(const f32x2*)(cw + 1024 + chn), w2 = *(const f32x2*)(cw + 2048 + chn), w3 = *(const f32x2*)(cw + 3072 + chn), cb2 = *(const f32x2*)(a.in[26] + chn);
        const bf16_t* pp = P + ((size_t)b * SEQ + t0) * NINP + C_XL + chn;
        f32x2 xm2 = {0.f, 0.f}, xm1 = {0.f, 0.f}, x0;
        if (t0 >= 2) { const unsigned v = *(const unsigned*)(pp - 2 * NINP); xm2 = (f32x2){bf2f(v & 0xffffu), __uint_as_float(v & 0xffff0000u)}; }
        if (t0 >= 1) { const unsigned v = *(const unsigned*)(pp - NINP); xm1 = (f32x2){bf2f(v & 0xffffu), __uint_as_float(v & 0xffff0000u)}; }
        { const unsigned v = *(const unsigned*)pp; x0 = (f32x2){bf2f(v & 0xffffu), __uint_as_float(v & 0xffff0000u)}; }
#pragma unroll 8
        for (int i = 0; i < 32; ++i) { f32x2 xp1 = {0.f, 0.f};
            if (t0 + i + 1 < SEQ) { const unsigned v = *(const unsigned*)(pp + (size_t)(i + 1) * NINP); xp1 = (f32x2){bf2f(v & 0xffffu), __uint_as_float(v & 0xffff0000u)}; }
            const f32x2 acc = cb2 + w0 * xm2 + w1 * xm1 + w2 * x0 + w3 * xp1;
            const unsigned pk = pk2(acc.x, acc.y);
            *(unsigned*)(xcb + i * 136 + 2 * lane) = pk; *(unsigned*)(XC + (size_t)i * 1024 + 2 * lane) = pk;
            xm2 = xm1; xm1 = x0; x0 = xp1; }
        LDS_WAIT();
    }
    const bf16_t* WT = (const bf16_t*)(a.ws + WS_WGT);
    float2* LS = (float2*)(a.ws + WS_LSUM);
    const bf16_t* xcr = XC + (size_t)r32 * 1024 + hi * 8;
#pragma unroll 1
    for (int ct = 0; ct < 4; ++ct) {
    const int j = ct * 32 + r32, cj = n * 128 + j;
    float xv[16];
#pragma unroll
    for (int r = 0; r < 16; ++r) { const int t = (r & 3) + 8 * (r >> 2) + 4 * hi; xv[r] = bf2f(FINAL ? XC[(size_t)t * 1024 + j] : xcb[t * 136 + j]); }
    float hs[16];
#pragma unroll
    for (int d = 0; d < 2; ++d) {
        const bf16_t* wa_p = WT + ((size_t)((2 * d) * 8 + n) * 128 + j) * 128 + hi * 8;
        const bf16_t* wx_p = WT + ((size_t)((2 * d + 1) * 8 + n) * 128 + j) * 128 + hi * 8;
        f32x16_t ca, cx;
#pragma unroll
        for (int r = 0; r < 16; ++r) { ca[r] = 0.f; cx[r] = 0.f; }
#pragma unroll
        for (int s = 0; s < 8; ++s) {
            const bf16x8_t af = FINAL ? *(const bf16x8_t*)(xcr + s * 16) : *(const bf16x8_t*)((const char*)xcb + r32 * 272 + (s * 16 + hi * 8) * 2);
            const bf16x8_t fa = *(const bf16x8_t*)(wa_p + s * 16); const bf16x8_t fx = *(const bf16x8_t*)(wx_p + s * 16);
            ca = __builtin_amdgcn_mfma_f32_32x32x16_bf16(af, fa, ca, 0, 0, 0); cx = __builtin_amdgcn_mfma_f32_32x32x16_bf16(af, fx, cx, 0, 0, 0);
        }
        asm volatile("" ::: "memory");
        const float baj = a.in[d ? 33 : 28][cj], bxj = a.in[d ? 35 : 30][cj], sp = softplus_f(-a.in[d ? 36 : 31][cj]);
        float av[16], uv[16];
#pragma unroll
        for (int r = 0; r < 16; ++r) { const int t = (r & 3) + 8 * (r >> 2) + 4 * hi;
            const float rg = __builtin_amdgcn_rcpf(1.f + __expf(-(ca[r] + baj))), ig = __builtin_amdgcn_rcpf(1.f + __expf(-(cx[r] + bxj))); const float la = -8.f * rg * sp;
            av[r] = __expf(la);
            const float om = (la > -0.0625f) ? -2.f * la * (1.f + la * (1.f + la * (0.6666667f + 0.3333333f * la))) : (1.f - av[r]) * (1.f + av[r]);
            uv[r] = __builtin_amdgcn_sqrtf(om) * (ig * xv[r]); }
        asm volatile("" ::: "memory");
        float Pg[4], Hg[4];
#pragma unroll
        for (int sg = 0; sg < 4; ++sg) { float Pp = 1.f, Hh = 0.f;
#pragma unroll
            for (int e4 = 0; e4 < 4; ++e4) { const int r = 4 * sg + (d ? 3 - e4 : e4); Hh = fmaf(av[r], Hh, uv[r]); Pp *= av[r]; }
            Pg[sg] = Pp; Hg[sg] = Hh; }
        float Po[4], Ho[4];
#pragma unroll
        for (int sg = 0; sg < 4; ++sg) { Po[sg] = __shfl_xor(Pg[sg], 32); Ho[sg] = __shfl_xor(Hg[sg], 32); }
        if constexpr (!FINAL) {
            float Ac = 1.f, Hc = 0.f;
#pragma unroll
            for (int qq = 0; qq < 8; ++qq) { const int q = d ? 7 - qq : qq;
                const bool mine = ((q & 1) == hi); const float pq = mine ? Pg[q >> 1] : Po[q >> 1], hq_ = mine ? Hg[q >> 1] : Ho[q >> 1];
                Hc = fmaf(pq, Hc, hq_); Ac *= pq; }
            if (hi == 0) LS[((size_t)(d * 4 + b) * 64 + tc) * 1024 + cj] = make_float2(Ac, Hc);
        } else {
            float c = 0.f;
            const float2* lsp = LS + ((size_t)(d * 4 + b) * 64) * 1024 + cj;
            const int nneed = d ? 63 - tc : tc;
#pragma unroll 1
            for (int c0 = 0; c0 < nneed; c0 += 16) { float2 sv[16];
#pragma unroll
                for (int i = 0; i < 16; ++i) { const int ci = (c0 + i < nneed) ? c0 + i : nneed - 1; const int cc = d ? 63 - ci : ci; sv[i] = lsp[(size_t)cc * 1024]; }
#pragma unroll
                for (int i = 0; i < 16; ++i) { if (c0 + i < nneed) c = fmaf(sv[i].x, c, sv[i].y); } }
            asm volatile("" ::: "memory");
            float cin[4];
#pragma unroll
            for (int qq = 0; qq < 8; ++qq) { const int q = d ? 7 - qq : qq;
                const bool mine = ((q & 1) == hi); const float pq = mine ? Pg[q >> 1] : Po[q >> 1], hq_ = mine ? Hg[q >> 1] : Ho[q >> 1];
                if (mine) cin[q >> 1] = c;
                c = fmaf(pq, c, hq_); }
#pragma unroll
            for (int sg = 0; sg < 4; ++sg) { float h = cin[sg];
#pragma unroll
                for (int e4 = 0; e4 < 4; ++e4) { const int r = 4 * sg + (d ? 3 - e4 : e4); h = fmaf(av[r], h, uv[r]); hs[r] = (d == 0) ? h : hs[r] + h; } }
        }
    }
    if constexpr (FINAL) {
        bf16_t* YC = (bf16_t*)(a.ws + WS_YCAT);
#pragma unroll
        for (int r = 0; r < 16; ++r) { const int t = (r & 3) + 8 * (r >> 2) + 4 * hi; const size_t row = (size_t)b * SEQ + t0 + t;
            const float gl = bf2f(P[row * NINP + C_GL + cj]);
            YC[row * 2048 + 1024 + cj] = (bf16_t)f2bf(hs[r] * silu_f(gl)); }
    }
    }
    LDS_WAIT();
}

template <int d>
__device__ __forceinline__ void lru_run(const Args& a, int task, int lane) {
    asm volatile("" : "+v"(lane));
    const int run = task & 7, ct = (task >> 4) & 3, n = (task >> 6) & 7, b = task >> 9;
    const int r32 = lane & 31, hi = lane >> 5, j = ct * 32 + r32, cj = n * 128 + j;
    const bf16_t* WT = (const bf16_t*)(a.ws + WS_WGT);
    const bf16_t* wa_p = WT + ((size_t)((2 * d) * 8 + n) * 128 + j) * 128 + hi * 8;
    const bf16_t* wx_p = WT + ((size_t)((2 * d + 1) * 8 + n) * 128 + j) * 128 + hi * 8;
    bf16x8_t fa[8], fx[8];
#pragma unroll
    for (int s = 0; s < 8; ++s) { fa[s] = *(const bf16x8_t*)(wa_p + s * 16); fx[s] = *(const bf16x8_t*)(wx_p + s * 16); }
    const float baj = a.in[d ? 33 : 28][cj], bxj = a.in[d ? 35 : 30][cj], sp = softplus_f(-a.in[d ? 36 : 31][cj]);
    const float2* lsp = (const float2*)(a.ws + WS_LSUM) + ((size_t)(d * 4 + b) * 64) * 1024 + cj;
    bf16_t* HD = (bf16_t*)(a.ws + (d ? WS_HB16 : WS_HF16));
    float c = 0.f;
    { const int nneed = 8 * run;
#pragma unroll 1
      for (int c0 = 0; c0 < nneed; c0 += 8) { float2 sv[8];
#pragma unroll
          for (int i = 0; i < 8; ++i) { const int ci = c0 + i; const int cc = d ? 63 - ci : ci; sv[i] = lsp[(size_t)cc * 1024]; }
#pragma unroll
          for (int i = 0; i < 8; ++i) c = fmaf(sv[i].x, c, sv[i].y); } }
#pragma unroll 1
    for (int k = 0; k < 8; ++k) {
        const int ci = 8 * run + k, tc = d ? 63 - ci : ci, t0 = tc * 32;
        const bf16_t* XC = (const bf16_t*)(a.ws + WS_XC16) + ((size_t)b * SEQ + t0) * 1024 + n * 128;
        const bf16_t* xcr = XC + (size_t)r32 * 1024 + hi * 8;
        f32x16_t ca, cx;
#pragma unroll
        for (int r = 0; r < 16; ++r) { ca[r] = 0.f; cx[r] = 0.f; }
#pragma unroll
        for (int s = 0; s < 8; ++s) { const bf16x8_t af = *(const bf16x8_t*)(xcr + s * 16);
            ca = __builtin_amdgcn_mfma_f32_32x32x16_bf16(af, fa[s], ca, 0, 0, 0); cx = __builtin_amdgcn_mfma_f32_32x32x16_bf16(af, fx[s], cx, 0, 0, 0); }
        float av[16], uv[16];
#pragma unroll
        for (int r = 0; r < 16; ++r) { const int t = (r & 3) + 8 * (r >> 2) + 4 * hi;
            const float xvr = bf2f(XC[(size_t)t * 1024 + j]);
            const float rg = __builtin_amdgcn_rcpf(1.f + __expf(-(ca[r] + baj))), ig = __builtin_amdgcn_rcpf(1.f + __expf(-(cx[r] + bxj))); const float la = -8.f * rg * sp;
            av[r] = __expf(la);
            const float om = (la > -0.0625f) ? -2.f * la * (1.f + la * (1.f + la * (0.6666667f + 0.3333333f * la))) : (1.f - av[r]) * (1.f + av[r]);
            uv[r] = __builtin_amdgcn_sqrtf(om) * (ig * xvr); }
        float Pg[4], Hg[4];
#pragma unroll
        for (int sg = 0; sg < 4; ++sg) { float Pp = 1.f, Hh = 0.f;
#pragma unroll
            for (int e4 = 0; e4 < 4; ++e4) { const int r = 4 * sg + (d ? 3 - e4 : e4); Hh = fmaf(av[r], Hh, uv[r]); Pp *= av[r]; }
            Pg[sg] = Pp; Hg[sg] = Hh; }
        float Po[4], Ho[4];
#pragma unroll
        for (int sg = 0; sg < 4; ++sg) { Po[sg] = __shfl_xor(Pg[sg], 32); Ho[sg] = __shfl_xor(Hg[sg], 32); }
        float cin[4];
#pragma unroll
        for (int qq = 0; qq < 8; ++qq) { const int q = d ? 7 - qq : qq;
            const bool mine = ((q & 1) == hi); const float pq = mine ? Pg[q >> 1] : Po[q >> 1], hq_ = mine ? Hg[q >> 1] : Ho[q >> 1];
            if (mine) cin[q >> 1] = c;
            c = fmaf(pq, c, hq_); }
#pragma unroll
        for (int sg = 0; sg < 4; ++sg) { float h = cin[sg];
#pragma unroll
            for (int e4 = 0; e4 < 4; ++e4) { const int r = 4 * sg + (d ? 3 - e4 : e4); const int t = (r & 3) + 8 * (r >> 2) + 4 * hi;
                h = fmaf(av[r], h, uv[r]); HD[((size_t)b * SEQ + t0 + t) * 1024 + cj] = (bf16_t)f2bf(h); } }
    }
}

__device__ __forceinline__ void combine1_phase(const Args& a, int gw, int NGW, int lane) {
    const float* OF = (const float*)(a.ws + WS_YF); const float* OB = (const float*)(a.ws + WS_YB);
    const bf16_t* P = (const bf16_t*)(a.ws + WS_PROJ); bf16_t* YC = (bf16_t*)(a.ws + WS_YCAT);
    const float* gn = a.in[24];
    for (int m = gw; m < MTOK; m += NGW) {
        const int ch = lane * 16, d0 = ch & 127;
        float z[16], ov[16];
        unpack8(*(const v4u*)(P + (size_t)m * NINP + C_Z + ch), z); unpack8(*(const v4u*)(P + (size_t)m * NINP + C_Z + ch + 8), z + 8);
#pragma unroll
        for (int q = 0; q < 4; ++q) { const f32x4 f = *(const f32x4*)(OF + (size_t)m * 1024 + ch + 4 * q), bk = *(const f32x4*)(OB + (size_t)m * 1024 + ch + 4 * q); const f32x4 o = f + bk;
            ov[4 * q] = o.x; ov[4 * q + 1] = o.y; ov[4 * q + 2] = o.z; ov[4 * q + 3] = o.w; }
        float ss = 0.f;
#pragma unroll
        for (int i = 0; i < 16; ++i) ss += ov[i] * ov[i];
        ss = group_sum<8>(ss);
        const float r = rsqrtf(ss * (1.f / 128.f) + EPS);
#pragma unroll
        for (int i = 0; i < 16; ++i) ov[i] = ov[i] * r * gn[d0 + i] * silu_f(z[i]);
        *(v4u*)(YC + (size_t)m * 2048 + ch) = pack8(ov); *(v4u*)(YC + (size_t)m * 2048 + ch + 8) = pack8(ov + 8);
        { const bf16_t* HF = (const bf16_t*)(a.ws + WS_HF16); const bf16_t* HB = (const bf16_t*)(a.ws + WS_HB16);
          float hf[16], hb[16];
          unpack8(*(const v4u*)(P + (size_t)m * NINP + C_GL + ch), z); unpack8(*(const v4u*)(P + (size_t)m * NINP + C_GL + ch + 8), z + 8);
          unpack8(*(const v4u*)(HF + (size_t)m * 1024 + ch), hf); unpack8(*(const v4u*)(HF + (size_t)m * 1024 + ch + 8), hf + 8);
          unpack8(*(const v4u*)(HB + (size_t)m * 1024 + ch), hb); unpack8(*(const v4u*)(HB + (size_t)m * 1024 + ch + 8), hb + 8);
#pragma unroll
          for (int i = 0; i < 16; ++i) ov[i] = (hf[i] + hb[i]) * silu_f(z[i]);
          *(v4u*)(YC + (size_t)m * 2048 + 1024 + ch) = pack8(ov); *(v4u*)(YC + (size_t)m * 2048 + 1024 + ch + 8) = pack8(ov + 8); }
    }
}

__device__ __forceinline__ void final_norm_phase(const Args& a, int gw, int NGW, int lane) {
    const float* nw = a.in[38];
    for (int m = gw; m < MTOK; m += NGW) {
        f32x4* xr = (f32x4*)(a.out + (size_t)m * 2048) + lane;
        f32x4 v[8]; float s = 0.f;
#pragma unroll
        for (int j = 0; j < 8; ++j) { v[j] = xr[64 * j]; s += (v[j].x * v[j].x + v[j].y * v[j].y) + (v[j].z * v[j].z + v[j].w * v[j].w); }
        const float rstd = rsqrtf(group_sum<64>(s) * (1.f / 2048.f) + EPS);
#pragma unroll
        for (int j = 0; j < 8; ++j) { const f32x4 w = *(const f32x4*)(nw + (64 * j + lane) * 4); xr[64 * j] = v[j] * rstd * w; }
    }
}

typedef GAS unsigned gu32;
#define RLX_AGENT __ATOMIC_RELAXED, __HIP_MEMORY_SCOPE_AGENT
constexpr int CW_BAR = 4096;
constexpr int MISC_OFF = 147456 - 128;
#define XB_TMO      128
#define XB_XCNT(j)  (256  + 64 * (j))
#define XB_XSUB(j)  (1280 + 64 * (j))
#define XB_XGEN(j)  (2304 + 64 * (j))
#define XB_TOP      3328
#define XB_TOPGEN   3392
#define XCD_BAR_WORDS 3456
#define XB_SPIN_CAP (1u << 18)

__device__ __forceinline__ unsigned xb_ld(unsigned* p)              { return __hip_atomic_load(p, __ATOMIC_RELAXED, __HIP_MEMORY_SCOPE_AGENT); }
__device__ __forceinline__ unsigned xb_add(unsigned* p, unsigned v) { return __hip_atomic_fetch_add(p, v, __ATOMIC_RELAXED, __HIP_MEMORY_SCOPE_AGENT); }
__device__ __forceinline__ unsigned xb_xcc_id() { return (unsigned)__builtin_amdgcn_s_getreg((3 << 11) | 20) & 0xFu; }
#define XB_SPIN(cond, bar) do { unsigned _sp = 0; while (cond) { __builtin_amdgcn_s_sleep(1); \
    if ((++_sp & 255u) == 0u) { if (xb_ld(&(bar)[XB_TMO])) break; if (_sp > XB_SPIN_CAP) { atomicAdd(&(bar)[XB_TMO], 1u); break; } } } } while (0)

struct XcdBarrier {
    unsigned* bar; unsigned x;
    volatile LAS unsigned* st;
};

__device__ __forceinline__ XcdBarrier xcd_barrier_post(unsigned* bar, volatile LAS unsigned* st) {
    XcdBarrier b; b.bar = bar; b.x = xb_xcc_id(); b.st = st;
    if (threadIdx.x == 0) (void)xb_add(&bar[XB_XCNT(b.x)], 1u);
    return b;
}
__device__ __forceinline__ void xcd_barrier_complete(unsigned* bar, unsigned x, unsigned& nloc, unsigned& nx) {
    const unsigned G = gridDim.x * gridDim.y * gridDim.z;
    unsigned sum, cnt, mine, sp = 0u;
    for (;;) {
        sum = 0u; cnt = 0u; mine = 0u;
#pragma unroll
        for (unsigned j = 0; j < 16; ++j) { const unsigned c = xb_ld(&bar[XB_XCNT(j)]); sum += c; cnt += (c > 0u) ? 1u : 0u; mine = (j == x) ? c : mine; }
        if (sum == G) break;
        __builtin_amdgcn_s_sleep(1);
        if ((++sp & 255u) == 0u) { if (xb_ld(&bar[XB_TMO])) break; if (sp > XB_SPIN_CAP) { atomicAdd(&bar[XB_TMO], 1u); break; } }
    }
    nloc = mine > 0u ? mine : 1u; nx = cnt > 0u ? cnt : 1u;
}

__device__ __forceinline__ void xcd_barrier(const XcdBarrier& b) {
    asm volatile("s_waitcnt vmcnt(0)" ::: "memory");
    __syncthreads();
    if (threadIdx.x == 0) {
        unsigned* bar = b.bar;
        __builtin_amdgcn_s_waitcnt(0);
        unsigned nloc = b.st[0], nx = b.st[1];
        if (nloc == 0u) { xcd_barrier_complete(bar, b.x, nloc, nx); b.st[0] = nloc; b.st[1] = nx; }
        const unsigned old = xb_add(&bar[XB_XSUB(b.x)], 1u);
        const unsigned gen = old / nloc;
        if (old + 1u == (gen + 1u) * nloc) {
            __builtin_amdgcn_fence(__ATOMIC_RELEASE, "agent");
            asm volatile("s_waitcnt vmcnt(0)" ::: "memory");
            const unsigned og = xb_add(&bar[XB_TOP], 1u);
            const unsigned tg = og / nx;
            if (og + 1u == (tg + 1u) * nx) xb_add(&bar[XB_TOPGEN], 1u);
            else XB_SPIN(xb_ld(&bar[XB_TOPGEN]) == tg, bar);
            __builtin_amdgcn_fence(__ATOMIC_ACQUIRE, "agent");
            xb_add(&bar[XB_XGEN(b.x)], 1u);
            asm volatile("s_waitcnt vmcnt(0)" ::: "memory");
        } else {
            XB_SPIN(xb_ld(&bar[XB_XGEN(b.x)]) == gen, bar);
            __builtin_amdgcn_fence(__ATOMIC_ACQUIRE, "agent");
            asm volatile("s_waitcnt vmcnt(0)" ::: "memory");
        }
    }
    __syncthreads();
}

#ifndef PROBE_MASK
#define PROBE_MASK 0
#endif
#define REP(bit) for (int rep_ = 0; rep_ < 1 + ((PROBE_MASK >> (bit)) & 1); ++rep_)
#ifndef PROBE_SSD
#define PROBE_SSD 0
#endif
#ifndef PROBE_GDN
#define PROBE_GDN 0
#endif
#ifndef PROBE_LRU
#define PROBE_LRU 0
#endif
#ifndef MK_SINGLE
#define MK_SINGLE 1
#endif
__global__ void __launch_bounds__(NTHREADS, 2) mk_fwd(Args a) {
    extern __shared__ __attribute__((aligned(16))) unsigned char lds[];
    LAS unsigned char* ldsl = (LAS unsigned char*)lds;
    const int tid = threadIdx.x, lane = tid & 63, wave = __builtin_amdgcn_readfirstlane(tid >> 6);
    const int G = gridDim.x, bx = blockIdx.x;
    const int vcu = (G % 8 == 0) ? (bx % 8) * (G / 8) + bx / 8 : bx;
    const int gw = vcu * NWAVES + wave, NGW = G * NWAVES;
    unsigned char* ws = a.ws;
    volatile LAS unsigned* MISC = (volatile LAS unsigned*)(ldsl + MISC_OFF);
    if (tid < 32) MISC[tid] = 0u;
    __syncthreads();
    XcdBarrier bar; bar.bar = (unsigned*)(ws + WS_CTL) + CW_BAR; bar.x = 0; bar.st = nullptr;
    if (a.ph_hi - a.ph_lo > 1) bar = xcd_barrier_post((unsigned*)(ws + WS_CTL) + CW_BAR, MISC + 8);
#define IN(k) (a.ph_lo <= (k) && (k) < a.ph_hi)
#define SEAM(k) do { if (IN(k) && IN((k) + 1)) { xcd_barrier(bar); } } while (0)

    if (IN(0)) { p0_prologue(a, ldsl, vcu, G); } SEAM(0);
    if (IN(1)) { REP(0) normmod_phase(a, a.in[0], 0, gw, NGW, lane); } SEAM(1);
    if (IN(2)) {
        pg8::Gemm g{(const bf16_t*)(ws + WS_H), (const bf16_t*)(ws + WS_WIN0), MTOK, NINP, 2048}; pg8::StaticOrder S; S.init(MTOK, NINP, G, bx);
        pg8::EpiProj E{(bf16_t*)(ws + WS_PROJ), (float*)(ws + WS_SMALL), NINP, A_DT / 256};
        REP(1) { pg8::gemm_phase<pg8::EpiProj, pg8::StaticOrder, true, true>(ldsl, g, S, E); __syncthreads(); }
    } SEAM(2);
    if (IN(3)) { REP(0) post0_phase(a, gw, NGW, lane); } SEAM(3);
    if (IN(4)) {
        REP(3) for (int u = vcu; u < 256; u += G) { const int b = u >> 6, h = (u >> 3) & 7, qb = u & 7, kvh = h >> 2; const size_t row0 = (size_t)b * SEQ + qb * 256;
            att::attn_dense_body((const att::bf16*)(ws + WS_QB) + row0 * 1024 + h * 128, (const att::bf16*)(ws + WS_KB) + (size_t)b * SEQ * 256 + kvh * 128,
                                 (const att::bf16*)(ws + WS_VB) + (size_t)b * SEQ * 256 + kvh * 128, (bf16_t*)(ws + WS_YCAT) + row0 * 2048 + h * 128,
                                 (const bf16_t*)(ws + WS_PROJ) + row0 * NINP + A_GA + h * 128, SEQ, (char*)lds);
            __syncthreads(); }
        if (wave == 0) { for (int it = vcu; it < 256; it += G) ssd2_item(a, it, lds); }
        else if (wave <= 4) late_transposes(a, (LAS float*)(ldsl + 100096 + (wave - 1) * 8448), vcu * 4 + (wave - 1), G * 4, lane);
        __syncthreads();
    } SEAM(4);
    if (IN(5)) { REP(0) ssd_combine_phase(a, gw, NGW, lane); } SEAM(5);
    if (IN(6)) {
        pg8::Gemm g{(const bf16_t*)(ws + WS_YCAT), (const bf16_t*)(ws + WS_WOUT0), MTOK, 2048, 2048}; pg8::StaticOrder S; S.init(MTOK, 2048, G, bx);
        pg8::EpiResid E{a.in[0], a.out, (const float*)(ws + WS_MOD), a.in[3]};
        REP(2) { pg8::gemm_phase<pg8::EpiResid, pg8::StaticOrder, true, true>(ldsl, g, S, E); __syncthreads(); }
    } SEAM(6);
    if (IN(7)) { REP(0) normmod_phase(a, a.out, 1, gw, NGW, lane); } SEAM(7);
    if (IN(8)) {
        pg8::Gemm g{(const bf16_t*)(ws + WS_H), (const bf16_t*)(ws + WS_WIN1), MTOK, NINP, 2048}; pg8::StaticOrder S; S.init(MTOK, NINP, G, bx);
        pg8::EpiProj E{(bf16_t*)(ws + WS_PROJ), (float*)(ws + WS_SMALL), NINP, C_SM / 256};
        pg8::gemm_phase<pg8::EpiProj, pg8::StaticOrder, true, true>(ldsl, g, S, E);
    } SEAM(8);
    if (IN(9)) { REP(0) post1_phase(a, gw, NGW, lane); } SEAM(9);
    if (IN(10)) {
        REP(5) { for (int it = gw; it < 2048; it += NGW) gdn1_item(a, it, lds + wave * GDN_LDS_PER_WAVE, lane); __syncthreads(); }
        for (int wi = gw; wi < 2048; wi += NGW) lru_wave<false>(a, wi, lds + wave * GDN_LDS_PER_WAVE, lane);
    } SEAM(10);
    if (IN(11)) {
        if (wave == 0) { REP(6) for (int it = vcu; it < 256; it += G) gdn2_item(a, it, lds); }
        else if (wave <= 3) { REP(7) for (int tk = vcu * 3 + (wave - 1); tk < 2048; tk += G * 3) { if ((tk >> 3) & 1) lru_run<1>(a, tk, lane); else lru_run<0>(a, tk, lane); } }
        __syncthreads();
    } SEAM(11);
    if (IN(12)) { REP(0) combine1_phase(a, gw, NGW, lane); } SEAM(12);
    if (IN(13)) {
        pg8::Gemm g{(const bf16_t*)(ws + WS_YCAT), (const bf16_t*)(ws + WS_WOUT1), MTOK, 2048, 2048}; pg8::StaticOrder S; S.init(MTOK, 2048, G, bx);
        pg8::EpiResid E{a.out, a.out, (const float*)(ws + WS_MOD) + 4 * 6144, a.in[3] + 6144};
        pg8::gemm_phase<pg8::EpiResid, pg8::StaticOrder, true, true>(ldsl, g, S, E);
    } SEAM(13);
    if (IN(14)) { final_norm_phase(a, gw, NGW, lane); }
#undef IN
#undef SEAM
}

extern "C" void kernel_launch(void* const* d_in, const int* in_sizes, int n_in, void* d_out, int out_size, void* d_ws, size_t ws_size, hipStream_t stream) {
    static int grid = 0;
    if (grid == 0) {
        if (n_in != 39 || out_size != MTOK * DM || ws_size < WS_END) { fprintf(stderr, "kernel_launch: unexpected problem (n_in %d, out %d, ws %zu < %zu)\n", n_in, out_size, ws_size, (size_t)WS_END); grid = -1; return; }
        int dev = 0, cus = 0, per_cu = 0;
        if (hipGetDevice(&dev) != hipSuccess || hipDeviceGetAttribute(&cus, hipDeviceAttributeMultiprocessorCount, dev) != hipSuccess) { grid = -1; return; }
        if (hipFuncSetAttribute((const void*)mk_fwd, hipFuncAttributeMaxDynamicSharedMemorySize, LDS_BYTES) != hipSuccess) { fprintf(stderr, "kernel_launch: hipFuncSetAttribute failed\n"); grid = -1; return; }
        if (hipOccupancyMaxActiveBlocksPerMultiprocessor(&per_cu, (const void*)mk_fwd, NTHREADS, LDS_BYTES) != hipSuccess || per_cu < 1) { fprintf(stderr, "kernel_launch: occupancy query says %d\n", per_cu); (void)hipGetLastError(); per_cu = 1; }
        grid = cus;
    }
    if (grid < 0) return;
    (void)hipMemsetAsync((char*)d_ws + WS_CTL, 0, CTL_ZERO_BYTES, stream);
    Args a{};
    for (int i = 0; i < 39; ++i) a.in[i] = (const float*)d_in[i];
    a.out = (float*)d_out; a.ws = (unsigned char*)d_ws;
#if MK_SINGLE
    a.ph_lo = 0; a.ph_hi = NPHASE;
    void* kargs[] = {&a};
    hipError_t e = hipLaunchCooperativeKernel((const void*)mk_fwd, dim3(grid), dim3(NTHREADS), kargs, LDS_BYTES, stream);
    if (e != hipSuccess) fprintf(stderr, "kernel_launch: cooperative launch failed: %s (grid %d)\n", hipGetErrorString(e), grid);
#else
    for (int p = 0; p < NPHASE; ++p) { a.ph_lo = p; a.ph_hi = p + 1; hipLaunchKernelGGL(mk_fwd, dim3(grid), dim3(NTHREADS), LDS_BYTES, stream, a); }
#endif
}
```

```cpp
#include <hip/hip_runtime.h>
#include <hip/hip_cooperative_groups.h>
#include <hip/hip_bf16.h>
#include <cstdio>
#include <cstdint>
namespace cg = cooperative_groups;

constexpr int BATCH = 4, SEQ = 2048, DM = 2048, MTOK = BATCH * SEQ;
constexpr int NIN = 5152, NINP = 5376;
constexpr float EPS = 1e-6f;
constexpr int A_Q = 0, A_K = 1024, A_V = 1280, A_GA = 1536, A_XS = 2560, A_BS = 3584, A_CS = 3840, A_DT = 4096, A_Z = 4128;
constexpr int C_Q = 0, C_K = 512, C_V = 1024, C_SM = 2048, C_Z = 2080, C_XL = 3104, C_GL = 4128;
namespace pg8 {
#define PG8_LAS __attribute__((address_space(3)))
typedef unsigned short bf16_t;
typedef short bf16x8 __attribute__((ext_vector_type(8)));
typedef float f32x4 __attribute__((ext_vector_type(4)));
typedef unsigned u32x4 __attribute__((ext_vector_type(4)));
constexpr int BM = 256, BK = 64, HALF = 128, HTB = HALF * BK * 2  , STAGE_BYTES = 8 * HTB, NXCD = 8, WGM = 8;

__host__ __device__ __forceinline__ int lds_byte(int r, int c) { const int st = (r >> 4) * 2 + (c >> 5), rr = r & 15, cc = c & 31, ob = rr * 64 + cc * 2; return st * 1024 + (ob ^ (((ob >> 9) & 1) << 5)); }
__host__ __device__ __forceinline__ void stage_rc(int b, int& R, int& C) { const int st = b / 1024, sb = b % 1024, swz = sb ^ (((sb >> 9) & 1) << 5); R = (st >> 1) * 16 + swz / 64; C = (st & 1) * 32 + (swz % 64) / 2; }
__host__ __device__ __forceinline__ int perm32(int rho) { const int n = rho >> 4, i = rho & 15; return 8 * (i >> 2) + 4 * n + (i & 3); }

struct Unit { int pm, pn; };
struct Gemm { const bf16_t* A; const bf16_t* Bt; int M, N, K; };

struct StaticOrder {
    int nM, nN, nwg, G, c;
    __host__ __device__ void init(int M, int N, int G_, int c_) { nM = M / BM; nN = N / BM; nwg = nM * nN; G = G_; c = c_; }
    __host__ __device__ bool next(int i, Unit& u) const {
        const long L = (long)i * G + c; if (L >= nwg) return false;
        int wgid = (int)L; { const int q = nwg / NXCD, r = nwg % NXCD, xcd = wgid % NXCD, off = wgid / NXCD; wgid = (xcd < r ? xcd * (q + 1) : r * (q + 1) + (xcd - r) * q) + off; }
        const int nig = WGM * nN, gid = wgid / nig, fm = gid * WGM, gsz = (nM - fm) < WGM ? (nM - fm) : WGM;
        u.pm = fm + ((wgid % nig) % gsz); u.pn = (wgid % nig) / gsz; return true;
    }
    __device__ __forceinline__ void a_ready(const Unit&) const {}
    __device__ __forceinline__ void done(const Unit&) const {}
};

__device__ __forceinline__ unsigned cvt_pk_bf16(float lo, float hi) { unsigned r; asm volatile("v_cvt_pk_bf16_f32 %0, %1, %2" : "=v"(r) : "v"(lo), "v"(hi)); return r; }
typedef float f32x2 __attribute__((ext_vector_type(2)));
struct EpiProj {
    static constexpr bool PERM = true, AFTER_DRAIN = false;
    bf16_t* O; float* small; int ldc; int small_tile;
    __device__ __forceinline__ void operator()(const f32x4 (&acc)[2][2][4][2], const Unit& u, int wr, int wc, int fr, int fq) const {
        const int row0 = u.pm * BM + wr * 64 + fr; const int col0 = u.pn * BM + wc * 32 + 8 * fq;
        const bool sm = (u.pn == small_tile) && (wc == 0);
#pragma unroll
        for (int ai = 0; ai < 2; ++ai)
#pragma unroll
            for (int m = 0; m < 4; ++m) { const int row = row0 + ai * HALF + m * 16; bf16_t* rowp = O + (size_t)row * ldc + col0;
#pragma unroll
                for (int bj = 0; bj < 2; ++bj) { const f32x4 v0 = acc[ai][bj][m][0], v1 = acc[ai][bj][m][1];
                    u32x4 w; w.x = cvt_pk_bf16(v0[0], v0[1]); w.y = cvt_pk_bf16(v0[2], v0[3]); w.z = cvt_pk_bf16(v1[0], v1[1]); w.w = cvt_pk_bf16(v1[2], v1[3]);
                    *(u32x4*)(rowp + bj * HALF) = w; }
                if (sm) { float* sp = small + (size_t)row * 32 + 8 * fq; *(f32x4*)sp = acc[ai][0][m][0]; *(f32x4*)(sp + 4) = acc[ai][0][m][1]; } }
    }
};
struct EpiResid {
    static constexpr bool PERM = false, AFTER_DRAIN = false;
    const float* xin; float* xout; const float* gacc; const float* gbias;
    __device__ __forceinline__ void operator()(const f32x4 (&acc)[2][2][4][2], const Unit& u, int wr, int wc, int fr, int fq) const {
        const int b = u.pm >> 3;
        const int col0 = u.pn * BM + wc * 32 + 4 * fq;
#pragma unroll
        for (int bj = 0; bj < 2; ++bj)
#pragma unroll
            for (int n = 0; n < 2; ++n) { const int col = col0 + bj * HALF + n * 16;
                const f32x4 g = *(const f32x4*)(gacc + (size_t)b * 6144 + 4096 + col) + *(const f32x4*)(gbias + 4096 + col);
#pragma unroll
                for (int ai = 0; ai < 2; ++ai)
#pragma unroll
                    for (int m = 0; m < 4; ++m) { const size_t off = (size_t)(u.pm * BM + ai * HALF + wr * 64 + m * 16 + fr) * 2048 + col;
                        const f32x4 xv = *(const f32x4*)(xin + off); *(f32x4*)(xout + off) = xv + g * acc[ai][bj][m][n]; } }
    }
};
template <class Epi, class Sched, bool ALIGN_EPI = false, bool SP2 = false>
__device__ __forceinline__ void gemm_phase(PG8_LAS unsigned char* lds, const Gemm g, const Sched& S, const Epi& E) {
    const int tid = threadIdx.x, wid = __builtin_amdgcn_readfirstlane(tid >> 6), lane = tid & 63, wr = wid >> 2, wc = wid & 3, fr = lane & 15, fq = lane >> 4;
    const int K = g.K, nt = K / BK;
    unsigned voffA[2], voffB[2];
#pragma unroll
    for (int i = 0; i < 2; ++i) { int R, C; stage_rc(tid * 16 + i * 8192, R, C); const int Rb = Epi::PERM ? ((R & ~31) + perm32(R & 31)) : R;
        voffA[i] = (unsigned)(R * K + C) * 2u; voffB[i] = (unsigned)(Rb * K + C) * 2u; }
    const size_t kstep = (size_t)(BK * 2);
    const size_t hstep = (size_t)HALF * K * 2;
    const size_t tstep = 2 * hstep;
    const unsigned ldsw = (unsigned)wid * 1024u;
    const int aoff = lds_byte(wr * 64 + fr, fq * 8), boff = lds_byte(wc * 32 + fr, fq * 8);
#define PG8_SA(b, h) (((b) * 2 + (h)) * HTB)
#define PG8_SB(b, h) ((4 + (b) * 2 + (h)) * HTB)
#define PG8_STAGE(bufoff, gbase, voff) do { _Pragma("unroll") for (int _i = 0; _i < 2; ++_i) \
        __builtin_amdgcn_global_load_lds((const unsigned*)((const char*)(gbase) + (voff)[_i]), (PG8_LAS unsigned*)(lds + (bufoff) + ldsw + _i * 8192), 16, 0, 0); } while (0)
#define PG8_LDA(dst, b, h) do { _Pragma("unroll") for (int m = 0; m < 4; ++m) _Pragma("unroll") for (int k = 0; k < 2; ++k) dst[m][k] = *(const PG8_LAS bf16x8*)(lds + PG8_SA(b, h) + aoff + m * 2048 + k * 1024); } while (0)
#define PG8_LDB(dst, b, h) do { _Pragma("unroll") for (int n = 0; n < 2; ++n) _Pragma("unroll") for (int k = 0; k < 2; ++k) dst[n][k] = *(const PG8_LAS bf16x8*)(lds + PG8_SB(b, h) + boff + n * 2048 + k * 1024); } while (0)
#define PG8_MMA(ai, bj, At, Bt) do { __builtin_amdgcn_s_setprio(1); _Pragma("unroll") for (int m = 0; m < 4; ++m) _Pragma("unroll") for (int n = 0; n < 2; ++n) _Pragma("unroll") for (int k = 0; k < 2; ++k) \
        acc[ai][bj][m][n] = __builtin_amdgcn_mfma_f32_16x16x32_bf16(Bt[n][k], At[m][k], acc[ai][bj][m][n], 0, 0, 0); __builtin_amdgcn_s_setprio(0); } while (0)
#define PG8_WAIT_V(n) asm volatile("s_waitcnt vmcnt(" #n ")" ::: "memory")
#define PG8_WAIT_L(n) asm volatile("s_waitcnt lgkmcnt(" #n ")" ::: "memory")
#define PG8_BAR __builtin_amdgcn_s_barrier()
#define PG8_SCHED __builtin_amdgcn_sched_barrier(0)
    Unit cur, nxt; int ui = 0;
    if (!S.next(0, cur)) return;
    f32x4 acc[2][2][4][2];
#pragma unroll
    for (int a = 0; a < 2; ++a)
#pragma unroll
        for (int b = 0; b < 2; ++b)
#pragma unroll
            for (int m = 0; m < 4; ++m)
#pragma unroll
                for (int n = 0; n < 2; ++n) acc[a][b][m][n] = (f32x4){0.f, 0.f, 0.f, 0.f};
    bf16x8 At[4][2], B0[2][2], B1[2][2];
    const char* cA = (const char*)g.A + (size_t)cur.pm * tstep; const char* cB = (const char*)g.Bt + (size_t)cur.pn * tstep;
    S.a_ready(cur);
    if constexpr (SP2) {
        PG8_STAGE(PG8_SB(0, 0), cB, voffB); PG8_STAGE(PG8_SB(0, 1), cB + hstep, voffB); PG8_STAGE(PG8_SA(0, 0), cA, voffA); PG8_STAGE(PG8_SA(0, 1), cA + hstep, voffA);
        if (wr == 1) PG8_BAR;
        PG8_WAIT_V(2); PG8_BAR;
        PG8_STAGE(PG8_SB(1, 0), cB + kstep, voffB); PG8_STAGE(PG8_SA(1, 0), cA + kstep, voffA); PG8_STAGE(PG8_SB(1, 1), cB + hstep + kstep, voffB);
        PG8_WAIT_V(6); PG8_BAR;
    } else {
        PG8_STAGE(PG8_SB(0, 0), cB, voffB); PG8_STAGE(PG8_SA(0, 0), cA, voffA); PG8_STAGE(PG8_SB(0, 1), cB + hstep, voffB); PG8_STAGE(PG8_SA(0, 1), cA + hstep, voffA);
        if (wr == 1) PG8_BAR;
        PG8_WAIT_V(4); PG8_BAR;
        PG8_STAGE(PG8_SB(1, 0), cB + kstep, voffB); PG8_STAGE(PG8_SA(1, 0), cA + kstep, voffA); PG8_STAGE(PG8_SB(1, 1), cB + hstep + kstep, voffB);
        PG8_WAIT_V(6); PG8_BAR;
    }
    for (;;) {
        const bool has_next = S.next(ui + 1, nxt);
        const char* nA = has_next ? (const char*)g.A + (size_t)nxt.pm * tstep : cA; const char* nB = has_next ? (const char*)g.Bt + (size_t)nxt.pn * tstep : cB;
        for (int t = 0; t < nt; t += 2) {
            const bool last = (t == nt - 2);
            const char* a1 = cA + (size_t)(t + 1) * kstep;
            const char* a2 = last ? nA : cA + (size_t)(t + 2) * kstep; const char* b2 = last ? nB : cB + (size_t)(t + 2) * kstep;
            const char* a3 = a2 + kstep; const char* b3 = b2 + kstep;
            if (last && has_next) S.a_ready(nxt);
            if constexpr (SP2) {
            PG8_LDB(B0, 0, 0); PG8_LDB(B1, 0, 1); PG8_SCHED; PG8_LDA(At, 0, 0); PG8_STAGE(PG8_SA(1, 1), a1 + hstep, voffA);
            PG8_WAIT_V(8); PG8_WAIT_L(0); PG8_BAR; PG8_MMA(0, 0, At, B0); PG8_MMA(0, 1, At, B1); PG8_BAR; PG8_SCHED;
            PG8_LDA(At, 0, 1); PG8_STAGE(PG8_SB(0, 0), b2, voffB); PG8_STAGE(PG8_SB(0, 1), b2 + hstep, voffB); PG8_STAGE(PG8_SA(0, 0), a2, voffA);
            PG8_WAIT_V(8); PG8_WAIT_L(0); PG8_BAR; PG8_MMA(1, 0, At, B0); PG8_MMA(1, 1, At, B1); PG8_BAR; PG8_SCHED;
            PG8_LDB(B0, 1, 0); PG8_LDB(B1, 1, 1); PG8_SCHED; PG8_LDA(At, 1, 0); PG8_STAGE(PG8_SA(0, 1), a2 + hstep, voffA);
            PG8_WAIT_V(8); PG8_WAIT_L(0); PG8_BAR; PG8_MMA(0, 0, At, B0); PG8_MMA(0, 1, At, B1); PG8_BAR; PG8_SCHED;
            PG8_LDA(At, 1, 1); PG8_STAGE(PG8_SB(1, 0), b3, voffB); PG8_STAGE(PG8_SB(1, 1), b3 + hstep, voffB); PG8_STAGE(PG8_SA(1, 0), a3, voffA);
            PG8_WAIT_V(8); PG8_WAIT_L(0); PG8_BAR; PG8_MMA(1, 0, At, B0); PG8_MMA(1, 1, At, B1); PG8_BAR; PG8_SCHED;
            } else {
            PG8_LDB(B0, 0, 0); PG8_SCHED; PG8_LDA(At, 0, 0); PG8_STAGE(PG8_SA(1, 1), a1 + hstep, voffA);
            PG8_WAIT_L(8); PG8_BAR; PG8_WAIT_L(0); PG8_MMA(0, 0, At, B0); PG8_BAR; PG8_SCHED;
            PG8_LDB(B1, 0, 1); PG8_STAGE(PG8_SB(0, 0), b2, voffB);
            PG8_BAR; PG8_WAIT_L(0); PG8_MMA(0, 1, At, B1); PG8_BAR;
            PG8_LDA(At, 0, 1); PG8_STAGE(PG8_SA(0, 0), a2, voffA);
            PG8_BAR; PG8_WAIT_L(0); PG8_MMA(1, 0, At, B0); PG8_BAR; PG8_SCHED;
            PG8_STAGE(PG8_SB(0, 1), b2 + hstep, voffB);
            PG8_WAIT_V(6); PG8_BAR; PG8_MMA(1, 1, At, B1); PG8_BAR;
            PG8_LDB(B0, 1, 0); PG8_SCHED; PG8_LDA(At, 1, 0); PG8_STAGE(PG8_SA(0, 1), a2 + hstep, voffA);
            PG8_WAIT_L(8); PG8_BAR; PG8_WAIT_L(0); PG8_MMA(0, 0, At, B0); PG8_BAR; PG8_SCHED;
            PG8_LDB(B1, 1, 1); PG8_STAGE(PG8_SB(1, 0), b3, voffB);
            PG8_BAR; PG8_WAIT_L(0); PG8_MMA(0, 1, At, B1); PG8_BAR;
            PG8_LDA(At, 1, 1); PG8_STAGE(PG8_SA(1, 0), a3, voffA);
            PG8_BAR; PG8_WAIT_L(0); PG8_MMA(1, 0, At, B0); PG8_BAR; PG8_SCHED;
            PG8_STAGE(PG8_SB(1, 1), b3 + hstep, voffB);
            PG8_WAIT_V(6); PG8_BAR; PG8_MMA(1, 1, At, B1); PG8_BAR;
            }
        }
        if constexpr (ALIGN_EPI) { if (wr == 0) PG8_BAR; }
        if constexpr (!Epi::AFTER_DRAIN) { E(acc, cur, wr, wc, fr, fq); S.done(cur); }
        if (!has_next) break;
#pragma unroll
        for (int a = 0; a < 2; ++a)
#pragma unroll
            for (int b = 0; b < 2; ++b)
#pragma unroll
                for (int m = 0; m < 4; ++m)
#pragma unroll
                    for (int n = 0; n < 2; ++n) acc[a][b][m][n] = (f32x4){0.f, 0.f, 0.f, 0.f};
        cur = nxt; cA = nA; cB = nB; ++ui;
        if constexpr (ALIGN_EPI) { if (wr == 1) PG8_BAR; }
    }
    PG8_WAIT_V(0);
    if constexpr (!ALIGN_EPI) { if (wr == 0) PG8_BAR; }
    PG8_BAR;
    if constexpr (Epi::AFTER_DRAIN) { E.fused(acc, cur, wr, wc, fr, fq, lds, wid, lane); S.done(cur); }
#undef PG8_SA
#undef PG8_SB
#undef PG8_STAGE
#undef PG8_LDA
#undef PG8_LDB
#undef PG8_MMA
#undef PG8_WAIT_V
#undef PG8_WAIT_L
#undef PG8_BAR
#undef PG8_SCHED
}
}
namespace att {
using bf16 = __hip_bfloat16;
constexpr int   D = 128, NW = 8, QBLK = 32, KVBLK = 64;
constexpr float SCALE = 0.088388347648318440f;
constexpr float THR = 8.f;
constexpr int SDEPTH = 2;
constexpr int LDQ = 1024, LDK = 256, LDY = 2048, LDG = NINP;
constexpr size_t SHM_V = KVBLK * D * 2, SHM_K = KVBLK * D * 2, SHM_ATTN = 2 * SHM_V + 2 * SHM_K + NW * 64 * 4;
using bf16x8 = __attribute__((ext_vector_type(8))) short;
using s16x4  = __attribute__((ext_vector_type(4))) short;
using f32x16 = __attribute__((ext_vector_type(16))) float;
using f32x8  = __attribute__((ext_vector_type(8))) float;
using u32x4  = __attribute__((ext_vector_type(4))) unsigned;
#define KSWZ(row, colB) ((row) * 256 + ((colB) ^ (((row) & 7) << 4)))
#define SBAR() __builtin_amdgcn_sched_barrier(0)
__device__ __forceinline__ int crow(int r, int hi) { return (r & 3) + 8 * (r >> 2) + 4 * hi; }
__device__ __forceinline__ unsigned cvtpk(float lo, float hi) {
  unsigned r; asm volatile("v_cvt_pk_bf16_f32 %0, %1, %2" : "=v"(r) : "v"(lo), "v"(hi)); return r;
}
template <typename TIn> struct Stage;
template <> struct Stage<bf16>  { using T = bf16x8;
  __device__ static __forceinline__ T ld8(const bf16* p) { return *reinterpret_cast<const bf16x8*>(p); }
  __device__ static __forceinline__ bf16x8 tobf(T x) { return x; } };
template <> struct Stage<float> { using T = f32x8;
  __device__ static __forceinline__ T ld8(const float* p) { return *reinterpret_cast<const f32x8*>(p); }
  __device__ static __forceinline__ bf16x8 tobf(T x) {
    u32x4 w = {cvtpk(x[0], x[1]), cvtpk(x[2], x[3]), cvtpk(x[4], x[5]), cvtpk(x[6], x[7])}; return *reinterpret_cast<bf16x8*>(&w); } };

__device__ __forceinline__ void partialSM(f32x16& p0, f32x16& p1, float& m_reg, float& mn, float& alpha) {
  constexpr float C = SCALE * 1.4426950408889634f;
  float pmax = p0[0]; for (int r = 1; r < 16; ++r) pmax = fmaxf(pmax, p0[r]); for (int r = 0; r < 16; ++r) pmax = fmaxf(pmax, p1[r]);
  { auto rr = __builtin_amdgcn_permlane32_swap(__float_as_uint(pmax), __float_as_uint(pmax), false, false);
    pmax = fmaxf(__uint_as_float(rr[0]), __uint_as_float(rr[1])); }
  if (__builtin_expect(__all(pmax - m_reg <= THR / SCALE), 1)) { mn = m_reg; alpha = 1.f; }
  else { mn = fmaxf(m_reg, pmax); alpha = __builtin_amdgcn_exp2f((m_reg - mn) * C); m_reg = mn; }
  float mnC = -mn * C;
  for (int r = 0; r < 16; ++r) p0[r] = fmaf(p0[r], C, mnC); for (int r = 0; r < 16; ++r) p1[r] = fmaf(p1[r], C, mnC);
  for (int r = 0; r < 16; ++r) p0[r] = __builtin_amdgcn_exp2f(p0[r]);
}
__device__ __forceinline__ void finishSM(f32x16& p0, f32x16& p1, float alpha, float& l_reg, bf16x8& pa0, bf16x8& pa1, bf16x8& pa2, bf16x8& pa3) {
  for (int r = 0; r < 16; ++r) p1[r] = __builtin_amdgcn_exp2f(p1[r]);
  float ps = 0; for (int r = 0; r < 16; ++r) ps += p0[r]; for (int r = 0; r < 16; ++r) ps += p1[r];
  { auto rr = __builtin_amdgcn_permlane32_swap(__float_as_uint(ps), __float_as_uint(ps), false, false);
    ps = __uint_as_float(rr[0]) + __uint_as_float(rr[1]); }
  l_reg = l_reg * alpha + ps;
#define PK4(P, BASE, OUT) do { unsigned a0 = cvtpk(P[BASE + 0], P[BASE + 1]), a1 = cvtpk(P[BASE + 2], P[BASE + 3]);   \
    unsigned b0 = cvtpk(P[BASE + 4], P[BASE + 5]), b1 = cvtpk(P[BASE + 6], P[BASE + 7]);                              \
    auto r0 = __builtin_amdgcn_permlane32_swap(a0, b0, false, false); auto r1 = __builtin_amdgcn_permlane32_swap(a1, b1, false, false); \
    u32x4 w = {r0[0], r1[0], r0[1], r1[1]}; OUT = *reinterpret_cast<bf16x8*>(&w); } while (0)
  PK4(p0, 0, pa0); PK4(p0, 8, pa1); PK4(p1, 0, pa2); PK4(p1, 8, pa3);
#undef PK4
}
__device__ __forceinline__ void qkt(f32x16& p0, f32x16& p1, const bf16* Ks, const bf16x8* qr, int r32, int hi) {
  p0 = f32x16{}; p1 = f32x16{};
  for (int d0 = 0; d0 < 8; ++d0) { int cb = (d0 * 16 + hi * 8) * 2;
    bf16x8 b0 = *reinterpret_cast<const bf16x8*>((const char*)Ks + KSWZ(r32, cb));
    bf16x8 b1 = *reinterpret_cast<const bf16x8*>((const char*)Ks + KSWZ(32 + r32, cb));
    p0 = __builtin_amdgcn_mfma_f32_32x32x16_bf16(b0, qr[d0], p0, 0, 0, 0);
    p1 = __builtin_amdgcn_mfma_f32_32x32x16_bf16(b1, qr[d0], p1, 0, 0, 0); }
}
__device__ __forceinline__ int v_st(int k, int c) { const int kk = (k & ~0xC) | ((k & 4) << 1) | ((k & 8) >> 1); return ((kk >> 3) * 4 + (c >> 5)) * 512 + ((kk & 7) * 32 + (c & 31)) * 2; }
__device__ __forceinline__ int v_rd_base(int lane) { return ((lane & 3) << 3) | (((lane >> 2) & 3) << 6) | (((lane >> 4) & 1) << 5) | (((lane >> 5) & 1) << 8); }
constexpr int v_rd_off(int d0, int ks, int half) { return d0 * 512 + ks * 4096 + half * 2048; }
template <int OFF> __device__ __forceinline__ s16x4 tr_read(int vb) {
  s16x4 r; asm volatile("ds_read_b64_tr_b16 %0, %1 offset:%2" : "=&v"(r) : "v"(vb), "i"(OFF) : "memory"); return r;
}
template <int D0> __device__ __forceinline__ void pv_one(f32x16& od, int vb, bf16x8 pa0, bf16x8 pa1, bf16x8 pa2, bf16x8 pa3) {
  const s16x4 l0 = tr_read<v_rd_off(D0, 0, 0)>(vb), h0 = tr_read<v_rd_off(D0, 0, 1)>(vb), l1 = tr_read<v_rd_off(D0, 1, 0)>(vb), h1 = tr_read<v_rd_off(D0, 1, 1)>(vb);
  const s16x4 l2 = tr_read<v_rd_off(D0, 2, 0)>(vb), h2 = tr_read<v_rd_off(D0, 2, 1)>(vb), l3 = tr_read<v_rd_off(D0, 3, 0)>(vb), h3 = tr_read<v_rd_off(D0, 3, 1)>(vb);
  asm volatile("s_waitcnt lgkmcnt(0)" ::: "memory"); SBAR();
#define PK(L, H) (bf16x8){L[0], L[1], L[2], L[3], H[0], H[1], H[2], H[3]}
  od = __builtin_amdgcn_mfma_f32_32x32x16_bf16(pa0, PK(l0, h0), od, 0, 0, 0);
  od = __builtin_amdgcn_mfma_f32_32x32x16_bf16(pa1, PK(l1, h1), od, 0, 0, 0);
  od = __builtin_amdgcn_mfma_f32_32x32x16_bf16(pa2, PK(l2, h2), od, 0, 0, 0);
  od = __builtin_amdgcn_mfma_f32_32x32x16_bf16(pa3, PK(l3, h3), od, 0, 0, 0);
#undef PK
}
__device__ __forceinline__ void pv_d0(f32x16* o, int vb, bf16x8 pa0, bf16x8 pa1, bf16x8 pa2, bf16x8 pa3) {
  pv_one<0>(o[0], vb, pa0, pa1, pa2, pa3); pv_one<1>(o[1], vb, pa0, pa1, pa2, pa3); pv_one<2>(o[2], vb, pa0, pa1, pa2, pa3); pv_one<3>(o[3], vb, pa0, pa1, pa2, pa3);
}
__device__ __forceinline__ void attn_dense_body(const bf16* __restrict__ Qb, const bf16* __restrict__ Kh, const bf16* __restrict__ Vh,
                                                unsigned short* __restrict__ Yb, const unsigned short* __restrict__ Gb, int seq, char* lds) {
  using St = Stage<bf16>; using SQ = Stage<bf16>; using TQ = bf16;
  const int tid = threadIdx.x, wid = tid >> 6, lane = tid & 63, r32 = lane & 31, hi = lane >> 5;
  bf16* V_lds = (bf16*)lds; bf16* K_lds = (bf16*)(lds + 2 * SHM_V);
  float* ws = (float*)(lds + 2 * SHM_V + 2 * SHM_K) + wid * 64; float* li_l = ws; float* al_l = ws + 32;
  float m_reg = -1e30f, l_reg = 0; f32x16 o[4] = {}; bf16x8 qr[8];
  const TQ* Qw = Qb + (long)(wid * QBLK + r32) * LDQ + hi * 8;
#pragma unroll
  for (int d0 = 0; d0 < 8; ++d0) qr[d0] = SQ::tobf(SQ::ld8(Qw + d0 * 16));
  const int sr = tid >> 4, sc = (tid & 15) * 8, vst0 = v_st(sr, sc), vst1 = v_st(32 + sr, sc);
  const int vb0 = (int)(uintptr_t)V_lds + v_rd_base(lane);
  struct { typename St::T vs0, vs1, ks0, ks1; } sr_[SDEPTH];
#define SLOAD(i, k0) do { sr_[i].vs0 = St::ld8(&Vh[(long)((k0) + sr) * LDK + sc]); sr_[i].vs1 = St::ld8(&Vh[(long)((k0) + 32 + sr) * LDK + sc]); \
    sr_[i].ks0 = St::ld8(&Kh[(long)((k0) + sr) * LDK + sc]); sr_[i].ks1 = St::ld8(&Kh[(long)((k0) + 32 + sr) * LDK + sc]); } while (0)
#define SWRITE(b, i) do { *(bf16x8*)((char*)V_lds + (b) * SHM_V + vst0) = St::tobf(sr_[i].vs0);          \
    *(bf16x8*)((char*)V_lds + (b) * SHM_V + vst1) = St::tobf(sr_[i].vs1); int kc = sc * 2;               \
    *(bf16x8*)((char*)K_lds + (b) * SHM_K + KSWZ(sr, kc)) = St::tobf(sr_[i].ks0);                       \
    *(bf16x8*)((char*)K_lds + (b) * SHM_K + KSWZ(32 + sr, kc)) = St::tobf(sr_[i].ks1); } while (0)
#define SWAIT() do { if constexpr (SDEPTH == 2) asm volatile("s_waitcnt vmcnt(4)" ::: "memory"); else asm volatile("s_waitcnt vmcnt(0)" ::: "memory"); } while (0)
#define RESC(a) do { if (__any((a) < 1.f)) { if (hi == 0) al_l[r32] = (a); asm volatile("s_waitcnt lgkmcnt(0)" ::: "memory"); \
    for (int d = 0; d < 4; ++d) for (int r = 0; r < 16; ++r) o[d][r] *= al_l[crow(r, hi)]; } } while (0)
  f32x16 pA0, pA1, pB0, pB1; float mnA, mnB, alA, alB; bf16x8 pa0, pa1, pa2, pa3; const int NT = seq / KVBLK;
  constexpr int SE = 0, SO = SDEPTH - 1;
  SLOAD(SE, 0); asm volatile("s_waitcnt vmcnt(0)" ::: "memory"); SWRITE(0, SE); __syncthreads();
  qkt(pA0, pA1, K_lds, qr, r32, hi); partialSM(pA0, pA1, m_reg, mnA, alA);
  SLOAD(SO, KVBLK); if constexpr (SDEPTH == 2) { if (2 < NT) SLOAD(SE, 2 * KVBLK); }
  SWAIT(); SWRITE(1, SO); __syncthreads();
  for (int j = 1; j + 1 < NT; j += 2) {
    SBAR(); qkt(pB0, pB1, (bf16*)((char*)K_lds + SHM_K), qr, r32, hi);
    finishSM(pA0, pA1, alA, l_reg, pa0, pa1, pa2, pa3); SBAR();
    SLOAD(SO, (j + SDEPTH) * KVBLK); SBAR();
    pv_d0(o, vb0, pa0, pa1, pa2, pa3); partialSM(pB0, pB1, m_reg, mnB, alB);
    __syncthreads(); SWAIT(); SWRITE(0, SE);
    RESC(alB); __syncthreads();
    SBAR(); qkt(pA0, pA1, K_lds, qr, r32, hi);
    finishSM(pB0, pB1, alB, l_reg, pa0, pa1, pa2, pa3); SBAR();
    if (SDEPTH == 1 || j + 3 < NT) SLOAD(SE, (j + 1 + SDEPTH) * KVBLK); SBAR();
    pv_d0(o, vb0 + (int)SHM_V, pa0, pa1, pa2, pa3); partialSM(pA0, pA1, m_reg, mnA, alA);
    __syncthreads(); SWAIT(); SWRITE(1, SO);
    RESC(alA); __syncthreads();
  }
  SBAR(); qkt(pB0, pB1, (bf16*)((char*)K_lds + SHM_K), qr, r32, hi);
  finishSM(pA0, pA1, alA, l_reg, pa0, pa1, pa2, pa3); SBAR();
  pv_d0(o, vb0, pa0, pa1, pa2, pa3); partialSM(pB0, pB1, m_reg, mnB, alB);
  __syncthreads(); RESC(alB);
  finishSM(pB0, pB1, alB, l_reg, pa0, pa1, pa2, pa3); SBAR();
  pv_d0(o, vb0 + (int)SHM_V, pa0, pa1, pa2, pa3);
  if (hi == 0) li_l[r32] = l_reg; asm volatile("s_waitcnt lgkmcnt(0)" ::: "memory");
  float rli[16];
#pragma unroll
  for (int r = 0; r < 16; ++r) rli[r] = __builtin_amdgcn_rcpf(li_l[crow(r, hi)]);
  __syncthreads();
  { int ew = wid; asm volatile("" : "+v"(ew));
    float* stg = (float*)lds + ew * (32 * 132);
#pragma unroll
    for (int r = 0; r < 16; ++r) { const int orow = crow(r, hi);
#pragma unroll
      for (int d0 = 0; d0 < 4; ++d0) stg[orow * 132 + d0 * 32 + r32] = o[d0][r] * rli[r]; }
    asm volatile("s_waitcnt lgkmcnt(0)" ::: "memory");
    int el = lane; asm volatile("" : "+v"(el));
    const unsigned short* Gw0 = Gb + (long)(ew * QBLK) * LDG; unsigned short* Yw0 = Yb + (long)(ew * QBLK) * LDY;
#pragma unroll 2
    for (int i = 0; i < 8; ++i) { const int id = el + 64 * i, row = id >> 4, c8 = id & 15;
      const float* sp = stg + row * 132 + c8 * 8;
      const u32x4 gw = *reinterpret_cast<const u32x4*>(Gw0 + (long)row * LDG + c8 * 8);
      u32x4 ow;
#pragma unroll
      for (int q = 0; q < 4; ++q) { const unsigned gq = (q == 0) ? gw.x : (q == 1) ? gw.y : (q == 2) ? gw.z : gw.w;
        const float g0 = __uint_as_float(gq << 16), g1 = __uint_as_float(gq & 0xffff0000u);
        const float v0 = sp[2 * q] * (g0 / (1.f + __expf(-g0))), v1 = sp[2 * q + 1] * (g1 / (1.f + __expf(-g1)));
        const unsigned pk = cvtpk(v0, v1);
        if (q == 0) ow.x = pk; else if (q == 1) ow.y = pk; else if (q == 2) ow.z = pk; else ow.w = pk; }
      *reinterpret_cast<u32x4*>(Yw0 + (long)row * LDY + c8 * 8) = ow; } }
#undef SLOAD
#undef SWRITE
#undef SWAIT
#undef RESC
}
}
#define GAS __attribute__((address_space(1)))
#define LAS __attribute__((address_space(3)))
typedef unsigned short bf16_t;
typedef unsigned v4u __attribute__((ext_vector_type(4)));
typedef unsigned v2u __attribute__((ext_vector_type(2)));
typedef float f32x4 __attribute__((ext_vector_type(4)));
typedef short bf16x8_t __attribute__((ext_vector_type(8)));
typedef float f32x16_t __attribute__((ext_vector_type(16)));
#define LDS_WAIT() asm volatile("s_waitcnt lgkmcnt(0)" ::: "memory")

constexpr size_t MiB = 1u << 20;
constexpr size_t WS_CTL = 0, CTL_ZERO_BYTES = 1 * MiB;
constexpr size_t WS_MOD = 64 * 1024;
constexpr size_t WS_ROPE = 1 * MiB;
constexpr size_t WS_SMALL = 2 * MiB;
constexpr size_t WS_WIN0 = 3 * MiB, WS_WOUT0 = 24 * MiB;
constexpr size_t WS_QB = 32 * MiB, WS_KB = 48 * MiB, WS_VB = 52 * MiB;
constexpr size_t WS_HB = 3 * MiB;
constexpr size_t WS_WIN1 = 56 * MiB, WS_WOUT1 = 77 * MiB;
constexpr size_t WS_H = 85 * MiB;
constexpr size_t WS_HF = 85 * MiB;
constexpr size_t WS_PROJ = 117 * MiB;
constexpr size_t WS_YCAT = 201 * MiB;
constexpr size_t WS_ACT = 233 * MiB;
constexpr size_t WS_YF = 297 * MiB, WS_YB = 329 * MiB;
constexpr size_t WS_XBC16 = 85 * MiB;
constexpr size_t WS_QKV16 = 3 * MiB;
constexpr size_t WS_XC16 = 35 * MiB;
constexpr size_t WS_GT = 85 * MiB, WS_GA = 101 * MiB;
constexpr size_t WS_WGT = 361 * MiB;
constexpr size_t WS_LSUM = 362 * MiB;
constexpr size_t WS_HF16 = 56 * MiB;
constexpr size_t WS_HB16 = 366 * MiB;
constexpr size_t WS_END = 382 * MiB;

constexpr int NWAVES = 8, NTHREADS = 512;
constexpr int LDS_BYTES = 147456;
constexpr int NPHASE = 15;

struct Args { const float* in[39]; float* out; unsigned char* ws; int ph_lo, ph_hi; };

__device__ __forceinline__ float bf2f(unsigned v) { return __uint_as_float(v << 16); }
__device__ __forceinline__ unsigned f2bf(float f) { unsigned u = __float_as_uint(f); return (u + 0x7fffu + ((u >> 16) & 1u)) >> 16; }
__device__ __forceinline__ unsigned pk2(float lo, float hi) { return f2bf(lo) | (f2bf(hi) << 16); }
__device__ __forceinline__ void unpack8(const v4u w, float* x) {
    x[0] = __uint_as_float(w.x << 16); x[1] = __uint_as_float(w.x & 0xffff0000u); x[2] = __uint_as_float(w.y << 16); x[3] = __uint_as_float(w.y & 0xffff0000u);
    x[4] = __uint_as_float(w.z << 16); x[5] = __uint_as_float(w.z & 0xffff0000u); x[6] = __uint_as_float(w.w << 16); x[7] = __uint_as_float(w.w & 0xffff0000u);
}
__device__ __forceinline__ v4u pack8(const float* x) { v4u w; w.x = pk2(x[0], x[1]); w.y = pk2(x[2], x[3]); w.z = pk2(x[4], x[5]); w.w = pk2(x[6], x[7]); return w; }
__device__ __forceinline__ float silu_f(float x) { return x / (1.f + expf(-x)); }
__device__ __forceinline__ float sigmoid_f(float x) { return 1.f / (1.f + expf(-x)); }
__device__ __forceinline__ float softplus_f(float x) { return fmaxf(x, 0.f) + log1pf(expf(-fabsf(x))); }
template <int CTRL> __device__ __forceinline__ float dpp_mov(float v) { return __builtin_bit_cast(float, __builtin_amdgcn_update_dpp(0, __builtin_bit_cast(int, v), CTRL, 0xF, 0xF, true)); }
template <int N> __device__ __forceinline__ float group_sum(float v) {
    if (N >= 2) v += dpp_mov<0xB1>(v);
    if (N >= 4) v += dpp_mov<0x4E>(v);
    if (N >= 8) v += dpp_mov<0x141>(v);
    if (N >= 16) v += dpp_mov<0x140>(v);
    if (N >= 32) v += __shfl_xor(v, 16);
    if (N >= 64) v += __shfl_xor(v, 32);
    return v;
}

__device__ __forceinline__ void p0_transpose_item(const float* W, int K, int N, bf16_t* WT, int row_off, LAS float* scr, int item, int lane) {
    const int nblk = N / 32, kb = item / nblk, nb = item % nblk, k0 = 64 * kb, n0 = 32 * nb;
#pragma unroll 8
    for (int i = 0; i < 32; ++i) { const int kk = 2 * i + (lane >> 5); scr[kk * 33 + (lane & 31)] = W[(size_t)(k0 + kk) * N + n0 + (lane & 31)]; }
    LDS_WAIT(); asm volatile("" ::: "memory");
    const int c = lane & 7;
#pragma unroll
    for (int j = 0; j < 4; ++j) { const int n = (lane >> 3) + 8 * j; const LAS float* s = scr + (8 * c) * 33 + n;
        v4u o; o.x = pk2(s[0 * 33], s[1 * 33]); o.y = pk2(s[2 * 33], s[3 * 33]); o.z = pk2(s[4 * 33], s[5 * 33]); o.w = pk2(s[6 * 33], s[7 * 33]);
        *(v4u*)(WT + (size_t)(row_off + n0 + n) * K + k0 + 8 * c) = o; }
    LDS_WAIT(); asm volatile("" ::: "memory");
}

__device__ __forceinline__ void p0_prologue(const Args& a, LAS unsigned char* lds, int vcu, int G) {
    const int tid = threadIdx.x, lane = tid & 63, wave = tid >> 6;
    unsigned char* ws = a.ws;
    { const int gid = blockIdx.x * NTHREADS + tid;
      if (gid < 2048) { const int pos = gid >> 5, i = gid & 31; const float freq = expf(-(float)i * (1.f / 32.f) * 9.210340371976184f); const float ang = (float)pos * freq;
          float* rt = (float*)(ws + WS_ROPE); rt[2 * gid] = cosf(ang); rt[2 * gid + 1] = sinf(ang); } }
    { const int gid = blockIdx.x * NTHREADS + tid, gn = G * NTHREADS; constexpr int NV = (NINP - NIN) * 2048 * 2 / 16;
      v4u* p0 = (v4u*)(ws + WS_WIN0 + (size_t)NIN * 2048 * 2); v4u* p1 = (v4u*)(ws + WS_WIN1 + (size_t)NIN * 2048 * 2);
      for (int i = gid; i < NV; i += gn) { p0[i] = (v4u){0, 0, 0, 0}; p1[i] = (v4u){0, 0, 0, 0}; } }
    if (blockIdx.x < 192) {
        const int it = blockIdx.x, l = it / 96, r = it % 96, kc = r / 3, nc = r % 3;
        LAS float* cond = (LAS float*)lds;
        if (tid < 256) { const int b = tid >> 6, k = tid & 63; const float c = a.in[1][b * 2048 + kc * 64 + k]; cond[tid] = silu_f(c); }
        __syncthreads();
        const float* W = a.in[2] + (size_t)l * 2048 * 6144 + (size_t)(kc * 64) * 6144 + nc * 2048 + tid * 4;
        f32x4 acc0 = {0, 0, 0, 0}, acc1 = acc0, acc2 = acc0, acc3 = acc0;
#pragma unroll 8
        for (int k = 0; k < 64; ++k) { const f32x4 w = *(const f32x4*)(W + (size_t)k * 6144);
            acc0 += cond[k] * w; acc1 += cond[64 + k] * w; acc2 += cond[128 + k] * w; acc3 += cond[192 + k] * w; }
        float* macc = (float*)(ws + WS_MOD) + (size_t)l * 4 * 6144 + nc * 2048 + tid * 4;
#pragma unroll
        for (int i = 0; i < 4; ++i) { atomicAdd(macc + i, acc0[i]); atomicAdd(macc + 6144 + i, acc1[i]); atomicAdd(macc + 2 * 6144 + i, acc2[i]); atomicAdd(macc + 3 * 6144 + i, acc3[i]); }
        __syncthreads();
    }
    { LAS float* scr = (LAS float*)(lds + wave * 16384);
      const int gw = vcu * NWAVES + wave, NGW = G * NWAVES;
      constexpr int I_IN = 32 * (NIN / 32), I_OUT = 32 * 64, NITEMS = I_IN + I_OUT;
      for (int it = gw; it < NITEMS; it += NGW) {
          int r = it;
          if (r < I_IN) { p0_transpose_item(a.in[5], 2048, NIN, (bf16_t*)(ws + WS_WIN0), 0, scr, r, lane); continue; } r -= I_IN;
          p0_transpose_item(a.in[16], 2048, 2048, (bf16_t*)(ws + WS_WOUT0), 0, scr, r, lane);
      } }
}
__device__ __forceinline__ void late_transposes(const Args& a, LAS float* scr, int hw, int NHW, int lane) {
    unsigned char* ws = a.ws;
    constexpr int I_IN = 32 * (NIN / 32), I_OUT = 32 * 64, I_G = 32 * 8, NITEMS = I_IN + I_OUT + I_G;
    for (int it = hw; it < NITEMS; it += NHW) {
        int r = it;
        if (r < I_G) { const int mn = r >> 3, m = mn >> 3; const float* Wg = a.in[m == 0 ? 27 : m == 1 ? 29 : m == 2 ? 32 : 34] + (size_t)(mn & 7) * 128 * 128;
            p0_transpose_item(Wg, 128, 128, (bf16_t*)(ws + WS_WGT) + (size_t)mn * 128 * 128, 0, scr, r & 7, lane); continue; } r -= I_G;
        if (r < I_IN) { p0_transpose_item(a.in[17], 2048, NIN, (bf16_t*)(ws + WS_WIN1), 0, scr, r, lane); continue; } r -= I_IN;
        p0_transpose_item(a.in[37], 2048, 2048, (bf16_t*)(ws + WS_WOUT1), 0, scr, r, lane);
    }
}

__device__ __forceinline__ void normmod_phase(const Args& a, const float* xin, int layer, int gw, int NGW, int lane) {
    const float* nw = a.in[4] + layer * 2048; const float* bm = a.in[3] + layer * 6144;
    const float* macc = (const float*)(a.ws + WS_MOD) + (size_t)layer * 4 * 6144;
    bf16_t* H = (bf16_t*)(a.ws + WS_H);
    for (int m = gw; m < MTOK; m += NGW) {
        const int b = m >> 11;
        const f32x4* xr = (const f32x4*)(xin + (size_t)m * 2048) + lane;
        f32x4 v[8]; float s = 0.f;
#pragma unroll
        for (int j = 0; j < 8; ++j) { v[j] = xr[64 * j]; s += (v[j].x * v[j].x + v[j].y * v[j].y) + (v[j].z * v[j].z + v[j].w * v[j].w); }
        const float rstd = rsqrtf(group_sum<64>(s) * (1.f / 2048.f) + EPS);
#pragma unroll
        for (int j = 0; j < 8; ++j) { const int col = (64 * j + lane) * 4;
            const f32x4 w = *(const f32x4*)(nw + col);
            const f32x4 sh = *(const f32x4*)(macc + b * 6144 + col) + *(const f32x4*)(bm + col);
            const f32x4 sc = *(const f32x4*)(macc + b * 6144 + 2048 + col) + *(const f32x4*)(bm + 2048 + col);
            const f32x4 o = v[j] * rstd * w * (1.f + sc) + sh;
            v2u pk; pk.x = pk2(o.x, o.y); pk.y = pk2(o.z, o.w);
            *(v2u*)(H + (size_t)m * 2048 + col) = pk; }
    }
}

__device__ __forceinline__ void post0_phase(const Args& a, int gw, int NGW, int lane) {
    const bf16_t* P = (const bf16_t*)(a.ws + WS_PROJ);
    const float2* rope = (const float2*)(a.ws + WS_ROPE);
    const float* qn = a.in[6]; const float* kn = a.in[7]; const float* cw = a.in[8]; const float* cb = a.in[9];
    bf16_t* Q = (bf16_t*)(a.ws + WS_QB); bf16_t* K = (bf16_t*)(a.ws + WS_KB); bf16_t* V = (bf16_t*)(a.ws + WS_VB);
    float* ACT = (float*)(a.ws + WS_ACT);
    for (int m = gw; m < MTOK; m += NGW) {
        const int t = m & 2047, prow = t >> 6, pcol = t & 63;
        const bf16_t* pr = P + (size_t)m * NINP;
        {
            float x[16]; unpack8(*(const v4u*)(pr + A_Q + lane * 16), x); unpack8(*(const v4u*)(pr + A_Q + lane * 16 + 8), x + 8);
            float ss = 0.f;
#pragma unroll
            for (int i = 0; i < 16; ++i) ss += x[i] * x[i];
            ss = group_sum<8>(ss);
            const float r = rsqrtf(ss * (1.f / 128.f) + EPS);
            const int d0 = (lane & 7) * 16;
#pragma unroll
            for (int i = 0; i < 16; ++i) x[i] = x[i] * r * qn[d0 + i];
#pragma unroll
            for (int pi = 0; pi < 8; ++pi) { const int p = (d0 >> 1) + pi; const float2 cs = (p < 32) ? rope[prow * 32 + p] : rope[pcol * 32 + p - 32];
                const float x0 = x[2 * pi], x1 = x[2 * pi + 1]; x[2 * pi] = x0 * cs.x - x1 * cs.y; x[2 * pi + 1] = x0 * cs.y + x1 * cs.x; }
            *(v4u*)(Q + (size_t)m * 1024 + lane * 16) = pack8(x); *(v4u*)(Q + (size_t)m * 1024 + lane * 16 + 8) = pack8(x + 8);
        }
        {
            const v2u w = *(const v2u*)(pr + A_K + lane * 4);
            float x[4] = {__uint_as_float(w.x << 16), __uint_as_float(w.x & 0xffff0000u), __uint_as_float(w.y << 16), __uint_as_float(w.y & 0xffff0000u)};
            float ss = (x[0] * x[0] + x[1] * x[1]) + (x[2] * x[2] + x[3] * x[3]);
            ss = group_sum<32>(ss);
            const float r = rsqrtf(ss * (1.f / 128.f) + EPS);
            const int d0 = (lane & 31) * 4;
#pragma unroll
            for (int i = 0; i < 4; ++i) x[i] = x[i] * r * kn[d0 + i];
#pragma unroll
            for (int pi = 0; pi < 2; ++pi) { const int p = (d0 >> 1) + pi; const float2 cs = (p < 32) ? rope[prow * 32 + p] : rope[pcol * 32 + p - 32];
                const float x0 = x[2 * pi], x1 = x[2 * pi + 1]; x[2 * pi] = x0 * cs.x - x1 * cs.y; x[2 * pi + 1] = x0 * cs.y + x1 * cs.x; }
            v2u o; o.x = pk2(x[0], x[1]); o.y = pk2(x[2], x[3]);
            *(v2u*)(K + (size_t)m * 256 + lane * 4) = o;
            *(v2u*)(V + (size_t)m * 256 + lane * 4) = *(const v2u*)(pr + A_V + lane * 4);
        }
#pragma unroll
        for (int j = 0; j < 3; ++j) { const int ch = (j * 64 + lane) * 8;
            float acc[8];
            { const f32x4 b0 = *(const f32x4*)(cb + ch), b1 = *(const f32x4*)(cb + ch + 4); acc[0] = b0.x; acc[1] = b0.y; acc[2] = b0.z; acc[3] = b0.w; acc[4] = b1.x; acc[5] = b1.y; acc[6] = b1.z; acc[7] = b1.w; }
#pragma unroll
            for (int d = 0; d < 4; ++d) { const int ts = t + d - 2;
                if (ts >= 0 && ts < SEQ) { float x[8]; unpack8(*(const v4u*)(P + (size_t)(m + d - 2) * NINP + A_XS + ch), x);
                    const f32x4 w0 = *(const f32x4*)(cw + d * 1536 + ch), w1 = *(const f32x4*)(cw + d * 1536 + ch + 4);
                    acc[0] += w0.x * x[0]; acc[1] += w0.y * x[1]; acc[2] += w0.z * x[2]; acc[3] += w0.w * x[3];
                    acc[4] += w1.x * x[4]; acc[5] += w1.y * x[5]; acc[6] += w1.z * x[6]; acc[7] += w1.w * x[7]; } }
            f32x4 o0, o1; o0.x = silu_f(acc[0]); o0.y = silu_f(acc[1]); o0.z = silu_f(acc[2]); o0.w = silu_f(acc[3]); o1.x = silu_f(acc[4]); o1.y = silu_f(acc[5]); o1.z = silu_f(acc[6]); o1.w = silu_f(acc[7]);
            *(f32x4*)(ACT + (size_t)m * 1536 + ch) = o0; *(f32x4*)(ACT + (size_t)m * 1536 + ch + 4) = o1;
            { v4u w; w.x = pk2(o0.x, o0.y); w.y = pk2(o0.z, o0.w); w.z = pk2(o1.x, o1.y); w.w = pk2(o1.z, o1.w); *(v4u*)((bf16_t*)(a.ws + WS_XBC16) + (size_t)m * 1536 + ch) = w; } }
    }
}

typedef float f32x2 __attribute__((ext_vector_type(2)));
__device__ __forceinline__ void ssd_combine_phase(const Args& a, int gw, int NGW, int lane) {
    const float* YF = (const float*)(a.ws + WS_YF); const float* YB = (const float*)(a.ws + WS_YB); const float* ACT = (const float*)(a.ws + WS_ACT);
    const bf16_t* P = (const bf16_t*)(a.ws + WS_PROJ); bf16_t* YC = (bf16_t*)(a.ws + WS_YCAT);
    const float* dsk = a.in[14]; const float* nw = a.in[15];
    for (int m = gw; m < MTOK; m += NGW) {
        const int ch = lane * 16; const float dk = dsk[ch >> 6];
        float z[16], gv[16]; unpack8(*(const v4u*)(P + (size_t)m * NINP + A_Z + ch), z); unpack8(*(const v4u*)(P + (size_t)m * NINP + A_Z + ch + 8), z + 8);
        float ss = 0.f;
#pragma unroll
        for (int q = 0; q < 4; ++q) { const f32x4 f = *(const f32x4*)(YF + (size_t)m * 1024 + ch + 4 * q), bk = *(const f32x4*)(YB + (size_t)m * 1024 + ch + 4 * q), xv = *(const f32x4*)(ACT + (size_t)m * 1536 + ch + 4 * q);
            const f32x4 y = f + bk + dk * xv;
            gv[4 * q] = y.x * silu_f(z[4 * q]); gv[4 * q + 1] = y.y * silu_f(z[4 * q + 1]); gv[4 * q + 2] = y.z * silu_f(z[4 * q + 2]); gv[4 * q + 3] = y.w * silu_f(z[4 * q + 3]); }
#pragma unroll
        for (int i = 0; i < 16; ++i) ss += gv[i] * gv[i];
        const float r = rsqrtf(group_sum<64>(ss) * (1.f / 1024.f) + EPS);
#pragma unroll
        for (int i = 0; i < 16; ++i) gv[i] = gv[i] * r * nw[ch + i];
        *(v4u*)(YC + (size_t)m * 2048 + 1024 + ch) = pack8(gv); *(v4u*)(YC + (size_t)m * 2048 + 1024 + ch + 8) = pack8(gv + 8);
    }
}

__device__ __forceinline__ void post1_phase(const Args& a, int gw, int NGW, int lane) {
    const bf16_t* P = (const bf16_t*)(a.ws + WS_PROJ); const float* cw = a.in[18]; const float* cb = a.in[19];
    float* ACT = (float*)(a.ws + WS_ACT);
    for (int m = gw; m < MTOK; m += NGW) {
        const int t = m & 2047;
#pragma unroll
        for (int j = 0; j < 4; ++j) { const int ch = (j * 64 + lane) * 8;
            float acc[8];
            { const f32x4 b0 = *(const f32x4*)(cb + ch), b1 = *(const f32x4*)(cb + ch + 4); acc[0] = b0.x; acc[1] = b0.y; acc[2] = b0.z; acc[3] = b0.w; acc[4] = b1.x; acc[5] = b1.y; acc[6] = b1.z; acc[7] = b1.w; }
#pragma unroll
            for (int d = 0; d < 4; ++d) { const int ts = t + d - 2;
                if (ts >= 0 && ts < SEQ) { float x[8]; unpack8(*(const v4u*)(P + (size_t)(m + d - 2) * NINP + C_Q + ch), x);
                    const f32x4 w0 = *(const f32x4*)(cw + d * 2048 + ch), w1 = *(const f32x4*)(cw + d * 2048 + ch + 4);
                    acc[0] += w0.x * x[0]; acc[1] += w0.y * x[1]; acc[2] += w0.z * x[2]; acc[3] += w0.w * x[3];
                    acc[4] += w1.x * x[4]; acc[5] += w1.y * x[5]; acc[6] += w1.z * x[6]; acc[7] += w1.w * x[7]; } }
#pragma unroll
            for (int i = 0; i < 8; ++i) acc[i] = silu_f(acc[i]);
            if (j < 2) {
                float ss = 0.f;
#pragma unroll
                for (int i = 0; i < 8; ++i) ss += acc[i] * acc[i];
                ss = group_sum<16>(ss);
                float r = rsqrtf(ss + EPS); if (j == 0) r *= 0.088388347648318440f;
#pragma unroll
                for (int i = 0; i < 8; ++i) acc[i] *= r;
            }
            *(f32x4*)(ACT + (size_t)m * 2048 + ch) = (f32x4){acc[0], acc[1], acc[2], acc[3]}; *(f32x4*)(ACT + (size_t)m * 2048 + ch + 4) = (f32x4){acc[4], acc[5], acc[6], acc[7]};
            *(v4u*)((bf16_t*)(a.ws + WS_QKV16) + (size_t)m * 2048 + ch) = pack8(acc); }
    }
}

typedef short s16x4_t __attribute__((ext_vector_type(4)));
typedef __bf16 bf16x2_v __attribute__((ext_vector_type(2)));
__device__ __forceinline__ unsigned cvtpk_rne(float lo, float hi) { f32x2 v = {lo, hi}; bf16x2_v bb = __builtin_convertvector(v, bf16x2_v); return __builtin_bit_cast(unsigned, bb); }
template <int S_> __device__ __forceinline__ bf16x8_t acc_frag(const f32x16_t& x) {
    v4u w; w.x = cvtpk_rne(x[8 * S_ + 0], x[8 * S_ + 1]); w.y = cvtpk_rne(x[8 * S_ + 2], x[8 * S_ + 3]); w.z = cvtpk_rne(x[8 * S_ + 4], x[8 * S_ + 5]); w.w = cvtpk_rne(x[8 * S_ + 6], x[8 * S_ + 7]);
    return __builtin_bit_cast(bf16x8_t, w);
}
__device__ __forceinline__ bf16x8_t join44(v2u lo, v2u hi) { v4u w; w.x = lo.x; w.y = lo.y; w.z = hi.x; w.w = hi.y; return __builtin_bit_cast(bf16x8_t, w); }
__device__ __forceinline__ float wave_incl_scan(float v, int lane) {
#pragma unroll
    for (int o = 1; o < 64; o <<= 1) { const float t = __shfl_up(v, o); if (lane >= o) v += t; }
    return v;
}
constexpr int GDN_LDS_PER_WAVE = 17920;
__device__ __forceinline__ void gdn1_item(const Args& a, int item, unsigned char* ldsw, int lane) {
    asm volatile("" : "+v"(lane));
    const int c = item & 31, dir = (item >> 5) & 1, hv = (item >> 6) & 7, b = item >> 9, hq = hv >> 1;
    const int r32 = lane & 31, hi = lane >> 5;
    float* AT = (float*)ldsw; float* Gs = AT + 64 * 64; float* Bs = Gs + 64;
    const bf16_t* QK = (const bf16_t*)(a.ws + WS_QKV16); const float* SM = (const float*)(a.ws + WS_SMALL);
    bf16_t* GT = (bf16_t*)(a.ws + WS_GT) + (size_t)item * 4096; bf16_t* GA = (bf16_t*)(a.ws + WS_GA) + (size_t)item * 4096;
    const float Aneg = -expf(a.in[dir ? 21 : 20][hv]); const float dtb = a.in[dir ? 23 : 22][hv];
    {
        const int t = dir ? SEQ - 1 - (64 * c + lane) : 64 * c + lane; const float* sm = SM + ((size_t)b * SEQ + t) * 32;
        const float gi = Aneg * softplus_f(sm[16 + dir * 8 + hv] + dtb), bi = sigmoid_f(sm[dir * 8 + hv]);
        Gs[lane] = wave_incl_scan(gi, lane); Bs[lane] = bi;
    }
    const int t0r = dir ? SEQ - 1 - (64 * c + r32) : 64 * c + r32, t1r = dir ? t0r - 32 : t0r + 32;
    const bf16_t* k0p = QK + ((size_t)b * SEQ + t0r) * 2048 + 512 + hq * 128 + hi * 8; const bf16_t* k1p = QK + ((size_t)b * SEQ + t1r) * 2048 + 512 + hq * 128 + hi * 8;
    const bf16_t* q0p = k0p - 512, * q1p = k1p - 512;
    LDS_WAIT();
    const float Gj0 = Gs[r32], Gj1 = Gs[32 + r32];
    {
        f32x16_t kk00, kk10, kk11;
#pragma unroll
        for (int r = 0; r < 16; ++r) { kk00[r] = 0.f; kk10[r] = 0.f; kk11[r] = 0.f; }
#pragma unroll
        for (int s = 0; s < 8; ++s) {
            const bf16x8_t kA0 = *(const bf16x8_t*)(k0p + 16 * s), kA1 = *(const bf16x8_t*)(k1p + 16 * s);
            kk00 = __builtin_amdgcn_mfma_f32_32x32x16_bf16(kA0, kA0, kk00, 0, 0, 0); kk10 = __builtin_amdgcn_mfma_f32_32x32x16_bf16(kA1, kA0, kk10, 0, 0, 0); kk11 = __builtin_amdgcn_mfma_f32_32x32x16_bf16(kA1, kA1, kk11, 0, 0, 0);
        }
#pragma unroll
        for (int r = 0; r < 16; ++r) { const int il = (r & 3) + 8 * (r >> 2) + 4 * hi;
            const float Gi0 = Gs[il], Gi1 = Gs[32 + il], bi0 = Bs[il], bi1 = Bs[32 + il];
            AT[r32 * 64 + il] = (r32 < il) ? bi0 * kk00[r] * expf(Gi0 - Gj0) : 0.f;
            AT[r32 * 64 + 32 + il] = bi1 * kk10[r] * expf(Gi1 - Gj0);
            AT[(32 + r32) * 64 + 32 + il] = (r32 < il) ? bi1 * kk11[r] * expf(Gi1 - Gj1) : 0.f;
            AT[(32 + r32) * 64 + il] = 0.f;
        }
    }
    asm volatile("" ::: "memory");
    {
        f32x16_t qk00, qk10, qk11;
#pragma unroll
        for (int r = 0; r < 16; ++r) { qk00[r] = 0.f; qk10[r] = 0.f; qk11[r] = 0.f; }
#pragma unroll
        for (int s = 0; s < 8; ++s) {
            const bf16x8_t kA0 = *(const bf16x8_t*)(k0p + 16 * s), kA1 = *(const bf16x8_t*)(k1p + 16 * s), qA0 = *(const bf16x8_t*)(q0p + 16 * s), qA1 = *(const bf16x8_t*)(q1p + 16 * s);
            qk00 = __builtin_amdgcn_mfma_f32_32x32x16_bf16(qA0, kA0, qk00, 0, 0, 0); qk10 = __builtin_amdgcn_mfma_f32_32x32x16_bf16(qA1, kA0, qk10, 0, 0, 0); qk11 = __builtin_amdgcn_mfma_f32_32x32x16_bf16(qA1, kA1, qk11, 0, 0, 0);
        }
#pragma unroll
        for (int r = 0; r < 16; ++r) { const int il = (r & 3) + 8 * (r >> 2) + 4 * hi;
            const float Gi0 = Gs[il], Gi1 = Gs[32 + il];
            GA[il * 64 + r32] = (bf16_t)f2bf((r32 <= il) ? qk00[r] * expf(Gi0 - Gj0) : 0.f);
            GA[(32 + il) * 64 + r32] = (bf16_t)f2bf(qk10[r] * expf(Gi1 - Gj0));
            GA[(32 + il) * 64 + 32 + r32] = (bf16_t)f2bf((r32 <= il) ? qk11[r] * expf(Gi1 - Gj1) : 0.f);
        }
    }
    LDS_WAIT(); asm volatile("" ::: "memory");
    float tr[64];
    int lane2 = lane; asm volatile("" : "+v"(lane2) :: "memory");
#pragma unroll
    for (int j = 0; j < 64; ++j) tr[j] = (j == lane2) ? 1.f : 0.f;
    int atoff = 0;
#pragma unroll
    for (int j = 62; j >= 0; --j) { float c0 = 0.f, c1 = 0.f, c2 = 0.f, c3 = 0.f;
        asm volatile("" : "+v"(atoff) : "v"(tr[j + 1]));
#pragma unroll
        for (int qd = (j + 1) / 4; qd < 16; ++qd) { const f32x4 av = *(const f32x4*)(AT + atoff + j * 64 + 4 * qd);
            if (4 * qd + 0 > j) c0 = fmaf(tr[4 * qd + 0], av.x, c0);
            if (4 * qd + 1 > j) c1 = fmaf(tr[4 * qd + 1], av.y, c1);
            if (4 * qd + 2 > j) c2 = fmaf(tr[4 * qd + 2], av.z, c2);
            if (4 * qd + 3 > j) c3 = fmaf(tr[4 * qd + 3], av.w, c3); }
        tr[j] -= (c0 + c1) + (c2 + c3); asm volatile("" ::: "memory"); }
#pragma unroll
    for (int x = 0; x < 8; ++x) *(v4u*)(GT + lane2 * 64 + x * 8) = pack8(tr + x * 8);
    LDS_WAIT();
}

__device__ __forceinline__ void gdn2_item(const Args& a, int item, unsigned char* lds) {
    const int dvs = item & 3, hv = (item >> 2) & 7, dir = (item >> 5) & 1, b = item >> 6, hq = hv >> 1;
    const int lane0 = threadIdx.x & 63;
    constexpr int BUFB = 57344, O_K = 0, O_Q = 16384, O_T = 32768, O_A = 40960, O_V = 49152;
    float* Gs = (float*)(lds + 2 * BUFB); float* Bs = Gs + 64; float* Es = Bs + 64; float* Ws = Es + 64; float* ot = Ws + 64;
    const LAS unsigned char* ldl = (const LAS unsigned char*)lds;
    const bf16_t* QK = (const bf16_t*)(a.ws + WS_QKV16); const float* ACT = (const float*)(a.ws + WS_ACT); const float* SM = (const float*)(a.ws + WS_SMALL);
    float* O = (float*)(a.ws + (dir ? WS_YB : WS_YF));
    const float Aneg = -expf(a.in[dir ? 21 : 20][hv]); const float dtb = a.in[dir ? 23 : 22][hv];
    const size_t gbase = (size_t)(((b * 8 + hv) * 2 + dir) * 32) * 4096;
    f32x16_t S[4];
#pragma unroll
    for (int nt = 0; nt < 4; ++nt)
#pragma unroll
        for (int r = 0; r < 16; ++r) S[nt][r] = 0.f;
    float gar, gbr;
#define G2_DMA(c_, buf_) do { const int t_ = dir ? SEQ - 1 - (64 * (c_) + lane0) : 64 * (c_) + lane0; const size_t mi_ = (size_t)b * SEQ + t_; \
        const bf16_t* kr_ = QK + mi_ * 2048 + 512 + hq * 128; const bf16_t* qr_ = QK + mi_ * 2048 + hq * 128; \
        const bf16_t* tr_ = (const bf16_t*)(a.ws + WS_GT) + gbase + (size_t)(c_) * 4096 + lane0 * 64; const bf16_t* ar_ = (const bf16_t*)(a.ws + WS_GA) + gbase + (size_t)(c_) * 4096 + lane0 * 64; \
        const float* vr_ = ACT + mi_ * 2048 + 1024 + hv * 128 + dvs * 32; \
        LAS unsigned char* lb_ = (LAS unsigned char*)lds + (buf_) * BUFB; \
        _Pragma("unroll") for (int x = 0; x < 16; ++x) { __builtin_amdgcn_global_load_lds((const unsigned*)(kr_ + 8 * x), (LAS unsigned*)(lb_ + O_K + 1024 * x), 16, 0, 0); \
                                                         __builtin_amdgcn_global_load_lds((const unsigned*)(qr_ + 8 * x), (LAS unsigned*)(lb_ + O_Q + 1024 * x), 16, 0, 0); } \
        _Pragma("unroll") for (int x = 0; x < 8; ++x) { __builtin_amdgcn_global_load_lds((const unsigned*)(tr_ + 8 * x), (LAS unsigned*)(lb_ + O_T + 1024 * x), 16, 0, 0); \
                                                        __builtin_amdgcn_global_load_lds((const unsigned*)(ar_ + 8 * x), (LAS unsigned*)(lb_ + O_A + 1024 * x), 16, 0, 0); \
                                                        __builtin_amdgcn_global_load_lds((const unsigned*)(vr_ + 4 * x), (LAS unsigned*)(lb_ + O_V + 1024 * x), 16, 0, 0); } \
        const float* sm_ = SM + mi_ * 32; gar = sm_[16 + dir * 8 + hv]; gbr = sm_[dir * 8 + hv]; } while (0)
    G2_DMA(0, 0);
    for (int c = 0; c < 32; ++c) {
        int lane = lane0; asm volatile("" : "+v"(lane));
        const int r32 = lane & 31, hi = lane >> 5, trq = (lane & 15) >> 2, trp = lane & 3, trc = (lane >> 4) & 1;
        const int bo = (c & 1) * BUFB;
        float GL;
        {
            const float gi = Aneg * softplus_f(gar + dtb), bi = sigmoid_f(gbr);
            const float G = wave_incl_scan(gi, lane); GL = __shfl(G, 63);
            Gs[lane] = G; Bs[lane] = bi; Es[lane] = __expf(G); Ws[lane] = __expf(GL - G);
        }
        asm volatile("s_waitcnt vmcnt(0)" ::: "memory");
        if (c + 1 < 32) G2_DMA(c + 1, (c + 1) & 1);
        LDS_WAIT();
        f32x16_t KS[2];
#pragma unroll
        for (int rt = 0; rt < 2; ++rt)
#pragma unroll
            for (int r = 0; r < 16; ++r) KS[rt][r] = 0.f;
#define LFRAG(off_) join44(*(const LAS v2u*)(ldl + (off_)), *(const LAS v2u*)(ldl + (off_) + 1024))
#pragma unroll
        for (int nt = 0; nt < 4; ++nt) {
            const bf16x8_t sb0 = acc_frag<0>(S[nt]), sb1 = acc_frag<1>(S[nt]);
#pragma unroll
            for (int rt = 0; rt < 2; ++rt) {
                const int ro = bo + O_K + ((4 * nt) * 64 + 32 * rt + r32) * 16 + 8 * hi;
                KS[rt] = __builtin_amdgcn_mfma_f32_32x32x16_bf16(LFRAG(ro), sb0, KS[rt], 0, 0, 0); KS[rt] = __builtin_amdgcn_mfma_f32_32x32x16_bf16(LFRAG(ro + 2048), sb1, KS[rt], 0, 0, 0);
            }
        }
        asm volatile("" ::: "memory");
        f32x16_t rhs[2];
#pragma unroll
        for (int rt = 0; rt < 2; ++rt)
#pragma unroll
            for (int r = 0; r < 16; ++r) { const int i = 32 * rt + (r & 3) + 8 * (r >> 2) + 4 * hi;
                const float vv = *(const LAS float*)(ldl + bo + O_V + ((r32 >> 2) * 64 + i) * 16 + (r32 & 3) * 4); const float bi = Bs[i];
                rhs[rt][r] = bi * vv - bi * Es[i] * KS[rt][r]; }
        asm volatile("" ::: "memory");
        f32x16_t vn[2];
#pragma unroll
        for (int r = 0; r < 16; ++r) { vn[0][r] = 0.f; vn[1][r] = 0.f; }
        {
            const bf16x8_t rb00 = acc_frag<0>(rhs[0]), rb01 = acc_frag<1>(rhs[0]), rb10 = acc_frag<0>(rhs[1]), rb11 = acc_frag<1>(rhs[1]);
            const int t0 = bo + O_T + r32 * 16 + 8 * hi, t1 = t0 + 512;
            vn[0] = __builtin_amdgcn_mfma_f32_32x32x16_bf16(LFRAG(t0), rb00, vn[0], 0, 0, 0); vn[0] = __builtin_amdgcn_mfma_f32_32x32x16_bf16(LFRAG(t0 + 2048), rb01, vn[0], 0, 0, 0);
            vn[1] = __builtin_amdgcn_mfma_f32_32x32x16_bf16(LFRAG(t1), rb00, vn[1], 0, 0, 0); vn[1] = __builtin_amdgcn_mfma_f32_32x32x16_bf16(LFRAG(t1 + 2048), rb01, vn[1], 0, 0, 0);
            vn[1] = __builtin_amdgcn_mfma_f32_32x32x16_bf16(LFRAG(t1 + 4096), rb10, vn[1], 0, 0, 0); vn[1] = __builtin_amdgcn_mfma_f32_32x32x16_bf16(LFRAG(t1 + 6144), rb11, vn[1], 0, 0, 0);
        }
        asm volatile("" ::: "memory");
        f32x16_t QS[2];
#pragma unroll
        for (int rt = 0; rt < 2; ++rt)
#pragma unroll
            for (int r = 0; r < 16; ++r) QS[rt][r] = 0.f;
#pragma unroll
        for (int nt = 0; nt < 4; ++nt) {
            const bf16x8_t sb0 = acc_frag<0>(S[nt]), sb1 = acc_frag<1>(S[nt]);
#pragma unroll
            for (int rt = 0; rt < 2; ++rt) {
                const int ro = bo + O_Q + ((4 * nt) * 64 + 32 * rt + r32) * 16 + 8 * hi;
                QS[rt] = __builtin_amdgcn_mfma_f32_32x32x16_bf16(LFRAG(ro), sb0, QS[rt], 0, 0, 0); QS[rt] = __builtin_amdgcn_mfma_f32_32x32x16_bf16(LFRAG(ro + 2048), sb1, QS[rt], 0, 0, 0);
            }
        }
        asm volatile("" ::: "memory");
        {
            const bf16x8_t vb00 = acc_frag<0>(vn[0]), vb01 = acc_frag<1>(vn[0]), vb10 = acc_frag<0>(vn[1]), vb11 = acc_frag<1>(vn[1]);
            const int a0 = bo + O_A + r32 * 16 + 8 * hi, a1 = a0 + 512;
            f32x16_t o0, o1;
#pragma unroll
            for (int r = 0; r < 16; ++r) { const int il = (r & 3) + 8 * (r >> 2) + 4 * hi; o0[r] = Es[il] * QS[0][r]; o1[r] = Es[32 + il] * QS[1][r]; }
            o0 = __builtin_amdgcn_mfma_f32_32x32x16_bf16(LFRAG(a0), vb00, o0, 0, 0, 0); o0 = __builtin_amdgcn_mfma_f32_32x32x16_bf16(LFRAG(a0 + 2048), vb01, o0, 0, 0, 0);
            o1 = __builtin_amdgcn_mfma_f32_32x32x16_bf16(LFRAG(a1), vb00, o1, 0, 0, 0); o1 = __builtin_amdgcn_mfma_f32_32x32x16_bf16(LFRAG(a1 + 2048), vb01, o1, 0, 0, 0);
            o1 = __builtin_amdgcn_mfma_f32_32x32x16_bf16(LFRAG(a1 + 4096), vb10, o1, 0, 0, 0); o1 = __builtin_amdgcn_mfma_f32_32x32x16_bf16(LFRAG(a1 + 6144), vb11, o1, 0, 0, 0);
#pragma unroll
            for (int r = 0; r < 16; ++r) { const int il = (r & 3) + 8 * (r >> 2) + 4 * hi; ot[il * 33 + r32] = o0[r]; ot[(32 + il) * 33 + r32] = o1[r]; }
            LDS_WAIT();
            { const int t = dir ? SEQ - 1 - (64 * c + lane) : 64 * c + lane; float* orow = O + ((size_t)b * SEQ + t) * 1024 + hv * 128 + dvs * 32;
#pragma unroll
              for (int x = 0; x < 8; ++x) *(f32x4*)(orow + 4 * x) = (f32x4){ot[lane * 33 + 4 * x], ot[lane * 33 + 4 * x + 1], ot[lane * 33 + 4 * x + 2], ot[lane * 33 + 4 * x + 3]}; }
        }
        asm volatile("" ::: "memory");
        {
#pragma unroll
            for (int r = 0; r < 16; ++r) { const int il = (r & 3) + 8 * (r >> 2) + 4 * hi; vn[0][r] *= Ws[il]; vn[1][r] *= Ws[32 + il]; }
            const bf16x8_t wb[4] = {acc_frag<0>(vn[0]), acc_frag<1>(vn[0]), acc_frag<0>(vn[1]), acc_frag<1>(vn[1])};
            const float eGL = __expf(GL);
#pragma unroll
            for (int nt = 0; nt < 4; ++nt) {
#pragma unroll
                for (int r = 0; r < 16; ++r) S[nt][r] *= eGL;
#pragma unroll
                for (int ks = 0; ks < 4; ++ks) {
                    const int ro = bo + O_K + ((4 * nt + 2 * trc + (trp >> 1)) * 64 + 16 * ks + 4 * hi + trq) * 16 + 8 * (trp & 1);
                    const s16x4_t lo = __builtin_bit_cast(s16x4_t, __builtin_amdgcn_ds_read_tr16_b64_v4i16((LAS s16x4_t*)(ldl + ro)));
                    const s16x4_t hi4 = __builtin_bit_cast(s16x4_t, __builtin_amdgcn_ds_read_tr16_b64_v4i16((LAS s16x4_t*)(ldl + ro + 8 * 16)));
                    const bf16x8_t kf = (bf16x8_t){lo[0], lo[1], lo[2], lo[3], hi4[0], hi4[1], hi4[2], hi4[3]};
                    S[nt] = __builtin_amdgcn_mfma_f32_32x32x16_bf16(kf, wb[ks], S[nt], 0, 0, 0);
                }
            }
        }
        LDS_WAIT();
    }
#undef LFRAG
#undef G2_DMA
}

__device__ __forceinline__ void ssd2_item(const Args& a, int item, unsigned char* lds) {
    const int ps = item & 1, h = (item >> 1) & 15, dir = (item >> 5) & 1, b = item >> 6, g = h >> 3;
    const int lane0 = threadIdx.x & 63;
    constexpr int BUFB = 40960, O_B = 0, O_C = 16384, O_X = 32768, O_XD = 2 * BUFB + 512, O_XW = O_XD + 64 * 72;
    float* Gs = (float*)(lds + 2 * BUFB); float* Es = Gs + 64; float* ot = (float*)(lds + O_XW + 64 * 72);
    const LAS unsigned char* ldl = (const LAS unsigned char*)lds;
    const bf16_t* XB = (const bf16_t*)(a.ws + WS_XBC16); const float* ACT = (const float*)(a.ws + WS_ACT); const float* SM = (const float*)(a.ws + WS_SMALL);
    float* Y = (float*)(a.ws + (dir ? WS_YB : WS_YF));
    const float A = -expf(a.in[dir ? 13 : 12][h]); const float dtb = a.in[dir ? 11 : 10][h];
    f32x16_t H[4];
#pragma unroll
    for (int nt = 0; nt < 4; ++nt)
#pragma unroll
        for (int r = 0; r < 16; ++r) H[nt][r] = 0.f;
    float gdr;
#define S2_DMA(c_, buf_) do { const int t_ = dir ? SEQ - 1 - (64 * (c_) + lane0) : 64 * (c_) + lane0; const size_t mi_ = (size_t)b * SEQ + t_; \
        const bf16_t* br_ = XB + mi_ * 1536 + 1024 + g * 128; const bf16_t* cr_ = XB + mi_ * 1536 + 1280 + g * 128; const float* xr_ = ACT + mi_ * 1536 + h * 64 + ps * 32; \
        LAS unsigned char* lb_ = (LAS unsigned char*)lds + (buf_) * BUFB; \
        _Pragma("unroll") for (int x = 0; x < 16; ++x) { __builtin_amdgcn_global_load_lds((const unsigned*)(br_ + 8 * x), (LAS unsigned*)(lb_ + O_B + 1024 * x), 16, 0, 0); \
                                                         __builtin_amdgcn_global_load_lds((const unsigned*)(cr_ + 8 * x), (LAS unsigned*)(lb_ + O_C + 1024 * x), 16, 0, 0); } \
        _Pragma("unroll") for (int x = 0; x < 8; ++x) __builtin_amdgcn_global_load_lds((const unsigned*)(xr_ + 4 * x), (LAS unsigned*)(lb_ + O_X + 1024 * x), 16, 0, 0); \
        gdr = SM[mi_ * 32 + dir * 16 + h]; } while (0)
    S2_DMA(0, 0);
    for (int c = 0; c < 32; ++c) {
        int lane = lane0; asm volatile("" : "+v"(lane));
        const int r32 = lane & 31, hi = lane >> 5, trq = (lane & 15) >> 2, trp = lane & 3, trc = (lane >> 4) & 1;
        const int bo = (c & 1) * BUFB;
        const float dt = softplus_f(gdr + dtb);
        const float cs = wave_incl_scan(dt * A, lane); const float csL = __shfl(cs, 63);
        Gs[lane] = cs; Es[lane] = __expf(cs);
        asm volatile("s_waitcnt vmcnt(0)" ::: "memory");
        if (c + 1 < 32) S2_DMA(c + 1, (c + 1) & 1);
        {
            const float wsc = dt * __expf(csL - cs);
#pragma unroll
            for (int x = 0; x < 8; ++x) { const f32x4 xv = *(const LAS f32x4*)(ldl + bo + O_X + (x * 64 + lane) * 16);
                v2u d; d.x = cvtpk_rne(xv.x * dt, xv.y * dt); d.y = cvtpk_rne(xv.z * dt, xv.w * dt); *(LAS v2u*)((LAS unsigned char*)lds + O_XD + lane * 72 + 8 * x) = d;
                v2u w; w.x = cvtpk_rne(xv.x * wsc, xv.y * wsc); w.y = cvtpk_rne(xv.z * wsc, xv.w * wsc); *(LAS v2u*)((LAS unsigned char*)lds + O_XW + lane * 72 + 8 * x) = w; }
        }
        LDS_WAIT();
        f32x16_t g00, g01, g11;
#pragma unroll
        for (int r = 0; r < 16; ++r) { g00[r] = 0.f; g01[r] = 0.f; g11[r] = 0.f; }
#pragma unroll
        for (int kk = 0; kk < 8; ++kk) { const int fo = ((2 * kk + hi) * 64 + r32) * 16;
            const bf16x8_t A0 = *(const LAS bf16x8_t*)(ldl + bo + O_B + fo), A1 = *(const LAS bf16x8_t*)(ldl + bo + O_B + fo + 512);
            const bf16x8_t B0 = *(const LAS bf16x8_t*)(ldl + bo + O_C + fo), B1 = *(const LAS bf16x8_t*)(ldl + bo + O_C + fo + 512);
            g00 = __builtin_amdgcn_mfma_f32_32x32x16_bf16(A0, B0, g00, 0, 0, 0); g01 = __builtin_amdgcn_mfma_f32_32x32x16_bf16(A0, B1, g01, 0, 0, 0); g11 = __builtin_amdgcn_mfma_f32_32x32x16_bf16(A1, B1, g11, 0, 0, 0); }
        {   const float cst0 = Gs[r32], cst1 = Gs[32 + r32];
#pragma unroll
            for (int r = 0; r < 16; ++r) { const int il = (r & 3) + 8 * (r >> 2) + 4 * hi; const float css0 = Gs[il], css1 = Gs[32 + il];
                g00[r] = (il <= r32) ? g00[r] * __expf(cst0 - css0) : 0.f; g01[r] = g01[r] * __expf(cst1 - css0); g11[r] = (il <= r32) ? g11[r] * __expf(cst1 - css1) : 0.f; } }
        asm volatile("" ::: "memory");
        f32x16_t y0, y1;
#pragma unroll
        for (int r = 0; r < 16; ++r) { y0[r] = 0.f; y1[r] = 0.f; }
#define TRFRAG(base_) ({ const s16x4_t lo_ = __builtin_bit_cast(s16x4_t, __builtin_amdgcn_ds_read_tr16_b64_v4i16((LAS s16x4_t*)(ldl + (base_)))); \
                         const s16x4_t hi_ = __builtin_bit_cast(s16x4_t, __builtin_amdgcn_ds_read_tr16_b64_v4i16((LAS s16x4_t*)(ldl + (base_) + 8 * 72))); \
                         (bf16x8_t){lo_[0], lo_[1], lo_[2], lo_[3], hi_[0], hi_[1], hi_[2], hi_[3]}; })
        {   const int xo = O_XD + (4 * hi + trq) * 72 + (16 * trc + 4 * trp) * 2;
            const bf16x8_t x0 = TRFRAG(xo), x1 = TRFRAG(xo + 16 * 72), x2 = TRFRAG(xo + 32 * 72), x3 = TRFRAG(xo + 48 * 72);
            y0 = __builtin_amdgcn_mfma_f32_32x32x16_bf16(acc_frag<0>(g00), x0, y0, 0, 0, 0); y0 = __builtin_amdgcn_mfma_f32_32x32x16_bf16(acc_frag<1>(g00), x1, y0, 0, 0, 0);
            y1 = __builtin_amdgcn_mfma_f32_32x32x16_bf16(acc_frag<0>(g01), x0, y1, 0, 0, 0); y1 = __builtin_amdgcn_mfma_f32_32x32x16_bf16(acc_frag<1>(g01), x1, y1, 0, 0, 0);
            y1 = __builtin_amdgcn_mfma_f32_32x32x16_bf16(acc_frag<0>(g11), x2, y1, 0, 0, 0); y1 = __builtin_amdgcn_mfma_f32_32x32x16_bf16(acc_frag<1>(g11), x3, y1, 0, 0, 0); }
        asm volatile("" ::: "memory");
        {   f32x16_t Z0, Z1;
#pragma unroll
            for (int r = 0; r < 16; ++r) { Z0[r] = 0.f; Z1[r] = 0.f; }
#define LFRAG(off_) join44(*(const LAS v2u*)(ldl + (off_)), *(const LAS v2u*)(ldl + (off_) + 1024))
#pragma unroll
            for (int nt = 0; nt < 4; ++nt) { const bf16x8_t hb0 = acc_frag<0>(H[nt]), hb1 = acc_frag<1>(H[nt]);
                const int ro = bo + O_C + ((4 * nt) * 64 + r32) * 16 + 8 * hi;
                Z0 = __builtin_amdgcn_mfma_f32_32x32x16_bf16(LFRAG(ro), hb0, Z0, 0, 0, 0); Z0 = __builtin_amdgcn_mfma_f32_32x32x16_bf16(LFRAG(ro + 2048), hb1, Z0, 0, 0, 0);
                Z1 = __builtin_amdgcn_mfma_f32_32x32x16_bf16(LFRAG(ro + 512), hb0, Z1, 0, 0, 0); Z1 = __builtin_amdgcn_mfma_f32_32x32x16_bf16(LFRAG(ro + 512 + 2048), hb1, Z1, 0, 0, 0); }
#undef LFRAG
#pragma unroll
            for (int r = 0; r < 16; ++r) { const int il = (r & 3) + 8 * (r >> 2) + 4 * hi; ot[il * 33 + r32] = fmaf(Es[il], Z0[r], y0[r]); ot[(32 + il) * 33 + r32] = fmaf(Es[32 + il], Z1[r], y1[r]); } }
        LDS_WAIT();
        { const int t = dir ? SEQ - 1 - (64 * c + lane) : 64 * c + lane; float* yrow = Y + ((size_t)b * SEQ + t) * 1024 + h * 64 + ps * 32;
#pragma unroll
          for (int x = 0; x < 8; ++x) *(f32x4*)(yrow + 4 * x) = (f32x4){ot[lane * 33 + 4 * x], ot[lane * 33 + 4 * x + 1], ot[lane * 33 + 4 * x + 2], ot[lane * 33 + 4 * x + 3]}; }
        asm volatile("" ::: "memory");
        {   const float eL = __expf(csL);
            const int xo = O_XW + (4 * hi + trq) * 72 + (16 * trc + 4 * trp) * 2;
            const bf16x8_t w0 = TRFRAG(xo), w1 = TRFRAG(xo + 16 * 72), w2 = TRFRAG(xo + 32 * 72), w3 = TRFRAG(xo + 48 * 72);
#undef TRFRAG
#pragma unroll
            for (int nt = 0; nt < 4; ++nt) {
#pragma unroll
                for (int r = 0; r < 16; ++r) H[nt][r] *= eL;
#pragma unroll
                for (int ks = 0; ks < 4; ++ks) {
                    const int ro = bo + O_B + ((4 * nt + 2 * trc + (trp >> 1)) * 64 + 16 * ks + 4 * hi + trq) * 16 + 8 * (trp & 1);
                    const s16x4_t lo = __builtin_bit_cast(s16x4_t, __builtin_amdgcn_ds_read_tr16_b64_v4i16((LAS s16x4_t*)(ldl + ro)));
                    const s16x4_t hi4 = __builtin_bit_cast(s16x4_t, __builtin_amdgcn_ds_read_tr16_b64_v4i16((LAS s16x4_t*)(ldl + ro + 8 * 16)));
                    const bf16x8_t bfr = (bf16x8_t){lo[0], lo[1], lo[2], lo[3], hi4[0], hi4[1], hi4[2], hi4[3]};
                    H[nt] = __builtin_amdgcn_mfma_f32_32x32x16_bf16(bfr, ks == 0 ? w0 : ks == 1 ? w1 : ks == 2 ? w2 : w3, H[nt], 0, 0, 0);
                }
            }
        }
        LDS_WAIT();
    }
#undef S2_DMA
}

namespace ssd3 {
constexpr int O_XR = 98304, O_DT = 114688, O_OUT = 115200, OUTB = 13312, OO_XW = 512, OO_Y = 512 + 4608, O_FLAG = 141824, O_END = 141888, GRP = 41;
__device__ __forceinline__ void spin_ge(const LAS unsigned char* ldl, int off, unsigned target) {
    for (;;) { const unsigned v = __builtin_amdgcn_readfirstlane(*(volatile const LAS unsigned*)(ldl + off)); if (v >= target) break; __builtin_amdgcn_s_sleep(1); }
    asm volatile("" ::: "memory");
}
#define S3_TRFRAG(base_) ({ const s16x4_t lo_ = __builtin_bit_cast(s16x4_t, __builtin_amdgcn_ds_read_tr16_b64_v4i16((LAS s16x4_t*)(ldl + (base_)))); \
                            const s16x4_t hi_ = __builtin_bit_cast(s16x4_t, __builtin_amdgcn_ds_read_tr16_b64_v4i16((LAS s16x4_t*)(ldl + (base_) + 8 * 72))); \
                            (bf16x8_t){lo_[0], lo_[1], lo_[2], lo_[3], hi_[0], hi_[1], hi_[2], hi_[3]}; })
__device__ __forceinline__ void producer(const Args& a, int item, unsigned char* lds) {
    const int ps = item & 1, h = (item >> 1) & 15, dir = (item >> 5) & 1, b = item >> 6, g = h >> 3;
    const int lane0 = threadIdx.x & 63;
    const LAS unsigned char* ldl = (const LAS unsigned char*)lds; LAS unsigned char* ldw = (LAS unsigned char*)lds;
    const bf16_t* XB = (const bf16_t*)(a.ws + WS_XBC16); const float* ACT = (const float*)(a.ws + WS_ACT); const float* SM = (const float*)(a.ws + WS_SMALL);
    const float A = -expf(a.in[dir ? 13 : 12][h]); const float dtb = a.in[dir ? 11 : 10][h];
#define S3_DMA(c_, slot3_) do { const int t_ = dir ? SEQ - 1 - (64 * (c_) + lane0) : 64 * (c_) + lane0; const size_t mi_ = (size_t)b * SEQ + t_; \
        const bf16_t* br_ = XB + mi_ * 1536 + 1024 + g * 128; const bf16_t* cr_ = XB + mi_ * 1536 + 1280 + g * 128; const float* xr_ = ACT + mi_ * 1536 + h * 64 + ps * 32; \
        LAS unsigned char* lb_ = ldw + (slot3_) * 32768; LAS unsigned char* lx_ = ldw + O_XR + ((c_) & 1) * 8192; \
        _Pragma("unroll") for (int x = 0; x < 16; ++x) { __builtin_amdgcn_global_load_lds((const unsigned*)(br_ + 8 * x), (LAS unsigned*)(lb_ + 1024 * x), 16, 0, 0); \
                                                         __builtin_amdgcn_global_load_lds((const unsigned*)(cr_ + 8 * x), (LAS unsigned*)(lb_ + 16384 + 1024 * x), 16, 0, 0); } \
        _Pragma("unroll") for (int x = 0; x < 8; ++x) __builtin_amdgcn_global_load_lds((const unsigned*)(xr_ + 4 * x), (LAS unsigned*)(lx_ + 1024 * x), 16, 0, 0); \
        __builtin_amdgcn_global_load_lds((const unsigned*)(SM + mi_ * 32 + dir * 16 + h), (LAS unsigned*)(ldw + O_DT + ((c_) & 1) * 256), 4, 0, 0); } while (0)
    S3_DMA(0, 0); S3_DMA(1, 1);
    int slot3 = 0;
    for (int c = 0; c < 32; ++c) {
        int lane = lane0; asm volatile("" : "+v"(lane));
        const int r32 = lane & 31, hi = lane >> 5, trq = (lane & 15) >> 2, trp = lane & 3, trc = (lane >> 4) & 1;
        const int par = c & 1, bo = slot3 * 32768, oo = O_OUT + par * OUTB;
        if (c < 31) asm volatile("s_waitcnt vmcnt(41)" ::: "memory"); else asm volatile("s_waitcnt vmcnt(0)" ::: "memory");
        if (c >= 2) spin_ge(ldl, O_FLAG + 4, (unsigned)(c - 1));
        LAS float* Gs = (LAS float*)(ldw + oo); LAS float* Es = Gs + 64;
        const float dt = softplus_f(*(const LAS float*)(ldl + O_DT + par * 256 + lane * 4) + dtb);
        const float cs = wave_incl_scan(dt * A, lane); const float csL = __shfl(cs, 63);
        Gs[lane] = cs; Es[lane] = __expf(cs);
        {   const float wsc = dt * __expf(csL - cs);
#pragma unroll
            for (int x = 0; x < 8; ++x) { const f32x4 xv = *(const LAS f32x4*)(ldl + O_XR + par * 8192 + (x * 64 + lane) * 16);
                v2u d; d.x = cvtpk_rne(xv.x * dt, xv.y * dt); d.y = cvtpk_rne(xv.z * dt, xv.w * dt); *(LAS v2u*)(ldw + oo + OO_Y + lane * 72 + 8 * x) = d;
                v2u w; w.x = cvtpk_rne(xv.x * wsc, xv.y * wsc); w.y = cvtpk_rne(xv.z * wsc, xv.w * wsc); *(LAS v2u*)(ldw + oo + OO_XW + lane * 72 + 8 * x) = w; }
        }
        LDS_WAIT();
        f32x16_t g00, g01, g11;
#pragma unroll
        for (int r = 0; r < 16; ++r) { g00[r] = 0.f; g01[r] = 0.f; g11[r] = 0.f; }
#pragma unroll
        for (int kk = 0; kk < 8; ++kk) { const int fo = ((2 * kk + hi) * 64 + r32) * 16;
            const bf16x8_t A0 = *(const LAS bf16x8_t*)(ldl + bo + fo), A1 = *(const LAS bf16x8_t*)(ldl + bo + fo + 512);
            const bf16x8_t B0 = *(const LAS bf16x8_t*)(ldl + bo + 16384 + fo), B1 = *(const LAS bf16x8_t*)(ldl + bo + 16384 + fo + 512);
            g00 = __builtin_amdgcn_mfma_f32_32x32x16_bf16(A0, B0, g00, 0, 0, 0); g01 = __builtin_amdgcn_mfma_f32_32x32x16_bf16(A0, B1, g01, 0, 0, 0); g11 = __builtin_amdgcn_mfma_f32_32x32x16_bf16(A1, B1, g11, 0, 0, 0); }
        {   const float cst0 = Gs[r32], cst1 = Gs[32 + r32];
#pragma unroll
            for (int r = 0; r < 16; ++r) { const int il = (r & 3) + 8 * (r >> 2) + 4 * hi; const float css0 = Gs[il], css1 = Gs[32 + il];
                g00[r] = (il <= r32) ? g00[r] * __expf(cst0 - css0) : 0.f; g01[r] = g01[r] * __expf(cst1 - css0); g11[r] = (il <= r32) ? g11[r] * __expf(cst1 - css1) : 0.f; } }
        asm volatile("" ::: "memory");
        f32x16_t y0, y1;
#pragma unroll
        for (int r = 0; r < 16; ++r) { y0[r] = 0.f; y1[r] = 0.f; }
        {   const int xo = oo + OO_Y + (4 * hi + trq) * 72 + (16 * trc + 4 * trp) * 2;
            const bf16x8_t x0 = S3_TRFRAG(xo), x1 = S3_TRFRAG(xo + 16 * 72), x2 = S3_TRFRAG(xo + 32 * 72), x3 = S3_TRFRAG(xo + 48 * 72);
            y0 = __builtin_amdgcn_mfma_f32_32x32x16_bf16(acc_frag<0>(g00), x0, y0, 0, 0, 0); y0 = __builtin_amdgcn_mfma_f32_32x32x16_bf16(acc_frag<1>(g00), x1, y0, 0, 0, 0);
            y1 = __builtin_amdgcn_mfma_f32_32x32x16_bf16(acc_frag<0>(g01), x0, y1, 0, 0, 0); y1 = __builtin_amdgcn_mfma_f32_32x32x16_bf16(acc_frag<1>(g01), x1, y1, 0, 0, 0);
            y1 = __builtin_amdgcn_mfma_f32_32x32x16_bf16(acc_frag<0>(g11), x2, y1, 0, 0, 0); y1 = __builtin_amdgcn_mfma_f32_32x32x16_bf16(acc_frag<1>(g11), x3, y1, 0, 0, 0); }
        LDS_WAIT();
#pragma unroll
        for (int r = 0; r < 16; ++r) { *(LAS float*)(ldw + oo + OO_Y + r * 256 + lane * 4) = y0[r]; *(LAS float*)(ldw + oo + OO_Y + (16 + r) * 256 + lane * 4) = y1[r]; }
        LDS_WAIT();
        if (lane == 0) *(volatile LAS unsigned*)(ldw + O_FLAG) = (unsigned)(c + 1);
        if (c + 2 < 32) { if (c >= 1) spin_ge(ldl, O_FLAG + 4, (unsigned)c);
                          S3_DMA(c + 2, slot3 == 0 ? 2 : slot3 - 1); }
        slot3 = (slot3 == 2) ? 0 : slot3 + 1;
    }
#undef S3_DMA
}
__device__ __forceinline__ void consumer(const Args& a, int item, unsigned char* lds) {
    const int ps = item & 1, h = (item >> 1) & 15, dir = (item >> 5) & 1, b = item >> 6;
    const int lane0 = threadIdx.x & 63;
    const LAS unsigned char* ldl = (const LAS unsigned char*)lds; LAS unsigned char* ldw = (LAS unsigned char*)lds;
    float* Y = (float*)(a.ws + (dir ? WS_YB : WS_YF));
    f32x16_t H[4];
#pragma unroll
    for (int nt = 0; nt < 4; ++nt)
#pragma unroll
        for (int r = 0; r < 16; ++r) H[nt][r] = 0.f;
    int slot3 = 0;
    for (int c = 0; c < 32; ++c) {
        int lane = lane0; asm volatile("" : "+v"(lane));
        const int r32 = lane & 31, hi = lane >> 5, trq = (lane & 15) >> 2, trp = lane & 3, trc = (lane >> 4) & 1;
        const int par = c & 1, bo = slot3 * 32768, oo = O_OUT + par * OUTB;
        const LAS float* Gs = (const LAS float*)(ldl + oo); const LAS float* Es = Gs + 64;
        spin_ge(ldl, O_FLAG, (unsigned)(c + 1));
        {   f32x16_t Z0, Z1;
#pragma unroll
            for (int r = 0; r < 16; ++r) { Z0[r] = 0.f; Z1[r] = 0.f; }
#define S3_LFRAG(off_) join44(*(const LAS v2u*)(ldl + (off_)), *(const LAS v2u*)(ldl + (off_) + 1024))
#pragma unroll
            for (int nt = 0; nt < 4; ++nt) { const bf16x8_t hb0 = acc_frag<0>(H[nt]), hb1 = acc_frag<1>(H[nt]);
                const int ro = bo + 16384 + ((4 * nt) * 64 + r32) * 16 + 8 * hi;
                Z0 = __builtin_amdgcn_mfma_f32_32x32x16_bf16(S3_LFRAG(ro), hb0, Z0, 0, 0, 0); Z0 = __builtin_amdgcn_mfma_f32_32x32x16_bf16(S3_LFRAG(ro + 2048), hb1, Z0, 0, 0, 0);
                Z1 = __builtin_amdgcn_mfma_f32_32x32x16_bf16(S3_LFRAG(ro + 512), hb0, Z1, 0, 0, 0); Z1 = __builtin_amdgcn_mfma_f32_32x32x16_bf16(S3_LFRAG(ro + 512 + 2048), hb1, Z1, 0, 0, 0); }
#undef S3_LFRAG
            const int tb = dir ? SEQ - 1 - (64 * c + 4 * hi) : 64 * c + 4 * hi;
            float* yb = Y + ((size_t)b * SEQ + tb) * 1024 + h * 64 + ps * 32 + r32;
#pragma unroll
            for (int r = 0; r < 16; ++r) { const int il0 = (r & 3) + 8 * (r >> 2), il = il0 + 4 * hi;
                const float yd0 = *(const LAS float*)(ldl + oo + OO_Y + r * 256 + lane * 4), yd1 = *(const LAS float*)(ldl + oo + OO_Y + (16 + r) * 256 + lane * 4);
                const long ro0 = dir ? -(long)il0 * 1024 : (long)il0 * 1024, ro1 = dir ? -(long)(il0 + 32) * 1024 : (long)(il0 + 32) * 1024;
                yb[ro0] = fmaf(Es[il], Z0[r], yd0); yb[ro1] = fmaf(Es[32 + il], Z1[r], yd1); } }
        asm volatile("" ::: "memory");
        {   const float eL = __expf(Gs[63]);
            const int xo = oo + OO_XW + (4 * hi + trq) * 72 + (16 * trc + 4 * trp) * 2;
            const bf16x8_t w0 = S3_TRFRAG(xo), w1 = S3_TRFRAG(xo + 16 * 72), w2 = S3_TRFRAG(xo + 32 * 72), w3 = S3_TRFRAG(xo + 48 * 72);
#pragma unroll
            for (int nt = 0; nt < 4; ++nt) {
#pragma unroll
                for (int r = 0; r < 16; ++r) H[nt][r] *= eL;
#pragma unroll
                for (int ks = 0; ks < 4; ++ks) {
                    const int ro = bo + ((4 * nt + 2 * trc + (trp >> 1)) * 64 + 16 * ks + 4 * hi + trq) * 16 + 8 * (trp & 1);
                    const s16x4_t lo = __builtin_bit_cast(s16x4_t, __builtin_amdgcn_ds_read_tr16_b64_v4i16((LAS s16x4_t*)(ldl + ro)));
                    const s16x4_t hi4 = __builtin_bit_cast(s16x4_t, __builtin_amdgcn_ds_read_tr16_b64_v4i16((LAS s16x4_t*)(ldl + ro + 8 * 16)));
                    const bf16x8_t bfr = (bf16x8_t){lo[0], lo[1], lo[2], lo[3], hi4[0], hi4[1], hi4[2], hi4[3]};
                    H[nt] = __builtin_amdgcn_mfma_f32_32x32x16_bf16(bfr, ks == 0 ? w0 : ks == 1 ? w1 : ks == 2 ? w2 : w3, H[nt], 0, 0, 0);
                }
            }
        }
        LDS_WAIT();
        if (lane == 0) *(volatile LAS unsigned*)(ldw + O_FLAG + 4) = (unsigned)(c + 1);
        slot3 = (slot3 == 2) ? 0 : slot3 + 1;
    }
}
#undef S3_TRFRAG
}

__device__ __forceinline__ void lru_tile(const Args& a, int item, unsigned char* lds, int pass) {
    const int n = item & 7, tc = (item >> 3) & 63, b = item >> 9, t0 = tc * 32;
    float* xc = (float*)lds; bf16_t* xcb = (bf16_t*)(lds + 16384); float* As = (float*)(lds + 25088); float* Us = As + 2 * 32 * 128; float2* sg = (float2*)(Us + 2 * 32 * 128);
    const int tid = threadIdx.x, lane = tid & 63, wave = tid >> 6;
    const bf16_t* P = (const bf16_t*)(a.ws + WS_PROJ);
    __syncthreads();
    {
        const int j = tid & 127, tg = tid >> 7, chn = n * 128 + j; const float* cw = a.in[25];
        const float w0 = cw[chn], w1 = cw[1024 + chn], w2 = cw[2048 + chn], w3 = cw[3072 + chn], cbias = a.in[26][chn];
        const int tb = t0 + tg * 8;
        const bf16_t* pp = P + ((size_t)b * SEQ + tb) * NINP + C_XL + chn;
        float xm2 = (tb >= 2) ? bf2f(pp[-2 * NINP]) : 0.f, xm1 = (tb >= 1) ? bf2f(pp[-NINP]) : 0.f, x0 = bf2f(pp[0]);
#pragma unroll
        for (int i = 0; i < 8; ++i) { const float xp1 = (tb + i + 1 < SEQ) ? bf2f(pp[(i + 1) * NINP]) : 0.f;
            const float acc = cbias + w0 * xm2 + w1 * xm1 + w2 * x0 + w3 * xp1;
            xc[(tg * 8 + i) * 128 + j] = acc; xcb[(tg * 8 + i) * 136 + j] = (bf16_t)f2bf(acc);
            xm2 = xm1; xm1 = x0; x0 = xp1; }
    }
    __syncthreads();
    {
        const int ct = wave & 3, d = wave >> 2, r32 = lane & 31, hi = lane >> 5;
        const bf16_t* WT = (const bf16_t*)(a.ws + WS_WGT);
        const bf16_t* wa_p = WT + ((size_t)((2 * d) * 8 + n) * 128 + ct * 32 + r32) * 128 + hi * 8;
        const bf16_t* wx_p = WT + ((size_t)((2 * d + 1) * 8 + n) * 128 + ct * 32 + r32) * 128 + hi * 8;
        f32x16_t ca, cx;
#pragma unroll
        for (int r = 0; r < 16; ++r) { ca[r] = 0.f; cx[r] = 0.f; }
#pragma unroll
        for (int s = 0; s < 8; ++s) {
            const bf16x8_t af = *(const bf16x8_t*)((const char*)xcb + r32 * 272 + (s * 16 + hi * 8) * 2);
            const bf16x8_t fa = *(const bf16x8_t*)(wa_p + s * 16); const bf16x8_t fx = *(const bf16x8_t*)(wx_p + s * 16);
            ca = __builtin_amdgcn_mfma_f32_32x32x16_bf16(af, fa, ca, 0, 0, 0); cx = __builtin_amdgcn_mfma_f32_32x32x16_bf16(af, fx, cx, 0, 0, 0);
        }
        const int j = ct * 32 + r32, cj = n * 128 + j;
        const float baj = a.in[d ? 33 : 28][cj], bxj = a.in[d ? 35 : 30][cj], sp = softplus_f(-a.in[d ? 36 : 31][cj]);
#pragma unroll
        for (int r = 0; r < 16; ++r) { const int t = (r & 3) + 8 * (r >> 2) + 4 * hi;
            const float rg = __builtin_amdgcn_rcpf(1.f + __expf(-(ca[r] + baj))), ig = __builtin_amdgcn_rcpf(1.f + __expf(-(cx[r] + bxj))); const float la = -8.f * rg * sp;
            const float av = __expf(la);
            const float om = (la > -0.0625f) ? -2.f * la * (1.f + la * (1.f + la * (0.6666667f + 0.3333333f * la))) : (1.f - av) * (1.f + av);
            As[(d * 32 + t) * 128 + j] = av; Us[(d * 32 + t) * 128 + j] = __builtin_amdgcn_sqrtf(om) * (ig * xc[t * 128 + j]); }
    }
    __syncthreads();
    {
        const int j = tid & 127, d = (tid >> 7) & 1, seg = tid >> 8;
        float Pp = 1.f, H = 0.f;
#pragma unroll
        for (int k = 0; k < 16; ++k) { const int q = seg * 16 + k, t = d ? 31 - q : q; const float a_ = As[(d * 32 + t) * 128 + j], u_ = Us[(d * 32 + t) * 128 + j]; H = fmaf(a_, H, u_); Pp *= a_; }
        sg[(d * 2 + seg) * 128 + j] = make_float2(Pp, H);
        __syncthreads();
        float2* LS = (float2*)(a.ws + WS_LSUM);
        if (pass == 0) {
            if (seg == 0) { const float2 s1 = sg[(d * 2 + 1) * 128 + j]; LS[((size_t)(d * 4 + b) * 64 + tc) * 1024 + n * 128 + j] = make_float2(Pp * s1.x, fmaf(s1.x, H, s1.y)); }
        } else {
            float c = 0.f;
            const float2* lsp = LS + ((size_t)(d * 4 + b) * 64) * 1024 + n * 128 + j;
#pragma unroll 1
            for (int c0 = 0; c0 < 64; c0 += 16) { float2 sv[16];
#pragma unroll
                for (int i = 0; i < 16; ++i) { const int cc = d ? 63 - (c0 + i) : c0 + i; sv[i] = lsp[(size_t)cc * 1024]; }
#pragma unroll
                for (int i = 0; i < 16; ++i) { const int cc = d ? 63 - (c0 + i) : c0 + i; const bool before = d ? (cc > tc) : (cc < tc); if (before) c = fmaf(sv[i].x, c, sv[i].y); } }
            if (seg == 1) { const float2 s0 = sg[(d * 2) * 128 + j]; c = fmaf(s0.x, c, s0.y); }
            float h = c;
#pragma unroll
            for (int k = 0; k < 16; ++k) { const int q = seg * 16 + k, t = d ? 31 - q : q; const float a_ = As[(d * 32 + t) * 128 + j], u_ = Us[(d * 32 + t) * 128 + j]; h = fmaf(a_, h, u_); Us[(d * 32 + t) * 128 + j] = h; }
            __syncthreads();
            bf16_t* YC = (bf16_t*)(a.ws + WS_YCAT);
            const int jj = tid & 127, tg = tid >> 7;
#pragma unroll
            for (int i = 0; i < 8; ++i) { const int t = tg * 8 + i; const size_t row = (size_t)b * SEQ + t0 + t;
                const float hs = Us[t * 128 + jj] + Us[(32 + t) * 128 + jj]; const float gl = bf2f(P[row * NINP + C_GL + n * 128 + jj]);
                YC[row * 2048 + 1024 + n * 128 + jj] = (bf16_t)f2bf(hs * silu_f(gl)); }
        }
    }
}

template <bool FINAL>
__device__ __forceinline__ void lru_wave(const Args& a, int witem, unsigned char* ldsw, int lane) {
    asm volatile("" : "+v"(lane));
    const int n = witem & 7, tc = (witem >> 3) & 63, b = witem >> 9, t0 = tc * 32;
    const int r32 = lane & 31, hi = lane >> 5;
    bf16_t* xcb = (bf16_t*)ldsw;
    const bf16_t* P = (const bf16_t*)(a.ws + WS_PROJ);
    bf16_t* XC = (bf16_t*)(a.ws + WS_XC16) + ((size_t)b * SEQ + t0) * 1024 + n * 128;
    if constexpr (!FINAL) {
        const int chn = n * 128 + 2 * lane; const float* cw = a.in[25];
        const f32x2 w0 = *(const f32x2*)(cw + chn), w1 = *(const f32x2*)(cw + 1024 + chn), w2 = *(const f32x2*)(cw + 2048 + chn), w3 = *(const f32x2*)(cw + 3072 + chn), cb2 = *(const f32x2*)(a.in[26] + chn);
        const bf16_t* pp = P + ((size_t)b * SEQ + t0) * NINP + C_XL + chn;
        f32x2 xm2 = {0.f, 0.f}, xm1 = {0.f, 0.f}, x0;
        if (t0 >= 2) { const unsigned v = *(const unsigned*)(pp - 2 * NINP); xm2 = (f32x2){bf2f(v & 0xffffu), __uint_as_float(v & 0xffff0000u)}; }
        if (t0 >= 1) { const unsigned v = *(const unsigned*)(pp - NINP); xm1 = (f32x2){bf2f(v & 0xffffu), __uint_as_float(v & 0xffff0000u)}; }
        { const unsigned v = *(const unsigned*)pp; x0 = (f32x2){bf2f(v & 0xffffu), __uint_as_float(v & 0xffff0000u)}; }
#pragma unroll 8
        for (int i = 0; i < 32; ++i) { f32x2 xp1 = {0.f, 0.f};
            if (t0 + i + 1 < SEQ) { const unsigned v = *(const unsigned*)(pp + (size_t)(i + 1) * NINP); xp1 = (f32x2){bf2f(v & 0xffffu), __uint_as_float(v & 0xffff0000u)}; }
            const f32x2 acc = cb2 + w0 * xm2 + w1 * xm1 + w2 * x0 + w3 * xp1;
            const unsigned pk = pk2(acc.x, acc.y);
            *(unsigned*)(xcb + i * 136 + 2 * lane) = pk; *(unsigned*)(XC + (size_t)i * 1024 + 2 * lane) = pk;
            xm2 = xm1; xm1 = x0; x0 = xp1; }
        LDS_WAIT();
    }
    const bf16_t* WT = (const bf16_t*)(a.ws + WS_WGT);
    float2* LS = (float2*)(a.ws + WS_LSUM);
    const bf16_t* xcr = XC + (size_t)r32 * 1024 + hi * 8;
#pragma unroll 1
    for (int ct = 0; ct < 4; ++ct) {
    const int j = ct * 32 + r32, cj = n * 128 + j;
    float xv[16];
#pragma unroll
    for (int r = 0; r < 16; ++r) { const int t = (r & 3) + 8 * (r >> 2) + 4 * hi; xv[r] = bf2f(FINAL ? XC[(size_t)t * 1024 + j] : xcb[t * 136 + j]); }
    float hs[16];
#pragma unroll
    for (int d = 0; d < 2; ++d) {
        const bf16_t* wa_p = WT + ((size_t)((2 * d) * 8 + n) * 128 + j) * 128 + hi * 8;
        const bf16_t* wx_p = WT + ((size_t)((2 * d + 1) * 8 + n) * 128 + j) * 128 + hi * 8;
        f32x16_t ca, cx;
#pragma unroll
        for (int r = 0; r < 16; ++r) { ca[r] = 0.f; cx[r] = 0.f; }
#pragma unroll
        for (int s = 0; s < 8; ++s) {
            const bf16x8_t af = FINAL ? *(const bf16x8_t*)(xcr + s * 16) : *(const bf16x8_t*)((const char*)xcb + r32 * 272 + (s * 16 + hi * 8) * 2);
            const bf16x8_t fa = *(const bf16x8_t*)(wa_p + s * 16); const bf16x8_t fx = *(const bf16x8_t*)(wx_p + s * 16);
            ca = __builtin_amdgcn_mfma_f32_32x32x16_bf16(af, fa, ca, 0, 0, 0); cx = __builtin_amdgcn_mfma_f32_32x32x16_bf16(af, fx, cx, 0, 0, 0);
        }
        asm volatile("" ::: "memory");
        const float baj = a.in[d ? 33 : 28][cj], bxj = a.in[d ? 35 : 30][cj], sp = softplus_f(-a.in[d ? 36 : 31][cj]);
        float av[16], uv[16];
#pragma unroll
        for (int r = 0; r < 16; ++r) { const int t = (r & 3) + 8 * (r >> 2) + 4 * hi;
            const float rg = __builtin_amdgcn_rcpf(1.f + __expf(-(ca[r] + baj))), ig = __builtin_amdgcn_rcpf(1.f + __expf(-(cx[r] + bxj))); const float la = -8.f * rg * sp;
            av[r] = __expf(la);
            const float om = (la > -0.0625f) ? -2.f * la * (1.f + la * (1.f + la * (0.6666667f + 0.3333333f * la))) : (1.f - av[r]) * (1.f + av[r]);
            uv[r] = __builtin_amdgcn_sqrtf(om) * (ig * xv[r]); }
        asm volatile("" ::: "memory");
        float Pg[4], Hg[4];
#pragma unroll
        for (int sg = 0; sg < 4; ++sg) { float Pp = 1.f, Hh = 0.f;
#pragma unroll
            for (int e4 = 0; e4 < 4; ++e4) { const int r = 4 * sg + (d ? 3 - e4 : e4); Hh = fmaf(av[r], Hh, uv[r]); Pp *= av[r]; }
            Pg[sg] = Pp; Hg[sg] = Hh; }
        float Po[4], Ho[4];
#pragma unroll
        for (int sg = 0; sg < 4; ++sg) { Po[sg] = __shfl_xor(Pg[sg], 32); Ho[sg] = __shfl_xor(Hg[sg], 32); }
        if constexpr (!FINAL) {
            float Ac = 1.f, Hc = 0.f;
#pragma unroll
            for (int qq = 0; qq < 8; ++qq) { const int q = d ? 7 - qq : qq;
                const bool mine = ((q & 1) == hi); const float pq = mine ? Pg[q >> 1] : Po[q >> 1], hq_ = mine ? Hg[q >> 1] : Ho[q >> 1];
                Hc = fmaf(pq, Hc, hq_); Ac *= pq; }
            if (hi == 0) LS[((size_t)(d * 4 + b) * 64 + tc) * 1024 + cj] = make_float2(Ac, Hc);
        } else {
            float c = 0.f;
            const float2* lsp = LS + ((size_t)(d * 4 + b) * 64) * 1024 + cj;
            const int nneed = d ? 63 - tc : tc;
#pragma unroll 1
            for (int c0 = 0; c0 < nneed; c0 += 16) { float2 sv[16];
#pragma unroll
                for (int i = 0; i < 16; ++i) { const int ci = (c0 + i < nneed) ? c0 + i : nneed - 1; const int cc = d ? 63 - ci : ci; sv[i] = lsp[(size_t)cc * 1024]; }
#pragma unroll
                for (int i = 0; i < 16; ++i) { if (c0 + i < nneed) c = fmaf(sv[i].x, c, sv[i].y); } }
            asm volatile("" ::: "memory");
            float cin[4];
#pragma unroll
            for (int qq = 0; qq < 8; ++qq) { const int q = d ? 7 - qq : qq;
                const bool mine = ((q & 1) == hi); const float pq = mine ? Pg[q >> 1] : Po[q >> 1], hq_ = mine ? Hg[q >> 1] : Ho[q >> 1];
                if (mine) cin[q >> 1] = c;
                c = fmaf(pq, c, hq_); }
#pragma unroll
            for (int sg = 0; sg < 4; ++sg) { float h = cin[sg];
#pragma unroll
                for (int e4 = 0; e4 < 4; ++e4) { const int r = 4 * sg + (d ? 3 - e4 : e4); h = fmaf(av[r], h, uv[r]); hs[r] = (d == 0) ? h : hs[r] + h; } }
        }
    }
    if constexpr (FINAL) {
        bf16_t* YC = (bf16_t*)(a.ws + WS_YCAT);
#pragma unroll
        for (int r = 0; r < 16; ++r) { const int t = (r & 3) + 8 * (r >> 2) + 4 * hi; const size_t row = (size_t)b * SEQ + t0 + t;
            const float gl = bf2f(P[row * NINP + C_GL + cj]);
            YC[row * 2048 + 1024 + cj] = (bf16_t)f2bf(hs[r] * silu_f(gl)); }
    }
    }
    LDS_WAIT();
}

template <int d>
__device__ __forceinline__ void lru_run(const Args& a, int task, int lane) {
    asm volatile("" : "+v"(lane));
    const int run = task & 7, ct = (task >> 4) & 3, n = (task >> 6) & 7, b = task >> 9;
    const int r32 = lane & 31, hi = lane >> 5, j = ct * 32 + r32, cj = n * 128 + j;
    const bf16_t* WT = (const bf16_t*)(a.ws + WS_WGT);
    const bf16_t* wa_p = WT + ((size_t)((2 * d) * 8 + n) * 128 + j) * 128 + hi * 8;
    const bf16_t* wx_p = WT + ((size_t)((2 * d + 1) * 8 + n) * 128 + j) * 128 + hi * 8;
    bf16x8_t fa[8], fx[8];
#pragma unroll
    for (int s = 0; s < 8; ++s) { fa[s] = *(const bf16x8_t*)(wa_p + s * 16); fx[s] = *(const bf16x8_t*)(wx_p + s * 16); }
    const float baj = a.in[d ? 33 : 28][cj], bxj = a.in[d ? 35 : 30][cj], sp = softplus_f(-a.in[d ? 36 : 31][cj]);
    const float2* lsp = (const float2*)(a.ws + WS_LSUM) + ((size_t)(d * 4 + b) * 64) * 1024 + cj;
    bf16_t* HD = (bf16_t*)(a.ws + (d ? WS_HB16 : WS_HF16));
    float c = 0.f;
    { const int nneed = 8 * run;
#pragma unroll 1
      for (int c0 = 0; c0 < nneed; c0 += 8) { float2 sv[8];
#pragma unroll
          for (int i = 0; i < 8; ++i) { const int ci = c0 + i; const int cc = d ? 63 - ci : ci; sv[i] = lsp[(size_t)cc * 1024]; }
#pragma unroll
          for (int i = 0; i < 8; ++i) c = fmaf(sv[i].x, c, sv[i].y); } }
#pragma unroll 1
    for (int k = 0; k < 8; ++k) {
        const int ci = 8 * run + k, tc = d ? 63 - ci : ci, t0 = tc * 32;
        const bf16_t* XC = (const bf16_t*)(a.ws + WS_XC16) + ((size_t)b * SEQ + t0) * 1024 + n * 128;
        const bf16_t* xcr = XC + (size_t)r32 * 1024 + hi * 8;
        f32x16_t ca, cx;
#pragma unroll
        for (int r = 0; r < 16; ++r) { ca[r] = 0.f; cx[r] = 0.f; }
#pragma unroll
        for (int s = 0; s < 8; ++s) { const bf16x8_t af = *(const bf16x8_t*)(xcr + s * 16);
            ca = __builtin_amdgcn_mfma_f32_32x32x16_bf16(af, fa[s], ca, 0, 0, 0); cx = __builtin_amdgcn_mfma_f32_32x32x16_bf16(af, fx[s], cx, 0, 0, 0); }
        float av[16], uv[16];
#pragma unroll
        for (int r = 0; r < 16; ++r) { const int t = (r & 3) + 8 * (r >> 2) + 4 * hi;
            const float xvr = bf2f(XC[(size_t)t * 1024 + j]);
            const float rg = __builtin_amdgcn_rcpf(1.f + __expf(-(ca[r] + baj))), ig = __builtin_amdgcn_rcpf(1.f + __expf(-(cx[r] + bxj))); const float la = -8.f * rg * sp;
            av[r] = __expf(la);
            const float om = (la > -0.0625f) ? -2.f * la * (1.f + la * (1.f + la * (0.6666667f + 0.3333333f * la))) : (1.f - av[r]) * (1.f + av[r]);
            uv[r] = __builtin_amdgcn_sqrtf(om) * (ig * xvr); }
        float Pg[4], Hg[4];
#pragma unroll
        for (int sg = 0; sg < 4; ++sg) { float Pp = 1.f, Hh = 0.f;
#pragma unroll
            for (int e4 = 0; e4 < 4; ++e4) { const int r = 4 * sg + (d ? 3 - e4 : e4); Hh = fmaf(av[r], Hh, uv[r]); Pp *= av[r]; }
            Pg[sg] = Pp; Hg[sg] = Hh; }
        float Po[4], Ho[4];
#pragma unroll
        for (int sg = 0; sg < 4; ++sg) { Po[sg] = __shfl_xor(Pg[sg], 32); Ho[sg] = __shfl_xor(Hg[sg], 32); }
        float cin[4];
#pragma unroll
        for (int qq = 0; qq < 8; ++qq) { const int q = d ? 7 - qq : qq;
            const bool mine = ((q & 1) == hi); const float pq = mine ? Pg[q >> 1] : Po[q >> 1], hq_ = mine ? Hg[q >> 1] : Ho[q >> 1];
            if (mine) cin[q >> 1] = c;
            c = fmaf(pq, c, hq_); }
#pragma unroll
        for (int sg = 0; sg < 4; ++sg) { float h = cin[sg];
#pragma unroll
            for (int e4 = 0; e4 < 4; ++e4) { const int r = 4 * sg + (d ? 3 - e4 : e4); const int t = (r & 3) + 8 * (r >> 2) + 4 * hi;
                h = fmaf(av[r], h, uv[r]); HD[((size_t)b * SEQ + t0 + t) * 1024 + cj] = (bf16_t)f2bf(h); } }
    }
}

__device__ __forceinline__ void combine1_phase(const Args& a, int gw, int NGW, int lane) {
    const float* OF = (const float*)(a.ws + WS_YF); const float* OB = (const float*)(a.ws + WS_YB);
    const bf16_t* P = (const bf16_t*)(a.ws + WS_PROJ); bf16_t* YC = (bf16_t*)(a.ws + WS_YCAT);
    const float* gn = a.in[24];
    for (int m = gw; m < MTOK; m += NGW) {
        const int ch = lane * 16, d0 = ch & 127;
        float z[16], ov[16];
        unpack8(*(const v4u*)(P + (size_t)m * NINP + C_Z + ch), z); unpack8(*(const v4u*)(P + (size_t)m * NINP + C_Z + ch + 8), z + 8);
#pragma unroll
        for (int q = 0; q < 4; ++q) { const f32x4 f = *(const f32x4*)(OF + (size_t)m * 1024 + ch + 4 * q), bk = *(const f32x4*)(OB + (size_t)m * 1024 + ch + 4 * q); const f32x4 o = f + bk;
            ov[4 * q] = o.x; ov[4 * q + 1] = o.y; ov[4 * q + 2] = o.z; ov[4 * q + 3] = o.w; }
        float ss = 0.f;
#pragma unroll
        for (int i = 0; i < 16; ++i) ss += ov[i] * ov[i];
        ss = group_sum<8>(ss);
        const float r = rsqrtf(ss * (1.f / 128.f) + EPS);
#pragma unroll
        for (int i = 0; i < 16; ++i) ov[i] = ov[i] * r * gn[d0 + i] * silu_f(z[i]);
        *(v4u*)(YC + (size_t)m * 2048 + ch) = pack8(ov); *(v4u*)(YC + (size_t)m * 2048 + ch + 8) = pack8(ov + 8);
        { const bf16_t* HF = (const bf16_t*)(a.ws + WS_HF16); const bf16_t* HB = (const bf16_t*)(a.ws + WS_HB16);
          float hf[16], hb[16];
          unpack8(*(const v4u*)(P + (size_t)m * NINP + C_GL + ch), z); unpack8(*(const v4u*)(P + (size_t)m * NINP + C_GL + ch + 8), z + 8);
          unpack8(*(const v4u*)(HF + (size_t)m * 1024 + ch), hf); unpack8(*(const v4u*)(HF + (size_t)m * 1024 + ch + 8), hf + 8);
          unpack8(*(const v4u*)(HB + (size_t)m * 1024 + ch), hb); unpack8(*(const v4u*)(HB + (size_t)m * 1024 + ch + 8), hb + 8);
#pragma unroll
          for (int i = 0; i < 16; ++i) ov[i] = (hf[i] + hb[i]) * silu_f(z[i]);
          *(v4u*)(YC + (size_t)m * 2048 + 1024 + ch) = pack8(ov); *(v4u*)(YC + (size_t)m * 2048 + 1024 + ch + 8) = pack8(ov + 8); }
    }
}

__device__ __forceinline__ void final_norm_phase(const Args& a, int gw, int NGW, int lane) {
    const float* nw = a.in[38];
    for (int m = gw; m < MTOK; m += NGW) {
        f32x4* xr = (f32x4*)(a.out + (size_t)m * 2048) + lane;
        f32x4 v[8]; float s = 0.f;
#pragma unroll
        for (int j = 0; j < 8; ++j) { v[j] = xr[64 * j]; s += (v[j].x * v[j].x + v[j].y * v[j].y) + (v[j].z * v[j].z + v[j].w * v[j].w); }
        const float rstd = rsqrtf(group_sum<64>(s) * (1.f / 2048.f) + EPS);
#pragma unroll
        for (int j = 0; j < 8; ++j) { const f32x4 w = *(const f32x4*)(nw + (64 * j + lane) * 4); xr[64 * j] = v[j] * rstd * w; }
    }
}

typedef GAS unsigned gu32;
#define RLX_AGENT __ATOMIC_RELAXED, __HIP_MEMORY_SCOPE_AGENT
constexpr int CW_BAR = 4096;
constexpr int MISC_OFF = 147456 - 128;
#define XB_TMO      128
#define XB_XCNT(j)  (256  + 64 * (j))
#define XB_XSUB(j)  (1280 + 64 * (j))
#define XB_XGEN(j)  (2304 + 64 * (j))
#define XB_TOP      3328
#define XB_TOPGEN   3392
#define XCD_BAR_WORDS 3456
#define XB_SPIN_CAP (1u << 18)

__device__ __forceinline__ unsigned xb_ld(unsigned* p)              { return __hip_atomic_load(p, __ATOMIC_RELAXED, __HIP_MEMORY_SCOPE_AGENT); }
__device__ __forceinline__ unsigned xb_add(unsigned* p, unsigned v) { return __hip_atomic_fetch_add(p, v, __ATOMIC_RELAXED, __HIP_MEMORY_SCOPE_AGENT); }
__device__ __forceinline__ unsigned xb_xcc_id() { return (unsigned)__builtin_amdgcn_s_getreg((3 << 11) | 20) & 0xFu; }
#define XB_SPIN(cond, bar) do { unsigned _sp = 0; while (cond) { __builtin_amdgcn_s_sleep(1); \
    if ((++_sp & 255u) == 0u) { if (xb_ld(&(bar)[XB_TMO])) break; if (_sp > XB_SPIN_CAP) { atomicAdd(&(bar)[XB_TMO], 1u); break; } } } } while (0)

struct XcdBarrier {
    unsigned* bar; unsigned x;
    volatile LAS unsigned* st;
};

__device__ __forceinline__ XcdBarrier xcd_barrier_post(unsigned* bar, volatile LAS unsigned* st) {
    XcdBarrier b; b.bar = bar; b.x = xb_xcc_id(); b.st = st;
    if (threadIdx.x == 0) (void)xb_add(&bar[XB_XCNT(b.x)], 1u);
    return b;
}
__device__ __forceinline__ void xcd_barrier_complete(unsigned* bar, unsigned x, unsigned& nloc, unsigned& nx) {
    const unsigned G = gridDim.x * gridDim.y * gridDim.z;
    unsigned sum, cnt, mine, sp = 0u;
    for (;;) {
        sum = 0u; cnt = 0u; mine = 0u;
#pragma unroll
        for (unsigned j = 0; j < 16; ++j) { const unsigned c = xb_ld(&bar[XB_XCNT(j)]); sum += c; cnt += (c > 0u) ? 1u : 0u; mine = (j == x) ? c : mine; }
        if (sum == G) break;
        __builtin_amdgcn_s_sleep(1);
        if ((++sp & 255u) == 0u) { if (xb_ld(&bar[XB_TMO])) break; if (sp > XB_SPIN_CAP) { atomicAdd(&bar[XB_TMO], 1u); break; } }
    }
    nloc = mine > 0u ? mine : 1u; nx = cnt > 0u ? cnt : 1u;
}

__device__ __forceinline__ void xcd_barrier(const XcdBarrier& b) {
    asm volatile("s_waitcnt vmcnt(0)" ::: "memory");
    __syncthreads();
    if (threadIdx.x == 0) {
        unsigned* bar = b.bar;
        __builtin_amdgcn_s_waitcnt(0);
        unsigned nloc = b.st[0], nx = b.st[1];
        if (nloc == 0u) { xcd_barrier_complete(bar, b.x, nloc, nx); b.st[0] = nloc; b.st[1] = nx; }
        const unsigned old = xb_add(&bar[XB_XSUB(b.x)], 1u);
        const unsigned gen = old / nloc;
        if (old + 1u == (gen + 1u) * nloc) {
            __builtin_amdgcn_fence(__ATOMIC_RELEASE, "agent");
            asm volatile("s_waitcnt vmcnt(0)" ::: "memory");
            const unsigned og = xb_add(&bar[XB_TOP], 1u);
            const unsigned tg = og / nx;
            if (og + 1u == (tg + 1u) * nx) xb_add(&bar[XB_TOPGEN], 1u);
            else XB_SPIN(xb_ld(&bar[XB_TOPGEN]) == tg, bar);
            __builtin_amdgcn_fence(__ATOMIC_ACQUIRE, "agent");
            xb_add(&bar[XB_XGEN(b.x)], 1u);
            asm volatile("s_waitcnt vmcnt(0)" ::: "memory");
        } else {
            XB_SPIN(xb_ld(&bar[XB_XGEN(b.x)]) == gen, bar);
            __builtin_amdgcn_fence(__ATOMIC_ACQUIRE, "agent");
            asm volatile("s_waitcnt vmcnt(0)" ::: "memory");
        }
    }
    __syncthreads();
}

#ifndef PROBE_MASK
#define PROBE_MASK 0
#endif
#define REP(bit) for (int rep_ = 0; rep_ < 1 + ((PROBE_MASK >> (bit)) & 1); ++rep_)
#ifndef PROBE_SSD
#define PROBE_SSD 0
#endif
#ifndef PROBE_GDN
#define PROBE_GDN 0
#endif
#ifndef PROBE_LRU
#define PROBE_LRU 0
#endif
#ifndef MK_SINGLE
#define MK_SINGLE 1
#endif
__global__ void __launch_bounds__(NTHREADS, 2) mk_fwd(Args a) {
    extern __shared__ __attribute__((aligned(16))) unsigned char lds[];
    LAS unsigned char* ldsl = (LAS unsigned char*)lds;
    const int tid = threadIdx.x, lane = tid & 63, wave = __builtin_amdgcn_readfirstlane(tid >> 6);
    const int G = gridDim.x, bx = blockIdx.x;
    const int vcu = (G % 8 == 0) ? (bx % 8) * (G / 8) + bx / 8 : bx;
    const int gw = vcu * NWAVES + wave, NGW = G * NWAVES;
    unsigned char* ws = a.ws;
    volatile LAS unsigned* MISC = (volatile LAS unsigned*)(ldsl + MISC_OFF);
    if (tid < 32) MISC[tid] = 0u;
    __syncthreads();
    XcdBarrier bar; bar.bar = (unsigned*)(ws + WS_CTL) + CW_BAR; bar.x = 0; bar.st = nullptr;
    if (a.ph_hi - a.ph_lo > 1) bar = xcd_barrier_post((unsigned*)(ws + WS_CTL) + CW_BAR, MISC + 8);
#define IN(k) (a.ph_lo <= (k) && (k) < a.ph_hi)
#define SEAM(k) do { if (IN(k) && IN((k) + 1)) { xcd_barrier(bar); } } while (0)

    if (IN(0)) { p0_prologue(a, ldsl, vcu, G); } SEAM(0);
    if (IN(1)) { REP(0) normmod_phase(a, a.in[0], 0, gw, NGW, lane); } SEAM(1);
    if (IN(2)) {
        pg8::Gemm g{(const bf16_t*)(ws + WS_H), (const bf16_t*)(ws + WS_WIN0), MTOK, NINP, 2048}; pg8::StaticOrder S; S.init(MTOK, NINP, G, bx);
        pg8::EpiProj E{(bf16_t*)(ws + WS_PROJ), (float*)(ws + WS_SMALL), NINP, A_DT / 256};
        REP(1) { pg8::gemm_phase<pg8::EpiProj, pg8::StaticOrder, true, true>(ldsl, g, S, E); __syncthreads(); }
    } SEAM(2);
    if (IN(3)) { REP(0) post0_phase(a, gw, NGW, lane); } SEAM(3);
    if (IN(4)) {
        REP(3) for (int u = vcu; u < 256; u += G) { const int b = u >> 6, h = (u >> 3) & 7, qb = u & 7, kvh = h >> 2; const size_t row0 = (size_t)b * SEQ + qb * 256;
            att::attn_dense_body((const att::bf16*)(ws + WS_QB) + row0 * 1024 + h * 128, (const att::bf16*)(ws + WS_KB) + (size_t)b * SEQ * 256 + kvh * 128,
                                 (const att::bf16*)(ws + WS_VB) + (size_t)b * SEQ * 256 + kvh * 128, (bf16_t*)(ws + WS_YCAT) + row0 * 2048 + h * 128,
                                 (const bf16_t*)(ws + WS_PROJ) + row0 * NINP + A_GA + h * 128, SEQ, (char*)lds);
            __syncthreads(); }
        for (int it = vcu; it < 256; it += G) {
            if (tid < 16) ((LAS unsigned*)(ldsl + ssd3::O_FLAG))[tid] = 0u;
            __syncthreads();
            if (wave == 0) ssd3::consumer(a, it, lds); else if (wave == 1) ssd3::producer(a, it, lds);
            __syncthreads(); }
    } SEAM(4);
    if (IN(5)) { REP(0) ssd_combine_phase(a, gw, NGW, lane); late_transposes(a, (LAS float*)(ldsl + wave * 16384), gw, NGW, lane); } SEAM(5);
    if (IN(6)) {
        pg8::Gemm g{(const bf16_t*)(ws + WS_YCAT), (const bf16_t*)(ws + WS_WOUT0), MTOK, 2048, 2048}; pg8::StaticOrder S; S.init(MTOK, 2048, G, bx);
        pg8::EpiResid E{a.in[0], a.out, (const float*)(ws + WS_MOD), a.in[3]};
        REP(2) { pg8::gemm_phase<pg8::EpiResid, pg8::StaticOrder, true, true>(ldsl, g, S, E); __syncthreads(); }
    } SEAM(6);
    if (IN(7)) { REP(0) normmod_phase(a, a.out, 1, gw, NGW, lane); } SEAM(7);
    if (IN(8)) {
        pg8::Gemm g{(const bf16_t*)(ws + WS_H), (const bf16_t*)(ws + WS_WIN1), MTOK, NINP, 2048}; pg8::StaticOrder S; S.init(MTOK, NINP, G, bx);
        pg8::EpiProj E{(bf16_t*)(ws + WS_PROJ), (float*)(ws + WS_SMALL), NINP, C_SM / 256};
        pg8::gemm_phase<pg8::EpiProj, pg8::StaticOrder, true, true>(ldsl, g, S, E);
    } SEAM(8);
    if (IN(9)) { REP(0) post1_phase(a, gw, NGW, lane); } SEAM(9);
    if (IN(10)) {
        REP(5) { for (int it = gw; it < 2048; it += NGW) gdn1_item(a, it, lds + wave * GDN_LDS_PER_WAVE, lane); __syncthreads(); }
        for (int wi = gw; wi < 2048; wi += NGW) lru_wave<false>(a, wi, lds + wave * GDN_LDS_PER_WAVE, lane);
    } SEAM(10);
    if (IN(11)) {
        if (wave == 0) { REP(6) for (int it = vcu; it < 256; it += G) gdn2_item(a, it, lds); }
        else if (wave <= 3) { REP(7) for (int tk = vcu * 3 + (wave - 1); tk < 2048; tk += G * 3) { if ((tk >> 3) & 1) lru_run<1>(a, tk, lane); else lru_run<0>(a, tk, lane); } }
        __syncthreads();
    } SEAM(11);
    if (IN(12)) { REP(0) combine1_phase(a, gw, NGW, lane); } SEAM(12);
    if (IN(13)) {
        pg8::Gemm g{(const bf16_t*)(ws + WS_YCAT), (const bf16_t*)(ws + WS_WOUT1), MTOK, 2048, 2048}; pg8::StaticOrder S; S.init(MTOK, 2048, G, bx);
        pg8::EpiResid E{a.out, a.out, (const float*)(ws + WS_MOD) + 4 * 6144, a.in[3] + 6144};
        pg8::gemm_phase<pg8::EpiResid, pg8::StaticOrder, true, true>(ldsl, g, S, E);
    } SEAM(13);
    if (IN(14)) { final_norm_phase(a, gw, NGW, lane); }
#undef IN
#undef SEAM
}

extern "C" void kernel_launch(void* const* d_in, const int* in_sizes, int n_in, void* d_out, int out_size, void* d_ws, size_t ws_size, hipStream_t stream) {
    static int grid = 0;
    if (grid == 0) {
        if (n_in != 39 || out_size != MTOK * DM || ws_size < WS_END) { fprintf(stderr, "kernel_launch: unexpected problem (n_in %d, out %d, ws %zu < %zu)\n", n_in, out_size, ws_size, (size_t)WS_END); grid = -1; return; }
        int dev = 0, cus = 0, per_cu = 0;
        if (hipGetDevice(&dev) != hipSuccess || hipDeviceGetAttribute(&cus, hipDeviceAttributeMultiprocessorCount, dev) != hipSuccess) { grid = -1; return; }
        if (hipFuncSetAttribute((const void*)mk_fwd, hipFuncAttributeMaxDynamicSharedMemorySize, LDS_BYTES) != hipSuccess) { fprintf(stderr, "kernel_launch: hipFuncSetAttribute failed\n"); grid = -1; return; }
        if (hipOccupancyMaxActiveBlocksPerMultiprocessor(&per_cu, (const void*)mk_fwd, NTHREADS, LDS_BYTES) != hipSuccess || per_cu < 1) { fprintf(stderr, "kernel_launch: occupancy query says %d\n", per_cu); (void)hipGetLastError(); per_cu = 1; }
        grid = cus;
    }
    if (grid < 0) return;
    (void)hipMemsetAsync((char*)d_ws + WS_CTL, 0, CTL_ZERO_BYTES, stream);
    Args a{};
    for (int i = 0; i < 39; ++i) a.in[i] = (const float*)d_in[i];
    a.out = (float*)d_out; a.ws = (unsigned char*)d_ws;
#if MK_SINGLE
    a.ph_lo = 0; a.ph_hi = NPHASE;
    void* kargs[] = {&a};
    hipError_t e = hipLaunchCooperativeKernel((const void*)mk_fwd, dim3(grid), dim3(NTHREADS), kargs, LDS_BYTES, stream);
    if (e != hipSuccess) fprintf(stderr, "kernel_launch: cooperative launch failed: %s (grid %d)\n", hipGetErrorString(e), grid);
#else
    for (int p = 0; p < NPHASE; ++p) { a.ph_lo = p; a.ph_hi = p + 1; hipLaunchKernelGGL(mk_fwd, dim3(grid), dim3(NTHREADS), LDS_BYTES, stream, a); }
#endif
}
```

```cpp
#include <hip/hip_runtime.h>
#include <hip/hip_cooperative_groups.h>
#include <hip/hip_bf16.h>
#include <cstdio>
#include <cstdint>
namespace cg = cooperative_groups;

constexpr int BATCH = 4, SEQ = 2048, DM = 2048, MTOK = BATCH * SEQ;
constexpr int NIN = 5152, NINP = 5376;
constexpr float EPS = 1e-6f;
constexpr int A_Q = 0, A_K = 1024, A_V = 1280, A_GA = 1536, A_XS = 2560, A_BS = 3584, A_CS = 3840, A_DT = 4096, A_Z = 4128;
constexpr int C_Q = 0, C_K = 512, C_V = 1024, C_SM = 2048, C_Z = 2080, C_XL = 3104, C_GL = 4128;
namespace pg8 {
#define PG8_LAS __attribute__((address_space(3)))
typedef unsigned short bf16_t;
typedef short bf16x8 __attribute__((ext_vector_type(8)));
typedef float f32x4 __attribute__((ext_vector_type(4)));
typedef unsigned u32x4 __attribute__((ext_vector_type(4)));
constexpr int BM = 256, BK = 64, HALF = 128, HTB = HALF * BK * 2  , STAGE_BYTES = 8 * HTB, NXCD = 8, WGM = 8;

__host__ __device__ __forceinline__ int lds_byte(int r, int c) { const int st = (r >> 4) * 2 + (c >> 5), rr = r & 15, cc = c & 31, ob = rr * 64 + cc * 2; return st * 1024 + (ob ^ (((ob >> 9) & 1) << 5)); }
__host__ __device__ __forceinline__ void stage_rc(int b, int& R, int& C) { const int st = b / 1024, sb = b % 1024, swz = sb ^ (((sb >> 9) & 1) << 5); R = (st >> 1) * 16 + swz / 64; C = (st & 1) * 32 + (swz % 64) / 2; }
__host__ __device__ __forceinline__ int perm32(int rho) { const int n = rho >> 4, i = rho & 15; return 8 * (i >> 2) + 4 * n + (i & 3); }

struct Unit { int pm, pn; };
struct Gemm { const bf16_t* A; const bf16_t* Bt; int M, N, K; };

struct StaticOrder {
    int nM, nN, nwg, G, c;
    __host__ __device__ void init(int M, int N, int G_, int c_) { nM = M / BM; nN = N / BM; nwg = nM * nN; G = G_; c = c_; }
    __host__ __device__ bool next(int i, Unit& u) const {
        const long L = (long)i * G + c; if (L >= nwg) return false;
        int wgid = (int)L; { const int q = nwg / NXCD, r = nwg % NXCD, xcd = wgid % NXCD, off = wgid / NXCD; wgid = (xcd < r ? xcd * (q + 1) : r * (q + 1) + (xcd - r) * q) + off; }
        const int nig = WGM * nN, gid = wgid / nig, fm = gid * WGM, gsz = (nM - fm) < WGM ? (nM - fm) : WGM;
        u.pm = fm + ((wgid % nig) % gsz); u.pn = (wgid % nig) / gsz; return true;
    }
    __device__ __forceinline__ void a_ready(const Unit&) const {}
    __device__ __forceinline__ void done(const Unit&) const {}
};

__device__ __forceinline__ unsigned cvt_pk_bf16(float lo, float hi) { unsigned r; asm volatile("v_cvt_pk_bf16_f32 %0, %1, %2" : "=v"(r) : "v"(lo), "v"(hi)); return r; }
typedef float f32x2 __attribute__((ext_vector_type(2)));
struct EpiProj {
    static constexpr bool PERM = true, AFTER_DRAIN = false;
    bf16_t* O; float* small; int ldc; int small_tile;
    __device__ __forceinline__ void operator()(const f32x4 (&acc)[2][2][4][2], const Unit& u, int wr, int wc, int fr, int fq) const {
        const int row0 = u.pm * BM + wr * 64 + fr; const int col0 = u.pn * BM + wc * 32 + 8 * fq;
        const bool sm = (u.pn == small_tile) && (wc == 0);
#pragma unroll
        for (int ai = 0; ai < 2; ++ai)
#pragma unroll
            for (int m = 0; m < 4; ++m) { const int row = row0 + ai * HALF + m * 16; bf16_t* rowp = O + (size_t)row * ldc + col0;
#pragma unroll
                for (int bj = 0; bj < 2; ++bj) { const f32x4 v0 = acc[ai][bj][m][0], v1 = acc[ai][bj][m][1];
                    u32x4 w; w.x = cvt_pk_bf16(v0[0], v0[1]); w.y = cvt_pk_bf16(v0[2], v0[3]); w.z = cvt_pk_bf16(v1[0], v1[1]); w.w = cvt_pk_bf16(v1[2], v1[3]);
                    *(u32x4*)(rowp + bj * HALF) = w; }
                if (sm) { float* sp = small + (size_t)row * 32 + 8 * fq; *(f32x4*)sp = acc[ai][0][m][0]; *(f32x4*)(sp + 4) = acc[ai][0][m][1]; } }
    }
};
struct EpiResid {
    static constexpr bool PERM = false, AFTER_DRAIN = false;
    const float* xin; float* xout; const float* gacc; const float* gbias;
    __device__ __forceinline__ void operator()(const f32x4 (&acc)[2][2][4][2], const Unit& u, int wr, int wc, int fr, int fq) const {
        const int b = u.pm >> 3;
        const int col0 = u.pn * BM + wc * 32 + 4 * fq;
#pragma unroll
        for (int bj = 0; bj < 2; ++bj)
#pragma unroll
            for (int n = 0; n < 2; ++n) { const int col = col0 + bj * HALF + n * 16;
                const f32x4 g = *(const f32x4*)(gacc + (size_t)b * 6144 + 4096 + col) + *(const f32x4*)(gbias + 4096 + col);
#pragma unroll
                for (int ai = 0; ai < 2; ++ai)
#pragma unroll
                    for (int m = 0; m < 4; ++m) { const size_t off = (size_t)(u.pm * BM + ai * HALF + wr * 64 + m * 16 + fr) * 2048 + col;
                        const f32x4 xv = *(const f32x4*)(xin + off); *(f32x4*)(xout + off) = xv + g * acc[ai][bj][m][n]; } }
    }
};
template <class Epi, class Sched, bool ALIGN_EPI = false, bool SP2 = false>
__device__ __forceinline__ void gemm_phase(PG8_LAS unsigned char* lds, const Gemm g, const Sched& S, const Epi& E) {
    const int tid = threadIdx.x, wid = __builtin_amdgcn_readfirstlane(tid >> 6), lane = tid & 63, wr = wid >> 2, wc = wid & 3, fr = lane & 15, fq = lane >> 4;
    const int K = g.K, nt = K / BK;
    unsigned voffA[2], voffB[2];
#pragma unroll
    for (int i = 0; i < 2; ++i) { int R, C; stage_rc(tid * 16 + i * 8192, R, C); const int Rb = Epi::PERM ? ((R & ~31) + perm32(R & 31)) : R;
        voffA[i] = (unsigned)(R * K + C) * 2u; voffB[i] = (unsigned)(Rb * K + C) * 2u; }
    const size_t kstep = (size_t)(BK * 2);
    const size_t hstep = (size_t)HALF * K * 2;
    const size_t tstep = 2 * hstep;
    const unsigned ldsw = (unsigned)wid * 1024u;
    const int aoff = lds_byte(wr * 64 + fr, fq * 8), boff = lds_byte(wc * 32 + fr, fq * 8);
#define PG8_SA(b, h) (((b) * 2 + (h)) * HTB)
#define PG8_SB(b, h) ((4 + (b) * 2 + (h)) * HTB)
#define PG8_STAGE(bufoff, gbase, voff) do { _Pragma("unroll") for (int _i = 0; _i < 2; ++_i) \
        __builtin_amdgcn_global_load_lds((const unsigned*)((const char*)(gbase) + (voff)[_i]), (PG8_LAS unsigned*)(lds + (bufoff) + ldsw + _i * 8192), 16, 0, 0); } while (0)
#define PG8_LDA(dst, b, h) do { _Pragma("unroll") for (int m = 0; m < 4; ++m) _Pragma("unroll") for (int k = 0; k < 2; ++k) dst[m][k] = *(const PG8_LAS bf16x8*)(lds + PG8_SA(b, h) + aoff + m * 2048 + k * 1024); } while (0)
#define PG8_LDB(dst, b, h) do { _Pragma("unroll") for (int n = 0; n < 2; ++n) _Pragma("unroll") for (int k = 0; k < 2; ++k) dst[n][k] = *(const PG8_LAS bf16x8*)(lds + PG8_SB(b, h) + boff + n * 2048 + k * 1024); } while (0)
#define PG8_MMA(ai, bj, At, Bt) do { __builtin_amdgcn_s_setprio(1); _Pragma("unroll") for (int m = 0; m < 4; ++m) _Pragma("unroll") for (int n = 0; n < 2; ++n) _Pragma("unroll") for (int k = 0; k < 2; ++k) \
        acc[ai][bj][m][n] = __builtin_amdgcn_mfma_f32_16x16x32_bf16(Bt[n][k], At[m][k], acc[ai][bj][m][n], 0, 0, 0); __builtin_amdgcn_s_setprio(0); } while (0)
#define PG8_WAIT_V(n) asm volatile("s_waitcnt vmcnt(" #n ")" ::: "memory")
#define PG8_WAIT_L(n) asm volatile("s_waitcnt lgkmcnt(" #n ")" ::: "memory")
#define PG8_BAR __builtin_amdgcn_s_barrier()
#define PG8_SCHED __builtin_amdgcn_sched_barrier(0)
    Unit cur, nxt; int ui = 0;
    if (!S.next(0, cur)) return;
    f32x4 acc[2][2][4][2];
#pragma unroll
    for (int a = 0; a < 2; ++a)
#pragma unroll
        for (int b = 0; b < 2; ++b)
#pragma unroll
            for (int m = 0; m < 4; ++m)
#pragma unroll
                for (int n = 0; n < 2; ++n) acc[a][b][m][n] = (f32x4){0.f, 0.f, 0.f, 0.f};
    bf16x8 At[4][2], B0[2][2], B1[2][2];
    const char* cA = (const char*)g.A + (size_t)cur.pm * tstep; const char* cB = (const char*)g.Bt + (size_t)cur.pn * tstep;
    S.a_ready(cur);
    if constexpr (SP2) {
        PG8_STAGE(PG8_SB(0, 0), cB, voffB); PG8_STAGE(PG8_SB(0, 1), cB + hstep, voffB); PG8_STAGE(PG8_SA(0, 0), cA, voffA); PG8_STAGE(PG8_SA(0, 1), cA + hstep, voffA);
        if (wr == 1) PG8_BAR;
        PG8_WAIT_V(2); PG8_BAR;
        PG8_STAGE(PG8_SB(1, 0), cB + kstep, voffB); PG8_STAGE(PG8_SA(1, 0), cA + kstep, voffA); PG8_STAGE(PG8_SB(1, 1), cB + hstep + kstep, voffB);
        PG8_WAIT_V(6); PG8_BAR;
    } else {
        PG8_STAGE(PG8_SB(0, 0), cB, voffB); PG8_STAGE(PG8_SA(0, 0), cA, voffA); PG8_STAGE(PG8_SB(0, 1), cB + hstep, voffB); PG8_STAGE(PG8_SA(0, 1), cA + hstep, voffA);
        if (wr == 1) PG8_BAR;
        PG8_WAIT_V(4); PG8_BAR;
        PG8_STAGE(PG8_SB(1, 0), cB + kstep, voffB); PG8_STAGE(PG8_SA(1, 0), cA + kstep, voffA); PG8_STAGE(PG8_SB(1, 1), cB + hstep + kstep, voffB);
        PG8_WAIT_V(6); PG8_BAR;
    }
    for (;;) {
        const bool has_next = S.next(ui + 1, nxt);
        const char* nA = has_next ? (const char*)g.A + (size_t)nxt.pm * tstep : cA; const char* nB = has_next ? (const char*)g.Bt + (size_t)nxt.pn * tstep : cB;
        for (int t = 0; t < nt; t += 2) {
            const bool last = (t == nt - 2);
            const char* a1 = cA + (size_t)(t + 1) * kstep;
            const char* a2 = last ? nA : cA + (size_t)(t + 2) * kstep; const char* b2 = last ? nB : cB + (size_t)(t + 2) * kstep;
            const char* a3 = a2 + kstep; const char* b3 = b2 + kstep;
            if (last && has_next) S.a_ready(nxt);
            if constexpr (SP2) {
            PG8_LDB(B0, 0, 0); PG8_LDB(B1, 0, 1); PG8_SCHED; PG8_LDA(At, 0, 0); PG8_STAGE(PG8_SA(1, 1), a1 + hstep, voffA);
            PG8_WAIT_V(8); PG8_WAIT_L(0); PG8_BAR; PG8_MMA(0, 0, At, B0); PG8_MMA(0, 1, At, B1); PG8_BAR; PG8_SCHED;
            PG8_LDA(At, 0, 1); PG8_STAGE(PG8_SB(0, 0), b2, voffB); PG8_STAGE(PG8_SB(0, 1), b2 + hstep, voffB); PG8_STAGE(PG8_SA(0, 0), a2, voffA);
            PG8_WAIT_V(8); PG8_WAIT_L(0); PG8_BAR; PG8_MMA(1, 0, At, B0); PG8_MMA(1, 1, At, B1); PG8_BAR; PG8_SCHED;
            PG8_LDB(B0, 1, 0); PG8_LDB(B1, 1, 1); PG8_SCHED; PG8_LDA(At, 1, 0); PG8_STAGE(PG8_SA(0, 1), a2 + hstep, voffA);
            PG8_WAIT_V(8); PG8_WAIT_L(0); PG8_BAR; PG8_MMA(0, 0, At, B0); PG8_MMA(0, 1, At, B1); PG8_BAR; PG8_SCHED;
            PG8_LDA(At, 1, 1); PG8_STAGE(PG8_SB(1, 0), b3, voffB); PG8_STAGE(PG8_SB(1, 1), b3 + hstep, voffB); PG8_STAGE(PG8_SA(1, 0), a3, voffA);
            PG8_WAIT_V(8); PG8_WAIT_L(0); PG8_BAR; PG8_MMA(1, 0, At, B0); PG8_MMA(1, 1, At, B1); PG8_BAR; PG8_SCHED;
            } else {
            PG8_LDB(B0, 0, 0); PG8_SCHED; PG8_LDA(At, 0, 0); PG8_STAGE(PG8_SA(1, 1), a1 + hstep, voffA);
            PG8_WAIT_L(8); PG8_BAR; PG8_WAIT_L(0); PG8_MMA(0, 0, At, B0); PG8_BAR; PG8_SCHED;
            PG8_LDB(B1, 0, 1); PG8_STAGE(PG8_SB(0, 0), b2, voffB);
            PG8_BAR; PG8_WAIT_L(0); PG8_MMA(0, 1, At, B1); PG8_BAR;
            PG8_LDA(At, 0, 1); PG8_STAGE(PG8_SA(0, 0), a2, voffA);
            PG8_BAR; PG8_WAIT_L(0); PG8_MMA(1, 0, At, B0); PG8_BAR; PG8_SCHED;
            PG8_STAGE(PG8_SB(0, 1), b2 + hstep, voffB);
            PG8_WAIT_V(6); PG8_BAR; PG8_MMA(1, 1, At, B1); PG8_BAR;
            PG8_LDB(B0, 1, 0); PG8_SCHED; PG8_LDA(At, 1, 0); PG8_STAGE(PG8_SA(0, 1), a2 + hstep, voffA);
            PG8_WAIT_L(8); PG8_BAR; PG8_WAIT_L(0); PG8_MMA(0, 0, At, B0); PG8_BAR; PG8_SCHED;
            PG8_LDB(B1, 1, 1); PG8_STAGE(PG8_SB(1, 0), b3, voffB);
            PG8_BAR; PG8_WAIT_L(0); PG8_MMA(0, 1, At, B1); PG8_BAR;
            PG8_LDA(At, 1, 1); PG8_STAGE(PG8_SA(1, 0), a3, voffA);
            PG8_BAR; PG8_WAIT_L(0); PG8_MMA(1, 0, At, B0); PG8_BAR; PG8_SCHED;
            PG8_STAGE(PG8_SB(1, 1), b3 + hstep, voffB);
            PG8_WAIT_V(6); PG8_BAR; PG8_MMA(1, 1, At, B1); PG8_BAR;
            }
        }
        if constexpr (ALIGN_EPI) { if (wr == 0) PG8_BAR; }
        if constexpr (!Epi::AFTER_DRAIN) { E(acc, cur, wr, wc, fr, fq); S.done(cur); }
        if (!has_next) break;
#pragma unroll
        for (int a = 0; a < 2; ++a)
#pragma unroll
            for (int b = 0; b < 2; ++b)
#pragma unroll
                for (int m = 0; m < 4; ++m)
#pragma unroll
                    for (int n = 0; n < 2; ++n) acc[a][b][m][n] = (f32x4){0.f, 0.f, 0.f, 0.f};
        cur = nxt; cA = nA; cB = nB; ++ui;
        if constexpr (ALIGN_EPI) { if (wr == 1) PG8_BAR; }
    }
    PG8_WAIT_V(0);
    if constexpr (!ALIGN_EPI) { if (wr == 0) PG8_BAR; }
    PG8_BAR;
    if constexpr (Epi::AFTER_DRAIN) { E.fused(acc, cur, wr, wc, fr, fq, lds, wid, lane); S.done(cur); }
#undef PG8_SA
#undef PG8_SB
#undef PG8_STAGE
#undef PG8_LDA
#undef PG8_LDB
#undef PG8_MMA
#undef PG8_WAIT_V
#undef PG8_WAIT_L
#undef PG8_BAR
#undef PG8_SCHED
}
}
namespace att {
using bf16 = __hip_bfloat16;
constexpr int   D = 128, NW = 8, QBLK = 32, KVBLK = 64;
constexpr float SCALE = 0.088388347648318440f;
constexpr float THR = 8.f;
constexpr int SDEPTH = 2;
constexpr int LDQ = 1024, LDK = 256, LDY = 2048, LDG = NINP;
constexpr size_t SHM_V = KVBLK * D * 2, SHM_K = KVBLK * D * 2, SHM_ATTN = 2 * SHM_V + 2 * SHM_K + NW * 64 * 4;
using bf16x8 = __attribute__((ext_vector_type(8))) short;
using s16x4  = __attribute__((ext_vector_type(4))) short;
using f32x16 = __attribute__((ext_vector_type(16))) float;
using f32x8  = __attribute__((ext_vector_type(8))) float;
using u32x4  = __attribute__((ext_vector_type(4))) unsigned;
#define KSWZ(row, colB) ((row) * 256 + ((colB) ^ (((row) & 7) << 4)))
#define SBAR() __builtin_amdgcn_sched_barrier(0)
__device__ __forceinline__ int crow(int r, int hi) { return (r & 3) + 8 * (r >> 2) + 4 * hi; }
__device__ __forceinline__ unsigned cvtpk(float lo, float hi) {
  unsigned r; asm volatile("v_cvt_pk_bf16_f32 %0, %1, %2" : "=v"(r) : "v"(lo), "v"(hi)); return r;
}
template <typename TIn> struct Stage;
template <> struct Stage<bf16>  { using T = bf16x8;
  __device__ static __forceinline__ T ld8(const bf16* p) { return *reinterpret_cast<const bf16x8*>(p); }
  __device__ static __forceinline__ bf16x8 tobf(T x) { return x; } };
template <> struct Stage<float> { using T = f32x8;
  __device__ static __forceinline__ T ld8(const float* p) { return *reinterpret_cast<const f32x8*>(p); }
  __device__ static __forceinline__ bf16x8 tobf(T x) {
    u32x4 w = {cvtpk(x[0], x[1]), cvtpk(x[2], x[3]), cvtpk(x[4], x[5]), cvtpk(x[6], x[7])}; return *reinterpret_cast<bf16x8*>(&w); } };

__device__ __forceinline__ void partialSM(f32x16& p0, f32x16& p1, float& m_reg, float& mn, float& alpha) {
  constexpr float C = SCALE * 1.4426950408889634f;
  float pmax = p0[0]; for (int r = 1; r < 16; ++r) pmax = fmaxf(pmax, p0[r]); for (int r = 0; r < 16; ++r) pmax = fmaxf(pmax, p1[r]);
  { auto rr = __builtin_amdgcn_permlane32_swap(__float_as_uint(pmax), __float_as_uint(pmax), false, false);
    pmax = fmaxf(__uint_as_float(rr[0]), __uint_as_float(rr[1])); }
  if (__builtin_expect(__all(pmax - m_reg <= THR / SCALE), 1)) { mn = m_reg; alpha = 1.f; }
  else { mn = fmaxf(m_reg, pmax); alpha = __builtin_amdgcn_exp2f((m_reg - mn) * C); m_reg = mn; }
  float mnC = -mn * C;
  for (int r = 0; r < 16; ++r) p0[r] = fmaf(p0[r], C, mnC); for (int r = 0; r < 16; ++r) p1[r] = fmaf(p1[r], C, mnC);
  for (int r = 0; r < 16; ++r) p0[r] = __builtin_amdgcn_exp2f(p0[r]);
}
__device__ __forceinline__ void finishSM(f32x16& p0, f32x16& p1, float alpha, float& l_reg, bf16x8& pa0, bf16x8& pa1, bf16x8& pa2, bf16x8& pa3) {
  for (int r = 0; r < 16; ++r) p1[r] = __builtin_amdgcn_exp2f(p1[r]);
  float ps = 0; for (int r = 0; r < 16; ++r) ps += p0[r]; for (int r = 0; r < 16; ++r) ps += p1[r];
  { auto rr = __builtin_amdgcn_permlane32_swap(__float_as_uint(ps), __float_as_uint(ps), false, false);
    ps = __uint_as_float(rr[0]) + __uint_as_float(rr[1]); }
  l_reg = l_reg * alpha + ps;
#define PK4(P, BASE, OUT) do { unsigned a0 = cvtpk(P[BASE + 0], P[BASE + 1]), a1 = cvtpk(P[BASE + 2], P[BASE + 3]);   \
    unsigned b0 = cvtpk(P[BASE + 4], P[BASE + 5]), b1 = cvtpk(P[BASE + 6], P[BASE + 7]);                              \
    auto r0 = __builtin_amdgcn_permlane32_swap(a0, b0, false, false); auto r1 = __builtin_amdgcn_permlane32_swap(a1, b1, false, false); \
    u32x4 w = {r0[0], r1[0], r0[1], r1[1]}; OUT = *reinterpret_cast<bf16x8*>(&w); } while (0)
  PK4(p0, 0, pa0); PK4(p0, 8, pa1); PK4(p1, 0, pa2); PK4(p1, 8, pa3);
#undef PK4
}
__device__ __forceinline__ void qkt(f32x16& p0, f32x16& p1, const bf16* Ks, const bf16x8* qr, int r32, int hi) {
  p0 = f32x16{}; p1 = f32x16{};
  for (int d0 = 0; d0 < 8; ++d0) { int cb = (d0 * 16 + hi * 8) * 2;
    bf16x8 b0 = *reinterpret_cast<const bf16x8*>((const char*)Ks + KSWZ(r32, cb));
    bf16x8 b1 = *reinterpret_cast<const bf16x8*>((const char*)Ks + KSWZ(32 + r32, cb));
    p0 = __builtin_amdgcn_mfma_f32_32x32x16_bf16(b0, qr[d0], p0, 0, 0, 0);
    p1 = __builtin_amdgcn_mfma_f32_32x32x16_bf16(b1, qr[d0], p1, 0, 0, 0); }
}
__device__ __forceinline__ int v_st(int k, int c) { const int kk = (k & ~0xC) | ((k & 4) << 1) | ((k & 8) >> 1); return ((kk >> 3) * 4 + (c >> 5)) * 512 + ((kk & 7) * 32 + (c & 31)) * 2; }
__device__ __forceinline__ int v_rd_base(int lane) { return ((lane & 3) << 3) | (((lane >> 2) & 3) << 6) | (((lane >> 4) & 1) << 5) | (((lane >> 5) & 1) << 8); }
constexpr int v_rd_off(int d0, int ks, int half) { return d0 * 512 + ks * 4096 + half * 2048; }
template <int OFF> __device__ __forceinline__ s16x4 tr_read(int vb) {
  s16x4 r; asm volatile("ds_read_b64_tr_b16 %0, %1 offset:%2" : "=&v"(r) : "v"(vb), "i"(OFF) : "memory"); return r;
}
template <int D0> __device__ __forceinline__ void pv_one(f32x16& od, int vb, bf16x8 pa0, bf16x8 pa1, bf16x8 pa2, bf16x8 pa3) {
  const s16x4 l0 = tr_read<v_rd_off(D0, 0, 0)>(vb), h0 = tr_read<v_rd_off(D0, 0, 1)>(vb), l1 = tr_read<v_rd_off(D0, 1, 0)>(vb), h1 = tr_read<v_rd_off(D0, 1, 1)>(vb);
  const s16x4 l2 = tr_read<v_rd_off(D0, 2, 0)>(vb), h2 = tr_read<v_rd_off(D0, 2, 1)>(vb), l3 = tr_read<v_rd_off(D0, 3, 0)>(vb), h3 = tr_read<v_rd_off(D0, 3, 1)>(vb);
  asm volatile("s_waitcnt lgkmcnt(0)" ::: "memory"); SBAR();
#define PK(L, H) (bf16x8){L[0], L[1], L[2], L[3], H[0], H[1], H[2], H[3]}
  od = __builtin_amdgcn_mfma_f32_32x32x16_bf16(pa0, PK(l0, h0), od, 0, 0, 0);
  od = __builtin_amdgcn_mfma_f32_32x32x16_bf16(pa1, PK(l1, h1), od, 0, 0, 0);
  od = __builtin_amdgcn_mfma_f32_32x32x16_bf16(pa2, PK(l2, h2), od, 0, 0, 0);
  od = __builtin_amdgcn_mfma_f32_32x32x16_bf16(pa3, PK(l3, h3), od, 0, 0, 0);
#undef PK
}
__device__ __forceinline__ void pv_d0(f32x16* o, int vb, bf16x8 pa0, bf16x8 pa1, bf16x8 pa2, bf16x8 pa3) {
  pv_one<0>(o[0], vb, pa0, pa1, pa2, pa3); pv_one<1>(o[1], vb, pa0, pa1, pa2, pa3); pv_one<2>(o[2], vb, pa0, pa1, pa2, pa3); pv_one<3>(o[3], vb, pa0, pa1, pa2, pa3);
}
__device__ __forceinline__ void attn_dense_body(const bf16* __restrict__ Qb, const bf16* __restrict__ Kh, const bf16* __restrict__ Vh,
                                                unsigned short* __restrict__ Yb, const unsigned short* __restrict__ Gb, int seq, char* lds) {
  using St = Stage<bf16>; using SQ = Stage<bf16>; using TQ = bf16;
  const int tid = threadIdx.x, wid = tid >> 6, lane = tid & 63, r32 = lane & 31, hi = lane >> 5;
  bf16* V_lds = (bf16*)lds; bf16* K_lds = (bf16*)(lds + 2 * SHM_V);
  float* ws = (float*)(lds + 2 * SHM_V + 2 * SHM_K) + wid * 64; float* li_l = ws; float* al_l = ws + 32;
  float m_reg = -1e30f, l_reg = 0; f32x16 o[4] = {}; bf16x8 qr[8];
  const TQ* Qw = Qb + (long)(wid * QBLK + r32) * LDQ + hi * 8;
#pragma unroll
  for (int d0 = 0; d0 < 8; ++d0) qr[d0] = SQ::tobf(SQ::ld8(Qw + d0 * 16));
  const int sr = tid >> 4, sc = (tid & 15) * 8, vst0 = v_st(sr, sc), vst1 = v_st(32 + sr, sc);
  const int vb0 = (int)(uintptr_t)V_lds + v_rd_base(lane);
  struct { typename St::T vs0, vs1, ks0, ks1; } sr_[SDEPTH];
#define SLOAD(i, k0) do { sr_[i].vs0 = St::ld8(&Vh[(long)((k0) + sr) * LDK + sc]); sr_[i].vs1 = St::ld8(&Vh[(long)((k0) + 32 + sr) * LDK + sc]); \
    sr_[i].ks0 = St::ld8(&Kh[(long)((k0) + sr) * LDK + sc]); sr_[i].ks1 = St::ld8(&Kh[(long)((k0) + 32 + sr) * LDK + sc]); } while (0)
#define SWRITE(b, i) do { *(bf16x8*)((char*)V_lds + (b) * SHM_V + vst0) = St::tobf(sr_[i].vs0);          \
    *(bf16x8*)((char*)V_lds + (b) * SHM_V + vst1) = St::tobf(sr_[i].vs1); int kc = sc * 2;               \
    *(bf16x8*)((char*)K_lds + (b) * SHM_K + KSWZ(sr, kc)) = St::tobf(sr_[i].ks0);                       \
    *(bf16x8*)((char*)K_lds + (b) * SHM_K + KSWZ(32 + sr, kc)) = St::tobf(sr_[i].ks1); } while (0)
#define SWAIT() do { if constexpr (SDEPTH == 2) asm volatile("s_waitcnt vmcnt(4)" ::: "memory"); else asm volatile("s_waitcnt vmcnt(0)" ::: "memory"); } while (0)
#define RESC(a) do { if (__any((a) < 1.f)) { if (hi == 0) al_l[r32] = (a); asm volatile("s_waitcnt lgkmcnt(0)" ::: "memory"); \
    for (int d = 0; d < 4; ++d) for (int r = 0; r < 16; ++r) o[d][r] *= al_l[crow(r, hi)]; } } while (0)
  f32x16 pA0, pA1, pB0, pB1; float mnA, mnB, alA, alB; bf16x8 pa0, pa1, pa2, pa3; const int NT = seq / KVBLK;
  constexpr int SE = 0, SO = SDEPTH - 1;
  SLOAD(SE, 0); asm volatile("s_waitcnt vmcnt(0)" ::: "memory"); SWRITE(0, SE); __syncthreads();
  qkt(pA0, pA1, K_lds, qr, r32, hi); partialSM(pA0, pA1, m_reg, mnA, alA);
  SLOAD(SO, KVBLK); if constexpr (SDEPTH == 2) { if (2 < NT) SLOAD(SE, 2 * KVBLK); }
  SWAIT(); SWRITE(1, SO); __syncthreads();
  for (int j = 1; j + 1 < NT; j += 2) {
    SBAR(); qkt(pB0, pB1, (bf16*)((char*)K_lds + SHM_K), qr, r32, hi);
    finishSM(pA0, pA1, alA, l_reg, pa0, pa1, pa2, pa3); SBAR();
    SLOAD(SO, (j + SDEPTH) * KVBLK); SBAR();
    pv_d0(o, vb0, pa0, pa1, pa2, pa3); partialSM(pB0, pB1, m_reg, mnB, alB);
    __syncthreads(); SWAIT(); SWRITE(0, SE);
    RESC(alB); __syncthreads();
    SBAR(); qkt(pA0, pA1, K_lds, qr, r32, hi);
    finishSM(pB0, pB1, alB, l_reg, pa0, pa1, pa2, pa3); SBAR();
    if (SDEPTH == 1 || j + 3 < NT) SLOAD(SE, (j + 1 + SDEPTH) * KVBLK); SBAR();
    pv_d0(o, vb0 + (int)SHM_V, pa0, pa1, pa2, pa3); partialSM(pA0, pA1, m_reg, mnA, alA);
    __syncthreads(); SWAIT(); SWRITE(1, SO);
    RESC(alA); __syncthreads();
  }
  SBAR(); qkt(pB0, pB1, (bf16*)((char*)K_lds + SHM_K), qr, r32, hi);
  finishSM(pA0, pA1, alA, l_reg, pa0, pa1, pa2, pa3); SBAR();
  pv_d0(o, vb0, pa0, pa1, pa2, pa3); partialSM(pB0, pB1, m_reg, mnB, alB);
  __syncthreads(); RESC(alB);
  finishSM(pB0, pB1, alB, l_reg, pa0, pa1, pa2, pa3); SBAR();
  pv_d0(o, vb0 + (int)SHM_V, pa0, pa1, pa2, pa3);
  if (hi == 0) li_l[r32] = l_reg; asm volatile("s_waitcnt lgkmcnt(0)" ::: "memory");
  float rli[16];
#pragma unroll
  for (int r = 0; r < 16; ++r) rli[r] = __builtin_amdgcn_rcpf(li_l[crow(r, hi)]);
  __syncthreads();
  { int ew = wid; asm volatile("" : "+v"(ew));
    float* stg = (float*)lds + ew * (32 * 132);
#pragma unroll
    for (int r = 0; r < 16; ++r) { const int orow = crow(r, hi);
#pragma unroll
      for (int d0 = 0; d0 < 4; ++d0) stg[orow * 132 + d0 * 32 + r32] = o[d0][r] * rli[r]; }
    asm volatile("s_waitcnt lgkmcnt(0)" ::: "memory");
    int el = lane; asm volatile("" : "+v"(el));
    const unsigned short* Gw0 = Gb + (long)(ew * QBLK) * LDG; unsigned short* Yw0 = Yb + (long)(ew * QBLK) * LDY;
#pragma unroll 2
    for (int i = 0; i < 8; ++i) { const int id = el + 64 * i, row = id >> 4, c8 = id & 15;
      const float* sp = stg + row * 132 + c8 * 8;
      const u32x4 gw = *reinterpret_cast<const u32x4*>(Gw0 + (long)row * LDG + c8 * 8);
      u32x4 ow;
#pragma unroll
      for (int q = 0; q < 4; ++q) { const unsigned gq = (q == 0) ? gw.x : (q == 1) ? gw.y : (q == 2) ? gw.z : gw.w;
        const float g0 = __uint_as_float(gq << 16), g1 = __uint_as_float(gq & 0xffff0000u);
        const float v0 = sp[2 * q] * (g0 / (1.f + __expf(-g0))), v1 = sp[2 * q + 1] * (g1 / (1.f + __expf(-g1)));
        const unsigned pk = cvtpk(v0, v1);
        if (q == 0) ow.x = pk; else if (q == 1) ow.y = pk; else if (q == 2) ow.z = pk; else ow.w = pk; }
      *reinterpret_cast<u32x4*>(Yw0 + (long)row * LDY + c8 * 8) = ow; } }
#undef SLOAD
#undef SWRITE
#undef SWAIT
#undef RESC
}
}
#define GAS __attribute__((address_space(1)))
#define LAS __attribute__((address_space(3)))
typedef unsigned short bf16_t;
typedef unsigned v4u __attribute__((ext_vector_type(4)));
typedef unsigned v2u __attribute__((ext_vector_type(2)));
typedef float f32x4 __attribute__((ext_vector_type(4)));
typedef short bf16x8_t __attribute__((ext_vector_type(8)));
typedef float f32x16_t __attribute__((ext_vector_type(16)));
#define LDS_WAIT() asm volatile("s_waitcnt lgkmcnt(0)" ::: "memory")

constexpr size_t MiB = 1u << 20;
constexpr size_t WS_CTL = 0, CTL_ZERO_BYTES = 1 * MiB;
constexpr size_t WS_MOD = 64 * 1024;
constexpr size_t WS_ROPE = 1 * MiB;
constexpr size_t WS_SMALL = 2 * MiB;
constexpr size_t WS_WIN0 = 3 * MiB, WS_WOUT0 = 24 * MiB;
constexpr size_t WS_QB = 32 * MiB, WS_KB = 48 * MiB, WS_VB = 52 * MiB;
constexpr size_t WS_HB = 3 * MiB;
constexpr size_t WS_WIN1 = 56 * MiB, WS_WOUT1 = 77 * MiB;
constexpr size_t WS_H = 85 * MiB;
constexpr size_t WS_HF = 85 * MiB;
constexpr size_t WS_PROJ = 117 * MiB;
constexpr size_t WS_YCAT = 201 * MiB;
constexpr size_t WS_ACT = 233 * MiB;
constexpr size_t WS_YF = 297 * MiB, WS_YB = 329 * MiB;
constexpr size_t WS_XBC16 = 85 * MiB;
constexpr size_t WS_QKV16 = 3 * MiB;
constexpr size_t WS_XC16 = 35 * MiB;
constexpr size_t WS_GT = 85 * MiB, WS_GA = 101 * MiB;
constexpr size_t WS_WGT = 361 * MiB;
constexpr size_t WS_LSUM = 362 * MiB;
constexpr size_t WS_HF16 = 56 * MiB;
constexpr size_t WS_HB16 = 366 * MiB;
constexpr size_t WS_END = 382 * MiB;

constexpr int NWAVES = 8, NTHREADS = 512;
constexpr int LDS_BYTES = 163840;
constexpr int NPHASE = 15;

struct Args { const float* in[39]; float* out; unsigned char* ws; int ph_lo, ph_hi; };

__device__ __forceinline__ float bf2f(unsigned v) { return __uint_as_float(v << 16); }
__device__ __forceinline__ unsigned f2bf(float f) { unsigned u = __float_as_uint(f); return (u + 0x7fffu + ((u >> 16) & 1u)) >> 16; }
__device__ __forceinline__ unsigned pk2(float lo, float hi) { return f2bf(lo) | (f2bf(hi) << 16); }
__device__ __forceinline__ void unpack8(const v4u w, float* x) {
    x[0] = __uint_as_float(w.x << 16); x[1] = __uint_as_float(w.x & 0xffff0000u); x[2] = __uint_as_float(w.y << 16); x[3] = __uint_as_float(w.y & 0xffff0000u);
    x[4] = __uint_as_float(w.z << 16); x[5] = __uint_as_float(w.z & 0xffff0000u); x[6] = __uint_as_float(w.w << 16); x[7] = __uint_as_float(w.w & 0xffff0000u);
}
__device__ __forceinline__ v4u pack8(const float* x) { v4u w; w.x = pk2(x[0], x[1]); w.y = pk2(x[2], x[3]); w.z = pk2(x[4], x[5]); w.w = pk2(x[6], x[7]); return w; }
__device__ __forceinline__ float silu_f(float x) { return x / (1.f + expf(-x)); }
__device__ __forceinline__ float sigmoid_f(float x) { return 1.f / (1.f + expf(-x)); }
__device__ __forceinline__ float softplus_f(float x) { return fmaxf(x, 0.f) + log1pf(expf(-fabsf(x))); }
template <int CTRL> __device__ __forceinline__ float dpp_mov(float v) { return __builtin_bit_cast(float, __builtin_amdgcn_update_dpp(0, __builtin_bit_cast(int, v), CTRL, 0xF, 0xF, true)); }
template <int N> __device__ __forceinline__ float group_sum(float v) {
    if (N >= 2) v += dpp_mov<0xB1>(v);
    if (N >= 4) v += dpp_mov<0x4E>(v);
    if (N >= 8) v += dpp_mov<0x141>(v);
    if (N >= 16) v += dpp_mov<0x140>(v);
    if (N >= 32) v += __shfl_xor(v, 16);
    if (N >= 64) v += __shfl_xor(v, 32);
    return v;
}

__device__ __forceinline__ void p0_transpose_item(const float* W, int K, int N, bf16_t* WT, int row_off, LAS float* scr, int item, int lane) {
    const int nblk = N / 32, kb = item / nblk, nb = item % nblk, k0 = 64 * kb, n0 = 32 * nb;
#pragma unroll 8
    for (int i = 0; i < 32; ++i) { const int kk = 2 * i + (lane >> 5); scr[kk * 33 + (lane & 31)] = W[(size_t)(k0 + kk) * N + n0 + (lane & 31)]; }
    LDS_WAIT(); asm volatile("" ::: "memory");
    const int c = lane & 7;
#pragma unroll
    for (int j = 0; j < 4; ++j) { const int n = (lane >> 3) + 8 * j; const LAS float* s = scr + (8 * c) * 33 + n;
        v4u o; o.x = pk2(s[0 * 33], s[1 * 33]); o.y = pk2(s[2 * 33], s[3 * 33]); o.z = pk2(s[4 * 33], s[5 * 33]); o.w = pk2(s[6 * 33], s[7 * 33]);
        *(v4u*)(WT + (size_t)(row_off + n0 + n) * K + k0 + 8 * c) = o; }
    LDS_WAIT(); asm volatile("" ::: "memory");
}

__device__ __forceinline__ void p0_prologue(const Args& a, LAS unsigned char* lds, int vcu, int G) {
    const int tid = threadIdx.x, lane = tid & 63, wave = tid >> 6;
    unsigned char* ws = a.ws;
    { const int gid = blockIdx.x * NTHREADS + tid;
      if (gid < 2048) { const int pos = gid >> 5, i = gid & 31; const float freq = expf(-(float)i * (1.f / 32.f) * 9.210340371976184f); const float ang = (float)pos * freq;
          float* rt = (float*)(ws + WS_ROPE); rt[2 * gid] = cosf(ang); rt[2 * gid + 1] = sinf(ang); } }
    { const int gid = blockIdx.x * NTHREADS + tid, gn = G * NTHREADS; constexpr int NV = (NINP - NIN) * 2048 * 2 / 16;
      v4u* p0 = (v4u*)(ws + WS_WIN0 + (size_t)NIN * 2048 * 2); v4u* p1 = (v4u*)(ws + WS_WIN1 + (size_t)NIN * 2048 * 2);
      for (int i = gid; i < NV; i += gn) { p0[i] = (v4u){0, 0, 0, 0}; p1[i] = (v4u){0, 0, 0, 0}; } }
    if (blockIdx.x < 192) {
        const int it = blockIdx.x, l = it / 96, r = it % 96, kc = r / 3, nc = r % 3;
        LAS float* cond = (LAS float*)lds;
        if (tid < 256) { const int b = tid >> 6, k = tid & 63; const float c = a.in[1][b * 2048 + kc * 64 + k]; cond[tid] = silu_f(c); }
        __syncthreads();
        const float* W = a.in[2] + (size_t)l * 2048 * 6144 + (size_t)(kc * 64) * 6144 + nc * 2048 + tid * 4;
        f32x4 acc0 = {0, 0, 0, 0}, acc1 = acc0, acc2 = acc0, acc3 = acc0;
#pragma unroll 8
        for (int k = 0; k < 64; ++k) { const f32x4 w = *(const f32x4*)(W + (size_t)k * 6144);
            acc0 += cond[k] * w; acc1 += cond[64 + k] * w; acc2 += cond[128 + k] * w; acc3 += cond[192 + k] * w; }
        float* macc = (float*)(ws + WS_MOD) + (size_t)l * 4 * 6144 + nc * 2048 + tid * 4;
#pragma unroll
        for (int i = 0; i < 4; ++i) { atomicAdd(macc + i, acc0[i]); atomicAdd(macc + 6144 + i, acc1[i]); atomicAdd(macc + 2 * 6144 + i, acc2[i]); atomicAdd(macc + 3 * 6144 + i, acc3[i]); }
        __syncthreads();
    }
    { LAS float* scr = (LAS float*)(lds + wave * 16384);
      const int gw = vcu * NWAVES + wave, NGW = G * NWAVES;
      constexpr int I_IN = 32 * (NIN / 32), I_OUT = 32 * 64, NITEMS = I_IN + I_OUT;
      for (int it = gw; it < NITEMS; it += NGW) {
          int r = it;
          if (r < I_IN) { p0_transpose_item(a.in[5], 2048, NIN, (bf16_t*)(ws + WS_WIN0), 0, scr, r, lane); continue; } r -= I_IN;
          p0_transpose_item(a.in[16], 2048, 2048, (bf16_t*)(ws + WS_WOUT0), 0, scr, r, lane);
      } }
}
__device__ __forceinline__ void late_transposes(const Args& a, LAS float* scr, int hw, int NHW, int lane) {
    unsigned char* ws = a.ws;
    constexpr int I_IN = 32 * (NIN / 32), I_OUT = 32 * 64, I_G = 32 * 8, NITEMS = I_IN + I_OUT + I_G;
    for (int it = hw; it < NITEMS; it += NHW) {
        int r = it;
        if (r < I_G) { const int mn = r >> 3, m = mn >> 3; const float* Wg = a.in[m == 0 ? 27 : m == 1 ? 29 : m == 2 ? 32 : 34] + (size_t)(mn & 7) * 128 * 128;
            p0_transpose_item(Wg, 128, 128, (bf16_t*)(ws + WS_WGT) + (size_t)mn * 128 * 128, 0, scr, r & 7, lane); continue; } r -= I_G;
        if (r < I_IN) { p0_transpose_item(a.in[17], 2048, NIN, (bf16_t*)(ws + WS_WIN1), 0, scr, r, lane); continue; } r -= I_IN;
        p0_transpose_item(a.in[37], 2048, 2048, (bf16_t*)(ws + WS_WOUT1), 0, scr, r, lane);
    }
}

__device__ __forceinline__ void normmod_phase(const Args& a, const float* xin, int layer, int gw, int NGW, int lane) {
    const float* nw = a.in[4] + layer * 2048; const float* bm = a.in[3] + layer * 6144;
    const float* macc = (const float*)(a.ws + WS_MOD) + (size_t)layer * 4 * 6144;
    bf16_t* H = (bf16_t*)(a.ws + WS_H);
    for (int m = gw; m < MTOK; m += NGW) {
        const int b = m >> 11;
        const f32x4* xr = (const f32x4*)(xin + (size_t)m * 2048) + lane;
        f32x4 v[8]; float s = 0.f;
#pragma unroll
        for (int j = 0; j < 8; ++j) { v[j] = xr[64 * j]; s += (v[j].x * v[j].x + v[j].y * v[j].y) + (v[j].z * v[j].z + v[j].w * v[j].w); }
        const float rstd = rsqrtf(group_sum<64>(s) * (1.f / 2048.f) + EPS);
#pragma unroll
        for (int j = 0; j < 8; ++j) { const int col = (64 * j + lane) * 4;
            const f32x4 w = *(const f32x4*)(nw + col);
            const f32x4 sh = *(const f32x4*)(macc + b * 6144 + col) + *(const f32x4*)(bm + col);
            const f32x4 sc = *(const f32x4*)(macc + b * 6144 + 2048 + col) + *(const f32x4*)(bm + 2048 + col);
            const f32x4 o = v[j] * rstd * w * (1.f + sc) + sh;
            v2u pk; pk.x = pk2(o.x, o.y); pk.y = pk2(o.z, o.w);
            *(v2u*)(H + (size_t)m * 2048 + col) = pk; }
    }
}

__device__ __forceinline__ void post0_phase(const Args& a, int gw, int NGW, int lane) {
    const bf16_t* P = (const bf16_t*)(a.ws + WS_PROJ);
    const float2* rope = (const float2*)(a.ws + WS_ROPE);
    const float* qn = a.in[6]; const float* kn = a.in[7]; const float* cw = a.in[8]; const float* cb = a.in[9];
    bf16_t* Q = (bf16_t*)(a.ws + WS_QB); bf16_t* K = (bf16_t*)(a.ws + WS_KB); bf16_t* V = (bf16_t*)(a.ws + WS_VB);
    float* ACT = (float*)(a.ws + WS_ACT);
    for (int m = gw; m < MTOK; m += NGW) {
        const int t = m & 2047, prow = t >> 6, pcol = t & 63;
        const bf16_t* pr = P + (size_t)m * NINP;
        {
            float x[16]; unpack8(*(const v4u*)(pr + A_Q + lane * 16), x); unpack8(*(const v4u*)(pr + A_Q + lane * 16 + 8), x + 8);
            float ss = 0.f;
#pragma unroll
            for (int i = 0; i < 16; ++i) ss += x[i] * x[i];
            ss = group_sum<8>(ss);
            const float r = rsqrtf(ss * (1.f / 128.f) + EPS);
            const int d0 = (lane & 7) * 16;
#pragma unroll
            for (int i = 0; i < 16; ++i) x[i] = x[i] * r * qn[d0 + i];
#pragma unroll
            for (int pi = 0; pi < 8; ++pi) { const int p = (d0 >> 1) + pi; const float2 cs = (p < 32) ? rope[prow * 32 + p] : rope[pcol * 32 + p - 32];
                const float x0 = x[2 * pi], x1 = x[2 * pi + 1]; x[2 * pi] = x0 * cs.x - x1 * cs.y; x[2 * pi + 1] = x0 * cs.y + x1 * cs.x; }
            *(v4u*)(Q + (size_t)m * 1024 + lane * 16) = pack8(x); *(v4u*)(Q + (size_t)m * 1024 + lane * 16 + 8) = pack8(x + 8);
        }
        {
            const v2u w = *(const v2u*)(pr + A_K + lane * 4);
            float x[4] = {__uint_as_float(w.x << 16), __uint_as_float(w.x & 0xffff0000u), __uint_as_float(w.y << 16), __uint_as_float(w.y & 0xffff0000u)};
            float ss = (x[0] * x[0] + x[1] * x[1]) + (x[2] * x[2] + x[3] * x[3]);
            ss = group_sum<32>(ss);
            const float r = rsqrtf(ss * (1.f / 128.f) + EPS);
            const int d0 = (lane & 31) * 4;
#pragma unroll
            for (int i = 0; i < 4; ++i) x[i] = x[i] * r * kn[d0 + i];
#pragma unroll
            for (int pi = 0; pi < 2; ++pi) { const int p = (d0 >> 1) + pi; const float2 cs = (p < 32) ? rope[prow * 32 + p] : rope[pcol * 32 + p - 32];
                const float x0 = x[2 * pi], x1 = x[2 * pi + 1]; x[2 * pi] = x0 * cs.x - x1 * cs.y; x[2 * pi + 1] = x0 * cs.y + x1 * cs.x; }
            v2u o; o.x = pk2(x[0], x[1]); o.y = pk2(x[2], x[3]);
            *(v2u*)(K + (size_t)m * 256 + lane * 4) = o;
            *(v2u*)(V + (size_t)m * 256 + lane * 4) = *(const v2u*)(pr + A_V + lane * 4);
        }
#pragma unroll
        for (int j = 0; j < 3; ++j) { const int ch = (j * 64 + lane) * 8;
            float acc[8];
            { const f32x4 b0 = *(const f32x4*)(cb + ch), b1 = *(const f32x4*)(cb + ch + 4); acc[0] = b0.x; acc[1] = b0.y; acc[2] = b0.z; acc[3] = b0.w; acc[4] = b1.x; acc[5] = b1.y; acc[6] = b1.z; acc[7] = b1.w; }
#pragma unroll
            for (int d = 0; d < 4; ++d) { const int ts = t + d - 2;
                if (ts >= 0 && ts < SEQ) { float x[8]; unpack8(*(const v4u*)(P + (size_t)(m + d - 2) * NINP + A_XS + ch), x);
                    const f32x4 w0 = *(const f32x4*)(cw + d * 1536 + ch), w1 = *(const f32x4*)(cw + d * 1536 + ch + 4);
                    acc[0] += w0.x * x[0]; acc[1] += w0.y * x[1]; acc[2] += w0.z * x[2]; acc[3] += w0.w * x[3];
                    acc[4] += w1.x * x[4]; acc[5] += w1.y * x[5]; acc[6] += w1.z * x[6]; acc[7] += w1.w * x[7]; } }
            f32x4 o0, o1; o0.x = silu_f(acc[0]); o0.y = silu_f(acc[1]); o0.z = silu_f(acc[2]); o0.w = silu_f(acc[3]); o1.x = silu_f(acc[4]); o1.y = silu_f(acc[5]); o1.z = silu_f(acc[6]); o1.w = silu_f(acc[7]);
            *(f32x4*)(ACT + (size_t)m * 1536 + ch) = o0; *(f32x4*)(ACT + (size_t)m * 1536 + ch + 4) = o1;
            { v4u w; w.x = pk2(o0.x, o0.y); w.y = pk2(o0.z, o0.w); w.z = pk2(o1.x, o1.y); w.w = pk2(o1.z, o1.w); *(v4u*)((bf16_t*)(a.ws + WS_XBC16) + (size_t)m * 1536 + ch) = w; } }
    }
}

typedef float f32x2 __attribute__((ext_vector_type(2)));
__device__ __forceinline__ void ssd_combine_phase(const Args& a, int gw, int NGW, int lane) {
    const float* YF = (const float*)(a.ws + WS_YF); const float* YB = (const float*)(a.ws + WS_YB); const float* ACT = (const float*)(a.ws + WS_ACT);
    const bf16_t* P = (const bf16_t*)(a.ws + WS_PROJ); bf16_t* YC = (bf16_t*)(a.ws + WS_YCAT);
    const float* dsk = a.in[14]; const float* nw = a.in[15];
    for (int m = gw; m < MTOK; m += NGW) {
        const int ch = lane * 16; const float dk = dsk[ch >> 6];
        float z[16], gv[16]; unpack8(*(const v4u*)(P + (size_t)m * NINP + A_Z + ch), z); unpack8(*(const v4u*)(P + (size_t)m * NINP + A_Z + ch + 8), z + 8);
        float ss = 0.f;
#pragma unroll
        for (int q = 0; q < 4; ++q) { const f32x4 f = *(const f32x4*)(YF + (size_t)m * 1024 + ch + 4 * q), bk = *(const f32x4*)(YB + (size_t)m * 1024 + ch + 4 * q), xv = *(const f32x4*)(ACT + (size_t)m * 1536 + ch + 4 * q);
            const f32x4 y = f + bk + dk * xv;
            gv[4 * q] = y.x * silu_f(z[4 * q]); gv[4 * q + 1] = y.y * silu_f(z[4 * q + 1]); gv[4 * q + 2] = y.z * silu_f(z[4 * q + 2]); gv[4 * q + 3] = y.w * silu_f(z[4 * q + 3]); }
#pragma unroll
        for (int i = 0; i < 16; ++i) ss += gv[i] * gv[i];
        const float r = rsqrtf(group_sum<64>(ss) * (1.f / 1024.f) + EPS);
#pragma unroll
        for (int i = 0; i < 16; ++i) gv[i] = gv[i] * r * nw[ch + i];
        *(v4u*)(YC + (size_t)m * 2048 + 1024 + ch) = pack8(gv); *(v4u*)(YC + (size_t)m * 2048 + 1024 + ch + 8) = pack8(gv + 8);
    }
}

__device__ __forceinline__ void post1_phase(const Args& a, int gw, int NGW, int lane) {
    const bf16_t* P = (const bf16_t*)(a.ws + WS_PROJ); const float* cw = a.in[18]; const float* cb = a.in[19];
    float* ACT = (float*)(a.ws + WS_ACT);
    for (int m = gw; m < MTOK; m += NGW) {
        const int t = m & 2047;
#pragma unroll
        for (int j = 0; j < 4; ++j) { const int ch = (j * 64 + lane) * 8;
            float acc[8];
            { const f32x4 b0 = *(const f32x4*)(cb + ch), b1 = *(const f32x4*)(cb + ch + 4); acc[0] = b0.x; acc[1] = b0.y; acc[2] = b0.z; acc[3] = b0.w; acc[4] = b1.x; acc[5] = b1.y; acc[6] = b1.z; acc[7] = b1.w; }
#pragma unroll
            for (int d = 0; d < 4; ++d) { const int ts = t + d - 2;
                if (ts >= 0 && ts < SEQ) { float x[8]; unpack8(*(const v4u*)(P + (size_t)(m + d - 2) * NINP + C_Q + ch), x);
                    const f32x4 w0 = *(const f32x4*)(cw + d * 2048 + ch), w1 = *(const f32x4*)(cw + d * 2048 + ch + 4);
                    acc[0] += w0.x * x[0]; acc[1] += w0.y * x[1]; acc[2] += w0.z * x[2]; acc[3] += w0.w * x[3];
                    acc[4] += w1.x * x[4]; acc[5] += w1.y * x[5]; acc[6] += w1.z * x[6]; acc[7] += w1.w * x[7]; } }
#pragma unroll
            for (int i = 0; i < 8; ++i) acc[i] = silu_f(acc[i]);
            if (j < 2) {
                float ss = 0.f;
#pragma unroll
                for (int i = 0; i < 8; ++i) ss += acc[i] * acc[i];
                ss = group_sum<16>(ss);
                float r = rsqrtf(ss + EPS); if (j == 0) r *= 0.088388347648318440f;
#pragma unroll
                for (int i = 0; i < 8; ++i) acc[i] *= r;
            }
            *(f32x4*)(ACT + (size_t)m * 2048 + ch) = (f32x4){acc[0], acc[1], acc[2], acc[3]}; *(f32x4*)(ACT + (size_t)m * 2048 + ch + 4) = (f32x4){acc[4], acc[5], acc[6], acc[7]};
            *(v4u*)((bf16_t*)(a.ws + WS_QKV16) + (size_t)m * 2048 + ch) = pack8(acc); }
    }
}

typedef short s16x4_t __attribute__((ext_vector_type(4)));
typedef __bf16 bf16x2_v __attribute__((ext_vector_type(2)));
__device__ __forceinline__ unsigned cvtpk_rne(float lo, float hi) { f32x2 v = {lo, hi}; bf16x2_v bb = __builtin_convertvector(v, bf16x2_v); return __builtin_bit_cast(unsigned, bb); }
template <int S_> __device__ __forceinline__ bf16x8_t acc_frag(const f32x16_t& x) {
    v4u w; w.x = cvtpk_rne(x[8 * S_ + 0], x[8 * S_ + 1]); w.y = cvtpk_rne(x[8 * S_ + 2], x[8 * S_ + 3]); w.z = cvtpk_rne(x[8 * S_ + 4], x[8 * S_ + 5]); w.w = cvtpk_rne(x[8 * S_ + 6], x[8 * S_ + 7]);
    return __builtin_bit_cast(bf16x8_t, w);
}
__device__ __forceinline__ bf16x8_t join44(v2u lo, v2u hi) { v4u w; w.x = lo.x; w.y = lo.y; w.z = hi.x; w.w = hi.y; return __builtin_bit_cast(bf16x8_t, w); }
__device__ __forceinline__ float wave_incl_scan(float v, int lane) {
#pragma unroll
    for (int o = 1; o < 64; o <<= 1) { const float t = __shfl_up(v, o); if (lane >= o) v += t; }
    return v;
}
constexpr int GDN_LDS_PER_WAVE = 17920;
__device__ __forceinline__ void gdn1_item(const Args& a, int item, unsigned char* ldsw, int lane) {
    asm volatile("" : "+v"(lane));
    const int c = item & 31, dir = (item >> 5) & 1, hv = (item >> 6) & 7, b = item >> 9, hq = hv >> 1;
    const int r32 = lane & 31, hi = lane >> 5;
    float* AT = (float*)ldsw; float* Gs = AT + 64 * 64; float* Bs = Gs + 64;
    const bf16_t* QK = (const bf16_t*)(a.ws + WS_QKV16); const float* SM = (const float*)(a.ws + WS_SMALL);
    bf16_t* GT = (bf16_t*)(a.ws + WS_GT) + (size_t)item * 4096; bf16_t* GA = (bf16_t*)(a.ws + WS_GA) + (size_t)item * 4096;
    const float Aneg = -expf(a.in[dir ? 21 : 20][hv]); const float dtb = a.in[dir ? 23 : 22][hv];
    {
        const int t = dir ? SEQ - 1 - (64 * c + lane) : 64 * c + lane; const float* sm = SM + ((size_t)b * SEQ + t) * 32;
        const float gi = Aneg * softplus_f(sm[16 + dir * 8 + hv] + dtb), bi = sigmoid_f(sm[dir * 8 + hv]);
        Gs[lane] = wave_incl_scan(gi, lane); Bs[lane] = bi;
    }
    const int t0r = dir ? SEQ - 1 - (64 * c + r32) : 64 * c + r32, t1r = dir ? t0r - 32 : t0r + 32;
    const bf16_t* k0p = QK + ((size_t)b * SEQ + t0r) * 2048 + 512 + hq * 128 + hi * 8; const bf16_t* k1p = QK + ((size_t)b * SEQ + t1r) * 2048 + 512 + hq * 128 + hi * 8;
    const bf16_t* q0p = k0p - 512, * q1p = k1p - 512;
    LDS_WAIT();
    const float Gj0 = Gs[r32], Gj1 = Gs[32 + r32];
    {
        f32x16_t kk00, kk10, kk11;
#pragma unroll
        for (int r = 0; r < 16; ++r) { kk00[r] = 0.f; kk10[r] = 0.f; kk11[r] = 0.f; }
#pragma unroll
        for (int s = 0; s < 8; ++s) {
            const bf16x8_t kA0 = *(const bf16x8_t*)(k0p + 16 * s), kA1 = *(const bf16x8_t*)(k1p + 16 * s);
            kk00 = __builtin_amdgcn_mfma_f32_32x32x16_bf16(kA0, kA0, kk00, 0, 0, 0); kk10 = __builtin_amdgcn_mfma_f32_32x32x16_bf16(kA1, kA0, kk10, 0, 0, 0); kk11 = __builtin_amdgcn_mfma_f32_32x32x16_bf16(kA1, kA1, kk11, 0, 0, 0);
        }
#pragma unroll
        for (int r = 0; r < 16; ++r) { const int il = (r & 3) + 8 * (r >> 2) + 4 * hi;
            const float Gi0 = Gs[il], Gi1 = Gs[32 + il], bi0 = Bs[il], bi1 = Bs[32 + il];
            AT[r32 * 64 + il] = (r32 < il) ? bi0 * kk00[r] * expf(Gi0 - Gj0) : 0.f;
            AT[r32 * 64 + 32 + il] = bi1 * kk10[r] * expf(Gi1 - Gj0);
            AT[(32 + r32) * 64 + 32 + il] = (r32 < il) ? bi1 * kk11[r] * expf(Gi1 - Gj1) : 0.f;
            AT[(32 + r32) * 64 + il] = 0.f;
        }
    }
    asm volatile("" ::: "memory");
    {
        f32x16_t qk00, qk10, qk11;
#pragma unroll
        for (int r = 0; r < 16; ++r) { qk00[r] = 0.f; qk10[r] = 0.f; qk11[r] = 0.f; }
#pragma unroll
        for (int s = 0; s < 8; ++s) {
            const bf16x8_t kA0 = *(const bf16x8_t*)(k0p + 16 * s), kA1 = *(const bf16x8_t*)(k1p + 16 * s), qA0 = *(const bf16x8_t*)(q0p + 16 * s), qA1 = *(const bf16x8_t*)(q1p + 16 * s);
            qk00 = __builtin_amdgcn_mfma_f32_32x32x16_bf16(qA0, kA0, qk00, 0, 0, 0); qk10 = __builtin_amdgcn_mfma_f32_32x32x16_bf16(qA1, kA0, qk10, 0, 0, 0); qk11 = __builtin_amdgcn_mfma_f32_32x32x16_bf16(qA1, kA1, qk11, 0, 0, 0);
        }
#pragma unroll
        for (int r = 0; r < 16; ++r) { const int il = (r & 3) + 8 * (r >> 2) + 4 * hi;
            const float Gi0 = Gs[il], Gi1 = Gs[32 + il];
            GA[il * 64 + r32] = (bf16_t)f2bf((r32 <= il) ? qk00[r] * expf(Gi0 - Gj0) : 0.f);
            GA[(32 + il) * 64 + r32] = (bf16_t)f2bf(qk10[r] * expf(Gi1 - Gj0));
            GA[(32 + il) * 64 + 32 + r32] = (bf16_t)f2bf((r32 <= il) ? qk11[r] * expf(Gi1 - Gj1) : 0.f);
        }
    }
    LDS_WAIT(); asm volatile("" ::: "memory");
    float tr[64];
    int lane2 = lane; asm volatile("" : "+v"(lane2) :: "memory");
#pragma unroll
    for (int j = 0; j < 64; ++j) tr[j] = (j == lane2) ? 1.f : 0.f;
    int atoff = 0;
#pragma unroll
    for (int j = 62; j >= 0; --j) { float c0 = 0.f, c1 = 0.f, c2 = 0.f, c3 = 0.f;
        asm volatile("" : "+v"(atoff) : "v"(tr[j + 1]));
#pragma unroll
        for (int qd = (j + 1) / 4; qd < 16; ++qd) { const f32x4 av = *(const f32x4*)(AT + atoff + j * 64 + 4 * qd);
            if (4 * qd + 0 > j) c0 = fmaf(tr[4 * qd + 0], av.x, c0);
            if (4 * qd + 1 > j) c1 = fmaf(tr[4 * qd + 1], av.y, c1);
            if (4 * qd + 2 > j) c2 = fmaf(tr[4 * qd + 2], av.z, c2);
            if (4 * qd + 3 > j) c3 = fmaf(tr[4 * qd + 3], av.w, c3); }
        tr[j] -= (c0 + c1) + (c2 + c3); asm volatile("" ::: "memory"); }
#pragma unroll
    for (int x = 0; x < 8; ++x) *(v4u*)(GT + lane2 * 64 + x * 8) = pack8(tr + x * 8);
    LDS_WAIT();
}

__device__ __forceinline__ void gdn2_item(const Args& a, int item, unsigned char* lds) {
    const int dvs = item & 3, hv = (item >> 2) & 7, dir = (item >> 5) & 1, b = item >> 6, hq = hv >> 1;
    const int lane0 = threadIdx.x & 63;
    constexpr int BUFB = 57344, O_K = 0, O_Q = 16384, O_T = 32768, O_A = 40960, O_V = 49152;
    float* Gs = (float*)(lds + 2 * BUFB); float* Bs = Gs + 64; float* Es = Bs + 64; float* Ws = Es + 64; float* ot = Ws + 64;
    const LAS unsigned char* ldl = (const LAS unsigned char*)lds;
    const bf16_t* QK = (const bf16_t*)(a.ws + WS_QKV16); const float* ACT = (const float*)(a.ws + WS_ACT); const float* SM = (const float*)(a.ws + WS_SMALL);
    float* O = (float*)(a.ws + (dir ? WS_YB : WS_YF));
    const float Aneg = -expf(a.in[dir ? 21 : 20][hv]); const float dtb = a.in[dir ? 23 : 22][hv];
    const size_t gbase = (size_t)(((b * 8 + hv) * 2 + dir) * 32) * 4096;
    f32x16_t S[4];
#pragma unroll
    for (int nt = 0; nt < 4; ++nt)
#pragma unroll
        for (int r = 0; r < 16; ++r) S[nt][r] = 0.f;
    float gar, gbr;
#define G2_DMA(c_, buf_) do { const int t_ = dir ? SEQ - 1 - (64 * (c_) + lane0) : 64 * (c_) + lane0; const size_t mi_ = (size_t)b * SEQ + t_; \
        const bf16_t* kr_ = QK + mi_ * 2048 + 512 + hq * 128; const bf16_t* qr_ = QK + mi_ * 2048 + hq * 128; \
        const bf16_t* tr_ = (const bf16_t*)(a.ws + WS_GT) + gbase + (size_t)(c_) * 4096 + lane0 * 64; const bf16_t* ar_ = (const bf16_t*)(a.ws + WS_GA) + gbase + (size_t)(c_) * 4096 + lane0 * 64; \
        const float* vr_ = ACT + mi_ * 2048 + 1024 + hv * 128 + dvs * 32; \
        LAS unsigned char* lb_ = (LAS unsigned char*)lds + (buf_) * BUFB; \
        _Pragma("unroll") for (int x = 0; x < 16; ++x) { __builtin_amdgcn_global_load_lds((const unsigned*)(kr_ + 8 * x), (LAS unsigned*)(lb_ + O_K + 1024 * x), 16, 0, 0); \
                                                         __builtin_amdgcn_global_load_lds((const unsigned*)(qr_ + 8 * x), (LAS unsigned*)(lb_ + O_Q + 1024 * x), 16, 0, 0); } \
        _Pragma("unroll") for (int x = 0; x < 8; ++x) { __builtin_amdgcn_global_load_lds((const unsigned*)(tr_ + 8 * x), (LAS unsigned*)(lb_ + O_T + 1024 * x), 16, 0, 0); \
                                                        __builtin_amdgcn_global_load_lds((const unsigned*)(ar_ + 8 * x), (LAS unsigned*)(lb_ + O_A + 1024 * x), 16, 0, 0); \
                                                        __builtin_amdgcn_global_load_lds((const unsigned*)(vr_ + 4 * x), (LAS unsigned*)(lb_ + O_V + 1024 * x), 16, 0, 0); } \
        const float* sm_ = SM + mi_ * 32; gar = sm_[16 + dir * 8 + hv]; gbr = sm_[dir * 8 + hv]; } while (0)
    G2_DMA(0, 0);
    for (int c = 0; c < 32; ++c) {
        int lane = lane0; asm volatile("" : "+v"(lane));
        const int r32 = lane & 31, hi = lane >> 5, trq = (lane & 15) >> 2, trp = lane & 3, trc = (lane >> 4) & 1;
        const int bo = (c & 1) * BUFB;
        float GL;
        {
            const float gi = Aneg * softplus_f(gar + dtb), bi = sigmoid_f(gbr);
            const float G = wave_incl_scan(gi, lane); GL = __shfl(G, 63);
            Gs[lane] = G; Bs[lane] = bi; Es[lane] = __expf(G); Ws[lane] = __expf(GL - G);
        }
        asm volatile("s_waitcnt vmcnt(0)" ::: "memory");
        if (c + 1 < 32) G2_DMA(c + 1, (c + 1) & 1);
        LDS_WAIT();
        f32x16_t KS[2];
#pragma unroll
        for (int rt = 0; rt < 2; ++rt)
#pragma unroll
            for (int r = 0; r < 16; ++r) KS[rt][r] = 0.f;
#define LFRAG(off_) join44(*(const LAS v2u*)(ldl + (off_)), *(const LAS v2u*)(ldl + (off_) + 1024))
#pragma unroll
        for (int nt = 0; nt < 4; ++nt) {
            const bf16x8_t sb0 = acc_frag<0>(S[nt]), sb1 = acc_frag<1>(S[nt]);
#pragma unroll
            for (int rt = 0; rt < 2; ++rt) {
                const int ro = bo + O_K + ((4 * nt) * 64 + 32 * rt + r32) * 16 + 8 * hi;
                KS[rt] = __builtin_amdgcn_mfma_f32_32x32x16_bf16(LFRAG(ro), sb0, KS[rt], 0, 0, 0); KS[rt] = __builtin_amdgcn_mfma_f32_32x32x16_bf16(LFRAG(ro + 2048), sb1, KS[rt], 0, 0, 0);
            }
        }
        asm volatile("" ::: "memory");
        f32x16_t rhs[2];
#pragma unroll
        for (int rt = 0; rt < 2; ++rt)
#pragma unroll
            for (int r = 0; r < 16; ++r) { const int i = 32 * rt + (r & 3) + 8 * (r >> 2) + 4 * hi;
                const float vv = *(const LAS float*)(ldl + bo + O_V + ((r32 >> 2) * 64 + i) * 16 + (r32 & 3) * 4); const float bi = Bs[i];
                rhs[rt][r] = bi * vv - bi * Es[i] * KS[rt][r]; }
        asm volatile("" ::: "memory");
        f32x16_t vn[2];
#pragma unroll
        for (int r = 0; r < 16; ++r) { vn[0][r] = 0.f; vn[1][r] = 0.f; }
        {
            const bf16x8_t rb00 = acc_frag<0>(rhs[0]), rb01 = acc_frag<1>(rhs[0]), rb10 = acc_frag<0>(rhs[1]), rb11 = acc_frag<1>(rhs[1]);
            const int t0 = bo + O_T + r32 * 16 + 8 * hi, t1 = t0 + 512;
            vn[0] = __builtin_amdgcn_mfma_f32_32x32x16_bf16(LFRAG(t0), rb00, vn[0], 0, 0, 0); vn[0] = __builtin_amdgcn_mfma_f32_32x32x16_bf16(LFRAG(t0 + 2048), rb01, vn[0], 0, 0, 0);
            vn[1] = __builtin_amdgcn_mfma_f32_32x32x16_bf16(LFRAG(t1), rb00, vn[1], 0, 0, 0); vn[1] = __builtin_amdgcn_mfma_f32_32x32x16_bf16(LFRAG(t1 + 2048), rb01, vn[1], 0, 0, 0);
            vn[1] = __builtin_amdgcn_mfma_f32_32x32x16_bf16(LFRAG(t1 + 4096), rb10, vn[1], 0, 0, 0); vn[1] = __builtin_amdgcn_mfma_f32_32x32x16_bf16(LFRAG(t1 + 6144), rb11, vn[1], 0, 0, 0);
        }
        asm volatile("" ::: "memory");
        f32x16_t QS[2];
#pragma unroll
        for (int rt = 0; rt < 2; ++rt)
#pragma unroll
            for (int r = 0; r < 16; ++r) QS[rt][r] = 0.f;
#pragma unroll
        for (int nt = 0; nt < 4; ++nt) {
            const bf16x8_t sb0 = acc_frag<0>(S[nt]), sb1 = acc_frag<1>(S[nt]);
#pragma unroll
            for (int rt = 0; rt < 2; ++rt) {
                const int ro = bo + O_Q + ((4 * nt) * 64 + 32 * rt + r32) * 16 + 8 * hi;
                QS[rt] = __builtin_amdgcn_mfma_f32_32x32x16_bf16(LFRAG(ro), sb0, QS[rt], 0, 0, 0); QS[rt] = __builtin_amdgcn_mfma_f32_32x32x16_bf16(LFRAG(ro + 2048), sb1, QS[rt], 0, 0, 0);
            }
        }
        asm volatile("" ::: "memory");
        {
            const bf16x8_t vb00 = acc_frag<0>(vn[0]), vb01 = acc_frag<1>(vn[0]), vb10 = acc_frag<0>(vn[1]), vb11 = acc_frag<1>(vn[1]);
            const int a0 = bo + O_A + r32 * 16 + 8 * hi, a1 = a0 + 512;
            f32x16_t o0, o1;
#pragma unroll
            for (int r = 0; r < 16; ++r) { const int il = (r & 3) + 8 * (r >> 2) + 4 * hi; o0[r] = Es[il] * QS[0][r]; o1[r] = Es[32 + il] * QS[1][r]; }
            o0 = __builtin_amdgcn_mfma_f32_32x32x16_bf16(LFRAG(a0), vb00, o0, 0, 0, 0); o0 = __builtin_amdgcn_mfma_f32_32x32x16_bf16(LFRAG(a0 + 2048), vb01, o0, 0, 0, 0);
            o1 = __builtin_amdgcn_mfma_f32_32x32x16_bf16(LFRAG(a1), vb00, o1, 0, 0, 0); o1 = __builtin_amdgcn_mfma_f32_32x32x16_bf16(LFRAG(a1 + 2048), vb01, o1, 0, 0, 0);
            o1 = __builtin_amdgcn_mfma_f32_32x32x16_bf16(LFRAG(a1 + 4096), vb10, o1, 0, 0, 0); o1 = __builtin_amdgcn_mfma_f32_32x32x16_bf16(LFRAG(a1 + 6144), vb11, o1, 0, 0, 0);
#pragma unroll
            for (int r = 0; r < 16; ++r) { const int il = (r & 3) + 8 * (r >> 2) + 4 * hi; ot[il * 33 + r32] = o0[r]; ot[(32 + il) * 33 + r32] = o1[r]; }
            LDS_WAIT();
            { const int t = dir ? SEQ - 1 - (64 * c + lane) : 64 * c + lane; float* orow = O + ((size_t)b * SEQ + t) * 1024 + hv * 128 + dvs * 32;
#pragma unroll
              for (int x = 0; x < 8; ++x) *(f32x4*)(orow + 4 * x) = (f32x4){ot[lane * 33 + 4 * x], ot[lane * 33 + 4 * x + 1], ot[lane * 33 + 4 * x + 2], ot[lane * 33 + 4 * x + 3]}; }
        }
        asm volatile("" ::: "memory");
        {
#pragma unroll
            for (int r = 0; r < 16; ++r) { const int il = (r & 3) + 8 * (r >> 2) + 4 * hi; vn[0][r] *= Ws[il]; vn[1][r] *= Ws[32 + il]; }
            const bf16x8_t wb[4] = {acc_frag<0>(vn[0]), acc_frag<1>(vn[0]), acc_frag<0>(vn[1]), acc_frag<1>(vn[1])};
            const float eGL = __expf(GL);
#pragma unroll
            for (int nt = 0; nt < 4; ++nt) {
#pragma unroll
                for (int r = 0; r < 16; ++r) S[nt][r] *= eGL;
#pragma unroll
                for (int ks = 0; ks < 4; ++ks) {
                    const int ro = bo + O_K + ((4 * nt + 2 * trc + (trp >> 1)) * 64 + 16 * ks + 4 * hi + trq) * 16 + 8 * (trp & 1);
                    const s16x4_t lo = __builtin_bit_cast(s16x4_t, __builtin_amdgcn_ds_read_tr16_b64_v4i16((LAS s16x4_t*)(ldl + ro)));
                    const s16x4_t hi4 = __builtin_bit_cast(s16x4_t, __builtin_amdgcn_ds_read_tr16_b64_v4i16((LAS s16x4_t*)(ldl + ro + 8 * 16)));
                    const bf16x8_t kf = (bf16x8_t){lo[0], lo[1], lo[2], lo[3], hi4[0], hi4[1], hi4[2], hi4[3]};
                    S[nt] = __builtin_amdgcn_mfma_f32_32x32x16_bf16(kf, wb[ks], S[nt], 0, 0, 0);
                }
            }
        }
        LDS_WAIT();
    }
#undef LFRAG
#undef G2_DMA
}

__device__ __forceinline__ void ssd2_item(const Args& a, int item, unsigned char* lds) {
    const int ps = item & 1, h = (item >> 1) & 15, dir = (item >> 5) & 1, b = item >> 6, g = h >> 3;
    const int lane0 = threadIdx.x & 63;
    constexpr int BUFB = 40960, O_B = 0, O_C = 16384, O_X = 32768, O_XD = 2 * BUFB + 512, O_XW = O_XD + 64 * 72;
    float* Gs = (float*)(lds + 2 * BUFB); float* Es = Gs + 64; float* ot = (float*)(lds + O_XW + 64 * 72);
    const LAS unsigned char* ldl = (const LAS unsigned char*)lds;
    const bf16_t* XB = (const bf16_t*)(a.ws + WS_XBC16); const float* ACT = (const float*)(a.ws + WS_ACT); const float* SM = (const float*)(a.ws + WS_SMALL);
    float* Y = (float*)(a.ws + (dir ? WS_YB : WS_YF));
    const float A = -expf(a.in[dir ? 13 : 12][h]); const float dtb = a.in[dir ? 11 : 10][h];
    f32x16_t H[4];
#pragma unroll
    for (int nt = 0; nt < 4; ++nt)
#pragma unroll
        for (int r = 0; r < 16; ++r) H[nt][r] = 0.f;
    float gdr;
#define S2_DMA(c_, buf_) do { const int t_ = dir ? SEQ - 1 - (64 * (c_) + lane0) : 64 * (c_) + lane0; const size_t mi_ = (size_t)b * SEQ + t_; \
        const bf16_t* br_ = XB + mi_ * 1536 + 1024 + g * 128; const bf16_t* cr_ = XB + mi_ * 1536 + 1280 + g * 128; const float* xr_ = ACT + mi_ * 1536 + h * 64 + ps * 32; \
        LAS unsigned char* lb_ = (LAS unsigned char*)lds + (buf_) * BUFB; \
        _Pragma("unroll") for (int x = 0; x < 16; ++x) { __builtin_amdgcn_global_load_lds((const unsigned*)(br_ + 8 * x), (LAS unsigned*)(lb_ + O_B + 1024 * x), 16, 0, 0); \
                                                         __builtin_amdgcn_global_load_lds((const unsigned*)(cr_ + 8 * x), (LAS unsigned*)(lb_ + O_C + 1024 * x), 16, 0, 0); } \
        _Pragma("unroll") for (int x = 0; x < 8; ++x) __builtin_amdgcn_global_load_lds((const unsigned*)(xr_ + 4 * x), (LAS unsigned*)(lb_ + O_X + 1024 * x), 16, 0, 0); \
        gdr = SM[mi_ * 32 + dir * 16 + h]; } while (0)
    S2_DMA(0, 0);
    for (int c = 0; c < 32; ++c) {
        int lane = lane0; asm volatile("" : "+v"(lane));
        const int r32 = lane & 31, hi = lane >> 5, trq = (lane & 15) >> 2, trp = lane & 3, trc = (lane >> 4) & 1;
        const int bo = (c & 1) * BUFB;
        const float dt = softplus_f(gdr + dtb);
        const float cs = wave_incl_scan(dt * A, lane); const float csL = __shfl(cs, 63);
        Gs[lane] = cs; Es[lane] = __expf(cs);
        asm volatile("s_waitcnt vmcnt(0)" ::: "memory");
        if (c + 1 < 32) S2_DMA(c + 1, (c + 1) & 1);
        {
            const float wsc = dt * __expf(csL - cs);
#pragma unroll
            for (int x = 0; x < 8; ++x) { const f32x4 xv = *(const LAS f32x4*)(ldl + bo + O_X + (x * 64 + lane) * 16);
                v2u d; d.x = cvtpk_rne(xv.x * dt, xv.y * dt); d.y = cvtpk_rne(xv.z * dt, xv.w * dt); *(LAS v2u*)((LAS unsigned char*)lds + O_XD + lane * 72 + 8 * x) = d;
                v2u w; w.x = cvtpk_rne(xv.x * wsc, xv.y * wsc); w.y = cvtpk_rne(xv.z * wsc, xv.w * wsc); *(LAS v2u*)((LAS unsigned char*)lds + O_XW + lane * 72 + 8 * x) = w; }
        }
        LDS_WAIT();
        f32x16_t g00, g01, g11;
#pragma unroll
        for (int r = 0; r < 16; ++r) { g00[r] = 0.f; g01[r] = 0.f; g11[r] = 0.f; }
#pragma unroll
        for (int kk = 0; kk < 8; ++kk) { const int fo = ((2 * kk + hi) * 64 + r32) * 16;
            const bf16x8_t A0 = *(const LAS bf16x8_t*)(ldl + bo + O_B + fo), A1 = *(const LAS bf16x8_t*)(ldl + bo + O_B + fo + 512);
            const bf16x8_t B0 = *(const LAS bf16x8_t*)(ldl + bo + O_C + fo), B1 = *(const LAS bf16x8_t*)(ldl + bo + O_C + fo + 512);
            g00 = __builtin_amdgcn_mfma_f32_32x32x16_bf16(A0, B0, g00, 0, 0, 0); g01 = __builtin_amdgcn_mfma_f32_32x32x16_bf16(A0, B1, g01, 0, 0, 0); g11 = __builtin_amdgcn_mfma_f32_32x32x16_bf16(A1, B1, g11, 0, 0, 0); }
        {   const float cst0 = Gs[r32], cst1 = Gs[32 + r32];
#pragma unroll
            for (int r = 0; r < 16; ++r) { const int il = (r & 3) + 8 * (r >> 2) + 4 * hi; const float css0 = Gs[il], css1 = Gs[32 + il];
                g00[r] = (il <= r32) ? g00[r] * __expf(cst0 - css0) : 0.f; g01[r] = g01[r] * __expf(cst1 - css0); g11[r] = (il <= r32) ? g11[r] * __expf(cst1 - css1) : 0.f; } }
        asm volatile("" ::: "memory");
        f32x16_t y0, y1;
#pragma unroll
        for (int r = 0; r < 16; ++r) { y0[r] = 0.f; y1[r] = 0.f; }
#define TRFRAG(base_) ({ const s16x4_t lo_ = __builtin_bit_cast(s16x4_t, __builtin_amdgcn_ds_read_tr16_b64_v4i16((LAS s16x4_t*)(ldl + (base_)))); \
                         const s16x4_t hi_ = __builtin_bit_cast(s16x4_t, __builtin_amdgcn_ds_read_tr16_b64_v4i16((LAS s16x4_t*)(ldl + (base_) + 8 * 72))); \
                         (bf16x8_t){lo_[0], lo_[1], lo_[2], lo_[3], hi_[0], hi_[1], hi_[2], hi_[3]}; })
        {   const int xo = O_XD + (4 * hi + trq) * 72 + (16 * trc + 4 * trp) * 2;
            const bf16x8_t x0 = TRFRAG(xo), x1 = TRFRAG(xo + 16 * 72), x2 = TRFRAG(xo + 32 * 72), x3 = TRFRAG(xo + 48 * 72);
            y0 = __builtin_amdgcn_mfma_f32_32x32x16_bf16(acc_frag<0>(g00), x0, y0, 0, 0, 0); y0 = __builtin_amdgcn_mfma_f32_32x32x16_bf16(acc_frag<1>(g00), x1, y0, 0, 0, 0);
            y1 = __builtin_amdgcn_mfma_f32_32x32x16_bf16(acc_frag<0>(g01), x0, y1, 0, 0, 0); y1 = __builtin_amdgcn_mfma_f32_32x32x16_bf16(acc_frag<1>(g01), x1, y1, 0, 0, 0);
            y1 = __builtin_amdgcn_mfma_f32_32x32x16_bf16(acc_frag<0>(g11), x2, y1, 0, 0, 0); y1 = __builtin_amdgcn_mfma_f32_32x32x16_bf16(acc_frag<1>(g11), x3, y1, 0, 0, 0); }
        asm volatile("" ::: "memory");
        {   f32x16_t Z0, Z1;
#pragma unroll
            for (int r = 0; r < 16; ++r) { Z0[r] = 0.f; Z1[r] = 0.f; }
#define LFRAG(off_) join44(*(const LAS v2u*)(ldl + (off_)), *(const LAS v2u*)(ldl + (off_) + 1024))
#pragma unroll
            for (int nt = 0; nt < 4; ++nt) { const bf16x8_t hb0 = acc_frag<0>(H[nt]), hb1 = acc_frag<1>(H[nt]);
                const int ro = bo + O_C + ((4 * nt) * 64 + r32) * 16 + 8 * hi;
                Z0 = __builtin_amdgcn_mfma_f32_32x32x16_bf16(LFRAG(ro), hb0, Z0, 0, 0, 0); Z0 = __builtin_amdgcn_mfma_f32_32x32x16_bf16(LFRAG(ro + 2048), hb1, Z0, 0, 0, 0);
                Z1 = __builtin_amdgcn_mfma_f32_32x32x16_bf16(LFRAG(ro + 512), hb0, Z1, 0, 0, 0); Z1 = __builtin_amdgcn_mfma_f32_32x32x16_bf16(LFRAG(ro + 512 + 2048), hb1, Z1, 0, 0, 0); }
#undef LFRAG
#pragma unroll
            for (int r = 0; r < 16; ++r) { const int il = (r & 3) + 8 * (r >> 2) + 4 * hi; ot[il * 33 + r32] = fmaf(Es[il], Z0[r], y0[r]); ot[(32 + il) * 33 + r32] = fmaf(Es[32 + il], Z1[r], y1[r]); } }
        LDS_WAIT();
        { const int t = dir ? SEQ - 1 - (64 * c + lane) : 64 * c + lane; float* yrow = Y + ((size_t)b * SEQ + t) * 1024 + h * 64 + ps * 32;
#pragma unroll
          for (int x = 0; x < 8; ++x) *(f32x4*)(yrow + 4 * x) = (f32x4){ot[lane * 33 + 4 * x], ot[lane * 33 + 4 * x + 1], ot[lane * 33 + 4 * x + 2], ot[lane * 33 + 4 * x + 3]}; }
        asm volatile("" ::: "memory");
        {   const float eL = __expf(csL);
            const int xo = O_XW + (4 * hi + trq) * 72 + (16 * trc + 4 * trp) * 2;
            const bf16x8_t w0 = TRFRAG(xo), w1 = TRFRAG(xo + 16 * 72), w2 = TRFRAG(xo + 32 * 72), w3 = TRFRAG(xo + 48 * 72);
#undef TRFRAG
#pragma unroll
            for (int nt = 0; nt < 4; ++nt) {
#pragma unroll
                for (int r = 0; r < 16; ++r) H[nt][r] *= eL;
#pragma unroll
                for (int ks = 0; ks < 4; ++ks) {
                    const int ro = bo + O_B + ((4 * nt + 2 * trc + (trp >> 1)) * 64 + 16 * ks + 4 * hi + trq) * 16 + 8 * (trp & 1);
                    const s16x4_t lo = __builtin_bit_cast(s16x4_t, __builtin_amdgcn_ds_read_tr16_b64_v4i16((LAS s16x4_t*)(ldl + ro)));
                    const s16x4_t hi4 = __builtin_bit_cast(s16x4_t, __builtin_amdgcn_ds_read_tr16_b64_v4i16((LAS s16x4_t*)(ldl + ro + 8 * 16)));
                    const bf16x8_t bfr = (bf16x8_t){lo[0], lo[1], lo[2], lo[3], hi4[0], hi4[1], hi4[2], hi4[3]};
                    H[nt] = __builtin_amdgcn_mfma_f32_32x32x16_bf16(bfr, ks == 0 ? w0 : ks == 1 ? w1 : ks == 2 ? w2 : w3, H[nt], 0, 0, 0);
                }
            }
        }
        LDS_WAIT();
    }
#undef S2_DMA
}

namespace ssd3 {
constexpr int O_DT = 98304, O_XD = 98816, O_OUT = 108032, OUTB = 13312, OO_XW = 512, OO_Y = 512 + 4608, O_FLAG = 147968, O_END = 148224;
__device__ __forceinline__ void spin_ge(const LAS unsigned char* ldl, int off, unsigned target) {
    for (;;) { const unsigned v = __builtin_amdgcn_readfirstlane(*(volatile const LAS unsigned*)(ldl + off)); if (v >= target) break; __builtin_amdgcn_s_sleep(1); }
    asm volatile("" ::: "memory");
}
#define S3_TRFRAG(base_) ({ const s16x4_t lo_ = __builtin_bit_cast(s16x4_t, __builtin_amdgcn_ds_read_tr16_b64_v4i16((LAS s16x4_t*)(ldl + (base_)))); \
                            const s16x4_t hi_ = __builtin_bit_cast(s16x4_t, __builtin_amdgcn_ds_read_tr16_b64_v4i16((LAS s16x4_t*)(ldl + (base_) + 8 * 72))); \
                            (bf16x8_t){lo_[0], lo_[1], lo_[2], lo_[3], hi_[0], hi_[1], hi_[2], hi_[3]}; })
__device__ __forceinline__ void producer(const Args& a, int item, unsigned char* lds, int p) {
    const int ps = item & 1, h = (item >> 1) & 15, dir = (item >> 5) & 1, b = item >> 6, g = h >> 3;
    const int lane0 = threadIdx.x & 63;
    const LAS unsigned char* ldl = (const LAS unsigned char*)lds; LAS unsigned char* ldw = (LAS unsigned char*)lds;
    const bf16_t* XB = (const bf16_t*)(a.ws + WS_XBC16); const float* ACT = (const float*)(a.ws + WS_ACT); const float* SM = (const float*)(a.ws + WS_SMALL);
    const float A = -expf(a.in[dir ? 13 : 12][h]); const float dtb = a.in[dir ? 11 : 10][h];
#define S3_DMA(c_, slot3_) do { const int t_ = dir ? SEQ - 1 - (64 * (c_) + lane0) : 64 * (c_) + lane0; const size_t mi_ = (size_t)b * SEQ + t_; \
        const bf16_t* br_ = XB + mi_ * 1536 + 1024 + g * 128; const bf16_t* cr_ = XB + mi_ * 1536 + 1280 + g * 128; const float* xr_ = ACT + mi_ * 1536 + h * 64 + ps * 32; \
        LAS unsigned char* lb_ = ldw + (slot3_) * 32768; LAS unsigned char* lx_ = ldw + O_OUT + (slot3_) * OUTB + OO_Y; \
        _Pragma("unroll") for (int x = 0; x < 16; ++x) { __builtin_amdgcn_global_load_lds((const unsigned*)(br_ + 8 * x), (LAS unsigned*)(lb_ + 1024 * x), 16, 0, 0); \
                                                         __builtin_amdgcn_global_load_lds((const unsigned*)(cr_ + 8 * x), (LAS unsigned*)(lb_ + 16384 + 1024 * x), 16, 0, 0); } \
        _Pragma("unroll") for (int x = 0; x < 8; ++x) __builtin_amdgcn_global_load_lds((const unsigned*)(xr_ + 4 * x), (LAS unsigned*)(lx_ + 1024 * x), 16, 0, 0); \
        __builtin_amdgcn_global_load_lds((const unsigned*)(SM + mi_ * 32 + dir * 16 + h), (LAS unsigned*)(ldw + O_DT + p * 256), 4, 0, 0); } while (0)
    int slot3 = p;
    for (int c = p; c < 32; c += 2) {
        int lane = lane0; asm volatile("" : "+v"(lane));
        const int r32 = lane & 31, hi = lane >> 5, trq = (lane & 15) >> 2, trp = lane & 3, trc = (lane >> 4) & 1;
        const int bo = slot3 * 32768, oo = O_OUT + slot3 * OUTB;
        if (c >= 3) spin_ge(ldl, O_FLAG, (unsigned)(c - 2));
        S3_DMA(c, slot3);
        asm volatile("s_waitcnt vmcnt(0)" ::: "memory");
        LAS float* Gs = (LAS float*)(ldw + oo); LAS float* Es = Gs + 64;
        const float dt = softplus_f(*(const LAS float*)(ldl + O_DT + p * 256 + lane * 4) + dtb);
        const float cs = wave_incl_scan(dt * A, lane); const float csL = __shfl(cs, 63);
        Gs[lane] = cs; Es[lane] = __expf(cs);
        {   const float wsc = dt * __expf(csL - cs);
#pragma unroll
            for (int x = 0; x < 8; ++x) { const f32x4 xv = *(const LAS f32x4*)(ldl + oo + OO_Y + (x * 64 + lane) * 16);
                v2u d; d.x = cvtpk_rne(xv.x * dt, xv.y * dt); d.y = cvtpk_rne(xv.z * dt, xv.w * dt); *(LAS v2u*)(ldw + O_XD + p * 4608 + lane * 72 + 8 * x) = d;
                v2u w; w.x = cvtpk_rne(xv.x * wsc, xv.y * wsc); w.y = cvtpk_rne(xv.z * wsc, xv.w * wsc); *(LAS v2u*)(ldw + oo + OO_XW + lane * 72 + 8 * x) = w; }
        }
        LDS_WAIT();
        f32x16_t g00, g01, g11;
#pragma unroll
        for (int r = 0; r < 16; ++r) { g00[r] = 0.f; g01[r] = 0.f; g11[r] = 0.f; }
#pragma unroll
        for (int kk = 0; kk < 8; ++kk) { const int fo = ((2 * kk + hi) * 64 + r32) * 16;
            const bf16x8_t A0 = *(const LAS bf16x8_t*)(ldl + bo + fo), A1 = *(const LAS bf16x8_t*)(ldl + bo + fo + 512);
            const bf16x8_t B0 = *(const LAS bf16x8_t*)(ldl + bo + 16384 + fo), B1 = *(const LAS bf16x8_t*)(ldl + bo + 16384 + fo + 512);
            g00 = __builtin_amdgcn_mfma_f32_32x32x16_bf16(A0, B0, g00, 0, 0, 0); g01 = __builtin_amdgcn_mfma_f32_32x32x16_bf16(A0, B1, g01, 0, 0, 0); g11 = __builtin_amdgcn_mfma_f32_32x32x16_bf16(A1, B1, g11, 0, 0, 0); }
        {   const float cst0 = Gs[r32], cst1 = Gs[32 + r32];
#pragma unroll
            for (int r = 0; r < 16; ++r) { const int il = (r & 3) + 8 * (r >> 2) + 4 * hi; const float css0 = Gs[il], css1 = Gs[32 + il];
                g00[r] = (il <= r32) ? g00[r] * __expf(cst0 - css0) : 0.f; g01[r] = g01[r] * __expf(cst1 - css0); g11[r] = (il <= r32) ? g11[r] * __expf(cst1 - css1) : 0.f; } }
        asm volatile("" ::: "memory");
        f32x16_t y0, y1;
#pragma unroll
        for (int r = 0; r < 16; ++r) { y0[r] = 0.f; y1[r] = 0.f; }
        {   const int xo = O_XD + p * 4608 + (4 * hi + trq) * 72 + (16 * trc + 4 * trp) * 2;
            const bf16x8_t x0 = S3_TRFRAG(xo), x1 = S3_TRFRAG(xo + 16 * 72), x2 = S3_TRFRAG(xo + 32 * 72), x3 = S3_TRFRAG(xo + 48 * 72);
            y0 = __builtin_amdgcn_mfma_f32_32x32x16_bf16(acc_frag<0>(g00), x0, y0, 0, 0, 0); y0 = __builtin_amdgcn_mfma_f32_32x32x16_bf16(acc_frag<1>(g00), x1, y0, 0, 0, 0);
            y1 = __builtin_amdgcn_mfma_f32_32x32x16_bf16(acc_frag<0>(g01), x0, y1, 0, 0, 0); y1 = __builtin_amdgcn_mfma_f32_32x32x16_bf16(acc_frag<1>(g01), x1, y1, 0, 0, 0);
            y1 = __builtin_amdgcn_mfma_f32_32x32x16_bf16(acc_frag<0>(g11), x2, y1, 0, 0, 0); y1 = __builtin_amdgcn_mfma_f32_32x32x16_bf16(acc_frag<1>(g11), x3, y1, 0, 0, 0); }
#pragma unroll
        for (int r = 0; r < 16; ++r) { *(LAS float*)(ldw + oo + OO_Y + r * 256 + lane * 4) = y0[r]; *(LAS float*)(ldw + oo + OO_Y + (16 + r) * 256 + lane * 4) = y1[r]; }
        LDS_WAIT();
        if (lane == 0) *(volatile LAS unsigned*)(ldw + O_FLAG + 64 + 4 * c) = 1u;
        slot3 = (slot3 == 0) ? 2 : slot3 - 1;
    }
#undef S3_DMA
}
__device__ __forceinline__ void consumer(const Args& a, int item, unsigned char* lds) {
    const int ps = item & 1, h = (item >> 1) & 15, dir = (item >> 5) & 1, b = item >> 6;
    const int lane0 = threadIdx.x & 63;
    const LAS unsigned char* ldl = (const LAS unsigned char*)lds; LAS unsigned char* ldw = (LAS unsigned char*)lds;
    float* Y = (float*)(a.ws + (dir ? WS_YB : WS_YF));
    f32x16_t H[4];
#pragma unroll
    for (int nt = 0; nt < 4; ++nt)
#pragma unroll
        for (int r = 0; r < 16; ++r) H[nt][r] = 0.f;
    int slot3 = 0;
    for (int c = 0; c < 32; ++c) {
        int lane = lane0; asm volatile("" : "+v"(lane));
        const int r32 = lane & 31, hi = lane >> 5, trq = (lane & 15) >> 2, trp = lane & 3, trc = (lane >> 4) & 1;
        const int bo = slot3 * 32768, oo = O_OUT + slot3 * OUTB;
        const LAS float* Gs = (const LAS float*)(ldl + oo); const LAS float* Es = Gs + 64;
        spin_ge(ldl, O_FLAG + 64 + 4 * c, 1u);
        {   f32x16_t Z0, Z1;
#pragma unroll
            for (int r = 0; r < 16; ++r) { Z0[r] = 0.f; Z1[r] = 0.f; }
#define S3_LFRAG(off_) join44(*(const LAS v2u*)(ldl + (off_)), *(const LAS v2u*)(ldl + (off_) + 1024))
#pragma unroll
            for (int nt = 0; nt < 4; ++nt) { const bf16x8_t hb0 = acc_frag<0>(H[nt]), hb1 = acc_frag<1>(H[nt]);
                const int ro = bo + 16384 + ((4 * nt) * 64 + r32) * 16 + 8 * hi;
                Z0 = __builtin_amdgcn_mfma_f32_32x32x16_bf16(S3_LFRAG(ro), hb0, Z0, 0, 0, 0); Z0 = __builtin_amdgcn_mfma_f32_32x32x16_bf16(S3_LFRAG(ro + 2048), hb1, Z0, 0, 0, 0);
                Z1 = __builtin_amdgcn_mfma_f32_32x32x16_bf16(S3_LFRAG(ro + 512), hb0, Z1, 0, 0, 0); Z1 = __builtin_amdgcn_mfma_f32_32x32x16_bf16(S3_LFRAG(ro + 512 + 2048), hb1, Z1, 0, 0, 0); }
#undef S3_LFRAG
            const int tb = dir ? SEQ - 1 - (64 * c + 4 * hi) : 64 * c + 4 * hi;
            float* yb = Y + ((size_t)b * SEQ + tb) * 1024 + h * 64 + ps * 32 + r32;
#pragma unroll
            for (int r = 0; r < 16; ++r) { const int il0 = (r & 3) + 8 * (r >> 2), il = il0 + 4 * hi;
                const float yd0 = *(const LAS float*)(ldl + oo + OO_Y + r * 256 + lane * 4), yd1 = *(const LAS float*)(ldl + oo + OO_Y + (16 + r) * 256 + lane * 4);
                const long ro0 = dir ? -(long)il0 * 1024 : (long)il0 * 1024, ro1 = dir ? -(long)(il0 + 32) * 1024 : (long)(il0 + 32) * 1024;
                yb[ro0] = fmaf(Es[il], Z0[r], yd0); yb[ro1] = fmaf(Es[32 + il], Z1[r], yd1); } }
        asm volatile("" ::: "memory");
        {   const float eL = __expf(Gs[63]);
            const int xo = oo + OO_XW + (4 * hi + trq) * 72 + (16 * trc + 4 * trp) * 2;
            const bf16x8_t w0 = S3_TRFRAG(xo), w1 = S3_TRFRAG(xo + 16 * 72), w2 = S3_TRFRAG(xo + 32 * 72), w3 = S3_TRFRAG(xo + 48 * 72);
#pragma unroll
            for (int nt = 0; nt < 4; ++nt) {
#pragma unroll
                for (int r = 0; r < 16; ++r) H[nt][r] *= eL;
#pragma unroll
                for (int ks = 0; ks < 4; ++ks) {
                    const int ro = bo + ((4 * nt + 2 * trc + (trp >> 1)) * 64 + 16 * ks + 4 * hi + trq) * 16 + 8 * (trp & 1);
                    const s16x4_t lo = __builtin_bit_cast(s16x4_t, __builtin_amdgcn_ds_read_tr16_b64_v4i16((LAS s16x4_t*)(ldl + ro)));
                    const s16x4_t hi4 = __builtin_bit_cast(s16x4_t, __builtin_amdgcn_ds_read_tr16_b64_v4i16((LAS s16x4_t*)(ldl + ro + 8 * 16)));
                    const bf16x8_t bfr = (bf16x8_t){lo[0], lo[1], lo[2], lo[3], hi4[0], hi4[1], hi4[2], hi4[3]};
                    H[nt] = __builtin_amdgcn_mfma_f32_32x32x16_bf16(bfr, ks == 0 ? w0 : ks == 1 ? w1 : ks == 2 ? w2 : w3, H[nt], 0, 0, 0);
                }
            }
        }
        LDS_WAIT();
        if (lane == 0) *(volatile LAS unsigned*)(ldw + O_FLAG) = (unsigned)(c + 1);
        slot3 = (slot3 == 2) ? 0 : slot3 + 1;
    }
}
#undef S3_TRFRAG
}

__device__ __forceinline__ void lru_tile(const Args& a, int item, unsigned char* lds, int pass) {
    const int n = item & 7, tc = (item >> 3) & 63, b = item >> 9, t0 = tc * 32;
    float* xc = (float*)lds; bf16_t* xcb = (bf16_t*)(lds + 16384); float* As = (float*)(lds + 25088); float* Us = As + 2 * 32 * 128; float2* sg = (float2*)(Us + 2 * 32 * 128);
    const int tid = threadIdx.x, lane = tid & 63, wave = tid >> 6;
    const bf16_t* P = (const bf16_t*)(a.ws + WS_PROJ);
    __syncthreads();
    {
        const int j = tid & 127, tg = tid >> 7, chn = n * 128 + j; const float* cw = a.in[25];
        const float w0 = cw[chn], w1 = cw[1024 + chn], w2 = cw[2048 + chn], w3 = cw[3072 + chn], cbias = a.in[26][chn];
        const int tb = t0 + tg * 8;
        const bf16_t* pp = P + ((size_t)b * SEQ + tb) * NINP + C_XL + chn;
        float xm2 = (tb >= 2) ? bf2f(pp[-2 * NINP]) : 0.f, xm1 = (tb >= 1) ? bf2f(pp[-NINP]) : 0.f, x0 = bf2f(pp[0]);
#pragma unroll
        for (int i = 0; i < 8; ++i) { const float xp1 = (tb + i + 1 < SEQ) ? bf2f(pp[(i + 1) * NINP]) : 0.f;
            const float acc = cbias + w0 * xm2 + w1 * xm1 + w2 * x0 + w3 * xp1;
            xc[(tg * 8 + i) * 128 + j] = acc; xcb[(tg * 8 + i) * 136 + j] = (bf16_t)f2bf(acc);
            xm2 = xm1; xm1 = x0; x0 = xp1; }
    }
    __syncthreads();
    {
        const int ct = wave & 3, d = wave >> 2, r32 = lane & 31, hi = lane >> 5;
        const bf16_t* WT = (const bf16_t*)(a.ws + WS_WGT);
        const bf16_t* wa_p = WT + ((size_t)((2 * d) * 8 + n) * 128 + ct * 32 + r32) * 128 + hi * 8;
        const bf16_t* wx_p = WT + ((size_t)((2 * d + 1) * 8 + n) * 128 + ct * 32 + r32) * 128 + hi * 8;
        f32x16_t ca, cx;
#pragma unroll
        for (int r = 0; r < 16; ++r) { ca[r] = 0.f; cx[r] = 0.f; }
#pragma unroll
        for (int s = 0; s < 8; ++s) {
            const bf16x8_t af = *(const bf16x8_t*)((const char*)xcb + r32 * 272 + (s * 16 + hi * 8) * 2);
            const bf16x8_t fa = *(const bf16x8_t*)(wa_p + s * 16); const bf16x8_t fx = *(const bf16x8_t*)(wx_p + s * 16);
            ca = __builtin_amdgcn_mfma_f32_32x32x16_bf16(af, fa, ca, 0, 0, 0); cx = __builtin_amdgcn_mfma_f32_32x32x16_bf16(af, fx, cx, 0, 0, 0);
        }
        const int j = ct * 32 + r32, cj = n * 128 + j;
        const float baj = a.in[d ? 33 : 28][cj], bxj = a.in[d ? 35 : 30][cj], sp = softplus_f(-a.in[d ? 36 : 31][cj]);
#pragma unroll
        for (int r = 0; r < 16; ++r) { const int t = (r & 3) + 8 * (r >> 2) + 4 * hi;
            const float rg = __builtin_amdgcn_rcpf(1.f + __expf(-(ca[r] + baj))), ig = __builtin_amdgcn_rcpf(1.f + __expf(-(cx[r] + bxj))); const float la = -8.f * rg * sp;
            const float av = __expf(la);
            const float om = (la > -0.0625f) ? -2.f * la * (1.f + la * (1.f + la * (0.6666667f + 0.3333333f * la))) : (1.f - av) * (1.f + av);
            As[(d * 32 + t) * 128 + j] = av; Us[(d * 32 + t) * 128 + j] = __builtin_amdgcn_sqrtf(om) * (ig * xc[t * 128 + j]); }
    }
    __syncthreads();
    {
        const int j = tid & 127, d = (tid >> 7) & 1, seg = tid >> 8;
        float Pp = 1.f, H = 0.f;
#pragma unroll
        for (int k = 0; k < 16; ++k) { const int q = seg * 16 + k, t = d ? 31 - q : q; const float a_ = As[(d * 32 + t) * 128 + j], u_ = Us[(d * 32 + t) * 128 + j]; H = fmaf(a_, H, u_); Pp *= a_; }
        sg[(d * 2 + seg) * 128 + j] = make_float2(Pp, H);
        __syncthreads();
        float2* LS = (float2*)(a.ws + WS_LSUM);
        if (pass == 0) {
            if (seg == 0) { const float2 s1 = sg[(d * 2 + 1) * 128 + j]; LS[((size_t)(d * 4 + b) * 64 + tc) * 1024 + n * 128 + j] = make_float2(Pp * s1.x, fmaf(s1.x, H, s1.y)); }
        } else {
            float c = 0.f;
            const float2* lsp = LS + ((size_t)(d * 4 + b) * 64) * 1024 + n * 128 + j;
#pragma unroll 1
            for (int c0 = 0; c0 < 64; c0 += 16) { float2 sv[16];
#pragma unroll
                for (int i = 0; i < 16; ++i) { const int cc = d ? 63 - (c0 + i) : c0 + i; sv[i] = lsp[(size_t)cc * 1024]; }
#pragma unroll
                for (int i = 0; i < 16; ++i) { const int cc = d ? 63 - (c0 + i) : c0 + i; const bool before = d ? (cc > tc) : (cc < tc); if (before) c = fmaf(sv[i].x, c, sv[i].y); } }
            if (seg == 1) { const float2 s0 = sg[(d * 2) * 128 + j]; c = fmaf(s0.x, c, s0.y); }
            float h = c;
#pragma unroll
            for (int k = 0; k < 16; ++k) { const int q = seg * 16 + k, t = d ? 31 - q : q; const float a_ = As[(d * 32 + t) * 128 + j], u_ = Us[(d * 32 + t) * 128 + j]; h = fmaf(a_, h, u_); Us[(d * 32 + t) * 128 + j] = h; }
            __syncthreads();
            bf16_t* YC = (bf16_t*)(a.ws + WS_YCAT);
            const int jj = tid & 127, tg = tid >> 7;
#pragma unroll
            for (int i = 0; i < 8; ++i) { const int t = tg * 8 + i; const size_t row = (size_t)b * SEQ + t0 + t;
                const float hs = Us[t * 128 + jj] + Us[(32 + t) * 128 + jj]; const float gl = bf2f(P[row * NINP + C_GL + n * 128 + jj]);
                YC[row * 2048 + 1024 + n * 128 + jj] = (bf16_t)f2bf(hs * silu_f(gl)); }
        }
    }
}

template <bool FINAL>
__device__ __forceinline__ void lru_wave(const Args& a, int witem, unsigned char* ldsw, int lane) {
    asm volatile("" : "+v"(lane));
    const int n = witem & 7, tc = (witem >> 3) & 63, b = witem >> 9, t0 = tc * 32;
    const int r32 = lane & 31, hi = lane >> 5;
    bf16_t* xcb = (bf16_t*)ldsw;
    const bf16_t* P = (const bf16_t*)(a.ws + WS_PROJ);
    bf16_t* XC = (bf16_t*)(a.ws + WS_XC16) + ((size_t)b * SEQ + t0) * 1024 + n * 128;
    if constexpr (!FINAL) {
        const int chn = n * 128 + 2 * lane; const float* cw = a.in[25];
        const f32x2 w0 = *(const f32x2*)(cw + chn), w1 = *(const f32x2*)(cw + 1024 + chn), w2 = *(const f32x2*)(cw + 2048 + chn), w3 = *(const f32x2*)(cw + 3072 + chn), cb2 = *(const f32x2*)(a.in[26] + chn);
        const bf16_t* pp = P + ((size_t)b * SEQ + t0) * NINP + C_XL + chn;
        f32x2 xm2 = {0.f, 0.f}, xm1 = {0.f, 0.f}, x0;
        if (t0 >= 2) { const unsigned v = *(const unsigned*)(pp - 2 * NINP); xm2 = (f32x2){bf2f(v & 0xffffu), __uint_as_float(v & 0xffff0000u)}; }
        if (t0 >= 1) { const unsigned v = *(const unsigned*)(pp - NINP); xm1 = (f32x2){bf2f(v & 0xffffu), __uint_as_float(v & 0xffff0000u)}; }
        { const unsigned v = *(const unsigned*)pp; x0 = (f32x2){bf2f(v & 0xffffu), __uint_as_float(v & 0xffff0000u)}; }
#pragma unroll 8
        for (int i = 0; i < 32; ++i) { f32x2 xp1 = {0.f, 0.f};
            if (t0 + i + 1 < SEQ) { const unsigned v = *(const unsigned*)(pp + (size_t)(i + 1) * NINP); xp1 = (f32x2){bf2f(v & 0xffffu), __uint_as_float(v & 0xffff0000u)}; }
            const f32x2 acc = cb2 + w0 * xm2 + w1 * xm1 + w2 * x0 + w3 * xp1;
            const unsigned pk = pk2(acc.x, acc.y);
            *(unsigned*)(xcb + i * 136 + 2 * lane) = pk; *(unsigned*)(XC + (size_t)i * 1024 + 2 * lane) = pk;
            xm2 = xm1; xm1 = x0; x0 = xp1; }
        LDS_WAIT();
    }
    const bf16_t* WT = (const bf16_t*)(a.ws + WS_WGT);
    float2* LS = (float2*)(a.ws + WS_LSUM);
    const bf16_t* xcr = XC + (size_t)r32 * 1024 + hi * 8;
#pragma unroll 1
    for (int ct = 0; ct < 4; ++ct) {
    const int j = ct * 32 + r32, cj = n * 128 + j;
    float xv[16];
#pragma unroll
    for (int r = 0; r < 16; ++r) { const int t = (r & 3) + 8 * (r >> 2) + 4 * hi; xv[r] = bf2f(FINAL ? XC[(size_t)t * 1024 + j] : xcb[t * 136 + j]); }
    float hs[16];
#pragma unroll
    for (int d = 0; d < 2; ++d) {
        const bf16_t* wa_p = WT + ((size_t)((2 * d) * 8 + n) * 128 + j) * 128 + hi * 8;
        const bf16_t* wx_p = WT + ((size_t)((2 * d + 1) * 8 + n) * 128 + j) * 128 + hi * 8;
        f32x16_t ca, cx;
#pragma unroll
        for (int r = 0; r < 16; ++r) { ca[r] = 0.f; cx[r] = 0.f; }
#pragma unroll
        for (int s = 0; s < 8; ++s) {
            const bf16x8_t af = FINAL ? *(const bf16x8_t*)(xcr + s * 16) : *(const bf16x8_t*)((const char*)xcb + r32 * 272 + (s * 16 + hi * 8) * 2);
            const bf16x8_t fa = *(const bf16x8_t*)(wa_p + s * 16); const bf16x8_t fx = *(const bf16x8_t*)(wx_p + s * 16);
            ca = __builtin_amdgcn_mfma_f32_32x32x16_bf16(af, fa, ca, 0, 0, 0); cx = __builtin_amdgcn_mfma_f32_32x32x16_bf16(af, fx, cx, 0, 0, 0);
        }
        asm volatile("" ::: "memory");
        const float baj = a.in[d ? 33 : 28][cj], bxj = a.in[d ? 35 : 30][cj], sp = softplus_f(-a.in[d ? 36 : 31][cj]);
        float av[16], uv[16];
#pragma unroll
        for (int r = 0; r < 16; ++r) { const int t = (r & 3) + 8 * (r >> 2) + 4 * hi;
            const float rg = __builtin_amdgcn_rcpf(1.f + __expf(-(ca[r] + baj))), ig = __builtin_amdgcn_rcpf(1.f + __expf(-(cx[r] + bxj))); const float la = -8.f * rg * sp;
            av[r] = __expf(la);
            const float om = (la > -0.0625f) ? -2.f * la * (1.f + la * (1.f + la * (0.6666667f + 0.3333333f * la))) : (1.f - av[r]) * (1.f + av[r]);
            uv[r] = __builtin_amdgcn_sqrtf(om) * (ig * xv[r]); }
        asm volatile("" ::: "memory");
        float Pg[4], Hg[4];
#pragma unroll
        for (int sg = 0; sg < 4; ++sg) { float Pp = 1.f, Hh = 0.f;
#pragma unroll
            for (int e4 = 0; e4 < 4; ++e4) { const int r = 4 * sg + (d ? 3 - e4 : e4); Hh = fmaf(av[r], Hh, uv[r]); Pp *= av[r]; }
            Pg[sg] = Pp; Hg[sg] = Hh; }
        float Po[4], Ho[4];
#pragma unroll
        for (int sg = 0; sg < 4; ++sg) { Po[sg] = __shfl_xor(Pg[sg], 32); Ho[sg] = __shfl_xor(Hg[sg], 32); }
        if constexpr (!FINAL) {
            float Ac = 1.f, Hc = 0.f;
#pragma unroll
            for (int qq = 0; qq < 8; ++qq) { const int q = d ? 7 - qq : qq;
                const bool mine = ((q & 1) == hi); const float pq = mine ? Pg[q >> 1] : Po[q >> 1], hq_ = mine ? Hg[q >> 1] : Ho[q >> 1];
                Hc = fmaf(pq, Hc, hq_); Ac *= pq; }
            if (hi == 0) LS[((size_t)(d * 4 + b) * 64 + tc) * 1024 + cj] = make_float2(Ac, Hc);
        } else {
            float c = 0.f;
            const float2* lsp = LS + ((size_t)(d * 4 + b) * 64) * 1024 + cj;
            const int nneed = d ? 63 - tc : tc;
#pragma unroll 1
            for (int c0 = 0; c0 < nneed; c0 += 16) { float2 sv[16];
#pragma unroll
                for (int i = 0; i < 16; ++i) { const int ci = (c0 + i < nneed) ? c0 + i : nneed - 1; const int cc = d ? 63 - ci : ci; sv[i] = lsp[(size_t)cc * 1024]; }
#pragma unroll
                for (int i = 0; i < 16; ++i) { if (c0 + i < nneed) c = fmaf(sv[i].x, c, sv[i].y); } }
            asm volatile("" ::: "memory");
            float cin[4];
#pragma unroll
            for (int qq = 0; qq < 8; ++qq) { const int q = d ? 7 - qq : qq;
                const bool mine = ((q & 1) == hi); const float pq = mine ? Pg[q >> 1] : Po[q >> 1], hq_ = mine ? Hg[q >> 1] : Ho[q >> 1];
                if (mine) cin[q >> 1] = c;
                c = fmaf(pq, c, hq_); }
#pragma unroll
            for (int sg = 0; sg < 4; ++sg) { float h = cin[sg];
#pragma unroll
                for (int e4 = 0; e4 < 4; ++e4) { const int r = 4 * sg + (d ? 3 - e4 : e4); h = fmaf(av[r], h, uv[r]); hs[r] = (d == 0) ? h : hs[r] + h; } }
        }
    }
    if constexpr (FINAL) {
        bf16_t* YC = (bf16_t*)(a.ws + WS_YCAT);
#pragma unroll
        for (int r = 0; r < 16; ++r) { const int t = (r & 3) + 8 * (r >> 2) + 4 * hi; const size_t row = (size_t)b * SEQ + t0 + t;
            const float gl = bf2f(P[row * NINP + C_GL + cj]);
            YC[row * 2048 + 1024 + cj] = (bf16_t)f2bf(hs[r] * silu_f(gl)); }
    }
    }
    LDS_WAIT();
}

template <int d>
__device__ __forceinline__ void lru_run(const Args& a, int task, int lane) {
    asm volatile("" : "+v"(lane));
    const int run = task & 7, ct = (task >> 4) & 3, n = (task >> 6) & 7, b = task >> 9;
    const int r32 = lane & 31, hi = lane >> 5, j = ct * 32 + r32, cj = n * 128 + j;
    const bf16_t* WT = (const bf16_t*)(a.ws + WS_WGT);
    const bf16_t* wa_p = WT + ((size_t)((2 * d) * 8 + n) * 128 + j) * 128 + hi * 8;
    const bf16_t* wx_p = WT + ((size_t)((2 * d + 1) * 8 + n) * 128 + j) * 128 + hi * 8;
    bf16x8_t fa[8], fx[8];
#pragma unroll
    for (int s = 0; s < 8; ++s) { fa[s] = *(const bf16x8_t*)(wa_p + s * 16); fx[s] = *(const bf16x8_t*)(wx_p + s * 16); }
    const float baj = a.in[d ? 33 : 28][cj], bxj = a.in[d ? 35 : 30][cj], sp = softplus_f(-a.in[d ? 36 : 31][cj]);
    const float2* lsp = (const float2*)(a.ws + WS_LSUM) + ((size_t)(d * 4 + b) * 64) * 1024 + cj;
    bf16_t* HD = (bf16_t*)(a.ws + (d ? WS_HB16 : WS_HF16));
    float c = 0.f;
    { const int nneed = 8 * run;
#pragma unroll 1
      for (int c0 = 0; c0 < nneed; c0 += 8) { float2 sv[8];
#pragma unroll
          for (int i = 0; i < 8; ++i) { const int ci = c0 + i; const int cc = d ? 63 - ci : ci; sv[i] = lsp[(size_t)cc * 1024]; }
#pragma unroll
          for (int i = 0; i < 8; ++i) c = fmaf(sv[i].x, c, sv[i].y); } }
#pragma unroll 1
    for (int k = 0; k < 8; ++k) {
        const int ci = 8 * run + k, tc = d ? 63 - ci : ci, t0 = tc * 32;
        const bf16_t* XC = (const bf16_t*)(a.ws + WS_XC16) + ((size_t)b * SEQ + t0) * 1024 + n * 128;
        const bf16_t* xcr = XC + (size_t)r32 * 1024 + hi * 8;
        f32x16_t ca, cx;
#pragma unroll
        for (int r = 0; r < 16; ++r) { ca[r] = 0.f; cx[r] = 0.f; }
#pragma unroll
        for (int s = 0; s < 8; ++s) { const bf16x8_t af = *(const bf16x8_t*)(xcr + s * 16);
            ca = __builtin_amdgcn_mfma_f32_32x32x16_bf16(af, fa[s], ca, 0, 0, 0); cx = __builtin_amdgcn_mfma_f32_32x32x16_bf16(af, fx[s], cx, 0, 0, 0); }
        float av[16], uv[16];
#pragma unroll
        for (int r = 0; r < 16; ++r) { const int t = (r & 3) + 8 * (r >> 2) + 4 * hi;
            const float xvr = bf2f(XC[(size_t)t * 1024 + j]);
            const float rg = __builtin_amdgcn_rcpf(1.f + __expf(-(ca[r] + baj))), ig = __builtin_amdgcn_rcpf(1.f + __expf(-(cx[r] + bxj))); const float la = -8.f * rg * sp;
            av[r] = __expf(la);
            const float om = (la > -0.0625f) ? -2.f * la * (1.f + la * (1.f + la * (0.6666667f + 0.3333333f * la))) : (1.f - av[r]) * (1.f + av[r]);
            uv[r] = __builtin_amdgcn_sqrtf(om) * (ig * xvr); }
        float Pg[4], Hg[4];
#pragma unroll
        for (int sg = 0; sg < 4; ++sg) { float Pp = 1.f, Hh = 0.f;
#pragma unroll
            for (int e4 = 0; e4 < 4; ++e4) { const int r = 4 * sg + (d ? 3 - e4 : e4); Hh = fmaf(av[r], Hh, uv[r]); Pp *= av[r]; }
            Pg[sg] = Pp; Hg[sg] = Hh; }
        float Po[4], Ho[4];
#pragma unroll
        for (int sg = 0; sg < 4; ++sg) { Po[sg] = __shfl_xor(Pg[sg], 32); Ho[sg] = __shfl_xor(Hg[sg], 32); }
        float cin[4];
#pragma unroll
        for (int qq = 0; qq < 8; ++qq) { const int q = d ? 7 - qq : qq;
            const bool mine = ((q & 1) == hi); const float pq = mine ? Pg[q >> 1] : Po[q >> 1], hq_ = mine ? Hg[q >> 1] : Ho[q >> 1];
            if (mine) cin[q >> 1] = c;
            c = fmaf(pq, c, hq_); }
#pragma unroll
        for (int sg = 0; sg < 4; ++sg) { float h = cin[sg];
#pragma unroll
            for (int e4 = 0; e4 < 4; ++e4) { const int r = 4 * sg + (d ? 3 - e4 : e4); const int t = (r & 3) + 8 * (r >> 2) + 4 * hi;
                h = fmaf(av[r], h, uv[r]); HD[((size_t)b * SEQ + t0 + t) * 1024 + cj] = (bf16_t)f2bf(h); } }
    }
}

__device__ __forceinline__ void combine1_phase(const Args& a, int gw, int NGW, int lane) {
    const float* OF = (const float*)(a.ws + WS_YF); const float* OB = (const float*)(a.ws + WS_YB);
    const bf16_t* P = (const bf16_t*)(a.ws + WS_PROJ); bf16_t* YC = (bf16_t*)(a.ws + WS_YCAT);
    const float* gn = a.in[24];
    for (int m = gw; m < MTOK; m += NGW) {
        const int ch = lane * 16, d0 = ch & 127;
        float z[16], ov[16];
        unpack8(*(const v4u*)(P + (size_t)m * NINP + C_Z + ch), z); unpack8(*(const v4u*)(P + (size_t)m * NINP + C_Z + ch + 8), z + 8);
#pragma unroll
        for (int q = 0; q < 4; ++q) { const f32x4 f = *(const f32x4*)(OF + (size_t)m * 1024 + ch + 4 * q), bk = *(const f32x4*)(OB + (size_t)m * 1024 + ch + 4 * q); const f32x4 o = f + bk;
            ov[4 * q] = o.x; ov[4 * q + 1] = o.y; ov[4 * q + 2] = o.z; ov[4 * q + 3] = o.w; }
        float ss = 0.f;
#pragma unroll
        for (int i = 0; i < 16; ++i) ss += ov[i] * ov[i];
        ss = group_sum<8>(ss);
        const float r = rsqrtf(ss * (1.f / 128.f) + EPS);
#pragma unroll
        for (int i = 0; i < 16; ++i) ov[i] = ov[i] * r * gn[d0 + i] * silu_f(z[i]);
        *(v4u*)(YC + (size_t)m * 2048 + ch) = pack8(ov); *(v4u*)(YC + (size_t)m * 2048 + ch + 8) = pack8(ov + 8);
        { const bf16_t* HF = (const bf16_t*)(a.ws + WS_HF16); const bf16_t* HB = (const bf16_t*)(a.ws + WS_HB16);
          float hf[16], hb[16];
          unpack8(*(const v4u*)(P + (size_t)m * NINP + C_GL + ch), z); unpack8(*(const v4u*)(P + (size_t)m * NINP + C_GL + ch + 8), z + 8);
          unpack8(*(const v4u*)(HF + (size_t)m * 1024 + ch), hf); unpack8(*(const v4u*)(HF + (size_t)m * 1024 + ch + 8), hf + 8);
          unpack8(*(const v4u*)(HB + (size_t)m * 1024 + ch), hb); unpack8(*(const v4u*)(HB + (size_t)m * 1024 + ch + 8), hb + 8);
#pragma unroll
          for (int i = 0; i < 16; ++i) ov[i] = (hf[i] + hb[i]) * silu_f(z[i]);
          *(v4u*)(YC + (size_t)m * 2048 + 1024 + ch) = pack8(ov); *(v4u*)(YC + (size_t)m * 2048 + 1024 + ch + 8) = pack8(ov + 8); }
    }
}

__device__ __forceinline__ void final_norm_phase(const Args& a, int gw, int NGW, int lane) {
    const float* nw = a.in[38];
    for (int m = gw; m < MTOK; m += NGW) {
        f32x4* xr = (f32x4*)(a.out + (size_t)m * 2048) + lane;
        f32x4 v[8]; float s = 0.f;
#pragma unroll
        for (int j = 0; j < 8; ++j) { v[j] = xr[64 * j]; s += (v[j].x * v[j].x + v[j].y * v[j].y) + (v[j].z * v[j].z + v[j].w * v[j].w); }
        const float rstd = rsqrtf(group_sum<64>(s) * (1.f / 2048.f) + EPS);
#pragma unroll
        for (int j = 0; j < 8; ++j) { const f32x4 w = *(const f32x4*)(nw + (64 * j + lane) * 4); xr[64 * j] = v[j] * rstd * w; }
    }
}

typedef GAS unsigned gu32;
#define RLX_AGENT __ATOMIC_RELAXED, __HIP_MEMORY_SCOPE_AGENT
constexpr int CW_BAR = 4096;
constexpr int MISC_OFF = 163840 - 128;
#define XB_TMO      128
#define XB_XCNT(j)  (256  + 64 * (j))
#define XB_XSUB(j)  (1280 + 64 * (j))
#define XB_XGEN(j)  (2304 + 64 * (j))
#define XB_TOP      3328
#define XB_TOPGEN   3392
#define XCD_BAR_WORDS 3456
#define XB_SPIN_CAP (1u << 18)

__device__ __forceinline__ unsigned xb_ld(unsigned* p)              { return __hip_atomic_load(p, __ATOMIC_RELAXED, __HIP_MEMORY_SCOPE_AGENT); }
__device__ __forceinline__ unsigned xb_add(unsigned* p, unsigned v) { return __hip_atomic_fetch_add(p, v, __ATOMIC_RELAXED, __HIP_MEMORY_SCOPE_AGENT); }
__device__ __forceinline__ unsigned xb_xcc_id() { return (unsigned)__builtin_amdgcn_s_getreg((3 << 11) | 20) & 0xFu; }
#define XB_SPIN(cond, bar) do { unsigned _sp = 0; while (cond) { __builtin_amdgcn_s_sleep(1); \
    if ((++_sp & 255u) == 0u) { if (xb_ld(&(bar)[XB_TMO])) break; if (_sp > XB_SPIN_CAP) { atomicAdd(&(bar)[XB_TMO], 1u); break; } } } } while (0)

struct XcdBarrier {
    unsigned* bar; unsigned x;
    volatile LAS unsigned* st;
};

__device__ __forceinline__ XcdBarrier xcd_barrier_post(unsigned* bar, volatile LAS unsigned* st) {
    XcdBarrier b; b.bar = bar; b.x = xb_xcc_id(); b.st = st;
    if (threadIdx.x == 0) (void)xb_add(&bar[XB_XCNT(b.x)], 1u);
    return b;
}
__device__ __forceinline__ void xcd_barrier_complete(unsigned* bar, unsigned x, unsigned& nloc, unsigned& nx) {
    const unsigned G = gridDim.x * gridDim.y * gridDim.z;
    unsigned sum, cnt, mine, sp = 0u;
    for (;;) {
        sum = 0u; cnt = 0u; mine = 0u;
#pragma unroll
        for (unsigned j = 0; j < 16; ++j) { const unsigned c = xb_ld(&bar[XB_XCNT(j)]); sum += c; cnt += (c > 0u) ? 1u : 0u; mine = (j == x) ? c : mine; }
        if (sum == G) break;
        __builtin_amdgcn_s_sleep(1);
        if ((++sp & 255u) == 0u) { if (xb_ld(&bar[XB_TMO])) break; if (sp > XB_SPIN_CAP) { atomicAdd(&bar[XB_TMO], 1u); break; } }
    }
    nloc = mine > 0u ? mine : 1u; nx = cnt > 0u ? cnt : 1u;
}

__device__ __forceinline__ void xcd_barrier(const XcdBarrier& b) {
    asm volatile("s_waitcnt vmcnt(0)" ::: "memory");
    __syncthreads();
    if (threadIdx.x == 0) {
        unsigned* bar = b.bar;
        __builtin_amdgcn_s_waitcnt(0);
        unsigned nloc = b.st[0], nx = b.st[1];
        if (nloc == 0u) { xcd_barrier_complete(bar, b.x, nloc, nx); b.st[0] = nloc; b.st[1] = nx; }
        const unsigned old = xb_add(&bar[XB_XSUB(b.x)], 1u);
        const unsigned gen = old / nloc;
        if (old + 1u == (gen + 1u) * nloc) {
            __builtin_amdgcn_fence(__ATOMIC_RELEASE, "agent");
            asm volatile("s_waitcnt vmcnt(0)" ::: "memory");
            const unsigned og = xb_add(&bar[XB_TOP], 1u);
            const unsigned tg = og / nx;
            if (og + 1u == (tg + 1u) * nx) xb_add(&bar[XB_TOPGEN], 1u);
            else XB_SPIN(xb_ld(&bar[XB_TOPGEN]) == tg, bar);
            __builtin_amdgcn_fence(__ATOMIC_ACQUIRE, "agent");
            xb_add(&bar[XB_XGEN(b.x)], 1u);
            asm volatile("s_waitcnt vmcnt(0)" ::: "memory");
        } else {
            XB_SPIN(xb_ld(&bar[XB_XGEN(b.x)]) == gen, bar);
            __builtin_amdgcn_fence(__ATOMIC_ACQUIRE, "agent");
            asm volatile("s_waitcnt vmcnt(0)" ::: "memory");
        }
    }
    __syncthreads();
}

#ifndef PROBE_MASK
#define PROBE_MASK 0
#endif
#define REP(bit) for (int rep_ = 0; rep_ < 1 + ((PROBE_MASK >> (bit)) & 1); ++rep_)
#ifndef PROBE_SSD
#define PROBE_SSD 0
#endif
#ifndef PROBE_GDN
#define PROBE_GDN 0
#endif
#ifndef PROBE_LRU
#define PROBE_LRU 0
#endif
#ifndef MK_SINGLE
#define MK_SINGLE 1
#endif
__global__ void __launch_bounds__(NTHREADS, 2) mk_fwd(Args a) {
    extern __shared__ __attribute__((aligned(16))) unsigned char lds[];
    LAS unsigned char* ldsl = (LAS unsigned char*)lds;
    const int tid = threadIdx.x, lane = tid & 63, wave = __builtin_amdgcn_readfirstlane(tid >> 6);
    const int G = gridDim.x, bx = blockIdx.x;
    const int vcu = (G % 8 == 0) ? (bx % 8) * (G / 8) + bx / 8 : bx;
    const int gw = vcu * NWAVES + wave, NGW = G * NWAVES;
    unsigned char* ws = a.ws;
    volatile LAS unsigned* MISC = (volatile LAS unsigned*)(ldsl + MISC_OFF);
    if (tid < 32) MISC[tid] = 0u;
    __syncthreads();
    XcdBarrier bar; bar.bar = (unsigned*)(ws + WS_CTL) + CW_BAR; bar.x = 0; bar.st = nullptr;
    if (a.ph_hi - a.ph_lo > 1) bar = xcd_barrier_post((unsigned*)(ws + WS_CTL) + CW_BAR, MISC + 8);
#define IN(k) (a.ph_lo <= (k) && (k) < a.ph_hi)
#define SEAM(k) do { if (IN(k) && IN((k) + 1)) { xcd_barrier(bar); } } while (0)

    if (IN(0)) { p0_prologue(a, ldsl, vcu, G); } SEAM(0);
    if (IN(1)) { REP(0) normmod_phase(a, a.in[0], 0, gw, NGW, lane); } SEAM(1);
    if (IN(2)) {
        pg8::Gemm g{(const bf16_t*)(ws + WS_H), (const bf16_t*)(ws + WS_WIN0), MTOK, NINP, 2048}; pg8::StaticOrder S; S.init(MTOK, NINP, G, bx);
        pg8::EpiProj E{(bf16_t*)(ws + WS_PROJ), (float*)(ws + WS_SMALL), NINP, A_DT / 256};
        REP(1) { pg8::gemm_phase<pg8::EpiProj, pg8::StaticOrder, true, true>(ldsl, g, S, E); __syncthreads(); }
    } SEAM(2);
    if (IN(3)) { REP(0) post0_phase(a, gw, NGW, lane); } SEAM(3);
    if (IN(4)) {
        REP(3) for (int u = vcu; u < 256; u += G) { const int b = u >> 6, h = (u >> 3) & 7, qb = u & 7, kvh = h >> 2; const size_t row0 = (size_t)b * SEQ + qb * 256;
            att::attn_dense_body((const att::bf16*)(ws + WS_QB) + row0 * 1024 + h * 128, (const att::bf16*)(ws + WS_KB) + (size_t)b * SEQ * 256 + kvh * 128,
                                 (const att::bf16*)(ws + WS_VB) + (size_t)b * SEQ * 256 + kvh * 128, (bf16_t*)(ws + WS_YCAT) + row0 * 2048 + h * 128,
                                 (const bf16_t*)(ws + WS_PROJ) + row0 * NINP + A_GA + h * 128, SEQ, (char*)lds);
            __syncthreads(); }
        for (int it = vcu; it < 256; it += G) {
            if (tid < 64) ((LAS unsigned*)(ldsl + ssd3::O_FLAG))[tid] = 0u;
            __syncthreads();
            if (wave == 0) ssd3::consumer(a, it, lds); else if (wave <= 2) ssd3::producer(a, it, lds, wave - 1);
            __syncthreads(); }
    } SEAM(4);
    if (IN(5)) { REP(0) ssd_combine_phase(a, gw, NGW, lane); late_transposes(a, (LAS float*)(ldsl + wave * 16384), gw, NGW, lane); } SEAM(5);
    if (IN(6)) {
        pg8::Gemm g{(const bf16_t*)(ws + WS_YCAT), (const bf16_t*)(ws + WS_WOUT0), MTOK, 2048, 2048}; pg8::StaticOrder S; S.init(MTOK, 2048, G, bx);
        pg8::EpiResid E{a.in[0], a.out, (const float*)(ws + WS_MOD), a.in[3]};
        REP(2) { pg8::gemm_phase<pg8::EpiResid, pg8::StaticOrder, true, true>(ldsl, g, S, E); __syncthreads(); }
    } SEAM(6);
    if (IN(7)) { REP(0) normmod_phase(a, a.out, 1, gw, NGW, lane); } SEAM(7);
    if (IN(8)) {
        pg8::Gemm g{(const bf16_t*)(ws + WS_H), (const bf16_t*)(ws + WS_WIN1), MTOK, NINP, 2048}; pg8::StaticOrder S; S.init(MTOK, NINP, G, bx);
        pg8::EpiProj E{(bf16_t*)(ws + WS_PROJ), (float*)(ws + WS_SMALL), NINP, C_SM / 256};
        pg8::gemm_phase<pg8::EpiProj, pg8::StaticOrder, true, true>(ldsl, g, S, E);
    } SEAM(8);
    if (IN(9)) { REP(0) post1_phase(a, gw, NGW, lane); } SEAM(9);
    if (IN(10)) {
        REP(5) { for (int it = gw; it < 2048; it += NGW) gdn1_item(a, it, lds + wave * GDN_LDS_PER_WAVE, lane); __syncthreads(); }
        for (int wi = gw; wi < 2048; wi += NGW) lru_wave<false>(a, wi, lds + wave * GDN_LDS_PER_WAVE, lane);
    } SEAM(10);
    if (IN(11)) {
        if (wave == 0) { REP(6) for (int it = vcu; it < 256; it += G) gdn2_item(a, it, lds); }
        else if (wave <= 3) { REP(7) for (int tk = vcu * 3 + (wave - 1); tk < 2048; tk += G * 3) { if ((tk >> 3) & 1) lru_run<1>(a, tk, lane); else lru_run<0>(a, tk, lane); } }
        __syncthreads();
    } SEAM(11);
    if (IN(12)) { REP(0) combine1_phase(a, gw, NGW, lane); } SEAM(12);
    if (IN(13)) {
        pg8::Gemm g{(const bf16_t*)(ws + WS_YCAT), (const bf16_t*)(ws + WS_WOUT1), MTOK, 2048, 2048}; pg8::StaticOrder S; S.init(MTOK, 2048, G, bx);
        pg8::EpiResid E{a.out, a.out, (const float*)(ws + WS_MOD) + 4 * 6144, a.in[3] + 6144};
        pg8::gemm_phase<pg8::EpiResid, pg8::StaticOrder, true, true>(ldsl, g, S, E);
    } SEAM(13);
    if (IN(14)) { final_norm_phase(a, gw, NGW, lane); }
#undef IN
#undef SEAM
}

extern "C" void kernel_launch(void* const* d_in, const int* in_sizes, int n_in, void* d_out, int out_size, void* d_ws, size_t ws_size, hipStream_t stream) {
    static int grid = 0;
    if (grid == 0) {
        if (n_in != 39 || out_size != MTOK * DM || ws_size < WS_END) { fprintf(stderr, "kernel_launch: unexpected problem (n_in %d, out %d, ws %zu < %zu)\n", n_in, out_size, ws_size, (size_t)WS_END); grid = -1; return; }
        int dev = 0, cus = 0, per_cu = 0;
        if (hipGetDevice(&dev) != hipSuccess || hipDeviceGetAttribute(&cus, hipDeviceAttributeMultiprocessorCount, dev) != hipSuccess) { grid = -1; return; }
        if (hipFuncSetAttribute((const void*)mk_fwd, hipFuncAttributeMaxDynamicSharedMemorySize, LDS_BYTES) != hipSuccess) { fprintf(stderr, "kernel_launch: hipFuncSetAttribute failed\n"); grid = -1; return; }
        if (hipOccupancyMaxActiveBlocksPerMultiprocessor(&per_cu, (const void*)mk_fwd, NTHREADS, LDS_BYTES) != hipSuccess || per_cu < 1) { fprintf(stderr, "kernel_launch: occupancy query says %d\n", per_cu); (void)hipGetLastError(); per_cu = 1; }
        grid = cus;
    }
    if (grid < 0) return;
    (void)hipMemsetAsync((char*)d_ws + WS_CTL, 0, CTL_ZERO_BYTES, stream);
    Args a{};
    for (int i = 0; i < 39; ++i) a.in[i] = (const float*)d_in[i];
    a.out = (float*)d_out; a.ws = (unsigned char*)d_ws;
#if MK_SINGLE
    a.ph_lo = 0; a.ph_hi = NPHASE;
    void* kargs[] = {&a};
    hipError_t e = hipLaunchCooperativeKernel((const void*)mk_fwd, dim3(grid), dim3(NTHREADS), kargs, LDS_BYTES, stream);
    if (e != hipSuccess) fprintf(stderr, "kernel_launch: cooperative launch failed: %s (grid %d)\n", hipGetErrorString(e), grid);
#else
    for (int p = 0; p < NPHASE; ++p) { a.ph_lo = p; a.ph_hi = p + 1; hipLaunchKernelGGL(mk_fwd, dim3(grid), dim3(NTHREADS), LDS_BYTES, stream, a); }
#endif
}
```

```cpp
#include <hip/hip_runtime.h>
#include <hip/hip_cooperative_groups.h>
#include <hip/hip_bf16.h>
#include <cstdio>
#include <cstdint>
namespace cg = cooperative_groups;

constexpr int BATCH = 4, SEQ = 2048, DM = 2048, MTOK = BATCH * SEQ;
constexpr int NIN = 5152, NINP = 5376;
constexpr float EPS = 1e-6f;
constexpr int A_Q = 0, A_K = 1024, A_V = 1280, A_GA = 1536, A_XS = 2560, A_BS = 3584, A_CS = 3840, A_DT = 4096, A_Z = 4128;
constexpr int C_Q = 0, C_K = 512, C_V = 1024, C_SM = 2048, C_Z = 2080, C_XL = 3104, C_GL = 4128;
namespace pg8 {
#define PG8_LAS __attribute__((address_space(3)))
typedef unsigned short bf16_t;
typedef short bf16x8 __attribute__((ext_vector_type(8)));
typedef float f32x4 __attribute__((ext_vector_type(4)));
typedef unsigned u32x4 __attribute__((ext_vector_type(4)));
constexpr int BM = 256, BK = 64, HALF = 128, HTB = HALF * BK * 2  , STAGE_BYTES = 8 * HTB, NXCD = 8, WGM = 8;

__host__ __device__ __forceinline__ int lds_byte(int r, int c) { const int st = (r >> 4) * 2 + (c >> 5), rr = r & 15, cc = c & 31, ob = rr * 64 + cc * 2; return st * 1024 + (ob ^ (((ob >> 9) & 1) << 5)); }
__host__ __device__ __forceinline__ void stage_rc(int b, int& R, int& C) { const int st = b / 1024, sb = b % 1024, swz = sb ^ (((sb >> 9) & 1) << 5); R = (st >> 1) * 16 + swz / 64; C = (st & 1) * 32 + (swz % 64) / 2; }
__host__ __device__ __forceinline__ int perm32(int rho) { const int n = rho >> 4, i = rho & 15; return 8 * (i >> 2) + 4 * n + (i & 3); }

struct Unit { int pm, pn; };
struct Gemm { const bf16_t* A; const bf16_t* Bt; int M, N, K; };

struct StaticOrder {
    int nM, nN, nwg, G, c;
    __host__ __device__ void init(int M, int N, int G_, int c_) { nM = M / BM; nN = N / BM; nwg = nM * nN; G = G_; c = c_; }
    __host__ __device__ bool next(int i, Unit& u) const {
        const long L = (long)i * G + c; if (L >= nwg) return false;
        int wgid = (int)L; { const int q = nwg / NXCD, r = nwg % NXCD, xcd = wgid % NXCD, off = wgid / NXCD; wgid = (xcd < r ? xcd * (q + 1) : r * (q + 1) + (xcd - r) * q) + off; }
        const int nig = WGM * nN, gid = wgid / nig, fm = gid * WGM, gsz = (nM - fm) < WGM ? (nM - fm) : WGM;
        u.pm = fm + ((wgid % nig) % gsz); u.pn = (wgid % nig) / gsz; return true;
    }
    __device__ __forceinline__ void a_ready(const Unit&) const {}
    __device__ __forceinline__ void done(const Unit&) const {}
};

__device__ __forceinline__ unsigned cvt_pk_bf16(float lo, float hi) { unsigned r; asm volatile("v_cvt_pk_bf16_f32 %0, %1, %2" : "=v"(r) : "v"(lo), "v"(hi)); return r; }
typedef float f32x2 __attribute__((ext_vector_type(2)));
struct EpiProj {
    static constexpr bool PERM = true, AFTER_DRAIN = false;
    bf16_t* O; float* small; int ldc; int small_tile;
    __device__ __forceinline__ void operator()(const f32x4 (&acc)[2][2][4][2], const Unit& u, int wr, int wc, int fr, int fq) const {
        const int row0 = u.pm * BM + wr * 64 + fr; const int col0 = u.pn * BM + wc * 32 + 8 * fq;
        const bool sm = (u.pn == small_tile) && (wc == 0);
#pragma unroll
        for (int ai = 0; ai < 2; ++ai)
#pragma unroll
            for (int m = 0; m < 4; ++m) { const int row = row0 + ai * HALF + m * 16; bf16_t* rowp = O + (size_t)row * ldc + col0;
#pragma unroll
                for (int bj = 0; bj < 2; ++bj) { const f32x4 v0 = acc[ai][bj][m][0], v1 = acc[ai][bj][m][1];
                    u32x4 w; w.x = cvt_pk_bf16(v0[0], v0[1]); w.y = cvt_pk_bf16(v0[2], v0[3]); w.z = cvt_pk_bf16(v1[0], v1[1]); w.w = cvt_pk_bf16(v1[2], v1[3]);
                    *(u32x4*)(rowp + bj * HALF) = w; }
                if (sm) { float* sp = small + (size_t)row * 32 + 8 * fq; *(f32x4*)sp = acc[ai][0][m][0]; *(f32x4*)(sp + 4) = acc[ai][0][m][1]; } }
    }
};
struct EpiResid {
    static constexpr bool PERM = false, AFTER_DRAIN = false;
    const float* xin; float* xout; const float* gacc; const float* gbias;
    __device__ __forceinline__ void operator()(const f32x4 (&acc)[2][2][4][2], const Unit& u, int wr, int wc, int fr, int fq) const {
        const int b = u.pm >> 3;
        const int col0 = u.pn * BM + wc * 32 + 4 * fq;
#pragma unroll
        for (int bj = 0; bj < 2; ++bj)
#pragma unroll
            for (int n = 0; n < 2; ++n) { const int col = col0 + bj * HALF + n * 16;
                const f32x4 g = *(const f32x4*)(gacc + (size_t)b * 6144 + 4096 + col) + *(const f32x4*)(gbias + 4096 + col);
#pragma unroll
                for (int ai = 0; ai < 2; ++ai)
#pragma unroll
                    for (int m = 0; m < 4; ++m) { const size_t off = (size_t)(u.pm * BM + ai * HALF + wr * 64 + m * 16 + fr) * 2048 + col;
                        const f32x4 xv = *(const f32x4*)(xin + off); *(f32x4*)(xout + off) = xv + g * acc[ai][bj][m][n]; } }
    }
};
template <class Epi, class Sched, bool ALIGN_EPI = false, bool SP2 = false>
__device__ __forceinline__ void gemm_phase(PG8_LAS unsigned char* lds, const Gemm g, const Sched& S, const Epi& E) {
    const int tid = threadIdx.x, wid = __builtin_amdgcn_readfirstlane(tid >> 6), lane = tid & 63, wr = wid >> 2, wc = wid & 3, fr = lane & 15, fq = lane >> 4;
    const int K = g.K, nt = K / BK;
    unsigned voffA[2], voffB[2];
#pragma unroll
    for (int i = 0; i < 2; ++i) { int R, C; stage_rc(tid * 16 + i * 8192, R, C); const int Rb = Epi::PERM ? ((R & ~31) + perm32(R & 31)) : R;
        voffA[i] = (unsigned)(R * K + C) * 2u; voffB[i] = (unsigned)(Rb * K + C) * 2u; }
    const size_t kstep = (size_t)(BK * 2);
    const size_t hstep = (size_t)HALF * K * 2;
    const size_t tstep = 2 * hstep;
    const unsigned ldsw = (unsigned)wid * 1024u;
    const int aoff = lds_byte(wr * 64 + fr, fq * 8), boff = lds_byte(wc * 32 + fr, fq * 8);
#define PG8_SA(b, h) (((b) * 2 + (h)) * HTB)
#define PG8_SB(b, h) ((4 + (b) * 2 + (h)) * HTB)
#define PG8_STAGE(bufoff, gbase, voff) do { _Pragma("unroll") for (int _i = 0; _i < 2; ++_i) \
        __builtin_amdgcn_global_load_lds((const unsigned*)((const char*)(gbase) + (voff)[_i]), (PG8_LAS unsigned*)(lds + (bufoff) + ldsw + _i * 8192), 16, 0, 0); } while (0)
#define PG8_LDA(dst, b, h) do { _Pragma("unroll") for (int m = 0; m < 4; ++m) _Pragma("unroll") for (int k = 0; k < 2; ++k) dst[m][k] = *(const PG8_LAS bf16x8*)(lds + PG8_SA(b, h) + aoff + m * 2048 + k * 1024); } while (0)
#define PG8_LDB(dst, b, h) do { _Pragma("unroll") for (int n = 0; n < 2; ++n) _Pragma("unroll") for (int k = 0; k < 2; ++k) dst[n][k] = *(const PG8_LAS bf16x8*)(lds + PG8_SB(b, h) + boff + n * 2048 + k * 1024); } while (0)
#define PG8_MMA(ai, bj, At, Bt) do { __builtin_amdgcn_s_setprio(1); _Pragma("unroll") for (int m = 0; m < 4; ++m) _Pragma("unroll") for (int n = 0; n < 2; ++n) _Pragma("unroll") for (int k = 0; k < 2; ++k) \
        acc[ai][bj][m][n] = __builtin_amdgcn_mfma_f32_16x16x32_bf16(Bt[n][k], At[m][k], acc[ai][bj][m][n], 0, 0, 0); __builtin_amdgcn_s_setprio(0); } while (0)
#define PG8_WAIT_V(n) asm volatile("s_waitcnt vmcnt(" #n ")" ::: "memory")
#define PG8_WAIT_L(n) asm volatile("s_waitcnt lgkmcnt(" #n ")" ::: "memory")
#define PG8_BAR __builtin_amdgcn_s_barrier()
#define PG8_SCHED __builtin_amdgcn_sched_barrier(0)
    Unit cur, nxt; int ui = 0;
    if (!S.next(0, cur)) return;
    f32x4 acc[2][2][4][2];
#pragma unroll
    for (int a = 0; a < 2; ++a)
#pragma unroll
        for (int b = 0; b < 2; ++b)
#pragma unroll
            for (int m = 0; m < 4; ++m)
#pragma unroll
                for (int n = 0; n < 2; ++n) acc[a][b][m][n] = (f32x4){0.f, 0.f, 0.f, 0.f};
    bf16x8 At[4][2], B0[2][2], B1[2][2];
    const char* cA = (const char*)g.A + (size_t)cur.pm * tstep; const char* cB = (const char*)g.Bt + (size_t)cur.pn * tstep;
    S.a_ready(cur);
    if constexpr (SP2) {
        PG8_STAGE(PG8_SB(0, 0), cB, voffB); PG8_STAGE(PG8_SB(0, 1), cB + hstep, voffB); PG8_STAGE(PG8_SA(0, 0), cA, voffA); PG8_STAGE(PG8_SA(0, 1), cA + hstep, voffA);
        if (wr == 1) PG8_BAR;
        PG8_WAIT_V(2); PG8_BAR;
        PG8_STAGE(PG8_SB(1, 0), cB + kstep, voffB); PG8_STAGE(PG8_SA(1, 0), cA + kstep, voffA); PG8_STAGE(PG8_SB(1, 1), cB + hstep + kstep, voffB);
        PG8_WAIT_V(6); PG8_BAR;
    } else {
        PG8_STAGE(PG8_SB(0, 0), cB, voffB); PG8_STAGE(PG8_SA(0, 0), cA, voffA); PG8_STAGE(PG8_SB(0, 1), cB + hstep, voffB); PG8_STAGE(PG8_SA(0, 1), cA + hstep, voffA);
        if (wr == 1) PG8_BAR;
        PG8_WAIT_V(4); PG8_BAR;
        PG8_STAGE(PG8_SB(1, 0), cB + kstep, voffB); PG8_STAGE(PG8_SA(1, 0), cA + kstep, voffA); PG8_STAGE(PG8_SB(1, 1), cB + hstep + kstep, voffB);
        PG8_WAIT_V(6); PG8_BAR;
    }
    for (;;) {
        const bool has_next = S.next(ui + 1, nxt);
        const char* nA = has_next ? (const char*)g.A + (size_t)nxt.pm * tstep : cA; const char* nB = has_next ? (const char*)g.Bt + (size_t)nxt.pn * tstep : cB;
        for (int t = 0; t < nt; t += 2) {
            const bool last = (t == nt - 2);
            const char* a1 = cA + (size_t)(t + 1) * kstep;
            const char* a2 = last ? nA : cA + (size_t)(t + 2) * kstep; const char* b2 = last ? nB : cB + (size_t)(t + 2) * kstep;
            const char* a3 = a2 + kstep; const char* b3 = b2 + kstep;
            if (last && has_next) S.a_ready(nxt);
            if constexpr (SP2) {
            PG8_LDB(B0, 0, 0); PG8_LDB(B1, 0, 1); PG8_SCHED; PG8_LDA(At, 0, 0); PG8_STAGE(PG8_SA(1, 1), a1 + hstep, voffA);
            PG8_WAIT_V(8); PG8_WAIT_L(0); PG8_BAR; PG8_MMA(0, 0, At, B0); PG8_MMA(0, 1, At, B1); PG8_BAR; PG8_SCHED;
            PG8_LDA(At, 0, 1); PG8_STAGE(PG8_SB(0, 0), b2, voffB); PG8_STAGE(PG8_SB(0, 1), b2 + hstep, voffB); PG8_STAGE(PG8_SA(0, 0), a2, voffA);
            PG8_WAIT_V(8); PG8_WAIT_L(0); PG8_BAR; PG8_MMA(1, 0, At, B0); PG8_MMA(1, 1, At, B1); PG8_BAR; PG8_SCHED;
            PG8_LDB(B0, 1, 0); PG8_LDB(B1, 1, 1); PG8_SCHED; PG8_LDA(At, 1, 0); PG8_STAGE(PG8_SA(0, 1), a2 + hstep, voffA);
            PG8_WAIT_V(8); PG8_WAIT_L(0); PG8_BAR; PG8_MMA(0, 0, At, B0); PG8_MMA(0, 1, At, B1); PG8_BAR; PG8_SCHED;
            PG8_LDA(At, 1, 1); PG8_STAGE(PG8_SB(1, 0), b3, voffB); PG8_STAGE(PG8_SB(1, 1), b3 + hstep, voffB); PG8_STAGE(PG8_SA(1, 0), a3, voffA);
            PG8_WAIT_V(8); PG8_WAIT_L(0); PG8_BAR; PG8_MMA(1, 0, At, B0); PG8_MMA(1, 1, At, B1); PG8_BAR; PG8_SCHED;
            } else {
            PG8_LDB(B0, 0, 0); PG8_SCHED; PG8_LDA(At, 0, 0); PG8_STAGE(PG8_SA(1, 1), a1 + hstep, voffA);
            PG8_WAIT_L(8); PG8_BAR; PG8_WAIT_L(0); PG8_MMA(0, 0, At, B0); PG8_BAR; PG8_SCHED;
            PG8_LDB(B1, 0, 1); PG8_STAGE(PG8_SB(0, 0), b2, voffB);
            PG8_BAR; PG8_WAIT_L(0); PG8_MMA(0, 1, At, B1); PG8_BAR;
            PG8_LDA(At, 0, 1); PG8_STAGE(PG8_SA(0, 0), a2, voffA);
            PG8_BAR; PG8_WAIT_L(0); PG8_MMA(1, 0, At, B0); PG8_BAR; PG8_SCHED;
            PG8_STAGE(PG8_SB(0, 1), b2 + hstep, voffB);
            PG8_WAIT_V(6); PG8_BAR; PG8_MMA(1, 1, At, B1); PG8_BAR;
            PG8_LDB(B0, 1, 0); PG8_SCHED; PG8_LDA(At, 1, 0); PG8_STAGE(PG8_SA(0, 1), a2 + hstep, voffA);
            PG8_WAIT_L(8); PG8_BAR; PG8_WAIT_L(0); PG8_MMA(0, 0, At, B0); PG8_BAR; PG8_SCHED;
            PG8_LDB(B1, 1, 1); PG8_STAGE(PG8_SB(1, 0), b3, voffB);
            PG8_BAR; PG8_WAIT_L(0); PG8_MMA(0, 1, At, B1); PG8_BAR;
            PG8_LDA(At, 1, 1); PG8_STAGE(PG8_SA(1, 0), a3, voffA);
            PG8_BAR; PG8_WAIT_L(0); PG8_MMA(1, 0, At, B0); PG8_BAR; PG8_SCHED;
            PG8_STAGE(PG8_SB(1, 1), b3 + hstep, voffB);
            PG8_WAIT_V(6); PG8_BAR; PG8_MMA(1, 1, At, B1); PG8_BAR;
            }
        }
        if constexpr (ALIGN_EPI) { if (wr == 0) PG8_BAR; }
        if constexpr (!Epi::AFTER_DRAIN) { E(acc, cur, wr, wc, fr, fq); S.done(cur); }
        if (!has_next) break;
#pragma unroll
        for (int a = 0; a < 2; ++a)
#pragma unroll
            for (int b = 0; b < 2; ++b)
#pragma unroll
                for (int m = 0; m < 4; ++m)
#pragma unroll
                    for (int n = 0; n < 2; ++n) acc[a][b][m][n] = (f32x4){0.f, 0.f, 0.f, 0.f};
        cur = nxt; cA = nA; cB = nB; ++ui;
        if constexpr (ALIGN_EPI) { if (wr == 1) PG8_BAR; }
    }
    PG8_WAIT_V(0);
    if constexpr (!ALIGN_EPI) { if (wr == 0) PG8_BAR; }
    PG8_BAR;
    if constexpr (Epi::AFTER_DRAIN) { E.fused(acc, cur, wr, wc, fr, fq, lds, wid, lane); S.done(cur); }
#undef PG8_SA
#undef PG8_SB
#undef PG8_STAGE
#undef PG8_LDA
#undef PG8_LDB
#undef PG8_MMA
#undef PG8_WAIT_V
#undef PG8_WAIT_L
#undef PG8_BAR
#undef PG8_SCHED
}
}
namespace att {
using bf16 = __hip_bfloat16;
constexpr int   D = 128, NW = 8, QBLK = 32, KVBLK = 64;
constexpr float SCALE = 0.088388347648318440f;
constexpr float THR = 8.f;
constexpr int SDEPTH = 2;
constexpr int LDQ = 1024, LDK = 256, LDY = 2048, LDG = NINP;
constexpr size_t SHM_V = KVBLK * D * 2, SHM_K = KVBLK * D * 2, SHM_ATTN = 2 * SHM_V + 2 * SHM_K + NW * 64 * 4;
using bf16x8 = __attribute__((ext_vector_type(8))) short;
using s16x4  = __attribute__((ext_vector_type(4))) short;
using f32x16 = __attribute__((ext_vector_type(16))) float;
using f32x8  = __attribute__((ext_vector_type(8))) float;
using u32x4  = __attribute__((ext_vector_type(4))) unsigned;
#define KSWZ(row, colB) ((row) * 256 + ((colB) ^ (((row) & 7) << 4)))
#define SBAR() __builtin_amdgcn_sched_barrier(0)
__device__ __forceinline__ int crow(int r, int hi) { return (r & 3) + 8 * (r >> 2) + 4 * hi; }
__device__ __forceinline__ unsigned cvtpk(float lo, float hi) {
  unsigned r; asm volatile("v_cvt_pk_bf16_f32 %0, %1, %2" : "=v"(r) : "v"(lo), "v"(hi)); return r;
}
template <typename TIn> struct Stage;
template <> struct Stage<bf16>  { using T = bf16x8;
  __device__ static __forceinline__ T ld8(const bf16* p) { return *reinterpret_cast<const bf16x8*>(p); }
  __device__ static __forceinline__ bf16x8 tobf(T x) { return x; } };
template <> struct Stage<float> { using T = f32x8;
  __device__ static __forceinline__ T ld8(const float* p) { return *reinterpret_cast<const f32x8*>(p); }
  __device__ static __forceinline__ bf16x8 tobf(T x) {
    u32x4 w = {cvtpk(x[0], x[1]), cvtpk(x[2], x[3]), cvtpk(x[4], x[5]), cvtpk(x[6], x[7])}; return *reinterpret_cast<bf16x8*>(&w); } };

__device__ __forceinline__ void partialSM(f32x16& p0, f32x16& p1, float& m_reg, float& mn, float& alpha) {
  constexpr float C = SCALE * 1.4426950408889634f;
  float pmax = p0[0]; for (int r = 1; r < 16; ++r) pmax = fmaxf(pmax, p0[r]); for (int r = 0; r < 16; ++r) pmax = fmaxf(pmax, p1[r]);
  { auto rr = __builtin_amdgcn_permlane32_swap(__float_as_uint(pmax), __float_as_uint(pmax), false, false);
    pmax = fmaxf(__uint_as_float(rr[0]), __uint_as_float(rr[1])); }
  if (__builtin_expect(__all(pmax - m_reg <= THR / SCALE), 1)) { mn = m_reg; alpha = 1.f; }
  else { mn = fmaxf(m_reg, pmax); alpha = __builtin_amdgcn_exp2f((m_reg - mn) * C); m_reg = mn; }
  float mnC = -mn * C;
  for (int r = 0; r < 16; ++r) p0[r] = fmaf(p0[r], C, mnC); for (int r = 0; r < 16; ++r) p1[r] = fmaf(p1[r], C, mnC);
  for (int r = 0; r < 16; ++r) p0[r] = __builtin_amdgcn_exp2f(p0[r]);
}
__device__ __forceinline__ void finishSM(f32x16& p0, f32x16& p1, float alpha, float& l_reg, bf16x8& pa0, bf16x8& pa1, bf16x8& pa2, bf16x8& pa3) {
  for (int r = 0; r < 16; ++r) p1[r] = __builtin_amdgcn_exp2f(p1[r]);
  float ps = 0; for (int r = 0; r < 16; ++r) ps += p0[r]; for (int r = 0; r < 16; ++r) ps += p1[r];
  { auto rr = __builtin_amdgcn_permlane32_swap(__float_as_uint(ps), __float_as_uint(ps), false, false);
    ps = __uint_as_float(rr[0]) + __uint_as_float(rr[1]); }
  l_reg = l_reg * alpha + ps;
#define PK4(P, BASE, OUT) do { unsigned a0 = cvtpk(P[BASE + 0], P[BASE + 1]), a1 = cvtpk(P[BASE + 2], P[BASE + 3]);   \
    unsigned b0 = cvtpk(P[BASE + 4], P[BASE + 5]), b1 = cvtpk(P[BASE + 6], P[BASE + 7]);                              \
    auto r0 = __builtin_amdgcn_permlane32_swap(a0, b0, false, false); auto r1 = __builtin_amdgcn_permlane32_swap(a1, b1, false, false); \
    u32x4 w = {r0[0], r1[0], r0[1], r1[1]}; OUT = *reinterpret_cast<bf16x8*>(&w); } while (0)
  PK4(p0, 0, pa0); PK4(p0, 8, pa1); PK4(p1, 0, pa2); PK4(p1, 8, pa3);
#undef PK4
}
__device__ __forceinline__ void qkt(f32x16& p0, f32x16& p1, const bf16* Ks, const bf16x8* qr, int r32, int hi) {
  p0 = f32x16{}; p1 = f32x16{};
  for (int d0 = 0; d0 < 8; ++d0) { int cb = (d0 * 16 + hi * 8) * 2;
    bf16x8 b0 = *reinterpret_cast<const bf16x8*>((const char*)Ks + KSWZ(r32, cb));
    bf16x8 b1 = *reinterpret_cast<const bf16x8*>((const char*)Ks + KSWZ(32 + r32, cb));
    p0 = __builtin_amdgcn_mfma_f32_32x32x16_bf16(b0, qr[d0], p0, 0, 0, 0);
    p1 = __builtin_amdgcn_mfma_f32_32x32x16_bf16(b1, qr[d0], p1, 0, 0, 0); }
}
__device__ __forceinline__ int v_st(int k, int c) { const int kk = (k & ~0xC) | ((k & 4) << 1) | ((k & 8) >> 1); return ((kk >> 3) * 4 + (c >> 5)) * 512 + ((kk & 7) * 32 + (c & 31)) * 2; }
__device__ __forceinline__ int v_rd_base(int lane) { return ((lane & 3) << 3) | (((lane >> 2) & 3) << 6) | (((lane >> 4) & 1) << 5) | (((lane >> 5) & 1) << 8); }
constexpr int v_rd_off(int d0, int ks, int half) { return d0 * 512 + ks * 4096 + half * 2048; }
template <int OFF> __device__ __forceinline__ s16x4 tr_read(int vb) {
  s16x4 r; asm volatile("ds_read_b64_tr_b16 %0, %1 offset:%2" : "=&v"(r) : "v"(vb), "i"(OFF) : "memory"); return r;
}
template <int D0> __device__ __forceinline__ void pv_one(f32x16& od, int vb, bf16x8 pa0, bf16x8 pa1, bf16x8 pa2, bf16x8 pa3) {
  const s16x4 l0 = tr_read<v_rd_off(D0, 0, 0)>(vb), h0 = tr_read<v_rd_off(D0, 0, 1)>(vb), l1 = tr_read<v_rd_off(D0, 1, 0)>(vb), h1 = tr_read<v_rd_off(D0, 1, 1)>(vb);
  const s16x4 l2 = tr_read<v_rd_off(D0, 2, 0)>(vb), h2 = tr_read<v_rd_off(D0, 2, 1)>(vb), l3 = tr_read<v_rd_off(D0, 3, 0)>(vb), h3 = tr_read<v_rd_off(D0, 3, 1)>(vb);
  asm volatile("s_waitcnt lgkmcnt(0)" ::: "memory"); SBAR();
#define PK(L, H) (bf16x8){L[0], L[1], L[2], L[3], H[0], H[1], H[2], H[3]}
  od = __builtin_amdgcn_mfma_f32_32x32x16_bf16(pa0, PK(l0, h0), od, 0, 0, 0);
  od = __builtin_amdgcn_mfma_f32_32x32x16_bf16(pa1, PK(l1, h1), od, 0, 0, 0);
  od = __builtin_amdgcn_mfma_f32_32x32x16_bf16(pa2, PK(l2, h2), od, 0, 0, 0);
  od = __builtin_amdgcn_mfma_f32_32x32x16_bf16(pa3, PK(l3, h3), od, 0, 0, 0);
#undef PK
}
__device__ __forceinline__ void pv_d0(f32x16* o, int vb, bf16x8 pa0, bf16x8 pa1, bf16x8 pa2, bf16x8 pa3) {
  pv_one<0>(o[0], vb, pa0, pa1, pa2, pa3); pv_one<1>(o[1], vb, pa0, pa1, pa2, pa3); pv_one<2>(o[2], vb, pa0, pa1, pa2, pa3); pv_one<3>(o[3], vb, pa0, pa1, pa2, pa3);
}
__device__ __forceinline__ void attn_dense_body(const bf16* __restrict__ Qb, const bf16* __restrict__ Kh, const bf16* __restrict__ Vh,
                                                unsigned short* __restrict__ Yb, const unsigned short* __restrict__ Gb, int seq, char* lds) {
  using St = Stage<bf16>; using SQ = Stage<bf16>; using TQ = bf16;
  const int tid = threadIdx.x, wid = tid >> 6, lane = tid & 63, r32 = lane & 31, hi = lane >> 5;
  bf16* V_lds = (bf16*)lds; bf16* K_lds = (bf16*)(lds + 2 * SHM_V);
  float* ws = (float*)(lds + 2 * SHM_V + 2 * SHM_K) + wid * 64; float* li_l = ws; float* al_l = ws + 32;
  float m_reg = -1e30f, l_reg = 0; f32x16 o[4] = {}; bf16x8 qr[8];
  const TQ* Qw = Qb + (long)(wid * QBLK + r32) * LDQ + hi * 8;
#pragma unroll
  for (int d0 = 0; d0 < 8; ++d0) qr[d0] = SQ::tobf(SQ::ld8(Qw + d0 * 16));
  const int sr = tid >> 4, sc = (tid & 15) * 8, vst0 = v_st(sr, sc), vst1 = v_st(32 + sr, sc);
  const int vb0 = (int)(uintptr_t)V_lds + v_rd_base(lane);
  struct { typename St::T vs0, vs1, ks0, ks1; } sr_[SDEPTH];
#define SLOAD(i, k0) do { sr_[i].vs0 = St::ld8(&Vh[(long)((k0) + sr) * LDK + sc]); sr_[i].vs1 = St::ld8(&Vh[(long)((k0) + 32 + sr) * LDK + sc]); \
    sr_[i].ks0 = St::ld8(&Kh[(long)((k0) + sr) * LDK + sc]); sr_[i].ks1 = St::ld8(&Kh[(long)((k0) + 32 + sr) * LDK + sc]); } while (0)
#define SWRITE(b, i) do { *(bf16x8*)((char*)V_lds + (b) * SHM_V + vst0) = St::tobf(sr_[i].vs0);          \
    *(bf16x8*)((char*)V_lds + (b) * SHM_V + vst1) = St::tobf(sr_[i].vs1); int kc = sc * 2;               \
    *(bf16x8*)((char*)K_lds + (b) * SHM_K + KSWZ(sr, kc)) = St::tobf(sr_[i].ks0);                       \
    *(bf16x8*)((char*)K_lds + (b) * SHM_K + KSWZ(32 + sr, kc)) = St::tobf(sr_[i].ks1); } while (0)
#define SWAIT() do { if constexpr (SDEPTH == 2) asm volatile("s_waitcnt vmcnt(4)" ::: "memory"); else asm volatile("s_waitcnt vmcnt(0)" ::: "memory"); } while (0)
#define RESC(a) do { if (__any((a) < 1.f)) { if (hi == 0) al_l[r32] = (a); asm volatile("s_waitcnt lgkmcnt(0)" ::: "memory"); \
    for (int d = 0; d < 4; ++d) for (int r = 0; r < 16; ++r) o[d][r] *= al_l[crow(r, hi)]; } } while (0)
  f32x16 pA0, pA1, pB0, pB1; float mnA, mnB, alA, alB; bf16x8 pa0, pa1, pa2, pa3; const int NT = seq / KVBLK;
  constexpr int SE = 0, SO = SDEPTH - 1;
  SLOAD(SE, 0); asm volatile("s_waitcnt vmcnt(0)" ::: "memory"); SWRITE(0, SE); __syncthreads();
  qkt(pA0, pA1, K_lds, qr, r32, hi); partialSM(pA0, pA1, m_reg, mnA, alA);
  SLOAD(SO, KVBLK); if constexpr (SDEPTH == 2) { if (2 < NT) SLOAD(SE, 2 * KVBLK); }
  SWAIT(); SWRITE(1, SO); __syncthreads();
  for (int j = 1; j + 1 < NT; j += 2) {
    SBAR(); qkt(pB0, pB1, (bf16*)((char*)K_lds + SHM_K), qr, r32, hi);
    finishSM(pA0, pA1, alA, l_reg, pa0, pa1, pa2, pa3); SBAR();
    SLOAD(SO, (j + SDEPTH) * KVBLK); SBAR();
    pv_d0(o, vb0, pa0, pa1, pa2, pa3); partialSM(pB0, pB1, m_reg, mnB, alB);
    __syncthreads(); SWAIT(); SWRITE(0, SE);
    RESC(alB); __syncthreads();
    SBAR(); qkt(pA0, pA1, K_lds, qr, r32, hi);
    finishSM(pB0, pB1, alB, l_reg, pa0, pa1, pa2, pa3); SBAR();
    if (SDEPTH == 1 || j + 3 < NT) SLOAD(SE, (j + 1 + SDEPTH) * KVBLK); SBAR();
    pv_d0(o, vb0 + (int)SHM_V, pa0, pa1, pa2, pa3); partialSM(pA0, pA1, m_reg, mnA, alA);
    __syncthreads(); SWAIT(); SWRITE(1, SO);
    RESC(alA); __syncthreads();
  }
  SBAR(); qkt(pB0, pB1, (bf16*)((char*)K_lds + SHM_K), qr, r32, hi);
  finishSM(pA0, pA1, alA, l_reg, pa0, pa1, pa2, pa3); SBAR();
  pv_d0(o, vb0, pa0, pa1, pa2, pa3); partialSM(pB0, pB1, m_reg, mnB, alB);
  __syncthreads(); RESC(alB);
  finishSM(pB0, pB1, alB, l_reg, pa0, pa1, pa2, pa3); SBAR();
  pv_d0(o, vb0 + (int)SHM_V, pa0, pa1, pa2, pa3);
  if (hi == 0) li_l[r32] = l_reg; asm volatile("s_waitcnt lgkmcnt(0)" ::: "memory");
  float rli[16];
#pragma unroll
  for (int r = 0; r < 16; ++r) rli[r] = __builtin_amdgcn_rcpf(li_l[crow(r, hi)]);
  __syncthreads();
  { int ew = wid; asm volatile("" : "+v"(ew));
    float* stg = (float*)lds + ew * (32 * 132);
#pragma unroll
    for (int r = 0; r < 16; ++r) { const int orow = crow(r, hi);
#pragma unroll
      for (int d0 = 0; d0 < 4; ++d0) stg[orow * 132 + d0 * 32 + r32] = o[d0][r] * rli[r]; }
    asm volatile("s_waitcnt lgkmcnt(0)" ::: "memory");
    int el = lane; asm volatile("" : "+v"(el));
    const unsigned short* Gw0 = Gb + (long)(ew * QBLK) * LDG; unsigned short* Yw0 = Yb + (long)(ew * QBLK) * LDY;
#pragma unroll 2
    for (int i = 0; i < 8; ++i) { const int id = el + 64 * i, row = id >> 4, c8 = id & 15;
      const float* sp = stg + row * 132 + c8 * 8;
      const u32x4 gw = *reinterpret_cast<const u32x4*>(Gw0 + (long)row * LDG + c8 * 8);
      u32x4 ow;
#pragma unroll
      for (int q = 0; q < 4; ++q) { const unsigned gq = (q == 0) ? gw.x : (q == 1) ? gw.y : (q == 2) ? gw.z : gw.w;
        const float g0 = __uint_as_float(gq << 16), g1 = __uint_as_float(gq & 0xffff0000u);
        const float v0 = sp[2 * q] * (g0 / (1.f + __expf(-g0))), v1 = sp[2 * q + 1] * (g1 / (1.f + __expf(-g1)));
        const unsigned pk = cvtpk(v0, v1);
        if (q == 0) ow.x = pk; else if (q == 1) ow.y = pk; else if (q == 2) ow.z = pk; else ow.w = pk; }
      *reinterpret_cast<u32x4*>(Yw0 + (long)row * LDY + c8 * 8) = ow; } }
#undef SLOAD
#undef SWRITE
#undef SWAIT
#undef RESC
}
}
#define GAS __attribute__((address_space(1)))
#define LAS __attribute__((address_space(3)))
typedef unsigned short bf16_t;
typedef unsigned v4u __attribute__((ext_vector_type(4)));
typedef unsigned v2u __attribute__((ext_vector_type(2)));
typedef float f32x4 __attribute__((ext_vector_type(4)));
typedef short bf16x8_t __attribute__((ext_vector_type(8)));
typedef float f32x16_t __attribute__((ext_vector_type(16)));
#define LDS_WAIT() asm volatile("s_waitcnt lgkmcnt(0)" ::: "memory")

constexpr size_t MiB = 1u << 20;
constexpr size_t WS_CTL = 0, CTL_ZERO_BYTES = 1 * MiB;
constexpr size_t WS_MOD = 64 * 1024;
constexpr size_t WS_ROPE = 1 * MiB;
constexpr size_t WS_SMALL = 2 * MiB;
constexpr size_t WS_WIN0 = 3 * MiB, WS_WOUT0 = 24 * MiB;
constexpr size_t WS_QB = 32 * MiB, WS_KB = 48 * MiB, WS_VB = 52 * MiB;
constexpr size_t WS_HB = 3 * MiB;
constexpr size_t WS_WIN1 = 56 * MiB, WS_WOUT1 = 77 * MiB;
constexpr size_t WS_H = 85 * MiB;
constexpr size_t WS_HF = 85 * MiB;
constexpr size_t WS_PROJ = 117 * MiB;
constexpr size_t WS_YCAT = 201 * MiB;
constexpr size_t WS_ACT = 233 * MiB;
constexpr size_t WS_YF = 297 * MiB, WS_YB = 329 * MiB;
constexpr size_t WS_XBC16 = 85 * MiB;
constexpr size_t WS_QKV16 = 3 * MiB;
constexpr size_t WS_XC16 = 35 * MiB;
constexpr size_t WS_GT = 85 * MiB, WS_GA = 101 * MiB;
constexpr size_t WS_WGT = 361 * MiB;
constexpr size_t WS_LSUM = 362 * MiB;
constexpr size_t WS_HF16 = 56 * MiB;
constexpr size_t WS_HB16 = 366 * MiB;
constexpr size_t WS_END = 382 * MiB;

constexpr int NWAVES = 8, NTHREADS = 512;
constexpr int LDS_BYTES = 163840;
constexpr int NPHASE = 15;

struct Args { const float* in[39]; float* out; unsigned char* ws; int ph_lo, ph_hi; };

__device__ __forceinline__ float bf2f(unsigned v) { return __uint_as_float(v << 16); }
__device__ __forceinline__ unsigned f2bf(float f) { unsigned u = __float_as_uint(f); return (u + 0x7fffu + ((u >> 16) & 1u)) >> 16; }
__device__ __forceinline__ unsigned pk2(float lo, float hi) { return f2bf(lo) | (f2bf(hi) << 16); }
__device__ __forceinline__ void unpack8(const v4u w, float* x) {
    x[0] = __uint_as_float(w.x << 16); x[1] = __uint_as_float(w.x & 0xffff0000u); x[2] = __uint_as_float(w.y << 16); x[3] = __uint_as_float(w.y & 0xffff0000u);
    x[4] = __uint_as_float(w.z << 16); x[5] = __uint_as_float(w.z & 0xffff0000u); x[6] = __uint_as_float(w.w << 16); x[7] = __uint_as_float(w.w & 0xffff0000u);
}
__device__ __forceinline__ v4u pack8(const float* x) { v4u w; w.x = pk2(x[0], x[1]); w.y = pk2(x[2], x[3]); w.z = pk2(x[4], x[5]); w.w = pk2(x[6], x[7]); return w; }
__device__ __forceinline__ float silu_f(float x) { return x / (1.f + expf(-x)); }
__device__ __forceinline__ float sigmoid_f(float x) { return 1.f / (1.f + expf(-x)); }
__device__ __forceinline__ float softplus_f(float x) { return fmaxf(x, 0.f) + log1pf(expf(-fabsf(x))); }
template <int CTRL> __device__ __forceinline__ float dpp_mov(float v) { return __builtin_bit_cast(float, __builtin_amdgcn_update_dpp(0, __builtin_bit_cast(int, v), CTRL, 0xF, 0xF, true)); }
template <int N> __device__ __forceinline__ float group_sum(float v) {
    if (N >= 2) v += dpp_mov<0xB1>(v);
    if (N >= 4) v += dpp_mov<0x4E>(v);
    if (N >= 8) v += dpp_mov<0x141>(v);
    if (N >= 16) v += dpp_mov<0x140>(v);
    if (N >= 32) v += __shfl_xor(v, 16);
    if (N >= 64) v += __shfl_xor(v, 32);
    return v;
}

__device__ __forceinline__ void p0_transpose_item(const float* W, int K, int N, bf16_t* WT, int row_off, LAS float* scr, int item, int lane) {
    const int nblk = N / 32, kb = item / nblk, nb = item % nblk, k0 = 64 * kb, n0 = 32 * nb;
#pragma unroll 8
    for (int i = 0; i < 32; ++i) { const int kk = 2 * i + (lane >> 5); scr[kk * 33 + (lane & 31)] = W[(size_t)(k0 + kk) * N + n0 + (lane & 31)]; }
    LDS_WAIT(); asm volatile("" ::: "memory");
    const int c = lane & 7;
#pragma unroll
    for (int j = 0; j < 4; ++j) { const int n = (lane >> 3) + 8 * j; const LAS float* s = scr + (8 * c) * 33 + n;
        v4u o; o.x = pk2(s[0 * 33], s[1 * 33]); o.y = pk2(s[2 * 33], s[3 * 33]); o.z = pk2(s[4 * 33], s[5 * 33]); o.w = pk2(s[6 * 33], s[7 * 33]);
        *(v4u*)(WT + (size_t)(row_off + n0 + n) * K + k0 + 8 * c) = o; }
    LDS_WAIT(); asm volatile("" ::: "memory");
}

__device__ __forceinline__ void p0_prologue(const Args& a, LAS unsigned char* lds, int vcu, int G) {
    const int tid = threadIdx.x, lane = tid & 63, wave = tid >> 6;
    unsigned char* ws = a.ws;
    { const int gid = blockIdx.x * NTHREADS + tid;
      if (gid < 2048) { const int pos = gid >> 5, i = gid & 31; const float freq = expf(-(float)i * (1.f / 32.f) * 9.210340371976184f); const float ang = (float)pos * freq;
          float* rt = (float*)(ws + WS_ROPE); rt[2 * gid] = cosf(ang); rt[2 * gid + 1] = sinf(ang); } }
    { const int gid = blockIdx.x * NTHREADS + tid, gn = G * NTHREADS; constexpr int NV = (NINP - NIN) * 2048 * 2 / 16;
      v4u* p0 = (v4u*)(ws + WS_WIN0 + (size_t)NIN * 2048 * 2); v4u* p1 = (v4u*)(ws + WS_WIN1 + (size_t)NIN * 2048 * 2);
      for (int i = gid; i < NV; i += gn) { p0[i] = (v4u){0, 0, 0, 0}; p1[i] = (v4u){0, 0, 0, 0}; } }
    if (blockIdx.x < 192) {
        const int it = blockIdx.x, l = it / 96, r = it % 96, kc = r / 3, nc = r % 3;
        LAS float* cond = (LAS float*)lds;
        if (tid < 256) { const int b = tid >> 6, k = tid & 63; const float c = a.in[1][b * 2048 + kc * 64 + k]; cond[tid] = silu_f(c); }
        __syncthreads();
        const float* W = a.in[2] + (size_t)l * 2048 * 6144 + (size_t)(kc * 64) * 6144 + nc * 2048 + tid * 4;
        f32x4 acc0 = {0, 0, 0, 0}, acc1 = acc0, acc2 = acc0, acc3 = acc0;
#pragma unroll 8
        for (int k = 0; k < 64; ++k) { const f32x4 w = *(const f32x4*)(W + (size_t)k * 6144);
            acc0 += cond[k] * w; acc1 += cond[64 + k] * w; acc2 += cond[128 + k] * w; acc3 += cond[192 + k] * w; }
        float* macc = (float*)(ws + WS_MOD) + (size_t)l * 4 * 6144 + nc * 2048 + tid * 4;
#pragma unroll
        for (int i = 0; i < 4; ++i) { atomicAdd(macc + i, acc0[i]); atomicAdd(macc + 6144 + i, acc1[i]); atomicAdd(macc + 2 * 6144 + i, acc2[i]); atomicAdd(macc + 3 * 6144 + i, acc3[i]); }
        __syncthreads();
    }
    { LAS float* scr = (LAS float*)(lds + wave * 16384);
      const int gw = vcu * NWAVES + wave, NGW = G * NWAVES;
      constexpr int I_IN = 32 * (NIN / 32), I_OUT = 32 * 64, NITEMS = I_IN + I_OUT;
      for (int it = gw; it < NITEMS; it += NGW) {
          int r = it;
          if (r < I_IN) { p0_transpose_item(a.in[5], 2048, NIN, (bf16_t*)(ws + WS_WIN0), 0, scr, r, lane); continue; } r -= I_IN;
          p0_transpose_item(a.in[16], 2048, 2048, (bf16_t*)(ws + WS_WOUT0), 0, scr, r, lane);
      } }
}
__device__ __forceinline__ void late_transposes(const Args& a, LAS float* scr, int hw, int NHW, int lane) {
    unsigned char* ws = a.ws;
    constexpr int I_IN = 32 * (NIN / 32), I_OUT = 32 * 64, I_G = 32 * 8, NITEMS = I_IN + I_OUT + I_G;
    for (int it = hw; it < NITEMS; it += NHW) {
        int r = it;
        if (r < I_G) { const int mn = r >> 3, m = mn >> 3; const float* Wg = a.in[m == 0 ? 27 : m == 1 ? 29 : m == 2 ? 32 : 34] + (size_t)(mn & 7) * 128 * 128;
            p0_transpose_item(Wg, 128, 128, (bf16_t*)(ws + WS_WGT) + (size_t)mn * 128 * 128, 0, scr, r & 7, lane); continue; } r -= I_G;
        if (r < I_IN) { p0_transpose_item(a.in[17], 2048, NIN, (bf16_t*)(ws + WS_WIN1), 0, scr, r, lane); continue; } r -= I_IN;
        p0_transpose_item(a.in[37], 2048, 2048, (bf16_t*)(ws + WS_WOUT1), 0, scr, r, lane);
    }
}

__device__ __forceinline__ void normmod_phase(const Args& a, const float* xin, int layer, int gw, int NGW, int lane) {
    const float* nw = a.in[4] + layer * 2048; const float* bm = a.in[3] + layer * 6144;
    const float* macc = (const float*)(a.ws + WS_MOD) + (size_t)layer * 4 * 6144;
    bf16_t* H = (bf16_t*)(a.ws + WS_H);
    for (int m = gw; m < MTOK; m += NGW) {
        const int b = m >> 11;
        const f32x4* xr = (const f32x4*)(xin + (size_t)m * 2048) + lane;
        f32x4 v[8]; float s = 0.f;
#pragma unroll
        for (int j = 0; j < 8; ++j) { v[j] = xr[64 * j]; s += (v[j].x * v[j].x + v[j].y * v[j].y) + (v[j].z * v[j].z + v[j].w * v[j].w); }
        const float rstd = rsqrtf(group_sum<64>(s) * (1.f / 2048.f) + EPS);
#pragma unroll
        for (int j = 0; j < 8; ++j) { const int col = (64 * j + lane) * 4;
            const f32x4 w = *(const f32x4*)(nw + col);
            const f32x4 sh = *(const f32x4*)(macc + b * 6144 + col) + *(const f32x4*)(bm + col);
            const f32x4 sc = *(const f32x4*)(macc + b * 6144 + 2048 + col) + *(const f32x4*)(bm + 2048 + col);
            const f32x4 o = v[j] * rstd * w * (1.f + sc) + sh;
            v2u pk; pk.x = pk2(o.x, o.y); pk.y = pk2(o.z, o.w);
            *(v2u*)(H + (size_t)m * 2048 + col) = pk; }
    }
}

__device__ __forceinline__ void post0_phase(const Args& a, int gw, int NGW, int lane) {
    const bf16_t* P = (const bf16_t*)(a.ws + WS_PROJ);
    const float2* rope = (const float2*)(a.ws + WS_ROPE);
    const float* qn = a.in[6]; const float* kn = a.in[7]; const float* cw = a.in[8]; const float* cb = a.in[9];
    bf16_t* Q = (bf16_t*)(a.ws + WS_QB); bf16_t* K = (bf16_t*)(a.ws + WS_KB); bf16_t* V = (bf16_t*)(a.ws + WS_VB);
    float* ACT = (float*)(a.ws + WS_ACT);
    for (int m = gw; m < MTOK; m += NGW) {
        const int t = m & 2047, prow = t >> 6, pcol = t & 63;
        const bf16_t* pr = P + (size_t)m * NINP;
        {
            float x[16]; unpack8(*(const v4u*)(pr + A_Q + lane * 16), x); unpack8(*(const v4u*)(pr + A_Q + lane * 16 + 8), x + 8);
            float ss = 0.f;
#pragma unroll
            for (int i = 0; i < 16; ++i) ss += x[i] * x[i];
            ss = group_sum<8>(ss);
            const float r = rsqrtf(ss * (1.f / 128.f) + EPS);
            const int d0 = (lane & 7) * 16;
#pragma unroll
            for (int i = 0; i < 16; ++i) x[i] = x[i] * r * qn[d0 + i];
#pragma unroll
            for (int pi = 0; pi < 8; ++pi) { const int p = (d0 >> 1) + pi; const float2 cs = (p < 32) ? rope[prow * 32 + p] : rope[pcol * 32 + p - 32];
                const float x0 = x[2 * pi], x1 = x[2 * pi + 1]; x[2 * pi] = x0 * cs.x - x1 * cs.y; x[2 * pi + 1] = x0 * cs.y + x1 * cs.x; }
            *(v4u*)(Q + (size_t)m * 1024 + lane * 16) = pack8(x); *(v4u*)(Q + (size_t)m * 1024 + lane * 16 + 8) = pack8(x + 8);
        }
        {
            const v2u w = *(const v2u*)(pr + A_K + lane * 4);
            float x[4] = {__uint_as_float(w.x << 16), __uint_as_float(w.x & 0xffff0000u), __uint_as_float(w.y << 16), __uint_as_float(w.y & 0xffff0000u)};
            float ss = (x[0] * x[0] + x[1] * x[1]) + (x[2] * x[2] + x[3] * x[3]);
            ss = group_sum<32>(ss);
            const float r = rsqrtf(ss * (1.f / 128.f) + EPS);
            const int d0 = (lane & 31) * 4;
#pragma unroll
            for (int i = 0; i < 4; ++i) x[i] = x[i] * r * kn[d0 + i];
#pragma unroll
            for (int pi = 0; pi < 2; ++pi) { const int p = (d0 >> 1) + pi; const float2 cs = (p < 32) ? rope[prow * 32 + p] : rope[pcol * 32 + p - 32];
                const float x0 = x[2 * pi], x1 = x[2 * pi + 1]; x[2 * pi] = x0 * cs.x - x1 * cs.y; x[2 * pi + 1] = x0 * cs.y + x1 * cs.x; }
            v2u o; o.x = pk2(x[0], x[1]); o.y = pk2(x[2], x[3]);
            *(v2u*)(K + (size_t)m * 256 + lane * 4) = o;
            *(v2u*)(V + (size_t)m * 256 + lane * 4) = *(const v2u*)(pr + A_V + lane * 4);
        }
#pragma unroll
        for (int j = 0; j < 3; ++j) { const int ch = (j * 64 + lane) * 8;
            float acc[8];
            { const f32x4 b0 = *(const f32x4*)(cb + ch), b1 = *(const f32x4*)(cb + ch + 4); acc[0] = b0.x; acc[1] = b0.y; acc[2] = b0.z; acc[3] = b0.w; acc[4] = b1.x; acc[5] = b1.y; acc[6] = b1.z; acc[7] = b1.w; }
#pragma unroll
            for (int d = 0; d < 4; ++d) { const int ts = t + d - 2;
                if (ts >= 0 && ts < SEQ) { float x[8]; unpack8(*(const v4u*)(P + (size_t)(m + d - 2) * NINP + A_XS + ch), x);
                    const f32x4 w0 = *(const f32x4*)(cw + d * 1536 + ch), w1 = *(const f32x4*)(cw + d * 1536 + ch + 4);
                    acc[0] += w0.x * x[0]; acc[1] += w0.y * x[1]; acc[2] += w0.z * x[2]; acc[3] += w0.w * x[3];
                    acc[4] += w1.x * x[4]; acc[5] += w1.y * x[5]; acc[6] += w1.z * x[6]; acc[7] += w1.w * x[7]; } }
            f32x4 o0, o1; o0.x = silu_f(acc[0]); o0.y = silu_f(acc[1]); o0.z = silu_f(acc[2]); o0.w = silu_f(acc[3]); o1.x = silu_f(acc[4]); o1.y = silu_f(acc[5]); o1.z = silu_f(acc[6]); o1.w = silu_f(acc[7]);
            *(f32x4*)(ACT + (size_t)m * 1536 + ch) = o0; *(f32x4*)(ACT + (size_t)m * 1536 + ch + 4) = o1;
            { v4u w; w.x = pk2(o0.x, o0.y); w.y = pk2(o0.z, o0.w); w.z = pk2(o1.x, o1.y); w.w = pk2(o1.z, o1.w); *(v4u*)((bf16_t*)(a.ws + WS_XBC16) + (size_t)m * 1536 + ch) = w; } }
    }
}

typedef float f32x2 __attribute__((ext_vector_type(2)));
__device__ __forceinline__ void ssd_combine_phase(const Args& a, int gw, int NGW, int lane) {
    const float* YF = (const float*)(a.ws + WS_YF); const float* YB = (const float*)(a.ws + WS_YB); const float* ACT = (const float*)(a.ws + WS_ACT);
    const bf16_t* P = (const bf16_t*)(a.ws + WS_PROJ); bf16_t* YC = (bf16_t*)(a.ws + WS_YCAT);
    const float* dsk = a.in[14]; const float* nw = a.in[15];
    for (int m = gw; m < MTOK; m += NGW) {
        const int ch = lane * 16; const float dk = dsk[ch >> 6];
        float z[16], gv[16]; unpack8(*(const v4u*)(P + (size_t)m * NINP + A_Z + ch), z); unpack8(*(const v4u*)(P + (size_t)m * NINP + A_Z + ch + 8), z + 8);
        float ss = 0.f;
#pragma unroll
        for (int q = 0; q < 4; ++q) { const f32x4 f = *(const f32x4*)(YF + (size_t)m * 1024 + ch + 4 * q), bk = *(const f32x4*)(YB + (size_t)m * 1024 + ch + 4 * q), xv = *(const f32x4*)(ACT + (size_t)m * 1536 + ch + 4 * q);
            const f32x4 y = f + bk + dk * xv;
            gv[4 * q] = y.x * silu_f(z[4 * q]); gv[4 * q + 1] = y.y * silu_f(z[4 * q + 1]); gv[4 * q + 2] = y.z * silu_f(z[4 * q + 2]); gv[4 * q + 3] = y.w * silu_f(z[4 * q + 3]); }
#pragma unroll
        for (int i = 0; i < 16; ++i) ss += gv[i] * gv[i];
        const float r = rsqrtf(group_sum<64>(ss) * (1.f / 1024.f) + EPS);
#pragma unroll
        for (int i = 0; i < 16; ++i) gv[i] = gv[i] * r * nw[ch + i];
        *(v4u*)(YC + (size_t)m * 2048 + 1024 + ch) = pack8(gv); *(v4u*)(YC + (size_t)m * 2048 + 1024 + ch + 8) = pack8(gv + 8);
    }
}

__device__ __forceinline__ void post1_phase(const Args& a, int gw, int NGW, int lane) {
    const bf16_t* P = (const bf16_t*)(a.ws + WS_PROJ); const float* cw = a.in[18]; const float* cb = a.in[19];
    float* ACT = (float*)(a.ws + WS_ACT);
    for (int m = gw; m < MTOK; m += NGW) {
        const int t = m & 2047;
#pragma unroll
        for (int j = 0; j < 4; ++j) { const int ch = (j * 64 + lane) * 8;
            float acc[8];
            { const f32x4 b0 = *(const f32x4*)(cb + ch), b1 = *(const f32x4*)(cb + ch + 4); acc[0] = b0.x; acc[1] = b0.y; acc[2] = b0.z; acc[3] = b0.w; acc[4] = b1.x; acc[5] = b1.y; acc[6] = b1.z; acc[7] = b1.w; }
#pragma unroll
            for (int d = 0; d < 4; ++d) { const int ts = t + d - 2;
                if (ts >= 0 && ts < SEQ) { float x[8]; unpack8(*(const v4u*)(P + (size_t)(m + d - 2) * NINP + C_Q + ch), x);
                    const f32x4 w0 = *(const f32x4*)(cw + d * 2048 + ch), w1 = *(const f32x4*)(cw + d * 2048 + ch + 4);
                    acc[0] += w0.x * x[0]; acc[1] += w0.y * x[1]; acc[2] += w0.z * x[2]; acc[3] += w0.w * x[3];
                    acc[4] += w1.x * x[4]; acc[5] += w1.y * x[5]; acc[6] += w1.z * x[6]; acc[7] += w1.w * x[7]; } }
#pragma unroll
            for (int i = 0; i < 8; ++i) acc[i] = silu_f(acc[i]);
            if (j < 2) {
                float ss = 0.f;
#pragma unroll
                for (int i = 0; i < 8; ++i) ss += acc[i] * acc[i];
                ss = group_sum<16>(ss);
                float r = rsqrtf(ss + EPS); if (j == 0) r *= 0.088388347648318440f;
#pragma unroll
                for (int i = 0; i < 8; ++i) acc[i] *= r;
            }
            *(f32x4*)(ACT + (size_t)m * 2048 + ch) = (f32x4){acc[0], acc[1], acc[2], acc[3]}; *(f32x4*)(ACT + (size_t)m * 2048 + ch + 4) = (f32x4){acc[4], acc[5], acc[6], acc[7]};
            *(v4u*)((bf16_t*)(a.ws + WS_QKV16) + (size_t)m * 2048 + ch) = pack8(acc); }
    }
}

typedef short s16x4_t __attribute__((ext_vector_type(4)));
typedef __bf16 bf16x2_v __attribute__((ext_vector_type(2)));
__device__ __forceinline__ unsigned cvtpk_rne(float lo, float hi) { f32x2 v = {lo, hi}; bf16x2_v bb = __builtin_convertvector(v, bf16x2_v); return __builtin_bit_cast(unsigned, bb); }
template <int S_> __device__ __forceinline__ bf16x8_t acc_frag(const f32x16_t& x) {
    v4u w; w.x = cvtpk_rne(x[8 * S_ + 0], x[8 * S_ + 1]); w.y = cvtpk_rne(x[8 * S_ + 2], x[8 * S_ + 3]); w.z = cvtpk_rne(x[8 * S_ + 4], x[8 * S_ + 5]); w.w = cvtpk_rne(x[8 * S_ + 6], x[8 * S_ + 7]);
    return __builtin_bit_cast(bf16x8_t, w);
}
__device__ __forceinline__ bf16x8_t join44(v2u lo, v2u hi) { v4u w; w.x = lo.x; w.y = lo.y; w.z = hi.x; w.w = hi.y; return __builtin_bit_cast(bf16x8_t, w); }
__device__ __forceinline__ float wave_incl_scan(float v, int lane) {
#pragma unroll
    for (int o = 1; o < 64; o <<= 1) { const float t = __shfl_up(v, o); if (lane >= o) v += t; }
    return v;
}
constexpr int GDN_LDS_PER_WAVE = 17920;
__device__ __forceinline__ void gdn1_item(const Args& a, int item, unsigned char* ldsw, int lane) {
    asm volatile("" : "+v"(lane));
    const int c = item & 31, dir = (item >> 5) & 1, hv = (item >> 6) & 7, b = item >> 9, hq = hv >> 1;
    const int r32 = lane & 31, hi = lane >> 5;
    float* AT = (float*)ldsw; float* Gs = AT + 64 * 64; float* Bs = Gs + 64;
    const bf16_t* QK = (const bf16_t*)(a.ws + WS_QKV16); const float* SM = (const float*)(a.ws + WS_SMALL);
    bf16_t* GT = (bf16_t*)(a.ws + WS_GT) + (size_t)item * 4096; bf16_t* GA = (bf16_t*)(a.ws + WS_GA) + (size_t)item * 4096;
    const float Aneg = -expf(a.in[dir ? 21 : 20][hv]); const float dtb = a.in[dir ? 23 : 22][hv];
    {
        const int t = dir ? SEQ - 1 - (64 * c + lane) : 64 * c + lane; const float* sm = SM + ((size_t)b * SEQ + t) * 32;
        const float gi = Aneg * softplus_f(sm[16 + dir * 8 + hv] + dtb), bi = sigmoid_f(sm[dir * 8 + hv]);
        Gs[lane] = wave_incl_scan(gi, lane); Bs[lane] = bi;
    }
    const int t0r = dir ? SEQ - 1 - (64 * c + r32) : 64 * c + r32, t1r = dir ? t0r - 32 : t0r + 32;
    const bf16_t* k0p = QK + ((size_t)b * SEQ + t0r) * 2048 + 512 + hq * 128 + hi * 8; const bf16_t* k1p = QK + ((size_t)b * SEQ + t1r) * 2048 + 512 + hq * 128 + hi * 8;
    const bf16_t* q0p = k0p - 512, * q1p = k1p - 512;
    LDS_WAIT();
    const float Gj0 = Gs[r32], Gj1 = Gs[32 + r32];
    {
        f32x16_t kk00, kk10, kk11;
#pragma unroll
        for (int r = 0; r < 16; ++r) { kk00[r] = 0.f; kk10[r] = 0.f; kk11[r] = 0.f; }
#pragma unroll
        for (int s = 0; s < 8; ++s) {
            const bf16x8_t kA0 = *(const bf16x8_t*)(k0p + 16 * s), kA1 = *(const bf16x8_t*)(k1p + 16 * s);
            kk00 = __builtin_amdgcn_mfma_f32_32x32x16_bf16(kA0, kA0, kk00, 0, 0, 0); kk10 = __builtin_amdgcn_mfma_f32_32x32x16_bf16(kA1, kA0, kk10, 0, 0, 0); kk11 = __builtin_amdgcn_mfma_f32_32x32x16_bf16(kA1, kA1, kk11, 0, 0, 0);
        }
#pragma unroll
        for (int r = 0; r < 16; ++r) { const int il = (r & 3) + 8 * (r >> 2) + 4 * hi;
            const float Gi0 = Gs[il], Gi1 = Gs[32 + il], bi0 = Bs[il], bi1 = Bs[32 + il];
            AT[r32 * 64 + il] = (r32 < il) ? bi0 * kk00[r] * expf(Gi0 - Gj0) : 0.f;
            AT[r32 * 64 + 32 + il] = bi1 * kk10[r] * expf(Gi1 - Gj0);
            AT[(32 + r32) * 64 + 32 + il] = (r32 < il) ? bi1 * kk11[r] * expf(Gi1 - Gj1) : 0.f;
            AT[(32 + r32) * 64 + il] = 0.f;
        }
    }
    asm volatile("" ::: "memory");
    {
        f32x16_t qk00, qk10, qk11;
#pragma unroll
        for (int r = 0; r < 16; ++r) { qk00[r] = 0.f; qk10[r] = 0.f; qk11[r] = 0.f; }
#pragma unroll
        for (int s = 0; s < 8; ++s) {
            const bf16x8_t kA0 = *(const bf16x8_t*)(k0p + 16 * s), kA1 = *(const bf16x8_t*)(k1p + 16 * s), qA0 = *(const bf16x8_t*)(q0p + 16 * s), qA1 = *(const bf16x8_t*)(q1p + 16 * s);
            qk00 = __builtin_amdgcn_mfma_f32_32x32x16_bf16(qA0, kA0, qk00, 0, 0, 0); qk10 = __builtin_amdgcn_mfma_f32_32x32x16_bf16(qA1, kA0, qk10, 0, 0, 0); qk11 = __builtin_amdgcn_mfma_f32_32x32x16_bf16(qA1, kA1, qk11, 0, 0, 0);
        }
#pragma unroll
        for (int r = 0; r < 16; ++r) { const int il = (r & 3) + 8 * (r >> 2) + 4 * hi;
            const float Gi0 = Gs[il], Gi1 = Gs[32 + il];
            GA[il * 64 + r32] = (bf16_t)f2bf((r32 <= il) ? qk00[r] * expf(Gi0 - Gj0) : 0.f);
            GA[(32 + il) * 64 + r32] = (bf16_t)f2bf(qk10[r] * expf(Gi1 - Gj0));
            GA[(32 + il) * 64 + 32 + r32] = (bf16_t)f2bf((r32 <= il) ? qk11[r] * expf(Gi1 - Gj1) : 0.f);
        }
    }
    LDS_WAIT(); asm volatile("" ::: "memory");
    float tr[64];
    int lane2 = lane; asm volatile("" : "+v"(lane2) :: "memory");
#pragma unroll
    for (int j = 0; j < 64; ++j) tr[j] = (j == lane2) ? 1.f : 0.f;
    int atoff = 0;
#pragma unroll
    for (int j = 62; j >= 0; --j) { float c0 = 0.f, c1 = 0.f, c2 = 0.f, c3 = 0.f;
        asm volatile("" : "+v"(atoff) : "v"(tr[j + 1]));
#pragma unroll
        for (int qd = (j + 1) / 4; qd < 16; ++qd) { const f32x4 av = *(const f32x4*)(AT + atoff + j * 64 + 4 * qd);
            if (4 * qd + 0 > j) c0 = fmaf(tr[4 * qd + 0], av.x, c0);
            if (4 * qd + 1 > j) c1 = fmaf(tr[4 * qd + 1], av.y, c1);
            if (4 * qd + 2 > j) c2 = fmaf(tr[4 * qd + 2], av.z, c2);
            if (4 * qd + 3 > j) c3 = fmaf(tr[4 * qd + 3], av.w, c3); }
        tr[j] -= (c0 + c1) + (c2 + c3); asm volatile("" ::: "memory"); }
#pragma unroll
    for (int x = 0; x < 8; ++x) *(v4u*)(GT + lane2 * 64 + x * 8) = pack8(tr + x * 8);
    LDS_WAIT();
}

__device__ __forceinline__ void gdn2_item(const Args& a, int item, unsigned char* lds) {
    const int dvs = item & 3, hv = (item >> 2) & 7, dir = (item >> 5) & 1, b = item >> 6, hq = hv >> 1;
    const int lane0 = threadIdx.x & 63;
    constexpr int BUFB = 57344, O_K = 0, O_Q = 16384, O_T = 32768, O_A = 40960, O_V = 49152;
    float* Gs = (float*)(lds + 2 * BUFB); float* Bs = Gs + 64; float* Es = Bs + 64; float* Ws = Es + 64; float* ot = Ws + 64;
    const LAS unsigned char* ldl = (const LAS unsigned char*)lds;
    const bf16_t* QK = (const bf16_t*)(a.ws + WS_QKV16); const float* ACT = (const float*)(a.ws + WS_ACT); const float* SM = (const float*)(a.ws + WS_SMALL);
    float* O = (float*)(a.ws + (dir ? WS_YB : WS_YF));
    const float Aneg = -expf(a.in[dir ? 21 : 20][hv]); const float dtb = a.in[dir ? 23 : 22][hv];
    const size_t gbase = (size_t)(((b * 8 + hv) * 2 + dir) * 32) * 4096;
    f32x16_t S[4];
#pragma unroll
    for (int nt = 0; nt < 4; ++nt)
#pragma unroll
        for (int r = 0; r < 16; ++r) S[nt][r] = 0.f;
    float gar, gbr;
#define G2_DMA(c_, buf_) do { const int t_ = dir ? SEQ - 1 - (64 * (c_) + lane0) : 64 * (c_) + lane0; const size_t mi_ = (size_t)b * SEQ + t_; \
        const bf16_t* kr_ = QK + mi_ * 2048 + 512 + hq * 128; const bf16_t* qr_ = QK + mi_ * 2048 + hq * 128; \
        const bf16_t* tr_ = (const bf16_t*)(a.ws + WS_GT) + gbase + (size_t)(c_) * 4096 + lane0 * 64; const bf16_t* ar_ = (const bf16_t*)(a.ws + WS_GA) + gbase + (size_t)(c_) * 4096 + lane0 * 64; \
        const float* vr_ = ACT + mi_ * 2048 + 1024 + hv * 128 + dvs * 32; \
        LAS unsigned char* lb_ = (LAS unsigned char*)lds + (buf_) * BUFB; \
        _Pragma("unroll") for (int x = 0; x < 16; ++x) { __builtin_amdgcn_global_load_lds((const unsigned*)(kr_ + 8 * x), (LAS unsigned*)(lb_ + O_K + 1024 * x), 16, 0, 0); \
                                                         __builtin_amdgcn_global_load_lds((const unsigned*)(qr_ + 8 * x), (LAS unsigned*)(lb_ + O_Q + 1024 * x), 16, 0, 0); } \
        _Pragma("unroll") for (int x = 0; x < 8; ++x) { __builtin_amdgcn_global_load_lds((const unsigned*)(tr_ + 8 * x), (LAS unsigned*)(lb_ + O_T + 1024 * x), 16, 0, 0); \
                                                        __builtin_amdgcn_global_load_lds((const unsigned*)(ar_ + 8 * x), (LAS unsigned*)(lb_ + O_A + 1024 * x), 16, 0, 0); \
                                                        __builtin_amdgcn_global_load_lds((const unsigned*)(vr_ + 4 * x), (LAS unsigned*)(lb_ + O_V + 1024 * x), 16, 0, 0); } \
        const float* sm_ = SM + mi_ * 32; gar = sm_[16 + dir * 8 + hv]; gbr = sm_[dir * 8 + hv]; } while (0)
    G2_DMA(0, 0);
    for (int c = 0; c < 32; ++c) {
        int lane = lane0; asm volatile("" : "+v"(lane));
        const int r32 = lane & 31, hi = lane >> 5, trq = (lane & 15) >> 2, trp = lane & 3, trc = (lane >> 4) & 1;
        const int bo = (c & 1) * BUFB;
        float GL;
        {
            const float gi = Aneg * softplus_f(gar + dtb), bi = sigmoid_f(gbr);
            const float G = wave_incl_scan(gi, lane); GL = __shfl(G, 63);
            Gs[lane] = G; Bs[lane] = bi; Es[lane] = __expf(G); Ws[lane] = __expf(GL - G);
        }
        asm volatile("s_waitcnt vmcnt(0)" ::: "memory");
        if (c + 1 < 32) G2_DMA(c + 1, (c + 1) & 1);
        LDS_WAIT();
        f32x16_t KS[2];
#pragma unroll
        for (int rt = 0; rt < 2; ++rt)
#pragma unroll
            for (int r = 0; r < 16; ++r) KS[rt][r] = 0.f;
#define LFRAG(off_) join44(*(const LAS v2u*)(ldl + (off_)), *(const LAS v2u*)(ldl + (off_) + 1024))
#pragma unroll
        for (int nt = 0; nt < 4; ++nt) {
            const bf16x8_t sb0 = acc_frag<0>(S[nt]), sb1 = acc_frag<1>(S[nt]);
#pragma unroll
            for (int rt = 0; rt < 2; ++rt) {
                const int ro = bo + O_K + ((4 * nt) * 64 + 32 * rt + r32) * 16 + 8 * hi;
                KS[rt] = __builtin_amdgcn_mfma_f32_32x32x16_bf16(LFRAG(ro), sb0, KS[rt], 0, 0, 0); KS[rt] = __builtin_amdgcn_mfma_f32_32x32x16_bf16(LFRAG(ro + 2048), sb1, KS[rt], 0, 0, 0);
            }
        }
        asm volatile("" ::: "memory");
        f32x16_t rhs[2];
#pragma unroll
        for (int rt = 0; rt < 2; ++rt)
#pragma unroll
            for (int r = 0; r < 16; ++r) { const int i = 32 * rt + (r & 3) + 8 * (r >> 2) + 4 * hi;
                const float vv = *(const LAS float*)(ldl + bo + O_V + ((r32 >> 2) * 64 + i) * 16 + (r32 & 3) * 4); const float bi = Bs[i];
                rhs[rt][r] = bi * vv - bi * Es[i] * KS[rt][r]; }
        asm volatile("" ::: "memory");
        f32x16_t vn[2];
#pragma unroll
        for (int r = 0; r < 16; ++r) { vn[0][r] = 0.f; vn[1][r] = 0.f; }
        {
            const bf16x8_t rb00 = acc_frag<0>(rhs[0]), rb01 = acc_frag<1>(rhs[0]), rb10 = acc_frag<0>(rhs[1]), rb11 = acc_frag<1>(rhs[1]);
            const int t0 = bo + O_T + r32 * 16 + 8 * hi, t1 = t0 + 512;
            vn[0] = __builtin_amdgcn_mfma_f32_32x32x16_bf16(LFRAG(t0), rb00, vn[0], 0, 0, 0); vn[0] = __builtin_amdgcn_mfma_f32_32x32x16_bf16(LFRAG(t0 + 2048), rb01, vn[0], 0, 0, 0);
            vn[1] = __builtin_amdgcn_mfma_f32_32x32x16_bf16(LFRAG(t1), rb00, vn[1], 0, 0, 0); vn[1] = __builtin_amdgcn_mfma_f32_32x32x16_bf16(LFRAG(t1 + 2048), rb01, vn[1], 0, 0, 0);
            vn[1] = __builtin_amdgcn_mfma_f32_32x32x16_bf16(LFRAG(t1 + 4096), rb10, vn[1], 0, 0, 0); vn[1] = __builtin_amdgcn_mfma_f32_32x32x16_bf16(LFRAG(t1 + 6144), rb11, vn[1], 0, 0, 0);
        }
        asm volatile("" ::: "memory");
        f32x16_t QS[2];
#pragma unroll
        for (int rt = 0; rt < 2; ++rt)
#pragma unroll
            for (int r = 0; r < 16; ++r) QS[rt][r] = 0.f;
#pragma unroll
        for (int nt = 0; nt < 4; ++nt) {
            const bf16x8_t sb0 = acc_frag<0>(S[nt]), sb1 = acc_frag<1>(S[nt]);
#pragma unroll
            for (int rt = 0; rt < 2; ++rt) {
                const int ro = bo + O_Q + ((4 * nt) * 64 + 32 * rt + r32) * 16 + 8 * hi;
                QS[rt] = __builtin_amdgcn_mfma_f32_32x32x16_bf16(LFRAG(ro), sb0, QS[rt], 0, 0, 0); QS[rt] = __builtin_amdgcn_mfma_f32_32x32x16_bf16(LFRAG(ro + 2048), sb1, QS[rt], 0, 0, 0);
            }
        }
        asm volatile("" ::: "memory");
        {
            const bf16x8_t vb00 = acc_frag<0>(vn[0]), vb01 = acc_frag<1>(vn[0]), vb10 = acc_frag<0>(vn[1]), vb11 = acc_frag<1>(vn[1]);
            const int a0 = bo + O_A + r32 * 16 + 8 * hi, a1 = a0 + 512;
            f32x16_t o0, o1;
#pragma unroll
            for (int r = 0; r < 16; ++r) { const int il = (r & 3) + 8 * (r >> 2) + 4 * hi; o0[r] = Es[il] * QS[0][r]; o1[r] = Es[32 + il] * QS[1][r]; }
            o0 = __builtin_amdgcn_mfma_f32_32x32x16_bf16(LFRAG(a0), vb00, o0, 0, 0, 0); o0 = __builtin_amdgcn_mfma_f32_32x32x16_bf16(LFRAG(a0 + 2048), vb01, o0, 0, 0, 0);
            o1 = __builtin_amdgcn_mfma_f32_32x32x16_bf16(LFRAG(a1), vb00, o1, 0, 0, 0); o1 = __builtin_amdgcn_mfma_f32_32x32x16_bf16(LFRAG(a1 + 2048), vb01, o1, 0, 0, 0);
            o1 = __builtin_amdgcn_mfma_f32_32x32x16_bf16(LFRAG(a1 + 4096), vb10, o1, 0, 0, 0); o1 = __builtin_amdgcn_mfma_f32_32x32x16_bf16(LFRAG(a1 + 6144), vb11, o1, 0, 0, 0);
#pragma unroll
            for (int r = 0; r < 16; ++r) { const int il = (r & 3) + 8 * (r >> 2) + 4 * hi; ot[il * 33 + r32] = o0[r]; ot[(32 + il) * 33 + r32] = o1[r]; }
            LDS_WAIT();
            { const int t = dir ? SEQ - 1 - (64 * c + lane) : 64 * c + lane; float* orow = O + ((size_t)b * SEQ + t) * 1024 + hv * 128 + dvs * 32;
#pragma unroll
              for (int x = 0; x < 8; ++x) *(f32x4*)(orow + 4 * x) = (f32x4){ot[lane * 33 + 4 * x], ot[lane * 33 + 4 * x + 1], ot[lane * 33 + 4 * x + 2], ot[lane * 33 + 4 * x + 3]}; }
        }
        asm volatile("" ::: "memory");
        {
#pragma unroll
            for (int r = 0; r < 16; ++r) { const int il = (r & 3) + 8 * (r >> 2) + 4 * hi; vn[0][r] *= Ws[il]; vn[1][r] *= Ws[32 + il]; }
            const bf16x8_t wb[4] = {acc_frag<0>(vn[0]), acc_frag<1>(vn[0]), acc_frag<0>(vn[1]), acc_frag<1>(vn[1])};
            const float eGL = __expf(GL);
#pragma unroll
            for (int nt = 0; nt < 4; ++nt) {
#pragma unroll
                for (int r = 0; r < 16; ++r) S[nt][r] *= eGL;
#pragma unroll
                for (int ks = 0; ks < 4; ++ks) {
                    const int ro = bo + O_K + ((4 * nt + 2 * trc + (trp >> 1)) * 64 + 16 * ks + 4 * hi + trq) * 16 + 8 * (trp & 1);
                    const s16x4_t lo = __builtin_bit_cast(s16x4_t, __builtin_amdgcn_ds_read_tr16_b64_v4i16((LAS s16x4_t*)(ldl + ro)));
                    const s16x4_t hi4 = __builtin_bit_cast(s16x4_t, __builtin_amdgcn_ds_read_tr16_b64_v4i16((LAS s16x4_t*)(ldl + ro + 8 * 16)));
                    const bf16x8_t kf = (bf16x8_t){lo[0], lo[1], lo[2], lo[3], hi4[0], hi4[1], hi4[2], hi4[3]};
                    S[nt] = __builtin_amdgcn_mfma_f32_32x32x16_bf16(kf, wb[ks], S[nt], 0, 0, 0);
                }
            }
        }
        LDS_WAIT();
    }
#undef LFRAG
#undef G2_DMA
}

namespace gdn3 {
constexpr int ABUF = 32768, A_K = 0, A_T = 16384, A_V = 24576, O_BR = 65536, BBUF = 24576, B_Q = 0, B_A = 16384, O_CM = 114688, CMB = 12800, CM_VB = 8192, CM_ES = 12288, O_SC = 140288, O_OT = 141312, O_FLAG = 149760, O_END = 149824;
__device__ __forceinline__ void spin_ge(const LAS unsigned char* ldl, int off, unsigned target) {
    for (;;) { const unsigned v = __builtin_amdgcn_readfirstlane(*(volatile const LAS unsigned*)(ldl + off)); if (v >= target) break; __builtin_amdgcn_s_sleep(1); }
    asm volatile("" ::: "memory");
}
#define G3_LFRAG(off_) join44(*(const LAS v2u*)(ldl + (off_)), *(const LAS v2u*)(ldl + (off_) + 1024))
__device__ __forceinline__ void chain(const Args& a, int item, unsigned char* lds) {
    const int dvs = item & 3, hv = (item >> 2) & 7, dir = (item >> 5) & 1, b = item >> 6, hq = hv >> 1;
    const int lane0 = threadIdx.x & 63;
    LAS unsigned char* ldw = (LAS unsigned char*)lds; const LAS unsigned char* ldl = (const LAS unsigned char*)lds;
    LAS float* Gs = (LAS float*)(ldw + O_SC); LAS float* Bs = Gs + 64; LAS float* Es = Bs + 64; LAS float* Ws = Es + 64;
    const bf16_t* QK = (const bf16_t*)(a.ws + WS_QKV16); const float* ACT = (const float*)(a.ws + WS_ACT); const float* SM = (const float*)(a.ws + WS_SMALL);
    const float Aneg = -expf(a.in[dir ? 21 : 20][hv]); const float dtb = a.in[dir ? 23 : 22][hv];
    const size_t gbase = (size_t)(((b * 8 + hv) * 2 + dir) * 32) * 4096;
    f32x16_t S[4];
#pragma unroll
    for (int nt = 0; nt < 4; ++nt)
#pragma unroll
        for (int r = 0; r < 16; ++r) S[nt][r] = 0.f;
    float gar, gbr;
#define G3A_DMA(c_, buf_) do { const int t_ = dir ? SEQ - 1 - (64 * (c_) + lane0) : 64 * (c_) + lane0; const size_t mi_ = (size_t)b * SEQ + t_; \
        const bf16_t* kr_ = QK + mi_ * 2048 + 512 + hq * 128; const bf16_t* tr_ = (const bf16_t*)(a.ws + WS_GT) + gbase + (size_t)(c_) * 4096 + lane0 * 64; \
        const float* vr_ = ACT + mi_ * 2048 + 1024 + hv * 128 + dvs * 32; LAS unsigned char* lb_ = ldw + (buf_) * ABUF; \
        _Pragma("unroll") for (int x = 0; x < 16; ++x) __builtin_amdgcn_global_load_lds((const unsigned*)(kr_ + 8 * x), (LAS unsigned*)(lb_ + A_K + 1024 * x), 16, 0, 0); \
        _Pragma("unroll") for (int x = 0; x < 8; ++x) { __builtin_amdgcn_global_load_lds((const unsigned*)(tr_ + 8 * x), (LAS unsigned*)(lb_ + A_T + 1024 * x), 16, 0, 0); \
                                                        __builtin_amdgcn_global_load_lds((const unsigned*)(vr_ + 4 * x), (LAS unsigned*)(lb_ + A_V + 1024 * x), 16, 0, 0); } \
        const float* sm_ = SM + mi_ * 32; gar = sm_[16 + dir * 8 + hv]; gbr = sm_[dir * 8 + hv]; } while (0)
    G3A_DMA(0, 0);
    for (int c = 0; c < 32; ++c) {
        int lane = lane0; asm volatile("" : "+v"(lane));
        const int r32 = lane & 31, hi = lane >> 5, trq = (lane & 15) >> 2, trp = lane & 3, trc = (lane >> 4) & 1;
        const int bo = (c & 1) * ABUF, cm = O_CM + (c & 1) * CMB;
        float GL, eG;
        {   const float gi = Aneg * softplus_f(gar + dtb), bi = sigmoid_f(gbr);
            const float G = wave_incl_scan(gi, lane); GL = __shfl(G, 63); eG = __expf(G);
            Gs[lane] = G; Bs[lane] = bi; Es[lane] = eG; Ws[lane] = __expf(GL - G); }
        asm volatile("s_waitcnt vmcnt(0)" ::: "memory");
        if (c + 1 < 32) G3A_DMA(c + 1, (c + 1) & 1);
        if (c >= 2) spin_ge(ldl, O_FLAG + 4, (unsigned)(c - 1));
        *(LAS float*)(ldw + cm + CM_ES + lane * 4) = eG;
        LDS_WAIT();
        f32x16_t KS[2];
#pragma unroll
        for (int rt = 0; rt < 2; ++rt)
#pragma unroll
            for (int r = 0; r < 16; ++r) KS[rt][r] = 0.f;
#pragma unroll
        for (int nt = 0; nt < 4; ++nt) {
            const bf16x8_t sb0 = acc_frag<0>(S[nt]), sb1 = acc_frag<1>(S[nt]);
            *(LAS bf16x8_t*)(ldw + cm + (2 * nt) * 1024 + lane * 16) = sb0; *(LAS bf16x8_t*)(ldw + cm + (2 * nt + 1) * 1024 + lane * 16) = sb1;
#pragma unroll
            for (int rt = 0; rt < 2; ++rt) {
                const int ro = bo + A_K + ((4 * nt) * 64 + 32 * rt + r32) * 16 + 8 * hi;
                KS[rt] = __builtin_amdgcn_mfma_f32_32x32x16_bf16(G3_LFRAG(ro), sb0, KS[rt], 0, 0, 0); KS[rt] = __builtin_amdgcn_mfma_f32_32x32x16_bf16(G3_LFRAG(ro + 2048), sb1, KS[rt], 0, 0, 0);
            }
        }
        asm volatile("" ::: "memory");
        f32x16_t rhs[2];
#pragma unroll
        for (int rt = 0; rt < 2; ++rt)
#pragma unroll
            for (int r = 0; r < 16; ++r) { const int i = 32 * rt + (r & 3) + 8 * (r >> 2) + 4 * hi;
                const float vv = *(const LAS float*)(ldl + bo + A_V + ((r32 >> 2) * 64 + i) * 16 + (r32 & 3) * 4); const float bi = Bs[i];
                rhs[rt][r] = bi * vv - bi * Es[i] * KS[rt][r]; }
        asm volatile("" ::: "memory");
        f32x16_t vn[2];
#pragma unroll
        for (int r = 0; r < 16; ++r) { vn[0][r] = 0.f; vn[1][r] = 0.f; }
        {   const bf16x8_t rb00 = acc_frag<0>(rhs[0]), rb01 = acc_frag<1>(rhs[0]), rb10 = acc_frag<0>(rhs[1]), rb11 = acc_frag<1>(rhs[1]);
            const int t0 = bo + A_T + r32 * 16 + 8 * hi, t1 = t0 + 512;
            vn[0] = __builtin_amdgcn_mfma_f32_32x32x16_bf16(G3_LFRAG(t0), rb00, vn[0], 0, 0, 0); vn[0] = __builtin_amdgcn_mfma_f32_32x32x16_bf16(G3_LFRAG(t0 + 2048), rb01, vn[0], 0, 0, 0);
            vn[1] = __builtin_amdgcn_mfma_f32_32x32x16_bf16(G3_LFRAG(t1), rb00, vn[1], 0, 0, 0); vn[1] = __builtin_amdgcn_mfma_f32_32x32x16_bf16(G3_LFRAG(t1 + 2048), rb01, vn[1], 0, 0, 0);
            vn[1] = __builtin_amdgcn_mfma_f32_32x32x16_bf16(G3_LFRAG(t1 + 4096), rb10, vn[1], 0, 0, 0); vn[1] = __builtin_amdgcn_mfma_f32_32x32x16_bf16(G3_LFRAG(t1 + 6144), rb11, vn[1], 0, 0, 0); }
        *(LAS bf16x8_t*)(ldw + cm + CM_VB + 0 * 1024 + lane * 16) = acc_frag<0>(vn[0]); *(LAS bf16x8_t*)(ldw + cm + CM_VB + 1 * 1024 + lane * 16) = acc_frag<1>(vn[0]);
        *(LAS bf16x8_t*)(ldw + cm + CM_VB + 2 * 1024 + lane * 16) = acc_frag<0>(vn[1]); *(LAS bf16x8_t*)(ldw + cm + CM_VB + 3 * 1024 + lane * 16) = acc_frag<1>(vn[1]);
        LDS_WAIT();
        if (lane == 0) *(volatile LAS unsigned*)(ldw + O_FLAG) = (unsigned)(c + 1);
        asm volatile("" ::: "memory");
        {
#pragma unroll
            for (int r = 0; r < 16; ++r) { const int il = (r & 3) + 8 * (r >> 2) + 4 * hi; vn[0][r] *= Ws[il]; vn[1][r] *= Ws[32 + il]; }
            const bf16x8_t wb[4] = {acc_frag<0>(vn[0]), acc_frag<1>(vn[0]), acc_frag<0>(vn[1]), acc_frag<1>(vn[1])};
            const float eGL = __expf(GL);
#pragma unroll
            for (int nt = 0; nt < 4; ++nt) {
#pragma unroll
                for (int r = 0; r < 16; ++r) S[nt][r] *= eGL;
#pragma unroll
                for (int ks = 0; ks < 4; ++ks) {
                    const int ro = bo + A_K + ((4 * nt + 2 * trc + (trp >> 1)) * 64 + 16 * ks + 4 * hi + trq) * 16 + 8 * (trp & 1);
                    const s16x4_t lo = __builtin_bit_cast(s16x4_t, __builtin_amdgcn_ds_read_tr16_b64_v4i16((LAS s16x4_t*)(ldl + ro)));
                    const s16x4_t hi4 = __builtin_bit_cast(s16x4_t, __builtin_amdgcn_ds_read_tr16_b64_v4i16((LAS s16x4_t*)(ldl + ro + 8 * 16)));
                    const bf16x8_t kf = (bf16x8_t){lo[0], lo[1], lo[2], lo[3], hi4[0], hi4[1], hi4[2], hi4[3]};
                    S[nt] = __builtin_amdgcn_mfma_f32_32x32x16_bf16(kf, wb[ks], S[nt], 0, 0, 0);
                }
            }
        }
        LDS_WAIT();
    }
#undef G3A_DMA
}
__device__ __forceinline__ void output(const Args& a, int item, unsigned char* lds) {
    const int dvs = item & 3, hv = (item >> 2) & 7, dir = (item >> 5) & 1, b = item >> 6, hq = hv >> 1;
    const int lane0 = threadIdx.x & 63;
    LAS unsigned char* ldw = (LAS unsigned char*)lds; const LAS unsigned char* ldl = (const LAS unsigned char*)lds;
    LAS float* ot = (LAS float*)(ldw + O_OT);
    const bf16_t* QK = (const bf16_t*)(a.ws + WS_QKV16);
    float* O = (float*)(a.ws + (dir ? WS_YB : WS_YF));
    const size_t gbase = (size_t)(((b * 8 + hv) * 2 + dir) * 32) * 4096;
#define G3B_DMA(c_, buf_) do { const int t_ = dir ? SEQ - 1 - (64 * (c_) + lane0) : 64 * (c_) + lane0; const size_t mi_ = (size_t)b * SEQ + t_; \
        const bf16_t* qr_ = QK + mi_ * 2048 + hq * 128; const bf16_t* ar_ = (const bf16_t*)(a.ws + WS_GA) + gbase + (size_t)(c_) * 4096 + lane0 * 64; \
        LAS unsigned char* lb_ = ldw + O_BR + (buf_) * BBUF; \
        _Pragma("unroll") for (int x = 0; x < 16; ++x) __builtin_amdgcn_global_load_lds((const unsigned*)(qr_ + 8 * x), (LAS unsigned*)(lb_ + B_Q + 1024 * x), 16, 0, 0); \
        _Pragma("unroll") for (int x = 0; x < 8; ++x) __builtin_amdgcn_global_load_lds((const unsigned*)(ar_ + 8 * x), (LAS unsigned*)(lb_ + B_A + 1024 * x), 16, 0, 0); } while (0)
    G3B_DMA(0, 0);
    for (int c = 0; c < 32; ++c) {
        int lane = lane0; asm volatile("" : "+v"(lane));
        const int r32 = lane & 31, hi = lane >> 5;
        const int bo = O_BR + (c & 1) * BBUF, cm = O_CM + (c & 1) * CMB;
        asm volatile("s_waitcnt vmcnt(0)" ::: "memory");
        if (c + 1 < 32) G3B_DMA(c + 1, (c + 1) & 1);
        spin_ge(ldl, O_FLAG, (unsigned)(c + 1));
        f32x16_t QS[2];
#pragma unroll
        for (int rt = 0; rt < 2; ++rt)
#pragma unroll
            for (int r = 0; r < 16; ++r) QS[rt][r] = 0.f;
#pragma unroll
        for (int nt = 0; nt < 4; ++nt) {
            const bf16x8_t sb0 = *(const LAS bf16x8_t*)(ldl + cm + (2 * nt) * 1024 + lane * 16), sb1 = *(const LAS bf16x8_t*)(ldl + cm + (2 * nt + 1) * 1024 + lane * 16);
#pragma unroll
            for (int rt = 0; rt < 2; ++rt) {
                const int ro = bo + B_Q + ((4 * nt) * 64 + 32 * rt + r32) * 16 + 8 * hi;
                QS[rt] = __builtin_amdgcn_mfma_f32_32x32x16_bf16(G3_LFRAG(ro), sb0, QS[rt], 0, 0, 0); QS[rt] = __builtin_amdgcn_mfma_f32_32x32x16_bf16(G3_LFRAG(ro + 2048), sb1, QS[rt], 0, 0, 0);
            }
        }
        {   const bf16x8_t vb00 = *(const LAS bf16x8_t*)(ldl + cm + CM_VB + lane * 16), vb01 = *(const LAS bf16x8_t*)(ldl + cm + CM_VB + 1024 + lane * 16);
            const bf16x8_t vb10 = *(const LAS bf16x8_t*)(ldl + cm + CM_VB + 2048 + lane * 16), vb11 = *(const LAS bf16x8_t*)(ldl + cm + CM_VB + 3072 + lane * 16);
            const LAS float* Es = (const LAS float*)(ldl + cm + CM_ES);
            const int a0 = bo + B_A + r32 * 16 + 8 * hi, a1 = a0 + 512;
            f32x16_t o0, o1;
#pragma unroll
            for (int r = 0; r < 16; ++r) { const int il = (r & 3) + 8 * (r >> 2) + 4 * hi; o0[r] = Es[il] * QS[0][r]; o1[r] = Es[32 + il] * QS[1][r]; }
            o0 = __builtin_amdgcn_mfma_f32_32x32x16_bf16(G3_LFRAG(a0), vb00, o0, 0, 0, 0); o0 = __builtin_amdgcn_mfma_f32_32x32x16_bf16(G3_LFRAG(a0 + 2048), vb01, o0, 0, 0, 0);
            o1 = __builtin_amdgcn_mfma_f32_32x32x16_bf16(G3_LFRAG(a1), vb00, o1, 0, 0, 0); o1 = __builtin_amdgcn_mfma_f32_32x32x16_bf16(G3_LFRAG(a1 + 2048), vb01, o1, 0, 0, 0);
            o1 = __builtin_amdgcn_mfma_f32_32x32x16_bf16(G3_LFRAG(a1 + 4096), vb10, o1, 0, 0, 0); o1 = __builtin_amdgcn_mfma_f32_32x32x16_bf16(G3_LFRAG(a1 + 6144), vb11, o1, 0, 0, 0);
#pragma unroll
            for (int r = 0; r < 16; ++r) { const int il = (r & 3) + 8 * (r >> 2) + 4 * hi; ot[il * 33 + r32] = o0[r]; ot[(32 + il) * 33 + r32] = o1[r]; }
        }
        LDS_WAIT();
        if (lane == 0) *(volatile LAS unsigned*)(ldw + O_FLAG + 4) = (unsigned)(c + 1);
        { const int t = dir ? SEQ - 1 - (64 * c + lane) : 64 * c + lane; float* orow = O + ((size_t)b * SEQ + t) * 1024 + hv * 128 + dvs * 32;
#pragma unroll
          for (int x = 0; x < 8; ++x) *(f32x4*)(orow + 4 * x) = (f32x4){ot[lane * 33 + 4 * x], ot[lane * 33 + 4 * x + 1], ot[lane * 33 + 4 * x + 2], ot[lane * 33 + 4 * x + 3]}; }
        LDS_WAIT();
    }
#undef G3B_DMA
}
#undef G3_LFRAG
}

__device__ __forceinline__ void ssd2_item(const Args& a, int item, unsigned char* lds) {
    const int ps = item & 1, h = (item >> 1) & 15, dir = (item >> 5) & 1, b = item >> 6, g = h >> 3;
    const int lane0 = threadIdx.x & 63;
    constexpr int BUFB = 40960, O_B = 0, O_C = 16384, O_X = 32768, O_XD = 2 * BUFB + 512, O_XW = O_XD + 64 * 72;
    float* Gs = (float*)(lds + 2 * BUFB); float* Es = Gs + 64; float* ot = (float*)(lds + O_XW + 64 * 72);
    const LAS unsigned char* ldl = (const LAS unsigned char*)lds;
    const bf16_t* XB = (const bf16_t*)(a.ws + WS_XBC16); const float* ACT = (const float*)(a.ws + WS_ACT); const float* SM = (const float*)(a.ws + WS_SMALL);
    float* Y = (float*)(a.ws + (dir ? WS_YB : WS_YF));
    const float A = -expf(a.in[dir ? 13 : 12][h]); const float dtb = a.in[dir ? 11 : 10][h];
    f32x16_t H[4];
#pragma unroll
    for (int nt = 0; nt < 4; ++nt)
#pragma unroll
        for (int r = 0; r < 16; ++r) H[nt][r] = 0.f;
    float gdr;
#define S2_DMA(c_, buf_) do { const int t_ = dir ? SEQ - 1 - (64 * (c_) + lane0) : 64 * (c_) + lane0; const size_t mi_ = (size_t)b * SEQ + t_; \
        const bf16_t* br_ = XB + mi_ * 1536 + 1024 + g * 128; const bf16_t* cr_ = XB + mi_ * 1536 + 1280 + g * 128; const float* xr_ = ACT + mi_ * 1536 + h * 64 + ps * 32; \
        LAS unsigned char* lb_ = (LAS unsigned char*)lds + (buf_) * BUFB; \
        _Pragma("unroll") for (int x = 0; x < 16; ++x) { __builtin_amdgcn_global_load_lds((const unsigned*)(br_ + 8 * x), (LAS unsigned*)(lb_ + O_B + 1024 * x), 16, 0, 0); \
                                                         __builtin_amdgcn_global_load_lds((const unsigned*)(cr_ + 8 * x), (LAS unsigned*)(lb_ + O_C + 1024 * x), 16, 0, 0); } \
        _Pragma("unroll") for (int x = 0; x < 8; ++x) __builtin_amdgcn_global_load_lds((const unsigned*)(xr_ + 4 * x), (LAS unsigned*)(lb_ + O_X + 1024 * x), 16, 0, 0); \
        gdr = SM[mi_ * 32 + dir * 16 + h]; } while (0)
    S2_DMA(0, 0);
    for (int c = 0; c < 32; ++c) {
        int lane = lane0; asm volatile("" : "+v"(lane));
        const int r32 = lane & 31, hi = lane >> 5, trq = (lane & 15) >> 2, trp = lane & 3, trc = (lane >> 4) & 1;
        const int bo = (c & 1) * BUFB;
        const float dt = softplus_f(gdr + dtb);
        const float cs = wave_incl_scan(dt * A, lane); const float csL = __shfl(cs, 63);
        Gs[lane] = cs; Es[lane] = __expf(cs);
        asm volatile("s_waitcnt vmcnt(0)" ::: "memory");
        if (c + 1 < 32) S2_DMA(c + 1, (c + 1) & 1);
        {
            const float wsc = dt * __expf(csL - cs);
#pragma unroll
            for (int x = 0; x < 8; ++x) { const f32x4 xv = *(const LAS f32x4*)(ldl + bo + O_X + (x * 64 + lane) * 16);
                v2u d; d.x = cvtpk_rne(xv.x * dt, xv.y * dt); d.y = cvtpk_rne(xv.z * dt, xv.w * dt); *(LAS v2u*)((LAS unsigned char*)lds + O_XD + lane * 72 + 8 * x) = d;
                v2u w; w.x = cvtpk_rne(xv.x * wsc, xv.y * wsc); w.y = cvtpk_rne(xv.z * wsc, xv.w * wsc); *(LAS v2u*)((LAS unsigned char*)lds + O_XW + lane * 72 + 8 * x) = w; }
        }
        LDS_WAIT();
        f32x16_t g00, g01, g11;
#pragma unroll
        for (int r = 0; r < 16; ++r) { g00[r] = 0.f; g01[r] = 0.f; g11[r] = 0.f; }
#pragma unroll
        for (int kk = 0; kk < 8; ++kk) { const int fo = ((2 * kk + hi) * 64 + r32) * 16;
            const bf16x8_t A0 = *(const LAS bf16x8_t*)(ldl + bo + O_B + fo), A1 = *(const LAS bf16x8_t*)(ldl + bo + O_B + fo + 512);
            const bf16x8_t B0 = *(const LAS bf16x8_t*)(ldl + bo + O_C + fo), B1 = *(const LAS bf16x8_t*)(ldl + bo + O_C + fo + 512);
            g00 = __builtin_amdgcn_mfma_f32_32x32x16_bf16(A0, B0, g00, 0, 0, 0); g01 = __builtin_amdgcn_mfma_f32_32x32x16_bf16(A0, B1, g01, 0, 0, 0); g11 = __builtin_amdgcn_mfma_f32_32x32x16_bf16(A1, B1, g11, 0, 0, 0); }
        {   const float cst0 = Gs[r32], cst1 = Gs[32 + r32];
#pragma unroll
            for (int r = 0; r < 16; ++r) { const int il = (r & 3) + 8 * (r >> 2) + 4 * hi; const float css0 = Gs[il], css1 = Gs[32 + il];
                g00[r] = (il <= r32) ? g00[r] * __expf(cst0 - css0) : 0.f; g01[r] = g01[r] * __expf(cst1 - css0); g11[r] = (il <= r32) ? g11[r] * __expf(cst1 - css1) : 0.f; } }
        asm volatile("" ::: "memory");
        f32x16_t y0, y1;
#pragma unroll
        for (int r = 0; r < 16; ++r) { y0[r] = 0.f; y1[r] = 0.f; }
#define TRFRAG(base_) ({ const s16x4_t lo_ = __builtin_bit_cast(s16x4_t, __builtin_amdgcn_ds_read_tr16_b64_v4i16((LAS s16x4_t*)(ldl + (base_)))); \
                         const s16x4_t hi_ = __builtin_bit_cast(s16x4_t, __builtin_amdgcn_ds_read_tr16_b64_v4i16((LAS s16x4_t*)(ldl + (base_) + 8 * 72))); \
                         (bf16x8_t){lo_[0], lo_[1], lo_[2], lo_[3], hi_[0], hi_[1], hi_[2], hi_[3]}; })
        {   const int xo = O_XD + (4 * hi + trq) * 72 + (16 * trc + 4 * trp) * 2;
            const bf16x8_t x0 = TRFRAG(xo), x1 = TRFRAG(xo + 16 * 72), x2 = TRFRAG(xo + 32 * 72), x3 = TRFRAG(xo + 48 * 72);
            y0 = __builtin_amdgcn_mfma_f32_32x32x16_bf16(acc_frag<0>(g00), x0, y0, 0, 0, 0); y0 = __builtin_amdgcn_mfma_f32_32x32x16_bf16(acc_frag<1>(g00), x1, y0, 0, 0, 0);
            y1 = __builtin_amdgcn_mfma_f32_32x32x16_bf16(acc_frag<0>(g01), x0, y1, 0, 0, 0); y1 = __builtin_amdgcn_mfma_f32_32x32x16_bf16(acc_frag<1>(g01), x1, y1, 0, 0, 0);
            y1 = __builtin_amdgcn_mfma_f32_32x32x16_bf16(acc_frag<0>(g11), x2, y1, 0, 0, 0); y1 = __builtin_amdgcn_mfma_f32_32x32x16_bf16(acc_frag<1>(g11), x3, y1, 0, 0, 0); }
        asm volatile("" ::: "memory");
        {   f32x16_t Z0, Z1;
#pragma unroll
            for (int r = 0; r < 16; ++r) { Z0[r] = 0.f; Z1[r] = 0.f; }
#define LFRAG(off_) join44(*(const LAS v2u*)(ldl + (off_)), *(const LAS v2u*)(ldl + (off_) + 1024))
#pragma unroll
            for (int nt = 0; nt < 4; ++nt) { const bf16x8_t hb0 = acc_frag<0>(H[nt]), hb1 = acc_frag<1>(H[nt]);
                const int ro = bo + O_C + ((4 * nt) * 64 + r32) * 16 + 8 * hi;
                Z0 = __builtin_amdgcn_mfma_f32_32x32x16_bf16(LFRAG(ro), hb0, Z0, 0, 0, 0); Z0 = __builtin_amdgcn_mfma_f32_32x32x16_bf16(LFRAG(ro + 2048), hb1, Z0, 0, 0, 0);
                Z1 = __builtin_amdgcn_mfma_f32_32x32x16_bf16(LFRAG(ro + 512), hb0, Z1, 0, 0, 0); Z1 = __builtin_amdgcn_mfma_f32_32x32x16_bf16(LFRAG(ro + 512 + 2048), hb1, Z1, 0, 0, 0); }
#undef LFRAG
#pragma unroll
            for (int r = 0; r < 16; ++r) { const int il = (r & 3) + 8 * (r >> 2) + 4 * hi; ot[il * 33 + r32] = fmaf(Es[il], Z0[r], y0[r]); ot[(32 + il) * 33 + r32] = fmaf(Es[32 + il], Z1[r], y1[r]); } }
        LDS_WAIT();
        { const int t = dir ? SEQ - 1 - (64 * c + lane) : 64 * c + lane; float* yrow = Y + ((size_t)b * SEQ + t) * 1024 + h * 64 + ps * 32;
#pragma unroll
          for (int x = 0; x < 8; ++x) *(f32x4*)(yrow + 4 * x) = (f32x4){ot[lane * 33 + 4 * x], ot[lane * 33 + 4 * x + 1], ot[lane * 33 + 4 * x + 2], ot[lane * 33 + 4 * x + 3]}; }
        asm volatile("" ::: "memory");
        {   const float eL = __expf(csL);
            const int xo = O_XW + (4 * hi + trq) * 72 + (16 * trc + 4 * trp) * 2;
            const bf16x8_t w0 = TRFRAG(xo), w1 = TRFRAG(xo + 16 * 72), w2 = TRFRAG(xo + 32 * 72), w3 = TRFRAG(xo + 48 * 72);
#undef TRFRAG
#pragma unroll
            for (int nt = 0; nt < 4; ++nt) {
#pragma unroll
                for (int r = 0; r < 16; ++r) H[nt][r] *= eL;
#pragma unroll
                for (int ks = 0; ks < 4; ++ks) {
                    const int ro = bo + O_B + ((4 * nt + 2 * trc + (trp >> 1)) * 64 + 16 * ks + 4 * hi + trq) * 16 + 8 * (trp & 1);
                    const s16x4_t lo = __builtin_bit_cast(s16x4_t, __builtin_amdgcn_ds_read_tr16_b64_v4i16((LAS s16x4_t*)(ldl + ro)));
                    const s16x4_t hi4 = __builtin_bit_cast(s16x4_t, __builtin_amdgcn_ds_read_tr16_b64_v4i16((LAS s16x4_t*)(ldl + ro + 8 * 16)));
                    const bf16x8_t bfr = (bf16x8_t){lo[0], lo[1], lo[2], lo[3], hi4[0], hi4[1], hi4[2], hi4[3]};
                    H[nt] = __builtin_amdgcn_mfma_f32_32x32x16_bf16(bfr, ks == 0 ? w0 : ks == 1 ? w1 : ks == 2 ? w2 : w3, H[nt], 0, 0, 0);
                }
            }
        }
        LDS_WAIT();
    }
#undef S2_DMA
}

namespace ssd3 {
constexpr int O_DT = 98304, O_XD = 98816, O_OUT = 108032, OUTB = 13312, OO_XW = 512, OO_Y = 512 + 4608, O_FLAG = 147968, O_END = 148224;
__device__ __forceinline__ void spin_ge(const LAS unsigned char* ldl, int off, unsigned target) {
    for (;;) { const unsigned v = __builtin_amdgcn_readfirstlane(*(volatile const LAS unsigned*)(ldl + off)); if (v >= target) break; __builtin_amdgcn_s_sleep(1); }
    asm volatile("" ::: "memory");
}
#define S3_TRFRAG(base_) ({ const s16x4_t lo_ = __builtin_bit_cast(s16x4_t, __builtin_amdgcn_ds_read_tr16_b64_v4i16((LAS s16x4_t*)(ldl + (base_)))); \
                            const s16x4_t hi_ = __builtin_bit_cast(s16x4_t, __builtin_amdgcn_ds_read_tr16_b64_v4i16((LAS s16x4_t*)(ldl + (base_) + 8 * 72))); \
                            (bf16x8_t){lo_[0], lo_[1], lo_[2], lo_[3], hi_[0], hi_[1], hi_[2], hi_[3]}; })
__device__ __forceinline__ void producer(const Args& a, int item, unsigned char* lds, int p) {
    const int ps = item & 1, h = (item >> 1) & 15, dir = (item >> 5) & 1, b = item >> 6, g = h >> 3;
    const int lane0 = threadIdx.x & 63;
    const LAS unsigned char* ldl = (const LAS unsigned char*)lds; LAS unsigned char* ldw = (LAS unsigned char*)lds;
    const bf16_t* XB = (const bf16_t*)(a.ws + WS_XBC16); const float* ACT = (const float*)(a.ws + WS_ACT); const float* SM = (const float*)(a.ws + WS_SMALL);
    const float A = -expf(a.in[dir ? 13 : 12][h]); const float dtb = a.in[dir ? 11 : 10][h];
#define S3_DMA(c_, slot3_) do { const int t_ = dir ? SEQ - 1 - (64 * (c_) + lane0) : 64 * (c_) + lane0; const size_t mi_ = (size_t)b * SEQ + t_; \
        const bf16_t* br_ = XB + mi_ * 1536 + 1024 + g * 128; const bf16_t* cr_ = XB + mi_ * 1536 + 1280 + g * 128; const float* xr_ = ACT + mi_ * 1536 + h * 64 + ps * 32; \
        LAS unsigned char* lb_ = ldw + (slot3_) * 32768; LAS unsigned char* lx_ = ldw + O_OUT + (slot3_) * OUTB + OO_Y; \
        _Pragma("unroll") for (int x = 0; x < 16; ++x) { __builtin_amdgcn_global_load_lds((const unsigned*)(br_ + 8 * x), (LAS unsigned*)(lb_ + 1024 * x), 16, 0, 0); \
                                                         __builtin_amdgcn_global_load_lds((const unsigned*)(cr_ + 8 * x), (LAS unsigned*)(lb_ + 16384 + 1024 * x), 16, 0, 0); } \
        _Pragma("unroll") for (int x = 0; x < 8; ++x) __builtin_amdgcn_global_load_lds((const unsigned*)(xr_ + 4 * x), (LAS unsigned*)(lx_ + 1024 * x), 16, 0, 0); \
        __builtin_amdgcn_global_load_lds((const unsigned*)(SM + mi_ * 32 + dir * 16 + h), (LAS unsigned*)(ldw + O_DT + p * 256), 4, 0, 0); } while (0)
    int slot3 = p;
    for (int c = p; c < 32; c += 2) {
        int lane = lane0; asm volatile("" : "+v"(lane));
        const int r32 = lane & 31, hi = lane >> 5, trq = (lane & 15) >> 2, trp = lane & 3, trc = (lane >> 4) & 1;
        const int bo = slot3 * 32768, oo = O_OUT + slot3 * OUTB;
        if (c >= 3) spin_ge(ldl, O_FLAG, (unsigned)(c - 2));
        S3_DMA(c, slot3);
        asm volatile("s_waitcnt vmcnt(0)" ::: "memory");
        LAS float* Gs = (LAS float*)(ldw + oo); LAS float* Es = Gs + 64;
        const float dt = softplus_f(*(const LAS float*)(ldl + O_DT + p * 256 + lane * 4) + dtb);
        const float cs = wave_incl_scan(dt * A, lane); const float csL = __shfl(cs, 63);
        Gs[lane] = cs; Es[lane] = __expf(cs);
        {   const float wsc = dt * __expf(csL - cs);
#pragma unroll
            for (int x = 0; x < 8; ++x) { const f32x4 xv = *(const LAS f32x4*)(ldl + oo + OO_Y + (x * 64 + lane) * 16);
                v2u d; d.x = cvtpk_rne(xv.x * dt, xv.y * dt); d.y = cvtpk_rne(xv.z * dt, xv.w * dt); *(LAS v2u*)(ldw + O_XD + p * 4608 + lane * 72 + 8 * x) = d;
                v2u w; w.x = cvtpk_rne(xv.x * wsc, xv.y * wsc); w.y = cvtpk_rne(xv.z * wsc, xv.w * wsc); *(LAS v2u*)(ldw + oo + OO_XW + lane * 72 + 8 * x) = w; }
        }
        LDS_WAIT();
        f32x16_t g00, g01, g11;
#pragma unroll
        for (int r = 0; r < 16; ++r) { g00[r] = 0.f; g01[r] = 0.f; g11[r] = 0.f; }
#pragma unroll
        for (int kk = 0; kk < 8; ++kk) { const int fo = ((2 * kk + hi) * 64 + r32) * 16;
            const bf16x8_t A0 = *(const LAS bf16x8_t*)(ldl + bo + fo), A1 = *(const LAS bf16x8_t*)(ldl + bo + fo + 512);
            const bf16x8_t B0 = *(const LAS bf16x8_t*)(ldl + bo + 16384 + fo), B1 = *(const LAS bf16x8_t*)(ldl + bo + 16384 + fo + 512);
            g00 = __builtin_amdgcn_mfma_f32_32x32x16_bf16(A0, B0, g00, 0, 0, 0); g01 = __builtin_amdgcn_mfma_f32_32x32x16_bf16(A0, B1, g01, 0, 0, 0); g11 = __builtin_amdgcn_mfma_f32_32x32x16_bf16(A1, B1, g11, 0, 0, 0); }
        {   const float cst0 = Gs[r32], cst1 = Gs[32 + r32];
#pragma unroll
            for (int r = 0; r < 16; ++r) { const int il = (r & 3) + 8 * (r >> 2) + 4 * hi; const float css0 = Gs[il], css1 = Gs[32 + il];
                g00[r] = (il <= r32) ? g00[r] * __expf(cst0 - css0) : 0.f; g01[r] = g01[r] * __expf(cst1 - css0); g11[r] = (il <= r32) ? g11[r] * __expf(cst1 - css1) : 0.f; } }
        asm volatile("" ::: "memory");
        f32x16_t y0, y1;
#pragma unroll
        for (int r = 0; r < 16; ++r) { y0[r] = 0.f; y1[r] = 0.f; }
        {   const int xo = O_XD + p * 4608 + (4 * hi + trq) * 72 + (16 * trc + 4 * trp) * 2;
            const bf16x8_t x0 = S3_TRFRAG(xo), x1 = S3_TRFRAG(xo + 16 * 72), x2 = S3_TRFRAG(xo + 32 * 72), x3 = S3_TRFRAG(xo + 48 * 72);
            y0 = __builtin_amdgcn_mfma_f32_32x32x16_bf16(acc_frag<0>(g00), x0, y0, 0, 0, 0); y0 = __builtin_amdgcn_mfma_f32_32x32x16_bf16(acc_frag<1>(g00), x1, y0, 0, 0, 0);
            y1 = __builtin_amdgcn_mfma_f32_32x32x16_bf16(acc_frag<0>(g01), x0, y1, 0, 0, 0); y1 = __builtin_amdgcn_mfma_f32_32x32x16_bf16(acc_frag<1>(g01), x1, y1, 0, 0, 0);
            y1 = __builtin_amdgcn_mfma_f32_32x32x16_bf16(acc_frag<0>(g11), x2, y1, 0, 0, 0); y1 = __builtin_amdgcn_mfma_f32_32x32x16_bf16(acc_frag<1>(g11), x3, y1, 0, 0, 0); }
#pragma unroll
        for (int r = 0; r < 16; ++r) { *(LAS float*)(ldw + oo + OO_Y + r * 256 + lane * 4) = y0[r]; *(LAS float*)(ldw + oo + OO_Y + (16 + r) * 256 + lane * 4) = y1[r]; }
        LDS_WAIT();
        if (lane == 0) *(volatile LAS unsigned*)(ldw + O_FLAG + 64 + 4 * c) = 1u;
        slot3 = (slot3 == 0) ? 2 : slot3 - 1;
    }
#undef S3_DMA
}
__device__ __forceinline__ void consumer(const Args& a, int item, unsigned char* lds) {
    const int ps = item & 1, h = (item >> 1) & 15, dir = (item >> 5) & 1, b = item >> 6;
    const int lane0 = threadIdx.x & 63;
    const LAS unsigned char* ldl = (const LAS unsigned char*)lds; LAS unsigned char* ldw = (LAS unsigned char*)lds;
    float* Y = (float*)(a.ws + (dir ? WS_YB : WS_YF));
    f32x16_t H[4];
#pragma unroll
    for (int nt = 0; nt < 4; ++nt)
#pragma unroll
        for (int r = 0; r < 16; ++r) H[nt][r] = 0.f;
    int slot3 = 0;
    for (int c = 0; c < 32; ++c) {
        int lane = lane0; asm volatile("" : "+v"(lane));
        const int r32 = lane & 31, hi = lane >> 5, trq = (lane & 15) >> 2, trp = lane & 3, trc = (lane >> 4) & 1;
        const int bo = slot3 * 32768, oo = O_OUT + slot3 * OUTB;
        const LAS float* Gs = (const LAS float*)(ldl + oo); const LAS float* Es = Gs + 64;
        spin_ge(ldl, O_FLAG + 64 + 4 * c, 1u);
        {   f32x16_t Z0, Z1;
#pragma unroll
            for (int r = 0; r < 16; ++r) { Z0[r] = 0.f; Z1[r] = 0.f; }
#define S3_LFRAG(off_) join44(*(const LAS v2u*)(ldl + (off_)), *(const LAS v2u*)(ldl + (off_) + 1024))
#pragma unroll
            for (int nt = 0; nt < 4; ++nt) { const bf16x8_t hb0 = acc_frag<0>(H[nt]), hb1 = acc_frag<1>(H[nt]);
                const int ro = bo + 16384 + ((4 * nt) * 64 + r32) * 16 + 8 * hi;
                Z0 = __builtin_amdgcn_mfma_f32_32x32x16_bf16(S3_LFRAG(ro), hb0, Z0, 0, 0, 0); Z0 = __builtin_amdgcn_mfma_f32_32x32x16_bf16(S3_LFRAG(ro + 2048), hb1, Z0, 0, 0, 0);
                Z1 = __builtin_amdgcn_mfma_f32_32x32x16_bf16(S3_LFRAG(ro + 512), hb0, Z1, 0, 0, 0); Z1 = __builtin_amdgcn_mfma_f32_32x32x16_bf16(S3_LFRAG(ro + 512 + 2048), hb1, Z1, 0, 0, 0); }
#undef S3_LFRAG
            const int tb = dir ? SEQ - 1 - (64 * c + 4 * hi) : 64 * c + 4 * hi;
            float* yb = Y + ((size_t)b * SEQ + tb) * 1024 + h * 64 + ps * 32 + r32;
#pragma unroll
            for (int r = 0; r < 16; ++r) { const int il0 = (r & 3) + 8 * (r >> 2), il = il0 + 4 * hi;
                const float yd0 = *(const LAS float*)(ldl + oo + OO_Y + r * 256 + lane * 4), yd1 = *(const LAS float*)(ldl + oo + OO_Y + (16 + r) * 256 + lane * 4);
                const long ro0 = dir ? -(long)il0 * 1024 : (long)il0 * 1024, ro1 = dir ? -(long)(il0 + 32) * 1024 : (long)(il0 + 32) * 1024;
                yb[ro0] = fmaf(Es[il], Z0[r], yd0); yb[ro1] = fmaf(Es[32 + il], Z1[r], yd1); } }
        asm volatile("" ::: "memory");
        {   const float eL = __expf(Gs[63]);
            const int xo = oo + OO_XW + (4 * hi + trq) * 72 + (16 * trc + 4 * trp) * 2;
            const bf16x8_t w0 = S3_TRFRAG(xo), w1 = S3_TRFRAG(xo + 16 * 72), w2 = S3_TRFRAG(xo + 32 * 72), w3 = S3_TRFRAG(xo + 48 * 72);
#pragma unroll
            for (int nt = 0; nt < 4; ++nt) {
#pragma unroll
                for (int r = 0; r < 16; ++r) H[nt][r] *= eL;
#pragma unroll
                for (int ks = 0; ks < 4; ++ks) {
                    const int ro = bo + ((4 * nt + 2 * trc + (trp >> 1)) * 64 + 16 * ks + 4 * hi + trq) * 16 + 8 * (trp & 1);
                    const s16x4_t lo = __builtin_bit_cast(s16x4_t, __builtin_amdgcn_ds_read_tr16_b64_v4i16((LAS s16x4_t*)(ldl + ro)));
                    const s16x4_t hi4 = __builtin_bit_cast(s16x4_t, __builtin_amdgcn_ds_read_tr16_b64_v4i16((LAS s16x4_t*)(ldl + ro + 8 * 16)));
                    const bf16x8_t bfr = (bf16x8_t){lo[0], lo[1], lo[2], lo[3], hi4[0], hi4[1], hi4[2], hi4[3]};
                    H[nt] = __builtin_amdgcn_mfma_f32_32x32x16_bf16(bfr, ks == 0 ? w0 : ks == 1 ? w1 : ks == 2 ? w2 : w3, H[nt], 0, 0, 0);
                }
            }
        }
        LDS_WAIT();
        if (lane == 0) *(volatile LAS unsigned*)(ldw + O_FLAG) = (unsigned)(c + 1);
        slot3 = (slot3 == 2) ? 0 : slot3 + 1;
    }
}
#undef S3_TRFRAG
}

__device__ __forceinline__ void lru_tile(const Args& a, int item, unsigned char* lds, int pass) {
    const int n = item & 7, tc = (item >> 3) & 63, b = item >> 9, t0 = tc * 32;
    float* xc = (float*)lds; bf16_t* xcb = (bf16_t*)(lds + 16384); float* As = (float*)(lds + 25088); float* Us = As + 2 * 32 * 128; float2* sg = (float2*)(Us + 2 * 32 * 128);
    const int tid = threadIdx.x, lane = tid & 63, wave = tid >> 6;
    const bf16_t* P = (const bf16_t*)(a.ws + WS_PROJ);
    __syncthreads();
    {
        const int j = tid & 127, tg = tid >> 7, chn = n * 128 + j; const float* cw = a.in[25];
        const float w0 = cw[chn], w1 = cw[1024 + chn], w2 = cw[2048 + chn], w3 = cw[3072 + chn], cbias = a.in[26][chn];
        const int tb = t0 + tg * 8;
        const bf16_t* pp = P + ((size_t)b * SEQ + tb) * NINP + C_XL + chn;
        float xm2 = (tb >= 2) ? bf2f(pp[-2 * NINP]) : 0.f, xm1 = (tb >= 1) ? bf2f(pp[-NINP]) : 0.f, x0 = bf2f(pp[0]);
#pragma unroll
        for (int i = 0; i < 8; ++i) { const float xp1 = (tb + i + 1 < SEQ) ? bf2f(pp[(i + 1) * NINP]) : 0.f;
            const float acc = cbias + w0 * xm2 + w1 * xm1 + w2 * x0 + w3 * xp1;
            xc[(tg * 8 + i) * 128 + j] = acc; xcb[(tg * 8 + i) * 136 + j] = (bf16_t)f2bf(acc);
            xm2 = xm1; xm1 = x0; x0 = xp1; }
    }
    __syncthreads();
    {
        const int ct = wave & 3, d = wave >> 2, r32 = lane & 31, hi = lane >> 5;
        const bf16_t* WT = (const bf16_t*)(a.ws + WS_WGT);
        const bf16_t* wa_p = WT + ((size_t)((2 * d) * 8 + n) * 128 + ct * 32 + r32) * 128 + hi * 8;
        const bf16_t* wx_p = WT + ((size_t)((2 * d + 1) * 8 + n) * 128 + ct * 32 + r32) * 128 + hi * 8;
        f32x16_t ca, cx;
#pragma unroll
        for (int r = 0; r < 16; ++r) { ca[r] = 0.f; cx[r] = 0.f; }
#pragma unroll
        for (int s = 0; s < 8; ++s) {
            const bf16x8_t af = *(const bf16x8_t*)((const char*)xcb + r32 * 272 + (s * 16 + hi * 8) * 2);
            const bf16x8_t fa = *(const bf16x8_t*)(wa_p + s * 16); const bf16x8_t fx = *(const bf16x8_t*)(wx_p + s * 16);
            ca = __builtin_amdgcn_mfma_f32_32x32x16_bf16(af, fa, ca, 0, 0, 0); cx = __builtin_amdgcn_mfma_f32_32x32x16_bf16(af, fx, cx, 0, 0, 0);
        }
        const int j = ct * 32 + r32, cj = n * 128 + j;
        const float baj = a.in[d ? 33 : 28][cj], bxj = a.in[d ? 35 : 30][cj], sp = softplus_f(-a.in[d ? 36 : 31][cj]);
#pragma unroll
        for (int r = 0; r < 16; ++r) { const int t = (r & 3) + 8 * (r >> 2) + 4 * hi;
            const float rg = __builtin_amdgcn_rcpf(1.f + __expf(-(ca[r] + baj))), ig = __builtin_amdgcn_rcpf(1.f + __expf(-(cx[r] + bxj))); const float la = -8.f * rg * sp;
            const float av = __expf(la);
            const float om = (la > -0.0625f) ? -2.f * la * (1.f + la * (1.f + la * (0.6666667f + 0.3333333f * la))) : (1.f - av) * (1.f + av);
            As[(d * 32 + t) * 128 + j] = av; Us[(d * 32 + t) * 128 + j] = __builtin_amdgcn_sqrtf(om) * (ig * xc[t * 128 + j]); }
    }
    __syncthreads();
    {
        const int j = tid & 127, d = (tid >> 7) & 1, seg = tid >> 8;
        float Pp = 1.f, H = 0.f;
#pragma unroll
        for (int k = 0; k < 16; ++k) { const int q = seg * 16 + k, t = d ? 31 - q : q; const float a_ = As[(d * 32 + t) * 128 + j], u_ = Us[(d * 32 + t) * 128 + j]; H = fmaf(a_, H, u_); Pp *= a_; }
        sg[(d * 2 + seg) * 128 + j] = make_float2(Pp, H);
        __syncthreads();
        float2* LS = (float2*)(a.ws + WS_LSUM);
        if (pass == 0) {
            if (seg == 0) { const float2 s1 = sg[(d * 2 + 1) * 128 + j]; LS[((size_t)(d * 4 + b) * 64 + tc) * 1024 + n * 128 + j] = make_float2(Pp * s1.x, fmaf(s1.x, H, s1.y)); }
        } else {
            float c = 0.f;
            const float2* lsp = LS + ((size_t)(d * 4 + b) * 64) * 1024 + n * 128 + j;
#pragma unroll 1
            for (int c0 = 0; c0 < 64; c0 += 16) { float2 sv[16];
#pragma unroll
                for (int i = 0; i < 16; ++i) { const int cc = d ? 63 - (c0 + i) : c0 + i; sv[i] = lsp[(size_t)cc * 1024]; }
#pragma unroll
                for (int i = 0; i < 16; ++i) { const int cc = d ? 63 - (c0 + i) : c0 + i; const bool before = d ? (cc > tc) : (cc < tc); if (before) c = fmaf(sv[i].x, c, sv[i].y); } }
            if (seg == 1) { const float2 s0 = sg[(d * 2) * 128 + j]; c = fmaf(s0.x, c, s0.y); }
            float h = c;
#pragma unroll
            for (int k = 0; k < 16; ++k) { const int q = seg * 16 + k, t = d ? 31 - q : q; const float a_ = As[(d * 32 + t) * 128 + j], u_ = Us[(d * 32 + t) * 128 + j]; h = fmaf(a_, h, u_); Us[(d * 32 + t) * 128 + j] = h; }
            __syncthreads();
            bf16_t* YC = (bf16_t*)(a.ws + WS_YCAT);
            const int jj = tid & 127, tg = tid >> 7;
#pragma unroll
            for (int i = 0; i < 8; ++i) { const int t = tg * 8 + i; const size_t row = (size_t)b * SEQ + t0 + t;
                const float hs = Us[t * 128 + jj] + Us[(32 + t) * 128 + jj]; const float gl = bf2f(P[row * NINP + C_GL + n * 128 + jj]);
                YC[row * 2048 + 1024 + n * 128 + jj] = (bf16_t)f2bf(hs * silu_f(gl)); }
        }
    }
}

template <bool FINAL>
__device__ __forceinline__ void lru_wave(const Args& a, int witem, unsigned char* ldsw, int lane) {
    asm volatile("" : "+v"(lane));
    const int n = witem & 7, tc = (witem >> 3) & 63, b = witem >> 9, t0 = tc * 32;
    const int r32 = lane & 31, hi = lane >> 5;
    bf16_t* xcb = (bf16_t*)ldsw;
    const bf16_t* P = (const bf16_t*)(a.ws + WS_PROJ);
    bf16_t* XC = (bf16_t*)(a.ws + WS_XC16) + ((size_t)b * SEQ + t0) * 1024 + n * 128;
    if constexpr (!FINAL) {
        const int chn = n * 128 + 2 * lane; const float* cw = a.in[25];
        const f32x2 w0 = *(const f32x2*)(cw + chn), w1 = *(const f32x2*)(cw + 1024 + chn), w2 = *(const f32x2*)(cw + 2048 + chn), w3 = *(const f32x2*)(cw + 3072 + chn), cb2 = *(const f32x2*)(a.in[26] + chn);
        const bf16_t* pp = P + ((size_t)b * SEQ + t0) * NINP + C_XL + chn;
        f32x2 xm2 = {0.f, 0.f}, xm1 = {0.f, 0.f}, x0;
        if (t0 >= 2) { const unsigned v = *(const unsigned*)(pp - 2 * NINP); xm2 = (f32x2){bf2f(v & 0xffffu), __uint_as_float(v & 0xffff0000u)}; }
        if (t0 >= 1) { const unsigned v = *(const unsigned*)(pp - NINP); xm1 = (f32x2){bf2f(v & 0xffffu), __uint_as_float(v & 0xffff0000u)}; }
        { const unsigned v = *(const unsigned*)pp; x0 = (f32x2){bf2f(v & 0xffffu), __uint_as_float(v & 0xffff0000u)}; }
#pragma unroll 8
        for (int i = 0; i < 32; ++i) { f32x2 xp1 = {0.f, 0.f};
            if (t0 + i + 1 < SEQ) { const unsigned v = *(const unsigned*)(pp + (size_t)(i + 1) * NINP); xp1 = (f32x2){bf2f(v & 0xffffu), __uint_as_float(v & 0xffff0000u)}; }
            const f32x2 acc = cb2 + w0 * xm2 + w1 * xm1 + w2 * x0 + w3 * xp1;
            const unsigned pk = pk2(acc.x, acc.y);
            *(unsigned*)(xcb + i * 136 + 2 * lane) = pk; *(unsigned*)(XC + (size_t)i * 1024 + 2 * lane) = pk;
            xm2 = xm1; xm1 = x0; x0 = xp1; }
        LDS_WAIT();
    }
    const bf16_t* WT = (const bf16_t*)(a.ws + WS_WGT);
    float2* LS = (float2*)(a.ws + WS_LSUM);
    const bf16_t* xcr = XC + (size_t)r32 * 1024 + hi * 8;
#pragma unroll 1
    for (int ct = 0; ct < 4; ++ct) {
    const int j = ct * 32 + r32, cj = n * 128 + j;
    float xv[16];
#pragma unroll
    for (int r = 0; r < 16; ++r) { const int t = (r & 3) + 8 * (r >> 2) + 4 * hi; xv[r] = bf2f(FINAL ? XC[(size_t)t * 1024 + j] : xcb[t * 136 + j]); }
    float hs[16];
#pragma unroll
    for (int d = 0; d < 2; ++d) {
        const bf16_t* wa_p = WT + ((size_t)((2 * d) * 8 + n) * 128 + j) * 128 + hi * 8;
        const bf16_t* wx_p = WT + ((size_t)((2 * d + 1) * 8 + n) * 128 + j) * 128 + hi * 8;
        f32x16_t ca, cx;
#pragma unroll
        for (int r = 0; r < 16; ++r) { ca[r] = 0.f; cx[r] = 0.f; }
#pragma unroll
        for (int s = 0; s < 8; ++s) {
            const bf16x8_t af = FINAL ? *(const bf16x8_t*)(xcr + s * 16) : *(const bf16x8_t*)((const char*)xcb + r32 * 272 + (s * 16 + hi * 8) * 2);
            const bf16x8_t fa = *(const bf16x8_t*)(wa_p + s * 16); const bf16x8_t fx = *(const bf16x8_t*)(wx_p + s * 16);
            ca = __builtin_amdgcn_mfma_f32_32x32x16_bf16(af, fa, ca, 0, 0, 0); cx = __builtin_amdgcn_mfma_f32_32x32x16_bf16(af, fx, cx, 0, 0, 0);
        }
        asm volatile("" ::: "memory");
        const float baj = a.in[d ? 33 : 28][cj], bxj = a.in[d ? 35 : 30][cj], sp = softplus_f(-a.in[d ? 36 : 31][cj]);
        float av[16], uv[16];
#pragma unroll
        for (int r = 0; r < 16; ++r) { const int t = (r & 3) + 8 * (r >> 2) + 4 * hi;
            const float rg = __builtin_amdgcn_rcpf(1.f + __expf(-(ca[r] + baj))), ig = __builtin_amdgcn_rcpf(1.f + __expf(-(cx[r] + bxj))); const float la = -8.f * rg * sp;
            av[r] = __expf(la);
            const float om = (la > -0.0625f) ? -2.f * la * (1.f + la * (1.f + la * (0.6666667f + 0.3333333f * la))) : (1.f - av[r]) * (1.f + av[r]);
            uv[r] = __builtin_amdgcn_sqrtf(om) * (ig * xv[r]); }
        asm volatile("" ::: "memory");
        float Pg[4], Hg[4];
#pragma unroll
        for (int sg = 0; sg < 4; ++sg) { float Pp = 1.f, Hh = 0.f;
#pragma unroll
            for (int e4 = 0; e4 < 4; ++e4) { const int r = 4 * sg + (d ? 3 - e4 : e4); Hh = fmaf(av[r], Hh, uv[r]); Pp *= av[r]; }
            Pg[sg] = Pp; Hg[sg] = Hh; }
        float Po[4], Ho[4];
#pragma unroll
        for (int sg = 0; sg < 4; ++sg) { Po[sg] = __shfl_xor(Pg[sg], 32); Ho[sg] = __shfl_xor(Hg[sg], 32); }
        if constexpr (!FINAL) {
            float Ac = 1.f, Hc = 0.f;
#pragma unroll
            for (int qq = 0; qq < 8; ++qq) { const int q = d ? 7 - qq : qq;
                const bool mine = ((q & 1) == hi); const float pq = mine ? Pg[q >> 1] : Po[q >> 1], hq_ = mine ? Hg[q >> 1] : Ho[q >> 1];
                Hc = fmaf(pq, Hc, hq_); Ac *= pq; }
            if (hi == 0) LS[((size_t)(d * 4 + b) * 64 + tc) * 1024 + cj] = make_float2(Ac, Hc);
        } else {
            float c = 0.f;
            const float2* lsp = LS + ((size_t)(d * 4 + b) * 64) * 1024 + cj;
            const int nneed = d ? 63 - tc : tc;
#pragma unroll 1
            for (int c0 = 0; c0 < nneed; c0 += 16) { float2 sv[16];
#pragma unroll
                for (int i = 0; i < 16; ++i) { const int ci = (c0 + i < nneed) ? c0 + i : nneed - 1; const int cc = d ? 63 - ci : ci; sv[i] = lsp[(size_t)cc * 1024]; }
#pragma unroll
                for (int i = 0; i < 16; ++i) { if (c0 + i < nneed) c = fmaf(sv[i].x, c, sv[i].y); } }
            asm volatile("" ::: "memory");
            float cin[4];
#pragma unroll
            for (int qq = 0; qq < 8; ++qq) { const int q = d ? 7 - qq : qq;
                const bool mine = ((q & 1) == hi); const float pq = mine ? Pg[q >> 1] : Po[q >> 1], hq_ = mine ? Hg[q >> 1] : Ho[q >> 1];
                if (mine) cin[q >> 1] = c;
                c = fmaf(pq, c, hq_); }
#pragma unroll
            for (int sg = 0; sg < 4; ++sg) { float h = cin[sg];
#pragma unroll
                for (int e4 = 0; e4 < 4; ++e4) { const int r = 4 * sg + (d ? 3 - e4 : e4); h = fmaf(av[r], h, uv[r]); hs[r] = (d == 0) ? h : hs[r] + h; } }
        }
    }
    if constexpr (FINAL) {
        bf16_t* YC = (bf16_t*)(a.ws + WS_YCAT);
#pragma unroll
        for (int r = 0; r < 16; ++r) { const int t = (r & 3) + 8 * (r >> 2) + 4 * hi; const size_t row = (size_t)b * SEQ + t0 + t;
            const float gl = bf2f(P[row * NINP + C_GL + cj]);
            YC[row * 2048 + 1024 + cj] = (bf16_t)f2bf(hs[r] * silu_f(gl)); }
    }
    }
    LDS_WAIT();
}

template <int d>
__device__ __forceinline__ void lru_run(const Args& a, int task, int lane) {
    asm volatile("" : "+v"(lane));
    const int run = task & 7, ct = (task >> 4) & 3, n = (task >> 6) & 7, b = task >> 9;
    const int r32 = lane & 31, hi = lane >> 5, j = ct * 32 + r32, cj = n * 128 + j;
    const bf16_t* WT = (const bf16_t*)(a.ws + WS_WGT);
    const bf16_t* wa_p = WT + ((size_t)((2 * d) * 8 + n) * 128 + j) * 128 + hi * 8;
    const bf16_t* wx_p = WT + ((size_t)((2 * d + 1) * 8 + n) * 128 + j) * 128 + hi * 8;
    bf16x8_t fa[8], fx[8];
#pragma unroll
    for (int s = 0; s < 8; ++s) { fa[s] = *(const bf16x8_t*)(wa_p + s * 16); fx[s] = *(const bf16x8_t*)(wx_p + s * 16); }
    const float baj = a.in[d ? 33 : 28][cj], bxj = a.in[d ? 35 : 30][cj], sp = softplus_f(-a.in[d ? 36 : 31][cj]);
    const float2* lsp = (const float2*)(a.ws + WS_LSUM) + ((size_t)(d * 4 + b) * 64) * 1024 + cj;
    bf16_t* HD = (bf16_t*)(a.ws + (d ? WS_HB16 : WS_HF16));
    float c = 0.f;
    { const int nneed = 8 * run;
#pragma unroll 1
      for (int c0 = 0; c0 < nneed; c0 += 8) { float2 sv[8];
#pragma unroll
          for (int i = 0; i < 8; ++i) { const int ci = c0 + i; const int cc = d ? 63 - ci : ci; sv[i] = lsp[(size_t)cc * 1024]; }
#pragma unroll
          for (int i = 0; i < 8; ++i) c = fmaf(sv[i].x, c, sv[i].y); } }
#pragma unroll 1
    for (int k = 0; k < 8; ++k) {
        const int ci = 8 * run + k, tc = d ? 63 - ci : ci, t0 = tc * 32;
        const bf16_t* XC = (const bf16_t*)(a.ws + WS_XC16) + ((size_t)b * SEQ + t0) * 1024 + n * 128;
        const bf16_t* xcr = XC + (size_t)r32 * 1024 + hi * 8;
        f32x16_t ca, cx;
#pragma unroll
        for (int r = 0; r < 16; ++r) { ca[r] = 0.f; cx[r] = 0.f; }
#pragma unroll
        for (int s = 0; s < 8; ++s) { const bf16x8_t af = *(const bf16x8_t*)(xcr + s * 16);
            ca = __builtin_amdgcn_mfma_f32_32x32x16_bf16(af, fa[s], ca, 0, 0, 0); cx = __builtin_amdgcn_mfma_f32_32x32x16_bf16(af, fx[s], cx, 0, 0, 0); }
        float av[16], uv[16];
#pragma unroll
        for (int r = 0; r < 16; ++r) { const int t = (r & 3) + 8 * (r >> 2) + 4 * hi;
            const float xvr = bf2f(XC[(size_t)t * 1024 + j]);
            const float rg = __builtin_amdgcn_rcpf(1.f + __expf(-(ca[r] + baj))), ig = __builtin_amdgcn_rcpf(1.f + __expf(-(cx[r] + bxj))); const float la = -8.f * rg * sp;
            av[r] = __expf(la);
            const float om = (la > -0.0625f) ? -2.f * la * (1.f + la * (1.f + la * (0.6666667f + 0.3333333f * la))) : (1.f - av[r]) * (1.f + av[r]);
            uv[r] = __builtin_amdgcn_sqrtf(om) * (ig * xvr); }
        float Pg[4], Hg[4];
#pragma unroll
        for (int sg = 0; sg < 4; ++sg) { float Pp = 1.f, Hh = 0.f;
#pragma unroll
            for (int e4 = 0; e4 < 4; ++e4) { const int r = 4 * sg + (d ? 3 - e4 : e4); Hh = fmaf(av[r], Hh, uv[r]); Pp *= av[r]; }
            Pg[sg] = Pp; Hg[sg] = Hh; }
        float Po[4], Ho[4];
#pragma unroll
        for (int sg = 0; sg < 4; ++sg) { Po[sg] = __shfl_xor(Pg[sg], 32); Ho[sg] = __shfl_xor(Hg[sg], 32); }
        float cin[4];
#pragma unroll
        for (int qq = 0; qq < 8; ++qq) { const int q = d ? 7 - qq : qq;
            const bool mine = ((q & 1) == hi); const float pq = mine ? Pg[q >> 1] : Po[q >> 1], hq_ = mine ? Hg[q >> 1] : Ho[q >> 1];
            if (mine) cin[q >> 1] = c;
            c = fmaf(pq, c, hq_); }
#pragma unroll
        for (int sg = 0; sg < 4; ++sg) { float h = cin[sg];
#pragma unroll
            for (int e4 = 0; e4 < 4; ++e4) { const int r = 4 * sg + (d ? 3 - e4 : e4); const int t = (r & 3) + 8 * (r >> 2) + 4 * hi;
                h = fmaf(av[r], h, uv[r]); HD[((size_t)b * SEQ + t0 + t) * 1024 + cj] = (bf16_t)f2bf(h); } }
    }
}

__device__ __forceinline__ void combine1_phase(const Args& a, int gw, int NGW, int lane) {
    const float* OF = (const float*)(a.ws + WS_YF); const float* OB = (const float*)(a.ws + WS_YB);
    const bf16_t* P = (const bf16_t*)(a.ws + WS_PROJ); bf16_t* YC = (bf16_t*)(a.ws + WS_YCAT);
    const float* gn = a.in[24];
    for (int m = gw; m < MTOK; m += NGW) {
        const int ch = lane * 16, d0 = ch & 127;
        float z[16], ov[16];
        unpack8(*(const v4u*)(P + (size_t)m * NINP + C_Z + ch), z); unpack8(*(const v4u*)(P + (size_t)m * NINP + C_Z + ch + 8), z + 8);
#pragma unroll
        for (int q = 0; q < 4; ++q) { const f32x4 f = *(const f32x4*)(OF + (size_t)m * 1024 + ch + 4 * q), bk = *(const f32x4*)(OB + (size_t)m * 1024 + ch + 4 * q); const f32x4 o = f + bk;
            ov[4 * q] = o.x; ov[4 * q + 1] = o.y; ov[4 * q + 2] = o.z; ov[4 * q + 3] = o.w; }
        float ss = 0.f;
#pragma unroll
        for (int i = 0; i < 16; ++i) ss += ov[i] * ov[i];
        ss = group_sum<8>(ss);
        const float r = rsqrtf(ss * (1.f / 128.f) + EPS);
#pragma unroll
        for (int i = 0; i < 16; ++i) ov[i] = ov[i] * r * gn[d0 + i] * silu_f(z[i]);
        *(v4u*)(YC + (size_t)m * 2048 + ch) = pack8(ov); *(v4u*)(YC + (size_t)m * 2048 + ch + 8) = pack8(ov + 8);
        { const bf16_t* HF = (const bf16_t*)(a.ws + WS_HF16); const bf16_t* HB = (const bf16_t*)(a.ws + WS_HB16);
          float hf[16], hb[16];
          unpack8(*(const v4u*)(P + (size_t)m * NINP + C_GL + ch), z); unpack8(*(const v4u*)(P + (size_t)m * NINP + C_GL + ch + 8), z + 8);
          unpack8(*(const v4u*)(HF + (size_t)m * 1024 + ch), hf); unpack8(*(const v4u*)(HF + (size_t)m * 1024 + ch + 8), hf + 8);
          unpack8(*(const v4u*)(HB + (size_t)m * 1024 + ch), hb); unpack8(*(const v4u*)(HB + (size_t)m * 1024 + ch + 8), hb + 8);
#pragma unroll
          for (int i = 0; i < 16; ++i) ov[i] = (hf[i] + hb[i]) * silu_f(z[i]);
          *(v4u*)(YC + (size_t)m * 2048 + 1024 + ch) = pack8(ov); *(v4u*)(YC + (size_t)m * 2048 + 1024 + ch + 8) = pack8(ov + 8); }
    }
}

__device__ __forceinline__ void final_norm_phase(const Args& a, int gw, int NGW, int lane) {
    const float* nw = a.in[38];
    for (int m = gw; m < MTOK; m += NGW) {
        f32x4* xr = (f32x4*)(a.out + (size_t)m * 2048) + lane;
        f32x4 v[8]; float s = 0.f;
#pragma unroll
        for (int j = 0; j < 8; ++j) { v[j] = xr[64 * j]; s += (v[j].x * v[j].x + v[j].y * v[j].y) + (v[j].z * v[j].z + v[j].w * v[j].w); }
        const float rstd = rsqrtf(group_sum<64>(s) * (1.f / 2048.f) + EPS);
#pragma unroll
        for (int j = 0; j < 8; ++j) { const f32x4 w = *(const f32x4*)(nw + (64 * j + lane) * 4); xr[64 * j] = v[j] * rstd * w; }
    }
}

typedef GAS unsigned gu32;
#define RLX_AGENT __ATOMIC_RELAXED, __HIP_MEMORY_SCOPE_AGENT
constexpr int CW_BAR = 4096;
constexpr int MISC_OFF = 163840 - 128;
#define XB_TMO      128
#define XB_XCNT(j)  (256  + 64 * (j))
#define XB_XSUB(j)  (1280 + 64 * (j))
#define XB_XGEN(j)  (2304 + 64 * (j))
#define XB_TOP      3328
#define XB_TOPGEN   3392
#define XCD_BAR_WORDS 3456
#define XB_SPIN_CAP (1u << 18)

__device__ __forceinline__ unsigned xb_ld(unsigned* p)              { return __hip_atomic_load(p, __ATOMIC_RELAXED, __HIP_MEMORY_SCOPE_AGENT); }
__device__ __forceinline__ unsigned xb_add(unsigned* p, unsigned v) { return __hip_atomic_fetch_add(p, v, __ATOMIC_RELAXED, __HIP_MEMORY_SCOPE_AGENT); }
__device__ __forceinline__ unsigned xb_xcc_id() { return (unsigned)__builtin_amdgcn_s_getreg((3 << 11) | 20) & 0xFu; }
#define XB_SPIN(cond, bar) do { unsigned _sp = 0; while (cond) { __builtin_amdgcn_s_sleep(1); \
    if ((++_sp & 255u) == 0u) { if (xb_ld(&(bar)[XB_TMO])) break; if (_sp > XB_SPIN_CAP) { atomicAdd(&(bar)[XB_TMO], 1u); break; } } } } while (0)

struct XcdBarrier {
    unsigned* bar; unsigned x;
    volatile LAS unsigned* st;
};

__device__ __forceinline__ XcdBarrier xcd_barrier_post(unsigned* bar, volatile LAS unsigned* st) {
    XcdBarrier b; b.bar = bar; b.x = xb_xcc_id(); b.st = st;
    if (threadIdx.x == 0) (void)xb_add(&bar[XB_XCNT(b.x)], 1u);
    return b;
}
__device__ __forceinline__ void xcd_barrier_complete(unsigned* bar, unsigned x, unsigned& nloc, unsigned& nx) {
    const unsigned G = gridDim.x * gridDim.y * gridDim.z;
    unsigned sum, cnt, mine, sp = 0u;
    for (;;) {
        sum = 0u; cnt = 0u; mine = 0u;
#pragma unroll
        for (unsigned j = 0; j < 16; ++j) { const unsigned c = xb_ld(&bar[XB_XCNT(j)]); sum += c; cnt += (c > 0u) ? 1u : 0u; mine = (j == x) ? c : mine; }
        if (sum == G) break;
        __builtin_amdgcn_s_sleep(1);
        if ((++sp & 255u) == 0u) { if (xb_ld(&bar[XB_TMO])) break; if (sp > XB_SPIN_CAP) { atomicAdd(&bar[XB_TMO], 1u); break; } }
    }
    nloc = mine > 0u ? mine : 1u; nx = cnt > 0u ? cnt : 1u;
}

__device__ __forceinline__ void xcd_barrier(const XcdBarrier& b) {
    asm volatile("s_waitcnt vmcnt(0)" ::: "memory");
    __syncthreads();
    if (threadIdx.x == 0) {
        unsigned* bar = b.bar;
        __builtin_amdgcn_s_waitcnt(0);
        unsigned nloc = b.st[0], nx = b.st[1];
        if (nloc == 0u) { xcd_barrier_complete(bar, b.x, nloc, nx); b.st[0] = nloc; b.st[1] = nx; }
        const unsigned old = xb_add(&bar[XB_XSUB(b.x)], 1u);
        const unsigned gen = old / nloc;
        if (old + 1u == (gen + 1u) * nloc) {
            __builtin_amdgcn_fence(__ATOMIC_RELEASE, "agent");
            asm volatile("s_waitcnt vmcnt(0)" ::: "memory");
            const unsigned og = xb_add(&bar[XB_TOP], 1u);
            const unsigned tg = og / nx;
            if (og + 1u == (tg + 1u) * nx) xb_add(&bar[XB_TOPGEN], 1u);
            else XB_SPIN(xb_ld(&bar[XB_TOPGEN]) == tg, bar);
            __builtin_amdgcn_fence(__ATOMIC_ACQUIRE, "agent");
            xb_add(&bar[XB_XGEN(b.x)], 1u);
            asm volatile("s_waitcnt vmcnt(0)" ::: "memory");
        } else {
            XB_SPIN(xb_ld(&bar[XB_XGEN(b.x)]) == gen, bar);
            __builtin_amdgcn_fence(__ATOMIC_ACQUIRE, "agent");
            asm volatile("s_waitcnt vmcnt(0)" ::: "memory");
        }
    }
    __syncthreads();
}

#ifndef PROBE_MASK
#define PROBE_MASK 0
#endif
#define REP(bit) for (int rep_ = 0; rep_ < 1 + ((PROBE_MASK >> (bit)) & 1); ++rep_)
#ifndef PROBE_SSD
#define PROBE_SSD 0
#endif
#ifndef PROBE_GDN
#define PROBE_GDN 0
#endif
#ifndef PROBE_LRU
#define PROBE_LRU 0
#endif
#ifndef MK_SINGLE
#define MK_SINGLE 1
#endif
__global__ void __launch_bounds__(NTHREADS, 2) mk_fwd(Args a) {
    extern __shared__ __attribute__((aligned(16))) unsigned char lds[];
    LAS unsigned char* ldsl = (LAS unsigned char*)lds;
    const int tid = threadIdx.x, lane = tid & 63, wave = __builtin_amdgcn_readfirstlane(tid >> 6);
    const int G = gridDim.x, bx = blockIdx.x;
    const int vcu = (G % 8 == 0) ? (bx % 8) * (G / 8) + bx / 8 : bx;
    const int gw = vcu * NWAVES + wave, NGW = G * NWAVES;
    unsigned char* ws = a.ws;
    volatile LAS unsigned* MISC = (volatile LAS unsigned*)(ldsl + MISC_OFF);
    if (tid < 32) MISC[tid] = 0u;
    __syncthreads();
    XcdBarrier bar; bar.bar = (unsigned*)(ws + WS_CTL) + CW_BAR; bar.x = 0; bar.st = nullptr;
    if (a.ph_hi - a.ph_lo > 1) bar = xcd_barrier_post((unsigned*)(ws + WS_CTL) + CW_BAR, MISC + 8);
#define IN(k) (a.ph_lo <= (k) && (k) < a.ph_hi)
#define SEAM(k) do { if (IN(k) && IN((k) + 1)) { xcd_barrier(bar); } } while (0)

    if (IN(0)) { p0_prologue(a, ldsl, vcu, G); } SEAM(0);
    if (IN(1)) { REP(0) normmod_phase(a, a.in[0], 0, gw, NGW, lane); } SEAM(1);
    if (IN(2)) {
        pg8::Gemm g{(const bf16_t*)(ws + WS_H), (const bf16_t*)(ws + WS_WIN0), MTOK, NINP, 2048}; pg8::StaticOrder S; S.init(MTOK, NINP, G, bx);
        pg8::EpiProj E{(bf16_t*)(ws + WS_PROJ), (float*)(ws + WS_SMALL), NINP, A_DT / 256};
        REP(1) { pg8::gemm_phase<pg8::EpiProj, pg8::StaticOrder, true, true>(ldsl, g, S, E); __syncthreads(); }
    } SEAM(2);
    if (IN(3)) { REP(0) post0_phase(a, gw, NGW, lane); } SEAM(3);
    if (IN(4)) {
        REP(3) for (int u = vcu; u < 256; u += G) { const int b = u >> 6, h = (u >> 3) & 7, qb = u & 7, kvh = h >> 2; const size_t row0 = (size_t)b * SEQ + qb * 256;
            att::attn_dense_body((const att::bf16*)(ws + WS_QB) + row0 * 1024 + h * 128, (const att::bf16*)(ws + WS_KB) + (size_t)b * SEQ * 256 + kvh * 128,
                                 (const att::bf16*)(ws + WS_VB) + (size_t)b * SEQ * 256 + kvh * 128, (bf16_t*)(ws + WS_YCAT) + row0 * 2048 + h * 128,
                                 (const bf16_t*)(ws + WS_PROJ) + row0 * NINP + A_GA + h * 128, SEQ, (char*)lds);
            __syncthreads(); }
        for (int it = vcu; it < 256; it += G) {
            if (tid < 64) ((LAS unsigned*)(ldsl + ssd3::O_FLAG))[tid] = 0u;
            __syncthreads();
            if (wave == 0) ssd3::consumer(a, it, lds); else if (wave <= 2) ssd3::producer(a, it, lds, wave - 1);
            __syncthreads(); }
    } SEAM(4);
    if (IN(5)) { REP(0) ssd_combine_phase(a, gw, NGW, lane); late_transposes(a, (LAS float*)(ldsl + wave * 16384), gw, NGW, lane); } SEAM(5);
    if (IN(6)) {
        pg8::Gemm g{(const bf16_t*)(ws + WS_YCAT), (const bf16_t*)(ws + WS_WOUT0), MTOK, 2048, 2048}; pg8::StaticOrder S; S.init(MTOK, 2048, G, bx);
        pg8::EpiResid E{a.in[0], a.out, (const float*)(ws + WS_MOD), a.in[3]};
        REP(2) { pg8::gemm_phase<pg8::EpiResid, pg8::StaticOrder, true, true>(ldsl, g, S, E); __syncthreads(); }
    } SEAM(6);
    if (IN(7)) { REP(0) normmod_phase(a, a.out, 1, gw, NGW, lane); } SEAM(7);
    if (IN(8)) {
        pg8::Gemm g{(const bf16_t*)(ws + WS_H), (const bf16_t*)(ws + WS_WIN1), MTOK, NINP, 2048}; pg8::StaticOrder S; S.init(MTOK, NINP, G, bx);
        pg8::EpiProj E{(bf16_t*)(ws + WS_PROJ), (float*)(ws + WS_SMALL), NINP, C_SM / 256};
        pg8::gemm_phase<pg8::EpiProj, pg8::StaticOrder, true, true>(ldsl, g, S, E);
    } SEAM(8);
    if (IN(9)) { REP(0) post1_phase(a, gw, NGW, lane); } SEAM(9);
    if (IN(10)) {
        REP(5) { for (int it = gw; it < 2048; it += NGW) gdn1_item(a, it, lds + wave * GDN_LDS_PER_WAVE, lane); __syncthreads(); }
        for (int wi = gw; wi < 2048; wi += NGW) lru_wave<false>(a, wi, lds + wave * GDN_LDS_PER_WAVE, lane);
    } SEAM(10);
    if (IN(11)) {
        if (tid < 16) ((LAS unsigned*)(ldsl + gdn3::O_FLAG))[tid] = 0u;
        __syncthreads();
        if (wave == 0) { for (int it = vcu; it < 256; it += G) gdn3::chain(a, it, lds); }
        else if (wave == 1) { for (int it = vcu; it < 256; it += G) gdn3::output(a, it, lds); }
        else if ((wave & 3) >= 2) { const int hw = (wave & 1) + ((wave >> 2) << 1);
            REP(7) for (int tk = vcu * 4 + hw; tk < 2048; tk += G * 4) { if ((tk >> 3) & 1) lru_run<1>(a, tk, lane); else lru_run<0>(a, tk, lane); } }
        __syncthreads();
    } SEAM(11);
    if (IN(12)) { REP(0) combine1_phase(a, gw, NGW, lane); } SEAM(12);
    if (IN(13)) {
        pg8::Gemm g{(const bf16_t*)(ws + WS_YCAT), (const bf16_t*)(ws + WS_WOUT1), MTOK, 2048, 2048}; pg8::StaticOrder S; S.init(MTOK, 2048, G, bx);
        pg8::EpiResid E{a.out, a.out, (const float*)(ws + WS_MOD) + 4 * 6144, a.in[3] + 6144};
        pg8::gemm_phase<pg8::EpiResid, pg8::StaticOrder, true, true>(ldsl, g, S, E);
    } SEAM(13);
    if (IN(14)) { final_norm_phase(a, gw, NGW, lane); }
#undef IN
#undef SEAM
}

extern "C" void kernel_launch(void* const* d_in, const int* in_sizes, int n_in, void* d_out, int out_size, void* d_ws, size_t ws_size, hipStream_t stream) {
    static int grid = 0;
    if (grid == 0) {
        if (n_in != 39 || out_size != MTOK * DM || ws_size < WS_END) { fprintf(stderr, "kernel_launch: unexpected problem (n_in %d, out %d, ws %zu < %zu)\n", n_in, out_size, ws_size, (size_t)WS_END); grid = -1; return; }
        int dev = 0, cus = 0, per_cu = 0;
        if (hipGetDevice(&dev) != hipSuccess || hipDeviceGetAttribute(&cus, hipDeviceAttributeMultiprocessorCount, dev) != hipSuccess) { grid = -1; return; }
        if (hipFuncSetAttribute((const void*)mk_fwd, hipFuncAttributeMaxDynamicSharedMemorySize, LDS_BYTES) != hipSuccess) { fprintf(stderr, "kernel_launch: hipFuncSetAttribute failed\n"); grid = -1; return; }
        if (hipOccupancyMaxActiveBlocksPerMultiprocessor(&per_cu, (const void*)mk_fwd, NTHREADS, LDS_BYTES) != hipSuccess || per_cu < 1) { fprintf(stderr, "kernel_launch: occupancy query says %d\n", per_cu); (void)hipGetLastError(); per_cu = 1; }
        grid = cus;
    }
    if (grid < 0) return;
    (void)hipMemsetAsync((char*)d_ws + WS_CTL, 0, CTL_ZERO_BYTES, stream);
    Args a{};
    for (int i = 0; i < 39; ++i) a.in[i] = (const float*)d_in[i];
    a.out = (float*)d_out; a.ws = (unsigned char*)d_ws;
#if MK_SINGLE
    a.ph_lo = 0; a.ph_hi = NPHASE;
    void* kargs[] = {&a};
    hipError_t e = hipLaunchCooperativeKernel((const void*)mk_fwd, dim3(grid), dim3(NTHREADS), kargs, LDS_BYTES, stream);
    if (e != hipSuccess) fprintf(stderr, "kernel_launch: cooperative launch failed: %s (grid %d)\n", hipGetErrorString(e), grid);
#else
    for (int p = 0; p < NPHASE; ++p) { a.ph_lo = p; a.ph_hi = p + 1; hipLaunchKernelGGL(mk_fwd, dim3(grid), dim3(NTHREADS), LDS_BYTES, stream, a); }
#endif
}
```

```cpp
#include <hip/hip_runtime.h>
#include <hip/hip_cooperative_groups.h>
#include <hip/hip_bf16.h>
#include <cstdio>
#include <cstdint>
namespace cg = cooperative_groups;

constexpr int BATCH = 4, SEQ = 2048, DM = 2048, MTOK = BATCH * SEQ;
constexpr int NIN = 5152, NINP = 5376;
constexpr float EPS = 1e-6f;
constexpr int A_Q = 0, A_K = 1024, A_V = 1280, A_GA = 1536, A_XS = 2560, A_BS = 3584, A_CS = 3840, A_DT = 4096, A_Z = 4128;
constexpr int C_Q = 0, C_K = 512, C_V = 1024, C_SM = 2048, C_Z = 2080, C_XL = 3104, C_GL = 4128;
namespace pg8 {
#define PG8_LAS __attribute__((address_space(3)))
typedef unsigned short bf16_t;
typedef short bf16x8 __attribute__((ext_vector_type(8)));
typedef float f32x4 __attribute__((ext_vector_type(4)));
typedef unsigned u32x4 __attribute__((ext_vector_type(4)));
constexpr int BM = 256, BK = 64, HALF = 128, HTB = HALF * BK * 2  , STAGE_BYTES = 8 * HTB, NXCD = 8, WGM = 8;

__host__ __device__ __forceinline__ int lds_byte(int r, int c) { const int st = (r >> 4) * 2 + (c >> 5), rr = r & 15, cc = c & 31, ob = rr * 64 + cc * 2; return st * 1024 + (ob ^ (((ob >> 9) & 1) << 5)); }
__host__ __device__ __forceinline__ void stage_rc(int b, int& R, int& C) { const int st = b / 1024, sb = b % 1024, swz = sb ^ (((sb >> 9) & 1) << 5); R = (st >> 1) * 16 + swz / 64; C = (st & 1) * 32 + (swz % 64) / 2; }
__host__ __device__ __forceinline__ int perm32(int rho) { const int n = rho >> 4, i = rho & 15; return 8 * (i >> 2) + 4 * n + (i & 3); }

struct Unit { int pm, pn; };
struct Gemm { const bf16_t* A; const bf16_t* Bt; int M, N, K; };

struct StaticOrder {
    int nM, nN, nwg, G, c;
    __host__ __device__ void init(int M, int N, int G_, int c_) { nM = M / BM; nN = N / BM; nwg = nM * nN; G = G_; c = c_; }
    __host__ __device__ bool next(int i, Unit& u) const {
        const long L = (long)i * G + c; if (L >= nwg) return false;
        int wgid = (int)L; { const int q = nwg / NXCD, r = nwg % NXCD, xcd = wgid % NXCD, off = wgid / NXCD; wgid = (xcd < r ? xcd * (q + 1) : r * (q + 1) + (xcd - r) * q) + off; }
        const int nig = WGM * nN, gid = wgid / nig, fm = gid * WGM, gsz = (nM - fm) < WGM ? (nM - fm) : WGM;
        u.pm = fm + ((wgid % nig) % gsz); u.pn = (wgid % nig) / gsz; return true;
    }
    __device__ __forceinline__ void a_ready(const Unit&) const {}
    __device__ __forceinline__ void done(const Unit&) const {}
};

__device__ __forceinline__ unsigned cvt_pk_bf16(float lo, float hi) { unsigned r; asm volatile("v_cvt_pk_bf16_f32 %0, %1, %2" : "=v"(r) : "v"(lo), "v"(hi)); return r; }
typedef float f32x2 __attribute__((ext_vector_type(2)));
struct EpiProj {
    static constexpr bool PERM = true, AFTER_DRAIN = false;
    bf16_t* O; float* small; int ldc; int small_tile;
    __device__ __forceinline__ void operator()(const f32x4 (&acc)[2][2][4][2], const Unit& u, int wr, int wc, int fr, int fq) const {
        const int row0 = u.pm * BM + wr * 64 + fr; const int col0 = u.pn * BM + wc * 32 + 8 * fq;
        const bool sm = (u.pn == small_tile) && (wc == 0);
#pragma unroll
        for (int ai = 0; ai < 2; ++ai)
#pragma unroll
            for (int m = 0; m < 4; ++m) { const int row = row0 + ai * HALF + m * 16; bf16_t* rowp = O + (size_t)row * ldc + col0;
#pragma unroll
                for (int bj = 0; bj < 2; ++bj) { const f32x4 v0 = acc[ai][bj][m][0], v1 = acc[ai][bj][m][1];
                    u32x4 w; w.x = cvt_pk_bf16(v0[0], v0[1]); w.y = cvt_pk_bf16(v0[2], v0[3]); w.z = cvt_pk_bf16(v1[0], v1[1]); w.w = cvt_pk_bf16(v1[2], v1[3]);
                    *(u32x4*)(rowp + bj * HALF) = w; }
                if (sm) { float* sp = small + (size_t)row * 32 + 8 * fq; *(f32x4*)sp = acc[ai][0][m][0]; *(f32x4*)(sp + 4) = acc[ai][0][m][1]; } }
    }
};
struct EpiResid {
    static constexpr bool PERM = false, AFTER_DRAIN = false;
    const float* xin; float* xout; const float* gacc; const float* gbias;
    __device__ __forceinline__ void operator()(const f32x4 (&acc)[2][2][4][2], const Unit& u, int wr, int wc, int fr, int fq) const {
        const int b = u.pm >> 3;
        const int col0 = u.pn * BM + wc * 32 + 4 * fq;
#pragma unroll
        for (int bj = 0; bj < 2; ++bj)
#pragma unroll
            for (int n = 0; n < 2; ++n) { const int col = col0 + bj * HALF + n * 16;
                const f32x4 g = *(const f32x4*)(gacc + (size_t)b * 6144 + 4096 + col) + *(const f32x4*)(gbias + 4096 + col);
#pragma unroll
                for (int ai = 0; ai < 2; ++ai)
#pragma unroll
                    for (int m = 0; m < 4; ++m) { const size_t off = (size_t)(u.pm * BM + ai * HALF + wr * 64 + m * 16 + fr) * 2048 + col;
                        const f32x4 xv = *(const f32x4*)(xin + off); *(f32x4*)(xout + off) = xv + g * acc[ai][bj][m][n]; } }
    }
};

struct EpiNull {
    static constexpr bool PERM = false, AFTER_DRAIN = false;
    __device__ __forceinline__ void operator()(const f32x4 (&acc)[2][2][4][2], const Unit& u, int wr, int wc, int fr, int fq) const {
#pragma unroll
        for (int ai = 0; ai < 2; ++ai)
#pragma unroll
            for (int bj = 0; bj < 2; ++bj)
#pragma unroll
                for (int m = 0; m < 4; ++m)
#pragma unroll
                    for (int n = 0; n < 2; ++n) asm volatile("" :: "v"(acc[ai][bj][m][n]));
    }
};
template <class Epi, class Sched, bool ALIGN_EPI = false, bool SP2 = false>
__device__ __forceinline__ void gemm_phase(PG8_LAS unsigned char* lds, const Gemm g, const Sched& S, const Epi& E) {
    const int tid = threadIdx.x, wid = __builtin_amdgcn_readfirstlane(tid >> 6), lane = tid & 63, wr = wid >> 2, wc = wid & 3, fr = lane & 15, fq = lane >> 4;
    const int K = g.K, nt = K / BK;
    unsigned voffA[2], voffB[2];
#pragma unroll
    for (int i = 0; i < 2; ++i) { int R, C; stage_rc(tid * 16 + i * 8192, R, C); const int Rb = Epi::PERM ? ((R & ~31) + perm32(R & 31)) : R;
        voffA[i] = (unsigned)(R * K + C) * 2u; voffB[i] = (unsigned)(Rb * K + C) * 2u; }
    const size_t kstep = (size_t)(BK * 2);
    const size_t hstep = (size_t)HALF * K * 2;
    const size_t tstep = 2 * hstep;
    const unsigned ldsw = (unsigned)wid * 1024u;
    const int aoff = lds_byte(wr * 64 + fr, fq * 8), boff = lds_byte(wc * 32 + fr, fq * 8);
#define PG8_SA(b, h) (((b) * 2 + (h)) * HTB)
#define PG8_SB(b, h) ((4 + (b) * 2 + (h)) * HTB)
#define PG8_STAGE(bufoff, gbase, voff) do { _Pragma("unroll") for (int _i = 0; _i < 2; ++_i) \
        __builtin_amdgcn_global_load_lds((const unsigned*)((const char*)(gbase) + (voff)[_i]), (PG8_LAS unsigned*)(lds + (bufoff) + ldsw + _i * 8192), 16, 0, 0); } while (0)
#define PG8_LDA(dst, b, h) do { _Pragma("unroll") for (int m = 0; m < 4; ++m) _Pragma("unroll") for (int k = 0; k < 2; ++k) dst[m][k] = *(const PG8_LAS bf16x8*)(lds + PG8_SA(b, h) + aoff + m * 2048 + k * 1024); } while (0)
#define PG8_LDB(dst, b, h) do { _Pragma("unroll") for (int n = 0; n < 2; ++n) _Pragma("unroll") for (int k = 0; k < 2; ++k) dst[n][k] = *(const PG8_LAS bf16x8*)(lds + PG8_SB(b, h) + boff + n * 2048 + k * 1024); } while (0)
#define PG8_MMA(ai, bj, At, Bt) do { __builtin_amdgcn_s_setprio(1); _Pragma("unroll") for (int m = 0; m < 4; ++m) _Pragma("unroll") for (int n = 0; n < 2; ++n) _Pragma("unroll") for (int k = 0; k < 2; ++k) \
        acc[ai][bj][m][n] = __builtin_amdgcn_mfma_f32_16x16x32_bf16(Bt[n][k], At[m][k], acc[ai][bj][m][n], 0, 0, 0); __builtin_amdgcn_s_setprio(0); } while (0)
#define PG8_WAIT_V(n) asm volatile("s_waitcnt vmcnt(" #n ")" ::: "memory")
#define PG8_WAIT_L(n) asm volatile("s_waitcnt lgkmcnt(" #n ")" ::: "memory")
#define PG8_BAR __builtin_amdgcn_s_barrier()
#define PG8_SCHED __builtin_amdgcn_sched_barrier(0)
    Unit cur, nxt; int ui = 0;
    if (!S.next(0, cur)) return;
    f32x4 acc[2][2][4][2];
#pragma unroll
    for (int a = 0; a < 2; ++a)
#pragma unroll
        for (int b = 0; b < 2; ++b)
#pragma unroll
            for (int m = 0; m < 4; ++m)
#pragma unroll
                for (int n = 0; n < 2; ++n) acc[a][b][m][n] = (f32x4){0.f, 0.f, 0.f, 0.f};
    bf16x8 At[4][2], B0[2][2], B1[2][2];
    const char* cA = (const char*)g.A + (size_t)cur.pm * tstep; const char* cB = (const char*)g.Bt + (size_t)cur.pn * tstep;
    S.a_ready(cur);
    if constexpr (SP2) {
        PG8_STAGE(PG8_SB(0, 0), cB, voffB); PG8_STAGE(PG8_SB(0, 1), cB + hstep, voffB); PG8_STAGE(PG8_SA(0, 0), cA, voffA); PG8_STAGE(PG8_SA(0, 1), cA + hstep, voffA);
        if (wr == 1) PG8_BAR;
        PG8_WAIT_V(2); PG8_BAR;
        PG8_STAGE(PG8_SB(1, 0), cB + kstep, voffB); PG8_STAGE(PG8_SA(1, 0), cA + kstep, voffA); PG8_STAGE(PG8_SB(1, 1), cB + hstep + kstep, voffB);
        PG8_WAIT_V(6); PG8_BAR;
    } else {
        PG8_STAGE(PG8_SB(0, 0), cB, voffB); PG8_STAGE(PG8_SA(0, 0), cA, voffA); PG8_STAGE(PG8_SB(0, 1), cB + hstep, voffB); PG8_STAGE(PG8_SA(0, 1), cA + hstep, voffA);
        if (wr == 1) PG8_BAR;
        PG8_WAIT_V(4); PG8_BAR;
        PG8_STAGE(PG8_SB(1, 0), cB + kstep, voffB); PG8_STAGE(PG8_SA(1, 0), cA + kstep, voffA); PG8_STAGE(PG8_SB(1, 1), cB + hstep + kstep, voffB);
        PG8_WAIT_V(6); PG8_BAR;
    }
    for (;;) {
        const bool has_next = S.next(ui + 1, nxt);
        const char* nA = has_next ? (const char*)g.A + (size_t)nxt.pm * tstep : cA; const char* nB = has_next ? (const char*)g.Bt + (size_t)nxt.pn * tstep : cB;
        for (int t = 0; t < nt; t += 2) {
            const bool last = (t == nt - 2);
            const char* a1 = cA + (size_t)(t + 1) * kstep;
            const char* a2 = last ? nA : cA + (size_t)(t + 2) * kstep; const char* b2 = last ? nB : cB + (size_t)(t + 2) * kstep;
            const char* a3 = a2 + kstep; const char* b3 = b2 + kstep;
            if (last && has_next) S.a_ready(nxt);
            if constexpr (SP2) {
            PG8_LDB(B0, 0, 0); PG8_LDB(B1, 0, 1); PG8_SCHED; PG8_LDA(At, 0, 0); PG8_STAGE(PG8_SA(1, 1), a1 + hstep, voffA);
            PG8_WAIT_V(8); PG8_WAIT_L(0); PG8_BAR; PG8_MMA(0, 0, At, B0); PG8_MMA(0, 1, At, B1); PG8_BAR; PG8_SCHED;
            PG8_LDA(At, 0, 1); PG8_STAGE(PG8_SB(0, 0), b2, voffB); PG8_STAGE(PG8_SB(0, 1), b2 + hstep, voffB); PG8_STAGE(PG8_SA(0, 0), a2, voffA);
            PG8_WAIT_V(8); PG8_WAIT_L(0); PG8_BAR; PG8_MMA(1, 0, At, B0); PG8_MMA(1, 1, At, B1); PG8_BAR; PG8_SCHED;
            PG8_LDB(B0, 1, 0); PG8_LDB(B1, 1, 1); PG8_SCHED; PG8_LDA(At, 1, 0); PG8_STAGE(PG8_SA(0, 1), a2 + hstep, voffA);
            PG8_WAIT_V(8); PG8_WAIT_L(0); PG8_BAR; PG8_MMA(0, 0, At, B0); PG8_MMA(0, 1, At, B1); PG8_BAR; PG8_SCHED;
            PG8_LDA(At, 1, 1); PG8_STAGE(PG8_SB(1, 0), b3, voffB); PG8_STAGE(PG8_SB(1, 1), b3 + hstep, voffB); PG8_STAGE(PG8_SA(1, 0), a3, voffA);
            PG8_WAIT_V(8); PG8_WAIT_L(0); PG8_BAR; PG8_MMA(1, 0, At, B0); PG8_MMA(1, 1, At, B1); PG8_BAR; PG8_SCHED;
            } else {
            PG8_LDB(B0, 0, 0); PG8_SCHED; PG8_LDA(At, 0, 0); PG8_STAGE(PG8_SA(1, 1), a1 + hstep, voffA);
            PG8_WAIT_L(8); PG8_BAR; PG8_WAIT_L(0); PG8_MMA(0, 0, At, B0); PG8_BAR; PG8_SCHED;
            PG8_LDB(B1, 0, 1); PG8_STAGE(PG8_SB(0, 0), b2, voffB);
            PG8_BAR; PG8_WAIT_L(0); PG8_MMA(0, 1, At, B1); PG8_BAR;
            PG8_LDA(At, 0, 1); PG8_STAGE(PG8_SA(0, 0), a2, voffA);
            PG8_BAR; PG8_WAIT_L(0); PG8_MMA(1, 0, At, B0); PG8_BAR; PG8_SCHED;
            PG8_STAGE(PG8_SB(0, 1), b2 + hstep, voffB);
            PG8_WAIT_V(6); PG8_BAR; PG8_MMA(1, 1, At, B1); PG8_BAR;
            PG8_LDB(B0, 1, 0); PG8_SCHED; PG8_LDA(At, 1, 0); PG8_STAGE(PG8_SA(0, 1), a2 + hstep, voffA);
            PG8_WAIT_L(8); PG8_BAR; PG8_WAIT_L(0); PG8_MMA(0, 0, At, B0); PG8_BAR; PG8_SCHED;
            PG8_LDB(B1, 1, 1); PG8_STAGE(PG8_SB(1, 0), b3, voffB);
            PG8_BAR; PG8_WAIT_L(0); PG8_MMA(0, 1, At, B1); PG8_BAR;
            PG8_LDA(At, 1, 1); PG8_STAGE(PG8_SA(1, 0), a3, voffA);
            PG8_BAR; PG8_WAIT_L(0); PG8_MMA(1, 0, At, B0); PG8_BAR; PG8_SCHED;
            PG8_STAGE(PG8_SB(1, 1), b3 + hstep, voffB);
            PG8_WAIT_V(6); PG8_BAR; PG8_MMA(1, 1, At, B1); PG8_BAR;
            }
        }
        if constexpr (ALIGN_EPI) { if (wr == 0) PG8_BAR; }
        if constexpr (!Epi::AFTER_DRAIN) { E(acc, cur, wr, wc, fr, fq); S.done(cur); }
        if (!has_next) break;
#pragma unroll
        for (int a = 0; a < 2; ++a)
#pragma unroll
            for (int b = 0; b < 2; ++b)
#pragma unroll
                for (int m = 0; m < 4; ++m)
#pragma unroll
                    for (int n = 0; n < 2; ++n) acc[a][b][m][n] = (f32x4){0.f, 0.f, 0.f, 0.f};
        cur = nxt; cA = nA; cB = nB; ++ui;
        if constexpr (ALIGN_EPI) { if (wr == 1) PG8_BAR; }
    }
    PG8_WAIT_V(0);
    if constexpr (!ALIGN_EPI) { if (wr == 0) PG8_BAR; }
    PG8_BAR;
    if constexpr (Epi::AFTER_DRAIN) { E.fused(acc, cur, wr, wc, fr, fq, lds, wid, lane); S.done(cur); }
#undef PG8_SA
#undef PG8_SB
#undef PG8_STAGE
#undef PG8_LDA
#undef PG8_LDB
#undef PG8_MMA
#undef PG8_WAIT_V
#undef PG8_WAIT_L
#undef PG8_BAR
#undef PG8_SCHED
}
}
namespace att {
using bf16 = __hip_bfloat16;
constexpr int   D = 128, NW = 8, QBLK = 32, KVBLK = 64;
constexpr float SCALE = 0.088388347648318440f;
constexpr float THR = 8.f;
constexpr int SDEPTH = 2;
constexpr int LDQ = 1024, LDK = 256, LDY = 2048, LDG = NINP;
constexpr size_t SHM_V = KVBLK * D * 2, SHM_K = KVBLK * D * 2, SHM_ATTN = 2 * SHM_V + 2 * SHM_K + NW * 64 * 4;
using bf16x8 = __attribute__((ext_vector_type(8))) short;
using s16x4  = __attribute__((ext_vector_type(4))) short;
using f32x16 = __attribute__((ext_vector_type(16))) float;
using f32x8  = __attribute__((ext_vector_type(8))) float;
using u32x4  = __attribute__((ext_vector_type(4))) unsigned;
#define KSWZ(row, colB) ((row) * 256 + ((colB) ^ (((row) & 7) << 4)))
#define SBAR() __builtin_amdgcn_sched_barrier(0)
__device__ __forceinline__ int crow(int r, int hi) { return (r & 3) + 8 * (r >> 2) + 4 * hi; }
__device__ __forceinline__ unsigned cvtpk(float lo, float hi) {
  unsigned r; asm volatile("v_cvt_pk_bf16_f32 %0, %1, %2" : "=v"(r) : "v"(lo), "v"(hi)); return r;
}
template <typename TIn> struct Stage;
template <> struct Stage<bf16>  { using T = bf16x8;
  __device__ static __forceinline__ T ld8(const bf16* p) { return *reinterpret_cast<const bf16x8*>(p); }
  __device__ static __forceinline__ bf16x8 tobf(T x) { return x; } };
template <> struct Stage<float> { using T = f32x8;
  __device__ static __forceinline__ T ld8(const float* p) { return *reinterpret_cast<const f32x8*>(p); }
  __device__ static __forceinline__ bf16x8 tobf(T x) {
    u32x4 w = {cvtpk(x[0], x[1]), cvtpk(x[2], x[3]), cvtpk(x[4], x[5]), cvtpk(x[6], x[7])}; return *reinterpret_cast<bf16x8*>(&w); } };

__device__ __forceinline__ void partialSM(f32x16& p0, f32x16& p1, float& m_reg, float& mn, float& alpha) {
  constexpr float C = SCALE * 1.4426950408889634f;
  float pmax = p0[0]; for (int r = 1; r < 16; ++r) pmax = fmaxf(pmax, p0[r]); for (int r = 0; r < 16; ++r) pmax = fmaxf(pmax, p1[r]);
  { auto rr = __builtin_amdgcn_permlane32_swap(__float_as_uint(pmax), __float_as_uint(pmax), false, false);
    pmax = fmaxf(__uint_as_float(rr[0]), __uint_as_float(rr[1])); }
  if (__builtin_expect(__all(pmax - m_reg <= THR / SCALE), 1)) { mn = m_reg; alpha = 1.f; }
  else { mn = fmaxf(m_reg, pmax); alpha = __builtin_amdgcn_exp2f((m_reg - mn) * C); m_reg = mn; }
  float mnC = -mn * C;
  for (int r = 0; r < 16; ++r) p0[r] = fmaf(p0[r], C, mnC); for (int r = 0; r < 16; ++r) p1[r] = fmaf(p1[r], C, mnC);
  for (int r = 0; r < 16; ++r) p0[r] = __builtin_amdgcn_exp2f(p0[r]);
}
__device__ __forceinline__ void finishSM(f32x16& p0, f32x16& p1, float alpha, float& l_reg, bf16x8& pa0, bf16x8& pa1, bf16x8& pa2, bf16x8& pa3) {
  for (int r = 0; r < 16; ++r) p1[r] = __builtin_amdgcn_exp2f(p1[r]);
  float ps = 0; for (int r = 0; r < 16; ++r) ps += p0[r]; for (int r = 0; r < 16; ++r) ps += p1[r];
  { auto rr = __builtin_amdgcn_permlane32_swap(__float_as_uint(ps), __float_as_uint(ps), false, false);
    ps = __uint_as_float(rr[0]) + __uint_as_float(rr[1]); }
  l_reg = l_reg * alpha + ps;
#define PK4(P, BASE, OUT) do { unsigned a0 = cvtpk(P[BASE + 0], P[BASE + 1]), a1 = cvtpk(P[BASE + 2], P[BASE + 3]);   \
    unsigned b0 = cvtpk(P[BASE + 4], P[BASE + 5]), b1 = cvtpk(P[BASE + 6], P[BASE + 7]);                              \
    auto r0 = __builtin_amdgcn_permlane32_swap(a0, b0, false, false); auto r1 = __builtin_amdgcn_permlane32_swap(a1, b1, false, false); \
    u32x4 w = {r0[0], r1[0], r0[1], r1[1]}; OUT = *reinterpret_cast<bf16x8*>(&w); } while (0)
  PK4(p0, 0, pa0); PK4(p0, 8, pa1); PK4(p1, 0, pa2); PK4(p1, 8, pa3);
#undef PK4
}
__device__ __forceinline__ void qkt(f32x16& p0, f32x16& p1, const bf16* Ks, const bf16x8* qr, int r32, int hi) {
  p0 = f32x16{}; p1 = f32x16{};
  for (int d0 = 0; d0 < 8; ++d0) { int cb = (d0 * 16 + hi * 8) * 2;
    bf16x8 b0 = *reinterpret_cast<const bf16x8*>((const char*)Ks + KSWZ(r32, cb));
    bf16x8 b1 = *reinterpret_cast<const bf16x8*>((const char*)Ks + KSWZ(32 + r32, cb));
    p0 = __builtin_amdgcn_mfma_f32_32x32x16_bf16(b0, qr[d0], p0, 0, 0, 0);
    p1 = __builtin_amdgcn_mfma_f32_32x32x16_bf16(b1, qr[d0], p1, 0, 0, 0); }
}
__device__ __forceinline__ int v_st(int k, int c) { const int kk = (k & ~0xC) | ((k & 4) << 1) | ((k & 8) >> 1); return ((kk >> 3) * 4 + (c >> 5)) * 512 + ((kk & 7) * 32 + (c & 31)) * 2; }
__device__ __forceinline__ int v_rd_base(int lane) { return ((lane & 3) << 3) | (((lane >> 2) & 3) << 6) | (((lane >> 4) & 1) << 5) | (((lane >> 5) & 1) << 8); }
constexpr int v_rd_off(int d0, int ks, int half) { return d0 * 512 + ks * 4096 + half * 2048; }
template <int OFF> __device__ __forceinline__ s16x4 tr_read(int vb) {
  s16x4 r; asm volatile("ds_read_b64_tr_b16 %0, %1 offset:%2" : "=&v"(r) : "v"(vb), "i"(OFF) : "memory"); return r;
}
template <int D0> __device__ __forceinline__ void pv_one(f32x16& od, int vb, bf16x8 pa0, bf16x8 pa1, bf16x8 pa2, bf16x8 pa3) {
  const s16x4 l0 = tr_read<v_rd_off(D0, 0, 0)>(vb), h0 = tr_read<v_rd_off(D0, 0, 1)>(vb), l1 = tr_read<v_rd_off(D0, 1, 0)>(vb), h1 = tr_read<v_rd_off(D0, 1, 1)>(vb);
  const s16x4 l2 = tr_read<v_rd_off(D0, 2, 0)>(vb), h2 = tr_read<v_rd_off(D0, 2, 1)>(vb), l3 = tr_read<v_rd_off(D0, 3, 0)>(vb), h3 = tr_read<v_rd_off(D0, 3, 1)>(vb);
  asm volatile("s_waitcnt lgkmcnt(0)" ::: "memory"); SBAR();
#define PK(L, H) (bf16x8){L[0], L[1], L[2], L[3], H[0], H[1], H[2], H[3]}
  od = __builtin_amdgcn_mfma_f32_32x32x16_bf16(pa0, PK(l0, h0), od, 0, 0, 0);
  od = __builtin_amdgcn_mfma_f32_32x32x16_bf16(pa1, PK(l1, h1), od, 0, 0, 0);
  od = __builtin_amdgcn_mfma_f32_32x32x16_bf16(pa2, PK(l2, h2), od, 0, 0, 0);
  od = __builtin_amdgcn_mfma_f32_32x32x16_bf16(pa3, PK(l3, h3), od, 0, 0, 0);
#undef PK
}
__device__ __forceinline__ void pv_d0(f32x16* o, int vb, bf16x8 pa0, bf16x8 pa1, bf16x8 pa2, bf16x8 pa3) {
  pv_one<0>(o[0], vb, pa0, pa1, pa2, pa3); pv_one<1>(o[1], vb, pa0, pa1, pa2, pa3); pv_one<2>(o[2], vb, pa0, pa1, pa2, pa3); pv_one<3>(o[3], vb, pa0, pa1, pa2, pa3);
}
__device__ __forceinline__ void attn_dense_body(const bf16* __restrict__ Qb, const bf16* __restrict__ Kh, const bf16* __restrict__ Vh,
                                                unsigned short* __restrict__ Yb, const unsigned short* __restrict__ Gb, int seq, char* lds) {
  using St = Stage<bf16>; using SQ = Stage<bf16>; using TQ = bf16;
  const int tid = threadIdx.x, wid = tid >> 6, lane = tid & 63, r32 = lane & 31, hi = lane >> 5;
  bf16* V_lds = (bf16*)lds; bf16* K_lds = (bf16*)(lds + 2 * SHM_V);
  float* ws = (float*)(lds + 2 * SHM_V + 2 * SHM_K) + wid * 64; float* li_l = ws; float* al_l = ws + 32;
  float m_reg = -1e30f, l_reg = 0; f32x16 o[4] = {}; bf16x8 qr[8];
  const TQ* Qw = Qb + (long)(wid * QBLK + r32) * LDQ + hi * 8;
#pragma unroll
  for (int d0 = 0; d0 < 8; ++d0) qr[d0] = SQ::tobf(SQ::ld8(Qw + d0 * 16));
  const int sr = tid >> 4, sc = (tid & 15) * 8, vst0 = v_st(sr, sc), vst1 = v_st(32 + sr, sc);
  const int vb0 = (int)(uintptr_t)V_lds + v_rd_base(lane);
  struct { typename St::T vs0, vs1, ks0, ks1; } sr_[SDEPTH];
#define SLOAD(i, k0) do { sr_[i].vs0 = St::ld8(&Vh[(long)((k0) + sr) * LDK + sc]); sr_[i].vs1 = St::ld8(&Vh[(long)((k0) + 32 + sr) * LDK + sc]); \
    sr_[i].ks0 = St::ld8(&Kh[(long)((k0) + sr) * LDK + sc]); sr_[i].ks1 = St::ld8(&Kh[(long)((k0) + 32 + sr) * LDK + sc]); } while (0)
#define SWRITE(b, i) do { *(bf16x8*)((char*)V_lds + (b) * SHM_V + vst0) = St::tobf(sr_[i].vs0);          \
    *(bf16x8*)((char*)V_lds + (b) * SHM_V + vst1) = St::tobf(sr_[i].vs1); int kc = sc * 2;               \
    *(bf16x8*)((char*)K_lds + (b) * SHM_K + KSWZ(sr, kc)) = St::tobf(sr_[i].ks0);                       \
    *(bf16x8*)((char*)K_lds + (b) * SHM_K + KSWZ(32 + sr, kc)) = St::tobf(sr_[i].ks1); } while (0)
#define SWAIT() do { if constexpr (SDEPTH == 2) asm volatile("s_waitcnt vmcnt(4)" ::: "memory"); else asm volatile("s_waitcnt vmcnt(0)" ::: "memory"); } while (0)
#define RESC(a) do { if (__any((a) < 1.f)) { if (hi == 0) al_l[r32] = (a); asm volatile("s_waitcnt lgkmcnt(0)" ::: "memory"); \
    for (int d = 0; d < 4; ++d) for (int r = 0; r < 16; ++r) o[d][r] *= al_l[crow(r, hi)]; } } while (0)
  f32x16 pA0, pA1, pB0, pB1; float mnA, mnB, alA, alB; bf16x8 pa0, pa1, pa2, pa3; const int NT = seq / KVBLK;
  constexpr int SE = 0, SO = SDEPTH - 1;
  SLOAD(SE, 0); asm volatile("s_waitcnt vmcnt(0)" ::: "memory"); SWRITE(0, SE); __syncthreads();
  qkt(pA0, pA1, K_lds, qr, r32, hi); partialSM(pA0, pA1, m_reg, mnA, alA);
  SLOAD(SO, KVBLK); if constexpr (SDEPTH == 2) { if (2 < NT) SLOAD(SE, 2 * KVBLK); }
  SWAIT(); SWRITE(1, SO); __syncthreads();
  for (int j = 1; j + 1 < NT; j += 2) {
    SBAR(); qkt(pB0, pB1, (bf16*)((char*)K_lds + SHM_K), qr, r32, hi);
    finishSM(pA0, pA1, alA, l_reg, pa0, pa1, pa2, pa3); SBAR();
    SLOAD(SO, (j + SDEPTH) * KVBLK); SBAR();
    pv_d0(o, vb0, pa0, pa1, pa2, pa3); partialSM(pB0, pB1, m_reg, mnB, alB);
    __syncthreads(); SWAIT(); SWRITE(0, SE);
    RESC(alB); __syncthreads();
    SBAR(); qkt(pA0, pA1, K_lds, qr, r32, hi);
    finishSM(pB0, pB1, alB, l_reg, pa0, pa1, pa2, pa3); SBAR();
    if (SDEPTH == 1 || j + 3 < NT) SLOAD(SE, (j + 1 + SDEPTH) * KVBLK); SBAR();
    pv_d0(o, vb0 + (int)SHM_V, pa0, pa1, pa2, pa3); partialSM(pA0, pA1, m_reg, mnA, alA);
    __syncthreads(); SWAIT(); SWRITE(1, SO);
    RESC(alA); __syncthreads();
  }
  SBAR(); qkt(pB0, pB1, (bf16*)((char*)K_lds + SHM_K), qr, r32, hi);
  finishSM(pA0, pA1, alA, l_reg, pa0, pa1, pa2, pa3); SBAR();
  pv_d0(o, vb0, pa0, pa1, pa2, pa3); partialSM(pB0, pB1, m_reg, mnB, alB);
  __syncthreads(); RESC(alB);
  finishSM(pB0, pB1, alB, l_reg, pa0, pa1, pa2, pa3); SBAR();
  pv_d0(o, vb0 + (int)SHM_V, pa0, pa1, pa2, pa3);
  if (hi == 0) li_l[r32] = l_reg; asm volatile("s_waitcnt lgkmcnt(0)" ::: "memory");
  float rli[16];
#pragma unroll
  for (int r = 0; r < 16; ++r) rli[r] = __builtin_amdgcn_rcpf(li_l[crow(r, hi)]);
  __syncthreads();
  { int ew = wid; asm volatile("" : "+v"(ew));
    float* stg = (float*)lds + ew * (32 * 132);
#pragma unroll
    for (int r = 0; r < 16; ++r) { const int orow = crow(r, hi);
#pragma unroll
      for (int d0 = 0; d0 < 4; ++d0) stg[orow * 132 + d0 * 32 + r32] = o[d0][r] * rli[r]; }
    asm volatile("s_waitcnt lgkmcnt(0)" ::: "memory");
    int el = lane; asm volatile("" : "+v"(el));
    const unsigned short* Gw0 = Gb + (long)(ew * QBLK) * LDG; unsigned short* Yw0 = Yb + (long)(ew * QBLK) * LDY;
#pragma unroll 2
    for (int i = 0; i < 8; ++i) { const int id = el + 64 * i, row = id >> 4, c8 = id & 15;
      const float* sp = stg + row * 132 + c8 * 8;
      const u32x4 gw = *reinterpret_cast<const u32x4*>(Gw0 + (long)row * LDG + c8 * 8);
      u32x4 ow;
#pragma unroll
      for (int q = 0; q < 4; ++q) { const unsigned gq = (q == 0) ? gw.x : (q == 1) ? gw.y : (q == 2) ? gw.z : gw.w;
        const float g0 = __uint_as_float(gq << 16), g1 = __uint_as_float(gq & 0xffff0000u);
        const float v0 = sp[2 * q] * (g0 / (1.f + __expf(-g0))), v1 = sp[2 * q + 1] * (g1 / (1.f + __expf(-g1)));
        const unsigned pk = cvtpk(v0, v1);
        if (q == 0) ow.x = pk; else if (q == 1) ow.y = pk; else if (q == 2) ow.z = pk; else ow.w = pk; }
      *reinterpret_cast<u32x4*>(Yw0 + (long)row * LDY + c8 * 8) = ow; } }
#undef SLOAD
#undef SWRITE
#undef SWAIT
#undef RESC
}
}
#define GAS __attribute__((address_space(1)))
#define LAS __attribute__((address_space(3)))
typedef unsigned short bf16_t;
typedef unsigned v4u __attribute__((ext_vector_type(4)));
typedef unsigned v2u __attribute__((ext_vector_type(2)));
typedef float f32x4 __attribute__((ext_vector_type(4)));
typedef short bf16x8_t __attribute__((ext_vector_type(8)));
typedef float f32x16_t __attribute__((ext_vector_type(16)));
#define LDS_WAIT() asm volatile("s_waitcnt lgkmcnt(0)" ::: "memory")

constexpr size_t MiB = 1u << 20;
constexpr size_t WS_CTL = 0, CTL_ZERO_BYTES = 1 * MiB;
constexpr size_t WS_MOD = 64 * 1024;
constexpr size_t WS_ROPE = 1 * MiB;
constexpr size_t WS_SMALL = 2 * MiB;
constexpr size_t WS_WIN0 = 3 * MiB, WS_WOUT0 = 24 * MiB;
constexpr size_t WS_QB = 32 * MiB, WS_KB = 48 * MiB, WS_VB = 52 * MiB;
constexpr size_t WS_HB = 3 * MiB;
constexpr size_t WS_WIN1 = 56 * MiB, WS_WOUT1 = 77 * MiB;
constexpr size_t WS_H = 85 * MiB;
constexpr size_t WS_HF = 85 * MiB;
constexpr size_t WS_PROJ = 117 * MiB;
constexpr size_t WS_YCAT = 201 * MiB;
constexpr size_t WS_ACT = 233 * MiB;
constexpr size_t WS_YF = 297 * MiB, WS_YB = 329 * MiB;
constexpr size_t WS_XBC16 = 85 * MiB;
constexpr size_t WS_QKV16 = 3 * MiB;
constexpr size_t WS_XC16 = 35 * MiB;
constexpr size_t WS_GT = 85 * MiB, WS_GA = 101 * MiB;
constexpr size_t WS_WGT = 361 * MiB;
constexpr size_t WS_LSUM = 362 * MiB;
constexpr size_t WS_HF16 = 56 * MiB;
constexpr size_t WS_HB16 = 366 * MiB;
constexpr size_t WS_END = 382 * MiB;

constexpr int NWAVES = 8, NTHREADS = 512;
constexpr int LDS_BYTES = 163840;
constexpr int NPHASE = 15;

struct Args { const float* in[39]; float* out; unsigned char* ws; int ph_lo, ph_hi; };

__device__ __forceinline__ float bf2f(unsigned v) { return __uint_as_float(v << 16); }
__device__ __forceinline__ unsigned f2bf(float f) { unsigned u = __float_as_uint(f); return (u + 0x7fffu + ((u >> 16) & 1u)) >> 16; }
__device__ __forceinline__ unsigned pk2(float lo, float hi) { return f2bf(lo) | (f2bf(hi) << 16); }
__device__ __forceinline__ void unpack8(const v4u w, float* x) {
    x[0] = __uint_as_float(w.x << 16); x[1] = __uint_as_float(w.x & 0xffff0000u); x[2] = __uint_as_float(w.y << 16); x[3] = __uint_as_float(w.y & 0xffff0000u);
    x[4] = __uint_as_float(w.z << 16); x[5] = __uint_as_float(w.z & 0xffff0000u); x[6] = __uint_as_float(w.w << 16); x[7] = __uint_as_float(w.w & 0xffff0000u);
}
__device__ __forceinline__ v4u pack8(const float* x) { v4u w; w.x = pk2(x[0], x[1]); w.y = pk2(x[2], x[3]); w.z = pk2(x[4], x[5]); w.w = pk2(x[6], x[7]); return w; }
__device__ __forceinline__ float silu_f(float x) { return x / (1.f + expf(-x)); }
__device__ __forceinline__ float sigmoid_f(float x) { return 1.f / (1.f + expf(-x)); }
__device__ __forceinline__ float softplus_f(float x) { return fmaxf(x, 0.f) + log1pf(expf(-fabsf(x))); }
template <int CTRL> __device__ __forceinline__ float dpp_mov(float v) { return __builtin_bit_cast(float, __builtin_amdgcn_update_dpp(0, __builtin_bit_cast(int, v), CTRL, 0xF, 0xF, true)); }
template <int N> __device__ __forceinline__ float group_sum(float v) {
    if (N >= 2) v += dpp_mov<0xB1>(v);
    if (N >= 4) v += dpp_mov<0x4E>(v);
    if (N >= 8) v += dpp_mov<0x141>(v);
    if (N >= 16) v += dpp_mov<0x140>(v);
    if (N >= 32) v += __shfl_xor(v, 16);
    if (N >= 64) v += __shfl_xor(v, 32);
    return v;
}

__device__ __forceinline__ void p0_transpose_item(const float* W, int K, int N, bf16_t* WT, int row_off, LAS float* scr, int item, int lane) {
    const int nblk = N / 32, kb = item / nblk, nb = item % nblk, k0 = 64 * kb, n0 = 32 * nb;
#pragma unroll 8
    for (int i = 0; i < 32; ++i) { const int kk = 2 * i + (lane >> 5); scr[kk * 33 + (lane & 31)] = W[(size_t)(k0 + kk) * N + n0 + (lane & 31)]; }
    LDS_WAIT(); asm volatile("" ::: "memory");
    const int c = lane & 7;
#pragma unroll
    for (int j = 0; j < 4; ++j) { const int n = (lane >> 3) + 8 * j; const LAS float* s = scr + (8 * c) * 33 + n;
        v4u o; o.x = pk2(s[0 * 33], s[1 * 33]); o.y = pk2(s[2 * 33], s[3 * 33]); o.z = pk2(s[4 * 33], s[5 * 33]); o.w = pk2(s[6 * 33], s[7 * 33]);
        *(v4u*)(WT + (size_t)(row_off + n0 + n) * K + k0 + 8 * c) = o; }
    LDS_WAIT(); asm volatile("" ::: "memory");
}

__device__ __forceinline__ void p0_prologue(const Args& a, LAS unsigned char* lds, int vcu, int G) {
    const int tid = threadIdx.x, lane = tid & 63, wave = tid >> 6;
    unsigned char* ws = a.ws;
    { const int gid = blockIdx.x * NTHREADS + tid;
      if (gid < 2048) { const int pos = gid >> 5, i = gid & 31; const float freq = expf(-(float)i * (1.f / 32.f) * 9.210340371976184f); const float ang = (float)pos * freq;
          float* rt = (float*)(ws + WS_ROPE); rt[2 * gid] = cosf(ang); rt[2 * gid + 1] = sinf(ang); } }
    { const int gid = blockIdx.x * NTHREADS + tid, gn = G * NTHREADS; constexpr int NV = (NINP - NIN) * 2048 * 2 / 16;
      v4u* p0 = (v4u*)(ws + WS_WIN0 + (size_t)NIN * 2048 * 2); v4u* p1 = (v4u*)(ws + WS_WIN1 + (size_t)NIN * 2048 * 2);
      for (int i = gid; i < NV; i += gn) { p0[i] = (v4u){0, 0, 0, 0}; p1[i] = (v4u){0, 0, 0, 0}; } }
    if (blockIdx.x < 192) {
        const int it = blockIdx.x, l = it / 96, r = it % 96, kc = r / 3, nc = r % 3;
        LAS float* cond = (LAS float*)lds;
        if (tid < 256) { const int b = tid >> 6, k = tid & 63; const float c = a.in[1][b * 2048 + kc * 64 + k]; cond[tid] = silu_f(c); }
        __syncthreads();
        const float* W = a.in[2] + (size_t)l * 2048 * 6144 + (size_t)(kc * 64) * 6144 + nc * 2048 + tid * 4;
        f32x4 acc0 = {0, 0, 0, 0}, acc1 = acc0, acc2 = acc0, acc3 = acc0;
#pragma unroll 8
        for (int k = 0; k < 64; ++k) { const f32x4 w = *(const f32x4*)(W + (size_t)k * 6144);
            acc0 += cond[k] * w; acc1 += cond[64 + k] * w; acc2 += cond[128 + k] * w; acc3 += cond[192 + k] * w; }
        float* macc = (float*)(ws + WS_MOD) + (size_t)l * 4 * 6144 + nc * 2048 + tid * 4;
#pragma unroll
        for (int i = 0; i < 4; ++i) { atomicAdd(macc + i, acc0[i]); atomicAdd(macc + 6144 + i, acc1[i]); atomicAdd(macc + 2 * 6144 + i, acc2[i]); atomicAdd(macc + 3 * 6144 + i, acc3[i]); }
        __syncthreads();
    }
    { LAS float* scr = (LAS float*)(lds + wave * 16384);
      const int gw = vcu * NWAVES + wave, NGW = G * NWAVES;
      constexpr int I_IN = 32 * (NIN / 32), I_OUT = 32 * 64, NITEMS = I_IN + I_OUT;
      for (int it = gw; it < NITEMS; it += NGW) {
          int r = it;
          if (r < I_IN) { p0_transpose_item(a.in[5], 2048, NIN, (bf16_t*)(ws + WS_WIN0), 0, scr, r, lane); continue; } r -= I_IN;
          p0_transpose_item(a.in[16], 2048, 2048, (bf16_t*)(ws + WS_WOUT0), 0, scr, r, lane);
      } }
}
__device__ __forceinline__ void late_transposes(const Args& a, LAS float* scr, int hw, int NHW, int lane) {
    unsigned char* ws = a.ws;
    constexpr int I_IN = 32 * (NIN / 32), I_OUT = 32 * 64, I_G = 32 * 8, NITEMS = I_IN + I_OUT + I_G;
    for (int it = hw; it < NITEMS; it += NHW) {
        int r = it;
        if (r < I_G) { const int mn = r >> 3, m = mn >> 3; const float* Wg = a.in[m == 0 ? 27 : m == 1 ? 29 : m == 2 ? 32 : 34] + (size_t)(mn & 7) * 128 * 128;
            p0_transpose_item(Wg, 128, 128, (bf16_t*)(ws + WS_WGT) + (size_t)mn * 128 * 128, 0, scr, r & 7, lane); continue; } r -= I_G;
        if (r < I_IN) { p0_transpose_item(a.in[17], 2048, NIN, (bf16_t*)(ws + WS_WIN1), 0, scr, r, lane); continue; } r -= I_IN;
        p0_transpose_item(a.in[37], 2048, 2048, (bf16_t*)(ws + WS_WOUT1), 0, scr, r, lane);
    }
}

__device__ __forceinline__ void normmod_phase(const Args& a, const float* xin, int layer, int gw, int NGW, int lane) {
    const float* nw = a.in[4] + layer * 2048; const float* bm = a.in[3] + layer * 6144;
    const float* macc = (const float*)(a.ws + WS_MOD) + (size_t)layer * 4 * 6144;
    bf16_t* H = (bf16_t*)(a.ws + WS_H);
    for (int m = gw; m < MTOK; m += NGW) {
        const int b = m >> 11;
        const f32x4* xr = (const f32x4*)(xin + (size_t)m * 2048) + lane;
        f32x4 v[8]; float s = 0.f;
#pragma unroll
        for (int j = 0; j < 8; ++j) { v[j] = xr[64 * j]; s += (v[j].x * v[j].x + v[j].y * v[j].y) + (v[j].z * v[j].z + v[j].w * v[j].w); }
        const float rstd = rsqrtf(group_sum<64>(s) * (1.f / 2048.f) + EPS);
#pragma unroll
        for (int j = 0; j < 8; ++j) { const int col = (64 * j + lane) * 4;
            const f32x4 w = *(const f32x4*)(nw + col);
            const f32x4 sh = *(const f32x4*)(macc + b * 6144 + col) + *(const f32x4*)(bm + col);
            const f32x4 sc = *(const f32x4*)(macc + b * 6144 + 2048 + col) + *(const f32x4*)(bm + 2048 + col);
            const f32x4 o = v[j] * rstd * w * (1.f + sc) + sh;
            v2u pk; pk.x = pk2(o.x, o.y); pk.y = pk2(o.z, o.w);
            *(v2u*)(H + (size_t)m * 2048 + col) = pk; }
    }
}

__device__ __forceinline__ void post0_phase(const Args& a, int gw, int NGW, int lane) {
    const bf16_t* P = (const bf16_t*)(a.ws + WS_PROJ);
    const float2* rope = (const float2*)(a.ws + WS_ROPE);
    const float* qn = a.in[6]; const float* kn = a.in[7]; const float* cw = a.in[8]; const float* cb = a.in[9];
    bf16_t* Q = (bf16_t*)(a.ws + WS_QB); bf16_t* K = (bf16_t*)(a.ws + WS_KB); bf16_t* V = (bf16_t*)(a.ws + WS_VB);
    float* ACT = (float*)(a.ws + WS_ACT);
    for (int m = gw; m < MTOK; m += NGW) {
        const int t = m & 2047, prow = t >> 6, pcol = t & 63;
        const bf16_t* pr = P + (size_t)m * NINP;
        {
            float x[16]; unpack8(*(const v4u*)(pr + A_Q + lane * 16), x); unpack8(*(const v4u*)(pr + A_Q + lane * 16 + 8), x + 8);
            float ss = 0.f;
#pragma unroll
            for (int i = 0; i < 16; ++i) ss += x[i] * x[i];
            ss = group_sum<8>(ss);
            const float r = rsqrtf(ss * (1.f / 128.f) + EPS);
            const int d0 = (lane & 7) * 16;
#pragma unroll
            for (int i = 0; i < 16; ++i) x[i] = x[i] * r * qn[d0 + i];
#pragma unroll
            for (int pi = 0; pi < 8; ++pi) { const int p = (d0 >> 1) + pi; const float2 cs = (p < 32) ? rope[prow * 32 + p] : rope[pcol * 32 + p - 32];
                const float x0 = x[2 * pi], x1 = x[2 * pi + 1]; x[2 * pi] = x0 * cs.x - x1 * cs.y; x[2 * pi + 1] = x0 * cs.y + x1 * cs.x; }
            *(v4u*)(Q + (size_t)m * 1024 + lane * 16) = pack8(x); *(v4u*)(Q + (size_t)m * 1024 + lane * 16 + 8) = pack8(x + 8);
        }
        {
            const v2u w = *(const v2u*)(pr + A_K + lane * 4);
            float x[4] = {__uint_as_float(w.x << 16), __uint_as_float(w.x & 0xffff0000u), __uint_as_float(w.y << 16), __uint_as_float(w.y & 0xffff0000u)};
            float ss = (x[0] * x[0] + x[1] * x[1]) + (x[2] * x[2] + x[3] * x[3]);
            ss = group_sum<32>(ss);
            const float r = rsqrtf(ss * (1.f / 128.f) + EPS);
            const int d0 = (lane & 31) * 4;
#pragma unroll
            for (int i = 0; i < 4; ++i) x[i] = x[i] * r * kn[d0 + i];
#pragma unroll
            for (int pi = 0; pi < 2; ++pi) { const int p = (d0 >> 1) + pi; const float2 cs = (p < 32) ? rope[prow * 32 + p] : rope[pcol * 32 + p - 32];
                const float x0 = x[2 * pi], x1 = x[2 * pi + 1]; x[2 * pi] = x0 * cs.x - x1 * cs.y; x[2 * pi + 1] = x0 * cs.y + x1 * cs.x; }
            v2u o; o.x = pk2(x[0], x[1]); o.y = pk2(x[2], x[3]);
            *(v2u*)(K + (size_t)m * 256 + lane * 4) = o;
            *(v2u*)(V + (size_t)m * 256 + lane * 4) = *(const v2u*)(pr + A_V + lane * 4);
        }
#pragma unroll
        for (int j = 0; j < 3; ++j) { const int ch = (j * 64 + lane) * 8;
            float acc[8];
            { const f32x4 b0 = *(const f32x4*)(cb + ch), b1 = *(const f32x4*)(cb + ch + 4); acc[0] = b0.x; acc[1] = b0.y; acc[2] = b0.z; acc[3] = b0.w; acc[4] = b1.x; acc[5] = b1.y; acc[6] = b1.z; acc[7] = b1.w; }
#pragma unroll
            for (int d = 0; d < 4; ++d) { const int ts = t + d - 2;
                if (ts >= 0 && ts < SEQ) { float x[8]; unpack8(*(const v4u*)(P + (size_t)(m + d - 2) * NINP + A_XS + ch), x);
                    const f32x4 w0 = *(const f32x4*)(cw + d * 1536 + ch), w1 = *(const f32x4*)(cw + d * 1536 + ch + 4);
                    acc[0] += w0.x * x[0]; acc[1] += w0.y * x[1]; acc[2] += w0.z * x[2]; acc[3] += w0.w * x[3];
                    acc[4] += w1.x * x[4]; acc[5] += w1.y * x[5]; acc[6] += w1.z * x[6]; acc[7] += w1.w * x[7]; } }
            f32x4 o0, o1; o0.x = silu_f(acc[0]); o0.y = silu_f(acc[1]); o0.z = silu_f(acc[2]); o0.w = silu_f(acc[3]); o1.x = silu_f(acc[4]); o1.y = silu_f(acc[5]); o1.z = silu_f(acc[6]); o1.w = silu_f(acc[7]);
            if (j < 2) { *(f32x4*)(ACT + (size_t)m * 1536 + ch) = o0; *(f32x4*)(ACT + (size_t)m * 1536 + ch + 4) = o1; }
            else { v4u w; w.x = pk2(o0.x, o0.y); w.y = pk2(o0.z, o0.w); w.z = pk2(o1.x, o1.y); w.w = pk2(o1.z, o1.w); *(v4u*)((bf16_t*)(a.ws + WS_XBC16) + (size_t)m * 1536 + ch) = w; } }
    }
}

typedef float f32x2 __attribute__((ext_vector_type(2)));
__device__ __forceinline__ void ssd_combine_phase(const Args& a, int gw, int NGW, int lane) {
    const float* YF = (const float*)(a.ws + WS_YF); const float* YB = (const float*)(a.ws + WS_YB); const float* ACT = (const float*)(a.ws + WS_ACT);
    const bf16_t* P = (const bf16_t*)(a.ws + WS_PROJ); bf16_t* YC = (bf16_t*)(a.ws + WS_YCAT);
    const float* dsk = a.in[14]; const float* nw = a.in[15];
    for (int m = gw; m < MTOK; m += NGW) {
        const int ch = lane * 16; const float dk = dsk[ch >> 6];
        float z[16], gv[16]; unpack8(*(const v4u*)(P + (size_t)m * NINP + A_Z + ch), z); unpack8(*(const v4u*)(P + (size_t)m * NINP + A_Z + ch + 8), z + 8);
        float ss = 0.f;
#pragma unroll
        for (int q = 0; q < 4; ++q) { const f32x4 f = *(const f32x4*)(YF + (size_t)m * 1024 + ch + 4 * q), bk = *(const f32x4*)(YB + (size_t)m * 1024 + ch + 4 * q), xv = *(const f32x4*)(ACT + (size_t)m * 1536 + ch + 4 * q);
            const f32x4 y = f + bk + dk * xv;
            gv[4 * q] = y.x * silu_f(z[4 * q]); gv[4 * q + 1] = y.y * silu_f(z[4 * q + 1]); gv[4 * q + 2] = y.z * silu_f(z[4 * q + 2]); gv[4 * q + 3] = y.w * silu_f(z[4 * q + 3]); }
#pragma unroll
        for (int i = 0; i < 16; ++i) ss += gv[i] * gv[i];
        const float r = rsqrtf(group_sum<64>(ss) * (1.f / 1024.f) + EPS);
#pragma unroll
        for (int i = 0; i < 16; ++i) gv[i] = gv[i] * r * nw[ch + i];
        *(v4u*)(YC + (size_t)m * 2048 + 1024 + ch) = pack8(gv); *(v4u*)(YC + (size_t)m * 2048 + 1024 + ch + 8) = pack8(gv + 8);
    }
}

__device__ __forceinline__ void post1_phase(const Args& a, int gw, int NGW, int lane) {
    const bf16_t* P = (const bf16_t*)(a.ws + WS_PROJ); const float* cw = a.in[18]; const float* cb = a.in[19];
    float* ACT = (float*)(a.ws + WS_ACT);
    for (int m = gw; m < MTOK; m += NGW) {
        const int t = m & 2047;
#pragma unroll
        for (int j = 0; j < 4; ++j) { const int ch = (j * 64 + lane) * 8;
            float acc[8];
            { const f32x4 b0 = *(const f32x4*)(cb + ch), b1 = *(const f32x4*)(cb + ch + 4); acc[0] = b0.x; acc[1] = b0.y; acc[2] = b0.z; acc[3] = b0.w; acc[4] = b1.x; acc[5] = b1.y; acc[6] = b1.z; acc[7] = b1.w; }
#pragma unroll
            for (int d = 0; d < 4; ++d) { const int ts = t + d - 2;
                if (ts >= 0 && ts < SEQ) { float x[8]; unpack8(*(const v4u*)(P + (size_t)(m + d - 2) * NINP + C_Q + ch), x);
                    const f32x4 w0 = *(const f32x4*)(cw + d * 2048 + ch), w1 = *(const f32x4*)(cw + d * 2048 + ch + 4);
                    acc[0] += w0.x * x[0]; acc[1] += w0.y * x[1]; acc[2] += w0.z * x[2]; acc[3] += w0.w * x[3];
                    acc[4] += w1.x * x[4]; acc[5] += w1.y * x[5]; acc[6] += w1.z * x[6]; acc[7] += w1.w * x[7]; } }
#pragma unroll
            for (int i = 0; i < 8; ++i) acc[i] = silu_f(acc[i]);
            if (j < 2) {
                float ss = 0.f;
#pragma unroll
                for (int i = 0; i < 8; ++i) ss += acc[i] * acc[i];
                ss = group_sum<16>(ss);
                float r = rsqrtf(ss + EPS); if (j == 0) r *= 0.088388347648318440f;
#pragma unroll
                for (int i = 0; i < 8; ++i) acc[i] *= r;
            }
            if (j >= 2) { *(f32x4*)(ACT + (size_t)m * 2048 + ch) = (f32x4){acc[0], acc[1], acc[2], acc[3]}; *(f32x4*)(ACT + (size_t)m * 2048 + ch + 4) = (f32x4){acc[4], acc[5], acc[6], acc[7]}; }
            else *(v4u*)((bf16_t*)(a.ws + WS_QKV16) + (size_t)m * 2048 + ch) = pack8(acc); }
    }
}

typedef short s16x4_t __attribute__((ext_vector_type(4)));
typedef __bf16 bf16x2_v __attribute__((ext_vector_type(2)));
__device__ __forceinline__ unsigned cvtpk_rne(float lo, float hi) { f32x2 v = {lo, hi}; bf16x2_v bb = __builtin_convertvector(v, bf16x2_v); return __builtin_bit_cast(unsigned, bb); }
template <int S_> __device__ __forceinline__ bf16x8_t acc_frag(const f32x16_t& x) {
    v4u w; w.x = cvtpk_rne(x[8 * S_ + 0], x[8 * S_ + 1]); w.y = cvtpk_rne(x[8 * S_ + 2], x[8 * S_ + 3]); w.z = cvtpk_rne(x[8 * S_ + 4], x[8 * S_ + 5]); w.w = cvtpk_rne(x[8 * S_ + 6], x[8 * S_ + 7]);
    return __builtin_bit_cast(bf16x8_t, w);
}
__device__ __forceinline__ bf16x8_t join44(v2u lo, v2u hi) { v4u w; w.x = lo.x; w.y = lo.y; w.z = hi.x; w.w = hi.y; return __builtin_bit_cast(bf16x8_t, w); }
__device__ __forceinline__ float wave_incl_scan(float v, int lane) {
#pragma unroll
    for (int o = 1; o < 64; o <<= 1) { const float t = __shfl_up(v, o); if (lane >= o) v += t; }
    return v;
}
constexpr int GDN_LDS_PER_WAVE = 17920;
__device__ __forceinline__ void gdn1_item(const Args& a, int item, unsigned char* ldsw, int lane) {
    asm volatile("" : "+v"(lane));
    const int c = item & 31, dir = (item >> 5) & 1, hv = (item >> 6) & 7, b = item >> 9, hq = hv >> 1;
    const int r32 = lane & 31, hi = lane >> 5;
    float* AT = (float*)ldsw; float* Gs = AT + 64 * 64; float* Bs = Gs + 64;
    const bf16_t* QK = (const bf16_t*)(a.ws + WS_QKV16); const float* SM = (const float*)(a.ws + WS_SMALL);
    bf16_t* GT = (bf16_t*)(a.ws + WS_GT) + (size_t)item * 4096; bf16_t* GA = (bf16_t*)(a.ws + WS_GA) + (size_t)item * 4096;
    const float Aneg = -expf(a.in[dir ? 21 : 20][hv]); const float dtb = a.in[dir ? 23 : 22][hv];
    {
        const int t = dir ? SEQ - 1 - (64 * c + lane) : 64 * c + lane; const float* sm = SM + ((size_t)b * SEQ + t) * 32;
        const float gi = Aneg * softplus_f(sm[16 + dir * 8 + hv] + dtb), bi = sigmoid_f(sm[dir * 8 + hv]);
        Gs[lane] = wave_incl_scan(gi, lane); Bs[lane] = bi;
    }
    const int t0r = dir ? SEQ - 1 - (64 * c + r32) : 64 * c + r32, t1r = dir ? t0r - 32 : t0r + 32;
    const bf16_t* k0p = QK + ((size_t)b * SEQ + t0r) * 2048 + 512 + hq * 128 + hi * 8; const bf16_t* k1p = QK + ((size_t)b * SEQ + t1r) * 2048 + 512 + hq * 128 + hi * 8;
    const bf16_t* q0p = k0p - 512, * q1p = k1p - 512;
    LDS_WAIT();
    const float Gj0 = Gs[r32], Gj1 = Gs[32 + r32];
    {
        f32x16_t kk00, kk10, kk11;
#pragma unroll
        for (int r = 0; r < 16; ++r) { kk00[r] = 0.f; kk10[r] = 0.f; kk11[r] = 0.f; }
#pragma unroll
        for (int s = 0; s < 8; ++s) {
            const bf16x8_t kA0 = *(const bf16x8_t*)(k0p + 16 * s), kA1 = *(const bf16x8_t*)(k1p + 16 * s);
            kk00 = __builtin_amdgcn_mfma_f32_32x32x16_bf16(kA0, kA0, kk00, 0, 0, 0); kk10 = __builtin_amdgcn_mfma_f32_32x32x16_bf16(kA1, kA0, kk10, 0, 0, 0); kk11 = __builtin_amdgcn_mfma_f32_32x32x16_bf16(kA1, kA1, kk11, 0, 0, 0);
        }
#pragma unroll
        for (int r = 0; r < 16; ++r) { const int il = (r & 3) + 8 * (r >> 2) + 4 * hi;
            const float Gi0 = Gs[il], Gi1 = Gs[32 + il], bi0 = Bs[il], bi1 = Bs[32 + il];
            AT[r32 * 64 + il] = (r32 < il) ? bi0 * kk00[r] * expf(Gi0 - Gj0) : 0.f;
            AT[r32 * 64 + 32 + il] = bi1 * kk10[r] * expf(Gi1 - Gj0);
            AT[(32 + r32) * 64 + 32 + il] = (r32 < il) ? bi1 * kk11[r] * expf(Gi1 - Gj1) : 0.f;
            AT[(32 + r32) * 64 + il] = 0.f;
        }
    }
    asm volatile("" ::: "memory");
    {
        f32x16_t qk00, qk10, qk11;
#pragma unroll
        for (int r = 0; r < 16; ++r) { qk00[r] = 0.f; qk10[r] = 0.f; qk11[r] = 0.f; }
#pragma unroll
        for (int s = 0; s < 8; ++s) {
            const bf16x8_t kA0 = *(const bf16x8_t*)(k0p + 16 * s), kA1 = *(const bf16x8_t*)(k1p + 16 * s), qA0 = *(const bf16x8_t*)(q0p + 16 * s), qA1 = *(const bf16x8_t*)(q1p + 16 * s);
            qk00 = __builtin_amdgcn_mfma_f32_32x32x16_bf16(qA0, kA0, qk00, 0, 0, 0); qk10 = __builtin_amdgcn_mfma_f32_32x32x16_bf16(qA1, kA0, qk10, 0, 0, 0); qk11 = __builtin_amdgcn_mfma_f32_32x32x16_bf16(qA1, kA1, qk11, 0, 0, 0);
        }
#pragma unroll
        for (int r = 0; r < 16; ++r) { const int il = (r & 3) + 8 * (r >> 2) + 4 * hi;
            const float Gi0 = Gs[il], Gi1 = Gs[32 + il];
            GA[il * 64 + r32] = (bf16_t)f2bf((r32 <= il) ? qk00[r] * expf(Gi0 - Gj0) : 0.f);
            GA[(32 + il) * 64 + r32] = (bf16_t)f2bf(qk10[r] * expf(Gi1 - Gj0));
            GA[(32 + il) * 64 + 32 + r32] = (bf16_t)f2bf((r32 <= il) ? qk11[r] * expf(Gi1 - Gj1) : 0.f);
        }
    }
    LDS_WAIT(); asm volatile("" ::: "memory");
    float tr[64];
    int lane2 = lane; asm volatile("" : "+v"(lane2) :: "memory");
#pragma unroll
    for (int j = 0; j < 64; ++j) tr[j] = (j == lane2) ? 1.f : 0.f;
    int atoff = 0;
#pragma unroll
    for (int j = 62; j >= 0; --j) { float c0 = 0.f, c1 = 0.f, c2 = 0.f, c3 = 0.f;
        asm volatile("" : "+v"(atoff) : "v"(tr[j + 1]));
#pragma unroll
        for (int qd = (j + 1) / 4; qd < 16; ++qd) { const f32x4 av = *(const f32x4*)(AT + atoff + j * 64 + 4 * qd);
            if (4 * qd + 0 > j) c0 = fmaf(tr[4 * qd + 0], av.x, c0);
            if (4 * qd + 1 > j) c1 = fmaf(tr[4 * qd + 1], av.y, c1);
            if (4 * qd + 2 > j) c2 = fmaf(tr[4 * qd + 2], av.z, c2);
            if (4 * qd + 3 > j) c3 = fmaf(tr[4 * qd + 3], av.w, c3); }
        tr[j] -= (c0 + c1) + (c2 + c3); asm volatile("" ::: "memory"); }
#pragma unroll
    for (int x = 0; x < 8; ++x) *(v4u*)(GT + lane2 * 64 + x * 8) = pack8(tr + x * 8);
    LDS_WAIT();
}

__device__ __forceinline__ void gdn2_item(const Args& a, int item, unsigned char* lds) {
    const int dvs = item & 3, hv = (item >> 2) & 7, dir = (item >> 5) & 1, b = item >> 6, hq = hv >> 1;
    const int lane0 = threadIdx.x & 63;
    constexpr int BUFB = 57344, O_K = 0, O_Q = 16384, O_T = 32768, O_A = 40960, O_V = 49152;
    float* Gs = (float*)(lds + 2 * BUFB); float* Bs = Gs + 64; float* Es = Bs + 64; float* Ws = Es + 64; float* ot = Ws + 64;
    const LAS unsigned char* ldl = (const LAS unsigned char*)lds;
    const bf16_t* QK = (const bf16_t*)(a.ws + WS_QKV16); const float* ACT = (const float*)(a.ws + WS_ACT); const float* SM = (const float*)(a.ws + WS_SMALL);
    float* O = (float*)(a.ws + (dir ? WS_YB : WS_YF));
    const float Aneg = -expf(a.in[dir ? 21 : 20][hv]); const float dtb = a.in[dir ? 23 : 22][hv];
    const size_t gbase = (size_t)(((b * 8 + hv) * 2 + dir) * 32) * 4096;
    f32x16_t S[4];
#pragma unroll
    for (int nt = 0; nt < 4; ++nt)
#pragma unroll
        for (int r = 0; r < 16; ++r) S[nt][r] = 0.f;
    float gar, gbr;
#define G2_DMA(c_, buf_) do { const int t_ = dir ? SEQ - 1 - (64 * (c_) + lane0) : 64 * (c_) + lane0; const size_t mi_ = (size_t)b * SEQ + t_; \
        const bf16_t* kr_ = QK + mi_ * 2048 + 512 + hq * 128; const bf16_t* qr_ = QK + mi_ * 2048 + hq * 128; \
        const bf16_t* tr_ = (const bf16_t*)(a.ws + WS_GT) + gbase + (size_t)(c_) * 4096 + lane0 * 64; const bf16_t* ar_ = (const bf16_t*)(a.ws + WS_GA) + gbase + (size_t)(c_) * 4096 + lane0 * 64; \
        const float* vr_ = ACT + mi_ * 2048 + 1024 + hv * 128 + dvs * 32; \
        LAS unsigned char* lb_ = (LAS unsigned char*)lds + (buf_) * BUFB; \
        _Pragma("unroll") for (int x = 0; x < 16; ++x) { __builtin_amdgcn_global_load_lds((const unsigned*)(kr_ + 8 * x), (LAS unsigned*)(lb_ + O_K + 1024 * x), 16, 0, 0); \
                                                         __builtin_amdgcn_global_load_lds((const unsigned*)(qr_ + 8 * x), (LAS unsigned*)(lb_ + O_Q + 1024 * x), 16, 0, 0); } \
        _Pragma("unroll") for (int x = 0; x < 8; ++x) { __builtin_amdgcn_global_load_lds((const unsigned*)(tr_ + 8 * x), (LAS unsigned*)(lb_ + O_T + 1024 * x), 16, 0, 0); \
                                                        __builtin_amdgcn_global_load_lds((const unsigned*)(ar_ + 8 * x), (LAS unsigned*)(lb_ + O_A + 1024 * x), 16, 0, 0); \
                                                        __builtin_amdgcn_global_load_lds((const unsigned*)(vr_ + 4 * x), (LAS unsigned*)(lb_ + O_V + 1024 * x), 16, 0, 0); } \
        const float* sm_ = SM + mi_ * 32; gar = sm_[16 + dir * 8 + hv]; gbr = sm_[dir * 8 + hv]; } while (0)
    G2_DMA(0, 0);
    for (int c = 0; c < 32; ++c) {
        int lane = lane0; asm volatile("" : "+v"(lane));
        const int r32 = lane & 31, hi = lane >> 5, trq = (lane & 15) >> 2, trp = lane & 3, trc = (lane >> 4) & 1;
        const int bo = (c & 1) * BUFB;
        float GL;
        {
            const float gi = Aneg * softplus_f(gar + dtb), bi = sigmoid_f(gbr);
            const float G = wave_incl_scan(gi, lane); GL = __shfl(G, 63);
            Gs[lane] = G; Bs[lane] = bi; Es[lane] = __expf(G); Ws[lane] = __expf(GL - G);
        }
        asm volatile("s_waitcnt vmcnt(0)" ::: "memory");
        if (c + 1 < 32) G2_DMA(c + 1, (c + 1) & 1);
        LDS_WAIT();
        f32x16_t KS[2];
#pragma unroll
        for (int rt = 0; rt < 2; ++rt)
#pragma unroll
            for (int r = 0; r < 16; ++r) KS[rt][r] = 0.f;
#define LFRAG(off_) join44(*(const LAS v2u*)(ldl + (off_)), *(const LAS v2u*)(ldl + (off_) + 1024))
#pragma unroll
        for (int nt = 0; nt < 4; ++nt) {
            const bf16x8_t sb0 = acc_frag<0>(S[nt]), sb1 = acc_frag<1>(S[nt]);
#pragma unroll
            for (int rt = 0; rt < 2; ++rt) {
                const int ro = bo + O_K + ((4 * nt) * 64 + 32 * rt + r32) * 16 + 8 * hi;
                KS[rt] = __builtin_amdgcn_mfma_f32_32x32x16_bf16(LFRAG(ro), sb0, KS[rt], 0, 0, 0); KS[rt] = __builtin_amdgcn_mfma_f32_32x32x16_bf16(LFRAG(ro + 2048), sb1, KS[rt], 0, 0, 0);
            }
        }
        asm volatile("" ::: "memory");
        f32x16_t rhs[2];
#pragma unroll
        for (int rt = 0; rt < 2; ++rt)
#pragma unroll
            for (int r = 0; r < 16; ++r) { const int i = 32 * rt + (r & 3) + 8 * (r >> 2) + 4 * hi;
                const float vv = *(const LAS float*)(ldl + bo + O_V + ((r32 >> 2) * 64 + i) * 16 + (r32 & 3) * 4); const float bi = Bs[i];
                rhs[rt][r] = bi * vv - bi * Es[i] * KS[rt][r]; }
        asm volatile("" ::: "memory");
        f32x16_t vn[2];
#pragma unroll
        for (int r = 0; r < 16; ++r) { vn[0][r] = 0.f; vn[1][r] = 0.f; }
        {
            const bf16x8_t rb00 = acc_frag<0>(rhs[0]), rb01 = acc_frag<1>(rhs[0]), rb10 = acc_frag<0>(rhs[1]), rb11 = acc_frag<1>(rhs[1]);
            const int t0 = bo + O_T + r32 * 16 + 8 * hi, t1 = t0 + 512;
            vn[0] = __builtin_amdgcn_mfma_f32_32x32x16_bf16(LFRAG(t0), rb00, vn[0], 0, 0, 0); vn[0] = __builtin_amdgcn_mfma_f32_32x32x16_bf16(LFRAG(t0 + 2048), rb01, vn[0], 0, 0, 0);
            vn[1] = __builtin_amdgcn_mfma_f32_32x32x16_bf16(LFRAG(t1), rb00, vn[1], 0, 0, 0); vn[1] = __builtin_amdgcn_mfma_f32_32x32x16_bf16(LFRAG(t1 + 2048), rb01, vn[1], 0, 0, 0);
            vn[1] = __builtin_amdgcn_mfma_f32_32x32x16_bf16(LFRAG(t1 + 4096), rb10, vn[1], 0, 0, 0); vn[1] = __builtin_amdgcn_mfma_f32_32x32x16_bf16(LFRAG(t1 + 6144), rb11, vn[1], 0, 0, 0);
        }
        asm volatile("" ::: "memory");
        f32x16_t QS[2];
#pragma unroll
        for (int rt = 0; rt < 2; ++rt)
#pragma unroll
            for (int r = 0; r < 16; ++r) QS[rt][r] = 0.f;
#pragma unroll
        for (int nt = 0; nt < 4; ++nt) {
            const bf16x8_t sb0 = acc_frag<0>(S[nt]), sb1 = acc_frag<1>(S[nt]);
#pragma unroll
            for (int rt = 0; rt < 2; ++rt) {
                const int ro = bo + O_Q + ((4 * nt) * 64 + 32 * rt + r32) * 16 + 8 * hi;
                QS[rt] = __builtin_amdgcn_mfma_f32_32x32x16_bf16(LFRAG(ro), sb0, QS[rt], 0, 0, 0); QS[rt] = __builtin_amdgcn_mfma_f32_32x32x16_bf16(LFRAG(ro + 2048), sb1, QS[rt], 0, 0, 0);
            }
        }
        asm volatile("" ::: "memory");
        {
            const bf16x8_t vb00 = acc_frag<0>(vn[0]), vb01 = acc_frag<1>(vn[0]), vb10 = acc_frag<0>(vn[1]), vb11 = acc_frag<1>(vn[1]);
            const int a0 = bo + O_A + r32 * 16 + 8 * hi, a1 = a0 + 512;
            f32x16_t o0, o1;
#pragma unroll
            for (int r = 0; r < 16; ++r) { const int il = (r & 3) + 8 * (r >> 2) + 4 * hi; o0[r] = Es[il] * QS[0][r]; o1[r] = Es[32 + il] * QS[1][r]; }
            o0 = __builtin_amdgcn_mfma_f32_32x32x16_bf16(LFRAG(a0), vb00, o0, 0, 0, 0); o0 = __builtin_amdgcn_mfma_f32_32x32x16_bf16(LFRAG(a0 + 2048), vb01, o0, 0, 0, 0);
            o1 = __builtin_amdgcn_mfma_f32_32x32x16_bf16(LFRAG(a1), vb00, o1, 0, 0, 0); o1 = __builtin_amdgcn_mfma_f32_32x32x16_bf16(LFRAG(a1 + 2048), vb01, o1, 0, 0, 0);
            o1 = __builtin_amdgcn_mfma_f32_32x32x16_bf16(LFRAG(a1 + 4096), vb10, o1, 0, 0, 0); o1 = __builtin_amdgcn_mfma_f32_32x32x16_bf16(LFRAG(a1 + 6144), vb11, o1, 0, 0, 0);
#pragma unroll
            for (int r = 0; r < 16; ++r) { const int il = (r & 3) + 8 * (r >> 2) + 4 * hi; ot[il * 33 + r32] = o0[r]; ot[(32 + il) * 33 + r32] = o1[r]; }
            LDS_WAIT();
            { const int t = dir ? SEQ - 1 - (64 * c + lane) : 64 * c + lane; float* orow = O + ((size_t)b * SEQ + t) * 1024 + hv * 128 + dvs * 32;
#pragma unroll
              for (int x = 0; x < 8; ++x) *(f32x4*)(orow + 4 * x) = (f32x4){ot[lane * 33 + 4 * x], ot[lane * 33 + 4 * x + 1], ot[lane * 33 + 4 * x + 2], ot[lane * 33 + 4 * x + 3]}; }
        }
        asm volatile("" ::: "memory");
        {
#pragma unroll
            for (int r = 0; r < 16; ++r) { const int il = (r & 3) + 8 * (r >> 2) + 4 * hi; vn[0][r] *= Ws[il]; vn[1][r] *= Ws[32 + il]; }
            const bf16x8_t wb[4] = {acc_frag<0>(vn[0]), acc_frag<1>(vn[0]), acc_frag<0>(vn[1]), acc_frag<1>(vn[1])};
            const float eGL = __expf(GL);
#pragma unroll
            for (int nt = 0; nt < 4; ++nt) {
#pragma unroll
                for (int r = 0; r < 16; ++r) S[nt][r] *= eGL;
#pragma unroll
                for (int ks = 0; ks < 4; ++ks) {
                    const int ro = bo + O_K + ((4 * nt + 2 * trc + (trp >> 1)) * 64 + 16 * ks + 4 * hi + trq) * 16 + 8 * (trp & 1);
                    const s16x4_t lo = __builtin_bit_cast(s16x4_t, __builtin_amdgcn_ds_read_tr16_b64_v4i16((LAS s16x4_t*)(ldl + ro)));
                    const s16x4_t hi4 = __builtin_bit_cast(s16x4_t, __builtin_amdgcn_ds_read_tr16_b64_v4i16((LAS s16x4_t*)(ldl + ro + 8 * 16)));
                    const bf16x8_t kf = (bf16x8_t){lo[0], lo[1], lo[2], lo[3], hi4[0], hi4[1], hi4[2], hi4[3]};
                    S[nt] = __builtin_amdgcn_mfma_f32_32x32x16_bf16(kf, wb[ks], S[nt], 0, 0, 0);
                }
            }
        }
        LDS_WAIT();
    }
#undef LFRAG
#undef G2_DMA
}

namespace gdn3 {
constexpr int ABUF = 32768, A_K = 0, A_T = 16384, A_V = 24576, O_BR = 65536, BBUF = 24576, B_Q = 0, B_A = 16384, O_CM = 114688, CMB = 12800, CM_VB = 8192, CM_ES = 12288, O_SC = 140288, O_OT = 141312, O_FLAG = 149760, O_END = 149824;
__device__ __forceinline__ void spin_ge(const LAS unsigned char* ldl, int off, unsigned target) {
    for (;;) { const unsigned v = __builtin_amdgcn_readfirstlane(*(volatile const LAS unsigned*)(ldl + off)); if (v >= target) break; __builtin_amdgcn_s_sleep(1); }
    asm volatile("" ::: "memory");
}
#define G3_LFRAG(off_) join44(*(const LAS v2u*)(ldl + (off_)), *(const LAS v2u*)(ldl + (off_) + 1024))
__device__ __forceinline__ void chain(const Args& a, int item, unsigned char* lds) {
    const int dvs = item & 3, hv = (item >> 2) & 7, dir = (item >> 5) & 1, b = item >> 6, hq = hv >> 1;
    const int lane0 = threadIdx.x & 63;
    LAS unsigned char* ldw = (LAS unsigned char*)lds; const LAS unsigned char* ldl = (const LAS unsigned char*)lds;
    LAS float* Gs = (LAS float*)(ldw + O_SC); LAS float* Bs = Gs + 64; LAS float* Es = Bs + 64; LAS float* Ws = Es + 64;
    const bf16_t* QK = (const bf16_t*)(a.ws + WS_QKV16); const float* ACT = (const float*)(a.ws + WS_ACT); const float* SM = (const float*)(a.ws + WS_SMALL);
    const float Aneg = -expf(a.in[dir ? 21 : 20][hv]); const float dtb = a.in[dir ? 23 : 22][hv];
    const size_t gbase = (size_t)(((b * 8 + hv) * 2 + dir) * 32) * 4096;
    f32x16_t S[4];
#pragma unroll
    for (int nt = 0; nt < 4; ++nt)
#pragma unroll
        for (int r = 0; r < 16; ++r) S[nt][r] = 0.f;
    float gar, gbr;
#define G3A_DMA(c_, buf_) do { const int t_ = dir ? SEQ - 1 - (64 * (c_) + lane0) : 64 * (c_) + lane0; const size_t mi_ = (size_t)b * SEQ + t_; \
        const bf16_t* kr_ = QK + mi_ * 2048 + 512 + hq * 128; const bf16_t* tr_ = (const bf16_t*)(a.ws + WS_GT) + gbase + (size_t)(c_) * 4096 + lane0 * 64; \
        const float* vr_ = ACT + mi_ * 2048 + 1024 + hv * 128 + dvs * 32; LAS unsigned char* lb_ = ldw + (buf_) * ABUF; \
        _Pragma("unroll") for (int x = 0; x < 16; ++x) __builtin_amdgcn_global_load_lds((const unsigned*)(kr_ + 8 * x), (LAS unsigned*)(lb_ + A_K + 1024 * x), 16, 0, 0); \
        _Pragma("unroll") for (int x = 0; x < 8; ++x) { __builtin_amdgcn_global_load_lds((const unsigned*)(tr_ + 8 * x), (LAS unsigned*)(lb_ + A_T + 1024 * x), 16, 0, 0); \
                                                        __builtin_amdgcn_global_load_lds((const unsigned*)(vr_ + 4 * x), (LAS unsigned*)(lb_ + A_V + 1024 * x), 16, 0, 0); } \
        const float* sm_ = SM + mi_ * 32; gar = sm_[16 + dir * 8 + hv]; gbr = sm_[dir * 8 + hv]; } while (0)
    G3A_DMA(0, 0);
    for (int c = 0; c < 32; ++c) {
        int lane = lane0; asm volatile("" : "+v"(lane));
        const int r32 = lane & 31, hi = lane >> 5, trq = (lane & 15) >> 2, trp = lane & 3, trc = (lane >> 4) & 1;
        const int bo = (c & 1) * ABUF, cm = O_CM + (c & 1) * CMB;
        float GL, eG;
        {   const float gi = Aneg * softplus_f(gar + dtb), bi = sigmoid_f(gbr);
            const float G = wave_incl_scan(gi, lane); GL = __shfl(G, 63); eG = __expf(G);
            Gs[lane] = G; Bs[lane] = bi; Es[lane] = eG; Ws[lane] = __expf(GL - G); }
        asm volatile("s_waitcnt vmcnt(0)" ::: "memory");
        if (c + 1 < 32) G3A_DMA(c + 1, (c + 1) & 1);
        if (c >= 2) spin_ge(ldl, O_FLAG + 4, (unsigned)(c - 1));
        *(LAS float*)(ldw + cm + CM_ES + lane * 4) = eG;
        LDS_WAIT();
        f32x16_t KS[2];
#pragma unroll
        for (int rt = 0; rt < 2; ++rt)
#pragma unroll
            for (int r = 0; r < 16; ++r) KS[rt][r] = 0.f;
#pragma unroll
        for (int nt = 0; nt < 4; ++nt) {
            const bf16x8_t sb0 = acc_frag<0>(S[nt]), sb1 = acc_frag<1>(S[nt]);
            *(LAS bf16x8_t*)(ldw + cm + (2 * nt) * 1024 + lane * 16) = sb0; *(LAS bf16x8_t*)(ldw + cm + (2 * nt + 1) * 1024 + lane * 16) = sb1;
#pragma unroll
            for (int rt = 0; rt < 2; ++rt) {
                const int ro = bo + A_K + ((4 * nt) * 64 + 32 * rt + r32) * 16 + 8 * hi;
                KS[rt] = __builtin_amdgcn_mfma_f32_32x32x16_bf16(G3_LFRAG(ro), sb0, KS[rt], 0, 0, 0); KS[rt] = __builtin_amdgcn_mfma_f32_32x32x16_bf16(G3_LFRAG(ro + 2048), sb1, KS[rt], 0, 0, 0);
            }
        }
        asm volatile("" ::: "memory");
        f32x16_t rhs[2];
#pragma unroll
        for (int rt = 0; rt < 2; ++rt)
#pragma unroll
            for (int r = 0; r < 16; ++r) { const int i = 32 * rt + (r & 3) + 8 * (r >> 2) + 4 * hi;
                const float vv = *(const LAS float*)(ldl + bo + A_V + ((r32 >> 2) * 64 + i) * 16 + (r32 & 3) * 4); const float bi = Bs[i];
                rhs[rt][r] = bi * vv - bi * Es[i] * KS[rt][r]; }
        asm volatile("" ::: "memory");
        f32x16_t vn[2];
#pragma unroll
        for (int r = 0; r < 16; ++r) { vn[0][r] = 0.f; vn[1][r] = 0.f; }
        {   const bf16x8_t rb00 = acc_frag<0>(rhs[0]), rb01 = acc_frag<1>(rhs[0]), rb10 = acc_frag<0>(rhs[1]), rb11 = acc_frag<1>(rhs[1]);
            const int t0 = bo + A_T + r32 * 16 + 8 * hi, t1 = t0 + 512;
            vn[0] = __builtin_amdgcn_mfma_f32_32x32x16_bf16(G3_LFRAG(t0), rb00, vn[0], 0, 0, 0); vn[0] = __builtin_amdgcn_mfma_f32_32x32x16_bf16(G3_LFRAG(t0 + 2048), rb01, vn[0], 0, 0, 0);
            vn[1] = __builtin_amdgcn_mfma_f32_32x32x16_bf16(G3_LFRAG(t1), rb00, vn[1], 0, 0, 0); vn[1] = __builtin_amdgcn_mfma_f32_32x32x16_bf16(G3_LFRAG(t1 + 2048), rb01, vn[1], 0, 0, 0);
            vn[1] = __builtin_amdgcn_mfma_f32_32x32x16_bf16(G3_LFRAG(t1 + 4096), rb10, vn[1], 0, 0, 0); vn[1] = __builtin_amdgcn_mfma_f32_32x32x16_bf16(G3_LFRAG(t1 + 6144), rb11, vn[1], 0, 0, 0); }
        *(LAS bf16x8_t*)(ldw + cm + CM_VB + 0 * 1024 + lane * 16) = acc_frag<0>(vn[0]); *(LAS bf16x8_t*)(ldw + cm + CM_VB + 1 * 1024 + lane * 16) = acc_frag<1>(vn[0]);
        *(LAS bf16x8_t*)(ldw + cm + CM_VB + 2 * 1024 + lane * 16) = acc_frag<0>(vn[1]); *(LAS bf16x8_t*)(ldw + cm + CM_VB + 3 * 1024 + lane * 16) = acc_frag<1>(vn[1]);
        LDS_WAIT();
        if (lane == 0) *(volatile LAS unsigned*)(ldw + O_FLAG) = (unsigned)(c + 1);
        asm volatile("" ::: "memory");
        {
#pragma unroll
            for (int r = 0; r < 16; ++r) { const int il = (r & 3) + 8 * (r >> 2) + 4 * hi; vn[0][r] *= Ws[il]; vn[1][r] *= Ws[32 + il]; }
            const bf16x8_t wb[4] = {acc_frag<0>(vn[0]), acc_frag<1>(vn[0]), acc_frag<0>(vn[1]), acc_frag<1>(vn[1])};
            const float eGL = __expf(GL);
#pragma unroll
            for (int nt = 0; nt < 4; ++nt) {
#pragma unroll
                for (int r = 0; r < 16; ++r) S[nt][r] *= eGL;
#pragma unroll
                for (int ks = 0; ks < 4; ++ks) {
                    const int ro = bo + A_K + ((4 * nt + 2 * trc + (trp >> 1)) * 64 + 16 * ks + 4 * hi + trq) * 16 + 8 * (trp & 1);
                    const s16x4_t lo = __builtin_bit_cast(s16x4_t, __builtin_amdgcn_ds_read_tr16_b64_v4i16((LAS s16x4_t*)(ldl + ro)));
                    const s16x4_t hi4 = __builtin_bit_cast(s16x4_t, __builtin_amdgcn_ds_read_tr16_b64_v4i16((LAS s16x4_t*)(ldl + ro + 8 * 16)));
                    const bf16x8_t kf = (bf16x8_t){lo[0], lo[1], lo[2], lo[3], hi4[0], hi4[1], hi4[2], hi4[3]};
                    S[nt] = __builtin_amdgcn_mfma_f32_32x32x16_bf16(kf, wb[ks], S[nt], 0, 0, 0);
                }
            }
        }
        LDS_WAIT();
    }
#undef G3A_DMA
}
__device__ __forceinline__ void output(const Args& a, int item, unsigned char* lds) {
    const int dvs = item & 3, hv = (item >> 2) & 7, dir = (item >> 5) & 1, b = item >> 6, hq = hv >> 1;
    const int lane0 = threadIdx.x & 63;
    LAS unsigned char* ldw = (LAS unsigned char*)lds; const LAS unsigned char* ldl = (const LAS unsigned char*)lds;
    LAS float* ot = (LAS float*)(ldw + O_OT);
    const bf16_t* QK = (const bf16_t*)(a.ws + WS_QKV16);
    float* O = (float*)(a.ws + (dir ? WS_YB : WS_YF));
    const size_t gbase = (size_t)(((b * 8 + hv) * 2 + dir) * 32) * 4096;
#define G3B_DMA(c_, buf_) do { const int t_ = dir ? SEQ - 1 - (64 * (c_) + lane0) : 64 * (c_) + lane0; const size_t mi_ = (size_t)b * SEQ + t_; \
        const bf16_t* qr_ = QK + mi_ * 2048 + hq * 128; const bf16_t* ar_ = (const bf16_t*)(a.ws + WS_GA) + gbase + (size_t)(c_) * 4096 + lane0 * 64; \
        LAS unsigned char* lb_ = ldw + O_BR + (buf_) * BBUF; \
        _Pragma("unroll") for (int x = 0; x < 16; ++x) __builtin_amdgcn_global_load_lds((const unsigned*)(qr_ + 8 * x), (LAS unsigned*)(lb_ + B_Q + 1024 * x), 16, 0, 0); \
        _Pragma("unroll") for (int x = 0; x < 8; ++x) __builtin_amdgcn_global_load_lds((const unsigned*)(ar_ + 8 * x), (LAS unsigned*)(lb_ + B_A + 1024 * x), 16, 0, 0); } while (0)
    G3B_DMA(0, 0);
    for (int c = 0; c < 32; ++c) {
        int lane = lane0; asm volatile("" : "+v"(lane));
        const int r32 = lane & 31, hi = lane >> 5;
        const int bo = O_BR + (c & 1) * BBUF, cm = O_CM + (c & 1) * CMB;
        asm volatile("s_waitcnt vmcnt(0)" ::: "memory");
        if (c + 1 < 32) G3B_DMA(c + 1, (c + 1) & 1);
        spin_ge(ldl, O_FLAG, (unsigned)(c + 1));
        f32x16_t QS[2];
#pragma unroll
        for (int rt = 0; rt < 2; ++rt)
#pragma unroll
            for (int r = 0; r < 16; ++r) QS[rt][r] = 0.f;
#pragma unroll
        for (int nt = 0; nt < 4; ++nt) {
            const bf16x8_t sb0 = *(const LAS bf16x8_t*)(ldl + cm + (2 * nt) * 1024 + lane * 16), sb1 = *(const LAS bf16x8_t*)(ldl + cm + (2 * nt + 1) * 1024 + lane * 16);
#pragma unroll
            for (int rt = 0; rt < 2; ++rt) {
                const int ro = bo + B_Q + ((4 * nt) * 64 + 32 * rt + r32) * 16 + 8 * hi;
                QS[rt] = __builtin_amdgcn_mfma_f32_32x32x16_bf16(G3_LFRAG(ro), sb0, QS[rt], 0, 0, 0); QS[rt] = __builtin_amdgcn_mfma_f32_32x32x16_bf16(G3_LFRAG(ro + 2048), sb1, QS[rt], 0, 0, 0);
            }
        }
        {   const bf16x8_t vb00 = *(const LAS bf16x8_t*)(ldl + cm + CM_VB + lane * 16), vb01 = *(const LAS bf16x8_t*)(ldl + cm + CM_VB + 1024 + lane * 16);
            const bf16x8_t vb10 = *(const LAS bf16x8_t*)(ldl + cm + CM_VB + 2048 + lane * 16), vb11 = *(const LAS bf16x8_t*)(ldl + cm + CM_VB + 3072 + lane * 16);
            const LAS float* Es = (const LAS float*)(ldl + cm + CM_ES);
            const int a0 = bo + B_A + r32 * 16 + 8 * hi, a1 = a0 + 512;
            f32x16_t o0, o1;
#pragma unroll
            for (int r = 0; r < 16; ++r) { const int il = (r & 3) + 8 * (r >> 2) + 4 * hi; o0[r] = Es[il] * QS[0][r]; o1[r] = Es[32 + il] * QS[1][r]; }
            o0 = __builtin_amdgcn_mfma_f32_32x32x16_bf16(G3_LFRAG(a0), vb00, o0, 0, 0, 0); o0 = __builtin_amdgcn_mfma_f32_32x32x16_bf16(G3_LFRAG(a0 + 2048), vb01, o0, 0, 0, 0);
            o1 = __builtin_amdgcn_mfma_f32_32x32x16_bf16(G3_LFRAG(a1), vb00, o1, 0, 0, 0); o1 = __builtin_amdgcn_mfma_f32_32x32x16_bf16(G3_LFRAG(a1 + 2048), vb01, o1, 0, 0, 0);
            o1 = __builtin_amdgcn_mfma_f32_32x32x16_bf16(G3_LFRAG(a1 + 4096), vb10, o1, 0, 0, 0); o1 = __builtin_amdgcn_mfma_f32_32x32x16_bf16(G3_LFRAG(a1 + 6144), vb11, o1, 0, 0, 0);
#pragma unroll
            for (int r = 0; r < 16; ++r) { const int il = (r & 3) + 8 * (r >> 2) + 4 * hi; ot[il * 33 + r32] = o0[r]; ot[(32 + il) * 33 + r32] = o1[r]; }
        }
        LDS_WAIT();
        if (lane == 0) *(volatile LAS unsigned*)(ldw + O_FLAG + 4) = (unsigned)(c + 1);
        { const int t = dir ? SEQ - 1 - (64 * c + lane) : 64 * c + lane; float* orow = O + ((size_t)b * SEQ + t) * 1024 + hv * 128 + dvs * 32;
#pragma unroll
          for (int x = 0; x < 8; ++x) *(f32x4*)(orow + 4 * x) = (f32x4){ot[lane * 33 + 4 * x], ot[lane * 33 + 4 * x + 1], ot[lane * 33 + 4 * x + 2], ot[lane * 33 + 4 * x + 3]}; }
        LDS_WAIT();
    }
#undef G3B_DMA
}
#undef G3_LFRAG
}

__device__ __forceinline__ void ssd2_item(const Args& a, int item, unsigned char* lds) {
    const int ps = item & 1, h = (item >> 1) & 15, dir = (item >> 5) & 1, b = item >> 6, g = h >> 3;
    const int lane0 = threadIdx.x & 63;
    constexpr int BUFB = 40960, O_B = 0, O_C = 16384, O_X = 32768, O_XD = 2 * BUFB + 512, O_XW = O_XD + 64 * 72;
    float* Gs = (float*)(lds + 2 * BUFB); float* Es = Gs + 64; float* ot = (float*)(lds + O_XW + 64 * 72);
    const LAS unsigned char* ldl = (const LAS unsigned char*)lds;
    const bf16_t* XB = (const bf16_t*)(a.ws + WS_XBC16); const float* ACT = (const float*)(a.ws + WS_ACT); const float* SM = (const float*)(a.ws + WS_SMALL);
    float* Y = (float*)(a.ws + (dir ? WS_YB : WS_YF));
    const float A = -expf(a.in[dir ? 13 : 12][h]); const float dtb = a.in[dir ? 11 : 10][h];
    f32x16_t H[4];
#pragma unroll
    for (int nt = 0; nt < 4; ++nt)
#pragma unroll
        for (int r = 0; r < 16; ++r) H[nt][r] = 0.f;
    float gdr;
#define S2_DMA(c_, buf_) do { const int t_ = dir ? SEQ - 1 - (64 * (c_) + lane0) : 64 * (c_) + lane0; const size_t mi_ = (size_t)b * SEQ + t_; \
        const bf16_t* br_ = XB + mi_ * 1536 + 1024 + g * 128; const bf16_t* cr_ = XB + mi_ * 1536 + 1280 + g * 128; const float* xr_ = ACT + mi_ * 1536 + h * 64 + ps * 32; \
        LAS unsigned char* lb_ = (LAS unsigned char*)lds + (buf_) * BUFB; \
        _Pragma("unroll") for (int x = 0; x < 16; ++x) { __builtin_amdgcn_global_load_lds((const unsigned*)(br_ + 8 * x), (LAS unsigned*)(lb_ + O_B + 1024 * x), 16, 0, 0); \
                                                         __builtin_amdgcn_global_load_lds((const unsigned*)(cr_ + 8 * x), (LAS unsigned*)(lb_ + O_C + 1024 * x), 16, 0, 0); } \
        _Pragma("unroll") for (int x = 0; x < 8; ++x) __builtin_amdgcn_global_load_lds((const unsigned*)(xr_ + 4 * x), (LAS unsigned*)(lb_ + O_X + 1024 * x), 16, 0, 0); \
        gdr = SM[mi_ * 32 + dir * 16 + h]; } while (0)
    S2_DMA(0, 0);
    for (int c = 0; c < 32; ++c) {
        int lane = lane0; asm volatile("" : "+v"(lane));
        const int r32 = lane & 31, hi = lane >> 5, trq = (lane & 15) >> 2, trp = lane & 3, trc = (lane >> 4) & 1;
        const int bo = (c & 1) * BUFB;
        const float dt = softplus_f(gdr + dtb);
        const float cs = wave_incl_scan(dt * A, lane); const float csL = __shfl(cs, 63);
        Gs[lane] = cs; Es[lane] = __expf(cs);
        asm volatile("s_waitcnt vmcnt(0)" ::: "memory");
        if (c + 1 < 32) S2_DMA(c + 1, (c + 1) & 1);
        {
            const float wsc = dt * __expf(csL - cs);
#pragma unroll
            for (int x = 0; x < 8; ++x) { const f32x4 xv = *(const LAS f32x4*)(ldl + bo + O_X + (x * 64 + lane) * 16);
                v2u d; d.x = cvtpk_rne(xv.x * dt, xv.y * dt); d.y = cvtpk_rne(xv.z * dt, xv.w * dt); *(LAS v2u*)((LAS unsigned char*)lds + O_XD + lane * 72 + 8 * x) = d;
                v2u w; w.x = cvtpk_rne(xv.x * wsc, xv.y * wsc); w.y = cvtpk_rne(xv.z * wsc, xv.w * wsc); *(LAS v2u*)((LAS unsigned char*)lds + O_XW + lane * 72 + 8 * x) = w; }
        }
        LDS_WAIT();
        f32x16_t g00, g01, g11;
#pragma unroll
        for (int r = 0; r < 16; ++r) { g00[r] = 0.f; g01[r] = 0.f; g11[r] = 0.f; }
#pragma unroll
        for (int kk = 0; kk < 8; ++kk) { const int fo = ((2 * kk + hi) * 64 + r32) * 16;
            const bf16x8_t A0 = *(const LAS bf16x8_t*)(ldl + bo + O_B + fo), A1 = *(const LAS bf16x8_t*)(ldl + bo + O_B + fo + 512);
            const bf16x8_t B0 = *(const LAS bf16x8_t*)(ldl + bo + O_C + fo), B1 = *(const LAS bf16x8_t*)(ldl + bo + O_C + fo + 512);
            g00 = __builtin_amdgcn_mfma_f32_32x32x16_bf16(A0, B0, g00, 0, 0, 0); g01 = __builtin_amdgcn_mfma_f32_32x32x16_bf16(A0, B1, g01, 0, 0, 0); g11 = __builtin_amdgcn_mfma_f32_32x32x16_bf16(A1, B1, g11, 0, 0, 0); }
        {   const float cst0 = Gs[r32], cst1 = Gs[32 + r32];
#pragma unroll
            for (int r = 0; r < 16; ++r) { const int il = (r & 3) + 8 * (r >> 2) + 4 * hi; const float css0 = Gs[il], css1 = Gs[32 + il];
                g00[r] = (il <= r32) ? g00[r] * __expf(cst0 - css0) : 0.f; g01[r] = g01[r] * __expf(cst1 - css0); g11[r] = (il <= r32) ? g11[r] * __expf(cst1 - css1) : 0.f; } }
        asm volatile("" ::: "memory");
        f32x16_t y0, y1;
#pragma unroll
        for (int r = 0; r < 16; ++r) { y0[r] = 0.f; y1[r] = 0.f; }
#define TRFRAG(base_) ({ const s16x4_t lo_ = __builtin_bit_cast(s16x4_t, __builtin_amdgcn_ds_read_tr16_b64_v4i16((LAS s16x4_t*)(ldl + (base_)))); \
                         const s16x4_t hi_ = __builtin_bit_cast(s16x4_t, __builtin_amdgcn_ds_read_tr16_b64_v4i16((LAS s16x4_t*)(ldl + (base_) + 8 * 72))); \
                         (bf16x8_t){lo_[0], lo_[1], lo_[2], lo_[3], hi_[0], hi_[1], hi_[2], hi_[3]}; })
        {   const int xo = O_XD + (4 * hi + trq) * 72 + (16 * trc + 4 * trp) * 2;
            const bf16x8_t x0 = TRFRAG(xo), x1 = TRFRAG(xo + 16 * 72), x2 = TRFRAG(xo + 32 * 72), x3 = TRFRAG(xo + 48 * 72);
            y0 = __builtin_amdgcn_mfma_f32_32x32x16_bf16(acc_frag<0>(g00), x0, y0, 0, 0, 0); y0 = __builtin_amdgcn_mfma_f32_32x32x16_bf16(acc_frag<1>(g00), x1, y0, 0, 0, 0);
            y1 = __builtin_amdgcn_mfma_f32_32x32x16_bf16(acc_frag<0>(g01), x0, y1, 0, 0, 0); y1 = __builtin_amdgcn_mfma_f32_32x32x16_bf16(acc_frag<1>(g01), x1, y1, 0, 0, 0);
            y1 = __builtin_amdgcn_mfma_f32_32x32x16_bf16(acc_frag<0>(g11), x2, y1, 0, 0, 0); y1 = __builtin_amdgcn_mfma_f32_32x32x16_bf16(acc_frag<1>(g11), x3, y1, 0, 0, 0); }
        asm volatile("" ::: "memory");
        {   f32x16_t Z0, Z1;
#pragma unroll
            for (int r = 0; r < 16; ++r) { Z0[r] = 0.f; Z1[r] = 0.f; }
#define LFRAG(off_) join44(*(const LAS v2u*)(ldl + (off_)), *(const LAS v2u*)(ldl + (off_) + 1024))
#pragma unroll
            for (int nt = 0; nt < 4; ++nt) { const bf16x8_t hb0 = acc_frag<0>(H[nt]), hb1 = acc_frag<1>(H[nt]);
                const int ro = bo + O_C + ((4 * nt) * 64 + r32) * 16 + 8 * hi;
                Z0 = __builtin_amdgcn_mfma_f32_32x32x16_bf16(LFRAG(ro), hb0, Z0, 0, 0, 0); Z0 = __builtin_amdgcn_mfma_f32_32x32x16_bf16(LFRAG(ro + 2048), hb1, Z0, 0, 0, 0);
                Z1 = __builtin_amdgcn_mfma_f32_32x32x16_bf16(LFRAG(ro + 512), hb0, Z1, 0, 0, 0); Z1 = __builtin_amdgcn_mfma_f32_32x32x16_bf16(LFRAG(ro + 512 + 2048), hb1, Z1, 0, 0, 0); }
#undef LFRAG
#pragma unroll
            for (int r = 0; r < 16; ++r) { const int il = (r & 3) + 8 * (r >> 2) + 4 * hi; ot[il * 33 + r32] = fmaf(Es[il], Z0[r], y0[r]); ot[(32 + il) * 33 + r32] = fmaf(Es[32 + il], Z1[r], y1[r]); } }
        LDS_WAIT();
        { const int t = dir ? SEQ - 1 - (64 * c + lane) : 64 * c + lane; float* yrow = Y + ((size_t)b * SEQ + t) * 1024 + h * 64 + ps * 32;
#pragma unroll
          for (int x = 0; x < 8; ++x) *(f32x4*)(yrow + 4 * x) = (f32x4){ot[lane * 33 + 4 * x], ot[lane * 33 + 4 * x + 1], ot[lane * 33 + 4 * x + 2], ot[lane * 33 + 4 * x + 3]}; }
        asm volatile("" ::: "memory");
        {   const float eL = __expf(csL);
            const int xo = O_XW + (4 * hi + trq) * 72 + (16 * trc + 4 * trp) * 2;
            const bf16x8_t w0 = TRFRAG(xo), w1 = TRFRAG(xo + 16 * 72), w2 = TRFRAG(xo + 32 * 72), w3 = TRFRAG(xo + 48 * 72);
#undef TRFRAG
#pragma unroll
            for (int nt = 0; nt < 4; ++nt) {
#pragma unroll
                for (int r = 0; r < 16; ++r) H[nt][r] *= eL;
#pragma unroll
                for (int ks = 0; ks < 4; ++ks) {
                    const int ro = bo + O_B + ((4 * nt + 2 * trc + (trp >> 1)) * 64 + 16 * ks + 4 * hi + trq) * 16 + 8 * (trp & 1);
                    const s16x4_t lo = __builtin_bit_cast(s16x4_t, __builtin_amdgcn_ds_read_tr16_b64_v4i16((LAS s16x4_t*)(ldl + ro)));
                    const s16x4_t hi4 = __builtin_bit_cast(s16x4_t, __builtin_amdgcn_ds_read_tr16_b64_v4i16((LAS s16x4_t*)(ldl + ro + 8 * 16)));
                    const bf16x8_t bfr = (bf16x8_t){lo[0], lo[1], lo[2], lo[3], hi4[0], hi4[1], hi4[2], hi4[3]};
                    H[nt] = __builtin_amdgcn_mfma_f32_32x32x16_bf16(bfr, ks == 0 ? w0 : ks == 1 ? w1 : ks == 2 ? w2 : w3, H[nt], 0, 0, 0);
                }
            }
        }
        LDS_WAIT();
    }
#undef S2_DMA
}

namespace ssd3 {
constexpr int O_DT = 98304, O_XD = 98816, O_OUT = 108032, OUTB = 13312, OO_XW = 512, OO_Y = 512 + 4608, O_FLAG = 147968, O_END = 148224;
__device__ __forceinline__ void spin_ge(const LAS unsigned char* ldl, int off, unsigned target) {
    for (;;) { const unsigned v = __builtin_amdgcn_readfirstlane(*(volatile const LAS unsigned*)(ldl + off)); if (v >= target) break; __builtin_amdgcn_s_sleep(1); }
    asm volatile("" ::: "memory");
}
#define S3_TRFRAG(base_) ({ const s16x4_t lo_ = __builtin_bit_cast(s16x4_t, __builtin_amdgcn_ds_read_tr16_b64_v4i16((LAS s16x4_t*)(ldl + (base_)))); \
                            const s16x4_t hi_ = __builtin_bit_cast(s16x4_t, __builtin_amdgcn_ds_read_tr16_b64_v4i16((LAS s16x4_t*)(ldl + (base_) + 8 * 72))); \
                            (bf16x8_t){lo_[0], lo_[1], lo_[2], lo_[3], hi_[0], hi_[1], hi_[2], hi_[3]}; })
__device__ __forceinline__ void producer(const Args& a, int item, unsigned char* lds, int p) {
    const int ps = item & 1, h = (item >> 1) & 15, dir = (item >> 5) & 1, b = item >> 6, g = h >> 3;
    const int lane0 = threadIdx.x & 63;
    const LAS unsigned char* ldl = (const LAS unsigned char*)lds; LAS unsigned char* ldw = (LAS unsigned char*)lds;
    const bf16_t* XB = (const bf16_t*)(a.ws + WS_XBC16); const float* ACT = (const float*)(a.ws + WS_ACT); const float* SM = (const float*)(a.ws + WS_SMALL);
    const float A = -expf(a.in[dir ? 13 : 12][h]); const float dtb = a.in[dir ? 11 : 10][h];
#define S3_DMA(c_, slot3_) do { const int t_ = dir ? SEQ - 1 - (64 * (c_) + lane0) : 64 * (c_) + lane0; const size_t mi_ = (size_t)b * SEQ + t_; \
        const bf16_t* br_ = XB + mi_ * 1536 + 1024 + g * 128; const bf16_t* cr_ = XB + mi_ * 1536 + 1280 + g * 128; const float* xr_ = ACT + mi_ * 1536 + h * 64 + ps * 32; \
        LAS unsigned char* lb_ = ldw + (slot3_) * 32768; LAS unsigned char* lx_ = ldw + O_OUT + (slot3_) * OUTB + OO_Y; \
        _Pragma("unroll") for (int x = 0; x < 16; ++x) { __builtin_amdgcn_global_load_lds((const unsigned*)(br_ + 8 * x), (LAS unsigned*)(lb_ + 1024 * x), 16, 0, 0); \
                                                         __builtin_amdgcn_global_load_lds((const unsigned*)(cr_ + 8 * x), (LAS unsigned*)(lb_ + 16384 + 1024 * x), 16, 0, 0); } \
        _Pragma("unroll") for (int x = 0; x < 8; ++x) __builtin_amdgcn_global_load_lds((const unsigned*)(xr_ + 4 * x), (LAS unsigned*)(lx_ + 1024 * x), 16, 0, 0); \
        __builtin_amdgcn_global_load_lds((const unsigned*)(SM + mi_ * 32 + dir * 16 + h), (LAS unsigned*)(ldw + O_DT + p * 256), 4, 0, 0); } while (0)
    int slot3 = p;
    for (int c = p; c < 32; c += 2) {
        int lane = lane0; asm volatile("" : "+v"(lane));
        const int r32 = lane & 31, hi = lane >> 5, trq = (lane & 15) >> 2, trp = lane & 3, trc = (lane >> 4) & 1;
        const int bo = slot3 * 32768, oo = O_OUT + slot3 * OUTB;
        if (c >= 3) spin_ge(ldl, O_FLAG, (unsigned)(c - 2));
        S3_DMA(c, slot3);
        asm volatile("s_waitcnt vmcnt(0)" ::: "memory");
        LAS float* Gs = (LAS float*)(ldw + oo); LAS float* Es = Gs + 64;
        const float dt = softplus_f(*(const LAS float*)(ldl + O_DT + p * 256 + lane * 4) + dtb);
        const float cs = wave_incl_scan(dt * A, lane); const float csL = __shfl(cs, 63);
        Gs[lane] = cs; Es[lane] = __expf(cs);
        {   const float wsc = dt * __expf(csL - cs);
#pragma unroll
            for (int x = 0; x < 8; ++x) { const f32x4 xv = *(const LAS f32x4*)(ldl + oo + OO_Y + (x * 64 + lane) * 16);
                v2u d; d.x = cvtpk_rne(xv.x * dt, xv.y * dt); d.y = cvtpk_rne(xv.z * dt, xv.w * dt); *(LAS v2u*)(ldw + O_XD + p * 4608 + lane * 72 + 8 * x) = d;
                v2u w; w.x = cvtpk_rne(xv.x * wsc, xv.y * wsc); w.y = cvtpk_rne(xv.z * wsc, xv.w * wsc); *(LAS v2u*)(ldw + oo + OO_XW + lane * 72 + 8 * x) = w; }
        }
        LDS_WAIT();
        f32x16_t g00, g01, g11;
#pragma unroll
        for (int r = 0; r < 16; ++r) { g00[r] = 0.f; g01[r] = 0.f; g11[r] = 0.f; }
#pragma unroll
        for (int kk = 0; kk < 8; ++kk) { const int fo = ((2 * kk + hi) * 64 + r32) * 16;
            const bf16x8_t A0 = *(const LAS bf16x8_t*)(ldl + bo + fo), A1 = *(const LAS bf16x8_t*)(ldl + bo + fo + 512);
            const bf16x8_t B0 = *(const LAS bf16x8_t*)(ldl + bo + 16384 + fo), B1 = *(const LAS bf16x8_t*)(ldl + bo + 16384 + fo + 512);
            g00 = __builtin_amdgcn_mfma_f32_32x32x16_bf16(A0, B0, g00, 0, 0, 0); g01 = __builtin_amdgcn_mfma_f32_32x32x16_bf16(A0, B1, g01, 0, 0, 0); g11 = __builtin_amdgcn_mfma_f32_32x32x16_bf16(A1, B1, g11, 0, 0, 0); }
        {   const float cst0 = Gs[r32], cst1 = Gs[32 + r32];
#pragma unroll
            for (int r = 0; r < 16; ++r) { const int il = (r & 3) + 8 * (r >> 2) + 4 * hi; const float css0 = Gs[il], css1 = Gs[32 + il];
                g00[r] = (il <= r32) ? g00[r] * __expf(cst0 - css0) : 0.f; g01[r] = g01[r] * __expf(cst1 - css0); g11[r] = (il <= r32) ? g11[r] * __expf(cst1 - css1) : 0.f; } }
        asm volatile("" ::: "memory");
        f32x16_t y0, y1;
#pragma unroll
        for (int r = 0; r < 16; ++r) { y0[r] = 0.f; y1[r] = 0.f; }
        {   const int xo = O_XD + p * 4608 + (4 * hi + trq) * 72 + (16 * trc + 4 * trp) * 2;
            const bf16x8_t x0 = S3_TRFRAG(xo), x1 = S3_TRFRAG(xo + 16 * 72), x2 = S3_TRFRAG(xo + 32 * 72), x3 = S3_TRFRAG(xo + 48 * 72);
            y0 = __builtin_amdgcn_mfma_f32_32x32x16_bf16(acc_frag<0>(g00), x0, y0, 0, 0, 0); y0 = __builtin_amdgcn_mfma_f32_32x32x16_bf16(acc_frag<1>(g00), x1, y0, 0, 0, 0);
            y1 = __builtin_amdgcn_mfma_f32_32x32x16_bf16(acc_frag<0>(g01), x0, y1, 0, 0, 0); y1 = __builtin_amdgcn_mfma_f32_32x32x16_bf16(acc_frag<1>(g01), x1, y1, 0, 0, 0);
            y1 = __builtin_amdgcn_mfma_f32_32x32x16_bf16(acc_frag<0>(g11), x2, y1, 0, 0, 0); y1 = __builtin_amdgcn_mfma_f32_32x32x16_bf16(acc_frag<1>(g11), x3, y1, 0, 0, 0); }
#pragma unroll
        for (int r = 0; r < 16; ++r) { *(LAS float*)(ldw + oo + OO_Y + r * 256 + lane * 4) = y0[r]; *(LAS float*)(ldw + oo + OO_Y + (16 + r) * 256 + lane * 4) = y1[r]; }
        LDS_WAIT();
        if (lane == 0) *(volatile LAS unsigned*)(ldw + O_FLAG + 64 + 4 * c) = 1u;
        slot3 = (slot3 == 0) ? 2 : slot3 - 1;
    }
#undef S3_DMA
}
__device__ __forceinline__ void consumer(const Args& a, int item, unsigned char* lds) {
    const int ps = item & 1, h = (item >> 1) & 15, dir = (item >> 5) & 1, b = item >> 6;
    const int lane0 = threadIdx.x & 63;
    const LAS unsigned char* ldl = (const LAS unsigned char*)lds; LAS unsigned char* ldw = (LAS unsigned char*)lds;
    float* Y = (float*)(a.ws + (dir ? WS_YB : WS_YF));
    f32x16_t H[4];
#pragma unroll
    for (int nt = 0; nt < 4; ++nt)
#pragma unroll
        for (int r = 0; r < 16; ++r) H[nt][r] = 0.f;
    int slot3 = 0;
    for (int c = 0; c < 32; ++c) {
        int lane = lane0; asm volatile("" : "+v"(lane));
        const int r32 = lane & 31, hi = lane >> 5, trq = (lane & 15) >> 2, trp = lane & 3, trc = (lane >> 4) & 1;
        const int bo = slot3 * 32768, oo = O_OUT + slot3 * OUTB;
        const LAS float* Gs = (const LAS float*)(ldl + oo); const LAS float* Es = Gs + 64;
        spin_ge(ldl, O_FLAG + 64 + 4 * c, 1u);
        {   f32x16_t Z0, Z1;
#pragma unroll
            for (int r = 0; r < 16; ++r) { Z0[r] = 0.f; Z1[r] = 0.f; }
#define S3_LFRAG(off_) join44(*(const LAS v2u*)(ldl + (off_)), *(const LAS v2u*)(ldl + (off_) + 1024))
#pragma unroll
            for (int nt = 0; nt < 4; ++nt) { const bf16x8_t hb0 = acc_frag<0>(H[nt]), hb1 = acc_frag<1>(H[nt]);
                const int ro = bo + 16384 + ((4 * nt) * 64 + r32) * 16 + 8 * hi;
                Z0 = __builtin_amdgcn_mfma_f32_32x32x16_bf16(S3_LFRAG(ro), hb0, Z0, 0, 0, 0); Z0 = __builtin_amdgcn_mfma_f32_32x32x16_bf16(S3_LFRAG(ro + 2048), hb1, Z0, 0, 0, 0);
                Z1 = __builtin_amdgcn_mfma_f32_32x32x16_bf16(S3_LFRAG(ro + 512), hb0, Z1, 0, 0, 0); Z1 = __builtin_amdgcn_mfma_f32_32x32x16_bf16(S3_LFRAG(ro + 512 + 2048), hb1, Z1, 0, 0, 0); }
#undef S3_LFRAG
            const int tb = dir ? SEQ - 1 - (64 * c + 4 * hi) : 64 * c + 4 * hi;
            float* yb = Y + ((size_t)b * SEQ + tb) * 1024 + h * 64 + ps * 32 + r32;
#pragma unroll
            for (int r = 0; r < 16; ++r) { const int il0 = (r & 3) + 8 * (r >> 2), il = il0 + 4 * hi;
                const float yd0 = *(const LAS float*)(ldl + oo + OO_Y + r * 256 + lane * 4), yd1 = *(const LAS float*)(ldl + oo + OO_Y + (16 + r) * 256 + lane * 4);
                const long ro0 = dir ? -(long)il0 * 1024 : (long)il0 * 1024, ro1 = dir ? -(long)(il0 + 32) * 1024 : (long)(il0 + 32) * 1024;
                yb[ro0] = fmaf(Es[il], Z0[r], yd0); yb[ro1] = fmaf(Es[32 + il], Z1[r], yd1); } }
        asm volatile("" ::: "memory");
        {   const float eL = __expf(Gs[63]);
            const int xo = oo + OO_XW + (4 * hi + trq) * 72 + (16 * trc + 4 * trp) * 2;
            const bf16x8_t w0 = S3_TRFRAG(xo), w1 = S3_TRFRAG(xo + 16 * 72), w2 = S3_TRFRAG(xo + 32 * 72), w3 = S3_TRFRAG(xo + 48 * 72);
#pragma unroll
            for (int nt = 0; nt < 4; ++nt) {
#pragma unroll
                for (int r = 0; r < 16; ++r) H[nt][r] *= eL;
#pragma unroll
                for (int ks = 0; ks < 4; ++ks) {
                    const int ro = bo + ((4 * nt + 2 * trc + (trp >> 1)) * 64 + 16 * ks + 4 * hi + trq) * 16 + 8 * (trp & 1);
                    const s16x4_t lo = __builtin_bit_cast(s16x4_t, __builtin_amdgcn_ds_read_tr16_b64_v4i16((LAS s16x4_t*)(ldl + ro)));
                    const s16x4_t hi4 = __builtin_bit_cast(s16x4_t, __builtin_amdgcn_ds_read_tr16_b64_v4i16((LAS s16x4_t*)(ldl + ro + 8 * 16)));
                    const bf16x8_t bfr = (bf16x8_t){lo[0], lo[1], lo[2], lo[3], hi4[0], hi4[1], hi4[2], hi4[3]};
                    H[nt] = __builtin_amdgcn_mfma_f32_32x32x16_bf16(bfr, ks == 0 ? w0 : ks == 1 ? w1 : ks == 2 ? w2 : w3, H[nt], 0, 0, 0);
                }
            }
        }
        LDS_WAIT();
        if (lane == 0) *(volatile LAS unsigned*)(ldw + O_FLAG) = (unsigned)(c + 1);
        slot3 = (slot3 == 2) ? 0 : slot3 + 1;
    }
}
#undef S3_TRFRAG
}

__device__ __forceinline__ void lru_tile(const Args& a, int item, unsigned char* lds, int pass) {
    const int n = item & 7, tc = (item >> 3) & 63, b = item >> 9, t0 = tc * 32;
    float* xc = (float*)lds; bf16_t* xcb = (bf16_t*)(lds + 16384); float* As = (float*)(lds + 25088); float* Us = As + 2 * 32 * 128; float2* sg = (float2*)(Us + 2 * 32 * 128);
    const int tid = threadIdx.x, lane = tid & 63, wave = tid >> 6;
    const bf16_t* P = (const bf16_t*)(a.ws + WS_PROJ);
    __syncthreads();
    {
        const int j = tid & 127, tg = tid >> 7, chn = n * 128 + j; const float* cw = a.in[25];
        const float w0 = cw[chn], w1 = cw[1024 + chn], w2 = cw[2048 + chn], w3 = cw[3072 + chn], cbias = a.in[26][chn];
        const int tb = t0 + tg * 8;
        const bf16_t* pp = P + ((size_t)b * SEQ + tb) * NINP + C_XL + chn;
        float xm2 = (tb >= 2) ? bf2f(pp[-2 * NINP]) : 0.f, xm1 = (tb >= 1) ? bf2f(pp[-NINP]) : 0.f, x0 = bf2f(pp[0]);
#pragma unroll
        for (int i = 0; i < 8; ++i) { const float xp1 = (tb + i + 1 < SEQ) ? bf2f(pp[(i + 1) * NINP]) : 0.f;
            const float acc = cbias + w0 * xm2 + w1 * xm1 + w2 * x0 + w3 * xp1;
            xc[(tg * 8 + i) * 128 + j] = acc; xcb[(tg * 8 + i) * 136 + j] = (bf16_t)f2bf(acc);
            xm2 = xm1; xm1 = x0; x0 = xp1; }
    }
    __syncthreads();
    {
        const int ct = wave & 3, d = wave >> 2, r32 = lane & 31, hi = lane >> 5;
        const bf16_t* WT = (const bf16_t*)(a.ws + WS_WGT);
        const bf16_t* wa_p = WT + ((size_t)((2 * d) * 8 + n) * 128 + ct * 32 + r32) * 128 + hi * 8;
        const bf16_t* wx_p = WT + ((size_t)((2 * d + 1) * 8 + n) * 128 + ct * 32 + r32) * 128 + hi * 8;
        f32x16_t ca, cx;
#pragma unroll
        for (int r = 0; r < 16; ++r) { ca[r] = 0.f; cx[r] = 0.f; }
#pragma unroll
        for (int s = 0; s < 8; ++s) {
            const bf16x8_t af = *(const bf16x8_t*)((const char*)xcb + r32 * 272 + (s * 16 + hi * 8) * 2);
            const bf16x8_t fa = *(const bf16x8_t*)(wa_p + s * 16); const bf16x8_t fx = *(const bf16x8_t*)(wx_p + s * 16);
            ca = __builtin_amdgcn_mfma_f32_32x32x16_bf16(af, fa, ca, 0, 0, 0); cx = __builtin_amdgcn_mfma_f32_32x32x16_bf16(af, fx, cx, 0, 0, 0);
        }
        const int j = ct * 32 + r32, cj = n * 128 + j;
        const float baj = a.in[d ? 33 : 28][cj], bxj = a.in[d ? 35 : 30][cj], sp = softplus_f(-a.in[d ? 36 : 31][cj]);
#pragma unroll
        for (int r = 0; r < 16; ++r) { const int t = (r & 3) + 8 * (r >> 2) + 4 * hi;
            const float rg = __builtin_amdgcn_rcpf(1.f + __expf(-(ca[r] + baj))), ig = __builtin_amdgcn_rcpf(1.f + __expf(-(cx[r] + bxj))); const float la = -8.f * rg * sp;
            const float av = __expf(la);
            const float om = (la > -0.0625f) ? -2.f * la * (1.f + la * (1.f + la * (0.6666667f + 0.3333333f * la))) : (1.f - av) * (1.f + av);
            As[(d * 32 + t) * 128 + j] = av; Us[(d * 32 + t) * 128 + j] = __builtin_amdgcn_sqrtf(om) * (ig * xc[t * 128 + j]); }
    }
    __syncthreads();
    {
        const int j = tid & 127, d = (tid >> 7) & 1, seg = tid >> 8;
        float Pp = 1.f, H = 0.f;
#pragma unroll
        for (int k = 0; k < 16; ++k) { const int q = seg * 16 + k, t = d ? 31 - q : q; const float a_ = As[(d * 32 + t) * 128 + j], u_ = Us[(d * 32 + t) * 128 + j]; H = fmaf(a_, H, u_); Pp *= a_; }
        sg[(d * 2 + seg) * 128 + j] = make_float2(Pp, H);
        __syncthreads();
        float2* LS = (float2*)(a.ws + WS_LSUM);
        if (pass == 0) {
            if (seg == 0) { const float2 s1 = sg[(d * 2 + 1) * 128 + j]; LS[((size_t)(d * 4 + b) * 64 + tc) * 1024 + n * 128 + j] = make_float2(Pp * s1.x, fmaf(s1.x, H, s1.y)); }
        } else {
            float c = 0.f;
            const float2* lsp = LS + ((size_t)(d * 4 + b) * 64) * 1024 + n * 128 + j;
#pragma unroll 1
            for (int c0 = 0; c0 < 64; c0 += 16) { float2 sv[16];
#pragma unroll
                for (int i = 0; i < 16; ++i) { const int cc = d ? 63 - (c0 + i) : c0 + i; sv[i] = lsp[(size_t)cc * 1024]; }
#pragma unroll
                for (int i = 0; i < 16; ++i) { const int cc = d ? 63 - (c0 + i) : c0 + i; const bool before = d ? (cc > tc) : (cc < tc); if (before) c = fmaf(sv[i].x, c, sv[i].y); } }
            if (seg == 1) { const float2 s0 = sg[(d * 2) * 128 + j]; c = fmaf(s0.x, c, s0.y); }
            float h = c;
#pragma unroll
            for (int k = 0; k < 16; ++k) { const int q = seg * 16 + k, t = d ? 31 - q : q; const float a_ = As[(d * 32 + t) * 128 + j], u_ = Us[(d * 32 + t) * 128 + j]; h = fmaf(a_, h, u_); Us[(d * 32 + t) * 128 + j] = h; }
            __syncthreads();
            bf16_t* YC = (bf16_t*)(a.ws + WS_YCAT);
            const int jj = tid & 127, tg = tid >> 7;
#pragma unroll
            for (int i = 0; i < 8; ++i) { const int t = tg * 8 + i; const size_t row = (size_t)b * SEQ + t0 + t;
                const float hs = Us[t * 128 + jj] + Us[(32 + t) * 128 + jj]; const float gl = bf2f(P[row * NINP + C_GL + n * 128 + jj]);
                YC[row * 2048 + 1024 + n * 128 + jj] = (bf16_t)f2bf(hs * silu_f(gl)); }
        }
    }
}

template <bool FINAL>
__device__ __forceinline__ void lru_wave(const Args& a, int witem, unsigned char* ldsw, int lane) {
    asm volatile("" : "+v"(lane));
    const int n = witem & 7, tc = (witem >> 3) & 63, b = witem >> 9, t0 = tc * 32;
    const int r32 = lane & 31, hi = lane >> 5;
    bf16_t* xcb = (bf16_t*)ldsw;
    const bf16_t* P = (const bf16_t*)(a.ws + WS_PROJ);
    bf16_t* XC = (bf16_t*)(a.ws + WS_XC16) + ((size_t)b * SEQ + t0) * 1024 + n * 128;
    if constexpr (!FINAL) {
        const int chn = n * 128 + 2 * lane; const float* cw = a.in[25];
        const f32x2 w0 = *(const f32x2*)(cw + chn), w1 = *(const f32x2*)(cw + 1024 + chn), w2 = *(const f32x2*)(cw + 2048 + chn), w3 = *(const f32x2*)(cw + 3072 + chn), cb2 = *(const f32x2*)(a.in[26] + chn);
        const bf16_t* pp = P + ((size_t)b * SEQ + t0) * NINP + C_XL + chn;
        f32x2 xm2 = {0.f, 0.f}, xm1 = {0.f, 0.f}, x0;
        if (t0 >= 2) { const unsigned v = *(const unsigned*)(pp - 2 * NINP); xm2 = (f32x2){bf2f(v & 0xffffu), __uint_as_float(v & 0xffff0000u)}; }
        if (t0 >= 1) { const unsigned v = *(const unsigned*)(pp - NINP); xm1 = (f32x2){bf2f(v & 0xffffu), __uint_as_float(v & 0xffff0000u)}; }
        { const unsigned v = *(const unsigned*)pp; x0 = (f32x2){bf2f(v & 0xffffu), __uint_as_float(v & 0xffff0000u)}; }
#pragma unroll 8
        for (int i = 0; i < 32; ++i) { f32x2 xp1 = {0.f, 0.f};
            if (t0 + i + 1 < SEQ) { const unsigned v = *(const unsigned*)(pp + (size_t)(i + 1) * NINP); xp1 = (f32x2){bf2f(v & 0xffffu), __uint_as_float(v & 0xffff0000u)}; }
            const f32x2 acc = cb2 + w0 * xm2 + w1 * xm1 + w2 * x0 + w3 * xp1;
            const unsigned pk = pk2(acc.x, acc.y);
            *(unsigned*)(xcb + i * 136 + 2 * lane) = pk; *(unsigned*)(XC + (size_t)i * 1024 + 2 * lane) = pk;
            xm2 = xm1; xm1 = x0; x0 = xp1; }
        LDS_WAIT();
    }
    const bf16_t* WT = (const bf16_t*)(a.ws + WS_WGT);
    float2* LS = (float2*)(a.ws + WS_LSUM);
    const bf16_t* xcr = XC + (size_t)r32 * 1024 + hi * 8;
#pragma unroll 1
    for (int ct = 0; ct < 4; ++ct) {
    const int j = ct * 32 + r32, cj = n * 128 + j;
    float xv[16];
#pragma unroll
    for (int r = 0; r < 16; ++r) { const int t = (r & 3) + 8 * (r >> 2) + 4 * hi; xv[r] = bf2f(FINAL ? XC[(size_t)t * 1024 + j] : xcb[t * 136 + j]); }
    float hs[16];
#pragma unroll
    for (int d = 0; d < 2; ++d) {
        const bf16_t* wa_p = WT + ((size_t)((2 * d) * 8 + n) * 128 + j) * 128 + hi * 8;
        const bf16_t* wx_p = WT + ((size_t)((2 * d + 1) * 8 + n) * 128 + j) * 128 + hi * 8;
        f32x16_t ca, cx;
#pragma unroll
        for (int r = 0; r < 16; ++r) { ca[r] = 0.f; cx[r] = 0.f; }
#pragma unroll
        for (int s = 0; s < 8; ++s) {
            const bf16x8_t af = FINAL ? *(const bf16x8_t*)(xcr + s * 16) : *(const bf16x8_t*)((const char*)xcb + r32 * 272 + (s * 16 + hi * 8) * 2);
            const bf16x8_t fa = *(const bf16x8_t*)(wa_p + s * 16); const bf16x8_t fx = *(const bf16x8_t*)(wx_p + s * 16);
            ca = __builtin_amdgcn_mfma_f32_32x32x16_bf16(af, fa, ca, 0, 0, 0); cx = __builtin_amdgcn_mfma_f32_32x32x16_bf16(af, fx, cx, 0, 0, 0);
        }
        asm volatile("" ::: "memory");
        const float baj = a.in[d ? 33 : 28][cj], bxj = a.in[d ? 35 : 30][cj], sp = softplus_f(-a.in[d ? 36 : 31][cj]);
        float av[16], uv[16];
#pragma unroll
        for (int r = 0; r < 16; ++r) { const int t = (r & 3) + 8 * (r >> 2) + 4 * hi;
            const float rg = __builtin_amdgcn_rcpf(1.f + __expf(-(ca[r] + baj))), ig = __builtin_amdgcn_rcpf(1.f + __expf(-(cx[r] + bxj))); const float la = -8.f * rg * sp;
            av[r] = __expf(la);
            const float om = (la > -0.0625f) ? -2.f * la * (1.f + la * (1.f + la * (0.6666667f + 0.3333333f * la))) : (1.f - av[r]) * (1.f + av[r]);
            uv[r] = __builtin_amdgcn_sqrtf(om) * (ig * xv[r]); }
        asm volatile("" ::: "memory");
        float Pg[4], Hg[4];
#pragma unroll
        for (int sg = 0; sg < 4; ++sg) { float Pp = 1.f, Hh = 0.f;
#pragma unroll
            for (int e4 = 0; e4 < 4; ++e4) { const int r = 4 * sg + (d ? 3 - e4 : e4); Hh = fmaf(av[r], Hh, uv[r]); Pp *= av[r]; }
            Pg[sg] = Pp; Hg[sg] = Hh; }
        float Po[4], Ho[4];
#pragma unroll
        for (int sg = 0; sg < 4; ++sg) { Po[sg] = __shfl_xor(Pg[sg], 32); Ho[sg] = __shfl_xor(Hg[sg], 32); }
        if constexpr (!FINAL) {
            float Ac = 1.f, Hc = 0.f;
#pragma unroll
            for (int qq = 0; qq < 8; ++qq) { const int q = d ? 7 - qq : qq;
                const bool mine = ((q & 1) == hi); const float pq = mine ? Pg[q >> 1] : Po[q >> 1], hq_ = mine ? Hg[q >> 1] : Ho[q >> 1];
                Hc = fmaf(pq, Hc, hq_); Ac *= pq; }
            if (hi == 0) LS[((size_t)(d * 4 + b) * 64 + tc) * 1024 + cj] = make_float2(Ac, Hc);
        } else {
            float c = 0.f;
            const float2* lsp = LS + ((size_t)(d * 4 + b) * 64) * 1024 + cj;
            const int nneed = d ? 63 - tc : tc;
#pragma unroll 1
            for (int c0 = 0; c0 < nneed; c0 += 16) { float2 sv[16];
#pragma unroll
                for (int i = 0; i < 16; ++i) { const int ci = (c0 + i < nneed) ? c0 + i : nneed - 1; const int cc = d ? 63 - ci : ci; sv[i] = lsp[(size_t)cc * 1024]; }
#pragma unroll
                for (int i = 0; i < 16; ++i) { if (c0 + i < nneed) c = fmaf(sv[i].x, c, sv[i].y); } }
            asm volatile("" ::: "memory");
            float cin[4];
#pragma unroll
            for (int qq = 0; qq < 8; ++qq) { const int q = d ? 7 - qq : qq;
                const bool mine = ((q & 1) == hi); const float pq = mine ? Pg[q >> 1] : Po[q >> 1], hq_ = mine ? Hg[q >> 1] : Ho[q >> 1];
                if (mine) cin[q >> 1] = c;
                c = fmaf(pq, c, hq_); }
#pragma unroll
            for (int sg = 0; sg < 4; ++sg) { float h = cin[sg];
#pragma unroll
                for (int e4 = 0; e4 < 4; ++e4) { const int r = 4 * sg + (d ? 3 - e4 : e4); h = fmaf(av[r], h, uv[r]); hs[r] = (d == 0) ? h : hs[r] + h; } }
        }
    }
    if constexpr (FINAL) {
        bf16_t* YC = (bf16_t*)(a.ws + WS_YCAT);
#pragma unroll
        for (int r = 0; r < 16; ++r) { const int t = (r & 3) + 8 * (r >> 2) + 4 * hi; const size_t row = (size_t)b * SEQ + t0 + t;
            const float gl = bf2f(P[row * NINP + C_GL + cj]);
            YC[row * 2048 + 1024 + cj] = (bf16_t)f2bf(hs[r] * silu_f(gl)); }
    }
    }
    LDS_WAIT();
}

template <int d>
__device__ __forceinline__ void lru_run(const Args& a, int task, int lane) {
    asm volatile("" : "+v"(lane));
    const int run = task & 7, ct = (task >> 4) & 3, n = (task >> 6) & 7, b = task >> 9;
    const int r32 = lane & 31, hi = lane >> 5, j = ct * 32 + r32, cj = n * 128 + j;
    const bf16_t* WT = (const bf16_t*)(a.ws + WS_WGT);
    const bf16_t* wa_p = WT + ((size_t)((2 * d) * 8 + n) * 128 + j) * 128 + hi * 8;
    const bf16_t* wx_p = WT + ((size_t)((2 * d + 1) * 8 + n) * 128 + j) * 128 + hi * 8;
    bf16x8_t fa[8], fx[8];
#pragma unroll
    for (int s = 0; s < 8; ++s) { fa[s] = *(const bf16x8_t*)(wa_p + s * 16); fx[s] = *(const bf16x8_t*)(wx_p + s * 16); }
    const float baj = a.in[d ? 33 : 28][cj], bxj = a.in[d ? 35 : 30][cj], sp = softplus_f(-a.in[d ? 36 : 31][cj]);
    const float2* lsp = (const float2*)(a.ws + WS_LSUM) + ((size_t)(d * 4 + b) * 64) * 1024 + cj;
    bf16_t* HD = (bf16_t*)(a.ws + (d ? WS_HB16 : WS_HF16));
    float c = 0.f;
    { const int nneed = 8 * run;
#pragma unroll 1
      for (int c0 = 0; c0 < nneed; c0 += 8) { float2 sv[8];
#pragma unroll
          for (int i = 0; i < 8; ++i) { const int ci = c0 + i; const int cc = d ? 63 - ci : ci; sv[i] = lsp[(size_t)cc * 1024]; }
#pragma unroll
          for (int i = 0; i < 8; ++i) c = fmaf(sv[i].x, c, sv[i].y); } }
#pragma unroll 1
    for (int k = 0; k < 8; ++k) {
        const int ci = 8 * run + k, tc = d ? 63 - ci : ci, t0 = tc * 32;
        const bf16_t* XC = (const bf16_t*)(a.ws + WS_XC16) + ((size_t)b * SEQ + t0) * 1024 + n * 128;
        const bf16_t* xcr = XC + (size_t)r32 * 1024 + hi * 8;
        f32x16_t ca, cx;
#pragma unroll
        for (int r = 0; r < 16; ++r) { ca[r] = 0.f; cx[r] = 0.f; }
#pragma unroll
        for (int s = 0; s < 8; ++s) { const bf16x8_t af = *(const bf16x8_t*)(xcr + s * 16);
            ca = __builtin_amdgcn_mfma_f32_32x32x16_bf16(af, fa[s], ca, 0, 0, 0); cx = __builtin_amdgcn_mfma_f32_32x32x16_bf16(af, fx[s], cx, 0, 0, 0); }
        float av[16], uv[16];
#pragma unroll
        for (int r = 0; r < 16; ++r) { const int t = (r & 3) + 8 * (r >> 2) + 4 * hi;
            const float xvr = bf2f(XC[(size_t)t * 1024 + j]);
            const float rg = __builtin_amdgcn_rcpf(1.f + __expf(-(ca[r] + baj))), ig = __builtin_amdgcn_rcpf(1.f + __expf(-(cx[r] + bxj))); const float la = -8.f * rg * sp;
            av[r] = __expf(la);
            const float om = (la > -0.0625f) ? -2.f * la * (1.f + la * (1.f + la * (0.6666667f + 0.3333333f * la))) : (1.f - av[r]) * (1.f + av[r]);
            uv[r] = __builtin_amdgcn_sqrtf(om) * (ig * xvr); }
        float Pg[4], Hg[4];
#pragma unroll
        for (int sg = 0; sg < 4; ++sg) { float Pp = 1.f, Hh = 0.f;
#pragma unroll
            for (int e4 = 0; e4 < 4; ++e4) { const int r = 4 * sg + (d ? 3 - e4 : e4); Hh = fmaf(av[r], Hh, uv[r]); Pp *= av[r]; }
            Pg[sg] = Pp; Hg[sg] = Hh; }
        float Po[4], Ho[4];
#pragma unroll
        for (int sg = 0; sg < 4; ++sg) { Po[sg] = __shfl_xor(Pg[sg], 32); Ho[sg] = __shfl_xor(Hg[sg], 32); }
        float cin[4];
#pragma unroll
        for (int qq = 0; qq < 8; ++qq) { const int q = d ? 7 - qq : qq;
            const bool mine = ((q & 1) == hi); const float pq = mine ? Pg[q >> 1] : Po[q >> 1], hq_ = mine ? Hg[q >> 1] : Ho[q >> 1];
            if (mine) cin[q >> 1] = c;
            c = fmaf(pq, c, hq_); }
#pragma unroll
        for (int sg = 0; sg < 4; ++sg) { float h = cin[sg];
#pragma unroll
            for (int e4 = 0; e4 < 4; ++e4) { const int r = 4 * sg + (d ? 3 - e4 : e4); const int t = (r & 3) + 8 * (r >> 2) + 4 * hi;
                h = fmaf(av[r], h, uv[r]); HD[((size_t)b * SEQ + t0 + t) * 1024 + cj] = (bf16_t)f2bf(h); } }
    }
}

__device__ __forceinline__ void combine1_phase(const Args& a, int gw, int NGW, int lane) {
    const float* OF = (const float*)(a.ws + WS_YF); const float* OB = (const float*)(a.ws + WS_YB);
    const bf16_t* P = (const bf16_t*)(a.ws + WS_PROJ); bf16_t* YC = (bf16_t*)(a.ws + WS_YCAT);
    const float* gn = a.in[24];
    for (int m = gw; m < MTOK; m += NGW) {
        const int ch = lane * 16, d0 = ch & 127;
        float z[16], ov[16];
        unpack8(*(const v4u*)(P + (size_t)m * NINP + C_Z + ch), z); unpack8(*(const v4u*)(P + (size_t)m * NINP + C_Z + ch + 8), z + 8);
#pragma unroll
        for (int q = 0; q < 4; ++q) { const f32x4 f = *(const f32x4*)(OF + (size_t)m * 1024 + ch + 4 * q), bk = *(const f32x4*)(OB + (size_t)m * 1024 + ch + 4 * q); const f32x4 o = f + bk;
            ov[4 * q] = o.x; ov[4 * q + 1] = o.y; ov[4 * q + 2] = o.z; ov[4 * q + 3] = o.w; }
        float ss = 0.f;
#pragma unroll
        for (int i = 0; i < 16; ++i) ss += ov[i] * ov[i];
        ss = group_sum<8>(ss);
        const float r = rsqrtf(ss * (1.f / 128.f) + EPS);
#pragma unroll
        for (int i = 0; i < 16; ++i) ov[i] = ov[i] * r * gn[d0 + i] * silu_f(z[i]);
        *(v4u*)(YC + (size_t)m * 2048 + ch) = pack8(ov); *(v4u*)(YC + (size_t)m * 2048 + ch + 8) = pack8(ov + 8);
        { const bf16_t* HF = (const bf16_t*)(a.ws + WS_HF16); const bf16_t* HB = (const bf16_t*)(a.ws + WS_HB16);
          float hf[16], hb[16];
          unpack8(*(const v4u*)(P + (size_t)m * NINP + C_GL + ch), z); unpack8(*(const v4u*)(P + (size_t)m * NINP + C_GL + ch + 8), z + 8);
          unpack8(*(const v4u*)(HF + (size_t)m * 1024 + ch), hf); unpack8(*(const v4u*)(HF + (size_t)m * 1024 + ch + 8), hf + 8);
          unpack8(*(const v4u*)(HB + (size_t)m * 1024 + ch), hb); unpack8(*(const v4u*)(HB + (size_t)m * 1024 + ch + 8), hb + 8);
#pragma unroll
          for (int i = 0; i < 16; ++i) ov[i] = (hf[i] + hb[i]) * silu_f(z[i]);
          *(v4u*)(YC + (size_t)m * 2048 + 1024 + ch) = pack8(ov); *(v4u*)(YC + (size_t)m * 2048 + 1024 + ch + 8) = pack8(ov + 8); }
    }
}

__device__ __forceinline__ void final_norm_phase(const Args& a, int gw, int NGW, int lane) {
    const float* nw = a.in[38];
    for (int m = gw; m < MTOK; m += NGW) {
        f32x4* xr = (f32x4*)(a.out + (size_t)m * 2048) + lane;
        f32x4 v[8]; float s = 0.f;
#pragma unroll
        for (int j = 0; j < 8; ++j) { v[j] = xr[64 * j]; s += (v[j].x * v[j].x + v[j].y * v[j].y) + (v[j].z * v[j].z + v[j].w * v[j].w); }
        const float rstd = rsqrtf(group_sum<64>(s) * (1.f / 2048.f) + EPS);
#pragma unroll
        for (int j = 0; j < 8; ++j) { const f32x4 w = *(const f32x4*)(nw + (64 * j + lane) * 4); xr[64 * j] = v[j] * rstd * w; }
    }
}

typedef GAS unsigned gu32;
#define RLX_AGENT __ATOMIC_RELAXED, __HIP_MEMORY_SCOPE_AGENT
constexpr int CW_BAR = 4096;
constexpr int MISC_OFF = 163840 - 128;
#define XB_TMO      128
#define XB_XCNT(j)  (256  + 64 * (j))
#define XB_XSUB(j)  (1280 + 64 * (j))
#define XB_XGEN(j)  (2304 + 64 * (j))
#define XB_TOP      3328
#define XB_TOPGEN   3392
#define XCD_BAR_WORDS 3456
#define XB_SPIN_CAP (1u << 18)

__device__ __forceinline__ unsigned xb_ld(unsigned* p)              { return __hip_atomic_load(p, __ATOMIC_RELAXED, __HIP_MEMORY_SCOPE_AGENT); }
__device__ __forceinline__ unsigned xb_add(unsigned* p, unsigned v) { return __hip_atomic_fetch_add(p, v, __ATOMIC_RELAXED, __HIP_MEMORY_SCOPE_AGENT); }
__device__ __forceinline__ unsigned xb_xcc_id() { return (unsigned)__builtin_amdgcn_s_getreg((3 << 11) | 20) & 0xFu; }
#define XB_SPIN(cond, bar) do { unsigned _sp = 0; while (cond) { __builtin_amdgcn_s_sleep(1); \
    if ((++_sp & 255u) == 0u) { if (xb_ld(&(bar)[XB_TMO])) break; if (_sp > XB_SPIN_CAP) { atomicAdd(&(bar)[XB_TMO], 1u); break; } } } } while (0)

struct XcdBarrier {
    unsigned* bar; unsigned x;
    volatile LAS unsigned* st;
};

__device__ __forceinline__ XcdBarrier xcd_barrier_post(unsigned* bar, volatile LAS unsigned* st) {
    XcdBarrier b; b.bar = bar; b.x = xb_xcc_id(); b.st = st;
    if (threadIdx.x == 0) (void)xb_add(&bar[XB_XCNT(b.x)], 1u);
    return b;
}
__device__ __forceinline__ void xcd_barrier_complete(unsigned* bar, unsigned x, unsigned& nloc, unsigned& nx) {
    const unsigned G = gridDim.x * gridDim.y * gridDim.z;
    unsigned sum, cnt, mine, sp = 0u;
    for (;;) {
        sum = 0u; cnt = 0u; mine = 0u;
#pragma unroll
        for (unsigned j = 0; j < 16; ++j) { const unsigned c = xb_ld(&bar[XB_XCNT(j)]); sum += c; cnt += (c > 0u) ? 1u : 0u; mine = (j == x) ? c : mine; }
        if (sum == G) break;
        __builtin_amdgcn_s_sleep(1);
        if ((++sp & 255u) == 0u) { if (xb_ld(&bar[XB_TMO])) break; if (sp > XB_SPIN_CAP) { atomicAdd(&bar[XB_TMO], 1u); break; } }
    }
    nloc = mine > 0u ? mine : 1u; nx = cnt > 0u ? cnt : 1u;
}

__device__ __forceinline__ void xcd_barrier(const XcdBarrier& b) {
    asm volatile("s_waitcnt vmcnt(0)" ::: "memory");
    __syncthreads();
    if (threadIdx.x == 0) {
        unsigned* bar = b.bar;
        __builtin_amdgcn_s_waitcnt(0);
        unsigned nloc = b.st[0], nx = b.st[1];
        if (nloc == 0u) { xcd_barrier_complete(bar, b.x, nloc, nx); b.st[0] = nloc; b.st[1] = nx; }
        const unsigned old = xb_add(&bar[XB_XSUB(b.x)], 1u);
        const unsigned gen = old / nloc;
        if (old + 1u == (gen + 1u) * nloc) {
            __builtin_amdgcn_fence(__ATOMIC_RELEASE, "agent");
            asm volatile("s_waitcnt vmcnt(0)" ::: "memory");
            const unsigned og = xb_add(&bar[XB_TOP], 1u);
            const unsigned tg = og / nx;
            if (og + 1u == (tg + 1u) * nx) xb_add(&bar[XB_TOPGEN], 1u);
            else XB_SPIN(xb_ld(&bar[XB_TOPGEN]) == tg, bar);
            __builtin_amdgcn_fence(__ATOMIC_ACQUIRE, "agent");
            xb_add(&bar[XB_XGEN(b.x)], 1u);
            asm volatile("s_waitcnt vmcnt(0)" ::: "memory");
        } else {
            XB_SPIN(xb_ld(&bar[XB_XGEN(b.x)]) == gen, bar);
            __builtin_amdgcn_fence(__ATOMIC_ACQUIRE, "agent");
            asm volatile("s_waitcnt vmcnt(0)" ::: "memory");
        }
    }
    __syncthreads();
}

#ifndef PROBE_MASK
#define PROBE_MASK 0
#endif
#define REP(bit) for (int rep_ = 0; rep_ < 1 + ((PROBE_MASK >> (bit)) & 1); ++rep_)
#ifndef PROBE_SSD
#define PROBE_SSD 0
#endif
#ifndef PROBE_GDN
#define PROBE_GDN 0
#endif
#ifndef PROBE_LRU
#define PROBE_LRU 0
#endif
#ifndef MK_SINGLE
#define MK_SINGLE 1
#endif
__global__ void __launch_bounds__(NTHREADS, 2) mk_fwd(Args a) {
    extern __shared__ __attribute__((aligned(16))) unsigned char lds[];
    LAS unsigned char* ldsl = (LAS unsigned char*)lds;
    const int tid = threadIdx.x, lane = tid & 63, wave = __builtin_amdgcn_readfirstlane(tid >> 6);
    const int G = gridDim.x, bx = blockIdx.x;
    const int vcu = (G % 8 == 0) ? (bx % 8) * (G / 8) + bx / 8 : bx;
    const int gw = vcu * NWAVES + wave, NGW = G * NWAVES;
    unsigned char* ws = a.ws;
    volatile LAS unsigned* MISC = (volatile LAS unsigned*)(ldsl + MISC_OFF);
    if (tid < 32) MISC[tid] = 0u;
    __syncthreads();
    XcdBarrier bar; bar.bar = (unsigned*)(ws + WS_CTL) + CW_BAR; bar.x = 0; bar.st = nullptr;
    if (a.ph_hi - a.ph_lo > 1) bar = xcd_barrier_post((unsigned*)(ws + WS_CTL) + CW_BAR, MISC + 8);
#define IN(k) (a.ph_lo <= (k) && (k) < a.ph_hi)
#define SEAM(k) do { if (IN(k) && IN((k) + 1)) { xcd_barrier(bar); } } while (0)

    if (IN(0)) { p0_prologue(a, ldsl, vcu, G); } SEAM(0);
    if (IN(1)) { REP(0) normmod_phase(a, a.in[0], 0, gw, NGW, lane); } SEAM(1);
    if (IN(2)) {
        pg8::Gemm g{(const bf16_t*)(ws + WS_H), (const bf16_t*)(ws + WS_WIN0), MTOK, NINP, 2048}; pg8::StaticOrder S; S.init(MTOK, NINP, G, bx);
        pg8::EpiProj E{(bf16_t*)(ws + WS_PROJ), (float*)(ws + WS_SMALL), NINP, A_DT / 256};
        REP(1) { pg8::gemm_phase<pg8::EpiProj, pg8::StaticOrder, true, true>(ldsl, g, S, E); __syncthreads(); }
    } SEAM(2);
    if (IN(3)) { REP(0) post0_phase(a, gw, NGW, lane); } SEAM(3);
    if (IN(4)) {
        for (int u = vcu; u < 256; u += G) { const int b = u >> 6, h = (u >> 3) & 7, qb = u & 7, kvh = h >> 2; const size_t row0 = (size_t)b * SEQ + qb * 256;
            att::attn_dense_body((const att::bf16*)(ws + WS_QB) + row0 * 1024 + h * 128, (const att::bf16*)(ws + WS_KB) + (size_t)b * SEQ * 256 + kvh * 128,
                                 (const att::bf16*)(ws + WS_VB) + (size_t)b * SEQ * 256 + kvh * 128, (bf16_t*)(ws + WS_YCAT) + row0 * 2048 + h * 128,
                                 (const bf16_t*)(ws + WS_PROJ) + row0 * NINP + A_GA + h * 128, SEQ, (char*)lds);
            __syncthreads(); }
        for (int it = vcu; it < 256; it += G) {
            if (tid < 64) ((LAS unsigned*)(ldsl + ssd3::O_FLAG))[tid] = 0u;
            __syncthreads();
            if (wave == 0) ssd3::consumer(a, it, lds); else if (wave <= 2) ssd3::producer(a, it, lds, wave - 1);
            __syncthreads(); }
    } SEAM(4);
    if (IN(5)) { REP(0) ssd_combine_phase(a, gw, NGW, lane); late_transposes(a, (LAS float*)(ldsl + wave * 16384), gw, NGW, lane); } SEAM(5);
    if (IN(6)) {
        pg8::Gemm g{(const bf16_t*)(ws + WS_YCAT), (const bf16_t*)(ws + WS_WOUT0), MTOK, 2048, 2048}; pg8::StaticOrder S; S.init(MTOK, 2048, G, bx);
        pg8::EpiResid E{a.in[0], a.out, (const float*)(ws + WS_MOD), a.in[3]};
        pg8::gemm_phase<pg8::EpiResid, pg8::StaticOrder, true, true>(ldsl, g, S, E); __syncthreads();
        if ((PROBE_MASK >> 2) & 1) { pg8::EpiNull EN; pg8::gemm_phase<pg8::EpiNull, pg8::StaticOrder, true, true>(ldsl, g, S, EN); __syncthreads(); }
        if ((PROBE_MASK >> 3) & 1) { pg8::gemm_phase<pg8::EpiResid, pg8::StaticOrder, true, true>(ldsl, g, S, E); __syncthreads(); }
    } SEAM(6);
    if (IN(7)) { REP(0) normmod_phase(a, a.out, 1, gw, NGW, lane); } SEAM(7);
    if (IN(8)) {
        pg8::Gemm g{(const bf16_t*)(ws + WS_H), (const bf16_t*)(ws + WS_WIN1), MTOK, NINP, 2048}; pg8::StaticOrder S; S.init(MTOK, NINP, G, bx);
        pg8::EpiProj E{(bf16_t*)(ws + WS_PROJ), (float*)(ws + WS_SMALL), NINP, C_SM / 256};
        pg8::gemm_phase<pg8::EpiProj, pg8::StaticOrder, true, true>(ldsl, g, S, E);
    } SEAM(8);
    if (IN(9)) { REP(0) post1_phase(a, gw, NGW, lane); } SEAM(9);
    if (IN(10)) {
        REP(5) { for (int it = gw; it < 2048; it += NGW) gdn1_item(a, it, lds + wave * GDN_LDS_PER_WAVE, lane); __syncthreads(); }
        for (int wi = gw; wi < 2048; wi += NGW) lru_wave<false>(a, wi, lds + wave * GDN_LDS_PER_WAVE, lane);
    } SEAM(10);
    if (IN(11)) {
        if (tid < 16) ((LAS unsigned*)(ldsl + gdn3::O_FLAG))[tid] = 0u;
        __syncthreads();
        if (wave == 0) { for (int it = vcu; it < 256; it += G) gdn3::chain(a, it, lds); }
        else if (wave == 1) { for (int it = vcu; it < 256; it += G) gdn3::output(a, it, lds); }
        else if ((wave & 3) >= 2) { const int hw = (wave & 1) + ((wave >> 2) << 1);
            REP(7) for (int tk = vcu * 4 + hw; tk < 2048; tk += G * 4) { if ((tk >> 3) & 1) lru_run<1>(a, tk, lane); else lru_run<0>(a, tk, lane); } }
        __syncthreads();
    } SEAM(11);
    if (IN(12)) { REP(0) combine1_phase(a, gw, NGW, lane); } SEAM(12);
    if (IN(13)) {
        pg8::Gemm g{(const bf16_t*)(ws + WS_YCAT), (const bf16_t*)(ws + WS_WOUT1), MTOK, 2048, 2048}; pg8::StaticOrder S; S.init(MTOK, 2048, G, bx);
        pg8::EpiResid E{a.out, a.out, (const float*)(ws + WS_MOD) + 4 * 6144, a.in[3] + 6144};
        pg8::gemm_phase<pg8::EpiResid, pg8::StaticOrder, true, true>(ldsl, g, S, E);
    } SEAM(13);
    if (IN(14)) { final_norm_phase(a, gw, NGW, lane); }
#undef IN
#undef SEAM
}

extern "C" void kernel_launch(void* const* d_in, const int* in_sizes, int n_in, void* d_out, int out_size, void* d_ws, size_t ws_size, hipStream_t stream) {
    static int grid = 0;
    if (grid == 0) {
        if (n_in != 39 || out_size != MTOK * DM || ws_size < WS_END) { fprintf(stderr, "kernel_launch: unexpected problem (n_in %d, out %d, ws %zu < %zu)\n", n_in, out_size, ws_size, (size_t)WS_END); grid = -1; return; }
        int dev = 0, cus = 0, per_cu = 0;
        if (hipGetDevice(&dev) != hipSuccess || hipDeviceGetAttribute(&cus, hipDeviceAttributeMultiprocessorCount, dev) != hipSuccess) { grid = -1; return; }
        if (hipFuncSetAttribute((const void*)mk_fwd, hipFuncAttributeMaxDynamicSharedMemorySize, LDS_BYTES) != hipSuccess) { fprintf(stderr, "kernel_launch: hipFuncSetAttribute failed\n"); grid = -1; return; }
        if (hipOccupancyMaxActiveBlocksPerMultiprocessor(&per_cu, (const void*)mk_fwd, NTHREADS, LDS_BYTES) != hipSuccess || per_cu < 1) { fprintf(stderr, "kernel_launch: occupancy query says %d\n", per_cu); (void)hipGetLastError(); per_cu = 1; }
        grid = cus;
    }
    if (grid < 0) return;
    (void)hipMemsetAsync((char*)d_ws + WS_CTL, 0, CTL_ZERO_BYTES, stream);
    Args a{};
    for (int i = 0; i < 39; ++i) a.in[i] = (const float*)d_in[i];
    a.out = (float*)d_out; a.ws = (unsigned char*)d_ws;
#if MK_SINGLE
    a.ph_lo = 0; a.ph_hi = NPHASE;
    void* kargs[] = {&a};
    hipError_t e = hipLaunchCooperativeKernel((const void*)mk_fwd, dim3(grid), dim3(NTHREADS), kargs, LDS_BYTES, stream);
    if (e != hipSuccess) fprintf(stderr, "kernel_launch: cooperative launch failed: %s (grid %d)\n", hipGetErrorString(e), grid);
#else
    for (int p = 0; p < NPHASE; ++p) { a.ph_lo = p; a.ph_hi = p + 1; hipLaunchKernelGGL(mk_fwd, dim3(grid), dim3(NTHREADS), LDS_BYTES, stream, a); }
#endif
}
```

```cpp
#include <hip/hip_runtime.h>
#include <hip/hip_cooperative_groups.h>
#include <hip/hip_bf16.h>
#include <cstdio>
#include <cstdint>
namespace cg = cooperative_groups;

constexpr int BATCH = 4, SEQ = 2048, DM = 2048, MTOK = BATCH * SEQ;
constexpr int NIN = 5152, NINP = 5376;
constexpr float EPS = 1e-6f;
constexpr int A_Q = 0, A_K = 1024, A_V = 1280, A_GA = 1536, A_XS = 2560, A_BS = 3584, A_CS = 3840, A_DT = 4096, A_Z = 4128;
constexpr int C_Q = 0, C_K = 512, C_V = 1024, C_SM = 2048, C_Z = 2080, C_XL = 3104, C_GL = 4128;
namespace pg8 {
#define PG8_LAS __attribute__((address_space(3)))
typedef unsigned short bf16_t;
typedef short bf16x8 __attribute__((ext_vector_type(8)));
typedef float f32x4 __attribute__((ext_vector_type(4)));
typedef unsigned u32x4 __attribute__((ext_vector_type(4)));
constexpr int BM = 256, BK = 64, HALF = 128, HTB = HALF * BK * 2  , STAGE_BYTES = 8 * HTB, NXCD = 8, WGM = 8;

__host__ __device__ __forceinline__ int lds_byte(int r, int c) { const int st = (r >> 4) * 2 + (c >> 5), rr = r & 15, cc = c & 31, ob = rr * 64 + cc * 2; return st * 1024 + (ob ^ (((ob >> 9) & 1) << 5)); }
__host__ __device__ __forceinline__ void stage_rc(int b, int& R, int& C) { const int st = b / 1024, sb = b % 1024, swz = sb ^ (((sb >> 9) & 1) << 5); R = (st >> 1) * 16 + swz / 64; C = (st & 1) * 32 + (swz % 64) / 2; }
__host__ __device__ __forceinline__ int perm32(int rho) { const int n = rho >> 4, i = rho & 15; return 8 * (i >> 2) + 4 * n + (i & 3); }

struct Unit { int pm, pn; };
struct Gemm { const bf16_t* A; const bf16_t* Bt; int M, N, K; };

struct StaticOrder {
    int nM, nN, nwg, G, c;
    __host__ __device__ void init(int M, int N, int G_, int c_) { nM = M / BM; nN = N / BM; nwg = nM * nN; G = G_; c = c_; }
    __host__ __device__ bool next(int i, Unit& u) const {
        const long L = (long)i * G + c; if (L >= nwg) return false;
        int wgid = (int)L; { const int q = nwg / NXCD, r = nwg % NXCD, xcd = wgid % NXCD, off = wgid / NXCD; wgid = (xcd < r ? xcd * (q + 1) : r * (q + 1) + (xcd - r) * q) + off; }
        const int nig = WGM * nN, gid = wgid / nig, fm = gid * WGM, gsz = (nM - fm) < WGM ? (nM - fm) : WGM;
        u.pm = fm + ((wgid % nig) % gsz); u.pn = (wgid % nig) / gsz; return true;
    }
    __device__ __forceinline__ void a_ready(const Unit&) const {}
    __device__ __forceinline__ void done(const Unit&) const {}
};

__device__ __forceinline__ unsigned cvt_pk_bf16(float lo, float hi) { unsigned r; asm volatile("v_cvt_pk_bf16_f32 %0, %1, %2" : "=v"(r) : "v"(lo), "v"(hi)); return r; }
typedef float f32x2 __attribute__((ext_vector_type(2)));
struct EpiProj {
    static constexpr bool PERM = true, AFTER_DRAIN = false;
    bf16_t* O; float* small; int ldc; int small_tile;
    __device__ __forceinline__ void operator()(const f32x4 (&acc)[2][2][4][2], const Unit& u, int wr, int wc, int fr, int fq) const {
        const int row0 = u.pm * BM + wr * 64 + fr; const int col0 = u.pn * BM + wc * 32 + 8 * fq;
        const bool sm = (u.pn == small_tile) && (wc == 0);
#pragma unroll
        for (int ai = 0; ai < 2; ++ai)
#pragma unroll
            for (int m = 0; m < 4; ++m) { const int row = row0 + ai * HALF + m * 16; bf16_t* rowp = O + (size_t)row * ldc + col0;
#pragma unroll
                for (int bj = 0; bj < 2; ++bj) { const f32x4 v0 = acc[ai][bj][m][0], v1 = acc[ai][bj][m][1];
                    u32x4 w; w.x = cvt_pk_bf16(v0[0], v0[1]); w.y = cvt_pk_bf16(v0[2], v0[3]); w.z = cvt_pk_bf16(v1[0], v1[1]); w.w = cvt_pk_bf16(v1[2], v1[3]);
                    *(u32x4*)(rowp + bj * HALF) = w; }
                if (sm) { float* sp = small + (size_t)row * 32 + 8 * fq; *(f32x4*)sp = acc[ai][0][m][0]; *(f32x4*)(sp + 4) = acc[ai][0][m][1]; } }
    }
};
struct EpiResid {
    static constexpr bool PERM = false, AFTER_DRAIN = false;
    const float* xin; float* xout; const float* gacc; const float* gbias;
    __device__ __forceinline__ void operator()(const f32x4 (&acc)[2][2][4][2], const Unit& u, int wr, int wc, int fr, int fq) const {
        const int b = u.pm >> 3;
        const int col0 = u.pn * BM + wc * 32 + 4 * fq;
#pragma unroll
        for (int bj = 0; bj < 2; ++bj)
#pragma unroll
            for (int n = 0; n < 2; ++n) { const int col = col0 + bj * HALF + n * 16;
                const f32x4 g = *(const f32x4*)(gacc + (size_t)b * 6144 + 4096 + col) + *(const f32x4*)(gbias + 4096 + col);
#pragma unroll
                for (int ai = 0; ai < 2; ++ai)
#pragma unroll
                    for (int m = 0; m < 4; ++m) { const size_t off = (size_t)(u.pm * BM + ai * HALF + wr * 64 + m * 16 + fr) * 2048 + col;
                        const f32x4 xv = *(const f32x4*)(xin + off); *(f32x4*)(xout + off) = xv + g * acc[ai][bj][m][n]; } }
    }
};

struct EpiNull {
    static constexpr bool PERM = false, AFTER_DRAIN = false;
    __device__ __forceinline__ void operator()(const f32x4 (&acc)[2][2][4][2], const Unit& u, int wr, int wc, int fr, int fq) const {
#pragma unroll
        for (int ai = 0; ai < 2; ++ai)
#pragma unroll
            for (int bj = 0; bj < 2; ++bj)
#pragma unroll
                for (int m = 0; m < 4; ++m)
#pragma unroll
                    for (int n = 0; n < 2; ++n) asm volatile("" :: "v"(acc[ai][bj][m][n]));
    }
};
template <class Epi, class Sched, bool ALIGN_EPI = false, bool SP2 = false>
__device__ __forceinline__ void gemm_phase(PG8_LAS unsigned char* lds, const Gemm g, const Sched& S, const Epi& E) {
    const int tid = threadIdx.x, wid = __builtin_amdgcn_readfirstlane(tid >> 6), lane = tid & 63, wr = wid >> 2, wc = wid & 3, fr = lane & 15, fq = lane >> 4;
    const int K = g.K, nt = K / BK;
    unsigned voffA[2], voffB[2];
#pragma unroll
    for (int i = 0; i < 2; ++i) { int R, C; stage_rc(tid * 16 + i * 8192, R, C); const int Rb = Epi::PERM ? ((R & ~31) + perm32(R & 31)) : R;
        voffA[i] = (unsigned)(R * K + C) * 2u; voffB[i] = (unsigned)(Rb * K + C) * 2u; }
    const size_t kstep = (size_t)(BK * 2);
    const size_t hstep = (size_t)HALF * K * 2;
    const size_t tstep = 2 * hstep;
    const unsigned ldsw = (unsigned)wid * 1024u;
    const int aoff = lds_byte(wr * 64 + fr, fq * 8), boff = lds_byte(wc * 32 + fr, fq * 8);
#define PG8_SA(b, h) (((b) * 2 + (h)) * HTB)
#define PG8_SB(b, h) ((4 + (b) * 2 + (h)) * HTB)
#define PG8_STAGE(bufoff, gbase, voff) do { _Pragma("unroll") for (int _i = 0; _i < 2; ++_i) \
        __builtin_amdgcn_global_load_lds((const unsigned*)((const char*)(gbase) + (voff)[_i]), (PG8_LAS unsigned*)(lds + (bufoff) + ldsw + _i * 8192), 16, 0, 0); } while (0)
#define PG8_LDA(dst, b, h) do { _Pragma("unroll") for (int m = 0; m < 4; ++m) _Pragma("unroll") for (int k = 0; k < 2; ++k) dst[m][k] = *(const PG8_LAS bf16x8*)(lds + PG8_SA(b, h) + aoff + m * 2048 + k * 1024); } while (0)
#define PG8_LDB(dst, b, h) do { _Pragma("unroll") for (int n = 0; n < 2; ++n) _Pragma("unroll") for (int k = 0; k < 2; ++k) dst[n][k] = *(const PG8_LAS bf16x8*)(lds + PG8_SB(b, h) + boff + n * 2048 + k * 1024); } while (0)
#define PG8_MMA(ai, bj, At, Bt) do { __builtin_amdgcn_s_setprio(1); _Pragma("unroll") for (int m = 0; m < 4; ++m) _Pragma("unroll") for (int n = 0; n < 2; ++n) _Pragma("unroll") for (int k = 0; k < 2; ++k) \
        acc[ai][bj][m][n] = __builtin_amdgcn_mfma_f32_16x16x32_bf16(Bt[n][k], At[m][k], acc[ai][bj][m][n], 0, 0, 0); __builtin_amdgcn_s_setprio(0); } while (0)
#define PG8_WAIT_V(n) asm volatile("s_waitcnt vmcnt(" #n ")" ::: "memory")
#define PG8_WAIT_L(n) asm volatile("s_waitcnt lgkmcnt(" #n ")" ::: "memory")
#define PG8_BAR __builtin_amdgcn_s_barrier()
#define PG8_SCHED __builtin_amdgcn_sched_barrier(0)
    Unit cur, nxt; int ui = 0;
    if (!S.next(0, cur)) return;
    f32x4 acc[2][2][4][2];
#pragma unroll
    for (int a = 0; a < 2; ++a)
#pragma unroll
        for (int b = 0; b < 2; ++b)
#pragma unroll
            for (int m = 0; m < 4; ++m)
#pragma unroll
                for (int n = 0; n < 2; ++n) acc[a][b][m][n] = (f32x4){0.f, 0.f, 0.f, 0.f};
    bf16x8 At[4][2], B0[2][2], B1[2][2];
    const char* cA = (const char*)g.A + (size_t)cur.pm * tstep; const char* cB = (const char*)g.Bt + (size_t)cur.pn * tstep;
    S.a_ready(cur);
    if constexpr (SP2) {
        PG8_STAGE(PG8_SB(0, 0), cB, voffB); PG8_STAGE(PG8_SB(0, 1), cB + hstep, voffB); PG8_STAGE(PG8_SA(0, 0), cA, voffA); PG8_STAGE(PG8_SA(0, 1), cA + hstep, voffA);
        if (wr == 1) PG8_BAR;
        PG8_WAIT_V(2); PG8_BAR;
        PG8_STAGE(PG8_SB(1, 0), cB + kstep, voffB); PG8_STAGE(PG8_SA(1, 0), cA + kstep, voffA); PG8_STAGE(PG8_SB(1, 1), cB + hstep + kstep, voffB);
        PG8_WAIT_V(6); PG8_BAR;
    } else {
        PG8_STAGE(PG8_SB(0, 0), cB, voffB); PG8_STAGE(PG8_SA(0, 0), cA, voffA); PG8_STAGE(PG8_SB(0, 1), cB + hstep, voffB); PG8_STAGE(PG8_SA(0, 1), cA + hstep, voffA);
        if (wr == 1) PG8_BAR;
        PG8_WAIT_V(4); PG8_BAR;
        PG8_STAGE(PG8_SB(1, 0), cB + kstep, voffB); PG8_STAGE(PG8_SA(1, 0), cA + kstep, voffA); PG8_STAGE(PG8_SB(1, 1), cB + hstep + kstep, voffB);
        PG8_WAIT_V(6); PG8_BAR;
    }
    for (;;) {
        const bool has_next = S.next(ui + 1, nxt);
        const char* nA = has_next ? (const char*)g.A + (size_t)nxt.pm * tstep : cA; const char* nB = has_next ? (const char*)g.Bt + (size_t)nxt.pn * tstep : cB;
        for (int t = 0; t < nt; t += 2) {
            const bool last = (t == nt - 2);
            const char* a1 = cA + (size_t)(t + 1) * kstep;
            const char* a2 = last ? nA : cA + (size_t)(t + 2) * kstep; const char* b2 = last ? nB : cB + (size_t)(t + 2) * kstep;
            const char* a3 = a2 + kstep; const char* b3 = b2 + kstep;
            if (last && has_next) S.a_ready(nxt);
            if constexpr (SP2) {
            PG8_LDB(B0, 0, 0); PG8_LDB(B1, 0, 1); PG8_SCHED; PG8_LDA(At, 0, 0); PG8_STAGE(PG8_SA(1, 1), a1 + hstep, voffA);
            PG8_WAIT_V(8); PG8_WAIT_L(0); PG8_BAR; PG8_MMA(0, 0, At, B0); PG8_MMA(0, 1, At, B1); PG8_BAR; PG8_SCHED;
            PG8_LDA(At, 0, 1); PG8_STAGE(PG8_SB(0, 0), b2, voffB); PG8_STAGE(PG8_SB(0, 1), b2 + hstep, voffB); PG8_STAGE(PG8_SA(0, 0), a2, voffA);
            PG8_WAIT_V(8); PG8_WAIT_L(0); PG8_BAR; PG8_MMA(1, 0, At, B0); PG8_MMA(1, 1, At, B1); PG8_BAR; PG8_SCHED;
            PG8_LDB(B0, 1, 0); PG8_LDB(B1, 1, 1); PG8_SCHED; PG8_LDA(At, 1, 0); PG8_STAGE(PG8_SA(0, 1), a2 + hstep, voffA);
            PG8_WAIT_V(8); PG8_WAIT_L(0); PG8_BAR; PG8_MMA(0, 0, At, B0); PG8_MMA(0, 1, At, B1); PG8_BAR; PG8_SCHED;
            PG8_LDA(At, 1, 1); PG8_STAGE(PG8_SB(1, 0), b3, voffB); PG8_STAGE(PG8_SB(1, 1), b3 + hstep, voffB); PG8_STAGE(PG8_SA(1, 0), a3, voffA);
            PG8_WAIT_V(8); PG8_WAIT_L(0); PG8_BAR; PG8_MMA(1, 0, At, B0); PG8_MMA(1, 1, At, B1); PG8_BAR; PG8_SCHED;
            } else {
            PG8_LDB(B0, 0, 0); PG8_SCHED; PG8_LDA(At, 0, 0); PG8_STAGE(PG8_SA(1, 1), a1 + hstep, voffA);
            PG8_WAIT_L(8); PG8_BAR; PG8_WAIT_L(0); PG8_MMA(0, 0, At, B0); PG8_BAR; PG8_SCHED;
            PG8_LDB(B1, 0, 1); PG8_STAGE(PG8_SB(0, 0), b2, voffB);
            PG8_BAR; PG8_WAIT_L(0); PG8_MMA(0, 1, At, B1); PG8_BAR;
            PG8_LDA(At, 0, 1); PG8_STAGE(PG8_SA(0, 0), a2, voffA);
            PG8_BAR; PG8_WAIT_L(0); PG8_MMA(1, 0, At, B0); PG8_BAR; PG8_SCHED;
            PG8_STAGE(PG8_SB(0, 1), b2 + hstep, voffB);
            PG8_WAIT_V(6); PG8_BAR; PG8_MMA(1, 1, At, B1); PG8_BAR;
            PG8_LDB(B0, 1, 0); PG8_SCHED; PG8_LDA(At, 1, 0); PG8_STAGE(PG8_SA(0, 1), a2 + hstep, voffA);
            PG8_WAIT_L(8); PG8_BAR; PG8_WAIT_L(0); PG8_MMA(0, 0, At, B0); PG8_BAR; PG8_SCHED;
            PG8_LDB(B1, 1, 1); PG8_STAGE(PG8_SB(1, 0), b3, voffB);
            PG8_BAR; PG8_WAIT_L(0); PG8_MMA(0, 1, At, B1); PG8_BAR;
            PG8_LDA(At, 1, 1); PG8_STAGE(PG8_SA(1, 0), a3, voffA);
            PG8_BAR; PG8_WAIT_L(0); PG8_MMA(1, 0, At, B0); PG8_BAR; PG8_SCHED;
            PG8_STAGE(PG8_SB(1, 1), b3 + hstep, voffB);
            PG8_WAIT_V(6); PG8_BAR; PG8_MMA(1, 1, At, B1); PG8_BAR;
            }
        }
        if constexpr (ALIGN_EPI) { if (wr == 0) PG8_BAR; }
        if constexpr (!Epi::AFTER_DRAIN) { E(acc, cur, wr, wc, fr, fq); S.done(cur); }
        if (!has_next) break;
#pragma unroll
        for (int a = 0; a < 2; ++a)
#pragma unroll
            for (int b = 0; b < 2; ++b)
#pragma unroll
                for (int m = 0; m < 4; ++m)
#pragma unroll
                    for (int n = 0; n < 2; ++n) acc[a][b][m][n] = (f32x4){0.f, 0.f, 0.f, 0.f};
        cur = nxt; cA = nA; cB = nB; ++ui;
        if constexpr (ALIGN_EPI) { if (wr == 1) PG8_BAR; }
    }
    PG8_WAIT_V(0);
    if constexpr (!ALIGN_EPI) { if (wr == 0) PG8_BAR; }
    PG8_BAR;
    if constexpr (Epi::AFTER_DRAIN) { E.fused(acc, cur, wr, wc, fr, fq, lds, wid, lane); S.done(cur); }
#undef PG8_SA
#undef PG8_SB
#undef PG8_STAGE
#undef PG8_LDA
#undef PG8_LDB
#undef PG8_MMA
#undef PG8_WAIT_V
#undef PG8_WAIT_L
#undef PG8_BAR
#undef PG8_SCHED
}
}
namespace att {
using bf16 = __hip_bfloat16;
constexpr int   D = 128, NW = 8, QBLK = 32, KVBLK = 64;
constexpr float SCALE = 0.088388347648318440f;
constexpr float THR = 8.f;
constexpr int SDEPTH = 2;
constexpr int LDQ = 1024, LDK = 256, LDY = 2048, LDG = NINP;
constexpr size_t SHM_V = KVBLK * D * 2, SHM_K = KVBLK * D * 2, SHM_ATTN = 2 * SHM_V + 2 * SHM_K + NW * 64 * 4;
using bf16x8 = __attribute__((ext_vector_type(8))) short;
using s16x4  = __attribute__((ext_vector_type(4))) short;
using f32x16 = __attribute__((ext_vector_type(16))) float;
using f32x8  = __attribute__((ext_vector_type(8))) float;
using u32x4  = __attribute__((ext_vector_type(4))) unsigned;
#define KSWZ(row, colB) ((row) * 256 + ((colB) ^ (((row) & 7) << 4)))
#define SBAR() __builtin_amdgcn_sched_barrier(0)
__device__ __forceinline__ int crow(int r, int hi) { return (r & 3) + 8 * (r >> 2) + 4 * hi; }
__device__ __forceinline__ unsigned cvtpk(float lo, float hi) {
  unsigned r; asm volatile("v_cvt_pk_bf16_f32 %0, %1, %2" : "=v"(r) : "v"(lo), "v"(hi)); return r;
}
template <typename TIn> struct Stage;
template <> struct Stage<bf16>  { using T = bf16x8;
  __device__ static __forceinline__ T ld8(const bf16* p) { return *reinterpret_cast<const bf16x8*>(p); }
  __device__ static __forceinline__ bf16x8 tobf(T x) { return x; } };
template <> struct Stage<float> { using T = f32x8;
  __device__ static __forceinline__ T ld8(const float* p) { return *reinterpret_cast<const f32x8*>(p); }
  __device__ static __forceinline__ bf16x8 tobf(T x) {
    u32x4 w = {cvtpk(x[0], x[1]), cvtpk(x[2], x[3]), cvtpk(x[4], x[5]), cvtpk(x[6], x[7])}; return *reinterpret_cast<bf16x8*>(&w); } };

__device__ __forceinline__ void partialSM(f32x16& p0, f32x16& p1, float& m_reg, float& mn, float& alpha) {
  constexpr float C = SCALE * 1.4426950408889634f;
  float pmax = p0[0]; for (int r = 1; r < 16; ++r) pmax = fmaxf(pmax, p0[r]); for (int r = 0; r < 16; ++r) pmax = fmaxf(pmax, p1[r]);
  { auto rr = __builtin_amdgcn_permlane32_swap(__float_as_uint(pmax), __float_as_uint(pmax), false, false);
    pmax = fmaxf(__uint_as_float(rr[0]), __uint_as_float(rr[1])); }
  if (__builtin_expect(__all(pmax - m_reg <= THR / SCALE), 1)) { mn = m_reg; alpha = 1.f; }
  else { mn = fmaxf(m_reg, pmax); alpha = __builtin_amdgcn_exp2f((m_reg - mn) * C); m_reg = mn; }
  float mnC = -mn * C;
  for (int r = 0; r < 16; ++r) p0[r] = fmaf(p0[r], C, mnC); for (int r = 0; r < 16; ++r) p1[r] = fmaf(p1[r], C, mnC);
  for (int r = 0; r < 16; ++r) p0[r] = __builtin_amdgcn_exp2f(p0[r]);
}
__device__ __forceinline__ void finishSM(f32x16& p0, f32x16& p1, float alpha, float& l_reg, bf16x8& pa0, bf16x8& pa1, bf16x8& pa2, bf16x8& pa3) {
  for (int r = 0; r < 16; ++r) p1[r] = __builtin_amdgcn_exp2f(p1[r]);
  float ps = 0; for (int r = 0; r < 16; ++r) ps += p0[r]; for (int r = 0; r < 16; ++r) ps += p1[r];
  { auto rr = __builtin_amdgcn_permlane32_swap(__float_as_uint(ps), __float_as_uint(ps), false, false);
    ps = __uint_as_float(rr[0]) + __uint_as_float(rr[1]); }
  l_reg = l_reg * alpha + ps;
#define PK4(P, BASE, OUT) do { unsigned a0 = cvtpk(P[BASE + 0], P[BASE + 1]), a1 = cvtpk(P[BASE + 2], P[BASE + 3]);   \
    unsigned b0 = cvtpk(P[BASE + 4], P[BASE + 5]), b1 = cvtpk(P[BASE + 6], P[BASE + 7]);                              \
    auto r0 = __builtin_amdgcn_permlane32_swap(a0, b0, false, false); auto r1 = __builtin_amdgcn_permlane32_swap(a1, b1, false, false); \
    u32x4 w = {r0[0], r1[0], r0[1], r1[1]}; OUT = *reinterpret_cast<bf16x8*>(&w); } while (0)
  PK4(p0, 0, pa0); PK4(p0, 8, pa1); PK4(p1, 0, pa2); PK4(p1, 8, pa3);
#undef PK4
}
__device__ __forceinline__ void qkt(f32x16& p0, f32x16& p1, const bf16* Ks, const bf16x8* qr, int r32, int hi) {
  p0 = f32x16{}; p1 = f32x16{};
  for (int d0 = 0; d0 < 8; ++d0) { int cb = (d0 * 16 + hi * 8) * 2;
    bf16x8 b0 = *reinterpret_cast<const bf16x8*>((const char*)Ks + KSWZ(r32, cb));
    bf16x8 b1 = *reinterpret_cast<const bf16x8*>((const char*)Ks + KSWZ(32 + r32, cb));
    p0 = __builtin_amdgcn_mfma_f32_32x32x16_bf16(b0, qr[d0], p0, 0, 0, 0);
    p1 = __builtin_amdgcn_mfma_f32_32x32x16_bf16(b1, qr[d0], p1, 0, 0, 0); }
}
__device__ __forceinline__ int v_st(int k, int c) { const int kk = (k & ~0xC) | ((k & 4) << 1) | ((k & 8) >> 1); return ((kk >> 3) * 4 + (c >> 5)) * 512 + ((kk & 7) * 32 + (c & 31)) * 2; }
__device__ __forceinline__ int v_rd_base(int lane) { return ((lane & 3) << 3) | (((lane >> 2) & 3) << 6) | (((lane >> 4) & 1) << 5) | (((lane >> 5) & 1) << 8); }
constexpr int v_rd_off(int d0, int ks, int half) { return d0 * 512 + ks * 4096 + half * 2048; }
template <int OFF> __device__ __forceinline__ s16x4 tr_read(int vb) {
  s16x4 r; asm volatile("ds_read_b64_tr_b16 %0, %1 offset:%2" : "=&v"(r) : "v"(vb), "i"(OFF) : "memory"); return r;
}
template <int D0> __device__ __forceinline__ void pv_one(f32x16& od, int vb, bf16x8 pa0, bf16x8 pa1, bf16x8 pa2, bf16x8 pa3) {
  const s16x4 l0 = tr_read<v_rd_off(D0, 0, 0)>(vb), h0 = tr_read<v_rd_off(D0, 0, 1)>(vb), l1 = tr_read<v_rd_off(D0, 1, 0)>(vb), h1 = tr_read<v_rd_off(D0, 1, 1)>(vb);
  const s16x4 l2 = tr_read<v_rd_off(D0, 2, 0)>(vb), h2 = tr_read<v_rd_off(D0, 2, 1)>(vb), l3 = tr_read<v_rd_off(D0, 3, 0)>(vb), h3 = tr_read<v_rd_off(D0, 3, 1)>(vb);
  asm volatile("s_waitcnt lgkmcnt(0)" ::: "memory"); SBAR();
#define PK(L, H) (bf16x8){L[0], L[1], L[2], L[3], H[0], H[1], H[2], H[3]}
  od = __builtin_amdgcn_mfma_f32_32x32x16_bf16(pa0, PK(l0, h0), od, 0, 0, 0);
  od = __builtin_amdgcn_mfma_f32_32x32x16_bf16(pa1, PK(l1, h1), od, 0, 0, 0);
  od = __builtin_amdgcn_mfma_f32_32x32x16_bf16(pa2, PK(l2, h2), od, 0, 0, 0);
  od = __builtin_amdgcn_mfma_f32_32x32x16_bf16(pa3, PK(l3, h3), od, 0, 0, 0);
#undef PK
}
__device__ __forceinline__ void pv_d0(f32x16* o, int vb, bf16x8 pa0, bf16x8 pa1, bf16x8 pa2, bf16x8 pa3) {
  pv_one<0>(o[0], vb, pa0, pa1, pa2, pa3); pv_one<1>(o[1], vb, pa0, pa1, pa2, pa3); pv_one<2>(o[2], vb, pa0, pa1, pa2, pa3); pv_one<3>(o[3], vb, pa0, pa1, pa2, pa3);
}
__device__ __forceinline__ void attn_dense_body(const bf16* __restrict__ Qb, const bf16* __restrict__ Kh, const bf16* __restrict__ Vh,
                                                unsigned short* __restrict__ Yb, const unsigned short* __restrict__ Gb, int seq, char* lds) {
  using St = Stage<bf16>; using SQ = Stage<bf16>; using TQ = bf16;
  const int tid = threadIdx.x, wid = tid >> 6, lane = tid & 63, r32 = lane & 31, hi = lane >> 5;
  bf16* V_lds = (bf16*)lds; bf16* K_lds = (bf16*)(lds + 2 * SHM_V);
  float* ws = (float*)(lds + 2 * SHM_V + 2 * SHM_K) + wid * 64; float* li_l = ws; float* al_l = ws + 32;
  float m_reg = -1e30f, l_reg = 0; f32x16 o[4] = {}; bf16x8 qr[8];
  const TQ* Qw = Qb + (long)(wid * QBLK + r32) * LDQ + hi * 8;
#pragma unroll
  for (int d0 = 0; d0 < 8; ++d0) qr[d0] = SQ::tobf(SQ::ld8(Qw + d0 * 16));
  const int sr = tid >> 4, sc = (tid & 15) * 8, vst0 = v_st(sr, sc), vst1 = v_st(32 + sr, sc);
  const int vb0 = (int)(uintptr_t)V_lds + v_rd_base(lane);
  struct { typename St::T vs0, vs1, ks0, ks1; } sr_[SDEPTH];
#define SLOAD(i, k0) do { sr_[i].vs0 = St::ld8(&Vh[(long)((k0) + sr) * LDK + sc]); sr_[i].vs1 = St::ld8(&Vh[(long)((k0) + 32 + sr) * LDK + sc]); \
    sr_[i].ks0 = St::ld8(&Kh[(long)((k0) + sr) * LDK + sc]); sr_[i].ks1 = St::ld8(&Kh[(long)((k0) + 32 + sr) * LDK + sc]); } while (0)
#define SWRITE(b, i) do { *(bf16x8*)((char*)V_lds + (b) * SHM_V + vst0) = St::tobf(sr_[i].vs0);          \
    *(bf16x8*)((char*)V_lds + (b) * SHM_V + vst1) = St::tobf(sr_[i].vs1); int kc = sc * 2;               \
    *(bf16x8*)((char*)K_lds + (b) * SHM_K + KSWZ(sr, kc)) = St::tobf(sr_[i].ks0);                       \
    *(bf16x8*)((char*)K_lds + (b) * SHM_K + KSWZ(32 + sr, kc)) = St::tobf(sr_[i].ks1); } while (0)
#define SWAIT() do { if constexpr (SDEPTH == 2) asm volatile("s_waitcnt vmcnt(4)" ::: "memory"); else asm volatile("s_waitcnt vmcnt(0)" ::: "memory"); } while (0)
#define RESC(a) do { if (__any((a) < 1.f)) { if (hi == 0) al_l[r32] = (a); asm volatile("s_waitcnt lgkmcnt(0)" ::: "memory"); \
    for (int d = 0; d < 4; ++d) for (int r = 0; r < 16; ++r) o[d][r] *= al_l[crow(r, hi)]; } } while (0)
  f32x16 pA0, pA1, pB0, pB1; float mnA, mnB, alA, alB; bf16x8 pa0, pa1, pa2, pa3; const int NT = seq / KVBLK;
  constexpr int SE = 0, SO = SDEPTH - 1;
  SLOAD(SE, 0); asm volatile("s_waitcnt vmcnt(0)" ::: "memory"); SWRITE(0, SE); __syncthreads();
  qkt(pA0, pA1, K_lds, qr, r32, hi); partialSM(pA0, pA1, m_reg, mnA, alA);
  SLOAD(SO, KVBLK); if constexpr (SDEPTH == 2) { if (2 < NT) SLOAD(SE, 2 * KVBLK); }
  SWAIT(); SWRITE(1, SO); __syncthreads();
  for (int j = 1; j + 1 < NT; j += 2) {
    SBAR(); qkt(pB0, pB1, (bf16*)((char*)K_lds + SHM_K), qr, r32, hi);
    finishSM(pA0, pA1, alA, l_reg, pa0, pa1, pa2, pa3); SBAR();
    SLOAD(SO, (j + SDEPTH) * KVBLK); SBAR();
    pv_d0(o, vb0, pa0, pa1, pa2, pa3); partialSM(pB0, pB1, m_reg, mnB, alB);
    __syncthreads(); SWAIT(); SWRITE(0, SE);
    RESC(alB); __syncthreads();
    SBAR(); qkt(pA0, pA1, K_lds, qr, r32, hi);
    finishSM(pB0, pB1, alB, l_reg, pa0, pa1, pa2, pa3); SBAR();
    if (SDEPTH == 1 || j + 3 < NT) SLOAD(SE, (j + 1 + SDEPTH) * KVBLK); SBAR();
    pv_d0(o, vb0 + (int)SHM_V, pa0, pa1, pa2, pa3); partialSM(pA0, pA1, m_reg, mnA, alA);
    __syncthreads(); SWAIT(); SWRITE(1, SO);
    RESC(alA); __syncthreads();
  }
  SBAR(); qkt(pB0, pB1, (bf16*)((char*)K_lds + SHM_K), qr, r32, hi);
  finishSM(pA0, pA1, alA, l_reg, pa0, pa1, pa2, pa3); SBAR();
  pv_d0(o, vb0, pa0, pa1, pa2, pa3); partialSM(pB0, pB1, m_reg, mnB, alB);
  __syncthreads(); RESC(alB);
  finishSM(pB0, pB1, alB, l_reg, pa0, pa1, pa2, pa3); SBAR();
  pv_d0(o, vb0 + (int)SHM_V, pa0, pa1, pa2, pa3);
  if (hi == 0) li_l[r32] = l_reg; asm volatile("s_waitcnt lgkmcnt(0)" ::: "memory");
  float rli[16];
#pragma unroll
  for (int r = 0; r < 16; ++r) rli[r] = __builtin_amdgcn_rcpf(li_l[crow(r, hi)]);
  __syncthreads();
  { int ew = wid; asm volatile("" : "+v"(ew));
    float* stg = (float*)lds + ew * (32 * 132);
#pragma unroll
    for (int r = 0; r < 16; ++r) { const int orow = crow(r, hi);
#pragma unroll
      for (int d0 = 0; d0 < 4; ++d0) stg[orow * 132 + d0 * 32 + r32] = o[d0][r] * rli[r]; }
    asm volatile("s_waitcnt lgkmcnt(0)" ::: "memory");
    int el = lane; asm volatile("" : "+v"(el));
    const unsigned short* Gw0 = Gb + (long)(ew * QBLK) * LDG; unsigned short* Yw0 = Yb + (long)(ew * QBLK) * LDY;
#pragma unroll 2
    for (int i = 0; i < 8; ++i) { const int id = el + 64 * i, row = id >> 4, c8 = id & 15;
      const float* sp = stg + row * 132 + c8 * 8;
      const u32x4 gw = *reinterpret_cast<const u32x4*>(Gw0 + (long)row * LDG + c8 * 8);
      u32x4 ow;
#pragma unroll
      for (int q = 0; q < 4; ++q) { const unsigned gq = (q == 0) ? gw.x : (q == 1) ? gw.y : (q == 2) ? gw.z : gw.w;
        const float g0 = __uint_as_float(gq << 16), g1 = __uint_as_float(gq & 0xffff0000u);
        const float v0 = sp[2 * q] * (g0 / (1.f + __expf(-g0))), v1 = sp[2 * q + 1] * (g1 / (1.f + __expf(-g1)));
        const unsigned pk = cvtpk(v0, v1);
        if (q == 0) ow.x = pk; else if (q == 1) ow.y = pk; else if (q == 2) ow.z = pk; else ow.w = pk; }
      *reinterpret_cast<u32x4*>(Yw0 + (long)row * LDY + c8 * 8) = ow; } }
#undef SLOAD
#undef SWRITE
#undef SWAIT
#undef RESC
}
}
#define GAS __attribute__((address_space(1)))
#define LAS __attribute__((address_space(3)))
typedef unsigned short bf16_t;
typedef unsigned v4u __attribute__((ext_vector_type(4)));
typedef unsigned v2u __attribute__((ext_vector_type(2)));
typedef float f32x4 __attribute__((ext_vector_type(4)));
typedef short bf16x8_t __attribute__((ext_vector_type(8)));
typedef float f32x16_t __attribute__((ext_vector_type(16)));
#define LDS_WAIT() asm volatile("s_waitcnt lgkmcnt(0)" ::: "memory")

constexpr size_t MiB = 1u << 20;
constexpr size_t WS_CTL = 0, CTL_ZERO_BYTES = 1 * MiB;
constexpr size_t WS_MOD = 64 * 1024;
constexpr size_t WS_ROPE = 1 * MiB;
constexpr size_t WS_SMALL = 2 * MiB;
constexpr size_t WS_WIN0 = 3 * MiB, WS_WOUT0 = 24 * MiB;
constexpr size_t WS_QB = 32 * MiB, WS_KB = 48 * MiB, WS_VB = 52 * MiB;
constexpr size_t WS_HB = 3 * MiB;
constexpr size_t WS_WIN1 = 56 * MiB, WS_WOUT1 = 77 * MiB;
constexpr size_t WS_H = 85 * MiB;
constexpr size_t WS_HF = 85 * MiB;
constexpr size_t WS_PROJ = 117 * MiB;
constexpr size_t WS_YCAT = 201 * MiB;
constexpr size_t WS_ACT = 233 * MiB;
constexpr size_t WS_YF = 297 * MiB, WS_YB = 329 * MiB;
constexpr size_t WS_XBC16 = 85 * MiB;
constexpr size_t WS_QKV16 = 3 * MiB;
constexpr size_t WS_XC16 = 35 * MiB;
constexpr size_t WS_GT = 85 * MiB, WS_GA = 101 * MiB;
constexpr size_t WS_WGT = 361 * MiB;
constexpr size_t WS_LSUM = 362 * MiB;
constexpr size_t WS_HF16 = 56 * MiB;
constexpr size_t WS_HB16 = 366 * MiB;
constexpr size_t WS_END = 382 * MiB;

constexpr int NWAVES = 8, NTHREADS = 512;
constexpr int LDS_BYTES = 163840;
constexpr int NPHASE = 15;

struct Args { const float* in[39]; float* out; unsigned char* ws; int ph_lo, ph_hi; };

__device__ __forceinline__ float bf2f(unsigned v) { return __uint_as_float(v << 16); }
__device__ __forceinline__ unsigned f2bf(float f) { unsigned u = __float_as_uint(f); return (u + 0x7fffu + ((u >> 16) & 1u)) >> 16; }
__device__ __forceinline__ unsigned pk2(float lo, float hi) { return f2bf(lo) | (f2bf(hi) << 16); }
__device__ __forceinline__ void unpack8(const v4u w, float* x) {
    x[0] = __uint_as_float(w.x << 16); x[1] = __uint_as_float(w.x & 0xffff0000u); x[2] = __uint_as_float(w.y << 16); x[3] = __uint_as_float(w.y & 0xffff0000u);
    x[4] = __uint_as_float(w.z << 16); x[5] = __uint_as_float(w.z & 0xffff0000u); x[6] = __uint_as_float(w.w << 16); x[7] = __uint_as_float(w.w & 0xffff0000u);
}
__device__ __forceinline__ v4u pack8(const float* x) { v4u w; w.x = pk2(x[0], x[1]); w.y = pk2(x[2], x[3]); w.z = pk2(x[4], x[5]); w.w = pk2(x[6], x[7]); return w; }
__device__ __forceinline__ float silu_f(float x) { return x / (1.f + expf(-x)); }
__device__ __forceinline__ float sigmoid_f(float x) { return 1.f / (1.f + expf(-x)); }
__device__ __forceinline__ float softplus_f(float x) { return fmaxf(x, 0.f) + log1pf(expf(-fabsf(x))); }
template <int CTRL> __device__ __forceinline__ float dpp_mov(float v) { return __builtin_bit_cast(float, __builtin_amdgcn_update_dpp(0, __builtin_bit_cast(int, v), CTRL, 0xF, 0xF, true)); }
template <int N> __device__ __forceinline__ float group_sum(float v) {
    if (N >= 2) v += dpp_mov<0xB1>(v);
    if (N >= 4) v += dpp_mov<0x4E>(v);
    if (N >= 8) v += dpp_mov<0x141>(v);
    if (N >= 16) v += dpp_mov<0x140>(v);
    if (N >= 32) v += __shfl_xor(v, 16);
    if (N >= 64) v += __shfl_xor(v, 32);
    return v;
}

__device__ __forceinline__ void p0_transpose_item(const float* W, int K, int N, bf16_t* WT, int row_off, LAS float* scr, int item, int lane) {
    const int nblk = N / 32, kb = item / nblk, nb = item % nblk, k0 = 64 * kb, n0 = 32 * nb;
#pragma unroll 8
    for (int i = 0; i < 32; ++i) { const int kk = 2 * i + (lane >> 5); scr[kk * 33 + (lane & 31)] = W[(size_t)(k0 + kk) * N + n0 + (lane & 31)]; }
    LDS_WAIT(); asm volatile("" ::: "memory");
    const int c = lane & 7;
#pragma unroll
    for (int j = 0; j < 4; ++j) { const int n = (lane >> 3) + 8 * j; const LAS float* s = scr + (8 * c) * 33 + n;
        v4u o; o.x = pk2(s[0 * 33], s[1 * 33]); o.y = pk2(s[2 * 33], s[3 * 33]); o.z = pk2(s[4 * 33], s[5 * 33]); o.w = pk2(s[6 * 33], s[7 * 33]);
        *(v4u*)(WT + (size_t)(row_off + n0 + n) * K + k0 + 8 * c) = o; }
    LDS_WAIT(); asm volatile("" ::: "memory");
}

__device__ __forceinline__ void p0_prologue(const Args& a, LAS unsigned char* lds, int vcu, int G) {
    const int tid = threadIdx.x, lane = tid & 63, wave = tid >> 6;
    unsigned char* ws = a.ws;
    { const int gid = blockIdx.x * NTHREADS + tid;
      if (gid < 2048) { const int pos = gid >> 5, i = gid & 31; const float freq = expf(-(float)i * (1.f / 32.f) * 9.210340371976184f); const float ang = (float)pos * freq;
          float* rt = (float*)(ws + WS_ROPE); rt[2 * gid] = cosf(ang); rt[2 * gid + 1] = sinf(ang); } }
    { const int gid = blockIdx.x * NTHREADS + tid, gn = G * NTHREADS; constexpr int NV = (NINP - NIN) * 2048 * 2 / 16;
      v4u* p0 = (v4u*)(ws + WS_WIN0 + (size_t)NIN * 2048 * 2); v4u* p1 = (v4u*)(ws + WS_WIN1 + (size_t)NIN * 2048 * 2);
      for (int i = gid; i < NV; i += gn) { p0[i] = (v4u){0, 0, 0, 0}; p1[i] = (v4u){0, 0, 0, 0}; } }
    if (blockIdx.x < 96) {
        const int it = blockIdx.x, l = 0, r = it, kc = r / 3, nc = r % 3;
        LAS float* cond = (LAS float*)lds;
        if (tid < 256) { const int b = tid >> 6, k = tid & 63; const float c = a.in[1][b * 2048 + kc * 64 + k]; cond[tid] = silu_f(c); }
        __syncthreads();
        const float* W = a.in[2] + (size_t)l * 2048 * 6144 + (size_t)(kc * 64) * 6144 + nc * 2048 + tid * 4;
        f32x4 acc0 = {0, 0, 0, 0}, acc1 = acc0, acc2 = acc0, acc3 = acc0;
#pragma unroll 8
        for (int k = 0; k < 64; ++k) { const f32x4 w = *(const f32x4*)(W + (size_t)k * 6144);
            acc0 += cond[k] * w; acc1 += cond[64 + k] * w; acc2 += cond[128 + k] * w; acc3 += cond[192 + k] * w; }
        float* macc = (float*)(ws + WS_MOD) + (size_t)l * 4 * 6144 + nc * 2048 + tid * 4;
#pragma unroll
        for (int i = 0; i < 4; ++i) { atomicAdd(macc + i, acc0[i]); atomicAdd(macc + 6144 + i, acc1[i]); atomicAdd(macc + 2 * 6144 + i, acc2[i]); atomicAdd(macc + 3 * 6144 + i, acc3[i]); }
        __syncthreads();
    }
    { LAS float* scr = (LAS float*)(lds + wave * 16384);
      const int gw = vcu * NWAVES + wave, NGW = G * NWAVES;
      constexpr int I_IN = 32 * (NIN / 32), I_OUT = 32 * 64, NITEMS = I_IN + I_OUT;
      for (int it = gw; it < NITEMS; it += NGW) {
          int r = it;
          if (r < I_IN) { p0_transpose_item(a.in[5], 2048, NIN, (bf16_t*)(ws + WS_WIN0), 0, scr, r, lane); continue; } r -= I_IN;
          p0_transpose_item(a.in[16], 2048, 2048, (bf16_t*)(ws + WS_WOUT0), 0, scr, r, lane);
      } }
}
__device__ __forceinline__ void late_transposes(const Args& a, LAS float* scr, int hw, int NHW, int lane) {
    unsigned char* ws = a.ws;
    constexpr int I_IN = 32 * (NIN / 32), I_OUT = 32 * 64, I_G = 32 * 8, NITEMS = I_IN + I_OUT + I_G;
    for (int it = hw; it < NITEMS; it += NHW) {
        int r = it;
        if (r < I_G) { const int mn = r >> 3, m = mn >> 3; const float* Wg = a.in[m == 0 ? 27 : m == 1 ? 29 : m == 2 ? 32 : 34] + (size_t)(mn & 7) * 128 * 128;
            p0_transpose_item(Wg, 128, 128, (bf16_t*)(ws + WS_WGT) + (size_t)mn * 128 * 128, 0, scr, r & 7, lane); continue; } r -= I_G;
        if (r < I_IN) { p0_transpose_item(a.in[17], 2048, NIN, (bf16_t*)(ws + WS_WIN1), 0, scr, r, lane); continue; } r -= I_IN;
        p0_transpose_item(a.in[37], 2048, 2048, (bf16_t*)(ws + WS_WOUT1), 0, scr, r, lane);
    }
}

__device__ __forceinline__ void gemv_wave(const Args& a, int layer, int item, int lane) {
    const int kc = item / 24, ncw = item % 24;
    float cv[4];
#pragma unroll
    for (int b = 0; b < 4; ++b) cv[b] = silu_f(a.in[1][b * 2048 + kc * 64 + lane]);
    const float* W = a.in[2] + (size_t)layer * 2048 * 6144 + (size_t)(kc * 64) * 6144 + ncw * 256 + lane * 4;
    f32x4 acc0 = {0, 0, 0, 0}, acc1 = acc0, acc2 = acc0, acc3 = acc0;
#pragma unroll 8
    for (int k = 0; k < 64; ++k) { const f32x4 w = *(const f32x4*)(W + (size_t)k * 6144);
        acc0 += __builtin_bit_cast(float, __builtin_amdgcn_readlane(__builtin_bit_cast(int, cv[0]), k)) * w;
        acc1 += __builtin_bit_cast(float, __builtin_amdgcn_readlane(__builtin_bit_cast(int, cv[1]), k)) * w;
        acc2 += __builtin_bit_cast(float, __builtin_amdgcn_readlane(__builtin_bit_cast(int, cv[2]), k)) * w;
        acc3 += __builtin_bit_cast(float, __builtin_amdgcn_readlane(__builtin_bit_cast(int, cv[3]), k)) * w; }
    float* macc = (float*)(a.ws + WS_MOD) + (size_t)layer * 4 * 6144 + ncw * 256 + lane * 4;
#pragma unroll
    for (int i = 0; i < 4; ++i) { atomicAdd(macc + i, acc0[i]); atomicAdd(macc + 6144 + i, acc1[i]); atomicAdd(macc + 2 * 6144 + i, acc2[i]); atomicAdd(macc + 3 * 6144 + i, acc3[i]); }
}
__device__ __forceinline__ void normmod_phase(const Args& a, const float* xin, int layer, int gw, int NGW, int lane) {
    const float* nw = a.in[4] + layer * 2048; const float* bm = a.in[3] + layer * 6144;
    const float* macc = (const float*)(a.ws + WS_MOD) + (size_t)layer * 4 * 6144;
    bf16_t* H = (bf16_t*)(a.ws + WS_H);
    for (int m = gw; m < MTOK; m += NGW) {
        const int b = m >> 11;
        const f32x4* xr = (const f32x4*)(xin + (size_t)m * 2048) + lane;
        f32x4 v[8]; float s = 0.f;
#pragma unroll
        for (int j = 0; j < 8; ++j) { v[j] = xr[64 * j]; s += (v[j].x * v[j].x + v[j].y * v[j].y) + (v[j].z * v[j].z + v[j].w * v[j].w); }
        const float rstd = rsqrtf(group_sum<64>(s) * (1.f / 2048.f) + EPS);
#pragma unroll
        for (int j = 0; j < 8; ++j) { const int col = (64 * j + lane) * 4;
            const f32x4 w = *(const f32x4*)(nw + col);
            const f32x4 sh = *(const f32x4*)(macc + b * 6144 + col) + *(const f32x4*)(bm + col);
            const f32x4 sc = *(const f32x4*)(macc + b * 6144 + 2048 + col) + *(const f32x4*)(bm + 2048 + col);
            const f32x4 o = v[j] * rstd * w * (1.f + sc) + sh;
            v2u pk; pk.x = pk2(o.x, o.y); pk.y = pk2(o.z, o.w);
            *(v2u*)(H + (size_t)m * 2048 + col) = pk; }
    }
}

__device__ __forceinline__ void post0_phase(const Args& a, int gw, int NGW, int lane) {
    const bf16_t* P = (const bf16_t*)(a.ws + WS_PROJ);
    const float2* rope = (const float2*)(a.ws + WS_ROPE);
    const float* qn = a.in[6]; const float* kn = a.in[7]; const float* cw = a.in[8]; const float* cb = a.in[9];
    bf16_t* Q = (bf16_t*)(a.ws + WS_QB); bf16_t* K = (bf16_t*)(a.ws + WS_KB); bf16_t* V = (bf16_t*)(a.ws + WS_VB);
    float* ACT = (float*)(a.ws + WS_ACT);
    for (int m = gw; m < MTOK; m += NGW) {
        const int t = m & 2047, prow = t >> 6, pcol = t & 63;
        const bf16_t* pr = P + (size_t)m * NINP;
        {
            float x[16]; unpack8(*(const v4u*)(pr + A_Q + lane * 16), x); unpack8(*(const v4u*)(pr + A_Q + lane * 16 + 8), x + 8);
            float ss = 0.f;
#pragma unroll
            for (int i = 0; i < 16; ++i) ss += x[i] * x[i];
            ss = group_sum<8>(ss);
            const float r = rsqrtf(ss * (1.f / 128.f) + EPS);
            const int d0 = (lane & 7) * 16;
#pragma unroll
            for (int i = 0; i < 16; ++i) x[i] = x[i] * r * qn[d0 + i];
#pragma unroll
            for (int pi = 0; pi < 8; ++pi) { const int p = (d0 >> 1) + pi; const float2 cs = (p < 32) ? rope[prow * 32 + p] : rope[pcol * 32 + p - 32];
                const float x0 = x[2 * pi], x1 = x[2 * pi + 1]; x[2 * pi] = x0 * cs.x - x1 * cs.y; x[2 * pi + 1] = x0 * cs.y + x1 * cs.x; }
            *(v4u*)(Q + (size_t)m * 1024 + lane * 16) = pack8(x); *(v4u*)(Q + (size_t)m * 1024 + lane * 16 + 8) = pack8(x + 8);
        }
        {
            const v2u w = *(const v2u*)(pr + A_K + lane * 4);
            float x[4] = {__uint_as_float(w.x << 16), __uint_as_float(w.x & 0xffff0000u), __uint_as_float(w.y << 16), __uint_as_float(w.y & 0xffff0000u)};
            float ss = (x[0] * x[0] + x[1] * x[1]) + (x[2] * x[2] + x[3] * x[3]);
            ss = group_sum<32>(ss);
            const float r = rsqrtf(ss * (1.f / 128.f) + EPS);
            const int d0 = (lane & 31) * 4;
#pragma unroll
            for (int i = 0; i < 4; ++i) x[i] = x[i] * r * kn[d0 + i];
#pragma unroll
            for (int pi = 0; pi < 2; ++pi) { const int p = (d0 >> 1) + pi; const float2 cs = (p < 32) ? rope[prow * 32 + p] : rope[pcol * 32 + p - 32];
                const float x0 = x[2 * pi], x1 = x[2 * pi + 1]; x[2 * pi] = x0 * cs.x - x1 * cs.y; x[2 * pi + 1] = x0 * cs.y + x1 * cs.x; }
            v2u o; o.x = pk2(x[0], x[1]); o.y = pk2(x[2], x[3]);
            *(v2u*)(K + (size_t)m * 256 + lane * 4) = o;
            *(v2u*)(V + (size_t)m * 256 + lane * 4) = *(const v2u*)(pr + A_V + lane * 4);
        }
#pragma unroll
        for (int j = 0; j < 3; ++j) { const int ch = (j * 64 + lane) * 8;
            float acc[8];
            { const f32x4 b0 = *(const f32x4*)(cb + ch), b1 = *(const f32x4*)(cb + ch + 4); acc[0] = b0.x; acc[1] = b0.y; acc[2] = b0.z; acc[3] = b0.w; acc[4] = b1.x; acc[5] = b1.y; acc[6] = b1.z; acc[7] = b1.w; }
#pragma unroll
            for (int d = 0; d < 4; ++d) { const int ts = t + d - 2;
                if (ts >= 0 && ts < SEQ) { float x[8]; unpack8(*(const v4u*)(P + (size_t)(m + d - 2) * NINP + A_XS + ch), x);
                    const f32x4 w0 = *(const f32x4*)(cw + d * 1536 + ch), w1 = *(const f32x4*)(cw + d * 1536 + ch + 4);
                    acc[0] += w0.x * x[0]; acc[1] += w0.y * x[1]; acc[2] += w0.z * x[2]; acc[3] += w0.w * x[3];
                    acc[4] += w1.x * x[4]; acc[5] += w1.y * x[5]; acc[6] += w1.z * x[6]; acc[7] += w1.w * x[7]; } }
            f32x4 o0, o1; o0.x = silu_f(acc[0]); o0.y = silu_f(acc[1]); o0.z = silu_f(acc[2]); o0.w = silu_f(acc[3]); o1.x = silu_f(acc[4]); o1.y = silu_f(acc[5]); o1.z = silu_f(acc[6]); o1.w = silu_f(acc[7]);
            if (j < 2) { *(f32x4*)(ACT + (size_t)m * 1536 + ch) = o0; *(f32x4*)(ACT + (size_t)m * 1536 + ch + 4) = o1; }
            else { v4u w; w.x = pk2(o0.x, o0.y); w.y = pk2(o0.z, o0.w); w.z = pk2(o1.x, o1.y); w.w = pk2(o1.z, o1.w); *(v4u*)((bf16_t*)(a.ws + WS_XBC16) + (size_t)m * 1536 + ch) = w; } }
    }
}

typedef float f32x2 __attribute__((ext_vector_type(2)));
__device__ __forceinline__ void ssd_combine_phase(const Args& a, int gw, int NGW, int lane) {
    const float* YF = (const float*)(a.ws + WS_YF); const float* YB = (const float*)(a.ws + WS_YB); const float* ACT = (const float*)(a.ws + WS_ACT);
    const bf16_t* P = (const bf16_t*)(a.ws + WS_PROJ); bf16_t* YC = (bf16_t*)(a.ws + WS_YCAT);
    const float* dsk = a.in[14]; const float* nw = a.in[15];
    for (int m = gw; m < MTOK; m += NGW) {
        const int ch = lane * 16; const float dk = dsk[ch >> 6];
        float z[16], gv[16]; unpack8(*(const v4u*)(P + (size_t)m * NINP + A_Z + ch), z); unpack8(*(const v4u*)(P + (size_t)m * NINP + A_Z + ch + 8), z + 8);
        float ss = 0.f;
#pragma unroll
        for (int q = 0; q < 4; ++q) { const f32x4 f = *(const f32x4*)(YF + (size_t)m * 1024 + ch + 4 * q), bk = *(const f32x4*)(YB + (size_t)m * 1024 + ch + 4 * q), xv = *(const f32x4*)(ACT + (size_t)m * 1536 + ch + 4 * q);
            const f32x4 y = f + bk + dk * xv;
            gv[4 * q] = y.x * silu_f(z[4 * q]); gv[4 * q + 1] = y.y * silu_f(z[4 * q + 1]); gv[4 * q + 2] = y.z * silu_f(z[4 * q + 2]); gv[4 * q + 3] = y.w * silu_f(z[4 * q + 3]); }
#pragma unroll
        for (int i = 0; i < 16; ++i) ss += gv[i] * gv[i];
        const float r = rsqrtf(group_sum<64>(ss) * (1.f / 1024.f) + EPS);
#pragma unroll
        for (int i = 0; i < 16; ++i) gv[i] = gv[i] * r * nw[ch + i];
        *(v4u*)(YC + (size_t)m * 2048 + 1024 + ch) = pack8(gv); *(v4u*)(YC + (size_t)m * 2048 + 1024 + ch + 8) = pack8(gv + 8);
    }
}

__device__ __forceinline__ void post1_phase(const Args& a, int gw, int NGW, int lane) {
    const bf16_t* P = (const bf16_t*)(a.ws + WS_PROJ); const float* cw = a.in[18]; const float* cb = a.in[19];
    float* ACT = (float*)(a.ws + WS_ACT);
    for (int m = gw; m < MTOK; m += NGW) {
        const int t = m & 2047;
#pragma unroll
        for (int j = 0; j < 4; ++j) { const int ch = (j * 64 + lane) * 8;
            float acc[8];
            { const f32x4 b0 = *(const f32x4*)(cb + ch), b1 = *(const f32x4*)(cb + ch + 4); acc[0] = b0.x; acc[1] = b0.y; acc[2] = b0.z; acc[3] = b0.w; acc[4] = b1.x; acc[5] = b1.y; acc[6] = b1.z; acc[7] = b1.w; }
#pragma unroll
            for (int d = 0; d < 4; ++d) { const int ts = t + d - 2;
                if (ts >= 0 && ts < SEQ) { float x[8]; unpack8(*(const v4u*)(P + (size_t)(m + d - 2) * NINP + C_Q + ch), x);
                    const f32x4 w0 = *(const f32x4*)(cw + d * 2048 + ch), w1 = *(const f32x4*)(cw + d * 2048 + ch + 4);
                    acc[0] += w0.x * x[0]; acc[1] += w0.y * x[1]; acc[2] += w0.z * x[2]; acc[3] += w0.w * x[3];
                    acc[4] += w1.x * x[4]; acc[5] += w1.y * x[5]; acc[6] += w1.z * x[6]; acc[7] += w1.w * x[7]; } }
#pragma unroll
            for (int i = 0; i < 8; ++i) acc[i] = silu_f(acc[i]);
            if (j < 2) {
                float ss = 0.f;
#pragma unroll
                for (int i = 0; i < 8; ++i) ss += acc[i] * acc[i];
                ss = group_sum<16>(ss);
                float r = rsqrtf(ss + EPS); if (j == 0) r *= 0.088388347648318440f;
#pragma unroll
                for (int i = 0; i < 8; ++i) acc[i] *= r;
            }
            if (j >= 2) { *(f32x4*)(ACT + (size_t)m * 2048 + ch) = (f32x4){acc[0], acc[1], acc[2], acc[3]}; *(f32x4*)(ACT + (size_t)m * 2048 + ch + 4) = (f32x4){acc[4], acc[5], acc[6], acc[7]}; }
            else *(v4u*)((bf16_t*)(a.ws + WS_QKV16) + (size_t)m * 2048 + ch) = pack8(acc); }
    }
}

typedef short s16x4_t __attribute__((ext_vector_type(4)));
typedef __bf16 bf16x2_v __attribute__((ext_vector_type(2)));
__device__ __forceinline__ unsigned cvtpk_rne(float lo, float hi) { f32x2 v = {lo, hi}; bf16x2_v bb = __builtin_convertvector(v, bf16x2_v); return __builtin_bit_cast(unsigned, bb); }
template <int S_> __device__ __forceinline__ bf16x8_t acc_frag(const f32x16_t& x) {
    v4u w; w.x = cvtpk_rne(x[8 * S_ + 0], x[8 * S_ + 1]); w.y = cvtpk_rne(x[8 * S_ + 2], x[8 * S_ + 3]); w.z = cvtpk_rne(x[8 * S_ + 4], x[8 * S_ + 5]); w.w = cvtpk_rne(x[8 * S_ + 6], x[8 * S_ + 7]);
    return __builtin_bit_cast(bf16x8_t, w);
}
__device__ __forceinline__ bf16x8_t join44(v2u lo, v2u hi) { v4u w; w.x = lo.x; w.y = lo.y; w.z = hi.x; w.w = hi.y; return __builtin_bit_cast(bf16x8_t, w); }
__device__ __forceinline__ float wave_incl_scan(float v, int lane) {
#pragma unroll
    for (int o = 1; o < 64; o <<= 1) { const float t = __shfl_up(v, o); if (lane >= o) v += t; }
    return v;
}
constexpr int GDN_LDS_PER_WAVE = 17920;
__device__ __forceinline__ void gdn1_item(const Args& a, int item, unsigned char* ldsw, int lane) {
    asm volatile("" : "+v"(lane));
    const int c = item & 31, dir = (item >> 5) & 1, hv = (item >> 6) & 7, b = item >> 9, hq = hv >> 1;
    const int r32 = lane & 31, hi = lane >> 5;
    float* AT = (float*)ldsw; float* Gs = AT + 64 * 68; float* Bs = Gs + 64;
    const bf16_t* QK = (const bf16_t*)(a.ws + WS_QKV16); const float* SM = (const float*)(a.ws + WS_SMALL);
    bf16_t* GT = (bf16_t*)(a.ws + WS_GT) + (size_t)item * 4096; bf16_t* GA = (bf16_t*)(a.ws + WS_GA) + (size_t)item * 4096;
    const float Aneg = -expf(a.in[dir ? 21 : 20][hv]); const float dtb = a.in[dir ? 23 : 22][hv];
    {
        const int t = dir ? SEQ - 1 - (64 * c + lane) : 64 * c + lane; const float* sm = SM + ((size_t)b * SEQ + t) * 32;
        const float gi = Aneg * softplus_f(sm[16 + dir * 8 + hv] + dtb), bi = sigmoid_f(sm[dir * 8 + hv]);
        Gs[lane] = wave_incl_scan(gi, lane); Bs[lane] = bi;
    }
    const int t0r = dir ? SEQ - 1 - (64 * c + r32) : 64 * c + r32, t1r = dir ? t0r - 32 : t0r + 32;
    const bf16_t* k0p = QK + ((size_t)b * SEQ + t0r) * 2048 + 512 + hq * 128 + hi * 8; const bf16_t* k1p = QK + ((size_t)b * SEQ + t1r) * 2048 + 512 + hq * 128 + hi * 8;
    const bf16_t* q0p = k0p - 512, * q1p = k1p - 512;
    LDS_WAIT();
    const float Gj0 = Gs[r32], Gj1 = Gs[32 + r32];
    {
        f32x16_t kk00, kk10, kk11;
#pragma unroll
        for (int r = 0; r < 16; ++r) { kk00[r] = 0.f; kk10[r] = 0.f; kk11[r] = 0.f; }
#pragma unroll
        for (int s = 0; s < 8; ++s) {
            const bf16x8_t kA0 = *(const bf16x8_t*)(k0p + 16 * s), kA1 = *(const bf16x8_t*)(k1p + 16 * s);
            kk00 = __builtin_amdgcn_mfma_f32_32x32x16_bf16(kA0, kA0, kk00, 0, 0, 0); kk10 = __builtin_amdgcn_mfma_f32_32x32x16_bf16(kA1, kA0, kk10, 0, 0, 0); kk11 = __builtin_amdgcn_mfma_f32_32x32x16_bf16(kA1, kA1, kk11, 0, 0, 0);
        }
#pragma unroll
        for (int r = 0; r < 16; ++r) { const int il = (r & 3) + 8 * (r >> 2) + 4 * hi;
            const float Gi0 = Gs[il], Gi1 = Gs[32 + il], bi0 = Bs[il], bi1 = Bs[32 + il];
            AT[r32 * 68 + il] = (r32 < il) ? bi0 * kk00[r] * __expf(Gi0 - Gj0) : 0.f;
            AT[r32 * 68 + 32 + il] = bi1 * kk10[r] * __expf(Gi1 - Gj0);
            AT[(32 + r32) * 68 + 32 + il] = (r32 < il) ? bi1 * kk11[r] * __expf(Gi1 - Gj1) : 0.f;
            AT[(32 + r32) * 68 + il] = 0.f;
        }
    }
    asm volatile("" ::: "memory");
    {
        f32x16_t qk00, qk10, qk11;
#pragma unroll
        for (int r = 0; r < 16; ++r) { qk00[r] = 0.f; qk10[r] = 0.f; qk11[r] = 0.f; }
#pragma unroll
        for (int s = 0; s < 8; ++s) {
            const bf16x8_t kA0 = *(const bf16x8_t*)(k0p + 16 * s), kA1 = *(const bf16x8_t*)(k1p + 16 * s), qA0 = *(const bf16x8_t*)(q0p + 16 * s), qA1 = *(const bf16x8_t*)(q1p + 16 * s);
            qk00 = __builtin_amdgcn_mfma_f32_32x32x16_bf16(qA0, kA0, qk00, 0, 0, 0); qk10 = __builtin_amdgcn_mfma_f32_32x32x16_bf16(qA1, kA0, qk10, 0, 0, 0); qk11 = __builtin_amdgcn_mfma_f32_32x32x16_bf16(qA1, kA1, qk11, 0, 0, 0);
        }
#pragma unroll
        for (int r = 0; r < 16; ++r) { const int il = (r & 3) + 8 * (r >> 2) + 4 * hi;
            const float Gi0 = Gs[il], Gi1 = Gs[32 + il];
            GA[il * 64 + r32] = (bf16_t)f2bf((r32 <= il) ? qk00[r] * __expf(Gi0 - Gj0) : 0.f);
            GA[(32 + il) * 64 + r32] = (bf16_t)f2bf(qk10[r] * __expf(Gi1 - Gj0));
            GA[(32 + il) * 64 + 32 + r32] = (bf16_t)f2bf((r32 <= il) ? qk11[r] * __expf(Gi1 - Gj1) : 0.f);
        }
    }
    LDS_WAIT(); asm volatile("" ::: "memory");
    float tr[64];
    int lane2 = lane; asm volatile("" : "+v"(lane2) :: "memory");
#pragma unroll
    for (int j = 0; j < 64; ++j) tr[j] = (j == lane2) ? 1.f : 0.f;
    int atoff = 0;
#pragma unroll
    for (int j = 62; j >= 0; --j) { float c0 = 0.f, c1 = 0.f, c2 = 0.f, c3 = 0.f;
        asm volatile("" : "+v"(atoff) : "v"(tr[j + 1]));
#pragma unroll
        for (int qd = (j + 1) / 4; qd < 16; ++qd) { const f32x4 av = *(const f32x4*)(AT + atoff + j * 68 + 4 * qd);
            if (4 * qd + 0 > j) c0 = fmaf(tr[4 * qd + 0], av.x, c0);
            if (4 * qd + 1 > j) c1 = fmaf(tr[4 * qd + 1], av.y, c1);
            if (4 * qd + 2 > j) c2 = fmaf(tr[4 * qd + 2], av.z, c2);
            if (4 * qd + 3 > j) c3 = fmaf(tr[4 * qd + 3], av.w, c3); }
        tr[j] -= (c0 + c1) + (c2 + c3); asm volatile("" ::: "memory"); }
#pragma unroll
    for (int x = 0; x < 8; ++x) *(v4u*)(GT + lane2 * 64 + x * 8) = pack8(tr + x * 8);
    LDS_WAIT();
}

__device__ __forceinline__ void gdn2_item(const Args& a, int item, unsigned char* lds) {
    const int dvs = item & 3, hv = (item >> 2) & 7, dir = (item >> 5) & 1, b = item >> 6, hq = hv >> 1;
    const int lane0 = threadIdx.x & 63;
    constexpr int BUFB = 57344, O_K = 0, O_Q = 16384, O_T = 32768, O_A = 40960, O_V = 49152;
    float* Gs = (float*)(lds + 2 * BUFB); float* Bs = Gs + 64; float* Es = Bs + 64; float* Ws = Es + 64; float* ot = Ws + 64;
    const LAS unsigned char* ldl = (const LAS unsigned char*)lds;
    const bf16_t* QK = (const bf16_t*)(a.ws + WS_QKV16); const float* ACT = (const float*)(a.ws + WS_ACT); const float* SM = (const float*)(a.ws + WS_SMALL);
    float* O = (float*)(a.ws + (dir ? WS_YB : WS_YF));
    const float Aneg = -expf(a.in[dir ? 21 : 20][hv]); const float dtb = a.in[dir ? 23 : 22][hv];
    const size_t gbase = (size_t)(((b * 8 + hv) * 2 + dir) * 32) * 4096;
    f32x16_t S[4];
#pragma unroll
    for (int nt = 0; nt < 4; ++nt)
#pragma unroll
        for (int r = 0; r < 16; ++r) S[nt][r] = 0.f;
    float gar, gbr;
#define G2_DMA(c_, buf_) do { const int t_ = dir ? SEQ - 1 - (64 * (c_) + lane0) : 64 * (c_) + lane0; const size_t mi_ = (size_t)b * SEQ + t_; \
        const bf16_t* kr_ = QK + mi_ * 2048 + 512 + hq * 128; const bf16_t* qr_ = QK + mi_ * 2048 + hq * 128; \
        const bf16_t* tr_ = (const bf16_t*)(a.ws + WS_GT) + gbase + (size_t)(c_) * 4096 + lane0 * 64; const bf16_t* ar_ = (const bf16_t*)(a.ws + WS_GA) + gbase + (size_t)(c_) * 4096 + lane0 * 64; \
        const float* vr_ = ACT + mi_ * 2048 + 1024 + hv * 128 + dvs * 32; \
        LAS unsigned char* lb_ = (LAS unsigned char*)lds + (buf_) * BUFB; \
        _Pragma("unroll") for (int x = 0; x < 16; ++x) { __builtin_amdgcn_global_load_lds((const unsigned*)(kr_ + 8 * x), (LAS unsigned*)(lb_ + O_K + 1024 * x), 16, 0, 0); \
                                                         __builtin_amdgcn_global_load_lds((const unsigned*)(qr_ + 8 * x), (LAS unsigned*)(lb_ + O_Q + 1024 * x), 16, 0, 0); } \
        _Pragma("unroll") for (int x = 0; x < 8; ++x) { __builtin_amdgcn_global_load_lds((const unsigned*)(tr_ + 8 * x), (LAS unsigned*)(lb_ + O_T + 1024 * x), 16, 0, 0); \
                                                        __builtin_amdgcn_global_load_lds((const unsigned*)(ar_ + 8 * x), (LAS unsigned*)(lb_ + O_A + 1024 * x), 16, 0, 0); \
                                                        __builtin_amdgcn_global_load_lds((const unsigned*)(vr_ + 4 * x), (LAS unsigned*)(lb_ + O_V + 1024 * x), 16, 0, 0); } \
        const float* sm_ = SM + mi_ * 32; gar = sm_[16 + dir * 8 + hv]; gbr = sm_[dir * 8 + hv]; } while (0)
    G2_DMA(0, 0);
    for (int c = 0; c < 32; ++c) {
        int lane = lane0; asm volatile("" : "+v"(lane));
        const int r32 = lane & 31, hi = lane >> 5, trq = (lane & 15) >> 2, trp = lane & 3, trc = (lane >> 4) & 1;
        const int bo = (c & 1) * BUFB;
        float GL;
        {
            const float gi = Aneg * softplus_f(gar + dtb), bi = sigmoid_f(gbr);
            const float G = wave_incl_scan(gi, lane); GL = __shfl(G, 63);
            Gs[lane] = G; Bs[lane] = bi; Es[lane] = __expf(G); Ws[lane] = __expf(GL - G);
        }
        asm volatile("s_waitcnt vmcnt(0)" ::: "memory");
        if (c + 1 < 32) G2_DMA(c + 1, (c + 1) & 1);
        LDS_WAIT();
        f32x16_t KS[2];
#pragma unroll
        for (int rt = 0; rt < 2; ++rt)
#pragma unroll
            for (int r = 0; r < 16; ++r) KS[rt][r] = 0.f;
#define LFRAG(off_) join44(*(const LAS v2u*)(ldl + (off_)), *(const LAS v2u*)(ldl + (off_) + 1024))
#pragma unroll
        for (int nt = 0; nt < 4; ++nt) {
            const bf16x8_t sb0 = acc_frag<0>(S[nt]), sb1 = acc_frag<1>(S[nt]);
#pragma unroll
            for (int rt = 0; rt < 2; ++rt) {
                const int ro = bo + O_K + ((4 * nt) * 64 + 32 * rt + r32) * 16 + 8 * hi;
                KS[rt] = __builtin_amdgcn_mfma_f32_32x32x16_bf16(LFRAG(ro), sb0, KS[rt], 0, 0, 0); KS[rt] = __builtin_amdgcn_mfma_f32_32x32x16_bf16(LFRAG(ro + 2048), sb1, KS[rt], 0, 0, 0);
            }
        }
        asm volatile("" ::: "memory");
        f32x16_t rhs[2];
#pragma unroll
        for (int rt = 0; rt < 2; ++rt)
#pragma unroll
            for (int r = 0; r < 16; ++r) { const int i = 32 * rt + (r & 3) + 8 * (r >> 2) + 4 * hi;
                const float vv = *(const LAS float*)(ldl + bo + O_V + ((r32 >> 2) * 64 + i) * 16 + (r32 & 3) * 4); const float bi = Bs[i];
                rhs[rt][r] = bi * vv - bi * Es[i] * KS[rt][r]; }
        asm volatile("" ::: "memory");
        f32x16_t vn[2];
#pragma unroll
        for (int r = 0; r < 16; ++r) { vn[0][r] = 0.f; vn[1][r] = 0.f; }
        {
            const bf16x8_t rb00 = acc_frag<0>(rhs[0]), rb01 = acc_frag<1>(rhs[0]), rb10 = acc_frag<0>(rhs[1]), rb11 = acc_frag<1>(rhs[1]);
            const int t0 = bo + O_T + r32 * 16 + 8 * hi, t1 = t0 + 512;
            vn[0] = __builtin_amdgcn_mfma_f32_32x32x16_bf16(LFRAG(t0), rb00, vn[0], 0, 0, 0); vn[0] = __builtin_amdgcn_mfma_f32_32x32x16_bf16(LFRAG(t0 + 2048), rb01, vn[0], 0, 0, 0);
            vn[1] = __builtin_amdgcn_mfma_f32_32x32x16_bf16(LFRAG(t1), rb00, vn[1], 0, 0, 0); vn[1] = __builtin_amdgcn_mfma_f32_32x32x16_bf16(LFRAG(t1 + 2048), rb01, vn[1], 0, 0, 0);
            vn[1] = __builtin_amdgcn_mfma_f32_32x32x16_bf16(LFRAG(t1 + 4096), rb10, vn[1], 0, 0, 0); vn[1] = __builtin_amdgcn_mfma_f32_32x32x16_bf16(LFRAG(t1 + 6144), rb11, vn[1], 0, 0, 0);
        }
        asm volatile("" ::: "memory");
        f32x16_t QS[2];
#pragma unroll
        for (int rt = 0; rt < 2; ++rt)
#pragma unroll
            for (int r = 0; r < 16; ++r) QS[rt][r] = 0.f;
#pragma unroll
        for (int nt = 0; nt < 4; ++nt) {
            const bf16x8_t sb0 = acc_frag<0>(S[nt]), sb1 = acc_frag<1>(S[nt]);
#pragma unroll
            for (int rt = 0; rt < 2; ++rt) {
                const int ro = bo + O_Q + ((4 * nt) * 64 + 32 * rt + r32) * 16 + 8 * hi;
                QS[rt] = __builtin_amdgcn_mfma_f32_32x32x16_bf16(LFRAG(ro), sb0, QS[rt], 0, 0, 0); QS[rt] = __builtin_amdgcn_mfma_f32_32x32x16_bf16(LFRAG(ro + 2048), sb1, QS[rt], 0, 0, 0);
            }
        }
        asm volatile("" ::: "memory");
        {
            const bf16x8_t vb00 = acc_frag<0>(vn[0]), vb01 = acc_frag<1>(vn[0]), vb10 = acc_frag<0>(vn[1]), vb11 = acc_frag<1>(vn[1]);
            const int a0 = bo + O_A + r32 * 16 + 8 * hi, a1 = a0 + 512;
            f32x16_t o0, o1;
#pragma unroll
            for (int r = 0; r < 16; ++r) { const int il = (r & 3) + 8 * (r >> 2) + 4 * hi; o0[r] = Es[il] * QS[0][r]; o1[r] = Es[32 + il] * QS[1][r]; }
            o0 = __builtin_amdgcn_mfma_f32_32x32x16_bf16(LFRAG(a0), vb00, o0, 0, 0, 0); o0 = __builtin_amdgcn_mfma_f32_32x32x16_bf16(LFRAG(a0 + 2048), vb01, o0, 0, 0, 0);
            o1 = __builtin_amdgcn_mfma_f32_32x32x16_bf16(LFRAG(a1), vb00, o1, 0, 0, 0); o1 = __builtin_amdgcn_mfma_f32_32x32x16_bf16(LFRAG(a1 + 2048), vb01, o1, 0, 0, 0);
            o1 = __builtin_amdgcn_mfma_f32_32x32x16_bf16(LFRAG(a1 + 4096), vb10, o1, 0, 0, 0); o1 = __builtin_amdgcn_mfma_f32_32x32x16_bf16(LFRAG(a1 + 6144), vb11, o1, 0, 0, 0);
#pragma unroll
            for (int r = 0; r < 16; ++r) { const int il = (r & 3) + 8 * (r >> 2) + 4 * hi; ot[il * 33 + r32] = o0[r]; ot[(32 + il) * 33 + r32] = o1[r]; }
            LDS_WAIT();
            { const int t = dir ? SEQ - 1 - (64 * c + lane) : 64 * c + lane; float* orow = O + ((size_t)b * SEQ + t) * 1024 + hv * 128 + dvs * 32;
#pragma unroll
              for (int x = 0; x < 8; ++x) *(f32x4*)(orow + 4 * x) = (f32x4){ot[lane * 33 + 4 * x], ot[lane * 33 + 4 * x + 1], ot[lane * 33 + 4 * x + 2], ot[lane * 33 + 4 * x + 3]}; }
        }
        asm volatile("" ::: "memory");
        {
#pragma unroll
            for (int r = 0; r < 16; ++r) { const int il = (r & 3) + 8 * (r >> 2) + 4 * hi; vn[0][r] *= Ws[il]; vn[1][r] *= Ws[32 + il]; }
            const bf16x8_t wb[4] = {acc_frag<0>(vn[0]), acc_frag<1>(vn[0]), acc_frag<0>(vn[1]), acc_frag<1>(vn[1])};
            const float eGL = __expf(GL);
#pragma unroll
            for (int nt = 0; nt < 4; ++nt) {
#pragma unroll
                for (int r = 0; r < 16; ++r) S[nt][r] *= eGL;
#pragma unroll
                for (int ks = 0; ks < 4; ++ks) {
                    const int ro = bo + O_K + ((4 * nt + 2 * trc + (trp >> 1)) * 64 + 16 * ks + 4 * hi + trq) * 16 + 8 * (trp & 1);
                    const s16x4_t lo = __builtin_bit_cast(s16x4_t, __builtin_amdgcn_ds_read_tr16_b64_v4i16((LAS s16x4_t*)(ldl + ro)));
                    const s16x4_t hi4 = __builtin_bit_cast(s16x4_t, __builtin_amdgcn_ds_read_tr16_b64_v4i16((LAS s16x4_t*)(ldl + ro + 8 * 16)));
                    const bf16x8_t kf = (bf16x8_t){lo[0], lo[1], lo[2], lo[3], hi4[0], hi4[1], hi4[2], hi4[3]};
                    S[nt] = __builtin_amdgcn_mfma_f32_32x32x16_bf16(kf, wb[ks], S[nt], 0, 0, 0);
                }
            }
        }
        LDS_WAIT();
    }
#undef LFRAG
#undef G2_DMA
}

namespace gdn3 {
constexpr int ABUF = 32768, A_K = 0, A_T = 16384, A_V = 24576, O_BR = 65536, BBUF = 24576, B_Q = 0, B_A = 16384, O_CM = 114688, CMB = 12800, CM_VB = 8192, CM_ES = 12288, O_SC = 140288, O_OT = 141312, O_FLAG = 149760, O_END = 149824;
__device__ __forceinline__ void spin_ge(const LAS unsigned char* ldl, int off, unsigned target) {
    for (;;) { const unsigned v = __builtin_amdgcn_readfirstlane(*(volatile const LAS unsigned*)(ldl + off)); if (v >= target) break; __builtin_amdgcn_s_sleep(1); }
    asm volatile("" ::: "memory");
}
#define G3_LFRAG(off_) join44(*(const LAS v2u*)(ldl + (off_)), *(const LAS v2u*)(ldl + (off_) + 1024))
__device__ __forceinline__ void chain(const Args& a, int item, unsigned char* lds) {
    const int dvs = item & 3, hv = (item >> 2) & 7, dir = (item >> 5) & 1, b = item >> 6, hq = hv >> 1;
    const int lane0 = threadIdx.x & 63;
    LAS unsigned char* ldw = (LAS unsigned char*)lds; const LAS unsigned char* ldl = (const LAS unsigned char*)lds;
    LAS float* Gs = (LAS float*)(ldw + O_SC); LAS float* Bs = Gs + 64; LAS float* Es = Bs + 64; LAS float* Ws = Es + 64;
    const bf16_t* QK = (const bf16_t*)(a.ws + WS_QKV16); const float* ACT = (const float*)(a.ws + WS_ACT); const float* SM = (const float*)(a.ws + WS_SMALL);
    const float Aneg = -expf(a.in[dir ? 21 : 20][hv]); const float dtb = a.in[dir ? 23 : 22][hv];
    const size_t gbase = (size_t)(((b * 8 + hv) * 2 + dir) * 32) * 4096;
    f32x16_t S[4];
#pragma unroll
    for (int nt = 0; nt < 4; ++nt)
#pragma unroll
        for (int r = 0; r < 16; ++r) S[nt][r] = 0.f;
    float gar, gbr;
#define G3A_DMA(c_, buf_) do { const int t_ = dir ? SEQ - 1 - (64 * (c_) + lane0) : 64 * (c_) + lane0; const size_t mi_ = (size_t)b * SEQ + t_; \
        const bf16_t* kr_ = QK + mi_ * 2048 + 512 + hq * 128; const bf16_t* tr_ = (const bf16_t*)(a.ws + WS_GT) + gbase + (size_t)(c_) * 4096 + lane0 * 64; \
        const float* vr_ = ACT + mi_ * 2048 + 1024 + hv * 128 + dvs * 32; LAS unsigned char* lb_ = ldw + (buf_) * ABUF; \
        _Pragma("unroll") for (int x = 0; x < 16; ++x) __builtin_amdgcn_global_load_lds((const unsigned*)(kr_ + 8 * x), (LAS unsigned*)(lb_ + A_K + 1024 * x), 16, 0, 0); \
        _Pragma("unroll") for (int x = 0; x < 8; ++x) { __builtin_amdgcn_global_load_lds((const unsigned*)(tr_ + 8 * x), (LAS unsigned*)(lb_ + A_T + 1024 * x), 16, 0, 0); \
                                                        __builtin_amdgcn_global_load_lds((const unsigned*)(vr_ + 4 * x), (LAS unsigned*)(lb_ + A_V + 1024 * x), 16, 0, 0); } \
        const float* sm_ = SM + mi_ * 32; gar = sm_[16 + dir * 8 + hv]; gbr = sm_[dir * 8 + hv]; } while (0)
    G3A_DMA(0, 0);
    for (int c = 0; c < 32; ++c) {
        int lane = lane0; asm volatile("" : "+v"(lane));
        const int r32 = lane & 31, hi = lane >> 5, trq = (lane & 15) >> 2, trp = lane & 3, trc = (lane >> 4) & 1;
        const int bo = (c & 1) * ABUF, cm = O_CM + (c & 1) * CMB;
        float GL, eG;
        {   const float gi = Aneg * softplus_f(gar + dtb), bi = sigmoid_f(gbr);
            const float G = wave_incl_scan(gi, lane); GL = __shfl(G, 63); eG = __expf(G);
            Gs[lane] = G; Bs[lane] = bi; Es[lane] = eG; Ws[lane] = __expf(GL - G); }
        asm volatile("s_waitcnt vmcnt(0)" ::: "memory");
        if (c + 1 < 32) G3A_DMA(c + 1, (c + 1) & 1);
        if (c >= 2) spin_ge(ldl, O_FLAG + 4, (unsigned)(c - 1));
        *(LAS float*)(ldw + cm + CM_ES + lane * 4) = eG;
        LDS_WAIT();
        f32x16_t KS[2];
#pragma unroll
        for (int rt = 0; rt < 2; ++rt)
#pragma unroll
            for (int r = 0; r < 16; ++r) KS[rt][r] = 0.f;
#pragma unroll
        for (int nt = 0; nt < 4; ++nt) {
            const bf16x8_t sb0 = acc_frag<0>(S[nt]), sb1 = acc_frag<1>(S[nt]);
            *(LAS bf16x8_t*)(ldw + cm + (2 * nt) * 1024 + lane * 16) = sb0; *(LAS bf16x8_t*)(ldw + cm + (2 * nt + 1) * 1024 + lane * 16) = sb1;
#pragma unroll
            for (int rt = 0; rt < 2; ++rt) {
                const int ro = bo + A_K + ((4 * nt) * 64 + 32 * rt + r32) * 16 + 8 * hi;
                KS[rt] = __builtin_amdgcn_mfma_f32_32x32x16_bf16(G3_LFRAG(ro), sb0, KS[rt], 0, 0, 0); KS[rt] = __builtin_amdgcn_mfma_f32_32x32x16_bf16(G3_LFRAG(ro + 2048), sb1, KS[rt], 0, 0, 0);
            }
        }
        asm volatile("" ::: "memory");
        f32x16_t rhs[2];
#pragma unroll
        for (int rt = 0; rt < 2; ++rt)
#pragma unroll
            for (int r = 0; r < 16; ++r) { const int i = 32 * rt + (r & 3) + 8 * (r >> 2) + 4 * hi;
                const float vv = *(const LAS float*)(ldl + bo + A_V + ((r32 >> 2) * 64 + i) * 16 + (r32 & 3) * 4); const float bi = Bs[i];
                rhs[rt][r] = bi * vv - bi * Es[i] * KS[rt][r]; }
        asm volatile("" ::: "memory");
        f32x16_t vn[2];
#pragma unroll
        for (int r = 0; r < 16; ++r) { vn[0][r] = 0.f; vn[1][r] = 0.f; }
        {   const bf16x8_t rb00 = acc_frag<0>(rhs[0]), rb01 = acc_frag<1>(rhs[0]), rb10 = acc_frag<0>(rhs[1]), rb11 = acc_frag<1>(rhs[1]);
            const int t0 = bo + A_T + r32 * 16 + 8 * hi, t1 = t0 + 512;
            vn[0] = __builtin_amdgcn_mfma_f32_32x32x16_bf16(G3_LFRAG(t0), rb00, vn[0], 0, 0, 0); vn[0] = __builtin_amdgcn_mfma_f32_32x32x16_bf16(G3_LFRAG(t0 + 2048), rb01, vn[0], 0, 0, 0);
            vn[1] = __builtin_amdgcn_mfma_f32_32x32x16_bf16(G3_LFRAG(t1), rb00, vn[1], 0, 0, 0); vn[1] = __builtin_amdgcn_mfma_f32_32x32x16_bf16(G3_LFRAG(t1 + 2048), rb01, vn[1], 0, 0, 0);
            vn[1] = __builtin_amdgcn_mfma_f32_32x32x16_bf16(G3_LFRAG(t1 + 4096), rb10, vn[1], 0, 0, 0); vn[1] = __builtin_amdgcn_mfma_f32_32x32x16_bf16(G3_LFRAG(t1 + 6144), rb11, vn[1], 0, 0, 0); }
        *(LAS bf16x8_t*)(ldw + cm + CM_VB + 0 * 1024 + lane * 16) = acc_frag<0>(vn[0]); *(LAS bf16x8_t*)(ldw + cm + CM_VB + 1 * 1024 + lane * 16) = acc_frag<1>(vn[0]);
        *(LAS bf16x8_t*)(ldw + cm + CM_VB + 2 * 1024 + lane * 16) = acc_frag<0>(vn[1]); *(LAS bf16x8_t*)(ldw + cm + CM_VB + 3 * 1024 + lane * 16) = acc_frag<1>(vn[1]);
        LDS_WAIT();
        if (lane == 0) *(volatile LAS unsigned*)(ldw + O_FLAG) = (unsigned)(c + 1);
        asm volatile("" ::: "memory");
        {
#pragma unroll
            for (int r = 0; r < 16; ++r) { const int il = (r & 3) + 8 * (r >> 2) + 4 * hi; vn[0][r] *= Ws[il]; vn[1][r] *= Ws[32 + il]; }
            const bf16x8_t wb[4] = {acc_frag<0>(vn[0]), acc_frag<1>(vn[0]), acc_frag<0>(vn[1]), acc_frag<1>(vn[1])};
            const float eGL = __expf(GL);
#pragma unroll
            for (int nt = 0; nt < 4; ++nt) {
#pragma unroll
                for (int r = 0; r < 16; ++r) S[nt][r] *= eGL;
#pragma unroll
                for (int ks = 0; ks < 4; ++ks) {
                    const int ro = bo + A_K + ((4 * nt + 2 * trc + (trp >> 1)) * 64 + 16 * ks + 4 * hi + trq) * 16 + 8 * (trp & 1);
                    const s16x4_t lo = __builtin_bit_cast(s16x4_t, __builtin_amdgcn_ds_read_tr16_b64_v4i16((LAS s16x4_t*)(ldl + ro)));
                    const s16x4_t hi4 = __builtin_bit_cast(s16x4_t, __builtin_amdgcn_ds_read_tr16_b64_v4i16((LAS s16x4_t*)(ldl + ro + 8 * 16)));
                    const bf16x8_t kf = (bf16x8_t){lo[0], lo[1], lo[2], lo[3], hi4[0], hi4[1], hi4[2], hi4[3]};
                    S[nt] = __builtin_amdgcn_mfma_f32_32x32x16_bf16(kf, wb[ks], S[nt], 0, 0, 0);
                }
            }
        }
        LDS_WAIT();
    }
#undef G3A_DMA
}
__device__ __forceinline__ void output(const Args& a, int item, unsigned char* lds) {
    const int dvs = item & 3, hv = (item >> 2) & 7, dir = (item >> 5) & 1, b = item >> 6, hq = hv >> 1;
    const int lane0 = threadIdx.x & 63;
    LAS unsigned char* ldw = (LAS unsigned char*)lds; const LAS unsigned char* ldl = (const LAS unsigned char*)lds;
    LAS float* ot = (LAS float*)(ldw + O_OT);
    const bf16_t* QK = (const bf16_t*)(a.ws + WS_QKV16);
    float* O = (float*)(a.ws + (dir ? WS_YB : WS_YF));
    const size_t gbase = (size_t)(((b * 8 + hv) * 2 + dir) * 32) * 4096;
#define G3B_DMA(c_, buf_) do { const int t_ = dir ? SEQ - 1 - (64 * (c_) + lane0) : 64 * (c_) + lane0; const size_t mi_ = (size_t)b * SEQ + t_; \
        const bf16_t* qr_ = QK + mi_ * 2048 + hq * 128; const bf16_t* ar_ = (const bf16_t*)(a.ws + WS_GA) + gbase + (size_t)(c_) * 4096 + lane0 * 64; \
        LAS unsigned char* lb_ = ldw + O_BR + (buf_) * BBUF; \
        _Pragma("unroll") for (int x = 0; x < 16; ++x) __builtin_amdgcn_global_load_lds((const unsigned*)(qr_ + 8 * x), (LAS unsigned*)(lb_ + B_Q + 1024 * x), 16, 0, 0); \
        _Pragma("unroll") for (int x = 0; x < 8; ++x) __builtin_amdgcn_global_load_lds((const unsigned*)(ar_ + 8 * x), (LAS unsigned*)(lb_ + B_A + 1024 * x), 16, 0, 0); } while (0)
    G3B_DMA(0, 0);
    for (int c = 0; c < 32; ++c) {
        int lane = lane0; asm volatile("" : "+v"(lane));
        const int r32 = lane & 31, hi = lane >> 5;
        const int bo = O_BR + (c & 1) * BBUF, cm = O_CM + (c & 1) * CMB;
        asm volatile("s_waitcnt vmcnt(0)" ::: "memory");
        if (c + 1 < 32) G3B_DMA(c + 1, (c + 1) & 1);
        spin_ge(ldl, O_FLAG, (unsigned)(c + 1));
        f32x16_t QS[2];
#pragma unroll
        for (int rt = 0; rt < 2; ++rt)
#pragma unroll
            for (int r = 0; r < 16; ++r) QS[rt][r] = 0.f;
#pragma unroll
        for (int nt = 0; nt < 4; ++nt) {
            const bf16x8_t sb0 = *(const LAS bf16x8_t*)(ldl + cm + (2 * nt) * 1024 + lane * 16), sb1 = *(const LAS bf16x8_t*)(ldl + cm + (2 * nt + 1) * 1024 + lane * 16);
#pragma unroll
            for (int rt = 0; rt < 2; ++rt) {
                const int ro = bo + B_Q + ((4 * nt) * 64 + 32 * rt + r32) * 16 + 8 * hi;
                QS[rt] = __builtin_amdgcn_mfma_f32_32x32x16_bf16(G3_LFRAG(ro), sb0, QS[rt], 0, 0, 0); QS[rt] = __builtin_amdgcn_mfma_f32_32x32x16_bf16(G3_LFRAG(ro + 2048), sb1, QS[rt], 0, 0, 0);
            }
        }
        {   const bf16x8_t vb00 = *(const LAS bf16x8_t*)(ldl + cm + CM_VB + lane * 16), vb01 = *(const LAS bf16x8_t*)(ldl + cm + CM_VB + 1024 + lane * 16);
            const bf16x8_t vb10 = *(const LAS bf16x8_t*)(ldl + cm + CM_VB + 2048 + lane * 16), vb11 = *(const LAS bf16x8_t*)(ldl + cm + CM_VB + 3072 + lane * 16);
            const LAS float* Es = (const LAS float*)(ldl + cm + CM_ES);
            const int a0 = bo + B_A + r32 * 16 + 8 * hi, a1 = a0 + 512;
            f32x16_t o0, o1;
#pragma unroll
            for (int r = 0; r < 16; ++r) { const int il = (r & 3) + 8 * (r >> 2) + 4 * hi; o0[r] = Es[il] * QS[0][r]; o1[r] = Es[32 + il] * QS[1][r]; }
            o0 = __builtin_amdgcn_mfma_f32_32x32x16_bf16(G3_LFRAG(a0), vb00, o0, 0, 0, 0); o0 = __builtin_amdgcn_mfma_f32_32x32x16_bf16(G3_LFRAG(a0 + 2048), vb01, o0, 0, 0, 0);
            o1 = __builtin_amdgcn_mfma_f32_32x32x16_bf16(G3_LFRAG(a1), vb00, o1, 0, 0, 0); o1 = __builtin_amdgcn_mfma_f32_32x32x16_bf16(G3_LFRAG(a1 + 2048), vb01, o1, 0, 0, 0);
            o1 = __builtin_amdgcn_mfma_f32_32x32x16_bf16(G3_LFRAG(a1 + 4096), vb10, o1, 0, 0, 0); o1 = __builtin_amdgcn_mfma_f32_32x32x16_bf16(G3_LFRAG(a1 + 6144), vb11, o1, 0, 0, 0);
#pragma unroll
            for (int r = 0; r < 16; ++r) { const int il = (r & 3) + 8 * (r >> 2) + 4 * hi; ot[il * 33 + r32] = o0[r]; ot[(32 + il) * 33 + r32] = o1[r]; }
        }
        LDS_WAIT();
        if (lane == 0) *(volatile LAS unsigned*)(ldw + O_FLAG + 4) = (unsigned)(c + 1);
        { const int t = dir ? SEQ - 1 - (64 * c + lane) : 64 * c + lane; float* orow = O + ((size_t)b * SEQ + t) * 1024 + hv * 128 + dvs * 32;
#pragma unroll
          for (int x = 0; x < 8; ++x) *(f32x4*)(orow + 4 * x) = (f32x4){ot[lane * 33 + 4 * x], ot[lane * 33 + 4 * x + 1], ot[lane * 33 + 4 * x + 2], ot[lane * 33 + 4 * x + 3]}; }
        LDS_WAIT();
    }
#undef G3B_DMA
}
#undef G3_LFRAG
}

__device__ __forceinline__ void ssd2_item(const Args& a, int item, unsigned char* lds) {
    const int ps = item & 1, h = (item >> 1) & 15, dir = (item >> 5) & 1, b = item >> 6, g = h >> 3;
    const int lane0 = threadIdx.x & 63;
    constexpr int BUFB = 40960, O_B = 0, O_C = 16384, O_X = 32768, O_XD = 2 * BUFB + 512, O_XW = O_XD + 64 * 72;
    float* Gs = (float*)(lds + 2 * BUFB); float* Es = Gs + 64; float* ot = (float*)(lds + O_XW + 64 * 72);
    const LAS unsigned char* ldl = (const LAS unsigned char*)lds;
    const bf16_t* XB = (const bf16_t*)(a.ws + WS_XBC16); const float* ACT = (const float*)(a.ws + WS_ACT); const float* SM = (const float*)(a.ws + WS_SMALL);
    float* Y = (float*)(a.ws + (dir ? WS_YB : WS_YF));
    const float A = -expf(a.in[dir ? 13 : 12][h]); const float dtb = a.in[dir ? 11 : 10][h];
    f32x16_t H[4];
#pragma unroll
    for (int nt = 0; nt < 4; ++nt)
#pragma unroll
        for (int r = 0; r < 16; ++r) H[nt][r] = 0.f;
    float gdr;
#define S2_DMA(c_, buf_) do { const int t_ = dir ? SEQ - 1 - (64 * (c_) + lane0) : 64 * (c_) + lane0; const size_t mi_ = (size_t)b * SEQ + t_; \
        const bf16_t* br_ = XB + mi_ * 1536 + 1024 + g * 128; const bf16_t* cr_ = XB + mi_ * 1536 + 1280 + g * 128; const float* xr_ = ACT + mi_ * 1536 + h * 64 + ps * 32; \
        LAS unsigned char* lb_ = (LAS unsigned char*)lds + (buf_) * BUFB; \
        _Pragma("unroll") for (int x = 0; x < 16; ++x) { __builtin_amdgcn_global_load_lds((const unsigned*)(br_ + 8 * x), (LAS unsigned*)(lb_ + O_B + 1024 * x), 16, 0, 0); \
                                                         __builtin_amdgcn_global_load_lds((const unsigned*)(cr_ + 8 * x), (LAS unsigned*)(lb_ + O_C + 1024 * x), 16, 0, 0); } \
        _Pragma("unroll") for (int x = 0; x < 8; ++x) __builtin_amdgcn_global_load_lds((const unsigned*)(xr_ + 4 * x), (LAS unsigned*)(lb_ + O_X + 1024 * x), 16, 0, 0); \
        gdr = SM[mi_ * 32 + dir * 16 + h]; } while (0)
    S2_DMA(0, 0);
    for (int c = 0; c < 32; ++c) {
        int lane = lane0; asm volatile("" : "+v"(lane));
        const int r32 = lane & 31, hi = lane >> 5, trq = (lane & 15) >> 2, trp = lane & 3, trc = (lane >> 4) & 1;
        const int bo = (c & 1) * BUFB;
        const float dt = softplus_f(gdr + dtb);
        const float cs = wave_incl_scan(dt * A, lane); const float csL = __shfl(cs, 63);
        Gs[lane] = cs; Es[lane] = __expf(cs);
        asm volatile("s_waitcnt vmcnt(0)" ::: "memory");
        if (c + 1 < 32) S2_DMA(c + 1, (c + 1) & 1);
        {
            const float wsc = dt * __expf(csL - cs);
#pragma unroll
            for (int x = 0; x < 8; ++x) { const f32x4 xv = *(const LAS f32x4*)(ldl + bo + O_X + (x * 64 + lane) * 16);
                v2u d; d.x = cvtpk_rne(xv.x * dt, xv.y * dt); d.y = cvtpk_rne(xv.z * dt, xv.w * dt); *(LAS v2u*)((LAS unsigned char*)lds + O_XD + lane * 72 + 8 * x) = d;
                v2u w; w.x = cvtpk_rne(xv.x * wsc, xv.y * wsc); w.y = cvtpk_rne(xv.z * wsc, xv.w * wsc); *(LAS v2u*)((LAS unsigned char*)lds + O_XW + lane * 72 + 8 * x) = w; }
        }
        LDS_WAIT();
        f32x16_t g00, g01, g11;
#pragma unroll
        for (int r = 0; r < 16; ++r) { g00[r] = 0.f; g01[r] = 0.f; g11[r] = 0.f; }
#pragma unroll
        for (int kk = 0; kk < 8; ++kk) { const int fo = ((2 * kk + hi) * 64 + r32) * 16;
            const bf16x8_t A0 = *(const LAS bf16x8_t*)(ldl + bo + O_B + fo), A1 = *(const LAS bf16x8_t*)(ldl + bo + O_B + fo + 512);
            const bf16x8_t B0 = *(const LAS bf16x8_t*)(ldl + bo + O_C + fo), B1 = *(const LAS bf16x8_t*)(ldl + bo + O_C + fo + 512);
            g00 = __builtin_amdgcn_mfma_f32_32x32x16_bf16(A0, B0, g00, 0, 0, 0); g01 = __builtin_amdgcn_mfma_f32_32x32x16_bf16(A0, B1, g01, 0, 0, 0); g11 = __builtin_amdgcn_mfma_f32_32x32x16_bf16(A1, B1, g11, 0, 0, 0); }
        {   const float cst0 = Gs[r32], cst1 = Gs[32 + r32];
#pragma unroll
            for (int r = 0; r < 16; ++r) { const int il = (r & 3) + 8 * (r >> 2) + 4 * hi; const float css0 = Gs[il], css1 = Gs[32 + il];
                g00[r] = (il <= r32) ? g00[r] * __expf(cst0 - css0) : 0.f; g01[r] = g01[r] * __expf(cst1 - css0); g11[r] = (il <= r32) ? g11[r] * __expf(cst1 - css1) : 0.f; } }
        asm volatile("" ::: "memory");
        f32x16_t y0, y1;
#pragma unroll
        for (int r = 0; r < 16; ++r) { y0[r] = 0.f; y1[r] = 0.f; }
#define TRFRAG(base_) ({ const s16x4_t lo_ = __builtin_bit_cast(s16x4_t, __builtin_amdgcn_ds_read_tr16_b64_v4i16((LAS s16x4_t*)(ldl + (base_)))); \
                         const s16x4_t hi_ = __builtin_bit_cast(s16x4_t, __builtin_amdgcn_ds_read_tr16_b64_v4i16((LAS s16x4_t*)(ldl + (base_) + 8 * 72))); \
                         (bf16x8_t){lo_[0], lo_[1], lo_[2], lo_[3], hi_[0], hi_[1], hi_[2], hi_[3]}; })
        {   const int xo = O_XD + (4 * hi + trq) * 72 + (16 * trc + 4 * trp) * 2;
            const bf16x8_t x0 = TRFRAG(xo), x1 = TRFRAG(xo + 16 * 72), x2 = TRFRAG(xo + 32 * 72), x3 = TRFRAG(xo + 48 * 72);
            y0 = __builtin_amdgcn_mfma_f32_32x32x16_bf16(acc_frag<0>(g00), x0, y0, 0, 0, 0); y0 = __builtin_amdgcn_mfma_f32_32x32x16_bf16(acc_frag<1>(g00), x1, y0, 0, 0, 0);
            y1 = __builtin_amdgcn_mfma_f32_32x32x16_bf16(acc_frag<0>(g01), x0, y1, 0, 0, 0); y1 = __builtin_amdgcn_mfma_f32_32x32x16_bf16(acc_frag<1>(g01), x1, y1, 0, 0, 0);
            y1 = __builtin_amdgcn_mfma_f32_32x32x16_bf16(acc_frag<0>(g11), x2, y1, 0, 0, 0); y1 = __builtin_amdgcn_mfma_f32_32x32x16_bf16(acc_frag<1>(g11), x3, y1, 0, 0, 0); }
        asm volatile("" ::: "memory");
        {   f32x16_t Z0, Z1;
#pragma unroll
            for (int r = 0; r < 16; ++r) { Z0[r] = 0.f; Z1[r] = 0.f; }
#define LFRAG(off_) join44(*(const LAS v2u*)(ldl + (off_)), *(const LAS v2u*)(ldl + (off_) + 1024))
#pragma unroll
            for (int nt = 0; nt < 4; ++nt) { const bf16x8_t hb0 = acc_frag<0>(H[nt]), hb1 = acc_frag<1>(H[nt]);
                const int ro = bo + O_C + ((4 * nt) * 64 + r32) * 16 + 8 * hi;
                Z0 = __builtin_amdgcn_mfma_f32_32x32x16_bf16(LFRAG(ro), hb0, Z0, 0, 0, 0); Z0 = __builtin_amdgcn_mfma_f32_32x32x16_bf16(LFRAG(ro + 2048), hb1, Z0, 0, 0, 0);
                Z1 = __builtin_amdgcn_mfma_f32_32x32x16_bf16(LFRAG(ro + 512), hb0, Z1, 0, 0, 0); Z1 = __builtin_amdgcn_mfma_f32_32x32x16_bf16(LFRAG(ro + 512 + 2048), hb1, Z1, 0, 0, 0); }
#undef LFRAG
#pragma unroll
            for (int r = 0; r < 16; ++r) { const int il = (r & 3) + 8 * (r >> 2) + 4 * hi; ot[il * 33 + r32] = fmaf(Es[il], Z0[r], y0[r]); ot[(32 + il) * 33 + r32] = fmaf(Es[32 + il], Z1[r], y1[r]); } }
        LDS_WAIT();
        { const int t = dir ? SEQ - 1 - (64 * c + lane) : 64 * c + lane; float* yrow = Y + ((size_t)b * SEQ + t) * 1024 + h * 64 + ps * 32;
#pragma unroll
          for (int x = 0; x < 8; ++x) *(f32x4*)(yrow + 4 * x) = (f32x4){ot[lane * 33 + 4 * x], ot[lane * 33 + 4 * x + 1], ot[lane * 33 + 4 * x + 2], ot[lane * 33 + 4 * x + 3]}; }
        asm volatile("" ::: "memory");
        {   const float eL = __expf(csL);
            const int xo = O_XW + (4 * hi + trq) * 72 + (16 * trc + 4 * trp) * 2;
            const bf16x8_t w0 = TRFRAG(xo), w1 = TRFRAG(xo + 16 * 72), w2 = TRFRAG(xo + 32 * 72), w3 = TRFRAG(xo + 48 * 72);
#undef TRFRAG
#pragma unroll
            for (int nt = 0; nt < 4; ++nt) {
#pragma unroll
                for (int r = 0; r < 16; ++r) H[nt][r] *= eL;
#pragma unroll
                for (int ks = 0; ks < 4; ++ks) {
                    const int ro = bo + O_B + ((4 * nt + 2 * trc + (trp >> 1)) * 64 + 16 * ks + 4 * hi + trq) * 16 + 8 * (trp & 1);
                    const s16x4_t lo = __builtin_bit_cast(s16x4_t, __builtin_amdgcn_ds_read_tr16_b64_v4i16((LAS s16x4_t*)(ldl + ro)));
                    const s16x4_t hi4 = __builtin_bit_cast(s16x4_t, __builtin_amdgcn_ds_read_tr16_b64_v4i16((LAS s16x4_t*)(ldl + ro + 8 * 16)));
                    const bf16x8_t bfr = (bf16x8_t){lo[0], lo[1], lo[2], lo[3], hi4[0], hi4[1], hi4[2], hi4[3]};
                    H[nt] = __builtin_amdgcn_mfma_f32_32x32x16_bf16(bfr, ks == 0 ? w0 : ks == 1 ? w1 : ks == 2 ? w2 : w3, H[nt], 0, 0, 0);
                }
            }
        }
        LDS_WAIT();
    }
#undef S2_DMA
}

namespace ssd3 {
constexpr int O_DT = 98304, O_XD = 98816, O_OUT = 108032, OUTB = 13312, OO_XW = 512, OO_Y = 512 + 4608, O_FLAG = 147968, O_END = 148224;
__device__ __forceinline__ void spin_ge(const LAS unsigned char* ldl, int off, unsigned target) {
    for (;;) { const unsigned v = __builtin_amdgcn_readfirstlane(*(volatile const LAS unsigned*)(ldl + off)); if (v >= target) break; __builtin_amdgcn_s_sleep(1); }
    asm volatile("" ::: "memory");
}
#define S3_TRFRAG(base_) ({ const s16x4_t lo_ = __builtin_bit_cast(s16x4_t, __builtin_amdgcn_ds_read_tr16_b64_v4i16((LAS s16x4_t*)(ldl + (base_)))); \
                            const s16x4_t hi_ = __builtin_bit_cast(s16x4_t, __builtin_amdgcn_ds_read_tr16_b64_v4i16((LAS s16x4_t*)(ldl + (base_) + 8 * 72))); \
                            (bf16x8_t){lo_[0], lo_[1], lo_[2], lo_[3], hi_[0], hi_[1], hi_[2], hi_[3]}; })
__device__ __forceinline__ void producer(const Args& a, int item, unsigned char* lds, int p) {
    const int ps = item & 1, h = (item >> 1) & 15, dir = (item >> 5) & 1, b = item >> 6, g = h >> 3;
    const int lane0 = threadIdx.x & 63;
    const LAS unsigned char* ldl = (const LAS unsigned char*)lds; LAS unsigned char* ldw = (LAS unsigned char*)lds;
    const bf16_t* XB = (const bf16_t*)(a.ws + WS_XBC16); const float* ACT = (const float*)(a.ws + WS_ACT); const float* SM = (const float*)(a.ws + WS_SMALL);
    const float A = -expf(a.in[dir ? 13 : 12][h]); const float dtb = a.in[dir ? 11 : 10][h];
#define S3_DMA(c_, slot3_) do { const int t_ = dir ? SEQ - 1 - (64 * (c_) + lane0) : 64 * (c_) + lane0; const size_t mi_ = (size_t)b * SEQ + t_; \
        const bf16_t* br_ = XB + mi_ * 1536 + 1024 + g * 128; const bf16_t* cr_ = XB + mi_ * 1536 + 1280 + g * 128; const float* xr_ = ACT + mi_ * 1536 + h * 64 + ps * 32; \
        LAS unsigned char* lb_ = ldw + (slot3_) * 32768; LAS unsigned char* lx_ = ldw + O_OUT + (slot3_) * OUTB + OO_Y; \
        _Pragma("unroll") for (int x = 0; x < 16; ++x) { __builtin_amdgcn_global_load_lds((const unsigned*)(br_ + 8 * x), (LAS unsigned*)(lb_ + 1024 * x), 16, 0, 0); \
                                                         __builtin_amdgcn_global_load_lds((const unsigned*)(cr_ + 8 * x), (LAS unsigned*)(lb_ + 16384 + 1024 * x), 16, 0, 0); } \
        _Pragma("unroll") for (int x = 0; x < 8; ++x) __builtin_amdgcn_global_load_lds((const unsigned*)(xr_ + 4 * x), (LAS unsigned*)(lx_ + 1024 * x), 16, 0, 0); \
        __builtin_amdgcn_global_load_lds((const unsigned*)(SM + mi_ * 32 + dir * 16 + h), (LAS unsigned*)(ldw + O_DT + p * 256), 4, 0, 0); } while (0)
    int slot3 = p;
    for (int c = p; c < 32; c += 2) {
        int lane = lane0; asm volatile("" : "+v"(lane));
        const int r32 = lane & 31, hi = lane >> 5, trq = (lane & 15) >> 2, trp = lane & 3, trc = (lane >> 4) & 1;
        const int bo = slot3 * 32768, oo = O_OUT + slot3 * OUTB;
        if (c >= 3) spin_ge(ldl, O_FLAG, (unsigned)(c - 2));
        S3_DMA(c, slot3);
        asm volatile("s_waitcnt vmcnt(0)" ::: "memory");
        LAS float* Gs = (LAS float*)(ldw + oo); LAS float* Es = Gs + 64;
        const float dt = softplus_f(*(const LAS float*)(ldl + O_DT + p * 256 + lane * 4) + dtb);
        const float cs = wave_incl_scan(dt * A, lane); const float csL = __shfl(cs, 63);
        Gs[lane] = cs; Es[lane] = __expf(cs);
        {   const float wsc = dt * __expf(csL - cs);
#pragma unroll
            for (int x = 0; x < 8; ++x) { const f32x4 xv = *(const LAS f32x4*)(ldl + oo + OO_Y + (x * 64 + lane) * 16);
                v2u d; d.x = cvtpk_rne(xv.x * dt, xv.y * dt); d.y = cvtpk_rne(xv.z * dt, xv.w * dt); *(LAS v2u*)(ldw + O_XD + p * 4608 + lane * 72 + 8 * x) = d;
                v2u w; w.x = cvtpk_rne(xv.x * wsc, xv.y * wsc); w.y = cvtpk_rne(xv.z * wsc, xv.w * wsc); *(LAS v2u*)(ldw + oo + OO_XW + lane * 72 + 8 * x) = w; }
        }
        LDS_WAIT();
        f32x16_t g00, g01, g11;
#pragma unroll
        for (int r = 0; r < 16; ++r) { g00[r] = 0.f; g01[r] = 0.f; g11[r] = 0.f; }
#pragma unroll
        for (int kk = 0; kk < 8; ++kk) { const int fo = ((2 * kk + hi) * 64 + r32) * 16;
            const bf16x8_t A0 = *(const LAS bf16x8_t*)(ldl + bo + fo), A1 = *(const LAS bf16x8_t*)(ldl + bo + fo + 512);
            const bf16x8_t B0 = *(const LAS bf16x8_t*)(ldl + bo + 16384 + fo), B1 = *(const LAS bf16x8_t*)(ldl + bo + 16384 + fo + 512);
            g00 = __builtin_amdgcn_mfma_f32_32x32x16_bf16(A0, B0, g00, 0, 0, 0); g01 = __builtin_amdgcn_mfma_f32_32x32x16_bf16(A0, B1, g01, 0, 0, 0); g11 = __builtin_amdgcn_mfma_f32_32x32x16_bf16(A1, B1, g11, 0, 0, 0); }
        {   const float cst0 = Gs[r32], cst1 = Gs[32 + r32];
#pragma unroll
            for (int r = 0; r < 16; ++r) { const int il = (r & 3) + 8 * (r >> 2) + 4 * hi; const float css0 = Gs[il], css1 = Gs[32 + il];
                g00[r] = (il <= r32) ? g00[r] * __expf(cst0 - css0) : 0.f; g01[r] = g01[r] * __expf(cst1 - css0); g11[r] = (il <= r32) ? g11[r] * __expf(cst1 - css1) : 0.f; } }
        asm volatile("" ::: "memory");
        f32x16_t y0, y1;
#pragma unroll
        for (int r = 0; r < 16; ++r) { y0[r] = 0.f; y1[r] = 0.f; }
        {   const int xo = O_XD + p * 4608 + (4 * hi + trq) * 72 + (16 * trc + 4 * trp) * 2;
            const bf16x8_t x0 = S3_TRFRAG(xo), x1 = S3_TRFRAG(xo + 16 * 72), x2 = S3_TRFRAG(xo + 32 * 72), x3 = S3_TRFRAG(xo + 48 * 72);
            y0 = __builtin_amdgcn_mfma_f32_32x32x16_bf16(acc_frag<0>(g00), x0, y0, 0, 0, 0); y0 = __builtin_amdgcn_mfma_f32_32x32x16_bf16(acc_frag<1>(g00), x1, y0, 0, 0, 0);
            y1 = __builtin_amdgcn_mfma_f32_32x32x16_bf16(acc_frag<0>(g01), x0, y1, 0, 0, 0); y1 = __builtin_amdgcn_mfma_f32_32x32x16_bf16(acc_frag<1>(g01), x1, y1, 0, 0, 0);
            y1 = __builtin_amdgcn_mfma_f32_32x32x16_bf16(acc_frag<0>(g11), x2, y1, 0, 0, 0); y1 = __builtin_amdgcn_mfma_f32_32x32x16_bf16(acc_frag<1>(g11), x3, y1, 0, 0, 0); }
#pragma unroll
        for (int r = 0; r < 16; ++r) { *(LAS float*)(ldw + oo + OO_Y + r * 256 + lane * 4) = y0[r]; *(LAS float*)(ldw + oo + OO_Y + (16 + r) * 256 + lane * 4) = y1[r]; }
        LDS_WAIT();
        if (lane == 0) *(volatile LAS unsigned*)(ldw + O_FLAG + 64 + 4 * c) = 1u;
        slot3 = (slot3 == 0) ? 2 : slot3 - 1;
    }
#undef S3_DMA
}
__device__ __forceinline__ void consumer(const Args& a, int item, unsigned char* lds) {
    const int ps = item & 1, h = (item >> 1) & 15, dir = (item >> 5) & 1, b = item >> 6;
    const int lane0 = threadIdx.x & 63;
    const LAS unsigned char* ldl = (const LAS unsigned char*)lds; LAS unsigned char* ldw = (LAS unsigned char*)lds;
    float* Y = (float*)(a.ws + (dir ? WS_YB : WS_YF));
    f32x16_t H[4];
#pragma unroll
    for (int nt = 0; nt < 4; ++nt)
#pragma unroll
        for (int r = 0; r < 16; ++r) H[nt][r] = 0.f;
    int slot3 = 0;
    for (int c = 0; c < 32; ++c) {
        int lane = lane0; asm volatile("" : "+v"(lane));
        const int r32 = lane & 31, hi = lane >> 5, trq = (lane & 15) >> 2, trp = lane & 3, trc = (lane >> 4) & 1;
        const int bo = slot3 * 32768, oo = O_OUT + slot3 * OUTB;
        const LAS float* Gs = (const LAS float*)(ldl + oo); const LAS float* Es = Gs + 64;
        spin_ge(ldl, O_FLAG + 64 + 4 * c, 1u);
        {   f32x16_t Z0, Z1;
#pragma unroll
            for (int r = 0; r < 16; ++r) { Z0[r] = 0.f; Z1[r] = 0.f; }
#define S3_LFRAG(off_) join44(*(const LAS v2u*)(ldl + (off_)), *(const LAS v2u*)(ldl + (off_) + 1024))
#pragma unroll
            for (int nt = 0; nt < 4; ++nt) { const bf16x8_t hb0 = acc_frag<0>(H[nt]), hb1 = acc_frag<1>(H[nt]);
                const int ro = bo + 16384 + ((4 * nt) * 64 + r32) * 16 + 8 * hi;
                Z0 = __builtin_amdgcn_mfma_f32_32x32x16_bf16(S3_LFRAG(ro), hb0, Z0, 0, 0, 0); Z0 = __builtin_amdgcn_mfma_f32_32x32x16_bf16(S3_LFRAG(ro + 2048), hb1, Z0, 0, 0, 0);
                Z1 = __builtin_amdgcn_mfma_f32_32x32x16_bf16(S3_LFRAG(ro + 512), hb0, Z1, 0, 0, 0); Z1 = __builtin_amdgcn_mfma_f32_32x32x16_bf16(S3_LFRAG(ro + 512 + 2048), hb1, Z1, 0, 0, 0); }
#undef S3_LFRAG
            const int tb = dir ? SEQ - 1 - (64 * c + 4 * hi) : 64 * c + 4 * hi;
            float* yb = Y + ((size_t)b * SEQ + tb) * 1024 + h * 64 + ps * 32 + r32;
#pragma unroll
            for (int r = 0; r < 16; ++r) { const int il0 = (r & 3) + 8 * (r >> 2), il = il0 + 4 * hi;
                const float yd0 = *(const LAS float*)(ldl + oo + OO_Y + r * 256 + lane * 4), yd1 = *(const LAS float*)(ldl + oo + OO_Y + (16 + r) * 256 + lane * 4);
                const long ro0 = dir ? -(long)il0 * 1024 : (long)il0 * 1024, ro1 = dir ? -(long)(il0 + 32) * 1024 : (long)(il0 + 32) * 1024;
                yb[ro0] = fmaf(Es[il], Z0[r], yd0); yb[ro1] = fmaf(Es[32 + il], Z1[r], yd1); } }
        asm volatile("" ::: "memory");
        {   const float eL = __expf(Gs[63]);
            const int xo = oo + OO_XW + (4 * hi + trq) * 72 + (16 * trc + 4 * trp) * 2;
            const bf16x8_t w0 = S3_TRFRAG(xo), w1 = S3_TRFRAG(xo + 16 * 72), w2 = S3_TRFRAG(xo + 32 * 72), w3 = S3_TRFRAG(xo + 48 * 72);
#pragma unroll
            for (int nt = 0; nt < 4; ++nt) {
#pragma unroll
                for (int r = 0; r < 16; ++r) H[nt][r] *= eL;
#pragma unroll
                for (int ks = 0; ks < 4; ++ks) {
                    const int ro = bo + ((4 * nt + 2 * trc + (trp >> 1)) * 64 + 16 * ks + 4 * hi + trq) * 16 + 8 * (trp & 1);
                    const s16x4_t lo = __builtin_bit_cast(s16x4_t, __builtin_amdgcn_ds_read_tr16_b64_v4i16((LAS s16x4_t*)(ldl + ro)));
                    const s16x4_t hi4 = __builtin_bit_cast(s16x4_t, __builtin_amdgcn_ds_read_tr16_b64_v4i16((LAS s16x4_t*)(ldl + ro + 8 * 16)));
                    const bf16x8_t bfr = (bf16x8_t){lo[0], lo[1], lo[2], lo[3], hi4[0], hi4[1], hi4[2], hi4[3]};
                    H[nt] = __builtin_amdgcn_mfma_f32_32x32x16_bf16(bfr, ks == 0 ? w0 : ks == 1 ? w1 : ks == 2 ? w2 : w3, H[nt], 0, 0, 0);
                }
            }
        }
        LDS_WAIT();
        if (lane == 0) *(volatile LAS unsigned*)(ldw + O_FLAG) = (unsigned)(c + 1);
        slot3 = (slot3 == 2) ? 0 : slot3 + 1;
    }
}
#undef S3_TRFRAG
}

__device__ __forceinline__ void lru_tile(const Args& a, int item, unsigned char* lds, int pass) {
    const int n = item & 7, tc = (item >> 3) & 63, b = item >> 9, t0 = tc * 32;
    float* xc = (float*)lds; bf16_t* xcb = (bf16_t*)(lds + 16384); float* As = (float*)(lds + 25088); float* Us = As + 2 * 32 * 128; float2* sg = (float2*)(Us + 2 * 32 * 128);
    const int tid = threadIdx.x, lane = tid & 63, wave = tid >> 6;
    const bf16_t* P = (const bf16_t*)(a.ws + WS_PROJ);
    __syncthreads();
    {
        const int j = tid & 127, tg = tid >> 7, chn = n * 128 + j; const float* cw = a.in[25];
        const float w0 = cw[chn], w1 = cw[1024 + chn], w2 = cw[2048 + chn], w3 = cw[3072 + chn], cbias = a.in[26][chn];
        const int tb = t0 + tg * 8;
        const bf16_t* pp = P + ((size_t)b * SEQ + tb) * NINP + C_XL + chn;
        float xm2 = (tb >= 2) ? bf2f(pp[-2 * NINP]) : 0.f, xm1 = (tb >= 1) ? bf2f(pp[-NINP]) : 0.f, x0 = bf2f(pp[0]);
#pragma unroll
        for (int i = 0; i < 8; ++i) { const float xp1 = (tb + i + 1 < SEQ) ? bf2f(pp[(i + 1) * NINP]) : 0.f;
            const float acc = cbias + w0 * xm2 + w1 * xm1 + w2 * x0 + w3 * xp1;
            xc[(tg * 8 + i) * 128 + j] = acc; xcb[(tg * 8 + i) * 136 + j] = (bf16_t)f2bf(acc);
            xm2 = xm1; xm1 = x0; x0 = xp1; }
    }
    __syncthreads();
    {
        const int ct = wave & 3, d = wave >> 2, r32 = lane & 31, hi = lane >> 5;
        const bf16_t* WT = (const bf16_t*)(a.ws + WS_WGT);
        const bf16_t* wa_p = WT + ((size_t)((2 * d) * 8 + n) * 128 + ct * 32 + r32) * 128 + hi * 8;
        const bf16_t* wx_p = WT + ((size_t)((2 * d + 1) * 8 + n) * 128 + ct * 32 + r32) * 128 + hi * 8;
        f32x16_t ca, cx;
#pragma unroll
        for (int r = 0; r < 16; ++r) { ca[r] = 0.f; cx[r] = 0.f; }
#pragma unroll
        for (int s = 0; s < 8; ++s) {
            const bf16x8_t af = *(const bf16x8_t*)((const char*)xcb + r32 * 272 + (s * 16 + hi * 8) * 2);
            const bf16x8_t fa = *(const bf16x8_t*)(wa_p + s * 16); const bf16x8_t fx = *(const bf16x8_t*)(wx_p + s * 16);
            ca = __builtin_amdgcn_mfma_f32_32x32x16_bf16(af, fa, ca, 0, 0, 0); cx = __builtin_amdgcn_mfma_f32_32x32x16_bf16(af, fx, cx, 0, 0, 0);
        }
        const int j = ct * 32 + r32, cj = n * 128 + j;
        const float baj = a.in[d ? 33 : 28][cj], bxj = a.in[d ? 35 : 30][cj], sp = softplus_f(-a.in[d ? 36 : 31][cj]);
#pragma unroll
        for (int r = 0; r < 16; ++r) { const int t = (r & 3) + 8 * (r >> 2) + 4 * hi;
            const float rg = __builtin_amdgcn_rcpf(1.f + __expf(-(ca[r] + baj))), ig = __builtin_amdgcn_rcpf(1.f + __expf(-(cx[r] + bxj))); const float la = -8.f * rg * sp;
            const float av = __expf(la);
            const float om = (la > -0.0625f) ? -2.f * la * (1.f + la * (1.f + la * (0.6666667f + 0.3333333f * la))) : (1.f - av) * (1.f + av);
            As[(d * 32 + t) * 128 + j] = av; Us[(d * 32 + t) * 128 + j] = __builtin_amdgcn_sqrtf(om) * (ig * xc[t * 128 + j]); }
    }
    __syncthreads();
    {
        const int j = tid & 127, d = (tid >> 7) & 1, seg = tid >> 8;
        float Pp = 1.f, H = 0.f;
#pragma unroll
        for (int k = 0; k < 16; ++k) { const int q = seg * 16 + k, t = d ? 31 - q : q; const float a_ = As[(d * 32 + t) * 128 + j], u_ = Us[(d * 32 + t) * 128 + j]; H = fmaf(a_, H, u_); Pp *= a_; }
        sg[(d * 2 + seg) * 128 + j] = make_float2(Pp, H);
        __syncthreads();
        float2* LS = (float2*)(a.ws + WS_LSUM);
        if (pass == 0) {
            if (seg == 0) { const float2 s1 = sg[(d * 2 + 1) * 128 + j]; LS[((size_t)(d * 4 + b) * 64 + tc) * 1024 + n * 128 + j] = make_float2(Pp * s1.x, fmaf(s1.x, H, s1.y)); }
        } else {
            float c = 0.f;
            const float2* lsp = LS + ((size_t)(d * 4 + b) * 64) * 1024 + n * 128 + j;
#pragma unroll 1
            for (int c0 = 0; c0 < 64; c0 += 16) { float2 sv[16];
#pragma unroll
                for (int i = 0; i < 16; ++i) { const int cc = d ? 63 - (c0 + i) : c0 + i; sv[i] = lsp[(size_t)cc * 1024]; }
#pragma unroll
                for (int i = 0; i < 16; ++i) { const int cc = d ? 63 - (c0 + i) : c0 + i; const bool before = d ? (cc > tc) : (cc < tc); if (before) c = fmaf(sv[i].x, c, sv[i].y); } }
            if (seg == 1) { const float2 s0 = sg[(d * 2) * 128 + j]; c = fmaf(s0.x, c, s0.y); }
            float h = c;
#pragma unroll
            for (int k = 0; k < 16; ++k) { const int q = seg * 16 + k, t = d ? 31 - q : q; const float a_ = As[(d * 32 + t) * 128 + j], u_ = Us[(d * 32 + t) * 128 + j]; h = fmaf(a_, h, u_); Us[(d * 32 + t) * 128 + j] = h; }
            __syncthreads();
            bf16_t* YC = (bf16_t*)(a.ws + WS_YCAT);
            const int jj = tid & 127, tg = tid >> 7;
#pragma unroll
            for (int i = 0; i < 8; ++i) { const int t = tg * 8 + i; const size_t row = (size_t)b * SEQ + t0 + t;
                const float hs = Us[t * 128 + jj] + Us[(32 + t) * 128 + jj]; const float gl = bf2f(P[row * NINP + C_GL + n * 128 + jj]);
                YC[row * 2048 + 1024 + n * 128 + jj] = (bf16_t)f2bf(hs * silu_f(gl)); }
        }
    }
}

template <bool FINAL>
__device__ __forceinline__ void lru_wave(const Args& a, int witem, unsigned char* ldsw, int lane) {
    asm volatile("" : "+v"(lane));
    const int n = witem & 7, tc = (witem >> 3) & 63, b = witem >> 9, t0 = tc * 32;
    const int r32 = lane & 31, hi = lane >> 5;
    bf16_t* xcb = (bf16_t*)ldsw;
    const bf16_t* P = (const bf16_t*)(a.ws + WS_PROJ);
    bf16_t* XC = (bf16_t*)(a.ws + WS_XC16) + ((size_t)b * SEQ + t0) * 1024 + n * 128;
    if constexpr (!FINAL) {
        const int chn = n * 128 + 2 * lane; const float* cw = a.in[25];
        const f32x2 w0 = *(const f32x2*)(cw + chn), w1 = *(const f32x2*)(cw + 1024 + chn), w2 = *(const f32x2*)(cw + 2048 + chn), w3 = *(const f32x2*)(cw + 3072 + chn), cb2 = *(const f32x2*)(a.in[26] + chn);
        const bf16_t* pp = P + ((size_t)b * SEQ + t0) * NINP + C_XL + chn;
        f32x2 xm2 = {0.f, 0.f}, xm1 = {0.f, 0.f}, x0;
        if (t0 >= 2) { const unsigned v = *(const unsigned*)(pp - 2 * NINP); xm2 = (f32x2){bf2f(v & 0xffffu), __uint_as_float(v & 0xffff0000u)}; }
        if (t0 >= 1) { const unsigned v = *(const unsigned*)(pp - NINP); xm1 = (f32x2){bf2f(v & 0xffffu), __uint_as_float(v & 0xffff0000u)}; }
        { const unsigned v = *(const unsigned*)pp; x0 = (f32x2){bf2f(v & 0xffffu), __uint_as_float(v & 0xffff0000u)}; }
#pragma unroll 8
        for (int i = 0; i < 32; ++i) { f32x2 xp1 = {0.f, 0.f};
            if (t0 + i + 1 < SEQ) { const unsigned v = *(const unsigned*)(pp + (size_t)(i + 1) * NINP); xp1 = (f32x2){bf2f(v & 0xffffu), __uint_as_float(v & 0xffff0000u)}; }
            const f32x2 acc = cb2 + w0 * xm2 + w1 * xm1 + w2 * x0 + w3 * xp1;
            const unsigned pk = pk2(acc.x, acc.y);
            *(unsigned*)(xcb + i * 136 + 2 * lane) = pk; *(unsigned*)(XC + (size_t)i * 1024 + 2 * lane) = pk;
            xm2 = xm1; xm1 = x0; x0 = xp1; }
        LDS_WAIT();
    }
    const bf16_t* WT = (const bf16_t*)(a.ws + WS_WGT);
    float2* LS = (float2*)(a.ws + WS_LSUM);
    const bf16_t* xcr = XC + (size_t)r32 * 1024 + hi * 8;
#pragma unroll 1
    for (int ct = 0; ct < 4; ++ct) {
    const int j = ct * 32 + r32, cj = n * 128 + j;
    float xv[16];
#pragma unroll
    for (int r = 0; r < 16; ++r) { const int t = (r & 3) + 8 * (r >> 2) + 4 * hi; xv[r] = bf2f(FINAL ? XC[(size_t)t * 1024 + j] : xcb[t * 136 + j]); }
    float hs[16];
#pragma unroll
    for (int d = 0; d < 2; ++d) {
        const bf16_t* wa_p = WT + ((size_t)((2 * d) * 8 + n) * 128 + j) * 128 + hi * 8;
        const bf16_t* wx_p = WT + ((size_t)((2 * d + 1) * 8 + n) * 128 + j) * 128 + hi * 8;
        f32x16_t ca, cx;
#pragma unroll
        for (int r = 0; r < 16; ++r) { ca[r] = 0.f; cx[r] = 0.f; }
#pragma unroll
        for (int s = 0; s < 8; ++s) {
            const bf16x8_t af = FINAL ? *(const bf16x8_t*)(xcr + s * 16) : *(const bf16x8_t*)((const char*)xcb + r32 * 272 + (s * 16 + hi * 8) * 2);
            const bf16x8_t fa = *(const bf16x8_t*)(wa_p + s * 16); const bf16x8_t fx = *(const bf16x8_t*)(wx_p + s * 16);
            ca = __builtin_amdgcn_mfma_f32_32x32x16_bf16(af, fa, ca, 0, 0, 0); cx = __builtin_amdgcn_mfma_f32_32x32x16_bf16(af, fx, cx, 0, 0, 0);
        }
        asm volatile("" ::: "memory");
        const float baj = a.in[d ? 33 : 28][cj], bxj = a.in[d ? 35 : 30][cj], sp = softplus_f(-a.in[d ? 36 : 31][cj]);
        float av[16], uv[16];
#pragma unroll
        for (int r = 0; r < 16; ++r) { const int t = (r & 3) + 8 * (r >> 2) + 4 * hi;
            const float rg = __builtin_amdgcn_rcpf(1.f + __expf(-(ca[r] + baj))), ig = __builtin_amdgcn_rcpf(1.f + __expf(-(cx[r] + bxj))); const float la = -8.f * rg * sp;
            av[r] = __expf(la);
            const float om = (la > -0.0625f) ? -2.f * la * (1.f + la * (1.f + la * (0.6666667f + 0.3333333f * la))) : (1.f - av[r]) * (1.f + av[r]);
            uv[r] = __builtin_amdgcn_sqrtf(om) * (ig * xv[r]); }
        asm volatile("" ::: "memory");
        float Pg[4], Hg[4];
#pragma unroll
        for (int sg = 0; sg < 4; ++sg) { float Pp = 1.f, Hh = 0.f;
#pragma unroll
            for (int e4 = 0; e4 < 4; ++e4) { const int r = 4 * sg + (d ? 3 - e4 : e4); Hh = fmaf(av[r], Hh, uv[r]); Pp *= av[r]; }
            Pg[sg] = Pp; Hg[sg] = Hh; }
        float Po[4], Ho[4];
#pragma unroll
        for (int sg = 0; sg < 4; ++sg) { Po[sg] = __shfl_xor(Pg[sg], 32); Ho[sg] = __shfl_xor(Hg[sg], 32); }
        if constexpr (!FINAL) {
            float Ac = 1.f, Hc = 0.f;
#pragma unroll
            for (int qq = 0; qq < 8; ++qq) { const int q = d ? 7 - qq : qq;
                const bool mine = ((q & 1) == hi); const float pq = mine ? Pg[q >> 1] : Po[q >> 1], hq_ = mine ? Hg[q >> 1] : Ho[q >> 1];
                Hc = fmaf(pq, Hc, hq_); Ac *= pq; }
            if (hi == 0) LS[((size_t)(d * 4 + b) * 64 + tc) * 1024 + cj] = make_float2(Ac, Hc);
        } else {
            float c = 0.f;
            const float2* lsp = LS + ((size_t)(d * 4 + b) * 64) * 1024 + cj;
            const int nneed = d ? 63 - tc : tc;
#pragma unroll 1
            for (int c0 = 0; c0 < nneed; c0 += 16) { float2 sv[16];
#pragma unroll
                for (int i = 0; i < 16; ++i) { const int ci = (c0 + i < nneed) ? c0 + i : nneed - 1; const int cc = d ? 63 - ci : ci; sv[i] = lsp[(size_t)cc * 1024]; }
#pragma unroll
                for (int i = 0; i < 16; ++i) { if (c0 + i < nneed) c = fmaf(sv[i].x, c, sv[i].y); } }
            asm volatile("" ::: "memory");
            float cin[4];
#pragma unroll
            for (int qq = 0; qq < 8; ++qq) { const int q = d ? 7 - qq : qq;
                const bool mine = ((q & 1) == hi); const float pq = mine ? Pg[q >> 1] : Po[q >> 1], hq_ = mine ? Hg[q >> 1] : Ho[q >> 1];
                if (mine) cin[q >> 1] = c;
                c = fmaf(pq, c, hq_); }
#pragma unroll
            for (int sg = 0; sg < 4; ++sg) { float h = cin[sg];
#pragma unroll
                for (int e4 = 0; e4 < 4; ++e4) { const int r = 4 * sg + (d ? 3 - e4 : e4); h = fmaf(av[r], h, uv[r]); hs[r] = (d == 0) ? h : hs[r] + h; } }
        }
    }
    if constexpr (FINAL) {
        bf16_t* YC = (bf16_t*)(a.ws + WS_YCAT);
#pragma unroll
        for (int r = 0; r < 16; ++r) { const int t = (r & 3) + 8 * (r >> 2) + 4 * hi; const size_t row = (size_t)b * SEQ + t0 + t;
            const float gl = bf2f(P[row * NINP + C_GL + cj]);
            YC[row * 2048 + 1024 + cj] = (bf16_t)f2bf(hs[r] * silu_f(gl)); }
    }
    }
    LDS_WAIT();
}

template <int d>
__device__ __forceinline__ void lru_run(const Args& a, int task, int lane) {
    asm volatile("" : "+v"(lane));
    const int run = task & 7, ct = (task >> 4) & 3, n = (task >> 6) & 7, b = task >> 9;
    const int r32 = lane & 31, hi = lane >> 5, j = ct * 32 + r32, cj = n * 128 + j;
    const bf16_t* WT = (const bf16_t*)(a.ws + WS_WGT);
    const bf16_t* wa_p = WT + ((size_t)((2 * d) * 8 + n) * 128 + j) * 128 + hi * 8;
    const bf16_t* wx_p = WT + ((size_t)((2 * d + 1) * 8 + n) * 128 + j) * 128 + hi * 8;
    bf16x8_t fa[8], fx[8];
#pragma unroll
    for (int s = 0; s < 8; ++s) { fa[s] = *(const bf16x8_t*)(wa_p + s * 16); fx[s] = *(const bf16x8_t*)(wx_p + s * 16); }
    const float baj = a.in[d ? 33 : 28][cj], bxj = a.in[d ? 35 : 30][cj], sp = softplus_f(-a.in[d ? 36 : 31][cj]);
    const float2* lsp = (const float2*)(a.ws + WS_LSUM) + ((size_t)(d * 4 + b) * 64) * 1024 + cj;
    bf16_t* HD = (bf16_t*)(a.ws + (d ? WS_HB16 : WS_HF16));
    float c = 0.f;
    { const int nneed = 8 * run;
#pragma unroll 1
      for (int c0 = 0; c0 < nneed; c0 += 8) { float2 sv[8];
#pragma unroll
          for (int i = 0; i < 8; ++i) { const int ci = c0 + i; const int cc = d ? 63 - ci : ci; sv[i] = lsp[(size_t)cc * 1024]; }
#pragma unroll
          for (int i = 0; i < 8; ++i) c = fmaf(sv[i].x, c, sv[i].y); } }
#pragma unroll 1
    for (int k = 0; k < 8; ++k) {
        const int ci = 8 * run + k, tc = d ? 63 - ci : ci, t0 = tc * 32;
        const bf16_t* XC = (const bf16_t*)(a.ws + WS_XC16) + ((size_t)b * SEQ + t0) * 1024 + n * 128;
        const bf16_t* xcr = XC + (size_t)r32 * 1024 + hi * 8;
        f32x16_t ca, cx;
#pragma unroll
        for (int r = 0; r < 16; ++r) { ca[r] = 0.f; cx[r] = 0.f; }
#pragma unroll
        for (int s = 0; s < 8; ++s) { const bf16x8_t af = *(const bf16x8_t*)(xcr + s * 16);
            ca = __builtin_amdgcn_mfma_f32_32x32x16_bf16(af, fa[s], ca, 0, 0, 0); cx = __builtin_amdgcn_mfma_f32_32x32x16_bf16(af, fx[s], cx, 0, 0, 0); }
        float av[16], uv[16];
#pragma unroll
        for (int r = 0; r < 16; ++r) { const int t = (r & 3) + 8 * (r >> 2) + 4 * hi;
            const float xvr = bf2f(XC[(size_t)t * 1024 + j]);
            const float rg = __builtin_amdgcn_rcpf(1.f + __expf(-(ca[r] + baj))), ig = __builtin_amdgcn_rcpf(1.f + __expf(-(cx[r] + bxj))); const float la = -8.f * rg * sp;
            av[r] = __expf(la);
            const float om = (la > -0.0625f) ? -2.f * la * (1.f + la * (1.f + la * (0.6666667f + 0.3333333f * la))) : (1.f - av[r]) * (1.f + av[r]);
            uv[r] = __builtin_amdgcn_sqrtf(om) * (ig * xvr); }
        float Pg[4], Hg[4];
#pragma unroll
        for (int sg = 0; sg < 4; ++sg) { float Pp = 1.f, Hh = 0.f;
#pragma unroll
            for (int e4 = 0; e4 < 4; ++e4) { const int r = 4 * sg + (d ? 3 - e4 : e4); Hh = fmaf(av[r], Hh, uv[r]); Pp *= av[r]; }
            Pg[sg] = Pp; Hg[sg] = Hh; }
        float Po[4], Ho[4];
#pragma unroll
        for (int sg = 0; sg < 4; ++sg) { Po[sg] = __shfl_xor(Pg[sg], 32); Ho[sg] = __shfl_xor(Hg[sg], 32); }
        float cin[4];
#pragma unroll
        for (int qq = 0; qq < 8; ++qq) { const int q = d ? 7 - qq : qq;
            const bool mine = ((q & 1) == hi); const float pq = mine ? Pg[q >> 1] : Po[q >> 1], hq_ = mine ? Hg[q >> 1] : Ho[q >> 1];
            if (mine) cin[q >> 1] = c;
            c = fmaf(pq, c, hq_); }
#pragma unroll
        for (int sg = 0; sg < 4; ++sg) { float h = cin[sg];
#pragma unroll
            for (int e4 = 0; e4 < 4; ++e4) { const int r = 4 * sg + (d ? 3 - e4 : e4); const int t = (r & 3) + 8 * (r >> 2) + 4 * hi;
                h = fmaf(av[r], h, uv[r]); HD[((size_t)b * SEQ + t0 + t) * 1024 + cj] = (bf16_t)f2bf(h); } }
    }
}

__device__ __forceinline__ void combine1_phase(const Args& a, int gw, int NGW, int lane) {
    const float* OF = (const float*)(a.ws + WS_YF); const float* OB = (const float*)(a.ws + WS_YB);
    const bf16_t* P = (const bf16_t*)(a.ws + WS_PROJ); bf16_t* YC = (bf16_t*)(a.ws + WS_YCAT);
    const float* gn = a.in[24];
    for (int m = gw; m < MTOK; m += NGW) {
        const int ch = lane * 16, d0 = ch & 127;
        float z[16], ov[16];
        unpack8(*(const v4u*)(P + (size_t)m * NINP + C_Z + ch), z); unpack8(*(const v4u*)(P + (size_t)m * NINP + C_Z + ch + 8), z + 8);
#pragma unroll
        for (int q = 0; q < 4; ++q) { const f32x4 f = *(const f32x4*)(OF + (size_t)m * 1024 + ch + 4 * q), bk = *(const f32x4*)(OB + (size_t)m * 1024 + ch + 4 * q); const f32x4 o = f + bk;
            ov[4 * q] = o.x; ov[4 * q + 1] = o.y; ov[4 * q + 2] = o.z; ov[4 * q + 3] = o.w; }
        float ss = 0.f;
#pragma unroll
        for (int i = 0; i < 16; ++i) ss += ov[i] * ov[i];
        ss = group_sum<8>(ss);
        const float r = rsqrtf(ss * (1.f / 128.f) + EPS);
#pragma unroll
        for (int i = 0; i < 16; ++i) ov[i] = ov[i] * r * gn[d0 + i] * silu_f(z[i]);
        *(v4u*)(YC + (size_t)m * 2048 + ch) = pack8(ov); *(v4u*)(YC + (size_t)m * 2048 + ch + 8) = pack8(ov + 8);
        { const bf16_t* HF = (const bf16_t*)(a.ws + WS_HF16); const bf16_t* HB = (const bf16_t*)(a.ws + WS_HB16);
          float hf[16], hb[16];
          unpack8(*(const v4u*)(P + (size_t)m * NINP + C_GL + ch), z); unpack8(*(const v4u*)(P + (size_t)m * NINP + C_GL + ch + 8), z + 8);
          unpack8(*(const v4u*)(HF + (size_t)m * 1024 + ch), hf); unpack8(*(const v4u*)(HF + (size_t)m * 1024 + ch + 8), hf + 8);
          unpack8(*(const v4u*)(HB + (size_t)m * 1024 + ch), hb); unpack8(*(const v4u*)(HB + (size_t)m * 1024 + ch + 8), hb + 8);
#pragma unroll
          for (int i = 0; i < 16; ++i) ov[i] = (hf[i] + hb[i]) * silu_f(z[i]);
          *(v4u*)(YC + (size_t)m * 2048 + 1024 + ch) = pack8(ov); *(v4u*)(YC + (size_t)m * 2048 + 1024 + ch + 8) = pack8(ov + 8); }
    }
}

__device__ __forceinline__ void final_norm_phase(const Args& a, int gw, int NGW, int lane) {
    const float* nw = a.in[38];
    for (int m = gw; m < MTOK; m += NGW) {
        f32x4* xr = (f32x4*)(a.out + (size_t)m * 2048) + lane;
        f32x4 v[8]; float s = 0.f;
#pragma unroll
        for (int j = 0; j < 8; ++j) { v[j] = xr[64 * j]; s += (v[j].x * v[j].x + v[j].y * v[j].y) + (v[j].z * v[j].z + v[j].w * v[j].w); }
        const float rstd = rsqrtf(group_sum<64>(s) * (1.f / 2048.f) + EPS);
#pragma unroll
        for (int j = 0; j < 8; ++j) { const f32x4 w = *(const f32x4*)(nw + (64 * j + lane) * 4); xr[64 * j] = v[j] * rstd * w; }
    }
}

typedef GAS unsigned gu32;
#define RLX_AGENT __ATOMIC_RELAXED, __HIP_MEMORY_SCOPE_AGENT
constexpr int CW_BAR = 4096;
constexpr int MISC_OFF = 163840 - 128;
#define XB_TMO      128
#define XB_XCNT(j)  (256  + 64 * (j))
#define XB_XSUB(j)  (1280 + 64 * (j))
#define XB_XGEN(j)  (2304 + 64 * (j))
#define XB_TOP      3328
#define XB_TOPGEN   3392
#define XCD_BAR_WORDS 3456
#define XB_SPIN_CAP (1u << 18)

__device__ __forceinline__ unsigned xb_ld(unsigned* p)              { return __hip_atomic_load(p, __ATOMIC_RELAXED, __HIP_MEMORY_SCOPE_AGENT); }
__device__ __forceinline__ unsigned xb_add(unsigned* p, unsigned v) { return __hip_atomic_fetch_add(p, v, __ATOMIC_RELAXED, __HIP_MEMORY_SCOPE_AGENT); }
__device__ __forceinline__ unsigned xb_xcc_id() { return (unsigned)__builtin_amdgcn_s_getreg((3 << 11) | 20) & 0xFu; }
#define XB_SPIN(cond, bar) do { unsigned _sp = 0; while (cond) { __builtin_amdgcn_s_sleep(1); \
    if ((++_sp & 255u) == 0u) { if (xb_ld(&(bar)[XB_TMO])) break; if (_sp > XB_SPIN_CAP) { atomicAdd(&(bar)[XB_TMO], 1u); break; } } } } while (0)

struct XcdBarrier {
    unsigned* bar; unsigned x;
    volatile LAS unsigned* st;
};

__device__ __forceinline__ XcdBarrier xcd_barrier_post(unsigned* bar, volatile LAS unsigned* st) {
    XcdBarrier b; b.bar = bar; b.x = xb_xcc_id(); b.st = st;
    if (threadIdx.x == 0) (void)xb_add(&bar[XB_XCNT(b.x)], 1u);
    return b;
}
__device__ __forceinline__ void xcd_barrier_complete(unsigned* bar, unsigned x, unsigned& nloc, unsigned& nx) {
    const unsigned G = gridDim.x * gridDim.y * gridDim.z;
    unsigned sum, cnt, mine, sp = 0u;
    for (;;) {
        sum = 0u; cnt = 0u; mine = 0u;
#pragma unroll
        for (unsigned j = 0; j < 16; ++j) { const unsigned c = xb_ld(&bar[XB_XCNT(j)]); sum += c; cnt += (c > 0u) ? 1u : 0u; mine = (j == x) ? c : mine; }
        if (sum == G) break;
        __builtin_amdgcn_s_sleep(1);
        if ((++sp & 255u) == 0u) { if (xb_ld(&bar[XB_TMO])) break; if (sp > XB_SPIN_CAP) { atomicAdd(&bar[XB_TMO], 1u); break; } }
    }
    nloc = mine > 0u ? mine : 1u; nx = cnt > 0u ? cnt : 1u;
}

__device__ __forceinline__ void xcd_barrier(const XcdBarrier& b) {
    asm volatile("s_waitcnt vmcnt(0)" ::: "memory");
    __syncthreads();
    if (threadIdx.x == 0) {
        unsigned* bar = b.bar;
        __builtin_amdgcn_s_waitcnt(0);
        unsigned nloc = b.st[0], nx = b.st[1];
        if (nloc == 0u) { xcd_barrier_complete(bar, b.x, nloc, nx); b.st[0] = nloc; b.st[1] = nx; }
        const unsigned old = xb_add(&bar[XB_XSUB(b.x)], 1u);
        const unsigned gen = old / nloc;
        if (old + 1u == (gen + 1u) * nloc) {
            __builtin_amdgcn_fence(__ATOMIC_RELEASE, "agent");
            asm volatile("s_waitcnt vmcnt(0)" ::: "memory");
            const unsigned og = xb_add(&bar[XB_TOP], 1u);
            const unsigned tg = og / nx;
            if (og + 1u == (tg + 1u) * nx) xb_add(&bar[XB_TOPGEN], 1u);
            else XB_SPIN(xb_ld(&bar[XB_TOPGEN]) == tg, bar);
            __builtin_amdgcn_fence(__ATOMIC_ACQUIRE, "agent");
            xb_add(&bar[XB_XGEN(b.x)], 1u);
            asm volatile("s_waitcnt vmcnt(0)" ::: "memory");
        } else {
            XB_SPIN(xb_ld(&bar[XB_XGEN(b.x)]) == gen, bar);
            __builtin_amdgcn_fence(__ATOMIC_ACQUIRE, "agent");
            asm volatile("s_waitcnt vmcnt(0)" ::: "memory");
        }
    }
    __syncthreads();
}

#ifndef PROBE_MASK
#define PROBE_MASK 0
#endif
#define REP(bit) for (int rep_ = 0; rep_ < 1 + ((PROBE_MASK >> (bit)) & 1); ++rep_)
#ifndef PROBE_SSD
#define PROBE_SSD 0
#endif
#ifndef PROBE_GDN
#define PROBE_GDN 0
#endif
#ifndef PROBE_LRU
#define PROBE_LRU 0
#endif
#ifndef MK_SINGLE
#define MK_SINGLE 1
#endif
__global__ void __launch_bounds__(NTHREADS, 2) mk_fwd(Args a) {
    extern __shared__ __attribute__((aligned(16))) unsigned char lds[];
    LAS unsigned char* ldsl = (LAS unsigned char*)lds;
    const int tid = threadIdx.x, lane = tid & 63, wave = __builtin_amdgcn_readfirstlane(tid >> 6);
    const int G = gridDim.x, bx = blockIdx.x;
    const int vcu = (G % 8 == 0) ? (bx % 8) * (G / 8) + bx / 8 : bx;
    const int gw = vcu * NWAVES + wave, NGW = G * NWAVES;
    unsigned char* ws = a.ws;
    volatile LAS unsigned* MISC = (volatile LAS unsigned*)(ldsl + MISC_OFF);
    if (tid < 32) MISC[tid] = 0u;
    __syncthreads();
    XcdBarrier bar; bar.bar = (unsigned*)(ws + WS_CTL) + CW_BAR; bar.x = 0; bar.st = nullptr;
    if (a.ph_hi - a.ph_lo > 1) bar = xcd_barrier_post((unsigned*)(ws + WS_CTL) + CW_BAR, MISC + 8);
#define IN(k) (a.ph_lo <= (k) && (k) < a.ph_hi)
#define SEAM(k) do { if (IN(k) && IN((k) + 1)) { xcd_barrier(bar); } } while (0)

    if (IN(0)) { p0_prologue(a, ldsl, vcu, G); } SEAM(0);
    if (IN(1)) { REP(0) normmod_phase(a, a.in[0], 0, gw, NGW, lane); } SEAM(1);
    if (IN(2)) {
        pg8::Gemm g{(const bf16_t*)(ws + WS_H), (const bf16_t*)(ws + WS_WIN0), MTOK, NINP, 2048}; pg8::StaticOrder S; S.init(MTOK, NINP, G, bx);
        pg8::EpiProj E{(bf16_t*)(ws + WS_PROJ), (float*)(ws + WS_SMALL), NINP, A_DT / 256};
        REP(1) { pg8::gemm_phase<pg8::EpiProj, pg8::StaticOrder, true, true>(ldsl, g, S, E); __syncthreads(); }
    } SEAM(2);
    if (IN(3)) { REP(0) post0_phase(a, gw, NGW, lane); } SEAM(3);
    if (IN(4)) {
        for (int u = vcu; u < 256; u += G) { const int b = u >> 6, h = (u >> 3) & 7, qb = u & 7, kvh = h >> 2; const size_t row0 = (size_t)b * SEQ + qb * 256;
            att::attn_dense_body((const att::bf16*)(ws + WS_QB) + row0 * 1024 + h * 128, (const att::bf16*)(ws + WS_KB) + (size_t)b * SEQ * 256 + kvh * 128,
                                 (const att::bf16*)(ws + WS_VB) + (size_t)b * SEQ * 256 + kvh * 128, (bf16_t*)(ws + WS_YCAT) + row0 * 2048 + h * 128,
                                 (const bf16_t*)(ws + WS_PROJ) + row0 * NINP + A_GA + h * 128, SEQ, (char*)lds);
            __syncthreads(); }
        for (int it = vcu; it < 256; it += G) {
            if (tid < 64) ((LAS unsigned*)(ldsl + ssd3::O_FLAG))[tid] = 0u;
            __syncthreads();
            if (wave == 0) ssd3::consumer(a, it, lds); else if (wave <= 2) ssd3::producer(a, it, lds, wave - 1);
            else if (it == vcu && wave >= 4) { const int gi = vcu * 4 + (wave - 4); if (gi < 768) gemv_wave(a, 1, gi, lane); }
            __syncthreads(); }
    } SEAM(4);
    if (IN(5)) { REP(0) ssd_combine_phase(a, gw, NGW, lane); late_transposes(a, (LAS float*)(ldsl + wave * 16384), gw, NGW, lane); } SEAM(5);
    if (IN(6)) {
        pg8::Gemm g{(const bf16_t*)(ws + WS_YCAT), (const bf16_t*)(ws + WS_WOUT0), MTOK, 2048, 2048}; pg8::StaticOrder S; S.init(MTOK, 2048, G, bx);
        pg8::EpiResid E{a.in[0], a.out, (const float*)(ws + WS_MOD), a.in[3]};
        pg8::gemm_phase<pg8::EpiResid, pg8::StaticOrder, true, true>(ldsl, g, S, E); __syncthreads();
        if ((PROBE_MASK >> 2) & 1) { pg8::EpiNull EN; pg8::gemm_phase<pg8::EpiNull, pg8::StaticOrder, true, true>(ldsl, g, S, EN); __syncthreads(); }
        if ((PROBE_MASK >> 3) & 1) { pg8::gemm_phase<pg8::EpiResid, pg8::StaticOrder, true, true>(ldsl, g, S, E); __syncthreads(); }
    } SEAM(6);
    if (IN(7)) { REP(0) normmod_phase(a, a.out, 1, gw, NGW, lane); } SEAM(7);
    if (IN(8)) {
        pg8::Gemm g{(const bf16_t*)(ws + WS_H), (const bf16_t*)(ws + WS_WIN1), MTOK, NINP, 2048}; pg8::StaticOrder S; S.init(MTOK, NINP, G, bx);
        pg8::EpiProj E{(bf16_t*)(ws + WS_PROJ), (float*)(ws + WS_SMALL), NINP, C_SM / 256};
        pg8::gemm_phase<pg8::EpiProj, pg8::StaticOrder, true, true>(ldsl, g, S, E);
    } SEAM(8);
    if (IN(9)) { REP(0) post1_phase(a, gw, NGW, lane); } SEAM(9);
    if (IN(10)) {
        REP(5) { for (int it = gw; it < 2048; it += NGW) gdn1_item(a, it, lds + wave * GDN_LDS_PER_WAVE, lane); __syncthreads(); }
        for (int wi = gw; wi < 2048; wi += NGW) lru_wave<false>(a, wi, lds + wave * GDN_LDS_PER_WAVE, lane);
    } SEAM(10);
    if (IN(11)) {
        if (tid < 16) ((LAS unsigned*)(ldsl + gdn3::O_FLAG))[tid] = 0u;
        __syncthreads();
        if (wave == 0) { for (int it = vcu; it < 256; it += G) gdn3::chain(a, it, lds); }
        else if (wave == 1) { for (int it = vcu; it < 256; it += G) gdn3::output(a, it, lds); }
        else if ((wave & 3) >= 2) { const int hw = (wave & 1) + ((wave >> 2) << 1);
            REP(7) for (int tk = vcu * 4 + hw; tk < 2048; tk += G * 4) { if ((tk >> 3) & 1) lru_run<1>(a, tk, lane); else lru_run<0>(a, tk, lane); } }
        __syncthreads();
    } SEAM(11);
    if (IN(12)) { REP(0) combine1_phase(a, gw, NGW, lane); } SEAM(12);
    if (IN(13)) {
        pg8::Gemm g{(const bf16_t*)(ws + WS_YCAT), (const bf16_t*)(ws + WS_WOUT1), MTOK, 2048, 2048}; pg8::StaticOrder S; S.init(MTOK, 2048, G, bx);
        pg8::EpiResid E{a.out, a.out, (const float*)(ws + WS_MOD) + 4 * 6144, a.in[3] + 6144};
        pg8::gemm_phase<pg8::EpiResid, pg8::StaticOrder, true, true>(ldsl, g, S, E);
    } SEAM(13);
    if (IN(14)) { final_norm_phase(a, gw, NGW, lane); }
#undef IN
#undef SEAM
}

extern "C" void kernel_launch(void* const* d_in, const int* in_sizes, int n_in, void* d_out, int out_size, void* d_ws, size_t ws_size, hipStream_t stream) {
    static int grid = 0;
    if (grid == 0) {
        if (n_in != 39 || out_size != MTOK * DM || ws_size < WS_END) { fprintf(stderr, "kernel_launch: unexpected problem (n_in %d, out %d, ws %zu < %zu)\n", n_in, out_size, ws_size, (size_t)WS_END); grid = -1; return; }
        int dev = 0, cus = 0, per_cu = 0;
        if (hipGetDevice(&dev) != hipSuccess || hipDeviceGetAttribute(&cus, hipDeviceAttributeMultiprocessorCount, dev) != hipSuccess) { grid = -1; return; }
        if (hipFuncSetAttribute((const void*)mk_fwd, hipFuncAttributeMaxDynamicSharedMemorySize, LDS_BYTES) != hipSuccess) { fprintf(stderr, "kernel_launch: hipFuncSetAttribute failed\n"); grid = -1; return; }
        if (hipOccupancyMaxActiveBlocksPerMultiprocessor(&per_cu, (const void*)mk_fwd, NTHREADS, LDS_BYTES) != hipSuccess || per_cu < 1) { fprintf(stderr, "kernel_launch: occupancy query says %d\n", per_cu); (void)hipGetLastError(); per_cu = 1; }
        grid = cus;
    }
    if (grid < 0) return;
    (void)hipMemsetAsync((char*)d_ws + WS_CTL, 0, CTL_ZERO_BYTES, stream);
    Args a{};
    for (int i = 0; i < 39; ++i) a.in[i] = (const float*)d_in[i];
    a.out = (float*)d_out; a.ws = (unsigned char*)d_ws;
#if MK_SINGLE
    a.ph_lo = 0; a.ph_hi = NPHASE;
    void* kargs[] = {&a};
    hipError_t e = hipLaunchCooperativeKernel((const void*)mk_fwd, dim3(grid), dim3(NTHREADS), kargs, LDS_BYTES, stream);
    if (e != hipSuccess) fprintf(stderr, "kernel_launch: cooperative launch failed: %s (grid %d)\n", hipGetErrorString(e), grid);
#else
    for (int p = 0; p < NPHASE; ++p) { a.ph_lo = p; a.ph_hi = p + 1; hipLaunchKernelGGL(mk_fwd, dim3(grid), dim3(NTHREADS), LDS_BYTES, stream, a); }
#endif
}
```
